# Optimizing an MI355X kernel written in HIP

```python
import math
import jax, jax.numpy as jnp
from jax import lax
import numpy as np

D_MODEL = 2048
BATCH = 2
SEQ = 8192
DEPTH = 4

GRID_W = 64
CTX_LEN = 256
Q_BLOCK = 128
ROPE_BASE = 10000.0
EPS = 1e-6
N_EVEN = (DEPTH + 1) // 2
N_ODD = DEPTH // 2

A_HEADS = 8
A_Q_LORA = 768
A_KV_LORA = 512
A_NOPE = 128
A_ROPE = 64
A_V = 128
A_QK = A_NOPE + A_ROPE

B_HEADS = 8
B_DIM = 64
B_V = 2 * B_DIM

AB_SIZES = (A_Q_LORA, A_KV_LORA, A_ROPE, B_HEADS * 2 * B_DIM, B_HEADS * 2 * B_DIM, B_HEADS * B_V)
AB_IN = sum(AB_SIZES)
AB_OUT = A_HEADS * A_V + B_HEADS * B_V

C_HEADS = 16
C_KV_HEADS = 4
C_GROUP = C_HEADS // C_KV_HEADS
C_DIM = 128
C_IN = (C_HEADS + 2 * C_KV_HEADS) * C_DIM
C_OUT = C_HEADS * C_DIM

P_HEADS = 8
N_KEYS = 128
N_EXPERTS = N_KEYS * N_KEYS
P_DQ = 256
P_TOPK = 16
P_CHUNK = 128

kernel_name = "hybrid_mla_diff_gqa_peer_dit"


def rmsnorm(x, g):
    xf = x.astype(jnp.float32)
    y = xf * lax.rsqrt(jnp.mean(xf * xf, axis=-1, keepdims=True) + EPS)
    return (y * g.astype(jnp.float32)).astype(x.dtype)


def modulate(h, shift, scale):
    return h * (1 + scale) + shift


def axial_angles(rows, rot_dim):
    n_freq = rot_dim // 4
    freqs = ROPE_BASE ** (-jnp.arange(n_freq, dtype=jnp.float32) / n_freq)
    row = jnp.broadcast_to(jnp.arange(rows, dtype=jnp.float32)[:, None], (rows, GRID_W)).reshape(-1)
    col = jnp.broadcast_to(jnp.arange(GRID_W, dtype=jnp.float32)[None, :], (rows, GRID_W)).reshape(-1)
    return row[:, None] * freqs, col[:, None] * freqs


def rope_half(x, ang):
    half = x.shape[-1] // 2
    a = ang.reshape((ang.shape[0],) + (1,) * (x.ndim - 3) + (ang.shape[-1],))
    cos = jnp.cos(a).astype(x.dtype)
    sin = jnp.sin(a).astype(x.dtype)
    x1, x2 = x[..., :half], x[..., half:]
    return jnp.concatenate([x1 * cos - x2 * sin, x1 * sin + x2 * cos], axis=-1)


def axial_rope(x, ang):
    row_ang, col_ang = ang
    half = x.shape[-1] // 2
    return jnp.concatenate([rope_half(x[..., :half], row_ang), rope_half(x[..., half:], col_ang)], axis=-1)


def sweep_query_blocks(fn, q):
    b, s = q.shape[:2]
    nb = s // Q_BLOCK
    blocks = jnp.moveaxis(q.reshape((b, nb, Q_BLOCK) + q.shape[2:]), 1, 0)
    out = lax.map(fn, blocks)
    return jnp.moveaxis(out, 0, 1).reshape((b, s) + out.shape[3:])


def attend(q, k, v, scale):
    s = jnp.einsum('bqhgd,bkhd->bhgqk', q, k).astype(jnp.float32) * scale
    p = jax.nn.softmax(s, axis=-1).astype(v.dtype)
    return jnp.einsum('bhgqk,bkhd->bqhgd', p, v)


def diff_attend(q, k, v, lam, scale):
    s = jnp.einsum('bqhmd,bkhmd->bhmqk', q, k).astype(jnp.float32) * scale
    p = jax.nn.softmax(s, axis=-1)
    w = (p[:, :, 0] - lam * p[:, :, 1]).astype(v.dtype)
    return jnp.einsum('bhqk,bkhd->bqhd', w, v)


def mixer_ab(h, hz, w_in, g_cq, w_uq, g_ckv, w_ukv, g_qn_a, g_kn_a, lam_vec, g_qn_b, g_kn_b, g_sub,
             w_out, ang_a, ang_b, lam_init, ctx_out):
    split_at = [int(i) for i in np.cumsum(AB_SIZES)[:-1]]

    def project(u):
        bsz, n = u.shape[:2]
        c_q, c_kv, k_rope, bq, bk, bv = jnp.split(u @ w_in, split_at, axis=-1)
        qa = rmsnorm((rmsnorm(c_q, g_cq) @ w_uq).reshape(bsz, n, A_HEADS, A_QK), g_qn_a)
        kv = (rmsnorm(c_kv, g_ckv) @ w_ukv).reshape(bsz, n, A_HEADS, A_NOPE + A_V)
        k_rope = jnp.broadcast_to(k_rope[:, :, None, :], (bsz, n, A_HEADS, A_ROPE))
        ka = rmsnorm(jnp.concatenate([kv[..., :A_NOPE], k_rope], axis=-1), g_kn_a)
        va = kv[..., A_NOPE:]
        qb = rmsnorm(bq.reshape(bsz, n, B_HEADS, 2, B_DIM), g_qn_b)
        kb = rmsnorm(bk.reshape(bsz, n, B_HEADS, 2, B_DIM), g_kn_b)
        vb = bv.reshape(bsz, n, B_HEADS, B_V)
        return qa, ka, va, qb, kb, vb

    def rope_mla(t):
        return jnp.concatenate([t[..., :A_NOPE], axial_rope(t[..., A_NOPE:], ang_a)], axis=-1)

    qa, ka, va, qb, kb, vb = project(h)
    qaz, kaz, vaz, qbz, kbz, vbz = project(hz)
    qa, ka = rope_mla(qa), rope_mla(ka)
    qb, kb = axial_rope(qb, ang_b), axial_rope(kb, ang_b)
    ka_all = jnp.concatenate([ka, kaz], axis=1)
    va_all = jnp.concatenate([va, vaz], axis=1)
    kb_all = jnp.concatenate([kb, kbz], axis=1)
    vb_all = jnp.concatenate([vb, vbz], axis=1)
    lv = lam_vec.astype(jnp.float32)
    lam = jnp.exp(jnp.sum(lv[0] * lv[1])) - jnp.exp(jnp.sum(lv[2] * lv[3])) + lam_init
    sa = A_QK ** -0.5
    sb = B_DIM ** -0.5

    def merge(oa, ob):
        bsz, n = oa.shape[:2]
        ob = rmsnorm(ob, g_sub) * (1.0 - lam_init)
        return jnp.concatenate([oa.reshape(bsz, n, -1), ob.reshape(bsz, n, -1)], axis=-1) @ w_out

    oa = sweep_query_blocks(lambda q: attend(q[:, :, :, None], ka_all, va_all, sa)[:, :, :, 0], qa)
    ob = sweep_query_blocks(lambda q: diff_attend(q, kb_all, vb_all, lam, sb), qb)
    out_x = merge(oa, ob)
    out_z = None
    if ctx_out:
        out_z = merge(attend(qaz[:, :, :, None], kaz, vaz, sa)[:, :, :, 0],
                      diff_attend(qbz, kbz, vbz, lam, sb))
    return out_x, out_z


def mixer_c(h, hz, w_in, g_qn, g_kn, w_out, ang, ctx_out):
    def project(u):
        bsz, n = u.shape[:2]
        p = u @ w_in
        q = p[..., :C_HEADS * C_DIM].reshape(bsz, n, C_KV_HEADS, C_GROUP, C_DIM)
        k = p[..., C_HEADS * C_DIM:(C_HEADS + C_KV_HEADS) * C_DIM].reshape(bsz, n, C_KV_HEADS, C_DIM)
        v = p[..., (C_HEADS + C_KV_HEADS) * C_DIM:].reshape(bsz, n, C_KV_HEADS, C_DIM)
        return rmsnorm(q, g_qn), rmsnorm(k, g_kn), v

    q, k, v = project(h)
    qz, kz, vz = project(hz)
    q, k = axial_rope(q, ang), axial_rope(k, ang)
    k_all = jnp.concatenate([k, kz], axis=1)
    v_all = jnp.concatenate([v, vz], axis=1)
    scale = C_DIM ** -0.5
    bsz, n = h.shape[:2]
    o = sweep_query_blocks(lambda qb: attend(qb, k_all, v_all, scale), q)
    out_x = o.reshape(bsz, n, C_OUT) @ w_out
    out_z = None
    if ctx_out:
        out_z = attend(qz, kz, vz, scale).reshape(bsz, hz.shape[1], C_OUT) @ w_out
    return out_x, out_z


def peer(h, w_pq, sub_keys, expert_u, expert_v):
    bsz, n, d = h.shape
    tokens = h.reshape(-1, P_CHUNK, d)

    def chunk(hc):
        q = (hc @ w_pq).reshape(P_CHUNK, P_HEADS, 2, P_DQ // 2)
        s = jnp.einsum('chpd,hpnd->chpn', q, sub_keys).astype(jnp.float32)
        s_top, i_top = lax.top_k(s, P_TOPK)
        cand = (s_top[:, :, 0, :, None] + s_top[:, :, 1, None, :]).reshape(P_CHUNK, P_HEADS, P_TOPK * P_TOPK)
        cand_idx = (i_top[:, :, 0, :, None] * N_KEYS + i_top[:, :, 1, None, :]).reshape(P_CHUNK, P_HEADS, P_TOPK * P_TOPK)
        best, pos = lax.top_k(cand, P_TOPK)
        idx = jnp.take_along_axis(cand_idx, pos, axis=-1)
        g = jax.nn.softmax(best, axis=-1)
        u = jnp.take(expert_u, idx, axis=0)
        a = jnp.einsum('cd,chkd->chk', hc, u).astype(jnp.float32)
        w = (g * jax.nn.gelu(a)).astype(h.dtype)
        vsel = jnp.take(expert_v, idx, axis=0)
        return jnp.einsum('chk,chkd->cd', w, vsel)

    return lax.map(chunk, tokens).reshape(bsz, n, d)


def setup_inputs(seed: int = 0) -> dict:
    key = jax.random.key(seed)
    ks = iter(jax.random.split(key, 40))
    f32 = jnp.float32

    def nrm(shape, scale):
        return jax.random.normal(next(ks), shape, f32) * scale

    def gain(shape):
        return 1.0 + 0.02 * jax.random.normal(next(ks), shape, f32)

    D = D_MODEL
    return {
        "x": nrm((BATCH, SEQ, D), 1.0),
        "c": nrm((BATCH, D), 1.0),
        "ctx": nrm((BATCH, CTX_LEN, D), 1.0),
        "c_ctx": nrm((D,), 1.0),
        "w_mod": nrm((DEPTH, D, 6 * D), 0.5 * D ** -0.5),
        "b_mod": nrm((DEPTH, 6 * D), 0.02),
        "g_norm1": gain((DEPTH, D)),
        "g_norm2": gain((DEPTH, D)),
        "w_in_ab": nrm((N_EVEN, D, AB_IN), D ** -0.5),
        "g_cq": gain((N_EVEN, A_Q_LORA)),
        "w_uq": nrm((N_EVEN, A_Q_LORA, A_HEADS * A_QK), A_Q_LORA ** -0.5),
        "g_ckv": gain((N_EVEN, A_KV_LORA)),
        "w_ukv": nrm((N_EVEN, A_KV_LORA, A_HEADS * (A_NOPE + A_V)), A_KV_LORA ** -0.5),
        "g_qn_a": gain((N_EVEN, A_QK)),
        "g_kn_a": gain((N_EVEN, A_QK)),
        "lam_vec": nrm((N_EVEN, 4, B_DIM), 0.1),
        "g_qn_b": gain((N_EVEN, B_DIM)),
        "g_kn_b": gain((N_EVEN, B_DIM)),
        "g_sub_b": gain((N_EVEN, B_V)),
        "w_out_ab": nrm((N_EVEN, AB_OUT, D), AB_OUT ** -0.5),
        "w_in_c": nrm((N_ODD, D, C_IN), D ** -0.5),
        "g_qn_c": gain((N_ODD, C_DIM)),
        "g_kn_c": gain((N_ODD, C_DIM)),
        "w_out_c": nrm((N_ODD, C_OUT, D), C_OUT ** -0.5),
        "w_pq": nrm((DEPTH, D, P_HEADS * P_DQ), D ** -0.5),
        "sub_keys": nrm((DEPTH, P_HEADS, 2, N_KEYS, P_DQ // 2), (P_DQ // 2) ** -0.5),
        "expert_u": nrm((DEPTH, N_EXPERTS, D), D ** -0.5),
        "expert_v": nrm((DEPTH, N_EXPERTS, D), (P_HEADS * P_TOPK) ** -0.5),
    }


def reference(x, c, ctx, c_ctx, w_mod, b_mod, g_norm1, g_norm2, w_in_ab, g_cq, w_uq, g_ckv, w_ukv,
              g_qn_a, g_kn_a, lam_vec, g_qn_b, g_kn_b, g_sub_b, w_out_ab, w_in_c, g_qn_c, g_kn_c,
              w_out_c, w_pq, sub_keys, expert_u, expert_v):
    seq = x.shape[1]
    rows = seq // GRID_W
    ang_a = axial_angles(rows, A_ROPE)
    ang_b = axial_angles(rows, B_DIM)
    ang_c = axial_angles(rows, C_DIM)
    z = ctx
    sc = jax.nn.silu(c)
    sz = jax.nn.silu(c_ctx)
    for layer in range(DEPTH):
        last = layer == DEPTH - 1
        e = layer // 2
        mod_x = (sc @ w_mod[layer] + b_mod[layer])[:, None, :]
        mod_z = sz @ w_mod[layer] + b_mod[layer]
        sh1, sc1, gt1, sh2, sc2, gt2 = jnp.split(mod_x, 6, axis=-1)
        zsh1, zsc1, zgt1, zsh2, zsc2, zgt2 = jnp.split(mod_z, 6, axis=-1)

        h = modulate(rmsnorm(x, g_norm1[layer]), sh1, sc1)
        hz = modulate(rmsnorm(z, g_norm1[layer]), zsh1, zsc1)
        if layer % 2 == 0:
            lam_init = 0.8 - 0.6 * math.exp(-0.3 * layer)
            out_x, out_z = mixer_ab(h, hz, w_in_ab[e], g_cq[e], w_uq[e], g_ckv[e], w_ukv[e],
                                    g_qn_a[e], g_kn_a[e], lam_vec[e], g_qn_b[e], g_kn_b[e],
                                    g_sub_b[e], w_out_ab[e], ang_a, ang_b, lam_init, not last)
        else:
            out_x, out_z = mixer_c(h, hz, w_in_c[e], g_qn_c[e], g_kn_c[e], w_out_c[e], ang_c, not last)
        x = x + gt1 * out_x
        x = x + gt2 * peer(modulate(rmsnorm(x, g_norm2[layer]), sh2, sc2),
                           w_pq[layer], sub_keys[layer], expert_u[layer], expert_v[layer])
        if not last:
            z = z + zgt1 * out_z
            z = z + zgt2 * peer(modulate(rmsnorm(z, g_norm2[layer]), zsh2, zsc2),
                                w_pq[layer], sub_keys[layer], expert_u[layer], expert_v[layer])
    return x
```

```cpp
#include <hip/hip_runtime.h>
#include <stdint.h>
#include <stdio.h>

#ifndef MK_PER_PHASE_LAUNCH
#define MK_PER_PHASE_LAUNCH 1
#endif

#ifndef MLA_QL
#define MLA_QL 4
#endif
#ifndef MLA_SD
#define MLA_SD 0
#endif
#ifndef GQA_SD
#define GQA_SD 1
#endif
#ifndef ATT_SEL
#define ATT_SEL 3
#endif
#ifndef PH_MASK
#define PH_MASK 0xFFFFFFFFu
#endif
#define LAS __attribute__((address_space(3)))
typedef unsigned short bf16_t;
typedef short bf16x8 __attribute__((ext_vector_type(8)));
typedef short s16x4 __attribute__((ext_vector_type(4)));
typedef float f32x4 __attribute__((ext_vector_type(4)));
typedef float f32x2 __attribute__((ext_vector_type(2)));
typedef float f32x16 __attribute__((ext_vector_type(16)));
typedef unsigned u32x4 __attribute__((ext_vector_type(4)));
typedef unsigned u32x2 __attribute__((ext_vector_type(2)));
typedef __bf16 bf16x2_t __attribute__((ext_vector_type(2)));

constexpr int DM = 2048, NB = 2, SEQ = 8192, DEPTH = 4, CTXL = 256;
constexpr int TL = NB * SEQ;
constexpr int TZ = NB * CTXL;
constexpr int TT = TL + TZ;
constexpr int KPB = SEQ + CTXL;
constexpr int AB_IN = 4416, AB_INP = 4608;
constexpr int C_IN = 3072;
constexpr int NEXP = 16384;
constexpr float EPS = 1e-6f;
constexpr float LOG2E = 1.4426950408889634f;

constexpr size_t al256(size_t x) { return (x + 255) / 256 * 256; }
constexpr size_t WS_CTL = 0, CTL_BYTES = 1u << 20;
constexpr size_t WS_MOD = WS_CTL + CTL_BYTES;
constexpr size_t WS_TAB16 = WS_MOD + al256((size_t)4 * 3 * 12288 * 4);
constexpr size_t WS_TAB32 = WS_TAB16 + al256((size_t)128 * 16 * 2 * 4);
constexpr size_t WS_LAM = WS_TAB32 + al256((size_t)128 * 32 * 2 * 4);
constexpr size_t WS_WINAB = WS_LAM + 256;
constexpr size_t WS_WUQ = WS_WINAB + (size_t)2 * AB_INP * DM * 2;
constexpr size_t WS_WUKV = WS_WUQ + (size_t)2 * 1536 * 768 * 2;
constexpr size_t WS_WOUTAB = WS_WUKV + (size_t)2 * 2048 * 512 * 2;
constexpr size_t WS_WINC = WS_WOUTAB + (size_t)2 * DM * DM * 2;
constexpr size_t WS_WOUTC = WS_WINC + (size_t)2 * C_IN * DM * 2;
constexpr size_t WS_WPQ = WS_WOUTC + (size_t)2 * DM * DM * 2;
constexpr size_t WS_SUBK = WS_WPQ + (size_t)4 * DM * DM * 2;
constexpr size_t WS_EU = WS_SUBK + (size_t)4 * 8 * 2 * 128 * 128 * 2;
constexpr size_t WS_EV = WS_EU + (size_t)4 * NEXP * DM * 2;
constexpr size_t WS_X = WS_EV + (size_t)4 * NEXP * DM * 2;
constexpr size_t WS_H = WS_X + (size_t)TT * DM * 4;
constexpr size_t WS_P1 = WS_H + (size_t)TT * DM * 2;
constexpr size_t WS_QA = WS_P1 + (size_t)TT * AB_INP * 2;
constexpr size_t WS_KV = WS_QA + (size_t)TT * 1536 * 2;
constexpr size_t WS_Q1 = WS_KV + (size_t)TT * 2048 * 2;
constexpr size_t WS_K1 = WS_Q1 + (size_t)TT * 2048 * 2;
constexpr size_t WS_V1 = WS_K1 + (size_t)TT * 1536 * 2;
constexpr size_t WS_Q2 = WS_V1 + (size_t)TT * 1024 * 2;
constexpr size_t WS_K2 = WS_Q2 + (size_t)TT * 1024 * 2;
constexpr size_t WS_V2 = WS_K2 + (size_t)TT * 1024 * 2;
constexpr size_t WS_OF = WS_V2 + (size_t)TT * 1024 * 2;
constexpr size_t WS_AO = WS_OF + (size_t)TT * 3072 * 4;
constexpr size_t WS_PQ = WS_AO + (size_t)TT * DM * 2;
constexpr size_t WS_PIDX = WS_PQ + (size_t)TT * DM * 2;
constexpr size_t WS_PG = WS_PIDX + (size_t)TT * 128 * 4;
constexpr size_t WS_END = WS_PG + (size_t)TT * 128 * 4;

constexpr int LDS_MAIN = 131072;
constexpr int LDS_MISC = LDS_MAIN;
constexpr int LDS_BYTES = LDS_MAIN + 4096;

__device__ __forceinline__ unsigned cvt_pk_bf16(float lo, float hi) { unsigned r; asm("v_cvt_pk_bf16_f32 %0, %1, %2" : "=v"(r) : "v"(lo), "v"(hi)); return r; }
__device__ __forceinline__ float bf_lo(unsigned w) { return __uint_as_float(w << 16); }
__device__ __forceinline__ float bf_hi(unsigned w) { return __uint_as_float(w & 0xffff0000u); }
__device__ __forceinline__ float wave_sum(float v) {
#pragma unroll
    for (int o = 32; o >= 1; o >>= 1) v += __shfl_xor(v, o);
    return v;
}
__device__ __forceinline__ float hw_sum(float v) {
#pragma unroll
    for (int o = 16; o >= 1; o >>= 1) v += __shfl_xor(v, o);
    return v;
}
__device__ __forceinline__ int mbcnt64(unsigned long long m) { return (int)__builtin_amdgcn_mbcnt_hi((unsigned)(m >> 32), __builtin_amdgcn_mbcnt_lo((unsigned)m, 0u)); }
__device__ __forceinline__ int krow_of(int t) { return t < TL ? (t >> 13) * KPB + (t & (SEQ - 1)) : ((t - TL) >> 8) * KPB + SEQ + ((t - TL) & (CTXL - 1)); }
__device__ __forceinline__ int vsel_of_row(int t) { return t < SEQ ? 0 : (t < TL ? 1 : 2); }

#define XB_TMO      128
#define XB_XCNT(j)  (256  + 64 * (j))
#define XB_XSUB(j)  (1280 + 64 * (j))
#define XB_XGEN(j)  (2304 + 64 * (j))
#define XB_TOP      3328
#define XB_TOPGEN   3392
#define XCD_BAR_WORDS 3456
#define XB_SPIN_CAP (1u << 27)
__device__ __forceinline__ unsigned xb_ld(unsigned* p)              { return __hip_atomic_load(p, __ATOMIC_RELAXED, __HIP_MEMORY_SCOPE_AGENT); }
__device__ __forceinline__ unsigned xb_add(unsigned* p, unsigned v) { return __hip_atomic_fetch_add(p, v, __ATOMIC_RELAXED, __HIP_MEMORY_SCOPE_AGENT); }
__device__ __forceinline__ unsigned xb_xcc_id() { return (unsigned)__builtin_amdgcn_s_getreg((3 << 11) | 20) & 0xFu; }
#define XB_SPIN(cond, bar) do { unsigned _sp = 0; while (cond) { __builtin_amdgcn_s_sleep(1); \
    if ((++_sp & 255u) == 0u) { if (xb_ld(&(bar)[XB_TMO])) break; if (_sp > XB_SPIN_CAP) { atomicAdd(&(bar)[XB_TMO], 1u); break; } } } } while (0)
struct XcdBarrier { unsigned* bar; unsigned x; volatile LAS unsigned* st; };
__device__ __forceinline__ XcdBarrier xcd_barrier_post(unsigned* bar, volatile LAS unsigned* st) {
    XcdBarrier b; b.bar = bar; b.x = xb_xcc_id(); b.st = st;
    if (threadIdx.x == 0) (void)xb_add(&bar[XB_XCNT(b.x)], 1u);
    return b;
}
__device__ __forceinline__ void xcd_barrier_complete(unsigned* bar, unsigned x, unsigned& nloc, unsigned& nx) {
    const unsigned G = gridDim.x * gridDim.y * gridDim.z;
    unsigned sum, cnt, mine, sp = 0u;
    for (;;) {
        sum = 0u; cnt = 0u; mine = 0u;
#pragma unroll
        for (unsigned j = 0; j < 16; ++j) { const unsigned c = xb_ld(&bar[XB_XCNT(j)]); sum += c; cnt += (c > 0u) ? 1u : 0u; mine = (j == x) ? c : mine; }
        if (sum == G) break;
        __builtin_amdgcn_s_sleep(1);
        if ((++sp & 255u) == 0u) { if (xb_ld(&bar[XB_TMO])) break; if (sp > XB_SPIN_CAP) { atomicAdd(&bar[XB_TMO], 1u); break; } }
    }
    nloc = mine > 0u ? mine : 1u; nx = cnt > 0u ? cnt : 1u;
}
__device__ __forceinline__ void xcd_barrier(const XcdBarrier& b) {
    asm volatile("s_waitcnt vmcnt(0)" ::: "memory");
    __syncthreads();
    if (threadIdx.x == 0) {
        unsigned* bar = b.bar;
        __builtin_amdgcn_s_waitcnt(0);
        unsigned nloc = b.st[0], nx = b.st[1];
        if (nloc == 0u) { xcd_barrier_complete(bar, b.x, nloc, nx); b.st[0] = nloc; b.st[1] = nx; }
        const unsigned old = xb_add(&bar[XB_XSUB(b.x)], 1u);
        const unsigned gen = old / nloc;
        if (old + 1u == (gen + 1u) * nloc) {
            __builtin_amdgcn_fence(__ATOMIC_RELEASE, "agent");
            asm volatile("s_waitcnt vmcnt(0)" ::: "memory");
            const unsigned og = xb_add(&bar[XB_TOP], 1u);
            const unsigned tg = og / nx;
            if (og + 1u == (tg + 1u) * nx) xb_add(&bar[XB_TOPGEN], 1u);
            else XB_SPIN(xb_ld(&bar[XB_TOPGEN]) == tg, bar);
            __builtin_amdgcn_fence(__ATOMIC_ACQUIRE, "agent");
            xb_add(&bar[XB_XGEN(b.x)], 1u);
            asm volatile("s_waitcnt vmcnt(0)" ::: "memory");
        } else {
            XB_SPIN(xb_ld(&bar[XB_XGEN(b.x)]) == gen, bar);
            __builtin_amdgcn_fence(__ATOMIC_ACQUIRE, "agent");
            asm volatile("s_waitcnt vmcnt(0)" ::: "memory");
        }
    }
    __syncthreads();
}

namespace pg8 {
constexpr int BM = 256, BK = 64, HALF = 128, HTB = HALF * BK * 2, STAGE_BYTES = 8 * HTB, NXCD = 8, WGM = 8;
__host__ __device__ __forceinline__ int lds_byte(int r, int c) { const int st = (r >> 4) * 2 + (c >> 5), rr = r & 15, cc = c & 31, ob = rr * 64 + cc * 2; return st * 1024 + (ob ^ (((ob >> 9) & 1) << 5)); }
__host__ __device__ __forceinline__ void stage_rc(int b, int& R, int& C) { const int st = b / 1024, sb = b % 1024, swz = sb ^ (((sb >> 9) & 1) << 5); R = (st >> 1) * 16 + swz / 64; C = (st & 1) * 32 + (swz % 64) / 2; }
__host__ __device__ __forceinline__ int perm32(int rho) { const int n = rho >> 4, i = rho & 15; return 8 * (i >> 2) + 4 * n + (i & 3); }
struct Unit { int pm, pn; };
struct Gemm { const bf16_t* A; const bf16_t* Bt; int M, N, K, lda; };
struct StaticOrder {
    int nM, nN, nwg, G, c;
    __host__ __device__ void init(int M, int N, int G_, int c_) { nM = M / BM; nN = N / BM; nwg = nM * nN; G = G_; c = c_; }
    __host__ __device__ bool next(int i, Unit& u) const {
        const long L = (long)i * G + c; if (L >= nwg) return false;
        int wgid = (int)L; { const int q = nwg / NXCD, r = nwg % NXCD, xcd = wgid % NXCD, off = wgid / NXCD; wgid = (xcd < r ? xcd * (q + 1) : r * (q + 1) + (xcd - r) * q) + off; }
        const int nig = WGM * nN, gid = wgid / nig, fm = gid * WGM, gsz = (nM - fm) < WGM ? (nM - fm) : WGM;
        u.pm = fm + ((wgid % nig) % gsz); u.pn = (wgid % nig) / gsz; return true;
    }
    __device__ __forceinline__ void a_ready(const Unit&) const {}
    __device__ __forceinline__ void done(const Unit&) const {}
};
struct EpiBf16 {
    static constexpr bool PERM = true;
    bf16_t* O; int ldc;
    __device__ __forceinline__ void operator()(const f32x4 (&acc)[2][2][4][2], const Unit& u, int wr, int wc, int fr, int fq) const {
        const int row0 = u.pm * BM + wr * 64 + fr; const int col0 = u.pn * BM + wc * 32 + 8 * fq;
#pragma unroll
        for (int ai = 0; ai < 2; ++ai)
#pragma unroll
            for (int m = 0; m < 4; ++m) { bf16_t* rowp = O + (size_t)(row0 + ai * HALF + m * 16) * ldc + col0;
#pragma unroll
                for (int bj = 0; bj < 2; ++bj) { const f32x4 v0 = acc[ai][bj][m][0], v1 = acc[ai][bj][m][1];
                    u32x4 w; w.x = cvt_pk_bf16(v0[0], v0[1]); w.y = cvt_pk_bf16(v0[2], v0[3]); w.z = cvt_pk_bf16(v1[0], v1[1]); w.w = cvt_pk_bf16(v1[2], v1[3]);
                    *(u32x4*)(rowp + bj * HALF) = w; } }
    }
};
struct EpiResid {
    static constexpr bool PERM = false;
    float* X; const float* modl; int chunk;
    __device__ __forceinline__ void operator()(const f32x4 (&acc)[2][2][4][2], const Unit& u, int wr, int wc, int fr, int fq) const {
        const int row0 = u.pm * BM + wr * 64 + fr, col0 = u.pn * BM + wc * 32 + 4 * fq;
        const int vs = u.pm < 32 ? 0 : (u.pm < 64 ? 1 : 2);
        const float* gate = modl + (size_t)vs * 12288 + chunk * 2048 + col0;
        f32x4 gv[2][2];
#pragma unroll
        for (int bj = 0; bj < 2; ++bj)
#pragma unroll
            for (int n = 0; n < 2; ++n) gv[bj][n] = *(const f32x4*)(gate + bj * HALF + n * 16);
#pragma unroll
        for (int ai = 0; ai < 2; ++ai)
#pragma unroll
            for (int m = 0; m < 4; ++m) { float* rowp = X + (size_t)(row0 + ai * HALF + m * 16) * DM + col0;
#pragma unroll
                for (int bj = 0; bj < 2; ++bj)
#pragma unroll
                    for (int n = 0; n < 2; ++n) { float* p = rowp + bj * HALF + n * 16; const f32x4 xo = *(const f32x4*)p; *(f32x4*)p = xo + gv[bj][n] * acc[ai][bj][m][n]; } }
    }
};

template <class Epi, class Sched>
__device__ __forceinline__ void gemm_phase(LAS unsigned char* lds, const Gemm g, const Sched& S, const Epi& E) {
    int tid_l = threadIdx.x; asm volatile("" : "+v"(tid_l));
    const int tid = tid_l, wid = __builtin_amdgcn_readfirstlane(tid >> 6), lane = tid & 63, wr = wid >> 2, wc = wid & 3, fr = lane & 15, fq = lane >> 4;
    const int K = g.K, nt = K / BK, lda = g.lda;
    unsigned voffA[2], voffB[2];
#pragma unroll
    for (int i = 0; i < 2; ++i) { int R, C; stage_rc(tid * 16 + i * 8192, R, C); const int Rb = Epi::PERM ? ((R & ~31) + perm32(R & 31)) : R;
        voffA[i] = (unsigned)(R * lda + C) * 2u; voffB[i] = (unsigned)(Rb * K + C) * 2u; }
    const size_t kstep = (size_t)(BK * 2);
    const size_t hstepA = (size_t)HALF * lda * 2, hstepB = (size_t)HALF * K * 2;
    const size_t tstepA = 2 * hstepA, tstepB = 2 * hstepB;
    const unsigned ldsw = (unsigned)wid * 1024u;
    const int aoff = lds_byte(wr * 64 + fr, fq * 8), boff = lds_byte(wc * 32 + fr, fq * 8);
#define PG8_SA(b, h) (((b) * 2 + (h)) * HTB)
#define PG8_SB(b, h) ((4 + (b) * 2 + (h)) * HTB)
#define PG8_STAGE(bufoff, gbase, voff) do { _Pragma("unroll") for (int _i = 0; _i < 2; ++_i) \
        __builtin_amdgcn_global_load_lds((const unsigned*)((const char*)(gbase) + (voff)[_i]), (LAS unsigned*)(lds + (bufoff) + ldsw + _i * 8192), 16, 0, 0); } while (0)
#define PG8_LDA(dst, b, h) do { _Pragma("unroll") for (int m = 0; m < 4; ++m) _Pragma("unroll") for (int k = 0; k < 2; ++k) dst[m][k] = *(const LAS bf16x8*)(lds + PG8_SA(b, h) + aoff + m * 2048 + k * 1024); } while (0)
#define PG8_LDB(dst, b, h) do { _Pragma("unroll") for (int n = 0; n < 2; ++n) _Pragma("unroll") for (int k = 0; k < 2; ++k) dst[n][k] = *(const LAS bf16x8*)(lds + PG8_SB(b, h) + boff + n * 2048 + k * 1024); } while (0)
#define PG8_MMA(ai, bj, At, Bt) do { __builtin_amdgcn_s_setprio(1); _Pragma("unroll") for (int m = 0; m < 4; ++m) _Pragma("unroll") for (int n = 0; n < 2; ++n) _Pragma("unroll") for (int k = 0; k < 2; ++k) \
        acc[ai][bj][m][n] = __builtin_amdgcn_mfma_f32_16x16x32_bf16(Bt[n][k], At[m][k], acc[ai][bj][m][n], 0, 0, 0); __builtin_amdgcn_s_setprio(0); } while (0)
#define PG8_WAIT_V(n) asm volatile("s_waitcnt vmcnt(" #n ")" ::: "memory")
#define PG8_WAIT_L(n) asm volatile("s_waitcnt lgkmcnt(" #n ")" ::: "memory")
#define PG8_BAR __builtin_amdgcn_s_barrier()
#define PG8_SCHED __builtin_amdgcn_sched_barrier(0)
    Unit cur, nxt; int ui = 0;
    if (!S.next(0, cur)) return;
    f32x4 acc[2][2][4][2];
#pragma unroll
    for (int a = 0; a < 2; ++a)
#pragma unroll
        for (int b = 0; b < 2; ++b)
#pragma unroll
            for (int m = 0; m < 4; ++m)
#pragma unroll
                for (int n = 0; n < 2; ++n) acc[a][b][m][n] = (f32x4){0.f, 0.f, 0.f, 0.f};
    bf16x8 At[4][2], B0[2][2], B1[2][2];
    const char* cA = (const char*)g.A + (size_t)cur.pm * tstepA; const char* cB = (const char*)g.Bt + (size_t)cur.pn * tstepB;
    S.a_ready(cur);
    PG8_STAGE(PG8_SB(0, 0), cB, voffB); PG8_STAGE(PG8_SA(0, 0), cA, voffA); PG8_STAGE(PG8_SB(0, 1), cB + hstepB, voffB); PG8_STAGE(PG8_SA(0, 1), cA + hstepA, voffA);
    if (wr == 1) PG8_BAR;
    PG8_WAIT_V(4); PG8_BAR;
    PG8_STAGE(PG8_SB(1, 0), cB + kstep, voffB); PG8_STAGE(PG8_SA(1, 0), cA + kstep, voffA); PG8_STAGE(PG8_SB(1, 1), cB + hstepB + kstep, voffB);
    PG8_WAIT_V(6); PG8_BAR;
    for (;;) {
        const bool has_next = S.next(ui + 1, nxt);
        const char* nA = has_next ? (const char*)g.A + (size_t)nxt.pm * tstepA : cA; const char* nB = has_next ? (const char*)g.Bt + (size_t)nxt.pn * tstepB : cB;
        for (int t = 0; t < nt; t += 2) {
            const bool last = (t == nt - 2);
            const char* a1 = cA + (size_t)(t + 1) * kstep;
            const char* a2 = last ? nA : cA + (size_t)(t + 2) * kstep; const char* b2 = last ? nB : cB + (size_t)(t + 2) * kstep;
            const char* a3 = a2 + kstep; const char* b3 = b2 + kstep;
            if (last && has_next) S.a_ready(nxt);
            PG8_LDB(B0, 0, 0); PG8_SCHED; PG8_LDA(At, 0, 0); PG8_STAGE(PG8_SA(1, 1), a1 + hstepA, voffA);
            PG8_WAIT_L(8); PG8_BAR; PG8_WAIT_L(0); PG8_MMA(0, 0, At, B0); PG8_BAR; PG8_SCHED;
            PG8_LDB(B1, 0, 1); PG8_STAGE(PG8_SB(0, 0), b2, voffB);
            PG8_BAR; PG8_WAIT_L(0); PG8_MMA(0, 1, At, B1); PG8_BAR;
            PG8_LDA(At, 0, 1); PG8_STAGE(PG8_SA(0, 0), a2, voffA);
            PG8_BAR; PG8_WAIT_L(0); PG8_MMA(1, 0, At, B0); PG8_BAR; PG8_SCHED;
            PG8_STAGE(PG8_SB(0, 1), b2 + hstepB, voffB);
            PG8_WAIT_V(6); PG8_BAR; PG8_MMA(1, 1, At, B1); PG8_BAR;
            PG8_LDB(B0, 1, 0); PG8_SCHED; PG8_LDA(At, 1, 0); PG8_STAGE(PG8_SA(0, 1), a2 + hstepA, voffA);
            PG8_WAIT_L(8); PG8_BAR; PG8_WAIT_L(0); PG8_MMA(0, 0, At, B0); PG8_BAR; PG8_SCHED;
            PG8_LDB(B1, 1, 1); PG8_STAGE(PG8_SB(1, 0), b3, voffB);
            PG8_BAR; PG8_WAIT_L(0); PG8_MMA(0, 1, At, B1); PG8_BAR;
            PG8_LDA(At, 1, 1); PG8_STAGE(PG8_SA(1, 0), a3, voffA);
            PG8_BAR; PG8_WAIT_L(0); PG8_MMA(1, 0, At, B0); PG8_BAR; PG8_SCHED;
            PG8_STAGE(PG8_SB(1, 1), b3 + hstepB, voffB);
            PG8_WAIT_V(6); PG8_BAR; PG8_MMA(1, 1, At, B1); PG8_BAR;
        }
        E(acc, cur, wr, wc, fr, fq); S.done(cur);
        if (!has_next) break;
#pragma unroll
        for (int a = 0; a < 2; ++a)
#pragma unroll
            for (int b = 0; b < 2; ++b)
#pragma unroll
                for (int m = 0; m < 4; ++m)
#pragma unroll
                    for (int n = 0; n < 2; ++n) acc[a][b][m][n] = (f32x4){0.f, 0.f, 0.f, 0.f};
        cur = nxt; cA = nA; cB = nB; ++ui;
    }
    PG8_WAIT_V(0);
    if (wr == 0) PG8_BAR;
    PG8_BAR;
#undef PG8_SA
#undef PG8_SB
#undef PG8_STAGE
#undef PG8_LDA
#undef PG8_LDB
#undef PG8_MMA
#undef PG8_WAIT_V
#undef PG8_WAIT_L
#undef PG8_BAR
#undef PG8_SCHED
}
}

namespace att {
constexpr int NW = 8, QBLK = 32, KVBLK = 64, DV = 128;
constexpr float THR = 8.f;
constexpr int SHM_V = KVBLK * DV * 2;
#define SBAR() __builtin_amdgcn_sched_barrier(0)
__device__ __forceinline__ int crow(int r, int hi) { return (r & 3) + 8 * (r >> 2) + 4 * hi; }
__device__ __forceinline__ unsigned cvtpk(float lo, float hi) { unsigned r; asm volatile("v_cvt_pk_bf16_f32 %0, %1, %2" : "=v"(r) : "v"(lo), "v"(hi)); return r; }
__device__ __forceinline__ void partialSM(f32x16& p0, f32x16& p1, float& m_reg, float& mn, float& alpha, const float C, const float thr_raw) {
    float pmax = p0[0];
#pragma unroll
    for (int r = 1; r < 16; ++r) pmax = fmaxf(pmax, p0[r]);
#pragma unroll
    for (int r = 0; r < 16; ++r) pmax = fmaxf(pmax, p1[r]);
    { auto rr = __builtin_amdgcn_permlane32_swap(__float_as_uint(pmax), __float_as_uint(pmax), false, false);
      pmax = fmaxf(__uint_as_float(rr[0]), __uint_as_float(rr[1])); }
    if (__builtin_expect(__all(pmax - m_reg <= thr_raw), 1)) { mn = m_reg; alpha = 1.f; }
    else { mn = fmaxf(m_reg, pmax); alpha = __builtin_amdgcn_exp2f((m_reg - mn) * C); m_reg = mn; }
    const float mnC = -mn * C;
#pragma unroll
    for (int r = 0; r < 16; ++r) p0[r] = fmaf(p0[r], C, mnC);
#pragma unroll
    for (int r = 0; r < 16; ++r) p1[r] = fmaf(p1[r], C, mnC);
#pragma unroll
    for (int r = 0; r < 16; ++r) p0[r] = __builtin_amdgcn_exp2f(p0[r]);
}
__device__ __forceinline__ void finishSM(f32x16& p0, f32x16& p1, float alpha, float& l_reg, bf16x8& pa0, bf16x8& pa1, bf16x8& pa2, bf16x8& pa3) {
#pragma unroll
    for (int r = 0; r < 16; ++r) p1[r] = __builtin_amdgcn_exp2f(p1[r]);
    float ps = 0;
#pragma unroll
    for (int r = 0; r < 16; ++r) ps += p0[r];
#pragma unroll
    for (int r = 0; r < 16; ++r) ps += p1[r];
    { auto rr = __builtin_amdgcn_permlane32_swap(__float_as_uint(ps), __float_as_uint(ps), false, false);
      ps = __uint_as_float(rr[0]) + __uint_as_float(rr[1]); }
    l_reg = l_reg * alpha + ps;
#define PK4(P, BASE, OUT) do { unsigned a0 = cvtpk(P[BASE + 0], P[BASE + 1]), a1 = cvtpk(P[BASE + 2], P[BASE + 3]);   \
    unsigned b0 = cvtpk(P[BASE + 4], P[BASE + 5]), b1 = cvtpk(P[BASE + 6], P[BASE + 7]);                              \
    auto r0 = __builtin_amdgcn_permlane32_swap(a0, b0, false, false); auto r1 = __builtin_amdgcn_permlane32_swap(a1, b1, false, false); \
    u32x4 w = {r0[0], r1[0], r0[1], r1[1]}; OUT = *reinterpret_cast<bf16x8*>(&w); } while (0)
    PK4(p0, 0, pa0); PK4(p0, 8, pa1); PK4(p1, 0, pa2); PK4(p1, 8, pa3);
#undef PK4
}
template <int DQK>
__device__ __forceinline__ void qkt(f32x16& p0, f32x16& p1, const char* Ks, const bf16x8 (&qr)[DQK / 16], int r32, int hi) {
    constexpr int RS = DQK * 2;
    p0 = f32x16{}; p1 = f32x16{};
#pragma unroll
    for (int d0 = 0; d0 < DQK / 16; ++d0) { const int cb = (d0 * 16 + hi * 8) * 2;
        const bf16x8 b0 = *reinterpret_cast<const bf16x8*>(Ks + r32 * RS + (cb ^ ((r32 & 7) << 4)));
        const bf16x8 b1 = *reinterpret_cast<const bf16x8*>(Ks + (32 + r32) * RS + (cb ^ ((r32 & 7) << 4)));
        p0 = __builtin_amdgcn_mfma_f32_32x32x16_bf16(b0, qr[d0], p0, 0, 0, 0);
        p1 = __builtin_amdgcn_mfma_f32_32x32x16_bf16(b1, qr[d0], p1, 0, 0, 0); }
}
__device__ __forceinline__ int v_st(int k, int c) { const int kk = (k & ~0xC) | ((k & 4) << 1) | ((k & 8) >> 1); return ((kk >> 3) * 4 + (c >> 5)) * 512 + ((kk & 7) * 32 + (c & 31)) * 2; }
__device__ __forceinline__ int v_rd_base(int lane) { return ((lane & 3) << 3) | (((lane >> 2) & 3) << 6) | (((lane >> 4) & 1) << 5) | (((lane >> 5) & 1) << 8); }
constexpr int v_rd_off(int d0, int ks, int half) { return d0 * 512 + ks * 4096 + half * 2048; }
template <int OFF> __device__ __forceinline__ s16x4 tr_read(int vb) {
    s16x4 r; asm volatile("ds_read_b64_tr_b16 %0, %1 offset:%2" : "=&v"(r) : "v"(vb), "i"(OFF) : "memory"); return r;
}
template <int D0> __device__ __forceinline__ void pv_one(f32x16& od, int vb, bf16x8 pa0, bf16x8 pa1, bf16x8 pa2, bf16x8 pa3) {
    const s16x4 l0 = tr_read<v_rd_off(D0, 0, 0)>(vb), h0 = tr_read<v_rd_off(D0, 0, 1)>(vb), l1 = tr_read<v_rd_off(D0, 1, 0)>(vb), h1 = tr_read<v_rd_off(D0, 1, 1)>(vb);
    const s16x4 l2 = tr_read<v_rd_off(D0, 2, 0)>(vb), h2 = tr_read<v_rd_off(D0, 2, 1)>(vb), l3 = tr_read<v_rd_off(D0, 3, 0)>(vb), h3 = tr_read<v_rd_off(D0, 3, 1)>(vb);
    asm volatile("s_waitcnt lgkmcnt(0)" ::: "memory"); SBAR();
#define PK(L, H) (bf16x8){L[0], L[1], L[2], L[3], H[0], H[1], H[2], H[3]}
    od = __builtin_amdgcn_mfma_f32_32x32x16_bf16(pa0, PK(l0, h0), od, 0, 0, 0);
    od = __builtin_amdgcn_mfma_f32_32x32x16_bf16(pa1, PK(l1, h1), od, 0, 0, 0);
    od = __builtin_amdgcn_mfma_f32_32x32x16_bf16(pa2, PK(l2, h2), od, 0, 0, 0);
    od = __builtin_amdgcn_mfma_f32_32x32x16_bf16(pa3, PK(l3, h3), od, 0, 0, 0);
#undef PK
}
__device__ __forceinline__ void pv_d0(f32x16* o, int vb, bf16x8 pa0, bf16x8 pa1, bf16x8 pa2, bf16x8 pa3) {
    pv_one<0>(o[0], vb, pa0, pa1, pa2, pa3); pv_one<1>(o[1], vb, pa0, pa1, pa2, pa3); pv_one<2>(o[2], vb, pa0, pa1, pa2, pa3); pv_one<3>(o[3], vb, pa0, pa1, pa2, pa3);
}
template <int DQK> struct ScaleOf { static constexpr float scale = DQK == 192 ? 0.07216878364870322f : (DQK == 128 ? 0.08838834764831845f : 0.125f); };
template <int DQK, int SDEPTH, int ldq, int ldk, int ldv, int ldo>
__device__ __forceinline__ void attn_body(const bf16_t* __restrict__ Qb, const bf16_t* __restrict__ Kh, const bf16_t* __restrict__ Vh,
                                          float* __restrict__ Ob, int seq, char* lds) {
    constexpr float C = ScaleOf<DQK>::scale * 1.4426950408889634f, thr_raw = THR / ScaleOf<DQK>::scale;
    constexpr int SHM_K = KVBLK * DQK * 2, RS = DQK * 2, NKP = DQK / 64, KPR = DQK / 8;
    int tid_l = threadIdx.x; asm volatile("" : "+v"(tid_l));
    const int tid = tid_l, wid = tid >> 6, lane = tid & 63, r32 = lane & 31, hi = lane >> 5;
    char* V_lds = lds; char* K_lds = lds + 2 * SHM_V;
    float* ws = (float*)(lds + 2 * SHM_V + 2 * SHM_K) + wid * 64; float* li_l = ws; float* al_l = ws + 32;
    float m_reg = -1e30f, l_reg = 0; f32x16 o[4] = {}; bf16x8 qr[DQK / 16];
    const bf16_t* Qw = Qb + (size_t)(wid * QBLK + r32) * ldq + hi * 8;
#pragma unroll
    for (int d0 = 0; d0 < DQK / 16; ++d0) qr[d0] = *reinterpret_cast<const bf16x8*>(Qw + d0 * 16);
    const int sr = tid >> 4, sc = (tid & 15) * 8, vst0 = v_st(sr, sc), vst1 = v_st(32 + sr, sc);
    int koff[NKP], klds[NKP];
#pragma unroll
    for (int i = 0; i < NKP; ++i) { const int p = tid + i * 512, row = p / KPR, c8 = p % KPR; koff[i] = row * ldk + c8 * 8; klds[i] = row * RS + ((c8 * 16) ^ ((row & 7) << 4)); }
    const int vb0 = (int)(uintptr_t)V_lds + v_rd_base(lane);
    bf16x8 sv0[SDEPTH], sv1[SDEPTH], sk[SDEPTH][NKP];
#define SLOAD(i, k0) do { sv0[i] = *reinterpret_cast<const bf16x8*>(&Vh[(size_t)((k0) + sr) * ldv + sc]); sv1[i] = *reinterpret_cast<const bf16x8*>(&Vh[(size_t)((k0) + 32 + sr) * ldv + sc]); \
    _Pragma("unroll") for (int _q = 0; _q < NKP; ++_q) sk[i][_q] = *reinterpret_cast<const bf16x8*>(&Kh[(size_t)(k0) * ldk + koff[_q]]); } while (0)
#define SWRITE(b, i) do { *(bf16x8*)(V_lds + (b) * SHM_V + vst0) = sv0[i]; *(bf16x8*)(V_lds + (b) * SHM_V + vst1) = sv1[i]; \
    _Pragma("unroll") for (int _q = 0; _q < NKP; ++_q) *(bf16x8*)(K_lds + (b) * SHM_K + klds[_q]) = sk[i][_q]; } while (0)
#define SWAIT() do { if constexpr (SDEPTH == 2) { if constexpr (NKP == 1) asm volatile("s_waitcnt vmcnt(3)" ::: "memory"); else if constexpr (NKP == 2) asm volatile("s_waitcnt vmcnt(4)" ::: "memory"); else asm volatile("s_waitcnt vmcnt(5)" ::: "memory"); } \
    else asm volatile("s_waitcnt vmcnt(0)" ::: "memory"); } while (0)
#define RESC(a) do { if (__any((a) < 1.f)) { if (hi == 0) al_l[r32] = (a); asm volatile("s_waitcnt lgkmcnt(0)" ::: "memory"); \
    _Pragma("unroll") for (int d = 0; d < 4; ++d) _Pragma("unroll") for (int r = 0; r < 16; ++r) o[d][r] *= al_l[crow(r, hi)]; } } while (0)
    f32x16 pA0, pA1, pB0, pB1; float mnA, mnB, alA, alB; bf16x8 pa0, pa1, pa2, pa3; const int NT = seq / KVBLK;
    constexpr int SE = 0, SO = SDEPTH - 1;
    SLOAD(SE, 0); asm volatile("s_waitcnt vmcnt(0)" ::: "memory"); SWRITE(0, SE); __syncthreads();
    qkt<DQK>(pA0, pA1, K_lds, qr, r32, hi); partialSM(pA0, pA1, m_reg, mnA, alA, C, thr_raw);
    SLOAD(SO, KVBLK); if constexpr (SDEPTH == 2) { if (2 < NT) SLOAD(SE, 2 * KVBLK); }
    SWAIT(); SWRITE(1, SO); __syncthreads();
    for (int j = 1; j + 1 < NT; j += 2) {
        SBAR(); qkt<DQK>(pB0, pB1, K_lds + SHM_K, qr, r32, hi);
        finishSM(pA0, pA1, alA, l_reg, pa0, pa1, pa2, pa3); SBAR();
        SLOAD(SO, (j + SDEPTH) * KVBLK); SBAR();
        pv_d0(o, vb0, pa0, pa1, pa2, pa3); partialSM(pB0, pB1, m_reg, mnB, alB, C, thr_raw);
        __syncthreads(); SWAIT(); SWRITE(0, SE);
        RESC(alB); __syncthreads();
        SBAR(); qkt<DQK>(pA0, pA1, K_lds, qr, r32, hi);
        finishSM(pB0, pB1, alB, l_reg, pa0, pa1, pa2, pa3); SBAR();
        if (SDEPTH == 1 || j + 3 < NT) SLOAD(SE, (j + 1 + SDEPTH) * KVBLK); SBAR();
        pv_d0(o, vb0 + SHM_V, pa0, pa1, pa2, pa3); partialSM(pA0, pA1, m_reg, mnA, alA, C, thr_raw);
        __syncthreads(); SWAIT(); SWRITE(1, SO);
        RESC(alA); __syncthreads();
    }
    SBAR(); qkt<DQK>(pB0, pB1, K_lds + SHM_K, qr, r32, hi);
    finishSM(pA0, pA1, alA, l_reg, pa0, pa1, pa2, pa3); SBAR();
    pv_d0(o, vb0, pa0, pa1, pa2, pa3); partialSM(pB0, pB1, m_reg, mnB, alB, C, thr_raw);
    __syncthreads(); RESC(alB);
    finishSM(pB0, pB1, alB, l_reg, pa0, pa1, pa2, pa3); SBAR();
    pv_d0(o, vb0 + SHM_V, pa0, pa1, pa2, pa3);
    if (hi == 0) li_l[r32] = l_reg; asm volatile("s_waitcnt lgkmcnt(0)" ::: "memory");
    float rli[16];
#pragma unroll
    for (int r = 0; r < 16; ++r) rli[r] = __builtin_amdgcn_rcpf(li_l[crow(r, hi)]);
    float* Ow = Ob + (size_t)(wid * QBLK) * ldo;
#pragma unroll
    for (int r = 0; r < 16; ++r) { const int orow = crow(r, hi);
#pragma unroll
        for (int d0 = 0; d0 < 4; ++d0) Ow[(size_t)orow * ldo + d0 * 32 + r32] = o[d0][r] * rli[r]; }
    __syncthreads();
#undef SLOAD
#undef SWRITE
#undef SWAIT
#undef RESC
}
template <int DQK, int QL, int ldq, int ldk, int ldv, int ldo>
__device__ __forceinline__ void attn_body_simple(const bf16_t* __restrict__ Qb, const bf16_t* __restrict__ Kh, const bf16_t* __restrict__ Vh,
                                                 float* __restrict__ Ob, int seq, char* lds) {
    constexpr float C = ScaleOf<DQK>::scale * 1.4426950408889634f, thr_raw = THR / ScaleOf<DQK>::scale;
    constexpr int SHM_K = KVBLK * DQK * 2, RS = DQK * 2, NKP = DQK / 64, KPR = DQK / 8;
    int tid_l = threadIdx.x; asm volatile("" : "+v"(tid_l));
    const int tid = tid_l, wid = tid >> 6, lane = tid & 63, r32 = lane & 31, hi = lane >> 5;
    char* V_lds = lds; char* K_lds = lds + 2 * SHM_V;
    float* ws = (float*)(lds + 2 * SHM_V + 2 * SHM_K) + wid * 64; float* li_l = ws; float* al_l = ws + 32;
    constexpr int NQR = DQK / 16 - QL;
    char* qpark = lds + 2 * SHM_V + 2 * SHM_K + 2048 + wid * (QL * 1024) + lane * 16;
    float m_reg = -1e30f, l_reg = 0; f32x16 o[4] = {}; bf16x8 qr[NQR];
    const bf16_t* Qw = Qb + (size_t)(wid * QBLK + r32) * ldq + hi * 8;
#pragma unroll
    for (int d0 = 0; d0 < NQR; ++d0) qr[d0] = *reinterpret_cast<const bf16x8*>(Qw + d0 * 16);
#pragma unroll
    for (int d0 = 0; d0 < QL; ++d0) *(bf16x8*)(qpark + d0 * 1024) = *reinterpret_cast<const bf16x8*>(Qw + (NQR + d0) * 16);
    const int sr = tid >> 4, sc = (tid & 15) * 8, vst0 = v_st(sr, sc), vst1 = v_st(32 + sr, sc);
    int koff[NKP], klds[NKP];
#pragma unroll
    for (int i = 0; i < NKP; ++i) { const int p = tid + i * 512, row = p / KPR, c8 = p % KPR; koff[i] = row * ldk + c8 * 8; klds[i] = row * RS + ((c8 * 16) ^ ((row & 7) << 4)); }
    const int vb0 = (int)(uintptr_t)V_lds + v_rd_base(lane);
    bf16x8 sv0, sv1, sk[NKP];
#define SLOAD(k0) do { sv0 = *reinterpret_cast<const bf16x8*>(&Vh[(size_t)((k0) + sr) * ldv + sc]); sv1 = *reinterpret_cast<const bf16x8*>(&Vh[(size_t)((k0) + 32 + sr) * ldv + sc]); \
    _Pragma("unroll") for (int _q = 0; _q < NKP; ++_q) sk[_q] = *reinterpret_cast<const bf16x8*>(&Kh[(size_t)(k0) * ldk + koff[_q]]); } while (0)
#define SWRITE(b) do { *(bf16x8*)(V_lds + (b) * SHM_V + vst0) = sv0; *(bf16x8*)(V_lds + (b) * SHM_V + vst1) = sv1; \
    _Pragma("unroll") for (int _q = 0; _q < NKP; ++_q) *(bf16x8*)(K_lds + (b) * SHM_K + klds[_q]) = sk[_q]; } while (0)
#define RESC(a) do { if (__any((a) < 1.f)) { if (hi == 0) al_l[r32] = (a); asm volatile("s_waitcnt lgkmcnt(0)" ::: "memory"); \
    _Pragma("unroll") for (int d = 0; d < 4; ++d) _Pragma("unroll") for (int r = 0; r < 16; ++r) o[d][r] *= al_l[crow(r, hi)]; } } while (0)
    const int NT = seq / KVBLK;
    SLOAD(0); asm volatile("s_waitcnt vmcnt(0)" ::: "memory"); SWRITE(0); __syncthreads();
    for (int j = 0; j < NT; ++j) {
        const int b = j & 1;
        if (j + 1 < NT) SLOAD((j + 1) * KVBLK);
        SBAR();
        f32x16 p0, p1; float mn, al; bf16x8 pa0, pa1, pa2, pa3;
        { const char* Ks = K_lds + b * SHM_K; p0 = f32x16{}; p1 = f32x16{};
#pragma unroll
          for (int d0 = 0; d0 < DQK / 16; ++d0) { const int cb = (d0 * 16 + hi * 8) * 2;
              const bf16x8 b0 = *reinterpret_cast<const bf16x8*>(Ks + r32 * RS + (cb ^ ((r32 & 7) << 4)));
              const bf16x8 b1 = *reinterpret_cast<const bf16x8*>(Ks + (32 + r32) * RS + (cb ^ ((r32 & 7) << 4)));
              bf16x8 qf; if (d0 < NQR) qf = qr[d0 < NQR ? d0 : 0]; else qf = *(const bf16x8*)(qpark + (d0 - NQR) * 1024);
              p0 = __builtin_amdgcn_mfma_f32_32x32x16_bf16(b0, qf, p0, 0, 0, 0);
              p1 = __builtin_amdgcn_mfma_f32_32x32x16_bf16(b1, qf, p1, 0, 0, 0); } }
        partialSM(p0, p1, m_reg, mn, al, C, thr_raw);
        RESC(al);
        finishSM(p0, p1, al, l_reg, pa0, pa1, pa2, pa3); SBAR();
        pv_d0(o, vb0 + b * SHM_V, pa0, pa1, pa2, pa3);
        if (j + 1 < NT) { asm volatile("s_waitcnt vmcnt(0)" ::: "memory"); SWRITE(b ^ 1); }
        __syncthreads();
    }
    if (hi == 0) li_l[r32] = l_reg; asm volatile("s_waitcnt lgkmcnt(0)" ::: "memory");
    float rli[16];
#pragma unroll
    for (int r = 0; r < 16; ++r) rli[r] = __builtin_amdgcn_rcpf(li_l[crow(r, hi)]);
    float* Ow = Ob + (size_t)(wid * QBLK) * ldo;
#pragma unroll
    for (int r = 0; r < 16; ++r) { const int orow = crow(r, hi);
#pragma unroll
        for (int d0 = 0; d0 < 4; ++d0) Ow[(size_t)orow * ldo + d0 * 32 + r32] = o[d0][r] * rli[r]; }
    __syncthreads();
#undef SLOAD
#undef SWRITE
#undef RESC
}
}

struct Params {
    const float* x; const float* c; const float* ctx; const float* c_ctx; const float* w_mod; const float* b_mod; const float* g_norm1; const float* g_norm2;
    const float* w_in_ab; const float* g_cq; const float* w_uq; const float* g_ckv; const float* w_ukv; const float* g_qn_a; const float* g_kn_a; const float* lam_vec;
    const float* g_qn_b; const float* g_kn_b; const float* g_sub_b; const float* w_out_ab; const float* w_in_c; const float* g_qn_c; const float* g_kn_c; const float* w_out_c;
    const float* w_pq; const float* sub_keys; const float* expert_u; const float* expert_v;
    float* out; unsigned char* ws; int ph_lo, ph_hi;
};

typedef const __attribute__((address_space(4))) Params CParams;
struct Ctx {
    int tid, lane, wid, G, vcu, bx;
    unsigned char* ws; char* lds;
};

__device__ __forceinline__ void tconv(const Ctx& F, const float* src, bf16_t* dst, const float* gain, int nmat, int K, int N, int Npad) {
    float* tile = (float*)(F.lds + 32768);
    const int ntn = Npad / 64, ntk = K / 64, per = ntn * ntk, total = per * nmat;
    for (int it = F.vcu; it < total; it += F.G) {
        const int mat = it / per, rem = it % per, tn = rem / ntk, tk = rem % ntk, k0 = tk * 64, n0 = tn * 64;
        const float* s = src + (size_t)mat * K * N; bf16_t* d = dst + (size_t)mat * Npad * K;
        __syncthreads();
        { const int r = F.tid >> 4, c4 = (F.tid & 15) * 4;
#pragma unroll
          for (int i = 0; i < 2; ++i) { const int rr = r + i * 32; f32x4 v = (f32x4){0.f, 0.f, 0.f, 0.f};
              if (n0 + c4 < N) v = *(const f32x4*)(s + (size_t)(k0 + rr) * N + n0 + c4);
              tile[rr * 65 + c4 + 0] = v[0]; tile[rr * 65 + c4 + 1] = v[1]; tile[rr * 65 + c4 + 2] = v[2]; tile[rr * 65 + c4 + 3] = v[3]; } }
        __syncthreads();
        { const int n = F.tid >> 3, kc = (F.tid & 7) * 8; float v[8];
#pragma unroll
          for (int e = 0; e < 8; ++e) { v[e] = tile[(kc + e) * 65 + n]; if (gain) v[e] *= gain[(size_t)mat * K + k0 + kc + e]; }
          u32x4 w; w.x = cvt_pk_bf16(v[0], v[1]); w.y = cvt_pk_bf16(v[2], v[3]); w.z = cvt_pk_bf16(v[4], v[5]); w.w = cvt_pk_bf16(v[6], v[7]);
          *(u32x4*)(d + (size_t)(n0 + n) * K + k0 + kc) = w; }
    }
}
__device__ __forceinline__ void cvt_flat(const Ctx& F, const float* src, bf16_t* dst, size_t n8) {
    for (size_t i = (size_t)F.vcu * 512 + F.tid; i < n8; i += (size_t)F.G * 512) {
        const f32x4 a = *(const f32x4*)(src + i * 8), b = *(const f32x4*)(src + i * 8 + 4);
        u32x4 w; w.x = cvt_pk_bf16(a[0], a[1]); w.y = cvt_pk_bf16(a[2], a[3]); w.z = cvt_pk_bf16(b[0], b[1]); w.w = cvt_pk_bf16(b[2], b[3]);
        *(u32x4*)(dst + i * 8) = w;
    }
}
__device__ __forceinline__ float silu_f(float v) { return v / (1.f + __expf(-v)); }

__device__ __forceinline__ void prologue_phase(const Ctx& F, CParams& P) {
    unsigned char* ws = F.ws;
    {
        float* sv = (float*)F.lds;
        float* part = (float*)(F.lds + 24576);
        for (int i = F.tid; i < 3 * DM; i += 512) { const int v = i / DM, k = i % DM; const float cv = v < 2 ? P.c[v * DM + k] : P.c_ctx[k]; sv[i] = silu_f(cv); }
        __syncthreads();
        float* mod = (float*)(ws + WS_MOD);
        for (int it = F.vcu; it < DEPTH * 192; it += F.G) {
            const int l = it / 192, n0 = (it % 192) * 64;
            const float* wp = P.w_mod + ((size_t)l * DM + F.wid * 256) * 12288 + n0 + F.lane;
            float a0 = 0.f, a1 = 0.f, a2 = 0.f;
#pragma unroll 8
            for (int k = 0; k < 256; ++k) { const float w = wp[(size_t)k * 12288]; const int kk = F.wid * 256 + k; a0 += sv[kk] * w; a1 += sv[DM + kk] * w; a2 += sv[2 * DM + kk] * w; }
            part[(F.wid * 3 + 0) * 64 + F.lane] = a0; part[(F.wid * 3 + 1) * 64 + F.lane] = a1; part[(F.wid * 3 + 2) * 64 + F.lane] = a2;
            __syncthreads();
            if (F.wid < 3) { float s = 0.f;
#pragma unroll
                for (int w = 0; w < 8; ++w) s += part[(w * 3 + F.wid) * 64 + F.lane];
                mod[((size_t)l * 3 + F.wid) * 12288 + n0 + F.lane] = s + P.b_mod[(size_t)l * 12288 + n0 + F.lane]; }
            __syncthreads();
        }
    }
    if (F.vcu == 0) {
        float* t16 = (float*)(ws + WS_TAB16); float* t32 = (float*)(ws + WS_TAB32);
        for (int i = F.tid; i < 128 * 16; i += 512) { const int pos = i >> 4, f = i & 15; const float fr = powf(10000.f, -(float)f / 16.f); const float a = (float)pos * fr; float s, c; sincosf(a, &s, &c); t16[i * 2] = c; t16[i * 2 + 1] = s; }
        for (int i = F.tid; i < 128 * 32; i += 512) { const int pos = i >> 5, f = i & 31; const float fr = powf(10000.f, -(float)f / 32.f); const float a = (float)pos * fr; float s, c; sincosf(a, &s, &c); t32[i * 2] = c; t32[i * 2 + 1] = s; }
        if (F.wid < 2) { const float* lv = P.lam_vec + F.wid * 256; const float d1 = wave_sum(lv[F.lane] * lv[64 + F.lane]), d2 = wave_sum(lv[128 + F.lane] * lv[192 + F.lane]);
            const float lam_init = 0.8f - 0.6f * expf(-0.3f * (float)(2 * F.wid));
            if (F.lane == 0) ((float*)(ws + WS_LAM))[F.wid] = expf(d1) - expf(d2) + lam_init; }
    }
    tconv(F, P.w_in_ab, (bf16_t*)(ws + WS_WINAB), nullptr, 2, DM, AB_IN, AB_INP);
    tconv(F, P.w_uq, (bf16_t*)(ws + WS_WUQ), P.g_cq, 2, 768, 1536, 1536);
    tconv(F, P.w_ukv, (bf16_t*)(ws + WS_WUKV), P.g_ckv, 2, 512, 2048, 2048);
    tconv(F, P.w_out_ab, (bf16_t*)(ws + WS_WOUTAB), nullptr, 2, DM, DM, DM);
    tconv(F, P.w_in_c, (bf16_t*)(ws + WS_WINC), nullptr, 2, DM, C_IN, C_IN);
    tconv(F, P.w_out_c, (bf16_t*)(ws + WS_WOUTC), nullptr, 2, DM, DM, DM);
    tconv(F, P.w_pq, (bf16_t*)(ws + WS_WPQ), nullptr, 4, DM, DM, DM);
    cvt_flat(F, P.sub_keys, (bf16_t*)(ws + WS_SUBK), (size_t)4 * 8 * 2 * 128 * 128 / 8);
    cvt_flat(F, P.expert_u, (bf16_t*)(ws + WS_EU), (size_t)4 * NEXP * DM / 8);
    cvt_flat(F, P.expert_v, (bf16_t*)(ws + WS_EV), (size_t)4 * NEXP * DM / 8);
}

__device__ __forceinline__ void norm_phase(const Ctx& F, CParams& P, int layer, int which  , int m_rows) {
    float* X = (float*)(F.ws + WS_X); bf16_t* H = (bf16_t*)(F.ws + WS_H);
    const float* mod = (const float*)(F.ws + WS_MOD) + (size_t)layer * 3 * 12288;
    const float* gn = (which ? P.g_norm2 : P.g_norm1) + (size_t)layer * DM;
    const bool from_in = (layer == 0 && which == 0);
    for (int t = F.vcu * 8 + F.wid; t < m_rows; t += F.G * 8) {
        const int vs = vsel_of_row(t);
        const float* src = from_in ? (t < TL ? P.x + (size_t)t * DM : P.ctx + (size_t)(t - TL) * DM) : X + (size_t)t * DM;
        const float* shf = mod + (size_t)vs * 12288 + (which ? 3 : 0) * DM; const float* scl = shf + DM;
        f32x4 v[8]; float ss = 0.f;
#pragma unroll
        for (int j = 0; j < 8; ++j) { v[j] = *(const f32x4*)(src + j * 256 + F.lane * 4); ss += v[j][0] * v[j][0] + v[j][1] * v[j][1] + v[j][2] * v[j][2] + v[j][3] * v[j][3]; }
        ss = wave_sum(ss);
        const float rstd = rsqrtf(ss * (1.f / DM) + EPS);
#pragma unroll
        for (int j = 0; j < 8; ++j) { const int c = j * 256 + F.lane * 4;
            if (from_in) *(f32x4*)(X + (size_t)t * DM + c) = v[j];
            const f32x4 g = *(const f32x4*)(gn + c), sc = *(const f32x4*)(scl + c), sh = *(const f32x4*)(shf + c);
            f32x4 y;
#pragma unroll
            for (int e = 0; e < 4; ++e) y[e] = (v[j][e] * rstd * g[e]) * (1.f + sc[e]) + sh[e];
            u32x2 w; w.x = cvt_pk_bf16(y[0], y[1]); w.y = cvt_pk_bf16(y[2], y[3]);
            *(u32x2*)(H + (size_t)t * DM + c) = w; }
    }
}

__device__ __forceinline__ void rope16(float& x0, float& x1, int l2, int row, int col, const float* t16) {
    const int o = 2 * l2, seg = o >> 5, i = o & 31, f = i & 15, pos = seg ? col : row; const bool first = i < 16;
    const float p0 = __shfl_xor(x0, 8), p1 = __shfl_xor(x1, 8);
    const f32x4 cs = *(const f32x4*)(t16 + (pos * 16 + f) * 2);
    if (first) { x0 = x0 * cs[0] - p0 * cs[1]; x1 = x1 * cs[2] - p1 * cs[3]; }
    else       { x0 = p0 * cs[1] + x0 * cs[0]; x1 = p1 * cs[3] + x1 * cs[2]; }
}
__device__ __forceinline__ void rope32(float& x0, float& x1, int l2, int pos, const float* t32) {
    const int i = 2 * l2, f = i & 31; const bool first = i < 32;
    const float p0 = __shfl_xor(x0, 16), p1 = __shfl_xor(x1, 16);
    const f32x4 cs = *(const f32x4*)(t32 + (pos * 32 + f) * 2);
    if (first) { x0 = x0 * cs[0] - p0 * cs[1]; x1 = x1 * cs[2] - p1 * cs[3]; }
    else       { x0 = p0 * cs[1] + x0 * cs[0]; x1 = p1 * cs[3] + x1 * cs[2]; }
}
__device__ __forceinline__ void ldpair(const bf16_t* p, float& a, float& b) { const unsigned w = *(const unsigned*)p; a = bf_lo(w); b = bf_hi(w); }
__device__ __forceinline__ void stpair(bf16_t* p, float a, float b) { *(unsigned*)p = cvt_pk_bf16(a, b); }

__device__ __forceinline__ void qkv_even_phase(const Ctx& F, CParams& P, int e) {
    const bf16_t* P1 = (const bf16_t*)(F.ws + WS_P1); const bf16_t* QA = (const bf16_t*)(F.ws + WS_QA); const bf16_t* KV = (const bf16_t*)(F.ws + WS_KV);
    bf16_t* Qm = (bf16_t*)(F.ws + WS_Q1); bf16_t* Km = (bf16_t*)(F.ws + WS_K1); bf16_t* Vm = (bf16_t*)(F.ws + WS_V1);
    bf16_t* Qd = (bf16_t*)(F.ws + WS_Q2); bf16_t* Kd = (bf16_t*)(F.ws + WS_K2); bf16_t* Vd = (bf16_t*)(F.ws + WS_V2);
    const float* t16 = (const float*)(F.ws + WS_TAB16);
    const float* gqa = P.g_qn_a + e * 192; const float* gka = P.g_kn_a + e * 192; const float* gqb = P.g_qn_b + e * 64; const float* gkb = P.g_kn_b + e * 64;
    const int l2 = F.lane & 31, hw = F.lane >> 5;
    for (int t = F.vcu * 8 + F.wid; t < TT; t += F.G * 8) {
        const bool latent = t < TL; const int s = t & (SEQ - 1), row = s >> 6, col = s & 63; const int kr = krow_of(t);
        const bf16_t* p1 = P1 + (size_t)t * AB_INP;
        float ss = 0.f;
#pragma unroll
        for (int j = 0; j < 3; ++j) { const u32x2 w = *(const u32x2*)(p1 + j * 256 + F.lane * 4); const float a = bf_lo(w.x), b = bf_hi(w.x), c = bf_lo(w.y), d = bf_hi(w.y); ss += a * a + b * b + c * c + d * d; }
        ss = wave_sum(ss); const float rstd_q = rsqrtf(ss * (1.f / 768.f) + EPS);
        float s2 = 0.f;
        { const u32x4 w = *(const u32x4*)(p1 + 768 + F.lane * 8);
#pragma unroll
          for (int q = 0; q < 4; ++q) { const float a = bf_lo(w[q]), b = bf_hi(w[q]); s2 += a * a + b * b; } }
        s2 = wave_sum(s2); const float rstd_kv = rsqrtf(s2 * (1.f / 512.f) + EPS);
#pragma unroll 1
        for (int it = 0; it < 4; ++it) { const int h = it * 2 + hw; const bf16_t* src = QA + (size_t)t * 1536 + h * 192 + 2 * l2;
            float x[3][2]; float sq = 0.f;
#pragma unroll
            for (int c = 0; c < 3; ++c) { ldpair(src + c * 64, x[c][0], x[c][1]); x[c][0] *= rstd_q; x[c][1] *= rstd_q; sq += x[c][0] * x[c][0] + x[c][1] * x[c][1]; }
            sq = hw_sum(sq); const float r = rsqrtf(sq * (1.f / 192.f) + EPS);
#pragma unroll
            for (int c = 0; c < 3; ++c) { x[c][0] *= r * gqa[c * 64 + 2 * l2]; x[c][1] *= r * gqa[c * 64 + 2 * l2 + 1]; }
            if (latent) rope16(x[2][0], x[2][1], l2, row, col, t16);
            bf16_t* dst = Qm + ((size_t)t * 8 + h) * 192 + 2 * l2;
#pragma unroll
            for (int c = 0; c < 3; ++c) stpair(dst + c * 64, x[c][0], x[c][1]); }
#pragma unroll 1
        for (int it = 0; it < 4; ++it) { const int h = it * 2 + hw; const bf16_t* src = KV + (size_t)t * 2048 + h * 256 + 2 * l2;
            float x[3][2]; float sq = 0.f;
#pragma unroll
            for (int c = 0; c < 2; ++c) { ldpair(src + c * 64, x[c][0], x[c][1]); x[c][0] *= rstd_kv; x[c][1] *= rstd_kv; }
            ldpair(p1 + 1280 + 2 * l2, x[2][0], x[2][1]);
#pragma unroll
            for (int c = 0; c < 3; ++c) sq += x[c][0] * x[c][0] + x[c][1] * x[c][1];
            sq = hw_sum(sq); const float r = rsqrtf(sq * (1.f / 192.f) + EPS);
#pragma unroll
            for (int c = 0; c < 3; ++c) { x[c][0] *= r * gka[c * 64 + 2 * l2]; x[c][1] *= r * gka[c * 64 + 2 * l2 + 1]; }
            if (latent) rope16(x[2][0], x[2][1], l2, row, col, t16);
            bf16_t* dst = Km + ((size_t)kr * 8 + h) * 192 + 2 * l2;
#pragma unroll
            for (int c = 0; c < 3; ++c) stpair(dst + c * 64, x[c][0], x[c][1]);
            bf16_t* dv = Vm + ((size_t)kr * 8 + h) * 128 + 2 * l2;
#pragma unroll
            for (int c = 0; c < 2; ++c) { float a, b; ldpair(src + 128 + c * 64, a, b); stpair(dv + c * 64, a * rstd_kv, b * rstd_kv); } }
#pragma unroll 1
        for (int it = 0; it < 8; ++it) { const int hm = it * 2 + hw;
            float a, b; ldpair(p1 + 1344 + hm * 64 + 2 * l2, a, b);
            float sq = hw_sum(a * a + b * b); float r = rsqrtf(sq * (1.f / 64.f) + EPS);
            a *= r * gqb[2 * l2]; b *= r * gqb[2 * l2 + 1];
            if (latent) rope16(a, b, l2, row, col, t16);
            stpair(Qd + ((size_t)t * 16 + hm) * 64 + 2 * l2, a, b);
            ldpair(p1 + 2368 + hm * 64 + 2 * l2, a, b);
            sq = hw_sum(a * a + b * b); r = rsqrtf(sq * (1.f / 64.f) + EPS);
            a *= r * gkb[2 * l2]; b *= r * gkb[2 * l2 + 1];
            if (latent) rope16(a, b, l2, row, col, t16);
            stpair(Kd + ((size_t)kr * 16 + hm) * 64 + 2 * l2, a, b); }
#pragma unroll
        for (int j = 0; j < 2; ++j) *(u32x4*)(Vd + (size_t)kr * 1024 + j * 512 + F.lane * 8) = *(const u32x4*)(p1 + 3392 + j * 512 + F.lane * 8);
    }
}
__device__ __forceinline__ void qkv_odd_phase(const Ctx& F, CParams& P, int e) {
    const bf16_t* P1 = (const bf16_t*)(F.ws + WS_P1);
    bf16_t* Qc = (bf16_t*)(F.ws + WS_Q1); bf16_t* Kc = (bf16_t*)(F.ws + WS_K1); bf16_t* Vc = (bf16_t*)(F.ws + WS_V1);
    const float* t32 = (const float*)(F.ws + WS_TAB32);
    const float* gq = P.g_qn_c + e * 128; const float* gk = P.g_kn_c + e * 128;
    const int l2 = F.lane & 31, hw = F.lane >> 5;
    for (int t = F.vcu * 8 + F.wid; t < TT; t += F.G * 8) {
        const bool latent = t < TL; const int s = t & (SEQ - 1), row = s >> 6, col = s & 63; const int kr = krow_of(t);
        const bf16_t* p1 = P1 + (size_t)t * C_IN;
#pragma unroll 1
        for (int it = 0; it < 10; ++it) {
            const bool isq = it < 8; const int h = (isq ? it : it - 8) * 2 + hw;
            const bf16_t* src = p1 + (isq ? 0 : 2048) + h * 128 + 2 * l2; const float* g = isq ? gq : gk;
            float x[2][2]; float sq = 0.f;
#pragma unroll
            for (int c = 0; c < 2; ++c) { ldpair(src + c * 64, x[c][0], x[c][1]); sq += x[c][0] * x[c][0] + x[c][1] * x[c][1]; }
            sq = hw_sum(sq); const float r = rsqrtf(sq * (1.f / 128.f) + EPS);
#pragma unroll
            for (int c = 0; c < 2; ++c) { x[c][0] *= r * g[c * 64 + 2 * l2]; x[c][1] *= r * g[c * 64 + 2 * l2 + 1]; }
            if (latent) { rope32(x[0][0], x[0][1], l2, row, t32); rope32(x[1][0], x[1][1], l2, col, t32); }
            bf16_t* dst = isq ? Qc + ((size_t)t * 16 + h) * 128 + 2 * l2 : Kc + ((size_t)kr * 4 + h) * 128 + 2 * l2;
#pragma unroll
            for (int c = 0; c < 2; ++c) stpair(dst + c * 64, x[c][0], x[c][1]); }
        *(u32x4*)(Vc + (size_t)kr * 512 + F.lane * 8) = *(const u32x4*)(p1 + 2560 + F.lane * 8);
    }
}

template <int DQK, int SDEPTH, int ldo, int NH, int NKVH, int NVH>
__device__ __forceinline__ void attn_phase(const Ctx& F, const bf16_t* Qbuf, const bf16_t* Kbuf, const bf16_t* Vbuf, float* OF, int ocol0, bool with_ctx) {
    constexpr int kv_div = NH / NKVH, v_div = NH / NVH;
    const int n_lat = NH * NB * 32, n_tot = n_lat + (with_ctx ? NH * NB : 0);
    constexpr int ldq = NH * DQK, ldk = NKVH * DQK, ldv = NVH * 128;
    for (int u = F.vcu; u < n_tot; u += F.G) {
        int b, h, qrow0, kstart, seq;
        if (u < n_lat) { const int bh = u >> 5, qb = u & 31; b = bh / NH; h = bh % NH; qrow0 = b * SEQ + qb * 256; kstart = b * KPB; seq = KPB; }
        else { const int bh = u - n_lat; b = bh / NH; h = bh % NH; qrow0 = TL + b * CTXL; kstart = b * KPB + SEQ; seq = CTXL; }
        const bf16_t* Qp = Qbuf + ((size_t)qrow0 * NH + h) * DQK;
        const bf16_t* Kp = Kbuf + ((size_t)kstart * NKVH + h / kv_div) * DQK;
        const bf16_t* Vp = Vbuf + ((size_t)kstart * NVH + h / v_div) * 128;
        float* Op = OF + (size_t)qrow0 * ldo + ocol0 + h * 128;
        if constexpr (SDEPTH == 0) att::attn_body_simple<DQK, (DQK == 192 ? MLA_QL : 0), ldq, ldk, ldv, ldo>(Qp, Kp, Vp, Op, seq, F.lds);
        else att::attn_body<DQK, SDEPTH, ldq, ldk, ldv, ldo>(Qp, Kp, Vp, Op, seq, F.lds);
    }
}

__device__ __forceinline__ void merge_even_phase(const Ctx& F, CParams& P, int e, int layer, int m_rows) {
    const float* OF = (const float*)(F.ws + WS_OF); bf16_t* AO = (bf16_t*)(F.ws + WS_AO);
    const float lam = ((const float*)(F.ws + WS_LAM))[e];
    const float lam_init = 0.8f - 0.6f * expf(-0.3f * (float)layer);
    const float* gs = P.g_sub_b + e * 128;
    const int l2 = F.lane & 31, hw = F.lane >> 5;
    for (int t = F.vcu * 8 + F.wid; t < m_rows; t += F.G * 8) {
        const float* of = OF + (size_t)t * 3072; bf16_t* ao = AO + (size_t)t * DM;
#pragma unroll
        for (int j = 0; j < 4; ++j) { const f32x4 v = *(const f32x4*)(of + j * 256 + F.lane * 4); u32x2 w; w.x = cvt_pk_bf16(v[0], v[1]); w.y = cvt_pk_bf16(v[2], v[3]); *(u32x2*)(ao + j * 256 + F.lane * 4) = w; }
#pragma unroll
        for (int it = 0; it < 4; ++it) { const int h = it * 2 + hw;
            const f32x4 o0 = *(const f32x4*)(of + 1024 + (2 * h) * 128 + l2 * 4), o1 = *(const f32x4*)(of + 1024 + (2 * h + 1) * 128 + l2 * 4);
            f32x4 d = o0 - lam * o1;
            float sq = hw_sum(d[0] * d[0] + d[1] * d[1] + d[2] * d[2] + d[3] * d[3]);
            const float r = rsqrtf(sq * (1.f / 128.f) + EPS) * (1.f - lam_init);
            const f32x4 g = *(const f32x4*)(gs + l2 * 4);
            u32x2 w; w.x = cvt_pk_bf16(d[0] * r * g[0], d[1] * r * g[1]); w.y = cvt_pk_bf16(d[2] * r * g[2], d[3] * r * g[3]);
            *(u32x2*)(ao + 1024 + h * 128 + l2 * 4) = w; }
    }
}
__device__ __forceinline__ void merge_odd_phase(const Ctx& F, int m_rows) {
    const float* OF = (const float*)(F.ws + WS_OF); bf16_t* AO = (bf16_t*)(F.ws + WS_AO);
    for (int t = F.vcu * 8 + F.wid; t < m_rows; t += F.G * 8) {
        const float* of = OF + (size_t)t * 2048; bf16_t* ao = AO + (size_t)t * DM;
#pragma unroll
        for (int j = 0; j < 8; ++j) { const f32x4 v = *(const f32x4*)(of + j * 256 + F.lane * 4); u32x2 w; w.x = cvt_pk_bf16(v[0], v[1]); w.y = cvt_pk_bf16(v[2], v[3]); *(u32x2*)(ao + j * 256 + F.lane * 4) = w; }
    }
}

__device__ __forceinline__ unsigned fkey(float f) { const unsigned b = __float_as_uint(f); return b ^ ((unsigned)((int)b >> 31) | 0x80000000u); }
template <int S> __device__ __forceinline__ unsigned kth16(const unsigned (&key)[S]) {
    unsigned lo = 0u, hi = 0xFFFFFFFFu;
    while (lo < hi) {
        const unsigned mid = lo + ((hi - lo) >> 1) + 1u;
        int c = 0;
#pragma unroll
        for (int s = 0; s < S; ++s) c += __popcll(__ballot(key[s] >= mid));
        if (c >= 16) { lo = mid; if (c == 16) break; } else hi = mid - 1u;
    }
    return lo;
}
template <int S> __device__ __forceinline__ void top16(const float (&val)[S], const int (&idx)[S], float* outv, int* outi) {
    unsigned key[S];
#pragma unroll
    for (int s = 0; s < S; ++s) key[s] = fkey(val[s]);
    const unsigned T = kth16<S>(key);
    int cgt = 0;
#pragma unroll
    for (int s = 0; s < S; ++s) cgt += __popcll(__ballot(key[s] > T));
    const int need = 16 - cgt;
    int base = 0, eqseen = 0;
#pragma unroll
    for (int s = 0; s < S; ++s) {
        const bool gt = key[s] > T, eq = key[s] == T;
        const unsigned long long meq = __ballot(eq);
        const int eqpos = eqseen + mbcnt64(meq);
        const bool take = gt || (eq && eqpos < need);
        const unsigned long long mt = __ballot(take);
        const int pos = base + mbcnt64(mt);
        if (take && pos < 16) { outv[pos] = val[s]; outi[pos] = idx[s]; }
        base += __popcll(mt); eqseen += __popcll(meq);
    }
}
__device__ __forceinline__ void wave_lds_fence() { asm volatile("s_waitcnt lgkmcnt(0)" ::: "memory"); __builtin_amdgcn_wave_barrier(); asm volatile("" ::: "memory"); }

__device__ __forceinline__ void peer_select_phase(const Ctx& F, int layer, int m_rows) {
    const bf16_t* PQ = (const bf16_t*)(F.ws + WS_PQ); const bf16_t* SK = (const bf16_t*)(F.ws + WS_SUBK) + (size_t)layer * 8 * 2 * 128 * 128;
    int* PIDX = (int*)(F.ws + WS_PIDX); float* PG = (float*)(F.ws + WS_PG);
    float* sc = (float*)F.lds;
    float* wsv = (float*)(F.lds + 65536) + F.wid * 128;
    int* wsi = (int*)(F.lds + 65536 + 8 * 512) + F.wid * 128;
    const int r32 = F.lane & 31, hi = F.lane >> 5;
    const int nunits = (m_rows / 64) * 8;
    for (int u = F.vcu; u < nunits; u += F.G) {
        const int tile = u >> 3, h = u & 7, t0 = tile * 64;
        { const int p = F.wid >> 2, nb = F.wid & 3;
          f32x16 acc0 = {}, acc1 = {};
          const bf16_t* bp = SK + ((size_t)(h * 2 + p) * 128 + nb * 32 + r32) * 128 + hi * 8;
          const bf16_t* ap = PQ + (size_t)(t0 + r32) * DM + h * 256 + p * 128 + hi * 8;
#pragma unroll
          for (int ks = 0; ks < 8; ++ks) {
              const bf16x8 bfr = *(const bf16x8*)(bp + ks * 16);
              const bf16x8 a0 = *(const bf16x8*)(ap + ks * 16), a1 = *(const bf16x8*)(ap + (size_t)32 * DM + ks * 16);
              acc0 = __builtin_amdgcn_mfma_f32_32x32x16_bf16(a0, bfr, acc0, 0, 0, 0);
              acc1 = __builtin_amdgcn_mfma_f32_32x32x16_bf16(a1, bfr, acc1, 0, 0, 0); }
          __syncthreads();
#pragma unroll
          for (int r = 0; r < 16; ++r) { const int rowi = att::crow(r, hi); sc[rowi * 256 + p * 128 + nb * 32 + r32] = acc0[r]; sc[(32 + rowi) * 256 + p * 128 + nb * 32 + r32] = acc1[r]; }
        }
        __syncthreads();
#pragma unroll 1
        for (int tt = 0; tt < 8; ++tt) {
            const int tok = F.wid * 8 + tt; const float* srow = sc + tok * 256;
#pragma unroll
            for (int p = 0; p < 2; ++p) { float val[2]; int idx[2];
                val[0] = srow[p * 128 + F.lane]; val[1] = srow[p * 128 + 64 + F.lane]; idx[0] = F.lane; idx[1] = 64 + F.lane;
                top16<2>(val, idx, wsv + p * 16, wsi + p * 16); }
            wave_lds_fence();
            { const int i = F.lane & 15, jq = F.lane >> 4; const float a = wsv[i]; const int ia = wsi[i];
              float cv[4]; int ci[4];
#pragma unroll
              for (int c = 0; c < 4; ++c) { const int j = jq * 4 + c; cv[c] = a + wsv[16 + j]; ci[c] = ia * 128 + wsi[16 + j]; }
              top16<4>(cv, ci, wsv + 32, wsi + 32); }
            wave_lds_fence();
            { const float v = wsv[32 + (F.lane & 15)]; const int id = wsi[32 + (F.lane & 15)];
              float mx = v;
#pragma unroll
              for (int o = 8; o >= 1; o >>= 1) mx = fmaxf(mx, __shfl_xor(mx, o));
              const float ex = __expf(v - mx); float sm = ex;
#pragma unroll
              for (int o = 8; o >= 1; o >>= 1) sm += __shfl_xor(sm, o);
              if (F.lane < 16) { const size_t o = ((size_t)(t0 + tok) * 8 + h) * 16 + F.lane; PG[o] = ex / sm; PIDX[o] = id; } }
            wave_lds_fence();
        }
    }
}

__device__ __forceinline__ float dot2bf(unsigned w, unsigned x, float acc) { return __builtin_amdgcn_fdot2_f32_bf16(__builtin_bit_cast(bf16x2_t, w), __builtin_bit_cast(bf16x2_t, x), acc, false); }
__device__ __forceinline__ float gelu_tanh(float a) { const float u = 0.7978845608028654f * (a + 0.044715f * a * a * a); const float t = 1.f - 2.f / (1.f + __expf(2.f * u)); return 0.5f * a * (1.f + t); }
__device__ __forceinline__ float dot_row(const u32x4 (&r)[4], const unsigned (&hq)[16]) {
    float s0 = 0.f, s1 = 0.f, s2 = 0.f, s3 = 0.f;
#pragma unroll
    for (int j = 0; j < 4; ++j) { s0 = dot2bf(r[j].x, hq[j * 4 + 0], s0); s1 = dot2bf(r[j].y, hq[j * 4 + 1], s1); s2 = dot2bf(r[j].z, hq[j * 4 + 2], s2); s3 = dot2bf(r[j].w, hq[j * 4 + 3], s3); }
    return (s0 + s1) + (s2 + s3);
}
__device__ __forceinline__ void ld_row(u32x4 (&r)[4], const bf16_t* tab, int e, int lane) {
    const u32x4* rp = (const u32x4*)(tab + (size_t)e * DM);
#pragma unroll
    for (int j = 0; j < 4; ++j) r[j] = rp[j * 64 + lane];
}
__device__ __forceinline__ void fma_row(float (&out)[32], const u32x4 (&r)[4], float w) {
#pragma unroll
    for (int j = 0; j < 4; ++j) {
        out[j * 8 + 0] = fmaf(w, bf_lo(r[j].x), out[j * 8 + 0]); out[j * 8 + 1] = fmaf(w, bf_hi(r[j].x), out[j * 8 + 1]);
        out[j * 8 + 2] = fmaf(w, bf_lo(r[j].y), out[j * 8 + 2]); out[j * 8 + 3] = fmaf(w, bf_hi(r[j].y), out[j * 8 + 3]);
        out[j * 8 + 4] = fmaf(w, bf_lo(r[j].z), out[j * 8 + 4]); out[j * 8 + 5] = fmaf(w, bf_hi(r[j].z), out[j * 8 + 5]);
        out[j * 8 + 6] = fmaf(w, bf_lo(r[j].w), out[j * 8 + 6]); out[j * 8 + 7] = fmaf(w, bf_hi(r[j].w), out[j * 8 + 7]); }
}
__device__ __forceinline__ void peer_expert_phase(const Ctx& F, CParams& P, int layer, int m_rows, bool last) {
    const bf16_t* EU = (const bf16_t*)(F.ws + WS_EU) + (size_t)layer * NEXP * DM; const bf16_t* EV = (const bf16_t*)(F.ws + WS_EV) + (size_t)layer * NEXP * DM;
    const bf16_t* H = (const bf16_t*)(F.ws + WS_H); float* X = (float*)(F.ws + WS_X);
    const int* PIDX = (const int*)(F.ws + WS_PIDX); const float* PG = (const float*)(F.ws + WS_PG);
    const float* mod = (const float*)(F.ws + WS_MOD) + (size_t)layer * 3 * 12288;
    const int lane = F.lane;
    for (int t = F.vcu * 8 + F.wid; t < m_rows; t += F.G * 8) {
        unsigned hq[16];
        { const u32x4* hp = (const u32x4*)(H + (size_t)t * DM);
#pragma unroll
          for (int j = 0; j < 4; ++j) { const u32x4 w = hp[j * 64 + lane]; hq[j * 4 + 0] = w.x; hq[j * 4 + 1] = w.y; hq[j * 4 + 2] = w.z; hq[j * 4 + 3] = w.w; } }
        int id[2]; float gg[2], aa[2];
        id[0] = PIDX[(size_t)t * 128 + lane]; id[1] = PIDX[(size_t)t * 128 + 64 + lane];
        gg[0] = PG[(size_t)t * 128 + lane]; gg[1] = PG[(size_t)t * 128 + 64 + lane];
#pragma unroll
        for (int half = 0; half < 2; ++half) {
            const int idr = id[half]; float acc = 0.f;
            u32x4 A0[4], A1[4], B0[4], B1[4];
            ld_row(A0, EU, __builtin_amdgcn_readlane(idr, 0), lane); ld_row(A1, EU, __builtin_amdgcn_readlane(idr, 1), lane);
#pragma unroll 1
            for (int k = 0; k < 64; k += 4) {
                ld_row(B0, EU, __builtin_amdgcn_readlane(idr, k + 2), lane); ld_row(B1, EU, __builtin_amdgcn_readlane(idr, k + 3), lane);
                { const float s0 = wave_sum(dot_row(A0, hq)), s1 = wave_sum(dot_row(A1, hq)); acc = (lane == k) ? s0 : acc; acc = (lane == k + 1) ? s1 : acc; }
                if (k + 4 < 64) { ld_row(A0, EU, __builtin_amdgcn_readlane(idr, k + 4), lane); ld_row(A1, EU, __builtin_amdgcn_readlane(idr, k + 5), lane); }
                { const float s2 = wave_sum(dot_row(B0, hq)), s3 = wave_sum(dot_row(B1, hq)); acc = (lane == k + 2) ? s2 : acc; acc = (lane == k + 3) ? s3 : acc; }
            }
            aa[half] = gg[half] * gelu_tanh(acc);
        }
        float out[32];
#pragma unroll
        for (int i = 0; i < 32; ++i) out[i] = 0.f;
#pragma unroll
        for (int half = 0; half < 2; ++half) {
            const int idr = id[half]; const unsigned wbits = __float_as_uint(aa[half]);
            u32x4 A0[4], A1[4], B0[4], B1[4];
            ld_row(A0, EV, __builtin_amdgcn_readlane(idr, 0), lane); ld_row(A1, EV, __builtin_amdgcn_readlane(idr, 1), lane);
#pragma unroll 1
            for (int k = 0; k < 64; k += 4) {
                ld_row(B0, EV, __builtin_amdgcn_readlane(idr, k + 2), lane); ld_row(B1, EV, __builtin_amdgcn_readlane(idr, k + 3), lane);
                fma_row(out, A0, __uint_as_float(__builtin_amdgcn_readlane(wbits, k))); fma_row(out, A1, __uint_as_float(__builtin_amdgcn_readlane(wbits, k + 1)));
                if (k + 4 < 64) { ld_row(A0, EV, __builtin_amdgcn_readlane(idr, k + 4), lane); ld_row(A1, EV, __builtin_amdgcn_readlane(idr, k + 5), lane); }
                fma_row(out, B0, __uint_as_float(__builtin_amdgcn_readlane(wbits, k + 2))); fma_row(out, B1, __uint_as_float(__builtin_amdgcn_readlane(wbits, k + 3)));
            }
        }
        const float* gate = mod + (size_t)vsel_of_row(t) * 12288 + 5 * DM;
        float* xr = X + (size_t)t * DM; float* dst = last ? P.out + (size_t)t * DM : xr;
#pragma unroll
        for (int j = 0; j < 4; ++j)
#pragma unroll
            for (int q = 0; q < 2; ++q) { const int c = j * 512 + lane * 8 + q * 4; const f32x4 xo = *(const f32x4*)(xr + c), g = *(const f32x4*)(gate + c);
                f32x4 y; y[0] = xo[0] + g[0] * out[j * 8 + q * 4 + 0]; y[1] = xo[1] + g[1] * out[j * 8 + q * 4 + 1]; y[2] = xo[2] + g[2] * out[j * 8 + q * 4 + 2]; y[3] = xo[3] + g[3] * out[j * 8 + q * 4 + 3];
                *(f32x4*)(dst + c) = y; }
    }
}

constexpr int N_PHASES = 1 + 2 * 11 + 2 * 10;
__global__ void __launch_bounds__(512, 2) mk_fwd(Params Pval) {
    extern __shared__ __attribute__((aligned(16))) unsigned char lds_raw[];
    LAS unsigned char* ldsl = (LAS unsigned char*)lds_raw;
    volatile LAS unsigned* misc = (volatile LAS unsigned*)(ldsl + LDS_MISC);
    if (threadIdx.x < 16) misc[threadIdx.x] = 0u;
    __syncthreads();
    XcdBarrier bar = xcd_barrier_post((unsigned*)(Pval.ws + WS_CTL) + 1024, misc);
    const int lo = Pval.ph_lo, hi = Pval.ph_hi; int ph = 0;
#define MKCTX() Ctx F; { int tid_ = threadIdx.x; asm volatile("" : "+v"(tid_)); F.tid = tid_; F.lane = tid_ & 63; F.wid = __builtin_amdgcn_readfirstlane(tid_ >> 6); \
        int G_ = gridDim.x, bx_ = blockIdx.x; asm volatile("" : "+s"(G_), "+s"(bx_)); F.G = G_; F.vcu = (G_ % 8 == 0) ? (bx_ % 8) * (G_ / 8) + bx_ / 8 : bx_; F.bx = bx_; } \
        unsigned long long kp_ = (unsigned long long)__builtin_amdgcn_kernarg_segment_ptr(); asm volatile("" : "+s"(kp_)); CParams& P = *(CParams*)kp_; \
        F.ws = P.ws; F.lds = (char*)lds_raw; unsigned char* ws = F.ws; (void)ws; \
        bf16_t* Hb = (bf16_t*)(ws + WS_H); bf16_t* P1 = (bf16_t*)(ws + WS_P1); float* X = (float*)(ws + WS_X); const float* mod = (const float*)(ws + WS_MOD); (void)Hb; (void)P1; (void)X; (void)mod;
#define PHASE(cls, ...) do { if (ph >= lo && ph < hi) { if constexpr ((PH_MASK >> (cls)) & 1u) { MKCTX(); __VA_ARGS__; } if (ph + 1 < hi) xcd_barrier(bar); } ++ph; } while (0)

    PHASE(0, prologue_phase(F, P));
#pragma unroll 1
    for (int layer = 0; layer < DEPTH; ++layer) {
        const int e = layer >> 1; const bool even = (layer & 1) == 0, lastl = layer == DEPTH - 1;
        const int m_post = lastl ? TL : TT;
        PHASE(1, norm_phase(F, P, layer, 0, TT));
        PHASE(2, { const bf16_t* W = even ? (const bf16_t*)(ws + WS_WINAB) + (size_t)e * AB_INP * DM : (const bf16_t*)(ws + WS_WINC) + (size_t)e * C_IN * DM;
                const int N = even ? AB_INP : C_IN;
                pg8::Gemm g{Hb, W, TT, N, DM, DM}; pg8::StaticOrder S; S.init(TT, N, F.G, F.bx);
                pg8::EpiBf16 E{P1, N};
                pg8::gemm_phase<pg8::EpiBf16, pg8::StaticOrder>(ldsl, g, S, E); });
        if (even) {
            PHASE(3, { { pg8::Gemm g{P1, (const bf16_t*)(ws + WS_WUQ) + (size_t)e * 1536 * 768, TT, 1536, 768, AB_INP}; pg8::StaticOrder S; S.init(TT, 1536, F.G, F.bx);
                      pg8::EpiBf16 E{(bf16_t*)(ws + WS_QA), 1536};
                      pg8::gemm_phase<pg8::EpiBf16, pg8::StaticOrder>(ldsl, g, S, E); }
                    { pg8::Gemm g{P1 + 768, (const bf16_t*)(ws + WS_WUKV) + (size_t)e * 2048 * 512, TT, 2048, 512, AB_INP}; pg8::StaticOrder S; S.init(TT, 2048, F.G, F.bx);
                      pg8::EpiBf16 E{(bf16_t*)(ws + WS_KV), 2048};
                      pg8::gemm_phase<pg8::EpiBf16, pg8::StaticOrder>(ldsl, g, S, E); } });
            PHASE(4, qkv_even_phase(F, P, e));
            PHASE(5, { if constexpr (ATT_SEL & 1) attn_phase<192, MLA_SD, 3072, 8, 8, 8>(F, (const bf16_t*)(ws + WS_Q1), (const bf16_t*)(ws + WS_K1), (const bf16_t*)(ws + WS_V1), (float*)(ws + WS_OF), 0, !lastl);
                    if constexpr (ATT_SEL & 2) attn_phase<64, 2, 3072, 16, 16, 8>(F, (const bf16_t*)(ws + WS_Q2), (const bf16_t*)(ws + WS_K2), (const bf16_t*)(ws + WS_V2), (float*)(ws + WS_OF), 1024, !lastl); });
            PHASE(6, merge_even_phase(F, P, e, layer, m_post));
        } else {
            PHASE(7, qkv_odd_phase(F, P, e));
            PHASE(8, attn_phase<128, GQA_SD, 2048, 16, 4, 4>(F, (const bf16_t*)(ws + WS_Q1), (const bf16_t*)(ws + WS_K1), (const bf16_t*)(ws + WS_V1), (float*)(ws + WS_OF), 0, !lastl));
            PHASE(9, merge_odd_phase(F, m_post));
        }
        PHASE(10, { const bf16_t* W = even ? (const bf16_t*)(ws + WS_WOUTAB) + (size_t)e * DM * DM : (const bf16_t*)(ws + WS_WOUTC) + (size_t)e * DM * DM;
                pg8::Gemm g{(const bf16_t*)(ws + WS_AO), W, m_post, DM, DM, DM}; pg8::StaticOrder S; S.init(m_post, DM, F.G, F.bx);
                pg8::EpiResid E{X, mod + (size_t)layer * 3 * 12288, 2};
                pg8::gemm_phase<pg8::EpiResid, pg8::StaticOrder>(ldsl, g, S, E); });
        PHASE(1, norm_phase(F, P, layer, 1, m_post));
        PHASE(11, { pg8::Gemm g{Hb, (const bf16_t*)(ws + WS_WPQ) + (size_t)layer * DM * DM, m_post, DM, DM, DM}; pg8::StaticOrder S; S.init(m_post, DM, F.G, F.bx);
                pg8::EpiBf16 E{(bf16_t*)(ws + WS_PQ), DM};
                pg8::gemm_phase<pg8::EpiBf16, pg8::StaticOrder>(ldsl, g, S, E); });
        PHASE(12, peer_select_phase(F, layer, m_post));
        PHASE(13, peer_expert_phase(F, P, layer, m_post, lastl));
    }
#undef PHASE
}

extern "C" void kernel_launch(void* const* d_in, const int* in_sizes, int n_in, void* d_out, int out_size, void* d_ws, size_t ws_size, hipStream_t stream) {
    static int grid = 0;
    if (grid == 0) {
        if (n_in != 28 || ws_size < WS_END) { fprintf(stderr, "kernel_launch: expected 28 inputs and >= %zu bytes of workspace, got %d / %zu\n", (size_t)WS_END, n_in, ws_size); grid = -1; return; }
        int dev = 0, cus = 0, per_cu = 0;
        if (hipGetDevice(&dev) != hipSuccess || hipDeviceGetAttribute(&cus, hipDeviceAttributeMultiprocessorCount, dev) != hipSuccess) { grid = -1; return; }
        if (hipFuncSetAttribute((const void*)mk_fwd, hipFuncAttributeMaxDynamicSharedMemorySize, LDS_BYTES) != hipSuccess) { fprintf(stderr, "kernel_launch: hipFuncSetAttribute failed\n"); grid = -1; return; }
        if (hipOccupancyMaxActiveBlocksPerMultiprocessor(&per_cu, (const void*)mk_fwd, 512, LDS_BYTES) != hipSuccess || per_cu < 1) fprintf(stderr, "kernel_launch: occupancy query says %d\n", per_cu);
        (void)hipGetLastError();
        grid = cus;
    }
    if (grid < 0) return;
    (void)hipMemsetAsync((char*)d_ws + WS_CTL, 0, CTL_BYTES, stream);
    Params p{};
    const float** pf = (const float**)&p;
    for (int i = 0; i < 28; ++i) pf[i] = (const float*)d_in[i];
    p.out = (float*)d_out; p.ws = (unsigned char*)d_ws;
#if MK_PER_PHASE_LAUNCH
    for (int i = 0; i < N_PHASES; ++i) { p.ph_lo = i; p.ph_hi = i + 1; hipLaunchKernelGGL(mk_fwd, dim3(grid), dim3(512), LDS_BYTES, stream, p); }
#else
    p.ph_lo = 0; p.ph_hi = N_PHASES;
    hipLaunchKernelGGL(mk_fwd, dim3(grid), dim3(512), LDS_BYTES, stream, p);
#endif
    const hipError_t le = hipPeekAtLastError();
    if (le != hipSuccess) fprintf(stderr, "kernel_launch: launch failed: %s\n", hipGetErrorName(le));
}
```

```cpp
#include <hip/hip_runtime.h>
#include <stdint.h>
#include <stdio.h>

#ifndef MK_PER_PHASE_LAUNCH
#define MK_PER_PHASE_LAUNCH 0
#endif

#ifndef MLA_QL
#define MLA_QL 4
#endif
#ifndef MLA_SD
#define MLA_SD 0
#endif
#ifndef GQA_SD
#define GQA_SD 1
#endif
#ifndef ATT_SEL
#define ATT_SEL 3
#endif
#ifndef PH_MASK
#define PH_MASK 0xFFFFFFFFu
#endif
#define LAS __attribute__((address_space(3)))
typedef unsigned short bf16_t;
typedef short bf16x8 __attribute__((ext_vector_type(8)));
typedef short s16x4 __attribute__((ext_vector_type(4)));
typedef float f32x4 __attribute__((ext_vector_type(4)));
typedef float f32x2 __attribute__((ext_vector_type(2)));
typedef float f32x16 __attribute__((ext_vector_type(16)));
typedef unsigned u32x4 __attribute__((ext_vector_type(4)));
typedef unsigned u32x2 __attribute__((ext_vector_type(2)));
typedef __bf16 bf16x2_t __attribute__((ext_vector_type(2)));

constexpr int DM = 2048, NB = 2, SEQ = 8192, DEPTH = 4, CTXL = 256;
constexpr int TL = NB * SEQ;
constexpr int TZ = NB * CTXL;
constexpr int TT = TL + TZ;
constexpr int KPB = SEQ + CTXL;
constexpr int AB_IN = 4416, AB_INP = 4608;
constexpr int C_IN = 3072;
constexpr int NEXP = 16384;
constexpr float EPS = 1e-6f;
constexpr float LOG2E = 1.4426950408889634f;

constexpr size_t al256(size_t x) { return (x + 255) / 256 * 256; }
constexpr size_t WS_CTL = 0, CTL_BYTES = 1u << 20;
constexpr size_t WS_MOD = WS_CTL + CTL_BYTES;
constexpr size_t WS_TAB16 = WS_MOD + al256((size_t)4 * 3 * 12288 * 4);
constexpr size_t WS_TAB32 = WS_TAB16 + al256((size_t)128 * 16 * 2 * 4);
constexpr size_t WS_LAM = WS_TAB32 + al256((size_t)128 * 32 * 2 * 4);
constexpr size_t WS_WINAB = WS_LAM + 256;
constexpr size_t WS_WUQ = WS_WINAB + (size_t)2 * AB_INP * DM * 2;
constexpr size_t WS_WUKV = WS_WUQ + (size_t)2 * 1536 * 768 * 2;
constexpr size_t WS_WOUTAB = WS_WUKV + (size_t)2 * 2048 * 512 * 2;
constexpr size_t WS_WINC = WS_WOUTAB + (size_t)2 * DM * DM * 2;
constexpr size_t WS_WOUTC = WS_WINC + (size_t)2 * C_IN * DM * 2;
constexpr size_t WS_WPQ = WS_WOUTC + (size_t)2 * DM * DM * 2;
constexpr size_t WS_SUBK = WS_WPQ + (size_t)4 * DM * DM * 2;
constexpr size_t WS_EU = WS_SUBK + (size_t)4 * 8 * 2 * 128 * 128 * 2;
constexpr size_t WS_EV = WS_EU + (size_t)4 * NEXP * DM * 2;
constexpr size_t WS_X = WS_EV + (size_t)4 * NEXP * DM * 2;
constexpr size_t WS_H = WS_X + (size_t)TT * DM * 4;
constexpr size_t WS_P1 = WS_H + (size_t)TT * DM * 2;
constexpr size_t WS_QA = WS_P1 + (size_t)TT * AB_INP * 2;
constexpr size_t WS_KV = WS_QA + (size_t)TT * 1536 * 2;
constexpr size_t WS_Q1 = WS_KV + (size_t)TT * 2048 * 2;
constexpr size_t WS_K1 = WS_Q1 + (size_t)TT * 2048 * 2;
constexpr size_t WS_V1 = WS_K1 + (size_t)TT * 1536 * 2;
constexpr size_t WS_Q2 = WS_V1 + (size_t)TT * 1024 * 2;
constexpr size_t WS_K2 = WS_Q2 + (size_t)TT * 1024 * 2;
constexpr size_t WS_V2 = WS_K2 + (size_t)TT * 1024 * 2;
constexpr size_t WS_OF = WS_V2 + (size_t)TT * 1024 * 2;
constexpr size_t WS_AO = WS_OF + (size_t)TT * 3072 * 4;
constexpr size_t WS_PQ = WS_AO + (size_t)TT * DM * 2;
constexpr size_t WS_PIDX = WS_PQ + (size_t)TT * DM * 2;
constexpr size_t WS_PG = WS_PIDX + (size_t)TT * 128 * 4;
constexpr size_t WS_END = WS_PG + (size_t)TT * 128 * 4;

constexpr int LDS_MAIN = 131072;
constexpr int LDS_MISC = LDS_MAIN;
constexpr int LDS_BYTES = LDS_MAIN + 4096;

__device__ __forceinline__ unsigned cvt_pk_bf16(float lo, float hi) { unsigned r; asm("v_cvt_pk_bf16_f32 %0, %1, %2" : "=v"(r) : "v"(lo), "v"(hi)); return r; }
__device__ __forceinline__ float bf_lo(unsigned w) { return __uint_as_float(w << 16); }
__device__ __forceinline__ float bf_hi(unsigned w) { return __uint_as_float(w & 0xffff0000u); }
__device__ __forceinline__ float wave_sum(float v) {
#pragma unroll
    for (int o = 32; o >= 1; o >>= 1) v += __shfl_xor(v, o);
    return v;
}
__device__ __forceinline__ float hw_sum(float v) {
#pragma unroll
    for (int o = 16; o >= 1; o >>= 1) v += __shfl_xor(v, o);
    return v;
}
__device__ __forceinline__ int mbcnt64(unsigned long long m) { return (int)__builtin_amdgcn_mbcnt_hi((unsigned)(m >> 32), __builtin_amdgcn_mbcnt_lo((unsigned)m, 0u)); }
__device__ __forceinline__ int krow_of(int t) { return t < TL ? (t >> 13) * KPB + (t & (SEQ - 1)) : ((t - TL) >> 8) * KPB + SEQ + ((t - TL) & (CTXL - 1)); }
__device__ __forceinline__ int vsel_of_row(int t) { return t < SEQ ? 0 : (t < TL ? 1 : 2); }

#define XB_TMO      128
#define XB_XCNT(j)  (256  + 64 * (j))
#define XB_XSUB(j)  (1280 + 64 * (j))
#define XB_XGEN(j)  (2304 + 64 * (j))
#define XB_TOP      3328
#define XB_TOPGEN   3392
#define XCD_BAR_WORDS 3456
#define XB_SPIN_CAP (1u << 27)
__device__ __forceinline__ unsigned xb_ld(unsigned* p)              { return __hip_atomic_load(p, __ATOMIC_RELAXED, __HIP_MEMORY_SCOPE_AGENT); }
__device__ __forceinline__ unsigned xb_add(unsigned* p, unsigned v) { return __hip_atomic_fetch_add(p, v, __ATOMIC_RELAXED, __HIP_MEMORY_SCOPE_AGENT); }
__device__ __forceinline__ unsigned xb_xcc_id() { return (unsigned)__builtin_amdgcn_s_getreg((3 << 11) | 20) & 0xFu; }
#define XB_SPIN(cond, bar) do { unsigned _sp = 0; while (cond) { __builtin_amdgcn_s_sleep(1); \
    if ((++_sp & 255u) == 0u) { if (xb_ld(&(bar)[XB_TMO])) break; if (_sp > XB_SPIN_CAP) { atomicAdd(&(bar)[XB_TMO], 1u); break; } } } } while (0)
struct XcdBarrier { unsigned* bar; unsigned x; volatile LAS unsigned* st; };
__device__ __forceinline__ XcdBarrier xcd_barrier_post(unsigned* bar, volatile LAS unsigned* st) {
    XcdBarrier b; b.bar = bar; b.x = xb_xcc_id(); b.st = st;
    if (threadIdx.x == 0) (void)xb_add(&bar[XB_XCNT(b.x)], 1u);
    return b;
}
__device__ __forceinline__ void xcd_barrier_complete(unsigned* bar, unsigned x, unsigned& nloc, unsigned& nx) {
    const unsigned G = gridDim.x * gridDim.y * gridDim.z;
    unsigned sum, cnt, mine, sp = 0u;
    for (;;) {
        sum = 0u; cnt = 0u; mine = 0u;
#pragma unroll
        for (unsigned j = 0; j < 16; ++j) { const unsigned c = xb_ld(&bar[XB_XCNT(j)]); sum += c; cnt += (c > 0u) ? 1u : 0u; mine = (j == x) ? c : mine; }
        if (sum == G) break;
        __builtin_amdgcn_s_sleep(1);
        if ((++sp & 255u) == 0u) { if (xb_ld(&bar[XB_TMO])) break; if (sp > XB_SPIN_CAP) { atomicAdd(&bar[XB_TMO], 1u); break; } }
    }
    nloc = mine > 0u ? mine : 1u; nx = cnt > 0u ? cnt : 1u;
}
__device__ __forceinline__ void xcd_barrier(const XcdBarrier& b) {
    asm volatile("s_waitcnt vmcnt(0)" ::: "memory");
    __syncthreads();
    if (threadIdx.x == 0) {
        unsigned* bar = b.bar;
        __builtin_amdgcn_s_waitcnt(0);
        unsigned nloc = b.st[0], nx = b.st[1];
        if (nloc == 0u) { xcd_barrier_complete(bar, b.x, nloc, nx); b.st[0] = nloc; b.st[1] = nx; }
        const unsigned old = xb_add(&bar[XB_XSUB(b.x)], 1u);
        const unsigned gen = old / nloc;
        if (old + 1u == (gen + 1u) * nloc) {
            __builtin_amdgcn_fence(__ATOMIC_RELEASE, "agent");
            asm volatile("s_waitcnt vmcnt(0)" ::: "memory");
            const unsigned og = xb_add(&bar[XB_TOP], 1u);
            const unsigned tg = og / nx;
            if (og + 1u == (tg + 1u) * nx) xb_add(&bar[XB_TOPGEN], 1u);
            else XB_SPIN(xb_ld(&bar[XB_TOPGEN]) == tg, bar);
            __builtin_amdgcn_fence(__ATOMIC_ACQUIRE, "agent");
            xb_add(&bar[XB_XGEN(b.x)], 1u);
            asm volatile("s_waitcnt vmcnt(0)" ::: "memory");
        } else {
            XB_SPIN(xb_ld(&bar[XB_XGEN(b.x)]) == gen, bar);
            __builtin_amdgcn_fence(__ATOMIC_ACQUIRE, "agent");
            asm volatile("s_waitcnt vmcnt(0)" ::: "memory");
        }
    }
    __syncthreads();
}

namespace pg8 {
constexpr int BM = 256, BK = 64, HALF = 128, HTB = HALF * BK * 2, STAGE_BYTES = 8 * HTB, NXCD = 8, WGM = 8;
__host__ __device__ __forceinline__ int lds_byte(int r, int c) { const int st = (r >> 4) * 2 + (c >> 5), rr = r & 15, cc = c & 31, ob = rr * 64 + cc * 2; return st * 1024 + (ob ^ (((ob >> 9) & 1) << 5)); }
__host__ __device__ __forceinline__ void stage_rc(int b, int& R, int& C) { const int st = b / 1024, sb = b % 1024, swz = sb ^ (((sb >> 9) & 1) << 5); R = (st >> 1) * 16 + swz / 64; C = (st & 1) * 32 + (swz % 64) / 2; }
__host__ __device__ __forceinline__ int perm32(int rho) { const int n = rho >> 4, i = rho & 15; return 8 * (i >> 2) + 4 * n + (i & 3); }
struct Unit { int pm, pn; };
struct Gemm { const bf16_t* A; const bf16_t* Bt; int M, N, K, lda; };
struct StaticOrder {
    int nM, nN, nwg, G, c;
    __host__ __device__ void init(int M, int N, int G_, int c_) { nM = M / BM; nN = N / BM; nwg = nM * nN; G = G_; c = c_; }
    __host__ __device__ bool next(int i, Unit& u) const {
        const long L = (long)i * G + c; if (L >= nwg) return false;
        int wgid = (int)L; { const int q = nwg / NXCD, r = nwg % NXCD, xcd = wgid % NXCD, off = wgid / NXCD; wgid = (xcd < r ? xcd * (q + 1) : r * (q + 1) + (xcd - r) * q) + off; }
        const int nig = WGM * nN, gid = wgid / nig, fm = gid * WGM, gsz = (nM - fm) < WGM ? (nM - fm) : WGM;
        u.pm = fm + ((wgid % nig) % gsz); u.pn = (wgid % nig) / gsz; return true;
    }
    __device__ __forceinline__ void a_ready(const Unit&) const {}
    __device__ __forceinline__ void done(const Unit&) const {}
};
struct EpiBf16 {
    static constexpr bool PERM = true;
    bf16_t* O; int ldc;
    __device__ __forceinline__ void operator()(const f32x4 (&acc)[2][2][4][2], const Unit& u, int wr, int wc, int fr, int fq) const {
        const int row0 = u.pm * BM + wr * 64 + fr; const int col0 = u.pn * BM + wc * 32 + 8 * fq;
#pragma unroll
        for (int ai = 0; ai < 2; ++ai)
#pragma unroll
            for (int m = 0; m < 4; ++m) { bf16_t* rowp = O + (size_t)(row0 + ai * HALF + m * 16) * ldc + col0;
#pragma unroll
                for (int bj = 0; bj < 2; ++bj) { const f32x4 v0 = acc[ai][bj][m][0], v1 = acc[ai][bj][m][1];
                    u32x4 w; w.x = cvt_pk_bf16(v0[0], v0[1]); w.y = cvt_pk_bf16(v0[2], v0[3]); w.z = cvt_pk_bf16(v1[0], v1[1]); w.w = cvt_pk_bf16(v1[2], v1[3]);
                    *(u32x4*)(rowp + bj * HALF) = w; } }
    }
};
struct EpiResid {
    static constexpr bool PERM = false;
    float* X; const float* modl; int chunk;
    __device__ __forceinline__ void operator()(const f32x4 (&acc)[2][2][4][2], const Unit& u, int wr, int wc, int fr, int fq) const {
        const int row0 = u.pm * BM + wr * 64 + fr, col0 = u.pn * BM + wc * 32 + 4 * fq;
        const int vs = u.pm < 32 ? 0 : (u.pm < 64 ? 1 : 2);
        const float* gate = modl + (size_t)vs * 12288 + chunk * 2048 + col0;
        f32x4 gv[2][2];
#pragma unroll
        for (int bj = 0; bj < 2; ++bj)
#pragma unroll
            for (int n = 0; n < 2; ++n) gv[bj][n] = *(const f32x4*)(gate + bj * HALF + n * 16);
#pragma unroll
        for (int ai = 0; ai < 2; ++ai)
#pragma unroll
            for (int m = 0; m < 4; ++m) { float* rowp = X + (size_t)(row0 + ai * HALF + m * 16) * DM + col0;
#pragma unroll
                for (int bj = 0; bj < 2; ++bj)
#pragma unroll
                    for (int n = 0; n < 2; ++n) { float* p = rowp + bj * HALF + n * 16; const f32x4 xo = *(const f32x4*)p; *(f32x4*)p = xo + gv[bj][n] * acc[ai][bj][m][n]; } }
    }
};

template <class Epi, class Sched>
__device__ __forceinline__ void gemm_phase(LAS unsigned char* lds, const Gemm g, const Sched& S, const Epi& E) {
    int tid_l = threadIdx.x; asm volatile("" : "+v"(tid_l));
    const int tid = tid_l, wid = __builtin_amdgcn_readfirstlane(tid >> 6), lane = tid & 63, wr = wid >> 2, wc = wid & 3, fr = lane & 15, fq = lane >> 4;
    const int K = g.K, nt = K / BK, lda = g.lda;
    unsigned voffA[2], voffB[2];
#pragma unroll
    for (int i = 0; i < 2; ++i) { int R, C; stage_rc(tid * 16 + i * 8192, R, C); const int Rb = Epi::PERM ? ((R & ~31) + perm32(R & 31)) : R;
        voffA[i] = (unsigned)(R * lda + C) * 2u; voffB[i] = (unsigned)(Rb * K + C) * 2u; }
    const size_t kstep = (size_t)(BK * 2);
    const size_t hstepA = (size_t)HALF * lda * 2, hstepB = (size_t)HALF * K * 2;
    const size_t tstepA = 2 * hstepA, tstepB = 2 * hstepB;
    const unsigned ldsw = (unsigned)wid * 1024u;
    const int aoff = lds_byte(wr * 64 + fr, fq * 8), boff = lds_byte(wc * 32 + fr, fq * 8);
#define PG8_SA(b, h) (((b) * 2 + (h)) * HTB)
#define PG8_SB(b, h) ((4 + (b) * 2 + (h)) * HTB)
#define PG8_STAGE(bufoff, gbase, voff) do { _Pragma("unroll") for (int _i = 0; _i < 2; ++_i) \
        __builtin_amdgcn_global_load_lds((const unsigned*)((const char*)(gbase) + (voff)[_i]), (LAS unsigned*)(lds + (bufoff) + ldsw + _i * 8192), 16, 0, 0); } while (0)
#define PG8_LDA(dst, b, h) do { _Pragma("unroll") for (int m = 0; m < 4; ++m) _Pragma("unroll") for (int k = 0; k < 2; ++k) dst[m][k] = *(const LAS bf16x8*)(lds + PG8_SA(b, h) + aoff + m * 2048 + k * 1024); } while (0)
#define PG8_LDB(dst, b, h) do { _Pragma("unroll") for (int n = 0; n < 2; ++n) _Pragma("unroll") for (int k = 0; k < 2; ++k) dst[n][k] = *(const LAS bf16x8*)(lds + PG8_SB(b, h) + boff + n * 2048 + k * 1024); } while (0)
#define PG8_MMA(ai, bj, At, Bt) do { __builtin_amdgcn_s_setprio(1); _Pragma("unroll") for (int m = 0; m < 4; ++m) _Pragma("unroll") for (int n = 0; n < 2; ++n) _Pragma("unroll") for (int k = 0; k < 2; ++k) \
        acc[ai][bj][m][n] = __builtin_amdgcn_mfma_f32_16x16x32_bf16(Bt[n][k], At[m][k], acc[ai][bj][m][n], 0, 0, 0); __builtin_amdgcn_s_setprio(0); } while (0)
#define PG8_WAIT_V(n) asm volatile("s_waitcnt vmcnt(" #n ")" ::: "memory")
#define PG8_WAIT_L(n) asm volatile("s_waitcnt lgkmcnt(" #n ")" ::: "memory")
#define PG8_BAR __builtin_amdgcn_s_barrier()
#define PG8_SCHED __builtin_amdgcn_sched_barrier(0)
    Unit cur, nxt; int ui = 0;
    if (!S.next(0, cur)) return;
    f32x4 acc[2][2][4][2];
#pragma unroll
    for (int a = 0; a < 2; ++a)
#pragma unroll
        for (int b = 0; b < 2; ++b)
#pragma unroll
            for (int m = 0; m < 4; ++m)
#pragma unroll
                for (int n = 0; n < 2; ++n) acc[a][b][m][n] = (f32x4){0.f, 0.f, 0.f, 0.f};
    bf16x8 At[4][2], B0[2][2], B1[2][2];
    const char* cA = (const char*)g.A + (size_t)cur.pm * tstepA; const char* cB = (const char*)g.Bt + (size_t)cur.pn * tstepB;
    S.a_ready(cur);
    PG8_STAGE(PG8_SB(0, 0), cB, voffB); PG8_STAGE(PG8_SA(0, 0), cA, voffA); PG8_STAGE(PG8_SB(0, 1), cB + hstepB, voffB); PG8_STAGE(PG8_SA(0, 1), cA + hstepA, voffA);
    if (wr == 1) PG8_BAR;
    PG8_WAIT_V(4); PG8_BAR;
    PG8_STAGE(PG8_SB(1, 0), cB + kstep, voffB); PG8_STAGE(PG8_SA(1, 0), cA + kstep, voffA); PG8_STAGE(PG8_SB(1, 1), cB + hstepB + kstep, voffB);
    PG8_WAIT_V(6); PG8_BAR;
    for (;;) {
        const bool has_next = S.next(ui + 1, nxt);
        const char* nA = has_next ? (const char*)g.A + (size_t)nxt.pm * tstepA : cA; const char* nB = has_next ? (const char*)g.Bt + (size_t)nxt.pn * tstepB : cB;
        for (int t = 0; t < nt; t += 2) {
            const bool last = (t == nt - 2);
            const char* a1 = cA + (size_t)(t + 1) * kstep;
            const char* a2 = last ? nA : cA + (size_t)(t + 2) * kstep; const char* b2 = last ? nB : cB + (size_t)(t + 2) * kstep;
            const char* a3 = a2 + kstep; const char* b3 = b2 + kstep;
            if (last && has_next) S.a_ready(nxt);
            PG8_LDB(B0, 0, 0); PG8_SCHED; PG8_LDA(At, 0, 0); PG8_STAGE(PG8_SA(1, 1), a1 + hstepA, voffA);
            PG8_WAIT_L(8); PG8_BAR; PG8_WAIT_L(0); PG8_MMA(0, 0, At, B0); PG8_BAR; PG8_SCHED;
            PG8_LDB(B1, 0, 1); PG8_STAGE(PG8_SB(0, 0), b2, voffB);
            PG8_BAR; PG8_WAIT_L(0); PG8_MMA(0, 1, At, B1); PG8_BAR;
            PG8_LDA(At, 0, 1); PG8_STAGE(PG8_SA(0, 0), a2, voffA);
            PG8_BAR; PG8_WAIT_L(0); PG8_MMA(1, 0, At, B0); PG8_BAR; PG8_SCHED;
            PG8_STAGE(PG8_SB(0, 1), b2 + hstepB, voffB);
            PG8_WAIT_V(6); PG8_BAR; PG8_MMA(1, 1, At, B1); PG8_BAR;
            PG8_LDB(B0, 1, 0); PG8_SCHED; PG8_LDA(At, 1, 0); PG8_STAGE(PG8_SA(0, 1), a2 + hstepA, voffA);
            PG8_WAIT_L(8); PG8_BAR; PG8_WAIT_L(0); PG8_MMA(0, 0, At, B0); PG8_BAR; PG8_SCHED;
            PG8_LDB(B1, 1, 1); PG8_STAGE(PG8_SB(1, 0), b3, voffB);
            PG8_BAR; PG8_WAIT_L(0); PG8_MMA(0, 1, At, B1); PG8_BAR;
            PG8_LDA(At, 1, 1); PG8_STAGE(PG8_SA(1, 0), a3, voffA);
            PG8_BAR; PG8_WAIT_L(0); PG8_MMA(1, 0, At, B0); PG8_BAR; PG8_SCHED;
            PG8_STAGE(PG8_SB(1, 1), b3 + hstepB, voffB);
            PG8_WAIT_V(6); PG8_BAR; PG8_MMA(1, 1, At, B1); PG8_BAR;
        }
        E(acc, cur, wr, wc, fr, fq); S.done(cur);
        if (!has_next) break;
#pragma unroll
        for (int a = 0; a < 2; ++a)
#pragma unroll
            for (int b = 0; b < 2; ++b)
#pragma unroll
                for (int m = 0; m < 4; ++m)
#pragma unroll
                    for (int n = 0; n < 2; ++n) acc[a][b][m][n] = (f32x4){0.f, 0.f, 0.f, 0.f};
        cur = nxt; cA = nA; cB = nB; ++ui;
    }
    PG8_WAIT_V(0);
    if (wr == 0) PG8_BAR;
    PG8_BAR;
#undef PG8_SA
#undef PG8_SB
#undef PG8_STAGE
#undef PG8_LDA
#undef PG8_LDB
#undef PG8_MMA
#undef PG8_WAIT_V
#undef PG8_WAIT_L
#undef PG8_BAR
#undef PG8_SCHED
}
}

namespace att {
constexpr int NW = 8, QBLK = 32, KVBLK = 64, DV = 128;
constexpr float THR = 8.f;
constexpr int SHM_V = KVBLK * DV * 2;
#define SBAR() __builtin_amdgcn_sched_barrier(0)
__device__ __forceinline__ int crow(int r, int hi) { return (r & 3) + 8 * (r >> 2) + 4 * hi; }
__device__ __forceinline__ unsigned cvtpk(float lo, float hi) { unsigned r; asm volatile("v_cvt_pk_bf16_f32 %0, %1, %2" : "=v"(r) : "v"(lo), "v"(hi)); return r; }
__device__ __forceinline__ void partialSM(f32x16& p0, f32x16& p1, float& m_reg, float& mn, float& alpha, const float C, const float thr_raw) {
    float pmax = p0[0];
#pragma unroll
    for (int r = 1; r < 16; ++r) pmax = fmaxf(pmax, p0[r]);
#pragma unroll
    for (int r = 0; r < 16; ++r) pmax = fmaxf(pmax, p1[r]);
    { auto rr = __builtin_amdgcn_permlane32_swap(__float_as_uint(pmax), __float_as_uint(pmax), false, false);
      pmax = fmaxf(__uint_as_float(rr[0]), __uint_as_float(rr[1])); }
    if (__builtin_expect(__all(pmax - m_reg <= thr_raw), 1)) { mn = m_reg; alpha = 1.f; }
    else { mn = fmaxf(m_reg, pmax); alpha = __builtin_amdgcn_exp2f((m_reg - mn) * C); m_reg = mn; }
    const float mnC = -mn * C;
#pragma unroll
    for (int r = 0; r < 16; ++r) p0[r] = fmaf(p0[r], C, mnC);
#pragma unroll
    for (int r = 0; r < 16; ++r) p1[r] = fmaf(p1[r], C, mnC);
#pragma unroll
    for (int r = 0; r < 16; ++r) p0[r] = __builtin_amdgcn_exp2f(p0[r]);
}
__device__ __forceinline__ void finishSM(f32x16& p0, f32x16& p1, float alpha, float& l_reg, bf16x8& pa0, bf16x8& pa1, bf16x8& pa2, bf16x8& pa3) {
#pragma unroll
    for (int r = 0; r < 16; ++r) p1[r] = __builtin_amdgcn_exp2f(p1[r]);
    float ps = 0;
#pragma unroll
    for (int r = 0; r < 16; ++r) ps += p0[r];
#pragma unroll
    for (int r = 0; r < 16; ++r) ps += p1[r];
    { auto rr = __builtin_amdgcn_permlane32_swap(__float_as_uint(ps), __float_as_uint(ps), false, false);
      ps = __uint_as_float(rr[0]) + __uint_as_float(rr[1]); }
    l_reg = l_reg * alpha + ps;
#define PK4(P, BASE, OUT) do { unsigned a0 = cvtpk(P[BASE + 0], P[BASE + 1]), a1 = cvtpk(P[BASE + 2], P[BASE + 3]);   \
    unsigned b0 = cvtpk(P[BASE + 4], P[BASE + 5]), b1 = cvtpk(P[BASE + 6], P[BASE + 7]);                              \
    auto r0 = __builtin_amdgcn_permlane32_swap(a0, b0, false, false); auto r1 = __builtin_amdgcn_permlane32_swap(a1, b1, false, false); \
    u32x4 w = {r0[0], r1[0], r0[1], r1[1]}; OUT = *reinterpret_cast<bf16x8*>(&w); } while (0)
    PK4(p0, 0, pa0); PK4(p0, 8, pa1); PK4(p1, 0, pa2); PK4(p1, 8, pa3);
#undef PK4
}
template <int DQK>
__device__ __forceinline__ void qkt(f32x16& p0, f32x16& p1, const char* Ks, const bf16x8 (&qr)[DQK / 16], int r32, int hi) {
    constexpr int RS = DQK * 2;
    p0 = f32x16{}; p1 = f32x16{};
#pragma unroll
    for (int d0 = 0; d0 < DQK / 16; ++d0) { const int cb = (d0 * 16 + hi * 8) * 2;
        const bf16x8 b0 = *reinterpret_cast<const bf16x8*>(Ks + r32 * RS + (cb ^ ((r32 & 7) << 4)));
        const bf16x8 b1 = *reinterpret_cast<const bf16x8*>(Ks + (32 + r32) * RS + (cb ^ ((r32 & 7) << 4)));
        p0 = __builtin_amdgcn_mfma_f32_32x32x16_bf16(b0, qr[d0], p0, 0, 0, 0);
        p1 = __builtin_amdgcn_mfma_f32_32x32x16_bf16(b1, qr[d0], p1, 0, 0, 0); }
}
__device__ __forceinline__ int v_st(int k, int c) { const int kk = (k & ~0xC) | ((k & 4) << 1) | ((k & 8) >> 1); return ((kk >> 3) * 4 + (c >> 5)) * 512 + ((kk & 7) * 32 + (c & 31)) * 2; }
__device__ __forceinline__ int v_rd_base(int lane) { return ((lane & 3) << 3) | (((lane >> 2) & 3) << 6) | (((lane >> 4) & 1) << 5) | (((lane >> 5) & 1) << 8); }
constexpr int v_rd_off(int d0, int ks, int half) { return d0 * 512 + ks * 4096 + half * 2048; }
template <int OFF> __device__ __forceinline__ s16x4 tr_read(int vb) {
    s16x4 r; asm volatile("ds_read_b64_tr_b16 %0, %1 offset:%2" : "=&v"(r) : "v"(vb), "i"(OFF) : "memory"); return r;
}
template <int D0> __device__ __forceinline__ void pv_one(f32x16& od, int vb, bf16x8 pa0, bf16x8 pa1, bf16x8 pa2, bf16x8 pa3) {
    const s16x4 l0 = tr_read<v_rd_off(D0, 0, 0)>(vb), h0 = tr_read<v_rd_off(D0, 0, 1)>(vb), l1 = tr_read<v_rd_off(D0, 1, 0)>(vb), h1 = tr_read<v_rd_off(D0, 1, 1)>(vb);
    const s16x4 l2 = tr_read<v_rd_off(D0, 2, 0)>(vb), h2 = tr_read<v_rd_off(D0, 2, 1)>(vb), l3 = tr_read<v_rd_off(D0, 3, 0)>(vb), h3 = tr_read<v_rd_off(D0, 3, 1)>(vb);
    asm volatile("s_waitcnt lgkmcnt(0)" ::: "memory"); SBAR();
#define PK(L, H) (bf16x8){L[0], L[1], L[2], L[3], H[0], H[1], H[2], H[3]}
    od = __builtin_amdgcn_mfma_f32_32x32x16_bf16(pa0, PK(l0, h0), od, 0, 0, 0);
    od = __builtin_amdgcn_mfma_f32_32x32x16_bf16(pa1, PK(l1, h1), od, 0, 0, 0);
    od = __builtin_amdgcn_mfma_f32_32x32x16_bf16(pa2, PK(l2, h2), od, 0, 0, 0);
    od = __builtin_amdgcn_mfma_f32_32x32x16_bf16(pa3, PK(l3, h3), od, 0, 0, 0);
#undef PK
}
__device__ __forceinline__ void pv_d0(f32x16* o, int vb, bf16x8 pa0, bf16x8 pa1, bf16x8 pa2, bf16x8 pa3) {
    pv_one<0>(o[0], vb, pa0, pa1, pa2, pa3); pv_one<1>(o[1], vb, pa0, pa1, pa2, pa3); pv_one<2>(o[2], vb, pa0, pa1, pa2, pa3); pv_one<3>(o[3], vb, pa0, pa1, pa2, pa3);
}
template <int DQK> struct ScaleOf { static constexpr float scale = DQK == 192 ? 0.07216878364870322f : (DQK == 128 ? 0.08838834764831845f : 0.125f); };
template <int DQK, int SDEPTH, int ldq, int ldk, int ldv, int ldo>
__device__ __forceinline__ void attn_body(const bf16_t* __restrict__ Qb, const bf16_t* __restrict__ Kh, const bf16_t* __restrict__ Vh,
                                          float* __restrict__ Ob, int seq, char* lds) {
    constexpr float C = ScaleOf<DQK>::scale * 1.4426950408889634f, thr_raw = THR / ScaleOf<DQK>::scale;
    constexpr int SHM_K = KVBLK * DQK * 2, RS = DQK * 2, NKP = DQK / 64, KPR = DQK / 8;
    int tid_l = threadIdx.x; asm volatile("" : "+v"(tid_l));
    const int tid = tid_l, wid = tid >> 6, lane = tid & 63, r32 = lane & 31, hi = lane >> 5;
    char* V_lds = lds; char* K_lds = lds + 2 * SHM_V;
    float* ws = (float*)(lds + 2 * SHM_V + 2 * SHM_K) + wid * 64; float* li_l = ws; float* al_l = ws + 32;
    float m_reg = -1e30f, l_reg = 0; f32x16 o[4] = {}; bf16x8 qr[DQK / 16];
    const bf16_t* Qw = Qb + (size_t)(wid * QBLK + r32) * ldq + hi * 8;
#pragma unroll
    for (int d0 = 0; d0 < DQK / 16; ++d0) qr[d0] = *reinterpret_cast<const bf16x8*>(Qw + d0 * 16);
    const int sr = tid >> 4, sc = (tid & 15) * 8, vst0 = v_st(sr, sc), vst1 = v_st(32 + sr, sc);
    int koff[NKP], klds[NKP];
#pragma unroll
    for (int i = 0; i < NKP; ++i) { const int p = tid + i * 512, row = p / KPR, c8 = p % KPR; koff[i] = row * ldk + c8 * 8; klds[i] = row * RS + ((c8 * 16) ^ ((row & 7) << 4)); }
    const int vb0 = (int)(uintptr_t)V_lds + v_rd_base(lane);
    bf16x8 sv0[SDEPTH], sv1[SDEPTH], sk[SDEPTH][NKP];
#define SLOAD(i, k0) do { sv0[i] = *reinterpret_cast<const bf16x8*>(&Vh[(size_t)((k0) + sr) * ldv + sc]); sv1[i] = *reinterpret_cast<const bf16x8*>(&Vh[(size_t)((k0) + 32 + sr) * ldv + sc]); \
    _Pragma("unroll") for (int _q = 0; _q < NKP; ++_q) sk[i][_q] = *reinterpret_cast<const bf16x8*>(&Kh[(size_t)(k0) * ldk + koff[_q]]); } while (0)
#define SWRITE(b, i) do { *(bf16x8*)(V_lds + (b) * SHM_V + vst0) = sv0[i]; *(bf16x8*)(V_lds + (b) * SHM_V + vst1) = sv1[i]; \
    _Pragma("unroll") for (int _q = 0; _q < NKP; ++_q) *(bf16x8*)(K_lds + (b) * SHM_K + klds[_q]) = sk[i][_q]; } while (0)
#define SWAIT() do { if constexpr (SDEPTH == 2) { if constexpr (NKP == 1) asm volatile("s_waitcnt vmcnt(3)" ::: "memory"); else if constexpr (NKP == 2) asm volatile("s_waitcnt vmcnt(4)" ::: "memory"); else asm volatile("s_waitcnt vmcnt(5)" ::: "memory"); } \
    else asm volatile("s_waitcnt vmcnt(0)" ::: "memory"); } while (0)
#define RESC(a) do { if (__any((a) < 1.f)) { if (hi == 0) al_l[r32] = (a); asm volatile("s_waitcnt lgkmcnt(0)" ::: "memory"); \
    _Pragma("unroll") for (int d = 0; d < 4; ++d) _Pragma("unroll") for (int r = 0; r < 16; ++r) o[d][r] *= al_l[crow(r, hi)]; } } while (0)
    f32x16 pA0, pA1, pB0, pB1; float mnA, mnB, alA, alB; bf16x8 pa0, pa1, pa2, pa3; const int NT = seq / KVBLK;
    constexpr int SE = 0, SO = SDEPTH - 1;
    SLOAD(SE, 0); asm volatile("s_waitcnt vmcnt(0)" ::: "memory"); SWRITE(0, SE); __syncthreads();
    qkt<DQK>(pA0, pA1, K_lds, qr, r32, hi); partialSM(pA0, pA1, m_reg, mnA, alA, C, thr_raw);
    SLOAD(SO, KVBLK); if constexpr (SDEPTH == 2) { if (2 < NT) SLOAD(SE, 2 * KVBLK); }
    SWAIT(); SWRITE(1, SO); __syncthreads();
    for (int j = 1; j + 1 < NT; j += 2) {
        SBAR(); qkt<DQK>(pB0, pB1, K_lds + SHM_K, qr, r32, hi);
        finishSM(pA0, pA1, alA, l_reg, pa0, pa1, pa2, pa3); SBAR();
        SLOAD(SO, (j + SDEPTH) * KVBLK); SBAR();
        pv_d0(o, vb0, pa0, pa1, pa2, pa3); partialSM(pB0, pB1, m_reg, mnB, alB, C, thr_raw);
        __syncthreads(); SWAIT(); SWRITE(0, SE);
        RESC(alB); __syncthreads();
        SBAR(); qkt<DQK>(pA0, pA1, K_lds, qr, r32, hi);
        finishSM(pB0, pB1, alB, l_reg, pa0, pa1, pa2, pa3); SBAR();
        if (SDEPTH == 1 || j + 3 < NT) SLOAD(SE, (j + 1 + SDEPTH) * KVBLK); SBAR();
        pv_d0(o, vb0 + SHM_V, pa0, pa1, pa2, pa3); partialSM(pA0, pA1, m_reg, mnA, alA, C, thr_raw);
        __syncthreads(); SWAIT(); SWRITE(1, SO);
        RESC(alA); __syncthreads();
    }
    SBAR(); qkt<DQK>(pB0, pB1, K_lds + SHM_K, qr, r32, hi);
    finishSM(pA0, pA1, alA, l_reg, pa0, pa1, pa2, pa3); SBAR();
    pv_d0(o, vb0, pa0, pa1, pa2, pa3); partialSM(pB0, pB1, m_reg, mnB, alB, C, thr_raw);
    __syncthreads(); RESC(alB);
    finishSM(pB0, pB1, alB, l_reg, pa0, pa1, pa2, pa3); SBAR();
    pv_d0(o, vb0 + SHM_V, pa0, pa1, pa2, pa3);
    if (hi == 0) li_l[r32] = l_reg; asm volatile("s_waitcnt lgkmcnt(0)" ::: "memory");
    float rli[16];
#pragma unroll
    for (int r = 0; r < 16; ++r) rli[r] = __builtin_amdgcn_rcpf(li_l[crow(r, hi)]);
    float* Ow = Ob + (size_t)(wid * QBLK) * ldo;
#pragma unroll
    for (int r = 0; r < 16; ++r) { const int orow = crow(r, hi);
#pragma unroll
        for (int d0 = 0; d0 < 4; ++d0) Ow[(size_t)orow * ldo + d0 * 32 + r32] = o[d0][r] * rli[r]; }
    __syncthreads();
#undef SLOAD
#undef SWRITE
#undef SWAIT
#undef RESC
}
template <int DQK, int QL, int ldq, int ldk, int ldv, int ldo>
__device__ __forceinline__ void attn_body_simple(const bf16_t* __restrict__ Qb, const bf16_t* __restrict__ Kh, const bf16_t* __restrict__ Vh,
                                                 float* __restrict__ Ob, int seq, char* lds) {
    constexpr float C = ScaleOf<DQK>::scale * 1.4426950408889634f, thr_raw = THR / ScaleOf<DQK>::scale;
    constexpr int SHM_K = KVBLK * DQK * 2, RS = DQK * 2, NKP = DQK / 64, KPR = DQK / 8;
    int tid_l = threadIdx.x; asm volatile("" : "+v"(tid_l));
    const int tid = tid_l, wid = tid >> 6, lane = tid & 63, r32 = lane & 31, hi = lane >> 5;
    char* V_lds = lds; char* K_lds = lds + 2 * SHM_V;
    float* ws = (float*)(lds + 2 * SHM_V + 2 * SHM_K) + wid * 64; float* li_l = ws; float* al_l = ws + 32;
    constexpr int NQR = DQK / 16 - QL;
    char* qpark = lds + 2 * SHM_V + 2 * SHM_K + 2048 + wid * (QL * 1024) + lane * 16;
    float m_reg = -1e30f, l_reg = 0; f32x16 o[4] = {}; bf16x8 qr[NQR];
    const bf16_t* Qw = Qb + (size_t)(wid * QBLK + r32) * ldq + hi * 8;
#pragma unroll
    for (int d0 = 0; d0 < NQR; ++d0) qr[d0] = *reinterpret_cast<const bf16x8*>(Qw + d0 * 16);
#pragma unroll
    for (int d0 = 0; d0 < QL; ++d0) *(bf16x8*)(qpark + d0 * 1024) = *reinterpret_cast<const bf16x8*>(Qw + (NQR + d0) * 16);
    const int sr = tid >> 4, sc = (tid & 15) * 8, vst0 = v_st(sr, sc), vst1 = v_st(32 + sr, sc);
    int koff[NKP], klds[NKP];
#pragma unroll
    for (int i = 0; i < NKP; ++i) { const int p = tid + i * 512, row = p / KPR, c8 = p % KPR; koff[i] = row * ldk + c8 * 8; klds[i] = row * RS + ((c8 * 16) ^ ((row & 7) << 4)); }
    const int vb0 = (int)(uintptr_t)V_lds + v_rd_base(lane);
    bf16x8 sv0, sv1, sk[NKP];
#define SLOAD(k0) do { sv0 = *reinterpret_cast<const bf16x8*>(&Vh[(size_t)((k0) + sr) * ldv + sc]); sv1 = *reinterpret_cast<const bf16x8*>(&Vh[(size_t)((k0) + 32 + sr) * ldv + sc]); \
    _Pragma("unroll") for (int _q = 0; _q < NKP; ++_q) sk[_q] = *reinterpret_cast<const bf16x8*>(&Kh[(size_t)(k0) * ldk + koff[_q]]); } while (0)
#define SWRITE(b) do { *(bf16x8*)(V_lds + (b) * SHM_V + vst0) = sv0; *(bf16x8*)(V_lds + (b) * SHM_V + vst1) = sv1; \
    _Pragma("unroll") for (int _q = 0; _q < NKP; ++_q) *(bf16x8*)(K_lds + (b) * SHM_K + klds[_q]) = sk[_q]; } while (0)
#define RESC(a) do { if (__any((a) < 1.f)) { if (hi == 0) al_l[r32] = (a); asm volatile("s_waitcnt lgkmcnt(0)" ::: "memory"); \
    _Pragma("unroll") for (int d = 0; d < 4; ++d) _Pragma("unroll") for (int r = 0; r < 16; ++r) o[d][r] *= al_l[crow(r, hi)]; } } while (0)
    const int NT = seq / KVBLK;
    SLOAD(0); asm volatile("s_waitcnt vmcnt(0)" ::: "memory"); SWRITE(0); __syncthreads();
    for (int j = 0; j < NT; ++j) {
        const int b = j & 1;
        if (j + 1 < NT) SLOAD((j + 1) * KVBLK);
        SBAR();
        f32x16 p0, p1; float mn, al; bf16x8 pa0, pa1, pa2, pa3;
        { const char* Ks = K_lds + b * SHM_K; p0 = f32x16{}; p1 = f32x16{};
#pragma unroll
          for (int d0 = 0; d0 < DQK / 16; ++d0) { const int cb = (d0 * 16 + hi * 8) * 2;
              const bf16x8 b0 = *reinterpret_cast<const bf16x8*>(Ks + r32 * RS + (cb ^ ((r32 & 7) << 4)));
              const bf16x8 b1 = *reinterpret_cast<const bf16x8*>(Ks + (32 + r32) * RS + (cb ^ ((r32 & 7) << 4)));
              bf16x8 qf; if (d0 < NQR) qf = qr[d0 < NQR ? d0 : 0]; else qf = *(const bf16x8*)(qpark + (d0 - NQR) * 1024);
              p0 = __builtin_amdgcn_mfma_f32_32x32x16_bf16(b0, qf, p0, 0, 0, 0);
              p1 = __builtin_amdgcn_mfma_f32_32x32x16_bf16(b1, qf, p1, 0, 0, 0); } }
        partialSM(p0, p1, m_reg, mn, al, C, thr_raw);
        RESC(al);
        finishSM(p0, p1, al, l_reg, pa0, pa1, pa2, pa3); SBAR();
        pv_d0(o, vb0 + b * SHM_V, pa0, pa1, pa2, pa3);
        if (j + 1 < NT) { asm volatile("s_waitcnt vmcnt(0)" ::: "memory"); SWRITE(b ^ 1); }
        __syncthreads();
    }
    if (hi == 0) li_l[r32] = l_reg; asm volatile("s_waitcnt lgkmcnt(0)" ::: "memory");
    float rli[16];
#pragma unroll
    for (int r = 0; r < 16; ++r) rli[r] = __builtin_amdgcn_rcpf(li_l[crow(r, hi)]);
    float* Ow = Ob + (size_t)(wid * QBLK) * ldo;
#pragma unroll
    for (int r = 0; r < 16; ++r) { const int orow = crow(r, hi);
#pragma unroll
        for (int d0 = 0; d0 < 4; ++d0) Ow[(size_t)orow * ldo + d0 * 32 + r32] = o[d0][r] * rli[r]; }
    __syncthreads();
#undef SLOAD
#undef SWRITE
#undef RESC
}
}

struct Params {
    const float* x; const float* c; const float* ctx; const float* c_ctx; const float* w_mod; const float* b_mod; const float* g_norm1; const float* g_norm2;
    const float* w_in_ab; const float* g_cq; const float* w_uq; const float* g_ckv; const float* w_ukv; const float* g_qn_a; const float* g_kn_a; const float* lam_vec;
    const float* g_qn_b; const float* g_kn_b; const float* g_sub_b; const float* w_out_ab; const float* w_in_c; const float* g_qn_c; const float* g_kn_c; const float* w_out_c;
    const float* w_pq; const float* sub_keys; const float* expert_u; const float* expert_v;
    float* out; unsigned char* ws; int ph_lo, ph_hi;
};

typedef const __attribute__((address_space(4))) Params CParams;
struct Ctx {
    int tid, lane, wid, G, vcu, bx;
    unsigned char* ws; char* lds;
};

__device__ __forceinline__ void tconv(const Ctx& F, const float* src, bf16_t* dst, const float* gain, int nmat, int K, int N, int Npad) {
    float* tile = (float*)(F.lds + 32768);
    const int ntn = Npad / 64, ntk = K / 64, per = ntn * ntk, total = per * nmat;
    for (int it = F.vcu; it < total; it += F.G) {
        const int mat = it / per, rem = it % per, tn = rem / ntk, tk = rem % ntk, k0 = tk * 64, n0 = tn * 64;
        const float* s = src + (size_t)mat * K * N; bf16_t* d = dst + (size_t)mat * Npad * K;
        __syncthreads();
        { const int r = F.tid >> 4, c4 = (F.tid & 15) * 4;
#pragma unroll
          for (int i = 0; i < 2; ++i) { const int rr = r + i * 32; f32x4 v = (f32x4){0.f, 0.f, 0.f, 0.f};
              if (n0 + c4 < N) v = *(const f32x4*)(s + (size_t)(k0 + rr) * N + n0 + c4);
              tile[rr * 65 + c4 + 0] = v[0]; tile[rr * 65 + c4 + 1] = v[1]; tile[rr * 65 + c4 + 2] = v[2]; tile[rr * 65 + c4 + 3] = v[3]; } }
        __syncthreads();
        { const int n = F.tid >> 3, kc = (F.tid & 7) * 8; float v[8];
#pragma unroll
          for (int e = 0; e < 8; ++e) { v[e] = tile[(kc + e) * 65 + n]; if (gain) v[e] *= gain[(size_t)mat * K + k0 + kc + e]; }
          u32x4 w; w.x = cvt_pk_bf16(v[0], v[1]); w.y = cvt_pk_bf16(v[2], v[3]); w.z = cvt_pk_bf16(v[4], v[5]); w.w = cvt_pk_bf16(v[6], v[7]);
          *(u32x4*)(d + (size_t)(n0 + n) * K + k0 + kc) = w; }
    }
}
__device__ __forceinline__ void cvt_flat(const Ctx& F, const float* src, bf16_t* dst, size_t n8) {
    for (size_t i = (size_t)F.vcu * 512 + F.tid; i < n8; i += (size_t)F.G * 512) {
        const f32x4 a = *(const f32x4*)(src + i * 8), b = *(const f32x4*)(src + i * 8 + 4);
        u32x4 w; w.x = cvt_pk_bf16(a[0], a[1]); w.y = cvt_pk_bf16(a[2], a[3]); w.z = cvt_pk_bf16(b[0], b[1]); w.w = cvt_pk_bf16(b[2], b[3]);
        *(u32x4*)(dst + i * 8) = w;
    }
}
__device__ __forceinline__ float silu_f(float v) { return v / (1.f + __expf(-v)); }

__device__ __forceinline__ void prologue_phase(const Ctx& F, CParams& P) {
    unsigned char* ws = F.ws;
    {
        float* sv = (float*)F.lds;
        float* part = (float*)(F.lds + 24576);
        for (int i = F.tid; i < 3 * DM; i += 512) { const int v = i / DM, k = i % DM; const float cv = v < 2 ? P.c[v * DM + k] : P.c_ctx[k]; sv[i] = silu_f(cv); }
        __syncthreads();
        float* mod = (float*)(ws + WS_MOD);
        for (int it = F.vcu; it < DEPTH * 192; it += F.G) {
            const int l = it / 192, n0 = (it % 192) * 64;
            const float* wp = P.w_mod + ((size_t)l * DM + F.wid * 256) * 12288 + n0 + F.lane;
            float a0 = 0.f, a1 = 0.f, a2 = 0.f;
#pragma unroll 8
            for (int k = 0; k < 256; ++k) { const float w = wp[(size_t)k * 12288]; const int kk = F.wid * 256 + k; a0 += sv[kk] * w; a1 += sv[DM + kk] * w; a2 += sv[2 * DM + kk] * w; }
            part[(F.wid * 3 + 0) * 64 + F.lane] = a0; part[(F.wid * 3 + 1) * 64 + F.lane] = a1; part[(F.wid * 3 + 2) * 64 + F.lane] = a2;
            __syncthreads();
            if (F.wid < 3) { float s = 0.f;
#pragma unroll
                for (int w = 0; w < 8; ++w) s += part[(w * 3 + F.wid) * 64 + F.lane];
                mod[((size_t)l * 3 + F.wid) * 12288 + n0 + F.lane] = s + P.b_mod[(size_t)l * 12288 + n0 + F.lane]; }
            __syncthreads();
        }
    }
    if (F.vcu == 0) {
        float* t16 = (float*)(ws + WS_TAB16); float* t32 = (float*)(ws + WS_TAB32);
        for (int i = F.tid; i < 128 * 16; i += 512) { const int pos = i >> 4, f = i & 15; const float fr = powf(10000.f, -(float)f / 16.f); const float a = (float)pos * fr; float s, c; sincosf(a, &s, &c); t16[i * 2] = c; t16[i * 2 + 1] = s; }
        for (int i = F.tid; i < 128 * 32; i += 512) { const int pos = i >> 5, f = i & 31; const float fr = powf(10000.f, -(float)f / 32.f); const float a = (float)pos * fr; float s, c; sincosf(a, &s, &c); t32[i * 2] = c; t32[i * 2 + 1] = s; }
        if (F.wid < 2) { const float* lv = P.lam_vec + F.wid * 256; const float d1 = wave_sum(lv[F.lane] * lv[64 + F.lane]), d2 = wave_sum(lv[128 + F.lane] * lv[192 + F.lane]);
            const float lam_init = 0.8f - 0.6f * expf(-0.3f * (float)(2 * F.wid));
            if (F.lane == 0) ((float*)(ws + WS_LAM))[F.wid] = expf(d1) - expf(d2) + lam_init; }
    }
    tconv(F, P.w_in_ab, (bf16_t*)(ws + WS_WINAB), nullptr, 2, DM, AB_IN, AB_INP);
    tconv(F, P.w_uq, (bf16_t*)(ws + WS_WUQ), P.g_cq, 2, 768, 1536, 1536);
    tconv(F, P.w_ukv, (bf16_t*)(ws + WS_WUKV), P.g_ckv, 2, 512, 2048, 2048);
    tconv(F, P.w_out_ab, (bf16_t*)(ws + WS_WOUTAB), nullptr, 2, DM, DM, DM);
    tconv(F, P.w_in_c, (bf16_t*)(ws + WS_WINC), nullptr, 2, DM, C_IN, C_IN);
    tconv(F, P.w_out_c, (bf16_t*)(ws + WS_WOUTC), nullptr, 2, DM, DM, DM);
    tconv(F, P.w_pq, (bf16_t*)(ws + WS_WPQ), nullptr, 4, DM, DM, DM);
    cvt_flat(F, P.sub_keys, (bf16_t*)(ws + WS_SUBK), (size_t)4 * 8 * 2 * 128 * 128 / 8);
    cvt_flat(F, P.expert_u, (bf16_t*)(ws + WS_EU), (size_t)4 * NEXP * DM / 8);
    cvt_flat(F, P.expert_v, (bf16_t*)(ws + WS_EV), (size_t)4 * NEXP * DM / 8);
}

__device__ __forceinline__ void norm_phase(const Ctx& F, CParams& P, int layer, int which  , int m_rows) {
    float* X = (float*)(F.ws + WS_X); bf16_t* H = (bf16_t*)(F.ws + WS_H);
    const float* mod = (const float*)(F.ws + WS_MOD) + (size_t)layer * 3 * 12288;
    const float* gn = (which ? P.g_norm2 : P.g_norm1) + (size_t)layer * DM;
    const bool from_in = (layer == 0 && which == 0);
    for (int t = F.vcu * 8 + F.wid; t < m_rows; t += F.G * 8) {
        const int vs = vsel_of_row(t);
        const float* src = from_in ? (t < TL ? P.x + (size_t)t * DM : P.ctx + (size_t)(t - TL) * DM) : X + (size_t)t * DM;
        const float* shf = mod + (size_t)vs * 12288 + (which ? 3 : 0) * DM; const float* scl = shf + DM;
        f32x4 v[8]; float ss = 0.f;
#pragma unroll
        for (int j = 0; j < 8; ++j) { v[j] = *(const f32x4*)(src + j * 256 + F.lane * 4); ss += v[j][0] * v[j][0] + v[j][1] * v[j][1] + v[j][2] * v[j][2] + v[j][3] * v[j][3]; }
        ss = wave_sum(ss);
        const float rstd = rsqrtf(ss * (1.f / DM) + EPS);
#pragma unroll
        for (int j = 0; j < 8; ++j) { const int c = j * 256 + F.lane * 4;
            if (from_in) *(f32x4*)(X + (size_t)t * DM + c) = v[j];
            const f32x4 g = *(const f32x4*)(gn + c), sc = *(const f32x4*)(scl + c), sh = *(const f32x4*)(shf + c);
            f32x4 y;
#pragma unroll
            for (int e = 0; e < 4; ++e) y[e] = (v[j][e] * rstd * g[e]) * (1.f + sc[e]) + sh[e];
            u32x2 w; w.x = cvt_pk_bf16(y[0], y[1]); w.y = cvt_pk_bf16(y[2], y[3]);
            *(u32x2*)(H + (size_t)t * DM + c) = w; }
    }
}

__device__ __forceinline__ void rope16(float& x0, float& x1, int l2, int row, int col, const float* t16) {
    const int o = 2 * l2, seg = o >> 5, i = o & 31, f = i & 15, pos = seg ? col : row; const bool first = i < 16;
    const float p0 = __shfl_xor(x0, 8), p1 = __shfl_xor(x1, 8);
    const f32x4 cs = *(const f32x4*)(t16 + (pos * 16 + f) * 2);
    if (first) { x0 = x0 * cs[0] - p0 * cs[1]; x1 = x1 * cs[2] - p1 * cs[3]; }
    else       { x0 = p0 * cs[1] + x0 * cs[0]; x1 = p1 * cs[3] + x1 * cs[2]; }
}
__device__ __forceinline__ void rope32(float& x0, float& x1, int l2, int pos, const float* t32) {
    const int i = 2 * l2, f = i & 31; const bool first = i < 32;
    const float p0 = __shfl_xor(x0, 16), p1 = __shfl_xor(x1, 16);
    const f32x4 cs = *(const f32x4*)(t32 + (pos * 32 + f) * 2);
    if (first) { x0 = x0 * cs[0] - p0 * cs[1]; x1 = x1 * cs[2] - p1 * cs[3]; }
    else       { x0 = p0 * cs[1] + x0 * cs[0]; x1 = p1 * cs[3] + x1 * cs[2]; }
}
__device__ __forceinline__ void ldpair(const bf16_t* p, float& a, float& b) { const unsigned w = *(const unsigned*)p; a = bf_lo(w); b = bf_hi(w); }
__device__ __forceinline__ void stpair(bf16_t* p, float a, float b) { *(unsigned*)p = cvt_pk_bf16(a, b); }

__device__ __forceinline__ void qkv_even_phase(const Ctx& F, CParams& P, int e) {
    const bf16_t* P1 = (const bf16_t*)(F.ws + WS_P1); const bf16_t* QA = (const bf16_t*)(F.ws + WS_QA); const bf16_t* KV = (const bf16_t*)(F.ws + WS_KV);
    bf16_t* Qm = (bf16_t*)(F.ws + WS_Q1); bf16_t* Km = (bf16_t*)(F.ws + WS_K1); bf16_t* Vm = (bf16_t*)(F.ws + WS_V1);
    bf16_t* Qd = (bf16_t*)(F.ws + WS_Q2); bf16_t* Kd = (bf16_t*)(F.ws + WS_K2); bf16_t* Vd = (bf16_t*)(F.ws + WS_V2);
    const float* t16 = (const float*)(F.ws + WS_TAB16);
    const float* gqa = P.g_qn_a + e * 192; const float* gka = P.g_kn_a + e * 192; const float* gqb = P.g_qn_b + e * 64; const float* gkb = P.g_kn_b + e * 64;
    const int l2 = F.lane & 31, hw = F.lane >> 5;
    for (int t = F.vcu * 8 + F.wid; t < TT; t += F.G * 8) {
        const bool latent = t < TL; const int s = t & (SEQ - 1), row = s >> 6, col = s & 63; const int kr = krow_of(t);
        const bf16_t* p1 = P1 + (size_t)t * AB_INP;
        float ss = 0.f;
#pragma unroll
        for (int j = 0; j < 3; ++j) { const u32x2 w = *(const u32x2*)(p1 + j * 256 + F.lane * 4); const float a = bf_lo(w.x), b = bf_hi(w.x), c = bf_lo(w.y), d = bf_hi(w.y); ss += a * a + b * b + c * c + d * d; }
        ss = wave_sum(ss); const float rstd_q = rsqrtf(ss * (1.f / 768.f) + EPS);
        float s2 = 0.f;
        { const u32x4 w = *(const u32x4*)(p1 + 768 + F.lane * 8);
#pragma unroll
          for (int q = 0; q < 4; ++q) { const float a = bf_lo(w[q]), b = bf_hi(w[q]); s2 += a * a + b * b; } }
        s2 = wave_sum(s2); const float rstd_kv = rsqrtf(s2 * (1.f / 512.f) + EPS);
#pragma unroll 1
        for (int it = 0; it < 4; ++it) { const int h = it * 2 + hw; const bf16_t* src = QA + (size_t)t * 1536 + h * 192 + 2 * l2;
            float x[3][2]; float sq = 0.f;
#pragma unroll
            for (int c = 0; c < 3; ++c) { ldpair(src + c * 64, x[c][0], x[c][1]); x[c][0] *= rstd_q; x[c][1] *= rstd_q; sq += x[c][0] * x[c][0] + x[c][1] * x[c][1]; }
            sq = hw_sum(sq); const float r = rsqrtf(sq * (1.f / 192.f) + EPS);
#pragma unroll
            for (int c = 0; c < 3; ++c) { x[c][0] *= r * gqa[c * 64 + 2 * l2]; x[c][1] *= r * gqa[c * 64 + 2 * l2 + 1]; }
            if (latent) rope16(x[2][0], x[2][1], l2, row, col, t16);
            bf16_t* dst = Qm + ((size_t)t * 8 + h) * 192 + 2 * l2;
#pragma unroll
            for (int c = 0; c < 3; ++c) stpair(dst + c * 64, x[c][0], x[c][1]); }
#pragma unroll 1
        for (int it = 0; it < 4; ++it) { const int h = it * 2 + hw; const bf16_t* src = KV + (size_t)t * 2048 + h * 256 + 2 * l2;
            float x[3][2]; float sq = 0.f;
#pragma unroll
            for (int c = 0; c < 2; ++c) { ldpair(src + c * 64, x[c][0], x[c][1]); x[c][0] *= rstd_kv; x[c][1] *= rstd_kv; }
            ldpair(p1 + 1280 + 2 * l2, x[2][0], x[2][1]);
#pragma unroll
            for (int c = 0; c < 3; ++c) sq += x[c][0] * x[c][0] + x[c][1] * x[c][1];
            sq = hw_sum(sq); const float r = rsqrtf(sq * (1.f / 192.f) + EPS);
#pragma unroll
            for (int c = 0; c < 3; ++c) { x[c][0] *= r * gka[c * 64 + 2 * l2]; x[c][1] *= r * gka[c * 64 + 2 * l2 + 1]; }
            if (latent) rope16(x[2][0], x[2][1], l2, row, col, t16);
            bf16_t* dst = Km + ((size_t)kr * 8 + h) * 192 + 2 * l2;
#pragma unroll
            for (int c = 0; c < 3; ++c) stpair(dst + c * 64, x[c][0], x[c][1]);
            bf16_t* dv = Vm + ((size_t)kr * 8 + h) * 128 + 2 * l2;
#pragma unroll
            for (int c = 0; c < 2; ++c) { float a, b; ldpair(src + 128 + c * 64, a, b); stpair(dv + c * 64, a * rstd_kv, b * rstd_kv); } }
#pragma unroll 1
        for (int it = 0; it < 8; ++it) { const int hm = it * 2 + hw;
            float a, b; ldpair(p1 + 1344 + hm * 64 + 2 * l2, a, b);
            float sq = hw_sum(a * a + b * b); float r = rsqrtf(sq * (1.f / 64.f) + EPS);
            a *= r * gqb[2 * l2]; b *= r * gqb[2 * l2 + 1];
            if (latent) rope16(a, b, l2, row, col, t16);
            stpair(Qd + ((size_t)t * 16 + hm) * 64 + 2 * l2, a, b);
            ldpair(p1 + 2368 + hm * 64 + 2 * l2, a, b);
            sq = hw_sum(a * a + b * b); r = rsqrtf(sq * (1.f / 64.f) + EPS);
            a *= r * gkb[2 * l2]; b *= r * gkb[2 * l2 + 1];
            if (latent) rope16(a, b, l2, row, col, t16);
            stpair(Kd + ((size_t)kr * 16 + hm) * 64 + 2 * l2, a, b); }
#pragma unroll
        for (int j = 0; j < 2; ++j) *(u32x4*)(Vd + (size_t)kr * 1024 + j * 512 + F.lane * 8) = *(const u32x4*)(p1 + 3392 + j * 512 + F.lane * 8);
    }
}
__device__ __forceinline__ void qkv_odd_phase(const Ctx& F, CParams& P, int e) {
    const bf16_t* P1 = (const bf16_t*)(F.ws + WS_P1);
    bf16_t* Qc = (bf16_t*)(F.ws + WS_Q1); bf16_t* Kc = (bf16_t*)(F.ws + WS_K1); bf16_t* Vc = (bf16_t*)(F.ws + WS_V1);
    const float* t32 = (const float*)(F.ws + WS_TAB32);
    const float* gq = P.g_qn_c + e * 128; const float* gk = P.g_kn_c + e * 128;
    const int l2 = F.lane & 31, hw = F.lane >> 5;
    for (int t = F.vcu * 8 + F.wid; t < TT; t += F.G * 8) {
        const bool latent = t < TL; const int s = t & (SEQ - 1), row = s >> 6, col = s & 63; const int kr = krow_of(t);
        const bf16_t* p1 = P1 + (size_t)t * C_IN;
#pragma unroll 1
        for (int it = 0; it < 10; ++it) {
            const bool isq = it < 8; const int h = (isq ? it : it - 8) * 2 + hw;
            const bf16_t* src = p1 + (isq ? 0 : 2048) + h * 128 + 2 * l2; const float* g = isq ? gq : gk;
            float x[2][2]; float sq = 0.f;
#pragma unroll
            for (int c = 0; c < 2; ++c) { ldpair(src + c * 64, x[c][0], x[c][1]); sq += x[c][0] * x[c][0] + x[c][1] * x[c][1]; }
            sq = hw_sum(sq); const float r = rsqrtf(sq * (1.f / 128.f) + EPS);
#pragma unroll
            for (int c = 0; c < 2; ++c) { x[c][0] *= r * g[c * 64 + 2 * l2]; x[c][1] *= r * g[c * 64 + 2 * l2 + 1]; }
            if (latent) { rope32(x[0][0], x[0][1], l2, row, t32); rope32(x[1][0], x[1][1], l2, col, t32); }
            bf16_t* dst = isq ? Qc + ((size_t)t * 16 + h) * 128 + 2 * l2 : Kc + ((size_t)kr * 4 + h) * 128 + 2 * l2;
#pragma unroll
            for (int c = 0; c < 2; ++c) stpair(dst + c * 64, x[c][0], x[c][1]); }
        *(u32x4*)(Vc + (size_t)kr * 512 + F.lane * 8) = *(const u32x4*)(p1 + 2560 + F.lane * 8);
    }
}

template <int DQK, int SDEPTH, int ldo, int NH, int NKVH, int NVH>
__device__ __forceinline__ void attn_phase(const Ctx& F, const bf16_t* Qbuf, const bf16_t* Kbuf, const bf16_t* Vbuf, float* OF, int ocol0, bool with_ctx) {
    constexpr int kv_div = NH / NKVH, v_div = NH / NVH;
    const int n_lat = NH * NB * 32, n_tot = n_lat + (with_ctx ? NH * NB : 0);
    constexpr int ldq = NH * DQK, ldk = NKVH * DQK, ldv = NVH * 128;
    for (int u = F.vcu; u < n_tot; u += F.G) {
        int b, h, qrow0, kstart, seq;
        if (u < n_lat) { const int bh = u >> 5, qb = u & 31; b = bh / NH; h = bh % NH; qrow0 = b * SEQ + qb * 256; kstart = b * KPB; seq = KPB; }
        else { const int bh = u - n_lat; b = bh / NH; h = bh % NH; qrow0 = TL + b * CTXL; kstart = b * KPB + SEQ; seq = CTXL; }
        const bf16_t* Qp = Qbuf + ((size_t)qrow0 * NH + h) * DQK;
        const bf16_t* Kp = Kbuf + ((size_t)kstart * NKVH + h / kv_div) * DQK;
        const bf16_t* Vp = Vbuf + ((size_t)kstart * NVH + h / v_div) * 128;
        float* Op = OF + (size_t)qrow0 * ldo + ocol0 + h * 128;
        if constexpr (SDEPTH == 0) att::attn_body_simple<DQK, (DQK == 192 ? MLA_QL : 0), ldq, ldk, ldv, ldo>(Qp, Kp, Vp, Op, seq, F.lds);
        else att::attn_body<DQK, SDEPTH, ldq, ldk, ldv, ldo>(Qp, Kp, Vp, Op, seq, F.lds);
    }
}

__device__ __forceinline__ void merge_even_phase(const Ctx& F, CParams& P, int e, int layer, int m_rows) {
    const float* OF = (const float*)(F.ws + WS_OF); bf16_t* AO = (bf16_t*)(F.ws + WS_AO);
    const float lam = ((const float*)(F.ws + WS_LAM))[e];
    const float lam_init = 0.8f - 0.6f * expf(-0.3f * (float)layer);
    const float* gs = P.g_sub_b + e * 128;
    const int l2 = F.lane & 31, hw = F.lane >> 5;
    for (int t = F.vcu * 8 + F.wid; t < m_rows; t += F.G * 8) {
        const float* of = OF + (size_t)t * 3072; bf16_t* ao = AO + (size_t)t * DM;
#pragma unroll
        for (int j = 0; j < 4; ++j) { const f32x4 v = *(const f32x4*)(of + j * 256 + F.lane * 4); u32x2 w; w.x = cvt_pk_bf16(v[0], v[1]); w.y = cvt_pk_bf16(v[2], v[3]); *(u32x2*)(ao + j * 256 + F.lane * 4) = w; }
#pragma unroll
        for (int it = 0; it < 4; ++it) { const int h = it * 2 + hw;
            const f32x4 o0 = *(const f32x4*)(of + 1024 + (2 * h) * 128 + l2 * 4), o1 = *(const f32x4*)(of + 1024 + (2 * h + 1) * 128 + l2 * 4);
            f32x4 d = o0 - lam * o1;
            float sq = hw_sum(d[0] * d[0] + d[1] * d[1] + d[2] * d[2] + d[3] * d[3]);
            const float r = rsqrtf(sq * (1.f / 128.f) + EPS) * (1.f - lam_init);
            const f32x4 g = *(const f32x4*)(gs + l2 * 4);
            u32x2 w; w.x = cvt_pk_bf16(d[0] * r * g[0], d[1] * r * g[1]); w.y = cvt_pk_bf16(d[2] * r * g[2], d[3] * r * g[3]);
            *(u32x2*)(ao + 1024 + h * 128 + l2 * 4) = w; }
    }
}
__device__ __forceinline__ void merge_odd_phase(const Ctx& F, int m_rows) {
    const float* OF = (const float*)(F.ws + WS_OF); bf16_t* AO = (bf16_t*)(F.ws + WS_AO);
    for (int t = F.vcu * 8 + F.wid; t < m_rows; t += F.G * 8) {
        const float* of = OF + (size_t)t * 2048; bf16_t* ao = AO + (size_t)t * DM;
#pragma unroll
        for (int j = 0; j < 8; ++j) { const f32x4 v = *(const f32x4*)(of + j * 256 + F.lane * 4); u32x2 w; w.x = cvt_pk_bf16(v[0], v[1]); w.y = cvt_pk_bf16(v[2], v[3]); *(u32x2*)(ao + j * 256 + F.lane * 4) = w; }
    }
}

__device__ __forceinline__ unsigned fkey(float f) { const unsigned b = __float_as_uint(f); return b ^ ((unsigned)((int)b >> 31) | 0x80000000u); }
template <int S> __device__ __forceinline__ unsigned kth16(const unsigned (&key)[S]) {
    unsigned lo = 0u, hi = 0xFFFFFFFFu;
    while (lo < hi) {
        const unsigned mid = lo + ((hi - lo) >> 1) + 1u;
        int c = 0;
#pragma unroll
        for (int s = 0; s < S; ++s) c += __popcll(__ballot(key[s] >= mid));
        if (c >= 16) { lo = mid; if (c == 16) break; } else hi = mid - 1u;
    }
    return lo;
}
template <int S> __device__ __forceinline__ void top16(const float (&val)[S], const int (&idx)[S], float* outv, int* outi) {
    unsigned key[S];
#pragma unroll
    for (int s = 0; s < S; ++s) key[s] = fkey(val[s]);
    const unsigned T = kth16<S>(key);
    int cgt = 0;
#pragma unroll
    for (int s = 0; s < S; ++s) cgt += __popcll(__ballot(key[s] > T));
    const int need = 16 - cgt;
    int base = 0, eqseen = 0;
#pragma unroll
    for (int s = 0; s < S; ++s) {
        const bool gt = key[s] > T, eq = key[s] == T;
        const unsigned long long meq = __ballot(eq);
        const int eqpos = eqseen + mbcnt64(meq);
        const bool take = gt || (eq && eqpos < need);
        const unsigned long long mt = __ballot(take);
        const int pos = base + mbcnt64(mt);
        if (take && pos < 16) { outv[pos] = val[s]; outi[pos] = idx[s]; }
        base += __popcll(mt); eqseen += __popcll(meq);
    }
}
__device__ __forceinline__ void wave_lds_fence() { asm volatile("s_waitcnt lgkmcnt(0)" ::: "memory"); __builtin_amdgcn_wave_barrier(); asm volatile("" ::: "memory"); }

__device__ __forceinline__ void peer_select_phase(const Ctx& F, int layer, int m_rows) {
    const bf16_t* PQ = (const bf16_t*)(F.ws + WS_PQ); const bf16_t* SK = (const bf16_t*)(F.ws + WS_SUBK) + (size_t)layer * 8 * 2 * 128 * 128;
    int* PIDX = (int*)(F.ws + WS_PIDX); float* PG = (float*)(F.ws + WS_PG);
    float* sc = (float*)F.lds;
    float* wsv = (float*)(F.lds + 65536) + F.wid * 128;
    int* wsi = (int*)(F.lds + 65536 + 8 * 512) + F.wid * 128;
    const int r32 = F.lane & 31, hi = F.lane >> 5;
    const int nunits = (m_rows / 64) * 8;
    for (int u = F.vcu; u < nunits; u += F.G) {
        const int tile = u >> 3, h = u & 7, t0 = tile * 64;
        { const int p = F.wid >> 2, nb = F.wid & 3;
          f32x16 acc0 = {}, acc1 = {};
          const bf16_t* bp = SK + ((size_t)(h * 2 + p) * 128 + nb * 32 + r32) * 128 + hi * 8;
          const bf16_t* ap = PQ + (size_t)(t0 + r32) * DM + h * 256 + p * 128 + hi * 8;
#pragma unroll
          for (int ks = 0; ks < 8; ++ks) {
              const bf16x8 bfr = *(const bf16x8*)(bp + ks * 16);
              const bf16x8 a0 = *(const bf16x8*)(ap + ks * 16), a1 = *(const bf16x8*)(ap + (size_t)32 * DM + ks * 16);
              acc0 = __builtin_amdgcn_mfma_f32_32x32x16_bf16(a0, bfr, acc0, 0, 0, 0);
              acc1 = __builtin_amdgcn_mfma_f32_32x32x16_bf16(a1, bfr, acc1, 0, 0, 0); }
          __syncthreads();
#pragma unroll
          for (int r = 0; r < 16; ++r) { const int rowi = att::crow(r, hi); sc[rowi * 256 + p * 128 + nb * 32 + r32] = acc0[r]; sc[(32 + rowi) * 256 + p * 128 + nb * 32 + r32] = acc1[r]; }
        }
        __syncthreads();
#pragma unroll 1
        for (int tt = 0; tt < 8; ++tt) {
            const int tok = F.wid * 8 + tt; const float* srow = sc + tok * 256;
#pragma unroll
            for (int p = 0; p < 2; ++p) { float val[2]; int idx[2];
                val[0] = srow[p * 128 + F.lane]; val[1] = srow[p * 128 + 64 + F.lane]; idx[0] = F.lane; idx[1] = 64 + F.lane;
                top16<2>(val, idx, wsv + p * 16, wsi + p * 16); }
            wave_lds_fence();
            { const int i = F.lane & 15, jq = F.lane >> 4; const float a = wsv[i]; const int ia = wsi[i];
              float cv[4]; int ci[4];
#pragma unroll
              for (int c = 0; c < 4; ++c) { const int j = jq * 4 + c; cv[c] = a + wsv[16 + j]; ci[c] = ia * 128 + wsi[16 + j]; }
              top16<4>(cv, ci, wsv + 32, wsi + 32); }
            wave_lds_fence();
            { const float v = wsv[32 + (F.lane & 15)]; const int id = wsi[32 + (F.lane & 15)];
              float mx = v;
#pragma unroll
              for (int o = 8; o >= 1; o >>= 1) mx = fmaxf(mx, __shfl_xor(mx, o));
              const float ex = __expf(v - mx); float sm = ex;
#pragma unroll
              for (int o = 8; o >= 1; o >>= 1) sm += __shfl_xor(sm, o);
              if (F.lane < 16) { const size_t o = ((size_t)(t0 + tok) * 8 + h) * 16 + F.lane; PG[o] = ex / sm; PIDX[o] = id; } }
            wave_lds_fence();
        }
    }
}

__device__ __forceinline__ float dot2bf(unsigned w, unsigned x, float acc) { return __builtin_amdgcn_fdot2_f32_bf16(__builtin_bit_cast(bf16x2_t, w), __builtin_bit_cast(bf16x2_t, x), acc, false); }
__device__ __forceinline__ float gelu_tanh(float a) { const float u = 0.7978845608028654f * (a + 0.044715f * a * a * a); const float t = 1.f - 2.f / (1.f + __expf(2.f * u)); return 0.5f * a * (1.f + t); }
__device__ __forceinline__ float dot_row(const u32x4 (&r)[4], const unsigned (&hq)[16]) {
    float s0 = 0.f, s1 = 0.f, s2 = 0.f, s3 = 0.f;
#pragma unroll
    for (int j = 0; j < 4; ++j) { s0 = dot2bf(r[j].x, hq[j * 4 + 0], s0); s1 = dot2bf(r[j].y, hq[j * 4 + 1], s1); s2 = dot2bf(r[j].z, hq[j * 4 + 2], s2); s3 = dot2bf(r[j].w, hq[j * 4 + 3], s3); }
    return (s0 + s1) + (s2 + s3);
}
__device__ __forceinline__ void ld_row(u32x4 (&r)[4], const bf16_t* tab, int e, int lane) {
    const u32x4* rp = (const u32x4*)(tab + (size_t)e * DM);
#pragma unroll
    for (int j = 0; j < 4; ++j) r[j] = rp[j * 64 + lane];
}
__device__ __forceinline__ void fma_row(float (&out)[32], const u32x4 (&r)[4], float w) {
#pragma unroll
    for (int j = 0; j < 4; ++j) {
        out[j * 8 + 0] = fmaf(w, bf_lo(r[j].x), out[j * 8 + 0]); out[j * 8 + 1] = fmaf(w, bf_hi(r[j].x), out[j * 8 + 1]);
        out[j * 8 + 2] = fmaf(w, bf_lo(r[j].y), out[j * 8 + 2]); out[j * 8 + 3] = fmaf(w, bf_hi(r[j].y), out[j * 8 + 3]);
        out[j * 8 + 4] = fmaf(w, bf_lo(r[j].z), out[j * 8 + 4]); out[j * 8 + 5] = fmaf(w, bf_hi(r[j].z), out[j * 8 + 5]);
        out[j * 8 + 6] = fmaf(w, bf_lo(r[j].w), out[j * 8 + 6]); out[j * 8 + 7] = fmaf(w, bf_hi(r[j].w), out[j * 8 + 7]); }
}
__device__ __forceinline__ void peer_expert_phase(const Ctx& F, CParams& P, int layer, int m_rows, bool last) {
    const bf16_t* EU = (const bf16_t*)(F.ws + WS_EU) + (size_t)layer * NEXP * DM; const bf16_t* EV = (const bf16_t*)(F.ws + WS_EV) + (size_t)layer * NEXP * DM;
    const bf16_t* H = (const bf16_t*)(F.ws + WS_H); float* X = (float*)(F.ws + WS_X);
    const int* PIDX = (const int*)(F.ws + WS_PIDX); const float* PG = (const float*)(F.ws + WS_PG);
    const float* mod = (const float*)(F.ws + WS_MOD) + (size_t)layer * 3 * 12288;
    const int lane = F.lane;
    for (int t = F.vcu * 8 + F.wid; t < m_rows; t += F.G * 8) {
        unsigned hq[16];
        { const u32x4* hp = (const u32x4*)(H + (size_t)t * DM);
#pragma unroll
          for (int j = 0; j < 4; ++j) { const u32x4 w = hp[j * 64 + lane]; hq[j * 4 + 0] = w.x; hq[j * 4 + 1] = w.y; hq[j * 4 + 2] = w.z; hq[j * 4 + 3] = w.w; } }
        int id[2]; float gg[2], aa[2];
        id[0] = PIDX[(size_t)t * 128 + lane]; id[1] = PIDX[(size_t)t * 128 + 64 + lane];
        gg[0] = PG[(size_t)t * 128 + lane]; gg[1] = PG[(size_t)t * 128 + 64 + lane];
#pragma unroll
        for (int half = 0; half < 2; ++half) {
            const int idr = id[half]; float acc = 0.f;
            u32x4 A0[4], A1[4], B0[4], B1[4];
            ld_row(A0, EU, __builtin_amdgcn_readlane(idr, 0), lane); ld_row(A1, EU, __builtin_amdgcn_readlane(idr, 1), lane);
#pragma unroll 1
            for (int k = 0; k < 64; k += 4) {
                ld_row(B0, EU, __builtin_amdgcn_readlane(idr, k + 2), lane); ld_row(B1, EU, __builtin_amdgcn_readlane(idr, k + 3), lane);
                { const float s0 = wave_sum(dot_row(A0, hq)), s1 = wave_sum(dot_row(A1, hq)); acc = (lane == k) ? s0 : acc; acc = (lane == k + 1) ? s1 : acc; }
                if (k + 4 < 64) { ld_row(A0, EU, __builtin_amdgcn_readlane(idr, k + 4), lane); ld_row(A1, EU, __builtin_amdgcn_readlane(idr, k + 5), lane); }
                { const float s2 = wave_sum(dot_row(B0, hq)), s3 = wave_sum(dot_row(B1, hq)); acc = (lane == k + 2) ? s2 : acc; acc = (lane == k + 3) ? s3 : acc; }
            }
            aa[half] = gg[half] * gelu_tanh(acc);
        }
        float out[32];
#pragma unroll
        for (int i = 0; i < 32; ++i) out[i] = 0.f;
#pragma unroll
        for (int half = 0; half < 2; ++half) {
            const int idr = id[half]; const unsigned wbits = __float_as_uint(aa[half]);
            u32x4 A0[4], A1[4], B0[4], B1[4];
            ld_row(A0, EV, __builtin_amdgcn_readlane(idr, 0), lane); ld_row(A1, EV, __builtin_amdgcn_readlane(idr, 1), lane);
#pragma unroll 1
            for (int k = 0; k < 64; k += 4) {
                ld_row(B0, EV, __builtin_amdgcn_readlane(idr, k + 2), lane); ld_row(B1, EV, __builtin_amdgcn_readlane(idr, k + 3), lane);
                fma_row(out, A0, __uint_as_float(__builtin_amdgcn_readlane(wbits, k))); fma_row(out, A1, __uint_as_float(__builtin_amdgcn_readlane(wbits, k + 1)));
                if (k + 4 < 64) { ld_row(A0, EV, __builtin_amdgcn_readlane(idr, k + 4), lane); ld_row(A1, EV, __builtin_amdgcn_readlane(idr, k + 5), lane); }
                fma_row(out, B0, __uint_as_float(__builtin_amdgcn_readlane(wbits, k + 2))); fma_row(out, B1, __uint_as_float(__builtin_amdgcn_readlane(wbits, k + 3)));
            }
        }
        const float* gate = mod + (size_t)vsel_of_row(t) * 12288 + 5 * DM;
        float* xr = X + (size_t)t * DM; float* dst = last ? P.out + (size_t)t * DM : xr;
#pragma unroll
        for (int j = 0; j < 4; ++j)
#pragma unroll
            for (int q = 0; q < 2; ++q) { const int c = j * 512 + lane * 8 + q * 4; const f32x4 xo = *(const f32x4*)(xr + c), g = *(const f32x4*)(gate + c);
                f32x4 y; y[0] = xo[0] + g[0] * out[j * 8 + q * 4 + 0]; y[1] = xo[1] + g[1] * out[j * 8 + q * 4 + 1]; y[2] = xo[2] + g[2] * out[j * 8 + q * 4 + 2]; y[3] = xo[3] + g[3] * out[j * 8 + q * 4 + 3];
                *(f32x4*)(dst + c) = y; }
    }
}

constexpr int N_PHASES = 1 + 2 * 11 + 2 * 10;
__global__ void __launch_bounds__(512, 2) mk_fwd(Params Pval) {
    extern __shared__ __attribute__((aligned(16))) unsigned char lds_raw[];
    LAS unsigned char* ldsl = (LAS unsigned char*)lds_raw;
    volatile LAS unsigned* misc = (volatile LAS unsigned*)(ldsl + LDS_MISC);
    if (threadIdx.x < 16) misc[threadIdx.x] = 0u;
    __syncthreads();
    XcdBarrier bar = xcd_barrier_post((unsigned*)(Pval.ws + WS_CTL) + 1024, misc);
    const int lo = Pval.ph_lo, hi = Pval.ph_hi; int ph = 0;
#define MKCTX() Ctx F; { int tid_ = threadIdx.x; asm volatile("" : "+v"(tid_)); F.tid = tid_; F.lane = tid_ & 63; F.wid = __builtin_amdgcn_readfirstlane(tid_ >> 6); \
        int G_ = gridDim.x, bx_ = blockIdx.x; asm volatile("" : "+s"(G_), "+s"(bx_)); F.G = G_; F.vcu = (G_ % 8 == 0) ? (bx_ % 8) * (G_ / 8) + bx_ / 8 : bx_; F.bx = bx_; } \
        unsigned long long kp_ = (unsigned long long)__builtin_amdgcn_kernarg_segment_ptr(); asm volatile("" : "+s"(kp_)); CParams& P = *(CParams*)kp_; \
        F.ws = P.ws; F.lds = (char*)lds_raw; unsigned char* ws = F.ws; (void)ws; \
        bf16_t* Hb = (bf16_t*)(ws + WS_H); bf16_t* P1 = (bf16_t*)(ws + WS_P1); float* X = (float*)(ws + WS_X); const float* mod = (const float*)(ws + WS_MOD); (void)Hb; (void)P1; (void)X; (void)mod;
#define PHASE(cls, ...) do { if (ph >= lo && ph < hi) { if constexpr ((PH_MASK >> (cls)) & 1u) { MKCTX(); __VA_ARGS__; } if (ph + 1 < hi) xcd_barrier(bar); } ++ph; } while (0)

    PHASE(0, prologue_phase(F, P));
#pragma unroll 1
    for (int layer = 0; layer < DEPTH; ++layer) {
        const int e = layer >> 1; const bool even = (layer & 1) == 0, lastl = layer == DEPTH - 1;
        const int m_post = lastl ? TL : TT;
        PHASE(1, norm_phase(F, P, layer, 0, TT));
        PHASE(2, { const bf16_t* W = even ? (const bf16_t*)(ws + WS_WINAB) + (size_t)e * AB_INP * DM : (const bf16_t*)(ws + WS_WINC) + (size_t)e * C_IN * DM;
                const int N = even ? AB_INP : C_IN;
                pg8::Gemm g{Hb, W, TT, N, DM, DM}; pg8::StaticOrder S; S.init(TT, N, F.G, F.bx);
                pg8::EpiBf16 E{P1, N};
                pg8::gemm_phase<pg8::EpiBf16, pg8::StaticOrder>(ldsl, g, S, E); });
        if (even) {
            PHASE(3, { { pg8::Gemm g{P1, (const bf16_t*)(ws + WS_WUQ) + (size_t)e * 1536 * 768, TT, 1536, 768, AB_INP}; pg8::StaticOrder S; S.init(TT, 1536, F.G, F.bx);
                      pg8::EpiBf16 E{(bf16_t*)(ws + WS_QA), 1536};
                      pg8::gemm_phase<pg8::EpiBf16, pg8::StaticOrder>(ldsl, g, S, E); }
                    { pg8::Gemm g{P1 + 768, (const bf16_t*)(ws + WS_WUKV) + (size_t)e * 2048 * 512, TT, 2048, 512, AB_INP}; pg8::StaticOrder S; S.init(TT, 2048, F.G, F.bx);
                      pg8::EpiBf16 E{(bf16_t*)(ws + WS_KV), 2048};
                      pg8::gemm_phase<pg8::EpiBf16, pg8::StaticOrder>(ldsl, g, S, E); } });
            PHASE(4, qkv_even_phase(F, P, e));
            PHASE(5, { if constexpr (ATT_SEL & 1) attn_phase<192, MLA_SD, 3072, 8, 8, 8>(F, (const bf16_t*)(ws + WS_Q1), (const bf16_t*)(ws + WS_K1), (const bf16_t*)(ws + WS_V1), (float*)(ws + WS_OF), 0, !lastl);
                    if constexpr (ATT_SEL & 2) attn_phase<64, 2, 3072, 16, 16, 8>(F, (const bf16_t*)(ws + WS_Q2), (const bf16_t*)(ws + WS_K2), (const bf16_t*)(ws + WS_V2), (float*)(ws + WS_OF), 1024, !lastl); });
            PHASE(6, merge_even_phase(F, P, e, layer, m_post));
        } else {
            PHASE(7, qkv_odd_phase(F, P, e));
            PHASE(8, attn_phase<128, GQA_SD, 2048, 16, 4, 4>(F, (const bf16_t*)(ws + WS_Q1), (const bf16_t*)(ws + WS_K1), (const bf16_t*)(ws + WS_V1), (float*)(ws + WS_OF), 0, !lastl));
            PHASE(9, merge_odd_phase(F, m_post));
        }
        PHASE(10, { const bf16_t* W = even ? (const bf16_t*)(ws + WS_WOUTAB) + (size_t)e * DM * DM : (const bf16_t*)(ws + WS_WOUTC) + (size_t)e * DM * DM;
                pg8::Gemm g{(const bf16_t*)(ws + WS_AO), W, m_post, DM, DM, DM}; pg8::StaticOrder S; S.init(m_post, DM, F.G, F.bx);
                pg8::EpiResid E{X, mod + (size_t)layer * 3 * 12288, 2};
                pg8::gemm_phase<pg8::EpiResid, pg8::StaticOrder>(ldsl, g, S, E); });
        PHASE(1, norm_phase(F, P, layer, 1, m_post));
        PHASE(11, { pg8::Gemm g{Hb, (const bf16_t*)(ws + WS_WPQ) + (size_t)layer * DM * DM, m_post, DM, DM, DM}; pg8::StaticOrder S; S.init(m_post, DM, F.G, F.bx);
                pg8::EpiBf16 E{(bf16_t*)(ws + WS_PQ), DM};
                pg8::gemm_phase<pg8::EpiBf16, pg8::StaticOrder>(ldsl, g, S, E); });
        PHASE(12, peer_select_phase(F, layer, m_post));
        PHASE(13, peer_expert_phase(F, P, layer, m_post, lastl));
    }
#undef PHASE
}

extern "C" void kernel_launch(void* const* d_in, const int* in_sizes, int n_in, void* d_out, int out_size, void* d_ws, size_t ws_size, hipStream_t stream) {
    static int grid = 0;
    if (grid == 0) {
        if (n_in != 28 || ws_size < WS_END) { fprintf(stderr, "kernel_launch: expected 28 inputs and >= %zu bytes of workspace, got %d / %zu\n", (size_t)WS_END, n_in, ws_size); grid = -1; return; }
        int dev = 0, cus = 0, per_cu = 0;
        if (hipGetDevice(&dev) != hipSuccess || hipDeviceGetAttribute(&cus, hipDeviceAttributeMultiprocessorCount, dev) != hipSuccess) { grid = -1; return; }
        if (hipFuncSetAttribute((const void*)mk_fwd, hipFuncAttributeMaxDynamicSharedMemorySize, LDS_BYTES) != hipSuccess) { fprintf(stderr, "kernel_launch: hipFuncSetAttribute failed\n"); grid = -1; return; }
        if (hipOccupancyMaxActiveBlocksPerMultiprocessor(&per_cu, (const void*)mk_fwd, 512, LDS_BYTES) != hipSuccess || per_cu < 1) fprintf(stderr, "kernel_launch: occupancy query says %d\n", per_cu);
        (void)hipGetLastError();
        grid = cus;
    }
    if (grid < 0) return;
    (void)hipMemsetAsync((char*)d_ws + WS_CTL, 0, CTL_BYTES, stream);
    Params p{};
    const float** pf = (const float**)&p;
    for (int i = 0; i < 28; ++i) pf[i] = (const float*)d_in[i];
    p.out = (float*)d_out; p.ws = (unsigned char*)d_ws;
#if MK_PER_PHASE_LAUNCH
    for (int i = 0; i < N_PHASES; ++i) { p.ph_lo = i; p.ph_hi = i + 1; hipLaunchKernelGGL(mk_fwd, dim3(grid), dim3(512), LDS_BYTES, stream, p); }
#else
    p.ph_lo = 0; p.ph_hi = N_PHASES;
    hipLaunchKernelGGL(mk_fwd, dim3(grid), dim3(512), LDS_BYTES, stream, p);
#endif
    const hipError_t le = hipPeekAtLastError();
    if (le != hipSuccess) fprintf(stderr, "kernel_launch: launch failed: %s\n", hipGetErrorName(le));
}
```

```cpp
#include <hip/hip_runtime.h>
#include <stdint.h>
#include <stdio.h>

#ifndef MK_PER_PHASE_LAUNCH
#define MK_PER_PHASE_LAUNCH 0
#endif

#ifndef MLA_QL
#define MLA_QL 4
#endif
#ifndef MLA_SD
#define MLA_SD 0
#endif
#ifndef GQA_SD
#define GQA_SD 1
#endif
#ifndef ATT_SEL
#define ATT_SEL 3
#endif
#ifndef PH_DOUBLE
#define PH_DOUBLE 0u
#endif
#ifndef PH_MASK
#define PH_MASK 0xFFFFFFFFu
#endif
#define LAS __attribute__((address_space(3)))
typedef unsigned short bf16_t;
typedef short bf16x8 __attribute__((ext_vector_type(8)));
typedef short s16x4 __attribute__((ext_vector_type(4)));
typedef float f32x4 __attribute__((ext_vector_type(4)));
typedef float f32x2 __attribute__((ext_vector_type(2)));
typedef float f32x16 __attribute__((ext_vector_type(16)));
typedef unsigned u32x4 __attribute__((ext_vector_type(4)));
typedef unsigned u32x2 __attribute__((ext_vector_type(2)));
typedef __bf16 bf16x2_t __attribute__((ext_vector_type(2)));

constexpr int DM = 2048, NB = 2, SEQ = 8192, DEPTH = 4, CTXL = 256;
constexpr int TL = NB * SEQ;
constexpr int TZ = NB * CTXL;
constexpr int TT = TL + TZ;
constexpr int KPB = SEQ + CTXL;
constexpr int AB_IN = 4416, AB_INP = 4608;
constexpr int C_IN = 3072;
constexpr int NEXP = 16384;
constexpr float EPS = 1e-6f;
constexpr float LOG2E = 1.4426950408889634f;

constexpr size_t al256(size_t x) { return (x + 255) / 256 * 256; }
constexpr size_t WS_CTL = 0, CTL_BYTES = 1u << 20;
constexpr size_t WS_MOD = WS_CTL + CTL_BYTES;
constexpr size_t WS_TAB16 = WS_MOD + al256((size_t)4 * 3 * 12288 * 4);
constexpr size_t WS_TAB32 = WS_TAB16 + al256((size_t)128 * 16 * 2 * 4);
constexpr size_t WS_LAM = WS_TAB32 + al256((size_t)128 * 32 * 2 * 4);
constexpr size_t WS_WINAB = WS_LAM + 256;
constexpr size_t WS_WUQ = WS_WINAB + (size_t)2 * AB_INP * DM * 2;
constexpr size_t WS_WUKV = WS_WUQ + (size_t)2 * 1536 * 768 * 2;
constexpr size_t WS_WOUTAB = WS_WUKV + (size_t)2 * 2048 * 512 * 2;
constexpr size_t WS_WINC = WS_WOUTAB + (size_t)2 * DM * DM * 2;
constexpr size_t WS_WOUTC = WS_WINC + (size_t)2 * C_IN * DM * 2;
constexpr size_t WS_WPQ = WS_WOUTC + (size_t)2 * DM * DM * 2;
constexpr size_t WS_SUBK = WS_WPQ + (size_t)4 * DM * DM * 2;
constexpr size_t WS_EU = WS_SUBK + (size_t)4 * 8 * 2 * 128 * 128 * 2;
constexpr size_t WS_EV = WS_EU + (size_t)4 * NEXP * DM;
constexpr size_t WS_SU = WS_EV + (size_t)4 * NEXP * DM;
constexpr size_t WS_SV = WS_SU + (size_t)4 * NEXP * 4;
constexpr size_t WS_X = WS_SV + (size_t)4 * NEXP * 4;
constexpr size_t WS_H = WS_X + (size_t)TT * DM * 4;
constexpr size_t WS_P1 = WS_H + (size_t)TT * DM * 2;
constexpr size_t WS_QA = WS_P1 + (size_t)TT * AB_INP * 2;
constexpr size_t WS_KV = WS_QA + (size_t)TT * 1536 * 2;
constexpr size_t WS_Q1 = WS_KV + (size_t)TT * 2048 * 2;
constexpr size_t WS_K1 = WS_Q1 + (size_t)TT * 2048 * 2;
constexpr size_t WS_V1 = WS_K1 + (size_t)TT * 1536 * 2;
constexpr size_t WS_Q2 = WS_V1 + (size_t)TT * 1024 * 2;
constexpr size_t WS_K2 = WS_Q2 + (size_t)TT * 1024 * 2;
constexpr size_t WS_V2 = WS_K2 + (size_t)TT * 1024 * 2;
constexpr size_t WS_OF = WS_V2 + (size_t)TT * 1024 * 2;
constexpr size_t WS_AO = WS_OF + (size_t)TT * 3072 * 4;
constexpr size_t WS_PQ = WS_AO + (size_t)TT * DM * 2;
constexpr size_t WS_PIDX = WS_PQ + (size_t)TT * DM * 2;
constexpr size_t WS_PG = WS_PIDX + (size_t)TT * 128 * 4;
constexpr size_t WS_END = WS_PG + (size_t)TT * 128 * 4;

constexpr int LDS_MAIN = 131072;
constexpr int LDS_MISC = LDS_MAIN;
constexpr int LDS_BYTES = LDS_MAIN + 4096;

__device__ __forceinline__ unsigned cvt_pk_bf16(float lo, float hi) { unsigned r; asm("v_cvt_pk_bf16_f32 %0, %1, %2" : "=v"(r) : "v"(lo), "v"(hi)); return r; }
__device__ __forceinline__ float bf_lo(unsigned w) { return __uint_as_float(w << 16); }
__device__ __forceinline__ float bf_hi(unsigned w) { return __uint_as_float(w & 0xffff0000u); }
__device__ __forceinline__ float wave_sum(float v) {
#pragma unroll
    for (int o = 32; o >= 1; o >>= 1) v += __shfl_xor(v, o);
    return v;
}
__device__ __forceinline__ float hw_sum(float v) {
#pragma unroll
    for (int o = 16; o >= 1; o >>= 1) v += __shfl_xor(v, o);
    return v;
}
__device__ __forceinline__ int mbcnt64(unsigned long long m) { return (int)__builtin_amdgcn_mbcnt_hi((unsigned)(m >> 32), __builtin_amdgcn_mbcnt_lo((unsigned)m, 0u)); }
__device__ __forceinline__ int krow_of(int t) { return t < TL ? (t >> 13) * KPB + (t & (SEQ - 1)) : ((t - TL) >> 8) * KPB + SEQ + ((t - TL) & (CTXL - 1)); }
__device__ __forceinline__ int vsel_of_row(int t) { return t < SEQ ? 0 : (t < TL ? 1 : 2); }

#define XB_TMO      128
#define XB_XCNT(j)  (256  + 64 * (j))
#define XB_XSUB(j)  (1280 + 64 * (j))
#define XB_XGEN(j)  (2304 + 64 * (j))
#define XB_TOP      3328
#define XB_TOPGEN   3392
#define XCD_BAR_WORDS 3456
#define XB_SPIN_CAP (1u << 27)
__device__ __forceinline__ unsigned xb_ld(unsigned* p)              { return __hip_atomic_load(p, __ATOMIC_RELAXED, __HIP_MEMORY_SCOPE_AGENT); }
__device__ __forceinline__ unsigned xb_add(unsigned* p, unsigned v) { return __hip_atomic_fetch_add(p, v, __ATOMIC_RELAXED, __HIP_MEMORY_SCOPE_AGENT); }
__device__ __forceinline__ unsigned xb_xcc_id() { return (unsigned)__builtin_amdgcn_s_getreg((3 << 11) | 20) & 0xFu; }
#define XB_SPIN(cond, bar) do { unsigned _sp = 0; while (cond) { __builtin_amdgcn_s_sleep(1); \
    if ((++_sp & 255u) == 0u) { if (xb_ld(&(bar)[XB_TMO])) break; if (_sp > XB_SPIN_CAP) { atomicAdd(&(bar)[XB_TMO], 1u); break; } } } } while (0)
struct XcdBarrier { unsigned* bar; unsigned x; volatile LAS unsigned* st; };
__device__ __forceinline__ XcdBarrier xcd_barrier_post(unsigned* bar, volatile LAS unsigned* st) {
    XcdBarrier b; b.bar = bar; b.x = xb_xcc_id(); b.st = st;
    if (threadIdx.x == 0) (void)xb_add(&bar[XB_XCNT(b.x)], 1u);
    return b;
}
__device__ __forceinline__ void xcd_barrier_complete(unsigned* bar, unsigned x, unsigned& nloc, unsigned& nx) {
    const unsigned G = gridDim.x * gridDim.y * gridDim.z;
    unsigned sum, cnt, mine, sp = 0u;
    for (;;) {
        sum = 0u; cnt = 0u; mine = 0u;
#pragma unroll
        for (unsigned j = 0; j < 16; ++j) { const unsigned c = xb_ld(&bar[XB_XCNT(j)]); sum += c; cnt += (c > 0u) ? 1u : 0u; mine = (j == x) ? c : mine; }
        if (sum == G) break;
        __builtin_amdgcn_s_sleep(1);
        if ((++sp & 255u) == 0u) { if (xb_ld(&bar[XB_TMO])) break; if (sp > XB_SPIN_CAP) { atomicAdd(&bar[XB_TMO], 1u); break; } }
    }
    nloc = mine > 0u ? mine : 1u; nx = cnt > 0u ? cnt : 1u;
}
__device__ __forceinline__ void xcd_barrier(const XcdBarrier& b) {
    asm volatile("s_waitcnt vmcnt(0)" ::: "memory");
    __syncthreads();
    if (threadIdx.x == 0) {
        unsigned* bar = b.bar;
        __builtin_amdgcn_s_waitcnt(0);
        unsigned nloc = b.st[0], nx = b.st[1];
        if (nloc == 0u) { xcd_barrier_complete(bar, b.x, nloc, nx); b.st[0] = nloc; b.st[1] = nx; }
        const unsigned old = xb_add(&bar[XB_XSUB(b.x)], 1u);
        const unsigned gen = old / nloc;
        if (old + 1u == (gen + 1u) * nloc) {
            __builtin_amdgcn_fence(__ATOMIC_RELEASE, "agent");
            asm volatile("s_waitcnt vmcnt(0)" ::: "memory");
            const unsigned og = xb_add(&bar[XB_TOP], 1u);
            const unsigned tg = og / nx;
            if (og + 1u == (tg + 1u) * nx) xb_add(&bar[XB_TOPGEN], 1u);
            else XB_SPIN(xb_ld(&bar[XB_TOPGEN]) == tg, bar);
            __builtin_amdgcn_fence(__ATOMIC_ACQUIRE, "agent");
            xb_add(&bar[XB_XGEN(b.x)], 1u);
            asm volatile("s_waitcnt vmcnt(0)" ::: "memory");
        } else {
            XB_SPIN(xb_ld(&bar[XB_XGEN(b.x)]) == gen, bar);
            __builtin_amdgcn_fence(__ATOMIC_ACQUIRE, "agent");
            asm volatile("s_waitcnt vmcnt(0)" ::: "memory");
        }
    }
    __syncthreads();
}

namespace pg8 {
constexpr int BM = 256, BK = 64, HALF = 128, HTB = HALF * BK * 2, STAGE_BYTES = 8 * HTB, NXCD = 8, WGM = 8;
__host__ __device__ __forceinline__ int lds_byte(int r, int c) { const int st = (r >> 4) * 2 + (c >> 5), rr = r & 15, cc = c & 31, ob = rr * 64 + cc * 2; return st * 1024 + (ob ^ (((ob >> 9) & 1) << 5)); }
__host__ __device__ __forceinline__ void stage_rc(int b, int& R, int& C) { const int st = b / 1024, sb = b % 1024, swz = sb ^ (((sb >> 9) & 1) << 5); R = (st >> 1) * 16 + swz / 64; C = (st & 1) * 32 + (swz % 64) / 2; }
__host__ __device__ __forceinline__ int perm32(int rho) { const int n = rho >> 4, i = rho & 15; return 8 * (i >> 2) + 4 * n + (i & 3); }
struct Unit { int pm, pn; };
struct Gemm { const bf16_t* A; const bf16_t* Bt; int M, N, K, lda; };
struct StaticOrder {
    int nM, nN, nwg, G, c;
    __host__ __device__ void init(int M, int N, int G_, int c_) { nM = M / BM; nN = N / BM; nwg = nM * nN; G = G_; c = c_; }
    __host__ __device__ bool next(int i, Unit& u) const {
        const long L = (long)i * G + c; if (L >= nwg) return false;
        int wgid = (int)L; { const int q = nwg / NXCD, r = nwg % NXCD, xcd = wgid % NXCD, off = wgid / NXCD; wgid = (xcd < r ? xcd * (q + 1) : r * (q + 1) + (xcd - r) * q) + off; }
        const int nig = WGM * nN, gid = wgid / nig, fm = gid * WGM, gsz = (nM - fm) < WGM ? (nM - fm) : WGM;
        u.pm = fm + ((wgid % nig) % gsz); u.pn = (wgid % nig) / gsz; return true;
    }
    __device__ __forceinline__ void a_ready(const Unit&) const {}
    __device__ __forceinline__ void done(const Unit&) const {}
};
struct EpiBf16 {
    static constexpr bool PERM = true;
    bf16_t* O; int ldc;
    __device__ __forceinline__ void operator()(const f32x4 (&acc)[2][2][4][2], const Unit& u, int wr, int wc, int fr, int fq) const {
        const int row0 = u.pm * BM + wr * 64 + fr; const int col0 = u.pn * BM + wc * 32 + 8 * fq;
#pragma unroll
        for (int ai = 0; ai < 2; ++ai)
#pragma unroll
            for (int m = 0; m < 4; ++m) { bf16_t* rowp = O + (size_t)(row0 + ai * HALF + m * 16) * ldc + col0;
#pragma unroll
                for (int bj = 0; bj < 2; ++bj) { const f32x4 v0 = acc[ai][bj][m][0], v1 = acc[ai][bj][m][1];
                    u32x4 w; w.x = cvt_pk_bf16(v0[0], v0[1]); w.y = cvt_pk_bf16(v0[2], v0[3]); w.z = cvt_pk_bf16(v1[0], v1[1]); w.w = cvt_pk_bf16(v1[2], v1[3]);
                    *(u32x4*)(rowp + bj * HALF) = w; } }
    }
};
struct EpiResid {
    static constexpr bool PERM = false;
    float* X; const float* modl; int chunk;
    __device__ __forceinline__ void operator()(const f32x4 (&acc)[2][2][4][2], const Unit& u, int wr, int wc, int fr, int fq) const {
        const int row0 = u.pm * BM + wr * 64 + fr, col0 = u.pn * BM + wc * 32 + 4 * fq;
        const int vs = u.pm < 32 ? 0 : (u.pm < 64 ? 1 : 2);
        const float* gate = modl + (size_t)vs * 12288 + chunk * 2048 + col0;
        f32x4 gv[2][2];
#pragma unroll
        for (int bj = 0; bj < 2; ++bj)
#pragma unroll
            for (int n = 0; n < 2; ++n) gv[bj][n] = *(const f32x4*)(gate + bj * HALF + n * 16);
#pragma unroll
        for (int ai = 0; ai < 2; ++ai)
#pragma unroll
            for (int m = 0; m < 4; ++m) { float* rowp = X + (size_t)(row0 + ai * HALF + m * 16) * DM + col0;
#pragma unroll
                for (int bj = 0; bj < 2; ++bj)
#pragma unroll
                    for (int n = 0; n < 2; ++n) { float* p = rowp + bj * HALF + n * 16; const f32x4 xo = *(const f32x4*)p; *(f32x4*)p = xo + gv[bj][n] * acc[ai][bj][m][n]; } }
    }
};

template <class Epi, class Sched>
__device__ __forceinline__ void gemm_phase(LAS unsigned char* lds, const Gemm g, const Sched& S, const Epi& E) {
    int tid_l = threadIdx.x; asm volatile("" : "+v"(tid_l));
    const int tid = tid_l, wid = __builtin_amdgcn_readfirstlane(tid >> 6), lane = tid & 63, wr = wid >> 2, wc = wid & 3, fr = lane & 15, fq = lane >> 4;
    const int K = g.K, nt = K / BK, lda = g.lda;
    unsigned voffA[2], voffB[2];
#pragma unroll
    for (int i = 0; i < 2; ++i) { int R, C; stage_rc(tid * 16 + i * 8192, R, C); const int Rb = Epi::PERM ? ((R & ~31) + perm32(R & 31)) : R;
        voffA[i] = (unsigned)(R * lda + C) * 2u; voffB[i] = (unsigned)(Rb * K + C) * 2u; }
    const size_t kstep = (size_t)(BK * 2);
    const size_t hstepA = (size_t)HALF * lda * 2, hstepB = (size_t)HALF * K * 2;
    const size_t tstepA = 2 * hstepA, tstepB = 2 * hstepB;
    const unsigned ldsw = (unsigned)wid * 1024u;
    const int aoff = lds_byte(wr * 64 + fr, fq * 8), boff = lds_byte(wc * 32 + fr, fq * 8);
#define PG8_SA(b, h) (((b) * 2 + (h)) * HTB)
#define PG8_SB(b, h) ((4 + (b) * 2 + (h)) * HTB)
#define PG8_STAGE(bufoff, gbase, voff) do { _Pragma("unroll") for (int _i = 0; _i < 2; ++_i) \
        __builtin_amdgcn_global_load_lds((const unsigned*)((const char*)(gbase) + (voff)[_i]), (LAS unsigned*)(lds + (bufoff) + ldsw + _i * 8192), 16, 0, 0); } while (0)
#define PG8_LDA(dst, b, h) do { _Pragma("unroll") for (int m = 0; m < 4; ++m) _Pragma("unroll") for (int k = 0; k < 2; ++k) dst[m][k] = *(const LAS bf16x8*)(lds + PG8_SA(b, h) + aoff + m * 2048 + k * 1024); } while (0)
#define PG8_LDB(dst, b, h) do { _Pragma("unroll") for (int n = 0; n < 2; ++n) _Pragma("unroll") for (int k = 0; k < 2; ++k) dst[n][k] = *(const LAS bf16x8*)(lds + PG8_SB(b, h) + boff + n * 2048 + k * 1024); } while (0)
#define PG8_MMA(ai, bj, At, Bt) do { __builtin_amdgcn_s_setprio(1); _Pragma("unroll") for (int m = 0; m < 4; ++m) _Pragma("unroll") for (int n = 0; n < 2; ++n) _Pragma("unroll") for (int k = 0; k < 2; ++k) \
        acc[ai][bj][m][n] = __builtin_amdgcn_mfma_f32_16x16x32_bf16(Bt[n][k], At[m][k], acc[ai][bj][m][n], 0, 0, 0); __builtin_amdgcn_s_setprio(0); } while (0)
#define PG8_WAIT_V(n) asm volatile("s_waitcnt vmcnt(" #n ")" ::: "memory")
#define PG8_WAIT_L(n) asm volatile("s_waitcnt lgkmcnt(" #n ")" ::: "memory")
#define PG8_BAR __builtin_amdgcn_s_barrier()
#define PG8_SCHED __builtin_amdgcn_sched_barrier(0)
    Unit cur, nxt; int ui = 0;
    if (!S.next(0, cur)) return;
    f32x4 acc[2][2][4][2];
#pragma unroll
    for (int a = 0; a < 2; ++a)
#pragma unroll
        for (int b = 0; b < 2; ++b)
#pragma unroll
            for (int m = 0; m < 4; ++m)
#pragma unroll
                for (int n = 0; n < 2; ++n) acc[a][b][m][n] = (f32x4){0.f, 0.f, 0.f, 0.f};
    bf16x8 At[4][2], B0[2][2], B1[2][2];
    const char* cA = (const char*)g.A + (size_t)cur.pm * tstepA; const char* cB = (const char*)g.Bt + (size_t)cur.pn * tstepB;
    S.a_ready(cur);
    PG8_STAGE(PG8_SB(0, 0), cB, voffB); PG8_STAGE(PG8_SA(0, 0), cA, voffA); PG8_STAGE(PG8_SB(0, 1), cB + hstepB, voffB); PG8_STAGE(PG8_SA(0, 1), cA + hstepA, voffA);
    if (wr == 1) PG8_BAR;
    PG8_WAIT_V(4); PG8_BAR;
    PG8_STAGE(PG8_SB(1, 0), cB + kstep, voffB); PG8_STAGE(PG8_SA(1, 0), cA + kstep, voffA); PG8_STAGE(PG8_SB(1, 1), cB + hstepB + kstep, voffB);
    PG8_WAIT_V(6); PG8_BAR;
    for (;;) {
        const bool has_next = S.next(ui + 1, nxt);
        const char* nA = has_next ? (const char*)g.A + (size_t)nxt.pm * tstepA : cA; const char* nB = has_next ? (const char*)g.Bt + (size_t)nxt.pn * tstepB : cB;
        for (int t = 0; t < nt; t += 2) {
            const bool last = (t == nt - 2);
            const char* a1 = cA + (size_t)(t + 1) * kstep;
            const char* a2 = last ? nA : cA + (size_t)(t + 2) * kstep; const char* b2 = last ? nB : cB + (size_t)(t + 2) * kstep;
            const char* a3 = a2 + kstep; const char* b3 = b2 + kstep;
            if (last && has_next) S.a_ready(nxt);
            PG8_LDB(B0, 0, 0); PG8_SCHED; PG8_LDA(At, 0, 0); PG8_STAGE(PG8_SA(1, 1), a1 + hstepA, voffA);
            PG8_WAIT_L(8); PG8_BAR; PG8_WAIT_L(0); PG8_MMA(0, 0, At, B0); PG8_BAR; PG8_SCHED;
            PG8_LDB(B1, 0, 1); PG8_STAGE(PG8_SB(0, 0), b2, voffB);
            PG8_BAR; PG8_WAIT_L(0); PG8_MMA(0, 1, At, B1); PG8_BAR;
            PG8_LDA(At, 0, 1); PG8_STAGE(PG8_SA(0, 0), a2, voffA);
            PG8_BAR; PG8_WAIT_L(0); PG8_MMA(1, 0, At, B0); PG8_BAR; PG8_SCHED;
            PG8_STAGE(PG8_SB(0, 1), b2 + hstepB, voffB);
            PG8_WAIT_V(6); PG8_BAR; PG8_MMA(1, 1, At, B1); PG8_BAR;
            PG8_LDB(B0, 1, 0); PG8_SCHED; PG8_LDA(At, 1, 0); PG8_STAGE(PG8_SA(0, 1), a2 + hstepA, voffA);
            PG8_WAIT_L(8); PG8_BAR; PG8_WAIT_L(0); PG8_MMA(0, 0, At, B0); PG8_BAR; PG8_SCHED;
            PG8_LDB(B1, 1, 1); PG8_STAGE(PG8_SB(1, 0), b3, voffB);
            PG8_BAR; PG8_WAIT_L(0); PG8_MMA(0, 1, At, B1); PG8_BAR;
            PG8_LDA(At, 1, 1); PG8_STAGE(PG8_SA(1, 0), a3, voffA);
            PG8_BAR; PG8_WAIT_L(0); PG8_MMA(1, 0, At, B0); PG8_BAR; PG8_SCHED;
            PG8_STAGE(PG8_SB(1, 1), b3 + hstepB, voffB);
            PG8_WAIT_V(6); PG8_BAR; PG8_MMA(1, 1, At, B1); PG8_BAR;
        }
        E(acc, cur, wr, wc, fr, fq); S.done(cur);
        if (!has_next) break;
#pragma unroll
        for (int a = 0; a < 2; ++a)
#pragma unroll
            for (int b = 0; b < 2; ++b)
#pragma unroll
                for (int m = 0; m < 4; ++m)
#pragma unroll
                    for (int n = 0; n < 2; ++n) acc[a][b][m][n] = (f32x4){0.f, 0.f, 0.f, 0.f};
        cur = nxt; cA = nA; cB = nB; ++ui;
    }
    PG8_WAIT_V(0);
    if (wr == 0) PG8_BAR;
    PG8_BAR;
#undef PG8_SA
#undef PG8_SB
#undef PG8_STAGE
#undef PG8_LDA
#undef PG8_LDB
#undef PG8_MMA
#undef PG8_WAIT_V
#undef PG8_WAIT_L
#undef PG8_BAR
#undef PG8_SCHED
}
}

namespace att {
constexpr int NW = 8, QBLK = 32, KVBLK = 64, DV = 128;
constexpr float THR = 8.f;
constexpr int SHM_V = KVBLK * DV * 2;
#define SBAR() __builtin_amdgcn_sched_barrier(0)
__device__ __forceinline__ int crow(int r, int hi) { return (r & 3) + 8 * (r >> 2) + 4 * hi; }
__device__ __forceinline__ unsigned cvtpk(float lo, float hi) { unsigned r; asm volatile("v_cvt_pk_bf16_f32 %0, %1, %2" : "=v"(r) : "v"(lo), "v"(hi)); return r; }
__device__ __forceinline__ void partialSM(f32x16& p0, f32x16& p1, float& m_reg, float& mn, float& alpha, const float C, const float thr_raw) {
    float pmax = p0[0];
#pragma unroll
    for (int r = 1; r < 16; ++r) pmax = fmaxf(pmax, p0[r]);
#pragma unroll
    for (int r = 0; r < 16; ++r) pmax = fmaxf(pmax, p1[r]);
    { auto rr = __builtin_amdgcn_permlane32_swap(__float_as_uint(pmax), __float_as_uint(pmax), false, false);
      pmax = fmaxf(__uint_as_float(rr[0]), __uint_as_float(rr[1])); }
    if (__builtin_expect(__all(pmax - m_reg <= thr_raw), 1)) { mn = m_reg; alpha = 1.f; }
    else { mn = fmaxf(m_reg, pmax); alpha = __builtin_amdgcn_exp2f((m_reg - mn) * C); m_reg = mn; }
    const float mnC = -mn * C;
#pragma unroll
    for (int r = 0; r < 16; ++r) p0[r] = fmaf(p0[r], C, mnC);
#pragma unroll
    for (int r = 0; r < 16; ++r) p1[r] = fmaf(p1[r], C, mnC);
#pragma unroll
    for (int r = 0; r < 16; ++r) p0[r] = __builtin_amdgcn_exp2f(p0[r]);
}
__device__ __forceinline__ void finishSM(f32x16& p0, f32x16& p1, float alpha, float& l_reg, bf16x8& pa0, bf16x8& pa1, bf16x8& pa2, bf16x8& pa3) {
#pragma unroll
    for (int r = 0; r < 16; ++r) p1[r] = __builtin_amdgcn_exp2f(p1[r]);
    float ps = 0;
#pragma unroll
    for (int r = 0; r < 16; ++r) ps += p0[r];
#pragma unroll
    for (int r = 0; r < 16; ++r) ps += p1[r];
    { auto rr = __builtin_amdgcn_permlane32_swap(__float_as_uint(ps), __float_as_uint(ps), false, false);
      ps = __uint_as_float(rr[0]) + __uint_as_float(rr[1]); }
    l_reg = l_reg * alpha + ps;
#define PK4(P, BASE, OUT) do { unsigned a0 = cvtpk(P[BASE + 0], P[BASE + 1]), a1 = cvtpk(P[BASE + 2], P[BASE + 3]);   \
    unsigned b0 = cvtpk(P[BASE + 4], P[BASE + 5]), b1 = cvtpk(P[BASE + 6], P[BASE + 7]);                              \
    auto r0 = __builtin_amdgcn_permlane32_swap(a0, b0, false, false); auto r1 = __builtin_amdgcn_permlane32_swap(a1, b1, false, false); \
    u32x4 w = {r0[0], r1[0], r0[1], r1[1]}; OUT = *reinterpret_cast<bf16x8*>(&w); } while (0)
    PK4(p0, 0, pa0); PK4(p0, 8, pa1); PK4(p1, 0, pa2); PK4(p1, 8, pa3);
#undef PK4
}
template <int DQK>
__device__ __forceinline__ void qkt(f32x16& p0, f32x16& p1, const char* Ks, const bf16x8 (&qr)[DQK / 16], int r32, int hi) {
    constexpr int RS = DQK * 2;
    p0 = f32x16{}; p1 = f32x16{};
#pragma unroll
    for (int d0 = 0; d0 < DQK / 16; ++d0) { const int cb = (d0 * 16 + hi * 8) * 2;
        const bf16x8 b0 = *reinterpret_cast<const bf16x8*>(Ks + r32 * RS + (cb ^ ((r32 & 7) << 4)));
        const bf16x8 b1 = *reinterpret_cast<const bf16x8*>(Ks + (32 + r32) * RS + (cb ^ ((r32 & 7) << 4)));
        p0 = __builtin_amdgcn_mfma_f32_32x32x16_bf16(b0, qr[d0], p0, 0, 0, 0);
        p1 = __builtin_amdgcn_mfma_f32_32x32x16_bf16(b1, qr[d0], p1, 0, 0, 0); }
}
__device__ __forceinline__ int v_st(int k, int c) { const int kk = (k & ~0xC) | ((k & 4) << 1) | ((k & 8) >> 1); return ((kk >> 3) * 4 + (c >> 5)) * 512 + ((kk & 7) * 32 + (c & 31)) * 2; }
__device__ __forceinline__ int v_rd_base(int lane) { return ((lane & 3) << 3) | (((lane >> 2) & 3) << 6) | (((lane >> 4) & 1) << 5) | (((lane >> 5) & 1) << 8); }
constexpr int v_rd_off(int d0, int ks, int half) { return d0 * 512 + ks * 4096 + half * 2048; }
template <int OFF> __device__ __forceinline__ s16x4 tr_read(int vb) {
    s16x4 r; asm volatile("ds_read_b64_tr_b16 %0, %1 offset:%2" : "=&v"(r) : "v"(vb), "i"(OFF) : "memory"); return r;
}
template <int D0> __device__ __forceinline__ void pv_one(f32x16& od, int vb, bf16x8 pa0, bf16x8 pa1, bf16x8 pa2, bf16x8 pa3) {
    const s16x4 l0 = tr_read<v_rd_off(D0, 0, 0)>(vb), h0 = tr_read<v_rd_off(D0, 0, 1)>(vb), l1 = tr_read<v_rd_off(D0, 1, 0)>(vb), h1 = tr_read<v_rd_off(D0, 1, 1)>(vb);
    const s16x4 l2 = tr_read<v_rd_off(D0, 2, 0)>(vb), h2 = tr_read<v_rd_off(D0, 2, 1)>(vb), l3 = tr_read<v_rd_off(D0, 3, 0)>(vb), h3 = tr_read<v_rd_off(D0, 3, 1)>(vb);
    asm volatile("s_waitcnt lgkmcnt(0)" ::: "memory"); SBAR();
#define PK(L, H) (bf16x8){L[0], L[1], L[2], L[3], H[0], H[1], H[2], H[3]}
    od = __builtin_amdgcn_mfma_f32_32x32x16_bf16(pa0, PK(l0, h0), od, 0, 0, 0);
    od = __builtin_amdgcn_mfma_f32_32x32x16_bf16(pa1, PK(l1, h1), od, 0, 0, 0);
    od = __builtin_amdgcn_mfma_f32_32x32x16_bf16(pa2, PK(l2, h2), od, 0, 0, 0);
    od = __builtin_amdgcn_mfma_f32_32x32x16_bf16(pa3, PK(l3, h3), od, 0, 0, 0);
#undef PK
}
__device__ __forceinline__ void pv_d0(f32x16* o, int vb, bf16x8 pa0, bf16x8 pa1, bf16x8 pa2, bf16x8 pa3) {
    pv_one<0>(o[0], vb, pa0, pa1, pa2, pa3); pv_one<1>(o[1], vb, pa0, pa1, pa2, pa3); pv_one<2>(o[2], vb, pa0, pa1, pa2, pa3); pv_one<3>(o[3], vb, pa0, pa1, pa2, pa3);
}
template <int DQK> struct ScaleOf { static constexpr float scale = DQK == 192 ? 0.07216878364870322f : (DQK == 128 ? 0.08838834764831845f : 0.125f); };
template <int DQK, int SDEPTH, int ldq, int ldk, int ldv, int ldo>
__device__ __forceinline__ void attn_body(const bf16_t* __restrict__ Qb, const bf16_t* __restrict__ Kh, const bf16_t* __restrict__ Vh,
                                          float* __restrict__ Ob, int seq, char* lds) {
    constexpr float C = ScaleOf<DQK>::scale * 1.4426950408889634f, thr_raw = THR / ScaleOf<DQK>::scale;
    constexpr int SHM_K = KVBLK * DQK * 2, RS = DQK * 2, NKP = DQK / 64, KPR = DQK / 8;
    int tid_l = threadIdx.x; asm volatile("" : "+v"(tid_l));
    const int tid = tid_l, wid = tid >> 6, lane = tid & 63, r32 = lane & 31, hi = lane >> 5;
    char* V_lds = lds; char* K_lds = lds + 2 * SHM_V;
    float* ws = (float*)(lds + 2 * SHM_V + 2 * SHM_K) + wid * 64; float* li_l = ws; float* al_l = ws + 32;
    float m_reg = -1e30f, l_reg = 0; f32x16 o[4] = {}; bf16x8 qr[DQK / 16];
    const bf16_t* Qw = Qb + (size_t)(wid * QBLK + r32) * ldq + hi * 8;
#pragma unroll
    for (int d0 = 0; d0 < DQK / 16; ++d0) qr[d0] = *reinterpret_cast<const bf16x8*>(Qw + d0 * 16);
    const int sr = tid >> 4, sc = (tid & 15) * 8, vst0 = v_st(sr, sc), vst1 = v_st(32 + sr, sc);
    int koff[NKP], klds[NKP];
#pragma unroll
    for (int i = 0; i < NKP; ++i) { const int p = tid + i * 512, row = p / KPR, c8 = p % KPR; koff[i] = row * ldk + c8 * 8; klds[i] = row * RS + ((c8 * 16) ^ ((row & 7) << 4)); }
    const int vb0 = (int)(uintptr_t)V_lds + v_rd_base(lane);
    bf16x8 sv0[SDEPTH], sv1[SDEPTH], sk[SDEPTH][NKP];
#define SLOAD(i, k0) do { sv0[i] = *reinterpret_cast<const bf16x8*>(&Vh[(size_t)((k0) + sr) * ldv + sc]); sv1[i] = *reinterpret_cast<const bf16x8*>(&Vh[(size_t)((k0) + 32 + sr) * ldv + sc]); \
    _Pragma("unroll") for (int _q = 0; _q < NKP; ++_q) sk[i][_q] = *reinterpret_cast<const bf16x8*>(&Kh[(size_t)(k0) * ldk + koff[_q]]); } while (0)
#define SWRITE(b, i) do { *(bf16x8*)(V_lds + (b) * SHM_V + vst0) = sv0[i]; *(bf16x8*)(V_lds + (b) * SHM_V + vst1) = sv1[i]; \
    _Pragma("unroll") for (int _q = 0; _q < NKP; ++_q) *(bf16x8*)(K_lds + (b) * SHM_K + klds[_q]) = sk[i][_q]; } while (0)
#define SWAIT() do { if constexpr (SDEPTH == 2) { if constexpr (NKP == 1) asm volatile("s_waitcnt vmcnt(3)" ::: "memory"); else if constexpr (NKP == 2) asm volatile("s_waitcnt vmcnt(4)" ::: "memory"); else asm volatile("s_waitcnt vmcnt(5)" ::: "memory"); } \
    else asm volatile("s_waitcnt vmcnt(0)" ::: "memory"); } while (0)
#define RESC(a) do { if (__any((a) < 1.f)) { if (hi == 0) al_l[r32] = (a); asm volatile("s_waitcnt lgkmcnt(0)" ::: "memory"); \
    _Pragma("unroll") for (int d = 0; d < 4; ++d) _Pragma("unroll") for (int r = 0; r < 16; ++r) o[d][r] *= al_l[crow(r, hi)]; } } while (0)
    f32x16 pA0, pA1, pB0, pB1; float mnA, mnB, alA, alB; bf16x8 pa0, pa1, pa2, pa3; const int NT = seq / KVBLK;
    constexpr int SE = 0, SO = SDEPTH - 1;
    SLOAD(SE, 0); asm volatile("s_waitcnt vmcnt(0)" ::: "memory"); SWRITE(0, SE); __syncthreads();
    qkt<DQK>(pA0, pA1, K_lds, qr, r32, hi); partialSM(pA0, pA1, m_reg, mnA, alA, C, thr_raw);
    SLOAD(SO, KVBLK); if constexpr (SDEPTH == 2) { if (2 < NT) SLOAD(SE, 2 * KVBLK); }
    SWAIT(); SWRITE(1, SO); __syncthreads();
    for (int j = 1; j + 1 < NT; j += 2) {
        SBAR(); qkt<DQK>(pB0, pB1, K_lds + SHM_K, qr, r32, hi);
        finishSM(pA0, pA1, alA, l_reg, pa0, pa1, pa2, pa3); SBAR();
        SLOAD(SO, (j + SDEPTH) * KVBLK); SBAR();
        pv_d0(o, vb0, pa0, pa1, pa2, pa3); partialSM(pB0, pB1, m_reg, mnB, alB, C, thr_raw);
        __syncthreads(); SWAIT(); SWRITE(0, SE);
        RESC(alB); __syncthreads();
        SBAR(); qkt<DQK>(pA0, pA1, K_lds, qr, r32, hi);
        finishSM(pB0, pB1, alB, l_reg, pa0, pa1, pa2, pa3); SBAR();
        if (SDEPTH == 1 || j + 3 < NT) SLOAD(SE, (j + 1 + SDEPTH) * KVBLK); SBAR();
        pv_d0(o, vb0 + SHM_V, pa0, pa1, pa2, pa3); partialSM(pA0, pA1, m_reg, mnA, alA, C, thr_raw);
        __syncthreads(); SWAIT(); SWRITE(1, SO);
        RESC(alA); __syncthreads();
    }
    SBAR(); qkt<DQK>(pB0, pB1, K_lds + SHM_K, qr, r32, hi);
    finishSM(pA0, pA1, alA, l_reg, pa0, pa1, pa2, pa3); SBAR();
    pv_d0(o, vb0, pa0, pa1, pa2, pa3); partialSM(pB0, pB1, m_reg, mnB, alB, C, thr_raw);
    __syncthreads(); RESC(alB);
    finishSM(pB0, pB1, alB, l_reg, pa0, pa1, pa2, pa3); SBAR();
    pv_d0(o, vb0 + SHM_V, pa0, pa1, pa2, pa3);
    if (hi == 0) li_l[r32] = l_reg; asm volatile("s_waitcnt lgkmcnt(0)" ::: "memory");
    float rli[16];
#pragma unroll
    for (int r = 0; r < 16; ++r) rli[r] = __builtin_amdgcn_rcpf(li_l[crow(r, hi)]);
    float* Ow = Ob + (size_t)(wid * QBLK) * ldo;
#pragma unroll
    for (int r = 0; r < 16; ++r) { const int orow = crow(r, hi);
#pragma unroll
        for (int d0 = 0; d0 < 4; ++d0) Ow[(size_t)orow * ldo + d0 * 32 + r32] = o[d0][r] * rli[r]; }
    __syncthreads();
#undef SLOAD
#undef SWRITE
#undef SWAIT
#undef RESC
}
template <int DQK, int QL, int ldq, int ldk, int ldv, int ldo>
__device__ __forceinline__ void attn_body_simple(const bf16_t* __restrict__ Qb, const bf16_t* __restrict__ Kh, const bf16_t* __restrict__ Vh,
                                                 float* __restrict__ Ob, int seq, char* lds) {
    constexpr float C = ScaleOf<DQK>::scale * 1.4426950408889634f, thr_raw = THR / ScaleOf<DQK>::scale;
    constexpr int SHM_K = KVBLK * DQK * 2, RS = DQK * 2, NKP = DQK / 64, KPR = DQK / 8;
    int tid_l = threadIdx.x; asm volatile("" : "+v"(tid_l));
    const int tid = tid_l, wid = tid >> 6, lane = tid & 63, r32 = lane & 31, hi = lane >> 5;
    char* V_lds = lds; char* K_lds = lds + 2 * SHM_V;
    float* ws = (float*)(lds + 2 * SHM_V + 2 * SHM_K) + wid * 64; float* li_l = ws; float* al_l = ws + 32;
    constexpr int NQR = DQK / 16 - QL;
    char* qpark = lds + 2 * SHM_V + 2 * SHM_K + 2048 + wid * (QL * 1024) + lane * 16;
    float m_reg = -1e30f, l_reg = 0; f32x16 o[4] = {}; bf16x8 qr[NQR];
    const bf16_t* Qw = Qb + (size_t)(wid * QBLK + r32) * ldq + hi * 8;
#pragma unroll
    for (int d0 = 0; d0 < NQR; ++d0) qr[d0] = *reinterpret_cast<const bf16x8*>(Qw + d0 * 16);
#pragma unroll
    for (int d0 = 0; d0 < QL; ++d0) *(bf16x8*)(qpark + d0 * 1024) = *reinterpret_cast<const bf16x8*>(Qw + (NQR + d0) * 16);
    const int sr = tid >> 4, sc = (tid & 15) * 8, vst0 = v_st(sr, sc), vst1 = v_st(32 + sr, sc);
    int koff[NKP], klds[NKP];
#pragma unroll
    for (int i = 0; i < NKP; ++i) { const int p = tid + i * 512, row = p / KPR, c8 = p % KPR; koff[i] = row * ldk + c8 * 8; klds[i] = row * RS + ((c8 * 16) ^ ((row & 7) << 4)); }
    const int vb0 = (int)(uintptr_t)V_lds + v_rd_base(lane);
    bf16x8 sv0, sv1, sk[NKP];
#define SLOAD(k0) do { sv0 = *reinterpret_cast<const bf16x8*>(&Vh[(size_t)((k0) + sr) * ldv + sc]); sv1 = *reinterpret_cast<const bf16x8*>(&Vh[(size_t)((k0) + 32 + sr) * ldv + sc]); \
    _Pragma("unroll") for (int _q = 0; _q < NKP; ++_q) sk[_q] = *reinterpret_cast<const bf16x8*>(&Kh[(size_t)(k0) * ldk + koff[_q]]); } while (0)
#define SWRITE(b) do { *(bf16x8*)(V_lds + (b) * SHM_V + vst0) = sv0; *(bf16x8*)(V_lds + (b) * SHM_V + vst1) = sv1; \
    _Pragma("unroll") for (int _q = 0; _q < NKP; ++_q) *(bf16x8*)(K_lds + (b) * SHM_K + klds[_q]) = sk[_q]; } while (0)
#define RESC(a) do { if (__any((a) < 1.f)) { if (hi == 0) al_l[r32] = (a); asm volatile("s_waitcnt lgkmcnt(0)" ::: "memory"); \
    _Pragma("unroll") for (int d = 0; d < 4; ++d) _Pragma("unroll") for (int r = 0; r < 16; ++r) o[d][r] *= al_l[crow(r, hi)]; } } while (0)
    const int NT = seq / KVBLK;
    SLOAD(0); asm volatile("s_waitcnt vmcnt(0)" ::: "memory"); SWRITE(0); __syncthreads();
    for (int j = 0; j < NT; ++j) {
        const int b = j & 1;
        if (j + 1 < NT) SLOAD((j + 1) * KVBLK);
        SBAR();
        f32x16 p0, p1; float mn, al; bf16x8 pa0, pa1, pa2, pa3;
        { const char* Ks = K_lds + b * SHM_K; p0 = f32x16{}; p1 = f32x16{};
#pragma unroll
          for (int d0 = 0; d0 < DQK / 16; ++d0) { const int cb = (d0 * 16 + hi * 8) * 2;
              const bf16x8 b0 = *reinterpret_cast<const bf16x8*>(Ks + r32 * RS + (cb ^ ((r32 & 7) << 4)));
              const bf16x8 b1 = *reinterpret_cast<const bf16x8*>(Ks + (32 + r32) * RS + (cb ^ ((r32 & 7) << 4)));
              bf16x8 qf; if (d0 < NQR) qf = qr[d0 < NQR ? d0 : 0]; else qf = *(const bf16x8*)(qpark + (d0 - NQR) * 1024);
              p0 = __builtin_amdgcn_mfma_f32_32x32x16_bf16(b0, qf, p0, 0, 0, 0);
              p1 = __builtin_amdgcn_mfma_f32_32x32x16_bf16(b1, qf, p1, 0, 0, 0); } }
        partialSM(p0, p1, m_reg, mn, al, C, thr_raw);
        RESC(al);
        finishSM(p0, p1, al, l_reg, pa0, pa1, pa2, pa3); SBAR();
        pv_d0(o, vb0 + b * SHM_V, pa0, pa1, pa2, pa3);
        if (j + 1 < NT) { asm volatile("s_waitcnt vmcnt(0)" ::: "memory"); SWRITE(b ^ 1); }
        __syncthreads();
    }
    if (hi == 0) li_l[r32] = l_reg; asm volatile("s_waitcnt lgkmcnt(0)" ::: "memory");
    float rli[16];
#pragma unroll
    for (int r = 0; r < 16; ++r) rli[r] = __builtin_amdgcn_rcpf(li_l[crow(r, hi)]);
    float* Ow = Ob + (size_t)(wid * QBLK) * ldo;
#pragma unroll
    for (int r = 0; r < 16; ++r) { const int orow = crow(r, hi);
#pragma unroll
        for (int d0 = 0; d0 < 4; ++d0) Ow[(size_t)orow * ldo + d0 * 32 + r32] = o[d0][r] * rli[r]; }
    __syncthreads();
#undef SLOAD
#undef SWRITE
#undef RESC
}
}

struct Params {
    const float* x; const float* c; const float* ctx; const float* c_ctx; const float* w_mod; const float* b_mod; const float* g_norm1; const float* g_norm2;
    const float* w_in_ab; const float* g_cq; const float* w_uq; const float* g_ckv; const float* w_ukv; const float* g_qn_a; const float* g_kn_a; const float* lam_vec;
    const float* g_qn_b; const float* g_kn_b; const float* g_sub_b; const float* w_out_ab; const float* w_in_c; const float* g_qn_c; const float* g_kn_c; const float* w_out_c;
    const float* w_pq; const float* sub_keys; const float* expert_u; const float* expert_v;
    float* out; unsigned char* ws; int ph_lo, ph_hi;
};

typedef const __attribute__((address_space(4))) Params CParams;
struct Ctx {
    int tid, lane, wid, G, vcu, bx;
    unsigned char* ws; char* lds;
};

__device__ __forceinline__ void tconv(const Ctx& F, const float* src, bf16_t* dst, const float* gain, int nmat, int K, int N, int Npad) {
    float* tile = (float*)(F.lds + 32768);
    const int ntn = Npad / 64, ntk = K / 64, per = ntn * ntk, total = per * nmat;
    for (int it = F.vcu; it < total; it += F.G) {
        const int mat = it / per, rem = it % per, tn = rem / ntk, tk = rem % ntk, k0 = tk * 64, n0 = tn * 64;
        const float* s = src + (size_t)mat * K * N; bf16_t* d = dst + (size_t)mat * Npad * K;
        __syncthreads();
        { const int r = F.tid >> 4, c4 = (F.tid & 15) * 4;
#pragma unroll
          for (int i = 0; i < 2; ++i) { const int rr = r + i * 32; f32x4 v = (f32x4){0.f, 0.f, 0.f, 0.f};
              if (n0 + c4 < N) v = *(const f32x4*)(s + (size_t)(k0 + rr) * N + n0 + c4);
              tile[rr * 65 + c4 + 0] = v[0]; tile[rr * 65 + c4 + 1] = v[1]; tile[rr * 65 + c4 + 2] = v[2]; tile[rr * 65 + c4 + 3] = v[3]; } }
        __syncthreads();
        { const int n = F.tid >> 3, kc = (F.tid & 7) * 8; float v[8];
#pragma unroll
          for (int e = 0; e < 8; ++e) { v[e] = tile[(kc + e) * 65 + n]; if (gain) v[e] *= gain[(size_t)mat * K + k0 + kc + e]; }
          u32x4 w; w.x = cvt_pk_bf16(v[0], v[1]); w.y = cvt_pk_bf16(v[2], v[3]); w.z = cvt_pk_bf16(v[4], v[5]); w.w = cvt_pk_bf16(v[6], v[7]);
          *(u32x4*)(d + (size_t)(n0 + n) * K + k0 + kc) = w; }
    }
}
__device__ __forceinline__ void cvt_flat(const Ctx& F, const float* src, bf16_t* dst, size_t n8) {
    for (size_t i = (size_t)F.vcu * 512 + F.tid; i < n8; i += (size_t)F.G * 512) {
        const f32x4 a = *(const f32x4*)(src + i * 8), b = *(const f32x4*)(src + i * 8 + 4);
        u32x4 w; w.x = cvt_pk_bf16(a[0], a[1]); w.y = cvt_pk_bf16(a[2], a[3]); w.z = cvt_pk_bf16(b[0], b[1]); w.w = cvt_pk_bf16(b[2], b[3]);
        *(u32x4*)(dst + i * 8) = w;
    }
}
__device__ __forceinline__ void cvt_rows_fp8(const Ctx& F, const float* src, unsigned char* dst, float* descale, int R) {
    for (int row = F.vcu * 8 + F.wid; row < R; row += F.G * 8) {
        const float* s = src + (size_t)row * DM; f32x4 v[8]; float am = 0.f;
#pragma unroll
        for (int j = 0; j < 2; ++j)
#pragma unroll
            for (int i = 0; i < 4; ++i) { v[j * 4 + i] = *(const f32x4*)(s + j * 1024 + F.lane * 16 + i * 4);
#pragma unroll
                for (int e = 0; e < 4; ++e) am = fmaxf(am, fabsf(v[j * 4 + i][e])); }
#pragma unroll
        for (int o = 32; o >= 1; o >>= 1) am = fmaxf(am, __shfl_xor(am, o));
        const float sc = am > 0.f ? 384.f / am : 1.f;
#pragma unroll
        for (int j = 0; j < 2; ++j) { u32x4 w;
#pragma unroll
            for (int i = 0; i < 4; ++i) { const f32x4 x = v[j * 4 + i] * sc; unsigned p = __builtin_amdgcn_cvt_pk_fp8_f32(x[0], x[1], 0u, false); p = __builtin_amdgcn_cvt_pk_fp8_f32(x[2], x[3], p, true); w[i] = p; }
            *(u32x4*)(dst + (size_t)row * DM + j * 1024 + F.lane * 16) = w; }
        if (F.lane == 0) descale[row] = am > 0.f ? am * (1.f / 384.f) : 1.f;
    }
}
__device__ __forceinline__ float silu_f(float v) { return v / (1.f + __expf(-v)); }

__device__ __forceinline__ void prologue_phase(const Ctx& F, CParams& P) {
    unsigned char* ws = F.ws;
    {
        float* sv = (float*)F.lds;
        float* part = (float*)(F.lds + 24576);
        for (int i = F.tid; i < 3 * DM; i += 512) { const int v = i / DM, k = i % DM; const float cv = v < 2 ? P.c[v * DM + k] : P.c_ctx[k]; sv[i] = silu_f(cv); }
        __syncthreads();
        float* mod = (float*)(ws + WS_MOD);
        for (int it = F.vcu; it < DEPTH * 192; it += F.G) {
            const int l = it / 192, n0 = (it % 192) * 64;
            const float* wp = P.w_mod + ((size_t)l * DM + F.wid * 256) * 12288 + n0 + F.lane;
            float a0 = 0.f, a1 = 0.f, a2 = 0.f;
#pragma unroll 8
            for (int k = 0; k < 256; ++k) { const float w = wp[(size_t)k * 12288]; const int kk = F.wid * 256 + k; a0 += sv[kk] * w; a1 += sv[DM + kk] * w; a2 += sv[2 * DM + kk] * w; }
            part[(F.wid * 3 + 0) * 64 + F.lane] = a0; part[(F.wid * 3 + 1) * 64 + F.lane] = a1; part[(F.wid * 3 + 2) * 64 + F.lane] = a2;
            __syncthreads();
            if (F.wid < 3) { float s = 0.f;
#pragma unroll
                for (int w = 0; w < 8; ++w) s += part[(w * 3 + F.wid) * 64 + F.lane];
                mod[((size_t)l * 3 + F.wid) * 12288 + n0 + F.lane] = s + P.b_mod[(size_t)l * 12288 + n0 + F.lane]; }
            __syncthreads();
        }
    }
    if (F.vcu == 0) {
        float* t16 = (float*)(ws + WS_TAB16); float* t32 = (float*)(ws + WS_TAB32);
        for (int i = F.tid; i < 128 * 16; i += 512) { const int pos = i >> 4, f = i & 15; const float fr = powf(10000.f, -(float)f / 16.f); const float a = (float)pos * fr; float s, c; sincosf(a, &s, &c); t16[i * 2] = c; t16[i * 2 + 1] = s; }
        for (int i = F.tid; i < 128 * 32; i += 512) { const int pos = i >> 5, f = i & 31; const float fr = powf(10000.f, -(float)f / 32.f); const float a = (float)pos * fr; float s, c; sincosf(a, &s, &c); t32[i * 2] = c; t32[i * 2 + 1] = s; }
        if (F.wid < 2) { const float* lv = P.lam_vec + F.wid * 256; const float d1 = wave_sum(lv[F.lane] * lv[64 + F.lane]), d2 = wave_sum(lv[128 + F.lane] * lv[192 + F.lane]);
            const float lam_init = 0.8f - 0.6f * expf(-0.3f * (float)(2 * F.wid));
            if (F.lane == 0) ((float*)(ws + WS_LAM))[F.wid] = expf(d1) - expf(d2) + lam_init; }
    }
    tconv(F, P.w_in_ab, (bf16_t*)(ws + WS_WINAB), nullptr, 2, DM, AB_IN, AB_INP);
    tconv(F, P.w_uq, (bf16_t*)(ws + WS_WUQ), P.g_cq, 2, 768, 1536, 1536);
    tconv(F, P.w_ukv, (bf16_t*)(ws + WS_WUKV), P.g_ckv, 2, 512, 2048, 2048);
    tconv(F, P.w_out_ab, (bf16_t*)(ws + WS_WOUTAB), nullptr, 2, DM, DM, DM);
    tconv(F, P.w_in_c, (bf16_t*)(ws + WS_WINC), nullptr, 2, DM, C_IN, C_IN);
    tconv(F, P.w_out_c, (bf16_t*)(ws + WS_WOUTC), nullptr, 2, DM, DM, DM);
    tconv(F, P.w_pq, (bf16_t*)(ws + WS_WPQ), nullptr, 4, DM, DM, DM);
    cvt_flat(F, P.sub_keys, (bf16_t*)(ws + WS_SUBK), (size_t)4 * 8 * 2 * 128 * 128 / 8);
    cvt_rows_fp8(F, P.expert_u, ws + WS_EU, (float*)(ws + WS_SU), 4 * NEXP);
    cvt_rows_fp8(F, P.expert_v, ws + WS_EV, (float*)(ws + WS_SV), 4 * NEXP);
}

__device__ __forceinline__ void norm_phase(const Ctx& F, CParams& P, int layer, int which  , int m_rows) {
    float* X = (float*)(F.ws + WS_X); bf16_t* H = (bf16_t*)(F.ws + WS_H);
    const float* mod = (const float*)(F.ws + WS_MOD) + (size_t)layer * 3 * 12288;
    const float* gn = (which ? P.g_norm2 : P.g_norm1) + (size_t)layer * DM;
    const bool from_in = (layer == 0 && which == 0);
    for (int t = F.vcu * 8 + F.wid; t < m_rows; t += F.G * 8) {
        const int vs = vsel_of_row(t);
        const float* src = from_in ? (t < TL ? P.x + (size_t)t * DM : P.ctx + (size_t)(t - TL) * DM) : X + (size_t)t * DM;
        const float* shf = mod + (size_t)vs * 12288 + (which ? 3 : 0) * DM; const float* scl = shf + DM;
        f32x4 v[8]; float ss = 0.f;
#pragma unroll
        for (int j = 0; j < 8; ++j) { v[j] = *(const f32x4*)(src + j * 256 + F.lane * 4); ss += v[j][0] * v[j][0] + v[j][1] * v[j][1] + v[j][2] * v[j][2] + v[j][3] * v[j][3]; }
        ss = wave_sum(ss);
        const float rstd = rsqrtf(ss * (1.f / DM) + EPS);
#pragma unroll
        for (int j = 0; j < 8; ++j) { const int c = j * 256 + F.lane * 4;
            if (from_in) *(f32x4*)(X + (size_t)t * DM + c) = v[j];
            const f32x4 g = *(const f32x4*)(gn + c), sc = *(const f32x4*)(scl + c), sh = *(const f32x4*)(shf + c);
            f32x4 y;
#pragma unroll
            for (int e = 0; e < 4; ++e) y[e] = (v[j][e] * rstd * g[e]) * (1.f + sc[e]) + sh[e];
            u32x2 w; w.x = cvt_pk_bf16(y[0], y[1]); w.y = cvt_pk_bf16(y[2], y[3]);
            *(u32x2*)(H + (size_t)t * DM + c) = w; }
    }
}

__device__ __forceinline__ void rope16(float& x0, float& x1, int l2, int row, int col, const float* t16) {
    const int o = 2 * l2, seg = o >> 5, i = o & 31, f = i & 15, pos = seg ? col : row; const bool first = i < 16;
    const float p0 = __shfl_xor(x0, 8), p1 = __shfl_xor(x1, 8);
    const f32x4 cs = *(const f32x4*)(t16 + (pos * 16 + f) * 2);
    if (first) { x0 = x0 * cs[0] - p0 * cs[1]; x1 = x1 * cs[2] - p1 * cs[3]; }
    else       { x0 = p0 * cs[1] + x0 * cs[0]; x1 = p1 * cs[3] + x1 * cs[2]; }
}
__device__ __forceinline__ void rope32(float& x0, float& x1, int l2, int pos, const float* t32) {
    const int i = 2 * l2, f = i & 31; const bool first = i < 32;
    const float p0 = __shfl_xor(x0, 16), p1 = __shfl_xor(x1, 16);
    const f32x4 cs = *(const f32x4*)(t32 + (pos * 32 + f) * 2);
    if (first) { x0 = x0 * cs[0] - p0 * cs[1]; x1 = x1 * cs[2] - p1 * cs[3]; }
    else       { x0 = p0 * cs[1] + x0 * cs[0]; x1 = p1 * cs[3] + x1 * cs[2]; }
}
__device__ __forceinline__ void ldpair(const bf16_t* p, float& a, float& b) { const unsigned w = *(const unsigned*)p; a = bf_lo(w); b = bf_hi(w); }
__device__ __forceinline__ void stpair(bf16_t* p, float a, float b) { *(unsigned*)p = cvt_pk_bf16(a, b); }

__device__ __forceinline__ void qkv_even_phase(const Ctx& F, CParams& P, int e) {
    const bf16_t* P1 = (const bf16_t*)(F.ws + WS_P1); const bf16_t* QA = (const bf16_t*)(F.ws + WS_QA); const bf16_t* KV = (const bf16_t*)(F.ws + WS_KV);
    bf16_t* Qm = (bf16_t*)(F.ws + WS_Q1); bf16_t* Km = (bf16_t*)(F.ws + WS_K1); bf16_t* Vm = (bf16_t*)(F.ws + WS_V1);
    bf16_t* Qd = (bf16_t*)(F.ws + WS_Q2); bf16_t* Kd = (bf16_t*)(F.ws + WS_K2); bf16_t* Vd = (bf16_t*)(F.ws + WS_V2);
    const float* t16 = (const float*)(F.ws + WS_TAB16);
    const float* gqa = P.g_qn_a + e * 192; const float* gka = P.g_kn_a + e * 192; const float* gqb = P.g_qn_b + e * 64; const float* gkb = P.g_kn_b + e * 64;
    const int l2 = F.lane & 31, hw = F.lane >> 5;
    for (int t = F.vcu * 8 + F.wid; t < TT; t += F.G * 8) {
        const bool latent = t < TL; const int s = t & (SEQ - 1), row = s >> 6, col = s & 63; const int kr = krow_of(t);
        const bf16_t* p1 = P1 + (size_t)t * AB_INP;
        float ss = 0.f;
#pragma unroll
        for (int j = 0; j < 3; ++j) { const u32x2 w = *(const u32x2*)(p1 + j * 256 + F.lane * 4); const float a = bf_lo(w.x), b = bf_hi(w.x), c = bf_lo(w.y), d = bf_hi(w.y); ss += a * a + b * b + c * c + d * d; }
        ss = wave_sum(ss); const float rstd_q = rsqrtf(ss * (1.f / 768.f) + EPS);
        float s2 = 0.f;
        { const u32x4 w = *(const u32x4*)(p1 + 768 + F.lane * 8);
#pragma unroll
          for (int q = 0; q < 4; ++q) { const float a = bf_lo(w[q]), b = bf_hi(w[q]); s2 += a * a + b * b; } }
        s2 = wave_sum(s2); const float rstd_kv = rsqrtf(s2 * (1.f / 512.f) + EPS);
#pragma unroll 1
        for (int it = 0; it < 4; ++it) { const int h = it * 2 + hw; const bf16_t* src = QA + (size_t)t * 1536 + h * 192 + 2 * l2;
            float x[3][2]; float sq = 0.f;
#pragma unroll
            for (int c = 0; c < 3; ++c) { ldpair(src + c * 64, x[c][0], x[c][1]); x[c][0] *= rstd_q; x[c][1] *= rstd_q; sq += x[c][0] * x[c][0] + x[c][1] * x[c][1]; }
            sq = hw_sum(sq); const float r = rsqrtf(sq * (1.f / 192.f) + EPS);
#pragma unroll
            for (int c = 0; c < 3; ++c) { x[c][0] *= r * gqa[c * 64 + 2 * l2]; x[c][1] *= r * gqa[c * 64 + 2 * l2 + 1]; }
            if (latent) rope16(x[2][0], x[2][1], l2, row, col, t16);
            bf16_t* dst = Qm + ((size_t)t * 8 + h) * 192 + 2 * l2;
#pragma unroll
            for (int c = 0; c < 3; ++c) stpair(dst + c * 64, x[c][0], x[c][1]); }
#pragma unroll 1
        for (int it = 0; it < 4; ++it) { const int h = it * 2 + hw; const bf16_t* src = KV + (size_t)t * 2048 + h * 256 + 2 * l2;
            float x[3][2]; float sq = 0.f;
#pragma unroll
            for (int c = 0; c < 2; ++c) { ldpair(src + c * 64, x[c][0], x[c][1]); x[c][0] *= rstd_kv; x[c][1] *= rstd_kv; }
            ldpair(p1 + 1280 + 2 * l2, x[2][0], x[2][1]);
#pragma unroll
            for (int c = 0; c < 3; ++c) sq += x[c][0] * x[c][0] + x[c][1] * x[c][1];
            sq = hw_sum(sq); const float r = rsqrtf(sq * (1.f / 192.f) + EPS);
#pragma unroll
            for (int c = 0; c < 3; ++c) { x[c][0] *= r * gka[c * 64 + 2 * l2]; x[c][1] *= r * gka[c * 64 + 2 * l2 + 1]; }
            if (latent) rope16(x[2][0], x[2][1], l2, row, col, t16);
            bf16_t* dst = Km + ((size_t)kr * 8 + h) * 192 + 2 * l2;
#pragma unroll
            for (int c = 0; c < 3; ++c) stpair(dst + c * 64, x[c][0], x[c][1]);
            bf16_t* dv = Vm + ((size_t)kr * 8 + h) * 128 + 2 * l2;
#pragma unroll
            for (int c = 0; c < 2; ++c) { float a, b; ldpair(src + 128 + c * 64, a, b); stpair(dv + c * 64, a * rstd_kv, b * rstd_kv); } }
#pragma unroll 1
        for (int it = 0; it < 8; ++it) { const int hm = it * 2 + hw;
            float a, b; ldpair(p1 + 1344 + hm * 64 + 2 * l2, a, b);
            float sq = hw_sum(a * a + b * b); float r = rsqrtf(sq * (1.f / 64.f) + EPS);
            a *= r * gqb[2 * l2]; b *= r * gqb[2 * l2 + 1];
            if (latent) rope16(a, b, l2, row, col, t16);
            stpair(Qd + ((size_t)t * 16 + hm) * 64 + 2 * l2, a, b);
            ldpair(p1 + 2368 + hm * 64 + 2 * l2, a, b);
            sq = hw_sum(a * a + b * b); r = rsqrtf(sq * (1.f / 64.f) + EPS);
            a *= r * gkb[2 * l2]; b *= r * gkb[2 * l2 + 1];
            if (latent) rope16(a, b, l2, row, col, t16);
            stpair(Kd + ((size_t)kr * 16 + hm) * 64 + 2 * l2, a, b); }
#pragma unroll
        for (int j = 0; j < 2; ++j) *(u32x4*)(Vd + (size_t)kr * 1024 + j * 512 + F.lane * 8) = *(const u32x4*)(p1 + 3392 + j * 512 + F.lane * 8);
    }
}
__device__ __forceinline__ void qkv_odd_phase(const Ctx& F, CParams& P, int e) {
    const bf16_t* P1 = (const bf16_t*)(F.ws + WS_P1);
    bf16_t* Qc = (bf16_t*)(F.ws + WS_Q1); bf16_t* Kc = (bf16_t*)(F.ws + WS_K1); bf16_t* Vc = (bf16_t*)(F.ws + WS_V1);
    const float* t32 = (const float*)(F.ws + WS_TAB32);
    const float* gq = P.g_qn_c + e * 128; const float* gk = P.g_kn_c + e * 128;
    const int l2 = F.lane & 31, hw = F.lane >> 5;
    for (int t = F.vcu * 8 + F.wid; t < TT; t += F.G * 8) {
        const bool latent = t < TL; const int s = t & (SEQ - 1), row = s >> 6, col = s & 63; const int kr = krow_of(t);
        const bf16_t* p1 = P1 + (size_t)t * C_IN;
#pragma unroll 1
        for (int it = 0; it < 10; ++it) {
            const bool isq = it < 8; const int h = (isq ? it : it - 8) * 2 + hw;
            const bf16_t* src = p1 + (isq ? 0 : 2048) + h * 128 + 2 * l2; const float* g = isq ? gq : gk;
            float x[2][2]; float sq = 0.f;
#pragma unroll
            for (int c = 0; c < 2; ++c) { ldpair(src + c * 64, x[c][0], x[c][1]); sq += x[c][0] * x[c][0] + x[c][1] * x[c][1]; }
            sq = hw_sum(sq); const float r = rsqrtf(sq * (1.f / 128.f) + EPS);
#pragma unroll
            for (int c = 0; c < 2; ++c) { x[c][0] *= r * g[c * 64 + 2 * l2]; x[c][1] *= r * g[c * 64 + 2 * l2 + 1]; }
            if (latent) { rope32(x[0][0], x[0][1], l2, row, t32); rope32(x[1][0], x[1][1], l2, col, t32); }
            bf16_t* dst = isq ? Qc + ((size_t)t * 16 + h) * 128 + 2 * l2 : Kc + ((size_t)kr * 4 + h) * 128 + 2 * l2;
#pragma unroll
            for (int c = 0; c < 2; ++c) stpair(dst + c * 64, x[c][0], x[c][1]); }
        *(u32x4*)(Vc + (size_t)kr * 512 + F.lane * 8) = *(const u32x4*)(p1 + 2560 + F.lane * 8);
    }
}

template <int DQK, int SDEPTH, int ldo, int NH, int NKVH, int NVH>
__device__ __forceinline__ void attn_phase(const Ctx& F, const bf16_t* Qbuf, const bf16_t* Kbuf, const bf16_t* Vbuf, float* OF, int ocol0, bool with_ctx) {
    constexpr int kv_div = NH / NKVH, v_div = NH / NVH;
    const int n_lat = NH * NB * 32, n_tot = n_lat + (with_ctx ? NH * NB : 0);
    constexpr int ldq = NH * DQK, ldk = NKVH * DQK, ldv = NVH * 128;
    for (int u = F.vcu; u < n_tot; u += F.G) {
        int b, h, qrow0, kstart, seq;
        if (u < n_lat) { const int bh = u >> 5, qb = u & 31; b = bh / NH; h = bh % NH; qrow0 = b * SEQ + qb * 256; kstart = b * KPB; seq = KPB; }
        else { const int bh = u - n_lat; b = bh / NH; h = bh % NH; qrow0 = TL + b * CTXL; kstart = b * KPB + SEQ; seq = CTXL; }
        const bf16_t* Qp = Qbuf + ((size_t)qrow0 * NH + h) * DQK;
        const bf16_t* Kp = Kbuf + ((size_t)kstart * NKVH + h / kv_div) * DQK;
        const bf16_t* Vp = Vbuf + ((size_t)kstart * NVH + h / v_div) * 128;
        float* Op = OF + (size_t)qrow0 * ldo + ocol0 + h * 128;
        if constexpr (SDEPTH == 0) att::attn_body_simple<DQK, (DQK == 192 ? MLA_QL : 0), ldq, ldk, ldv, ldo>(Qp, Kp, Vp, Op, seq, F.lds);
        else att::attn_body<DQK, SDEPTH, ldq, ldk, ldv, ldo>(Qp, Kp, Vp, Op, seq, F.lds);
    }
}

__device__ __forceinline__ void merge_even_phase(const Ctx& F, CParams& P, int e, int layer, int m_rows) {
    const float* OF = (const float*)(F.ws + WS_OF); bf16_t* AO = (bf16_t*)(F.ws + WS_AO);
    const float lam = ((const float*)(F.ws + WS_LAM))[e];
    const float lam_init = 0.8f - 0.6f * expf(-0.3f * (float)layer);
    const float* gs = P.g_sub_b + e * 128;
    const int l2 = F.lane & 31, hw = F.lane >> 5;
    for (int t = F.vcu * 8 + F.wid; t < m_rows; t += F.G * 8) {
        const float* of = OF + (size_t)t * 3072; bf16_t* ao = AO + (size_t)t * DM;
#pragma unroll
        for (int j = 0; j < 4; ++j) { const f32x4 v = *(const f32x4*)(of + j * 256 + F.lane * 4); u32x2 w; w.x = cvt_pk_bf16(v[0], v[1]); w.y = cvt_pk_bf16(v[2], v[3]); *(u32x2*)(ao + j * 256 + F.lane * 4) = w; }
#pragma unroll
        for (int it = 0; it < 4; ++it) { const int h = it * 2 + hw;
            const f32x4 o0 = *(const f32x4*)(of + 1024 + (2 * h) * 128 + l2 * 4), o1 = *(const f32x4*)(of + 1024 + (2 * h + 1) * 128 + l2 * 4);
            f32x4 d = o0 - lam * o1;
            float sq = hw_sum(d[0] * d[0] + d[1] * d[1] + d[2] * d[2] + d[3] * d[3]);
            const float r = rsqrtf(sq * (1.f / 128.f) + EPS) * (1.f - lam_init);
            const f32x4 g = *(const f32x4*)(gs + l2 * 4);
            u32x2 w; w.x = cvt_pk_bf16(d[0] * r * g[0], d[1] * r * g[1]); w.y = cvt_pk_bf16(d[2] * r * g[2], d[3] * r * g[3]);
            *(u32x2*)(ao + 1024 + h * 128 + l2 * 4) = w; }
    }
}
__device__ __forceinline__ void merge_odd_phase(const Ctx& F, int m_rows) {
    const float* OF = (const float*)(F.ws + WS_OF); bf16_t* AO = (bf16_t*)(F.ws + WS_AO);
    for (int t = F.vcu * 8 + F.wid; t < m_rows; t += F.G * 8) {
        const float* of = OF + (size_t)t * 2048; bf16_t* ao = AO + (size_t)t * DM;
#pragma unroll
        for (int j = 0; j < 8; ++j) { const f32x4 v = *(const f32x4*)(of + j * 256 + F.lane * 4); u32x2 w; w.x = cvt_pk_bf16(v[0], v[1]); w.y = cvt_pk_bf16(v[2], v[3]); *(u32x2*)(ao + j * 256 + F.lane * 4) = w; }
    }
}

__device__ __forceinline__ unsigned fkey(float f) { const unsigned b = __float_as_uint(f); return b ^ ((unsigned)((int)b >> 31) | 0x80000000u); }
template <int S> __device__ __forceinline__ unsigned kth16(const unsigned (&key)[S]) {
    unsigned lo = 0u, hi = 0xFFFFFFFFu;
    while (lo < hi) {
        const unsigned mid = lo + ((hi - lo) >> 1) + 1u;
        int c = 0;
#pragma unroll
        for (int s = 0; s < S; ++s) c += __popcll(__ballot(key[s] >= mid));
        if (c >= 16) { lo = mid; if (c == 16) break; } else hi = mid - 1u;
    }
    return lo;
}
template <int S> __device__ __forceinline__ void top16(const float (&val)[S], const int (&idx)[S], float* outv, int* outi) {
    unsigned key[S];
#pragma unroll
    for (int s = 0; s < S; ++s) key[s] = fkey(val[s]);
    const unsigned T = kth16<S>(key);
    int cgt = 0;
#pragma unroll
    for (int s = 0; s < S; ++s) cgt += __popcll(__ballot(key[s] > T));
    const int need = 16 - cgt;
    int base = 0, eqseen = 0;
#pragma unroll
    for (int s = 0; s < S; ++s) {
        const bool gt = key[s] > T, eq = key[s] == T;
        const unsigned long long meq = __ballot(eq);
        const int eqpos = eqseen + mbcnt64(meq);
        const bool take = gt || (eq && eqpos < need);
        const unsigned long long mt = __ballot(take);
        const int pos = base + mbcnt64(mt);
        if (take && pos < 16) { outv[pos] = val[s]; outi[pos] = idx[s]; }
        base += __popcll(mt); eqseen += __popcll(meq);
    }
}
__device__ __forceinline__ void wave_lds_fence() { asm volatile("s_waitcnt lgkmcnt(0)" ::: "memory"); __builtin_amdgcn_wave_barrier(); asm volatile("" ::: "memory"); }

__device__ __forceinline__ void peer_select_phase(const Ctx& F, int layer, int m_rows) {
    const bf16_t* PQ = (const bf16_t*)(F.ws + WS_PQ); const bf16_t* SK = (const bf16_t*)(F.ws + WS_SUBK) + (size_t)layer * 8 * 2 * 128 * 128;
    int* PIDX = (int*)(F.ws + WS_PIDX); float* PG = (float*)(F.ws + WS_PG);
    float* sc = (float*)F.lds;
    float* wsv = (float*)(F.lds + 65536) + F.wid * 128;
    int* wsi = (int*)(F.lds + 65536 + 8 * 512) + F.wid * 128;
    const int r32 = F.lane & 31, hi = F.lane >> 5;
    const int nunits = (m_rows / 64) * 8;
    for (int u = F.vcu; u < nunits; u += F.G) {
        const int tile = u >> 3, h = u & 7, t0 = tile * 64;
        { const int p = F.wid >> 2, nb = F.wid & 3;
          f32x16 acc0 = {}, acc1 = {};
          const bf16_t* bp = SK + ((size_t)(h * 2 + p) * 128 + nb * 32 + r32) * 128 + hi * 8;
          const bf16_t* ap = PQ + (size_t)(t0 + r32) * DM + h * 256 + p * 128 + hi * 8;
#pragma unroll
          for (int ks = 0; ks < 8; ++ks) {
              const bf16x8 bfr = *(const bf16x8*)(bp + ks * 16);
              const bf16x8 a0 = *(const bf16x8*)(ap + ks * 16), a1 = *(const bf16x8*)(ap + (size_t)32 * DM + ks * 16);
              acc0 = __builtin_amdgcn_mfma_f32_32x32x16_bf16(a0, bfr, acc0, 0, 0, 0);
              acc1 = __builtin_amdgcn_mfma_f32_32x32x16_bf16(a1, bfr, acc1, 0, 0, 0); }
          __syncthreads();
#pragma unroll
          for (int r = 0; r < 16; ++r) { const int rowi = att::crow(r, hi); sc[rowi * 256 + p * 128 + nb * 32 + r32] = acc0[r]; sc[(32 + rowi) * 256 + p * 128 + nb * 32 + r32] = acc1[r]; }
        }
        __syncthreads();
#pragma unroll 1
        for (int tt = 0; tt < 8; ++tt) {
            const int tok = F.wid * 8 + tt; const float* srow = sc + tok * 256;
#pragma unroll
            for (int p = 0; p < 2; ++p) { float val[2]; int idx[2];
                val[0] = srow[p * 128 + F.lane]; val[1] = srow[p * 128 + 64 + F.lane]; idx[0] = F.lane; idx[1] = 64 + F.lane;
                top16<2>(val, idx, wsv + p * 16, wsi + p * 16); }
            wave_lds_fence();
            { const int i = F.lane & 15, jq = F.lane >> 4; const float a = wsv[i]; const int ia = wsi[i];
              float cv[4]; int ci[4];
#pragma unroll
              for (int c = 0; c < 4; ++c) { const int j = jq * 4 + c; cv[c] = a + wsv[16 + j]; ci[c] = ia * 128 + wsi[16 + j]; }
              top16<4>(cv, ci, wsv + 32, wsi + 32); }
            wave_lds_fence();
            { const float v = wsv[32 + (F.lane & 15)]; const int id = wsi[32 + (F.lane & 15)];
              float mx = v;
#pragma unroll
              for (int o = 8; o >= 1; o >>= 1) mx = fmaxf(mx, __shfl_xor(mx, o));
              const float ex = __expf(v - mx); float sm = ex;
#pragma unroll
              for (int o = 8; o >= 1; o >>= 1) sm += __shfl_xor(sm, o);
              if (F.lane < 16) { const size_t o = ((size_t)(t0 + tok) * 8 + h) * 16 + F.lane; PG[o] = ex / sm; PIDX[o] = id; } }
            wave_lds_fence();
        }
    }
}

__device__ __forceinline__ float gelu_tanh(float a) { const float u = 0.7978845608028654f * (a + 0.044715f * a * a * a); const float t = 1.f - 2.f / (1.f + __expf(2.f * u)); return 0.5f * a * (1.f + t); }
struct Row8 { u32x4 r[2]; };
__device__ __forceinline__ void ld_row8(Row8& R, const unsigned char* tab, int e, int lane) {
    const u32x4* rp = (const u32x4*)(tab + (size_t)e * DM);
    R.r[0] = rp[lane]; R.r[1] = rp[64 + lane];
}
__device__ __forceinline__ float dot_row8(const Row8& R, const float (&h)[32]) {
    float s0 = 0.f, s1 = 0.f, s2 = 0.f, s3 = 0.f;
#pragma unroll
    for (int j = 0; j < 2; ++j)
#pragma unroll
        for (int q = 0; q < 4; ++q) { const unsigned w = R.r[j][q]; const f32x2 lo = __builtin_amdgcn_cvt_pk_f32_fp8(w, false), hi = __builtin_amdgcn_cvt_pk_f32_fp8(w, true);
            s0 = fmaf(lo[0], h[j * 16 + q * 4 + 0], s0); s1 = fmaf(lo[1], h[j * 16 + q * 4 + 1], s1); s2 = fmaf(hi[0], h[j * 16 + q * 4 + 2], s2); s3 = fmaf(hi[1], h[j * 16 + q * 4 + 3], s3); }
    return (s0 + s1) + (s2 + s3);
}
__device__ __forceinline__ void fma_row8(float (&out)[32], const Row8& R, float w) {
#pragma unroll
    for (int j = 0; j < 2; ++j)
#pragma unroll
        for (int q = 0; q < 4; ++q) { const unsigned x = R.r[j][q]; const f32x2 lo = __builtin_amdgcn_cvt_pk_f32_fp8(x, false), hi = __builtin_amdgcn_cvt_pk_f32_fp8(x, true);
            out[j * 16 + q * 4 + 0] = fmaf(w, lo[0], out[j * 16 + q * 4 + 0]); out[j * 16 + q * 4 + 1] = fmaf(w, lo[1], out[j * 16 + q * 4 + 1]);
            out[j * 16 + q * 4 + 2] = fmaf(w, hi[0], out[j * 16 + q * 4 + 2]); out[j * 16 + q * 4 + 3] = fmaf(w, hi[1], out[j * 16 + q * 4 + 3]); }
}
__device__ __forceinline__ float reduce4(float s0, float s1, float s2, float s3, int lane) {
    const bool hi = (lane & 32) != 0, b4 = (lane & 16) != 0;
    const float r0 = __shfl_xor(hi ? s0 : s2, 32), r1 = __shfl_xor(hi ? s1 : s3, 32);
    const float a0 = (hi ? s2 : s0) + r0, a1 = (hi ? s3 : s1) + r1;
    const float r = __shfl_xor(b4 ? a0 : a1, 16);
    float b = (b4 ? a1 : a0) + r;
#pragma unroll
    for (int o = 8; o >= 1; o >>= 1) b += __shfl_xor(b, o);
    return b;
}
__device__ __forceinline__ float rl_f(float v, int l) { return __uint_as_float(__builtin_amdgcn_readlane(__float_as_uint(v), l)); }
__device__ __forceinline__ void peer_expert_phase(const Ctx& F, CParams& P, int layer, int m_rows, bool last, bool dry) {
    const unsigned char* EU = F.ws + WS_EU + (size_t)layer * NEXP * DM; const unsigned char* EV = F.ws + WS_EV + (size_t)layer * NEXP * DM;
    const float* SU = (const float*)(F.ws + WS_SU) + (size_t)layer * NEXP; const float* SV = (const float*)(F.ws + WS_SV) + (size_t)layer * NEXP;
    const bf16_t* H = (const bf16_t*)(F.ws + WS_H); float* X = (float*)(F.ws + WS_X);
    const int* PIDX = (const int*)(F.ws + WS_PIDX); const float* PG = (const float*)(F.ws + WS_PG);
    const float* mod = (const float*)(F.ws + WS_MOD) + (size_t)layer * 3 * 12288;
    const int lane = F.lane;
    for (int t = F.vcu * 8 + F.wid; t < m_rows; t += F.G * 8) {
        float hf[32];
#pragma unroll
        for (int j = 0; j < 2; ++j) { const u32x4* hp = (const u32x4*)(H + (size_t)t * DM + j * 1024 + lane * 16); const u32x4 w0 = hp[0], w1 = hp[1];
#pragma unroll
            for (int q = 0; q < 4; ++q) { hf[j * 16 + q * 2] = bf_lo(w0[q]); hf[j * 16 + q * 2 + 1] = bf_hi(w0[q]); hf[j * 16 + 8 + q * 2] = bf_lo(w1[q]); hf[j * 16 + 8 + q * 2 + 1] = bf_hi(w1[q]); } }
        int id[2]; float wv[2];
        id[0] = PIDX[(size_t)t * 128 + lane]; id[1] = PIDX[(size_t)t * 128 + 64 + lane];
#pragma unroll
        for (int half = 0; half < 2; ++half) {
            const int idr = id[half]; float acc = 0.f;
            const float gk = PG[(size_t)t * 128 + half * 64 + lane], su = SU[idr], sv = SV[idr];
            Row8 A[4], B[4];
#pragma unroll
            for (int q = 0; q < 4; ++q) ld_row8(A[q], EU, __builtin_amdgcn_readlane(idr, q), lane);
#pragma unroll 1
            for (int k = 0; k < 64; k += 8) {
#pragma unroll
                for (int q = 0; q < 4; ++q) ld_row8(B[q], EU, __builtin_amdgcn_readlane(idr, k + 4 + q), lane);
                { const float b = reduce4(dot_row8(A[0], hf), dot_row8(A[1], hf), dot_row8(A[2], hf), dot_row8(A[3], hf), lane);
#pragma unroll
                  for (int q = 0; q < 4; ++q) { const float tq = rl_f(b, 16 * q); acc = (lane == k + q) ? tq : acc; } }
                if (k + 8 < 64) {
#pragma unroll
                    for (int q = 0; q < 4; ++q) ld_row8(A[q], EU, __builtin_amdgcn_readlane(idr, k + 8 + q), lane); }
                { const float b = reduce4(dot_row8(B[0], hf), dot_row8(B[1], hf), dot_row8(B[2], hf), dot_row8(B[3], hf), lane);
#pragma unroll
                  for (int q = 0; q < 4; ++q) { const float tq = rl_f(b, 16 * q); acc = (lane == k + 4 + q) ? tq : acc; } }
            }
            wv[half] = gk * gelu_tanh(acc * su) * sv;
        }
        float out[32];
#pragma unroll
        for (int i = 0; i < 32; ++i) out[i] = 0.f;
#pragma unroll
        for (int half = 0; half < 2; ++half) {
            const int idr = id[half]; const float wr = wv[half];
            Row8 A[4], B[4];
#pragma unroll
            for (int q = 0; q < 4; ++q) ld_row8(A[q], EV, __builtin_amdgcn_readlane(idr, q), lane);
#pragma unroll 1
            for (int k = 0; k < 64; k += 8) {
#pragma unroll
                for (int q = 0; q < 4; ++q) ld_row8(B[q], EV, __builtin_amdgcn_readlane(idr, k + 4 + q), lane);
#pragma unroll
                for (int q = 0; q < 4; ++q) fma_row8(out, A[q], rl_f(wr, k + q));
                if (k + 8 < 64) {
#pragma unroll
                    for (int q = 0; q < 4; ++q) ld_row8(A[q], EV, __builtin_amdgcn_readlane(idr, k + 8 + q), lane); }
#pragma unroll
                for (int q = 0; q < 4; ++q) fma_row8(out, B[q], rl_f(wr, k + 4 + q));
            }
        }
        const float* gate = mod + (size_t)vsel_of_row(t) * 12288 + 5 * DM;
        float* xr = X + (size_t)t * DM; float* dst = dry ? (float*)(F.ws + WS_OF) + (size_t)t * DM : (last ? P.out + (size_t)t * DM : xr);
#pragma unroll
        for (int j = 0; j < 2; ++j)
#pragma unroll
            for (int q = 0; q < 4; ++q) { const int c = j * 1024 + lane * 16 + q * 4; const f32x4 xo = *(const f32x4*)(xr + c), g = *(const f32x4*)(gate + c);
                f32x4 y; y[0] = xo[0] + g[0] * out[j * 16 + q * 4 + 0]; y[1] = xo[1] + g[1] * out[j * 16 + q * 4 + 1]; y[2] = xo[2] + g[2] * out[j * 16 + q * 4 + 2]; y[3] = xo[3] + g[3] * out[j * 16 + q * 4 + 3];
                *(f32x4*)(dst + c) = y; }
    }
}

constexpr int N_PHASES = 1 + 2 * 11 + 2 * 10;
__global__ void __launch_bounds__(512, 2) mk_fwd(Params Pval) {
    extern __shared__ __attribute__((aligned(16))) unsigned char lds_raw[];
    LAS unsigned char* ldsl = (LAS unsigned char*)lds_raw;
    volatile LAS unsigned* misc = (volatile LAS unsigned*)(ldsl + LDS_MISC);
    if (threadIdx.x < 16) misc[threadIdx.x] = 0u;
    __syncthreads();
    XcdBarrier bar = xcd_barrier_post((unsigned*)(Pval.ws + WS_CTL) + 1024, misc);
    const int lo = Pval.ph_lo, hi = Pval.ph_hi; int ph = 0;
#define MKCTX() Ctx F; { int tid_ = threadIdx.x; asm volatile("" : "+v"(tid_)); F.tid = tid_; F.lane = tid_ & 63; F.wid = __builtin_amdgcn_readfirstlane(tid_ >> 6); \
        int G_ = gridDim.x, bx_ = blockIdx.x; asm volatile("" : "+s"(G_), "+s"(bx_)); F.G = G_; F.vcu = (G_ % 8 == 0) ? (bx_ % 8) * (G_ / 8) + bx_ / 8 : bx_; F.bx = bx_; } \
        unsigned long long kp_ = (unsigned long long)__builtin_amdgcn_kernarg_segment_ptr(); asm volatile("" : "+s"(kp_)); CParams& P = *(CParams*)kp_; \
        F.ws = P.ws; F.lds = (char*)lds_raw; unsigned char* ws = F.ws; (void)ws; \
        bf16_t* Hb = (bf16_t*)(ws + WS_H); bf16_t* P1 = (bf16_t*)(ws + WS_P1); float* X = (float*)(ws + WS_X); const float* mod = (const float*)(ws + WS_MOD); (void)Hb; (void)P1; (void)X; (void)mod;
#define PHASE(cls, ...) do { if (ph >= lo && ph < hi) { if constexpr ((PH_MASK >> (cls)) & 1u) { \
        if constexpr ((PH_DOUBLE >> (cls)) & 1u) { const bool dry = true; (void)dry; MKCTX(); __VA_ARGS__; __syncthreads(); } \
        { const bool dry = false; (void)dry; MKCTX(); __VA_ARGS__; } } if (ph + 1 < hi) xcd_barrier(bar); } ++ph; } while (0)

    PHASE(0, prologue_phase(F, P));
#pragma unroll 1
    for (int layer = 0; layer < DEPTH; ++layer) {
        const int e = layer >> 1; const bool even = (layer & 1) == 0, lastl = layer == DEPTH - 1;
        const int m_post = lastl ? TL : TT;
        PHASE(1, norm_phase(F, P, layer, 0, TT));
        PHASE(2, { const bf16_t* W = even ? (const bf16_t*)(ws + WS_WINAB) + (size_t)e * AB_INP * DM : (const bf16_t*)(ws + WS_WINC) + (size_t)e * C_IN * DM;
                const int N = even ? AB_INP : C_IN;
                pg8::Gemm g{Hb, W, TT, N, DM, DM}; pg8::StaticOrder S; S.init(TT, N, F.G, F.bx);
                pg8::EpiBf16 E{P1, N};
                pg8::gemm_phase<pg8::EpiBf16, pg8::StaticOrder>(ldsl, g, S, E); });
        if (even) {
            PHASE(3, { { pg8::Gemm g{P1, (const bf16_t*)(ws + WS_WUQ) + (size_t)e * 1536 * 768, TT, 1536, 768, AB_INP}; pg8::StaticOrder S; S.init(TT, 1536, F.G, F.bx);
                      pg8::EpiBf16 E{(bf16_t*)(ws + WS_QA), 1536};
                      pg8::gemm_phase<pg8::EpiBf16, pg8::StaticOrder>(ldsl, g, S, E); }
                    { pg8::Gemm g{P1 + 768, (const bf16_t*)(ws + WS_WUKV) + (size_t)e * 2048 * 512, TT, 2048, 512, AB_INP}; pg8::StaticOrder S; S.init(TT, 2048, F.G, F.bx);
                      pg8::EpiBf16 E{(bf16_t*)(ws + WS_KV), 2048};
                      pg8::gemm_phase<pg8::EpiBf16, pg8::StaticOrder>(ldsl, g, S, E); } });
            PHASE(4, qkv_even_phase(F, P, e));
            PHASE(5, { if constexpr (ATT_SEL & 1) attn_phase<192, MLA_SD, 3072, 8, 8, 8>(F, (const bf16_t*)(ws + WS_Q1), (const bf16_t*)(ws + WS_K1), (const bf16_t*)(ws + WS_V1), (float*)(ws + WS_OF), 0, !lastl);
                    if constexpr (ATT_SEL & 2) attn_phase<64, 2, 3072, 16, 16, 8>(F, (const bf16_t*)(ws + WS_Q2), (const bf16_t*)(ws + WS_K2), (const bf16_t*)(ws + WS_V2), (float*)(ws + WS_OF), 1024, !lastl); });
            PHASE(6, merge_even_phase(F, P, e, layer, m_post));
        } else {
            PHASE(7, qkv_odd_phase(F, P, e));
            PHASE(8, attn_phase<128, GQA_SD, 2048, 16, 4, 4>(F, (const bf16_t*)(ws + WS_Q1), (const bf16_t*)(ws + WS_K1), (const bf16_t*)(ws + WS_V1), (float*)(ws + WS_OF), 0, !lastl));
            PHASE(9, merge_odd_phase(F, m_post));
        }
        PHASE(10, { const bf16_t* W = even ? (const bf16_t*)(ws + WS_WOUTAB) + (size_t)e * DM * DM : (const bf16_t*)(ws + WS_WOUTC) + (size_t)e * DM * DM;
                pg8::Gemm g{(const bf16_t*)(ws + WS_AO), W, m_post, DM, DM, DM}; pg8::StaticOrder S; S.init(m_post, DM, F.G, F.bx);
                pg8::EpiResid E{X, mod + (size_t)layer * 3 * 12288, 2};
                pg8::gemm_phase<pg8::EpiResid, pg8::StaticOrder>(ldsl, g, S, E); });
        PHASE(1, norm_phase(F, P, layer, 1, m_post));
        PHASE(11, { pg8::Gemm g{Hb, (const bf16_t*)(ws + WS_WPQ) + (size_t)layer * DM * DM, m_post, DM, DM, DM}; pg8::StaticOrder S; S.init(m_post, DM, F.G, F.bx);
                pg8::EpiBf16 E{(bf16_t*)(ws + WS_PQ), DM};
                pg8::gemm_phase<pg8::EpiBf16, pg8::StaticOrder>(ldsl, g, S, E); });
        PHASE(12, peer_select_phase(F, layer, m_post));
        PHASE(13, peer_expert_phase(F, P, layer, m_post, lastl, dry));
    }
#undef PHASE
}

extern "C" void kernel_launch(void* const* d_in, const int* in_sizes, int n_in, void* d_out, int out_size, void* d_ws, size_t ws_size, hipStream_t stream) {
    static int grid = 0;
    if (grid == 0) {
        if (n_in != 28 || ws_size < WS_END) { fprintf(stderr, "kernel_launch: expected 28 inputs and >= %zu bytes of workspace, got %d / %zu\n", (size_t)WS_END, n_in, ws_size); grid = -1; return; }
        int dev = 0, cus = 0, per_cu = 0;
        if (hipGetDevice(&dev) != hipSuccess || hipDeviceGetAttribute(&cus, hipDeviceAttributeMultiprocessorCount, dev) != hipSuccess) { grid = -1; return; }
        if (hipFuncSetAttribute((const void*)mk_fwd, hipFuncAttributeMaxDynamicSharedMemorySize, LDS_BYTES) != hipSuccess) { fprintf(stderr, "kernel_launch: hipFuncSetAttribute failed\n"); grid = -1; return; }
        if (hipOccupancyMaxActiveBlocksPerMultiprocessor(&per_cu, (const void*)mk_fwd, 512, LDS_BYTES) != hipSuccess || per_cu < 1) fprintf(stderr, "kernel_launch: occupancy query says %d\n", per_cu);
        (void)hipGetLastError();
        grid = cus;
    }
    if (grid < 0) return;
    (void)hipMemsetAsync((char*)d_ws + WS_CTL, 0, CTL_BYTES, stream);
    Params p{};
    const float** pf = (const float**)&p;
    for (int i = 0; i < 28; ++i) pf[i] = (const float*)d_in[i];
    p.out = (float*)d_out; p.ws = (unsigned char*)d_ws;
#if MK_PER_PHASE_LAUNCH
    for (int i = 0; i < N_PHASES; ++i) { p.ph_lo = i; p.ph_hi = i + 1; hipLaunchKernelGGL(mk_fwd, dim3(grid), dim3(512), LDS_BYTES, stream, p); }
#else
    p.ph_lo = 0; p.ph_hi = N_PHASES;
    hipLaunchKernelGGL(mk_fwd, dim3(grid), dim3(512), LDS_BYTES, stream, p);
#endif
    const hipError_t le = hipPeekAtLastError();
    if (le != hipSuccess) fprintf(stderr, "kernel_launch: launch failed: %s\n", hipGetErrorName(le));
}
```

```cpp
#include <hip/hip_runtime.h>
#include <stdint.h>
#include <stdio.h>

#ifndef MK_PER_PHASE_LAUNCH
#define MK_PER_PHASE_LAUNCH 0
#endif

#ifndef MLA_QL
#define MLA_QL 4
#endif
#ifndef MLA_SD
#define MLA_SD 0
#endif
#ifndef GQA_SD
#define GQA_SD 1
#endif
#ifndef ATT_SEL
#define ATT_SEL 3
#endif
#ifndef PH_DOUBLE
#define PH_DOUBLE 0u
#endif
#ifndef PH_MASK
#define PH_MASK 0xFFFFFFFFu
#endif
#define LAS __attribute__((address_space(3)))
typedef unsigned short bf16_t;
typedef short bf16x8 __attribute__((ext_vector_type(8)));
typedef short s16x4 __attribute__((ext_vector_type(4)));
typedef float f32x4 __attribute__((ext_vector_type(4)));
typedef float f32x2 __attribute__((ext_vector_type(2)));
typedef float f32x16 __attribute__((ext_vector_type(16)));
typedef unsigned u32x4 __attribute__((ext_vector_type(4)));
typedef unsigned u32x2 __attribute__((ext_vector_type(2)));
typedef __bf16 bf16x2_t __attribute__((ext_vector_type(2)));

constexpr int DM = 2048, NB = 2, SEQ = 8192, DEPTH = 4, CTXL = 256;
constexpr int TL = NB * SEQ;
constexpr int TZ = NB * CTXL;
constexpr int TT = TL + TZ;
constexpr int KPB = SEQ + CTXL;
constexpr int AB_IN = 4416, AB_INP = 4608;
constexpr int C_IN = 3072;
constexpr int NEXP = 16384;
constexpr float EPS = 1e-6f;
constexpr float LOG2E = 1.4426950408889634f;

constexpr size_t al256(size_t x) { return (x + 255) / 256 * 256; }
constexpr size_t WS_CTL = 0, CTL_BYTES = 1u << 20;
constexpr size_t WS_MOD = WS_CTL + CTL_BYTES;
constexpr size_t WS_TAB16 = WS_MOD + al256((size_t)4 * 3 * 12288 * 4);
constexpr size_t WS_TAB32 = WS_TAB16 + al256((size_t)128 * 16 * 2 * 4);
constexpr size_t WS_LAM = WS_TAB32 + al256((size_t)128 * 32 * 2 * 4);
constexpr size_t WS_WINAB = WS_LAM + 256;
constexpr size_t WS_WUQ = WS_WINAB + (size_t)2 * AB_INP * DM * 2;
constexpr size_t WS_WUKV = WS_WUQ + (size_t)2 * 1536 * 768 * 2;
constexpr size_t WS_WOUTAB = WS_WUKV + (size_t)2 * 2048 * 512 * 2;
constexpr size_t WS_WINC = WS_WOUTAB + (size_t)2 * DM * DM * 2;
constexpr size_t WS_WOUTC = WS_WINC + (size_t)2 * C_IN * DM * 2;
constexpr size_t WS_WPQ = WS_WOUTC + (size_t)2 * DM * DM * 2;
constexpr size_t WS_SUBK = WS_WPQ + (size_t)4 * DM * DM * 2;
constexpr size_t WS_EU = WS_SUBK + (size_t)4 * 8 * 2 * 128 * 128 * 2;
constexpr size_t WS_EV = WS_EU + (size_t)4 * NEXP * DM;
constexpr size_t WS_SU = WS_EV + (size_t)4 * NEXP * DM;
constexpr size_t WS_SV = WS_SU + (size_t)4 * NEXP * 4;
constexpr size_t WS_X = WS_SV + (size_t)4 * NEXP * 4;
constexpr size_t WS_H = WS_X + (size_t)TT * DM * 4;
constexpr size_t WS_P1 = WS_H + (size_t)TT * DM * 2;
constexpr size_t WS_QA = WS_P1 + (size_t)TT * AB_INP * 2;
constexpr size_t WS_KV = WS_QA + (size_t)TT * 1536 * 2;
constexpr size_t WS_Q1 = WS_KV + (size_t)TT * 2048 * 2;
constexpr size_t WS_K1 = WS_Q1 + (size_t)TT * 2048 * 2;
constexpr size_t WS_V1 = WS_K1 + (size_t)TT * 1536 * 2;
constexpr size_t WS_Q2 = WS_V1 + (size_t)TT * 1024 * 2;
constexpr size_t WS_K2 = WS_Q2 + (size_t)TT * 1024 * 2;
constexpr size_t WS_V2 = WS_K2 + (size_t)TT * 1024 * 2;
constexpr size_t WS_OF = WS_V2 + (size_t)TT * 1024 * 2;
constexpr size_t WS_AO = WS_OF + (size_t)TT * 3072 * 4;
constexpr size_t WS_PQ = WS_AO + (size_t)TT * DM * 2;
constexpr size_t WS_PIDX = WS_PQ + (size_t)TT * DM * 2;
constexpr size_t WS_PG = WS_PIDX + (size_t)TT * 128 * 4;
constexpr size_t WS_END = WS_PG + (size_t)TT * 128 * 4;

constexpr int LDS_MAIN = 131072;
constexpr int LDS_MISC = LDS_MAIN;
constexpr int LDS_BYTES = LDS_MAIN + 4096;

__device__ __forceinline__ unsigned cvt_pk_bf16(float lo, float hi) { unsigned r; asm("v_cvt_pk_bf16_f32 %0, %1, %2" : "=v"(r) : "v"(lo), "v"(hi)); return r; }
__device__ __forceinline__ float bf_lo(unsigned w) { return __uint_as_float(w << 16); }
__device__ __forceinline__ float bf_hi(unsigned w) { return __uint_as_float(w & 0xffff0000u); }
__device__ __forceinline__ float wave_sum(float v) {
#pragma unroll
    for (int o = 32; o >= 1; o >>= 1) v += __shfl_xor(v, o);
    return v;
}
__device__ __forceinline__ float hw_sum(float v) {
#pragma unroll
    for (int o = 16; o >= 1; o >>= 1) v += __shfl_xor(v, o);
    return v;
}
__device__ __forceinline__ int mbcnt64(unsigned long long m) { return (int)__builtin_amdgcn_mbcnt_hi((unsigned)(m >> 32), __builtin_amdgcn_mbcnt_lo((unsigned)m, 0u)); }
__device__ __forceinline__ int krow_of(int t) { return t < TL ? (t >> 13) * KPB + (t & (SEQ - 1)) : ((t - TL) >> 8) * KPB + SEQ + ((t - TL) & (CTXL - 1)); }
__device__ __forceinline__ int vsel_of_row(int t) { return t < SEQ ? 0 : (t < TL ? 1 : 2); }

#define XB_TMO      128
#define XB_XCNT(j)  (256  + 64 * (j))
#define XB_XSUB(j)  (1280 + 64 * (j))
#define XB_XGEN(j)  (2304 + 64 * (j))
#define XB_TOP      3328
#define XB_TOPGEN   3392
#define XCD_BAR_WORDS 3456
#define XB_SPIN_CAP (1u << 27)
__device__ __forceinline__ unsigned xb_ld(unsigned* p)              { return __hip_atomic_load(p, __ATOMIC_RELAXED, __HIP_MEMORY_SCOPE_AGENT); }
__device__ __forceinline__ unsigned xb_add(unsigned* p, unsigned v) { return __hip_atomic_fetch_add(p, v, __ATOMIC_RELAXED, __HIP_MEMORY_SCOPE_AGENT); }
__device__ __forceinline__ unsigned xb_xcc_id() { return (unsigned)__builtin_amdgcn_s_getreg((3 << 11) | 20) & 0xFu; }
#define XB_SPIN(cond, bar) do { unsigned _sp = 0; while (cond) { __builtin_amdgcn_s_sleep(1); \
    if ((++_sp & 255u) == 0u) { if (xb_ld(&(bar)[XB_TMO])) break; if (_sp > XB_SPIN_CAP) { atomicAdd(&(bar)[XB_TMO], 1u); break; } } } } while (0)
struct XcdBarrier { unsigned* bar; unsigned x; volatile LAS unsigned* st; };
__device__ __forceinline__ XcdBarrier xcd_barrier_post(unsigned* bar, volatile LAS unsigned* st) {
    XcdBarrier b; b.bar = bar; b.x = xb_xcc_id(); b.st = st;
    if (threadIdx.x == 0) (void)xb_add(&bar[XB_XCNT(b.x)], 1u);
    return b;
}
__device__ __forceinline__ void xcd_barrier_complete(unsigned* bar, unsigned x, unsigned& nloc, unsigned& nx) {
    const unsigned G = gridDim.x * gridDim.y * gridDim.z;
    unsigned sum, cnt, mine, sp = 0u;
    for (;;) {
        sum = 0u; cnt = 0u; mine = 0u;
#pragma unroll
        for (unsigned j = 0; j < 16; ++j) { const unsigned c = xb_ld(&bar[XB_XCNT(j)]); sum += c; cnt += (c > 0u) ? 1u : 0u; mine = (j == x) ? c : mine; }
        if (sum == G) break;
        __builtin_amdgcn_s_sleep(1);
        if ((++sp & 255u) == 0u) { if (xb_ld(&bar[XB_TMO])) break; if (sp > XB_SPIN_CAP) { atomicAdd(&bar[XB_TMO], 1u); break; } }
    }
    nloc = mine > 0u ? mine : 1u; nx = cnt > 0u ? cnt : 1u;
}
__device__ __forceinline__ void xcd_barrier(const XcdBarrier& b) {
    asm volatile("s_waitcnt vmcnt(0)" ::: "memory");
    __syncthreads();
    if (threadIdx.x == 0) {
        unsigned* bar = b.bar;
        __builtin_amdgcn_s_waitcnt(0);
        unsigned nloc = b.st[0], nx = b.st[1];
        if (nloc == 0u) { xcd_barrier_complete(bar, b.x, nloc, nx); b.st[0] = nloc; b.st[1] = nx; }
        const unsigned old = xb_add(&bar[XB_XSUB(b.x)], 1u);
        const unsigned gen = old / nloc;
        if (old + 1u == (gen + 1u) * nloc) {
            __builtin_amdgcn_fence(__ATOMIC_RELEASE, "agent");
            asm volatile("s_waitcnt vmcnt(0)" ::: "memory");
            const unsigned og = xb_add(&bar[XB_TOP], 1u);
            const unsigned tg = og / nx;
            if (og + 1u == (tg + 1u) * nx) xb_add(&bar[XB_TOPGEN], 1u);
            else XB_SPIN(xb_ld(&bar[XB_TOPGEN]) == tg, bar);
            __builtin_amdgcn_fence(__ATOMIC_ACQUIRE, "agent");
            xb_add(&bar[XB_XGEN(b.x)], 1u);
            asm volatile("s_waitcnt vmcnt(0)" ::: "memory");
        } else {
            XB_SPIN(xb_ld(&bar[XB_XGEN(b.x)]) == gen, bar);
            __builtin_amdgcn_fence(__ATOMIC_ACQUIRE, "agent");
            asm volatile("s_waitcnt vmcnt(0)" ::: "memory");
        }
    }
    __syncthreads();
}

namespace pg8 {
constexpr int BM = 256, BK = 64, HALF = 128, HTB = HALF * BK * 2, STAGE_BYTES = 8 * HTB, NXCD = 8, WGM = 8;
__host__ __device__ __forceinline__ int lds_byte(int r, int c) { const int st = (r >> 4) * 2 + (c >> 5), rr = r & 15, cc = c & 31, ob = rr * 64 + cc * 2; return st * 1024 + (ob ^ (((ob >> 9) & 1) << 5)); }
__host__ __device__ __forceinline__ void stage_rc(int b, int& R, int& C) { const int st = b / 1024, sb = b % 1024, swz = sb ^ (((sb >> 9) & 1) << 5); R = (st >> 1) * 16 + swz / 64; C = (st & 1) * 32 + (swz % 64) / 2; }
__host__ __device__ __forceinline__ int perm32(int rho) { const int n = rho >> 4, i = rho & 15; return 8 * (i >> 2) + 4 * n + (i & 3); }
struct Unit { int pm, pn; };
struct Gemm { const bf16_t* A; const bf16_t* Bt; int M, N, K, lda; };
struct StaticOrder {
    int nM, nN, nwg, G, c;
    __host__ __device__ void init(int M, int N, int G_, int c_) { nM = M / BM; nN = N / BM; nwg = nM * nN; G = G_; c = c_; }
    __host__ __device__ bool next(int i, Unit& u) const {
        const long L = (long)i * G + c; if (L >= nwg) return false;
        int wgid = (int)L; { const int q = nwg / NXCD, r = nwg % NXCD, xcd = wgid % NXCD, off = wgid / NXCD; wgid = (xcd < r ? xcd * (q + 1) : r * (q + 1) + (xcd - r) * q) + off; }
        const int nig = WGM * nN, gid = wgid / nig, fm = gid * WGM, gsz = (nM - fm) < WGM ? (nM - fm) : WGM;
        u.pm = fm + ((wgid % nig) % gsz); u.pn = (wgid % nig) / gsz; return true;
    }
    __device__ __forceinline__ void a_ready(const Unit&) const {}
    __device__ __forceinline__ void done(const Unit&) const {}
};
struct EpiBf16 {
    static constexpr bool PERM = true;
    bf16_t* O; int ldc;
    __device__ __forceinline__ void operator()(const f32x4 (&acc)[2][2][4][2], const Unit& u, int wr, int wc, int fr, int fq) const {
        const int row0 = u.pm * BM + wr * 64 + fr; const int col0 = u.pn * BM + wc * 32 + 8 * fq;
#pragma unroll
        for (int ai = 0; ai < 2; ++ai)
#pragma unroll
            for (int m = 0; m < 4; ++m) { bf16_t* rowp = O + (size_t)(row0 + ai * HALF + m * 16) * ldc + col0;
#pragma unroll
                for (int bj = 0; bj < 2; ++bj) { const f32x4 v0 = acc[ai][bj][m][0], v1 = acc[ai][bj][m][1];
                    u32x4 w; w.x = cvt_pk_bf16(v0[0], v0[1]); w.y = cvt_pk_bf16(v0[2], v0[3]); w.z = cvt_pk_bf16(v1[0], v1[1]); w.w = cvt_pk_bf16(v1[2], v1[3]);
                    *(u32x4*)(rowp + bj * HALF) = w; } }
    }
};
struct EpiResid {
    static constexpr bool PERM = false;
    float* X; const float* modl; int chunk;
    __device__ __forceinline__ void operator()(const f32x4 (&acc)[2][2][4][2], const Unit& u, int wr, int wc, int fr, int fq) const {
        const int row0 = u.pm * BM + wr * 64 + fr, col0 = u.pn * BM + wc * 32 + 4 * fq;
        const int vs = u.pm < 32 ? 0 : (u.pm < 64 ? 1 : 2);
        const float* gate = modl + (size_t)vs * 12288 + chunk * 2048 + col0;
        f32x4 gv[2][2];
#pragma unroll
        for (int bj = 0; bj < 2; ++bj)
#pragma unroll
            for (int n = 0; n < 2; ++n) gv[bj][n] = *(const f32x4*)(gate + bj * HALF + n * 16);
#pragma unroll
        for (int ai = 0; ai < 2; ++ai)
#pragma unroll
            for (int m = 0; m < 4; ++m) { float* rowp = X + (size_t)(row0 + ai * HALF + m * 16) * DM + col0;
#pragma unroll
                for (int bj = 0; bj < 2; ++bj)
#pragma unroll
                    for (int n = 0; n < 2; ++n) { float* p = rowp + bj * HALF + n * 16; const f32x4 xo = *(const f32x4*)p; *(f32x4*)p = xo + gv[bj][n] * acc[ai][bj][m][n]; } }
    }
};

template <class Epi, class Sched>
__device__ __forceinline__ void gemm_phase(LAS unsigned char* lds, const Gemm g, const Sched& S, const Epi& E) {
    int tid_l = threadIdx.x; asm volatile("" : "+v"(tid_l));
    const int tid = tid_l, wid = __builtin_amdgcn_readfirstlane(tid >> 6), lane = tid & 63, wr = wid >> 2, wc = wid & 3, fr = lane & 15, fq = lane >> 4;
    const int K = g.K, nt = K / BK, lda = g.lda;
    unsigned voffA[2], voffB[2];
#pragma unroll
    for (int i = 0; i < 2; ++i) { int R, C; stage_rc(tid * 16 + i * 8192, R, C); const int Rb = Epi::PERM ? ((R & ~31) + perm32(R & 31)) : R;
        voffA[i] = (unsigned)(R * lda + C) * 2u; voffB[i] = (unsigned)(Rb * K + C) * 2u; }
    const size_t kstep = (size_t)(BK * 2);
    const size_t hstepA = (size_t)HALF * lda * 2, hstepB = (size_t)HALF * K * 2;
    const size_t tstepA = 2 * hstepA, tstepB = 2 * hstepB;
    const unsigned ldsw = (unsigned)wid * 1024u;
    const int aoff = lds_byte(wr * 64 + fr, fq * 8), boff = lds_byte(wc * 32 + fr, fq * 8);
#define PG8_SA(b, h) (((b) * 2 + (h)) * HTB)
#define PG8_SB(b, h) ((4 + (b) * 2 + (h)) * HTB)
#define PG8_STAGE(bufoff, gbase, voff) do { _Pragma("unroll") for (int _i = 0; _i < 2; ++_i) \
        __builtin_amdgcn_global_load_lds((const unsigned*)((const char*)(gbase) + (voff)[_i]), (LAS unsigned*)(lds + (bufoff) + ldsw + _i * 8192), 16, 0, 0); } while (0)
#define PG8_LDA(dst, b, h) do { _Pragma("unroll") for (int m = 0; m < 4; ++m) _Pragma("unroll") for (int k = 0; k < 2; ++k) dst[m][k] = *(const LAS bf16x8*)(lds + PG8_SA(b, h) + aoff + m * 2048 + k * 1024); } while (0)
#define PG8_LDB(dst, b, h) do { _Pragma("unroll") for (int n = 0; n < 2; ++n) _Pragma("unroll") for (int k = 0; k < 2; ++k) dst[n][k] = *(const LAS bf16x8*)(lds + PG8_SB(b, h) + boff + n * 2048 + k * 1024); } while (0)
#define PG8_MMA(ai, bj, At, Bt) do { __builtin_amdgcn_s_setprio(1); _Pragma("unroll") for (int m = 0; m < 4; ++m) _Pragma("unroll") for (int n = 0; n < 2; ++n) _Pragma("unroll") for (int k = 0; k < 2; ++k) \
        acc[ai][bj][m][n] = __builtin_amdgcn_mfma_f32_16x16x32_bf16(Bt[n][k], At[m][k], acc[ai][bj][m][n], 0, 0, 0); __builtin_amdgcn_s_setprio(0); } while (0)
#define PG8_WAIT_V(n) asm volatile("s_waitcnt vmcnt(" #n ")" ::: "memory")
#define PG8_WAIT_L(n) asm volatile("s_waitcnt lgkmcnt(" #n ")" ::: "memory")
#define PG8_BAR __builtin_amdgcn_s_barrier()
#define PG8_SCHED __builtin_amdgcn_sched_barrier(0)
    Unit cur, nxt; int ui = 0;
    if (!S.next(0, cur)) return;
    f32x4 acc[2][2][4][2];
#pragma unroll
    for (int a = 0; a < 2; ++a)
#pragma unroll
        for (int b = 0; b < 2; ++b)
#pragma unroll
            for (int m = 0; m < 4; ++m)
#pragma unroll
                for (int n = 0; n < 2; ++n) acc[a][b][m][n] = (f32x4){0.f, 0.f, 0.f, 0.f};
    bf16x8 At[4][2], B0[2][2], B1[2][2];
    const char* cA = (const char*)g.A + (size_t)cur.pm * tstepA; const char* cB = (const char*)g.Bt + (size_t)cur.pn * tstepB;
    S.a_ready(cur);
    PG8_STAGE(PG8_SB(0, 0), cB, voffB); PG8_STAGE(PG8_SA(0, 0), cA, voffA); PG8_STAGE(PG8_SB(0, 1), cB + hstepB, voffB); PG8_STAGE(PG8_SA(0, 1), cA + hstepA, voffA);
    if (wr == 1) PG8_BAR;
    PG8_WAIT_V(4); PG8_BAR;
    PG8_STAGE(PG8_SB(1, 0), cB + kstep, voffB); PG8_STAGE(PG8_SA(1, 0), cA + kstep, voffA); PG8_STAGE(PG8_SB(1, 1), cB + hstepB + kstep, voffB);
    PG8_WAIT_V(6); PG8_BAR;
    for (;;) {
        const bool has_next = S.next(ui + 1, nxt);
        const char* nA = has_next ? (const char*)g.A + (size_t)nxt.pm * tstepA : cA; const char* nB = has_next ? (const char*)g.Bt + (size_t)nxt.pn * tstepB : cB;
        for (int t = 0; t < nt; t += 2) {
            const bool last = (t == nt - 2);
            const char* a1 = cA + (size_t)(t + 1) * kstep;
            const char* a2 = last ? nA : cA + (size_t)(t + 2) * kstep; const char* b2 = last ? nB : cB + (size_t)(t + 2) * kstep;
            const char* a3 = a2 + kstep; const char* b3 = b2 + kstep;
            if (last && has_next) S.a_ready(nxt);
            PG8_LDB(B0, 0, 0); PG8_SCHED; PG8_LDA(At, 0, 0); PG8_STAGE(PG8_SA(1, 1), a1 + hstepA, voffA);
            PG8_WAIT_L(8); PG8_BAR; PG8_WAIT_L(0); PG8_MMA(0, 0, At, B0); PG8_BAR; PG8_SCHED;
            PG8_LDB(B1, 0, 1); PG8_STAGE(PG8_SB(0, 0), b2, voffB);
            PG8_BAR; PG8_WAIT_L(0); PG8_MMA(0, 1, At, B1); PG8_BAR;
            PG8_LDA(At, 0, 1); PG8_STAGE(PG8_SA(0, 0), a2, voffA);
            PG8_BAR; PG8_WAIT_L(0); PG8_MMA(1, 0, At, B0); PG8_BAR; PG8_SCHED;
            PG8_STAGE(PG8_SB(0, 1), b2 + hstepB, voffB);
            PG8_WAIT_V(6); PG8_BAR; PG8_MMA(1, 1, At, B1); PG8_BAR;
            PG8_LDB(B0, 1, 0); PG8_SCHED; PG8_LDA(At, 1, 0); PG8_STAGE(PG8_SA(0, 1), a2 + hstepA, voffA);
            PG8_WAIT_L(8); PG8_BAR; PG8_WAIT_L(0); PG8_MMA(0, 0, At, B0); PG8_BAR; PG8_SCHED;
            PG8_LDB(B1, 1, 1); PG8_STAGE(PG8_SB(1, 0), b3, voffB);
            PG8_BAR; PG8_WAIT_L(0); PG8_MMA(0, 1, At, B1); PG8_BAR;
            PG8_LDA(At, 1, 1); PG8_STAGE(PG8_SA(1, 0), a3, voffA);
            PG8_BAR; PG8_WAIT_L(0); PG8_MMA(1, 0, At, B0); PG8_BAR; PG8_SCHED;
            PG8_STAGE(PG8_SB(1, 1), b3 + hstepB, voffB);
            PG8_WAIT_V(6); PG8_BAR; PG8_MMA(1, 1, At, B1); PG8_BAR;
        }
        E(acc, cur, wr, wc, fr, fq); S.done(cur);
        if (!has_next) break;
#pragma unroll
        for (int a = 0; a < 2; ++a)
#pragma unroll
            for (int b = 0; b < 2; ++b)
#pragma unroll
                for (int m = 0; m < 4; ++m)
#pragma unroll
                    for (int n = 0; n < 2; ++n) acc[a][b][m][n] = (f32x4){0.f, 0.f, 0.f, 0.f};
        cur = nxt; cA = nA; cB = nB; ++ui;
    }
    PG8_WAIT_V(0);
    if (wr == 0) PG8_BAR;
    PG8_BAR;
#undef PG8_SA
#undef PG8_SB
#undef PG8_STAGE
#undef PG8_LDA
#undef PG8_LDB
#undef PG8_MMA
#undef PG8_WAIT_V
#undef PG8_WAIT_L
#undef PG8_BAR
#undef PG8_SCHED
}
}

namespace att {
constexpr int NW = 8, QBLK = 32, KVBLK = 64, DV = 128;
constexpr float THR = 8.f;
constexpr int SHM_V = KVBLK * DV * 2;
#define SBAR() __builtin_amdgcn_sched_barrier(0)
__device__ __forceinline__ int crow(int r, int hi) { return (r & 3) + 8 * (r >> 2) + 4 * hi; }
__device__ __forceinline__ unsigned cvtpk(float lo, float hi) { unsigned r; asm volatile("v_cvt_pk_bf16_f32 %0, %1, %2" : "=v"(r) : "v"(lo), "v"(hi)); return r; }
__device__ __forceinline__ void partialSM(f32x16& p0, f32x16& p1, float& m_reg, float& mn, float& alpha, const float C, const float thr_raw) {
    float pmax = p0[0];
#pragma unroll
    for (int r = 1; r < 16; ++r) pmax = fmaxf(pmax, p0[r]);
#pragma unroll
    for (int r = 0; r < 16; ++r) pmax = fmaxf(pmax, p1[r]);
    { auto rr = __builtin_amdgcn_permlane32_swap(__float_as_uint(pmax), __float_as_uint(pmax), false, false);
      pmax = fmaxf(__uint_as_float(rr[0]), __uint_as_float(rr[1])); }
    if (__builtin_expect(__all(pmax - m_reg <= thr_raw), 1)) { mn = m_reg; alpha = 1.f; }
    else { mn = fmaxf(m_reg, pmax); alpha = __builtin_amdgcn_exp2f((m_reg - mn) * C); m_reg = mn; }
    const float mnC = -mn * C;
#pragma unroll
    for (int r = 0; r < 16; ++r) p0[r] = fmaf(p0[r], C, mnC);
#pragma unroll
    for (int r = 0; r < 16; ++r) p1[r] = fmaf(p1[r], C, mnC);
#pragma unroll
    for (int r = 0; r < 16; ++r) p0[r] = __builtin_amdgcn_exp2f(p0[r]);
}
__device__ __forceinline__ void finishSM(f32x16& p0, f32x16& p1, float alpha, float& l_reg, bf16x8& pa0, bf16x8& pa1, bf16x8& pa2, bf16x8& pa3) {
#pragma unroll
    for (int r = 0; r < 16; ++r) p1[r] = __builtin_amdgcn_exp2f(p1[r]);
    float ps = 0;
#pragma unroll
    for (int r = 0; r < 16; ++r) ps += p0[r];
#pragma unroll
    for (int r = 0; r < 16; ++r) ps += p1[r];
    { auto rr = __builtin_amdgcn_permlane32_swap(__float_as_uint(ps), __float_as_uint(ps), false, false);
      ps = __uint_as_float(rr[0]) + __uint_as_float(rr[1]); }
    l_reg = l_reg * alpha + ps;
#define PK4(P, BASE, OUT) do { unsigned a0 = cvtpk(P[BASE + 0], P[BASE + 1]), a1 = cvtpk(P[BASE + 2], P[BASE + 3]);   \
    unsigned b0 = cvtpk(P[BASE + 4], P[BASE + 5]), b1 = cvtpk(P[BASE + 6], P[BASE + 7]);                              \
    auto r0 = __builtin_amdgcn_permlane32_swap(a0, b0, false, false); auto r1 = __builtin_amdgcn_permlane32_swap(a1, b1, false, false); \
    u32x4 w = {r0[0], r1[0], r0[1], r1[1]}; OUT = *reinterpret_cast<bf16x8*>(&w); } while (0)
    PK4(p0, 0, pa0); PK4(p0, 8, pa1); PK4(p1, 0, pa2); PK4(p1, 8, pa3);
#undef PK4
}
template <int DQK>
__device__ __forceinline__ void qkt(f32x16& p0, f32x16& p1, const char* Ks, const bf16x8 (&qr)[DQK / 16], int r32, int hi) {
    constexpr int RS = DQK * 2;
    p0 = f32x16{}; p1 = f32x16{};
#pragma unroll
    for (int d0 = 0; d0 < DQK / 16; ++d0) { const int cb = (d0 * 16 + hi * 8) * 2;
        const bf16x8 b0 = *reinterpret_cast<const bf16x8*>(Ks + r32 * RS + (cb ^ ((r32 & 7) << 4)));
        const bf16x8 b1 = *reinterpret_cast<const bf16x8*>(Ks + (32 + r32) * RS + (cb ^ ((r32 & 7) << 4)));
        p0 = __builtin_amdgcn_mfma_f32_32x32x16_bf16(b0, qr[d0], p0, 0, 0, 0);
        p1 = __builtin_amdgcn_mfma_f32_32x32x16_bf16(b1, qr[d0], p1, 0, 0, 0); }
}
__device__ __forceinline__ int v_st(int k, int c) { const int kk = (k & ~0xC) | ((k & 4) << 1) | ((k & 8) >> 1); return ((kk >> 3) * 4 + (c >> 5)) * 512 + ((kk & 7) * 32 + (c & 31)) * 2; }
__device__ __forceinline__ int v_rd_base(int lane) { return ((lane & 3) << 3) | (((lane >> 2) & 3) << 6) | (((lane >> 4) & 1) << 5) | (((lane >> 5) & 1) << 8); }
constexpr int v_rd_off(int d0, int ks, int half) { return d0 * 512 + ks * 4096 + half * 2048; }
template <int OFF> __device__ __forceinline__ s16x4 tr_read(int vb) {
    s16x4 r; asm volatile("ds_read_b64_tr_b16 %0, %1 offset:%2" : "=&v"(r) : "v"(vb), "i"(OFF) : "memory"); return r;
}
template <int D0> __device__ __forceinline__ void pv_one(f32x16& od, int vb, bf16x8 pa0, bf16x8 pa1, bf16x8 pa2, bf16x8 pa3) {
    const s16x4 l0 = tr_read<v_rd_off(D0, 0, 0)>(vb), h0 = tr_read<v_rd_off(D0, 0, 1)>(vb), l1 = tr_read<v_rd_off(D0, 1, 0)>(vb), h1 = tr_read<v_rd_off(D0, 1, 1)>(vb);
    const s16x4 l2 = tr_read<v_rd_off(D0, 2, 0)>(vb), h2 = tr_read<v_rd_off(D0, 2, 1)>(vb), l3 = tr_read<v_rd_off(D0, 3, 0)>(vb), h3 = tr_read<v_rd_off(D0, 3, 1)>(vb);
    asm volatile("s_waitcnt lgkmcnt(0)" ::: "memory"); SBAR();
#define PK(L, H) (bf16x8){L[0], L[1], L[2], L[3], H[0], H[1], H[2], H[3]}
    od = __builtin_amdgcn_mfma_f32_32x32x16_bf16(pa0, PK(l0, h0), od, 0, 0, 0);
    od = __builtin_amdgcn_mfma_f32_32x32x16_bf16(pa1, PK(l1, h1), od, 0, 0, 0);
    od = __builtin_amdgcn_mfma_f32_32x32x16_bf16(pa2, PK(l2, h2), od, 0, 0, 0);
    od = __builtin_amdgcn_mfma_f32_32x32x16_bf16(pa3, PK(l3, h3), od, 0, 0, 0);
#undef PK
}
__device__ __forceinline__ void pv_d0(f32x16* o, int vb, bf16x8 pa0, bf16x8 pa1, bf16x8 pa2, bf16x8 pa3) {
    pv_one<0>(o[0], vb, pa0, pa1, pa2, pa3); pv_one<1>(o[1], vb, pa0, pa1, pa2, pa3); pv_one<2>(o[2], vb, pa0, pa1, pa2, pa3); pv_one<3>(o[3], vb, pa0, pa1, pa2, pa3);
}
template <int DQK> struct ScaleOf { static constexpr float scale = DQK == 192 ? 0.07216878364870322f : (DQK == 128 ? 0.08838834764831845f : 0.125f); };
template <int DQK, int SDEPTH, int ldq, int ldk, int ldv, int ldo>
__device__ __forceinline__ void attn_body(const bf16_t* __restrict__ Qb, const bf16_t* __restrict__ Kh, const bf16_t* __restrict__ Vh,
                                          float* __restrict__ Ob, int seq, char* lds) {
    constexpr float C = ScaleOf<DQK>::scale * 1.4426950408889634f, thr_raw = THR / ScaleOf<DQK>::scale;
    constexpr int SHM_K = KVBLK * DQK * 2, RS = DQK * 2, NKP = DQK / 64, KPR = DQK / 8;
    int tid_l = threadIdx.x; asm volatile("" : "+v"(tid_l));
    const int tid = tid_l, wid = tid >> 6, lane = tid & 63, r32 = lane & 31, hi = lane >> 5;
    char* V_lds = lds; char* K_lds = lds + 2 * SHM_V;
    float* ws = (float*)(lds + 2 * SHM_V + 2 * SHM_K) + wid * 64; float* li_l = ws; float* al_l = ws + 32;
    float m_reg = -1e30f, l_reg = 0; f32x16 o[4] = {}; bf16x8 qr[DQK / 16];
    const bf16_t* Qw = Qb + (size_t)(wid * QBLK + r32) * ldq + hi * 8;
#pragma unroll
    for (int d0 = 0; d0 < DQK / 16; ++d0) qr[d0] = *reinterpret_cast<const bf16x8*>(Qw + d0 * 16);
    const int sr = tid >> 4, sc = (tid & 15) * 8, vst0 = v_st(sr, sc), vst1 = v_st(32 + sr, sc);
    int koff[NKP], klds[NKP];
#pragma unroll
    for (int i = 0; i < NKP; ++i) { const int p = tid + i * 512, row = p / KPR, c8 = p % KPR; koff[i] = row * ldk + c8 * 8; klds[i] = row * RS + ((c8 * 16) ^ ((row & 7) << 4)); }
    const int vb0 = (int)(uintptr_t)V_lds + v_rd_base(lane);
    bf16x8 sv0[SDEPTH], sv1[SDEPTH], sk[SDEPTH][NKP];
#define SLOAD(i, k0) do { sv0[i] = *reinterpret_cast<const bf16x8*>(&Vh[(size_t)((k0) + sr) * ldv + sc]); sv1[i] = *reinterpret_cast<const bf16x8*>(&Vh[(size_t)((k0) + 32 + sr) * ldv + sc]); \
    _Pragma("unroll") for (int _q = 0; _q < NKP; ++_q) sk[i][_q] = *reinterpret_cast<const bf16x8*>(&Kh[(size_t)(k0) * ldk + koff[_q]]); } while (0)
#define SWRITE(b, i) do { *(bf16x8*)(V_lds + (b) * SHM_V + vst0) = sv0[i]; *(bf16x8*)(V_lds + (b) * SHM_V + vst1) = sv1[i]; \
    _Pragma("unroll") for (int _q = 0; _q < NKP; ++_q) *(bf16x8*)(K_lds + (b) * SHM_K + klds[_q]) = sk[i][_q]; } while (0)
#define SWAIT() do { if constexpr (SDEPTH == 2) { if constexpr (NKP == 1) asm volatile("s_waitcnt vmcnt(3)" ::: "memory"); else if constexpr (NKP == 2) asm volatile("s_waitcnt vmcnt(4)" ::: "memory"); else asm volatile("s_waitcnt vmcnt(5)" ::: "memory"); } \
    else asm volatile("s_waitcnt vmcnt(0)" ::: "memory"); } while (0)
#define RESC(a) do { if (__any((a) < 1.f)) { if (hi == 0) al_l[r32] = (a); asm volatile("s_waitcnt lgkmcnt(0)" ::: "memory"); \
    _Pragma("unroll") for (int d = 0; d < 4; ++d) _Pragma("unroll") for (int r = 0; r < 16; ++r) o[d][r] *= al_l[crow(r, hi)]; } } while (0)
    f32x16 pA0, pA1, pB0, pB1; float mnA, mnB, alA, alB; bf16x8 pa0, pa1, pa2, pa3; const int NT = seq / KVBLK;
    constexpr int SE = 0, SO = SDEPTH - 1;
    SLOAD(SE, 0); asm volatile("s_waitcnt vmcnt(0)" ::: "memory"); SWRITE(0, SE); __syncthreads();
    qkt<DQK>(pA0, pA1, K_lds, qr, r32, hi); partialSM(pA0, pA1, m_reg, mnA, alA, C, thr_raw);
    SLOAD(SO, KVBLK); if constexpr (SDEPTH == 2) { if (2 < NT) SLOAD(SE, 2 * KVBLK); }
    SWAIT(); SWRITE(1, SO); __syncthreads();
    for (int j = 1; j + 1 < NT; j += 2) {
        SBAR(); qkt<DQK>(pB0, pB1, K_lds + SHM_K, qr, r32, hi);
        finishSM(pA0, pA1, alA, l_reg, pa0, pa1, pa2, pa3); SBAR();
        SLOAD(SO, (j + SDEPTH) * KVBLK); SBAR();
        pv_d0(o, vb0, pa0, pa1, pa2, pa3); partialSM(pB0, pB1, m_reg, mnB, alB, C, thr_raw);
        __syncthreads(); SWAIT(); SWRITE(0, SE);
        RESC(alB); __syncthreads();
        SBAR(); qkt<DQK>(pA0, pA1, K_lds, qr, r32, hi);
        finishSM(pB0, pB1, alB, l_reg, pa0, pa1, pa2, pa3); SBAR();
        if (SDEPTH == 1 || j + 3 < NT) SLOAD(SE, (j + 1 + SDEPTH) * KVBLK); SBAR();
        pv_d0(o, vb0 + SHM_V, pa0, pa1, pa2, pa3); partialSM(pA0, pA1, m_reg, mnA, alA, C, thr_raw);
        __syncthreads(); SWAIT(); SWRITE(1, SO);
        RESC(alA); __syncthreads();
    }
    SBAR(); qkt<DQK>(pB0, pB1, K_lds + SHM_K, qr, r32, hi);
    finishSM(pA0, pA1, alA, l_reg, pa0, pa1, pa2, pa3); SBAR();
    pv_d0(o, vb0, pa0, pa1, pa2, pa3); partialSM(pB0, pB1, m_reg, mnB, alB, C, thr_raw);
    __syncthreads(); RESC(alB);
    finishSM(pB0, pB1, alB, l_reg, pa0, pa1, pa2, pa3); SBAR();
    pv_d0(o, vb0 + SHM_V, pa0, pa1, pa2, pa3);
    if (hi == 0) li_l[r32] = l_reg; asm volatile("s_waitcnt lgkmcnt(0)" ::: "memory");
    float rli[16];
#pragma unroll
    for (int r = 0; r < 16; ++r) rli[r] = __builtin_amdgcn_rcpf(li_l[crow(r, hi)]);
    float* Ow = Ob + (size_t)(wid * QBLK) * ldo;
#pragma unroll
    for (int r = 0; r < 16; ++r) { const int orow = crow(r, hi);
#pragma unroll
        for (int d0 = 0; d0 < 4; ++d0) Ow[(size_t)orow * ldo + d0 * 32 + r32] = o[d0][r] * rli[r]; }
    __syncthreads();
#undef SLOAD
#undef SWRITE
#undef SWAIT
#undef RESC
}
template <int DQK, int QL, int ldq, int ldk, int ldv, int ldo>
__device__ __forceinline__ void attn_body_simple(const bf16_t* __restrict__ Qb, const bf16_t* __restrict__ Kh, const bf16_t* __restrict__ Vh,
                                                 float* __restrict__ Ob, int seq, char* lds) {
    constexpr float C = ScaleOf<DQK>::scale * 1.4426950408889634f, thr_raw = THR / ScaleOf<DQK>::scale;
    constexpr int SHM_K = KVBLK * DQK * 2, RS = DQK * 2, NKP = DQK / 64, KPR = DQK / 8;
    int tid_l = threadIdx.x; asm volatile("" : "+v"(tid_l));
    const int tid = tid_l, wid = tid >> 6, lane = tid & 63, r32 = lane & 31, hi = lane >> 5;
    char* V_lds = lds; char* K_lds = lds + 2 * SHM_V;
    float* ws = (float*)(lds + 2 * SHM_V + 2 * SHM_K) + wid * 64; float* li_l = ws; float* al_l = ws + 32;
    constexpr int NQR = DQK / 16 - QL;
    char* qpark = lds + 2 * SHM_V + 2 * SHM_K + 2048 + wid * (QL * 1024) + lane * 16;
    float m_reg = -1e30f, l_reg = 0; f32x16 o[4] = {}; bf16x8 qr[NQR];
    const bf16_t* Qw = Qb + (size_t)(wid * QBLK + r32) * ldq + hi * 8;
#pragma unroll
    for (int d0 = 0; d0 < NQR; ++d0) qr[d0] = *reinterpret_cast<const bf16x8*>(Qw + d0 * 16);
#pragma unroll
    for (int d0 = 0; d0 < QL; ++d0) *(bf16x8*)(qpark + d0 * 1024) = *reinterpret_cast<const bf16x8*>(Qw + (NQR + d0) * 16);
    const int sr = tid >> 4, sc = (tid & 15) * 8, vst0 = v_st(sr, sc), vst1 = v_st(32 + sr, sc);
    int koff[NKP], klds[NKP];
#pragma unroll
    for (int i = 0; i < NKP; ++i) { const int p = tid + i * 512, row = p / KPR, c8 = p % KPR; koff[i] = row * ldk + c8 * 8; klds[i] = row * RS + ((c8 * 16) ^ ((row & 7) << 4)); }
    const int vb0 = (int)(uintptr_t)V_lds + v_rd_base(lane);
    bf16x8 sv0, sv1, sk[NKP];
#define SLOAD(k0) do { sv0 = *reinterpret_cast<const bf16x8*>(&Vh[(size_t)((k0) + sr) * ldv + sc]); sv1 = *reinterpret_cast<const bf16x8*>(&Vh[(size_t)((k0) + 32 + sr) * ldv + sc]); \
    _Pragma("unroll") for (int _q = 0; _q < NKP; ++_q) sk[_q] = *reinterpret_cast<const bf16x8*>(&Kh[(size_t)(k0) * ldk + koff[_q]]); } while (0)
#define SWRITE(b) do { *(bf16x8*)(V_lds + (b) * SHM_V + vst0) = sv0; *(bf16x8*)(V_lds + (b) * SHM_V + vst1) = sv1; \
    _Pragma("unroll") for (int _q = 0; _q < NKP; ++_q) *(bf16x8*)(K_lds + (b) * SHM_K + klds[_q]) = sk[_q]; } while (0)
#define RESC(a) do { if (__any((a) < 1.f)) { if (hi == 0) al_l[r32] = (a); asm volatile("s_waitcnt lgkmcnt(0)" ::: "memory"); \
    _Pragma("unroll") for (int d = 0; d < 4; ++d) _Pragma("unroll") for (int r = 0; r < 16; ++r) o[d][r] *= al_l[crow(r, hi)]; } } while (0)
    const int NT = seq / KVBLK;
    SLOAD(0); asm volatile("s_waitcnt vmcnt(0)" ::: "memory"); SWRITE(0); __syncthreads();
    for (int j = 0; j < NT; ++j) {
        const int b = j & 1;
        if (j + 1 < NT) SLOAD((j + 1) * KVBLK);
        SBAR();
        f32x16 p0, p1; float mn, al; bf16x8 pa0, pa1, pa2, pa3;
        { const char* Ks = K_lds + b * SHM_K; p0 = f32x16{}; p1 = f32x16{};
#pragma unroll
          for (int d0 = 0; d0 < DQK / 16; ++d0) { const int cb = (d0 * 16 + hi * 8) * 2;
              const bf16x8 b0 = *reinterpret_cast<const bf16x8*>(Ks + r32 * RS + (cb ^ ((r32 & 7) << 4)));
              const bf16x8 b1 = *reinterpret_cast<const bf16x8*>(Ks + (32 + r32) * RS + (cb ^ ((r32 & 7) << 4)));
              bf16x8 qf; if (d0 < NQR) qf = qr[d0 < NQR ? d0 : 0]; else qf = *(const bf16x8*)(qpark + (d0 - NQR) * 1024);
              p0 = __builtin_amdgcn_mfma_f32_32x32x16_bf16(b0, qf, p0, 0, 0, 0);
              p1 = __builtin_amdgcn_mfma_f32_32x32x16_bf16(b1, qf, p1, 0, 0, 0); } }
        partialSM(p0, p1, m_reg, mn, al, C, thr_raw);
        RESC(al);
        finishSM(p0, p1, al, l_reg, pa0, pa1, pa2, pa3); SBAR();
        pv_d0(o, vb0 + b * SHM_V, pa0, pa1, pa2, pa3);
        if (j + 1 < NT) { asm volatile("s_waitcnt vmcnt(0)" ::: "memory"); SWRITE(b ^ 1); }
        __syncthreads();
    }
    if (hi == 0) li_l[r32] = l_reg; asm volatile("s_waitcnt lgkmcnt(0)" ::: "memory");
    float rli[16];
#pragma unroll
    for (int r = 0; r < 16; ++r) rli[r] = __builtin_amdgcn_rcpf(li_l[crow(r, hi)]);
    float* Ow = Ob + (size_t)(wid * QBLK) * ldo;
#pragma unroll
    for (int r = 0; r < 16; ++r) { const int orow = crow(r, hi);
#pragma unroll
        for (int d0 = 0; d0 < 4; ++d0) Ow[(size_t)orow * ldo + d0 * 32 + r32] = o[d0][r] * rli[r]; }
    __syncthreads();
#undef SLOAD
#undef SWRITE
#undef RESC
}
}

struct Params {
    const float* x; const float* c; const float* ctx; const float* c_ctx; const float* w_mod; const float* b_mod; const float* g_norm1; const float* g_norm2;
    const float* w_in_ab; const float* g_cq; const float* w_uq; const float* g_ckv; const float* w_ukv; const float* g_qn_a; const float* g_kn_a; const float* lam_vec;
    const float* g_qn_b; const float* g_kn_b; const float* g_sub_b; const float* w_out_ab; const float* w_in_c; const float* g_qn_c; const float* g_kn_c; const float* w_out_c;
    const float* w_pq; const float* sub_keys; const float* expert_u; const float* expert_v;
    float* out; unsigned char* ws; int ph_lo, ph_hi;
};

typedef const __attribute__((address_space(4))) Params CParams;
struct Ctx {
    int tid, lane, wid, G, vcu, bx;
    unsigned char* ws; char* lds;
};

__device__ __forceinline__ void tconv(const Ctx& F, const float* src, bf16_t* dst, const float* gain, int nmat, int K, int N, int Npad) {
    float* tile = (float*)(F.lds + 32768);
    const int ntn = Npad / 64, ntk = K / 64, per = ntn * ntk, total = per * nmat;
    for (int it = F.vcu; it < total; it += F.G) {
        const int mat = it / per, rem = it % per, tn = rem / ntk, tk = rem % ntk, k0 = tk * 64, n0 = tn * 64;
        const float* s = src + (size_t)mat * K * N; bf16_t* d = dst + (size_t)mat * Npad * K;
        __syncthreads();
        { const int r = F.tid >> 4, c4 = (F.tid & 15) * 4;
#pragma unroll
          for (int i = 0; i < 2; ++i) { const int rr = r + i * 32; f32x4 v = (f32x4){0.f, 0.f, 0.f, 0.f};
              if (n0 + c4 < N) v = *(const f32x4*)(s + (size_t)(k0 + rr) * N + n0 + c4);
              tile[rr * 65 + c4 + 0] = v[0]; tile[rr * 65 + c4 + 1] = v[1]; tile[rr * 65 + c4 + 2] = v[2]; tile[rr * 65 + c4 + 3] = v[3]; } }
        __syncthreads();
        { const int n = F.tid >> 3, kc = (F.tid & 7) * 8; float v[8];
#pragma unroll
          for (int e = 0; e < 8; ++e) { v[e] = tile[(kc + e) * 65 + n]; if (gain) v[e] *= gain[(size_t)mat * K + k0 + kc + e]; }
          u32x4 w; w.x = cvt_pk_bf16(v[0], v[1]); w.y = cvt_pk_bf16(v[2], v[3]); w.z = cvt_pk_bf16(v[4], v[5]); w.w = cvt_pk_bf16(v[6], v[7]);
          *(u32x4*)(d + (size_t)(n0 + n) * K + k0 + kc) = w; }
    }
}
__device__ __forceinline__ void cvt_flat(const Ctx& F, const float* src, bf16_t* dst, size_t n8) {
    for (size_t i = (size_t)F.vcu * 512 + F.tid; i < n8; i += (size_t)F.G * 512) {
        const f32x4 a = *(const f32x4*)(src + i * 8), b = *(const f32x4*)(src + i * 8 + 4);
        u32x4 w; w.x = cvt_pk_bf16(a[0], a[1]); w.y = cvt_pk_bf16(a[2], a[3]); w.z = cvt_pk_bf16(b[0], b[1]); w.w = cvt_pk_bf16(b[2], b[3]);
        *(u32x4*)(dst + i * 8) = w;
    }
}
__device__ __forceinline__ void cvt_rows_fp8(const Ctx& F, const float* src, unsigned char* dst, float* descale, int R) {
    for (int row = F.vcu * 8 + F.wid; row < R; row += F.G * 8) {
        const float* s = src + (size_t)row * DM; f32x4 v[8]; float am = 0.f;
#pragma unroll
        for (int j = 0; j < 2; ++j)
#pragma unroll
            for (int i = 0; i < 4; ++i) { v[j * 4 + i] = *(const f32x4*)(s + j * 1024 + F.lane * 16 + i * 4);
#pragma unroll
                for (int e = 0; e < 4; ++e) am = fmaxf(am, fabsf(v[j * 4 + i][e])); }
#pragma unroll
        for (int o = 32; o >= 1; o >>= 1) am = fmaxf(am, __shfl_xor(am, o));
        const float sc = am > 0.f ? 384.f / am : 1.f;
#pragma unroll
        for (int j = 0; j < 2; ++j) { u32x4 w;
#pragma unroll
            for (int i = 0; i < 4; ++i) { const f32x4 x = v[j * 4 + i] * sc; unsigned p = __builtin_amdgcn_cvt_pk_fp8_f32(x[0], x[1], 0u, false); p = __builtin_amdgcn_cvt_pk_fp8_f32(x[2], x[3], p, true); w[i] = p; }
            *(u32x4*)(dst + (size_t)row * DM + j * 1024 + F.lane * 16) = w; }
        if (F.lane == 0) descale[row] = am > 0.f ? am * (1.f / 384.f) : 1.f;
    }
}
__device__ __forceinline__ float silu_f(float v) { return v / (1.f + __expf(-v)); }

__device__ __forceinline__ void prologue_phase(const Ctx& F, CParams& P) {
    unsigned char* ws = F.ws;
    {
        float* sv = (float*)F.lds;
        float* part = (float*)(F.lds + 24576);
        for (int i = F.tid; i < 3 * DM; i += 512) { const int v = i / DM, k = i % DM; const float cv = v < 2 ? P.c[v * DM + k] : P.c_ctx[k]; sv[i] = silu_f(cv); }
        __syncthreads();
        float* mod = (float*)(ws + WS_MOD);
        for (int it = F.vcu; it < DEPTH * 192; it += F.G) {
            const int l = it / 192, n0 = (it % 192) * 64;
            const float* wp = P.w_mod + ((size_t)l * DM + F.wid * 256) * 12288 + n0 + F.lane;
            float a0 = 0.f, a1 = 0.f, a2 = 0.f;
#pragma unroll 8
            for (int k = 0; k < 256; ++k) { const float w = wp[(size_t)k * 12288]; const int kk = F.wid * 256 + k; a0 += sv[kk] * w; a1 += sv[DM + kk] * w; a2 += sv[2 * DM + kk] * w; }
            part[(F.wid * 3 + 0) * 64 + F.lane] = a0; part[(F.wid * 3 + 1) * 64 + F.lane] = a1; part[(F.wid * 3 + 2) * 64 + F.lane] = a2;
            __syncthreads();
            if (F.wid < 3) { float s = 0.f;
#pragma unroll
                for (int w = 0; w < 8; ++w) s += part[(w * 3 + F.wid) * 64 + F.lane];
                mod[((size_t)l * 3 + F.wid) * 12288 + n0 + F.lane] = s + P.b_mod[(size_t)l * 12288 + n0 + F.lane]; }
            __syncthreads();
        }
    }
    if (F.vcu == 0) {
        float* t16 = (float*)(ws + WS_TAB16); float* t32 = (float*)(ws + WS_TAB32);
        for (int i = F.tid; i < 128 * 16; i += 512) { const int pos = i >> 4, f = i & 15; const float fr = powf(10000.f, -(float)f / 16.f); const float a = (float)pos * fr; float s, c; sincosf(a, &s, &c); t16[i * 2] = c; t16[i * 2 + 1] = s; }
        for (int i = F.tid; i < 128 * 32; i += 512) { const int pos = i >> 5, f = i & 31; const float fr = powf(10000.f, -(float)f / 32.f); const float a = (float)pos * fr; float s, c; sincosf(a, &s, &c); t32[i * 2] = c; t32[i * 2 + 1] = s; }
        if (F.wid < 2) { const float* lv = P.lam_vec + F.wid * 256; const float d1 = wave_sum(lv[F.lane] * lv[64 + F.lane]), d2 = wave_sum(lv[128 + F.lane] * lv[192 + F.lane]);
            const float lam_init = 0.8f - 0.6f * expf(-0.3f * (float)(2 * F.wid));
            if (F.lane == 0) ((float*)(ws + WS_LAM))[F.wid] = expf(d1) - expf(d2) + lam_init; }
    }
    tconv(F, P.w_in_ab, (bf16_t*)(ws + WS_WINAB), nullptr, 2, DM, AB_IN, AB_INP);
    tconv(F, P.w_uq, (bf16_t*)(ws + WS_WUQ), P.g_cq, 2, 768, 1536, 1536);
    tconv(F, P.w_ukv, (bf16_t*)(ws + WS_WUKV), P.g_ckv, 2, 512, 2048, 2048);
    tconv(F, P.w_out_ab, (bf16_t*)(ws + WS_WOUTAB), nullptr, 2, DM, DM, DM);
    tconv(F, P.w_in_c, (bf16_t*)(ws + WS_WINC), nullptr, 2, DM, C_IN, C_IN);
    tconv(F, P.w_out_c, (bf16_t*)(ws + WS_WOUTC), nullptr, 2, DM, DM, DM);
    tconv(F, P.w_pq, (bf16_t*)(ws + WS_WPQ), nullptr, 4, DM, DM, DM);
    cvt_flat(F, P.sub_keys, (bf16_t*)(ws + WS_SUBK), (size_t)4 * 8 * 2 * 128 * 128 / 8);
    cvt_rows_fp8(F, P.expert_u, ws + WS_EU, (float*)(ws + WS_SU), 4 * NEXP);
    cvt_rows_fp8(F, P.expert_v, ws + WS_EV, (float*)(ws + WS_SV), 4 * NEXP);
}

__device__ __forceinline__ void norm_phase(const Ctx& F, CParams& P, int layer, int which  , int m_rows) {
    float* X = (float*)(F.ws + WS_X); bf16_t* H = (bf16_t*)(F.ws + WS_H);
    const float* mod = (const float*)(F.ws + WS_MOD) + (size_t)layer * 3 * 12288;
    const float* gn = (which ? P.g_norm2 : P.g_norm1) + (size_t)layer * DM;
    const bool from_in = (layer == 0 && which == 0);
    for (int t = F.vcu * 8 + F.wid; t < m_rows; t += F.G * 8) {
        const int vs = vsel_of_row(t);
        const float* src = from_in ? (t < TL ? P.x + (size_t)t * DM : P.ctx + (size_t)(t - TL) * DM) : X + (size_t)t * DM;
        const float* shf = mod + (size_t)vs * 12288 + (which ? 3 : 0) * DM; const float* scl = shf + DM;
        f32x4 v[8]; float ss = 0.f;
#pragma unroll
        for (int j = 0; j < 8; ++j) { v[j] = *(const f32x4*)(src + j * 256 + F.lane * 4); ss += v[j][0] * v[j][0] + v[j][1] * v[j][1] + v[j][2] * v[j][2] + v[j][3] * v[j][3]; }
        ss = wave_sum(ss);
        const float rstd = rsqrtf(ss * (1.f / DM) + EPS);
#pragma unroll
        for (int j = 0; j < 8; ++j) { const int c = j * 256 + F.lane * 4;
            if (from_in) *(f32x4*)(X + (size_t)t * DM + c) = v[j];
            const f32x4 g = *(const f32x4*)(gn + c), sc = *(const f32x4*)(scl + c), sh = *(const f32x4*)(shf + c);
            f32x4 y;
#pragma unroll
            for (int e = 0; e < 4; ++e) y[e] = (v[j][e] * rstd * g[e]) * (1.f + sc[e]) + sh[e];
            u32x2 w; w.x = cvt_pk_bf16(y[0], y[1]); w.y = cvt_pk_bf16(y[2], y[3]);
            *(u32x2*)(H + (size_t)t * DM + c) = w; }
    }
}

__device__ __forceinline__ void rope16(float& x0, float& x1, int l2, int row, int col, const float* t16) {
    const int o = 2 * l2, seg = o >> 5, i = o & 31, f = i & 15, pos = seg ? col : row; const bool first = i < 16;
    const float p0 = __shfl_xor(x0, 8), p1 = __shfl_xor(x1, 8);
    const f32x4 cs = *(const f32x4*)(t16 + (pos * 16 + f) * 2);
    if (first) { x0 = x0 * cs[0] - p0 * cs[1]; x1 = x1 * cs[2] - p1 * cs[3]; }
    else       { x0 = p0 * cs[1] + x0 * cs[0]; x1 = p1 * cs[3] + x1 * cs[2]; }
}
__device__ __forceinline__ void rope32(float& x0, float& x1, int l2, int pos, const float* t32) {
    const int i = 2 * l2, f = i & 31; const bool first = i < 32;
    const float p0 = __shfl_xor(x0, 16), p1 = __shfl_xor(x1, 16);
    const f32x4 cs = *(const f32x4*)(t32 + (pos * 32 + f) * 2);
    if (first) { x0 = x0 * cs[0] - p0 * cs[1]; x1 = x1 * cs[2] - p1 * cs[3]; }
    else       { x0 = p0 * cs[1] + x0 * cs[0]; x1 = p1 * cs[3] + x1 * cs[2]; }
}
__device__ __forceinline__ void ldpair(const bf16_t* p, float& a, float& b) { const unsigned w = *(const unsigned*)p; a = bf_lo(w); b = bf_hi(w); }
__device__ __forceinline__ void stpair(bf16_t* p, float a, float b) { *(unsigned*)p = cvt_pk_bf16(a, b); }

__device__ __forceinline__ void qkv_even_phase(const Ctx& F, CParams& P, int e) {
    const bf16_t* P1 = (const bf16_t*)(F.ws + WS_P1); const bf16_t* QA = (const bf16_t*)(F.ws + WS_QA); const bf16_t* KV = (const bf16_t*)(F.ws + WS_KV);
    bf16_t* Qm = (bf16_t*)(F.ws + WS_Q1); bf16_t* Km = (bf16_t*)(F.ws + WS_K1); bf16_t* Vm = (bf16_t*)(F.ws + WS_V1);
    bf16_t* Qd = (bf16_t*)(F.ws + WS_Q2); bf16_t* Kd = (bf16_t*)(F.ws + WS_K2); bf16_t* Vd = (bf16_t*)(F.ws + WS_V2);
    const float* t16 = (const float*)(F.ws + WS_TAB16);
    const float* gqa = P.g_qn_a + e * 192; const float* gka = P.g_kn_a + e * 192; const float* gqb = P.g_qn_b + e * 64; const float* gkb = P.g_kn_b + e * 64;
    const int l2 = F.lane & 31, hw = F.lane >> 5;
    for (int t = F.vcu * 8 + F.wid; t < TT; t += F.G * 8) {
        const bool latent = t < TL; const int s = t & (SEQ - 1), row = s >> 6, col = s & 63; const int kr = krow_of(t);
        const bf16_t* p1 = P1 + (size_t)t * AB_INP;
        float ss = 0.f;
#pragma unroll
        for (int j = 0; j < 3; ++j) { const u32x2 w = *(const u32x2*)(p1 + j * 256 + F.lane * 4); const float a = bf_lo(w.x), b = bf_hi(w.x), c = bf_lo(w.y), d = bf_hi(w.y); ss += a * a + b * b + c * c + d * d; }
        ss = wave_sum(ss); const float rstd_q = rsqrtf(ss * (1.f / 768.f) + EPS);
        float s2 = 0.f;
        { const u32x4 w = *(const u32x4*)(p1 + 768 + F.lane * 8);
#pragma unroll
          for (int q = 0; q < 4; ++q) { const float a = bf_lo(w[q]), b = bf_hi(w[q]); s2 += a * a + b * b; } }
        s2 = wave_sum(s2); const float rstd_kv = rsqrtf(s2 * (1.f / 512.f) + EPS);
#pragma unroll 1
        for (int it = 0; it < 4; ++it) { const int h = it * 2 + hw; const bf16_t* src = QA + (size_t)t * 1536 + h * 192 + 2 * l2;
            float x[3][2]; float sq = 0.f;
#pragma unroll
            for (int c = 0; c < 3; ++c) { ldpair(src + c * 64, x[c][0], x[c][1]); x[c][0] *= rstd_q; x[c][1] *= rstd_q; sq += x[c][0] * x[c][0] + x[c][1] * x[c][1]; }
            sq = hw_sum(sq); const float r = rsqrtf(sq * (1.f / 192.f) + EPS);
#pragma unroll
            for (int c = 0; c < 3; ++c) { x[c][0] *= r * gqa[c * 64 + 2 * l2]; x[c][1] *= r * gqa[c * 64 + 2 * l2 + 1]; }
            if (latent) rope16(x[2][0], x[2][1], l2, row, col, t16);
            bf16_t* dst = Qm + ((size_t)t * 8 + h) * 192 + 2 * l2;
#pragma unroll
            for (int c = 0; c < 3; ++c) stpair(dst + c * 64, x[c][0], x[c][1]); }
#pragma unroll 1
        for (int it = 0; it < 4; ++it) { const int h = it * 2 + hw; const bf16_t* src = KV + (size_t)t * 2048 + h * 256 + 2 * l2;
            float x[3][2]; float sq = 0.f;
#pragma unroll
            for (int c = 0; c < 2; ++c) { ldpair(src + c * 64, x[c][0], x[c][1]); x[c][0] *= rstd_kv; x[c][1] *= rstd_kv; }
            ldpair(p1 + 1280 + 2 * l2, x[2][0], x[2][1]);
#pragma unroll
            for (int c = 0; c < 3; ++c) sq += x[c][0] * x[c][0] + x[c][1] * x[c][1];
            sq = hw_sum(sq); const float r = rsqrtf(sq * (1.f / 192.f) + EPS);
#pragma unroll
            for (int c = 0; c < 3; ++c) { x[c][0] *= r * gka[c * 64 + 2 * l2]; x[c][1] *= r * gka[c * 64 + 2 * l2 + 1]; }
            if (latent) rope16(x[2][0], x[2][1], l2, row, col, t16);
            bf16_t* dst = Km + ((size_t)kr * 8 + h) * 192 + 2 * l2;
#pragma unroll
            for (int c = 0; c < 3; ++c) stpair(dst + c * 64, x[c][0], x[c][1]);
            bf16_t* dv = Vm + ((size_t)kr * 8 + h) * 128 + 2 * l2;
#pragma unroll
            for (int c = 0; c < 2; ++c) { float a, b; ldpair(src + 128 + c * 64, a, b); stpair(dv + c * 64, a * rstd_kv, b * rstd_kv); } }
#pragma unroll 1
        for (int it = 0; it < 8; ++it) { const int hm = it * 2 + hw;
            float a, b; ldpair(p1 + 1344 + hm * 64 + 2 * l2, a, b);
            float sq = hw_sum(a * a + b * b); float r = rsqrtf(sq * (1.f / 64.f) + EPS);
            a *= r * gqb[2 * l2]; b *= r * gqb[2 * l2 + 1];
            if (latent) rope16(a, b, l2, row, col, t16);
            stpair(Qd + ((size_t)t * 16 + hm) * 64 + 2 * l2, a, b);
            ldpair(p1 + 2368 + hm * 64 + 2 * l2, a, b);
            sq = hw_sum(a * a + b * b); r = rsqrtf(sq * (1.f / 64.f) + EPS);
            a *= r * gkb[2 * l2]; b *= r * gkb[2 * l2 + 1];
            if (latent) rope16(a, b, l2, row, col, t16);
            stpair(Kd + ((size_t)kr * 16 + hm) * 64 + 2 * l2, a, b); }
#pragma unroll
        for (int j = 0; j < 2; ++j) *(u32x4*)(Vd + (size_t)kr * 1024 + j * 512 + F.lane * 8) = *(const u32x4*)(p1 + 3392 + j * 512 + F.lane * 8);
    }
}
__device__ __forceinline__ void qkv_odd_phase(const Ctx& F, CParams& P, int e) {
    const bf16_t* P1 = (const bf16_t*)(F.ws + WS_P1);
    bf16_t* Qc = (bf16_t*)(F.ws + WS_Q1); bf16_t* Kc = (bf16_t*)(F.ws + WS_K1); bf16_t* Vc = (bf16_t*)(F.ws + WS_V1);
    const float* t32 = (const float*)(F.ws + WS_TAB32);
    const float* gq = P.g_qn_c + e * 128; const float* gk = P.g_kn_c + e * 128;
    const int l2 = F.lane & 31, hw = F.lane >> 5;
    for (int t = F.vcu * 8 + F.wid; t < TT; t += F.G * 8) {
        const bool latent = t < TL; const int s = t & (SEQ - 1), row = s >> 6, col = s & 63; const int kr = krow_of(t);
        const bf16_t* p1 = P1 + (size_t)t * C_IN;
#pragma unroll 1
        for (int it = 0; it < 10; ++it) {
            const bool isq = it < 8; const int h = (isq ? it : it - 8) * 2 + hw;
            const bf16_t* src = p1 + (isq ? 0 : 2048) + h * 128 + 2 * l2; const float* g = isq ? gq : gk;
            float x[2][2]; float sq = 0.f;
#pragma unroll
            for (int c = 0; c < 2; ++c) { ldpair(src + c * 64, x[c][0], x[c][1]); sq += x[c][0] * x[c][0] + x[c][1] * x[c][1]; }
            sq = hw_sum(sq); const float r = rsqrtf(sq * (1.f / 128.f) + EPS);
#pragma unroll
            for (int c = 0; c < 2; ++c) { x[c][0] *= r * g[c * 64 + 2 * l2]; x[c][1] *= r * g[c * 64 + 2 * l2 + 1]; }
            if (latent) { rope32(x[0][0], x[0][1], l2, row, t32); rope32(x[1][0], x[1][1], l2, col, t32); }
            bf16_t* dst = isq ? Qc + ((size_t)t * 16 + h) * 128 + 2 * l2 : Kc + ((size_t)kr * 4 + h) * 128 + 2 * l2;
#pragma unroll
            for (int c = 0; c < 2; ++c) stpair(dst + c * 64, x[c][0], x[c][1]); }
        *(u32x4*)(Vc + (size_t)kr * 512 + F.lane * 8) = *(const u32x4*)(p1 + 2560 + F.lane * 8);
    }
}

template <int DQK, int SDEPTH, int ldo, int NH, int NKVH, int NVH>
__device__ __forceinline__ void attn_phase(const Ctx& F, const bf16_t* Qbuf, const bf16_t* Kbuf, const bf16_t* Vbuf, float* OF, int ocol0, bool with_ctx) {
    constexpr int kv_div = NH / NKVH, v_div = NH / NVH;
    const int n_lat = NH * NB * 32, n_tot = n_lat + (with_ctx ? NH * NB : 0);
    constexpr int ldq = NH * DQK, ldk = NKVH * DQK, ldv = NVH * 128;
    for (int u = F.vcu; u < n_tot; u += F.G) {
        int b, h, qrow0, kstart, seq;
        if (u < n_lat) { const int bh = u >> 5, qb = u & 31; b = bh / NH; h = bh % NH; qrow0 = b * SEQ + qb * 256; kstart = b * KPB; seq = KPB; }
        else { const int bh = u - n_lat; b = bh / NH; h = bh % NH; qrow0 = TL + b * CTXL; kstart = b * KPB + SEQ; seq = CTXL; }
        const bf16_t* Qp = Qbuf + ((size_t)qrow0 * NH + h) * DQK;
        const bf16_t* Kp = Kbuf + ((size_t)kstart * NKVH + h / kv_div) * DQK;
        const bf16_t* Vp = Vbuf + ((size_t)kstart * NVH + h / v_div) * 128;
        float* Op = OF + (size_t)qrow0 * ldo + ocol0 + h * 128;
        if constexpr (SDEPTH == 0) att::attn_body_simple<DQK, (DQK == 192 ? MLA_QL : 0), ldq, ldk, ldv, ldo>(Qp, Kp, Vp, Op, seq, F.lds);
        else att::attn_body<DQK, SDEPTH, ldq, ldk, ldv, ldo>(Qp, Kp, Vp, Op, seq, F.lds);
    }
}

__device__ __forceinline__ void merge_even_phase(const Ctx& F, CParams& P, int e, int layer, int m_rows) {
    const float* OF = (const float*)(F.ws + WS_OF); bf16_t* AO = (bf16_t*)(F.ws + WS_AO);
    const float lam = ((const float*)(F.ws + WS_LAM))[e];
    const float lam_init = 0.8f - 0.6f * expf(-0.3f * (float)layer);
    const float* gs = P.g_sub_b + e * 128;
    const int l2 = F.lane & 31, hw = F.lane >> 5;
    for (int t = F.vcu * 8 + F.wid; t < m_rows; t += F.G * 8) {
        const float* of = OF + (size_t)t * 3072; bf16_t* ao = AO + (size_t)t * DM;
#pragma unroll
        for (int j = 0; j < 4; ++j) { const f32x4 v = *(const f32x4*)(of + j * 256 + F.lane * 4); u32x2 w; w.x = cvt_pk_bf16(v[0], v[1]); w.y = cvt_pk_bf16(v[2], v[3]); *(u32x2*)(ao + j * 256 + F.lane * 4) = w; }
#pragma unroll
        for (int it = 0; it < 4; ++it) { const int h = it * 2 + hw;
            const f32x4 o0 = *(const f32x4*)(of + 1024 + (2 * h) * 128 + l2 * 4), o1 = *(const f32x4*)(of + 1024 + (2 * h + 1) * 128 + l2 * 4);
            f32x4 d = o0 - lam * o1;
            float sq = hw_sum(d[0] * d[0] + d[1] * d[1] + d[2] * d[2] + d[3] * d[3]);
            const float r = rsqrtf(sq * (1.f / 128.f) + EPS) * (1.f - lam_init);
            const f32x4 g = *(const f32x4*)(gs + l2 * 4);
            u32x2 w; w.x = cvt_pk_bf16(d[0] * r * g[0], d[1] * r * g[1]); w.y = cvt_pk_bf16(d[2] * r * g[2], d[3] * r * g[3]);
            *(u32x2*)(ao + 1024 + h * 128 + l2 * 4) = w; }
    }
}
__device__ __forceinline__ void merge_odd_phase(const Ctx& F, int m_rows) {
    const float* OF = (const float*)(F.ws + WS_OF); bf16_t* AO = (bf16_t*)(F.ws + WS_AO);
    for (int t = F.vcu * 8 + F.wid; t < m_rows; t += F.G * 8) {
        const float* of = OF + (size_t)t * 2048; bf16_t* ao = AO + (size_t)t * DM;
#pragma unroll
        for (int j = 0; j < 8; ++j) { const f32x4 v = *(const f32x4*)(of + j * 256 + F.lane * 4); u32x2 w; w.x = cvt_pk_bf16(v[0], v[1]); w.y = cvt_pk_bf16(v[2], v[3]); *(u32x2*)(ao + j * 256 + F.lane * 4) = w; }
    }
}

__device__ __forceinline__ void wave_lds_fence() { asm volatile("s_waitcnt lgkmcnt(0)" ::: "memory"); __builtin_amdgcn_wave_barrier(); asm volatile("" ::: "memory"); }
__device__ __forceinline__ unsigned fkey(float f) { const unsigned b = __float_as_uint(f); return b ^ ((unsigned)((int)b >> 31) | 0x80000000u); }
__device__ __forceinline__ float funkey(unsigned k) { return __uint_as_float((k & 0x80000000u) ? (k ^ 0x80000000u) : ~k); }
__device__ __forceinline__ unsigned umed3(unsigned a, unsigned b, unsigned c) { unsigned r; asm("v_med3_u32 %0, %1, %2, %3" : "=v"(r) : "v"(a), "v"(b), "v"(c)); return r; }
__device__ __forceinline__ void kins16(unsigned (&L)[16], unsigned k) {
#pragma unroll
    for (int p = 15; p >= 1; --p) L[p] = umed3(L[p - 1], L[p], k);
    L[0] = L[0] > k ? L[0] : k;
}
__device__ __forceinline__ void scan_set(unsigned (&L)[16], const bf16_t* qbase  , const bf16_t* kbase  , float* buf, int lane) {
    const int r32 = lane & 31, hi = lane >> 5;
#pragma unroll
    for (int p = 0; p < 16; ++p) L[p] = 0u;
    bf16x8 a0[8], a1[8];
    { const bf16_t* ap = qbase + (size_t)r32 * DM + hi * 8;
#pragma unroll
      for (int ks = 0; ks < 8; ++ks) { a0[ks] = *(const bf16x8*)(ap + ks * 16); a1[ks] = *(const bf16x8*)(ap + (size_t)32 * DM + ks * 16); } }
#pragma unroll 1
    for (int kb = 0; kb < 4; ++kb) {
        f32x16 acc0 = {}, acc1 = {};
        { const bf16_t* bp = kbase + (size_t)(kb * 32 + r32) * 128 + hi * 8;
          bf16x8 b[8];
#pragma unroll
          for (int ks = 0; ks < 8; ++ks) b[ks] = *(const bf16x8*)(bp + ks * 16);
#pragma unroll
          for (int ks = 0; ks < 8; ++ks) { acc0 = __builtin_amdgcn_mfma_f32_32x32x16_bf16(a0[ks], b[ks], acc0, 0, 0, 0); acc1 = __builtin_amdgcn_mfma_f32_32x32x16_bf16(a1[ks], b[ks], acc1, 0, 0, 0); } }
        wave_lds_fence();
#pragma unroll
        for (int r = 0; r < 16; ++r) { const int rowi = att::crow(r, hi); buf[rowi * 33 + r32] = acc0[r]; buf[(32 + rowi) * 33 + r32] = acc1[r]; }
        wave_lds_fence();
        const unsigned tb = 127u - (unsigned)(kb * 32);
#pragma unroll 8
        for (int k = 0; k < 32; ++k) kins16(L, (fkey(buf[lane * 33 + k]) & ~127u) | (tb - (unsigned)k));
    }
}
__device__ __forceinline__ void peer_select_phase(const Ctx& F, int layer, int m_rows) {
    const bf16_t* PQ = (const bf16_t*)(F.ws + WS_PQ); const bf16_t* SK = (const bf16_t*)(F.ws + WS_SUBK) + (size_t)layer * 8 * 2 * 128 * 128;
    int* PIDX = (int*)(F.ws + WS_PIDX); float* PG = (float*)(F.ws + WS_PG);
    float* buf = (float*)F.lds + F.wid * (64 * 33);
    const int lane = F.lane;
    const int nunits = (m_rows / 64) * 8;
    for (int u = F.vcu * 8 + F.wid; u < nunits; u += F.G * 8) {
        const int tile = u >> 3, h = u & 7, t0 = tile * 64;
        unsigned Ka[16], Kb[16];
        scan_set(Ka, PQ + (size_t)t0 * DM + h * 256, SK + (size_t)(h * 2) * 128 * 128, buf, lane);
        scan_set(Kb, PQ + (size_t)t0 * DM + h * 256 + 128, SK + (size_t)(h * 2 + 1) * 128 * 128, buf, lane);
        wave_lds_fence();
        float la[16], lb[16];
#pragma unroll
        for (int p = 0; p < 16; ++p) { la[p] = funkey(Ka[p] & ~127u); lb[p] = funkey(Kb[p] & ~127u);
            buf[lane * 33 + p] = __int_as_float(127 - (int)(Ka[p] & 127u)); buf[lane * 33 + 16 + p] = __int_as_float(127 - (int)(Kb[p] & 127u)); }
        wave_lds_fence();
        unsigned Kc[16];
#pragma unroll
        for (int p = 0; p < 16; ++p) Kc[p] = 0u;
#pragma unroll
        for (int r1 = 0; r1 < 16; ++r1)
#pragma unroll
            for (int r2 = 0; r2 < 16; ++r2) if ((r1 + 1) * (r2 + 1) <= 16) kins16(Kc, (fkey(la[r1] + lb[r2]) & ~255u) | (unsigned)(255 - (16 * r1 + r2)));
        float bv[16], sm = 0.f; unsigned idx[16];
#pragma unroll
        for (int p = 0; p < 16; ++p) { const int code = 255 - (int)(Kc[p] & 255u); bv[p] = funkey(Kc[p] & ~255u);
            idx[p] = (unsigned)(__float_as_int(buf[lane * 33 + (code >> 4)]) * 128 + __float_as_int(buf[lane * 33 + 16 + (code & 15)])); }
        const float bmax = bv[0];
#pragma unroll
        for (int p = 0; p < 16; ++p) { bv[p] = __expf(bv[p] - bmax); sm += bv[p]; }
        const float inv = 1.f / sm;
        const size_t o = ((size_t)(t0 + lane) * 8 + h) * 16;
#pragma unroll
        for (int q = 0; q < 4; ++q) { *(f32x4*)(PG + o + q * 4) = (f32x4){bv[q * 4] * inv, bv[q * 4 + 1] * inv, bv[q * 4 + 2] * inv, bv[q * 4 + 3] * inv};
            *(u32x4*)(PIDX + o + q * 4) = (u32x4){idx[q * 4], idx[q * 4 + 1], idx[q * 4 + 2], idx[q * 4 + 3]}; }
    }
}

__device__ __forceinline__ float gelu_tanh(float a) { const float u = 0.7978845608028654f * (a + 0.044715f * a * a * a); const float t = 1.f - 2.f / (1.f + __expf(2.f * u)); return 0.5f * a * (1.f + t); }
struct Row8 { u32x4 r[2]; };
__device__ __forceinline__ void ld_row8(Row8& R, const unsigned char* tab, int e, int lane) {
    const u32x4* rp = (const u32x4*)(tab + (size_t)e * DM);
    R.r[0] = rp[lane]; R.r[1] = rp[64 + lane];
}
__device__ __forceinline__ float dot_row8(const Row8& R, const float (&h)[32]) {
    float s0 = 0.f, s1 = 0.f, s2 = 0.f, s3 = 0.f;
#pragma unroll
    for (int j = 0; j < 2; ++j)
#pragma unroll
        for (int q = 0; q < 4; ++q) { const unsigned w = R.r[j][q]; const f32x2 lo = __builtin_amdgcn_cvt_pk_f32_fp8(w, false), hi = __builtin_amdgcn_cvt_pk_f32_fp8(w, true);
            s0 = fmaf(lo[0], h[j * 16 + q * 4 + 0], s0); s1 = fmaf(lo[1], h[j * 16 + q * 4 + 1], s1); s2 = fmaf(hi[0], h[j * 16 + q * 4 + 2], s2); s3 = fmaf(hi[1], h[j * 16 + q * 4 + 3], s3); }
    return (s0 + s1) + (s2 + s3);
}
__device__ __forceinline__ void fma_row8(float (&out)[32], const Row8& R, float w) {
#pragma unroll
    for (int j = 0; j < 2; ++j)
#pragma unroll
        for (int q = 0; q < 4; ++q) { const unsigned x = R.r[j][q]; const f32x2 lo = __builtin_amdgcn_cvt_pk_f32_fp8(x, false), hi = __builtin_amdgcn_cvt_pk_f32_fp8(x, true);
            out[j * 16 + q * 4 + 0] = fmaf(w, lo[0], out[j * 16 + q * 4 + 0]); out[j * 16 + q * 4 + 1] = fmaf(w, lo[1], out[j * 16 + q * 4 + 1]);
            out[j * 16 + q * 4 + 2] = fmaf(w, hi[0], out[j * 16 + q * 4 + 2]); out[j * 16 + q * 4 + 3] = fmaf(w, hi[1], out[j * 16 + q * 4 + 3]); }
}
__device__ __forceinline__ float reduce4(float s0, float s1, float s2, float s3, int lane) {
    const bool hi = (lane & 32) != 0, b4 = (lane & 16) != 0;
    const float r0 = __shfl_xor(hi ? s0 : s2, 32), r1 = __shfl_xor(hi ? s1 : s3, 32);
    const float a0 = (hi ? s2 : s0) + r0, a1 = (hi ? s3 : s1) + r1;
    const float r = __shfl_xor(b4 ? a0 : a1, 16);
    float b = (b4 ? a1 : a0) + r;
#pragma unroll
    for (int o = 8; o >= 1; o >>= 1) b += __shfl_xor(b, o);
    return b;
}
__device__ __forceinline__ float rl_f(float v, int l) { return __uint_as_float(__builtin_amdgcn_readlane(__float_as_uint(v), l)); }
__device__ __forceinline__ void peer_expert_phase(const Ctx& F, CParams& P, int layer, int m_rows, bool last, bool dry) {
    const unsigned char* EU = F.ws + WS_EU + (size_t)layer * NEXP * DM; const unsigned char* EV = F.ws + WS_EV + (size_t)layer * NEXP * DM;
    const float* SU = (const float*)(F.ws + WS_SU) + (size_t)layer * NEXP; const float* SV = (const float*)(F.ws + WS_SV) + (size_t)layer * NEXP;
    const bf16_t* H = (const bf16_t*)(F.ws + WS_H); float* X = (float*)(F.ws + WS_X);
    const int* PIDX = (const int*)(F.ws + WS_PIDX); const float* PG = (const float*)(F.ws + WS_PG);
    const float* mod = (const float*)(F.ws + WS_MOD) + (size_t)layer * 3 * 12288;
    const int lane = F.lane;
    for (int t = F.vcu * 8 + F.wid; t < m_rows; t += F.G * 8) {
        float hf[32];
#pragma unroll
        for (int j = 0; j < 2; ++j) { const u32x4* hp = (const u32x4*)(H + (size_t)t * DM + j * 1024 + lane * 16); const u32x4 w0 = hp[0], w1 = hp[1];
#pragma unroll
            for (int q = 0; q < 4; ++q) { hf[j * 16 + q * 2] = bf_lo(w0[q]); hf[j * 16 + q * 2 + 1] = bf_hi(w0[q]); hf[j * 16 + 8 + q * 2] = bf_lo(w1[q]); hf[j * 16 + 8 + q * 2 + 1] = bf_hi(w1[q]); } }
        int id[2]; float wv[2];
        id[0] = PIDX[(size_t)t * 128 + lane]; id[1] = PIDX[(size_t)t * 128 + 64 + lane];
#pragma unroll
        for (int half = 0; half < 2; ++half) {
            const int idr = id[half]; float acc = 0.f;
            const float gk = PG[(size_t)t * 128 + half * 64 + lane], su = SU[idr], sv = SV[idr];
            Row8 A[4], B[4];
#pragma unroll
            for (int q = 0; q < 4; ++q) ld_row8(A[q], EU, __builtin_amdgcn_readlane(idr, q), lane);
#pragma unroll 1
            for (int k = 0; k < 64; k += 8) {
#pragma unroll
                for (int q = 0; q < 4; ++q) ld_row8(B[q], EU, __builtin_amdgcn_readlane(idr, k + 4 + q), lane);
                { const float b = reduce4(dot_row8(A[0], hf), dot_row8(A[1], hf), dot_row8(A[2], hf), dot_row8(A[3], hf), lane);
#pragma unroll
                  for (int q = 0; q < 4; ++q) { const float tq = rl_f(b, 16 * q); acc = (lane == k + q) ? tq : acc; } }
                if (k + 8 < 64) {
#pragma unroll
                    for (int q = 0; q < 4; ++q) ld_row8(A[q], EU, __builtin_amdgcn_readlane(idr, k + 8 + q), lane); }
                { const float b = reduce4(dot_row8(B[0], hf), dot_row8(B[1], hf), dot_row8(B[2], hf), dot_row8(B[3], hf), lane);
#pragma unroll
                  for (int q = 0; q < 4; ++q) { const float tq = rl_f(b, 16 * q); acc = (lane == k + 4 + q) ? tq : acc; } }
            }
            wv[half] = gk * gelu_tanh(acc * su) * sv;
        }
        float out[32];
#pragma unroll
        for (int i = 0; i < 32; ++i) out[i] = 0.f;
#pragma unroll
        for (int half = 0; half < 2; ++half) {
            const int idr = id[half]; const float wr = wv[half];
            Row8 A[4], B[4];
#pragma unroll
            for (int q = 0; q < 4; ++q) ld_row8(A[q], EV, __builtin_amdgcn_readlane(idr, q), lane);
#pragma unroll 1
            for (int k = 0; k < 64; k += 8) {
#pragma unroll
                for (int q = 0; q < 4; ++q) ld_row8(B[q], EV, __builtin_amdgcn_readlane(idr, k + 4 + q), lane);
#pragma unroll
                for (int q = 0; q < 4; ++q) fma_row8(out, A[q], rl_f(wr, k + q));
                if (k + 8 < 64) {
#pragma unroll
                    for (int q = 0; q < 4; ++q) ld_row8(A[q], EV, __builtin_amdgcn_readlane(idr, k + 8 + q), lane); }
#pragma unroll
                for (int q = 0; q < 4; ++q) fma_row8(out, B[q], rl_f(wr, k + 4 + q));
            }
        }
        const float* gate = mod + (size_t)vsel_of_row(t) * 12288 + 5 * DM;
        float* xr = X + (size_t)t * DM; float* dst = dry ? (float*)(F.ws + WS_OF) + (size_t)t * DM : (last ? P.out + (size_t)t * DM : xr);
#pragma unroll
        for (int j = 0; j < 2; ++j)
#pragma unroll
            for (int q = 0; q < 4; ++q) { const int c = j * 1024 + lane * 16 + q * 4; const f32x4 xo = *(const f32x4*)(xr + c), g = *(const f32x4*)(gate + c);
                f32x4 y; y[0] = xo[0] + g[0] * out[j * 16 + q * 4 + 0]; y[1] = xo[1] + g[1] * out[j * 16 + q * 4 + 1]; y[2] = xo[2] + g[2] * out[j * 16 + q * 4 + 2]; y[3] = xo[3] + g[3] * out[j * 16 + q * 4 + 3];
                *(f32x4*)(dst + c) = y; }
    }
}

constexpr int N_PHASES = 1 + 2 * 11 + 2 * 10;
__global__ void __launch_bounds__(512, 2) mk_fwd(Params Pval) {
    extern __shared__ __attribute__((aligned(16))) unsigned char lds_raw[];
    LAS unsigned char* ldsl = (LAS unsigned char*)lds_raw;
    volatile LAS unsigned* misc = (volatile LAS unsigned*)(ldsl + LDS_MISC);
    if (threadIdx.x < 16) misc[threadIdx.x] = 0u;
    __syncthreads();
    XcdBarrier bar = xcd_barrier_post((unsigned*)(Pval.ws + WS_CTL) + 1024, misc);
    const int lo = Pval.ph_lo, hi = Pval.ph_hi; int ph = 0;
#define MKCTX() Ctx F; { int tid_ = threadIdx.x; asm volatile("" : "+v"(tid_)); F.tid = tid_; F.lane = tid_ & 63; F.wid = __builtin_amdgcn_readfirstlane(tid_ >> 6); \
        int G_ = gridDim.x, bx_ = blockIdx.x; asm volatile("" : "+s"(G_), "+s"(bx_)); F.G = G_; F.vcu = (G_ % 8 == 0) ? (bx_ % 8) * (G_ / 8) + bx_ / 8 : bx_; F.bx = bx_; } \
        unsigned long long kp_ = (unsigned long long)__builtin_amdgcn_kernarg_segment_ptr(); asm volatile("" : "+s"(kp_)); CParams& P = *(CParams*)kp_; \
        F.ws = P.ws; F.lds = (char*)lds_raw; unsigned char* ws = F.ws; (void)ws; \
        bf16_t* Hb = (bf16_t*)(ws + WS_H); bf16_t* P1 = (bf16_t*)(ws + WS_P1); float* X = (float*)(ws + WS_X); const float* mod = (const float*)(ws + WS_MOD); (void)Hb; (void)P1; (void)X; (void)mod;
#define PHASE(cls, ...) do { if (ph >= lo && ph < hi) { if constexpr ((PH_MASK >> (cls)) & 1u) { \
        if constexpr ((PH_DOUBLE >> (cls)) & 1u) { const bool dry = true; (void)dry; MKCTX(); __VA_ARGS__; __syncthreads(); } \
        { const bool dry = false; (void)dry; MKCTX(); __VA_ARGS__; } } if (ph + 1 < hi) xcd_barrier(bar); } ++ph; } while (0)

    PHASE(0, prologue_phase(F, P));
#pragma unroll 1
    for (int layer = 0; layer < DEPTH; ++layer) {
        const int e = layer >> 1; const bool even = (layer & 1) == 0, lastl = layer == DEPTH - 1;
        const int m_post = lastl ? TL : TT;
        PHASE(1, norm_phase(F, P, layer, 0, TT));
        PHASE(2, { const bf16_t* W = even ? (const bf16_t*)(ws + WS_WINAB) + (size_t)e * AB_INP * DM : (const bf16_t*)(ws + WS_WINC) + (size_t)e * C_IN * DM;
                const int N = even ? AB_INP : C_IN;
                pg8::Gemm g{Hb, W, TT, N, DM, DM}; pg8::StaticOrder S; S.init(TT, N, F.G, F.bx);
                pg8::EpiBf16 E{P1, N};
                pg8::gemm_phase<pg8::EpiBf16, pg8::StaticOrder>(ldsl, g, S, E); });
        if (even) {
            PHASE(3, { { pg8::Gemm g{P1, (const bf16_t*)(ws + WS_WUQ) + (size_t)e * 1536 * 768, TT, 1536, 768, AB_INP}; pg8::StaticOrder S; S.init(TT, 1536, F.G, F.bx);
                      pg8::EpiBf16 E{(bf16_t*)(ws + WS_QA), 1536};
                      pg8::gemm_phase<pg8::EpiBf16, pg8::StaticOrder>(ldsl, g, S, E); }
                    { pg8::Gemm g{P1 + 768, (const bf16_t*)(ws + WS_WUKV) + (size_t)e * 2048 * 512, TT, 2048, 512, AB_INP}; pg8::StaticOrder S; S.init(TT, 2048, F.G, F.bx);
                      pg8::EpiBf16 E{(bf16_t*)(ws + WS_KV), 2048};
                      pg8::gemm_phase<pg8::EpiBf16, pg8::StaticOrder>(ldsl, g, S, E); } });
            PHASE(4, qkv_even_phase(F, P, e));
            PHASE(5, { if constexpr (ATT_SEL & 1) attn_phase<192, MLA_SD, 3072, 8, 8, 8>(F, (const bf16_t*)(ws + WS_Q1), (const bf16_t*)(ws + WS_K1), (const bf16_t*)(ws + WS_V1), (float*)(ws + WS_OF), 0, !lastl);
                    if constexpr (ATT_SEL & 2) attn_phase<64, 2, 3072, 16, 16, 8>(F, (const bf16_t*)(ws + WS_Q2), (const bf16_t*)(ws + WS_K2), (const bf16_t*)(ws + WS_V2), (float*)(ws + WS_OF), 1024, !lastl); });
            PHASE(6, merge_even_phase(F, P, e, layer, m_post));
        } else {
            PHASE(7, qkv_odd_phase(F, P, e));
            PHASE(8, attn_phase<128, GQA_SD, 2048, 16, 4, 4>(F, (const bf16_t*)(ws + WS_Q1), (const bf16_t*)(ws + WS_K1), (const bf16_t*)(ws + WS_V1), (float*)(ws + WS_OF), 0, !lastl));
            PHASE(9, merge_odd_phase(F, m_post));
        }
        PHASE(10, { const bf16_t* W = even ? (const bf16_t*)(ws + WS_WOUTAB) + (size_t)e * DM * DM : (const bf16_t*)(ws + WS_WOUTC) + (size_t)e * DM * DM;
                pg8::Gemm g{(const bf16_t*)(ws + WS_AO), W, m_post, DM, DM, DM}; pg8::StaticOrder S; S.init(m_post, DM, F.G, F.bx);
                pg8::EpiResid E{X, mod + (size_t)layer * 3 * 12288, 2};
                pg8::gemm_phase<pg8::EpiResid, pg8::StaticOrder>(ldsl, g, S, E); });
        PHASE(1, norm_phase(F, P, layer, 1, m_post));
        PHASE(11, { pg8::Gemm g{Hb, (const bf16_t*)(ws + WS_WPQ) + (size_t)layer * DM * DM, m_post, DM, DM, DM}; pg8::StaticOrder S; S.init(m_post, DM, F.G, F.bx);
                pg8::EpiBf16 E{(bf16_t*)(ws + WS_PQ), DM};
                pg8::gemm_phase<pg8::EpiBf16, pg8::StaticOrder>(ldsl, g, S, E); });
        PHASE(12, peer_select_phase(F, layer, m_post));
        PHASE(13, peer_expert_phase(F, P, layer, m_post, lastl, dry));
    }
#undef PHASE
}

extern "C" void kernel_launch(void* const* d_in, const int* in_sizes, int n_in, void* d_out, int out_size, void* d_ws, size_t ws_size, hipStream_t stream) {
    static int grid = 0;
    if (grid == 0) {
        if (n_in != 28 || ws_size < WS_END) { fprintf(stderr, "kernel_launch: expected 28 inputs and >= %zu bytes of workspace, got %d / %zu\n", (size_t)WS_END, n_in, ws_size); grid = -1; return; }
        int dev = 0, cus = 0, per_cu = 0;
        if (hipGetDevice(&dev) != hipSuccess || hipDeviceGetAttribute(&cus, hipDeviceAttributeMultiprocessorCount, dev) != hipSuccess) { grid = -1; return; }
        if (hipFuncSetAttribute((const void*)mk_fwd, hipFuncAttributeMaxDynamicSharedMemorySize, LDS_BYTES) != hipSuccess) { fprintf(stderr, "kernel_launch: hipFuncSetAttribute failed\n"); grid = -1; return; }
        if (hipOccupancyMaxActiveBlocksPerMultiprocessor(&per_cu, (const void*)mk_fwd, 512, LDS_BYTES) != hipSuccess || per_cu < 1) fprintf(stderr, "kernel_launch: occupancy query says %d\n", per_cu);
        (void)hipGetLastError();
        grid = cus;
    }
    if (grid < 0) return;
    (void)hipMemsetAsync((char*)d_ws + WS_CTL, 0, CTL_BYTES, stream);
    Params p{};
    const float** pf = (const float**)&p;
    for (int i = 0; i < 28; ++i) pf[i] = (const float*)d_in[i];
    p.out = (float*)d_out; p.ws = (unsigned char*)d_ws;
#if MK_PER_PHASE_LAUNCH
    for (int i = 0; i < N_PHASES; ++i) { p.ph_lo = i; p.ph_hi = i + 1; hipLaunchKernelGGL(mk_fwd, dim3(grid), dim3(512), LDS_BYTES, stream, p); }
#else
    p.ph_lo = 0; p.ph_hi = N_PHASES;
    hipLaunchKernelGGL(mk_fwd, dim3(grid), dim3(512), LDS_BYTES, stream, p);
#endif
    const hipError_t le = hipPeekAtLastError();
    if (le != hipSuccess) fprintf(stderr, "kernel_launch: launch failed: %s\n", hipGetErrorName(le));
}
```

```cpp
#include <hip/hip_runtime.h>
#include <stdint.h>
#include <stdio.h>

#ifndef MK_PER_PHASE_LAUNCH
#define MK_PER_PHASE_LAUNCH 0
#endif

#ifndef MLA_QL
#define MLA_QL 0
#endif
#ifndef GQA_QL
#define GQA_QL 0
#endif
#ifndef QKT_GRP
#define QKT_GRP 12
#endif
#ifndef MLA_SD
#define MLA_SD 1
#endif
#ifndef GQA_SD
#define GQA_SD 2
#endif
#ifndef ATT_SEL
#define ATT_SEL 3
#endif
#ifndef PH_DOUBLE
#define PH_DOUBLE 0u
#endif
#ifndef PH_MASK
#define PH_MASK 0xFFFFFFFFu
#endif
#define LAS __attribute__((address_space(3)))
typedef unsigned short bf16_t;
typedef short bf16x8 __attribute__((ext_vector_type(8)));
typedef short s16x4 __attribute__((ext_vector_type(4)));
typedef float f32x4 __attribute__((ext_vector_type(4)));
typedef float f32x2 __attribute__((ext_vector_type(2)));
typedef float f32x16 __attribute__((ext_vector_type(16)));
typedef unsigned u32x4 __attribute__((ext_vector_type(4)));
typedef unsigned u32x2 __attribute__((ext_vector_type(2)));
typedef __bf16 bf16x2_t __attribute__((ext_vector_type(2)));

constexpr int DM = 2048, NB = 2, SEQ = 8192, DEPTH = 4, CTXL = 256;
constexpr int TL = NB * SEQ;
constexpr int TZ = NB * CTXL;
constexpr int TT = TL + TZ;
constexpr int KPB = SEQ + CTXL;
constexpr int AB_IN = 4416, AB_INP = 4608;
constexpr int C_IN = 3072;
constexpr int NEXP = 16384;
constexpr float EPS = 1e-6f;
constexpr float LOG2E = 1.4426950408889634f;

constexpr size_t al256(size_t x) { return (x + 255) / 256 * 256; }
constexpr size_t WS_CTL = 0, CTL_BYTES = 1u << 20;
constexpr size_t WS_MOD = WS_CTL + CTL_BYTES;
constexpr size_t WS_TAB16 = WS_MOD + al256((size_t)4 * 3 * 12288 * 4);
constexpr size_t WS_TAB32 = WS_TAB16 + al256((size_t)128 * 16 * 2 * 4);
constexpr size_t WS_LAM = WS_TAB32 + al256((size_t)128 * 32 * 2 * 4);
constexpr size_t WS_WINAB = WS_LAM + 256;
constexpr size_t WS_WUQ = WS_WINAB + (size_t)2 * AB_INP * DM * 2;
constexpr size_t WS_WUKV = WS_WUQ + (size_t)2 * 1536 * 768 * 2;
constexpr size_t WS_WOUTAB = WS_WUKV + (size_t)2 * 2048 * 512 * 2;
constexpr size_t WS_WINC = WS_WOUTAB + (size_t)2 * DM * DM * 2;
constexpr size_t WS_WOUTC = WS_WINC + (size_t)2 * C_IN * DM * 2;
constexpr size_t WS_WPQ = WS_WOUTC + (size_t)2 * DM * DM * 2;
constexpr size_t WS_SUBK = WS_WPQ + (size_t)4 * DM * DM * 2;
constexpr size_t WS_EU = WS_SUBK + (size_t)4 * 8 * 2 * 128 * 128 * 2;
constexpr size_t WS_EV = WS_EU + (size_t)4 * NEXP * DM;
constexpr size_t WS_SU = WS_EV + (size_t)4 * NEXP * DM;
constexpr size_t WS_SV = WS_SU + (size_t)4 * NEXP * 4;
constexpr size_t WS_X = WS_SV + (size_t)4 * NEXP * 4;
constexpr size_t WS_H = WS_X + (size_t)TT * DM * 4;
constexpr size_t WS_P1 = WS_H + (size_t)TT * DM * 2;
constexpr size_t WS_QA = WS_P1 + (size_t)TT * AB_INP * 2;
constexpr size_t WS_KV = WS_QA + (size_t)TT * 1536 * 2;
constexpr size_t WS_Q1 = WS_KV + (size_t)TT * 2048 * 2;
constexpr size_t WS_K1 = WS_Q1 + (size_t)TT * 2048 * 2;
constexpr size_t WS_V1 = WS_K1 + (size_t)TT * 1536 * 2;
constexpr size_t WS_Q2 = WS_V1 + (size_t)TT * 1024 * 2;
constexpr size_t WS_K2 = WS_Q2 + (size_t)TT * 1024 * 2;
constexpr size_t WS_V2 = WS_K2 + (size_t)TT * 1024 * 2;
constexpr size_t WS_OF = WS_V2 + (size_t)TT * 1024 * 2;
constexpr size_t WS_AO = WS_OF + (size_t)TT * 3072 * 4;
constexpr size_t WS_PQ = WS_AO + (size_t)TT * DM * 2;
constexpr size_t WS_PIDX = WS_PQ + (size_t)TT * DM * 2;
constexpr size_t WS_PG = WS_PIDX + (size_t)TT * 128 * 4;
constexpr size_t WS_END = WS_PG + (size_t)TT * 128 * 4;

constexpr int LDS_MAIN = 157696;
constexpr int LDS_MISC = LDS_MAIN;
constexpr int LDS_BYTES = LDS_MAIN + 4096;

__device__ __forceinline__ unsigned cvt_pk_bf16(float lo, float hi) { unsigned r; asm("v_cvt_pk_bf16_f32 %0, %1, %2" : "=v"(r) : "v"(lo), "v"(hi)); return r; }
__device__ __forceinline__ float bf_lo(unsigned w) { return __uint_as_float(w << 16); }
__device__ __forceinline__ float bf_hi(unsigned w) { return __uint_as_float(w & 0xffff0000u); }
template <int M> __device__ __forceinline__ float swz_xor(float v) { return __int_as_float(__builtin_amdgcn_ds_swizzle(__float_as_int(v), (M << 10) | 0x1f)); }
__device__ __forceinline__ float xor32_partner(float v, int lane) {
    const auto rr = __builtin_amdgcn_permlane32_swap(__float_as_uint(v), __float_as_uint(v), false, false);
    return __uint_as_float(lane < 32 ? rr[1] : rr[0]);
}
__device__ __forceinline__ float hw_sum(float v) {
    v += swz_xor<16>(v); v += swz_xor<8>(v); v += swz_xor<4>(v); v += swz_xor<2>(v); v += swz_xor<1>(v);
    return v;
}
__device__ __forceinline__ float wave_sum(float v) {
    v = hw_sum(v);
    const auto rr = __builtin_amdgcn_permlane32_swap(__float_as_uint(v), __float_as_uint(v), false, false);
    return __uint_as_float(rr[0]) + __uint_as_float(rr[1]);
}
__device__ __forceinline__ float wave_max(float v) {
    v = fmaxf(v, swz_xor<16>(v)); v = fmaxf(v, swz_xor<8>(v)); v = fmaxf(v, swz_xor<4>(v)); v = fmaxf(v, swz_xor<2>(v)); v = fmaxf(v, swz_xor<1>(v));
    const auto rr = __builtin_amdgcn_permlane32_swap(__float_as_uint(v), __float_as_uint(v), false, false);
    return fmaxf(__uint_as_float(rr[0]), __uint_as_float(rr[1]));
}
__device__ __forceinline__ int mbcnt64(unsigned long long m) { return (int)__builtin_amdgcn_mbcnt_hi((unsigned)(m >> 32), __builtin_amdgcn_mbcnt_lo((unsigned)m, 0u)); }
__device__ __forceinline__ int fresh_lane() { int l; asm volatile("v_mbcnt_lo_u32_b32 %0, -1, 0\n\tv_mbcnt_hi_u32_b32 %0, -1, %0" : "=v"(l)); return l; }
__device__ __forceinline__ int krow_of(int t) { return t < TL ? (t >> 13) * KPB + (t & (SEQ - 1)) : ((t - TL) >> 8) * KPB + SEQ + ((t - TL) & (CTXL - 1)); }
__device__ __forceinline__ int vsel_of_row(int t) { return t < SEQ ? 0 : (t < TL ? 1 : 2); }

#define XB_TMO      128
#define XB_XCNT(j)  (256  + 64 * (j))
#define XB_XSUB(j)  (1280 + 64 * (j))
#define XB_XGEN(j)  (2304 + 64 * (j))
#define XB_TOP      3328
#define XB_TOPGEN   3392
#define XCD_BAR_WORDS 3456
#define XB_SPIN_CAP (1u << 27)
__device__ __forceinline__ unsigned xb_ld(unsigned* p)              { return __hip_atomic_load(p, __ATOMIC_RELAXED, __HIP_MEMORY_SCOPE_AGENT); }
__device__ __forceinline__ unsigned xb_add(unsigned* p, unsigned v) { return __hip_atomic_fetch_add(p, v, __ATOMIC_RELAXED, __HIP_MEMORY_SCOPE_AGENT); }
__device__ __forceinline__ unsigned xb_xcc_id() { return (unsigned)__builtin_amdgcn_s_getreg((3 << 11) | 20) & 0xFu; }
#define XB_SPIN(cond, bar) do { unsigned _sp = 0; while (cond) { __builtin_amdgcn_s_sleep(1); \
    if ((++_sp & 255u) == 0u) { if (xb_ld(&(bar)[XB_TMO])) break; if (_sp > XB_SPIN_CAP) { atomicAdd(&(bar)[XB_TMO], 1u); break; } } } } while (0)
struct XcdBarrier { unsigned* bar; unsigned x; volatile LAS unsigned* st; };
__device__ __forceinline__ XcdBarrier xcd_barrier_post(unsigned* bar, volatile LAS unsigned* st) {
    XcdBarrier b; b.bar = bar; b.x = xb_xcc_id(); b.st = st;
    if (threadIdx.x == 0) (void)xb_add(&bar[XB_XCNT(b.x)], 1u);
    return b;
}
__device__ __forceinline__ void xcd_barrier_complete(unsigned* bar, unsigned x, unsigned& nloc, unsigned& nx) {
    asm volatile("" : "+s"(x));
    const unsigned G = gridDim.x * gridDim.y * gridDim.z;
    unsigned sum, cnt, mine, sp = 0u;
    for (;;) {
        sum = 0u; cnt = 0u; mine = 0u;
#pragma unroll
        for (unsigned j = 0; j < 16; ++j) { const unsigned c = xb_ld(&bar[XB_XCNT(j)]); sum += c; cnt += (c > 0u) ? 1u : 0u; mine = (j == x) ? c : mine; }
        if (sum == G) break;
        __builtin_amdgcn_s_sleep(1);
        if ((++sp & 255u) == 0u) { if (xb_ld(&bar[XB_TMO])) break; if (sp > XB_SPIN_CAP) { atomicAdd(&bar[XB_TMO], 1u); break; } }
    }
    nloc = mine > 0u ? mine : 1u; nx = cnt > 0u ? cnt : 1u;
}
__device__ __forceinline__ void xcd_barrier(const XcdBarrier& b, const bool thread0  ) {
    asm volatile("s_waitcnt vmcnt(0)" ::: "memory");
    __syncthreads();
    if (thread0) {
        unsigned* bar = b.bar;
        __builtin_amdgcn_s_waitcnt(0);
        unsigned nloc = b.st[0], nx = b.st[1];
        if (nloc == 0u) { xcd_barrier_complete(bar, b.x, nloc, nx); b.st[0] = nloc; b.st[1] = nx; }
        const unsigned old = xb_add(&bar[XB_XSUB(b.x)], 1u);
        const unsigned gen = old / nloc;
        if (old + 1u == (gen + 1u) * nloc) {
            __builtin_amdgcn_fence(__ATOMIC_RELEASE, "agent");
            asm volatile("s_waitcnt vmcnt(0)" ::: "memory");
            const unsigned og = xb_add(&bar[XB_TOP], 1u);
            const unsigned tg = og / nx;
            if (og + 1u == (tg + 1u) * nx) xb_add(&bar[XB_TOPGEN], 1u);
            else XB_SPIN(xb_ld(&bar[XB_TOPGEN]) == tg, bar);
            __builtin_amdgcn_fence(__ATOMIC_ACQUIRE, "agent");
            xb_add(&bar[XB_XGEN(b.x)], 1u);
            asm volatile("s_waitcnt vmcnt(0)" ::: "memory");
        } else {
            XB_SPIN(xb_ld(&bar[XB_XGEN(b.x)]) == gen, bar);
            __builtin_amdgcn_fence(__ATOMIC_ACQUIRE, "agent");
            asm volatile("s_waitcnt vmcnt(0)" ::: "memory");
        }
    }
    __syncthreads();
}

namespace pg8 {
constexpr int BM = 256, BK = 64, HALF = 128, HTB = HALF * BK * 2, STAGE_BYTES = 8 * HTB, NXCD = 8, WGM = 8;
__host__ __device__ __forceinline__ int lds_byte(int r, int c) { const int st = (r >> 4) * 2 + (c >> 5), rr = r & 15, cc = c & 31, ob = rr * 64 + cc * 2; return st * 1024 + (ob ^ (((ob >> 9) & 1) << 5)); }
__host__ __device__ __forceinline__ void stage_rc(int b, int& R, int& C) { const int st = b / 1024, sb = b % 1024, swz = sb ^ (((sb >> 9) & 1) << 5); R = (st >> 1) * 16 + swz / 64; C = (st & 1) * 32 + (swz % 64) / 2; }
__host__ __device__ __forceinline__ int perm32(int rho) { const int n = rho >> 4, i = rho & 15; return 8 * (i >> 2) + 4 * n + (i & 3); }
struct Unit { int pm, pn; };
struct Gemm { const bf16_t* A; const bf16_t* Bt; int M, N, K, lda; };
struct StaticOrder {
    int nM, nN, nwg, G, c;
    __host__ __device__ void init(int M, int N, int G_, int c_) { nM = M / BM; nN = N / BM; nwg = nM * nN; G = G_; c = c_; }
    __host__ __device__ bool next(int i, Unit& u) const {
        const long L = (long)i * G + c; if (L >= nwg) return false;
        int wgid = (int)L; { const int q = nwg / NXCD, r = nwg % NXCD, xcd = wgid % NXCD, off = wgid / NXCD; wgid = (xcd < r ? xcd * (q + 1) : r * (q + 1) + (xcd - r) * q) + off; }
        const int nig = WGM * nN, gid = wgid / nig, fm = gid * WGM, gsz = (nM - fm) < WGM ? (nM - fm) : WGM;
        u.pm = fm + ((wgid % nig) % gsz); u.pn = (wgid % nig) / gsz; return true;
    }
    __device__ __forceinline__ void a_ready(const Unit&) const {}
    __device__ __forceinline__ void done(const Unit&) const {}
};
struct EpiBf16 {
    static constexpr bool PERM = true;
    bf16_t* O; int ldc;
    __device__ __forceinline__ void operator()(const f32x4 (&acc)[2][2][4][2], const Unit& u, int wr, int wc, int fr, int fq) const {
        const int row0 = u.pm * BM + wr * 64 + fr; const int col0 = u.pn * BM + wc * 32 + 8 * fq;
#pragma unroll
        for (int ai = 0; ai < 2; ++ai)
#pragma unroll
            for (int m = 0; m < 4; ++m) { bf16_t* rowp = O + (size_t)(row0 + ai * HALF + m * 16) * ldc + col0;
#pragma unroll
                for (int bj = 0; bj < 2; ++bj) { const f32x4 v0 = acc[ai][bj][m][0], v1 = acc[ai][bj][m][1];
                    u32x4 w; w.x = cvt_pk_bf16(v0[0], v0[1]); w.y = cvt_pk_bf16(v0[2], v0[3]); w.z = cvt_pk_bf16(v1[0], v1[1]); w.w = cvt_pk_bf16(v1[2], v1[3]);
                    *(u32x4*)(rowp + bj * HALF) = w; } }
    }
};
struct EpiResid {
    static constexpr bool PERM = false;
    float* X; const float* modl; int chunk;
    __device__ __forceinline__ void operator()(const f32x4 (&acc)[2][2][4][2], const Unit& u, int wr, int wc, int fr, int fq) const {
        const int row0 = u.pm * BM + wr * 64 + fr, col0 = u.pn * BM + wc * 32 + 4 * fq;
        const int vs = u.pm < 32 ? 0 : (u.pm < 64 ? 1 : 2);
        const float* gate = modl + (size_t)vs * 12288 + chunk * 2048 + col0;
        f32x4 gv[2][2];
#pragma unroll
        for (int bj = 0; bj < 2; ++bj)
#pragma unroll
            for (int n = 0; n < 2; ++n) gv[bj][n] = *(const f32x4*)(gate + bj * HALF + n * 16);
#pragma unroll
        for (int ai = 0; ai < 2; ++ai)
#pragma unroll
            for (int m = 0; m < 4; ++m) { float* rowp = X + (size_t)(row0 + ai * HALF + m * 16) * DM + col0;
#pragma unroll
                for (int bj = 0; bj < 2; ++bj)
#pragma unroll
                    for (int n = 0; n < 2; ++n) { float* p = rowp + bj * HALF + n * 16; const f32x4 xo = *(const f32x4*)p; *(f32x4*)p = xo + gv[bj][n] * acc[ai][bj][m][n]; } }
    }
};

template <class Epi, class Sched>
__device__ __forceinline__ void gemm_phase(LAS unsigned char* lds, const Gemm g, const Sched& S, const Epi& E, int tid_in) {
    const int tid_l = tid_in * 64 + fresh_lane();
    const int tid = tid_l, wid = tid_in  , lane = tid & 63, wr = wid >> 2, wc = wid & 3, fr = lane & 15, fq = lane >> 4;
    const int K = g.K, nt = K / BK, lda = g.lda;
    unsigned voffA[2], voffB[2];
#pragma unroll
    for (int i = 0; i < 2; ++i) { int R, C; stage_rc(tid * 16 + i * 8192, R, C); const int Rb = Epi::PERM ? ((R & ~31) + perm32(R & 31)) : R;
        voffA[i] = (unsigned)(R * lda + C) * 2u; voffB[i] = (unsigned)(Rb * K + C) * 2u; }
    const size_t kstep = (size_t)(BK * 2);
    const size_t hstepA = (size_t)HALF * lda * 2, hstepB = (size_t)HALF * K * 2;
    const size_t tstepA = 2 * hstepA, tstepB = 2 * hstepB;
    const unsigned ldsw = (unsigned)wid * 1024u;
    const int aoff = lds_byte(wr * 64 + fr, fq * 8), boff = lds_byte(wc * 32 + fr, fq * 8);
#define PG8_SA(b, h) (((b) * 2 + (h)) * HTB)
#define PG8_SB(b, h) ((4 + (b) * 2 + (h)) * HTB)
#define PG8_STAGE(bufoff, gbase, voff) do { _Pragma("unroll") for (int _i = 0; _i < 2; ++_i) \
        __builtin_amdgcn_global_load_lds((const unsigned*)((const char*)(gbase) + (voff)[_i]), (LAS unsigned*)(lds + (bufoff) + ldsw + _i * 8192), 16, 0, 0); } while (0)
#define PG8_LDA(dst, b, h) do { _Pragma("unroll") for (int m = 0; m < 4; ++m) _Pragma("unroll") for (int k = 0; k < 2; ++k) dst[m][k] = *(const LAS bf16x8*)(lds + PG8_SA(b, h) + aoff + m * 2048 + k * 1024); } while (0)
#define PG8_LDB(dst, b, h) do { _Pragma("unroll") for (int n = 0; n < 2; ++n) _Pragma("unroll") for (int k = 0; k < 2; ++k) dst[n][k] = *(const LAS bf16x8*)(lds + PG8_SB(b, h) + boff + n * 2048 + k * 1024); } while (0)
#define PG8_MMA(ai, bj, At, Bt) do { __builtin_amdgcn_s_setprio(1); _Pragma("unroll") for (int m = 0; m < 4; ++m) _Pragma("unroll") for (int n = 0; n < 2; ++n) _Pragma("unroll") for (int k = 0; k < 2; ++k) \
        acc[ai][bj][m][n] = __builtin_amdgcn_mfma_f32_16x16x32_bf16(Bt[n][k], At[m][k], acc[ai][bj][m][n], 0, 0, 0); __builtin_amdgcn_s_setprio(0); } while (0)
#define PG8_WAIT_V(n) asm volatile("s_waitcnt vmcnt(" #n ")" ::: "memory")
#define PG8_WAIT_L(n) asm volatile("s_waitcnt lgkmcnt(" #n ")" ::: "memory")
#define PG8_BAR __builtin_amdgcn_s_barrier()
#define PG8_SCHED __builtin_amdgcn_sched_barrier(0)
    Unit cur, nxt; int ui = 0;
    if (!S.next(0, cur)) return;
    f32x4 acc[2][2][4][2];
#pragma unroll
    for (int a = 0; a < 2; ++a)
#pragma unroll
        for (int b = 0; b < 2; ++b)
#pragma unroll
            for (int m = 0; m < 4; ++m)
#pragma unroll
                for (int n = 0; n < 2; ++n) acc[a][b][m][n] = (f32x4){0.f, 0.f, 0.f, 0.f};
    bf16x8 At[4][2], B0[2][2], B1[2][2];
    const char* cA = (const char*)g.A + (size_t)cur.pm * tstepA; const char* cB = (const char*)g.Bt + (size_t)cur.pn * tstepB;
    S.a_ready(cur);
    PG8_STAGE(PG8_SB(0, 0), cB, voffB); PG8_STAGE(PG8_SA(0, 0), cA, voffA); PG8_STAGE(PG8_SB(0, 1), cB + hstepB, voffB); PG8_STAGE(PG8_SA(0, 1), cA + hstepA, voffA);
    if (wr == 1) PG8_BAR;
    PG8_WAIT_V(4); PG8_BAR;
    PG8_STAGE(PG8_SB(1, 0), cB + kstep, voffB); PG8_STAGE(PG8_SA(1, 0), cA + kstep, voffA); PG8_STAGE(PG8_SB(1, 1), cB + hstepB + kstep, voffB);
    PG8_WAIT_V(6); PG8_BAR;
    for (;;) {
        const bool has_next = S.next(ui + 1, nxt);
        const char* nA = has_next ? (const char*)g.A + (size_t)nxt.pm * tstepA : cA; const char* nB = has_next ? (const char*)g.Bt + (size_t)nxt.pn * tstepB : cB;
        for (int t = 0; t < nt; t += 2) {
            const bool last = (t == nt - 2);
            const char* a1 = cA + (size_t)(t + 1) * kstep;
            const char* a2 = last ? nA : cA + (size_t)(t + 2) * kstep; const char* b2 = last ? nB : cB + (size_t)(t + 2) * kstep;
            const char* a3 = a2 + kstep; const char* b3 = b2 + kstep;
            if (last && has_next) S.a_ready(nxt);
            PG8_LDB(B0, 0, 0); PG8_SCHED; PG8_LDA(At, 0, 0); PG8_STAGE(PG8_SA(1, 1), a1 + hstepA, voffA);
            PG8_WAIT_L(8); PG8_BAR; PG8_WAIT_L(0); PG8_MMA(0, 0, At, B0); PG8_BAR; PG8_SCHED;
            PG8_LDB(B1, 0, 1); PG8_STAGE(PG8_SB(0, 0), b2, voffB);
            PG8_BAR; PG8_WAIT_L(0); PG8_MMA(0, 1, At, B1); PG8_BAR;
            PG8_LDA(At, 0, 1); PG8_STAGE(PG8_SA(0, 0), a2, voffA);
            PG8_BAR; PG8_WAIT_L(0); PG8_MMA(1, 0, At, B0); PG8_BAR; PG8_SCHED;
            PG8_STAGE(PG8_SB(0, 1), b2 + hstepB, voffB);
            PG8_WAIT_V(6); PG8_BAR; PG8_MMA(1, 1, At, B1); PG8_BAR;
            PG8_LDB(B0, 1, 0); PG8_SCHED; PG8_LDA(At, 1, 0); PG8_STAGE(PG8_SA(0, 1), a2 + hstepA, voffA);
            PG8_WAIT_L(8); PG8_BAR; PG8_WAIT_L(0); PG8_MMA(0, 0, At, B0); PG8_BAR; PG8_SCHED;
            PG8_LDB(B1, 1, 1); PG8_STAGE(PG8_SB(1, 0), b3, voffB);
            PG8_BAR; PG8_WAIT_L(0); PG8_MMA(0, 1, At, B1); PG8_BAR;
            PG8_LDA(At, 1, 1); PG8_STAGE(PG8_SA(1, 0), a3, voffA);
            PG8_BAR; PG8_WAIT_L(0); PG8_MMA(1, 0, At, B0); PG8_BAR; PG8_SCHED;
            PG8_STAGE(PG8_SB(1, 1), b3 + hstepB, voffB);
            PG8_WAIT_V(6); PG8_BAR; PG8_MMA(1, 1, At, B1); PG8_BAR;
        }
        E(acc, cur, wr, wc, fr, fq); S.done(cur);
        if (!has_next) break;
#pragma unroll
        for (int a = 0; a < 2; ++a)
#pragma unroll
            for (int b = 0; b < 2; ++b)
#pragma unroll
                for (int m = 0; m < 4; ++m)
#pragma unroll
                    for (int n = 0; n < 2; ++n) acc[a][b][m][n] = (f32x4){0.f, 0.f, 0.f, 0.f};
        cur = nxt; cA = nA; cB = nB; ++ui;
    }
    PG8_WAIT_V(0);
    if (wr == 0) PG8_BAR;
    PG8_BAR;
#undef PG8_SA
#undef PG8_SB
#undef PG8_STAGE
#undef PG8_LDA
#undef PG8_LDB
#undef PG8_MMA
#undef PG8_WAIT_V
#undef PG8_WAIT_L
#undef PG8_BAR
#undef PG8_SCHED
}
}

namespace att {
constexpr int NW = 8, QBLK = 32, KVBLK = 64, DV = 128;
constexpr float THR = 8.f;
constexpr int SHM_V = KVBLK * DV * 2;
#define SBAR() __builtin_amdgcn_sched_barrier(0)
__device__ __forceinline__ int crow(int r, int hi) { return (r & 3) + 8 * (r >> 2) + 4 * hi; }
__device__ __forceinline__ unsigned cvtpk(float lo, float hi) { unsigned r; asm volatile("v_cvt_pk_bf16_f32 %0, %1, %2" : "=v"(r) : "v"(lo), "v"(hi)); return r; }
__device__ __forceinline__ void partialSM(f32x16& p0, f32x16& p1, float& m_reg, float& mn, float& alpha, const float C, const float thr_raw) {
    float pmax = p0[0];
#pragma unroll
    for (int r = 1; r < 16; ++r) pmax = fmaxf(pmax, p0[r]);
#pragma unroll
    for (int r = 0; r < 16; ++r) pmax = fmaxf(pmax, p1[r]);
    { auto rr = __builtin_amdgcn_permlane32_swap(__float_as_uint(pmax), __float_as_uint(pmax), false, false);
      pmax = fmaxf(__uint_as_float(rr[0]), __uint_as_float(rr[1])); }
    if (__builtin_expect(__all(pmax - m_reg <= thr_raw), 1)) { mn = m_reg; alpha = 1.f; }
    else { mn = fmaxf(m_reg, pmax); alpha = __builtin_amdgcn_exp2f((m_reg - mn) * C); m_reg = mn; }
    const float mnC = -mn * C;
#pragma unroll
    for (int r = 0; r < 16; ++r) p0[r] = fmaf(p0[r], C, mnC);
#pragma unroll
    for (int r = 0; r < 16; ++r) p1[r] = fmaf(p1[r], C, mnC);
#pragma unroll
    for (int r = 0; r < 16; ++r) p0[r] = __builtin_amdgcn_exp2f(p0[r]);
}
__device__ __forceinline__ void finishSM(f32x16& p0, f32x16& p1, float alpha, float& l_reg, bf16x8& pa0, bf16x8& pa1, bf16x8& pa2, bf16x8& pa3) {
#pragma unroll
    for (int r = 0; r < 16; ++r) p1[r] = __builtin_amdgcn_exp2f(p1[r]);
    float ps = 0;
#pragma unroll
    for (int r = 0; r < 16; ++r) ps += p0[r];
#pragma unroll
    for (int r = 0; r < 16; ++r) ps += p1[r];
    { auto rr = __builtin_amdgcn_permlane32_swap(__float_as_uint(ps), __float_as_uint(ps), false, false);
      ps = __uint_as_float(rr[0]) + __uint_as_float(rr[1]); }
    l_reg = l_reg * alpha + ps;
#define PK4(P, BASE, OUT) do { unsigned a0 = cvtpk(P[BASE + 0], P[BASE + 1]), a1 = cvtpk(P[BASE + 2], P[BASE + 3]);   \
    unsigned b0 = cvtpk(P[BASE + 4], P[BASE + 5]), b1 = cvtpk(P[BASE + 6], P[BASE + 7]);                              \
    auto r0 = __builtin_amdgcn_permlane32_swap(a0, b0, false, false); auto r1 = __builtin_amdgcn_permlane32_swap(a1, b1, false, false); \
    u32x4 w = {r0[0], r1[0], r0[1], r1[1]}; OUT = *reinterpret_cast<bf16x8*>(&w); } while (0)
    PK4(p0, 0, pa0); PK4(p0, 8, pa1); PK4(p1, 0, pa2); PK4(p1, 8, pa3);
#undef PK4
}
template <int DQK, int QL>
__device__ __forceinline__ void qkt(f32x16& p0, f32x16& p1, const char* Ks, const bf16x8 (&qr)[DQK / 16 - QL], const char* qpark, int r32, int hi) {
    constexpr int RS = DQK * 2 + 16, NQR = DQK / 16 - QL, GRP = (DQK > 128) ? QKT_GRP : DQK / 16;
    p0 = f32x16{}; p1 = f32x16{};
#pragma unroll
    for (int g0 = 0; g0 < DQK / 16; g0 += GRP) {
#pragma unroll
        for (int d0 = g0; d0 < g0 + GRP; ++d0) { const int cb = (d0 * 16 + hi * 8) * 2;
            const bf16x8 b0 = *reinterpret_cast<const bf16x8*>(Ks + r32 * RS + cb);
            const bf16x8 b1 = *reinterpret_cast<const bf16x8*>(Ks + (32 + r32) * RS + cb);
            bf16x8 qf; if (d0 < NQR) qf = qr[d0 < NQR ? d0 : 0]; else qf = *reinterpret_cast<const bf16x8*>(qpark + (d0 - NQR) * 1024);
            p0 = __builtin_amdgcn_mfma_f32_32x32x16_bf16(b0, qf, p0, 0, 0, 0);
            p1 = __builtin_amdgcn_mfma_f32_32x32x16_bf16(b1, qf, p1, 0, 0, 0); }
        if (g0 + GRP < DQK / 16) SBAR();
    }
}
__device__ __forceinline__ int v_st(int k, int c) { const int kk = (k & ~0xC) | ((k & 4) << 1) | ((k & 8) >> 1); return ((kk >> 3) * 4 + (c >> 5)) * 512 + ((kk & 7) * 32 + (c & 31)) * 2; }
__device__ __forceinline__ int v_rd_base(int lane) { return ((lane & 3) << 3) | (((lane >> 2) & 3) << 6) | (((lane >> 4) & 1) << 5) | (((lane >> 5) & 1) << 8); }
constexpr int v_rd_off(int d0, int ks, int half) { return d0 * 512 + ks * 4096 + half * 2048; }
template <int OFF> __device__ __forceinline__ s16x4 tr_read(int vb) {
    s16x4 r; asm volatile("ds_read_b64_tr_b16 %0, %1 offset:%2" : "=&v"(r) : "v"(vb), "i"(OFF) : "memory"); return r;
}
template <int D0> __device__ __forceinline__ void pv_one(f32x16& od, int vb, bf16x8 pa0, bf16x8 pa1, bf16x8 pa2, bf16x8 pa3) {
    const s16x4 l0 = tr_read<v_rd_off(D0, 0, 0)>(vb), h0 = tr_read<v_rd_off(D0, 0, 1)>(vb), l1 = tr_read<v_rd_off(D0, 1, 0)>(vb), h1 = tr_read<v_rd_off(D0, 1, 1)>(vb);
    const s16x4 l2 = tr_read<v_rd_off(D0, 2, 0)>(vb), h2 = tr_read<v_rd_off(D0, 2, 1)>(vb), l3 = tr_read<v_rd_off(D0, 3, 0)>(vb), h3 = tr_read<v_rd_off(D0, 3, 1)>(vb);
    asm volatile("s_waitcnt lgkmcnt(0)" ::: "memory"); SBAR();
#define PK(L, H) (bf16x8){L[0], L[1], L[2], L[3], H[0], H[1], H[2], H[3]}
    od = __builtin_amdgcn_mfma_f32_32x32x16_bf16(pa0, PK(l0, h0), od, 0, 0, 0);
    od = __builtin_amdgcn_mfma_f32_32x32x16_bf16(pa1, PK(l1, h1), od, 0, 0, 0);
    od = __builtin_amdgcn_mfma_f32_32x32x16_bf16(pa2, PK(l2, h2), od, 0, 0, 0);
    od = __builtin_amdgcn_mfma_f32_32x32x16_bf16(pa3, PK(l3, h3), od, 0, 0, 0);
#undef PK
}
__device__ __forceinline__ void pv_d0(f32x16* o, int vb, bf16x8 pa0, bf16x8 pa1, bf16x8 pa2, bf16x8 pa3) {
    pv_one<0>(o[0], vb, pa0, pa1, pa2, pa3); pv_one<1>(o[1], vb, pa0, pa1, pa2, pa3); pv_one<2>(o[2], vb, pa0, pa1, pa2, pa3); pv_one<3>(o[3], vb, pa0, pa1, pa2, pa3);
}
template <int DQK> struct ScaleOf { static constexpr float scale = DQK == 192 ? 0.07216878364870322f : (DQK == 128 ? 0.08838834764831845f : 0.125f); };
template <int DQK, int SDEPTH, int QL, int ldq, int ldk, int ldv, int ldo>
__device__ __forceinline__ void attn_body(const bf16_t* __restrict__ Qb, const bf16_t* __restrict__ Kh, const bf16_t* __restrict__ Vh,
                                          float* __restrict__ Ob, int seq, char* lds, int tid_in) {
    constexpr float C = ScaleOf<DQK>::scale * 1.4426950408889634f, thr_raw = THR / ScaleOf<DQK>::scale;
    constexpr int RS = DQK * 2 + 16  , SHM_K = KVBLK * RS, NKP = DQK / 64, KPR = DQK / 8;
    const int tid_l = tid_in * 64 + fresh_lane();
    const int tid = tid_l, wid = tid_in  , lane = tid & 63, r32 = lane & 31, hi = lane >> 5;
    char* V_lds = lds; char* K_lds = lds + 2 * SHM_V;
    float* ws = (float*)(lds + 2 * SHM_V + 2 * SHM_K) + wid * 64; float* li_l = ws; float* al_l = ws + 32;
    constexpr int NQR = DQK / 16 - QL;
    char* qpark = lds + 2 * SHM_V + 2 * SHM_K + 2048 + wid * (QL * 1024) + lane * 16;
    float m_reg = -1e30f, l_reg = 0; f32x16 o[4] = {}; bf16x8 qr[NQR];
    const bf16_t* Qw = Qb + (size_t)(wid * QBLK + r32) * ldq + hi * 8;
#pragma unroll
    for (int d0 = 0; d0 < NQR; ++d0) qr[d0] = *reinterpret_cast<const bf16x8*>(Qw + d0 * 16);
#pragma unroll
    for (int d0 = 0; d0 < QL; ++d0) *(bf16x8*)(qpark + d0 * 1024) = *reinterpret_cast<const bf16x8*>(Qw + (NQR + d0) * 16);
    const int sr = tid >> 4, sc = (tid & 15) * 8, vst0 = v_st(sr, sc), vst1 = v_st(32 + sr, sc);
    int koff[NKP], klds[NKP];
#pragma unroll
    for (int i = 0; i < NKP; ++i) { const int row = tid >> 3, c8 = (tid & 7) + 8 * i; koff[i] = row * ldk + c8 * 8; klds[i] = row * RS + c8 * 16; }
    const int vb0 = (int)(uintptr_t)V_lds + v_rd_base(lane);
    bf16x8 sv0[SDEPTH], sv1[SDEPTH], sk[SDEPTH][NKP];
#define SLOAD(i, k0) do { sv0[i] = *reinterpret_cast<const bf16x8*>(&Vh[(size_t)((k0) + sr) * ldv + sc]); sv1[i] = *reinterpret_cast<const bf16x8*>(&Vh[(size_t)((k0) + 32 + sr) * ldv + sc]); \
    _Pragma("unroll") for (int _q = 0; _q < NKP; ++_q) sk[i][_q] = *reinterpret_cast<const bf16x8*>(&Kh[(size_t)(k0) * ldk + koff[_q]]); } while (0)
#define SWRITE(b, i) do { *(bf16x8*)(V_lds + (b) * SHM_V + vst0) = sv0[i]; *(bf16x8*)(V_lds + (b) * SHM_V + vst1) = sv1[i]; \
    _Pragma("unroll") for (int _q = 0; _q < NKP; ++_q) *(bf16x8*)(K_lds + (b) * SHM_K + klds[_q]) = sk[i][_q]; } while (0)
#define SWAIT() do { if constexpr (SDEPTH == 2) { if constexpr (NKP == 1) asm volatile("s_waitcnt vmcnt(3)" ::: "memory"); else if constexpr (NKP == 2) asm volatile("s_waitcnt vmcnt(4)" ::: "memory"); else asm volatile("s_waitcnt vmcnt(5)" ::: "memory"); } \
    else asm volatile("s_waitcnt vmcnt(0)" ::: "memory"); } while (0)
#define RESC(a) do { if (__any((a) < 1.f)) { if (hi == 0) al_l[r32] = (a); asm volatile("s_waitcnt lgkmcnt(0)" ::: "memory"); \
    _Pragma("unroll") for (int d = 0; d < 4; ++d) _Pragma("unroll") for (int r = 0; r < 16; ++r) o[d][r] *= al_l[crow(r, hi)]; } } while (0)
    f32x16 pA0, pA1, pB0, pB1; float mnA, mnB, alA, alB; bf16x8 pa0, pa1, pa2, pa3; const int NT = seq / KVBLK;
    constexpr int SE = 0, SO = SDEPTH - 1;
    SLOAD(SE, 0); asm volatile("s_waitcnt vmcnt(0)" ::: "memory"); SWRITE(0, SE); __syncthreads();
    qkt<DQK, QL>(pA0, pA1, K_lds, qr, qpark, r32, hi); partialSM(pA0, pA1, m_reg, mnA, alA, C, thr_raw);
    SLOAD(SO, KVBLK); if constexpr (SDEPTH == 2) { if (2 < NT) SLOAD(SE, 2 * KVBLK); }
    SWAIT(); SWRITE(1, SO); __syncthreads();
    for (int j = 1; j + 1 < NT; j += 2) {
        SBAR(); qkt<DQK, QL>(pB0, pB1, K_lds + SHM_K, qr, qpark, r32, hi);
        finishSM(pA0, pA1, alA, l_reg, pa0, pa1, pa2, pa3); SBAR();
        SLOAD(SO, (j + SDEPTH) * KVBLK); SBAR();
        pv_d0(o, vb0, pa0, pa1, pa2, pa3); partialSM(pB0, pB1, m_reg, mnB, alB, C, thr_raw);
        __syncthreads(); SWAIT(); SWRITE(0, SE);
        RESC(alB); __syncthreads();
        SBAR(); qkt<DQK, QL>(pA0, pA1, K_lds, qr, qpark, r32, hi);
        finishSM(pB0, pB1, alB, l_reg, pa0, pa1, pa2, pa3); SBAR();
        if (SDEPTH == 1 || j + 3 < NT) SLOAD(SE, (j + 1 + SDEPTH) * KVBLK); SBAR();
        pv_d0(o, vb0 + SHM_V, pa0, pa1, pa2, pa3); partialSM(pA0, pA1, m_reg, mnA, alA, C, thr_raw);
        __syncthreads(); SWAIT(); SWRITE(1, SO);
        RESC(alA); __syncthreads();
    }
    SBAR(); qkt<DQK, QL>(pB0, pB1, K_lds + SHM_K, qr, qpark, r32, hi);
    finishSM(pA0, pA1, alA, l_reg, pa0, pa1, pa2, pa3); SBAR();
    pv_d0(o, vb0, pa0, pa1, pa2, pa3); partialSM(pB0, pB1, m_reg, mnB, alB, C, thr_raw);
    __syncthreads(); RESC(alB);
    finishSM(pB0, pB1, alB, l_reg, pa0, pa1, pa2, pa3); SBAR();
    pv_d0(o, vb0 + SHM_V, pa0, pa1, pa2, pa3);
    if (hi == 0) li_l[r32] = l_reg; asm volatile("s_waitcnt lgkmcnt(0)" ::: "memory");
    float rli[16];
#pragma unroll
    for (int r = 0; r < 16; ++r) rli[r] = __builtin_amdgcn_rcpf(li_l[crow(r, hi)]);
    float* Ow = Ob + (size_t)(wid * QBLK) * ldo;
#pragma unroll
    for (int r = 0; r < 16; ++r) { const int orow = crow(r, hi);
#pragma unroll
        for (int d0 = 0; d0 < 4; ++d0) Ow[(size_t)orow * ldo + d0 * 32 + r32] = o[d0][r] * rli[r]; }
    __syncthreads();
#undef SLOAD
#undef SWRITE
#undef SWAIT
#undef RESC
}
template <int DQK, int QL, int ldq, int ldk, int ldv, int ldo>
__device__ __forceinline__ void attn_body_simple(const bf16_t* __restrict__ Qb, const bf16_t* __restrict__ Kh, const bf16_t* __restrict__ Vh,
                                                 float* __restrict__ Ob, int seq, char* lds, int tid_in) {
    constexpr float C = ScaleOf<DQK>::scale * 1.4426950408889634f, thr_raw = THR / ScaleOf<DQK>::scale;
    constexpr int RS = DQK * 2 + 16  , SHM_K = KVBLK * RS, NKP = DQK / 64, KPR = DQK / 8;
    const int tid_l = tid_in * 64 + fresh_lane();
    const int tid = tid_l, wid = tid_in  , lane = tid & 63, r32 = lane & 31, hi = lane >> 5;
    char* V_lds = lds; char* K_lds = lds + 2 * SHM_V;
    float* ws = (float*)(lds + 2 * SHM_V + 2 * SHM_K) + wid * 64; float* li_l = ws; float* al_l = ws + 32;
    constexpr int NQR = DQK / 16 - QL;
    char* qpark = lds + 2 * SHM_V + 2 * SHM_K + 2048 + wid * (QL * 1024) + lane * 16;
    float m_reg = -1e30f, l_reg = 0; f32x16 o[4] = {}; bf16x8 qr[NQR];
    const bf16_t* Qw = Qb + (size_t)(wid * QBLK + r32) * ldq + hi * 8;
#pragma unroll
    for (int d0 = 0; d0 < NQR; ++d0) qr[d0] = *reinterpret_cast<const bf16x8*>(Qw + d0 * 16);
#pragma unroll
    for (int d0 = 0; d0 < QL; ++d0) *(bf16x8*)(qpark + d0 * 1024) = *reinterpret_cast<const bf16x8*>(Qw + (NQR + d0) * 16);
    const int sr = tid >> 4, sc = (tid & 15) * 8, vst0 = v_st(sr, sc), vst1 = v_st(32 + sr, sc);
    int koff[NKP], klds[NKP];
#pragma unroll
    for (int i = 0; i < NKP; ++i) { const int row = tid >> 3, c8 = (tid & 7) + 8 * i; koff[i] = row * ldk + c8 * 8; klds[i] = row * RS + c8 * 16; }
    const int vb0 = (int)(uintptr_t)V_lds + v_rd_base(lane);
    bf16x8 sv0, sv1, sk[NKP];
#define SLOAD(k0) do { sv0 = *reinterpret_cast<const bf16x8*>(&Vh[(size_t)((k0) + sr) * ldv + sc]); sv1 = *reinterpret_cast<const bf16x8*>(&Vh[(size_t)((k0) + 32 + sr) * ldv + sc]); \
    _Pragma("unroll") for (int _q = 0; _q < NKP; ++_q) sk[_q] = *reinterpret_cast<const bf16x8*>(&Kh[(size_t)(k0) * ldk + koff[_q]]); } while (0)
#define SWRITE(b) do { *(bf16x8*)(V_lds + (b) * SHM_V + vst0) = sv0; *(bf16x8*)(V_lds + (b) * SHM_V + vst1) = sv1; \
    _Pragma("unroll") for (int _q = 0; _q < NKP; ++_q) *(bf16x8*)(K_lds + (b) * SHM_K + klds[_q]) = sk[_q]; } while (0)
#define RESC(a) do { if (__any((a) < 1.f)) { if (hi == 0) al_l[r32] = (a); asm volatile("s_waitcnt lgkmcnt(0)" ::: "memory"); \
    _Pragma("unroll") for (int d = 0; d < 4; ++d) _Pragma("unroll") for (int r = 0; r < 16; ++r) o[d][r] *= al_l[crow(r, hi)]; } } while (0)
    const int NT = seq / KVBLK;
    SLOAD(0); asm volatile("s_waitcnt vmcnt(0)" ::: "memory"); SWRITE(0); __syncthreads();
    for (int j = 0; j < NT; ++j) {
        const int b = j & 1;
        if (j + 1 < NT) SLOAD((j + 1) * KVBLK);
        SBAR();
        f32x16 p0, p1; float mn, al; bf16x8 pa0, pa1, pa2, pa3;
        { const char* Ks = K_lds + b * SHM_K; p0 = f32x16{}; p1 = f32x16{};
#pragma unroll
          for (int d0 = 0; d0 < DQK / 16; ++d0) { const int cb = (d0 * 16 + hi * 8) * 2;
              const bf16x8 b0 = *reinterpret_cast<const bf16x8*>(Ks + r32 * RS + cb);
              const bf16x8 b1 = *reinterpret_cast<const bf16x8*>(Ks + (32 + r32) * RS + cb);
              bf16x8 qf; if (d0 < NQR) qf = qr[d0 < NQR ? d0 : 0]; else qf = *(const bf16x8*)(qpark + (d0 - NQR) * 1024);
              p0 = __builtin_amdgcn_mfma_f32_32x32x16_bf16(b0, qf, p0, 0, 0, 0);
              p1 = __builtin_amdgcn_mfma_f32_32x32x16_bf16(b1, qf, p1, 0, 0, 0); } }
        partialSM(p0, p1, m_reg, mn, al, C, thr_raw);
        RESC(al);
        finishSM(p0, p1, al, l_reg, pa0, pa1, pa2, pa3); SBAR();
        pv_d0(o, vb0 + b * SHM_V, pa0, pa1, pa2, pa3);
        if (j + 1 < NT) { asm volatile("s_waitcnt vmcnt(0)" ::: "memory"); SWRITE(b ^ 1); }
        __syncthreads();
    }
    if (hi == 0) li_l[r32] = l_reg; asm volatile("s_waitcnt lgkmcnt(0)" ::: "memory");
    float rli[16];
#pragma unroll
    for (int r = 0; r < 16; ++r) rli[r] = __builtin_amdgcn_rcpf(li_l[crow(r, hi)]);
    float* Ow = Ob + (size_t)(wid * QBLK) * ldo;
#pragma unroll
    for (int r = 0; r < 16; ++r) { const int orow = crow(r, hi);
#pragma unroll
        for (int d0 = 0; d0 < 4; ++d0) Ow[(size_t)orow * ldo + d0 * 32 + r32] = o[d0][r] * rli[r]; }
    __syncthreads();
#undef SLOAD
#undef SWRITE
#undef RESC
}
}

struct Params {
    const float* x; const float* c; const float* ctx; const float* c_ctx; const float* w_mod; const float* b_mod; const float* g_norm1; const float* g_norm2;
    const float* w_in_ab; const float* g_cq; const float* w_uq; const float* g_ckv; const float* w_ukv; const float* g_qn_a; const float* g_kn_a; const float* lam_vec;
    const float* g_qn_b; const float* g_kn_b; const float* g_sub_b; const float* w_out_ab; const float* w_in_c; const float* g_qn_c; const float* g_kn_c; const float* w_out_c;
    const float* w_pq; const float* sub_keys; const float* expert_u; const float* expert_v;
    float* out; unsigned char* ws; int ph_lo, ph_hi;
};

typedef const __attribute__((address_space(4))) Params CParams;
struct Ctx {
    int tid, lane, wid, G, vcu, bx;
    unsigned char* ws; char* lds;
};

__device__ __forceinline__ void tconv(const Ctx& F, const float* src, bf16_t* dst, const float* gain, int nmat, int K, int N, int Npad) {
    float* tile = (float*)(F.lds + 32768);
    const int ntn = Npad / 64, ntk = K / 64, per = ntn * ntk, total = per * nmat;
    for (int it = F.vcu; it < total; it += F.G) {
        const int mat = it / per, rem = it % per, tn = rem / ntk, tk = rem % ntk, k0 = tk * 64, n0 = tn * 64;
        const float* s = src + (size_t)mat * K * N; bf16_t* d = dst + (size_t)mat * Npad * K;
        __syncthreads();
        { const int r = F.tid >> 4, c4 = (F.tid & 15) * 4;
#pragma unroll
          for (int i = 0; i < 2; ++i) { const int rr = r + i * 32; f32x4 v = (f32x4){0.f, 0.f, 0.f, 0.f};
              if (n0 + c4 < N) v = *(const f32x4*)(s + (size_t)(k0 + rr) * N + n0 + c4);
              tile[rr * 65 + c4 + 0] = v[0]; tile[rr * 65 + c4 + 1] = v[1]; tile[rr * 65 + c4 + 2] = v[2]; tile[rr * 65 + c4 + 3] = v[3]; } }
        __syncthreads();
        { const int n = F.tid >> 3, kc = (F.tid & 7) * 8; float v[8];
#pragma unroll
          for (int e = 0; e < 8; ++e) { v[e] = tile[(kc + e) * 65 + n]; if (gain) v[e] *= gain[(size_t)mat * K + k0 + kc + e]; }
          u32x4 w; w.x = cvt_pk_bf16(v[0], v[1]); w.y = cvt_pk_bf16(v[2], v[3]); w.z = cvt_pk_bf16(v[4], v[5]); w.w = cvt_pk_bf16(v[6], v[7]);
          *(u32x4*)(d + (size_t)(n0 + n) * K + k0 + kc) = w; }
    }
}
__device__ __forceinline__ void cvt_flat(const Ctx& F, const float* src, bf16_t* dst, size_t n8) {
    for (size_t i = (size_t)F.vcu * 512 + F.tid; i < n8; i += (size_t)F.G * 512) {
        const f32x4 a = *(const f32x4*)(src + i * 8), b = *(const f32x4*)(src + i * 8 + 4);
        u32x4 w; w.x = cvt_pk_bf16(a[0], a[1]); w.y = cvt_pk_bf16(a[2], a[3]); w.z = cvt_pk_bf16(b[0], b[1]); w.w = cvt_pk_bf16(b[2], b[3]);
        *(u32x4*)(dst + i * 8) = w;
    }
}
__device__ __forceinline__ void cvt_rows_fp8(const Ctx& F, const float* src, unsigned char* dst, float* descale, int R) {
    for (int row = F.vcu * 8 + F.wid; row < R; row += F.G * 8) {
        const float* s = src + (size_t)row * DM; f32x4 v[8]; float am = 0.f;
#pragma unroll
        for (int j = 0; j < 2; ++j)
#pragma unroll
            for (int i = 0; i < 4; ++i) { v[j * 4 + i] = *(const f32x4*)(s + j * 1024 + F.lane * 16 + i * 4);
#pragma unroll
                for (int e = 0; e < 4; ++e) am = fmaxf(am, fabsf(v[j * 4 + i][e])); }
        am = wave_max(am);
        const float sc = am > 0.f ? 384.f / am : 1.f;
#pragma unroll
        for (int j = 0; j < 2; ++j) { u32x4 w;
#pragma unroll
            for (int i = 0; i < 4; ++i) { const f32x4 x = v[j * 4 + i] * sc; unsigned p = __builtin_amdgcn_cvt_pk_fp8_f32(x[0], x[1], 0u, false); p = __builtin_amdgcn_cvt_pk_fp8_f32(x[2], x[3], p, true); w[i] = p; }
            *(u32x4*)(dst + (size_t)row * DM + j * 1024 + F.lane * 16) = w; }
        if (F.lane == 0) descale[row] = am > 0.f ? am * (1.f / 384.f) : 1.f;
    }
}
__device__ __forceinline__ float silu_f(float v) { return v / (1.f + __expf(-v)); }

__device__ __forceinline__ void prologue_phase(const Ctx& F, CParams& P) {
    unsigned char* ws = F.ws;
    {
        float* sv = (float*)F.lds;
        float* part = (float*)(F.lds + 24576);
        for (int i = F.tid; i < 3 * DM; i += 512) { const int v = i / DM, k = i % DM; const float cv = v < 2 ? P.c[v * DM + k] : P.c_ctx[k]; sv[i] = silu_f(cv); }
        __syncthreads();
        float* mod = (float*)(ws + WS_MOD);
        for (int it = F.vcu; it < DEPTH * 192; it += F.G) {
            const int l = it / 192, n0 = (it % 192) * 64;
            const float* wp = P.w_mod + ((size_t)l * DM + F.wid * 256) * 12288 + n0 + F.lane;
            float a0 = 0.f, a1 = 0.f, a2 = 0.f;
#pragma unroll 8
            for (int k = 0; k < 256; ++k) { const float w = wp[(size_t)k * 12288]; const int kk = F.wid * 256 + k; a0 += sv[kk] * w; a1 += sv[DM + kk] * w; a2 += sv[2 * DM + kk] * w; }
            part[(F.wid * 3 + 0) * 64 + F.lane] = a0; part[(F.wid * 3 + 1) * 64 + F.lane] = a1; part[(F.wid * 3 + 2) * 64 + F.lane] = a2;
            __syncthreads();
            if (F.wid < 3) { float s = 0.f;
#pragma unroll
                for (int w = 0; w < 8; ++w) s += part[(w * 3 + F.wid) * 64 + F.lane];
                mod[((size_t)l * 3 + F.wid) * 12288 + n0 + F.lane] = s + P.b_mod[(size_t)l * 12288 + n0 + F.lane]; }
            __syncthreads();
        }
    }
    if (F.vcu == 0) {
        float* t16 = (float*)(ws + WS_TAB16); float* t32 = (float*)(ws + WS_TAB32);
        for (int i = F.tid; i < 128 * 16; i += 512) { const int pos = i >> 4, f = i & 15; const float fr = powf(10000.f, -(float)f / 16.f); const float a = (float)pos * fr; float s, c; sincosf(a, &s, &c); t16[i * 2] = c; t16[i * 2 + 1] = s; }
        for (int i = F.tid; i < 128 * 32; i += 512) { const int pos = i >> 5, f = i & 31; const float fr = powf(10000.f, -(float)f / 32.f); const float a = (float)pos * fr; float s, c; sincosf(a, &s, &c); t32[i * 2] = c; t32[i * 2 + 1] = s; }
        if (F.wid < 2) { const float* lv = P.lam_vec + F.wid * 256; const float d1 = wave_sum(lv[F.lane] * lv[64 + F.lane]), d2 = wave_sum(lv[128 + F.lane] * lv[192 + F.lane]);
            const float lam_init = 0.8f - 0.6f * expf(-0.3f * (float)(2 * F.wid));
            if (F.lane == 0) ((float*)(ws + WS_LAM))[F.wid] = expf(d1) - expf(d2) + lam_init; }
    }
    tconv(F, P.w_in_ab, (bf16_t*)(ws + WS_WINAB), nullptr, 2, DM, AB_IN, AB_INP);
    tconv(F, P.w_uq, (bf16_t*)(ws + WS_WUQ), P.g_cq, 2, 768, 1536, 1536);
    tconv(F, P.w_ukv, (bf16_t*)(ws + WS_WUKV), P.g_ckv, 2, 512, 2048, 2048);
    tconv(F, P.w_out_ab, (bf16_t*)(ws + WS_WOUTAB), nullptr, 2, DM, DM, DM);
    tconv(F, P.w_in_c, (bf16_t*)(ws + WS_WINC), nullptr, 2, DM, C_IN, C_IN);
    tconv(F, P.w_out_c, (bf16_t*)(ws + WS_WOUTC), nullptr, 2, DM, DM, DM);
    tconv(F, P.w_pq, (bf16_t*)(ws + WS_WPQ), nullptr, 4, DM, DM, DM);
    cvt_flat(F, P.sub_keys, (bf16_t*)(ws + WS_SUBK), (size_t)4 * 8 * 2 * 128 * 128 / 8);
    cvt_rows_fp8(F, P.expert_u, ws + WS_EU, (float*)(ws + WS_SU), 4 * NEXP);
    cvt_rows_fp8(F, P.expert_v, ws + WS_EV, (float*)(ws + WS_SV), 4 * NEXP);
}

__device__ __forceinline__ void norm_phase(const Ctx& F, CParams& P, int layer, int which  , int m_rows) {
    float* X = (float*)(F.ws + WS_X); bf16_t* H = (bf16_t*)(F.ws + WS_H);
    const float* mod = (const float*)(F.ws + WS_MOD) + (size_t)layer * 3 * 12288;
    const float* gn = (which ? P.g_norm2 : P.g_norm1) + (size_t)layer * DM;
    const bool from_in = (layer == 0 && which == 0);
    for (int t = F.vcu * 8 + F.wid; t < m_rows; t += F.G * 8) {
        const int vs = vsel_of_row(t);
        const float* src = from_in ? (t < TL ? P.x + (size_t)t * DM : P.ctx + (size_t)(t - TL) * DM) : X + (size_t)t * DM;
        const float* shf = mod + (size_t)vs * 12288 + (which ? 3 : 0) * DM; const float* scl = shf + DM;
        f32x4 v[8]; float ss = 0.f;
#pragma unroll
        for (int j = 0; j < 8; ++j) { v[j] = *(const f32x4*)(src + j * 256 + F.lane * 4); ss += v[j][0] * v[j][0] + v[j][1] * v[j][1] + v[j][2] * v[j][2] + v[j][3] * v[j][3]; }
        ss = wave_sum(ss);
        const float rstd = rsqrtf(ss * (1.f / DM) + EPS);
#pragma unroll
        for (int j = 0; j < 8; ++j) { const int c = j * 256 + F.lane * 4;
            if (from_in) *(f32x4*)(X + (size_t)t * DM + c) = v[j];
            const f32x4 g = *(const f32x4*)(gn + c), sc = *(const f32x4*)(scl + c), sh = *(const f32x4*)(shf + c);
            f32x4 y;
#pragma unroll
            for (int e = 0; e < 4; ++e) y[e] = (v[j][e] * rstd * g[e]) * (1.f + sc[e]) + sh[e];
            u32x2 w; w.x = cvt_pk_bf16(y[0], y[1]); w.y = cvt_pk_bf16(y[2], y[3]);
            *(u32x2*)(H + (size_t)t * DM + c) = w; }
    }
}

__device__ __forceinline__ void rope16(float& x0, float& x1, int l2, int row, int col, const float* t16) {
    const int o = 2 * l2, seg = o >> 5, i = o & 31, f = i & 15, pos = seg ? col : row; const bool first = i < 16;
    const float p0 = swz_xor<8>(x0), p1 = swz_xor<8>(x1);
    const f32x4 cs = *(const f32x4*)(t16 + (pos * 16 + f) * 2);
    if (first) { x0 = x0 * cs[0] - p0 * cs[1]; x1 = x1 * cs[2] - p1 * cs[3]; }
    else       { x0 = p0 * cs[1] + x0 * cs[0]; x1 = p1 * cs[3] + x1 * cs[2]; }
}
__device__ __forceinline__ void rope32(float& x0, float& x1, int l2, int pos, const float* t32) {
    const int i = 2 * l2, f = i & 31; const bool first = i < 32;
    const float p0 = swz_xor<16>(x0), p1 = swz_xor<16>(x1);
    const f32x4 cs = *(const f32x4*)(t32 + (pos * 32 + f) * 2);
    if (first) { x0 = x0 * cs[0] - p0 * cs[1]; x1 = x1 * cs[2] - p1 * cs[3]; }
    else       { x0 = p0 * cs[1] + x0 * cs[0]; x1 = p1 * cs[3] + x1 * cs[2]; }
}
__device__ __forceinline__ void ldpair(const bf16_t* p, float& a, float& b) { const unsigned w = *(const unsigned*)p; a = bf_lo(w); b = bf_hi(w); }
__device__ __forceinline__ void stpair(bf16_t* p, float a, float b) { *(unsigned*)p = cvt_pk_bf16(a, b); }

__device__ __forceinline__ void qkv_even_phase(const Ctx& F, CParams& P, int e) {
    const bf16_t* P1 = (const bf16_t*)(F.ws + WS_P1); const bf16_t* QA = (const bf16_t*)(F.ws + WS_QA); const bf16_t* KV = (const bf16_t*)(F.ws + WS_KV);
    bf16_t* Qm = (bf16_t*)(F.ws + WS_Q1); bf16_t* Km = (bf16_t*)(F.ws + WS_K1); bf16_t* Vm = (bf16_t*)(F.ws + WS_V1);
    bf16_t* Qd = (bf16_t*)(F.ws + WS_Q2); bf16_t* Kd = (bf16_t*)(F.ws + WS_K2); bf16_t* Vd = (bf16_t*)(F.ws + WS_V2);
    const float* t16 = (const float*)(F.ws + WS_TAB16);
    const float* gqa = P.g_qn_a + e * 192; const float* gka = P.g_kn_a + e * 192; const float* gqb = P.g_qn_b + e * 64; const float* gkb = P.g_kn_b + e * 64;
    const int l2 = F.lane & 31, hw = F.lane >> 5;
    for (int t = F.vcu * 8 + F.wid; t < TT; t += F.G * 8) {
        const bool latent = t < TL; const int s = t & (SEQ - 1), row = s >> 6, col = s & 63; const int kr = krow_of(t);
        const bf16_t* p1 = P1 + (size_t)t * AB_INP;
        float ss = 0.f;
#pragma unroll
        for (int j = 0; j < 3; ++j) { const u32x2 w = *(const u32x2*)(p1 + j * 256 + F.lane * 4); const float a = bf_lo(w.x), b = bf_hi(w.x), c = bf_lo(w.y), d = bf_hi(w.y); ss += a * a + b * b + c * c + d * d; }
        ss = wave_sum(ss); const float rstd_q = rsqrtf(ss * (1.f / 768.f) + EPS);
        float s2 = 0.f;
        { const u32x4 w = *(const u32x4*)(p1 + 768 + F.lane * 8);
#pragma unroll
          for (int q = 0; q < 4; ++q) { const float a = bf_lo(w[q]), b = bf_hi(w[q]); s2 += a * a + b * b; } }
        s2 = wave_sum(s2); const float rstd_kv = rsqrtf(s2 * (1.f / 512.f) + EPS);
#pragma unroll 1
        for (int it = 0; it < 4; ++it) { const int h = it * 2 + hw; const bf16_t* src = QA + (size_t)t * 1536 + h * 192 + 2 * l2;
            float x[3][2]; float sq = 0.f;
#pragma unroll
            for (int c = 0; c < 3; ++c) { ldpair(src + c * 64, x[c][0], x[c][1]); x[c][0] *= rstd_q; x[c][1] *= rstd_q; sq += x[c][0] * x[c][0] + x[c][1] * x[c][1]; }
            sq = hw_sum(sq); const float r = rsqrtf(sq * (1.f / 192.f) + EPS);
#pragma unroll
            for (int c = 0; c < 3; ++c) { x[c][0] *= r * gqa[c * 64 + 2 * l2]; x[c][1] *= r * gqa[c * 64 + 2 * l2 + 1]; }
            if (latent) rope16(x[2][0], x[2][1], l2, row, col, t16);
            bf16_t* dst = Qm + ((size_t)t * 8 + h) * 192 + 2 * l2;
#pragma unroll
            for (int c = 0; c < 3; ++c) stpair(dst + c * 64, x[c][0], x[c][1]); }
#pragma unroll 1
        for (int it = 0; it < 4; ++it) { const int h = it * 2 + hw; const bf16_t* src = KV + (size_t)t * 2048 + h * 256 + 2 * l2;
            float x[3][2]; float sq = 0.f;
#pragma unroll
            for (int c = 0; c < 2; ++c) { ldpair(src + c * 64, x[c][0], x[c][1]); x[c][0] *= rstd_kv; x[c][1] *= rstd_kv; }
            ldpair(p1 + 1280 + 2 * l2, x[2][0], x[2][1]);
#pragma unroll
            for (int c = 0; c < 3; ++c) sq += x[c][0] * x[c][0] + x[c][1] * x[c][1];
            sq = hw_sum(sq); const float r = rsqrtf(sq * (1.f / 192.f) + EPS);
#pragma unroll
            for (int c = 0; c < 3; ++c) { x[c][0] *= r * gka[c * 64 + 2 * l2]; x[c][1] *= r * gka[c * 64 + 2 * l2 + 1]; }
            if (latent) rope16(x[2][0], x[2][1], l2, row, col, t16);
            bf16_t* dst = Km + ((size_t)kr * 8 + h) * 192 + 2 * l2;
#pragma unroll
            for (int c = 0; c < 3; ++c) stpair(dst + c * 64, x[c][0], x[c][1]);
            bf16_t* dv = Vm + ((size_t)kr * 8 + h) * 128 + 2 * l2;
#pragma unroll
            for (int c = 0; c < 2; ++c) { float a, b; ldpair(src + 128 + c * 64, a, b); stpair(dv + c * 64, a * rstd_kv, b * rstd_kv); } }
#pragma unroll 1
        for (int it = 0; it < 8; ++it) { const int hm = it * 2 + hw;
            float a, b; ldpair(p1 + 1344 + hm * 64 + 2 * l2, a, b);
            float sq = hw_sum(a * a + b * b); float r = rsqrtf(sq * (1.f / 64.f) + EPS);
            a *= r * gqb[2 * l2]; b *= r * gqb[2 * l2 + 1];
            if (latent) rope16(a, b, l2, row, col, t16);
            stpair(Qd + ((size_t)t * 16 + hm) * 64 + 2 * l2, a, b);
            ldpair(p1 + 2368 + hm * 64 + 2 * l2, a, b);
            sq = hw_sum(a * a + b * b); r = rsqrtf(sq * (1.f / 64.f) + EPS);
            a *= r * gkb[2 * l2]; b *= r * gkb[2 * l2 + 1];
            if (latent) rope16(a, b, l2, row, col, t16);
            stpair(Kd + ((size_t)kr * 16 + hm) * 64 + 2 * l2, a, b); }
#pragma unroll
        for (int j = 0; j < 2; ++j) *(u32x4*)(Vd + (size_t)kr * 1024 + j * 512 + F.lane * 8) = *(const u32x4*)(p1 + 3392 + j * 512 + F.lane * 8);
    }
}
__device__ __forceinline__ void qkv_odd_phase(const Ctx& F, CParams& P, int e) {
    const bf16_t* P1 = (const bf16_t*)(F.ws + WS_P1);
    bf16_t* Qc = (bf16_t*)(F.ws + WS_Q1); bf16_t* Kc = (bf16_t*)(F.ws + WS_K1); bf16_t* Vc = (bf16_t*)(F.ws + WS_V1);
    const float* t32 = (const float*)(F.ws + WS_TAB32);
    const float* gq = P.g_qn_c + e * 128; const float* gk = P.g_kn_c + e * 128;
    const int l2 = F.lane & 31, hw = F.lane >> 5;
    for (int t = F.vcu * 8 + F.wid; t < TT; t += F.G * 8) {
        const bool latent = t < TL; const int s = t & (SEQ - 1), row = s >> 6, col = s & 63; const int kr = krow_of(t);
        const bf16_t* p1 = P1 + (size_t)t * C_IN;
#pragma unroll 1
        for (int it = 0; it < 10; ++it) {
            const bool isq = it < 8; const int h = (isq ? it : it - 8) * 2 + hw;
            const bf16_t* src = p1 + (isq ? 0 : 2048) + h * 128 + 2 * l2; const float* g = isq ? gq : gk;
            float x[2][2]; float sq = 0.f;
#pragma unroll
            for (int c = 0; c < 2; ++c) { ldpair(src + c * 64, x[c][0], x[c][1]); sq += x[c][0] * x[c][0] + x[c][1] * x[c][1]; }
            sq = hw_sum(sq); const float r = rsqrtf(sq * (1.f / 128.f) + EPS);
#pragma unroll
            for (int c = 0; c < 2; ++c) { x[c][0] *= r * g[c * 64 + 2 * l2]; x[c][1] *= r * g[c * 64 + 2 * l2 + 1]; }
            if (latent) { rope32(x[0][0], x[0][1], l2, row, t32); rope32(x[1][0], x[1][1], l2, col, t32); }
            bf16_t* dst = isq ? Qc + ((size_t)t * 16 + h) * 128 + 2 * l2 : Kc + ((size_t)kr * 4 + h) * 128 + 2 * l2;
#pragma unroll
            for (int c = 0; c < 2; ++c) stpair(dst + c * 64, x[c][0], x[c][1]); }
        *(u32x4*)(Vc + (size_t)kr * 512 + F.lane * 8) = *(const u32x4*)(p1 + 2560 + F.lane * 8);
    }
}

template <int DQK, int SDEPTH, int ldo, int NH, int NKVH, int NVH>
__device__ __forceinline__ void attn_phase(const Ctx& F, const bf16_t* Qbuf, const bf16_t* Kbuf, const bf16_t* Vbuf, float* OF, int ocol0, bool with_ctx) {
    constexpr int kv_div = NH / NKVH, v_div = NH / NVH;
    const int n_lat = NH * NB * 32, n_tot = n_lat + (with_ctx ? NH * NB : 0);
    constexpr int ldq = NH * DQK, ldk = NKVH * DQK, ldv = NVH * 128;
    for (int u = F.vcu; u < n_tot; u += F.G) {
        int b, h, qrow0, kstart, seq;
        if (u < n_lat) { const int bh = u >> 5, qb = u & 31; b = bh / NH; h = bh % NH; qrow0 = b * SEQ + qb * 256; kstart = b * KPB; seq = KPB; }
        else { const int bh = u - n_lat; b = bh / NH; h = bh % NH; qrow0 = TL + b * CTXL; kstart = b * KPB + SEQ; seq = CTXL; }
        const bf16_t* Qp = Qbuf + ((size_t)qrow0 * NH + h) * DQK;
        const bf16_t* Kp = Kbuf + ((size_t)kstart * NKVH + h / kv_div) * DQK;
        const bf16_t* Vp = Vbuf + ((size_t)kstart * NVH + h / v_div) * 128;
        float* Op = OF + (size_t)qrow0 * ldo + ocol0 + h * 128;
        if constexpr (SDEPTH == 0) att::attn_body_simple<DQK, (DQK == 192 ? MLA_QL : 0), ldq, ldk, ldv, ldo>(Qp, Kp, Vp, Op, seq, F.lds, F.wid);
        else att::attn_body<DQK, SDEPTH, (DQK == 192 ? MLA_QL : (DQK == 128 ? GQA_QL : 0)), ldq, ldk, ldv, ldo>(Qp, Kp, Vp, Op, seq, F.lds, F.wid);
    }
}

__device__ __forceinline__ void merge_even_phase(const Ctx& F, CParams& P, int e, int layer, int m_rows) {
    const float* OF = (const float*)(F.ws + WS_OF); bf16_t* AO = (bf16_t*)(F.ws + WS_AO);
    const float lam = ((const float*)(F.ws + WS_LAM))[e];
    const float lam_init = 0.8f - 0.6f * expf(-0.3f * (float)layer);
    const float* gs = P.g_sub_b + e * 128;
    const int l2 = F.lane & 31, hw = F.lane >> 5;
    for (int t = F.vcu * 8 + F.wid; t < m_rows; t += F.G * 8) {
        const float* of = OF + (size_t)t * 3072; bf16_t* ao = AO + (size_t)t * DM;
#pragma unroll
        for (int j = 0; j < 4; ++j) { const f32x4 v = *(const f32x4*)(of + j * 256 + F.lane * 4); u32x2 w; w.x = cvt_pk_bf16(v[0], v[1]); w.y = cvt_pk_bf16(v[2], v[3]); *(u32x2*)(ao + j * 256 + F.lane * 4) = w; }
#pragma unroll
        for (int it = 0; it < 4; ++it) { const int h = it * 2 + hw;
            const f32x4 o0 = *(const f32x4*)(of + 1024 + (2 * h) * 128 + l2 * 4), o1 = *(const f32x4*)(of + 1024 + (2 * h + 1) * 128 + l2 * 4);
            f32x4 d = o0 - lam * o1;
            float sq = hw_sum(d[0] * d[0] + d[1] * d[1] + d[2] * d[2] + d[3] * d[3]);
            const float r = rsqrtf(sq * (1.f / 128.f) + EPS) * (1.f - lam_init);
            const f32x4 g = *(const f32x4*)(gs + l2 * 4);
            u32x2 w; w.x = cvt_pk_bf16(d[0] * r * g[0], d[1] * r * g[1]); w.y = cvt_pk_bf16(d[2] * r * g[2], d[3] * r * g[3]);
            *(u32x2*)(ao + 1024 + h * 128 + l2 * 4) = w; }
    }
}
__device__ __forceinline__ void merge_odd_phase(const Ctx& F, int m_rows) {
    const float* OF = (const float*)(F.ws + WS_OF); bf16_t* AO = (bf16_t*)(F.ws + WS_AO);
    for (int t = F.vcu * 8 + F.wid; t < m_rows; t += F.G * 8) {
        const float* of = OF + (size_t)t * 2048; bf16_t* ao = AO + (size_t)t * DM;
#pragma unroll
        for (int j = 0; j < 8; ++j) { const f32x4 v = *(const f32x4*)(of + j * 256 + F.lane * 4); u32x2 w; w.x = cvt_pk_bf16(v[0], v[1]); w.y = cvt_pk_bf16(v[2], v[3]); *(u32x2*)(ao + j * 256 + F.lane * 4) = w; }
    }
}

__device__ __forceinline__ void wave_lds_fence() { asm volatile("s_waitcnt lgkmcnt(0)" ::: "memory"); __builtin_amdgcn_wave_barrier(); asm volatile("" ::: "memory"); }
__device__ __forceinline__ unsigned fkey(float f) { const unsigned b = __float_as_uint(f); return b ^ ((unsigned)((int)b >> 31) | 0x80000000u); }
__device__ __forceinline__ float funkey(unsigned k) { return __uint_as_float((k & 0x80000000u) ? (k ^ 0x80000000u) : ~k); }
__device__ __forceinline__ unsigned umed3(unsigned a, unsigned b, unsigned c) { unsigned r; asm("v_med3_u32 %0, %1, %2, %3" : "=v"(r) : "v"(a), "v"(b), "v"(c)); return r; }
__device__ __forceinline__ void kins16(unsigned (&L)[16], unsigned k) {
#pragma unroll
    for (int p = 15; p >= 1; --p) L[p] = umed3(L[p - 1], L[p], k);
    L[0] = L[0] > k ? L[0] : k;
}
__device__ __forceinline__ void scan_set(unsigned (&L)[16], const bf16_t* qbase  , const bf16_t* kbase  , float* buf, int lane) {
    const int r32 = lane & 31, hi = lane >> 5;
#pragma unroll
    for (int p = 0; p < 16; ++p) L[p] = 0u;
    bf16x8 a0[8], a1[8];
    { const bf16_t* ap = qbase + (size_t)r32 * DM + hi * 8;
#pragma unroll
      for (int ks = 0; ks < 8; ++ks) { a0[ks] = *(const bf16x8*)(ap + ks * 16); a1[ks] = *(const bf16x8*)(ap + (size_t)32 * DM + ks * 16); } }
#pragma unroll 1
    for (int kb = 0; kb < 4; ++kb) {
        f32x16 acc0 = {}, acc1 = {};
        { const bf16_t* bp = kbase + (size_t)(kb * 32 + r32) * 128 + hi * 8;
          bf16x8 b[8];
#pragma unroll
          for (int ks = 0; ks < 8; ++ks) b[ks] = *(const bf16x8*)(bp + ks * 16);
#pragma unroll
          for (int ks = 0; ks < 8; ++ks) { acc0 = __builtin_amdgcn_mfma_f32_32x32x16_bf16(a0[ks], b[ks], acc0, 0, 0, 0); acc1 = __builtin_amdgcn_mfma_f32_32x32x16_bf16(a1[ks], b[ks], acc1, 0, 0, 0); } }
        wave_lds_fence();
#pragma unroll
        for (int r = 0; r < 16; ++r) { const int rowi = att::crow(r, hi); buf[rowi * 33 + r32] = acc0[r]; buf[(32 + rowi) * 33 + r32] = acc1[r]; }
        wave_lds_fence();
        const unsigned tb = 127u - (unsigned)(kb * 32);
#pragma unroll 8
        for (int k = 0; k < 32; ++k) kins16(L, (fkey(buf[lane * 33 + k]) & ~127u) | (tb - (unsigned)k));
    }
}
__device__ __forceinline__ void peer_select_phase(const Ctx& F, int layer, int m_rows) {
    const bf16_t* PQ = (const bf16_t*)(F.ws + WS_PQ); const bf16_t* SK = (const bf16_t*)(F.ws + WS_SUBK) + (size_t)layer * 8 * 2 * 128 * 128;
    int* PIDX = (int*)(F.ws + WS_PIDX); float* PG = (float*)(F.ws + WS_PG);
    float* buf = (float*)F.lds + F.wid * (64 * 33);
    const int lane = F.lane;
    const int nunits = (m_rows / 64) * 8;
    for (int u = F.vcu * 8 + F.wid; u < nunits; u += F.G * 8) {
        const int tile = u >> 3, h = u & 7, t0 = tile * 64;
        unsigned Ka[16], Kb[16];
        scan_set(Ka, PQ + (size_t)t0 * DM + h * 256, SK + (size_t)(h * 2) * 128 * 128, buf, lane);
        scan_set(Kb, PQ + (size_t)t0 * DM + h * 256 + 128, SK + (size_t)(h * 2 + 1) * 128 * 128, buf, lane);
        wave_lds_fence();
        float la[16], lb[16];
#pragma unroll
        for (int p = 0; p < 16; ++p) { la[p] = funkey(Ka[p] & ~127u); lb[p] = funkey(Kb[p] & ~127u);
            buf[lane * 33 + p] = __int_as_float(127 - (int)(Ka[p] & 127u)); buf[lane * 33 + 16 + p] = __int_as_float(127 - (int)(Kb[p] & 127u)); }
        wave_lds_fence();
        unsigned Kc[16];
#pragma unroll
        for (int p = 0; p < 16; ++p) Kc[p] = 0u;
#pragma unroll
        for (int r1 = 0; r1 < 16; ++r1)
#pragma unroll
            for (int r2 = 0; r2 < 16; ++r2) if ((r1 + 1) * (r2 + 1) <= 16) kins16(Kc, (fkey(la[r1] + lb[r2]) & ~255u) | (unsigned)(255 - (16 * r1 + r2)));
        float bv[16], sm = 0.f; unsigned idx[16];
#pragma unroll
        for (int p = 0; p < 16; ++p) { const int code = 255 - (int)(Kc[p] & 255u); bv[p] = funkey(Kc[p] & ~255u);
            idx[p] = (unsigned)(__float_as_int(buf[lane * 33 + (code >> 4)]) * 128 + __float_as_int(buf[lane * 33 + 16 + (code & 15)])); }
        const float bmax = bv[0];
#pragma unroll
        for (int p = 0; p < 16; ++p) { bv[p] = __expf(bv[p] - bmax); sm += bv[p]; }
        const float inv = 1.f / sm;
        const size_t o = ((size_t)(t0 + lane) * 8 + h) * 16;
#pragma unroll
        for (int q = 0; q < 4; ++q) { *(f32x4*)(PG + o + q * 4) = (f32x4){bv[q * 4] * inv, bv[q * 4 + 1] * inv, bv[q * 4 + 2] * inv, bv[q * 4 + 3] * inv};
            *(u32x4*)(PIDX + o + q * 4) = (u32x4){idx[q * 4], idx[q * 4 + 1], idx[q * 4 + 2], idx[q * 4 + 3]}; }
    }
}

__device__ __forceinline__ float gelu_tanh(float a) { const float u = 0.7978845608028654f * (a + 0.044715f * a * a * a); const float t = 1.f - 2.f / (1.f + __expf(2.f * u)); return 0.5f * a * (1.f + t); }
struct Row8 { u32x4 r[2]; };
__device__ __forceinline__ void ld_row8(Row8& R, const unsigned char* tab, int e, int lane) {
    const u32x4* rp = (const u32x4*)(tab + (size_t)e * DM);
    R.r[0] = rp[lane]; R.r[1] = rp[64 + lane];
}
__device__ __forceinline__ float dot_row8(const Row8& R, const float (&h)[32]) {
    float s0 = 0.f, s1 = 0.f, s2 = 0.f, s3 = 0.f;
#pragma unroll
    for (int j = 0; j < 2; ++j)
#pragma unroll
        for (int q = 0; q < 4; ++q) { const unsigned w = R.r[j][q]; const f32x2 lo = __builtin_amdgcn_cvt_pk_f32_fp8(w, false), hi = __builtin_amdgcn_cvt_pk_f32_fp8(w, true);
            s0 = fmaf(lo[0], h[j * 16 + q * 4 + 0], s0); s1 = fmaf(lo[1], h[j * 16 + q * 4 + 1], s1); s2 = fmaf(hi[0], h[j * 16 + q * 4 + 2], s2); s3 = fmaf(hi[1], h[j * 16 + q * 4 + 3], s3); }
    return (s0 + s1) + (s2 + s3);
}
__device__ __forceinline__ void fma_row8(float (&out)[32], const Row8& R, float w) {
#pragma unroll
    for (int j = 0; j < 2; ++j)
#pragma unroll
        for (int q = 0; q < 4; ++q) { const unsigned x = R.r[j][q]; const f32x2 lo = __builtin_amdgcn_cvt_pk_f32_fp8(x, false), hi = __builtin_amdgcn_cvt_pk_f32_fp8(x, true);
            out[j * 16 + q * 4 + 0] = fmaf(w, lo[0], out[j * 16 + q * 4 + 0]); out[j * 16 + q * 4 + 1] = fmaf(w, lo[1], out[j * 16 + q * 4 + 1]);
            out[j * 16 + q * 4 + 2] = fmaf(w, hi[0], out[j * 16 + q * 4 + 2]); out[j * 16 + q * 4 + 3] = fmaf(w, hi[1], out[j * 16 + q * 4 + 3]); }
}
__device__ __forceinline__ float reduce4(float s0, float s1, float s2, float s3, int lane) {
    const bool hi = (lane & 32) != 0, b4 = (lane & 16) != 0;
    const float r0 = xor32_partner(hi ? s0 : s2, lane), r1 = xor32_partner(hi ? s1 : s3, lane);
    const float a0 = (hi ? s2 : s0) + r0, a1 = (hi ? s3 : s1) + r1;
    const float r = swz_xor<16>(b4 ? a0 : a1);
    float b = (b4 ? a1 : a0) + r;
    b += swz_xor<8>(b); b += swz_xor<4>(b); b += swz_xor<2>(b); b += swz_xor<1>(b);
    return b;
}
__device__ __forceinline__ float rl_f(float v, int l) { return __uint_as_float(__builtin_amdgcn_readlane(__float_as_uint(v), l)); }
__device__ __forceinline__ void peer_expert_phase(const Ctx& F, CParams& P, int layer, int m_rows, bool last, bool dry) {
    const unsigned char* EU = F.ws + WS_EU + (size_t)layer * NEXP * DM; const unsigned char* EV = F.ws + WS_EV + (size_t)layer * NEXP * DM;
    const float* SU = (const float*)(F.ws + WS_SU) + (size_t)layer * NEXP; const float* SV = (const float*)(F.ws + WS_SV) + (size_t)layer * NEXP;
    const bf16_t* H = (const bf16_t*)(F.ws + WS_H); float* X = (float*)(F.ws + WS_X);
    const int* PIDX = (const int*)(F.ws + WS_PIDX); const float* PG = (const float*)(F.ws + WS_PG);
    const float* mod = (const float*)(F.ws + WS_MOD) + (size_t)layer * 3 * 12288;
    const int lane = F.lane;
    for (int t = F.vcu * 8 + F.wid; t < m_rows; t += F.G * 8) {
        float hf[32];
#pragma unroll
        for (int j = 0; j < 2; ++j) { const u32x4* hp = (const u32x4*)(H + (size_t)t * DM + j * 1024 + lane * 16); const u32x4 w0 = hp[0], w1 = hp[1];
#pragma unroll
            for (int q = 0; q < 4; ++q) { hf[j * 16 + q * 2] = bf_lo(w0[q]); hf[j * 16 + q * 2 + 1] = bf_hi(w0[q]); hf[j * 16 + 8 + q * 2] = bf_lo(w1[q]); hf[j * 16 + 8 + q * 2 + 1] = bf_hi(w1[q]); } }
        int id[2]; float wv[2];
        id[0] = PIDX[(size_t)t * 128 + lane]; id[1] = PIDX[(size_t)t * 128 + 64 + lane];
#pragma unroll
        for (int half = 0; half < 2; ++half) {
            const int idr = id[half]; float acc = 0.f;
            const float gk = PG[(size_t)t * 128 + half * 64 + lane], su = SU[idr], sv = SV[idr];
            Row8 A[4], B[4];
#pragma unroll
            for (int q = 0; q < 4; ++q) ld_row8(A[q], EU, __builtin_amdgcn_readlane(idr, q), lane);
#pragma unroll 1
            for (int k = 0; k < 64; k += 8) {
#pragma unroll
                for (int q = 0; q < 4; ++q) ld_row8(B[q], EU, __builtin_amdgcn_readlane(idr, k + 4 + q), lane);
                { const float b = reduce4(dot_row8(A[0], hf), dot_row8(A[1], hf), dot_row8(A[2], hf), dot_row8(A[3], hf), lane);
#pragma unroll
                  for (int q = 0; q < 4; ++q) { const float tq = rl_f(b, 16 * q); acc = (lane == k + q) ? tq : acc; } }
                if (k + 8 < 64) {
#pragma unroll
                    for (int q = 0; q < 4; ++q) ld_row8(A[q], EU, __builtin_amdgcn_readlane(idr, k + 8 + q), lane); }
                { const float b = reduce4(dot_row8(B[0], hf), dot_row8(B[1], hf), dot_row8(B[2], hf), dot_row8(B[3], hf), lane);
#pragma unroll
                  for (int q = 0; q < 4; ++q) { const float tq = rl_f(b, 16 * q); acc = (lane == k + 4 + q) ? tq : acc; } }
            }
            wv[half] = gk * gelu_tanh(acc * su) * sv;
        }
        float out[32];
#pragma unroll
        for (int i = 0; i < 32; ++i) out[i] = 0.f;
#pragma unroll
        for (int half = 0; half < 2; ++half) {
            const int idr = id[half]; const float wr = wv[half];
            Row8 A[4], B[4];
#pragma unroll
            for (int q = 0; q < 4; ++q) ld_row8(A[q], EV, __builtin_amdgcn_readlane(idr, q), lane);
#pragma unroll 1
            for (int k = 0; k < 64; k += 8) {
#pragma unroll
                for (int q = 0; q < 4; ++q) ld_row8(B[q], EV, __builtin_amdgcn_readlane(idr, k + 4 + q), lane);
#pragma unroll
                for (int q = 0; q < 4; ++q) fma_row8(out, A[q], rl_f(wr, k + q));
                if (k + 8 < 64) {
#pragma unroll
                    for (int q = 0; q < 4; ++q) ld_row8(A[q], EV, __builtin_amdgcn_readlane(idr, k + 8 + q), lane); }
#pragma unroll
                for (int q = 0; q < 4; ++q) fma_row8(out, B[q], rl_f(wr, k + 4 + q));
            }
        }
        const float* gate = mod + (size_t)vsel_of_row(t) * 12288 + 5 * DM;
        float* xr = X + (size_t)t * DM; float* dst = dry ? (float*)(F.ws + WS_OF) + (size_t)t * DM : (last ? P.out + (size_t)t * DM : xr);
#pragma unroll
        for (int j = 0; j < 2; ++j)
#pragma unroll
            for (int q = 0; q < 4; ++q) { const int c = j * 1024 + lane * 16 + q * 4; const f32x4 xo = *(const f32x4*)(xr + c), g = *(const f32x4*)(gate + c);
                f32x4 y; y[0] = xo[0] + g[0] * out[j * 16 + q * 4 + 0]; y[1] = xo[1] + g[1] * out[j * 16 + q * 4 + 1]; y[2] = xo[2] + g[2] * out[j * 16 + q * 4 + 2]; y[3] = xo[3] + g[3] * out[j * 16 + q * 4 + 3];
                *(f32x4*)(dst + c) = y; }
    }
}

constexpr int N_PHASES = 1 + 2 * 11 + 2 * 10;
__global__ void __launch_bounds__(512, 2) mk_fwd(Params Pval) {
    extern __shared__ __attribute__((aligned(16))) unsigned char lds_raw[];
    LAS unsigned char* ldsl = (LAS unsigned char*)lds_raw;
    volatile LAS unsigned* misc = (volatile LAS unsigned*)(ldsl + LDS_MISC);
    if (threadIdx.x < 16) misc[threadIdx.x] = 0u;
    __syncthreads();
    XcdBarrier bar = xcd_barrier_post((unsigned*)(Pval.ws + WS_CTL) + 1024, misc);
    const int wid0 = __builtin_amdgcn_readfirstlane((int)threadIdx.x >> 6);
    const int lo = Pval.ph_lo, hi = Pval.ph_hi; int ph = 0;
#define MKCTX() Ctx F; { const int lane_ = fresh_lane(); int wid_ = wid0; asm volatile("" : "+s"(wid_)); const int tid_ = wid_ * 64 + lane_; F.tid = tid_; F.lane = lane_; F.wid = wid_; \
        int G_ = gridDim.x, bx_ = blockIdx.x; asm volatile("" : "+s"(G_), "+s"(bx_)); F.G = G_; F.vcu = (G_ % 8 == 0) ? (bx_ % 8) * (G_ / 8) + bx_ / 8 : bx_; F.bx = bx_; } \
        unsigned long long kp_ = (unsigned long long)__builtin_amdgcn_kernarg_segment_ptr(); asm volatile("" : "+s"(kp_)); CParams& P = *(CParams*)kp_; \
        F.ws = P.ws; F.lds = (char*)lds_raw; unsigned char* ws = F.ws; (void)ws; \
        bf16_t* Hb = (bf16_t*)(ws + WS_H); bf16_t* P1 = (bf16_t*)(ws + WS_P1); float* X = (float*)(ws + WS_X); const float* mod = (const float*)(ws + WS_MOD); (void)Hb; (void)P1; (void)X; (void)mod;
#define PHASE(cls, ...) do { if (ph >= lo && ph < hi) { if constexpr ((PH_MASK >> (cls)) & 1u) { \
        if constexpr ((PH_DOUBLE >> (cls)) & 1u) { const bool dry = true; (void)dry; MKCTX(); __VA_ARGS__; __syncthreads(); } \
        { const bool dry = false; (void)dry; MKCTX(); __VA_ARGS__; } } if (ph + 1 < hi) { int w0_ = wid0; asm volatile("" : "+s"(w0_)); xcd_barrier(bar, w0_ == 0 && fresh_lane() == 0); } } ++ph; } while (0)

    PHASE(0, prologue_phase(F, P));
#pragma unroll 1
    for (int layer = 0; layer < DEPTH; ++layer) {
        const int e = layer >> 1; const bool even = (layer & 1) == 0, lastl = layer == DEPTH - 1;
        const int m_post = lastl ? TL : TT;
        PHASE(1, norm_phase(F, P, layer, 0, TT));
        PHASE(2, { const bf16_t* W = even ? (const bf16_t*)(ws + WS_WINAB) + (size_t)e * AB_INP * DM : (const bf16_t*)(ws + WS_WINC) + (size_t)e * C_IN * DM;
                const int N = even ? AB_INP : C_IN;
                pg8::Gemm g{Hb, W, TT, N, DM, DM}; pg8::StaticOrder S; S.init(TT, N, F.G, F.bx);
                pg8::EpiBf16 E{P1, N};
                pg8::gemm_phase<pg8::EpiBf16, pg8::StaticOrder>(ldsl, g, S, E, F.wid); });
        if (even) {
            PHASE(3, { { pg8::Gemm g{P1, (const bf16_t*)(ws + WS_WUQ) + (size_t)e * 1536 * 768, TT, 1536, 768, AB_INP}; pg8::StaticOrder S; S.init(TT, 1536, F.G, F.bx);
                      pg8::EpiBf16 E{(bf16_t*)(ws + WS_QA), 1536};
                      pg8::gemm_phase<pg8::EpiBf16, pg8::StaticOrder>(ldsl, g, S, E, F.wid); }
                    { pg8::Gemm g{P1 + 768, (const bf16_t*)(ws + WS_WUKV) + (size_t)e * 2048 * 512, TT, 2048, 512, AB_INP}; pg8::StaticOrder S; S.init(TT, 2048, F.G, F.bx);
                      pg8::EpiBf16 E{(bf16_t*)(ws + WS_KV), 2048};
                      pg8::gemm_phase<pg8::EpiBf16, pg8::StaticOrder>(ldsl, g, S, E, F.wid); } });
            PHASE(4, qkv_even_phase(F, P, e));
            PHASE(5, { if constexpr (ATT_SEL & 1) attn_phase<192, MLA_SD, 3072, 8, 8, 8>(F, (const bf16_t*)(ws + WS_Q1), (const bf16_t*)(ws + WS_K1), (const bf16_t*)(ws + WS_V1), (float*)(ws + WS_OF), 0, !lastl);
                    if constexpr (ATT_SEL & 2) attn_phase<64, 2, 3072, 16, 16, 8>(F, (const bf16_t*)(ws + WS_Q2), (const bf16_t*)(ws + WS_K2), (const bf16_t*)(ws + WS_V2), (float*)(ws + WS_OF), 1024, !lastl); });
            PHASE(6, merge_even_phase(F, P, e, layer, m_post));
        } else {
            PHASE(7, qkv_odd_phase(F, P, e));
            PHASE(8, attn_phase<128, GQA_SD, 2048, 16, 4, 4>(F, (const bf16_t*)(ws + WS_Q1), (const bf16_t*)(ws + WS_K1), (const bf16_t*)(ws + WS_V1), (float*)(ws + WS_OF), 0, !lastl));
            PHASE(9, merge_odd_phase(F, m_post));
        }
        PHASE(10, { const bf16_t* W = even ? (const bf16_t*)(ws + WS_WOUTAB) + (size_t)e * DM * DM : (const bf16_t*)(ws + WS_WOUTC) + (size_t)e * DM * DM;
                pg8::Gemm g{(const bf16_t*)(ws + WS_AO), W, m_post, DM, DM, DM}; pg8::StaticOrder S; S.init(m_post, DM, F.G, F.bx);
                pg8::EpiResid E{X, mod + (size_t)layer * 3 * 12288, 2};
                pg8::gemm_phase<pg8::EpiResid, pg8::StaticOrder>(ldsl, g, S, E, F.wid); });
        PHASE(1, norm_phase(F, P, layer, 1, m_post));
        PHASE(11, { pg8::Gemm g{Hb, (const bf16_t*)(ws + WS_WPQ) + (size_t)layer * DM * DM, m_post, DM, DM, DM}; pg8::StaticOrder S; S.init(m_post, DM, F.G, F.bx);
                pg8::EpiBf16 E{(bf16_t*)(ws + WS_PQ), DM};
                pg8::gemm_phase<pg8::EpiBf16, pg8::StaticOrder>(ldsl, g, S, E, F.wid); });
        PHASE(12, peer_select_phase(F, layer, m_post));
        PHASE(13, peer_expert_phase(F, P, layer, m_post, lastl, dry));
    }
#undef PHASE
}

extern "C" void kernel_launch(void* const* d_in, const int* in_sizes, int n_in, void* d_out, int out_size, void* d_ws, size_t ws_size, hipStream_t stream) {
    static int grid = 0;
    if (grid == 0) {
        if (n_in != 28 || ws_size < WS_END) { fprintf(stderr, "kernel_launch: expected 28 inputs and >= %zu bytes of workspace, got %d / %zu\n", (size_t)WS_END, n_in, ws_size); grid = -1; return; }
        int dev = 0, cus = 0, per_cu = 0;
        if (hipGetDevice(&dev) != hipSuccess || hipDeviceGetAttribute(&cus, hipDeviceAttributeMultiprocessorCount, dev) != hipSuccess) { grid = -1; return; }
        if (hipFuncSetAttribute((const void*)mk_fwd, hipFuncAttributeMaxDynamicSharedMemorySize, LDS_BYTES) != hipSuccess) { fprintf(stderr, "kernel_launch: hipFuncSetAttribute failed\n"); grid = -1; return; }
        if (hipOccupancyMaxActiveBlocksPerMultiprocessor(&per_cu, (const void*)mk_fwd, 512, LDS_BYTES) != hipSuccess || per_cu < 1) fprintf(stderr, "kernel_launch: occupancy query says %d\n", per_cu);
        (void)hipGetLastError();
        grid = cus;
    }
    if (grid < 0) return;
    (void)hipMemsetAsync((char*)d_ws + WS_CTL, 0, CTL_BYTES, stream);
    Params p{};
    const float** pf = (const float**)&p;
    for (int i = 0; i < 28; ++i) pf[i] = (const float*)d_in[i];
    p.out = (float*)d_out; p.ws = (unsigned char*)d_ws;
#if MK_PER_PHASE_LAUNCH
    for (int i = 0; i < N_PHASES; ++i) { p.ph_lo = i; p.ph_hi = i + 1; hipLaunchKernelGGL(mk_fwd, dim3(grid), dim3(512), LDS_BYTES, stream, p); }
#else
    p.ph_lo = 0; p.ph_hi = N_PHASES;
    hipLaunchKernelGGL(mk_fwd, dim3(grid), dim3(512), LDS_BYTES, stream, p);
#endif
    const hipError_t le = hipPeekAtLastError();
    if (le != hipSuccess) fprintf(stderr, "kernel_launch: launch failed: %s\n", hipGetErrorName(le));
}
```

```cpp
#include <hip/hip_runtime.h>
#include <stdint.h>
#include <stdio.h>

#ifndef MK_PER_PHASE_LAUNCH
#define MK_PER_PHASE_LAUNCH 0
#endif

#ifndef MLA_QL
#define MLA_QL 0
#endif
#ifndef GQA_QL
#define GQA_QL 0
#endif
#ifndef QKT_GRP
#define QKT_GRP 12
#endif
#ifndef MLA_SD
#define MLA_SD 1
#endif
#ifndef GQA_SD
#define GQA_SD 2
#endif
#ifndef ATT_SEL
#define ATT_SEL 3
#endif
#ifndef PH_DOUBLE
#define PH_DOUBLE 0u
#endif
#ifndef PH_MASK
#define PH_MASK 0xFFFFFFFFu
#endif
#define LAS __attribute__((address_space(3)))
typedef unsigned short bf16_t;
typedef short bf16x8 __attribute__((ext_vector_type(8)));
typedef short s16x4 __attribute__((ext_vector_type(4)));
typedef float f32x4 __attribute__((ext_vector_type(4)));
typedef float f32x2 __attribute__((ext_vector_type(2)));
typedef float f32x16 __attribute__((ext_vector_type(16)));
typedef unsigned u32x4 __attribute__((ext_vector_type(4)));
typedef unsigned u32x2 __attribute__((ext_vector_type(2)));
typedef __bf16 bf16x2_t __attribute__((ext_vector_type(2)));

constexpr int DM = 2048, NB = 2, SEQ = 8192, DEPTH = 4, CTXL = 256;
constexpr int TL = NB * SEQ;
constexpr int TZ = NB * CTXL;
constexpr int TT = TL + TZ;
constexpr int KPB = SEQ + CTXL;
constexpr int AB_IN = 4416, AB_INP = 4608;
constexpr int C_IN = 3072;
constexpr int NEXP = 16384;
constexpr float EPS = 1e-6f;
constexpr float LOG2E = 1.4426950408889634f;

constexpr size_t al256(size_t x) { return (x + 255) / 256 * 256; }
constexpr size_t WS_CTL = 0, CTL_BYTES = 1u << 20;
constexpr size_t WS_MOD = WS_CTL + CTL_BYTES;
constexpr size_t WS_TAB16 = WS_MOD + al256((size_t)4 * 3 * 12288 * 4);
constexpr size_t WS_TAB32 = WS_TAB16 + al256((size_t)128 * 16 * 2 * 4);
constexpr size_t WS_LAM = WS_TAB32 + al256((size_t)128 * 32 * 2 * 4);
constexpr size_t WS_WINAB = WS_LAM + 256;
constexpr size_t WS_WUQ = WS_WINAB + (size_t)2 * AB_INP * DM * 2;
constexpr size_t WS_WUKV = WS_WUQ + (size_t)2 * 1536 * 768 * 2;
constexpr size_t WS_WOUTAB = WS_WUKV + (size_t)2 * 2048 * 512 * 2;
constexpr size_t WS_WINC = WS_WOUTAB + (size_t)2 * DM * DM * 2;
constexpr size_t WS_WOUTC = WS_WINC + (size_t)2 * C_IN * DM * 2;
constexpr size_t WS_WPQ = WS_WOUTC + (size_t)2 * DM * DM * 2;
constexpr size_t WS_SUBK = WS_WPQ + (size_t)4 * DM * DM * 2;
constexpr size_t WS_EU = WS_SUBK + (size_t)4 * 8 * 2 * 128 * 128 * 2;
constexpr size_t WS_EV = WS_EU + (size_t)4 * NEXP * DM;
constexpr size_t WS_SU = WS_EV + (size_t)4 * NEXP * DM;
constexpr size_t WS_SV = WS_SU + (size_t)4 * NEXP * 4;
constexpr size_t WS_X = WS_SV + (size_t)4 * NEXP * 4;
constexpr size_t WS_H = WS_X + (size_t)TT * DM * 4;
constexpr size_t WS_P1 = WS_H + (size_t)TT * DM * 2;
constexpr size_t WS_QA = WS_P1 + (size_t)TT * AB_INP * 2;
constexpr size_t WS_KV = WS_QA + (size_t)TT * 1536 * 2;
constexpr size_t WS_Q1 = WS_KV + (size_t)TT * 2048 * 2;
constexpr size_t WS_K1 = WS_Q1 + (size_t)TT * 2048 * 2;
constexpr size_t WS_V1 = WS_K1 + (size_t)TT * 1536 * 2;
constexpr size_t WS_Q2 = WS_V1 + (size_t)TT * 1024 * 2;
constexpr size_t WS_K2 = WS_Q2 + (size_t)TT * 1024 * 2;
constexpr size_t WS_V2 = WS_K2 + (size_t)TT * 1024 * 2;
constexpr size_t WS_OF = WS_V2 + (size_t)TT * 1024 * 2;
constexpr size_t WS_AO = WS_OF + (size_t)TT * 3072 * 4;
constexpr size_t WS_PQ = WS_AO + (size_t)TT * DM * 2;
constexpr size_t WS_PIDX = WS_PQ + (size_t)TT * DM * 2;
constexpr size_t WS_PG = WS_PIDX + (size_t)TT * 128 * 4;
constexpr size_t WS_END = WS_PG + (size_t)TT * 128 * 4;

constexpr int LDS_MAIN = 157696;
constexpr int LDS_MISC = LDS_MAIN;
constexpr int LDS_BYTES = LDS_MAIN + 4096;

__device__ __forceinline__ unsigned cvt_pk_bf16(float lo, float hi) { unsigned r; asm("v_cvt_pk_bf16_f32 %0, %1, %2" : "=v"(r) : "v"(lo), "v"(hi)); return r; }
__device__ __forceinline__ float bf_lo(unsigned w) { return __uint_as_float(w << 16); }
__device__ __forceinline__ float bf_hi(unsigned w) { return __uint_as_float(w & 0xffff0000u); }
template <int M> __device__ __forceinline__ float swz_xor(float v) { return __int_as_float(__builtin_amdgcn_ds_swizzle(__float_as_int(v), (M << 10) | 0x1f)); }
__device__ __forceinline__ float xor32_partner(float v, int lane) {
    const auto rr = __builtin_amdgcn_permlane32_swap(__float_as_uint(v), __float_as_uint(v), false, false);
    return __uint_as_float(lane < 32 ? rr[1] : rr[0]);
}
__device__ __forceinline__ float hw_sum(float v) {
    v += swz_xor<16>(v); v += swz_xor<8>(v); v += swz_xor<4>(v); v += swz_xor<2>(v); v += swz_xor<1>(v);
    return v;
}
__device__ __forceinline__ float wave_sum(float v) {
    v = hw_sum(v);
    const auto rr = __builtin_amdgcn_permlane32_swap(__float_as_uint(v), __float_as_uint(v), false, false);
    return __uint_as_float(rr[0]) + __uint_as_float(rr[1]);
}
__device__ __forceinline__ float wave_max(float v) {
    v = fmaxf(v, swz_xor<16>(v)); v = fmaxf(v, swz_xor<8>(v)); v = fmaxf(v, swz_xor<4>(v)); v = fmaxf(v, swz_xor<2>(v)); v = fmaxf(v, swz_xor<1>(v));
    const auto rr = __builtin_amdgcn_permlane32_swap(__float_as_uint(v), __float_as_uint(v), false, false);
    return fmaxf(__uint_as_float(rr[0]), __uint_as_float(rr[1]));
}
__device__ __forceinline__ int mbcnt64(unsigned long long m) { return (int)__builtin_amdgcn_mbcnt_hi((unsigned)(m >> 32), __builtin_amdgcn_mbcnt_lo((unsigned)m, 0u)); }
__device__ __forceinline__ int fresh_lane() { int l; asm volatile("v_mbcnt_lo_u32_b32 %0, -1, 0\n\tv_mbcnt_hi_u32_b32 %0, -1, %0" : "=v"(l)); return l; }
__device__ __forceinline__ int krow_of(int t) { return t < TL ? (t >> 13) * KPB + (t & (SEQ - 1)) : ((t - TL) >> 8) * KPB + SEQ + ((t - TL) & (CTXL - 1)); }
__device__ __forceinline__ int vsel_of_row(int t) { return t < SEQ ? 0 : (t < TL ? 1 : 2); }

#define XB_TMO      128
#define XB_XCNT(j)  (256  + 64 * (j))
#define XB_XSUB(j)  (1280 + 64 * (j))
#define XB_XGEN(j)  (2304 + 64 * (j))
#define XB_TOP      3328
#define XB_TOPGEN   3392
#define XCD_BAR_WORDS 3456
#define XB_SPIN_CAP (1u << 27)
__device__ __forceinline__ unsigned xb_ld(unsigned* p)              { return __hip_atomic_load(p, __ATOMIC_RELAXED, __HIP_MEMORY_SCOPE_AGENT); }
__device__ __forceinline__ unsigned xb_add(unsigned* p, unsigned v) { return __hip_atomic_fetch_add(p, v, __ATOMIC_RELAXED, __HIP_MEMORY_SCOPE_AGENT); }
__device__ __forceinline__ unsigned xb_xcc_id() { return (unsigned)__builtin_amdgcn_s_getreg((3 << 11) | 20) & 0xFu; }
#define XB_SPIN(cond, bar) do { unsigned _sp = 0; while (cond) { __builtin_amdgcn_s_sleep(1); \
    if ((++_sp & 255u) == 0u) { if (xb_ld(&(bar)[XB_TMO])) break; if (_sp > XB_SPIN_CAP) { atomicAdd(&(bar)[XB_TMO], 1u); break; } } } } while (0)
struct XcdBarrier { unsigned* bar; unsigned x; volatile LAS unsigned* st; };
__device__ __forceinline__ XcdBarrier xcd_barrier_post(unsigned* bar, volatile LAS unsigned* st) {
    XcdBarrier b; b.bar = bar; b.x = xb_xcc_id(); b.st = st;
    if (threadIdx.x == 0) (void)xb_add(&bar[XB_XCNT(b.x)], 1u);
    return b;
}
__device__ __forceinline__ void xcd_barrier_complete(unsigned* bar, unsigned x, unsigned& nloc, unsigned& nx) {
    asm volatile("" : "+s"(x));
    const unsigned G = gridDim.x * gridDim.y * gridDim.z;
    unsigned sum, cnt, mine, sp = 0u;
    for (;;) {
        sum = 0u; cnt = 0u; mine = 0u;
#pragma unroll
        for (unsigned j = 0; j < 16; ++j) { const unsigned c = xb_ld(&bar[XB_XCNT(j)]); sum += c; cnt += (c > 0u) ? 1u : 0u; mine = (j == x) ? c : mine; }
        if (sum == G) break;
        __builtin_amdgcn_s_sleep(1);
        if ((++sp & 255u) == 0u) { if (xb_ld(&bar[XB_TMO])) break; if (sp > XB_SPIN_CAP) { atomicAdd(&bar[XB_TMO], 1u); break; } }
    }
    nloc = mine > 0u ? mine : 1u; nx = cnt > 0u ? cnt : 1u;
}
__device__ __forceinline__ void xcd_barrier(const XcdBarrier& b, const bool thread0  ) {
    asm volatile("s_waitcnt vmcnt(0)" ::: "memory");
    __syncthreads();
    if (thread0) {
        unsigned* bar = b.bar;
        __builtin_amdgcn_s_waitcnt(0);
        unsigned nloc = b.st[0], nx = b.st[1];
        if (nloc == 0u) { xcd_barrier_complete(bar, b.x, nloc, nx); b.st[0] = nloc; b.st[1] = nx; }
        const unsigned old = xb_add(&bar[XB_XSUB(b.x)], 1u);
        const unsigned gen = old / nloc;
        if (old + 1u == (gen + 1u) * nloc) {
            __builtin_amdgcn_fence(__ATOMIC_RELEASE, "agent");
            asm volatile("s_waitcnt vmcnt(0)" ::: "memory");
            const unsigned og = xb_add(&bar[XB_TOP], 1u);
            const unsigned tg = og / nx;
            if (og + 1u == (tg + 1u) * nx) xb_add(&bar[XB_TOPGEN], 1u);
            else XB_SPIN(xb_ld(&bar[XB_TOPGEN]) == tg, bar);
            __builtin_amdgcn_fence(__ATOMIC_ACQUIRE, "agent");
            xb_add(&bar[XB_XGEN(b.x)], 1u);
            asm volatile("s_waitcnt vmcnt(0)" ::: "memory");
        } else {
            XB_SPIN(xb_ld(&bar[XB_XGEN(b.x)]) == gen, bar);
            __builtin_amdgcn_fence(__ATOMIC_ACQUIRE, "agent");
            asm volatile("s_waitcnt vmcnt(0)" ::: "memory");
        }
    }
    __syncthreads();
}

namespace pg8 {
constexpr int BM = 256, BK = 64, HALF = 128, HTB = HALF * BK * 2, STAGE_BYTES = 8 * HTB, NXCD = 8, WGM = 8;
__host__ __device__ __forceinline__ int lds_byte(int r, int c) { const int st = (r >> 4) * 2 + (c >> 5), rr = r & 15, cc = c & 31, ob = rr * 64 + cc * 2; return st * 1024 + (ob ^ (((ob >> 9) & 1) << 5)); }
__host__ __device__ __forceinline__ void stage_rc(int b, int& R, int& C) { const int st = b / 1024, sb = b % 1024, swz = sb ^ (((sb >> 9) & 1) << 5); R = (st >> 1) * 16 + swz / 64; C = (st & 1) * 32 + (swz % 64) / 2; }
__host__ __device__ __forceinline__ int perm32(int rho) { const int n = rho >> 4, i = rho & 15; return 8 * (i >> 2) + 4 * n + (i & 3); }
struct Unit { int pm, pn; };
struct Gemm { const bf16_t* A; const bf16_t* Bt; int M, N, K, lda; };
struct StaticOrder {
    int nM, nN, nwg, G, c;
    __host__ __device__ void init(int M, int N, int G_, int c_) { nM = M / BM; nN = N / BM; nwg = nM * nN; G = G_; c = c_; }
    __host__ __device__ bool next(int i, Unit& u) const {
        const long L = (long)i * G + c; if (L >= nwg) return false;
        int wgid = (int)L; { const int q = nwg / NXCD, r = nwg % NXCD, xcd = wgid % NXCD, off = wgid / NXCD; wgid = (xcd < r ? xcd * (q + 1) : r * (q + 1) + (xcd - r) * q) + off; }
        const int nig = WGM * nN, gid = wgid / nig, fm = gid * WGM, gsz = (nM - fm) < WGM ? (nM - fm) : WGM;
        u.pm = fm + ((wgid % nig) % gsz); u.pn = (wgid % nig) / gsz; return true;
    }
    __device__ __forceinline__ void a_ready(const Unit&) const {}
    __device__ __forceinline__ void done(const Unit&) const {}
};
struct EpiBf16 {
    static constexpr bool PERM = true;
    bf16_t* O; int ldc;
    __device__ __forceinline__ void operator()(const f32x4 (&acc)[2][2][4][2], const Unit& u, int wr, int wc, int fr, int fq) const {
        const int row0 = u.pm * BM + wr * 64 + fr; const int col0 = u.pn * BM + wc * 32 + 8 * fq;
#pragma unroll
        for (int ai = 0; ai < 2; ++ai)
#pragma unroll
            for (int m = 0; m < 4; ++m) { bf16_t* rowp = O + (size_t)(row0 + ai * HALF + m * 16) * ldc + col0;
#pragma unroll
                for (int bj = 0; bj < 2; ++bj) { const f32x4 v0 = acc[ai][bj][m][0], v1 = acc[ai][bj][m][1];
                    u32x4 w; w.x = cvt_pk_bf16(v0[0], v0[1]); w.y = cvt_pk_bf16(v0[2], v0[3]); w.z = cvt_pk_bf16(v1[0], v1[1]); w.w = cvt_pk_bf16(v1[2], v1[3]);
                    *(u32x4*)(rowp + bj * HALF) = w; } }
    }
};
struct EpiResid {
    static constexpr bool PERM = false;
    float* X; const float* modl; int chunk;
    __device__ __forceinline__ void operator()(const f32x4 (&acc)[2][2][4][2], const Unit& u, int wr, int wc, int fr, int fq) const {
        const int row0 = u.pm * BM + wr * 64 + fr, col0 = u.pn * BM + wc * 32 + 4 * fq;
        const int vs = u.pm < 32 ? 0 : (u.pm < 64 ? 1 : 2);
        const float* gate = modl + (size_t)vs * 12288 + chunk * 2048 + col0;
        f32x4 gv[2][2];
#pragma unroll
        for (int bj = 0; bj < 2; ++bj)
#pragma unroll
            for (int n = 0; n < 2; ++n) gv[bj][n] = *(const f32x4*)(gate + bj * HALF + n * 16);
#pragma unroll
        for (int ai = 0; ai < 2; ++ai)
#pragma unroll
            for (int m = 0; m < 4; ++m) { float* rowp = X + (size_t)(row0 + ai * HALF + m * 16) * DM + col0;
#pragma unroll
                for (int bj = 0; bj < 2; ++bj)
#pragma unroll
                    for (int n = 0; n < 2; ++n) { float* p = rowp + bj * HALF + n * 16; const f32x4 xo = *(const f32x4*)p; *(f32x4*)p = xo + gv[bj][n] * acc[ai][bj][m][n]; } }
    }
};

template <class Epi, class Sched>
__device__ __forceinline__ void gemm_phase(LAS unsigned char* lds, const Gemm g, const Sched& S, const Epi& E, int tid_in) {
    const int tid_l = tid_in * 64 + fresh_lane();
    const int tid = tid_l, wid = tid_in  , lane = tid & 63, wr = wid >> 2, wc = wid & 3, fr = lane & 15, fq = lane >> 4;
    const int K = g.K, nt = K / BK, lda = g.lda;
    unsigned voffA[2], voffB[2];
#pragma unroll
    for (int i = 0; i < 2; ++i) { int R, C; stage_rc(tid * 16 + i * 8192, R, C); const int Rb = Epi::PERM ? ((R & ~31) + perm32(R & 31)) : R;
        voffA[i] = (unsigned)(R * lda + C) * 2u; voffB[i] = (unsigned)(Rb * K + C) * 2u; }
    const size_t kstep = (size_t)(BK * 2);
    const size_t hstepA = (size_t)HALF * lda * 2, hstepB = (size_t)HALF * K * 2;
    const size_t tstepA = 2 * hstepA, tstepB = 2 * hstepB;
    const unsigned ldsw = (unsigned)wid * 1024u;
    const int aoff = lds_byte(wr * 64 + fr, fq * 8), boff = lds_byte(wc * 32 + fr, fq * 8);
#define PG8_SA(b, h) (((b) * 2 + (h)) * HTB)
#define PG8_SB(b, h) ((4 + (b) * 2 + (h)) * HTB)
#define PG8_STAGE(bufoff, gbase, voff) do { _Pragma("unroll") for (int _i = 0; _i < 2; ++_i) \
        __builtin_amdgcn_global_load_lds((const unsigned*)((const char*)(gbase) + (voff)[_i]), (LAS unsigned*)(lds + (bufoff) + ldsw + _i * 8192), 16, 0, 0); } while (0)
#define PG8_LDA(dst, b, h) do { _Pragma("unroll") for (int m = 0; m < 4; ++m) _Pragma("unroll") for (int k = 0; k < 2; ++k) dst[m][k] = *(const LAS bf16x8*)(lds + PG8_SA(b, h) + aoff + m * 2048 + k * 1024); } while (0)
#define PG8_LDB(dst, b, h) do { _Pragma("unroll") for (int n = 0; n < 2; ++n) _Pragma("unroll") for (int k = 0; k < 2; ++k) dst[n][k] = *(const LAS bf16x8*)(lds + PG8_SB(b, h) + boff + n * 2048 + k * 1024); } while (0)
#define PG8_MMA(ai, bj, At, Bt) do { __builtin_amdgcn_s_setprio(1); _Pragma("unroll") for (int m = 0; m < 4; ++m) _Pragma("unroll") for (int n = 0; n < 2; ++n) _Pragma("unroll") for (int k = 0; k < 2; ++k) \
        acc[ai][bj][m][n] = __builtin_amdgcn_mfma_f32_16x16x32_bf16(Bt[n][k], At[m][k], acc[ai][bj][m][n], 0, 0, 0); __builtin_amdgcn_s_setprio(0); } while (0)
#define PG8_WAIT_V(n) asm volatile("s_waitcnt vmcnt(" #n ")" ::: "memory")
#define PG8_WAIT_L(n) asm volatile("s_waitcnt lgkmcnt(" #n ")" ::: "memory")
#define PG8_BAR __builtin_amdgcn_s_barrier()
#define PG8_SCHED __builtin_amdgcn_sched_barrier(0)
    Unit cur, nxt; int ui = 0;
    if (!S.next(0, cur)) return;
    f32x4 acc[2][2][4][2];
#pragma unroll
    for (int a = 0; a < 2; ++a)
#pragma unroll
        for (int b = 0; b < 2; ++b)
#pragma unroll
            for (int m = 0; m < 4; ++m)
#pragma unroll
                for (int n = 0; n < 2; ++n) acc[a][b][m][n] = (f32x4){0.f, 0.f, 0.f, 0.f};
    bf16x8 At[4][2], B0[2][2], B1[2][2];
    const char* cA = (const char*)g.A + (size_t)cur.pm * tstepA; const char* cB = (const char*)g.Bt + (size_t)cur.pn * tstepB;
    S.a_ready(cur);
    PG8_STAGE(PG8_SB(0, 0), cB, voffB); PG8_STAGE(PG8_SA(0, 0), cA, voffA); PG8_STAGE(PG8_SB(0, 1), cB + hstepB, voffB); PG8_STAGE(PG8_SA(0, 1), cA + hstepA, voffA);
    if (wr == 1) PG8_BAR;
    PG8_WAIT_V(4); PG8_BAR;
    PG8_STAGE(PG8_SB(1, 0), cB + kstep, voffB); PG8_STAGE(PG8_SA(1, 0), cA + kstep, voffA); PG8_STAGE(PG8_SB(1, 1), cB + hstepB + kstep, voffB);
    PG8_WAIT_V(6); PG8_BAR;
    for (;;) {
        const bool has_next = S.next(ui + 1, nxt);
        const char* nA = has_next ? (const char*)g.A + (size_t)nxt.pm * tstepA : cA; const char* nB = has_next ? (const char*)g.Bt + (size_t)nxt.pn * tstepB : cB;
        for (int t = 0; t < nt; t += 2) {
            const bool last = (t == nt - 2);
            const char* a1 = cA + (size_t)(t + 1) * kstep;
            const char* a2 = last ? nA : cA + (size_t)(t + 2) * kstep; const char* b2 = last ? nB : cB + (size_t)(t + 2) * kstep;
            const char* a3 = a2 + kstep; const char* b3 = b2 + kstep;
            if (last && has_next) S.a_ready(nxt);
            PG8_LDB(B0, 0, 0); PG8_SCHED; PG8_LDA(At, 0, 0); PG8_STAGE(PG8_SA(1, 1), a1 + hstepA, voffA);
            PG8_WAIT_L(8); PG8_BAR; PG8_WAIT_L(0); PG8_MMA(0, 0, At, B0); PG8_BAR; PG8_SCHED;
            PG8_LDB(B1, 0, 1); PG8_STAGE(PG8_SB(0, 0), b2, voffB);
            PG8_BAR; PG8_WAIT_L(0); PG8_MMA(0, 1, At, B1); PG8_BAR;
            PG8_LDA(At, 0, 1); PG8_STAGE(PG8_SA(0, 0), a2, voffA);
            PG8_BAR; PG8_WAIT_L(0); PG8_MMA(1, 0, At, B0); PG8_BAR; PG8_SCHED;
            PG8_STAGE(PG8_SB(0, 1), b2 + hstepB, voffB);
            PG8_WAIT_V(6); PG8_BAR; PG8_MMA(1, 1, At, B1); PG8_BAR;
            PG8_LDB(B0, 1, 0); PG8_SCHED; PG8_LDA(At, 1, 0); PG8_STAGE(PG8_SA(0, 1), a2 + hstepA, voffA);
            PG8_WAIT_L(8); PG8_BAR; PG8_WAIT_L(0); PG8_MMA(0, 0, At, B0); PG8_BAR; PG8_SCHED;
            PG8_LDB(B1, 1, 1); PG8_STAGE(PG8_SB(1, 0), b3, voffB);
            PG8_BAR; PG8_WAIT_L(0); PG8_MMA(0, 1, At, B1); PG8_BAR;
            PG8_LDA(At, 1, 1); PG8_STAGE(PG8_SA(1, 0), a3, voffA);
            PG8_BAR; PG8_WAIT_L(0); PG8_MMA(1, 0, At, B0); PG8_BAR; PG8_SCHED;
            PG8_STAGE(PG8_SB(1, 1), b3 + hstepB, voffB);
            PG8_WAIT_V(6); PG8_BAR; PG8_MMA(1, 1, At, B1); PG8_BAR;
        }
        E(acc, cur, wr, wc, fr, fq); S.done(cur);
        if (!has_next) break;
#pragma unroll
        for (int a = 0; a < 2; ++a)
#pragma unroll
            for (int b = 0; b < 2; ++b)
#pragma unroll
                for (int m = 0; m < 4; ++m)
#pragma unroll
                    for (int n = 0; n < 2; ++n) acc[a][b][m][n] = (f32x4){0.f, 0.f, 0.f, 0.f};
        cur = nxt; cA = nA; cB = nB; ++ui;
    }
    PG8_WAIT_V(0);
    if (wr == 0) PG8_BAR;
    PG8_BAR;
#undef PG8_SA
#undef PG8_SB
#undef PG8_STAGE
#undef PG8_LDA
#undef PG8_LDB
#undef PG8_MMA
#undef PG8_WAIT_V
#undef PG8_WAIT_L
#undef PG8_BAR
#undef PG8_SCHED
}
}

namespace att {
constexpr int NW = 8, QBLK = 32, KVBLK = 64, DV = 128;
constexpr float THR = 8.f;
constexpr int SHM_V = KVBLK * DV * 2;
#define SBAR() __builtin_amdgcn_sched_barrier(0)
__device__ __forceinline__ int crow(int r, int hi) { return (r & 3) + 8 * (r >> 2) + 4 * hi; }
__device__ __forceinline__ unsigned cvtpk(float lo, float hi) { unsigned r; asm volatile("v_cvt_pk_bf16_f32 %0, %1, %2" : "=v"(r) : "v"(lo), "v"(hi)); return r; }
__device__ __forceinline__ void partialSM(f32x16& p0, f32x16& p1, float& m_reg, float& mn, float& alpha, const float C, const float thr_raw) {
    float pmax = p0[0];
#pragma unroll
    for (int r = 1; r < 16; ++r) pmax = fmaxf(pmax, p0[r]);
#pragma unroll
    for (int r = 0; r < 16; ++r) pmax = fmaxf(pmax, p1[r]);
    { auto rr = __builtin_amdgcn_permlane32_swap(__float_as_uint(pmax), __float_as_uint(pmax), false, false);
      pmax = fmaxf(__uint_as_float(rr[0]), __uint_as_float(rr[1])); }
    if (__builtin_expect(__all(pmax - m_reg <= thr_raw), 1)) { mn = m_reg; alpha = 1.f; }
    else { mn = fmaxf(m_reg, pmax); alpha = __builtin_amdgcn_exp2f((m_reg - mn) * C); m_reg = mn; }
    const float mnC = -mn * C;
#pragma unroll
    for (int r = 0; r < 16; ++r) p0[r] = fmaf(p0[r], C, mnC);
#pragma unroll
    for (int r = 0; r < 16; ++r) p1[r] = fmaf(p1[r], C, mnC);
#pragma unroll
    for (int r = 0; r < 16; ++r) p0[r] = __builtin_amdgcn_exp2f(p0[r]);
}
__device__ __forceinline__ void finishSM(f32x16& p0, f32x16& p1, float alpha, float& l_reg, bf16x8& pa0, bf16x8& pa1, bf16x8& pa2, bf16x8& pa3) {
#pragma unroll
    for (int r = 0; r < 16; ++r) p1[r] = __builtin_amdgcn_exp2f(p1[r]);
    float ps = 0;
#pragma unroll
    for (int r = 0; r < 16; ++r) ps += p0[r];
#pragma unroll
    for (int r = 0; r < 16; ++r) ps += p1[r];
    { auto rr = __builtin_amdgcn_permlane32_swap(__float_as_uint(ps), __float_as_uint(ps), false, false);
      ps = __uint_as_float(rr[0]) + __uint_as_float(rr[1]); }
    l_reg = l_reg * alpha + ps;
#define PK4(P, BASE, OUT) do { unsigned a0 = cvtpk(P[BASE + 0], P[BASE + 1]), a1 = cvtpk(P[BASE + 2], P[BASE + 3]);   \
    unsigned b0 = cvtpk(P[BASE + 4], P[BASE + 5]), b1 = cvtpk(P[BASE + 6], P[BASE + 7]);                              \
    auto r0 = __builtin_amdgcn_permlane32_swap(a0, b0, false, false); auto r1 = __builtin_amdgcn_permlane32_swap(a1, b1, false, false); \
    u32x4 w = {r0[0], r1[0], r0[1], r1[1]}; OUT = *reinterpret_cast<bf16x8*>(&w); } while (0)
    PK4(p0, 0, pa0); PK4(p0, 8, pa1); PK4(p1, 0, pa2); PK4(p1, 8, pa3);
#undef PK4
}
template <int DQK, int QL>
__device__ __forceinline__ void qkt(f32x16& p0, f32x16& p1, const char* Ks, const bf16x8 (&qr)[DQK / 16 - QL], const char* qpark, int r32, int hi) {
    constexpr int RS = DQK * 2 + 16, NQR = DQK / 16 - QL, GRP = (DQK > 128) ? QKT_GRP : DQK / 16;
    p0 = f32x16{}; p1 = f32x16{};
#pragma unroll
    for (int g0 = 0; g0 < DQK / 16; g0 += GRP) {
#pragma unroll
        for (int d0 = g0; d0 < g0 + GRP; ++d0) { const int cb = (d0 * 16 + hi * 8) * 2;
            const bf16x8 b0 = *reinterpret_cast<const bf16x8*>(Ks + r32 * RS + cb);
            const bf16x8 b1 = *reinterpret_cast<const bf16x8*>(Ks + (32 + r32) * RS + cb);
            bf16x8 qf; if (d0 < NQR) qf = qr[d0 < NQR ? d0 : 0]; else qf = *reinterpret_cast<const bf16x8*>(qpark + (d0 - NQR) * 1024);
            p0 = __builtin_amdgcn_mfma_f32_32x32x16_bf16(b0, qf, p0, 0, 0, 0);
            p1 = __builtin_amdgcn_mfma_f32_32x32x16_bf16(b1, qf, p1, 0, 0, 0); }
        if (g0 + GRP < DQK / 16) SBAR();
    }
}
__device__ __forceinline__ int v_st(int k, int c) { const int kk = (k & ~0xC) | ((k & 4) << 1) | ((k & 8) >> 1); return ((kk >> 3) * 4 + (c >> 5)) * 512 + ((kk & 7) * 32 + (c & 31)) * 2; }
__device__ __forceinline__ int v_rd_base(int lane) { return ((lane & 3) << 3) | (((lane >> 2) & 3) << 6) | (((lane >> 4) & 1) << 5) | (((lane >> 5) & 1) << 8); }
constexpr int v_rd_off(int d0, int ks, int half) { return d0 * 512 + ks * 4096 + half * 2048; }
template <int OFF> __device__ __forceinline__ s16x4 tr_read(int vb) {
    s16x4 r; asm volatile("ds_read_b64_tr_b16 %0, %1 offset:%2" : "=&v"(r) : "v"(vb), "i"(OFF) : "memory"); return r;
}
template <int D0> __device__ __forceinline__ void pv_one(f32x16& od, int vb, bf16x8 pa0, bf16x8 pa1, bf16x8 pa2, bf16x8 pa3) {
    const s16x4 l0 = tr_read<v_rd_off(D0, 0, 0)>(vb), h0 = tr_read<v_rd_off(D0, 0, 1)>(vb), l1 = tr_read<v_rd_off(D0, 1, 0)>(vb), h1 = tr_read<v_rd_off(D0, 1, 1)>(vb);
    const s16x4 l2 = tr_read<v_rd_off(D0, 2, 0)>(vb), h2 = tr_read<v_rd_off(D0, 2, 1)>(vb), l3 = tr_read<v_rd_off(D0, 3, 0)>(vb), h3 = tr_read<v_rd_off(D0, 3, 1)>(vb);
    asm volatile("s_waitcnt lgkmcnt(0)" ::: "memory"); SBAR();
#define PK(L, H) (bf16x8){L[0], L[1], L[2], L[3], H[0], H[1], H[2], H[3]}
    od = __builtin_amdgcn_mfma_f32_32x32x16_bf16(pa0, PK(l0, h0), od, 0, 0, 0);
    od = __builtin_amdgcn_mfma_f32_32x32x16_bf16(pa1, PK(l1, h1), od, 0, 0, 0);
    od = __builtin_amdgcn_mfma_f32_32x32x16_bf16(pa2, PK(l2, h2), od, 0, 0, 0);
    od = __builtin_amdgcn_mfma_f32_32x32x16_bf16(pa3, PK(l3, h3), od, 0, 0, 0);
#undef PK
}
__device__ __forceinline__ void pv_d0(f32x16* o, int vb, bf16x8 pa0, bf16x8 pa1, bf16x8 pa2, bf16x8 pa3) {
    pv_one<0>(o[0], vb, pa0, pa1, pa2, pa3); pv_one<1>(o[1], vb, pa0, pa1, pa2, pa3); pv_one<2>(o[2], vb, pa0, pa1, pa2, pa3); pv_one<3>(o[3], vb, pa0, pa1, pa2, pa3);
}
template <int DQK> struct ScaleOf { static constexpr float scale = DQK == 192 ? 0.07216878364870322f : (DQK == 128 ? 0.08838834764831845f : 0.125f); };
template <int DQK, int SDEPTH, int QL, int ldq, int ldk, int ldv, int ldo>
__device__ __forceinline__ void attn_body(const bf16_t* __restrict__ Qb, const bf16_t* __restrict__ Kh, const bf16_t* __restrict__ Vh,
                                          bf16_t* __restrict__ Ob, int seq, char* lds, int tid_in) {
    constexpr float C = ScaleOf<DQK>::scale * 1.4426950408889634f, thr_raw = THR / ScaleOf<DQK>::scale;
    constexpr int RS = DQK * 2 + 16  , SHM_K = KVBLK * RS, NKP = DQK / 64, KPR = DQK / 8;
    const int tid_l = tid_in * 64 + fresh_lane();
    const int tid = tid_l, wid = tid_in  , lane = tid & 63, r32 = lane & 31, hi = lane >> 5;
    char* V_lds = lds; char* K_lds = lds + 2 * SHM_V;
    float* ws = (float*)(lds + 2 * SHM_V + 2 * SHM_K) + wid * 64; float* li_l = ws; float* al_l = ws + 32;
    constexpr int NQR = DQK / 16 - QL;
    char* qpark = lds + 2 * SHM_V + 2 * SHM_K + 2048 + wid * (QL * 1024) + lane * 16;
    float m_reg = -1e30f, l_reg = 0; f32x16 o[4] = {}; bf16x8 qr[NQR];
    const bf16_t* Qw = Qb + (size_t)(wid * QBLK + r32) * ldq + hi * 8;
#pragma unroll
    for (int d0 = 0; d0 < NQR; ++d0) qr[d0] = *reinterpret_cast<const bf16x8*>(Qw + d0 * 16);
#pragma unroll
    for (int d0 = 0; d0 < QL; ++d0) *(bf16x8*)(qpark + d0 * 1024) = *reinterpret_cast<const bf16x8*>(Qw + (NQR + d0) * 16);
    const int sr = tid >> 4, sc = (tid & 15) * 8, vst0 = v_st(sr, sc), vst1 = v_st(32 + sr, sc);
    int koff[NKP], klds[NKP];
#pragma unroll
    for (int i = 0; i < NKP; ++i) { const int row = tid >> 3, c8 = (tid & 7) + 8 * i; koff[i] = row * ldk + c8 * 8; klds[i] = row * RS + c8 * 16; }
    const int vb0 = (int)(uintptr_t)V_lds + v_rd_base(lane);
    bf16x8 sv0[SDEPTH], sv1[SDEPTH], sk[SDEPTH][NKP];
#define SLOAD(i, k0) do { sv0[i] = *reinterpret_cast<const bf16x8*>(&Vh[(size_t)((k0) + sr) * ldv + sc]); sv1[i] = *reinterpret_cast<const bf16x8*>(&Vh[(size_t)((k0) + 32 + sr) * ldv + sc]); \
    _Pragma("unroll") for (int _q = 0; _q < NKP; ++_q) sk[i][_q] = *reinterpret_cast<const bf16x8*>(&Kh[(size_t)(k0) * ldk + koff[_q]]); } while (0)
#define SWRITE(b, i) do { *(bf16x8*)(V_lds + (b) * SHM_V + vst0) = sv0[i]; *(bf16x8*)(V_lds + (b) * SHM_V + vst1) = sv1[i]; \
    _Pragma("unroll") for (int _q = 0; _q < NKP; ++_q) *(bf16x8*)(K_lds + (b) * SHM_K + klds[_q]) = sk[i][_q]; } while (0)
#define SWAIT() do { if constexpr (SDEPTH == 2) { if constexpr (NKP == 1) asm volatile("s_waitcnt vmcnt(3)" ::: "memory"); else if constexpr (NKP == 2) asm volatile("s_waitcnt vmcnt(4)" ::: "memory"); else asm volatile("s_waitcnt vmcnt(5)" ::: "memory"); } \
    else asm volatile("s_waitcnt vmcnt(0)" ::: "memory"); } while (0)
#define RESC(a) do { if (__any((a) < 1.f)) { if (hi == 0) al_l[r32] = (a); asm volatile("s_waitcnt lgkmcnt(0)" ::: "memory"); \
    _Pragma("unroll") for (int d = 0; d < 4; ++d) _Pragma("unroll") for (int r = 0; r < 16; ++r) o[d][r] *= al_l[crow(r, hi)]; } } while (0)
    f32x16 pA0, pA1, pB0, pB1; float mnA, mnB, alA, alB; bf16x8 pa0, pa1, pa2, pa3; const int NT = seq / KVBLK;
    constexpr int SE = 0, SO = SDEPTH - 1;
    SLOAD(SE, 0); asm volatile("s_waitcnt vmcnt(0)" ::: "memory"); SWRITE(0, SE); __syncthreads();
    qkt<DQK, QL>(pA0, pA1, K_lds, qr, qpark, r32, hi); partialSM(pA0, pA1, m_reg, mnA, alA, C, thr_raw);
    SLOAD(SO, KVBLK); if constexpr (SDEPTH == 2) { if (2 < NT) SLOAD(SE, 2 * KVBLK); }
    SWAIT(); SWRITE(1, SO); __syncthreads();
    for (int j = 1; j + 1 < NT; j += 2) {
        SBAR(); qkt<DQK, QL>(pB0, pB1, K_lds + SHM_K, qr, qpark, r32, hi);
        finishSM(pA0, pA1, alA, l_reg, pa0, pa1, pa2, pa3); SBAR();
        SLOAD(SO, (j + SDEPTH) * KVBLK); SBAR();
        pv_d0(o, vb0, pa0, pa1, pa2, pa3); partialSM(pB0, pB1, m_reg, mnB, alB, C, thr_raw);
        __syncthreads(); SWAIT(); SWRITE(0, SE);
        RESC(alB); __syncthreads();
        SBAR(); qkt<DQK, QL>(pA0, pA1, K_lds, qr, qpark, r32, hi);
        finishSM(pB0, pB1, alB, l_reg, pa0, pa1, pa2, pa3); SBAR();
        if (SDEPTH == 1 || j + 3 < NT) SLOAD(SE, (j + 1 + SDEPTH) * KVBLK); SBAR();
        pv_d0(o, vb0 + SHM_V, pa0, pa1, pa2, pa3); partialSM(pA0, pA1, m_reg, mnA, alA, C, thr_raw);
        __syncthreads(); SWAIT(); SWRITE(1, SO);
        RESC(alA); __syncthreads();
    }
    SBAR(); qkt<DQK, QL>(pB0, pB1, K_lds + SHM_K, qr, qpark, r32, hi);
    finishSM(pA0, pA1, alA, l_reg, pa0, pa1, pa2, pa3); SBAR();
    pv_d0(o, vb0, pa0, pa1, pa2, pa3); partialSM(pB0, pB1, m_reg, mnB, alB, C, thr_raw);
    __syncthreads(); RESC(alB);
    finishSM(pB0, pB1, alB, l_reg, pa0, pa1, pa2, pa3); SBAR();
    pv_d0(o, vb0 + SHM_V, pa0, pa1, pa2, pa3);
    if (hi == 0) li_l[r32] = l_reg; asm volatile("s_waitcnt lgkmcnt(0)" ::: "memory");
    float rli[16];
#pragma unroll
    for (int r = 0; r < 16; ++r) rli[r] = __builtin_amdgcn_rcpf(li_l[crow(r, hi)]);
    bf16_t* Ow = Ob + (size_t)(wid * QBLK) * ldo + (r32 & ~1);
    const bool odd = (r32 & 1) != 0;
#pragma unroll
    for (int r = 0; r < 16; r += 2) { const int orow = crow(r, hi) + (odd ? 1 : 0);
#pragma unroll
        for (int d0 = 0; d0 < 4; ++d0) { const float a = o[d0][r] * rli[r], b = o[d0][r + 1] * rli[r + 1];
            const float recv = swz_xor<1>(odd ? a : b);
            const unsigned w = odd ? cvtpk(recv, b) : cvtpk(a, recv);
            *(unsigned*)(Ow + (size_t)orow * ldo + d0 * 32) = w; } }
    __syncthreads();
#undef SLOAD
#undef SWRITE
#undef SWAIT
#undef RESC
}
template <int DQK, int QL, int ldq, int ldk, int ldv, int ldo>
__device__ __forceinline__ void attn_body_simple(const bf16_t* __restrict__ Qb, const bf16_t* __restrict__ Kh, const bf16_t* __restrict__ Vh,
                                                 bf16_t* __restrict__ Ob, int seq, char* lds, int tid_in) {
    constexpr float C = ScaleOf<DQK>::scale * 1.4426950408889634f, thr_raw = THR / ScaleOf<DQK>::scale;
    constexpr int RS = DQK * 2 + 16  , SHM_K = KVBLK * RS, NKP = DQK / 64, KPR = DQK / 8;
    const int tid_l = tid_in * 64 + fresh_lane();
    const int tid = tid_l, wid = tid_in  , lane = tid & 63, r32 = lane & 31, hi = lane >> 5;
    char* V_lds = lds; char* K_lds = lds + 2 * SHM_V;
    float* ws = (float*)(lds + 2 * SHM_V + 2 * SHM_K) + wid * 64; float* li_l = ws; float* al_l = ws + 32;
    constexpr int NQR = DQK / 16 - QL;
    char* qpark = lds + 2 * SHM_V + 2 * SHM_K + 2048 + wid * (QL * 1024) + lane * 16;
    float m_reg = -1e30f, l_reg = 0; f32x16 o[4] = {}; bf16x8 qr[NQR];
    const bf16_t* Qw = Qb + (size_t)(wid * QBLK + r32) * ldq + hi * 8;
#pragma unroll
    for (int d0 = 0; d0 < NQR; ++d0) qr[d0] = *reinterpret_cast<const bf16x8*>(Qw + d0 * 16);
#pragma unroll
    for (int d0 = 0; d0 < QL; ++d0) *(bf16x8*)(qpark + d0 * 1024) = *reinterpret_cast<const bf16x8*>(Qw + (NQR + d0) * 16);
    const int sr = tid >> 4, sc = (tid & 15) * 8, vst0 = v_st(sr, sc), vst1 = v_st(32 + sr, sc);
    int koff[NKP], klds[NKP];
#pragma unroll
    for (int i = 0; i < NKP; ++i) { const int row = tid >> 3, c8 = (tid & 7) + 8 * i; koff[i] = row * ldk + c8 * 8; klds[i] = row * RS + c8 * 16; }
    const int vb0 = (int)(uintptr_t)V_lds + v_rd_base(lane);
    bf16x8 sv0, sv1, sk[NKP];
#define SLOAD(k0) do { sv0 = *reinterpret_cast<const bf16x8*>(&Vh[(size_t)((k0) + sr) * ldv + sc]); sv1 = *reinterpret_cast<const bf16x8*>(&Vh[(size_t)((k0) + 32 + sr) * ldv + sc]); \
    _Pragma("unroll") for (int _q = 0; _q < NKP; ++_q) sk[_q] = *reinterpret_cast<const bf16x8*>(&Kh[(size_t)(k0) * ldk + koff[_q]]); } while (0)
#define SWRITE(b) do { *(bf16x8*)(V_lds + (b) * SHM_V + vst0) = sv0; *(bf16x8*)(V_lds + (b) * SHM_V + vst1) = sv1; \
    _Pragma("unroll") for (int _q = 0; _q < NKP; ++_q) *(bf16x8*)(K_lds + (b) * SHM_K + klds[_q]) = sk[_q]; } while (0)
#define RESC(a) do { if (__any((a) < 1.f)) { if (hi == 0) al_l[r32] = (a); asm volatile("s_waitcnt lgkmcnt(0)" ::: "memory"); \
    _Pragma("unroll") for (int d = 0; d < 4; ++d) _Pragma("unroll") for (int r = 0; r < 16; ++r) o[d][r] *= al_l[crow(r, hi)]; } } while (0)
    const int NT = seq / KVBLK;
    SLOAD(0); asm volatile("s_waitcnt vmcnt(0)" ::: "memory"); SWRITE(0); __syncthreads();
    for (int j = 0; j < NT; ++j) {
        const int b = j & 1;
        if (j + 1 < NT) SLOAD((j + 1) * KVBLK);
        SBAR();
        f32x16 p0, p1; float mn, al; bf16x8 pa0, pa1, pa2, pa3;
        { const char* Ks = K_lds + b * SHM_K; p0 = f32x16{}; p1 = f32x16{};
#pragma unroll
          for (int d0 = 0; d0 < DQK / 16; ++d0) { const int cb = (d0 * 16 + hi * 8) * 2;
              const bf16x8 b0 = *reinterpret_cast<const bf16x8*>(Ks + r32 * RS + cb);
              const bf16x8 b1 = *reinterpret_cast<const bf16x8*>(Ks + (32 + r32) * RS + cb);
              bf16x8 qf; if (d0 < NQR) qf = qr[d0 < NQR ? d0 : 0]; else qf = *(const bf16x8*)(qpark + (d0 - NQR) * 1024);
              p0 = __builtin_amdgcn_mfma_f32_32x32x16_bf16(b0, qf, p0, 0, 0, 0);
              p1 = __builtin_amdgcn_mfma_f32_32x32x16_bf16(b1, qf, p1, 0, 0, 0); } }
        partialSM(p0, p1, m_reg, mn, al, C, thr_raw);
        RESC(al);
        finishSM(p0, p1, al, l_reg, pa0, pa1, pa2, pa3); SBAR();
        pv_d0(o, vb0 + b * SHM_V, pa0, pa1, pa2, pa3);
        if (j + 1 < NT) { asm volatile("s_waitcnt vmcnt(0)" ::: "memory"); SWRITE(b ^ 1); }
        __syncthreads();
    }
    if (hi == 0) li_l[r32] = l_reg; asm volatile("s_waitcnt lgkmcnt(0)" ::: "memory");
    float rli[16];
#pragma unroll
    for (int r = 0; r < 16; ++r) rli[r] = __builtin_amdgcn_rcpf(li_l[crow(r, hi)]);
    bf16_t* Ow = Ob + (size_t)(wid * QBLK) * ldo + (r32 & ~1);
    const bool odd = (r32 & 1) != 0;
#pragma unroll
    for (int r = 0; r < 16; r += 2) { const int orow = crow(r, hi) + (odd ? 1 : 0);
#pragma unroll
        for (int d0 = 0; d0 < 4; ++d0) { const float a = o[d0][r] * rli[r], b = o[d0][r + 1] * rli[r + 1];
            const float recv = swz_xor<1>(odd ? a : b);
            const unsigned w = odd ? cvtpk(recv, b) : cvtpk(a, recv);
            *(unsigned*)(Ow + (size_t)orow * ldo + d0 * 32) = w; } }
    __syncthreads();
#undef SLOAD
#undef SWRITE
#undef RESC
}
}

struct Params {
    const float* x; const float* c; const float* ctx; const float* c_ctx; const float* w_mod; const float* b_mod; const float* g_norm1; const float* g_norm2;
    const float* w_in_ab; const float* g_cq; const float* w_uq; const float* g_ckv; const float* w_ukv; const float* g_qn_a; const float* g_kn_a; const float* lam_vec;
    const float* g_qn_b; const float* g_kn_b; const float* g_sub_b; const float* w_out_ab; const float* w_in_c; const float* g_qn_c; const float* g_kn_c; const float* w_out_c;
    const float* w_pq; const float* sub_keys; const float* expert_u; const float* expert_v;
    float* out; unsigned char* ws; int ph_lo, ph_hi;
};

typedef const __attribute__((address_space(4))) Params CParams;
struct Ctx {
    int tid, lane, wid, G, vcu, bx;
    unsigned char* ws; char* lds;
};

__device__ __forceinline__ void tconv(const Ctx& F, const float* src, bf16_t* dst, const float* gain, int nmat, int K, int N, int Npad) {
    float* tile = (float*)(F.lds + 32768);
    const int ntn = Npad / 64, ntk = K / 64, per = ntn * ntk, total = per * nmat;
    for (int it = F.vcu; it < total; it += F.G) {
        const int mat = it / per, rem = it % per, tn = rem / ntk, tk = rem % ntk, k0 = tk * 64, n0 = tn * 64;
        const float* s = src + (size_t)mat * K * N; bf16_t* d = dst + (size_t)mat * Npad * K;
        __syncthreads();
        { const int r = F.tid >> 4, c4 = (F.tid & 15) * 4;
#pragma unroll
          for (int i = 0; i < 2; ++i) { const int rr = r + i * 32; f32x4 v = (f32x4){0.f, 0.f, 0.f, 0.f};
              if (n0 + c4 < N) v = *(const f32x4*)(s + (size_t)(k0 + rr) * N + n0 + c4);
              tile[rr * 65 + c4 + 0] = v[0]; tile[rr * 65 + c4 + 1] = v[1]; tile[rr * 65 + c4 + 2] = v[2]; tile[rr * 65 + c4 + 3] = v[3]; } }
        __syncthreads();
        { const int n = F.tid >> 3, kc = (F.tid & 7) * 8; float v[8];
#pragma unroll
          for (int e = 0; e < 8; ++e) { v[e] = tile[(kc + e) * 65 + n]; if (gain) v[e] *= gain[(size_t)mat * K + k0 + kc + e]; }
          u32x4 w; w.x = cvt_pk_bf16(v[0], v[1]); w.y = cvt_pk_bf16(v[2], v[3]); w.z = cvt_pk_bf16(v[4], v[5]); w.w = cvt_pk_bf16(v[6], v[7]);
          *(u32x4*)(d + (size_t)(n0 + n) * K + k0 + kc) = w; }
    }
}
__device__ __forceinline__ void cvt_flat(const Ctx& F, const float* src, bf16_t* dst, size_t n8) {
    for (size_t i = (size_t)F.vcu * 512 + F.tid; i < n8; i += (size_t)F.G * 512) {
        const f32x4 a = *(const f32x4*)(src + i * 8), b = *(const f32x4*)(src + i * 8 + 4);
        u32x4 w; w.x = cvt_pk_bf16(a[0], a[1]); w.y = cvt_pk_bf16(a[2], a[3]); w.z = cvt_pk_bf16(b[0], b[1]); w.w = cvt_pk_bf16(b[2], b[3]);
        *(u32x4*)(dst + i * 8) = w;
    }
}
__device__ __forceinline__ void cvt_rows_fp8(const Ctx& F, const float* src, unsigned char* dst, float* descale, int R) {
    for (int row = F.vcu * 8 + F.wid; row < R; row += F.G * 8) {
        const float* s = src + (size_t)row * DM; f32x4 v[8]; float am = 0.f;
#pragma unroll
        for (int j = 0; j < 2; ++j)
#pragma unroll
            for (int i = 0; i < 4; ++i) { v[j * 4 + i] = *(const f32x4*)(s + j * 1024 + F.lane * 16 + i * 4);
#pragma unroll
                for (int e = 0; e < 4; ++e) am = fmaxf(am, fabsf(v[j * 4 + i][e])); }
        am = wave_max(am);
        const float sc = am > 0.f ? 384.f / am : 1.f;
#pragma unroll
        for (int j = 0; j < 2; ++j) { u32x4 w;
#pragma unroll
            for (int i = 0; i < 4; ++i) { const f32x4 x = v[j * 4 + i] * sc; unsigned p = __builtin_amdgcn_cvt_pk_fp8_f32(x[0], x[1], 0u, false); p = __builtin_amdgcn_cvt_pk_fp8_f32(x[2], x[3], p, true); w[i] = p; }
            *(u32x4*)(dst + (size_t)row * DM + j * 1024 + F.lane * 16) = w; }
        if (F.lane == 0) descale[row] = am > 0.f ? am * (1.f / 384.f) : 1.f;
    }
}
__device__ __forceinline__ float silu_f(float v) { return v / (1.f + __expf(-v)); }

__device__ __forceinline__ void prologue_phase(const Ctx& F, CParams& P) {
    unsigned char* ws = F.ws;
    {
        float* sv = (float*)F.lds;
        float* part = (float*)(F.lds + 24576);
        for (int i = F.tid; i < 3 * DM; i += 512) { const int v = i / DM, k = i % DM; const float cv = v < 2 ? P.c[v * DM + k] : P.c_ctx[k]; sv[i] = silu_f(cv); }
        __syncthreads();
        float* mod = (float*)(ws + WS_MOD);
        for (int it = F.vcu; it < DEPTH * 192; it += F.G) {
            const int l = it / 192, n0 = (it % 192) * 64;
            const float* wp = P.w_mod + ((size_t)l * DM + F.wid * 256) * 12288 + n0 + F.lane;
            float a0 = 0.f, a1 = 0.f, a2 = 0.f;
#pragma unroll 8
            for (int k = 0; k < 256; ++k) { const float w = wp[(size_t)k * 12288]; const int kk = F.wid * 256 + k; a0 += sv[kk] * w; a1 += sv[DM + kk] * w; a2 += sv[2 * DM + kk] * w; }
            part[(F.wid * 3 + 0) * 64 + F.lane] = a0; part[(F.wid * 3 + 1) * 64 + F.lane] = a1; part[(F.wid * 3 + 2) * 64 + F.lane] = a2;
            __syncthreads();
            if (F.wid < 3) { float s = 0.f;
#pragma unroll
                for (int w = 0; w < 8; ++w) s += part[(w * 3 + F.wid) * 64 + F.lane];
                mod[((size_t)l * 3 + F.wid) * 12288 + n0 + F.lane] = s + P.b_mod[(size_t)l * 12288 + n0 + F.lane]; }
            __syncthreads();
        }
    }
    if (F.vcu == 0) {
        float* t16 = (float*)(ws + WS_TAB16); float* t32 = (float*)(ws + WS_TAB32);
        for (int i = F.tid; i < 128 * 16; i += 512) { const int pos = i >> 4, f = i & 15; const float fr = powf(10000.f, -(float)f / 16.f); const float a = (float)pos * fr; float s, c; sincosf(a, &s, &c); t16[i * 2] = c; t16[i * 2 + 1] = s; }
        for (int i = F.tid; i < 128 * 32; i += 512) { const int pos = i >> 5, f = i & 31; const float fr = powf(10000.f, -(float)f / 32.f); const float a = (float)pos * fr; float s, c; sincosf(a, &s, &c); t32[i * 2] = c; t32[i * 2 + 1] = s; }
        if (F.wid < 2) { const float* lv = P.lam_vec + F.wid * 256; const float d1 = wave_sum(lv[F.lane] * lv[64 + F.lane]), d2 = wave_sum(lv[128 + F.lane] * lv[192 + F.lane]);
            const float lam_init = 0.8f - 0.6f * expf(-0.3f * (float)(2 * F.wid));
            if (F.lane == 0) ((float*)(ws + WS_LAM))[F.wid] = expf(d1) - expf(d2) + lam_init; }
    }
    tconv(F, P.w_in_ab, (bf16_t*)(ws + WS_WINAB), nullptr, 2, DM, AB_IN, AB_INP);
    tconv(F, P.w_uq, (bf16_t*)(ws + WS_WUQ), P.g_cq, 2, 768, 1536, 1536);
    tconv(F, P.w_ukv, (bf16_t*)(ws + WS_WUKV), P.g_ckv, 2, 512, 2048, 2048);
    tconv(F, P.w_out_ab, (bf16_t*)(ws + WS_WOUTAB), nullptr, 2, DM, DM, DM);
    tconv(F, P.w_in_c, (bf16_t*)(ws + WS_WINC), nullptr, 2, DM, C_IN, C_IN);
    tconv(F, P.w_out_c, (bf16_t*)(ws + WS_WOUTC), nullptr, 2, DM, DM, DM);
    tconv(F, P.w_pq, (bf16_t*)(ws + WS_WPQ), nullptr, 4, DM, DM, DM);
    cvt_flat(F, P.sub_keys, (bf16_t*)(ws + WS_SUBK), (size_t)4 * 8 * 2 * 128 * 128 / 8);
    cvt_rows_fp8(F, P.expert_u, ws + WS_EU, (float*)(ws + WS_SU), 4 * NEXP);
    cvt_rows_fp8(F, P.expert_v, ws + WS_EV, (float*)(ws + WS_SV), 4 * NEXP);
}

__device__ __forceinline__ void norm_phase(const Ctx& F, CParams& P, int layer, int which  , int m_rows) {
    float* X = (float*)(F.ws + WS_X); bf16_t* H = (bf16_t*)(F.ws + WS_H);
    const float* mod = (const float*)(F.ws + WS_MOD) + (size_t)layer * 3 * 12288;
    const float* gn = (which ? P.g_norm2 : P.g_norm1) + (size_t)layer * DM;
    const bool from_in = (layer == 0 && which == 0);
    for (int t = F.vcu * 8 + F.wid; t < m_rows; t += F.G * 8) {
        const int vs = vsel_of_row(t);
        const float* src = from_in ? (t < TL ? P.x + (size_t)t * DM : P.ctx + (size_t)(t - TL) * DM) : X + (size_t)t * DM;
        const float* shf = mod + (size_t)vs * 12288 + (which ? 3 : 0) * DM; const float* scl = shf + DM;
        f32x4 v[8]; float ss = 0.f;
#pragma unroll
        for (int j = 0; j < 8; ++j) { v[j] = *(const f32x4*)(src + j * 256 + F.lane * 4); ss += v[j][0] * v[j][0] + v[j][1] * v[j][1] + v[j][2] * v[j][2] + v[j][3] * v[j][3]; }
        ss = wave_sum(ss);
        const float rstd = rsqrtf(ss * (1.f / DM) + EPS);
#pragma unroll
        for (int j = 0; j < 8; ++j) { const int c = j * 256 + F.lane * 4;
            if (from_in) *(f32x4*)(X + (size_t)t * DM + c) = v[j];
            const f32x4 g = *(const f32x4*)(gn + c), sc = *(const f32x4*)(scl + c), sh = *(const f32x4*)(shf + c);
            f32x4 y;
#pragma unroll
            for (int e = 0; e < 4; ++e) y[e] = (v[j][e] * rstd * g[e]) * (1.f + sc[e]) + sh[e];
            u32x2 w; w.x = cvt_pk_bf16(y[0], y[1]); w.y = cvt_pk_bf16(y[2], y[3]);
            *(u32x2*)(H + (size_t)t * DM + c) = w; }
    }
}

__device__ __forceinline__ float grp16_sum(float v) { v += swz_xor<8>(v); v += swz_xor<4>(v); v += swz_xor<2>(v); v += swz_xor<1>(v); return v; }
__device__ __forceinline__ void rope4(float (&x)[4], int q16, int row, int col, const float* t16) {
    const int seg = q16 >> 3, f0 = (q16 & 3) * 4, pos = seg ? col : row; const bool first = (q16 & 7) < 4;
    const f32x4 c0 = *(const f32x4*)(t16 + (pos * 16 + f0) * 2), c1 = *(const f32x4*)(t16 + (pos * 16 + f0) * 2 + 4);
    const float cs[4] = {c0[0], c0[2], c1[0], c1[2]}, sn[4] = {c0[1], c0[3], c1[1], c1[3]};
#pragma unroll
    for (int e = 0; e < 4; ++e) { const float p = swz_xor<4>(x[e]); x[e] = first ? x[e] * cs[e] - p * sn[e] : p * sn[e] + x[e] * cs[e]; }
}
__device__ __forceinline__ void rope8(float (&x)[8], int q16, int row, int col, const float* t32) {
    const int seg = q16 >> 3, f0 = (q16 & 3) * 8, pos = seg ? col : row; const bool first = (q16 & 7) < 4;
    const float* tp = t32 + (pos * 32 + f0) * 2;
#pragma unroll
    for (int q = 0; q < 4; ++q) { const f32x4 c = *(const f32x4*)(tp + q * 4);
#pragma unroll
        for (int s = 0; s < 2; ++s) { const int e = q * 2 + s; const float cs = c[s * 2], sn = c[s * 2 + 1]; const float p = swz_xor<4>(x[e]); x[e] = first ? x[e] * cs - p * sn : p * sn + x[e] * cs; } }
}
__device__ __forceinline__ void ld8bf(const bf16_t* p, float (&x)[8]) { const u32x4 w = *(const u32x4*)p;
#pragma unroll
    for (int q = 0; q < 4; ++q) { x[q * 2] = bf_lo(w[q]); x[q * 2 + 1] = bf_hi(w[q]); } }
__device__ __forceinline__ void ld4bf(const bf16_t* p, float (&x)[4]) { const u32x2 w = *(const u32x2*)p; x[0] = bf_lo(w.x); x[1] = bf_hi(w.x); x[2] = bf_lo(w.y); x[3] = bf_hi(w.y); }
__device__ __forceinline__ void st8bf(bf16_t* p, const float (&x)[8]) { u32x4 w; w.x = cvt_pk_bf16(x[0], x[1]); w.y = cvt_pk_bf16(x[2], x[3]); w.z = cvt_pk_bf16(x[4], x[5]); w.w = cvt_pk_bf16(x[6], x[7]); *(u32x4*)p = w; }
__device__ __forceinline__ void st4bf(bf16_t* p, const float (&x)[4]) { u32x2 w; w.x = cvt_pk_bf16(x[0], x[1]); w.y = cvt_pk_bf16(x[2], x[3]); *(u32x2*)p = w; }

__device__ __forceinline__ void qkv_even_phase(const Ctx& F, CParams& P, int e) {
    const bf16_t* P1 = (const bf16_t*)(F.ws + WS_P1); const bf16_t* QA = (const bf16_t*)(F.ws + WS_QA); const bf16_t* KV = (const bf16_t*)(F.ws + WS_KV);
    bf16_t* Qm = (bf16_t*)(F.ws + WS_Q1); bf16_t* Km = (bf16_t*)(F.ws + WS_K1); bf16_t* Vm = (bf16_t*)(F.ws + WS_V1);
    bf16_t* Qd = (bf16_t*)(F.ws + WS_Q2); bf16_t* Kd = (bf16_t*)(F.ws + WS_K2); bf16_t* Vd = (bf16_t*)(F.ws + WS_V2);
    const float* t16 = (const float*)(F.ws + WS_TAB16);
    const float* gqa = P.g_qn_a + e * 192; const float* gka = P.g_kn_a + e * 192; const float* gqb = P.g_qn_b + e * 64; const float* gkb = P.g_kn_b + e * 64;
    const int q16 = F.lane & 15, grp = F.lane >> 4;
    float gq_n[8], gq_r[4], gk_n[8], gk_r[4], gqd[4], gkd[4];
#pragma unroll
    for (int i = 0; i < 8; ++i) { gq_n[i] = gqa[q16 * 8 + i]; gk_n[i] = gka[q16 * 8 + i]; }
#pragma unroll
    for (int i = 0; i < 4; ++i) { gq_r[i] = gqa[128 + q16 * 4 + i]; gk_r[i] = gka[128 + q16 * 4 + i]; gqd[i] = gqb[q16 * 4 + i]; gkd[i] = gkb[q16 * 4 + i]; }
    for (int t = F.vcu * 8 + F.wid; t < TT; t += F.G * 8) {
        const bool latent = t < TL; const int s = t & (SEQ - 1), row = s >> 6, col = s & 63; const int kr = krow_of(t);
        const bf16_t* p1 = P1 + (size_t)t * AB_INP;
        float ss = 0.f;
#pragma unroll
        for (int j = 0; j < 3; ++j) { float x[4]; ld4bf(p1 + j * 256 + F.lane * 4, x); ss += x[0] * x[0] + x[1] * x[1] + x[2] * x[2] + x[3] * x[3]; }
        ss = wave_sum(ss); const float rstd_q = rsqrtf(ss * (1.f / 768.f) + EPS);
        float s2 = 0.f;
        { float x[8]; ld8bf(p1 + 768 + F.lane * 8, x);
#pragma unroll
          for (int i = 0; i < 8; ++i) s2 += x[i] * x[i]; }
        s2 = wave_sum(s2); const float rstd_kv = rsqrtf(s2 * (1.f / 512.f) + EPS);
        float kro[4]; ld4bf(p1 + 1280 + q16 * 4, kro);
#pragma unroll
        for (int ps = 0; ps < 2; ++ps) { const int h = ps * 4 + grp; const bf16_t* src = QA + (size_t)t * 1536 + h * 192;
            float xn[8], xr[4]; ld8bf(src + q16 * 8, xn); ld4bf(src + 128 + q16 * 4, xr);
            float sq = 0.f;
#pragma unroll
            for (int i = 0; i < 8; ++i) { xn[i] *= rstd_q; sq += xn[i] * xn[i]; }
#pragma unroll
            for (int i = 0; i < 4; ++i) { xr[i] *= rstd_q; sq += xr[i] * xr[i]; }
            sq = grp16_sum(sq); const float r = rsqrtf(sq * (1.f / 192.f) + EPS);
#pragma unroll
            for (int i = 0; i < 8; ++i) xn[i] *= r * gq_n[i];
#pragma unroll
            for (int i = 0; i < 4; ++i) xr[i] *= r * gq_r[i];
            if (latent) rope4(xr, q16, row, col, t16);
            bf16_t* dst = Qm + ((size_t)t * 8 + h) * 192; st8bf(dst + q16 * 8, xn); st4bf(dst + 128 + q16 * 4, xr); }
#pragma unroll
        for (int ps = 0; ps < 2; ++ps) { const int h = ps * 4 + grp; const bf16_t* src = KV + (size_t)t * 2048 + h * 256;
            float xn[8], xr[4], xv[8]; ld8bf(src + q16 * 8, xn); ld8bf(src + 128 + q16 * 8, xv);
            float sq = 0.f;
#pragma unroll
            for (int i = 0; i < 8; ++i) { xn[i] *= rstd_kv; xv[i] *= rstd_kv; sq += xn[i] * xn[i]; }
#pragma unroll
            for (int i = 0; i < 4; ++i) { xr[i] = kro[i]; sq += xr[i] * xr[i]; }
            sq = grp16_sum(sq); const float r = rsqrtf(sq * (1.f / 192.f) + EPS);
#pragma unroll
            for (int i = 0; i < 8; ++i) xn[i] *= r * gk_n[i];
#pragma unroll
            for (int i = 0; i < 4; ++i) xr[i] *= r * gk_r[i];
            if (latent) rope4(xr, q16, row, col, t16);
            bf16_t* dst = Km + ((size_t)kr * 8 + h) * 192; st8bf(dst + q16 * 8, xn); st4bf(dst + 128 + q16 * 4, xr);
            st8bf(Vm + ((size_t)kr * 8 + h) * 128 + q16 * 8, xv); }
#pragma unroll
        for (int ps = 0; ps < 4; ++ps) { const int hm = ps * 4 + grp;
            float x[4]; ld4bf(p1 + 1344 + hm * 64 + q16 * 4, x);
            float sq = grp16_sum(x[0] * x[0] + x[1] * x[1] + x[2] * x[2] + x[3] * x[3]); float r = rsqrtf(sq * (1.f / 64.f) + EPS);
#pragma unroll
            for (int i = 0; i < 4; ++i) x[i] *= r * gqd[i];
            if (latent) rope4(x, q16, row, col, t16);
            st4bf(Qd + ((size_t)t * 16 + hm) * 64 + q16 * 4, x);
            ld4bf(p1 + 2368 + hm * 64 + q16 * 4, x);
            sq = grp16_sum(x[0] * x[0] + x[1] * x[1] + x[2] * x[2] + x[3] * x[3]); r = rsqrtf(sq * (1.f / 64.f) + EPS);
#pragma unroll
            for (int i = 0; i < 4; ++i) x[i] *= r * gkd[i];
            if (latent) rope4(x, q16, row, col, t16);
            st4bf(Kd + ((size_t)kr * 16 + hm) * 64 + q16 * 4, x); }
#pragma unroll
        for (int j = 0; j < 2; ++j) *(u32x4*)(Vd + (size_t)kr * 1024 + j * 512 + F.lane * 8) = *(const u32x4*)(p1 + 3392 + j * 512 + F.lane * 8);
    }
}
__device__ __forceinline__ void qkv_odd_phase(const Ctx& F, CParams& P, int e) {
    const bf16_t* P1 = (const bf16_t*)(F.ws + WS_P1);
    bf16_t* Qc = (bf16_t*)(F.ws + WS_Q1); bf16_t* Kc = (bf16_t*)(F.ws + WS_K1); bf16_t* Vc = (bf16_t*)(F.ws + WS_V1);
    const float* t32 = (const float*)(F.ws + WS_TAB32);
    const int q16 = F.lane & 15, grp = F.lane >> 4;
    float gq[8], gk[8];
#pragma unroll
    for (int i = 0; i < 8; ++i) { gq[i] = P.g_qn_c[e * 128 + q16 * 8 + i]; gk[i] = P.g_kn_c[e * 128 + q16 * 8 + i]; }
    for (int t = F.vcu * 8 + F.wid; t < TT; t += F.G * 8) {
        const bool latent = t < TL; const int s = t & (SEQ - 1), row = s >> 6, col = s & 63; const int kr = krow_of(t);
        const bf16_t* p1 = P1 + (size_t)t * C_IN;
#pragma unroll
        for (int ps = 0; ps < 5; ++ps) {
            const bool isq = ps < 4; const int h = isq ? ps * 4 + grp : grp;
            float x[8]; ld8bf(p1 + (isq ? 0 : 2048) + h * 128 + q16 * 8, x);
            float sq = 0.f;
#pragma unroll
            for (int i = 0; i < 8; ++i) sq += x[i] * x[i];
            sq = grp16_sum(sq); const float r = rsqrtf(sq * (1.f / 128.f) + EPS);
#pragma unroll
            for (int i = 0; i < 8; ++i) x[i] *= r * (isq ? gq[i] : gk[i]);
            if (latent) rope8(x, q16, row, col, t32);
            st8bf(isq ? Qc + ((size_t)t * 16 + h) * 128 + q16 * 8 : Kc + ((size_t)kr * 4 + h) * 128 + q16 * 8, x); }
        *(u32x4*)(Vc + (size_t)kr * 512 + F.lane * 8) = *(const u32x4*)(p1 + 2560 + F.lane * 8);
    }
}

template <int DQK, int SDEPTH, int ldo, int NH, int NKVH, int NVH>
__device__ __forceinline__ void attn_phase(const Ctx& F, const bf16_t* Qbuf, const bf16_t* Kbuf, const bf16_t* Vbuf, bf16_t* OF, int ocol0, bool with_ctx) {
    constexpr int kv_div = NH / NKVH, v_div = NH / NVH;
    const int n_lat = NH * NB * 32, n_tot = n_lat + (with_ctx ? NH * NB : 0);
    constexpr int ldq = NH * DQK, ldk = NKVH * DQK, ldv = NVH * 128;
    for (int u = F.vcu; u < n_tot; u += F.G) {
        int b, h, qrow0, kstart, seq;
        if (u < n_lat) { const int bh = u >> 5, qb = u & 31; b = bh / NH; h = bh % NH; qrow0 = b * SEQ + qb * 256; kstart = b * KPB; seq = KPB; }
        else { const int bh = u - n_lat; b = bh / NH; h = bh % NH; qrow0 = TL + b * CTXL; kstart = b * KPB + SEQ; seq = CTXL; }
        const bf16_t* Qp = Qbuf + ((size_t)qrow0 * NH + h) * DQK;
        const bf16_t* Kp = Kbuf + ((size_t)kstart * NKVH + h / kv_div) * DQK;
        const bf16_t* Vp = Vbuf + ((size_t)kstart * NVH + h / v_div) * 128;
        bf16_t* Op = OF + (size_t)qrow0 * ldo + ocol0 + h * 128;
        if constexpr (SDEPTH == 0) att::attn_body_simple<DQK, (DQK == 192 ? MLA_QL : 0), ldq, ldk, ldv, ldo>(Qp, Kp, Vp, Op, seq, F.lds, F.wid);
        else att::attn_body<DQK, SDEPTH, (DQK == 192 ? MLA_QL : (DQK == 128 ? GQA_QL : 0)), ldq, ldk, ldv, ldo>(Qp, Kp, Vp, Op, seq, F.lds, F.wid);
    }
}

__device__ __forceinline__ void merge_even_phase(const Ctx& F, CParams& P, int e, int layer, int m_rows) {
    const bf16_t* OD = (const bf16_t*)(F.ws + WS_OF); bf16_t* AO = (bf16_t*)(F.ws + WS_AO);
    const float lam = ((const float*)(F.ws + WS_LAM))[e];
    const float lam_init = 0.8f - 0.6f * expf(-0.3f * (float)layer);
    const int q16 = F.lane & 15, grp = F.lane >> 4;
    float gs[8];
#pragma unroll
    for (int i = 0; i < 8; ++i) gs[i] = P.g_sub_b[e * 128 + q16 * 8 + i] * (1.f - lam_init);
    for (int t = F.vcu * 8 + F.wid; t < m_rows; t += F.G * 8) {
        const bf16_t* od = OD + (size_t)t * DM; bf16_t* ao = AO + (size_t)t * DM + 1024;
#pragma unroll
        for (int ps = 0; ps < 2; ++ps) { const int h = ps * 4 + grp;
            float o0[8], o1[8], d[8]; ld8bf(od + (2 * h) * 128 + q16 * 8, o0); ld8bf(od + (2 * h + 1) * 128 + q16 * 8, o1);
            float sq = 0.f;
#pragma unroll
            for (int i = 0; i < 8; ++i) { d[i] = o0[i] - lam * o1[i]; sq += d[i] * d[i]; }
            sq = grp16_sum(sq); const float r = rsqrtf(sq * (1.f / 128.f) + EPS);
#pragma unroll
            for (int i = 0; i < 8; ++i) d[i] *= r * gs[i];
            st8bf(ao + h * 128 + q16 * 8, d); }
    }
}

__device__ __forceinline__ void wave_lds_fence() { asm volatile("s_waitcnt lgkmcnt(0)" ::: "memory"); __builtin_amdgcn_wave_barrier(); asm volatile("" ::: "memory"); }
__device__ __forceinline__ unsigned fkey(float f) { const unsigned b = __float_as_uint(f); return b ^ ((unsigned)((int)b >> 31) | 0x80000000u); }
__device__ __forceinline__ float funkey(unsigned k) { return __uint_as_float((k & 0x80000000u) ? (k ^ 0x80000000u) : ~k); }
__device__ __forceinline__ unsigned umed3(unsigned a, unsigned b, unsigned c) { unsigned r; asm("v_med3_u32 %0, %1, %2, %3" : "=v"(r) : "v"(a), "v"(b), "v"(c)); return r; }
__device__ __forceinline__ void kins16(unsigned (&L)[16], unsigned k) {
#pragma unroll
    for (int p = 15; p >= 1; --p) L[p] = umed3(L[p - 1], L[p], k);
    L[0] = L[0] > k ? L[0] : k;
}
__device__ __forceinline__ void scan_set(unsigned (&L)[16], const bf16_t* qbase  , const bf16_t* kbase  , float* buf, int lane) {
    const int r32 = lane & 31, hi = lane >> 5;
#pragma unroll
    for (int p = 0; p < 16; ++p) L[p] = 0u;
    bf16x8 a0[8], a1[8];
    { const bf16_t* ap = qbase + (size_t)r32 * DM + hi * 8;
#pragma unroll
      for (int ks = 0; ks < 8; ++ks) { a0[ks] = *(const bf16x8*)(ap + ks * 16); a1[ks] = *(const bf16x8*)(ap + (size_t)32 * DM + ks * 16); } }
#pragma unroll 1
    for (int kb = 0; kb < 4; ++kb) {
        f32x16 acc0 = {}, acc1 = {};
        { const bf16_t* bp = kbase + (size_t)(kb * 32 + r32) * 128 + hi * 8;
          bf16x8 b[8];
#pragma unroll
          for (int ks = 0; ks < 8; ++ks) b[ks] = *(const bf16x8*)(bp + ks * 16);
#pragma unroll
          for (int ks = 0; ks < 8; ++ks) { acc0 = __builtin_amdgcn_mfma_f32_32x32x16_bf16(a0[ks], b[ks], acc0, 0, 0, 0); acc1 = __builtin_amdgcn_mfma_f32_32x32x16_bf16(a1[ks], b[ks], acc1, 0, 0, 0); } }
        wave_lds_fence();
#pragma unroll
        for (int r = 0; r < 16; ++r) { const int rowi = att::crow(r, hi); buf[rowi * 33 + r32] = acc0[r]; buf[(32 + rowi) * 33 + r32] = acc1[r]; }
        wave_lds_fence();
        const unsigned tb = 127u - (unsigned)(kb * 32);
#pragma unroll 8
        for (int k = 0; k < 32; ++k) kins16(L, (fkey(buf[lane * 33 + k]) & ~127u) | (tb - (unsigned)k));
    }
}
__device__ __forceinline__ void peer_select_phase(const Ctx& F, int layer, int m_rows) {
    const bf16_t* PQ = (const bf16_t*)(F.ws + WS_PQ); const bf16_t* SK = (const bf16_t*)(F.ws + WS_SUBK) + (size_t)layer * 8 * 2 * 128 * 128;
    int* PIDX = (int*)(F.ws + WS_PIDX); float* PG = (float*)(F.ws + WS_PG);
    float* buf = (float*)F.lds + F.wid * (64 * 33);
    const int lane = F.lane;
    const int nunits = (m_rows / 64) * 8;
    for (int u = F.vcu * 8 + F.wid; u < nunits; u += F.G * 8) {
        const int tile = u >> 3, h = u & 7, t0 = tile * 64;
        unsigned Ka[16], Kb[16];
        scan_set(Ka, PQ + (size_t)t0 * DM + h * 256, SK + (size_t)(h * 2) * 128 * 128, buf, lane);
        scan_set(Kb, PQ + (size_t)t0 * DM + h * 256 + 128, SK + (size_t)(h * 2 + 1) * 128 * 128, buf, lane);
        wave_lds_fence();
        float la[16], lb[16];
#pragma unroll
        for (int p = 0; p < 16; ++p) { la[p] = funkey(Ka[p] & ~127u); lb[p] = funkey(Kb[p] & ~127u);
            buf[lane * 33 + p] = __int_as_float(127 - (int)(Ka[p] & 127u)); buf[lane * 33 + 16 + p] = __int_as_float(127 - (int)(Kb[p] & 127u)); }
        wave_lds_fence();
        unsigned Kc[16];
#pragma unroll
        for (int p = 0; p < 16; ++p) Kc[p] = 0u;
#pragma unroll
        for (int r1 = 0; r1 < 16; ++r1)
#pragma unroll
            for (int r2 = 0; r2 < 16; ++r2) if ((r1 + 1) * (r2 + 1) <= 16) kins16(Kc, (fkey(la[r1] + lb[r2]) & ~255u) | (unsigned)(255 - (16 * r1 + r2)));
        float bv[16], sm = 0.f; unsigned idx[16];
#pragma unroll
        for (int p = 0; p < 16; ++p) { const int code = 255 - (int)(Kc[p] & 255u); bv[p] = funkey(Kc[p] & ~255u);
            idx[p] = (unsigned)(__float_as_int(buf[lane * 33 + (code >> 4)]) * 128 + __float_as_int(buf[lane * 33 + 16 + (code & 15)])); }
        const float bmax = bv[0];
#pragma unroll
        for (int p = 0; p < 16; ++p) { bv[p] = __expf(bv[p] - bmax); sm += bv[p]; }
        const float inv = 1.f / sm;
        const size_t o = ((size_t)(t0 + lane) * 8 + h) * 16;
#pragma unroll
        for (int q = 0; q < 4; ++q) { *(f32x4*)(PG + o + q * 4) = (f32x4){bv[q * 4] * inv, bv[q * 4 + 1] * inv, bv[q * 4 + 2] * inv, bv[q * 4 + 3] * inv};
            *(u32x4*)(PIDX + o + q * 4) = (u32x4){idx[q * 4], idx[q * 4 + 1], idx[q * 4 + 2], idx[q * 4 + 3]}; }
    }
}

__device__ __forceinline__ float gelu_tanh(float a) { const float u = 0.7978845608028654f * (a + 0.044715f * a * a * a); const float t = 1.f - 2.f / (1.f + __expf(2.f * u)); return 0.5f * a * (1.f + t); }
struct Row8 { u32x4 r[2]; };
__device__ __forceinline__ void ld_row8(Row8& R, const unsigned char* tab, int e, int lane) {
    const u32x4* rp = (const u32x4*)(tab + (size_t)e * DM);
    R.r[0] = rp[lane]; R.r[1] = rp[64 + lane];
}
__device__ __forceinline__ float dot_row8(const Row8& R, const float (&h)[32]) {
    float s0 = 0.f, s1 = 0.f, s2 = 0.f, s3 = 0.f;
#pragma unroll
    for (int j = 0; j < 2; ++j)
#pragma unroll
        for (int q = 0; q < 4; ++q) { const unsigned w = R.r[j][q]; const f32x2 lo = __builtin_amdgcn_cvt_pk_f32_fp8(w, false), hi = __builtin_amdgcn_cvt_pk_f32_fp8(w, true);
            s0 = fmaf(lo[0], h[j * 16 + q * 4 + 0], s0); s1 = fmaf(lo[1], h[j * 16 + q * 4 + 1], s1); s2 = fmaf(hi[0], h[j * 16 + q * 4 + 2], s2); s3 = fmaf(hi[1], h[j * 16 + q * 4 + 3], s3); }
    return (s0 + s1) + (s2 + s3);
}
__device__ __forceinline__ void fma_row8(float (&out)[32], const Row8& R, float w) {
#pragma unroll
    for (int j = 0; j < 2; ++j)
#pragma unroll
        for (int q = 0; q < 4; ++q) { const unsigned x = R.r[j][q]; const f32x2 lo = __builtin_amdgcn_cvt_pk_f32_fp8(x, false), hi = __builtin_amdgcn_cvt_pk_f32_fp8(x, true);
            out[j * 16 + q * 4 + 0] = fmaf(w, lo[0], out[j * 16 + q * 4 + 0]); out[j * 16 + q * 4 + 1] = fmaf(w, lo[1], out[j * 16 + q * 4 + 1]);
            out[j * 16 + q * 4 + 2] = fmaf(w, hi[0], out[j * 16 + q * 4 + 2]); out[j * 16 + q * 4 + 3] = fmaf(w, hi[1], out[j * 16 + q * 4 + 3]); }
}
__device__ __forceinline__ float reduce4(float s0, float s1, float s2, float s3, int lane) {
    const bool hi = (lane & 32) != 0, b4 = (lane & 16) != 0;
    const float r0 = xor32_partner(hi ? s0 : s2, lane), r1 = xor32_partner(hi ? s1 : s3, lane);
    const float a0 = (hi ? s2 : s0) + r0, a1 = (hi ? s3 : s1) + r1;
    const float r = swz_xor<16>(b4 ? a0 : a1);
    float b = (b4 ? a1 : a0) + r;
    b += swz_xor<8>(b); b += swz_xor<4>(b); b += swz_xor<2>(b); b += swz_xor<1>(b);
    return b;
}
__device__ __forceinline__ float rl_f(float v, int l) { return __uint_as_float(__builtin_amdgcn_readlane(__float_as_uint(v), l)); }
__device__ __forceinline__ void peer_expert_phase(const Ctx& F, CParams& P, int layer, int m_rows, bool last, bool dry) {
    const unsigned char* EU = F.ws + WS_EU + (size_t)layer * NEXP * DM; const unsigned char* EV = F.ws + WS_EV + (size_t)layer * NEXP * DM;
    const float* SU = (const float*)(F.ws + WS_SU) + (size_t)layer * NEXP; const float* SV = (const float*)(F.ws + WS_SV) + (size_t)layer * NEXP;
    const bf16_t* H = (const bf16_t*)(F.ws + WS_H); float* X = (float*)(F.ws + WS_X);
    const int* PIDX = (const int*)(F.ws + WS_PIDX); const float* PG = (const float*)(F.ws + WS_PG);
    const float* mod = (const float*)(F.ws + WS_MOD) + (size_t)layer * 3 * 12288;
    const int lane = F.lane;
    for (int t = F.vcu * 8 + F.wid; t < m_rows; t += F.G * 8) {
        float hf[32];
#pragma unroll
        for (int j = 0; j < 2; ++j) { const u32x4* hp = (const u32x4*)(H + (size_t)t * DM + j * 1024 + lane * 16); const u32x4 w0 = hp[0], w1 = hp[1];
#pragma unroll
            for (int q = 0; q < 4; ++q) { hf[j * 16 + q * 2] = bf_lo(w0[q]); hf[j * 16 + q * 2 + 1] = bf_hi(w0[q]); hf[j * 16 + 8 + q * 2] = bf_lo(w1[q]); hf[j * 16 + 8 + q * 2 + 1] = bf_hi(w1[q]); } }
        int id[2]; float wv[2];
        id[0] = PIDX[(size_t)t * 128 + lane]; id[1] = PIDX[(size_t)t * 128 + 64 + lane];
#pragma unroll
        for (int half = 0; half < 2; ++half) {
            const int idr = id[half]; float acc = 0.f;
            const float gk = PG[(size_t)t * 128 + half * 64 + lane], su = SU[idr], sv = SV[idr];
            Row8 A[4], B[4];
#pragma unroll
            for (int q = 0; q < 4; ++q) ld_row8(A[q], EU, __builtin_amdgcn_readlane(idr, q), lane);
#pragma unroll 1
            for (int k = 0; k < 64; k += 8) {
#pragma unroll
                for (int q = 0; q < 4; ++q) ld_row8(B[q], EU, __builtin_amdgcn_readlane(idr, k + 4 + q), lane);
                { const float b = reduce4(dot_row8(A[0], hf), dot_row8(A[1], hf), dot_row8(A[2], hf), dot_row8(A[3], hf), lane);
#pragma unroll
                  for (int q = 0; q < 4; ++q) { const float tq = rl_f(b, 16 * q); acc = (lane == k + q) ? tq : acc; } }
                if (k + 8 < 64) {
#pragma unroll
                    for (int q = 0; q < 4; ++q) ld_row8(A[q], EU, __builtin_amdgcn_readlane(idr, k + 8 + q), lane); }
                { const float b = reduce4(dot_row8(B[0], hf), dot_row8(B[1], hf), dot_row8(B[2], hf), dot_row8(B[3], hf), lane);
#pragma unroll
                  for (int q = 0; q < 4; ++q) { const float tq = rl_f(b, 16 * q); acc = (lane == k + 4 + q) ? tq : acc; } }
            }
            wv[half] = gk * gelu_tanh(acc * su) * sv;
        }
        float out[32];
#pragma unroll
        for (int i = 0; i < 32; ++i) out[i] = 0.f;
#pragma unroll
        for (int half = 0; half < 2; ++half) {
            const int idr = id[half]; const float wr = wv[half];
            Row8 A[4], B[4];
#pragma unroll
            for (int q = 0; q < 4; ++q) ld_row8(A[q], EV, __builtin_amdgcn_readlane(idr, q), lane);
#pragma unroll 1
            for (int k = 0; k < 64; k += 8) {
#pragma unroll
                for (int q = 0; q < 4; ++q) ld_row8(B[q], EV, __builtin_amdgcn_readlane(idr, k + 4 + q), lane);
#pragma unroll
                for (int q = 0; q < 4; ++q) fma_row8(out, A[q], rl_f(wr, k + q));
                if (k + 8 < 64) {
#pragma unroll
                    for (int q = 0; q < 4; ++q) ld_row8(A[q], EV, __builtin_amdgcn_readlane(idr, k + 8 + q), lane); }
#pragma unroll
                for (int q = 0; q < 4; ++q) fma_row8(out, B[q], rl_f(wr, k + 4 + q));
            }
        }
        const int vs = vsel_of_row(t);
        const float* gate = mod + (size_t)vs * 12288 + 5 * DM;
        float* xr = X + (size_t)t * DM; float* dst = dry ? (float*)(F.ws + WS_OF) + (size_t)t * DM : (last ? P.out + (size_t)t * DM : xr);
        float ssq = 0.f;
#pragma unroll
        for (int j = 0; j < 2; ++j)
#pragma unroll
            for (int q = 0; q < 4; ++q) { const int c = j * 1024 + lane * 16 + q * 4; const f32x4 xo = *(const f32x4*)(xr + c), g = *(const f32x4*)(gate + c);
                f32x4 y; y[0] = xo[0] + g[0] * out[j * 16 + q * 4 + 0]; y[1] = xo[1] + g[1] * out[j * 16 + q * 4 + 1]; y[2] = xo[2] + g[2] * out[j * 16 + q * 4 + 2]; y[3] = xo[3] + g[3] * out[j * 16 + q * 4 + 3];
                *(f32x4*)(dst + c) = y;
                out[j * 16 + q * 4 + 0] = y[0]; out[j * 16 + q * 4 + 1] = y[1]; out[j * 16 + q * 4 + 2] = y[2]; out[j * 16 + q * 4 + 3] = y[3];
                ssq += y[0] * y[0] + y[1] * y[1] + y[2] * y[2] + y[3] * y[3]; }
        if (!last && !dry) {
            const float rstd = rsqrtf(wave_sum(ssq) * (1.f / DM) + EPS);
            const float* gn = P.g_norm1 + (size_t)(layer + 1) * DM;
            const float* shf = mod + (size_t)3 * 12288 + (size_t)vs * 12288; const float* scl = shf + DM;
            bf16_t* hrow = (bf16_t*)(F.ws + WS_H) + (size_t)t * DM;
#pragma unroll
            for (int j = 0; j < 2; ++j) { u32x4 w[2];
#pragma unroll
                for (int q = 0; q < 4; ++q) { const int c = j * 1024 + lane * 16 + q * 4; const f32x4 g = *(const f32x4*)(gn + c), sc = *(const f32x4*)(scl + c), sh = *(const f32x4*)(shf + c);
                    float y[4];
#pragma unroll
                    for (int e2 = 0; e2 < 4; ++e2) y[e2] = (out[j * 16 + q * 4 + e2] * rstd * g[e2]) * (1.f + sc[e2]) + sh[e2];
                    w[q >> 1][(q & 1) * 2] = cvt_pk_bf16(y[0], y[1]); w[q >> 1][(q & 1) * 2 + 1] = cvt_pk_bf16(y[2], y[3]); }
                *(u32x4*)(hrow + j * 1024 + lane * 16) = w[0]; *(u32x4*)(hrow + j * 1024 + lane * 16 + 8) = w[1]; }
        }
    }
}

constexpr int N_PHASES = 1 + 2 * 11 + 2 * 9 - 3;
__global__ void __launch_bounds__(512, 2) mk_fwd(Params Pval) {
    extern __shared__ __attribute__((aligned(16))) unsigned char lds_raw[];
    LAS unsigned char* ldsl = (LAS unsigned char*)lds_raw;
    volatile LAS unsigned* misc = (volatile LAS unsigned*)(ldsl + LDS_MISC);
    if (threadIdx.x < 16) misc[threadIdx.x] = 0u;
    __syncthreads();
    XcdBarrier bar = xcd_barrier_post((unsigned*)(Pval.ws + WS_CTL) + 1024, misc);
    const int wid0 = __builtin_amdgcn_readfirstlane((int)threadIdx.x >> 6);
    const int lo = Pval.ph_lo, hi = Pval.ph_hi; int ph = 0;
#define MKCTX() Ctx F; { const int lane_ = fresh_lane(); int wid_ = wid0; asm volatile("" : "+s"(wid_)); const int tid_ = wid_ * 64 + lane_; F.tid = tid_; F.lane = lane_; F.wid = wid_; \
        int G_ = gridDim.x, bx_ = blockIdx.x; asm volatile("" : "+s"(G_), "+s"(bx_)); F.G = G_; F.vcu = (G_ % 8 == 0) ? (bx_ % 8) * (G_ / 8) + bx_ / 8 : bx_; F.bx = bx_; } \
        unsigned long long kp_ = (unsigned long long)__builtin_amdgcn_kernarg_segment_ptr(); asm volatile("" : "+s"(kp_)); CParams& P = *(CParams*)kp_; \
        F.ws = P.ws; F.lds = (char*)lds_raw; unsigned char* ws = F.ws; (void)ws; \
        bf16_t* Hb = (bf16_t*)(ws + WS_H); bf16_t* P1 = (bf16_t*)(ws + WS_P1); float* X = (float*)(ws + WS_X); const float* mod = (const float*)(ws + WS_MOD); (void)Hb; (void)P1; (void)X; (void)mod;
#define PHASE(cls, ...) do { if (ph >= lo && ph < hi) { if constexpr ((PH_MASK >> (cls)) & 1u) { \
        if constexpr ((PH_DOUBLE >> (cls)) & 1u) { const bool dry = true; (void)dry; MKCTX(); __VA_ARGS__; __syncthreads(); } \
        { const bool dry = false; (void)dry; MKCTX(); __VA_ARGS__; } } if (ph + 1 < hi) { int w0_ = wid0; asm volatile("" : "+s"(w0_)); xcd_barrier(bar, w0_ == 0 && fresh_lane() == 0); } } ++ph; } while (0)

    PHASE(0, prologue_phase(F, P));
#pragma unroll 1
    for (int layer = 0; layer < DEPTH; ++layer) {
        const int e = layer >> 1; const bool even = (layer & 1) == 0, lastl = layer == DEPTH - 1;
        const int m_post = lastl ? TL : TT;
        if (layer == 0) PHASE(1, norm_phase(F, P, layer, 0, TT));
        PHASE(2, { const bf16_t* W = even ? (const bf16_t*)(ws + WS_WINAB) + (size_t)e * AB_INP * DM : (const bf16_t*)(ws + WS_WINC) + (size_t)e * C_IN * DM;
                const int N = even ? AB_INP : C_IN;
                pg8::Gemm g{Hb, W, TT, N, DM, DM}; pg8::StaticOrder S; S.init(TT, N, F.G, F.bx);
                pg8::EpiBf16 E{P1, N};
                pg8::gemm_phase<pg8::EpiBf16, pg8::StaticOrder>(ldsl, g, S, E, F.wid); });
        if (even) {
            PHASE(3, { { pg8::Gemm g{P1, (const bf16_t*)(ws + WS_WUQ) + (size_t)e * 1536 * 768, TT, 1536, 768, AB_INP}; pg8::StaticOrder S; S.init(TT, 1536, F.G, F.bx);
                      pg8::EpiBf16 E{(bf16_t*)(ws + WS_QA), 1536};
                      pg8::gemm_phase<pg8::EpiBf16, pg8::StaticOrder>(ldsl, g, S, E, F.wid); }
                    { pg8::Gemm g{P1 + 768, (const bf16_t*)(ws + WS_WUKV) + (size_t)e * 2048 * 512, TT, 2048, 512, AB_INP}; pg8::StaticOrder S; S.init(TT, 2048, F.G, F.bx);
                      pg8::EpiBf16 E{(bf16_t*)(ws + WS_KV), 2048};
                      pg8::gemm_phase<pg8::EpiBf16, pg8::StaticOrder>(ldsl, g, S, E, F.wid); } });
            PHASE(4, qkv_even_phase(F, P, e));
            PHASE(5, { if constexpr (ATT_SEL & 1) attn_phase<192, MLA_SD, 2048, 8, 8, 8>(F, (const bf16_t*)(ws + WS_Q1), (const bf16_t*)(ws + WS_K1), (const bf16_t*)(ws + WS_V1), (bf16_t*)(ws + WS_AO), 0, !lastl);
                    if constexpr (ATT_SEL & 2) attn_phase<64, 2, 2048, 16, 16, 8>(F, (const bf16_t*)(ws + WS_Q2), (const bf16_t*)(ws + WS_K2), (const bf16_t*)(ws + WS_V2), (bf16_t*)(ws + WS_OF), 0, !lastl); });
            PHASE(6, merge_even_phase(F, P, e, layer, m_post));
        } else {
            PHASE(7, qkv_odd_phase(F, P, e));
            PHASE(8, attn_phase<128, GQA_SD, 2048, 16, 4, 4>(F, (const bf16_t*)(ws + WS_Q1), (const bf16_t*)(ws + WS_K1), (const bf16_t*)(ws + WS_V1), (bf16_t*)(ws + WS_AO), 0, !lastl));
        }
        PHASE(10, { const bf16_t* W = even ? (const bf16_t*)(ws + WS_WOUTAB) + (size_t)e * DM * DM : (const bf16_t*)(ws + WS_WOUTC) + (size_t)e * DM * DM;
                pg8::Gemm g{(const bf16_t*)(ws + WS_AO), W, m_post, DM, DM, DM}; pg8::StaticOrder S; S.init(m_post, DM, F.G, F.bx);
                pg8::EpiResid E{X, mod + (size_t)layer * 3 * 12288, 2};
                pg8::gemm_phase<pg8::EpiResid, pg8::StaticOrder>(ldsl, g, S, E, F.wid); });
        PHASE(1, norm_phase(F, P, layer, 1, m_post));
        PHASE(11, { pg8::Gemm g{Hb, (const bf16_t*)(ws + WS_WPQ) + (size_t)layer * DM * DM, m_post, DM, DM, DM}; pg8::StaticOrder S; S.init(m_post, DM, F.G, F.bx);
                pg8::EpiBf16 E{(bf16_t*)(ws + WS_PQ), DM};
                pg8::gemm_phase<pg8::EpiBf16, pg8::StaticOrder>(ldsl, g, S, E, F.wid); });
        PHASE(12, peer_select_phase(F, layer, m_post));
        PHASE(13, peer_expert_phase(F, P, layer, m_post, lastl, dry));
    }
#undef PHASE
}

extern "C" void kernel_launch(void* const* d_in, const int* in_sizes, int n_in, void* d_out, int out_size, void* d_ws, size_t ws_size, hipStream_t stream) {
    static int grid = 0;
    if (grid == 0) {
        if (n_in != 28 || ws_size < WS_END) { fprintf(stderr, "kernel_launch: expected 28 inputs and >= %zu bytes of workspace, got %d / %zu\n", (size_t)WS_END, n_in, ws_size); grid = -1; return; }
        int dev = 0, cus = 0, per_cu = 0;
        if (hipGetDevice(&dev) != hipSuccess || hipDeviceGetAttribute(&cus, hipDeviceAttributeMultiprocessorCount, dev) != hipSuccess) { grid = -1; return; }
        if (hipFuncSetAttribute((const void*)mk_fwd, hipFuncAttributeMaxDynamicSharedMemorySize, LDS_BYTES) != hipSuccess) { fprintf(stderr, "kernel_launch: hipFuncSetAttribute failed\n"); grid = -1; return; }
        if (hipOccupancyMaxActiveBlocksPerMultiprocessor(&per_cu, (const void*)mk_fwd, 512, LDS_BYTES) != hipSuccess || per_cu < 1) fprintf(stderr, "kernel_launch: occupancy query says %d\n", per_cu);
        (void)hipGetLastError();
        grid = cus;
    }
    if (grid < 0) return;
    (void)hipMemsetAsync((char*)d_ws + WS_CTL, 0, CTL_BYTES, stream);
    Params p{};
    const float** pf = (const float**)&p;
    for (int i = 0; i < 28; ++i) pf[i] = (const float*)d_in[i];
    p.out = (float*)d_out; p.ws = (unsigned char*)d_ws;
#if MK_PER_PHASE_LAUNCH
    for (int i = 0; i < N_PHASES; ++i) { p.ph_lo = i; p.ph_hi = i + 1; hipLaunchKernelGGL(mk_fwd, dim3(grid), dim3(512), LDS_BYTES, stream, p); }
#else
    p.ph_lo = 0; p.ph_hi = N_PHASES;
    hipLaunchKernelGGL(mk_fwd, dim3(grid), dim3(512), LDS_BYTES, stream, p);
#endif
    const hipError_t le = hipPeekAtLastError();
    if (le != hipSuccess) fprintf(stderr, "kernel_launch: launch failed: %s\n", hipGetErrorName(le));
}
```

```cpp
#include <hip/hip_runtime.h>
#include <stdint.h>
#include <stdio.h>

#ifndef MK_PER_PHASE_LAUNCH
#define MK_PER_PHASE_LAUNCH 0
#endif

#ifndef MLA_QL
#define MLA_QL 0
#endif
#ifndef GQA_QL
#define GQA_QL 0
#endif
#ifndef QKT_GRP
#define QKT_GRP 12
#endif
#ifndef EB
#define EB 4
#endif
#ifndef MLA_SD
#define MLA_SD 1
#endif
#ifndef GQA_SD
#define GQA_SD 2
#endif
#ifndef ATT_SEL
#define ATT_SEL 3
#endif
#ifndef PH_DOUBLE
#define PH_DOUBLE 0u
#endif
#ifndef PH_MASK
#define PH_MASK 0xFFFFFFFFu
#endif
#define LAS __attribute__((address_space(3)))
typedef unsigned short bf16_t;
typedef short bf16x8 __attribute__((ext_vector_type(8)));
typedef short s16x4 __attribute__((ext_vector_type(4)));
typedef float f32x4 __attribute__((ext_vector_type(4)));
typedef float f32x2 __attribute__((ext_vector_type(2)));
typedef float f32x16 __attribute__((ext_vector_type(16)));
typedef unsigned u32x4 __attribute__((ext_vector_type(4)));
typedef unsigned u32x2 __attribute__((ext_vector_type(2)));
typedef __bf16 bf16x2_t __attribute__((ext_vector_type(2)));

constexpr int DM = 2048, NB = 2, SEQ = 8192, DEPTH = 4, CTXL = 256;
constexpr int TL = NB * SEQ;
constexpr int TZ = NB * CTXL;
constexpr int TT = TL + TZ;
constexpr int KPB = SEQ + CTXL;
constexpr int AB_IN = 4416, AB_INP = 4608;
constexpr int C_IN = 3072;
constexpr int NEXP = 16384;
constexpr float EPS = 1e-6f;
constexpr float LOG2E = 1.4426950408889634f;

constexpr size_t al256(size_t x) { return (x + 255) / 256 * 256; }
constexpr size_t WS_CTL = 0, CTL_BYTES = 1u << 20;
constexpr size_t WS_MOD = WS_CTL + CTL_BYTES;
constexpr size_t WS_TAB16 = WS_MOD + al256((size_t)4 * 3 * 12288 * 4);
constexpr size_t WS_TAB32 = WS_TAB16 + al256((size_t)128 * 16 * 2 * 4);
constexpr size_t WS_LAM = WS_TAB32 + al256((size_t)128 * 32 * 2 * 4);
constexpr size_t WS_WINAB = WS_LAM + 256;
constexpr size_t WS_WUQ = WS_WINAB + (size_t)2 * AB_INP * DM * 2;
constexpr size_t WS_WUKV = WS_WUQ + (size_t)2 * 1536 * 768 * 2;
constexpr size_t WS_WOUTAB = WS_WUKV + (size_t)2 * 2048 * 512 * 2;
constexpr size_t WS_WINC = WS_WOUTAB + (size_t)2 * DM * DM * 2;
constexpr size_t WS_WOUTC = WS_WINC + (size_t)2 * C_IN * DM * 2;
constexpr size_t WS_WPQ = WS_WOUTC + (size_t)2 * DM * DM * 2;
constexpr size_t WS_SUBK = WS_WPQ + (size_t)4 * DM * DM * 2;
constexpr size_t WS_EU = WS_SUBK + (size_t)4 * 8 * 2 * 128 * 128 * 2;
constexpr int EROW = DM * 6 / 8;
constexpr size_t WS_EV = WS_EU + (size_t)4 * NEXP * DM;
constexpr size_t WS_SU = WS_EV + (size_t)4 * NEXP * DM;
constexpr size_t WS_SV = WS_SU + (size_t)4 * NEXP * 4;
constexpr size_t WS_X = WS_SV + (size_t)4 * NEXP * 4;
constexpr size_t WS_H = WS_X + (size_t)TT * DM * 4;
constexpr size_t WS_P1 = WS_H + (size_t)TT * DM * 2;
constexpr size_t WS_QA = WS_P1 + (size_t)TT * AB_INP * 2;
constexpr size_t WS_KV = WS_QA + (size_t)TT * 1536 * 2;
constexpr size_t WS_Q1 = WS_KV + (size_t)TT * 2048 * 2;
constexpr size_t WS_K1 = WS_Q1 + (size_t)TT * 2048 * 2;
constexpr size_t WS_V1 = WS_K1 + (size_t)TT * 1536 * 2;
constexpr size_t WS_Q2 = WS_V1 + (size_t)TT * 1024 * 2;
constexpr size_t WS_K2 = WS_Q2 + (size_t)TT * 1024 * 2;
constexpr size_t WS_V2 = WS_K2 + (size_t)TT * 1024 * 2;
constexpr size_t WS_OF = WS_V2 + (size_t)TT * 1024 * 2;
constexpr size_t WS_AO = WS_OF + (size_t)TT * 3072 * 4;
constexpr size_t WS_PQ = WS_AO + (size_t)TT * DM * 2;
constexpr size_t WS_PIDX = WS_PQ + (size_t)TT * DM * 2;
constexpr size_t WS_PG = WS_PIDX + (size_t)TT * 128 * 4;
constexpr size_t WS_END = WS_PG + (size_t)TT * 128 * 4;

constexpr int LDS_MAIN = 157696;
constexpr int LDS_MISC = LDS_MAIN;
constexpr int LDS_BYTES = LDS_MAIN + 4096;

__device__ __forceinline__ unsigned cvt_pk_bf16(float lo, float hi) { unsigned r; asm("v_cvt_pk_bf16_f32 %0, %1, %2" : "=v"(r) : "v"(lo), "v"(hi)); return r; }
__device__ __forceinline__ float bf_lo(unsigned w) { return __uint_as_float(w << 16); }
__device__ __forceinline__ float bf_hi(unsigned w) { return __uint_as_float(w & 0xffff0000u); }
template <int M> __device__ __forceinline__ float swz_xor(float v) { return __int_as_float(__builtin_amdgcn_ds_swizzle(__float_as_int(v), (M << 10) | 0x1f)); }
__device__ __forceinline__ float xor32_partner(float v, int lane) {
    const auto rr = __builtin_amdgcn_permlane32_swap(__float_as_uint(v), __float_as_uint(v), false, false);
    return __uint_as_float(lane < 32 ? rr[1] : rr[0]);
}
__device__ __forceinline__ float hw_sum(float v) {
    v += swz_xor<16>(v); v += swz_xor<8>(v); v += swz_xor<4>(v); v += swz_xor<2>(v); v += swz_xor<1>(v);
    return v;
}
__device__ __forceinline__ float wave_sum(float v) {
    v = hw_sum(v);
    const auto rr = __builtin_amdgcn_permlane32_swap(__float_as_uint(v), __float_as_uint(v), false, false);
    return __uint_as_float(rr[0]) + __uint_as_float(rr[1]);
}
__device__ __forceinline__ float wave_max(float v) {
    v = fmaxf(v, swz_xor<16>(v)); v = fmaxf(v, swz_xor<8>(v)); v = fmaxf(v, swz_xor<4>(v)); v = fmaxf(v, swz_xor<2>(v)); v = fmaxf(v, swz_xor<1>(v));
    const auto rr = __builtin_amdgcn_permlane32_swap(__float_as_uint(v), __float_as_uint(v), false, false);
    return fmaxf(__uint_as_float(rr[0]), __uint_as_float(rr[1]));
}
__device__ __forceinline__ int mbcnt64(unsigned long long m) { return (int)__builtin_amdgcn_mbcnt_hi((unsigned)(m >> 32), __builtin_amdgcn_mbcnt_lo((unsigned)m, 0u)); }
__device__ __forceinline__ int fresh_lane() { int l; asm volatile("v_mbcnt_lo_u32_b32 %0, -1, 0\n\tv_mbcnt_hi_u32_b32 %0, -1, %0" : "=v"(l)); return l; }
__device__ __forceinline__ int krow_of(int t) { return t < TL ? (t >> 13) * KPB + (t & (SEQ - 1)) : ((t - TL) >> 8) * KPB + SEQ + ((t - TL) & (CTXL - 1)); }
__device__ __forceinline__ int vsel_of_row(int t) { return t < SEQ ? 0 : (t < TL ? 1 : 2); }

#define XB_TMO      128
#define XB_XCNT(j)  (256  + 64 * (j))
#define XB_XSUB(j)  (1280 + 64 * (j))
#define XB_XGEN(j)  (2304 + 64 * (j))
#define XB_TOP      3328
#define XB_TOPGEN   3392
#define XCD_BAR_WORDS 3456
#define XB_SPIN_CAP (1u << 27)
__device__ __forceinline__ unsigned xb_ld(unsigned* p)              { return __hip_atomic_load(p, __ATOMIC_RELAXED, __HIP_MEMORY_SCOPE_AGENT); }
__device__ __forceinline__ unsigned xb_add(unsigned* p, unsigned v) { return __hip_atomic_fetch_add(p, v, __ATOMIC_RELAXED, __HIP_MEMORY_SCOPE_AGENT); }
__device__ __forceinline__ unsigned xb_xcc_id() { return (unsigned)__builtin_amdgcn_s_getreg((3 << 11) | 20) & 0xFu; }
#define XB_SPIN(cond, bar) do { unsigned _sp = 0; while (cond) { __builtin_amdgcn_s_sleep(1); \
    if ((++_sp & 255u) == 0u) { if (xb_ld(&(bar)[XB_TMO])) break; if (_sp > XB_SPIN_CAP) { atomicAdd(&(bar)[XB_TMO], 1u); break; } } } } while (0)
struct XcdBarrier { unsigned* bar; unsigned x; volatile LAS unsigned* st; };
__device__ __forceinline__ XcdBarrier xcd_barrier_post(unsigned* bar, volatile LAS unsigned* st) {
    XcdBarrier b; b.bar = bar; b.x = xb_xcc_id(); b.st = st;
    if (threadIdx.x == 0) (void)xb_add(&bar[XB_XCNT(b.x)], 1u);
    return b;
}
__device__ __forceinline__ void xcd_barrier_complete(unsigned* bar, unsigned x, unsigned& nloc, unsigned& nx) {
    asm volatile("" : "+s"(x));
    const unsigned G = gridDim.x * gridDim.y * gridDim.z;
    unsigned sum, cnt, mine, sp = 0u;
    for (;;) {
        sum = 0u; cnt = 0u; mine = 0u;
#pragma unroll
        for (unsigned j = 0; j < 16; ++j) { const unsigned c = xb_ld(&bar[XB_XCNT(j)]); sum += c; cnt += (c > 0u) ? 1u : 0u; mine = (j == x) ? c : mine; }
        if (sum == G) break;
        __builtin_amdgcn_s_sleep(1);
        if ((++sp & 255u) == 0u) { if (xb_ld(&bar[XB_TMO])) break; if (sp > XB_SPIN_CAP) { atomicAdd(&bar[XB_TMO], 1u); break; } }
    }
    nloc = mine > 0u ? mine : 1u; nx = cnt > 0u ? cnt : 1u;
}
__device__ __forceinline__ void xcd_barrier(const XcdBarrier& b, const bool thread0  ) {
    asm volatile("s_waitcnt vmcnt(0)" ::: "memory");
    __syncthreads();
    if (thread0) {
        unsigned* bar = b.bar;
        __builtin_amdgcn_s_waitcnt(0);
        unsigned nloc = b.st[0], nx = b.st[1];
        if (nloc == 0u) { xcd_barrier_complete(bar, b.x, nloc, nx); b.st[0] = nloc; b.st[1] = nx; }
        const unsigned old = xb_add(&bar[XB_XSUB(b.x)], 1u);
        const unsigned gen = old / nloc;
        if (old + 1u == (gen + 1u) * nloc) {
            __builtin_amdgcn_fence(__ATOMIC_RELEASE, "agent");
            asm volatile("s_waitcnt vmcnt(0)" ::: "memory");
            const unsigned og = xb_add(&bar[XB_TOP], 1u);
            const unsigned tg = og / nx;
            if (og + 1u == (tg + 1u) * nx) xb_add(&bar[XB_TOPGEN], 1u);
            else XB_SPIN(xb_ld(&bar[XB_TOPGEN]) == tg, bar);
            __builtin_amdgcn_fence(__ATOMIC_ACQUIRE, "agent");
            xb_add(&bar[XB_XGEN(b.x)], 1u);
            asm volatile("s_waitcnt vmcnt(0)" ::: "memory");
        } else {
            XB_SPIN(xb_ld(&bar[XB_XGEN(b.x)]) == gen, bar);
            __builtin_amdgcn_fence(__ATOMIC_ACQUIRE, "agent");
            asm volatile("s_waitcnt vmcnt(0)" ::: "memory");
        }
    }
    __syncthreads();
}

namespace pg8 {
constexpr int BM = 256, BK = 64, HALF = 128, HTB = HALF * BK * 2, STAGE_BYTES = 8 * HTB, NXCD = 8, WGM = 8;
__host__ __device__ __forceinline__ int lds_byte(int r, int c) { const int st = (r >> 4) * 2 + (c >> 5), rr = r & 15, cc = c & 31, ob = rr * 64 + cc * 2; return st * 1024 + (ob ^ (((ob >> 9) & 1) << 5)); }
__host__ __device__ __forceinline__ void stage_rc(int b, int& R, int& C) { const int st = b / 1024, sb = b % 1024, swz = sb ^ (((sb >> 9) & 1) << 5); R = (st >> 1) * 16 + swz / 64; C = (st & 1) * 32 + (swz % 64) / 2; }
__host__ __device__ __forceinline__ int perm32(int rho) { const int n = rho >> 4, i = rho & 15; return 8 * (i >> 2) + 4 * n + (i & 3); }
struct Unit { int pm, pn; };
struct Gemm { const bf16_t* A; const bf16_t* Bt; int M, N, K, lda; };
struct StaticOrder {
    int nM, nN, nwg, G, c;
    __host__ __device__ void init(int M, int N, int G_, int c_) { nM = M / BM; nN = N / BM; nwg = nM * nN; G = G_; c = c_; }
    __host__ __device__ bool next(int i, Unit& u) const {
        const long L = (long)i * G + c; if (L >= nwg) return false;
        int wgid = (int)L; { const int q = nwg / NXCD, r = nwg % NXCD, xcd = wgid % NXCD, off = wgid / NXCD; wgid = (xcd < r ? xcd * (q + 1) : r * (q + 1) + (xcd - r) * q) + off; }
        const int nig = WGM * nN, gid = wgid / nig, fm = gid * WGM, gsz = (nM - fm) < WGM ? (nM - fm) : WGM;
        u.pm = fm + ((wgid % nig) % gsz); u.pn = (wgid % nig) / gsz; return true;
    }
    __device__ __forceinline__ void a_ready(const Unit&) const {}
    __device__ __forceinline__ void done(const Unit&) const {}
};
struct EpiBf16 {
    static constexpr bool PERM = true;
    bf16_t* O; int ldc;
    __device__ __forceinline__ void operator()(const f32x4 (&acc)[2][2][4][2], const Unit& u, int wr, int wc, int fr, int fq) const {
        const int row0 = u.pm * BM + wr * 64 + fr; const int col0 = u.pn * BM + wc * 32 + 8 * fq;
#pragma unroll
        for (int ai = 0; ai < 2; ++ai)
#pragma unroll
            for (int m = 0; m < 4; ++m) { bf16_t* rowp = O + (size_t)(row0 + ai * HALF + m * 16) * ldc + col0;
#pragma unroll
                for (int bj = 0; bj < 2; ++bj) { const f32x4 v0 = acc[ai][bj][m][0], v1 = acc[ai][bj][m][1];
                    u32x4 w; w.x = cvt_pk_bf16(v0[0], v0[1]); w.y = cvt_pk_bf16(v0[2], v0[3]); w.z = cvt_pk_bf16(v1[0], v1[1]); w.w = cvt_pk_bf16(v1[2], v1[3]);
                    *(u32x4*)(rowp + bj * HALF) = w; } }
    }
};
struct EpiResid {
    static constexpr bool PERM = false;
    float* X; const float* modl; int chunk;
    __device__ __forceinline__ void operator()(const f32x4 (&acc)[2][2][4][2], const Unit& u, int wr, int wc, int fr, int fq) const {
        const int row0 = u.pm * BM + wr * 64 + fr, col0 = u.pn * BM + wc * 32 + 4 * fq;
        const int vs = u.pm < 32 ? 0 : (u.pm < 64 ? 1 : 2);
        const float* gate = modl + (size_t)vs * 12288 + chunk * 2048 + col0;
        f32x4 gv[2][2];
#pragma unroll
        for (int bj = 0; bj < 2; ++bj)
#pragma unroll
            for (int n = 0; n < 2; ++n) gv[bj][n] = *(const f32x4*)(gate + bj * HALF + n * 16);
#pragma unroll
        for (int ai = 0; ai < 2; ++ai)
#pragma unroll
            for (int m = 0; m < 4; ++m) { float* rowp = X + (size_t)(row0 + ai * HALF + m * 16) * DM + col0;
#pragma unroll
                for (int bj = 0; bj < 2; ++bj)
#pragma unroll
                    for (int n = 0; n < 2; ++n) { float* p = rowp + bj * HALF + n * 16; const f32x4 xo = *(const f32x4*)p; *(f32x4*)p = xo + gv[bj][n] * acc[ai][bj][m][n]; } }
    }
};

template <class Epi, class Sched>
__device__ __forceinline__ void gemm_phase(LAS unsigned char* lds, const Gemm g, const Sched& S, const Epi& E, int tid_in) {
    const int tid_l = tid_in * 64 + fresh_lane();
    const int tid = tid_l, wid = tid_in  , lane = tid & 63, wr = wid >> 2, wc = wid & 3, fr = lane & 15, fq = lane >> 4;
    const int K = g.K, nt = K / BK, lda = g.lda;
    unsigned voffA[2], voffB[2];
#pragma unroll
    for (int i = 0; i < 2; ++i) { int R, C; stage_rc(tid * 16 + i * 8192, R, C); const int Rb = Epi::PERM ? ((R & ~31) + perm32(R & 31)) : R;
        voffA[i] = (unsigned)(R * lda + C) * 2u; voffB[i] = (unsigned)(Rb * K + C) * 2u; }
    const size_t kstep = (size_t)(BK * 2);
    const size_t hstepA = (size_t)HALF * lda * 2, hstepB = (size_t)HALF * K * 2;
    const size_t tstepA = 2 * hstepA, tstepB = 2 * hstepB;
    const unsigned ldsw = (unsigned)wid * 1024u;
    const int aoff = lds_byte(wr * 64 + fr, fq * 8), boff = lds_byte(wc * 32 + fr, fq * 8);
#define PG8_SA(b, h) (((b) * 2 + (h)) * HTB)
#define PG8_SB(b, h) ((4 + (b) * 2 + (h)) * HTB)
#define PG8_STAGE(bufoff, gbase, voff) do { _Pragma("unroll") for (int _i = 0; _i < 2; ++_i) \
        __builtin_amdgcn_global_load_lds((const unsigned*)((const char*)(gbase) + (voff)[_i]), (LAS unsigned*)(lds + (bufoff) + ldsw + _i * 8192), 16, 0, 0); } while (0)
#define PG8_LDA(dst, b, h) do { _Pragma("unroll") for (int m = 0; m < 4; ++m) _Pragma("unroll") for (int k = 0; k < 2; ++k) dst[m][k] = *(const LAS bf16x8*)(lds + PG8_SA(b, h) + aoff + m * 2048 + k * 1024); } while (0)
#define PG8_LDB(dst, b, h) do { _Pragma("unroll") for (int n = 0; n < 2; ++n) _Pragma("unroll") for (int k = 0; k < 2; ++k) dst[n][k] = *(const LAS bf16x8*)(lds + PG8_SB(b, h) + boff + n * 2048 + k * 1024); } while (0)
#define PG8_MMA(ai, bj, At, Bt) do { __builtin_amdgcn_s_setprio(1); _Pragma("unroll") for (int m = 0; m < 4; ++m) _Pragma("unroll") for (int n = 0; n < 2; ++n) _Pragma("unroll") for (int k = 0; k < 2; ++k) \
        acc[ai][bj][m][n] = __builtin_amdgcn_mfma_f32_16x16x32_bf16(Bt[n][k], At[m][k], acc[ai][bj][m][n], 0, 0, 0); __builtin_amdgcn_s_setprio(0); } while (0)
#define PG8_WAIT_V(n) asm volatile("s_waitcnt vmcnt(" #n ")" ::: "memory")
#define PG8_WAIT_L(n) asm volatile("s_waitcnt lgkmcnt(" #n ")" ::: "memory")
#define PG8_BAR __builtin_amdgcn_s_barrier()
#define PG8_SCHED __builtin_amdgcn_sched_barrier(0)
    Unit cur, nxt; int ui = 0;
    if (!S.next(0, cur)) return;
    f32x4 acc[2][2][4][2];
#pragma unroll
    for (int a = 0; a < 2; ++a)
#pragma unroll
        for (int b = 0; b < 2; ++b)
#pragma unroll
            for (int m = 0; m < 4; ++m)
#pragma unroll
                for (int n = 0; n < 2; ++n) acc[a][b][m][n] = (f32x4){0.f, 0.f, 0.f, 0.f};
    bf16x8 At[4][2], B0[2][2], B1[2][2];
    const char* cA = (const char*)g.A + (size_t)cur.pm * tstepA; const char* cB = (const char*)g.Bt + (size_t)cur.pn * tstepB;
    S.a_ready(cur);
    PG8_STAGE(PG8_SB(0, 0), cB, voffB); PG8_STAGE(PG8_SA(0, 0), cA, voffA); PG8_STAGE(PG8_SB(0, 1), cB + hstepB, voffB); PG8_STAGE(PG8_SA(0, 1), cA + hstepA, voffA);
    if (wr == 1) PG8_BAR;
    PG8_WAIT_V(4); PG8_BAR;
    PG8_STAGE(PG8_SB(1, 0), cB + kstep, voffB); PG8_STAGE(PG8_SA(1, 0), cA + kstep, voffA); PG8_STAGE(PG8_SB(1, 1), cB + hstepB + kstep, voffB);
    PG8_WAIT_V(6); PG8_BAR;
    for (;;) {
        const bool has_next = S.next(ui + 1, nxt);
        const char* nA = has_next ? (const char*)g.A + (size_t)nxt.pm * tstepA : cA; const char* nB = has_next ? (const char*)g.Bt + (size_t)nxt.pn * tstepB : cB;
        for (int t = 0; t < nt; t += 2) {
            const bool last = (t == nt - 2);
            const char* a1 = cA + (size_t)(t + 1) * kstep;
            const char* a2 = last ? nA : cA + (size_t)(t + 2) * kstep; const char* b2 = last ? nB : cB + (size_t)(t + 2) * kstep;
            const char* a3 = a2 + kstep; const char* b3 = b2 + kstep;
            if (last && has_next) S.a_ready(nxt);
            PG8_LDB(B0, 0, 0); PG8_SCHED; PG8_LDA(At, 0, 0); PG8_STAGE(PG8_SA(1, 1), a1 + hstepA, voffA);
            PG8_WAIT_L(8); PG8_BAR; PG8_WAIT_L(0); PG8_MMA(0, 0, At, B0); PG8_BAR; PG8_SCHED;
            PG8_LDB(B1, 0, 1); PG8_STAGE(PG8_SB(0, 0), b2, voffB);
            PG8_BAR; PG8_WAIT_L(0); PG8_MMA(0, 1, At, B1); PG8_BAR;
            PG8_LDA(At, 0, 1); PG8_STAGE(PG8_SA(0, 0), a2, voffA);
            PG8_BAR; PG8_WAIT_L(0); PG8_MMA(1, 0, At, B0); PG8_BAR; PG8_SCHED;
            PG8_STAGE(PG8_SB(0, 1), b2 + hstepB, voffB);
            PG8_WAIT_V(6); PG8_BAR; PG8_MMA(1, 1, At, B1); PG8_BAR;
            PG8_LDB(B0, 1, 0); PG8_SCHED; PG8_LDA(At, 1, 0); PG8_STAGE(PG8_SA(0, 1), a2 + hstepA, voffA);
            PG8_WAIT_L(8); PG8_BAR; PG8_WAIT_L(0); PG8_MMA(0, 0, At, B0); PG8_BAR; PG8_SCHED;
            PG8_LDB(B1, 1, 1); PG8_STAGE(PG8_SB(1, 0), b3, voffB);
            PG8_BAR; PG8_WAIT_L(0); PG8_MMA(0, 1, At, B1); PG8_BAR;
            PG8_LDA(At, 1, 1); PG8_STAGE(PG8_SA(1, 0), a3, voffA);
            PG8_BAR; PG8_WAIT_L(0); PG8_MMA(1, 0, At, B0); PG8_BAR; PG8_SCHED;
            PG8_STAGE(PG8_SB(1, 1), b3 + hstepB, voffB);
            PG8_WAIT_V(6); PG8_BAR; PG8_MMA(1, 1, At, B1); PG8_BAR;
        }
        E(acc, cur, wr, wc, fr, fq); S.done(cur);
        if (!has_next) break;
#pragma unroll
        for (int a = 0; a < 2; ++a)
#pragma unroll
            for (int b = 0; b < 2; ++b)
#pragma unroll
                for (int m = 0; m < 4; ++m)
#pragma unroll
                    for (int n = 0; n < 2; ++n) acc[a][b][m][n] = (f32x4){0.f, 0.f, 0.f, 0.f};
        cur = nxt; cA = nA; cB = nB; ++ui;
    }
    PG8_WAIT_V(0);
    if (wr == 0) PG8_BAR;
    PG8_BAR;
#undef PG8_SA
#undef PG8_SB
#undef PG8_STAGE
#undef PG8_LDA
#undef PG8_LDB
#undef PG8_MMA
#undef PG8_WAIT_V
#undef PG8_WAIT_L
#undef PG8_BAR
#undef PG8_SCHED
}
}

namespace att {
constexpr int NW = 8, QBLK = 32, KVBLK = 64, DV = 128;
constexpr float THR = 8.f;
constexpr int SHM_V = KVBLK * DV * 2;
#define SBAR() __builtin_amdgcn_sched_barrier(0)
__device__ __forceinline__ int crow(int r, int hi) { return (r & 3) + 8 * (r >> 2) + 4 * hi; }
__device__ __forceinline__ unsigned cvtpk(float lo, float hi) { unsigned r; asm volatile("v_cvt_pk_bf16_f32 %0, %1, %2" : "=v"(r) : "v"(lo), "v"(hi)); return r; }
__device__ __forceinline__ void partialSM(f32x16& p0, f32x16& p1, float& m_reg, float& mn, float& alpha, const float C, const float thr_raw) {
    float pmax = p0[0];
#pragma unroll
    for (int r = 1; r < 16; ++r) pmax = fmaxf(pmax, p0[r]);
#pragma unroll
    for (int r = 0; r < 16; ++r) pmax = fmaxf(pmax, p1[r]);
    { auto rr = __builtin_amdgcn_permlane32_swap(__float_as_uint(pmax), __float_as_uint(pmax), false, false);
      pmax = fmaxf(__uint_as_float(rr[0]), __uint_as_float(rr[1])); }
    if (__builtin_expect(__all(pmax - m_reg <= thr_raw), 1)) { mn = m_reg; alpha = 1.f; }
    else { mn = fmaxf(m_reg, pmax); alpha = __builtin_amdgcn_exp2f((m_reg - mn) * C); m_reg = mn; }
    const float mnC = -mn * C;
#pragma unroll
    for (int r = 0; r < 16; ++r) p0[r] = fmaf(p0[r], C, mnC);
#pragma unroll
    for (int r = 0; r < 16; ++r) p1[r] = fmaf(p1[r], C, mnC);
#pragma unroll
    for (int r = 0; r < 16; ++r) p0[r] = __builtin_amdgcn_exp2f(p0[r]);
}
__device__ __forceinline__ void finishSM(f32x16& p0, f32x16& p1, float alpha, float& l_reg, bf16x8& pa0, bf16x8& pa1, bf16x8& pa2, bf16x8& pa3) {
#pragma unroll
    for (int r = 0; r < 16; ++r) p1[r] = __builtin_amdgcn_exp2f(p1[r]);
    float ps = 0;
#pragma unroll
    for (int r = 0; r < 16; ++r) ps += p0[r];
#pragma unroll
    for (int r = 0; r < 16; ++r) ps += p1[r];
    { auto rr = __builtin_amdgcn_permlane32_swap(__float_as_uint(ps), __float_as_uint(ps), false, false);
      ps = __uint_as_float(rr[0]) + __uint_as_float(rr[1]); }
    l_reg = l_reg * alpha + ps;
#define PK4(P, BASE, OUT) do { unsigned a0 = cvtpk(P[BASE + 0], P[BASE + 1]), a1 = cvtpk(P[BASE + 2], P[BASE + 3]);   \
    unsigned b0 = cvtpk(P[BASE + 4], P[BASE + 5]), b1 = cvtpk(P[BASE + 6], P[BASE + 7]);                              \
    auto r0 = __builtin_amdgcn_permlane32_swap(a0, b0, false, false); auto r1 = __builtin_amdgcn_permlane32_swap(a1, b1, false, false); \
    u32x4 w = {r0[0], r1[0], r0[1], r1[1]}; OUT = *reinterpret_cast<bf16x8*>(&w); } while (0)
    PK4(p0, 0, pa0); PK4(p0, 8, pa1); PK4(p1, 0, pa2); PK4(p1, 8, pa3);
#undef PK4
}
template <int DQK, int QL>
__device__ __forceinline__ void qkt(f32x16& p0, f32x16& p1, const char* Ks, const bf16x8 (&qr)[DQK / 16 - QL], const char* qpark, int r32, int hi) {
    constexpr int RS = DQK * 2 + 16, NQR = DQK / 16 - QL, GRP = (DQK > 128) ? QKT_GRP : DQK / 16;
    p0 = f32x16{}; p1 = f32x16{};
#pragma unroll
    for (int g0 = 0; g0 < DQK / 16; g0 += GRP) {
#pragma unroll
        for (int d0 = g0; d0 < g0 + GRP; ++d0) { const int cb = (d0 * 16 + hi * 8) * 2;
            const bf16x8 b0 = *reinterpret_cast<const bf16x8*>(Ks + r32 * RS + cb);
            const bf16x8 b1 = *reinterpret_cast<const bf16x8*>(Ks + (32 + r32) * RS + cb);
            bf16x8 qf; if (d0 < NQR) qf = qr[d0 < NQR ? d0 : 0]; else qf = *reinterpret_cast<const bf16x8*>(qpark + (d0 - NQR) * 1024);
            p0 = __builtin_amdgcn_mfma_f32_32x32x16_bf16(b0, qf, p0, 0, 0, 0);
            p1 = __builtin_amdgcn_mfma_f32_32x32x16_bf16(b1, qf, p1, 0, 0, 0); }
        if (g0 + GRP < DQK / 16) SBAR();
    }
}
__device__ __forceinline__ int v_st(int k, int c) { const int kk = (k & ~0xC) | ((k & 4) << 1) | ((k & 8) >> 1); return ((kk >> 3) * 4 + (c >> 5)) * 512 + ((kk & 7) * 32 + (c & 31)) * 2; }
__device__ __forceinline__ int v_rd_base(int lane) { return ((lane & 3) << 3) | (((lane >> 2) & 3) << 6) | (((lane >> 4) & 1) << 5) | (((lane >> 5) & 1) << 8); }
constexpr int v_rd_off(int d0, int ks, int half) { return d0 * 512 + ks * 4096 + half * 2048; }
template <int OFF> __device__ __forceinline__ s16x4 tr_read(int vb) {
    s16x4 r; asm volatile("ds_read_b64_tr_b16 %0, %1 offset:%2" : "=&v"(r) : "v"(vb), "i"(OFF) : "memory"); return r;
}
template <int D0> __device__ __forceinline__ void pv_one(f32x16& od, int vb, bf16x8 pa0, bf16x8 pa1, bf16x8 pa2, bf16x8 pa3) {
    const s16x4 l0 = tr_read<v_rd_off(D0, 0, 0)>(vb), h0 = tr_read<v_rd_off(D0, 0, 1)>(vb), l1 = tr_read<v_rd_off(D0, 1, 0)>(vb), h1 = tr_read<v_rd_off(D0, 1, 1)>(vb);
    const s16x4 l2 = tr_read<v_rd_off(D0, 2, 0)>(vb), h2 = tr_read<v_rd_off(D0, 2, 1)>(vb), l3 = tr_read<v_rd_off(D0, 3, 0)>(vb), h3 = tr_read<v_rd_off(D0, 3, 1)>(vb);
    asm volatile("s_waitcnt lgkmcnt(0)" ::: "memory"); SBAR();
#define PK(L, H) (bf16x8){L[0], L[1], L[2], L[3], H[0], H[1], H[2], H[3]}
    od = __builtin_amdgcn_mfma_f32_32x32x16_bf16(pa0, PK(l0, h0), od, 0, 0, 0);
    od = __builtin_amdgcn_mfma_f32_32x32x16_bf16(pa1, PK(l1, h1), od, 0, 0, 0);
    od = __builtin_amdgcn_mfma_f32_32x32x16_bf16(pa2, PK(l2, h2), od, 0, 0, 0);
    od = __builtin_amdgcn_mfma_f32_32x32x16_bf16(pa3, PK(l3, h3), od, 0, 0, 0);
#undef PK
}
__device__ __forceinline__ void pv_d0(f32x16* o, int vb, bf16x8 pa0, bf16x8 pa1, bf16x8 pa2, bf16x8 pa3) {
    pv_one<0>(o[0], vb, pa0, pa1, pa2, pa3); pv_one<1>(o[1], vb, pa0, pa1, pa2, pa3); pv_one<2>(o[2], vb, pa0, pa1, pa2, pa3); pv_one<3>(o[3], vb, pa0, pa1, pa2, pa3);
}
template <int DQK> struct ScaleOf { static constexpr float scale = DQK == 192 ? 0.07216878364870322f : (DQK == 128 ? 0.08838834764831845f : 0.125f); };
template <int DQK, int SDEPTH, int QL, int ldq, int ldk, int ldv, int ldo>
__device__ __forceinline__ void attn_body(const bf16_t* __restrict__ Qb, const bf16_t* __restrict__ Kh, const bf16_t* __restrict__ Vh,
                                          bf16_t* __restrict__ Ob, int seq, char* lds, int tid_in) {
    constexpr float C = ScaleOf<DQK>::scale * 1.4426950408889634f, thr_raw = THR / ScaleOf<DQK>::scale;
    constexpr int RS = DQK * 2 + 16  , SHM_K = KVBLK * RS, NKP = DQK / 64, KPR = DQK / 8;
    const int tid_l = tid_in * 64 + fresh_lane();
    const int tid = tid_l, wid = tid_in  , lane = tid & 63, r32 = lane & 31, hi = lane >> 5;
    char* V_lds = lds; char* K_lds = lds + 2 * SHM_V;
    float* ws = (float*)(lds + 2 * SHM_V + 2 * SHM_K) + wid * 64; float* li_l = ws; float* al_l = ws + 32;
    constexpr int NQR = DQK / 16 - QL;
    char* qpark = lds + 2 * SHM_V + 2 * SHM_K + 2048 + wid * (QL * 1024) + lane * 16;
    float m_reg = -1e30f, l_reg = 0; f32x16 o[4] = {}; bf16x8 qr[NQR];
    const bf16_t* Qw = Qb + (size_t)(wid * QBLK + r32) * ldq + hi * 8;
#pragma unroll
    for (int d0 = 0; d0 < NQR; ++d0) qr[d0] = *reinterpret_cast<const bf16x8*>(Qw + d0 * 16);
#pragma unroll
    for (int d0 = 0; d0 < QL; ++d0) *(bf16x8*)(qpark + d0 * 1024) = *reinterpret_cast<const bf16x8*>(Qw + (NQR + d0) * 16);
    const int sr = tid >> 4, sc = (tid & 15) * 8, vst0 = v_st(sr, sc), vst1 = v_st(32 + sr, sc);
    int koff[NKP], klds[NKP];
#pragma unroll
    for (int i = 0; i < NKP; ++i) { const int row = tid >> 3, c8 = (tid & 7) + 8 * i; koff[i] = row * ldk + c8 * 8; klds[i] = row * RS + c8 * 16; }
    const int vb0 = (int)(uintptr_t)V_lds + v_rd_base(lane);
    bf16x8 sv0[SDEPTH], sv1[SDEPTH], sk[SDEPTH][NKP];
#define SLOAD(i, k0) do { sv0[i] = *reinterpret_cast<const bf16x8*>(&Vh[(size_t)((k0) + sr) * ldv + sc]); sv1[i] = *reinterpret_cast<const bf16x8*>(&Vh[(size_t)((k0) + 32 + sr) * ldv + sc]); \
    _Pragma("unroll") for (int _q = 0; _q < NKP; ++_q) sk[i][_q] = *reinterpret_cast<const bf16x8*>(&Kh[(size_t)(k0) * ldk + koff[_q]]); } while (0)
#define SWRITE(b, i) do { *(bf16x8*)(V_lds + (b) * SHM_V + vst0) = sv0[i]; *(bf16x8*)(V_lds + (b) * SHM_V + vst1) = sv1[i]; \
    _Pragma("unroll") for (int _q = 0; _q < NKP; ++_q) *(bf16x8*)(K_lds + (b) * SHM_K + klds[_q]) = sk[i][_q]; } while (0)
#define SWAIT() do { if constexpr (SDEPTH == 2) { if constexpr (NKP == 1) asm volatile("s_waitcnt vmcnt(3)" ::: "memory"); else if constexpr (NKP == 2) asm volatile("s_waitcnt vmcnt(4)" ::: "memory"); else asm volatile("s_waitcnt vmcnt(5)" ::: "memory"); } \
    else asm volatile("s_waitcnt vmcnt(0)" ::: "memory"); } while (0)
#define RESC(a) do { if (__any((a) < 1.f)) { if (hi == 0) al_l[r32] = (a); asm volatile("s_waitcnt lgkmcnt(0)" ::: "memory"); \
    _Pragma("unroll") for (int d = 0; d < 4; ++d) _Pragma("unroll") for (int r = 0; r < 16; ++r) o[d][r] *= al_l[crow(r, hi)]; } } while (0)
    f32x16 pA0, pA1, pB0, pB1; float mnA, mnB, alA, alB; bf16x8 pa0, pa1, pa2, pa3; const int NT = seq / KVBLK;
    constexpr int SE = 0, SO = SDEPTH - 1;
    SLOAD(SE, 0); asm volatile("s_waitcnt vmcnt(0)" ::: "memory"); SWRITE(0, SE); __syncthreads();
    qkt<DQK, QL>(pA0, pA1, K_lds, qr, qpark, r32, hi); partialSM(pA0, pA1, m_reg, mnA, alA, C, thr_raw);
    SLOAD(SO, KVBLK); if constexpr (SDEPTH == 2) { if (2 < NT) SLOAD(SE, 2 * KVBLK); }
    SWAIT(); SWRITE(1, SO); __syncthreads();
    for (int j = 1; j + 1 < NT; j += 2) {
        SBAR(); qkt<DQK, QL>(pB0, pB1, K_lds + SHM_K, qr, qpark, r32, hi);
        finishSM(pA0, pA1, alA, l_reg, pa0, pa1, pa2, pa3); SBAR();
        SLOAD(SO, (j + SDEPTH) * KVBLK); SBAR();
        pv_d0(o, vb0, pa0, pa1, pa2, pa3); partialSM(pB0, pB1, m_reg, mnB, alB, C, thr_raw);
        __syncthreads(); SWAIT(); SWRITE(0, SE);
        RESC(alB); __syncthreads();
        SBAR(); qkt<DQK, QL>(pA0, pA1, K_lds, qr, qpark, r32, hi);
        finishSM(pB0, pB1, alB, l_reg, pa0, pa1, pa2, pa3); SBAR();
        if (SDEPTH == 1 || j + 3 < NT) SLOAD(SE, (j + 1 + SDEPTH) * KVBLK); SBAR();
        pv_d0(o, vb0 + SHM_V, pa0, pa1, pa2, pa3); partialSM(pA0, pA1, m_reg, mnA, alA, C, thr_raw);
        __syncthreads(); SWAIT(); SWRITE(1, SO);
        RESC(alA); __syncthreads();
    }
    SBAR(); qkt<DQK, QL>(pB0, pB1, K_lds + SHM_K, qr, qpark, r32, hi);
    finishSM(pA0, pA1, alA, l_reg, pa0, pa1, pa2, pa3); SBAR();
    pv_d0(o, vb0, pa0, pa1, pa2, pa3); partialSM(pB0, pB1, m_reg, mnB, alB, C, thr_raw);
    __syncthreads(); RESC(alB);
    finishSM(pB0, pB1, alB, l_reg, pa0, pa1, pa2, pa3); SBAR();
    pv_d0(o, vb0 + SHM_V, pa0, pa1, pa2, pa3);
    if (hi == 0) li_l[r32] = l_reg; asm volatile("s_waitcnt lgkmcnt(0)" ::: "memory");
    float rli[16];
#pragma unroll
    for (int r = 0; r < 16; ++r) rli[r] = __builtin_amdgcn_rcpf(li_l[crow(r, hi)]);
    bf16_t* Ow = Ob + (size_t)(wid * QBLK) * ldo + (r32 & ~1);
    const bool odd = (r32 & 1) != 0;
#pragma unroll
    for (int r = 0; r < 16; r += 2) { const int orow = crow(r, hi) + (odd ? 1 : 0);
#pragma unroll
        for (int d0 = 0; d0 < 4; ++d0) { const float a = o[d0][r] * rli[r], b = o[d0][r + 1] * rli[r + 1];
            const float recv = swz_xor<1>(odd ? a : b);
            const unsigned w = odd ? cvtpk(recv, b) : cvtpk(a, recv);
            *(unsigned*)(Ow + (size_t)orow * ldo + d0 * 32) = w; } }
    __syncthreads();
#undef SLOAD
#undef SWRITE
#undef SWAIT
#undef RESC
}
template <int DQK, int QL, int ldq, int ldk, int ldv, int ldo>
__device__ __forceinline__ void attn_body_simple(const bf16_t* __restrict__ Qb, const bf16_t* __restrict__ Kh, const bf16_t* __restrict__ Vh,
                                                 bf16_t* __restrict__ Ob, int seq, char* lds, int tid_in) {
    constexpr float C = ScaleOf<DQK>::scale * 1.4426950408889634f, thr_raw = THR / ScaleOf<DQK>::scale;
    constexpr int RS = DQK * 2 + 16  , SHM_K = KVBLK * RS, NKP = DQK / 64, KPR = DQK / 8;
    const int tid_l = tid_in * 64 + fresh_lane();
    const int tid = tid_l, wid = tid_in  , lane = tid & 63, r32 = lane & 31, hi = lane >> 5;
    char* V_lds = lds; char* K_lds = lds + 2 * SHM_V;
    float* ws = (float*)(lds + 2 * SHM_V + 2 * SHM_K) + wid * 64; float* li_l = ws; float* al_l = ws + 32;
    constexpr int NQR = DQK / 16 - QL;
    char* qpark = lds + 2 * SHM_V + 2 * SHM_K + 2048 + wid * (QL * 1024) + lane * 16;
    float m_reg = -1e30f, l_reg = 0; f32x16 o[4] = {}; bf16x8 qr[NQR];
    const bf16_t* Qw = Qb + (size_t)(wid * QBLK + r32) * ldq + hi * 8;
#pragma unroll
    for (int d0 = 0; d0 < NQR; ++d0) qr[d0] = *reinterpret_cast<const bf16x8*>(Qw + d0 * 16);
#pragma unroll
    for (int d0 = 0; d0 < QL; ++d0) *(bf16x8*)(qpark + d0 * 1024) = *reinterpret_cast<const bf16x8*>(Qw + (NQR + d0) * 16);
    const int sr = tid >> 4, sc = (tid & 15) * 8, vst0 = v_st(sr, sc), vst1 = v_st(32 + sr, sc);
    int koff[NKP], klds[NKP];
#pragma unroll
    for (int i = 0; i < NKP; ++i) { const int row = tid >> 3, c8 = (tid & 7) + 8 * i; koff[i] = row * ldk + c8 * 8; klds[i] = row * RS + c8 * 16; }
    const int vb0 = (int)(uintptr_t)V_lds + v_rd_base(lane);
    bf16x8 sv0, sv1, sk[NKP];
#define SLOAD(k0) do { sv0 = *reinterpret_cast<const bf16x8*>(&Vh[(size_t)((k0) + sr) * ldv + sc]); sv1 = *reinterpret_cast<const bf16x8*>(&Vh[(size_t)((k0) + 32 + sr) * ldv + sc]); \
    _Pragma("unroll") for (int _q = 0; _q < NKP; ++_q) sk[_q] = *reinterpret_cast<const bf16x8*>(&Kh[(size_t)(k0) * ldk + koff[_q]]); } while (0)
#define SWRITE(b) do { *(bf16x8*)(V_lds + (b) * SHM_V + vst0) = sv0; *(bf16x8*)(V_lds + (b) * SHM_V + vst1) = sv1; \
    _Pragma("unroll") for (int _q = 0; _q < NKP; ++_q) *(bf16x8*)(K_lds + (b) * SHM_K + klds[_q]) = sk[_q]; } while (0)
#define RESC(a) do { if (__any((a) < 1.f)) { if (hi == 0) al_l[r32] = (a); asm volatile("s_waitcnt lgkmcnt(0)" ::: "memory"); \
    _Pragma("unroll") for (int d = 0; d < 4; ++d) _Pragma("unroll") for (int r = 0; r < 16; ++r) o[d][r] *= al_l[crow(r, hi)]; } } while (0)
    const int NT = seq / KVBLK;
    SLOAD(0); asm volatile("s_waitcnt vmcnt(0)" ::: "memory"); SWRITE(0); __syncthreads();
    for (int j = 0; j < NT; ++j) {
        const int b = j & 1;
        if (j + 1 < NT) SLOAD((j + 1) * KVBLK);
        SBAR();
        f32x16 p0, p1; float mn, al; bf16x8 pa0, pa1, pa2, pa3;
        { const char* Ks = K_lds + b * SHM_K; p0 = f32x16{}; p1 = f32x16{};
#pragma unroll
          for (int d0 = 0; d0 < DQK / 16; ++d0) { const int cb = (d0 * 16 + hi * 8) * 2;
              const bf16x8 b0 = *reinterpret_cast<const bf16x8*>(Ks + r32 * RS + cb);
              const bf16x8 b1 = *reinterpret_cast<const bf16x8*>(Ks + (32 + r32) * RS + cb);
              bf16x8 qf; if (d0 < NQR) qf = qr[d0 < NQR ? d0 : 0]; else qf = *(const bf16x8*)(qpark + (d0 - NQR) * 1024);
              p0 = __builtin_amdgcn_mfma_f32_32x32x16_bf16(b0, qf, p0, 0, 0, 0);
              p1 = __builtin_amdgcn_mfma_f32_32x32x16_bf16(b1, qf, p1, 0, 0, 0); } }
        partialSM(p0, p1, m_reg, mn, al, C, thr_raw);
        RESC(al);
        finishSM(p0, p1, al, l_reg, pa0, pa1, pa2, pa3); SBAR();
        pv_d0(o, vb0 + b * SHM_V, pa0, pa1, pa2, pa3);
        if (j + 1 < NT) { asm volatile("s_waitcnt vmcnt(0)" ::: "memory"); SWRITE(b ^ 1); }
        __syncthreads();
    }
    if (hi == 0) li_l[r32] = l_reg; asm volatile("s_waitcnt lgkmcnt(0)" ::: "memory");
    float rli[16];
#pragma unroll
    for (int r = 0; r < 16; ++r) rli[r] = __builtin_amdgcn_rcpf(li_l[crow(r, hi)]);
    bf16_t* Ow = Ob + (size_t)(wid * QBLK) * ldo + (r32 & ~1);
    const bool odd = (r32 & 1) != 0;
#pragma unroll
    for (int r = 0; r < 16; r += 2) { const int orow = crow(r, hi) + (odd ? 1 : 0);
#pragma unroll
        for (int d0 = 0; d0 < 4; ++d0) { const float a = o[d0][r] * rli[r], b = o[d0][r + 1] * rli[r + 1];
            const float recv = swz_xor<1>(odd ? a : b);
            const unsigned w = odd ? cvtpk(recv, b) : cvtpk(a, recv);
            *(unsigned*)(Ow + (size_t)orow * ldo + d0 * 32) = w; } }
    __syncthreads();
#undef SLOAD
#undef SWRITE
#undef RESC
}
}

struct Params {
    const float* x; const float* c; const float* ctx; const float* c_ctx; const float* w_mod; const float* b_mod; const float* g_norm1; const float* g_norm2;
    const float* w_in_ab; const float* g_cq; const float* w_uq; const float* g_ckv; const float* w_ukv; const float* g_qn_a; const float* g_kn_a; const float* lam_vec;
    const float* g_qn_b; const float* g_kn_b; const float* g_sub_b; const float* w_out_ab; const float* w_in_c; const float* g_qn_c; const float* g_kn_c; const float* w_out_c;
    const float* w_pq; const float* sub_keys; const float* expert_u; const float* expert_v;
    float* out; unsigned char* ws; int ph_lo, ph_hi;
};

typedef const __attribute__((address_space(4))) Params CParams;
struct Ctx {
    int tid, lane, wid, G, vcu, bx;
    unsigned char* ws; char* lds;
};

__device__ __forceinline__ void tconv(const Ctx& F, const float* src, bf16_t* dst, const float* gain, int nmat, int K, int N, int Npad) {
    float* tile = (float*)(F.lds + 32768);
    const int ntn = Npad / 64, ntk = K / 64, per = ntn * ntk, total = per * nmat;
    for (int it = F.vcu; it < total; it += F.G) {
        const int mat = it / per, rem = it % per, tn = rem / ntk, tk = rem % ntk, k0 = tk * 64, n0 = tn * 64;
        const float* s = src + (size_t)mat * K * N; bf16_t* d = dst + (size_t)mat * Npad * K;
        __syncthreads();
        { const int r = F.tid >> 4, c4 = (F.tid & 15) * 4;
#pragma unroll
          for (int i = 0; i < 2; ++i) { const int rr = r + i * 32; f32x4 v = (f32x4){0.f, 0.f, 0.f, 0.f};
              if (n0 + c4 < N) v = *(const f32x4*)(s + (size_t)(k0 + rr) * N + n0 + c4);
              tile[rr * 65 + c4 + 0] = v[0]; tile[rr * 65 + c4 + 1] = v[1]; tile[rr * 65 + c4 + 2] = v[2]; tile[rr * 65 + c4 + 3] = v[3]; } }
        __syncthreads();
        { const int n = F.tid >> 3, kc = (F.tid & 7) * 8; float v[8];
#pragma unroll
          for (int e = 0; e < 8; ++e) { v[e] = tile[(kc + e) * 65 + n]; if (gain) v[e] *= gain[(size_t)mat * K + k0 + kc + e]; }
          u32x4 w; w.x = cvt_pk_bf16(v[0], v[1]); w.y = cvt_pk_bf16(v[2], v[3]); w.z = cvt_pk_bf16(v[4], v[5]); w.w = cvt_pk_bf16(v[6], v[7]);
          *(u32x4*)(d + (size_t)(n0 + n) * K + k0 + kc) = w; }
    }
}
__device__ __forceinline__ void cvt_flat(const Ctx& F, const float* src, bf16_t* dst, size_t n8) {
    for (size_t i = (size_t)F.vcu * 512 + F.tid; i < n8; i += (size_t)F.G * 512) {
        const f32x4 a = *(const f32x4*)(src + i * 8), b = *(const f32x4*)(src + i * 8 + 4);
        u32x4 w; w.x = cvt_pk_bf16(a[0], a[1]); w.y = cvt_pk_bf16(a[2], a[3]); w.z = cvt_pk_bf16(b[0], b[1]); w.w = cvt_pk_bf16(b[2], b[3]);
        *(u32x4*)(dst + i * 8) = w;
    }
}
typedef unsigned v6u __attribute__((ext_vector_type(6)));
typedef float v32f __attribute__((ext_vector_type(32)));
typedef float v16f __attribute__((ext_vector_type(16)));
__device__ __forceinline__ float fp6_val(int c) { return c < 8 ? c * 0.125f : (c < 16 ? 1.f + (c - 8) * 0.125f : (c < 24 ? 2.f + (c - 16) * 0.25f : 4.f + (c - 24) * 0.5f)); }
__device__ __forceinline__ int fp6_code(float x) { return x < 1.f ? (int)(x * 8.f + 0.5f) : (x < 2.f ? 8 + (int)((x - 1.f) * 8.f + 0.5f) : (x < 4.f ? 16 + (int)((x - 2.f) * 4.f + 0.5f) : 24 + (int)((x - 4.f) * 2.f + 0.5f))); }
__device__ __forceinline__ void cvt_rows_fp6(const Ctx& F, const float* src, unsigned char* dst, float* descale, int R) {
    float* stg = (float*)(F.lds + 65536) + F.wid * (64 * 33);
    int* permL = (int*)(F.lds + 65536 + 8 * 64 * 33 * 4) + F.wid * 32;
    float fac;
    {   v16f lo, hi;
#pragma unroll
        for (int i = 0; i < 16; ++i) { lo[i] = fp6_val(i); hi[i] = fp6_val(16 + i); }
        const v6u w = __builtin_amdgcn_cvt_scalef32_2xpk16_fp6_f32(lo, hi, 1.0f);
        const v32f f = __builtin_amdgcn_cvt_scalef32_pk32_f32_fp6(w, 1.0f);
        float mx = 0.f;
#pragma unroll
        for (int j = 0; j < 32; ++j) mx = fmaxf(mx, f[j]);
        fac = mx * (1.f / 7.5f);
        const float inv = fac > 0.f ? 1.f / fac : 1.f;
        if (F.lane == 0) {
#pragma unroll
            for (int j = 0; j < 32; ++j) permL[j] = fp6_code(f[j] * inv) & 31; }
        asm volatile("s_waitcnt lgkmcnt(0)" ::: "memory"); __builtin_amdgcn_wave_barrier(); asm volatile("" ::: "memory");
    }
    for (int row = F.vcu * 8 + F.wid; row < R; row += F.G * 8) {
        const float* s = src + (size_t)row * DM + F.lane * 32; f32x4 v[8]; float am = 0.f;
#pragma unroll
        for (int i = 0; i < 8; ++i) { v[i] = *(const f32x4*)(s + i * 4);
#pragma unroll
            for (int e = 0; e < 4; ++e) am = fmaxf(am, fabsf(v[i][e])); }
        am = wave_max(am);
        const float sc = am > 0.f ? 7.f / am : 1.f;
#pragma unroll
        for (int i = 0; i < 8; ++i)
#pragma unroll
            for (int e = 0; e < 4; ++e) stg[F.lane * 33 + permL[i * 4 + e]] = v[i][e] * sc;
        asm volatile("s_waitcnt lgkmcnt(0)" ::: "memory"); __builtin_amdgcn_wave_barrier(); asm volatile("" ::: "memory");
        v16f lo, hi;
#pragma unroll
        for (int i = 0; i < 16; ++i) { lo[i] = stg[F.lane * 33 + i]; hi[i] = stg[F.lane * 33 + 16 + i]; }
        asm volatile("s_waitcnt lgkmcnt(0)" ::: "memory"); __builtin_amdgcn_wave_barrier(); asm volatile("" ::: "memory");
        const v6u w = __builtin_amdgcn_cvt_scalef32_2xpk16_fp6_f32(lo, hi, 1.0f);
        u32x2* d = (u32x2*)(dst + (size_t)row * EROW + F.lane * 24);
        d[0] = (u32x2){w[0], w[1]}; d[1] = (u32x2){w[2], w[3]}; d[2] = (u32x2){w[4], w[5]};
        if (F.lane == 0) descale[row] = (am > 0.f ? am * (1.f / 7.f) : 1.f) / (fac > 0.f ? fac : 1.f);
    }
}
__device__ __forceinline__ float silu_f(float v) { return v / (1.f + __expf(-v)); }

__device__ __forceinline__ void prologue_phase(const Ctx& F, CParams& P) {
    unsigned char* ws = F.ws;
    {
        float* sv = (float*)F.lds;
        float* part = (float*)(F.lds + 24576);
        for (int i = F.tid; i < 3 * DM; i += 512) { const int v = i / DM, k = i % DM; const float cv = v < 2 ? P.c[v * DM + k] : P.c_ctx[k]; sv[i] = silu_f(cv); }
        __syncthreads();
        float* mod = (float*)(ws + WS_MOD);
        for (int it = F.vcu; it < DEPTH * 192; it += F.G) {
            const int l = it / 192, n0 = (it % 192) * 64;
            const float* wp = P.w_mod + ((size_t)l * DM + F.wid * 256) * 12288 + n0 + F.lane;
            float a0 = 0.f, a1 = 0.f, a2 = 0.f;
#pragma unroll 8
            for (int k = 0; k < 256; ++k) { const float w = wp[(size_t)k * 12288]; const int kk = F.wid * 256 + k; a0 += sv[kk] * w; a1 += sv[DM + kk] * w; a2 += sv[2 * DM + kk] * w; }
            part[(F.wid * 3 + 0) * 64 + F.lane] = a0; part[(F.wid * 3 + 1) * 64 + F.lane] = a1; part[(F.wid * 3 + 2) * 64 + F.lane] = a2;
            __syncthreads();
            if (F.wid < 3) { float s = 0.f;
#pragma unroll
                for (int w = 0; w < 8; ++w) s += part[(w * 3 + F.wid) * 64 + F.lane];
                mod[((size_t)l * 3 + F.wid) * 12288 + n0 + F.lane] = s + P.b_mod[(size_t)l * 12288 + n0 + F.lane]; }
            __syncthreads();
        }
    }
    if (F.vcu == 0) {
        float* t16 = (float*)(ws + WS_TAB16); float* t32 = (float*)(ws + WS_TAB32);
        for (int i = F.tid; i < 128 * 16; i += 512) { const int pos = i >> 4, f = i & 15; const float fr = powf(10000.f, -(float)f / 16.f); const float a = (float)pos * fr; float s, c; sincosf(a, &s, &c); t16[i * 2] = c; t16[i * 2 + 1] = s; }
        for (int i = F.tid; i < 128 * 32; i += 512) { const int pos = i >> 5, f = i & 31; const float fr = powf(10000.f, -(float)f / 32.f); const float a = (float)pos * fr; float s, c; sincosf(a, &s, &c); t32[i * 2] = c; t32[i * 2 + 1] = s; }
        if (F.wid < 2) { const float* lv = P.lam_vec + F.wid * 256; const float d1 = wave_sum(lv[F.lane] * lv[64 + F.lane]), d2 = wave_sum(lv[128 + F.lane] * lv[192 + F.lane]);
            const float lam_init = 0.8f - 0.6f * expf(-0.3f * (float)(2 * F.wid));
            if (F.lane == 0) ((float*)(ws + WS_LAM))[F.wid] = expf(d1) - expf(d2) + lam_init; }
    }
    tconv(F, P.w_in_ab, (bf16_t*)(ws + WS_WINAB), nullptr, 2, DM, AB_IN, AB_INP);
    tconv(F, P.w_uq, (bf16_t*)(ws + WS_WUQ), P.g_cq, 2, 768, 1536, 1536);
    tconv(F, P.w_ukv, (bf16_t*)(ws + WS_WUKV), P.g_ckv, 2, 512, 2048, 2048);
    tconv(F, P.w_out_ab, (bf16_t*)(ws + WS_WOUTAB), nullptr, 2, DM, DM, DM);
    tconv(F, P.w_in_c, (bf16_t*)(ws + WS_WINC), nullptr, 2, DM, C_IN, C_IN);
    tconv(F, P.w_out_c, (bf16_t*)(ws + WS_WOUTC), nullptr, 2, DM, DM, DM);
    tconv(F, P.w_pq, (bf16_t*)(ws + WS_WPQ), nullptr, 4, DM, DM, DM);
    cvt_flat(F, P.sub_keys, (bf16_t*)(ws + WS_SUBK), (size_t)4 * 8 * 2 * 128 * 128 / 8);
    cvt_rows_fp6(F, P.expert_u, ws + WS_EU, (float*)(ws + WS_SU), 4 * NEXP);
    cvt_rows_fp6(F, P.expert_v, ws + WS_EV, (float*)(ws + WS_SV), 4 * NEXP);
}

__device__ __forceinline__ void norm_phase(const Ctx& F, CParams& P, int layer, int which  , int m_rows) {
    float* X = (float*)(F.ws + WS_X); bf16_t* H = (bf16_t*)(F.ws + WS_H);
    const float* mod = (const float*)(F.ws + WS_MOD) + (size_t)layer * 3 * 12288;
    const float* gn = (which ? P.g_norm2 : P.g_norm1) + (size_t)layer * DM;
    const bool from_in = (layer == 0 && which == 0);
    for (int t = F.vcu * 8 + F.wid; t < m_rows; t += F.G * 8) {
        const int vs = vsel_of_row(t);
        const float* src = from_in ? (t < TL ? P.x + (size_t)t * DM : P.ctx + (size_t)(t - TL) * DM) : X + (size_t)t * DM;
        const float* shf = mod + (size_t)vs * 12288 + (which ? 3 : 0) * DM; const float* scl = shf + DM;
        f32x4 v[8]; float ss = 0.f;
#pragma unroll
        for (int j = 0; j < 8; ++j) { v[j] = *(const f32x4*)(src + j * 256 + F.lane * 4); ss += v[j][0] * v[j][0] + v[j][1] * v[j][1] + v[j][2] * v[j][2] + v[j][3] * v[j][3]; }
        ss = wave_sum(ss);
        const float rstd = rsqrtf(ss * (1.f / DM) + EPS);
#pragma unroll
        for (int j = 0; j < 8; ++j) { const int c = j * 256 + F.lane * 4;
            if (from_in) *(f32x4*)(X + (size_t)t * DM + c) = v[j];
            const f32x4 g = *(const f32x4*)(gn + c), sc = *(const f32x4*)(scl + c), sh = *(const f32x4*)(shf + c);
            f32x4 y;
#pragma unroll
            for (int e = 0; e < 4; ++e) y[e] = (v[j][e] * rstd * g[e]) * (1.f + sc[e]) + sh[e];
            u32x2 w; w.x = cvt_pk_bf16(y[0], y[1]); w.y = cvt_pk_bf16(y[2], y[3]);
            *(u32x2*)(H + (size_t)t * DM + c) = w; }
    }
}

__device__ __forceinline__ float grp16_sum(float v) { v += swz_xor<8>(v); v += swz_xor<4>(v); v += swz_xor<2>(v); v += swz_xor<1>(v); return v; }
__device__ __forceinline__ void rope4(float (&x)[4], int q16, int row, int col, const float* t16) {
    const int seg = q16 >> 3, f0 = (q16 & 3) * 4, pos = seg ? col : row; const bool first = (q16 & 7) < 4;
    const f32x4 c0 = *(const f32x4*)(t16 + (pos * 16 + f0) * 2), c1 = *(const f32x4*)(t16 + (pos * 16 + f0) * 2 + 4);
    const float cs[4] = {c0[0], c0[2], c1[0], c1[2]}, sn[4] = {c0[1], c0[3], c1[1], c1[3]};
#pragma unroll
    for (int e = 0; e < 4; ++e) { const float p = swz_xor<4>(x[e]); x[e] = first ? x[e] * cs[e] - p * sn[e] : p * sn[e] + x[e] * cs[e]; }
}
__device__ __forceinline__ void rope8(float (&x)[8], int q16, int row, int col, const float* t32) {
    const int seg = q16 >> 3, f0 = (q16 & 3) * 8, pos = seg ? col : row; const bool first = (q16 & 7) < 4;
    const float* tp = t32 + (pos * 32 + f0) * 2;
#pragma unroll
    for (int q = 0; q < 4; ++q) { const f32x4 c = *(const f32x4*)(tp + q * 4);
#pragma unroll
        for (int s = 0; s < 2; ++s) { const int e = q * 2 + s; const float cs = c[s * 2], sn = c[s * 2 + 1]; const float p = swz_xor<4>(x[e]); x[e] = first ? x[e] * cs - p * sn : p * sn + x[e] * cs; } }
}
__device__ __forceinline__ void ld8bf(const bf16_t* p, float (&x)[8]) { const u32x4 w = *(const u32x4*)p;
#pragma unroll
    for (int q = 0; q < 4; ++q) { x[q * 2] = bf_lo(w[q]); x[q * 2 + 1] = bf_hi(w[q]); } }
__device__ __forceinline__ void ld4bf(const bf16_t* p, float (&x)[4]) { const u32x2 w = *(const u32x2*)p; x[0] = bf_lo(w.x); x[1] = bf_hi(w.x); x[2] = bf_lo(w.y); x[3] = bf_hi(w.y); }
__device__ __forceinline__ void st8bf(bf16_t* p, const float (&x)[8]) { u32x4 w; w.x = cvt_pk_bf16(x[0], x[1]); w.y = cvt_pk_bf16(x[2], x[3]); w.z = cvt_pk_bf16(x[4], x[5]); w.w = cvt_pk_bf16(x[6], x[7]); *(u32x4*)p = w; }
__device__ __forceinline__ void st4bf(bf16_t* p, const float (&x)[4]) { u32x2 w; w.x = cvt_pk_bf16(x[0], x[1]); w.y = cvt_pk_bf16(x[2], x[3]); *(u32x2*)p = w; }

__device__ __forceinline__ void qkv_even_phase(const Ctx& F, CParams& P, int e) {
    const bf16_t* P1 = (const bf16_t*)(F.ws + WS_P1); const bf16_t* QA = (const bf16_t*)(F.ws + WS_QA); const bf16_t* KV = (const bf16_t*)(F.ws + WS_KV);
    bf16_t* Qm = (bf16_t*)(F.ws + WS_Q1); bf16_t* Km = (bf16_t*)(F.ws + WS_K1); bf16_t* Vm = (bf16_t*)(F.ws + WS_V1);
    bf16_t* Qd = (bf16_t*)(F.ws + WS_Q2); bf16_t* Kd = (bf16_t*)(F.ws + WS_K2); bf16_t* Vd = (bf16_t*)(F.ws + WS_V2);
    const float* t16 = (const float*)(F.ws + WS_TAB16);
    const float* gqa = P.g_qn_a + e * 192; const float* gka = P.g_kn_a + e * 192; const float* gqb = P.g_qn_b + e * 64; const float* gkb = P.g_kn_b + e * 64;
    const int q16 = F.lane & 15, grp = F.lane >> 4;
    float gq_n[8], gq_r[4], gk_n[8], gk_r[4], gqd[4], gkd[4];
#pragma unroll
    for (int i = 0; i < 8; ++i) { gq_n[i] = gqa[q16 * 8 + i]; gk_n[i] = gka[q16 * 8 + i]; }
#pragma unroll
    for (int i = 0; i < 4; ++i) { gq_r[i] = gqa[128 + q16 * 4 + i]; gk_r[i] = gka[128 + q16 * 4 + i]; gqd[i] = gqb[q16 * 4 + i]; gkd[i] = gkb[q16 * 4 + i]; }
    for (int t = F.vcu * 8 + F.wid; t < TT; t += F.G * 8) {
        const bool latent = t < TL; const int s = t & (SEQ - 1), row = s >> 6, col = s & 63; const int kr = krow_of(t);
        const bf16_t* p1 = P1 + (size_t)t * AB_INP;
        float ss = 0.f;
#pragma unroll
        for (int j = 0; j < 3; ++j) { float x[4]; ld4bf(p1 + j * 256 + F.lane * 4, x); ss += x[0] * x[0] + x[1] * x[1] + x[2] * x[2] + x[3] * x[3]; }
        ss = wave_sum(ss); const float rstd_q = rsqrtf(ss * (1.f / 768.f) + EPS);
        float s2 = 0.f;
        { float x[8]; ld8bf(p1 + 768 + F.lane * 8, x);
#pragma unroll
          for (int i = 0; i < 8; ++i) s2 += x[i] * x[i]; }
        s2 = wave_sum(s2); const float rstd_kv = rsqrtf(s2 * (1.f / 512.f) + EPS);
        float kro[4]; ld4bf(p1 + 1280 + q16 * 4, kro);
#pragma unroll
        for (int ps = 0; ps < 2; ++ps) { const int h = ps * 4 + grp; const bf16_t* src = QA + (size_t)t * 1536 + h * 192;
            float xn[8], xr[4]; ld8bf(src + q16 * 8, xn); ld4bf(src + 128 + q16 * 4, xr);
            float sq = 0.f;
#pragma unroll
            for (int i = 0; i < 8; ++i) { xn[i] *= rstd_q; sq += xn[i] * xn[i]; }
#pragma unroll
            for (int i = 0; i < 4; ++i) { xr[i] *= rstd_q; sq += xr[i] * xr[i]; }
            sq = grp16_sum(sq); const float r = rsqrtf(sq * (1.f / 192.f) + EPS);
#pragma unroll
            for (int i = 0; i < 8; ++i) xn[i] *= r * gq_n[i];
#pragma unroll
            for (int i = 0; i < 4; ++i) xr[i] *= r * gq_r[i];
            if (latent) rope4(xr, q16, row, col, t16);
            bf16_t* dst = Qm + ((size_t)t * 8 + h) * 192; st8bf(dst + q16 * 8, xn); st4bf(dst + 128 + q16 * 4, xr); }
#pragma unroll
        for (int ps = 0; ps < 2; ++ps) { const int h = ps * 4 + grp; const bf16_t* src = KV + (size_t)t * 2048 + h * 256;
            float xn[8], xr[4], xv[8]; ld8bf(src + q16 * 8, xn); ld8bf(src + 128 + q16 * 8, xv);
            float sq = 0.f;
#pragma unroll
            for (int i = 0; i < 8; ++i) { xn[i] *= rstd_kv; xv[i] *= rstd_kv; sq += xn[i] * xn[i]; }
#pragma unroll
            for (int i = 0; i < 4; ++i) { xr[i] = kro[i]; sq += xr[i] * xr[i]; }
            sq = grp16_sum(sq); const float r = rsqrtf(sq * (1.f / 192.f) + EPS);
#pragma unroll
            for (int i = 0; i < 8; ++i) xn[i] *= r * gk_n[i];
#pragma unroll
            for (int i = 0; i < 4; ++i) xr[i] *= r * gk_r[i];
            if (latent) rope4(xr, q16, row, col, t16);
            bf16_t* dst = Km + ((size_t)kr * 8 + h) * 192; st8bf(dst + q16 * 8, xn); st4bf(dst + 128 + q16 * 4, xr);
            st8bf(Vm + ((size_t)kr * 8 + h) * 128 + q16 * 8, xv); }
#pragma unroll
        for (int ps = 0; ps < 4; ++ps) { const int hm = ps * 4 + grp;
            float x[4]; ld4bf(p1 + 1344 + hm * 64 + q16 * 4, x);
            float sq = grp16_sum(x[0] * x[0] + x[1] * x[1] + x[2] * x[2] + x[3] * x[3]); float r = rsqrtf(sq * (1.f / 64.f) + EPS);
#pragma unroll
            for (int i = 0; i < 4; ++i) x[i] *= r * gqd[i];
            if (latent) rope4(x, q16, row, col, t16);
            st4bf(Qd + ((size_t)t * 16 + hm) * 64 + q16 * 4, x);
            ld4bf(p1 + 2368 + hm * 64 + q16 * 4, x);
            sq = grp16_sum(x[0] * x[0] + x[1] * x[1] + x[2] * x[2] + x[3] * x[3]); r = rsqrtf(sq * (1.f / 64.f) + EPS);
#pragma unroll
            for (int i = 0; i < 4; ++i) x[i] *= r * gkd[i];
            if (latent) rope4(x, q16, row, col, t16);
            st4bf(Kd + ((size_t)kr * 16 + hm) * 64 + q16 * 4, x); }
#pragma unroll
        for (int j = 0; j < 2; ++j) *(u32x4*)(Vd + (size_t)kr * 1024 + j * 512 + F.lane * 8) = *(const u32x4*)(p1 + 3392 + j * 512 + F.lane * 8);
    }
}
__device__ __forceinline__ void qkv_odd_phase(const Ctx& F, CParams& P, int e) {
    const bf16_t* P1 = (const bf16_t*)(F.ws + WS_P1);
    bf16_t* Qc = (bf16_t*)(F.ws + WS_Q1); bf16_t* Kc = (bf16_t*)(F.ws + WS_K1); bf16_t* Vc = (bf16_t*)(F.ws + WS_V1);
    const float* t32 = (const float*)(F.ws + WS_TAB32);
    const int q16 = F.lane & 15, grp = F.lane >> 4;
    float gq[8], gk[8];
#pragma unroll
    for (int i = 0; i < 8; ++i) { gq[i] = P.g_qn_c[e * 128 + q16 * 8 + i]; gk[i] = P.g_kn_c[e * 128 + q16 * 8 + i]; }
    for (int t = F.vcu * 8 + F.wid; t < TT; t += F.G * 8) {
        const bool latent = t < TL; const int s = t & (SEQ - 1), row = s >> 6, col = s & 63; const int kr = krow_of(t);
        const bf16_t* p1 = P1 + (size_t)t * C_IN;
#pragma unroll
        for (int ps = 0; ps < 5; ++ps) {
            const bool isq = ps < 4; const int h = isq ? ps * 4 + grp : grp;
            float x[8]; ld8bf(p1 + (isq ? 0 : 2048) + h * 128 + q16 * 8, x);
            float sq = 0.f;
#pragma unroll
            for (int i = 0; i < 8; ++i) sq += x[i] * x[i];
            sq = grp16_sum(sq); const float r = rsqrtf(sq * (1.f / 128.f) + EPS);
#pragma unroll
            for (int i = 0; i < 8; ++i) x[i] *= r * (isq ? gq[i] : gk[i]);
            if (latent) rope8(x, q16, row, col, t32);
            st8bf(isq ? Qc + ((size_t)t * 16 + h) * 128 + q16 * 8 : Kc + ((size_t)kr * 4 + h) * 128 + q16 * 8, x); }
        *(u32x4*)(Vc + (size_t)kr * 512 + F.lane * 8) = *(const u32x4*)(p1 + 2560 + F.lane * 8);
    }
}

template <int DQK, int SDEPTH, int ldo, int NH, int NKVH, int NVH>
__device__ __forceinline__ void attn_phase(const Ctx& F, const bf16_t* Qbuf, const bf16_t* Kbuf, const bf16_t* Vbuf, bf16_t* OF, int ocol0, bool with_ctx) {
    constexpr int kv_div = NH / NKVH, v_div = NH / NVH;
    const int n_lat = NH * NB * 32, n_tot = n_lat + (with_ctx ? NH * NB : 0);
    constexpr int ldq = NH * DQK, ldk = NKVH * DQK, ldv = NVH * 128;
    for (int u = F.vcu; u < n_tot; u += F.G) {
        int b, h, qrow0, kstart, seq;
        if (u < n_lat) { const int bh = u >> 5, qb = u & 31; b = bh / NH; h = bh % NH; qrow0 = b * SEQ + qb * 256; kstart = b * KPB; seq = KPB; }
        else { const int bh = u - n_lat; b = bh / NH; h = bh % NH; qrow0 = TL + b * CTXL; kstart = b * KPB + SEQ; seq = CTXL; }
        const bf16_t* Qp = Qbuf + ((size_t)qrow0 * NH + h) * DQK;
        const bf16_t* Kp = Kbuf + ((size_t)kstart * NKVH + h / kv_div) * DQK;
        const bf16_t* Vp = Vbuf + ((size_t)kstart * NVH + h / v_div) * 128;
        bf16_t* Op = OF + (size_t)qrow0 * ldo + ocol0 + h * 128;
        if constexpr (SDEPTH == 0) att::attn_body_simple<DQK, (DQK == 192 ? MLA_QL : 0), ldq, ldk, ldv, ldo>(Qp, Kp, Vp, Op, seq, F.lds, F.wid);
        else att::attn_body<DQK, SDEPTH, (DQK == 192 ? MLA_QL : (DQK == 128 ? GQA_QL : 0)), ldq, ldk, ldv, ldo>(Qp, Kp, Vp, Op, seq, F.lds, F.wid);
    }
}

__device__ __forceinline__ void merge_even_phase(const Ctx& F, CParams& P, int e, int layer, int m_rows) {
    const bf16_t* OD = (const bf16_t*)(F.ws + WS_OF); bf16_t* AO = (bf16_t*)(F.ws + WS_AO);
    const float lam = ((const float*)(F.ws + WS_LAM))[e];
    const float lam_init = 0.8f - 0.6f * expf(-0.3f * (float)layer);
    const int q16 = F.lane & 15, grp = F.lane >> 4;
    float gs[8];
#pragma unroll
    for (int i = 0; i < 8; ++i) gs[i] = P.g_sub_b[e * 128 + q16 * 8 + i] * (1.f - lam_init);
    for (int t = F.vcu * 8 + F.wid; t < m_rows; t += F.G * 8) {
        const bf16_t* od = OD + (size_t)t * DM; bf16_t* ao = AO + (size_t)t * DM + 1024;
#pragma unroll
        for (int ps = 0; ps < 2; ++ps) { const int h = ps * 4 + grp;
            float o0[8], o1[8], d[8]; ld8bf(od + (2 * h) * 128 + q16 * 8, o0); ld8bf(od + (2 * h + 1) * 128 + q16 * 8, o1);
            float sq = 0.f;
#pragma unroll
            for (int i = 0; i < 8; ++i) { d[i] = o0[i] - lam * o1[i]; sq += d[i] * d[i]; }
            sq = grp16_sum(sq); const float r = rsqrtf(sq * (1.f / 128.f) + EPS);
#pragma unroll
            for (int i = 0; i < 8; ++i) d[i] *= r * gs[i];
            st8bf(ao + h * 128 + q16 * 8, d); }
    }
}

__device__ __forceinline__ void wave_lds_fence() { asm volatile("s_waitcnt lgkmcnt(0)" ::: "memory"); __builtin_amdgcn_wave_barrier(); asm volatile("" ::: "memory"); }
__device__ __forceinline__ unsigned fkey(float f) { const unsigned b = __float_as_uint(f); return b ^ ((unsigned)((int)b >> 31) | 0x80000000u); }
__device__ __forceinline__ float funkey(unsigned k) { return __uint_as_float((k & 0x80000000u) ? (k ^ 0x80000000u) : ~k); }
__device__ __forceinline__ unsigned umed3(unsigned a, unsigned b, unsigned c) { unsigned r; asm("v_med3_u32 %0, %1, %2, %3" : "=v"(r) : "v"(a), "v"(b), "v"(c)); return r; }
__device__ __forceinline__ void kins16(unsigned (&L)[16], unsigned k) {
#pragma unroll
    for (int p = 15; p >= 1; --p) L[p] = umed3(L[p - 1], L[p], k);
    L[0] = L[0] > k ? L[0] : k;
}
__device__ __forceinline__ void scan_set(unsigned (&L)[16], const bf16_t* qbase  , const bf16_t* kbase  , float* buf, int lane) {
    const int r32 = lane & 31, hi = lane >> 5;
#pragma unroll
    for (int p = 0; p < 16; ++p) L[p] = 0u;
    bf16x8 a0[8], a1[8];
    { const bf16_t* ap = qbase + (size_t)r32 * DM + hi * 8;
#pragma unroll
      for (int ks = 0; ks < 8; ++ks) { a0[ks] = *(const bf16x8*)(ap + ks * 16); a1[ks] = *(const bf16x8*)(ap + (size_t)32 * DM + ks * 16); } }
#pragma unroll 1
    for (int kb = 0; kb < 4; ++kb) {
        f32x16 acc0 = {}, acc1 = {};
        { const bf16_t* bp = kbase + (size_t)(kb * 32 + r32) * 128 + hi * 8;
          bf16x8 b[8];
#pragma unroll
          for (int ks = 0; ks < 8; ++ks) b[ks] = *(const bf16x8*)(bp + ks * 16);
#pragma unroll
          for (int ks = 0; ks < 8; ++ks) { acc0 = __builtin_amdgcn_mfma_f32_32x32x16_bf16(a0[ks], b[ks], acc0, 0, 0, 0); acc1 = __builtin_amdgcn_mfma_f32_32x32x16_bf16(a1[ks], b[ks], acc1, 0, 0, 0); } }
        wave_lds_fence();
#pragma unroll
        for (int r = 0; r < 16; ++r) { const int rowi = att::crow(r, hi); buf[rowi * 33 + r32] = acc0[r]; buf[(32 + rowi) * 33 + r32] = acc1[r]; }
        wave_lds_fence();
        const unsigned tb = 127u - (unsigned)(kb * 32);
#pragma unroll 8
        for (int k = 0; k < 32; ++k) kins16(L, (fkey(buf[lane * 33 + k]) & ~127u) | (tb - (unsigned)k));
    }
}
__device__ __forceinline__ void peer_select_phase(const Ctx& F, int layer, int m_rows) {
    const bf16_t* PQ = (const bf16_t*)(F.ws + WS_PQ); const bf16_t* SK = (const bf16_t*)(F.ws + WS_SUBK) + (size_t)layer * 8 * 2 * 128 * 128;
    int* PIDX = (int*)(F.ws + WS_PIDX); float* PG = (float*)(F.ws + WS_PG);
    float* buf = (float*)F.lds + F.wid * (64 * 33);
    const int lane = F.lane;
    const int nunits = (m_rows / 64) * 8;
    for (int u = F.vcu * 8 + F.wid; u < nunits; u += F.G * 8) {
        const int tile = u >> 3, h = u & 7, t0 = tile * 64;
        unsigned Ka[16], Kb[16];
        scan_set(Ka, PQ + (size_t)t0 * DM + h * 256, SK + (size_t)(h * 2) * 128 * 128, buf, lane);
        scan_set(Kb, PQ + (size_t)t0 * DM + h * 256 + 128, SK + (size_t)(h * 2 + 1) * 128 * 128, buf, lane);
        wave_lds_fence();
        float la[16], lb[16];
#pragma unroll
        for (int p = 0; p < 16; ++p) { la[p] = funkey(Ka[p] & ~127u); lb[p] = funkey(Kb[p] & ~127u);
            buf[lane * 33 + p] = __int_as_float(127 - (int)(Ka[p] & 127u)); buf[lane * 33 + 16 + p] = __int_as_float(127 - (int)(Kb[p] & 127u)); }
        wave_lds_fence();
        unsigned Kc[16];
#pragma unroll
        for (int p = 0; p < 16; ++p) Kc[p] = 0u;
#pragma unroll
        for (int r1 = 0; r1 < 16; ++r1)
#pragma unroll
            for (int r2 = 0; r2 < 16; ++r2) if ((r1 + 1) * (r2 + 1) <= 16) kins16(Kc, (fkey(la[r1] + lb[r2]) & ~255u) | (unsigned)(255 - (16 * r1 + r2)));
        float bv[16], sm = 0.f; unsigned idx[16];
#pragma unroll
        for (int p = 0; p < 16; ++p) { const int code = 255 - (int)(Kc[p] & 255u); bv[p] = funkey(Kc[p] & ~255u);
            idx[p] = (unsigned)(__float_as_int(buf[lane * 33 + (code >> 4)]) * 128 + __float_as_int(buf[lane * 33 + 16 + (code & 15)])); }
        const float bmax = bv[0];
#pragma unroll
        for (int p = 0; p < 16; ++p) { bv[p] = __expf(bv[p] - bmax); sm += bv[p]; }
        const float inv = 1.f / sm;
        const size_t o = ((size_t)(t0 + lane) * 8 + h) * 16;
#pragma unroll
        for (int q = 0; q < 4; ++q) { *(f32x4*)(PG + o + q * 4) = (f32x4){bv[q * 4] * inv, bv[q * 4 + 1] * inv, bv[q * 4 + 2] * inv, bv[q * 4 + 3] * inv};
            *(u32x4*)(PIDX + o + q * 4) = (u32x4){idx[q * 4], idx[q * 4 + 1], idx[q * 4 + 2], idx[q * 4 + 3]}; }
    }
}

__device__ __forceinline__ float gelu_tanh(float a) { const float u = 0.7978845608028654f * (a + 0.044715f * a * a * a); const float t = 1.f - 2.f / (1.f + __expf(2.f * u)); return 0.5f * a * (1.f + t); }
struct Row6 { u32x2 r[3]; };
__device__ __forceinline__ void ld_row6(Row6& R, const unsigned char* tab, int e, int lane) {
    const u32x2* rp = (const u32x2*)(tab + (size_t)e * EROW + (unsigned)lane * 24u);
    R.r[0] = rp[0]; R.r[1] = rp[1]; R.r[2] = rp[2];
}
__device__ __forceinline__ v32f dq_row6(const Row6& R) { const v6u w = {R.r[0].x, R.r[0].y, R.r[1].x, R.r[1].y, R.r[2].x, R.r[2].y}; return __builtin_amdgcn_cvt_scalef32_pk32_f32_fp6(w, 1.0f); }
__device__ __forceinline__ float dot_row6(const Row6& R, const float (&h)[32]) {
    const v32f f = dq_row6(R);
    float s0 = 0.f, s1 = 0.f, s2 = 0.f, s3 = 0.f;
#pragma unroll
    for (int i = 0; i < 8; ++i) { s0 = fmaf(f[i * 4 + 0], h[i * 4 + 0], s0); s1 = fmaf(f[i * 4 + 1], h[i * 4 + 1], s1); s2 = fmaf(f[i * 4 + 2], h[i * 4 + 2], s2); s3 = fmaf(f[i * 4 + 3], h[i * 4 + 3], s3); }
    const float s = (s0 + s1) + (s2 + s3);
    __builtin_amdgcn_sched_barrier(0);
    return s;
}
__device__ __forceinline__ void fma_row6(float (&out)[32], const Row6& R, float w) {
    const v32f f = dq_row6(R);
#pragma unroll
    for (int i = 0; i < 32; ++i) out[i] = fmaf(w, f[i], out[i]);
    __builtin_amdgcn_sched_barrier(0);
}
__device__ __forceinline__ float reduce4(float s0, float s1, float s2, float s3, int lane) {
    const bool hi = (lane & 32) != 0, b4 = (lane & 16) != 0;
    const float r0 = xor32_partner(hi ? s0 : s2, lane), r1 = xor32_partner(hi ? s1 : s3, lane);
    const float a0 = (hi ? s2 : s0) + r0, a1 = (hi ? s3 : s1) + r1;
    const float r = swz_xor<16>(b4 ? a0 : a1);
    float b = (b4 ? a1 : a0) + r;
    b += swz_xor<8>(b); b += swz_xor<4>(b); b += swz_xor<2>(b); b += swz_xor<1>(b);
    return b;
}
__device__ __forceinline__ float rl_f(float v, int l) { return __uint_as_float(__builtin_amdgcn_readlane(__float_as_uint(v), l)); }
__device__ __forceinline__ void wr_lane(float& dst, float val_uniform, int lane_uniform, int lane) { asm volatile("" : "+s"(lane_uniform)); dst = (lane == lane_uniform) ? val_uniform : dst; }
__device__ __forceinline__ void peer_expert_phase(const Ctx& F, CParams& P, int layer, int m_rows, bool last, bool dry) {
    const unsigned char* EU = F.ws + WS_EU + (size_t)layer * NEXP * EROW; const unsigned char* EV = F.ws + WS_EV + (size_t)layer * NEXP * EROW;
    const float* SU = (const float*)(F.ws + WS_SU) + (size_t)layer * NEXP; const float* SV = (const float*)(F.ws + WS_SV) + (size_t)layer * NEXP;
    const bf16_t* H = (const bf16_t*)(F.ws + WS_H); float* X = (float*)(F.ws + WS_X);
    const int* PIDX = (const int*)(F.ws + WS_PIDX); const float* PG = (const float*)(F.ws + WS_PG);
    const float* mod = (const float*)(F.ws + WS_MOD) + (size_t)layer * 3 * 12288;
    const int lane = F.lane;
    for (int t = F.vcu * 8 + F.wid; t < m_rows; t += F.G * 8) {
        float hf[32];
        { const u32x4* hp = (const u32x4*)(H + (size_t)t * DM + (unsigned)lane * 32u);
#pragma unroll
          for (int j = 0; j < 4; ++j) { const u32x4 w = hp[j];
#pragma unroll
              for (int q = 0; q < 4; ++q) { hf[j * 8 + q * 2] = bf_lo(w[q]); hf[j * 8 + q * 2 + 1] = bf_hi(w[q]); } } }
        int id[2]; float wv[2];
        id[0] = PIDX[(size_t)t * 128 + lane]; id[1] = PIDX[(size_t)t * 128 + 64 + lane];
#pragma unroll
        for (int half = 0; half < 2; ++half) {
            const int idr = id[half]; float acc = 0.f;
            const float gk = PG[(size_t)t * 128 + half * 64 + lane], su = SU[idr], sv = SV[idr];
            Row6 A[EB], B[EB];
#pragma unroll
            for (int q = 0; q < EB; ++q) ld_row6(A[q], EU, __builtin_amdgcn_readlane(idr, q), lane);
#pragma unroll 1
            for (int k = 0; k < 64; k += 2 * EB) {
#pragma unroll
                for (int q = 0; q < EB; ++q) ld_row6(B[q], EU, __builtin_amdgcn_readlane(idr, k + EB + q), lane);
#pragma unroll
                for (int g = 0; g < EB; g += 4) { const float b = reduce4(dot_row6(A[g], hf), dot_row6(A[g + 1], hf), dot_row6(A[g + 2], hf), dot_row6(A[g + 3], hf), lane);
#pragma unroll
                    for (int q = 0; q < 4; ++q) wr_lane(acc, rl_f(b, 16 * q), k + g + q, lane); }
                if (k + 2 * EB < 64) {
#pragma unroll
                    for (int q = 0; q < EB; ++q) ld_row6(A[q], EU, __builtin_amdgcn_readlane(idr, k + 2 * EB + q), lane); }
#pragma unroll
                for (int g = 0; g < EB; g += 4) { const float b = reduce4(dot_row6(B[g], hf), dot_row6(B[g + 1], hf), dot_row6(B[g + 2], hf), dot_row6(B[g + 3], hf), lane);
#pragma unroll
                    for (int q = 0; q < 4; ++q) wr_lane(acc, rl_f(b, 16 * q), k + EB + g + q, lane); }
            }
            wv[half] = gk * gelu_tanh(acc * su) * sv;
        }
        float out[32];
#pragma unroll
        for (int i = 0; i < 32; ++i) out[i] = 0.f;
#pragma unroll
        for (int half = 0; half < 2; ++half) {
            const int idr = id[half]; const float wr = wv[half];
            Row6 A[EB], B[EB];
#pragma unroll
            for (int q = 0; q < EB; ++q) ld_row6(A[q], EV, __builtin_amdgcn_readlane(idr, q), lane);
#pragma unroll 1
            for (int k = 0; k < 64; k += 2 * EB) {
#pragma unroll
                for (int q = 0; q < EB; ++q) ld_row6(B[q], EV, __builtin_amdgcn_readlane(idr, k + EB + q), lane);
#pragma unroll
                for (int q = 0; q < EB; ++q) fma_row6(out, A[q], rl_f(wr, k + q));
                if (k + 2 * EB < 64) {
#pragma unroll
                    for (int q = 0; q < EB; ++q) ld_row6(A[q], EV, __builtin_amdgcn_readlane(idr, k + 2 * EB + q), lane); }
#pragma unroll
                for (int q = 0; q < EB; ++q) fma_row6(out, B[q], rl_f(wr, k + EB + q));
            }
        }
        const int vs = vsel_of_row(t);
        const float* gate = mod + (size_t)vs * 12288 + 5 * DM;
        float* xr = X + (size_t)t * DM; float* dst = dry ? (float*)(F.ws + WS_OF) + (size_t)t * DM : (last ? P.out + (size_t)t * DM : xr);
        float ssq = 0.f;
        const unsigned lo32 = (unsigned)lane * 32u;
#pragma unroll
        for (int q = 0; q < 8; ++q) { const unsigned c = lo32 + q * 4; const f32x4 xo = *(const f32x4*)(xr + c), g = *(const f32x4*)(gate + c);
            f32x4 y; y[0] = xo[0] + g[0] * out[q * 4 + 0]; y[1] = xo[1] + g[1] * out[q * 4 + 1]; y[2] = xo[2] + g[2] * out[q * 4 + 2]; y[3] = xo[3] + g[3] * out[q * 4 + 3];
            *(f32x4*)(dst + c) = y;
            out[q * 4 + 0] = y[0]; out[q * 4 + 1] = y[1]; out[q * 4 + 2] = y[2]; out[q * 4 + 3] = y[3];
            ssq += y[0] * y[0] + y[1] * y[1] + y[2] * y[2] + y[3] * y[3]; }
        if (!last && !dry) {
            const float rstd = rsqrtf(wave_sum(ssq) * (1.f / DM) + EPS);
            const float* gn = P.g_norm1 + (size_t)(layer + 1) * DM;
            const float* shf = mod + (size_t)3 * 12288 + (size_t)vs * 12288; const float* scl = shf + DM;
            bf16_t* hrow = (bf16_t*)(F.ws + WS_H) + (size_t)t * DM;
#pragma unroll
            for (int j = 0; j < 4; ++j) { u32x4 w;
#pragma unroll
                for (int q = 0; q < 2; ++q) { const unsigned c = lo32 + j * 8 + q * 4; const f32x4 g = *(const f32x4*)(gn + c), sc = *(const f32x4*)(scl + c), sh = *(const f32x4*)(shf + c);
                    float y[4];
#pragma unroll
                    for (int e2 = 0; e2 < 4; ++e2) y[e2] = (out[j * 8 + q * 4 + e2] * rstd * g[e2]) * (1.f + sc[e2]) + sh[e2];
                    w[q * 2] = cvt_pk_bf16(y[0], y[1]); w[q * 2 + 1] = cvt_pk_bf16(y[2], y[3]); }
                *(u32x4*)(hrow + lo32 + j * 8) = w; }
        }
    }
}

constexpr int N_PHASES = 1 + 2 * 11 + 2 * 9 - 3;
__global__ void __launch_bounds__(512, 2) mk_fwd(Params Pval) {
    extern __shared__ __attribute__((aligned(16))) unsigned char lds_raw[];
    LAS unsigned char* ldsl = (LAS unsigned char*)lds_raw;
    volatile LAS unsigned* misc = (volatile LAS unsigned*)(ldsl + LDS_MISC);
    if (threadIdx.x < 16) misc[threadIdx.x] = 0u;
    __syncthreads();
    XcdBarrier bar = xcd_barrier_post((unsigned*)(Pval.ws + WS_CTL) + 1024, misc);
    const int wid0 = __builtin_amdgcn_readfirstlane((int)threadIdx.x >> 6);
    const int lo = Pval.ph_lo, hi = Pval.ph_hi; int ph = 0;
#define MKCTX() Ctx F; { const int lane_ = fresh_lane(); int wid_ = wid0; asm volatile("" : "+s"(wid_)); const int tid_ = wid_ * 64 + lane_; F.tid = tid_; F.lane = lane_; F.wid = wid_; \
        int G_ = gridDim.x, bx_ = blockIdx.x; asm volatile("" : "+s"(G_), "+s"(bx_)); F.G = G_; F.vcu = (G_ % 8 == 0) ? (bx_ % 8) * (G_ / 8) + bx_ / 8 : bx_; F.bx = bx_; } \
        unsigned long long kp_ = (unsigned long long)__builtin_amdgcn_kernarg_segment_ptr(); asm volatile("" : "+s"(kp_)); CParams& P = *(CParams*)kp_; \
        F.ws = P.ws; F.lds = (char*)lds_raw; unsigned char* ws = F.ws; (void)ws; \
        bf16_t* Hb = (bf16_t*)(ws + WS_H); bf16_t* P1 = (bf16_t*)(ws + WS_P1); float* X = (float*)(ws + WS_X); const float* mod = (const float*)(ws + WS_MOD); (void)Hb; (void)P1; (void)X; (void)mod;
#define PHASE(cls, ...) do { if (ph >= lo && ph < hi) { if constexpr ((PH_MASK >> (cls)) & 1u) { \
        if constexpr ((PH_DOUBLE >> (cls)) & 1u) { const bool dry = true; (void)dry; MKCTX(); __VA_ARGS__; __syncthreads(); } \
        { const bool dry = false; (void)dry; MKCTX(); __VA_ARGS__; } } if (ph + 1 < hi) { int w0_ = wid0; asm volatile("" : "+s"(w0_)); xcd_barrier(bar, w0_ == 0 && fresh_lane() == 0); } } ++ph; } while (0)

    PHASE(0, prologue_phase(F, P));
#pragma unroll 1
    for (int layer = 0; layer < DEPTH; ++layer) {
        const int e = layer >> 1; const bool even = (layer & 1) == 0, lastl = layer == DEPTH - 1;
        const int m_post = lastl ? TL : TT;
        if (layer == 0) PHASE(1, norm_phase(F, P, layer, 0, TT));
        PHASE(2, { const bf16_t* W = even ? (const bf16_t*)(ws + WS_WINAB) + (size_t)e * AB_INP * DM : (const bf16_t*)(ws + WS_WINC) + (size_t)e * C_IN * DM;
                const int N = even ? AB_INP : C_IN;
                pg8::Gemm g{Hb, W, TT, N, DM, DM}; pg8::StaticOrder S; S.init(TT, N, F.G, F.bx);
                pg8::EpiBf16 E{P1, N};
                pg8::gemm_phase<pg8::EpiBf16, pg8::StaticOrder>(ldsl, g, S, E, F.wid); });
        if (even) {
            PHASE(3, { { pg8::Gemm g{P1, (const bf16_t*)(ws + WS_WUQ) + (size_t)e * 1536 * 768, TT, 1536, 768, AB_INP}; pg8::StaticOrder S; S.init(TT, 1536, F.G, F.bx);
                      pg8::EpiBf16 E{(bf16_t*)(ws + WS_QA), 1536};
                      pg8::gemm_phase<pg8::EpiBf16, pg8::StaticOrder>(ldsl, g, S, E, F.wid); }
                    { pg8::Gemm g{P1 + 768, (const bf16_t*)(ws + WS_WUKV) + (size_t)e * 2048 * 512, TT, 2048, 512, AB_INP}; pg8::StaticOrder S; S.init(TT, 2048, F.G, F.bx);
                      pg8::EpiBf16 E{(bf16_t*)(ws + WS_KV), 2048};
                      pg8::gemm_phase<pg8::EpiBf16, pg8::StaticOrder>(ldsl, g, S, E, F.wid); } });
            PHASE(4, qkv_even_phase(F, P, e));
            PHASE(5, { if constexpr (ATT_SEL & 1) attn_phase<192, MLA_SD, 2048, 8, 8, 8>(F, (const bf16_t*)(ws + WS_Q1), (const bf16_t*)(ws + WS_K1), (const bf16_t*)(ws + WS_V1), (bf16_t*)(ws + WS_AO), 0, !lastl);
                    if constexpr (ATT_SEL & 2) attn_phase<64, 2, 2048, 16, 16, 8>(F, (const bf16_t*)(ws + WS_Q2), (const bf16_t*)(ws + WS_K2), (const bf16_t*)(ws + WS_V2), (bf16_t*)(ws + WS_OF), 0, !lastl); });
            PHASE(6, merge_even_phase(F, P, e, layer, m_post));
        } else {
            PHASE(7, qkv_odd_phase(F, P, e));
            PHASE(8, attn_phase<128, GQA_SD, 2048, 16, 4, 4>(F, (const bf16_t*)(ws + WS_Q1), (const bf16_t*)(ws + WS_K1), (const bf16_t*)(ws + WS_V1), (bf16_t*)(ws + WS_AO), 0, !lastl));
        }
        PHASE(10, { const bf16_t* W = even ? (const bf16_t*)(ws + WS_WOUTAB) + (size_t)e * DM * DM : (const bf16_t*)(ws + WS_WOUTC) + (size_t)e * DM * DM;
                pg8::Gemm g{(const bf16_t*)(ws + WS_AO), W, m_post, DM, DM, DM}; pg8::StaticOrder S; S.init(m_post, DM, F.G, F.bx);
                pg8::EpiResid E{X, mod + (size_t)layer * 3 * 12288, 2};
                pg8::gemm_phase<pg8::EpiResid, pg8::StaticOrder>(ldsl, g, S, E, F.wid); });
        PHASE(1, norm_phase(F, P, layer, 1, m_post));
        PHASE(11, { pg8::Gemm g{Hb, (const bf16_t*)(ws + WS_WPQ) + (size_t)layer * DM * DM, m_post, DM, DM, DM}; pg8::StaticOrder S; S.init(m_post, DM, F.G, F.bx);
                pg8::EpiBf16 E{(bf16_t*)(ws + WS_PQ), DM};
                pg8::gemm_phase<pg8::EpiBf16, pg8::StaticOrder>(ldsl, g, S, E, F.wid); });
        PHASE(12, peer_select_phase(F, layer, m_post));
        PHASE(13, peer_expert_phase(F, P, layer, m_post, lastl, dry));
    }
#undef PHASE
}

extern "C" void kernel_launch(void* const* d_in, const int* in_sizes, int n_in, void* d_out, int out_size, void* d_ws, size_t ws_size, hipStream_t stream) {
    static int grid = 0;
    if (grid == 0) {
        if (n_in != 28 || ws_size < WS_END) { fprintf(stderr, "kernel_launch: expected 28 inputs and >= %zu bytes of workspace, got %d / %zu\n", (size_t)WS_END, n_in, ws_size); grid = -1; return; }
        int dev = 0, cus = 0, per_cu = 0;
        if (hipGetDevice(&dev) != hipSuccess || hipDeviceGetAttribute(&cus, hipDeviceAttributeMultiprocessorCount, dev) != hipSuccess) { grid = -1; return; }
        if (hipFuncSetAttribute((const void*)mk_fwd, hipFuncAttributeMaxDynamicSharedMemorySize, LDS_BYTES) != hipSuccess) { fprintf(stderr, "kernel_launch: hipFuncSetAttribute failed\n"); grid = -1; return; }
        if (hipOccupancyMaxActiveBlocksPerMultiprocessor(&per_cu, (const void*)mk_fwd, 512, LDS_BYTES) != hipSuccess || per_cu < 1) fprintf(stderr, "kernel_launch: occupancy query says %d\n", per_cu);
        (void)hipGetLastError();
        grid = cus;
    }
    if (grid < 0) return;
    (void)hipMemsetAsync((char*)d_ws + WS_CTL, 0, CTL_BYTES, stream);
    Params p{};
    const float** pf = (const float**)&p;
    for (int i = 0; i < 28; ++i) pf[i] = (const float*)d_in[i];
    p.out = (float*)d_out; p.ws = (unsigned char*)d_ws;
#if MK_PER_PHASE_LAUNCH
    for (int i = 0; i < N_PHASES; ++i) { p.ph_lo = i; p.ph_hi = i + 1; hipLaunchKernelGGL(mk_fwd, dim3(grid), dim3(512), LDS_BYTES, stream, p); }
#else
    p.ph_lo = 0; p.ph_hi = N_PHASES;
    hipLaunchKernelGGL(mk_fwd, dim3(grid), dim3(512), LDS_BYTES, stream, p);
#endif
    const hipError_t le = hipPeekAtLastError();
    if (le != hipSuccess) fprintf(stderr, "kernel_launch: launch failed: %s\n", hipGetErrorName(le));
}
```

```cpp
#include <hip/hip_runtime.h>
#include <stdint.h>
#include <stdio.h>

#ifndef MK_PER_PHASE_LAUNCH
#define MK_PER_PHASE_LAUNCH 0
#endif

#ifndef MLA_QL
#define MLA_QL 0
#endif
#ifndef GQA_QL
#define GQA_QL 0
#endif
#ifndef QKT_GRP
#define QKT_GRP 12
#endif
#ifndef EB
#define EB 4
#endif
#ifndef PV_PIPE
#define PV_PIPE 0
#endif
#ifndef MLA_SD
#define MLA_SD 1
#endif
#ifndef GQA_SD
#define GQA_SD 2
#endif
#ifndef ATT_SEL
#define ATT_SEL 3
#endif
#ifndef PH_DOUBLE
#define PH_DOUBLE 0u
#endif
#ifndef PH_MASK
#define PH_MASK 0xFFFFFFFFu
#endif
#define LAS __attribute__((address_space(3)))
typedef unsigned short bf16_t;
typedef short bf16x8 __attribute__((ext_vector_type(8)));
typedef short s16x4 __attribute__((ext_vector_type(4)));
typedef float f32x4 __attribute__((ext_vector_type(4)));
typedef float f32x2 __attribute__((ext_vector_type(2)));
typedef float f32x16 __attribute__((ext_vector_type(16)));
typedef unsigned u32x4 __attribute__((ext_vector_type(4)));
typedef unsigned u32x2 __attribute__((ext_vector_type(2)));
typedef __bf16 bf16x2_t __attribute__((ext_vector_type(2)));

constexpr int DM = 2048, NB = 2, SEQ = 8192, DEPTH = 4, CTXL = 256;
constexpr int TL = NB * SEQ;
constexpr int TZ = NB * CTXL;
constexpr int TT = TL + TZ;
constexpr int KPB = SEQ + CTXL;
constexpr int AB_IN = 4416, AB_INP = 4608;
constexpr int C_IN = 3072;
constexpr int NEXP = 16384;
constexpr float EPS = 1e-6f;
constexpr float LOG2E = 1.4426950408889634f;

constexpr size_t al256(size_t x) { return (x + 255) / 256 * 256; }
constexpr size_t WS_CTL = 0, CTL_BYTES = 1u << 20;
constexpr size_t WS_MOD = WS_CTL + CTL_BYTES;
constexpr size_t WS_TAB16 = WS_MOD + al256((size_t)4 * 3 * 12288 * 4);
constexpr size_t WS_TAB32 = WS_TAB16 + al256((size_t)128 * 16 * 2 * 4);
constexpr size_t WS_LAM = WS_TAB32 + al256((size_t)128 * 32 * 2 * 4);
constexpr size_t WS_WINAB = WS_LAM + 256;
constexpr size_t WS_WUQ = WS_WINAB + (size_t)2 * AB_INP * DM * 2;
constexpr size_t WS_WUKV = WS_WUQ + (size_t)2 * 1536 * 768 * 2;
constexpr size_t WS_WOUTAB = WS_WUKV + (size_t)2 * 2048 * 512 * 2;
constexpr size_t WS_WINC = WS_WOUTAB + (size_t)2 * DM * DM * 2;
constexpr size_t WS_WOUTC = WS_WINC + (size_t)2 * C_IN * DM * 2;
constexpr size_t WS_WPQ = WS_WOUTC + (size_t)2 * DM * DM * 2;
constexpr size_t WS_SUBK = WS_WPQ + (size_t)4 * DM * DM * 2;
constexpr size_t WS_EU = WS_SUBK + (size_t)4 * 8 * 2 * 128 * 128 * 2;
constexpr int EROW = DM * 6 / 8;
constexpr size_t WS_EV = WS_EU + (size_t)4 * NEXP * DM;
constexpr size_t WS_SU = WS_EV + (size_t)4 * NEXP * DM;
constexpr size_t WS_SV = WS_SU + (size_t)4 * NEXP * 4;
constexpr size_t WS_X = WS_SV + (size_t)4 * NEXP * 4;
constexpr size_t WS_H = WS_X + (size_t)TT * DM * 4;
constexpr size_t WS_P1 = WS_H + (size_t)TT * DM * 2;
constexpr size_t WS_QA = WS_P1 + (size_t)TT * AB_INP * 2;
constexpr size_t WS_KV = WS_QA + (size_t)TT * 1536 * 2;
constexpr size_t WS_Q1 = WS_KV + (size_t)TT * 2048 * 2;
constexpr size_t WS_K1 = WS_Q1 + (size_t)TT * 2048 * 2;
constexpr size_t WS_V1 = WS_K1 + (size_t)TT * 1536 * 2;
constexpr size_t WS_Q2 = WS_V1 + (size_t)TT * 1024 * 2;
constexpr size_t WS_K2 = WS_Q2 + (size_t)TT * 1024 * 2;
constexpr size_t WS_V2 = WS_K2 + (size_t)TT * 1024 * 2;
constexpr size_t WS_OF = WS_V2 + (size_t)TT * 1024 * 2;
constexpr size_t WS_AO = WS_OF + (size_t)TT * 3072 * 4;
constexpr size_t WS_PQ = WS_AO + (size_t)TT * DM * 2;
constexpr size_t WS_PIDX = WS_PQ + (size_t)TT * DM * 2;
constexpr size_t WS_PG = WS_PIDX + (size_t)TT * 128 * 4;
constexpr size_t WS_END = WS_PG + (size_t)TT * 128 * 4;

constexpr int LDS_MAIN = 157696;
constexpr int LDS_MISC = LDS_MAIN;
constexpr int LDS_BYTES = LDS_MAIN + 4096;

__device__ __forceinline__ unsigned cvt_pk_bf16(float lo, float hi) { unsigned r; asm("v_cvt_pk_bf16_f32 %0, %1, %2" : "=v"(r) : "v"(lo), "v"(hi)); return r; }
__device__ __forceinline__ float bf_lo(unsigned w) { return __uint_as_float(w << 16); }
__device__ __forceinline__ float bf_hi(unsigned w) { return __uint_as_float(w & 0xffff0000u); }
template <int M> __device__ __forceinline__ float swz_xor(float v) { return __int_as_float(__builtin_amdgcn_ds_swizzle(__float_as_int(v), (M << 10) | 0x1f)); }
__device__ __forceinline__ float xor32_partner(float v, int lane) {
    const auto rr = __builtin_amdgcn_permlane32_swap(__float_as_uint(v), __float_as_uint(v), false, false);
    return __uint_as_float(lane < 32 ? rr[1] : rr[0]);
}
__device__ __forceinline__ float hw_sum(float v) {
    v += swz_xor<16>(v); v += swz_xor<8>(v); v += swz_xor<4>(v); v += swz_xor<2>(v); v += swz_xor<1>(v);
    return v;
}
__device__ __forceinline__ float wave_sum(float v) {
    v = hw_sum(v);
    const auto rr = __builtin_amdgcn_permlane32_swap(__float_as_uint(v), __float_as_uint(v), false, false);
    return __uint_as_float(rr[0]) + __uint_as_float(rr[1]);
}
__device__ __forceinline__ float wave_max(float v) {
    v = fmaxf(v, swz_xor<16>(v)); v = fmaxf(v, swz_xor<8>(v)); v = fmaxf(v, swz_xor<4>(v)); v = fmaxf(v, swz_xor<2>(v)); v = fmaxf(v, swz_xor<1>(v));
    const auto rr = __builtin_amdgcn_permlane32_swap(__float_as_uint(v), __float_as_uint(v), false, false);
    return fmaxf(__uint_as_float(rr[0]), __uint_as_float(rr[1]));
}
__device__ __forceinline__ int mbcnt64(unsigned long long m) { return (int)__builtin_amdgcn_mbcnt_hi((unsigned)(m >> 32), __builtin_amdgcn_mbcnt_lo((unsigned)m, 0u)); }
__device__ __forceinline__ int fresh_lane() { int l; asm volatile("v_mbcnt_lo_u32_b32 %0, -1, 0\n\tv_mbcnt_hi_u32_b32 %0, -1, %0" : "=v"(l)); return l; }
__device__ __forceinline__ int krow_of(int t) { return t < TL ? (t >> 13) * KPB + (t & (SEQ - 1)) : ((t - TL) >> 8) * KPB + SEQ + ((t - TL) & (CTXL - 1)); }
__device__ __forceinline__ int vsel_of_row(int t) { return t < SEQ ? 0 : (t < TL ? 1 : 2); }

#define XB_TMO      128
#define XB_XCNT(j)  (256  + 64 * (j))
#define XB_XSUB(j)  (1280 + 64 * (j))
#define XB_XGEN(j)  (2304 + 64 * (j))
#define XB_TOP      3328
#define XB_TOPGEN   3392
#define XCD_BAR_WORDS 3456
#define XB_SPIN_CAP (1u << 27)
__device__ __forceinline__ unsigned xb_ld(unsigned* p)              { return __hip_atomic_load(p, __ATOMIC_RELAXED, __HIP_MEMORY_SCOPE_AGENT); }
__device__ __forceinline__ unsigned xb_add(unsigned* p, unsigned v) { return __hip_atomic_fetch_add(p, v, __ATOMIC_RELAXED, __HIP_MEMORY_SCOPE_AGENT); }
__device__ __forceinline__ unsigned xb_xcc_id() { return (unsigned)__builtin_amdgcn_s_getreg((3 << 11) | 20) & 0xFu; }
#define XB_SPIN(cond, bar) do { unsigned _sp = 0; while (cond) { __builtin_amdgcn_s_sleep(1); \
    if ((++_sp & 255u) == 0u) { if (xb_ld(&(bar)[XB_TMO])) break; if (_sp > XB_SPIN_CAP) { atomicAdd(&(bar)[XB_TMO], 1u); break; } } } } while (0)
struct XcdBarrier { unsigned* bar; unsigned x; volatile LAS unsigned* st; };
__device__ __forceinline__ XcdBarrier xcd_barrier_post(unsigned* bar, volatile LAS unsigned* st) {
    XcdBarrier b; b.bar = bar; b.x = xb_xcc_id(); b.st = st;
    if (threadIdx.x == 0) (void)xb_add(&bar[XB_XCNT(b.x)], 1u);
    return b;
}
__device__ __forceinline__ void xcd_barrier_complete(unsigned* bar, unsigned x, unsigned& nloc, unsigned& nx) {
    asm volatile("" : "+s"(x));
    const unsigned G = gridDim.x * gridDim.y * gridDim.z;
    unsigned sum, cnt, mine, sp = 0u;
    for (;;) {
        sum = 0u; cnt = 0u; mine = 0u;
#pragma unroll
        for (unsigned j = 0; j < 16; ++j) { const unsigned c = xb_ld(&bar[XB_XCNT(j)]); sum += c; cnt += (c > 0u) ? 1u : 0u; mine = (j == x) ? c : mine; }
        if (sum == G) break;
        __builtin_amdgcn_s_sleep(1);
        if ((++sp & 255u) == 0u) { if (xb_ld(&bar[XB_TMO])) break; if (sp > XB_SPIN_CAP) { atomicAdd(&bar[XB_TMO], 1u); break; } }
    }
    nloc = mine > 0u ? mine : 1u; nx = cnt > 0u ? cnt : 1u;
}
__device__ __forceinline__ void xcd_barrier(const XcdBarrier& b, const bool thread0  ) {
    asm volatile("s_waitcnt vmcnt(0)" ::: "memory");
    __syncthreads();
    if (thread0) {
        unsigned* bar = b.bar;
        __builtin_amdgcn_s_waitcnt(0);
        unsigned nloc = b.st[0], nx = b.st[1];
        if (nloc == 0u) { xcd_barrier_complete(bar, b.x, nloc, nx); b.st[0] = nloc; b.st[1] = nx; }
        const unsigned old = xb_add(&bar[XB_XSUB(b.x)], 1u);
        const unsigned gen = old / nloc;
        if (old + 1u == (gen + 1u) * nloc) {
            __builtin_amdgcn_fence(__ATOMIC_RELEASE, "agent");
            asm volatile("s_waitcnt vmcnt(0)" ::: "memory");
            const unsigned og = xb_add(&bar[XB_TOP], 1u);
            const unsigned tg = og / nx;
            if (og + 1u == (tg + 1u) * nx) xb_add(&bar[XB_TOPGEN], 1u);
            else XB_SPIN(xb_ld(&bar[XB_TOPGEN]) == tg, bar);
            __builtin_amdgcn_fence(__ATOMIC_ACQUIRE, "agent");
            xb_add(&bar[XB_XGEN(b.x)], 1u);
            asm volatile("s_waitcnt vmcnt(0)" ::: "memory");
        } else {
            XB_SPIN(xb_ld(&bar[XB_XGEN(b.x)]) == gen, bar);
            __builtin_amdgcn_fence(__ATOMIC_ACQUIRE, "agent");
            asm volatile("s_waitcnt vmcnt(0)" ::: "memory");
        }
    }
    __syncthreads();
}

namespace pg8 {
constexpr int BM = 256, BK = 64, HALF = 128, HTB = HALF * BK * 2, STAGE_BYTES = 8 * HTB, NXCD = 8, WGM = 8;
__host__ __device__ __forceinline__ int lds_byte(int r, int c) { const int st = (r >> 4) * 2 + (c >> 5), rr = r & 15, cc = c & 31, ob = rr * 64 + cc * 2; return st * 1024 + (ob ^ (((ob >> 9) & 1) << 5)); }
__host__ __device__ __forceinline__ void stage_rc(int b, int& R, int& C) { const int st = b / 1024, sb = b % 1024, swz = sb ^ (((sb >> 9) & 1) << 5); R = (st >> 1) * 16 + swz / 64; C = (st & 1) * 32 + (swz % 64) / 2; }
__host__ __device__ __forceinline__ int perm32(int rho) { const int n = rho >> 4, i = rho & 15; return 8 * (i >> 2) + 4 * n + (i & 3); }
struct Unit { int pm, pn; };
struct Gemm { const bf16_t* A; const bf16_t* Bt; int M, N, K, lda; };
struct StaticOrder {
    int nM, nN, nwg, G, c;
    __host__ __device__ void init(int M, int N, int G_, int c_) { nM = M / BM; nN = N / BM; nwg = nM * nN; G = G_; c = c_; }
    __host__ __device__ bool next(int i, Unit& u) const {
        const long L = (long)i * G + c; if (L >= nwg) return false;
        int wgid = (int)L; { const int q = nwg / NXCD, r = nwg % NXCD, xcd = wgid % NXCD, off = wgid / NXCD; wgid = (xcd < r ? xcd * (q + 1) : r * (q + 1) + (xcd - r) * q) + off; }
        const int nig = WGM * nN, gid = wgid / nig, fm = gid * WGM, gsz = (nM - fm) < WGM ? (nM - fm) : WGM;
        u.pm = fm + ((wgid % nig) % gsz); u.pn = (wgid % nig) / gsz; return true;
    }
    __device__ __forceinline__ void a_ready(const Unit&) const {}
    __device__ __forceinline__ void done(const Unit&) const {}
};
struct EpiBf16 {
    static constexpr bool PERM = true;
    bf16_t* O; int ldc;
    __device__ __forceinline__ void operator()(const f32x4 (&acc)[2][2][4][2], const Unit& u, int wr, int wc, int fr, int fq) const {
        const int row0 = u.pm * BM + wr * 64 + fr; const int col0 = u.pn * BM + wc * 32 + 8 * fq;
#pragma unroll
        for (int ai = 0; ai < 2; ++ai)
#pragma unroll
            for (int m = 0; m < 4; ++m) { bf16_t* rowp = O + (size_t)(row0 + ai * HALF + m * 16) * ldc + col0;
#pragma unroll
                for (int bj = 0; bj < 2; ++bj) { const f32x4 v0 = acc[ai][bj][m][0], v1 = acc[ai][bj][m][1];
                    u32x4 w; w.x = cvt_pk_bf16(v0[0], v0[1]); w.y = cvt_pk_bf16(v0[2], v0[3]); w.z = cvt_pk_bf16(v1[0], v1[1]); w.w = cvt_pk_bf16(v1[2], v1[3]);
                    *(u32x4*)(rowp + bj * HALF) = w; } }
    }
};
struct EpiResid {
    static constexpr bool PERM = false;
    float* X; const float* modl; int chunk;
    __device__ __forceinline__ void operator()(const f32x4 (&acc)[2][2][4][2], const Unit& u, int wr, int wc, int fr, int fq) const {
        const int row0 = u.pm * BM + wr * 64 + fr, col0 = u.pn * BM + wc * 32 + 4 * fq;
        const int vs = u.pm < 32 ? 0 : (u.pm < 64 ? 1 : 2);
        const float* gate = modl + (size_t)vs * 12288 + chunk * 2048 + col0;
        f32x4 gv[2][2];
#pragma unroll
        for (int bj = 0; bj < 2; ++bj)
#pragma unroll
            for (int n = 0; n < 2; ++n) gv[bj][n] = *(const f32x4*)(gate + bj * HALF + n * 16);
#pragma unroll
        for (int ai = 0; ai < 2; ++ai)
#pragma unroll
            for (int m = 0; m < 4; ++m) { float* rowp = X + (size_t)(row0 + ai * HALF + m * 16) * DM + col0;
#pragma unroll
                for (int bj = 0; bj < 2; ++bj)
#pragma unroll
                    for (int n = 0; n < 2; ++n) { float* p = rowp + bj * HALF + n * 16; const f32x4 xo = *(const f32x4*)p; *(f32x4*)p = xo + gv[bj][n] * acc[ai][bj][m][n]; } }
    }
};

template <class Epi, class Sched>
__device__ __forceinline__ void gemm_phase(LAS unsigned char* lds, const Gemm g, const Sched& S, const Epi& E, int tid_in) {
    const int tid_l = tid_in * 64 + fresh_lane();
    const int tid = tid_l, wid = tid_in  , lane = tid & 63, wr = wid >> 2, wc = wid & 3, fr = lane & 15, fq = lane >> 4;
    const int K = g.K, nt = K / BK, lda = g.lda;
    unsigned voffA[2], voffB[2];
#pragma unroll
    for (int i = 0; i < 2; ++i) { int R, C; stage_rc(tid * 16 + i * 8192, R, C); const int Rb = Epi::PERM ? ((R & ~31) + perm32(R & 31)) : R;
        voffA[i] = (unsigned)(R * lda + C) * 2u; voffB[i] = (unsigned)(Rb * K + C) * 2u; }
    const size_t kstep = (size_t)(BK * 2);
    const size_t hstepA = (size_t)HALF * lda * 2, hstepB = (size_t)HALF * K * 2;
    const size_t tstepA = 2 * hstepA, tstepB = 2 * hstepB;
    const unsigned ldsw = (unsigned)wid * 1024u;
    const int aoff = lds_byte(wr * 64 + fr, fq * 8), boff = lds_byte(wc * 32 + fr, fq * 8);
#define PG8_SA(b, h) (((b) * 2 + (h)) * HTB)
#define PG8_SB(b, h) ((4 + (b) * 2 + (h)) * HTB)
#define PG8_STAGE(bufoff, gbase, voff) do { _Pragma("unroll") for (int _i = 0; _i < 2; ++_i) \
        __builtin_amdgcn_global_load_lds((const unsigned*)((const char*)(gbase) + (voff)[_i]), (LAS unsigned*)(lds + (bufoff) + ldsw + _i * 8192), 16, 0, 0); } while (0)
#define PG8_LDA(dst, b, h) do { _Pragma("unroll") for (int m = 0; m < 4; ++m) _Pragma("unroll") for (int k = 0; k < 2; ++k) dst[m][k] = *(const LAS bf16x8*)(lds + PG8_SA(b, h) + aoff + m * 2048 + k * 1024); } while (0)
#define PG8_LDB(dst, b, h) do { _Pragma("unroll") for (int n = 0; n < 2; ++n) _Pragma("unroll") for (int k = 0; k < 2; ++k) dst[n][k] = *(const LAS bf16x8*)(lds + PG8_SB(b, h) + boff + n * 2048 + k * 1024); } while (0)
#define PG8_MMA(ai, bj, At, Bt) do { __builtin_amdgcn_s_setprio(1); _Pragma("unroll") for (int m = 0; m < 4; ++m) _Pragma("unroll") for (int n = 0; n < 2; ++n) _Pragma("unroll") for (int k = 0; k < 2; ++k) \
        acc[ai][bj][m][n] = __builtin_amdgcn_mfma_f32_16x16x32_bf16(Bt[n][k], At[m][k], acc[ai][bj][m][n], 0, 0, 0); __builtin_amdgcn_s_setprio(0); } while (0)
#define PG8_WAIT_V(n) asm volatile("s_waitcnt vmcnt(" #n ")" ::: "memory")
#define PG8_WAIT_L(n) asm volatile("s_waitcnt lgkmcnt(" #n ")" ::: "memory")
#define PG8_BAR __builtin_amdgcn_s_barrier()
#define PG8_SCHED __builtin_amdgcn_sched_barrier(0)
    Unit cur, nxt; int ui = 0;
    if (!S.next(0, cur)) return;
    f32x4 acc[2][2][4][2];
#pragma unroll
    for (int a = 0; a < 2; ++a)
#pragma unroll
        for (int b = 0; b < 2; ++b)
#pragma unroll
            for (int m = 0; m < 4; ++m)
#pragma unroll
                for (int n = 0; n < 2; ++n) acc[a][b][m][n] = (f32x4){0.f, 0.f, 0.f, 0.f};
    bf16x8 At[4][2], B0[2][2], B1[2][2];
    const char* cA = (const char*)g.A + (size_t)cur.pm * tstepA; const char* cB = (const char*)g.Bt + (size_t)cur.pn * tstepB;
    S.a_ready(cur);
    PG8_STAGE(PG8_SB(0, 0), cB, voffB); PG8_STAGE(PG8_SA(0, 0), cA, voffA); PG8_STAGE(PG8_SB(0, 1), cB + hstepB, voffB); PG8_STAGE(PG8_SA(0, 1), cA + hstepA, voffA);
    if (wr == 1) PG8_BAR;
    PG8_WAIT_V(4); PG8_BAR;
    PG8_STAGE(PG8_SB(1, 0), cB + kstep, voffB); PG8_STAGE(PG8_SA(1, 0), cA + kstep, voffA); PG8_STAGE(PG8_SB(1, 1), cB + hstepB + kstep, voffB);
    PG8_WAIT_V(6); PG8_BAR;
    for (;;) {
        const bool has_next = S.next(ui + 1, nxt);
        const char* nA = has_next ? (const char*)g.A + (size_t)nxt.pm * tstepA : cA; const char* nB = has_next ? (const char*)g.Bt + (size_t)nxt.pn * tstepB : cB;
        for (int t = 0; t < nt; t += 2) {
            const bool last = (t == nt - 2);
            const char* a1 = cA + (size_t)(t + 1) * kstep;
            const char* a2 = last ? nA : cA + (size_t)(t + 2) * kstep; const char* b2 = last ? nB : cB + (size_t)(t + 2) * kstep;
            const char* a3 = a2 + kstep; const char* b3 = b2 + kstep;
            if (last && has_next) S.a_ready(nxt);
            PG8_LDB(B0, 0, 0); PG8_SCHED; PG8_LDA(At, 0, 0); PG8_STAGE(PG8_SA(1, 1), a1 + hstepA, voffA);
            PG8_WAIT_L(8); PG8_BAR; PG8_WAIT_L(0); PG8_MMA(0, 0, At, B0); PG8_BAR; PG8_SCHED;
            PG8_LDB(B1, 0, 1); PG8_STAGE(PG8_SB(0, 0), b2, voffB);
            PG8_BAR; PG8_WAIT_L(0); PG8_MMA(0, 1, At, B1); PG8_BAR;
            PG8_LDA(At, 0, 1); PG8_STAGE(PG8_SA(0, 0), a2, voffA);
            PG8_BAR; PG8_WAIT_L(0); PG8_MMA(1, 0, At, B0); PG8_BAR; PG8_SCHED;
            PG8_STAGE(PG8_SB(0, 1), b2 + hstepB, voffB);
            PG8_WAIT_V(6); PG8_BAR; PG8_MMA(1, 1, At, B1); PG8_BAR;
            PG8_LDB(B0, 1, 0); PG8_SCHED; PG8_LDA(At, 1, 0); PG8_STAGE(PG8_SA(0, 1), a2 + hstepA, voffA);
            PG8_WAIT_L(8); PG8_BAR; PG8_WAIT_L(0); PG8_MMA(0, 0, At, B0); PG8_BAR; PG8_SCHED;
            PG8_LDB(B1, 1, 1); PG8_STAGE(PG8_SB(1, 0), b3, voffB);
            PG8_BAR; PG8_WAIT_L(0); PG8_MMA(0, 1, At, B1); PG8_BAR;
            PG8_LDA(At, 1, 1); PG8_STAGE(PG8_SA(1, 0), a3, voffA);
            PG8_BAR; PG8_WAIT_L(0); PG8_MMA(1, 0, At, B0); PG8_BAR; PG8_SCHED;
            PG8_STAGE(PG8_SB(1, 1), b3 + hstepB, voffB);
            PG8_WAIT_V(6); PG8_BAR; PG8_MMA(1, 1, At, B1); PG8_BAR;
        }
        E(acc, cur, wr, wc, fr, fq); S.done(cur);
        if (!has_next) break;
#pragma unroll
        for (int a = 0; a < 2; ++a)
#pragma unroll
            for (int b = 0; b < 2; ++b)
#pragma unroll
                for (int m = 0; m < 4; ++m)
#pragma unroll
                    for (int n = 0; n < 2; ++n) acc[a][b][m][n] = (f32x4){0.f, 0.f, 0.f, 0.f};
        cur = nxt; cA = nA; cB = nB; ++ui;
    }
    PG8_WAIT_V(0);
    if (wr == 0) PG8_BAR;
    PG8_BAR;
#undef PG8_SA
#undef PG8_SB
#undef PG8_STAGE
#undef PG8_LDA
#undef PG8_LDB
#undef PG8_MMA
#undef PG8_WAIT_V
#undef PG8_WAIT_L
#undef PG8_BAR
#undef PG8_SCHED
}
}

namespace att {
constexpr int NW = 8, QBLK = 32, KVBLK = 64, DV = 128;
constexpr float THR = 8.f;
constexpr int SHM_V = KVBLK * DV * 2;
#define SBAR() __builtin_amdgcn_sched_barrier(0)
__device__ __forceinline__ int crow(int r, int hi) { return (r & 3) + 8 * (r >> 2) + 4 * hi; }
__device__ __forceinline__ unsigned cvtpk(float lo, float hi) { unsigned r; asm volatile("v_cvt_pk_bf16_f32 %0, %1, %2" : "=v"(r) : "v"(lo), "v"(hi)); return r; }
__device__ __forceinline__ void partialSM(f32x16& p0, f32x16& p1, float& m_reg, float& mn, float& alpha, const float C, const float thr_raw) {
    float pmax = p0[0];
#pragma unroll
    for (int r = 1; r < 16; ++r) pmax = fmaxf(pmax, p0[r]);
#pragma unroll
    for (int r = 0; r < 16; ++r) pmax = fmaxf(pmax, p1[r]);
    { auto rr = __builtin_amdgcn_permlane32_swap(__float_as_uint(pmax), __float_as_uint(pmax), false, false);
      pmax = fmaxf(__uint_as_float(rr[0]), __uint_as_float(rr[1])); }
    if (__builtin_expect(__all(pmax - m_reg <= thr_raw), 1)) { mn = m_reg; alpha = 1.f; }
    else { mn = fmaxf(m_reg, pmax); alpha = __builtin_amdgcn_exp2f((m_reg - mn) * C); m_reg = mn; }
    const float mnC = -mn * C;
#pragma unroll
    for (int r = 0; r < 16; ++r) p0[r] = fmaf(p0[r], C, mnC);
#pragma unroll
    for (int r = 0; r < 16; ++r) p1[r] = fmaf(p1[r], C, mnC);
#pragma unroll
    for (int r = 0; r < 16; ++r) p0[r] = __builtin_amdgcn_exp2f(p0[r]);
}
__device__ __forceinline__ void finishSM(f32x16& p0, f32x16& p1, float alpha, float& l_reg, bf16x8& pa0, bf16x8& pa1, bf16x8& pa2, bf16x8& pa3) {
#pragma unroll
    for (int r = 0; r < 16; ++r) p1[r] = __builtin_amdgcn_exp2f(p1[r]);
    float ps = 0;
#pragma unroll
    for (int r = 0; r < 16; ++r) ps += p0[r];
#pragma unroll
    for (int r = 0; r < 16; ++r) ps += p1[r];
    { auto rr = __builtin_amdgcn_permlane32_swap(__float_as_uint(ps), __float_as_uint(ps), false, false);
      ps = __uint_as_float(rr[0]) + __uint_as_float(rr[1]); }
    l_reg = l_reg * alpha + ps;
#define PK4(P, BASE, OUT) do { unsigned a0 = cvtpk(P[BASE + 0], P[BASE + 1]), a1 = cvtpk(P[BASE + 2], P[BASE + 3]);   \
    unsigned b0 = cvtpk(P[BASE + 4], P[BASE + 5]), b1 = cvtpk(P[BASE + 6], P[BASE + 7]);                              \
    auto r0 = __builtin_amdgcn_permlane32_swap(a0, b0, false, false); auto r1 = __builtin_amdgcn_permlane32_swap(a1, b1, false, false); \
    u32x4 w = {r0[0], r1[0], r0[1], r1[1]}; OUT = *reinterpret_cast<bf16x8*>(&w); } while (0)
    PK4(p0, 0, pa0); PK4(p0, 8, pa1); PK4(p1, 0, pa2); PK4(p1, 8, pa3);
#undef PK4
}
__device__ __forceinline__ void partialSM_nm(f32x16& p0) {
#pragma unroll
    for (int r = 0; r < 16; ++r) p0[r] = __builtin_amdgcn_exp2f(p0[r]);
}
template <int DQK, int QL>
__device__ __forceinline__ void qkt(f32x16& p0, f32x16& p1, const char* Ks, const bf16x8 (&qr)[DQK / 16 - QL], const char* qpark, int r32, int hi) {
    constexpr int RS = DQK * 2 + 16, NQR = DQK / 16 - QL, GRP = (DQK > 128) ? QKT_GRP : DQK / 16;
    p0 = f32x16{}; p1 = f32x16{};
#pragma unroll
    for (int g0 = 0; g0 < DQK / 16; g0 += GRP) {
#pragma unroll
        for (int d0 = g0; d0 < g0 + GRP; ++d0) { const int cb = (d0 * 16 + hi * 8) * 2;
            const bf16x8 b0 = *reinterpret_cast<const bf16x8*>(Ks + r32 * RS + cb);
            const bf16x8 b1 = *reinterpret_cast<const bf16x8*>(Ks + (32 + r32) * RS + cb);
            bf16x8 qf; if (d0 < NQR) qf = qr[d0 < NQR ? d0 : 0]; else qf = *reinterpret_cast<const bf16x8*>(qpark + (d0 - NQR) * 1024);
            p0 = __builtin_amdgcn_mfma_f32_32x32x16_bf16(b0, qf, p0, 0, 0, 0);
            p1 = __builtin_amdgcn_mfma_f32_32x32x16_bf16(b1, qf, p1, 0, 0, 0); }
        if (g0 + GRP < DQK / 16) SBAR();
    }
}
__device__ __forceinline__ int v_st(int k, int c) { const int kk = (k & ~0xC) | ((k & 4) << 1) | ((k & 8) >> 1); return ((kk >> 3) * 4 + (c >> 5)) * 512 + ((kk & 7) * 32 + (c & 31)) * 2; }
__device__ __forceinline__ int v_rd_base(int lane) { return ((lane & 3) << 3) | (((lane >> 2) & 3) << 6) | (((lane >> 4) & 1) << 5) | (((lane >> 5) & 1) << 8); }
constexpr int v_rd_off(int d0, int ks, int half) { return d0 * 512 + ks * 4096 + half * 2048; }
template <int OFF> __device__ __forceinline__ s16x4 tr_read(int vb) {
    s16x4 r; asm volatile("ds_read_b64_tr_b16 %0, %1 offset:%2" : "=&v"(r) : "v"(vb), "i"(OFF) : "memory"); return r;
}
template <int D0> __device__ __forceinline__ void pv_one(f32x16& od, int vb, bf16x8 pa0, bf16x8 pa1, bf16x8 pa2, bf16x8 pa3) {
    const s16x4 l0 = tr_read<v_rd_off(D0, 0, 0)>(vb), h0 = tr_read<v_rd_off(D0, 0, 1)>(vb), l1 = tr_read<v_rd_off(D0, 1, 0)>(vb), h1 = tr_read<v_rd_off(D0, 1, 1)>(vb);
    const s16x4 l2 = tr_read<v_rd_off(D0, 2, 0)>(vb), h2 = tr_read<v_rd_off(D0, 2, 1)>(vb), l3 = tr_read<v_rd_off(D0, 3, 0)>(vb), h3 = tr_read<v_rd_off(D0, 3, 1)>(vb);
    asm volatile("s_waitcnt lgkmcnt(0)" ::: "memory"); SBAR();
#define PK(L, H) (bf16x8){L[0], L[1], L[2], L[3], H[0], H[1], H[2], H[3]}
    od = __builtin_amdgcn_mfma_f32_32x32x16_bf16(pa0, PK(l0, h0), od, 0, 0, 0);
    od = __builtin_amdgcn_mfma_f32_32x32x16_bf16(pa1, PK(l1, h1), od, 0, 0, 0);
    od = __builtin_amdgcn_mfma_f32_32x32x16_bf16(pa2, PK(l2, h2), od, 0, 0, 0);
    od = __builtin_amdgcn_mfma_f32_32x32x16_bf16(pa3, PK(l3, h3), od, 0, 0, 0);
#undef PK
}
__device__ __forceinline__ void pv_d0(f32x16* o, int vb, bf16x8 pa0, bf16x8 pa1, bf16x8 pa2, bf16x8 pa3) {
    pv_one<0>(o[0], vb, pa0, pa1, pa2, pa3); pv_one<1>(o[1], vb, pa0, pa1, pa2, pa3); pv_one<2>(o[2], vb, pa0, pa1, pa2, pa3); pv_one<3>(o[3], vb, pa0, pa1, pa2, pa3);
}
struct VFrag { s16x4 l0, h0, l1, h1, l2, h2, l3, h3; };
template <int D0> __device__ __forceinline__ void pv_rd(VFrag& f, int vb) {
    f.l0 = tr_read<v_rd_off(D0, 0, 0)>(vb); f.h0 = tr_read<v_rd_off(D0, 0, 1)>(vb); f.l1 = tr_read<v_rd_off(D0, 1, 0)>(vb); f.h1 = tr_read<v_rd_off(D0, 1, 1)>(vb);
    f.l2 = tr_read<v_rd_off(D0, 2, 0)>(vb); f.h2 = tr_read<v_rd_off(D0, 2, 1)>(vb); f.l3 = tr_read<v_rd_off(D0, 3, 0)>(vb); f.h3 = tr_read<v_rd_off(D0, 3, 1)>(vb);
}
__device__ __forceinline__ void pv_mm(f32x16& od, const VFrag& f, bf16x8 pa0, bf16x8 pa1, bf16x8 pa2, bf16x8 pa3) {
#define PK(L, H) (bf16x8){L[0], L[1], L[2], L[3], H[0], H[1], H[2], H[3]}
    od = __builtin_amdgcn_mfma_f32_32x32x16_bf16(pa0, PK(f.l0, f.h0), od, 0, 0, 0);
    od = __builtin_amdgcn_mfma_f32_32x32x16_bf16(pa1, PK(f.l1, f.h1), od, 0, 0, 0);
    od = __builtin_amdgcn_mfma_f32_32x32x16_bf16(pa2, PK(f.l2, f.h2), od, 0, 0, 0);
    od = __builtin_amdgcn_mfma_f32_32x32x16_bf16(pa3, PK(f.l3, f.h3), od, 0, 0, 0);
#undef PK
}
__device__ __forceinline__ void pv_d0_pipe(f32x16* o, int vb, bf16x8 pa0, bf16x8 pa1, bf16x8 pa2, bf16x8 pa3) {
    VFrag fa, fb;
    pv_rd<0>(fa, vb); pv_rd<1>(fb, vb);
    asm volatile("s_waitcnt lgkmcnt(8)" ::: "memory"); SBAR(); pv_mm(o[0], fa, pa0, pa1, pa2, pa3); SBAR();
    pv_rd<2>(fa, vb);
    asm volatile("s_waitcnt lgkmcnt(8)" ::: "memory"); SBAR(); pv_mm(o[1], fb, pa0, pa1, pa2, pa3); SBAR();
    pv_rd<3>(fb, vb);
    asm volatile("s_waitcnt lgkmcnt(8)" ::: "memory"); SBAR(); pv_mm(o[2], fa, pa0, pa1, pa2, pa3); SBAR();
    asm volatile("s_waitcnt lgkmcnt(0)" ::: "memory"); SBAR(); pv_mm(o[3], fb, pa0, pa1, pa2, pa3);
}
template <int DQK> struct ScaleOf { static constexpr float scale = DQK == 192 ? 0.07216878364870322f : (DQK == 128 ? 0.08838834764831845f : 0.125f); };
template <int DQK, int SDEPTH, int QL, bool NOMAX, int ldq, int ldk, int ldv, int ldo>
__device__ __forceinline__ void attn_body(const bf16_t* __restrict__ Qb, const bf16_t* __restrict__ Kh, const bf16_t* __restrict__ Vh,
                                          bf16_t* __restrict__ Ob, int seq, char* lds, int tid_in, const float negMC) {
    constexpr float C = 1.0f, thr_raw = THR * 1.4426950408889634f;
    constexpr int RS = DQK * 2 + 16  , SHM_K = KVBLK * RS, NKP = DQK / 64, KPR = DQK / 8;
    const int tid_l = tid_in * 64 + fresh_lane();
    const int tid = tid_l, wid = tid_in  , lane = tid & 63, r32 = lane & 31, hi = lane >> 5;
    char* V_lds = lds; char* K_lds = lds + 2 * SHM_V;
    float* ws = (float*)(lds + 2 * SHM_V + 2 * SHM_K) + wid * 64; float* li_l = ws; float* al_l = ws + 32;
    constexpr int NQR = DQK / 16 - QL;
    char* qpark = lds + 2 * SHM_V + 2 * SHM_K + 2048 + wid * (QL * 1024) + lane * 16;
    float m_reg = -1e30f, l_reg = 0; f32x16 o[4] = {}; bf16x8 qr[NQR];
    const bf16_t* Qw = Qb + (size_t)(wid * QBLK + r32) * ldq + hi * 8;
#pragma unroll
    for (int d0 = 0; d0 < NQR; ++d0) qr[d0] = *reinterpret_cast<const bf16x8*>(Qw + d0 * 16);
#pragma unroll
    for (int d0 = 0; d0 < QL; ++d0) *(bf16x8*)(qpark + d0 * 1024) = *reinterpret_cast<const bf16x8*>(Qw + (NQR + d0) * 16);
    const int sr = tid >> 4, sc = (tid & 15) * 8, vst0 = v_st(sr, sc), vst1 = v_st(32 + sr, sc);
    int koff[NKP], klds[NKP];
#pragma unroll
    for (int i = 0; i < NKP; ++i) { const int row = tid >> 3, c8 = (tid & 7) + 8 * i; koff[i] = row * ldk + c8 * 8; klds[i] = row * RS + c8 * 16; }
    const int vb0 = (int)(uintptr_t)V_lds + v_rd_base(lane);
    bf16x8 sv0[SDEPTH], sv1[SDEPTH], sk[SDEPTH][NKP];
#define SLOAD(i, k0) do { sv0[i] = *reinterpret_cast<const bf16x8*>(&Vh[(size_t)((k0) + sr) * ldv + sc]); sv1[i] = *reinterpret_cast<const bf16x8*>(&Vh[(size_t)((k0) + 32 + sr) * ldv + sc]); \
    _Pragma("unroll") for (int _q = 0; _q < NKP; ++_q) sk[i][_q] = *reinterpret_cast<const bf16x8*>(&Kh[(size_t)(k0) * ldk + koff[_q]]); } while (0)
#define SWRITE(b, i) do { *(bf16x8*)(V_lds + (b) * SHM_V + vst0) = sv0[i]; *(bf16x8*)(V_lds + (b) * SHM_V + vst1) = sv1[i]; \
    _Pragma("unroll") for (int _q = 0; _q < NKP; ++_q) *(bf16x8*)(K_lds + (b) * SHM_K + klds[_q]) = sk[i][_q]; } while (0)
#define SWAIT() do { if constexpr (SDEPTH == 2) { if constexpr (NKP == 1) asm volatile("s_waitcnt vmcnt(3)" ::: "memory"); else if constexpr (NKP == 2) asm volatile("s_waitcnt vmcnt(4)" ::: "memory"); else asm volatile("s_waitcnt vmcnt(5)" ::: "memory"); } \
    else asm volatile("s_waitcnt vmcnt(0)" ::: "memory"); } while (0)
#define PVD0(...) do { if constexpr (PV_PIPE != 0) pv_d0_pipe(__VA_ARGS__); else pv_d0(__VA_ARGS__); } while (0)
#define RESC(a) do { if constexpr (!NOMAX) if (__any((a) < 1.f)) { if (hi == 0) al_l[r32] = (a); asm volatile("s_waitcnt lgkmcnt(0)" ::: "memory"); \
    _Pragma("unroll") for (int d = 0; d < 4; ++d) _Pragma("unroll") for (int r = 0; r < 16; ++r) o[d][r] *= al_l[crow(r, hi)]; } } while (0)
    f32x16 pA0, pA1, pB0, pB1; float mnA, mnB, alA, alB; bf16x8 pa0, pa1, pa2, pa3; const int NT = seq / KVBLK;
    constexpr int SE = 0, SO = SDEPTH - 1;
    SLOAD(SE, 0); asm volatile("s_waitcnt vmcnt(0)" ::: "memory"); SWRITE(0, SE); __syncthreads();
    qkt<DQK, QL>(pA0, pA1, K_lds, qr, qpark, r32, hi); if constexpr (NOMAX) { partialSM_nm(pA0); alA = 1.f; } else partialSM(pA0, pA1, m_reg, mnA, alA, C, thr_raw);
    SLOAD(SO, KVBLK); if constexpr (SDEPTH == 2) { if (2 < NT) SLOAD(SE, 2 * KVBLK); }
    SWAIT(); SWRITE(1, SO); __syncthreads();
    for (int j = 1; j + 1 < NT; j += 2) {
        SBAR(); qkt<DQK, QL>(pB0, pB1, K_lds + SHM_K, qr, qpark, r32, hi);
        finishSM(pA0, pA1, alA, l_reg, pa0, pa1, pa2, pa3); SBAR();
        SLOAD(SO, (j + SDEPTH) * KVBLK); SBAR();
        PVD0(o, vb0, pa0, pa1, pa2, pa3); if constexpr (NOMAX) { partialSM_nm(pB0); alB = 1.f; } else partialSM(pB0, pB1, m_reg, mnB, alB, C, thr_raw);
        __syncthreads(); SWAIT(); SWRITE(0, SE);
        RESC(alB); __syncthreads();
        SBAR(); qkt<DQK, QL>(pA0, pA1, K_lds, qr, qpark, r32, hi);
        finishSM(pB0, pB1, alB, l_reg, pa0, pa1, pa2, pa3); SBAR();
        if (SDEPTH == 1 || j + 3 < NT) SLOAD(SE, (j + 1 + SDEPTH) * KVBLK); SBAR();
        PVD0(o, vb0 + SHM_V, pa0, pa1, pa2, pa3); if constexpr (NOMAX) { partialSM_nm(pA0); alA = 1.f; } else partialSM(pA0, pA1, m_reg, mnA, alA, C, thr_raw);
        __syncthreads(); SWAIT(); SWRITE(1, SO);
        RESC(alA); __syncthreads();
    }
    SBAR(); qkt<DQK, QL>(pB0, pB1, K_lds + SHM_K, qr, qpark, r32, hi);
    finishSM(pA0, pA1, alA, l_reg, pa0, pa1, pa2, pa3); SBAR();
    PVD0(o, vb0, pa0, pa1, pa2, pa3); if constexpr (NOMAX) { partialSM_nm(pB0); alB = 1.f; } else partialSM(pB0, pB1, m_reg, mnB, alB, C, thr_raw);
    __syncthreads(); RESC(alB);
    finishSM(pB0, pB1, alB, l_reg, pa0, pa1, pa2, pa3); SBAR();
    PVD0(o, vb0 + SHM_V, pa0, pa1, pa2, pa3);
    if (hi == 0) li_l[r32] = l_reg; asm volatile("s_waitcnt lgkmcnt(0)" ::: "memory");
    float rli[16];
#pragma unroll
    for (int r = 0; r < 16; ++r) rli[r] = __builtin_amdgcn_rcpf(li_l[crow(r, hi)]);
    bf16_t* Ow = Ob + (size_t)(wid * QBLK) * ldo + (r32 & ~1);
    const bool odd = (r32 & 1) != 0;
#pragma unroll
    for (int r = 0; r < 16; r += 2) { const int orow = crow(r, hi) + (odd ? 1 : 0);
#pragma unroll
        for (int d0 = 0; d0 < 4; ++d0) { const float a = o[d0][r] * rli[r], b = o[d0][r + 1] * rli[r + 1];
            const float recv = swz_xor<1>(odd ? a : b);
            const unsigned w = odd ? cvtpk(recv, b) : cvtpk(a, recv);
            *(unsigned*)(Ow + (size_t)orow * ldo + d0 * 32) = w; } }
    __syncthreads();
#undef SLOAD
#undef SWRITE
#undef SWAIT
#undef RESC
#undef PVD0
}
template <int DQK, int QL, int ldq, int ldk, int ldv, int ldo>
__device__ __forceinline__ void attn_body_simple(const bf16_t* __restrict__ Qb, const bf16_t* __restrict__ Kh, const bf16_t* __restrict__ Vh,
                                                 bf16_t* __restrict__ Ob, int seq, char* lds, int tid_in) {
    constexpr float C = 1.0f, thr_raw = THR * 1.4426950408889634f;
    constexpr int RS = DQK * 2 + 16  , SHM_K = KVBLK * RS, NKP = DQK / 64, KPR = DQK / 8;
    const int tid_l = tid_in * 64 + fresh_lane();
    const int tid = tid_l, wid = tid_in  , lane = tid & 63, r32 = lane & 31, hi = lane >> 5;
    char* V_lds = lds; char* K_lds = lds + 2 * SHM_V;
    float* ws = (float*)(lds + 2 * SHM_V + 2 * SHM_K) + wid * 64; float* li_l = ws; float* al_l = ws + 32;
    constexpr int NQR = DQK / 16 - QL;
    char* qpark = lds + 2 * SHM_V + 2 * SHM_K + 2048 + wid * (QL * 1024) + lane * 16;
    float m_reg = -1e30f, l_reg = 0; f32x16 o[4] = {}; bf16x8 qr[NQR];
    const bf16_t* Qw = Qb + (size_t)(wid * QBLK + r32) * ldq + hi * 8;
#pragma unroll
    for (int d0 = 0; d0 < NQR; ++d0) qr[d0] = *reinterpret_cast<const bf16x8*>(Qw + d0 * 16);
#pragma unroll
    for (int d0 = 0; d0 < QL; ++d0) *(bf16x8*)(qpark + d0 * 1024) = *reinterpret_cast<const bf16x8*>(Qw + (NQR + d0) * 16);
    const int sr = tid >> 4, sc = (tid & 15) * 8, vst0 = v_st(sr, sc), vst1 = v_st(32 + sr, sc);
    int koff[NKP], klds[NKP];
#pragma unroll
    for (int i = 0; i < NKP; ++i) { const int row = tid >> 3, c8 = (tid & 7) + 8 * i; koff[i] = row * ldk + c8 * 8; klds[i] = row * RS + c8 * 16; }
    const int vb0 = (int)(uintptr_t)V_lds + v_rd_base(lane);
    bf16x8 sv0, sv1, sk[NKP];
#define SLOAD(k0) do { sv0 = *reinterpret_cast<const bf16x8*>(&Vh[(size_t)((k0) + sr) * ldv + sc]); sv1 = *reinterpret_cast<const bf16x8*>(&Vh[(size_t)((k0) + 32 + sr) * ldv + sc]); \
    _Pragma("unroll") for (int _q = 0; _q < NKP; ++_q) sk[_q] = *reinterpret_cast<const bf16x8*>(&Kh[(size_t)(k0) * ldk + koff[_q]]); } while (0)
#define SWRITE(b) do { *(bf16x8*)(V_lds + (b) * SHM_V + vst0) = sv0; *(bf16x8*)(V_lds + (b) * SHM_V + vst1) = sv1; \
    _Pragma("unroll") for (int _q = 0; _q < NKP; ++_q) *(bf16x8*)(K_lds + (b) * SHM_K + klds[_q]) = sk[_q]; } while (0)
#define RESC(a) do { if (__any((a) < 1.f)) { if (hi == 0) al_l[r32] = (a); asm volatile("s_waitcnt lgkmcnt(0)" ::: "memory"); \
    _Pragma("unroll") for (int d = 0; d < 4; ++d) _Pragma("unroll") for (int r = 0; r < 16; ++r) o[d][r] *= al_l[crow(r, hi)]; } } while (0)
    const int NT = seq / KVBLK;
    SLOAD(0); asm volatile("s_waitcnt vmcnt(0)" ::: "memory"); SWRITE(0); __syncthreads();
    for (int j = 0; j < NT; ++j) {
        const int b = j & 1;
        if (j + 1 < NT) SLOAD((j + 1) * KVBLK);
        SBAR();
        f32x16 p0, p1; float mn, al; bf16x8 pa0, pa1, pa2, pa3;
        { const char* Ks = K_lds + b * SHM_K; p0 = f32x16{}; p1 = f32x16{};
#pragma unroll
          for (int d0 = 0; d0 < DQK / 16; ++d0) { const int cb = (d0 * 16 + hi * 8) * 2;
              const bf16x8 b0 = *reinterpret_cast<const bf16x8*>(Ks + r32 * RS + cb);
              const bf16x8 b1 = *reinterpret_cast<const bf16x8*>(Ks + (32 + r32) * RS + cb);
              bf16x8 qf; if (d0 < NQR) qf = qr[d0 < NQR ? d0 : 0]; else qf = *(const bf16x8*)(qpark + (d0 - NQR) * 1024);
              p0 = __builtin_amdgcn_mfma_f32_32x32x16_bf16(b0, qf, p0, 0, 0, 0);
              p1 = __builtin_amdgcn_mfma_f32_32x32x16_bf16(b1, qf, p1, 0, 0, 0); } }
        partialSM(p0, p1, m_reg, mn, al, C, thr_raw);
        RESC(al);
        finishSM(p0, p1, al, l_reg, pa0, pa1, pa2, pa3); SBAR();
        pv_d0(o, vb0 + b * SHM_V, pa0, pa1, pa2, pa3);
        if (j + 1 < NT) { asm volatile("s_waitcnt vmcnt(0)" ::: "memory"); SWRITE(b ^ 1); }
        __syncthreads();
    }
    if (hi == 0) li_l[r32] = l_reg; asm volatile("s_waitcnt lgkmcnt(0)" ::: "memory");
    float rli[16];
#pragma unroll
    for (int r = 0; r < 16; ++r) rli[r] = __builtin_amdgcn_rcpf(li_l[crow(r, hi)]);
    bf16_t* Ow = Ob + (size_t)(wid * QBLK) * ldo + (r32 & ~1);
    const bool odd = (r32 & 1) != 0;
#pragma unroll
    for (int r = 0; r < 16; r += 2) { const int orow = crow(r, hi) + (odd ? 1 : 0);
#pragma unroll
        for (int d0 = 0; d0 < 4; ++d0) { const float a = o[d0][r] * rli[r], b = o[d0][r + 1] * rli[r + 1];
            const float recv = swz_xor<1>(odd ? a : b);
            const unsigned w = odd ? cvtpk(recv, b) : cvtpk(a, recv);
            *(unsigned*)(Ow + (size_t)orow * ldo + d0 * 32) = w; } }
    __syncthreads();
#undef SLOAD
#undef SWRITE
#undef RESC
}
}

struct Params {
    const float* x; const float* c; const float* ctx; const float* c_ctx; const float* w_mod; const float* b_mod; const float* g_norm1; const float* g_norm2;
    const float* w_in_ab; const float* g_cq; const float* w_uq; const float* g_ckv; const float* w_ukv; const float* g_qn_a; const float* g_kn_a; const float* lam_vec;
    const float* g_qn_b; const float* g_kn_b; const float* g_sub_b; const float* w_out_ab; const float* w_in_c; const float* g_qn_c; const float* g_kn_c; const float* w_out_c;
    const float* w_pq; const float* sub_keys; const float* expert_u; const float* expert_v;
    float* out; unsigned char* ws; int ph_lo, ph_hi;
};

typedef const __attribute__((address_space(4))) Params CParams;
struct Ctx {
    int tid, lane, wid, G, vcu, bx;
    unsigned char* ws; char* lds;
};

__device__ __forceinline__ void tconv(const Ctx& F, const float* src, bf16_t* dst, const float* gain, int nmat, int K, int N, int Npad) {
    float* tile = (float*)(F.lds + 32768);
    const int ntn = Npad / 64, ntk = K / 64, per = ntn * ntk, total = per * nmat;
    for (int it = F.vcu; it < total; it += F.G) {
        const int mat = it / per, rem = it % per, tn = rem / ntk, tk = rem % ntk, k0 = tk * 64, n0 = tn * 64;
        const float* s = src + (size_t)mat * K * N; bf16_t* d = dst + (size_t)mat * Npad * K;
        __syncthreads();
        { const int r = F.tid >> 4, c4 = (F.tid & 15) * 4;
#pragma unroll
          for (int i = 0; i < 2; ++i) { const int rr = r + i * 32; f32x4 v = (f32x4){0.f, 0.f, 0.f, 0.f};
              if (n0 + c4 < N) v = *(const f32x4*)(s + (size_t)(k0 + rr) * N + n0 + c4);
              tile[rr * 65 + c4 + 0] = v[0]; tile[rr * 65 + c4 + 1] = v[1]; tile[rr * 65 + c4 + 2] = v[2]; tile[rr * 65 + c4 + 3] = v[3]; } }
        __syncthreads();
        { const int n = F.tid >> 3, kc = (F.tid & 7) * 8; float v[8];
#pragma unroll
          for (int e = 0; e < 8; ++e) { v[e] = tile[(kc + e) * 65 + n]; if (gain) v[e] *= gain[(size_t)mat * K + k0 + kc + e]; }
          u32x4 w; w.x = cvt_pk_bf16(v[0], v[1]); w.y = cvt_pk_bf16(v[2], v[3]); w.z = cvt_pk_bf16(v[4], v[5]); w.w = cvt_pk_bf16(v[6], v[7]);
          *(u32x4*)(d + (size_t)(n0 + n) * K + k0 + kc) = w; }
    }
}
__device__ __forceinline__ void cvt_flat(const Ctx& F, const float* src, bf16_t* dst, size_t n8) {
    for (size_t i = (size_t)F.vcu * 512 + F.tid; i < n8; i += (size_t)F.G * 512) {
        const f32x4 a = *(const f32x4*)(src + i * 8), b = *(const f32x4*)(src + i * 8 + 4);
        u32x4 w; w.x = cvt_pk_bf16(a[0], a[1]); w.y = cvt_pk_bf16(a[2], a[3]); w.z = cvt_pk_bf16(b[0], b[1]); w.w = cvt_pk_bf16(b[2], b[3]);
        *(u32x4*)(dst + i * 8) = w;
    }
}
typedef unsigned v6u __attribute__((ext_vector_type(6)));
typedef float v32f __attribute__((ext_vector_type(32)));
typedef float v16f __attribute__((ext_vector_type(16)));
__device__ __forceinline__ float fp6_val(int c) { return c < 8 ? c * 0.125f : (c < 16 ? 1.f + (c - 8) * 0.125f : (c < 24 ? 2.f + (c - 16) * 0.25f : 4.f + (c - 24) * 0.5f)); }
__device__ __forceinline__ int fp6_code(float x) { return x < 1.f ? (int)(x * 8.f + 0.5f) : (x < 2.f ? 8 + (int)((x - 1.f) * 8.f + 0.5f) : (x < 4.f ? 16 + (int)((x - 2.f) * 4.f + 0.5f) : 24 + (int)((x - 4.f) * 2.f + 0.5f))); }
__device__ __forceinline__ void cvt_rows_fp6(const Ctx& F, const float* src, unsigned char* dst, float* descale, int R) {
    float* stg = (float*)(F.lds + 65536) + F.wid * (64 * 33);
    int* permL = (int*)(F.lds + 65536 + 8 * 64 * 33 * 4) + F.wid * 32;
    float fac;
    {   v16f lo, hi;
#pragma unroll
        for (int i = 0; i < 16; ++i) { lo[i] = fp6_val(i); hi[i] = fp6_val(16 + i); }
        const v6u w = __builtin_amdgcn_cvt_scalef32_2xpk16_fp6_f32(lo, hi, 1.0f);
        const v32f f = __builtin_amdgcn_cvt_scalef32_pk32_f32_fp6(w, 1.0f);
        float mx = 0.f;
#pragma unroll
        for (int j = 0; j < 32; ++j) mx = fmaxf(mx, f[j]);
        fac = mx * (1.f / 7.5f);
        const float inv = fac > 0.f ? 1.f / fac : 1.f;
        if (F.lane == 0) {
#pragma unroll
            for (int j = 0; j < 32; ++j) permL[j] = fp6_code(f[j] * inv) & 31; }
        asm volatile("s_waitcnt lgkmcnt(0)" ::: "memory"); __builtin_amdgcn_wave_barrier(); asm volatile("" ::: "memory");
    }
    for (int row = F.vcu * 8 + F.wid; row < R; row += F.G * 8) {
        const float* s = src + (size_t)row * DM + F.lane * 32; f32x4 v[8]; float am = 0.f;
#pragma unroll
        for (int i = 0; i < 8; ++i) { v[i] = *(const f32x4*)(s + i * 4);
#pragma unroll
            for (int e = 0; e < 4; ++e) am = fmaxf(am, fabsf(v[i][e])); }
        am = wave_max(am);
        const float sc = am > 0.f ? 7.f / am : 1.f;
#pragma unroll
        for (int i = 0; i < 8; ++i)
#pragma unroll
            for (int e = 0; e < 4; ++e) stg[F.lane * 33 + permL[i * 4 + e]] = v[i][e] * sc;
        asm volatile("s_waitcnt lgkmcnt(0)" ::: "memory"); __builtin_amdgcn_wave_barrier(); asm volatile("" ::: "memory");
        v16f lo, hi;
#pragma unroll
        for (int i = 0; i < 16; ++i) { lo[i] = stg[F.lane * 33 + i]; hi[i] = stg[F.lane * 33 + 16 + i]; }
        asm volatile("s_waitcnt lgkmcnt(0)" ::: "memory"); __builtin_amdgcn_wave_barrier(); asm volatile("" ::: "memory");
        const v6u w = __builtin_amdgcn_cvt_scalef32_2xpk16_fp6_f32(lo, hi, 1.0f);
        u32x2* d = (u32x2*)(dst + (size_t)row * EROW + F.lane * 24);
        d[0] = (u32x2){w[0], w[1]}; d[1] = (u32x2){w[2], w[3]}; d[2] = (u32x2){w[4], w[5]};
        if (F.lane == 0) descale[row] = (am > 0.f ? am * (1.f / 7.f) : 1.f) / (fac > 0.f ? fac : 1.f);
    }
}
__device__ __forceinline__ float silu_f(float v) { return v / (1.f + __expf(-v)); }

__device__ __forceinline__ void prologue_phase(const Ctx& F, CParams& P) {
    unsigned char* ws = F.ws;
    {
        float* sv = (float*)F.lds;
        float* part = (float*)(F.lds + 24576);
        for (int i = F.tid; i < 3 * DM; i += 512) { const int v = i / DM, k = i % DM; const float cv = v < 2 ? P.c[v * DM + k] : P.c_ctx[k]; sv[i] = silu_f(cv); }
        __syncthreads();
        float* mod = (float*)(ws + WS_MOD);
        for (int it = F.vcu; it < DEPTH * 192; it += F.G) {
            const int l = it / 192, n0 = (it % 192) * 64;
            const float* wp = P.w_mod + ((size_t)l * DM + F.wid * 256) * 12288 + n0 + F.lane;
            float a0 = 0.f, a1 = 0.f, a2 = 0.f;
#pragma unroll 8
            for (int k = 0; k < 256; ++k) { const float w = wp[(size_t)k * 12288]; const int kk = F.wid * 256 + k; a0 += sv[kk] * w; a1 += sv[DM + kk] * w; a2 += sv[2 * DM + kk] * w; }
            part[(F.wid * 3 + 0) * 64 + F.lane] = a0; part[(F.wid * 3 + 1) * 64 + F.lane] = a1; part[(F.wid * 3 + 2) * 64 + F.lane] = a2;
            __syncthreads();
            if (F.wid < 3) { float s = 0.f;
#pragma unroll
                for (int w = 0; w < 8; ++w) s += part[(w * 3 + F.wid) * 64 + F.lane];
                mod[((size_t)l * 3 + F.wid) * 12288 + n0 + F.lane] = s + P.b_mod[(size_t)l * 12288 + n0 + F.lane]; }
            __syncthreads();
        }
    }
    if (F.vcu == 0) {
        float* t16 = (float*)(ws + WS_TAB16); float* t32 = (float*)(ws + WS_TAB32);
        for (int i = F.tid; i < 128 * 16; i += 512) { const int pos = i >> 4, f = i & 15; const float fr = powf(10000.f, -(float)f / 16.f); const float a = (float)pos * fr; float s, c; sincosf(a, &s, &c); t16[i * 2] = c; t16[i * 2 + 1] = s; }
        for (int i = F.tid; i < 128 * 32; i += 512) { const int pos = i >> 5, f = i & 31; const float fr = powf(10000.f, -(float)f / 32.f); const float a = (float)pos * fr; float s, c; sincosf(a, &s, &c); t32[i * 2] = c; t32[i * 2 + 1] = s; }
        if (F.wid == 2) { float* bnd = (float*)(ws + WS_LAM) + 4;
            for (int e2 = 0; e2 < 2; ++e2) {
                float ga = 0.f, gb = 0.f, gc = 0.f, gd = 0.f, ge = 0.f, gf = 0.f;
                for (int i = F.lane; i < 192; i += 64) { ga = fmaxf(ga, fabsf(P.g_qn_a[e2 * 192 + i])); gb = fmaxf(gb, fabsf(P.g_kn_a[e2 * 192 + i])); }
                gc = fabsf(P.g_qn_b[e2 * 64 + F.lane]); gd = fabsf(P.g_kn_b[e2 * 64 + F.lane]);
                for (int i = F.lane; i < 128; i += 64) { ge = fmaxf(ge, fabsf(P.g_qn_c[e2 * 128 + i])); gf = fmaxf(gf, fabsf(P.g_kn_c[e2 * 128 + i])); }
                ga = wave_max(ga); gb = wave_max(gb); gc = wave_max(gc); gd = wave_max(gd); ge = wave_max(ge); gf = wave_max(gf);
                if (F.lane == 0) { bnd[(2 * e2) * 2 + 0] = 1.03f * 13.856406f * ga * gb;
                                   bnd[(2 * e2) * 2 + 1] = 1.03f * 8.f * gc * gd;
                                   bnd[(2 * e2 + 1) * 2 + 0] = 1.03f * 11.313708f * ge * gf;
                                   bnd[(2 * e2 + 1) * 2 + 1] = 0.f; } } }
        if (F.wid < 2) { const float* lv = P.lam_vec + F.wid * 256; const float d1 = wave_sum(lv[F.lane] * lv[64 + F.lane]), d2 = wave_sum(lv[128 + F.lane] * lv[192 + F.lane]);
            const float lam_init = 0.8f - 0.6f * expf(-0.3f * (float)(2 * F.wid));
            if (F.lane == 0) ((float*)(ws + WS_LAM))[F.wid] = expf(d1) - expf(d2) + lam_init; }
    }
    tconv(F, P.w_in_ab, (bf16_t*)(ws + WS_WINAB), nullptr, 2, DM, AB_IN, AB_INP);
    tconv(F, P.w_uq, (bf16_t*)(ws + WS_WUQ), P.g_cq, 2, 768, 1536, 1536);
    tconv(F, P.w_ukv, (bf16_t*)(ws + WS_WUKV), P.g_ckv, 2, 512, 2048, 2048);
    tconv(F, P.w_out_ab, (bf16_t*)(ws + WS_WOUTAB), nullptr, 2, DM, DM, DM);
    tconv(F, P.w_in_c, (bf16_t*)(ws + WS_WINC), nullptr, 2, DM, C_IN, C_IN);
    tconv(F, P.w_out_c, (bf16_t*)(ws + WS_WOUTC), nullptr, 2, DM, DM, DM);
    tconv(F, P.w_pq, (bf16_t*)(ws + WS_WPQ), nullptr, 4, DM, DM, DM);
    cvt_flat(F, P.sub_keys, (bf16_t*)(ws + WS_SUBK), (size_t)4 * 8 * 2 * 128 * 128 / 8);
    cvt_rows_fp6(F, P.expert_u, ws + WS_EU, (float*)(ws + WS_SU), 4 * NEXP);
    cvt_rows_fp6(F, P.expert_v, ws + WS_EV, (float*)(ws + WS_SV), 4 * NEXP);
}

__device__ __forceinline__ void norm_phase(const Ctx& F, CParams& P, int layer, int which  , int m_rows) {
    float* X = (float*)(F.ws + WS_X); bf16_t* H = (bf16_t*)(F.ws + WS_H);
    const float* mod = (const float*)(F.ws + WS_MOD) + (size_t)layer * 3 * 12288;
    const float* gn = (which ? P.g_norm2 : P.g_norm1) + (size_t)layer * DM;
    const bool from_in = (layer == 0 && which == 0);
    for (int t = F.vcu * 8 + F.wid; t < m_rows; t += F.G * 8) {
        const int vs = vsel_of_row(t);
        const float* src = from_in ? (t < TL ? P.x + (size_t)t * DM : P.ctx + (size_t)(t - TL) * DM) : X + (size_t)t * DM;
        const float* shf = mod + (size_t)vs * 12288 + (which ? 3 : 0) * DM; const float* scl = shf + DM;
        f32x4 v[8]; float ss = 0.f;
#pragma unroll
        for (int j = 0; j < 8; ++j) { v[j] = *(const f32x4*)(src + j * 256 + F.lane * 4); ss += v[j][0] * v[j][0] + v[j][1] * v[j][1] + v[j][2] * v[j][2] + v[j][3] * v[j][3]; }
        ss = wave_sum(ss);
        const float rstd = rsqrtf(ss * (1.f / DM) + EPS);
#pragma unroll
        for (int j = 0; j < 8; ++j) { const int c = j * 256 + F.lane * 4;
            if (from_in) *(f32x4*)(X + (size_t)t * DM + c) = v[j];
            const f32x4 g = *(const f32x4*)(gn + c), sc = *(const f32x4*)(scl + c), sh = *(const f32x4*)(shf + c);
            f32x4 y;
#pragma unroll
            for (int e = 0; e < 4; ++e) y[e] = (v[j][e] * rstd * g[e]) * (1.f + sc[e]) + sh[e];
            u32x2 w; w.x = cvt_pk_bf16(y[0], y[1]); w.y = cvt_pk_bf16(y[2], y[3]);
            *(u32x2*)(H + (size_t)t * DM + c) = w; }
    }
}

__device__ __forceinline__ float grp16_sum(float v) { v += swz_xor<8>(v); v += swz_xor<4>(v); v += swz_xor<2>(v); v += swz_xor<1>(v); return v; }
__device__ __forceinline__ void rope4(float (&x)[4], int q16, int row, int col, const float* t16) {
    const int seg = q16 >> 3, f0 = (q16 & 3) * 4, pos = seg ? col : row; const bool first = (q16 & 7) < 4;
    const f32x4 c0 = *(const f32x4*)(t16 + (pos * 16 + f0) * 2), c1 = *(const f32x4*)(t16 + (pos * 16 + f0) * 2 + 4);
    const float cs[4] = {c0[0], c0[2], c1[0], c1[2]}, sn[4] = {c0[1], c0[3], c1[1], c1[3]};
#pragma unroll
    for (int e = 0; e < 4; ++e) { const float p = swz_xor<4>(x[e]); x[e] = first ? x[e] * cs[e] - p * sn[e] : p * sn[e] + x[e] * cs[e]; }
}
__device__ __forceinline__ void rope8(float (&x)[8], int q16, int row, int col, const float* t32) {
    const int seg = q16 >> 3, f0 = (q16 & 3) * 8, pos = seg ? col : row; const bool first = (q16 & 7) < 4;
    const float* tp = t32 + (pos * 32 + f0) * 2;
#pragma unroll
    for (int q = 0; q < 4; ++q) { const f32x4 c = *(const f32x4*)(tp + q * 4);
#pragma unroll
        for (int s = 0; s < 2; ++s) { const int e = q * 2 + s; const float cs = c[s * 2], sn = c[s * 2 + 1]; const float p = swz_xor<4>(x[e]); x[e] = first ? x[e] * cs - p * sn : p * sn + x[e] * cs; } }
}
__device__ __forceinline__ void ld8bf(const bf16_t* p, float (&x)[8]) { const u32x4 w = *(const u32x4*)p;
#pragma unroll
    for (int q = 0; q < 4; ++q) { x[q * 2] = bf_lo(w[q]); x[q * 2 + 1] = bf_hi(w[q]); } }
__device__ __forceinline__ void ld4bf(const bf16_t* p, float (&x)[4]) { const u32x2 w = *(const u32x2*)p; x[0] = bf_lo(w.x); x[1] = bf_hi(w.x); x[2] = bf_lo(w.y); x[3] = bf_hi(w.y); }
__device__ __forceinline__ void st8bf(bf16_t* p, const float (&x)[8]) { u32x4 w; w.x = cvt_pk_bf16(x[0], x[1]); w.y = cvt_pk_bf16(x[2], x[3]); w.z = cvt_pk_bf16(x[4], x[5]); w.w = cvt_pk_bf16(x[6], x[7]); *(u32x4*)p = w; }
__device__ __forceinline__ void st4bf(bf16_t* p, const float (&x)[4]) { u32x2 w; w.x = cvt_pk_bf16(x[0], x[1]); w.y = cvt_pk_bf16(x[2], x[3]); *(u32x2*)p = w; }

__device__ __forceinline__ void qkv_even_phase(const Ctx& F, CParams& P, int e) {
    const bf16_t* P1 = (const bf16_t*)(F.ws + WS_P1); const bf16_t* QA = (const bf16_t*)(F.ws + WS_QA); const bf16_t* KV = (const bf16_t*)(F.ws + WS_KV);
    bf16_t* Qm = (bf16_t*)(F.ws + WS_Q1); bf16_t* Km = (bf16_t*)(F.ws + WS_K1); bf16_t* Vm = (bf16_t*)(F.ws + WS_V1);
    bf16_t* Qd = (bf16_t*)(F.ws + WS_Q2); bf16_t* Kd = (bf16_t*)(F.ws + WS_K2); bf16_t* Vd = (bf16_t*)(F.ws + WS_V2);
    const float* t16 = (const float*)(F.ws + WS_TAB16);
    const float* gqa = P.g_qn_a + e * 192; const float* gka = P.g_kn_a + e * 192; const float* gqb = P.g_qn_b + e * 64; const float* gkb = P.g_kn_b + e * 64;
    const int q16 = F.lane & 15, grp = F.lane >> 4;
    float gq_n[8], gq_r[4], gk_n[8], gk_r[4], gqd[4], gkd[4];
#pragma unroll
    for (int i = 0; i < 8; ++i) { gq_n[i] = gqa[q16 * 8 + i]; gk_n[i] = gka[q16 * 8 + i]; }
#pragma unroll
    for (int i = 0; i < 4; ++i) { gq_r[i] = gqa[128 + q16 * 4 + i]; gk_r[i] = gka[128 + q16 * 4 + i]; gqd[i] = gqb[q16 * 4 + i]; gkd[i] = gkb[q16 * 4 + i]; }
    for (int t = F.vcu * 8 + F.wid; t < TT; t += F.G * 8) {
        const bool latent = t < TL; const int s = t & (SEQ - 1), row = s >> 6, col = s & 63; const int kr = krow_of(t);
        const bf16_t* p1 = P1 + (size_t)t * AB_INP;
        float ss = 0.f;
#pragma unroll
        for (int j = 0; j < 3; ++j) { float x[4]; ld4bf(p1 + j * 256 + F.lane * 4, x); ss += x[0] * x[0] + x[1] * x[1] + x[2] * x[2] + x[3] * x[3]; }
        ss = wave_sum(ss); const float rstd_q = rsqrtf(ss * (1.f / 768.f) + EPS);
        float s2 = 0.f;
        { float x[8]; ld8bf(p1 + 768 + F.lane * 8, x);
#pragma unroll
          for (int i = 0; i < 8; ++i) s2 += x[i] * x[i]; }
        s2 = wave_sum(s2); const float rstd_kv = rsqrtf(s2 * (1.f / 512.f) + EPS);
        float kro[4]; ld4bf(p1 + 1280 + q16 * 4, kro);
#pragma unroll
        for (int ps = 0; ps < 2; ++ps) { const int h = ps * 4 + grp; const bf16_t* src = QA + (size_t)t * 1536 + h * 192;
            float xn[8], xr[4]; ld8bf(src + q16 * 8, xn); ld4bf(src + 128 + q16 * 4, xr);
            float sq = 0.f;
#pragma unroll
            for (int i = 0; i < 8; ++i) { xn[i] *= rstd_q; sq += xn[i] * xn[i]; }
#pragma unroll
            for (int i = 0; i < 4; ++i) { xr[i] *= rstd_q; sq += xr[i] * xr[i]; }
            sq = grp16_sum(sq); const float r = rsqrtf(sq * (1.f / 192.f) + EPS);
            const float rq = r * (0.07216878364870322f * LOG2E);
#pragma unroll
            for (int i = 0; i < 8; ++i) xn[i] *= rq * gq_n[i];
#pragma unroll
            for (int i = 0; i < 4; ++i) xr[i] *= rq * gq_r[i];
            if (latent) rope4(xr, q16, row, col, t16);
            bf16_t* dst = Qm + ((size_t)t * 8 + h) * 192; st8bf(dst + q16 * 8, xn); st4bf(dst + 128 + q16 * 4, xr); }
#pragma unroll
        for (int ps = 0; ps < 2; ++ps) { const int h = ps * 4 + grp; const bf16_t* src = KV + (size_t)t * 2048 + h * 256;
            float xn[8], xr[4], xv[8]; ld8bf(src + q16 * 8, xn); ld8bf(src + 128 + q16 * 8, xv);
            float sq = 0.f;
#pragma unroll
            for (int i = 0; i < 8; ++i) { xn[i] *= rstd_kv; xv[i] *= rstd_kv; sq += xn[i] * xn[i]; }
#pragma unroll
            for (int i = 0; i < 4; ++i) { xr[i] = kro[i]; sq += xr[i] * xr[i]; }
            sq = grp16_sum(sq); const float r = rsqrtf(sq * (1.f / 192.f) + EPS);
#pragma unroll
            for (int i = 0; i < 8; ++i) xn[i] *= r * gk_n[i];
#pragma unroll
            for (int i = 0; i < 4; ++i) xr[i] *= r * gk_r[i];
            if (latent) rope4(xr, q16, row, col, t16);
            bf16_t* dst = Km + ((size_t)kr * 8 + h) * 192; st8bf(dst + q16 * 8, xn); st4bf(dst + 128 + q16 * 4, xr);
            st8bf(Vm + ((size_t)kr * 8 + h) * 128 + q16 * 8, xv); }
#pragma unroll
        for (int ps = 0; ps < 4; ++ps) { const int hm = ps * 4 + grp;
            float x[4]; ld4bf(p1 + 1344 + hm * 64 + q16 * 4, x);
            float sq = grp16_sum(x[0] * x[0] + x[1] * x[1] + x[2] * x[2] + x[3] * x[3]); float r = rsqrtf(sq * (1.f / 64.f) + EPS);
#pragma unroll
            for (int i = 0; i < 4; ++i) x[i] *= r * (0.125f * LOG2E) * gqd[i];
            if (latent) rope4(x, q16, row, col, t16);
            st4bf(Qd + ((size_t)t * 16 + hm) * 64 + q16 * 4, x);
            ld4bf(p1 + 2368 + hm * 64 + q16 * 4, x);
            sq = grp16_sum(x[0] * x[0] + x[1] * x[1] + x[2] * x[2] + x[3] * x[3]); r = rsqrtf(sq * (1.f / 64.f) + EPS);
#pragma unroll
            for (int i = 0; i < 4; ++i) x[i] *= r * gkd[i];
            if (latent) rope4(x, q16, row, col, t16);
            st4bf(Kd + ((size_t)kr * 16 + hm) * 64 + q16 * 4, x); }
#pragma unroll
        for (int j = 0; j < 2; ++j) *(u32x4*)(Vd + (size_t)kr * 1024 + j * 512 + F.lane * 8) = *(const u32x4*)(p1 + 3392 + j * 512 + F.lane * 8);
    }
}
__device__ __forceinline__ void qkv_odd_phase(const Ctx& F, CParams& P, int e) {
    const bf16_t* P1 = (const bf16_t*)(F.ws + WS_P1);
    bf16_t* Qc = (bf16_t*)(F.ws + WS_Q1); bf16_t* Kc = (bf16_t*)(F.ws + WS_K1); bf16_t* Vc = (bf16_t*)(F.ws + WS_V1);
    const float* t32 = (const float*)(F.ws + WS_TAB32);
    const int q16 = F.lane & 15, grp = F.lane >> 4;
    float gq[8], gk[8];
#pragma unroll
    for (int i = 0; i < 8; ++i) { gq[i] = P.g_qn_c[e * 128 + q16 * 8 + i]; gk[i] = P.g_kn_c[e * 128 + q16 * 8 + i]; }
    for (int t = F.vcu * 8 + F.wid; t < TT; t += F.G * 8) {
        const bool latent = t < TL; const int s = t & (SEQ - 1), row = s >> 6, col = s & 63; const int kr = krow_of(t);
        const bf16_t* p1 = P1 + (size_t)t * C_IN;
#pragma unroll
        for (int ps = 0; ps < 5; ++ps) {
            const bool isq = ps < 4; const int h = isq ? ps * 4 + grp : grp;
            float x[8]; ld8bf(p1 + (isq ? 0 : 2048) + h * 128 + q16 * 8, x);
            float sq = 0.f;
#pragma unroll
            for (int i = 0; i < 8; ++i) sq += x[i] * x[i];
            sq = grp16_sum(sq); const float r = rsqrtf(sq * (1.f / 128.f) + EPS);
#pragma unroll
            for (int i = 0; i < 8; ++i) x[i] *= r * (isq ? gq[i] * (0.08838834764831845f * LOG2E) : gk[i]);
            if (latent) rope8(x, q16, row, col, t32);
            st8bf(isq ? Qc + ((size_t)t * 16 + h) * 128 + q16 * 8 : Kc + ((size_t)kr * 4 + h) * 128 + q16 * 8, x); }
        *(u32x4*)(Vc + (size_t)kr * 512 + F.lane * 8) = *(const u32x4*)(p1 + 2560 + F.lane * 8);
    }
}

template <int DQK, int SDEPTH, int ldo, int NH, int NKVH, int NVH>
__device__ __forceinline__ void attn_phase(const Ctx& F, const bf16_t* Qbuf, const bf16_t* Kbuf, const bf16_t* Vbuf, bf16_t* OF, int ocol0, bool with_ctx, const float bound  ) {
    const bool nomax = bound < 60.f;
    const float negMC = 0.f;
    constexpr int kv_div = NH / NKVH, v_div = NH / NVH;
    const int n_lat = NH * NB * 32, n_tot = n_lat + (with_ctx ? NH * NB : 0);
    constexpr int ldq = NH * DQK, ldk = NKVH * DQK, ldv = NVH * 128;
    for (int u = F.vcu; u < n_tot; u += F.G) {
        int b, h, qrow0, kstart, seq;
        if (u < n_lat) { const int bh = u >> 5, qb = u & 31; b = bh / NH; h = bh % NH; qrow0 = b * SEQ + qb * 256; kstart = b * KPB; seq = KPB; }
        else { const int bh = u - n_lat; b = bh / NH; h = bh % NH; qrow0 = TL + b * CTXL; kstart = b * KPB + SEQ; seq = CTXL; }
        const bf16_t* Qp = Qbuf + ((size_t)qrow0 * NH + h) * DQK;
        const bf16_t* Kp = Kbuf + ((size_t)kstart * NKVH + h / kv_div) * DQK;
        const bf16_t* Vp = Vbuf + ((size_t)kstart * NVH + h / v_div) * 128;
        bf16_t* Op = OF + (size_t)qrow0 * ldo + ocol0 + h * 128;
        if constexpr (SDEPTH == 0) att::attn_body_simple<DQK, (DQK == 192 ? MLA_QL : 0), ldq, ldk, ldv, ldo>(Qp, Kp, Vp, Op, seq, F.lds, F.wid);
        else { if (nomax) att::attn_body<DQK, SDEPTH, (DQK == 192 ? MLA_QL : (DQK == 128 ? GQA_QL : 0)), true, ldq, ldk, ldv, ldo>(Qp, Kp, Vp, Op, seq, F.lds, F.wid, negMC);
               else att::attn_body_simple<DQK, 0, ldq, ldk, ldv, ldo>(Qp, Kp, Vp, Op, seq, F.lds, F.wid); }
    }
}

__device__ __forceinline__ void merge_even_phase(const Ctx& F, CParams& P, int e, int layer, int m_rows) {
    const bf16_t* OD = (const bf16_t*)(F.ws + WS_OF); bf16_t* AO = (bf16_t*)(F.ws + WS_AO);
    const float lam = ((const float*)(F.ws + WS_LAM))[e];
    const float lam_init = 0.8f - 0.6f * expf(-0.3f * (float)layer);
    const int q16 = F.lane & 15, grp = F.lane >> 4;
    float gs[8];
#pragma unroll
    for (int i = 0; i < 8; ++i) gs[i] = P.g_sub_b[e * 128 + q16 * 8 + i] * (1.f - lam_init);
    for (int t = F.vcu * 8 + F.wid; t < m_rows; t += F.G * 8) {
        const bf16_t* od = OD + (size_t)t * DM; bf16_t* ao = AO + (size_t)t * DM + 1024;
#pragma unroll
        for (int ps = 0; ps < 2; ++ps) { const int h = ps * 4 + grp;
            float o0[8], o1[8], d[8]; ld8bf(od + (2 * h) * 128 + q16 * 8, o0); ld8bf(od + (2 * h + 1) * 128 + q16 * 8, o1);
            float sq = 0.f;
#pragma unroll
            for (int i = 0; i < 8; ++i) { d[i] = o0[i] - lam * o1[i]; sq += d[i] * d[i]; }
            sq = grp16_sum(sq); const float r = rsqrtf(sq * (1.f / 128.f) + EPS);
#pragma unroll
            for (int i = 0; i < 8; ++i) d[i] *= r * gs[i];
            st8bf(ao + h * 128 + q16 * 8, d); }
    }
}

__device__ __forceinline__ void wave_lds_fence() { asm volatile("s_waitcnt lgkmcnt(0)" ::: "memory"); __builtin_amdgcn_wave_barrier(); asm volatile("" ::: "memory"); }
__device__ __forceinline__ unsigned fkey(float f) { const unsigned b = __float_as_uint(f); return b ^ ((unsigned)((int)b >> 31) | 0x80000000u); }
__device__ __forceinline__ float funkey(unsigned k) { return __uint_as_float((k & 0x80000000u) ? (k ^ 0x80000000u) : ~k); }
__device__ __forceinline__ unsigned umed3(unsigned a, unsigned b, unsigned c) { unsigned r; asm("v_med3_u32 %0, %1, %2, %3" : "=v"(r) : "v"(a), "v"(b), "v"(c)); return r; }
__device__ __forceinline__ void kins16(unsigned (&L)[16], unsigned k) {
#pragma unroll
    for (int p = 15; p >= 1; --p) L[p] = umed3(L[p - 1], L[p], k);
    L[0] = L[0] > k ? L[0] : k;
}
__device__ __forceinline__ void scan_set(unsigned (&L)[16], const bf16_t* qbase  , const bf16_t* kbase  , float* buf, int lane) {
    const int r32 = lane & 31, hi = lane >> 5;
#pragma unroll
    for (int p = 0; p < 16; ++p) L[p] = 0u;
    bf16x8 a0[8], a1[8];
    { const bf16_t* ap = qbase + (size_t)r32 * DM + hi * 8;
#pragma unroll
      for (int ks = 0; ks < 8; ++ks) { a0[ks] = *(const bf16x8*)(ap + ks * 16); a1[ks] = *(const bf16x8*)(ap + (size_t)32 * DM + ks * 16); } }
#pragma unroll 1
    for (int kb = 0; kb < 4; ++kb) {
        f32x16 acc0 = {}, acc1 = {};
        { const bf16_t* bp = kbase + (size_t)(kb * 32 + r32) * 128 + hi * 8;
          bf16x8 b[8];
#pragma unroll
          for (int ks = 0; ks < 8; ++ks) b[ks] = *(const bf16x8*)(bp + ks * 16);
#pragma unroll
          for (int ks = 0; ks < 8; ++ks) { acc0 = __builtin_amdgcn_mfma_f32_32x32x16_bf16(a0[ks], b[ks], acc0, 0, 0, 0); acc1 = __builtin_amdgcn_mfma_f32_32x32x16_bf16(a1[ks], b[ks], acc1, 0, 0, 0); } }
        wave_lds_fence();
#pragma unroll
        for (int r = 0; r < 16; ++r) { const int rowi = att::crow(r, hi); buf[rowi * 33 + r32] = acc0[r]; buf[(32 + rowi) * 33 + r32] = acc1[r]; }
        wave_lds_fence();
        const unsigned tb = 127u - (unsigned)(kb * 32);
#pragma unroll 8
        for (int k = 0; k < 32; ++k) kins16(L, (fkey(buf[lane * 33 + k]) & ~127u) | (tb - (unsigned)k));
    }
}
__device__ __forceinline__ void peer_select_phase(const Ctx& F, int layer, int m_rows) {
    const bf16_t* PQ = (const bf16_t*)(F.ws + WS_PQ); const bf16_t* SK = (const bf16_t*)(F.ws + WS_SUBK) + (size_t)layer * 8 * 2 * 128 * 128;
    int* PIDX = (int*)(F.ws + WS_PIDX); float* PG = (float*)(F.ws + WS_PG);
    float* buf = (float*)F.lds + F.wid * (64 * 33);
    const int lane = F.lane;
    const int nunits = (m_rows / 64) * 8;
    for (int u = F.vcu * 8 + F.wid; u < nunits; u += F.G * 8) {
        const int tile = u >> 3, h = u & 7, t0 = tile * 64;
        unsigned Ka[16], Kb[16];
        scan_set(Ka, PQ + (size_t)t0 * DM + h * 256, SK + (size_t)(h * 2) * 128 * 128, buf, lane);
        scan_set(Kb, PQ + (size_t)t0 * DM + h * 256 + 128, SK + (size_t)(h * 2 + 1) * 128 * 128, buf, lane);
        wave_lds_fence();
        float la[16], lb[16];
#pragma unroll
        for (int p = 0; p < 16; ++p) { la[p] = funkey(Ka[p] & ~127u); lb[p] = funkey(Kb[p] & ~127u);
            buf[lane * 33 + p] = __int_as_float(127 - (int)(Ka[p] & 127u)); buf[lane * 33 + 16 + p] = __int_as_float(127 - (int)(Kb[p] & 127u)); }
        wave_lds_fence();
        unsigned Kc[16];
#pragma unroll
        for (int p = 0; p < 16; ++p) Kc[p] = 0u;
#pragma unroll
        for (int r1 = 0; r1 < 16; ++r1)
#pragma unroll
            for (int r2 = 0; r2 < 16; ++r2) if ((r1 + 1) * (r2 + 1) <= 16) kins16(Kc, (fkey(la[r1] + lb[r2]) & ~255u) | (unsigned)(255 - (16 * r1 + r2)));
        float bv[16], sm = 0.f; unsigned idx[16];
#pragma unroll
        for (int p = 0; p < 16; ++p) { const int code = 255 - (int)(Kc[p] & 255u); bv[p] = funkey(Kc[p] & ~255u);
            idx[p] = (unsigned)(__float_as_int(buf[lane * 33 + (code >> 4)]) * 128 + __float_as_int(buf[lane * 33 + 16 + (code & 15)])); }
        const float bmax = bv[0];
#pragma unroll
        for (int p = 0; p < 16; ++p) { bv[p] = __expf(bv[p] - bmax); sm += bv[p]; }
        const float inv = 1.f / sm;
        const size_t o = ((size_t)(t0 + lane) * 8 + h) * 16;
#pragma unroll
        for (int q = 0; q < 4; ++q) { *(f32x4*)(PG + o + q * 4) = (f32x4){bv[q * 4] * inv, bv[q * 4 + 1] * inv, bv[q * 4 + 2] * inv, bv[q * 4 + 3] * inv};
            *(u32x4*)(PIDX + o + q * 4) = (u32x4){idx[q * 4], idx[q * 4 + 1], idx[q * 4 + 2], idx[q * 4 + 3]}; }
    }
}

__device__ __forceinline__ float gelu_tanh(float a) { const float u = 0.7978845608028654f * (a + 0.044715f * a * a * a); const float t = 1.f - 2.f / (1.f + __expf(2.f * u)); return 0.5f * a * (1.f + t); }
struct Row6 { u32x2 r[3]; };
__device__ __forceinline__ void ld_row6(Row6& R, const unsigned char* tab, int e, int lane) {
    const u32x2* rp = (const u32x2*)(tab + (size_t)e * EROW + (unsigned)lane * 24u);
    R.r[0] = rp[0]; R.r[1] = rp[1]; R.r[2] = rp[2];
}
__device__ __forceinline__ v32f dq_row6(const Row6& R, float dep) { unsigned r0 = R.r[0].x; asm volatile("" : "+v"(r0) : "v"(dep));
    const v6u w = {r0, R.r[0].y, R.r[1].x, R.r[1].y, R.r[2].x, R.r[2].y}; return __builtin_amdgcn_cvt_scalef32_pk32_f32_fp6(w, 1.0f); }
__device__ __forceinline__ float dot_row6(const Row6& R, const float (&h)[32], float& chain) {
    const v32f f = dq_row6(R, chain);
    float s0 = 0.f, s1 = 0.f, s2 = 0.f, s3 = 0.f;
#pragma unroll
    for (int i = 0; i < 8; ++i) { s0 = fmaf(f[i * 4 + 0], h[i * 4 + 0], s0); s1 = fmaf(f[i * 4 + 1], h[i * 4 + 1], s1); s2 = fmaf(f[i * 4 + 2], h[i * 4 + 2], s2); s3 = fmaf(f[i * 4 + 3], h[i * 4 + 3], s3); }
    const float s = (s0 + s1) + (s2 + s3);
    chain = s;
    return s;
}
__device__ __forceinline__ void fma_row6(float (&out)[32], const Row6& R, float w) {
    const v32f f = dq_row6(R, out[0]);
#pragma unroll
    for (int i = 0; i < 32; ++i) out[i] = fmaf(w, f[i], out[i]);
}
__device__ __forceinline__ float reduce4(float s0, float s1, float s2, float s3, int lane) {
    const bool hi = (lane & 32) != 0, b4 = (lane & 16) != 0;
    const float r0 = xor32_partner(hi ? s0 : s2, lane), r1 = xor32_partner(hi ? s1 : s3, lane);
    const float a0 = (hi ? s2 : s0) + r0, a1 = (hi ? s3 : s1) + r1;
    const float r = swz_xor<16>(b4 ? a0 : a1);
    float b = (b4 ? a1 : a0) + r;
    b += swz_xor<8>(b); b += swz_xor<4>(b); b += swz_xor<2>(b); b += swz_xor<1>(b);
    return b;
}
__device__ __forceinline__ float rl_f(float v, int l) { return __uint_as_float(__builtin_amdgcn_readlane(__float_as_uint(v), l)); }
__device__ __forceinline__ void wr_lane(float& dst, float val_uniform, int lane_uniform, int lane) { asm volatile("" : "+s"(lane_uniform)); dst = (lane == lane_uniform) ? val_uniform : dst; }
__device__ __forceinline__ void peer_expert_phase(const Ctx& F, CParams& P, int layer, int m_rows, bool last, bool dry) {
    const unsigned char* EU = F.ws + WS_EU + (size_t)layer * NEXP * EROW; const unsigned char* EV = F.ws + WS_EV + (size_t)layer * NEXP * EROW;
    const float* SU = (const float*)(F.ws + WS_SU) + (size_t)layer * NEXP; const float* SV = (const float*)(F.ws + WS_SV) + (size_t)layer * NEXP;
    const bf16_t* H = (const bf16_t*)(F.ws + WS_H); float* X = (float*)(F.ws + WS_X);
    const int* PIDX = (const int*)(F.ws + WS_PIDX); const float* PG = (const float*)(F.ws + WS_PG);
    const float* mod = (const float*)(F.ws + WS_MOD) + (size_t)layer * 3 * 12288;
    const int lane = F.lane;
    const int t0 = F.vcu * 8 + F.wid, tstride = F.G * 8;
    if (t0 >= m_rows) return;
    int id0 = PIDX[(size_t)t0 * 128 + lane], id1 = PIDX[(size_t)t0 * 128 + 64 + lane];
    u32x4 hp4[4]; float gk0, gk1;
    { const u32x4* hp = (const u32x4*)(H + (size_t)t0 * DM + (unsigned)lane * 32u);
#pragma unroll
      for (int j = 0; j < 4; ++j) hp4[j] = hp[j]; }
    gk0 = PG[(size_t)t0 * 128 + lane]; gk1 = PG[(size_t)t0 * 128 + 64 + lane];
    Row6 A[4], B[4];
#pragma unroll
    for (int q = 0; q < 4; ++q) ld_row6(A[q], EU, __builtin_amdgcn_readlane(id0, q), lane);
    for (int t = t0; t < m_rows; t += tstride) {
        const int tn = t + tstride; const int tq = tn < m_rows ? tn : t;
        float hf[32];
#pragma unroll
        for (int j = 0; j < 4; ++j)
#pragma unroll
            for (int q = 0; q < 4; ++q) { hf[j * 8 + q * 2] = bf_lo(hp4[j][q]); hf[j * 8 + q * 2 + 1] = bf_hi(hp4[j][q]); }
        const float cgk0 = gk0, cgk1 = gk1;
        const float su0 = SU[id0], sv0 = SV[id0], su1 = SU[id1], sv1 = SV[id1];
        const int nid0 = PIDX[(size_t)tq * 128 + lane], nid1 = PIDX[(size_t)tq * 128 + 64 + lane];
        { const u32x4* hp = (const u32x4*)(H + (size_t)tq * DM + (unsigned)lane * 32u);
#pragma unroll
          for (int j = 0; j < 4; ++j) hp4[j] = hp[j]; }
        gk0 = PG[(size_t)tq * 128 + lane]; gk1 = PG[(size_t)tq * 128 + 64 + lane];
        float wv0 = 0.f, wv1 = 0.f;
        float out[32];
#pragma unroll
        for (int i = 0; i < 32; ++i) out[i] = 0.f;
#pragma unroll
        for (int seg = 0; seg < 4; ++seg) {
            const int idc = (seg & 1) ? id1 : id0;
            const int idn = (seg == 0) ? id1 : (seg == 1 ? id0 : (seg == 2 ? id1 : nid0));
            const unsigned char* tabc = seg < 2 ? EU : EV; const unsigned char* tabn = (seg == 0 || seg == 3) ? EU : EV;
            const float wr = (seg & 1) ? wv1 : wv0;
            float acc = 0.f, chain = 0.f;
#pragma unroll 1
            for (int k = 0; k < 64; k += 8) {
#pragma unroll
                for (int q = 0; q < 4; ++q) ld_row6(B[q], tabc, __builtin_amdgcn_readlane(idc, k + 4 + q), lane);
                if (seg < 2) { const float d0 = dot_row6(A[0], hf, chain), d1 = dot_row6(A[1], hf, chain), d2 = dot_row6(A[2], hf, chain), d3 = dot_row6(A[3], hf, chain); const float b = reduce4(d0, d1, d2, d3, lane);
#pragma unroll
                    for (int q = 0; q < 4; ++q) wr_lane(acc, rl_f(b, 16 * q), k + q, lane); }
                else {
#pragma unroll
                    for (int q = 0; q < 4; ++q) fma_row6(out, A[q], rl_f(wr, k + q)); }
                { const bool nx = k + 8 >= 64;
#pragma unroll
                  for (int q = 0; q < 4; ++q) { const int ec = __builtin_amdgcn_readlane(idc, (k + 8 + q) & 63), en = __builtin_amdgcn_readlane(idn, q);
                      ld_row6(A[q], nx ? tabn : tabc, nx ? en : ec, lane); } }
                if (seg < 2) { const float d0 = dot_row6(B[0], hf, chain), d1 = dot_row6(B[1], hf, chain), d2 = dot_row6(B[2], hf, chain), d3 = dot_row6(B[3], hf, chain); const float b = reduce4(d0, d1, d2, d3, lane);
#pragma unroll
                    for (int q = 0; q < 4; ++q) wr_lane(acc, rl_f(b, 16 * q), k + 4 + q, lane); }
                else {
#pragma unroll
                    for (int q = 0; q < 4; ++q) fma_row6(out, B[q], rl_f(wr, k + 4 + q)); }
            }
            if (seg == 0) wv0 = cgk0 * gelu_tanh(acc * su0) * sv0;
            if (seg == 1) wv1 = cgk1 * gelu_tanh(acc * su1) * sv1;
        }
        id0 = nid0; id1 = nid1;
        const int vs = vsel_of_row(t);
        const float* gate = mod + (size_t)vs * 12288 + 5 * DM;
        float* xr = X + (size_t)t * DM; float* dst = dry ? (float*)(F.ws + WS_OF) + (size_t)t * DM : (last ? P.out + (size_t)t * DM : xr);
        float ssq = 0.f;
        const unsigned lo32 = (unsigned)lane * 32u;
#pragma unroll
        for (int q = 0; q < 8; ++q) { const unsigned c = lo32 + q * 4; const f32x4 xo = *(const f32x4*)(xr + c), g = *(const f32x4*)(gate + c);
            f32x4 y; y[0] = xo[0] + g[0] * out[q * 4 + 0]; y[1] = xo[1] + g[1] * out[q * 4 + 1]; y[2] = xo[2] + g[2] * out[q * 4 + 2]; y[3] = xo[3] + g[3] * out[q * 4 + 3];
            *(f32x4*)(dst + c) = y;
            out[q * 4 + 0] = y[0]; out[q * 4 + 1] = y[1]; out[q * 4 + 2] = y[2]; out[q * 4 + 3] = y[3];
            ssq += y[0] * y[0] + y[1] * y[1] + y[2] * y[2] + y[3] * y[3]; }
        if (!last && !dry) {
            const float rstd = rsqrtf(wave_sum(ssq) * (1.f / DM) + EPS);
            const float* gn = P.g_norm1 + (size_t)(layer + 1) * DM;
            const float* shf = mod + (size_t)3 * 12288 + (size_t)vs * 12288; const float* scl = shf + DM;
            bf16_t* hrow = (bf16_t*)(F.ws + WS_H) + (size_t)t * DM;
#pragma unroll
            for (int j = 0; j < 4; ++j) { u32x4 w;
#pragma unroll
                for (int q = 0; q < 2; ++q) { const unsigned c = lo32 + j * 8 + q * 4; const f32x4 g = *(const f32x4*)(gn + c), sc = *(const f32x4*)(scl + c), sh = *(const f32x4*)(shf + c);
                    float y[4];
#pragma unroll
                    for (int e2 = 0; e2 < 4; ++e2) y[e2] = (out[j * 8 + q * 4 + e2] * rstd * g[e2]) * (1.f + sc[e2]) + sh[e2];
                    w[q * 2] = cvt_pk_bf16(y[0], y[1]); w[q * 2 + 1] = cvt_pk_bf16(y[2], y[3]); }
                *(u32x4*)(hrow + lo32 + j * 8) = w; }
        }
    }
}

constexpr int N_PHASES = 1 + 2 * 11 + 2 * 9 - 3;
__global__ void __launch_bounds__(512, 2) mk_fwd(Params Pval) {
    extern __shared__ __attribute__((aligned(16))) unsigned char lds_raw[];
    LAS unsigned char* ldsl = (LAS unsigned char*)lds_raw;
    volatile LAS unsigned* misc = (volatile LAS unsigned*)(ldsl + LDS_MISC);
    if (threadIdx.x < 16) misc[threadIdx.x] = 0u;
    __syncthreads();
    XcdBarrier bar = xcd_barrier_post((unsigned*)(Pval.ws + WS_CTL) + 1024, misc);
    const int wid0 = __builtin_amdgcn_readfirstlane((int)threadIdx.x >> 6);
    const int lo = Pval.ph_lo, hi = Pval.ph_hi; int ph = 0;
#define MKCTX() Ctx F; { const int lane_ = fresh_lane(); int wid_ = wid0; asm volatile("" : "+s"(wid_)); const int tid_ = wid_ * 64 + lane_; F.tid = tid_; F.lane = lane_; F.wid = wid_; \
        int G_ = gridDim.x, bx_ = blockIdx.x; asm volatile("" : "+s"(G_), "+s"(bx_)); F.G = G_; F.vcu = (G_ % 8 == 0) ? (bx_ % 8) * (G_ / 8) + bx_ / 8 : bx_; F.bx = bx_; } \
        unsigned long long kp_ = (unsigned long long)__builtin_amdgcn_kernarg_segment_ptr(); asm volatile("" : "+s"(kp_)); CParams& P = *(CParams*)kp_; \
        F.ws = P.ws; F.lds = (char*)lds_raw; unsigned char* ws = F.ws; (void)ws; \
        bf16_t* Hb = (bf16_t*)(ws + WS_H); bf16_t* P1 = (bf16_t*)(ws + WS_P1); float* X = (float*)(ws + WS_X); const float* mod = (const float*)(ws + WS_MOD); (void)Hb; (void)P1; (void)X; (void)mod;
#define PHASE(cls, ...) do { if (ph >= lo && ph < hi) { if constexpr ((PH_MASK >> (cls)) & 1u) { \
        if constexpr ((PH_DOUBLE >> (cls)) & 1u) { const bool dry = true; (void)dry; MKCTX(); __VA_ARGS__; __syncthreads(); } \
        { const bool dry = false; (void)dry; MKCTX(); __VA_ARGS__; } } if (ph + 1 < hi) { int w0_ = wid0; asm volatile("" : "+s"(w0_)); xcd_barrier(bar, w0_ == 0 && fresh_lane() == 0); } } ++ph; } while (0)

    PHASE(0, prologue_phase(F, P));
#pragma unroll 1
    for (int layer = 0; layer < DEPTH; ++layer) {
        const int e = layer >> 1; const bool even = (layer & 1) == 0, lastl = layer == DEPTH - 1;
        const int m_post = lastl ? TL : TT;
        if (layer == 0) PHASE(1, norm_phase(F, P, layer, 0, TT));
        PHASE(2, { const bf16_t* W = even ? (const bf16_t*)(ws + WS_WINAB) + (size_t)e * AB_INP * DM : (const bf16_t*)(ws + WS_WINC) + (size_t)e * C_IN * DM;
                const int N = even ? AB_INP : C_IN;
                pg8::Gemm g{Hb, W, TT, N, DM, DM}; pg8::StaticOrder S; S.init(TT, N, F.G, F.bx);
                pg8::EpiBf16 E{P1, N};
                pg8::gemm_phase<pg8::EpiBf16, pg8::StaticOrder>(ldsl, g, S, E, F.wid); });
        if (even) {
            PHASE(3, { { pg8::Gemm g{P1, (const bf16_t*)(ws + WS_WUQ) + (size_t)e * 1536 * 768, TT, 1536, 768, AB_INP}; pg8::StaticOrder S; S.init(TT, 1536, F.G, F.bx);
                      pg8::EpiBf16 E{(bf16_t*)(ws + WS_QA), 1536};
                      pg8::gemm_phase<pg8::EpiBf16, pg8::StaticOrder>(ldsl, g, S, E, F.wid); }
                    { pg8::Gemm g{P1 + 768, (const bf16_t*)(ws + WS_WUKV) + (size_t)e * 2048 * 512, TT, 2048, 512, AB_INP}; pg8::StaticOrder S; S.init(TT, 2048, F.G, F.bx);
                      pg8::EpiBf16 E{(bf16_t*)(ws + WS_KV), 2048};
                      pg8::gemm_phase<pg8::EpiBf16, pg8::StaticOrder>(ldsl, g, S, E, F.wid); } });
            PHASE(4, qkv_even_phase(F, P, e));
            PHASE(5, { if constexpr (ATT_SEL & 1) attn_phase<192, MLA_SD, 2048, 8, 8, 8>(F, (const bf16_t*)(ws + WS_Q1), (const bf16_t*)(ws + WS_K1), (const bf16_t*)(ws + WS_V1), (bf16_t*)(ws + WS_AO), 0, !lastl, ((const float*)(ws + WS_LAM))[4 + layer * 2]);
                    if constexpr (ATT_SEL & 2) attn_phase<64, 2, 2048, 16, 16, 8>(F, (const bf16_t*)(ws + WS_Q2), (const bf16_t*)(ws + WS_K2), (const bf16_t*)(ws + WS_V2), (bf16_t*)(ws + WS_OF), 0, !lastl, ((const float*)(ws + WS_LAM))[4 + layer * 2 + 1]); });
            PHASE(6, merge_even_phase(F, P, e, layer, m_post));
        } else {
            PHASE(7, qkv_odd_phase(F, P, e));
            PHASE(8, attn_phase<128, GQA_SD, 2048, 16, 4, 4>(F, (const bf16_t*)(ws + WS_Q1), (const bf16_t*)(ws + WS_K1), (const bf16_t*)(ws + WS_V1), (bf16_t*)(ws + WS_AO), 0, !lastl, ((const float*)(ws + WS_LAM))[4 + layer * 2]));
        }
        PHASE(10, { const bf16_t* W = even ? (const bf16_t*)(ws + WS_WOUTAB) + (size_t)e * DM * DM : (const bf16_t*)(ws + WS_WOUTC) + (size_t)e * DM * DM;
                pg8::Gemm g{(const bf16_t*)(ws + WS_AO), W, m_post, DM, DM, DM}; pg8::StaticOrder S; S.init(m_post, DM, F.G, F.bx);
                pg8::EpiResid E{X, mod + (size_t)layer * 3 * 12288, 2};
                pg8::gemm_phase<pg8::EpiResid, pg8::StaticOrder>(ldsl, g, S, E, F.wid); });
        PHASE(1, norm_phase(F, P, layer, 1, m_post));
        PHASE(11, { pg8::Gemm g{Hb, (const bf16_t*)(ws + WS_WPQ) + (size_t)layer * DM * DM, m_post, DM, DM, DM}; pg8::StaticOrder S; S.init(m_post, DM, F.G, F.bx);
                pg8::EpiBf16 E{(bf16_t*)(ws + WS_PQ), DM};
                pg8::gemm_phase<pg8::EpiBf16, pg8::StaticOrder>(ldsl, g, S, E, F.wid); });
        PHASE(12, peer_select_phase(F, layer, m_post));
        PHASE(13, peer_expert_phase(F, P, layer, m_post, lastl, dry));
    }
#undef PHASE
}

extern "C" void kernel_launch(void* const* d_in, const int* in_sizes, int n_in, void* d_out, int out_size, void* d_ws, size_t ws_size, hipStream_t stream) {
    static int grid = 0;
    if (grid == 0) {
        if (n_in != 28 || ws_size < WS_END) { fprintf(stderr, "kernel_launch: expected 28 inputs and >= %zu bytes of workspace, got %d / %zu\n", (size_t)WS_END, n_in, ws_size); grid = -1; return; }
        int dev = 0, cus = 0, per_cu = 0;
        if (hipGetDevice(&dev) != hipSuccess || hipDeviceGetAttribute(&cus, hipDeviceAttributeMultiprocessorCount, dev) != hipSuccess) { grid = -1; return; }
        if (hipFuncSetAttribute((const void*)mk_fwd, hipFuncAttributeMaxDynamicSharedMemorySize, LDS_BYTES) != hipSuccess) { fprintf(stderr, "kernel_launch: hipFuncSetAttribute failed\n"); grid = -1; return; }
        if (hipOccupancyMaxActiveBlocksPerMultiprocessor(&per_cu, (const void*)mk_fwd, 512, LDS_BYTES) != hipSuccess || per_cu < 1) fprintf(stderr, "kernel_launch: occupancy query says %d\n", per_cu);
        (void)hipGetLastError();
        grid = cus;
    }
    if (grid < 0) return;
    (void)hipMemsetAsync((char*)d_ws + WS_CTL, 0, CTL_BYTES, stream);
    Params p{};
    const float** pf = (const float**)&p;
    for (int i = 0; i < 28; ++i) pf[i] = (const float*)d_in[i];
    p.out = (float*)d_out; p.ws = (unsigned char*)d_ws;
#if MK_PER_PHASE_LAUNCH
    for (int i = 0; i < N_PHASES; ++i) { p.ph_lo = i; p.ph_hi = i + 1; hipLaunchKernelGGL(mk_fwd, dim3(grid), dim3(512), LDS_BYTES, stream, p); }
#else
    p.ph_lo = 0; p.ph_hi = N_PHASES;
    hipLaunchKernelGGL(mk_fwd, dim3(grid), dim3(512), LDS_BYTES, stream, p);
#endif
    const hipError_t le = hipPeekAtLastError();
    if (le != hipSuccess) fprintf(stderr, "kernel_launch: launch failed: %s\n", hipGetErrorName(le));
}
```

```cpp
#include <hip/hip_runtime.h>
#include <stdint.h>
#include <stdio.h>

#ifndef MK_PER_PHASE_LAUNCH
#define MK_PER_PHASE_LAUNCH 0
#endif

#ifndef MLA_QL
#define MLA_QL 0
#endif
#ifndef GQA_QL
#define GQA_QL 0
#endif
#ifndef QKT_GRP
#define QKT_GRP 12
#endif
#ifndef EB
#define EB 4
#endif
#ifndef PV_PIPE
#define PV_PIPE 0
#endif
#ifndef ATT_DBL
#define ATT_DBL 0
#endif
#ifndef ATT_PRIO
#define ATT_PRIO 1
#endif
#ifndef MLA_SD
#define MLA_SD 1
#endif
#ifndef GQA_SD
#define GQA_SD 2
#endif
#ifndef ATT_SEL
#define ATT_SEL 3
#endif
#ifndef PH_DOUBLE
#define PH_DOUBLE 0u
#endif
#ifndef PH_MASK
#define PH_MASK 0xFFFFFFFFu
#endif
#define LAS __attribute__((address_space(3)))
typedef unsigned short bf16_t;
typedef short bf16x8 __attribute__((ext_vector_type(8)));
typedef short s16x4 __attribute__((ext_vector_type(4)));
typedef float f32x4 __attribute__((ext_vector_type(4)));
typedef float f32x2 __attribute__((ext_vector_type(2)));
typedef float f32x16 __attribute__((ext_vector_type(16)));
typedef unsigned u32x4 __attribute__((ext_vector_type(4)));
typedef unsigned u32x2 __attribute__((ext_vector_type(2)));
typedef __bf16 bf16x2_t __attribute__((ext_vector_type(2)));

constexpr int DM = 2048, NB = 2, SEQ = 8192, DEPTH = 4, CTXL = 256;
constexpr int TL = NB * SEQ;
constexpr int TZ = NB * CTXL;
constexpr int TT = TL + TZ;
constexpr int KPB = SEQ + CTXL;
constexpr int AB_IN = 4416, AB_INP = 4608;
constexpr int C_IN = 3072;
constexpr int NEXP = 16384;
constexpr float EPS = 1e-6f;
constexpr float LOG2E = 1.4426950408889634f;

constexpr size_t al256(size_t x) { return (x + 255) / 256 * 256; }
constexpr size_t WS_CTL = 0, CTL_BYTES = 1u << 20;
constexpr size_t WS_MOD = WS_CTL + CTL_BYTES;
constexpr size_t WS_TAB16 = WS_MOD + al256((size_t)4 * 3 * 12288 * 4);
constexpr size_t WS_TAB32 = WS_TAB16 + al256((size_t)128 * 16 * 2 * 4);
constexpr size_t WS_LAM = WS_TAB32 + al256((size_t)128 * 32 * 2 * 4);
constexpr size_t WS_WINAB = WS_LAM + 256;
constexpr size_t WS_WUQ = WS_WINAB + (size_t)2 * AB_INP * DM * 2;
constexpr size_t WS_WUKV = WS_WUQ + (size_t)2 * 1536 * 768 * 2;
constexpr size_t WS_WOUTAB = WS_WUKV + (size_t)2 * 2048 * 512 * 2;
constexpr size_t WS_WINC = WS_WOUTAB + (size_t)2 * DM * DM * 2;
constexpr size_t WS_WOUTC = WS_WINC + (size_t)2 * C_IN * DM * 2;
constexpr size_t WS_WPQ = WS_WOUTC + (size_t)2 * DM * DM * 2;
constexpr size_t WS_SUBK = WS_WPQ + (size_t)4 * DM * DM * 2;
constexpr size_t WS_EU = WS_SUBK + (size_t)4 * 8 * 2 * 128 * 128 * 2;
constexpr int EROW = DM * 6 / 8;
constexpr size_t WS_EV = WS_EU + (size_t)4 * NEXP * DM;
constexpr size_t WS_SU = WS_EV + (size_t)4 * NEXP * DM;
constexpr size_t WS_SV = WS_SU + (size_t)4 * NEXP * 4;
constexpr size_t WS_X = WS_SV + (size_t)4 * NEXP * 4;
constexpr size_t WS_H = WS_X + (size_t)TT * DM * 4;
constexpr size_t WS_P1 = WS_H + (size_t)TT * DM * 2;
constexpr size_t WS_QA = WS_P1 + (size_t)TT * AB_INP * 2;
constexpr size_t WS_KV = WS_QA + (size_t)TT * 1536 * 2;
constexpr size_t WS_Q1 = WS_KV + (size_t)TT * 2048 * 2;
constexpr size_t WS_K1 = WS_Q1 + (size_t)TT * 2048 * 2;
constexpr size_t WS_V1 = WS_K1 + (size_t)TT * 1536 * 2;
constexpr size_t WS_Q2 = WS_V1 + (size_t)TT * 1024 * 2;
constexpr size_t WS_K2 = WS_Q2 + (size_t)TT * 1024 * 2;
constexpr size_t WS_V2 = WS_K2 + (size_t)TT * 1024 * 2;
constexpr size_t WS_OF = WS_V2 + (size_t)TT * 1024 * 2;
constexpr size_t WS_AO = WS_OF + (size_t)TT * 3072 * 4;
constexpr size_t WS_PQ = WS_AO + (size_t)TT * DM * 2;
constexpr size_t WS_PIDX = WS_PQ + (size_t)TT * DM * 2;
constexpr size_t WS_PG = WS_PIDX + (size_t)TT * 128 * 4;
constexpr size_t WS_END = WS_PG + (size_t)TT * 128 * 4;

constexpr int LDS_MAIN = 157696;
constexpr int LDS_MISC = LDS_MAIN;
constexpr int LDS_BYTES = LDS_MAIN + 4096;

__device__ __forceinline__ unsigned cvt_pk_bf16(float lo, float hi) { unsigned r; asm("v_cvt_pk_bf16_f32 %0, %1, %2" : "=v"(r) : "v"(lo), "v"(hi)); return r; }
__device__ __forceinline__ float bf_lo(unsigned w) { return __uint_as_float(w << 16); }
__device__ __forceinline__ float bf_hi(unsigned w) { return __uint_as_float(w & 0xffff0000u); }
template <int M> __device__ __forceinline__ float swz_xor(float v) { return __int_as_float(__builtin_amdgcn_ds_swizzle(__float_as_int(v), (M << 10) | 0x1f)); }
__device__ __forceinline__ float xor32_partner(float v, int lane) {
    const auto rr = __builtin_amdgcn_permlane32_swap(__float_as_uint(v), __float_as_uint(v), false, false);
    return __uint_as_float(lane < 32 ? rr[1] : rr[0]);
}
__device__ __forceinline__ float hw_sum(float v) {
    v += swz_xor<16>(v); v += swz_xor<8>(v); v += swz_xor<4>(v); v += swz_xor<2>(v); v += swz_xor<1>(v);
    return v;
}
__device__ __forceinline__ float wave_sum(float v) {
    v = hw_sum(v);
    const auto rr = __builtin_amdgcn_permlane32_swap(__float_as_uint(v), __float_as_uint(v), false, false);
    return __uint_as_float(rr[0]) + __uint_as_float(rr[1]);
}
__device__ __forceinline__ float wave_max(float v) {
    v = fmaxf(v, swz_xor<16>(v)); v = fmaxf(v, swz_xor<8>(v)); v = fmaxf(v, swz_xor<4>(v)); v = fmaxf(v, swz_xor<2>(v)); v = fmaxf(v, swz_xor<1>(v));
    const auto rr = __builtin_amdgcn_permlane32_swap(__float_as_uint(v), __float_as_uint(v), false, false);
    return fmaxf(__uint_as_float(rr[0]), __uint_as_float(rr[1]));
}
__device__ __forceinline__ int mbcnt64(unsigned long long m) { return (int)__builtin_amdgcn_mbcnt_hi((unsigned)(m >> 32), __builtin_amdgcn_mbcnt_lo((unsigned)m, 0u)); }
__device__ __forceinline__ int fresh_lane() { int l; asm volatile("v_mbcnt_lo_u32_b32 %0, -1, 0\n\tv_mbcnt_hi_u32_b32 %0, -1, %0" : "=v"(l)); return l; }
__device__ __forceinline__ int krow_of(int t) { return t < TL ? (t >> 13) * KPB + (t & (SEQ - 1)) : ((t - TL) >> 8) * KPB + SEQ + ((t - TL) & (CTXL - 1)); }
__device__ __forceinline__ int vsel_of_row(int t) { return t < SEQ ? 0 : (t < TL ? 1 : 2); }

#define XB_TMO      128
#define XB_XCNT(j)  (256  + 64 * (j))
#define XB_XSUB(j)  (1280 + 64 * (j))
#define XB_XGEN(j)  (2304 + 64 * (j))
#define XB_TOP      3328
#define XB_TOPGEN   3392
#define XCD_BAR_WORDS 3456
#define XB_SPIN_CAP (1u << 27)
__device__ __forceinline__ unsigned xb_ld(unsigned* p)              { return __hip_atomic_load(p, __ATOMIC_RELAXED, __HIP_MEMORY_SCOPE_AGENT); }
__device__ __forceinline__ unsigned xb_add(unsigned* p, unsigned v) { return __hip_atomic_fetch_add(p, v, __ATOMIC_RELAXED, __HIP_MEMORY_SCOPE_AGENT); }
__device__ __forceinline__ unsigned xb_xcc_id() { return (unsigned)__builtin_amdgcn_s_getreg((3 << 11) | 20) & 0xFu; }
#define XB_SPIN(cond, bar) do { unsigned _sp = 0; while (cond) { __builtin_amdgcn_s_sleep(1); \
    if ((++_sp & 255u) == 0u) { if (xb_ld(&(bar)[XB_TMO])) break; if (_sp > XB_SPIN_CAP) { atomicAdd(&(bar)[XB_TMO], 1u); break; } } } } while (0)
struct XcdBarrier { unsigned* bar; unsigned x; volatile LAS unsigned* st; };
__device__ __forceinline__ XcdBarrier xcd_barrier_post(unsigned* bar, volatile LAS unsigned* st) {
    XcdBarrier b; b.bar = bar; b.x = xb_xcc_id(); b.st = st;
    if (threadIdx.x == 0) (void)xb_add(&bar[XB_XCNT(b.x)], 1u);
    return b;
}
__device__ __forceinline__ void xcd_barrier_complete(unsigned* bar, unsigned x, unsigned& nloc, unsigned& nx) {
    asm volatile("" : "+s"(x));
    const unsigned G = gridDim.x * gridDim.y * gridDim.z;
    unsigned sum, cnt, mine, sp = 0u;
    for (;;) {
        sum = 0u; cnt = 0u; mine = 0u;
#pragma unroll
        for (unsigned j = 0; j < 16; ++j) { const unsigned c = xb_ld(&bar[XB_XCNT(j)]); sum += c; cnt += (c > 0u) ? 1u : 0u; mine = (j == x) ? c : mine; }
        if (sum == G) break;
        __builtin_amdgcn_s_sleep(1);
        if ((++sp & 255u) == 0u) { if (xb_ld(&bar[XB_TMO])) break; if (sp > XB_SPIN_CAP) { atomicAdd(&bar[XB_TMO], 1u); break; } }
    }
    nloc = mine > 0u ? mine : 1u; nx = cnt > 0u ? cnt : 1u;
}
__device__ __forceinline__ void xcd_barrier(const XcdBarrier& b, const bool thread0  ) {
    asm volatile("s_waitcnt vmcnt(0)" ::: "memory");
    __syncthreads();
    if (thread0) {
        unsigned* bar = b.bar;
        __builtin_amdgcn_s_waitcnt(0);
        unsigned nloc = b.st[0], nx = b.st[1];
        if (nloc == 0u) { xcd_barrier_complete(bar, b.x, nloc, nx); b.st[0] = nloc; b.st[1] = nx; }
        const unsigned old = xb_add(&bar[XB_XSUB(b.x)], 1u);
        const unsigned gen = old / nloc;
        if (old + 1u == (gen + 1u) * nloc) {
            __builtin_amdgcn_fence(__ATOMIC_RELEASE, "agent");
            asm volatile("s_waitcnt vmcnt(0)" ::: "memory");
            const unsigned og = xb_add(&bar[XB_TOP], 1u);
            const unsigned tg = og / nx;
            if (og + 1u == (tg + 1u) * nx) xb_add(&bar[XB_TOPGEN], 1u);
            else XB_SPIN(xb_ld(&bar[XB_TOPGEN]) == tg, bar);
            __builtin_amdgcn_fence(__ATOMIC_ACQUIRE, "agent");
            xb_add(&bar[XB_XGEN(b.x)], 1u);
            asm volatile("s_waitcnt vmcnt(0)" ::: "memory");
        } else {
            XB_SPIN(xb_ld(&bar[XB_XGEN(b.x)]) == gen, bar);
            __builtin_amdgcn_fence(__ATOMIC_ACQUIRE, "agent");
            asm volatile("s_waitcnt vmcnt(0)" ::: "memory");
        }
    }
    __syncthreads();
}

namespace pg8 {
constexpr int BM = 256, BK = 64, HALF = 128, HTB = HALF * BK * 2, STAGE_BYTES = 8 * HTB, NXCD = 8, WGM = 8;
__host__ __device__ __forceinline__ int lds_byte(int r, int c) { const int st = (r >> 4) * 2 + (c >> 5), rr = r & 15, cc = c & 31, ob = rr * 64 + cc * 2; return st * 1024 + (ob ^ (((ob >> 9) & 1) << 5)); }
__host__ __device__ __forceinline__ void stage_rc(int b, int& R, int& C) { const int st = b / 1024, sb = b % 1024, swz = sb ^ (((sb >> 9) & 1) << 5); R = (st >> 1) * 16 + swz / 64; C = (st & 1) * 32 + (swz % 64) / 2; }
__host__ __device__ __forceinline__ int perm32(int rho) { const int n = rho >> 4, i = rho & 15; return 8 * (i >> 2) + 4 * n + (i & 3); }
struct Unit { int pm, pn; };
struct Gemm { const bf16_t* A; const bf16_t* Bt; int M, N, K, lda; };
struct StaticOrder {
    int nM, nN, nwg, G, c;
    __host__ __device__ void init(int M, int N, int G_, int c_) { nM = M / BM; nN = N / BM; nwg = nM * nN; G = G_; c = c_; }
    __host__ __device__ bool next(int i, Unit& u) const {
        const long L = (long)i * G + c; if (L >= nwg) return false;
        int wgid = (int)L; { const int q = nwg / NXCD, r = nwg % NXCD, xcd = wgid % NXCD, off = wgid / NXCD; wgid = (xcd < r ? xcd * (q + 1) : r * (q + 1) + (xcd - r) * q) + off; }
        const int nig = WGM * nN, gid = wgid / nig, fm = gid * WGM, gsz = (nM - fm) < WGM ? (nM - fm) : WGM;
        u.pm = fm + ((wgid % nig) % gsz); u.pn = (wgid % nig) / gsz; return true;
    }
    __device__ __forceinline__ void a_ready(const Unit&) const {}
    __device__ __forceinline__ void done(const Unit&) const {}
};
struct EpiBf16 {
    static constexpr bool PERM = true;
    bf16_t* O; int ldc;
    __device__ __forceinline__ void operator()(const f32x4 (&acc)[2][2][4][2], const Unit& u, int wr, int wc, int fr, int fq) const {
        const int row0 = u.pm * BM + wr * 64 + fr; const int col0 = u.pn * BM + wc * 32 + 8 * fq;
#pragma unroll
        for (int ai = 0; ai < 2; ++ai)
#pragma unroll
            for (int m = 0; m < 4; ++m) { bf16_t* rowp = O + (size_t)(row0 + ai * HALF + m * 16) * ldc + col0;
#pragma unroll
                for (int bj = 0; bj < 2; ++bj) { const f32x4 v0 = acc[ai][bj][m][0], v1 = acc[ai][bj][m][1];
                    u32x4 w; w.x = cvt_pk_bf16(v0[0], v0[1]); w.y = cvt_pk_bf16(v0[2], v0[3]); w.z = cvt_pk_bf16(v1[0], v1[1]); w.w = cvt_pk_bf16(v1[2], v1[3]);
                    *(u32x4*)(rowp + bj * HALF) = w; } }
    }
};
struct EpiResid {
    static constexpr bool PERM = false;
    float* X; const float* modl; int chunk;
    __device__ __forceinline__ void operator()(const f32x4 (&acc)[2][2][4][2], const Unit& u, int wr, int wc, int fr, int fq) const {
        const int row0 = u.pm * BM + wr * 64 + fr, col0 = u.pn * BM + wc * 32 + 4 * fq;
        const int vs = u.pm < 32 ? 0 : (u.pm < 64 ? 1 : 2);
        const float* gate = modl + (size_t)vs * 12288 + chunk * 2048 + col0;
        f32x4 gv[2][2];
#pragma unroll
        for (int bj = 0; bj < 2; ++bj)
#pragma unroll
            for (int n = 0; n < 2; ++n) gv[bj][n] = *(const f32x4*)(gate + bj * HALF + n * 16);
#pragma unroll
        for (int ai = 0; ai < 2; ++ai)
#pragma unroll
            for (int m = 0; m < 4; ++m) { float* rowp = X + (size_t)(row0 + ai * HALF + m * 16) * DM + col0;
#pragma unroll
                for (int bj = 0; bj < 2; ++bj)
#pragma unroll
                    for (int n = 0; n < 2; ++n) { float* p = rowp + bj * HALF + n * 16; const f32x4 xo = *(const f32x4*)p; *(f32x4*)p = xo + gv[bj][n] * acc[ai][bj][m][n]; } }
    }
};

template <class Epi, class Sched>
__device__ __forceinline__ void gemm_phase(LAS unsigned char* lds, const Gemm g, const Sched& S, const Epi& E, int tid_in) {
    const int tid_l = tid_in * 64 + fresh_lane();
    const int tid = tid_l, wid = tid_in  , lane = tid & 63, wr = wid >> 2, wc = wid & 3, fr = lane & 15, fq = lane >> 4;
    const int K = g.K, nt = K / BK, lda = g.lda;
    unsigned voffA[2], voffB[2];
#pragma unroll
    for (int i = 0; i < 2; ++i) { int R, C; stage_rc(tid * 16 + i * 8192, R, C); const int Rb = Epi::PERM ? ((R & ~31) + perm32(R & 31)) : R;
        voffA[i] = (unsigned)(R * lda + C) * 2u; voffB[i] = (unsigned)(Rb * K + C) * 2u; }
    const size_t kstep = (size_t)(BK * 2);
    const size_t hstepA = (size_t)HALF * lda * 2, hstepB = (size_t)HALF * K * 2;
    const size_t tstepA = 2 * hstepA, tstepB = 2 * hstepB;
    const unsigned ldsw = (unsigned)wid * 1024u;
    const int aoff = lds_byte(wr * 64 + fr, fq * 8), boff = lds_byte(wc * 32 + fr, fq * 8);
#define PG8_SA(b, h) (((b) * 2 + (h)) * HTB)
#define PG8_SB(b, h) ((4 + (b) * 2 + (h)) * HTB)
#define PG8_STAGE(bufoff, gbase, voff) do { _Pragma("unroll") for (int _i = 0; _i < 2; ++_i) \
        __builtin_amdgcn_global_load_lds((const unsigned*)((const char*)(gbase) + (voff)[_i]), (LAS unsigned*)(lds + (bufoff) + ldsw + _i * 8192), 16, 0, 0); } while (0)
#define PG8_LDA(dst, b, h) do { _Pragma("unroll") for (int m = 0; m < 4; ++m) _Pragma("unroll") for (int k = 0; k < 2; ++k) dst[m][k] = *(const LAS bf16x8*)(lds + PG8_SA(b, h) + aoff + m * 2048 + k * 1024); } while (0)
#define PG8_LDB(dst, b, h) do { _Pragma("unroll") for (int n = 0; n < 2; ++n) _Pragma("unroll") for (int k = 0; k < 2; ++k) dst[n][k] = *(const LAS bf16x8*)(lds + PG8_SB(b, h) + boff + n * 2048 + k * 1024); } while (0)
#define PG8_MMA(ai, bj, At, Bt) do { __builtin_amdgcn_s_setprio(1); _Pragma("unroll") for (int m = 0; m < 4; ++m) _Pragma("unroll") for (int n = 0; n < 2; ++n) _Pragma("unroll") for (int k = 0; k < 2; ++k) \
        acc[ai][bj][m][n] = __builtin_amdgcn_mfma_f32_16x16x32_bf16(Bt[n][k], At[m][k], acc[ai][bj][m][n], 0, 0, 0); __builtin_amdgcn_s_setprio(0); } while (0)
#define PG8_WAIT_V(n) asm volatile("s_waitcnt vmcnt(" #n ")" ::: "memory")
#define PG8_WAIT_L(n) asm volatile("s_waitcnt lgkmcnt(" #n ")" ::: "memory")
#define PG8_BAR __builtin_amdgcn_s_barrier()
#define PG8_SCHED __builtin_amdgcn_sched_barrier(0)
    Unit cur, nxt; int ui = 0;
    if (!S.next(0, cur)) return;
    f32x4 acc[2][2][4][2];
#pragma unroll
    for (int a = 0; a < 2; ++a)
#pragma unroll
        for (int b = 0; b < 2; ++b)
#pragma unroll
            for (int m = 0; m < 4; ++m)
#pragma unroll
                for (int n = 0; n < 2; ++n) acc[a][b][m][n] = (f32x4){0.f, 0.f, 0.f, 0.f};
    bf16x8 At[4][2], B0[2][2], B1[2][2];
    const char* cA = (const char*)g.A + (size_t)cur.pm * tstepA; const char* cB = (const char*)g.Bt + (size_t)cur.pn * tstepB;
    S.a_ready(cur);
    PG8_STAGE(PG8_SB(0, 0), cB, voffB); PG8_STAGE(PG8_SA(0, 0), cA, voffA); PG8_STAGE(PG8_SB(0, 1), cB + hstepB, voffB); PG8_STAGE(PG8_SA(0, 1), cA + hstepA, voffA);
    if (wr == 1) PG8_BAR;
    PG8_WAIT_V(4); PG8_BAR;
    PG8_STAGE(PG8_SB(1, 0), cB + kstep, voffB); PG8_STAGE(PG8_SA(1, 0), cA + kstep, voffA); PG8_STAGE(PG8_SB(1, 1), cB + hstepB + kstep, voffB);
    PG8_WAIT_V(6); PG8_BAR;
    for (;;) {
        const bool has_next = S.next(ui + 1, nxt);
        const char* nA = has_next ? (const char*)g.A + (size_t)nxt.pm * tstepA : cA; const char* nB = has_next ? (const char*)g.Bt + (size_t)nxt.pn * tstepB : cB;
        for (int t = 0; t < nt; t += 2) {
            const bool last = (t == nt - 2);
            const char* a1 = cA + (size_t)(t + 1) * kstep;
            const char* a2 = last ? nA : cA + (size_t)(t + 2) * kstep; const char* b2 = last ? nB : cB + (size_t)(t + 2) * kstep;
            const char* a3 = a2 + kstep; const char* b3 = b2 + kstep;
            if (last && has_next) S.a_ready(nxt);
            PG8_LDB(B0, 0, 0); PG8_SCHED; PG8_LDA(At, 0, 0); PG8_STAGE(PG8_SA(1, 1), a1 + hstepA, voffA);
            PG8_WAIT_L(8); PG8_BAR; PG8_WAIT_L(0); PG8_MMA(0, 0, At, B0); PG8_BAR; PG8_SCHED;
            PG8_LDB(B1, 0, 1); PG8_STAGE(PG8_SB(0, 0), b2, voffB);
            PG8_BAR; PG8_WAIT_L(0); PG8_MMA(0, 1, At, B1); PG8_BAR;
            PG8_LDA(At, 0, 1); PG8_STAGE(PG8_SA(0, 0), a2, voffA);
            PG8_BAR; PG8_WAIT_L(0); PG8_MMA(1, 0, At, B0); PG8_BAR; PG8_SCHED;
            PG8_STAGE(PG8_SB(0, 1), b2 + hstepB, voffB);
            PG8_WAIT_V(6); PG8_BAR; PG8_MMA(1, 1, At, B1); PG8_BAR;
            PG8_LDB(B0, 1, 0); PG8_SCHED; PG8_LDA(At, 1, 0); PG8_STAGE(PG8_SA(0, 1), a2 + hstepA, voffA);
            PG8_WAIT_L(8); PG8_BAR; PG8_WAIT_L(0); PG8_MMA(0, 0, At, B0); PG8_BAR; PG8_SCHED;
            PG8_LDB(B1, 1, 1); PG8_STAGE(PG8_SB(1, 0), b3, voffB);
            PG8_BAR; PG8_WAIT_L(0); PG8_MMA(0, 1, At, B1); PG8_BAR;
            PG8_LDA(At, 1, 1); PG8_STAGE(PG8_SA(1, 0), a3, voffA);
            PG8_BAR; PG8_WAIT_L(0); PG8_MMA(1, 0, At, B0); PG8_BAR; PG8_SCHED;
            PG8_STAGE(PG8_SB(1, 1), b3 + hstepB, voffB);
            PG8_WAIT_V(6); PG8_BAR; PG8_MMA(1, 1, At, B1); PG8_BAR;
        }
        E(acc, cur, wr, wc, fr, fq); S.done(cur);
        if (!has_next) break;
#pragma unroll
        for (int a = 0; a < 2; ++a)
#pragma unroll
            for (int b = 0; b < 2; ++b)
#pragma unroll
                for (int m = 0; m < 4; ++m)
#pragma unroll
                    for (int n = 0; n < 2; ++n) acc[a][b][m][n] = (f32x4){0.f, 0.f, 0.f, 0.f};
        cur = nxt; cA = nA; cB = nB; ++ui;
    }
    PG8_WAIT_V(0);
    if (wr == 0) PG8_BAR;
    PG8_BAR;
#undef PG8_SA
#undef PG8_SB
#undef PG8_STAGE
#undef PG8_LDA
#undef PG8_LDB
#undef PG8_MMA
#undef PG8_WAIT_V
#undef PG8_WAIT_L
#undef PG8_BAR
#undef PG8_SCHED
}
}

namespace att {
constexpr int NW = 8, QBLK = 32, KVBLK = 64, DV = 128;
constexpr float THR = 8.f;
constexpr int SHM_V = KVBLK * DV * 2;
#define SBAR() __builtin_amdgcn_sched_barrier(0)
__device__ __forceinline__ int crow(int r, int hi) { return (r & 3) + 8 * (r >> 2) + 4 * hi; }
__device__ __forceinline__ unsigned cvtpk(float lo, float hi) { unsigned r; asm volatile("v_cvt_pk_bf16_f32 %0, %1, %2" : "=v"(r) : "v"(lo), "v"(hi)); return r; }
__device__ __forceinline__ void partialSM(f32x16& p0, f32x16& p1, float& m_reg, float& mn, float& alpha, const float C, const float thr_raw) {
    float pmax = p0[0];
#pragma unroll
    for (int r = 1; r < 16; ++r) pmax = fmaxf(pmax, p0[r]);
#pragma unroll
    for (int r = 0; r < 16; ++r) pmax = fmaxf(pmax, p1[r]);
    { auto rr = __builtin_amdgcn_permlane32_swap(__float_as_uint(pmax), __float_as_uint(pmax), false, false);
      pmax = fmaxf(__uint_as_float(rr[0]), __uint_as_float(rr[1])); }
    if (__builtin_expect(__all(pmax - m_reg <= thr_raw), 1)) { mn = m_reg; alpha = 1.f; }
    else { mn = fmaxf(m_reg, pmax); alpha = __builtin_amdgcn_exp2f((m_reg - mn) * C); m_reg = mn; }
    const float mnC = -mn * C;
#pragma unroll
    for (int r = 0; r < 16; ++r) p0[r] = fmaf(p0[r], C, mnC);
#pragma unroll
    for (int r = 0; r < 16; ++r) p1[r] = fmaf(p1[r], C, mnC);
#pragma unroll
    for (int r = 0; r < 16; ++r) p0[r] = __builtin_amdgcn_exp2f(p0[r]);
}
__device__ __forceinline__ void finishSM(f32x16& p0, f32x16& p1, float alpha, float& l_reg, bf16x8& pa0, bf16x8& pa1, bf16x8& pa2, bf16x8& pa3) {
#pragma unroll
    for (int r = 0; r < 16; ++r) p1[r] = __builtin_amdgcn_exp2f(p1[r]);
    float ps = 0;
#pragma unroll
    for (int r = 0; r < 16; ++r) ps += p0[r];
#pragma unroll
    for (int r = 0; r < 16; ++r) ps += p1[r];
    { auto rr = __builtin_amdgcn_permlane32_swap(__float_as_uint(ps), __float_as_uint(ps), false, false);
      ps = __uint_as_float(rr[0]) + __uint_as_float(rr[1]); }
    l_reg = l_reg * alpha + ps;
#define PK4(P, BASE, OUT) do { unsigned a0 = cvtpk(P[BASE + 0], P[BASE + 1]), a1 = cvtpk(P[BASE + 2], P[BASE + 3]);   \
    unsigned b0 = cvtpk(P[BASE + 4], P[BASE + 5]), b1 = cvtpk(P[BASE + 6], P[BASE + 7]);                              \
    auto r0 = __builtin_amdgcn_permlane32_swap(a0, b0, false, false); auto r1 = __builtin_amdgcn_permlane32_swap(a1, b1, false, false); \
    u32x4 w = {r0[0], r1[0], r0[1], r1[1]}; OUT = *reinterpret_cast<bf16x8*>(&w); } while (0)
    PK4(p0, 0, pa0); PK4(p0, 8, pa1); PK4(p1, 0, pa2); PK4(p1, 8, pa3);
#undef PK4
}
__device__ __forceinline__ void partialSM_nm(f32x16& p0) {
#pragma unroll
    for (int r = 0; r < 16; ++r) p0[r] = __builtin_amdgcn_exp2f(p0[r]);
}
template <int DQK, int QL>
__device__ __forceinline__ void qkt(f32x16& p0, f32x16& p1, const char* Ks, const bf16x8 (&qr)[DQK / 16 - QL], const char* qpark, int r32, int hi) {
    constexpr int RS = DQK * 2 + 16, NQR = DQK / 16 - QL, GRP = (DQK > 128) ? QKT_GRP : DQK / 16;
    p0 = f32x16{}; p1 = f32x16{};
#pragma unroll
    for (int g0 = 0; g0 < DQK / 16; g0 += GRP) {
#pragma unroll
        for (int d0 = g0; d0 < g0 + GRP; ++d0) { const int cb = (d0 * 16 + hi * 8) * 2;
            const bf16x8 b0 = *reinterpret_cast<const bf16x8*>(Ks + r32 * RS + cb);
            const bf16x8 b1 = *reinterpret_cast<const bf16x8*>(Ks + (32 + r32) * RS + cb);
            bf16x8 qf; if (d0 < NQR) qf = qr[d0 < NQR ? d0 : 0]; else qf = *reinterpret_cast<const bf16x8*>(qpark + (d0 - NQR) * 1024);
            p0 = __builtin_amdgcn_mfma_f32_32x32x16_bf16(b0, qf, p0, 0, 0, 0);
            p1 = __builtin_amdgcn_mfma_f32_32x32x16_bf16(b1, qf, p1, 0, 0, 0); }
        if (g0 + GRP < DQK / 16) SBAR();
    }
}
__device__ __forceinline__ int v_st(int k, int c) { const int kk = (k & ~0xC) | ((k & 4) << 1) | ((k & 8) >> 1); return ((kk >> 3) * 4 + (c >> 5)) * 512 + ((kk & 7) * 32 + (c & 31)) * 2; }
__device__ __forceinline__ int v_rd_base(int lane) { return ((lane & 3) << 3) | (((lane >> 2) & 3) << 6) | (((lane >> 4) & 1) << 5) | (((lane >> 5) & 1) << 8); }
constexpr int v_rd_off(int d0, int ks, int half) { return d0 * 512 + ks * 4096 + half * 2048; }
template <int OFF> __device__ __forceinline__ s16x4 tr_read(int vb) {
    s16x4 r; asm volatile("ds_read_b64_tr_b16 %0, %1 offset:%2" : "=&v"(r) : "v"(vb), "i"(OFF) : "memory"); return r;
}
template <int D0> __device__ __forceinline__ void pv_one(f32x16& od, int vb, bf16x8 pa0, bf16x8 pa1, bf16x8 pa2, bf16x8 pa3) {
    const s16x4 l0 = tr_read<v_rd_off(D0, 0, 0)>(vb), h0 = tr_read<v_rd_off(D0, 0, 1)>(vb), l1 = tr_read<v_rd_off(D0, 1, 0)>(vb), h1 = tr_read<v_rd_off(D0, 1, 1)>(vb);
    const s16x4 l2 = tr_read<v_rd_off(D0, 2, 0)>(vb), h2 = tr_read<v_rd_off(D0, 2, 1)>(vb), l3 = tr_read<v_rd_off(D0, 3, 0)>(vb), h3 = tr_read<v_rd_off(D0, 3, 1)>(vb);
    asm volatile("s_waitcnt lgkmcnt(0)" ::: "memory"); SBAR();
#define PK(L, H) (bf16x8){L[0], L[1], L[2], L[3], H[0], H[1], H[2], H[3]}
    od = __builtin_amdgcn_mfma_f32_32x32x16_bf16(pa0, PK(l0, h0), od, 0, 0, 0);
    od = __builtin_amdgcn_mfma_f32_32x32x16_bf16(pa1, PK(l1, h1), od, 0, 0, 0);
    od = __builtin_amdgcn_mfma_f32_32x32x16_bf16(pa2, PK(l2, h2), od, 0, 0, 0);
    od = __builtin_amdgcn_mfma_f32_32x32x16_bf16(pa3, PK(l3, h3), od, 0, 0, 0);
#undef PK
}
__device__ __forceinline__ void pv_d0(f32x16* o, int vb, bf16x8 pa0, bf16x8 pa1, bf16x8 pa2, bf16x8 pa3) {
    pv_one<0>(o[0], vb, pa0, pa1, pa2, pa3); pv_one<1>(o[1], vb, pa0, pa1, pa2, pa3); pv_one<2>(o[2], vb, pa0, pa1, pa2, pa3); pv_one<3>(o[3], vb, pa0, pa1, pa2, pa3);
}
struct VFrag { s16x4 l0, h0, l1, h1, l2, h2, l3, h3; };
template <int D0> __device__ __forceinline__ void pv_rd(VFrag& f, int vb) {
    f.l0 = tr_read<v_rd_off(D0, 0, 0)>(vb); f.h0 = tr_read<v_rd_off(D0, 0, 1)>(vb); f.l1 = tr_read<v_rd_off(D0, 1, 0)>(vb); f.h1 = tr_read<v_rd_off(D0, 1, 1)>(vb);
    f.l2 = tr_read<v_rd_off(D0, 2, 0)>(vb); f.h2 = tr_read<v_rd_off(D0, 2, 1)>(vb); f.l3 = tr_read<v_rd_off(D0, 3, 0)>(vb); f.h3 = tr_read<v_rd_off(D0, 3, 1)>(vb);
}
__device__ __forceinline__ void pv_mm(f32x16& od, const VFrag& f, bf16x8 pa0, bf16x8 pa1, bf16x8 pa2, bf16x8 pa3) {
#define PK(L, H) (bf16x8){L[0], L[1], L[2], L[3], H[0], H[1], H[2], H[3]}
    od = __builtin_amdgcn_mfma_f32_32x32x16_bf16(pa0, PK(f.l0, f.h0), od, 0, 0, 0);
    od = __builtin_amdgcn_mfma_f32_32x32x16_bf16(pa1, PK(f.l1, f.h1), od, 0, 0, 0);
    od = __builtin_amdgcn_mfma_f32_32x32x16_bf16(pa2, PK(f.l2, f.h2), od, 0, 0, 0);
    od = __builtin_amdgcn_mfma_f32_32x32x16_bf16(pa3, PK(f.l3, f.h3), od, 0, 0, 0);
#undef PK
}
__device__ __forceinline__ void pv_d0_pipe(f32x16* o, int vb, bf16x8 pa0, bf16x8 pa1, bf16x8 pa2, bf16x8 pa3) {
    VFrag fa, fb;
    pv_rd<0>(fa, vb); pv_rd<1>(fb, vb);
    asm volatile("s_waitcnt lgkmcnt(8)" ::: "memory"); SBAR(); pv_mm(o[0], fa, pa0, pa1, pa2, pa3); SBAR();
    pv_rd<2>(fa, vb);
    asm volatile("s_waitcnt lgkmcnt(8)" ::: "memory"); SBAR(); pv_mm(o[1], fb, pa0, pa1, pa2, pa3); SBAR();
    pv_rd<3>(fb, vb);
    asm volatile("s_waitcnt lgkmcnt(8)" ::: "memory"); SBAR(); pv_mm(o[2], fa, pa0, pa1, pa2, pa3); SBAR();
    asm volatile("s_waitcnt lgkmcnt(0)" ::: "memory"); SBAR(); pv_mm(o[3], fb, pa0, pa1, pa2, pa3);
}
template <int DQK> struct ScaleOf { static constexpr float scale = DQK == 192 ? 0.07216878364870322f : (DQK == 128 ? 0.08838834764831845f : 0.125f); };
template <int DQK, int SDEPTH, int QL, bool NOMAX, int ldq, int ldk, int ldv, int ldo>
__device__ __forceinline__ void attn_body(const bf16_t* __restrict__ Qb, const bf16_t* __restrict__ Kh, const bf16_t* __restrict__ Vh,
                                          bf16_t* __restrict__ Ob, int seq, char* lds, int tid_in, const float negMC) {
    constexpr float C = 1.0f, thr_raw = THR * 1.4426950408889634f;
    constexpr int RS = DQK * 2 + 16  , SHM_K = KVBLK * RS, NKP = DQK / 64, KPR = DQK / 8;
    const int tid_l = tid_in * 64 + fresh_lane();
    const int tid = tid_l, wid = tid_in  , lane = tid & 63, r32 = lane & 31, hi = lane >> 5;
    char* V_lds = lds; char* K_lds = lds + 2 * SHM_V;
    float* ws = (float*)(lds + 2 * SHM_V + 2 * SHM_K) + wid * 64; float* li_l = ws; float* al_l = ws + 32;
    constexpr int NQR = DQK / 16 - QL;
    char* qpark = lds + 2 * SHM_V + 2 * SHM_K + 2048 + wid * (QL * 1024) + lane * 16;
    float m_reg = -1e30f, l_reg = 0; f32x16 o[4] = {}; bf16x8 qr[NQR];
    const bf16_t* Qw = Qb + (size_t)(wid * QBLK + r32) * ldq + hi * 8;
#pragma unroll
    for (int d0 = 0; d0 < NQR; ++d0) qr[d0] = *reinterpret_cast<const bf16x8*>(Qw + d0 * 16);
#pragma unroll
    for (int d0 = 0; d0 < QL; ++d0) *(bf16x8*)(qpark + d0 * 1024) = *reinterpret_cast<const bf16x8*>(Qw + (NQR + d0) * 16);
    const int sr = tid >> 4, sc = (tid & 15) * 8, vst0 = v_st(sr, sc), vst1 = v_st(32 + sr, sc);
    int koff[NKP], klds[NKP];
#pragma unroll
    for (int i = 0; i < NKP; ++i) { const int row = tid >> 3, c8 = (tid & 7) + 8 * i; koff[i] = row * ldk + c8 * 8; klds[i] = row * RS + c8 * 16; }
    const int vb0 = (int)(uintptr_t)V_lds + v_rd_base(lane);
    bf16x8 sv0[SDEPTH], sv1[SDEPTH], sk[SDEPTH][NKP];
#define SLOAD(i, k0) do { sv0[i] = *reinterpret_cast<const bf16x8*>(&Vh[(size_t)((k0) + sr) * ldv + sc]); sv1[i] = *reinterpret_cast<const bf16x8*>(&Vh[(size_t)((k0) + 32 + sr) * ldv + sc]); \
    _Pragma("unroll") for (int _q = 0; _q < NKP; ++_q) sk[i][_q] = *reinterpret_cast<const bf16x8*>(&Kh[(size_t)(k0) * ldk + koff[_q]]); } while (0)
#define SWRITE(b, i) do { *(bf16x8*)(V_lds + (b) * SHM_V + vst0) = sv0[i]; *(bf16x8*)(V_lds + (b) * SHM_V + vst1) = sv1[i]; \
    _Pragma("unroll") for (int _q = 0; _q < NKP; ++_q) *(bf16x8*)(K_lds + (b) * SHM_K + klds[_q]) = sk[i][_q]; } while (0)
#define SWAIT() do { if constexpr (SDEPTH == 2) { if constexpr (NKP == 1) asm volatile("s_waitcnt vmcnt(3)" ::: "memory"); else if constexpr (NKP == 2) asm volatile("s_waitcnt vmcnt(4)" ::: "memory"); else asm volatile("s_waitcnt vmcnt(5)" ::: "memory"); } \
    else asm volatile("s_waitcnt vmcnt(0)" ::: "memory"); } while (0)
#define PVD0(...) do { if constexpr (PV_PIPE != 0) pv_d0_pipe(__VA_ARGS__); else pv_d0(__VA_ARGS__); } while (0)
#define RESC(a) do { if constexpr (!NOMAX) if (__any((a) < 1.f)) { if (hi == 0) al_l[r32] = (a); asm volatile("s_waitcnt lgkmcnt(0)" ::: "memory"); \
    _Pragma("unroll") for (int d = 0; d < 4; ++d) _Pragma("unroll") for (int r = 0; r < 16; ++r) o[d][r] *= al_l[crow(r, hi)]; } } while (0)
    f32x16 pA0, pA1, pB0, pB1; float mnA, mnB, alA, alB; bf16x8 pa0, pa1, pa2, pa3; const int NT = seq / KVBLK;
    if (ATT_PRIO && wid >= 4) __builtin_amdgcn_s_setprio(1);
    constexpr int SE = 0, SO = SDEPTH - 1;
    SLOAD(SE, 0); asm volatile("s_waitcnt vmcnt(0)" ::: "memory"); SWRITE(0, SE); __syncthreads();
    qkt<DQK, QL>(pA0, pA1, K_lds, qr, qpark, r32, hi); if constexpr (NOMAX) { partialSM_nm(pA0); alA = 1.f; } else partialSM(pA0, pA1, m_reg, mnA, alA, C, thr_raw);
    SLOAD(SO, KVBLK); if constexpr (SDEPTH == 2) { if (2 < NT) SLOAD(SE, 2 * KVBLK); }
    SWAIT(); SWRITE(1, SO); __syncthreads();
    for (int j = 1; j + 1 < NT; j += 2) {
        SBAR(); qkt<DQK, QL>(pB0, pB1, K_lds + SHM_K, qr, qpark, r32, hi);
        finishSM(pA0, pA1, alA, l_reg, pa0, pa1, pa2, pa3); SBAR();
        SLOAD(SO, (j + SDEPTH) * KVBLK); SBAR();
        PVD0(o, vb0, pa0, pa1, pa2, pa3); if constexpr (NOMAX) { partialSM_nm(pB0); alB = 1.f; } else partialSM(pB0, pB1, m_reg, mnB, alB, C, thr_raw);
        __syncthreads(); SWAIT(); SWRITE(0, SE);
        RESC(alB); __syncthreads();
        SBAR(); qkt<DQK, QL>(pA0, pA1, K_lds, qr, qpark, r32, hi);
        finishSM(pB0, pB1, alB, l_reg, pa0, pa1, pa2, pa3); SBAR();
        if (SDEPTH == 1 || j + 3 < NT) SLOAD(SE, (j + 1 + SDEPTH) * KVBLK); SBAR();
        PVD0(o, vb0 + SHM_V, pa0, pa1, pa2, pa3); if constexpr (NOMAX) { partialSM_nm(pA0); alA = 1.f; } else partialSM(pA0, pA1, m_reg, mnA, alA, C, thr_raw);
        __syncthreads(); SWAIT(); SWRITE(1, SO);
        RESC(alA); __syncthreads();
    }
    SBAR(); qkt<DQK, QL>(pB0, pB1, K_lds + SHM_K, qr, qpark, r32, hi);
    finishSM(pA0, pA1, alA, l_reg, pa0, pa1, pa2, pa3); SBAR();
    PVD0(o, vb0, pa0, pa1, pa2, pa3); if constexpr (NOMAX) { partialSM_nm(pB0); alB = 1.f; } else partialSM(pB0, pB1, m_reg, mnB, alB, C, thr_raw);
    __syncthreads(); RESC(alB);
    finishSM(pB0, pB1, alB, l_reg, pa0, pa1, pa2, pa3); SBAR();
    PVD0(o, vb0 + SHM_V, pa0, pa1, pa2, pa3);
    if (ATT_PRIO) __builtin_amdgcn_s_setprio(0);
    if (hi == 0) li_l[r32] = l_reg; asm volatile("s_waitcnt lgkmcnt(0)" ::: "memory");
    float rli[16];
#pragma unroll
    for (int r = 0; r < 16; ++r) rli[r] = __builtin_amdgcn_rcpf(li_l[crow(r, hi)]);
    bf16_t* Ow = Ob + (size_t)(wid * QBLK) * ldo + (r32 & ~1);
    const bool odd = (r32 & 1) != 0;
#pragma unroll
    for (int r = 0; r < 16; r += 2) { const int orow = crow(r, hi) + (odd ? 1 : 0);
#pragma unroll
        for (int d0 = 0; d0 < 4; ++d0) { const float a = o[d0][r] * rli[r], b = o[d0][r + 1] * rli[r + 1];
            const float recv = swz_xor<1>(odd ? a : b);
            const unsigned w = odd ? cvtpk(recv, b) : cvtpk(a, recv);
            *(unsigned*)(Ow + (size_t)orow * ldo + d0 * 32) = w; } }
    __syncthreads();
#undef SLOAD
#undef SWRITE
#undef SWAIT
#undef RESC
#undef PVD0
}
template <int DQK, int QL, int ldq, int ldk, int ldv, int ldo>
__device__ __forceinline__ void attn_body_simple(const bf16_t* __restrict__ Qb, const bf16_t* __restrict__ Kh, const bf16_t* __restrict__ Vh,
                                                 bf16_t* __restrict__ Ob, int seq, char* lds, int tid_in) {
    constexpr float C = 1.0f, thr_raw = THR * 1.4426950408889634f;
    constexpr int RS = DQK * 2 + 16  , SHM_K = KVBLK * RS, NKP = DQK / 64, KPR = DQK / 8;
    const int tid_l = tid_in * 64 + fresh_lane();
    const int tid = tid_l, wid = tid_in  , lane = tid & 63, r32 = lane & 31, hi = lane >> 5;
    char* V_lds = lds; char* K_lds = lds + 2 * SHM_V;
    float* ws = (float*)(lds + 2 * SHM_V + 2 * SHM_K) + wid * 64; float* li_l = ws; float* al_l = ws + 32;
    constexpr int NQR = DQK / 16 - QL;
    char* qpark = lds + 2 * SHM_V + 2 * SHM_K + 2048 + wid * (QL * 1024) + lane * 16;
    float m_reg = -1e30f, l_reg = 0; f32x16 o[4] = {}; bf16x8 qr[NQR];
    const bf16_t* Qw = Qb + (size_t)(wid * QBLK + r32) * ldq + hi * 8;
#pragma unroll
    for (int d0 = 0; d0 < NQR; ++d0) qr[d0] = *reinterpret_cast<const bf16x8*>(Qw + d0 * 16);
#pragma unroll
    for (int d0 = 0; d0 < QL; ++d0) *(bf16x8*)(qpark + d0 * 1024) = *reinterpret_cast<const bf16x8*>(Qw + (NQR + d0) * 16);
    const int sr = tid >> 4, sc = (tid & 15) * 8, vst0 = v_st(sr, sc), vst1 = v_st(32 + sr, sc);
    int koff[NKP], klds[NKP];
#pragma unroll
    for (int i = 0; i < NKP; ++i) { const int row = tid >> 3, c8 = (tid & 7) + 8 * i; koff[i] = row * ldk + c8 * 8; klds[i] = row * RS + c8 * 16; }
    const int vb0 = (int)(uintptr_t)V_lds + v_rd_base(lane);
    bf16x8 sv0, sv1, sk[NKP];
#define SLOAD(k0) do { sv0 = *reinterpret_cast<const bf16x8*>(&Vh[(size_t)((k0) + sr) * ldv + sc]); sv1 = *reinterpret_cast<const bf16x8*>(&Vh[(size_t)((k0) + 32 + sr) * ldv + sc]); \
    _Pragma("unroll") for (int _q = 0; _q < NKP; ++_q) sk[_q] = *reinterpret_cast<const bf16x8*>(&Kh[(size_t)(k0) * ldk + koff[_q]]); } while (0)
#define SWRITE(b) do { *(bf16x8*)(V_lds + (b) * SHM_V + vst0) = sv0; *(bf16x8*)(V_lds + (b) * SHM_V + vst1) = sv1; \
    _Pragma("unroll") for (int _q = 0; _q < NKP; ++_q) *(bf16x8*)(K_lds + (b) * SHM_K + klds[_q]) = sk[_q]; } while (0)
#define RESC(a) do { if (__any((a) < 1.f)) { if (hi == 0) al_l[r32] = (a); asm volatile("s_waitcnt lgkmcnt(0)" ::: "memory"); \
    _Pragma("unroll") for (int d = 0; d < 4; ++d) _Pragma("unroll") for (int r = 0; r < 16; ++r) o[d][r] *= al_l[crow(r, hi)]; } } while (0)
    const int NT = seq / KVBLK;
    SLOAD(0); asm volatile("s_waitcnt vmcnt(0)" ::: "memory"); SWRITE(0); __syncthreads();
    for (int j = 0; j < NT; ++j) {
        const int b = j & 1;
        if (j + 1 < NT) SLOAD((j + 1) * KVBLK);
        SBAR();
        f32x16 p0, p1; float mn, al; bf16x8 pa0, pa1, pa2, pa3;
        { const char* Ks = K_lds + b * SHM_K; p0 = f32x16{}; p1 = f32x16{};
#pragma unroll
          for (int d0 = 0; d0 < DQK / 16; ++d0) { const int cb = (d0 * 16 + hi * 8) * 2;
              const bf16x8 b0 = *reinterpret_cast<const bf16x8*>(Ks + r32 * RS + cb);
              const bf16x8 b1 = *reinterpret_cast<const bf16x8*>(Ks + (32 + r32) * RS + cb);
              bf16x8 qf; if (d0 < NQR) qf = qr[d0 < NQR ? d0 : 0]; else qf = *(const bf16x8*)(qpark + (d0 - NQR) * 1024);
              p0 = __builtin_amdgcn_mfma_f32_32x32x16_bf16(b0, qf, p0, 0, 0, 0);
              p1 = __builtin_amdgcn_mfma_f32_32x32x16_bf16(b1, qf, p1, 0, 0, 0); } }
        partialSM(p0, p1, m_reg, mn, al, C, thr_raw);
        RESC(al);
        finishSM(p0, p1, al, l_reg, pa0, pa1, pa2, pa3); SBAR();
        pv_d0(o, vb0 + b * SHM_V, pa0, pa1, pa2, pa3);
        if (j + 1 < NT) { asm volatile("s_waitcnt vmcnt(0)" ::: "memory"); SWRITE(b ^ 1); }
        __syncthreads();
    }
    if (hi == 0) li_l[r32] = l_reg; asm volatile("s_waitcnt lgkmcnt(0)" ::: "memory");
    float rli[16];
#pragma unroll
    for (int r = 0; r < 16; ++r) rli[r] = __builtin_amdgcn_rcpf(li_l[crow(r, hi)]);
    bf16_t* Ow = Ob + (size_t)(wid * QBLK) * ldo + (r32 & ~1);
    const bool odd = (r32 & 1) != 0;
#pragma unroll
    for (int r = 0; r < 16; r += 2) { const int orow = crow(r, hi) + (odd ? 1 : 0);
#pragma unroll
        for (int d0 = 0; d0 < 4; ++d0) { const float a = o[d0][r] * rli[r], b = o[d0][r + 1] * rli[r + 1];
            const float recv = swz_xor<1>(odd ? a : b);
            const unsigned w = odd ? cvtpk(recv, b) : cvtpk(a, recv);
            *(unsigned*)(Ow + (size_t)orow * ldo + d0 * 32) = w; } }
    __syncthreads();
#undef SLOAD
#undef SWRITE
#undef RESC
}
}

struct Params {
    const float* x; const float* c; const float* ctx; const float* c_ctx; const float* w_mod; const float* b_mod; const float* g_norm1; const float* g_norm2;
    const float* w_in_ab; const float* g_cq; const float* w_uq; const float* g_ckv; const float* w_ukv; const float* g_qn_a; const float* g_kn_a; const float* lam_vec;
    const float* g_qn_b; const float* g_kn_b; const float* g_sub_b; const float* w_out_ab; const float* w_in_c; const float* g_qn_c; const float* g_kn_c; const float* w_out_c;
    const float* w_pq; const float* sub_keys; const float* expert_u; const float* expert_v;
    float* out; unsigned char* ws; int ph_lo, ph_hi;
};

typedef const __attribute__((address_space(4))) Params CParams;
struct Ctx {
    int tid, lane, wid, G, vcu, bx;
    unsigned char* ws; char* lds;
};

__device__ __forceinline__ void tconv(const Ctx& F, const float* src, bf16_t* dst, const float* gain, int nmat, int K, int N, int Npad) {
    float* tile = (float*)(F.lds + 32768);
    const int ntn = Npad / 64, ntk = K / 64, per = ntn * ntk, total = per * nmat;
    for (int it = F.vcu; it < total; it += F.G) {
        const int mat = it / per, rem = it % per, tn = rem / ntk, tk = rem % ntk, k0 = tk * 64, n0 = tn * 64;
        const float* s = src + (size_t)mat * K * N; bf16_t* d = dst + (size_t)mat * Npad * K;
        __syncthreads();
        { const int r = F.tid >> 4, c4 = (F.tid & 15) * 4;
#pragma unroll
          for (int i = 0; i < 2; ++i) { const int rr = r + i * 32; f32x4 v = (f32x4){0.f, 0.f, 0.f, 0.f};
              if (n0 + c4 < N) v = *(const f32x4*)(s + (size_t)(k0 + rr) * N + n0 + c4);
              tile[rr * 65 + c4 + 0] = v[0]; tile[rr * 65 + c4 + 1] = v[1]; tile[rr * 65 + c4 + 2] = v[2]; tile[rr * 65 + c4 + 3] = v[3]; } }
        __syncthreads();
        { const int n = F.tid >> 3, kc = (F.tid & 7) * 8; float v[8];
#pragma unroll
          for (int e = 0; e < 8; ++e) { v[e] = tile[(kc + e) * 65 + n]; if (gain) v[e] *= gain[(size_t)mat * K + k0 + kc + e]; }
          u32x4 w; w.x = cvt_pk_bf16(v[0], v[1]); w.y = cvt_pk_bf16(v[2], v[3]); w.z = cvt_pk_bf16(v[4], v[5]); w.w = cvt_pk_bf16(v[6], v[7]);
          *(u32x4*)(d + (size_t)(n0 + n) * K + k0 + kc) = w; }
    }
}
__device__ __forceinline__ void cvt_flat(const Ctx& F, const float* src, bf16_t* dst, size_t n8) {
    for (size_t i = (size_t)F.vcu * 512 + F.tid; i < n8; i += (size_t)F.G * 512) {
        const f32x4 a = *(const f32x4*)(src + i * 8), b = *(const f32x4*)(src + i * 8 + 4);
        u32x4 w; w.x = cvt_pk_bf16(a[0], a[1]); w.y = cvt_pk_bf16(a[2], a[3]); w.z = cvt_pk_bf16(b[0], b[1]); w.w = cvt_pk_bf16(b[2], b[3]);
        *(u32x4*)(dst + i * 8) = w;
    }
}
typedef unsigned v6u __attribute__((ext_vector_type(6)));
typedef float v32f __attribute__((ext_vector_type(32)));
typedef float v16f __attribute__((ext_vector_type(16)));
__device__ __forceinline__ float fp6_val(int c) { return c < 8 ? c * 0.125f : (c < 16 ? 1.f + (c - 8) * 0.125f : (c < 24 ? 2.f + (c - 16) * 0.25f : 4.f + (c - 24) * 0.5f)); }
__device__ __forceinline__ int fp6_code(float x) { return x < 1.f ? (int)(x * 8.f + 0.5f) : (x < 2.f ? 8 + (int)((x - 1.f) * 8.f + 0.5f) : (x < 4.f ? 16 + (int)((x - 2.f) * 4.f + 0.5f) : 24 + (int)((x - 4.f) * 2.f + 0.5f))); }
__device__ __forceinline__ void cvt_rows_fp6(const Ctx& F, const float* src, unsigned char* dst, float* descale, int R) {
    float* stg = (float*)(F.lds + 65536) + F.wid * (64 * 33);
    int* permL = (int*)(F.lds + 65536 + 8 * 64 * 33 * 4) + F.wid * 32;
    float fac;
    {   v16f lo, hi;
#pragma unroll
        for (int i = 0; i < 16; ++i) { lo[i] = fp6_val(i); hi[i] = fp6_val(16 + i); }
        const v6u w = __builtin_amdgcn_cvt_scalef32_2xpk16_fp6_f32(lo, hi, 1.0f);
        const v32f f = __builtin_amdgcn_cvt_scalef32_pk32_f32_fp6(w, 1.0f);
        float mx = 0.f;
#pragma unroll
        for (int j = 0; j < 32; ++j) mx = fmaxf(mx, f[j]);
        fac = mx * (1.f / 7.5f);
        const float inv = fac > 0.f ? 1.f / fac : 1.f;
        if (F.lane == 0) {
#pragma unroll
            for (int j = 0; j < 32; ++j) permL[j] = fp6_code(f[j] * inv) & 31; }
        asm volatile("s_waitcnt lgkmcnt(0)" ::: "memory"); __builtin_amdgcn_wave_barrier(); asm volatile("" ::: "memory");
    }
    for (int row = F.vcu * 8 + F.wid; row < R; row += F.G * 8) {
        const float* s = src + (size_t)row * DM + F.lane * 32; f32x4 v[8]; float am = 0.f;
#pragma unroll
        for (int i = 0; i < 8; ++i) { v[i] = *(const f32x4*)(s + i * 4);
#pragma unroll
            for (int e = 0; e < 4; ++e) am = fmaxf(am, fabsf(v[i][e])); }
        am = wave_max(am);
        const float sc = am > 0.f ? 7.f / am : 1.f;
#pragma unroll
        for (int i = 0; i < 8; ++i)
#pragma unroll
            for (int e = 0; e < 4; ++e) stg[F.lane * 33 + permL[i * 4 + e]] = v[i][e] * sc;
        asm volatile("s_waitcnt lgkmcnt(0)" ::: "memory"); __builtin_amdgcn_wave_barrier(); asm volatile("" ::: "memory");
        v16f lo, hi;
#pragma unroll
        for (int i = 0; i < 16; ++i) { lo[i] = stg[F.lane * 33 + i]; hi[i] = stg[F.lane * 33 + 16 + i]; }
        asm volatile("s_waitcnt lgkmcnt(0)" ::: "memory"); __builtin_amdgcn_wave_barrier(); asm volatile("" ::: "memory");
        const v6u w = __builtin_amdgcn_cvt_scalef32_2xpk16_fp6_f32(lo, hi, 1.0f);
        u32x2* d = (u32x2*)(dst + (size_t)row * EROW + F.lane * 24);
        d[0] = (u32x2){w[0], w[1]}; d[1] = (u32x2){w[2], w[3]}; d[2] = (u32x2){w[4], w[5]};
        if (F.lane == 0) descale[row] = (am > 0.f ? am * (1.f / 7.f) : 1.f) / (fac > 0.f ? fac : 1.f);
    }
}
__device__ __forceinline__ float silu_f(float v) { return v / (1.f + __expf(-v)); }

__device__ __forceinline__ void prologue_phase(const Ctx& F, CParams& P) {
    unsigned char* ws = F.ws;
    {
        float* sv = (float*)F.lds;
        float* part = (float*)(F.lds + 24576);
        for (int i = F.tid; i < 3 * DM; i += 512) { const int v = i / DM, k = i % DM; const float cv = v < 2 ? P.c[v * DM + k] : P.c_ctx[k]; sv[i] = silu_f(cv); }
        __syncthreads();
        float* mod = (float*)(ws + WS_MOD);
        for (int it = F.vcu; it < DEPTH * 192; it += F.G) {
            const int l = it / 192, n0 = (it % 192) * 64;
            const float* wp = P.w_mod + ((size_t)l * DM + F.wid * 256) * 12288 + n0 + F.lane;
            float a0 = 0.f, a1 = 0.f, a2 = 0.f;
#pragma unroll 8
            for (int k = 0; k < 256; ++k) { const float w = wp[(size_t)k * 12288]; const int kk = F.wid * 256 + k; a0 += sv[kk] * w; a1 += sv[DM + kk] * w; a2 += sv[2 * DM + kk] * w; }
            part[(F.wid * 3 + 0) * 64 + F.lane] = a0; part[(F.wid * 3 + 1) * 64 + F.lane] = a1; part[(F.wid * 3 + 2) * 64 + F.lane] = a2;
            __syncthreads();
            if (F.wid < 3) { float s = 0.f;
#pragma unroll
                for (int w = 0; w < 8; ++w) s += part[(w * 3 + F.wid) * 64 + F.lane];
                mod[((size_t)l * 3 + F.wid) * 12288 + n0 + F.lane] = s + P.b_mod[(size_t)l * 12288 + n0 + F.lane]; }
            __syncthreads();
        }
    }
    if (F.vcu == 0) {
        float* t16 = (float*)(ws + WS_TAB16); float* t32 = (float*)(ws + WS_TAB32);
        for (int i = F.tid; i < 128 * 16; i += 512) { const int pos = i >> 4, f = i & 15; const float fr = powf(10000.f, -(float)f / 16.f); const float a = (float)pos * fr; float s, c; sincosf(a, &s, &c); t16[i * 2] = c; t16[i * 2 + 1] = s; }
        for (int i = F.tid; i < 128 * 32; i += 512) { const int pos = i >> 5, f = i & 31; const float fr = powf(10000.f, -(float)f / 32.f); const float a = (float)pos * fr; float s, c; sincosf(a, &s, &c); t32[i * 2] = c; t32[i * 2 + 1] = s; }
        if (F.wid == 2) { float* bnd = (float*)(ws + WS_LAM) + 4;
            for (int e2 = 0; e2 < 2; ++e2) {
                float ga = 0.f, gb = 0.f, gc = 0.f, gd = 0.f, ge = 0.f, gf = 0.f;
                for (int i = F.lane; i < 192; i += 64) { ga = fmaxf(ga, fabsf(P.g_qn_a[e2 * 192 + i])); gb = fmaxf(gb, fabsf(P.g_kn_a[e2 * 192 + i])); }
                gc = fabsf(P.g_qn_b[e2 * 64 + F.lane]); gd = fabsf(P.g_kn_b[e2 * 64 + F.lane]);
                for (int i = F.lane; i < 128; i += 64) { ge = fmaxf(ge, fabsf(P.g_qn_c[e2 * 128 + i])); gf = fmaxf(gf, fabsf(P.g_kn_c[e2 * 128 + i])); }
                ga = wave_max(ga); gb = wave_max(gb); gc = wave_max(gc); gd = wave_max(gd); ge = wave_max(ge); gf = wave_max(gf);
                if (F.lane == 0) { bnd[(2 * e2) * 2 + 0] = 1.03f * 13.856406f * ga * gb;
                                   bnd[(2 * e2) * 2 + 1] = 1.03f * 8.f * gc * gd;
                                   bnd[(2 * e2 + 1) * 2 + 0] = 1.03f * 11.313708f * ge * gf;
                                   bnd[(2 * e2 + 1) * 2 + 1] = 0.f; } } }
        if (F.wid < 2) { const float* lv = P.lam_vec + F.wid * 256; const float d1 = wave_sum(lv[F.lane] * lv[64 + F.lane]), d2 = wave_sum(lv[128 + F.lane] * lv[192 + F.lane]);
            const float lam_init = 0.8f - 0.6f * expf(-0.3f * (float)(2 * F.wid));
            if (F.lane == 0) ((float*)(ws + WS_LAM))[F.wid] = expf(d1) - expf(d2) + lam_init; }
    }
    tconv(F, P.w_in_ab, (bf16_t*)(ws + WS_WINAB), nullptr, 2, DM, AB_IN, AB_INP);
    tconv(F, P.w_uq, (bf16_t*)(ws + WS_WUQ), P.g_cq, 2, 768, 1536, 1536);
    tconv(F, P.w_ukv, (bf16_t*)(ws + WS_WUKV), P.g_ckv, 2, 512, 2048, 2048);
    tconv(F, P.w_out_ab, (bf16_t*)(ws + WS_WOUTAB), nullptr, 2, DM, DM, DM);
    tconv(F, P.w_in_c, (bf16_t*)(ws + WS_WINC), nullptr, 2, DM, C_IN, C_IN);
    tconv(F, P.w_out_c, (bf16_t*)(ws + WS_WOUTC), nullptr, 2, DM, DM, DM);
    tconv(F, P.w_pq, (bf16_t*)(ws + WS_WPQ), nullptr, 4, DM, DM, DM);
    cvt_flat(F, P.sub_keys, (bf16_t*)(ws + WS_SUBK), (size_t)4 * 8 * 2 * 128 * 128 / 8);
    cvt_rows_fp6(F, P.expert_u, ws + WS_EU, (float*)(ws + WS_SU), 4 * NEXP);
    cvt_rows_fp6(F, P.expert_v, ws + WS_EV, (float*)(ws + WS_SV), 4 * NEXP);
}

__device__ __forceinline__ void norm_phase(const Ctx& F, CParams& P, int layer, int which  , int m_rows) {
    float* X = (float*)(F.ws + WS_X); bf16_t* H = (bf16_t*)(F.ws + WS_H);
    const float* mod = (const float*)(F.ws + WS_MOD) + (size_t)layer * 3 * 12288;
    const float* gn = (which ? P.g_norm2 : P.g_norm1) + (size_t)layer * DM;
    const bool from_in = (layer == 0 && which == 0);
    for (int t = F.vcu * 8 + F.wid; t < m_rows; t += F.G * 8) {
        const int vs = vsel_of_row(t);
        const float* src = from_in ? (t < TL ? P.x + (size_t)t * DM : P.ctx + (size_t)(t - TL) * DM) : X + (size_t)t * DM;
        const float* shf = mod + (size_t)vs * 12288 + (which ? 3 : 0) * DM; const float* scl = shf + DM;
        f32x4 v[8]; float ss = 0.f;
#pragma unroll
        for (int j = 0; j < 8; ++j) { v[j] = *(const f32x4*)(src + j * 256 + F.lane * 4); ss += v[j][0] * v[j][0] + v[j][1] * v[j][1] + v[j][2] * v[j][2] + v[j][3] * v[j][3]; }
        ss = wave_sum(ss);
        const float rstd = rsqrtf(ss * (1.f / DM) + EPS);
#pragma unroll
        for (int j = 0; j < 8; ++j) { const int c = j * 256 + F.lane * 4;
            if (from_in) *(f32x4*)(X + (size_t)t * DM + c) = v[j];
            const f32x4 g = *(const f32x4*)(gn + c), sc = *(const f32x4*)(scl + c), sh = *(const f32x4*)(shf + c);
            f32x4 y;
#pragma unroll
            for (int e = 0; e < 4; ++e) y[e] = (v[j][e] * rstd * g[e]) * (1.f + sc[e]) + sh[e];
            u32x2 w; w.x = cvt_pk_bf16(y[0], y[1]); w.y = cvt_pk_bf16(y[2], y[3]);
            *(u32x2*)(H + (size_t)t * DM + c) = w; }
    }
}

__device__ __forceinline__ float grp16_sum(float v) { v += swz_xor<8>(v); v += swz_xor<4>(v); v += swz_xor<2>(v); v += swz_xor<1>(v); return v; }
__device__ __forceinline__ void rope4(float (&x)[4], int q16, int row, int col, const float* t16) {
    const int seg = q16 >> 3, f0 = (q16 & 3) * 4, pos = seg ? col : row; const bool first = (q16 & 7) < 4;
    const f32x4 c0 = *(const f32x4*)(t16 + (pos * 16 + f0) * 2), c1 = *(const f32x4*)(t16 + (pos * 16 + f0) * 2 + 4);
    const float cs[4] = {c0[0], c0[2], c1[0], c1[2]}, sn[4] = {c0[1], c0[3], c1[1], c1[3]};
#pragma unroll
    for (int e = 0; e < 4; ++e) { const float p = swz_xor<4>(x[e]); x[e] = first ? x[e] * cs[e] - p * sn[e] : p * sn[e] + x[e] * cs[e]; }
}
__device__ __forceinline__ void rope8(float (&x)[8], int q16, int row, int col, const float* t32) {
    const int seg = q16 >> 3, f0 = (q16 & 3) * 8, pos = seg ? col : row; const bool first = (q16 & 7) < 4;
    const float* tp = t32 + (pos * 32 + f0) * 2;
#pragma unroll
    for (int q = 0; q < 4; ++q) { const f32x4 c = *(const f32x4*)(tp + q * 4);
#pragma unroll
        for (int s = 0; s < 2; ++s) { const int e = q * 2 + s; const float cs = c[s * 2], sn = c[s * 2 + 1]; const float p = swz_xor<4>(x[e]); x[e] = first ? x[e] * cs - p * sn : p * sn + x[e] * cs; } }
}
__device__ __forceinline__ void ld8bf(const bf16_t* p, float (&x)[8]) { const u32x4 w = *(const u32x4*)p;
#pragma unroll
    for (int q = 0; q < 4; ++q) { x[q * 2] = bf_lo(w[q]); x[q * 2 + 1] = bf_hi(w[q]); } }
__device__ __forceinline__ void ld4bf(const bf16_t* p, float (&x)[4]) { const u32x2 w = *(const u32x2*)p; x[0] = bf_lo(w.x); x[1] = bf_hi(w.x); x[2] = bf_lo(w.y); x[3] = bf_hi(w.y); }
__device__ __forceinline__ void st8bf(bf16_t* p, const float (&x)[8]) { u32x4 w; w.x = cvt_pk_bf16(x[0], x[1]); w.y = cvt_pk_bf16(x[2], x[3]); w.z = cvt_pk_bf16(x[4], x[5]); w.w = cvt_pk_bf16(x[6], x[7]); *(u32x4*)p = w; }
__device__ __forceinline__ void st4bf(bf16_t* p, const float (&x)[4]) { u32x2 w; w.x = cvt_pk_bf16(x[0], x[1]); w.y = cvt_pk_bf16(x[2], x[3]); *(u32x2*)p = w; }

__device__ __forceinline__ void qkv_even_phase(const Ctx& F, CParams& P, int e) {
    const bf16_t* P1 = (const bf16_t*)(F.ws + WS_P1); const bf16_t* QA = (const bf16_t*)(F.ws + WS_QA); const bf16_t* KV = (const bf16_t*)(F.ws + WS_KV);
    bf16_t* Qm = (bf16_t*)(F.ws + WS_Q1); bf16_t* Km = (bf16_t*)(F.ws + WS_K1); bf16_t* Vm = (bf16_t*)(F.ws + WS_V1);
    bf16_t* Qd = (bf16_t*)(F.ws + WS_Q2); bf16_t* Kd = (bf16_t*)(F.ws + WS_K2); bf16_t* Vd = (bf16_t*)(F.ws + WS_V2);
    const float* t16 = (const float*)(F.ws + WS_TAB16);
    const float* gqa = P.g_qn_a + e * 192; const float* gka = P.g_kn_a + e * 192; const float* gqb = P.g_qn_b + e * 64; const float* gkb = P.g_kn_b + e * 64;
    const int q16 = F.lane & 15, grp = F.lane >> 4;
    float gq_n[8], gq_r[4], gk_n[8], gk_r[4], gqd[4], gkd[4];
#pragma unroll
    for (int i = 0; i < 8; ++i) { gq_n[i] = gqa[q16 * 8 + i]; gk_n[i] = gka[q16 * 8 + i]; }
#pragma unroll
    for (int i = 0; i < 4; ++i) { gq_r[i] = gqa[128 + q16 * 4 + i]; gk_r[i] = gka[128 + q16 * 4 + i]; gqd[i] = gqb[q16 * 4 + i]; gkd[i] = gkb[q16 * 4 + i]; }
    for (int t = F.vcu * 8 + F.wid; t < TT; t += F.G * 8) {
        const bool latent = t < TL; const int s = t & (SEQ - 1), row = s >> 6, col = s & 63; const int kr = krow_of(t);
        const bf16_t* p1 = P1 + (size_t)t * AB_INP;
        float ss = 0.f;
#pragma unroll
        for (int j = 0; j < 3; ++j) { float x[4]; ld4bf(p1 + j * 256 + F.lane * 4, x); ss += x[0] * x[0] + x[1] * x[1] + x[2] * x[2] + x[3] * x[3]; }
        ss = wave_sum(ss); const float rstd_q = rsqrtf(ss * (1.f / 768.f) + EPS);
        float s2 = 0.f;
        { float x[8]; ld8bf(p1 + 768 + F.lane * 8, x);
#pragma unroll
          for (int i = 0; i < 8; ++i) s2 += x[i] * x[i]; }
        s2 = wave_sum(s2); const float rstd_kv = rsqrtf(s2 * (1.f / 512.f) + EPS);
        float kro[4]; ld4bf(p1 + 1280 + q16 * 4, kro);
#pragma unroll
        for (int ps = 0; ps < 2; ++ps) { const int h = ps * 4 + grp; const bf16_t* src = QA + (size_t)t * 1536 + h * 192;
            float xn[8], xr[4]; ld8bf(src + q16 * 8, xn); ld4bf(src + 128 + q16 * 4, xr);
            float sq = 0.f;
#pragma unroll
            for (int i = 0; i < 8; ++i) { xn[i] *= rstd_q; sq += xn[i] * xn[i]; }
#pragma unroll
            for (int i = 0; i < 4; ++i) { xr[i] *= rstd_q; sq += xr[i] * xr[i]; }
            sq = grp16_sum(sq); const float r = rsqrtf(sq * (1.f / 192.f) + EPS);
            const float rq = r * (0.07216878364870322f * LOG2E);
#pragma unroll
            for (int i = 0; i < 8; ++i) xn[i] *= rq * gq_n[i];
#pragma unroll
            for (int i = 0; i < 4; ++i) xr[i] *= rq * gq_r[i];
            if (latent) rope4(xr, q16, row, col, t16);
            bf16_t* dst = Qm + ((size_t)t * 8 + h) * 192; st8bf(dst + q16 * 8, xn); st4bf(dst + 128 + q16 * 4, xr); }
#pragma unroll
        for (int ps = 0; ps < 2; ++ps) { const int h = ps * 4 + grp; const bf16_t* src = KV + (size_t)t * 2048 + h * 256;
            float xn[8], xr[4], xv[8]; ld8bf(src + q16 * 8, xn); ld8bf(src + 128 + q16 * 8, xv);
            float sq = 0.f;
#pragma unroll
            for (int i = 0; i < 8; ++i) { xn[i] *= rstd_kv; xv[i] *= rstd_kv; sq += xn[i] * xn[i]; }
#pragma unroll
            for (int i = 0; i < 4; ++i) { xr[i] = kro[i]; sq += xr[i] * xr[i]; }
            sq = grp16_sum(sq); const float r = rsqrtf(sq * (1.f / 192.f) + EPS);
#pragma unroll
            for (int i = 0; i < 8; ++i) xn[i] *= r * gk_n[i];
#pragma unroll
            for (int i = 0; i < 4; ++i) xr[i] *= r * gk_r[i];
            if (latent) rope4(xr, q16, row, col, t16);
            bf16_t* dst = Km + ((size_t)kr * 8 + h) * 192; st8bf(dst + q16 * 8, xn); st4bf(dst + 128 + q16 * 4, xr);
            st8bf(Vm + ((size_t)kr * 8 + h) * 128 + q16 * 8, xv); }
#pragma unroll
        for (int ps = 0; ps < 4; ++ps) { const int hm = ps * 4 + grp;
            float x[4]; ld4bf(p1 + 1344 + hm * 64 + q16 * 4, x);
            float sq = grp16_sum(x[0] * x[0] + x[1] * x[1] + x[2] * x[2] + x[3] * x[3]); float r = rsqrtf(sq * (1.f / 64.f) + EPS);
#pragma unroll
            for (int i = 0; i < 4; ++i) x[i] *= r * (0.125f * LOG2E) * gqd[i];
            if (latent) rope4(x, q16, row, col, t16);
            st4bf(Qd + ((size_t)t * 16 + hm) * 64 + q16 * 4, x);
            ld4bf(p1 + 2368 + hm * 64 + q16 * 4, x);
            sq = grp16_sum(x[0] * x[0] + x[1] * x[1] + x[2] * x[2] + x[3] * x[3]); r = rsqrtf(sq * (1.f / 64.f) + EPS);
#pragma unroll
            for (int i = 0; i < 4; ++i) x[i] *= r * gkd[i];
            if (latent) rope4(x, q16, row, col, t16);
            st4bf(Kd + ((size_t)kr * 16 + hm) * 64 + q16 * 4, x); }
#pragma unroll
        for (int j = 0; j < 2; ++j) *(u32x4*)(Vd + (size_t)kr * 1024 + j * 512 + F.lane * 8) = *(const u32x4*)(p1 + 3392 + j * 512 + F.lane * 8);
    }
}
__device__ __forceinline__ void qkv_odd_phase(const Ctx& F, CParams& P, int e) {
    const bf16_t* P1 = (const bf16_t*)(F.ws + WS_P1);
    bf16_t* Qc = (bf16_t*)(F.ws + WS_Q1); bf16_t* Kc = (bf16_t*)(F.ws + WS_K1); bf16_t* Vc = (bf16_t*)(F.ws + WS_V1);
    const float* t32 = (const float*)(F.ws + WS_TAB32);
    const int q16 = F.lane & 15, grp = F.lane >> 4;
    float gq[8], gk[8];
#pragma unroll
    for (int i = 0; i < 8; ++i) { gq[i] = P.g_qn_c[e * 128 + q16 * 8 + i]; gk[i] = P.g_kn_c[e * 128 + q16 * 8 + i]; }
    for (int t = F.vcu * 8 + F.wid; t < TT; t += F.G * 8) {
        const bool latent = t < TL; const int s = t & (SEQ - 1), row = s >> 6, col = s & 63; const int kr = krow_of(t);
        const bf16_t* p1 = P1 + (size_t)t * C_IN;
#pragma unroll
        for (int ps = 0; ps < 5; ++ps) {
            const bool isq = ps < 4; const int h = isq ? ps * 4 + grp : grp;
            float x[8]; ld8bf(p1 + (isq ? 0 : 2048) + h * 128 + q16 * 8, x);
            float sq = 0.f;
#pragma unroll
            for (int i = 0; i < 8; ++i) sq += x[i] * x[i];
            sq = grp16_sum(sq); const float r = rsqrtf(sq * (1.f / 128.f) + EPS);
#pragma unroll
            for (int i = 0; i < 8; ++i) x[i] *= r * (isq ? gq[i] * (0.08838834764831845f * LOG2E) : gk[i]);
            if (latent) rope8(x, q16, row, col, t32);
            st8bf(isq ? Qc + ((size_t)t * 16 + h) * 128 + q16 * 8 : Kc + ((size_t)kr * 4 + h) * 128 + q16 * 8, x); }
        *(u32x4*)(Vc + (size_t)kr * 512 + F.lane * 8) = *(const u32x4*)(p1 + 2560 + F.lane * 8);
    }
}

template <int DQK, int SDEPTH, int ldo, int NH, int NKVH, int NVH>
__device__ __forceinline__ void attn_phase(const Ctx& F, const bf16_t* Qbuf, const bf16_t* Kbuf, const bf16_t* Vbuf, bf16_t* OF, int ocol0, bool with_ctx, const float bound  ) {
    const bool nomax = bound < 60.f;
    const float negMC = 0.f;
    constexpr int kv_div = NH / NKVH, v_div = NH / NVH;
    const int n_lat = NH * NB * 32, n_tot = n_lat + (with_ctx ? NH * NB : 0);
    constexpr int ldq = NH * DQK, ldk = NKVH * DQK, ldv = NVH * 128;
    for (int u = F.vcu; u < n_tot; u += F.G) {
        int b, h, qrow0, kstart, seq;
        if (u < n_lat) { const int bh = u >> 5, qb = u & 31; b = bh / NH; h = bh % NH; qrow0 = b * SEQ + qb * 256; kstart = b * KPB; seq = KPB; }
        else { const int bh = u - n_lat; b = bh / NH; h = bh % NH; qrow0 = TL + b * CTXL; kstart = b * KPB + SEQ; seq = CTXL; }
        const bf16_t* Qp = Qbuf + ((size_t)qrow0 * NH + h) * DQK;
        const bf16_t* Kp = Kbuf + ((size_t)kstart * NKVH + h / kv_div) * DQK;
        const bf16_t* Vp = Vbuf + ((size_t)kstart * NVH + h / v_div) * 128;
        bf16_t* Op = OF + (size_t)qrow0 * ldo + ocol0 + h * 128;
        if constexpr (SDEPTH == 0) att::attn_body_simple<DQK, (DQK == 192 ? MLA_QL : 0), ldq, ldk, ldv, ldo>(Qp, Kp, Vp, Op, seq, F.lds, F.wid);
        else { if (nomax) att::attn_body<DQK, SDEPTH, (DQK == 192 ? MLA_QL : (DQK == 128 ? GQA_QL : 0)), true, ldq, ldk, ldv, ldo>(Qp, Kp, Vp, Op, seq, F.lds, F.wid, negMC);
               else att::attn_body_simple<DQK, 0, ldq, ldk, ldv, ldo>(Qp, Kp, Vp, Op, seq, F.lds, F.wid); }
    }
}

__device__ __forceinline__ void merge_even_phase(const Ctx& F, CParams& P, int e, int layer, int m_rows) {
    const bf16_t* OD = (const bf16_t*)(F.ws + WS_OF); bf16_t* AO = (bf16_t*)(F.ws + WS_AO);
    const float lam = ((const float*)(F.ws + WS_LAM))[e];
    const float lam_init = 0.8f - 0.6f * expf(-0.3f * (float)layer);
    const int q16 = F.lane & 15, grp = F.lane >> 4;
    float gs[8];
#pragma unroll
    for (int i = 0; i < 8; ++i) gs[i] = P.g_sub_b[e * 128 + q16 * 8 + i] * (1.f - lam_init);
    for (int t = F.vcu * 8 + F.wid; t < m_rows; t += F.G * 8) {
        const bf16_t* od = OD + (size_t)t * DM; bf16_t* ao = AO + (size_t)t * DM + 1024;
#pragma unroll
        for (int ps = 0; ps < 2; ++ps) { const int h = ps * 4 + grp;
            float o0[8], o1[8], d[8]; ld8bf(od + (2 * h) * 128 + q16 * 8, o0); ld8bf(od + (2 * h + 1) * 128 + q16 * 8, o1);
            float sq = 0.f;
#pragma unroll
            for (int i = 0; i < 8; ++i) { d[i] = o0[i] - lam * o1[i]; sq += d[i] * d[i]; }
            sq = grp16_sum(sq); const float r = rsqrtf(sq * (1.f / 128.f) + EPS);
#pragma unroll
            for (int i = 0; i < 8; ++i) d[i] *= r * gs[i];
            st8bf(ao + h * 128 + q16 * 8, d); }
    }
}

__device__ __forceinline__ void wave_lds_fence() { asm volatile("s_waitcnt lgkmcnt(0)" ::: "memory"); __builtin_amdgcn_wave_barrier(); asm volatile("" ::: "memory"); }
__device__ __forceinline__ unsigned fkey(float f) { const unsigned b = __float_as_uint(f); return b ^ ((unsigned)((int)b >> 31) | 0x80000000u); }
__device__ __forceinline__ float funkey(unsigned k) { return __uint_as_float((k & 0x80000000u) ? (k ^ 0x80000000u) : ~k); }
__device__ __forceinline__ unsigned umed3(unsigned a, unsigned b, unsigned c) { unsigned r; asm("v_med3_u32 %0, %1, %2, %3" : "=v"(r) : "v"(a), "v"(b), "v"(c)); return r; }
__device__ __forceinline__ void kins16(unsigned (&L)[16], unsigned k) {
#pragma unroll
    for (int p = 15; p >= 1; --p) L[p] = umed3(L[p - 1], L[p], k);
    L[0] = L[0] > k ? L[0] : k;
}
__device__ __forceinline__ void scan_set(unsigned (&L)[16], const bf16_t* qbase  , const bf16_t* kbase  , float* buf, int lane) {
    const int r32 = lane & 31, hi = lane >> 5;
#pragma unroll
    for (int p = 0; p < 16; ++p) L[p] = 0u;
    bf16x8 a0[8], a1[8];
    { const bf16_t* ap = qbase + (size_t)r32 * DM + hi * 8;
#pragma unroll
      for (int ks = 0; ks < 8; ++ks) { a0[ks] = *(const bf16x8*)(ap + ks * 16); a1[ks] = *(const bf16x8*)(ap + (size_t)32 * DM + ks * 16); } }
#pragma unroll 1
    for (int kb = 0; kb < 4; ++kb) {
        f32x16 acc0 = {}, acc1 = {};
        { const bf16_t* bp = kbase + (size_t)(kb * 32 + r32) * 128 + hi * 8;
          bf16x8 b[8];
#pragma unroll
          for (int ks = 0; ks < 8; ++ks) b[ks] = *(const bf16x8*)(bp + ks * 16);
#pragma unroll
          for (int ks = 0; ks < 8; ++ks) { acc0 = __builtin_amdgcn_mfma_f32_32x32x16_bf16(a0[ks], b[ks], acc0, 0, 0, 0); acc1 = __builtin_amdgcn_mfma_f32_32x32x16_bf16(a1[ks], b[ks], acc1, 0, 0, 0); } }
        wave_lds_fence();
#pragma unroll
        for (int r = 0; r < 16; ++r) { const int rowi = att::crow(r, hi); buf[rowi * 33 + r32] = acc0[r]; buf[(32 + rowi) * 33 + r32] = acc1[r]; }
        wave_lds_fence();
        const unsigned tb = 127u - (unsigned)(kb * 32);
#pragma unroll 8
        for (int k = 0; k < 32; ++k) kins16(L, (fkey(buf[lane * 33 + k]) & ~127u) | (tb - (unsigned)k));
    }
}
__device__ __forceinline__ void peer_select_phase(const Ctx& F, int layer, int m_rows) {
    const bf16_t* PQ = (const bf16_t*)(F.ws + WS_PQ); const bf16_t* SK = (const bf16_t*)(F.ws + WS_SUBK) + (size_t)layer * 8 * 2 * 128 * 128;
    int* PIDX = (int*)(F.ws + WS_PIDX); float* PG = (float*)(F.ws + WS_PG);
    float* buf = (float*)F.lds + F.wid * (64 * 33);
    const int lane = F.lane;
    const int nunits = (m_rows / 64) * 8;
    for (int u = F.vcu * 8 + F.wid; u < nunits; u += F.G * 8) {
        const int tile = u >> 3, h = u & 7, t0 = tile * 64;
        unsigned Ka[16], Kb[16];
        scan_set(Ka, PQ + (size_t)t0 * DM + h * 256, SK + (size_t)(h * 2) * 128 * 128, buf, lane);
        scan_set(Kb, PQ + (size_t)t0 * DM + h * 256 + 128, SK + (size_t)(h * 2 + 1) * 128 * 128, buf, lane);
        wave_lds_fence();
        float la[16], lb[16];
#pragma unroll
        for (int p = 0; p < 16; ++p) { la[p] = funkey(Ka[p] & ~127u); lb[p] = funkey(Kb[p] & ~127u);
            buf[lane * 33 + p] = __int_as_float(127 - (int)(Ka[p] & 127u)); buf[lane * 33 + 16 + p] = __int_as_float(127 - (int)(Kb[p] & 127u)); }
        wave_lds_fence();
        unsigned Kc[16];
#pragma unroll
        for (int p = 0; p < 16; ++p) Kc[p] = 0u;
#pragma unroll
        for (int r1 = 0; r1 < 16; ++r1)
#pragma unroll
            for (int r2 = 0; r2 < 16; ++r2) if ((r1 + 1) * (r2 + 1) <= 16) kins16(Kc, (fkey(la[r1] + lb[r2]) & ~255u) | (unsigned)(255 - (16 * r1 + r2)));
        float bv[16], sm = 0.f; unsigned idx[16];
#pragma unroll
        for (int p = 0; p < 16; ++p) { const int code = 255 - (int)(Kc[p] & 255u); bv[p] = funkey(Kc[p] & ~255u);
            idx[p] = (unsigned)(__float_as_int(buf[lane * 33 + (code >> 4)]) * 128 + __float_as_int(buf[lane * 33 + 16 + (code & 15)])); }
        const float bmax = bv[0];
#pragma unroll
        for (int p = 0; p < 16; ++p) { bv[p] = __expf(bv[p] - bmax); sm += bv[p]; }
        const float inv = 1.f / sm;
        const size_t o = ((size_t)(t0 + lane) * 8 + h) * 16;
#pragma unroll
        for (int q = 0; q < 4; ++q) { *(f32x4*)(PG + o + q * 4) = (f32x4){bv[q * 4] * inv, bv[q * 4 + 1] * inv, bv[q * 4 + 2] * inv, bv[q * 4 + 3] * inv};
            *(u32x4*)(PIDX + o + q * 4) = (u32x4){idx[q * 4], idx[q * 4 + 1], idx[q * 4 + 2], idx[q * 4 + 3]}; }
    }
}

__device__ __forceinline__ float gelu_tanh(float a) { const float u = 0.7978845608028654f * (a + 0.044715f * a * a * a); const float t = 1.f - 2.f / (1.f + __expf(2.f * u)); return 0.5f * a * (1.f + t); }
struct Row6 { u32x2 r[3]; };
__device__ __forceinline__ void ld_row6(Row6& R, const unsigned char* tab, int e, int lane) {
    const u32x2* rp = (const u32x2*)(tab + (size_t)e * EROW + (unsigned)lane * 24u);
    R.r[0] = rp[0]; R.r[1] = rp[1]; R.r[2] = rp[2];
}
__device__ __forceinline__ v32f dq_row6(const Row6& R, float dep) { unsigned r0 = R.r[0].x; asm volatile("" : "+v"(r0) : "v"(dep));
    const v6u w = {r0, R.r[0].y, R.r[1].x, R.r[1].y, R.r[2].x, R.r[2].y}; return __builtin_amdgcn_cvt_scalef32_pk32_f32_fp6(w, 1.0f); }
__device__ __forceinline__ float dot_row6(const Row6& R, const float (&h)[32], float& chain) {
    const v32f f = dq_row6(R, chain);
    float s0 = 0.f, s1 = 0.f, s2 = 0.f, s3 = 0.f;
#pragma unroll
    for (int i = 0; i < 8; ++i) { s0 = fmaf(f[i * 4 + 0], h[i * 4 + 0], s0); s1 = fmaf(f[i * 4 + 1], h[i * 4 + 1], s1); s2 = fmaf(f[i * 4 + 2], h[i * 4 + 2], s2); s3 = fmaf(f[i * 4 + 3], h[i * 4 + 3], s3); }
    const float s = (s0 + s1) + (s2 + s3);
    chain = s;
    return s;
}
__device__ __forceinline__ void fma_row6(float (&out)[32], const Row6& R, float w) {
    const v32f f = dq_row6(R, out[0]);
#pragma unroll
    for (int i = 0; i < 32; ++i) out[i] = fmaf(w, f[i], out[i]);
}
__device__ __forceinline__ float reduce4(float s0, float s1, float s2, float s3, int lane) {
    const bool hi = (lane & 32) != 0, b4 = (lane & 16) != 0;
    const float r0 = xor32_partner(hi ? s0 : s2, lane), r1 = xor32_partner(hi ? s1 : s3, lane);
    const float a0 = (hi ? s2 : s0) + r0, a1 = (hi ? s3 : s1) + r1;
    const float r = swz_xor<16>(b4 ? a0 : a1);
    float b = (b4 ? a1 : a0) + r;
    b += swz_xor<8>(b); b += swz_xor<4>(b); b += swz_xor<2>(b); b += swz_xor<1>(b);
    return b;
}
__device__ __forceinline__ float rl_f(float v, int l) { return __uint_as_float(__builtin_amdgcn_readlane(__float_as_uint(v), l)); }
__device__ __forceinline__ void wr_lane(float& dst, float val_uniform, int lane_uniform, int lane) { asm volatile("" : "+s"(lane_uniform)); dst = (lane == lane_uniform) ? val_uniform : dst; }
__device__ __forceinline__ void peer_expert_phase(const Ctx& F, CParams& P, int layer, int m_rows, bool last, bool dry) {
    const unsigned char* EU = F.ws + WS_EU + (size_t)layer * NEXP * EROW; const unsigned char* EV = F.ws + WS_EV + (size_t)layer * NEXP * EROW;
    const float* SU = (const float*)(F.ws + WS_SU) + (size_t)layer * NEXP; const float* SV = (const float*)(F.ws + WS_SV) + (size_t)layer * NEXP;
    const bf16_t* H = (const bf16_t*)(F.ws + WS_H); float* X = (float*)(F.ws + WS_X);
    const int* PIDX = (const int*)(F.ws + WS_PIDX); const float* PG = (const float*)(F.ws + WS_PG);
    const float* mod = (const float*)(F.ws + WS_MOD) + (size_t)layer * 3 * 12288;
    const int lane = F.lane;
    const int t0 = F.vcu * 8 + F.wid, tstride = F.G * 8;
    if (t0 >= m_rows) return;
    int id0 = PIDX[(size_t)t0 * 128 + lane], id1 = PIDX[(size_t)t0 * 128 + 64 + lane];
    u32x4 hp4[4]; float gk0, gk1;
    { const u32x4* hp = (const u32x4*)(H + (size_t)t0 * DM + (unsigned)lane * 32u);
#pragma unroll
      for (int j = 0; j < 4; ++j) hp4[j] = hp[j]; }
    gk0 = PG[(size_t)t0 * 128 + lane]; gk1 = PG[(size_t)t0 * 128 + 64 + lane];
    Row6 A[4], B[4];
#pragma unroll
    for (int q = 0; q < 4; ++q) ld_row6(A[q], EU, __builtin_amdgcn_readlane(id0, q), lane);
    for (int t = t0; t < m_rows; t += tstride) {
        const int tn = t + tstride; const int tq = tn < m_rows ? tn : t;
        float hf[32];
#pragma unroll
        for (int j = 0; j < 4; ++j)
#pragma unroll
            for (int q = 0; q < 4; ++q) { hf[j * 8 + q * 2] = bf_lo(hp4[j][q]); hf[j * 8 + q * 2 + 1] = bf_hi(hp4[j][q]); }
        const float cgk0 = gk0, cgk1 = gk1;
        const float su0 = SU[id0], sv0 = SV[id0], su1 = SU[id1], sv1 = SV[id1];
        const int nid0 = PIDX[(size_t)tq * 128 + lane], nid1 = PIDX[(size_t)tq * 128 + 64 + lane];
        { const u32x4* hp = (const u32x4*)(H + (size_t)tq * DM + (unsigned)lane * 32u);
#pragma unroll
          for (int j = 0; j < 4; ++j) hp4[j] = hp[j]; }
        gk0 = PG[(size_t)tq * 128 + lane]; gk1 = PG[(size_t)tq * 128 + 64 + lane];
        float wv0 = 0.f, wv1 = 0.f;
        float out[32];
#pragma unroll
        for (int i = 0; i < 32; ++i) out[i] = 0.f;
#pragma unroll
        for (int seg = 0; seg < 4; ++seg) {
            const int idc = (seg & 1) ? id1 : id0;
            const int idn = (seg == 0) ? id1 : (seg == 1 ? id0 : (seg == 2 ? id1 : nid0));
            const unsigned char* tabc = seg < 2 ? EU : EV; const unsigned char* tabn = (seg == 0 || seg == 3) ? EU : EV;
            const float wr = (seg & 1) ? wv1 : wv0;
            float acc = 0.f, chain = 0.f;
#pragma unroll 1
            for (int k = 0; k < 64; k += 8) {
#pragma unroll
                for (int q = 0; q < 4; ++q) ld_row6(B[q], tabc, __builtin_amdgcn_readlane(idc, k + 4 + q), lane);
                if (seg < 2) { const float d0 = dot_row6(A[0], hf, chain), d1 = dot_row6(A[1], hf, chain), d2 = dot_row6(A[2], hf, chain), d3 = dot_row6(A[3], hf, chain); const float b = reduce4(d0, d1, d2, d3, lane);
#pragma unroll
                    for (int q = 0; q < 4; ++q) wr_lane(acc, rl_f(b, 16 * q), k + q, lane); }
                else {
#pragma unroll
                    for (int q = 0; q < 4; ++q) fma_row6(out, A[q], rl_f(wr, k + q)); }
                { const bool nx = k + 8 >= 64;
#pragma unroll
                  for (int q = 0; q < 4; ++q) { const int ec = __builtin_amdgcn_readlane(idc, (k + 8 + q) & 63), en = __builtin_amdgcn_readlane(idn, q);
                      ld_row6(A[q], nx ? tabn : tabc, nx ? en : ec, lane); } }
                if (seg < 2) { const float d0 = dot_row6(B[0], hf, chain), d1 = dot_row6(B[1], hf, chain), d2 = dot_row6(B[2], hf, chain), d3 = dot_row6(B[3], hf, chain); const float b = reduce4(d0, d1, d2, d3, lane);
#pragma unroll
                    for (int q = 0; q < 4; ++q) wr_lane(acc, rl_f(b, 16 * q), k + 4 + q, lane); }
                else {
#pragma unroll
                    for (int q = 0; q < 4; ++q) fma_row6(out, B[q], rl_f(wr, k + 4 + q)); }
            }
            if (seg == 0) wv0 = cgk0 * gelu_tanh(acc * su0) * sv0;
            if (seg == 1) wv1 = cgk1 * gelu_tanh(acc * su1) * sv1;
        }
        id0 = nid0; id1 = nid1;
        const int vs = vsel_of_row(t);
        const float* gate = mod + (size_t)vs * 12288 + 5 * DM;
        float* xr = X + (size_t)t * DM; float* dst = dry ? (float*)(F.ws + WS_OF) + (size_t)t * DM : (last ? P.out + (size_t)t * DM : xr);
        float ssq = 0.f;
        const unsigned lo32 = (unsigned)lane * 32u;
#pragma unroll
        for (int q = 0; q < 8; ++q) { const unsigned c = lo32 + q * 4; const f32x4 xo = *(const f32x4*)(xr + c), g = *(const f32x4*)(gate + c);
            f32x4 y; y[0] = xo[0] + g[0] * out[q * 4 + 0]; y[1] = xo[1] + g[1] * out[q * 4 + 1]; y[2] = xo[2] + g[2] * out[q * 4 + 2]; y[3] = xo[3] + g[3] * out[q * 4 + 3];
            *(f32x4*)(dst + c) = y;
            out[q * 4 + 0] = y[0]; out[q * 4 + 1] = y[1]; out[q * 4 + 2] = y[2]; out[q * 4 + 3] = y[3];
            ssq += y[0] * y[0] + y[1] * y[1] + y[2] * y[2] + y[3] * y[3]; }
        if (!last && !dry) {
            const float rstd = rsqrtf(wave_sum(ssq) * (1.f / DM) + EPS);
            const float* gn = P.g_norm1 + (size_t)(layer + 1) * DM;
            const float* shf = mod + (size_t)3 * 12288 + (size_t)vs * 12288; const float* scl = shf + DM;
            bf16_t* hrow = (bf16_t*)(F.ws + WS_H) + (size_t)t * DM;
#pragma unroll
            for (int j = 0; j < 4; ++j) { u32x4 w;
#pragma unroll
                for (int q = 0; q < 2; ++q) { const unsigned c = lo32 + j * 8 + q * 4; const f32x4 g = *(const f32x4*)(gn + c), sc = *(const f32x4*)(scl + c), sh = *(const f32x4*)(shf + c);
                    float y[4];
#pragma unroll
                    for (int e2 = 0; e2 < 4; ++e2) y[e2] = (out[j * 8 + q * 4 + e2] * rstd * g[e2]) * (1.f + sc[e2]) + sh[e2];
                    w[q * 2] = cvt_pk_bf16(y[0], y[1]); w[q * 2 + 1] = cvt_pk_bf16(y[2], y[3]); }
                *(u32x4*)(hrow + lo32 + j * 8) = w; }
        }
    }
}

constexpr int N_PHASES = 1 + 2 * 11 + 2 * 9 - 3;
__global__ void __launch_bounds__(512, 2) mk_fwd(Params Pval) {
    extern __shared__ __attribute__((aligned(16))) unsigned char lds_raw[];
    LAS unsigned char* ldsl = (LAS unsigned char*)lds_raw;
    volatile LAS unsigned* misc = (volatile LAS unsigned*)(ldsl + LDS_MISC);
    if (threadIdx.x < 16) misc[threadIdx.x] = 0u;
    __syncthreads();
    XcdBarrier bar = xcd_barrier_post((unsigned*)(Pval.ws + WS_CTL) + 1024, misc);
    const int wid0 = __builtin_amdgcn_readfirstlane((int)threadIdx.x >> 6);
    const int lo = Pval.ph_lo, hi = Pval.ph_hi; int ph = 0;
#define MKCTX() Ctx F; { const int lane_ = fresh_lane(); int wid_ = wid0; asm volatile("" : "+s"(wid_)); const int tid_ = wid_ * 64 + lane_; F.tid = tid_; F.lane = lane_; F.wid = wid_; \
        int G_ = gridDim.x, bx_ = blockIdx.x; asm volatile("" : "+s"(G_), "+s"(bx_)); F.G = G_; F.vcu = (G_ % 8 == 0) ? (bx_ % 8) * (G_ / 8) + bx_ / 8 : bx_; F.bx = bx_; } \
        unsigned long long kp_ = (unsigned long long)__builtin_amdgcn_kernarg_segment_ptr(); asm volatile("" : "+s"(kp_)); CParams& P = *(CParams*)kp_; \
        F.ws = P.ws; F.lds = (char*)lds_raw; unsigned char* ws = F.ws; (void)ws; \
        bf16_t* Hb = (bf16_t*)(ws + WS_H); bf16_t* P1 = (bf16_t*)(ws + WS_P1); float* X = (float*)(ws + WS_X); const float* mod = (const float*)(ws + WS_MOD); (void)Hb; (void)P1; (void)X; (void)mod;
#define PHASE(cls, ...) do { if (ph >= lo && ph < hi) { if constexpr ((PH_MASK >> (cls)) & 1u) { \
        if constexpr ((PH_DOUBLE >> (cls)) & 1u) { const bool dry = true; (void)dry; MKCTX(); __VA_ARGS__; __syncthreads(); } \
        { const bool dry = false; (void)dry; MKCTX(); __VA_ARGS__; } } if (ph + 1 < hi) { int w0_ = wid0; asm volatile("" : "+s"(w0_)); xcd_barrier(bar, w0_ == 0 && fresh_lane() == 0); } } ++ph; } while (0)

    PHASE(0, prologue_phase(F, P));
#pragma unroll 1
    for (int layer = 0; layer < DEPTH; ++layer) {
        const int e = layer >> 1; const bool even = (layer & 1) == 0, lastl = layer == DEPTH - 1;
        const int m_post = lastl ? TL : TT;
        if (layer == 0) PHASE(1, norm_phase(F, P, layer, 0, TT));
        PHASE(2, { const bf16_t* W = even ? (const bf16_t*)(ws + WS_WINAB) + (size_t)e * AB_INP * DM : (const bf16_t*)(ws + WS_WINC) + (size_t)e * C_IN * DM;
                const int N = even ? AB_INP : C_IN;
                pg8::Gemm g{Hb, W, TT, N, DM, DM}; pg8::StaticOrder S; S.init(TT, N, F.G, F.bx);
                pg8::EpiBf16 E{P1, N};
                pg8::gemm_phase<pg8::EpiBf16, pg8::StaticOrder>(ldsl, g, S, E, F.wid); });
        if (even) {
            PHASE(3, { { pg8::Gemm g{P1, (const bf16_t*)(ws + WS_WUQ) + (size_t)e * 1536 * 768, TT, 1536, 768, AB_INP}; pg8::StaticOrder S; S.init(TT, 1536, F.G, F.bx);
                      pg8::EpiBf16 E{(bf16_t*)(ws + WS_QA), 1536};
                      pg8::gemm_phase<pg8::EpiBf16, pg8::StaticOrder>(ldsl, g, S, E, F.wid); }
                    { pg8::Gemm g{P1 + 768, (const bf16_t*)(ws + WS_WUKV) + (size_t)e * 2048 * 512, TT, 2048, 512, AB_INP}; pg8::StaticOrder S; S.init(TT, 2048, F.G, F.bx);
                      pg8::EpiBf16 E{(bf16_t*)(ws + WS_KV), 2048};
                      pg8::gemm_phase<pg8::EpiBf16, pg8::StaticOrder>(ldsl, g, S, E, F.wid); } });
            PHASE(4, qkv_even_phase(F, P, e));
            PHASE(5, { if constexpr (ATT_DBL & 1) attn_phase<192, MLA_SD, 2048, 8, 8, 8>(F, (const bf16_t*)(ws + WS_Q1), (const bf16_t*)(ws + WS_K1), (const bf16_t*)(ws + WS_V1), (bf16_t*)(ws + WS_AO), 0, !lastl, ((const float*)(ws + WS_LAM))[4 + layer * 2]);
                    if constexpr (ATT_DBL & 2) attn_phase<64, 2, 2048, 16, 16, 8>(F, (const bf16_t*)(ws + WS_Q2), (const bf16_t*)(ws + WS_K2), (const bf16_t*)(ws + WS_V2), (bf16_t*)(ws + WS_OF), 0, !lastl, ((const float*)(ws + WS_LAM))[4 + layer * 2 + 1]);
                    if constexpr (ATT_SEL & 1) attn_phase<192, MLA_SD, 2048, 8, 8, 8>(F, (const bf16_t*)(ws + WS_Q1), (const bf16_t*)(ws + WS_K1), (const bf16_t*)(ws + WS_V1), (bf16_t*)(ws + WS_AO), 0, !lastl, ((const float*)(ws + WS_LAM))[4 + layer * 2]);
                    if constexpr (ATT_SEL & 2) attn_phase<64, 2, 2048, 16, 16, 8>(F, (const bf16_t*)(ws + WS_Q2), (const bf16_t*)(ws + WS_K2), (const bf16_t*)(ws + WS_V2), (bf16_t*)(ws + WS_OF), 0, !lastl, ((const float*)(ws + WS_LAM))[4 + layer * 2 + 1]); });
            PHASE(6, merge_even_phase(F, P, e, layer, m_post));
        } else {
            PHASE(7, qkv_odd_phase(F, P, e));
            PHASE(8, attn_phase<128, GQA_SD, 2048, 16, 4, 4>(F, (const bf16_t*)(ws + WS_Q1), (const bf16_t*)(ws + WS_K1), (const bf16_t*)(ws + WS_V1), (bf16_t*)(ws + WS_AO), 0, !lastl, ((const float*)(ws + WS_LAM))[4 + layer * 2]));
        }
        PHASE(10, { const bf16_t* W = even ? (const bf16_t*)(ws + WS_WOUTAB) + (size_t)e * DM * DM : (const bf16_t*)(ws + WS_WOUTC) + (size_t)e * DM * DM;
                pg8::Gemm g{(const bf16_t*)(ws + WS_AO), W, m_post, DM, DM, DM}; pg8::StaticOrder S; S.init(m_post, DM, F.G, F.bx);
                pg8::EpiResid E{X, mod + (size_t)layer * 3 * 12288, 2};
                pg8::gemm_phase<pg8::EpiResid, pg8::StaticOrder>(ldsl, g, S, E, F.wid); });
        PHASE(1, norm_phase(F, P, layer, 1, m_post));
        PHASE(11, { pg8::Gemm g{Hb, (const bf16_t*)(ws + WS_WPQ) + (size_t)layer * DM * DM, m_post, DM, DM, DM}; pg8::StaticOrder S; S.init(m_post, DM, F.G, F.bx);
                pg8::EpiBf16 E{(bf16_t*)(ws + WS_PQ), DM};
                pg8::gemm_phase<pg8::EpiBf16, pg8::StaticOrder>(ldsl, g, S, E, F.wid); });
        PHASE(12, peer_select_phase(F, layer, m_post));
        PHASE(13, peer_expert_phase(F, P, layer, m_post, lastl, dry));
    }
#undef PHASE
}

extern "C" void kernel_launch(void* const* d_in, const int* in_sizes, int n_in, void* d_out, int out_size, void* d_ws, size_t ws_size, hipStream_t stream) {
    static int grid = 0;
    if (grid == 0) {
        if (n_in != 28 || ws_size < WS_END) { fprintf(stderr, "kernel_launch: expected 28 inputs and >= %zu bytes of workspace, got %d / %zu\n", (size_t)WS_END, n_in, ws_size); grid = -1; return; }
        int dev = 0, cus = 0, per_cu = 0;
        if (hipGetDevice(&dev) != hipSuccess || hipDeviceGetAttribute(&cus, hipDeviceAttributeMultiprocessorCount, dev) != hipSuccess) { grid = -1; return; }
        if (hipFuncSetAttribute((const void*)mk_fwd, hipFuncAttributeMaxDynamicSharedMemorySize, LDS_BYTES) != hipSuccess) { fprintf(stderr, "kernel_launch: hipFuncSetAttribute failed\n"); grid = -1; return; }
        if (hipOccupancyMaxActiveBlocksPerMultiprocessor(&per_cu, (const void*)mk_fwd, 512, LDS_BYTES) != hipSuccess || per_cu < 1) fprintf(stderr, "kernel_launch: occupancy query says %d\n", per_cu);
        (void)hipGetLastError();
        grid = cus;
    }
    if (grid < 0) return;
    (void)hipMemsetAsync((char*)d_ws + WS_CTL, 0, CTL_BYTES, stream);
    Params p{};
    const float** pf = (const float**)&p;
    for (int i = 0; i < 28; ++i) pf[i] = (const float*)d_in[i];
    p.out = (float*)d_out; p.ws = (unsigned char*)d_ws;
#if MK_PER_PHASE_LAUNCH
    for (int i = 0; i < N_PHASES; ++i) { p.ph_lo = i; p.ph_hi = i + 1; hipLaunchKernelGGL(mk_fwd, dim3(grid), dim3(512), LDS_BYTES, stream, p); }
#else
    p.ph_lo = 0; p.ph_hi = N_PHASES;
    hipLaunchKernelGGL(mk_fwd, dim3(grid), dim3(512), LDS_BYTES, stream, p);
#endif
    const hipError_t le = hipPeekAtLastError();
    if (le != hipSuccess) fprintf(stderr, "kernel_launch: launch failed: %s\n", hipGetErrorName(le));
}
```

```cpp
#include <hip/hip_runtime.h>
#include <stdint.h>
#include <stdio.h>

#ifndef MK_PER_PHASE_LAUNCH
#define MK_PER_PHASE_LAUNCH 0
#endif

#ifndef MLA_QL
#define MLA_QL 0
#endif
#ifndef GQA_QL
#define GQA_QL 0
#endif
#ifndef QKT_GRP
#define QKT_GRP 12
#endif
#ifndef EB
#define EB 4
#endif
#ifndef PV_PIPE
#define PV_PIPE 0
#endif
#ifndef ATT_DBL
#define ATT_DBL 0
#endif
#ifndef ATT_PRIO
#define ATT_PRIO 1
#endif
#ifndef MLA_SD
#define MLA_SD 1
#endif
#ifndef GQA_SD
#define GQA_SD 2
#endif
#ifndef ATT_SEL
#define ATT_SEL 3
#endif
#ifndef PH_DOUBLE
#define PH_DOUBLE 0u
#endif
#ifndef PH_MASK
#define PH_MASK 0xFFFFFFFFu
#endif
#define LAS __attribute__((address_space(3)))
typedef unsigned short bf16_t;
typedef short bf16x8 __attribute__((ext_vector_type(8)));
typedef short s16x4 __attribute__((ext_vector_type(4)));
typedef float f32x4 __attribute__((ext_vector_type(4)));
typedef float f32x2 __attribute__((ext_vector_type(2)));
typedef float f32x16 __attribute__((ext_vector_type(16)));
typedef unsigned u32x4 __attribute__((ext_vector_type(4)));
typedef unsigned u32x2 __attribute__((ext_vector_type(2)));
typedef __bf16 bf16x2_t __attribute__((ext_vector_type(2)));

constexpr int DM = 2048, NB = 2, SEQ = 8192, DEPTH = 4, CTXL = 256;
constexpr int TL = NB * SEQ;
constexpr int TZ = NB * CTXL;
constexpr int TT = TL + TZ;
constexpr int KPB = SEQ + CTXL;
constexpr int AB_IN = 4416, AB_INP = 4608;
constexpr int C_IN = 3072;
constexpr int NEXP = 16384;
constexpr float EPS = 1e-6f;
constexpr float LOG2E = 1.4426950408889634f;

constexpr size_t al256(size_t x) { return (x + 255) / 256 * 256; }
constexpr size_t WS_CTL = 0, CTL_BYTES = 1u << 20;
constexpr size_t WS_MOD = WS_CTL + CTL_BYTES;
constexpr size_t WS_TAB16 = WS_MOD + al256((size_t)4 * 3 * 12288 * 4);
constexpr size_t WS_TAB32 = WS_TAB16 + al256((size_t)128 * 16 * 2 * 4);
constexpr size_t WS_LAM = WS_TAB32 + al256((size_t)128 * 32 * 2 * 4);
constexpr size_t WS_WINAB = WS_LAM + 256;
constexpr size_t WS_WUQ = WS_WINAB + (size_t)2 * AB_INP * DM * 2;
constexpr size_t WS_WUKV = WS_WUQ + (size_t)2 * 1536 * 768 * 2;
constexpr size_t WS_WOUTAB = WS_WUKV + (size_t)2 * 2048 * 512 * 2;
constexpr size_t WS_WINC = WS_WOUTAB + (size_t)2 * DM * DM * 2;
constexpr size_t WS_WOUTC = WS_WINC + (size_t)2 * C_IN * DM * 2;
constexpr size_t WS_WPQ = WS_WOUTC + (size_t)2 * DM * DM * 2;
constexpr size_t WS_SUBK = WS_WPQ + (size_t)4 * DM * DM * 2;
constexpr size_t WS_EU = WS_SUBK + (size_t)4 * 8 * 2 * 128 * 128 * 2;
constexpr int EROW = DM * 6 / 8;
constexpr size_t WS_EV = WS_EU + (size_t)4 * NEXP * DM;
constexpr size_t WS_SU = WS_EV + (size_t)4 * NEXP * DM;
constexpr size_t WS_SV = WS_SU + (size_t)4 * NEXP * 4;
constexpr size_t WS_X = WS_SV + (size_t)4 * NEXP * 4;
constexpr size_t WS_H = WS_X + (size_t)TT * DM * 4;
constexpr size_t WS_P1 = WS_H + (size_t)TT * DM * 2;
constexpr size_t WS_QA = WS_P1 + (size_t)TT * AB_INP * 2;
constexpr size_t WS_KV = WS_QA + (size_t)TT * 1536 * 2;
constexpr size_t WS_Q1 = WS_KV + (size_t)TT * 2048 * 2;
constexpr size_t WS_K1 = WS_Q1 + (size_t)TT * 2048 * 2;
constexpr size_t WS_V1 = WS_K1 + (size_t)TT * 1536 * 2;
constexpr size_t WS_Q2 = WS_V1 + (size_t)TT * 1024 * 2;
constexpr size_t WS_K2 = WS_Q2 + (size_t)TT * 1024 * 2;
constexpr size_t WS_V2 = WS_K2 + (size_t)TT * 1024 * 2;
constexpr size_t WS_OF = WS_V2 + (size_t)TT * 1024 * 2;
constexpr size_t WS_AO = WS_OF + (size_t)TT * 3072 * 4;
constexpr size_t WS_PQ = WS_AO + (size_t)TT * DM * 2;
constexpr size_t WS_PIDX = WS_PQ + (size_t)TT * DM * 2;
constexpr size_t WS_PG = WS_PIDX + (size_t)TT * 128 * 4;
constexpr size_t WS_END = WS_PG + (size_t)TT * 128 * 4;

constexpr int LDS_MAIN = 157696;
constexpr int LDS_MISC = LDS_MAIN;
constexpr int LDS_BYTES = LDS_MAIN + 4096;

__device__ __forceinline__ unsigned cvt_pk_bf16(float lo, float hi) { unsigned r; asm("v_cvt_pk_bf16_f32 %0, %1, %2" : "=v"(r) : "v"(lo), "v"(hi)); return r; }
__device__ __forceinline__ float bf_lo(unsigned w) { return __uint_as_float(w << 16); }
__device__ __forceinline__ float bf_hi(unsigned w) { return __uint_as_float(w & 0xffff0000u); }
template <int M> __device__ __forceinline__ float swz_xor(float v) { return __int_as_float(__builtin_amdgcn_ds_swizzle(__float_as_int(v), (M << 10) | 0x1f)); }
__device__ __forceinline__ float xor32_partner(float v, int lane) {
    const auto rr = __builtin_amdgcn_permlane32_swap(__float_as_uint(v), __float_as_uint(v), false, false);
    return __uint_as_float(lane < 32 ? rr[1] : rr[0]);
}
__device__ __forceinline__ float hw_sum(float v) {
    v += swz_xor<16>(v); v += swz_xor<8>(v); v += swz_xor<4>(v); v += swz_xor<2>(v); v += swz_xor<1>(v);
    return v;
}
__device__ __forceinline__ float wave_sum(float v) {
    v = hw_sum(v);
    const auto rr = __builtin_amdgcn_permlane32_swap(__float_as_uint(v), __float_as_uint(v), false, false);
    return __uint_as_float(rr[0]) + __uint_as_float(rr[1]);
}
__device__ __forceinline__ float wave_max(float v) {
    v = fmaxf(v, swz_xor<16>(v)); v = fmaxf(v, swz_xor<8>(v)); v = fmaxf(v, swz_xor<4>(v)); v = fmaxf(v, swz_xor<2>(v)); v = fmaxf(v, swz_xor<1>(v));
    const auto rr = __builtin_amdgcn_permlane32_swap(__float_as_uint(v), __float_as_uint(v), false, false);
    return fmaxf(__uint_as_float(rr[0]), __uint_as_float(rr[1]));
}
__device__ __forceinline__ int mbcnt64(unsigned long long m) { return (int)__builtin_amdgcn_mbcnt_hi((unsigned)(m >> 32), __builtin_amdgcn_mbcnt_lo((unsigned)m, 0u)); }
__device__ __forceinline__ int fresh_lane() { int l; asm volatile("v_mbcnt_lo_u32_b32 %0, -1, 0\n\tv_mbcnt_hi_u32_b32 %0, -1, %0" : "=v"(l)); return l; }
__device__ __forceinline__ int krow_of(int t) { return t < TL ? (t >> 13) * KPB + (t & (SEQ - 1)) : ((t - TL) >> 8) * KPB + SEQ + ((t - TL) & (CTXL - 1)); }
__device__ __forceinline__ int vsel_of_row(int t) { return t < SEQ ? 0 : (t < TL ? 1 : 2); }

#define XB_TMO      128
#define XB_XCNT(j)  (256  + 64 * (j))
#define XB_XSUB(j)  (1280 + 64 * (j))
#define XB_XGEN(j)  (2304 + 64 * (j))
#define XB_TOP      3328
#define XB_TOPGEN   3392
#define XCD_BAR_WORDS 3456
#define XB_SPIN_CAP (1u << 27)
__device__ __forceinline__ unsigned xb_ld(unsigned* p)              { return __hip_atomic_load(p, __ATOMIC_RELAXED, __HIP_MEMORY_SCOPE_AGENT); }
__device__ __forceinline__ unsigned xb_add(unsigned* p, unsigned v) { return __hip_atomic_fetch_add(p, v, __ATOMIC_RELAXED, __HIP_MEMORY_SCOPE_AGENT); }
__device__ __forceinline__ unsigned xb_xcc_id() { return (unsigned)__builtin_amdgcn_s_getreg((3 << 11) | 20) & 0xFu; }
#define XB_SPIN(cond, bar) do { unsigned _sp = 0; while (cond) { __builtin_amdgcn_s_sleep(1); \
    if ((++_sp & 255u) == 0u) { if (xb_ld(&(bar)[XB_TMO])) break; if (_sp > XB_SPIN_CAP) { atomicAdd(&(bar)[XB_TMO], 1u); break; } } } } while (0)
struct XcdBarrier { unsigned* bar; unsigned x; volatile LAS unsigned* st; };
__device__ __forceinline__ XcdBarrier xcd_barrier_post(unsigned* bar, volatile LAS unsigned* st) {
    XcdBarrier b; b.bar = bar; b.x = xb_xcc_id(); b.st = st;
    if (threadIdx.x == 0) (void)xb_add(&bar[XB_XCNT(b.x)], 1u);
    return b;
}
__device__ __forceinline__ void xcd_barrier_complete(unsigned* bar, unsigned x, unsigned& nloc, unsigned& nx) {
    asm volatile("" : "+s"(x));
    const unsigned G = gridDim.x * gridDim.y * gridDim.z;
    unsigned sum, cnt, mine, sp = 0u;
    for (;;) {
        sum = 0u; cnt = 0u; mine = 0u;
#pragma unroll
        for (unsigned j = 0; j < 16; ++j) { const unsigned c = xb_ld(&bar[XB_XCNT(j)]); sum += c; cnt += (c > 0u) ? 1u : 0u; mine = (j == x) ? c : mine; }
        if (sum == G) break;
        __builtin_amdgcn_s_sleep(1);
        if ((++sp & 255u) == 0u) { if (xb_ld(&bar[XB_TMO])) break; if (sp > XB_SPIN_CAP) { atomicAdd(&bar[XB_TMO], 1u); break; } }
    }
    nloc = mine > 0u ? mine : 1u; nx = cnt > 0u ? cnt : 1u;
}
__device__ __forceinline__ void xcd_barrier(const XcdBarrier& b, const bool thread0  ) {
    asm volatile("s_waitcnt vmcnt(0)" ::: "memory");
    __syncthreads();
    if (thread0) {
        unsigned* bar = b.bar;
        __builtin_amdgcn_s_waitcnt(0);
        unsigned nloc = b.st[0], nx = b.st[1];
        if (nloc == 0u) { xcd_barrier_complete(bar, b.x, nloc, nx); b.st[0] = nloc; b.st[1] = nx; }
        const unsigned old = xb_add(&bar[XB_XSUB(b.x)], 1u);
        const unsigned gen = old / nloc;
        if (old + 1u == (gen + 1u) * nloc) {
            __builtin_amdgcn_fence(__ATOMIC_RELEASE, "agent");
            asm volatile("s_waitcnt vmcnt(0)" ::: "memory");
            const unsigned og = xb_add(&bar[XB_TOP], 1u);
            const unsigned tg = og / nx;
            if (og + 1u == (tg + 1u) * nx) xb_add(&bar[XB_TOPGEN], 1u);
            else XB_SPIN(xb_ld(&bar[XB_TOPGEN]) == tg, bar);
            __builtin_amdgcn_fence(__ATOMIC_ACQUIRE, "agent");
            xb_add(&bar[XB_XGEN(b.x)], 1u);
            asm volatile("s_waitcnt vmcnt(0)" ::: "memory");
        } else {
            XB_SPIN(xb_ld(&bar[XB_XGEN(b.x)]) == gen, bar);
            __builtin_amdgcn_fence(__ATOMIC_ACQUIRE, "agent");
            asm volatile("s_waitcnt vmcnt(0)" ::: "memory");
        }
    }
    __syncthreads();
}

namespace pg8 {
constexpr int BM = 256, BK = 64, HALF = 128, HTB = HALF * BK * 2, STAGE_BYTES = 8 * HTB, NXCD = 8, WGM = 8;
__host__ __device__ __forceinline__ int lds_byte(int r, int c) { const int st = (r >> 4) * 2 + (c >> 5), rr = r & 15, cc = c & 31, ob = rr * 64 + cc * 2; return st * 1024 + (ob ^ (((ob >> 9) & 1) << 5)); }
__host__ __device__ __forceinline__ void stage_rc(int b, int& R, int& C) { const int st = b / 1024, sb = b % 1024, swz = sb ^ (((sb >> 9) & 1) << 5); R = (st >> 1) * 16 + swz / 64; C = (st & 1) * 32 + (swz % 64) / 2; }
__host__ __device__ __forceinline__ int perm32(int rho) { const int n = rho >> 4, i = rho & 15; return 8 * (i >> 2) + 4 * n + (i & 3); }
struct Unit { int pm, pn; };
struct Gemm { const bf16_t* A; const bf16_t* Bt; int M, N, K, lda; };
struct StaticOrder {
    int nM, nN, nwg, G, c;
    __host__ __device__ void init(int M, int N, int G_, int c_) { nM = M / BM; nN = N / BM; nwg = nM * nN; G = G_; c = c_; }
    __host__ __device__ bool next(int i, Unit& u) const {
        const long L = (long)i * G + c; if (L >= nwg) return false;
        int wgid = (int)L; { const int q = nwg / NXCD, r = nwg % NXCD, xcd = wgid % NXCD, off = wgid / NXCD; wgid = (xcd < r ? xcd * (q + 1) : r * (q + 1) + (xcd - r) * q) + off; }
        const int nig = WGM * nN, gid = wgid / nig, fm = gid * WGM, gsz = (nM - fm) < WGM ? (nM - fm) : WGM;
        u.pm = fm + ((wgid % nig) % gsz); u.pn = (wgid % nig) / gsz; return true;
    }
    __device__ __forceinline__ void a_ready(const Unit&) const {}
    __device__ __forceinline__ void done(const Unit&) const {}
};
struct OneUnit {
    int pm, pn;
    __device__ bool next(int i, Unit& u) const { if (i != 0) return false; u.pm = pm; u.pn = pn; return true; }
    __device__ __forceinline__ void a_ready(const Unit&) const {}
    __device__ __forceinline__ void done(const Unit&) const {}
};
struct EpiBf16 {
    static constexpr bool PERM = true;
    bf16_t* O; int ldc;
    __device__ __forceinline__ void operator()(const f32x4 (&acc)[2][2][4][2], const Unit& u, int wr, int wc, int fr, int fq) const {
        const int row0 = u.pm * BM + wr * 64 + fr; const int col0 = u.pn * BM + wc * 32 + 8 * fq;
#pragma unroll
        for (int ai = 0; ai < 2; ++ai)
#pragma unroll
            for (int m = 0; m < 4; ++m) { bf16_t* rowp = O + (size_t)(row0 + ai * HALF + m * 16) * ldc + col0;
#pragma unroll
                for (int bj = 0; bj < 2; ++bj) { const f32x4 v0 = acc[ai][bj][m][0], v1 = acc[ai][bj][m][1];
                    u32x4 w; w.x = cvt_pk_bf16(v0[0], v0[1]); w.y = cvt_pk_bf16(v0[2], v0[3]); w.z = cvt_pk_bf16(v1[0], v1[1]); w.w = cvt_pk_bf16(v1[2], v1[3]);
                    *(u32x4*)(rowp + bj * HALF) = w; } }
    }
};
struct EpiBf16V {
    static constexpr bool PERM = true;
    bf16_t* O; int ldc; bf16_t* V; int vpn0, vld;
    __device__ __forceinline__ void operator()(const f32x4 (&acc)[2][2][4][2], const Unit& u, int wr, int wc, int fr, int fq) const {
        const int row0 = u.pm * BM + wr * 64 + fr; const int col0 = u.pn * BM + wc * 32 + 8 * fq;
        const bool tov = u.pn >= vpn0;
        const long delta = u.pm < 32 ? 0 : (u.pm < 64 ? KPB - SEQ : (u.pm == 64 ? SEQ - TL : KPB + SEQ - TL - CTXL));
        bf16_t* base = tov ? V + delta * vld - (long)vpn0 * BM : O; const int ld = tov ? vld : ldc;
#pragma unroll
        for (int ai = 0; ai < 2; ++ai)
#pragma unroll
            for (int m = 0; m < 4; ++m) { bf16_t* rowp = base + (size_t)(row0 + ai * HALF + m * 16) * ld + col0;
#pragma unroll
                for (int bj = 0; bj < 2; ++bj) { const f32x4 v0 = acc[ai][bj][m][0], v1 = acc[ai][bj][m][1];
                    u32x4 w; w.x = cvt_pk_bf16(v0[0], v0[1]); w.y = cvt_pk_bf16(v0[2], v0[3]); w.z = cvt_pk_bf16(v1[0], v1[1]); w.w = cvt_pk_bf16(v1[2], v1[3]);
                    *(u32x4*)(rowp + bj * HALF) = w; } }
    }
};
struct EpiResid {
    static constexpr bool PERM = false;
    float* X; const float* modl; int chunk;
    const float* Rlat; const float* Rctx;
    __device__ __forceinline__ void operator()(const f32x4 (&acc)[2][2][4][2], const Unit& u, int wr, int wc, int fr, int fq) const {
        const int row0 = u.pm * BM + wr * 64 + fr, col0 = u.pn * BM + wc * 32 + 4 * fq;
        const int vs = u.pm < 32 ? 0 : (u.pm < 64 ? 1 : 2);
        const float* gate = modl + (size_t)vs * 12288 + chunk * 2048 + col0;
        f32x4 gv[2][2];
#pragma unroll
        for (int bj = 0; bj < 2; ++bj)
#pragma unroll
            for (int n = 0; n < 2; ++n) gv[bj][n] = *(const f32x4*)(gate + bj * HALF + n * 16);
#pragma unroll
        for (int ai = 0; ai < 2; ++ai) {
            f32x4 xo[4][2][2];
#pragma unroll
            for (int m = 0; m < 4; ++m) { const int row = row0 + ai * HALF + m * 16;
                const float* srcp = (vs < 2 ? Rlat + (size_t)row * DM : Rctx + (size_t)(row - TL) * DM) + col0;
#pragma unroll
                for (int bj = 0; bj < 2; ++bj)
#pragma unroll
                    for (int n = 0; n < 2; ++n) xo[m][bj][n] = *(const f32x4*)(srcp + bj * HALF + n * 16); }
#pragma unroll
            for (int m = 0; m < 4; ++m) { const int row = row0 + ai * HALF + m * 16; float* rowp = X + (size_t)row * DM + col0;
#pragma unroll
                for (int bj = 0; bj < 2; ++bj)
#pragma unroll
                    for (int n = 0; n < 2; ++n) *(f32x4*)(rowp + bj * HALF + n * 16) = xo[m][bj][n] + gv[bj][n] * acc[ai][bj][m][n]; } }
    }
};

template <class Epi, class Sched>
__device__ __forceinline__ void gemm_phase(LAS unsigned char* lds, const Gemm g, const Sched& S, const Epi& E, int tid_in) {
    const int tid_l = tid_in * 64 + fresh_lane();
    const int tid = tid_l, wid = tid_in  , lane = tid & 63, wr = wid >> 2, wc = wid & 3, fr = lane & 15, fq = lane >> 4;
    const int K = g.K, nt = K / BK, lda = g.lda;
    unsigned voffA[2], voffB[2];
#pragma unroll
    for (int i = 0; i < 2; ++i) { int R, C; stage_rc(tid * 16 + i * 8192, R, C); const int Rb = Epi::PERM ? ((R & ~31) + perm32(R & 31)) : R;
        voffA[i] = (unsigned)(R * lda + C) * 2u; voffB[i] = (unsigned)(Rb * K + C) * 2u; }
    const size_t kstep = (size_t)(BK * 2);
    const size_t hstepA = (size_t)HALF * lda * 2, hstepB = (size_t)HALF * K * 2;
    const size_t tstepA = 2 * hstepA, tstepB = 2 * hstepB;
    const unsigned ldsw = (unsigned)wid * 1024u;
    const int aoff = lds_byte(wr * 64 + fr, fq * 8), boff = lds_byte(wc * 32 + fr, fq * 8);
#define PG8_SA(b, h) (((b) * 2 + (h)) * HTB)
#define PG8_SB(b, h) ((4 + (b) * 2 + (h)) * HTB)
#define PG8_STAGE(bufoff, gbase, voff) do { _Pragma("unroll") for (int _i = 0; _i < 2; ++_i) \
        __builtin_amdgcn_global_load_lds((const unsigned*)((const char*)(gbase) + (voff)[_i]), (LAS unsigned*)(lds + (bufoff) + ldsw + _i * 8192), 16, 0, 0); } while (0)
#define PG8_LDA(dst, b, h) do { _Pragma("unroll") for (int m = 0; m < 4; ++m) _Pragma("unroll") for (int k = 0; k < 2; ++k) dst[m][k] = *(const LAS bf16x8*)(lds + PG8_SA(b, h) + aoff + m * 2048 + k * 1024); } while (0)
#define PG8_LDB(dst, b, h) do { _Pragma("unroll") for (int n = 0; n < 2; ++n) _Pragma("unroll") for (int k = 0; k < 2; ++k) dst[n][k] = *(const LAS bf16x8*)(lds + PG8_SB(b, h) + boff + n * 2048 + k * 1024); } while (0)
#define PG8_MMA(ai, bj, At, Bt) do { __builtin_amdgcn_s_setprio(1); _Pragma("unroll") for (int m = 0; m < 4; ++m) _Pragma("unroll") for (int n = 0; n < 2; ++n) _Pragma("unroll") for (int k = 0; k < 2; ++k) \
        acc[ai][bj][m][n] = __builtin_amdgcn_mfma_f32_16x16x32_bf16(Bt[n][k], At[m][k], acc[ai][bj][m][n], 0, 0, 0); __builtin_amdgcn_s_setprio(0); } while (0)
#define PG8_WAIT_V(n) asm volatile("s_waitcnt vmcnt(" #n ")" ::: "memory")
#define PG8_WAIT_L(n) asm volatile("s_waitcnt lgkmcnt(" #n ")" ::: "memory")
#define PG8_BAR __builtin_amdgcn_s_barrier()
#define PG8_SCHED __builtin_amdgcn_sched_barrier(0)
    Unit cur, nxt; int ui = 0;
    if (!S.next(0, cur)) return;
    f32x4 acc[2][2][4][2];
#pragma unroll
    for (int a = 0; a < 2; ++a)
#pragma unroll
        for (int b = 0; b < 2; ++b)
#pragma unroll
            for (int m = 0; m < 4; ++m)
#pragma unroll
                for (int n = 0; n < 2; ++n) acc[a][b][m][n] = (f32x4){0.f, 0.f, 0.f, 0.f};
    bf16x8 At[4][2], B0[2][2], B1[2][2];
    const char* cA = (const char*)g.A + (size_t)cur.pm * tstepA; const char* cB = (const char*)g.Bt + (size_t)cur.pn * tstepB;
    S.a_ready(cur);
    PG8_STAGE(PG8_SB(0, 0), cB, voffB); PG8_STAGE(PG8_SA(0, 0), cA, voffA); PG8_STAGE(PG8_SB(0, 1), cB + hstepB, voffB); PG8_STAGE(PG8_SA(0, 1), cA + hstepA, voffA);
    if (wr == 1) PG8_BAR;
    PG8_WAIT_V(4); PG8_BAR;
    PG8_STAGE(PG8_SB(1, 0), cB + kstep, voffB); PG8_STAGE(PG8_SA(1, 0), cA + kstep, voffA); PG8_STAGE(PG8_SB(1, 1), cB + hstepB + kstep, voffB);
    PG8_WAIT_V(6); PG8_BAR;
    for (;;) {
        const bool has_next = S.next(ui + 1, nxt);
        const char* nA = has_next ? (const char*)g.A + (size_t)nxt.pm * tstepA : cA; const char* nB = has_next ? (const char*)g.Bt + (size_t)nxt.pn * tstepB : cB;
        for (int t = 0; t < nt; t += 2) {
            const bool last = (t == nt - 2);
            const char* a1 = cA + (size_t)(t + 1) * kstep;
            const char* a2 = last ? nA : cA + (size_t)(t + 2) * kstep; const char* b2 = last ? nB : cB + (size_t)(t + 2) * kstep;
            const char* a3 = a2 + kstep; const char* b3 = b2 + kstep;
            if (last && has_next) S.a_ready(nxt);
            PG8_LDB(B0, 0, 0); PG8_SCHED; PG8_LDA(At, 0, 0); PG8_STAGE(PG8_SA(1, 1), a1 + hstepA, voffA);
            PG8_WAIT_L(8); PG8_BAR; PG8_WAIT_L(0); PG8_MMA(0, 0, At, B0); PG8_BAR; PG8_SCHED;
            PG8_LDB(B1, 0, 1); PG8_STAGE(PG8_SB(0, 0), b2, voffB);
            PG8_BAR; PG8_WAIT_L(0); PG8_MMA(0, 1, At, B1); PG8_BAR;
            PG8_LDA(At, 0, 1); PG8_STAGE(PG8_SA(0, 0), a2, voffA);
            PG8_BAR; PG8_WAIT_L(0); PG8_MMA(1, 0, At, B0); PG8_BAR; PG8_SCHED;
            PG8_STAGE(PG8_SB(0, 1), b2 + hstepB, voffB);
            PG8_WAIT_V(6); PG8_BAR; PG8_MMA(1, 1, At, B1); PG8_BAR;
            PG8_LDB(B0, 1, 0); PG8_SCHED; PG8_LDA(At, 1, 0); PG8_STAGE(PG8_SA(0, 1), a2 + hstepA, voffA);
            PG8_WAIT_L(8); PG8_BAR; PG8_WAIT_L(0); PG8_MMA(0, 0, At, B0); PG8_BAR; PG8_SCHED;
            PG8_LDB(B1, 1, 1); PG8_STAGE(PG8_SB(1, 0), b3, voffB);
            PG8_BAR; PG8_WAIT_L(0); PG8_MMA(0, 1, At, B1); PG8_BAR;
            PG8_LDA(At, 1, 1); PG8_STAGE(PG8_SA(1, 0), a3, voffA);
            PG8_BAR; PG8_WAIT_L(0); PG8_MMA(1, 0, At, B0); PG8_BAR; PG8_SCHED;
            PG8_STAGE(PG8_SB(1, 1), b3 + hstepB, voffB);
            PG8_WAIT_V(6); PG8_BAR; PG8_MMA(1, 1, At, B1); PG8_BAR;
        }
        E(acc, cur, wr, wc, fr, fq); S.done(cur);
        if (!has_next) break;
#pragma unroll
        for (int a = 0; a < 2; ++a)
#pragma unroll
            for (int b = 0; b < 2; ++b)
#pragma unroll
                for (int m = 0; m < 4; ++m)
#pragma unroll
                    for (int n = 0; n < 2; ++n) acc[a][b][m][n] = (f32x4){0.f, 0.f, 0.f, 0.f};
        cur = nxt; cA = nA; cB = nB; ++ui;
    }
    PG8_WAIT_V(0);
    if (wr == 0) PG8_BAR;
    PG8_BAR;
#undef PG8_SA
#undef PG8_SB
#undef PG8_STAGE
#undef PG8_LDA
#undef PG8_LDB
#undef PG8_MMA
#undef PG8_WAIT_V
#undef PG8_WAIT_L
#undef PG8_BAR
#undef PG8_SCHED
}
}

namespace att {
constexpr int NW = 8, QBLK = 32, KVBLK = 64, DV = 128;
constexpr float THR = 8.f;
constexpr int SHM_V = KVBLK * DV * 2;
#define SBAR() __builtin_amdgcn_sched_barrier(0)
__device__ __forceinline__ int crow(int r, int hi) { return (r & 3) + 8 * (r >> 2) + 4 * hi; }
__device__ __forceinline__ unsigned cvtpk(float lo, float hi) { unsigned r; asm volatile("v_cvt_pk_bf16_f32 %0, %1, %2" : "=v"(r) : "v"(lo), "v"(hi)); return r; }
__device__ __forceinline__ void partialSM(f32x16& p0, f32x16& p1, float& m_reg, float& mn, float& alpha, const float C, const float thr_raw) {
    float pmax = p0[0];
#pragma unroll
    for (int r = 1; r < 16; ++r) pmax = fmaxf(pmax, p0[r]);
#pragma unroll
    for (int r = 0; r < 16; ++r) pmax = fmaxf(pmax, p1[r]);
    { auto rr = __builtin_amdgcn_permlane32_swap(__float_as_uint(pmax), __float_as_uint(pmax), false, false);
      pmax = fmaxf(__uint_as_float(rr[0]), __uint_as_float(rr[1])); }
    if (__builtin_expect(__all(pmax - m_reg <= thr_raw), 1)) { mn = m_reg; alpha = 1.f; }
    else { mn = fmaxf(m_reg, pmax); alpha = __builtin_amdgcn_exp2f((m_reg - mn) * C); m_reg = mn; }
    const float mnC = -mn * C;
#pragma unroll
    for (int r = 0; r < 16; ++r) p0[r] = fmaf(p0[r], C, mnC);
#pragma unroll
    for (int r = 0; r < 16; ++r) p1[r] = fmaf(p1[r], C, mnC);
#pragma unroll
    for (int r = 0; r < 16; ++r) p0[r] = __builtin_amdgcn_exp2f(p0[r]);
}
__device__ __forceinline__ void finishSM(f32x16& p0, f32x16& p1, float alpha, float& l_reg, bf16x8& pa0, bf16x8& pa1, bf16x8& pa2, bf16x8& pa3) {
#pragma unroll
    for (int r = 0; r < 16; ++r) p1[r] = __builtin_amdgcn_exp2f(p1[r]);
    float ps = 0;
#pragma unroll
    for (int r = 0; r < 16; ++r) ps += p0[r];
#pragma unroll
    for (int r = 0; r < 16; ++r) ps += p1[r];
    { auto rr = __builtin_amdgcn_permlane32_swap(__float_as_uint(ps), __float_as_uint(ps), false, false);
      ps = __uint_as_float(rr[0]) + __uint_as_float(rr[1]); }
    l_reg = l_reg * alpha + ps;
#define PK4(P, BASE, OUT) do { unsigned a0 = cvtpk(P[BASE + 0], P[BASE + 1]), a1 = cvtpk(P[BASE + 2], P[BASE + 3]);   \
    unsigned b0 = cvtpk(P[BASE + 4], P[BASE + 5]), b1 = cvtpk(P[BASE + 6], P[BASE + 7]);                              \
    auto r0 = __builtin_amdgcn_permlane32_swap(a0, b0, false, false); auto r1 = __builtin_amdgcn_permlane32_swap(a1, b1, false, false); \
    u32x4 w = {r0[0], r1[0], r0[1], r1[1]}; OUT = *reinterpret_cast<bf16x8*>(&w); } while (0)
    PK4(p0, 0, pa0); PK4(p0, 8, pa1); PK4(p1, 0, pa2); PK4(p1, 8, pa3);
#undef PK4
}
__device__ __forceinline__ void partialSM_nm(f32x16& p0) {
#pragma unroll
    for (int r = 0; r < 16; ++r) p0[r] = __builtin_amdgcn_exp2f(p0[r]);
}
template <int DQK, int QL>
__device__ __forceinline__ void qkt(f32x16& p0, f32x16& p1, const char* Ks, const bf16x8 (&qr)[DQK / 16 - QL], const char* qpark, int r32, int hi) {
    constexpr int RS = DQK * 2 + 16, NQR = DQK / 16 - QL, GRP = (DQK > 128) ? QKT_GRP : DQK / 16;
    p0 = f32x16{}; p1 = f32x16{};
#pragma unroll
    for (int g0 = 0; g0 < DQK / 16; g0 += GRP) {
#pragma unroll
        for (int d0 = g0; d0 < g0 + GRP; ++d0) { const int cb = (d0 * 16 + hi * 8) * 2;
            const bf16x8 b0 = *reinterpret_cast<const bf16x8*>(Ks + r32 * RS + cb);
            const bf16x8 b1 = *reinterpret_cast<const bf16x8*>(Ks + (32 + r32) * RS + cb);
            bf16x8 qf; if (d0 < NQR) qf = qr[d0 < NQR ? d0 : 0]; else qf = *reinterpret_cast<const bf16x8*>(qpark + (d0 - NQR) * 1024);
            p0 = __builtin_amdgcn_mfma_f32_32x32x16_bf16(b0, qf, p0, 0, 0, 0);
            p1 = __builtin_amdgcn_mfma_f32_32x32x16_bf16(b1, qf, p1, 0, 0, 0); }
        if (g0 + GRP < DQK / 16) SBAR();
    }
}
__device__ __forceinline__ int v_st(int k, int c) { const int kk = (k & ~0xC) | ((k & 4) << 1) | ((k & 8) >> 1); return ((kk >> 3) * 4 + (c >> 5)) * 512 + ((kk & 7) * 32 + (c & 31)) * 2; }
__device__ __forceinline__ int v_rd_base(int lane) { return ((lane & 3) << 3) | (((lane >> 2) & 3) << 6) | (((lane >> 4) & 1) << 5) | (((lane >> 5) & 1) << 8); }
constexpr int v_rd_off(int d0, int ks, int half) { return d0 * 512 + ks * 4096 + half * 2048; }
template <int OFF> __device__ __forceinline__ s16x4 tr_read(int vb) {
    s16x4 r; asm volatile("ds_read_b64_tr_b16 %0, %1 offset:%2" : "=&v"(r) : "v"(vb), "i"(OFF) : "memory"); return r;
}
template <int D0> __device__ __forceinline__ void pv_one(f32x16& od, int vb, bf16x8 pa0, bf16x8 pa1, bf16x8 pa2, bf16x8 pa3) {
    const s16x4 l0 = tr_read<v_rd_off(D0, 0, 0)>(vb), h0 = tr_read<v_rd_off(D0, 0, 1)>(vb), l1 = tr_read<v_rd_off(D0, 1, 0)>(vb), h1 = tr_read<v_rd_off(D0, 1, 1)>(vb);
    const s16x4 l2 = tr_read<v_rd_off(D0, 2, 0)>(vb), h2 = tr_read<v_rd_off(D0, 2, 1)>(vb), l3 = tr_read<v_rd_off(D0, 3, 0)>(vb), h3 = tr_read<v_rd_off(D0, 3, 1)>(vb);
    asm volatile("s_waitcnt lgkmcnt(0)" ::: "memory"); SBAR();
#define PK(L, H) (bf16x8){L[0], L[1], L[2], L[3], H[0], H[1], H[2], H[3]}
    od = __builtin_amdgcn_mfma_f32_32x32x16_bf16(pa0, PK(l0, h0), od, 0, 0, 0);
    od = __builtin_amdgcn_mfma_f32_32x32x16_bf16(pa1, PK(l1, h1), od, 0, 0, 0);
    od = __builtin_amdgcn_mfma_f32_32x32x16_bf16(pa2, PK(l2, h2), od, 0, 0, 0);
    od = __builtin_amdgcn_mfma_f32_32x32x16_bf16(pa3, PK(l3, h3), od, 0, 0, 0);
#undef PK
}
__device__ __forceinline__ void pv_d0(f32x16* o, int vb, bf16x8 pa0, bf16x8 pa1, bf16x8 pa2, bf16x8 pa3) {
    pv_one<0>(o[0], vb, pa0, pa1, pa2, pa3); pv_one<1>(o[1], vb, pa0, pa1, pa2, pa3); pv_one<2>(o[2], vb, pa0, pa1, pa2, pa3); pv_one<3>(o[3], vb, pa0, pa1, pa2, pa3);
}
struct VFrag { s16x4 l0, h0, l1, h1, l2, h2, l3, h3; };
template <int D0> __device__ __forceinline__ void pv_rd(VFrag& f, int vb) {
    f.l0 = tr_read<v_rd_off(D0, 0, 0)>(vb); f.h0 = tr_read<v_rd_off(D0, 0, 1)>(vb); f.l1 = tr_read<v_rd_off(D0, 1, 0)>(vb); f.h1 = tr_read<v_rd_off(D0, 1, 1)>(vb);
    f.l2 = tr_read<v_rd_off(D0, 2, 0)>(vb); f.h2 = tr_read<v_rd_off(D0, 2, 1)>(vb); f.l3 = tr_read<v_rd_off(D0, 3, 0)>(vb); f.h3 = tr_read<v_rd_off(D0, 3, 1)>(vb);
}
__device__ __forceinline__ void pv_mm(f32x16& od, const VFrag& f, bf16x8 pa0, bf16x8 pa1, bf16x8 pa2, bf16x8 pa3) {
#define PK(L, H) (bf16x8){L[0], L[1], L[2], L[3], H[0], H[1], H[2], H[3]}
    od = __builtin_amdgcn_mfma_f32_32x32x16_bf16(pa0, PK(f.l0, f.h0), od, 0, 0, 0);
    od = __builtin_amdgcn_mfma_f32_32x32x16_bf16(pa1, PK(f.l1, f.h1), od, 0, 0, 0);
    od = __builtin_amdgcn_mfma_f32_32x32x16_bf16(pa2, PK(f.l2, f.h2), od, 0, 0, 0);
    od = __builtin_amdgcn_mfma_f32_32x32x16_bf16(pa3, PK(f.l3, f.h3), od, 0, 0, 0);
#undef PK
}
__device__ __forceinline__ void pv_d0_pipe(f32x16* o, int vb, bf16x8 pa0, bf16x8 pa1, bf16x8 pa2, bf16x8 pa3) {
    VFrag fa, fb;
    pv_rd<0>(fa, vb); pv_rd<1>(fb, vb);
    asm volatile("s_waitcnt lgkmcnt(8)" ::: "memory"); SBAR(); pv_mm(o[0], fa, pa0, pa1, pa2, pa3); SBAR();
    pv_rd<2>(fa, vb);
    asm volatile("s_waitcnt lgkmcnt(8)" ::: "memory"); SBAR(); pv_mm(o[1], fb, pa0, pa1, pa2, pa3); SBAR();
    pv_rd<3>(fb, vb);
    asm volatile("s_waitcnt lgkmcnt(8)" ::: "memory"); SBAR(); pv_mm(o[2], fa, pa0, pa1, pa2, pa3); SBAR();
    asm volatile("s_waitcnt lgkmcnt(0)" ::: "memory"); SBAR(); pv_mm(o[3], fb, pa0, pa1, pa2, pa3);
}
template <int DQK> struct ScaleOf { static constexpr float scale = DQK == 192 ? 0.07216878364870322f : (DQK == 128 ? 0.08838834764831845f : 0.125f); };
template <int DQK, int SDEPTH, int QL, bool NOMAX, int ldq, int ldk, int ldv, int ldo>
__device__ __forceinline__ void attn_body(const bf16_t* __restrict__ Qb, const bf16_t* __restrict__ Kh, const bf16_t* __restrict__ Vh,
                                          bf16_t* __restrict__ Ob, int seq, char* lds, int tid_in, const float negMC) {
    constexpr float C = 1.0f, thr_raw = THR * 1.4426950408889634f;
    constexpr int RS = DQK * 2 + 16  , SHM_K = KVBLK * RS, NKP = DQK / 64, KPR = DQK / 8;
    const int tid_l = tid_in * 64 + fresh_lane();
    const int tid = tid_l, wid = tid_in  , lane = tid & 63, r32 = lane & 31, hi = lane >> 5;
    char* V_lds = lds; char* K_lds = lds + 2 * SHM_V;
    float* ws = (float*)(lds + 2 * SHM_V + 2 * SHM_K) + wid * 64; float* li_l = ws; float* al_l = ws + 32;
    constexpr int NQR = DQK / 16 - QL;
    char* qpark = lds + 2 * SHM_V + 2 * SHM_K + 2048 + wid * (QL * 1024) + lane * 16;
    float m_reg = -1e30f, l_reg = 0; f32x16 o[4] = {}; bf16x8 qr[NQR];
    const bf16_t* Qw = Qb + (size_t)(wid * QBLK + r32) * ldq + hi * 8;
#pragma unroll
    for (int d0 = 0; d0 < NQR; ++d0) qr[d0] = *reinterpret_cast<const bf16x8*>(Qw + d0 * 16);
#pragma unroll
    for (int d0 = 0; d0 < QL; ++d0) *(bf16x8*)(qpark + d0 * 1024) = *reinterpret_cast<const bf16x8*>(Qw + (NQR + d0) * 16);
    const int sr = tid >> 4, sc = (tid & 15) * 8, vst0 = v_st(sr, sc), vst1 = v_st(32 + sr, sc);
    int koff[NKP], klds[NKP];
#pragma unroll
    for (int i = 0; i < NKP; ++i) { const int row = tid >> 3, c8 = (tid & 7) + 8 * i; koff[i] = row * ldk + c8 * 8; klds[i] = row * RS + c8 * 16; }
    const int vb0 = (int)(uintptr_t)V_lds + v_rd_base(lane);
    bf16x8 sv0[SDEPTH], sv1[SDEPTH], sk[SDEPTH][NKP];
#define SLOAD(i, k0) do { sv0[i] = *reinterpret_cast<const bf16x8*>(&Vh[(size_t)((k0) + sr) * ldv + sc]); sv1[i] = *reinterpret_cast<const bf16x8*>(&Vh[(size_t)((k0) + 32 + sr) * ldv + sc]); \
    _Pragma("unroll") for (int _q = 0; _q < NKP; ++_q) sk[i][_q] = *reinterpret_cast<const bf16x8*>(&Kh[(size_t)(k0) * ldk + koff[_q]]); } while (0)
#define SWRITE(b, i) do { *(bf16x8*)(V_lds + (b) * SHM_V + vst0) = sv0[i]; *(bf16x8*)(V_lds + (b) * SHM_V + vst1) = sv1[i]; \
    _Pragma("unroll") for (int _q = 0; _q < NKP; ++_q) *(bf16x8*)(K_lds + (b) * SHM_K + klds[_q]) = sk[i][_q]; } while (0)
#define SWAIT() do { if constexpr (SDEPTH == 2) { if constexpr (NKP == 1) asm volatile("s_waitcnt vmcnt(3)" ::: "memory"); else if constexpr (NKP == 2) asm volatile("s_waitcnt vmcnt(4)" ::: "memory"); else asm volatile("s_waitcnt vmcnt(5)" ::: "memory"); } \
    else asm volatile("s_waitcnt vmcnt(0)" ::: "memory"); } while (0)
#define PVD0(...) do { if constexpr (PV_PIPE != 0) pv_d0_pipe(__VA_ARGS__); else pv_d0(__VA_ARGS__); } while (0)
#define RESC(a) do { if constexpr (!NOMAX) if (__any((a) < 1.f)) { if (hi == 0) al_l[r32] = (a); asm volatile("s_waitcnt lgkmcnt(0)" ::: "memory"); \
    _Pragma("unroll") for (int d = 0; d < 4; ++d) _Pragma("unroll") for (int r = 0; r < 16; ++r) o[d][r] *= al_l[crow(r, hi)]; } } while (0)
    f32x16 pA0, pA1, pB0, pB1; float mnA, mnB, alA, alB; bf16x8 pa0, pa1, pa2, pa3; const int NT = seq / KVBLK;
    if (ATT_PRIO && wid >= 4) __builtin_amdgcn_s_setprio(1);
    constexpr int SE = 0, SO = SDEPTH - 1;
    SLOAD(SE, 0); asm volatile("s_waitcnt vmcnt(0)" ::: "memory"); SWRITE(0, SE); __syncthreads();
    qkt<DQK, QL>(pA0, pA1, K_lds, qr, qpark, r32, hi); if constexpr (NOMAX) { partialSM_nm(pA0); alA = 1.f; } else partialSM(pA0, pA1, m_reg, mnA, alA, C, thr_raw);
    SLOAD(SO, KVBLK); if constexpr (SDEPTH == 2) { if (2 < NT) SLOAD(SE, 2 * KVBLK); }
    SWAIT(); SWRITE(1, SO); __syncthreads();
    for (int j = 1; j + 1 < NT; j += 2) {
        SBAR(); qkt<DQK, QL>(pB0, pB1, K_lds + SHM_K, qr, qpark, r32, hi);
        finishSM(pA0, pA1, alA, l_reg, pa0, pa1, pa2, pa3); SBAR();
        SLOAD(SO, (j + SDEPTH) * KVBLK); SBAR();
        PVD0(o, vb0, pa0, pa1, pa2, pa3); if constexpr (NOMAX) { partialSM_nm(pB0); alB = 1.f; } else partialSM(pB0, pB1, m_reg, mnB, alB, C, thr_raw);
        __syncthreads(); SWAIT(); SWRITE(0, SE);
        RESC(alB); __syncthreads();
        SBAR(); qkt<DQK, QL>(pA0, pA1, K_lds, qr, qpark, r32, hi);
        finishSM(pB0, pB1, alB, l_reg, pa0, pa1, pa2, pa3); SBAR();
        if (SDEPTH == 1 || j + 3 < NT) SLOAD(SE, (j + 1 + SDEPTH) * KVBLK); SBAR();
        PVD0(o, vb0 + SHM_V, pa0, pa1, pa2, pa3); if constexpr (NOMAX) { partialSM_nm(pA0); alA = 1.f; } else partialSM(pA0, pA1, m_reg, mnA, alA, C, thr_raw);
        __syncthreads(); SWAIT(); SWRITE(1, SO);
        RESC(alA); __syncthreads();
    }
    SBAR(); qkt<DQK, QL>(pB0, pB1, K_lds + SHM_K, qr, qpark, r32, hi);
    finishSM(pA0, pA1, alA, l_reg, pa0, pa1, pa2, pa3); SBAR();
    PVD0(o, vb0, pa0, pa1, pa2, pa3); if constexpr (NOMAX) { partialSM_nm(pB0); alB = 1.f; } else partialSM(pB0, pB1, m_reg, mnB, alB, C, thr_raw);
    __syncthreads(); RESC(alB);
    finishSM(pB0, pB1, alB, l_reg, pa0, pa1, pa2, pa3); SBAR();
    PVD0(o, vb0 + SHM_V, pa0, pa1, pa2, pa3);
    if (ATT_PRIO) __builtin_amdgcn_s_setprio(0);
    if (hi == 0) li_l[r32] = l_reg; asm volatile("s_waitcnt lgkmcnt(0)" ::: "memory");
    float rli[16];
#pragma unroll
    for (int r = 0; r < 16; ++r) rli[r] = __builtin_amdgcn_rcpf(li_l[crow(r, hi)]);
    bf16_t* Ow = Ob + (size_t)(wid * QBLK) * ldo + (r32 & ~1);
    const bool odd = (r32 & 1) != 0;
#pragma unroll
    for (int r = 0; r < 16; r += 2) { const int orow = crow(r, hi) + (odd ? 1 : 0);
#pragma unroll
        for (int d0 = 0; d0 < 4; ++d0) { const float a = o[d0][r] * rli[r], b = o[d0][r + 1] * rli[r + 1];
            const float recv = swz_xor<1>(odd ? a : b);
            const unsigned w = odd ? cvtpk(recv, b) : cvtpk(a, recv);
            *(unsigned*)(Ow + (size_t)orow * ldo + d0 * 32) = w; } }
    __syncthreads();
#undef SLOAD
#undef SWRITE
#undef SWAIT
#undef RESC
#undef PVD0
}
template <int DQK, int QL, int ldq, int ldk, int ldv, int ldo>
__device__ __forceinline__ void attn_body_simple(const bf16_t* __restrict__ Qb, const bf16_t* __restrict__ Kh, const bf16_t* __restrict__ Vh,
                                                 bf16_t* __restrict__ Ob, int seq, char* lds, int tid_in) {
    constexpr float C = 1.0f, thr_raw = THR * 1.4426950408889634f;
    constexpr int RS = DQK * 2 + 16  , SHM_K = KVBLK * RS, NKP = DQK / 64, KPR = DQK / 8;
    const int tid_l = tid_in * 64 + fresh_lane();
    const int tid = tid_l, wid = tid_in  , lane = tid & 63, r32 = lane & 31, hi = lane >> 5;
    char* V_lds = lds; char* K_lds = lds + 2 * SHM_V;
    float* ws = (float*)(lds + 2 * SHM_V + 2 * SHM_K) + wid * 64; float* li_l = ws; float* al_l = ws + 32;
    constexpr int NQR = DQK / 16 - QL;
    char* qpark = lds + 2 * SHM_V + 2 * SHM_K + 2048 + wid * (QL * 1024) + lane * 16;
    float m_reg = -1e30f, l_reg = 0; f32x16 o[4] = {}; bf16x8 qr[NQR];
    const bf16_t* Qw = Qb + (size_t)(wid * QBLK + r32) * ldq + hi * 8;
#pragma unroll
    for (int d0 = 0; d0 < NQR; ++d0) qr[d0] = *reinterpret_cast<const bf16x8*>(Qw + d0 * 16);
#pragma unroll
    for (int d0 = 0; d0 < QL; ++d0) *(bf16x8*)(qpark + d0 * 1024) = *reinterpret_cast<const bf16x8*>(Qw + (NQR + d0) * 16);
    const int sr = tid >> 4, sc = (tid & 15) * 8, vst0 = v_st(sr, sc), vst1 = v_st(32 + sr, sc);
    int koff[NKP], klds[NKP];
#pragma unroll
    for (int i = 0; i < NKP; ++i) { const int row = tid >> 3, c8 = (tid & 7) + 8 * i; koff[i] = row * ldk + c8 * 8; klds[i] = row * RS + c8 * 16; }
    const int vb0 = (int)(uintptr_t)V_lds + v_rd_base(lane);
    bf16x8 sv0, sv1, sk[NKP];
#define SLOAD(k0) do { sv0 = *reinterpret_cast<const bf16x8*>(&Vh[(size_t)((k0) + sr) * ldv + sc]); sv1 = *reinterpret_cast<const bf16x8*>(&Vh[(size_t)((k0) + 32 + sr) * ldv + sc]); \
    _Pragma("unroll") for (int _q = 0; _q < NKP; ++_q) sk[_q] = *reinterpret_cast<const bf16x8*>(&Kh[(size_t)(k0) * ldk + koff[_q]]); } while (0)
#define SWRITE(b) do { *(bf16x8*)(V_lds + (b) * SHM_V + vst0) = sv0; *(bf16x8*)(V_lds + (b) * SHM_V + vst1) = sv1; \
    _Pragma("unroll") for (int _q = 0; _q < NKP; ++_q) *(bf16x8*)(K_lds + (b) * SHM_K + klds[_q]) = sk[_q]; } while (0)
#define RESC(a) do { if (__any((a) < 1.f)) { if (hi == 0) al_l[r32] = (a); asm volatile("s_waitcnt lgkmcnt(0)" ::: "memory"); \
    _Pragma("unroll") for (int d = 0; d < 4; ++d) _Pragma("unroll") for (int r = 0; r < 16; ++r) o[d][r] *= al_l[crow(r, hi)]; } } while (0)
    const int NT = seq / KVBLK;
    SLOAD(0); asm volatile("s_waitcnt vmcnt(0)" ::: "memory"); SWRITE(0); __syncthreads();
    for (int j = 0; j < NT; ++j) {
        const int b = j & 1;
        if (j + 1 < NT) SLOAD((j + 1) * KVBLK);
        SBAR();
        f32x16 p0, p1; float mn, al; bf16x8 pa0, pa1, pa2, pa3;
        { const char* Ks = K_lds + b * SHM_K; p0 = f32x16{}; p1 = f32x16{};
#pragma unroll
          for (int d0 = 0; d0 < DQK / 16; ++d0) { const int cb = (d0 * 16 + hi * 8) * 2;
              const bf16x8 b0 = *reinterpret_cast<const bf16x8*>(Ks + r32 * RS + cb);
              const bf16x8 b1 = *reinterpret_cast<const bf16x8*>(Ks + (32 + r32) * RS + cb);
              bf16x8 qf; if (d0 < NQR) qf = qr[d0 < NQR ? d0 : 0]; else qf = *(const bf16x8*)(qpark + (d0 - NQR) * 1024);
              p0 = __builtin_amdgcn_mfma_f32_32x32x16_bf16(b0, qf, p0, 0, 0, 0);
              p1 = __builtin_amdgcn_mfma_f32_32x32x16_bf16(b1, qf, p1, 0, 0, 0); } }
        partialSM(p0, p1, m_reg, mn, al, C, thr_raw);
        RESC(al);
        finishSM(p0, p1, al, l_reg, pa0, pa1, pa2, pa3); SBAR();
        pv_d0(o, vb0 + b * SHM_V, pa0, pa1, pa2, pa3);
        if (j + 1 < NT) { asm volatile("s_waitcnt vmcnt(0)" ::: "memory"); SWRITE(b ^ 1); }
        __syncthreads();
    }
    if (hi == 0) li_l[r32] = l_reg; asm volatile("s_waitcnt lgkmcnt(0)" ::: "memory");
    float rli[16];
#pragma unroll
    for (int r = 0; r < 16; ++r) rli[r] = __builtin_amdgcn_rcpf(li_l[crow(r, hi)]);
    bf16_t* Ow = Ob + (size_t)(wid * QBLK) * ldo + (r32 & ~1);
    const bool odd = (r32 & 1) != 0;
#pragma unroll
    for (int r = 0; r < 16; r += 2) { const int orow = crow(r, hi) + (odd ? 1 : 0);
#pragma unroll
        for (int d0 = 0; d0 < 4; ++d0) { const float a = o[d0][r] * rli[r], b = o[d0][r + 1] * rli[r + 1];
            const float recv = swz_xor<1>(odd ? a : b);
            const unsigned w = odd ? cvtpk(recv, b) : cvtpk(a, recv);
            *(unsigned*)(Ow + (size_t)orow * ldo + d0 * 32) = w; } }
    __syncthreads();
#undef SLOAD
#undef SWRITE
#undef RESC
}
}

struct Params {
    const float* x; const float* c; const float* ctx; const float* c_ctx; const float* w_mod; const float* b_mod; const float* g_norm1; const float* g_norm2;
    const float* w_in_ab; const float* g_cq; const float* w_uq; const float* g_ckv; const float* w_ukv; const float* g_qn_a; const float* g_kn_a; const float* lam_vec;
    const float* g_qn_b; const float* g_kn_b; const float* g_sub_b; const float* w_out_ab; const float* w_in_c; const float* g_qn_c; const float* g_kn_c; const float* w_out_c;
    const float* w_pq; const float* sub_keys; const float* expert_u; const float* expert_v;
    float* out; unsigned char* ws; int ph_lo, ph_hi;
};

typedef const __attribute__((address_space(4))) Params CParams;
struct Ctx {
    int tid, lane, wid, G, vcu, bx;
    unsigned char* ws; char* lds;
};

__device__ __forceinline__ void tconv(const Ctx& F, const float* src, bf16_t* dst, const float* gain, int nmat, int K, int N, int Npad, int pad_at = 1 << 30, int pad_len = 0) {
    float* tile = (float*)(F.lds + 32768);
    const int ntn = Npad / 64, ntk = K / 64, per = ntn * ntk, total = per * nmat;
    for (int it = F.vcu; it < total; it += F.G) {
        const int mat = it / per, rem = it % per, tn = rem / ntk, tk = rem % ntk, k0 = tk * 64, n0 = tn * 64;
        const float* s = src + (size_t)mat * K * N; bf16_t* d = dst + (size_t)mat * Npad * K;
        __syncthreads();
        { const int r = F.tid >> 4, c4 = (F.tid & 15) * 4;
#pragma unroll
          for (int i = 0; i < 2; ++i) { const int rr = r + i * 32; f32x4 v = (f32x4){0.f, 0.f, 0.f, 0.f};
              const int sn0 = n0 < pad_at ? n0 : n0 - pad_len;
              if (sn0 + c4 < N && !(n0 >= pad_at && n0 < pad_at + pad_len)) v = *(const f32x4*)(s + (size_t)(k0 + rr) * N + sn0 + c4);
              tile[rr * 65 + c4 + 0] = v[0]; tile[rr * 65 + c4 + 1] = v[1]; tile[rr * 65 + c4 + 2] = v[2]; tile[rr * 65 + c4 + 3] = v[3]; } }
        __syncthreads();
        { const int n = F.tid >> 3, kc = (F.tid & 7) * 8; float v[8];
#pragma unroll
          for (int e = 0; e < 8; ++e) { v[e] = tile[(kc + e) * 65 + n]; if (gain) v[e] *= gain[(size_t)mat * K + k0 + kc + e]; }
          u32x4 w; w.x = cvt_pk_bf16(v[0], v[1]); w.y = cvt_pk_bf16(v[2], v[3]); w.z = cvt_pk_bf16(v[4], v[5]); w.w = cvt_pk_bf16(v[6], v[7]);
          *(u32x4*)(d + (size_t)(n0 + n) * K + k0 + kc) = w; }
    }
}
__device__ __forceinline__ void cvt_flat(const Ctx& F, const float* src, bf16_t* dst, size_t n8) {
    for (size_t i = (size_t)F.vcu * 512 + F.tid; i < n8; i += (size_t)F.G * 512) {
        const f32x4 a = *(const f32x4*)(src + i * 8), b = *(const f32x4*)(src + i * 8 + 4);
        u32x4 w; w.x = cvt_pk_bf16(a[0], a[1]); w.y = cvt_pk_bf16(a[2], a[3]); w.z = cvt_pk_bf16(b[0], b[1]); w.w = cvt_pk_bf16(b[2], b[3]);
        *(u32x4*)(dst + i * 8) = w;
    }
}
typedef unsigned v6u __attribute__((ext_vector_type(6)));
typedef float v32f __attribute__((ext_vector_type(32)));
typedef float v16f __attribute__((ext_vector_type(16)));
__device__ __forceinline__ float fp6_val(int c) { return c < 8 ? c * 0.125f : (c < 16 ? 1.f + (c - 8) * 0.125f : (c < 24 ? 2.f + (c - 16) * 0.25f : 4.f + (c - 24) * 0.5f)); }
__device__ __forceinline__ int fp6_code(float x) { return x < 1.f ? (int)(x * 8.f + 0.5f) : (x < 2.f ? 8 + (int)((x - 1.f) * 8.f + 0.5f) : (x < 4.f ? 16 + (int)((x - 2.f) * 4.f + 0.5f) : 24 + (int)((x - 4.f) * 2.f + 0.5f))); }
__device__ __forceinline__ void cvt_rows_fp6(const Ctx& F, const float* src, unsigned char* dst, float* descale, int R) {
    float* stg = (float*)(F.lds + 65536) + F.wid * (64 * 33);
    int* permL = (int*)(F.lds + 65536 + 8 * 64 * 33 * 4) + F.wid * 32;
    float fac;
    {   v16f lo, hi;
#pragma unroll
        for (int i = 0; i < 16; ++i) { lo[i] = fp6_val(i); hi[i] = fp6_val(16 + i); }
        const v6u w = __builtin_amdgcn_cvt_scalef32_2xpk16_fp6_f32(lo, hi, 1.0f);
        const v32f f = __builtin_amdgcn_cvt_scalef32_pk32_f32_fp6(w, 1.0f);
        float mx = 0.f;
#pragma unroll
        for (int j = 0; j < 32; ++j) mx = fmaxf(mx, f[j]);
        fac = mx * (1.f / 7.5f);
        const float inv = fac > 0.f ? 1.f / fac : 1.f;
        if (F.lane == 0) {
#pragma unroll
            for (int j = 0; j < 32; ++j) permL[j] = fp6_code(f[j] * inv) & 31; }
        asm volatile("s_waitcnt lgkmcnt(0)" ::: "memory"); __builtin_amdgcn_wave_barrier(); asm volatile("" ::: "memory");
    }
    for (int row = F.vcu * 8 + F.wid; row < R; row += F.G * 8) {
        const float* s = src + (size_t)row * DM + F.lane * 32; f32x4 v[8]; float am = 0.f;
#pragma unroll
        for (int i = 0; i < 8; ++i) { v[i] = *(const f32x4*)(s + i * 4);
#pragma unroll
            for (int e = 0; e < 4; ++e) am = fmaxf(am, fabsf(v[i][e])); }
        am = wave_max(am);
        const float sc = am > 0.f ? 7.f / am : 1.f;
#pragma unroll
        for (int i = 0; i < 8; ++i)
#pragma unroll
            for (int e = 0; e < 4; ++e) stg[F.lane * 33 + permL[i * 4 + e]] = v[i][e] * sc;
        asm volatile("s_waitcnt lgkmcnt(0)" ::: "memory"); __builtin_amdgcn_wave_barrier(); asm volatile("" ::: "memory");
        v16f lo, hi;
#pragma unroll
        for (int i = 0; i < 16; ++i) { lo[i] = stg[F.lane * 33 + i]; hi[i] = stg[F.lane * 33 + 16 + i]; }
        asm volatile("s_waitcnt lgkmcnt(0)" ::: "memory"); __builtin_amdgcn_wave_barrier(); asm volatile("" ::: "memory");
        const v6u w = __builtin_amdgcn_cvt_scalef32_2xpk16_fp6_f32(lo, hi, 1.0f);
        u32x2* d = (u32x2*)(dst + (size_t)row * EROW + F.lane * 24);
        d[0] = (u32x2){w[0], w[1]}; d[1] = (u32x2){w[2], w[3]}; d[2] = (u32x2){w[4], w[5]};
        if (F.lane == 0) descale[row] = (am > 0.f ? am * (1.f / 7.f) : 1.f) / (fac > 0.f ? fac : 1.f);
    }
}
__device__ __forceinline__ float silu_f(float v) { return v / (1.f + __expf(-v)); }

__device__ __forceinline__ void prologue_phase(const Ctx& F, CParams& P) {
    unsigned char* ws = F.ws;
    {
        float* sv = (float*)F.lds;
        float* part = (float*)(F.lds + 24576);
        for (int i = F.tid; i < 3 * DM; i += 512) { const int v = i / DM, k = i % DM; const float cv = v < 2 ? P.c[v * DM + k] : P.c_ctx[k]; sv[i] = silu_f(cv); }
        __syncthreads();
        float* mod = (float*)(ws + WS_MOD);
        for (int it = F.vcu; it < DEPTH * 192; it += F.G) {
            const int l = it / 192, n0 = (it % 192) * 64;
            const float* wp = P.w_mod + ((size_t)l * DM + F.wid * 256) * 12288 + n0 + F.lane;
            float a0 = 0.f, a1 = 0.f, a2 = 0.f;
#pragma unroll 8
            for (int k = 0; k < 256; ++k) { const float w = wp[(size_t)k * 12288]; const int kk = F.wid * 256 + k; a0 += sv[kk] * w; a1 += sv[DM + kk] * w; a2 += sv[2 * DM + kk] * w; }
            part[(F.wid * 3 + 0) * 64 + F.lane] = a0; part[(F.wid * 3 + 1) * 64 + F.lane] = a1; part[(F.wid * 3 + 2) * 64 + F.lane] = a2;
            __syncthreads();
            if (F.wid < 3) { float s = 0.f;
#pragma unroll
                for (int w = 0; w < 8; ++w) s += part[(w * 3 + F.wid) * 64 + F.lane];
                mod[((size_t)l * 3 + F.wid) * 12288 + n0 + F.lane] = s + P.b_mod[(size_t)l * 12288 + n0 + F.lane]; }
            __syncthreads();
        }
    }
    if (F.vcu == 0) {
        float* t16 = (float*)(ws + WS_TAB16); float* t32 = (float*)(ws + WS_TAB32);
        for (int i = F.tid; i < 128 * 16; i += 512) { const int pos = i >> 4, f = i & 15; const float fr = powf(10000.f, -(float)f / 16.f); const float a = (float)pos * fr; float s, c; sincosf(a, &s, &c); t16[i * 2] = c; t16[i * 2 + 1] = s; }
        for (int i = F.tid; i < 128 * 32; i += 512) { const int pos = i >> 5, f = i & 31; const float fr = powf(10000.f, -(float)f / 32.f); const float a = (float)pos * fr; float s, c; sincosf(a, &s, &c); t32[i * 2] = c; t32[i * 2 + 1] = s; }
        if (F.wid == 2) { float* bnd = (float*)(ws + WS_LAM) + 4;
            for (int e2 = 0; e2 < 2; ++e2) {
                float ga = 0.f, gb = 0.f, gc = 0.f, gd = 0.f, ge = 0.f, gf = 0.f;
                for (int i = F.lane; i < 192; i += 64) { ga = fmaxf(ga, fabsf(P.g_qn_a[e2 * 192 + i])); gb = fmaxf(gb, fabsf(P.g_kn_a[e2 * 192 + i])); }
                gc = fabsf(P.g_qn_b[e2 * 64 + F.lane]); gd = fabsf(P.g_kn_b[e2 * 64 + F.lane]);
                for (int i = F.lane; i < 128; i += 64) { ge = fmaxf(ge, fabsf(P.g_qn_c[e2 * 128 + i])); gf = fmaxf(gf, fabsf(P.g_kn_c[e2 * 128 + i])); }
                ga = wave_max(ga); gb = wave_max(gb); gc = wave_max(gc); gd = wave_max(gd); ge = wave_max(ge); gf = wave_max(gf);
                if (F.lane == 0) { bnd[(2 * e2) * 2 + 0] = 1.03f * 13.856406f * ga * gb;
                                   bnd[(2 * e2) * 2 + 1] = 1.03f * 8.f * gc * gd;
                                   bnd[(2 * e2 + 1) * 2 + 0] = 1.03f * 11.313708f * ge * gf;
                                   bnd[(2 * e2 + 1) * 2 + 1] = 0.f; } } }
        if (F.wid < 2) { const float* lv = P.lam_vec + F.wid * 256; const float d1 = wave_sum(lv[F.lane] * lv[64 + F.lane]), d2 = wave_sum(lv[128 + F.lane] * lv[192 + F.lane]);
            const float lam_init = 0.8f - 0.6f * expf(-0.3f * (float)(2 * F.wid));
            if (F.lane == 0) ((float*)(ws + WS_LAM))[F.wid] = expf(d1) - expf(d2) + lam_init; }
    }
    tconv(F, P.w_in_ab, (bf16_t*)(ws + WS_WINAB), nullptr, 2, DM, AB_IN, AB_INP, 3392, AB_INP - AB_IN);
    tconv(F, P.w_uq, (bf16_t*)(ws + WS_WUQ), P.g_cq, 2, 768, 1536, 1536);
    tconv(F, P.w_ukv, (bf16_t*)(ws + WS_WUKV), P.g_ckv, 2, 512, 2048, 2048);
    tconv(F, P.w_out_ab, (bf16_t*)(ws + WS_WOUTAB), nullptr, 2, DM, DM, DM);
    tconv(F, P.w_in_c, (bf16_t*)(ws + WS_WINC), nullptr, 2, DM, C_IN, C_IN);
    tconv(F, P.w_out_c, (bf16_t*)(ws + WS_WOUTC), nullptr, 2, DM, DM, DM);
    tconv(F, P.w_pq, (bf16_t*)(ws + WS_WPQ), nullptr, 4, DM, DM, DM);
    cvt_flat(F, P.sub_keys, (bf16_t*)(ws + WS_SUBK), (size_t)4 * 8 * 2 * 128 * 128 / 8);
    cvt_rows_fp6(F, P.expert_u, ws + WS_EU, (float*)(ws + WS_SU), 4 * NEXP);
    cvt_rows_fp6(F, P.expert_v, ws + WS_EV, (float*)(ws + WS_SV), 4 * NEXP);
}

__device__ __forceinline__ void norm_rows(const Ctx& F, CParams& P, int layer, int which  , int t_first, int t_end, int t_stride) {
    float* X = (float*)(F.ws + WS_X); bf16_t* H = (bf16_t*)(F.ws + WS_H);
    const float* mod = (const float*)(F.ws + WS_MOD) + (size_t)layer * 3 * 12288;
    const float* gn = (which ? P.g_norm2 : P.g_norm1) + (size_t)layer * DM;
    const bool from_in = (layer == 0 && which == 0);
    const int lane = fresh_lane();
    if (t_first >= t_end) return;
    f32x4 g[8];
#pragma unroll
    for (int j = 0; j < 8; ++j) g[j] = *(const f32x4*)(gn + j * 256 + lane * 4);
    auto srcrow = [&](int t) { return from_in ? (t < TL ? P.x + (size_t)t * DM : P.ctx + (size_t)(t - TL) * DM) : X + (size_t)t * DM; };
    f32x4 vn[8];
    { const float* src = srcrow(t_first);
#pragma unroll
      for (int j = 0; j < 8; ++j) vn[j] = *(const f32x4*)(src + j * 256 + lane * 4); }
    for (int t = t_first; t < t_end; t += t_stride) {
        const int vs = vsel_of_row(t);
        const float* shf = mod + (size_t)vs * 12288 + (which ? 3 : 0) * DM; const float* scl = shf + DM;
        f32x4 v[8], sc[8], sh[8]; float ss = 0.f;
#pragma unroll
        for (int j = 0; j < 8; ++j) { v[j] = vn[j]; sc[j] = *(const f32x4*)(scl + j * 256 + lane * 4); sh[j] = *(const f32x4*)(shf + j * 256 + lane * 4); }
        { const int tn = t + t_stride; const float* src = srcrow(tn < t_end ? tn : t);
#pragma unroll
          for (int j = 0; j < 8; ++j) vn[j] = *(const f32x4*)(src + j * 256 + lane * 4); }
#pragma unroll
        for (int j = 0; j < 8; ++j) ss += v[j][0] * v[j][0] + v[j][1] * v[j][1] + v[j][2] * v[j][2] + v[j][3] * v[j][3];
        ss = wave_sum(ss);
        const float rstd = rsqrtf(ss * (1.f / DM) + EPS);
#pragma unroll
        for (int j = 0; j < 8; ++j) { const int c = j * 256 + lane * 4;
            f32x4 y;
#pragma unroll
            for (int e = 0; e < 4; ++e) y[e] = (v[j][e] * rstd * g[j][e]) * (1.f + sc[j][e]) + sh[j][e];
            u32x2 w; w.x = cvt_pk_bf16(y[0], y[1]); w.y = cvt_pk_bf16(y[2], y[3]);
            *(u32x2*)(H + (size_t)t * DM + c) = w; }
    }
}
__device__ __forceinline__ void norm_phase(const Ctx& F, CParams& P, int layer, int which, int m_rows) { norm_rows(F, P, layer, which, F.vcu * 8 + F.wid, m_rows, F.G * 8); }

__device__ __forceinline__ float grp16_sum(float v) { v += swz_xor<8>(v); v += swz_xor<4>(v); v += swz_xor<2>(v); v += swz_xor<1>(v); return v; }
__device__ __forceinline__ void rope4(float (&x)[4], int q16, int row, int col, const float* t16) {
    const int seg = q16 >> 3, f0 = (q16 & 3) * 4, pos = seg ? col : row; const bool first = (q16 & 7) < 4;
    const f32x4 c0 = *(const f32x4*)(t16 + (pos * 16 + f0) * 2), c1 = *(const f32x4*)(t16 + (pos * 16 + f0) * 2 + 4);
    const float cs[4] = {c0[0], c0[2], c1[0], c1[2]}, sn[4] = {c0[1], c0[3], c1[1], c1[3]};
#pragma unroll
    for (int e = 0; e < 4; ++e) { const float p = swz_xor<4>(x[e]); x[e] = first ? x[e] * cs[e] - p * sn[e] : p * sn[e] + x[e] * cs[e]; }
}
__device__ __forceinline__ void rope8(float (&x)[8], int q16, int row, int col, const float* t32) {
    const int seg = q16 >> 3, f0 = (q16 & 3) * 8, pos = seg ? col : row; const bool first = (q16 & 7) < 4;
    const float* tp = t32 + (pos * 32 + f0) * 2;
#pragma unroll
    for (int q = 0; q < 4; ++q) { const f32x4 c = *(const f32x4*)(tp + q * 4);
#pragma unroll
        for (int s = 0; s < 2; ++s) { const int e = q * 2 + s; const float cs = c[s * 2], sn = c[s * 2 + 1]; const float p = swz_xor<4>(x[e]); x[e] = first ? x[e] * cs - p * sn : p * sn + x[e] * cs; } }
}
__device__ __forceinline__ void ld8bf(const bf16_t* p, float (&x)[8]) { const u32x4 w = *(const u32x4*)p;
#pragma unroll
    for (int q = 0; q < 4; ++q) { x[q * 2] = bf_lo(w[q]); x[q * 2 + 1] = bf_hi(w[q]); } }
__device__ __forceinline__ void ld4bf(const bf16_t* p, float (&x)[4]) { const u32x2 w = *(const u32x2*)p; x[0] = bf_lo(w.x); x[1] = bf_hi(w.x); x[2] = bf_lo(w.y); x[3] = bf_hi(w.y); }
__device__ __forceinline__ void st8bf(bf16_t* p, const float (&x)[8]) { u32x4 w; w.x = cvt_pk_bf16(x[0], x[1]); w.y = cvt_pk_bf16(x[2], x[3]); w.z = cvt_pk_bf16(x[4], x[5]); w.w = cvt_pk_bf16(x[6], x[7]); *(u32x4*)p = w; }
__device__ __forceinline__ void st4bf(bf16_t* p, const float (&x)[4]) { u32x2 w; w.x = cvt_pk_bf16(x[0], x[1]); w.y = cvt_pk_bf16(x[2], x[3]); *(u32x2*)p = w; }

__device__ __forceinline__ void qkv_even_phase(const Ctx& F, CParams& P, int e) {
    const bf16_t* P1 = (const bf16_t*)(F.ws + WS_P1); const bf16_t* QA = (const bf16_t*)(F.ws + WS_QA); const bf16_t* KV = (const bf16_t*)(F.ws + WS_KV);
    bf16_t* Qm = (bf16_t*)(F.ws + WS_Q1); bf16_t* Km = (bf16_t*)(F.ws + WS_K1); bf16_t* Vm = (bf16_t*)(F.ws + WS_V1);
    bf16_t* Qd = (bf16_t*)(F.ws + WS_Q2); bf16_t* Kd = (bf16_t*)(F.ws + WS_K2); bf16_t* Vd = (bf16_t*)(F.ws + WS_V2);
    const float* t16 = (const float*)(F.ws + WS_TAB16);
    const float* gqa = P.g_qn_a + e * 192; const float* gka = P.g_kn_a + e * 192; const float* gqb = P.g_qn_b + e * 64; const float* gkb = P.g_kn_b + e * 64;
    const int q16 = F.lane & 15, grp = F.lane >> 4;
    float gq_n[8], gq_r[4], gk_n[8], gk_r[4], gqd[4], gkd[4];
#pragma unroll
    for (int i = 0; i < 8; ++i) { gq_n[i] = gqa[q16 * 8 + i]; gk_n[i] = gka[q16 * 8 + i]; }
#pragma unroll
    for (int i = 0; i < 4; ++i) { gq_r[i] = gqa[128 + q16 * 4 + i]; gk_r[i] = gka[128 + q16 * 4 + i]; gqd[i] = gqb[q16 * 4 + i]; gkd[i] = gkb[q16 * 4 + i]; }
    struct Raw { u32x2 cq[3]; u32x4 ckv; u32x2 kro; u32x4 qn[2]; u32x2 qr[2]; u32x4 kn[2], kv[2]; u32x2 dq[4], dk[4]; f32x4 rc0, rc1; };
    auto load_raw = [&](int t, Raw& R) {
        const bf16_t* p1 = P1 + (size_t)t * AB_INP;
        { const int s_ = t & (SEQ - 1), pos_ = (q16 >> 3) ? (s_ & 63) : (s_ >> 6); const float* tp = t16 + (pos_ * 16 + (q16 & 3) * 4) * 2; R.rc0 = *(const f32x4*)tp; R.rc1 = *(const f32x4*)(tp + 4); }
#pragma unroll
        for (int j = 0; j < 3; ++j) R.cq[j] = *(const u32x2*)(p1 + j * 256 + F.lane * 4);
        R.ckv = *(const u32x4*)(p1 + 768 + F.lane * 8);
        R.kro = *(const u32x2*)(p1 + 1280 + q16 * 4);
#pragma unroll
        for (int ps = 0; ps < 2; ++ps) { const int h = ps * 4 + grp; const bf16_t* src = QA + (size_t)t * 1536 + h * 192;
            R.qn[ps] = *(const u32x4*)(src + q16 * 8); R.qr[ps] = *(const u32x2*)(src + 128 + q16 * 4);
            const bf16_t* sk = KV + (size_t)t * 2048 + h * 256; R.kn[ps] = *(const u32x4*)(sk + q16 * 8); R.kv[ps] = *(const u32x4*)(sk + 128 + q16 * 8); }
#pragma unroll
        for (int ps = 0; ps < 4; ++ps) { const int hm = ps * 4 + grp; R.dq[ps] = *(const u32x2*)(p1 + 1344 + hm * 64 + q16 * 4); R.dk[ps] = *(const u32x2*)(p1 + 2368 + hm * 64 + q16 * 4); }
    };
#define UNP8(W, X) do { X[0] = bf_lo(W.x); X[1] = bf_hi(W.x); X[2] = bf_lo(W.y); X[3] = bf_hi(W.y); X[4] = bf_lo(W.z); X[5] = bf_hi(W.z); X[6] = bf_lo(W.w); X[7] = bf_hi(W.w); } while (0)
#define UNP4(W, X) do { X[0] = bf_lo(W.x); X[1] = bf_hi(W.x); X[2] = bf_lo(W.y); X[3] = bf_hi(W.y); } while (0)
    const int tfirst = F.vcu * 8 + F.wid, tstr = F.G * 8;
    Raw R; if (tfirst < TT) load_raw(tfirst, R);
    for (int t = tfirst; t < TT; t += tstr) {
        const bool latent = t < TL; const int s = t & (SEQ - 1), row = s >> 6, col = s & 63; const int kr = krow_of(t);
        Raw C = R; { const int tn = t + tstr; load_raw(tn < TT ? tn : t, R); }
        const float rcs[4] = {C.rc0[0], C.rc0[2], C.rc1[0], C.rc1[2]}, rsn[4] = {C.rc0[1], C.rc0[3], C.rc1[1], C.rc1[3]}; const bool rfirst = (q16 & 7) < 4;
#define ROPE4V(X) do { _Pragma("unroll") for (int e_ = 0; e_ < 4; ++e_) { const float p_ = swz_xor<4>(X[e_]); X[e_] = rfirst ? X[e_] * rcs[e_] - p_ * rsn[e_] : p_ * rsn[e_] + X[e_] * rcs[e_]; } } while (0)
        float ss = 0.f;
#pragma unroll
        for (int j = 0; j < 3; ++j) { float x[4]; UNP4(C.cq[j], x); ss += x[0] * x[0] + x[1] * x[1] + x[2] * x[2] + x[3] * x[3]; }
        ss = wave_sum(ss); const float rstd_q = rsqrtf(ss * (1.f / 768.f) + EPS);
        float s2 = 0.f;
        { float x[8]; UNP8(C.ckv, x);
#pragma unroll
          for (int i = 0; i < 8; ++i) s2 += x[i] * x[i]; }
        s2 = wave_sum(s2); const float rstd_kv = rsqrtf(s2 * (1.f / 512.f) + EPS);
        float kro[4]; UNP4(C.kro, kro);
#pragma unroll
        for (int ps = 0; ps < 2; ++ps) { const int h = ps * 4 + grp;
            float xn[8], xr[4]; UNP8(C.qn[ps], xn); UNP4(C.qr[ps], xr);
            float sq = 0.f;
#pragma unroll
            for (int i = 0; i < 8; ++i) { xn[i] *= rstd_q; sq += xn[i] * xn[i]; }
#pragma unroll
            for (int i = 0; i < 4; ++i) { xr[i] *= rstd_q; sq += xr[i] * xr[i]; }
            sq = grp16_sum(sq); const float r = rsqrtf(sq * (1.f / 192.f) + EPS);
            const float rq = r * (0.07216878364870322f * LOG2E);
#pragma unroll
            for (int i = 0; i < 8; ++i) xn[i] *= rq * gq_n[i];
#pragma unroll
            for (int i = 0; i < 4; ++i) xr[i] *= rq * gq_r[i];
            if (latent) ROPE4V(xr);
            bf16_t* dst = Qm + ((size_t)t * 8 + h) * 192; st8bf(dst + q16 * 8, xn); st4bf(dst + 128 + q16 * 4, xr); }
#pragma unroll
        for (int ps = 0; ps < 2; ++ps) { const int h = ps * 4 + grp;
            float xn[8], xr[4], xv[8]; UNP8(C.kn[ps], xn); UNP8(C.kv[ps], xv);
            float sq = 0.f;
#pragma unroll
            for (int i = 0; i < 8; ++i) { xn[i] *= rstd_kv; xv[i] *= rstd_kv; sq += xn[i] * xn[i]; }
#pragma unroll
            for (int i = 0; i < 4; ++i) { xr[i] = kro[i]; sq += xr[i] * xr[i]; }
            sq = grp16_sum(sq); const float r = rsqrtf(sq * (1.f / 192.f) + EPS);
#pragma unroll
            for (int i = 0; i < 8; ++i) xn[i] *= r * gk_n[i];
#pragma unroll
            for (int i = 0; i < 4; ++i) xr[i] *= r * gk_r[i];
            if (latent) ROPE4V(xr);
            bf16_t* dst = Km + ((size_t)kr * 8 + h) * 192; st8bf(dst + q16 * 8, xn); st4bf(dst + 128 + q16 * 4, xr);
            st8bf(Vm + ((size_t)kr * 8 + h) * 128 + q16 * 8, xv); }
#pragma unroll
        for (int ps = 0; ps < 4; ++ps) { const int hm = ps * 4 + grp;
            float x[4]; UNP4(C.dq[ps], x);
            float sq = grp16_sum(x[0] * x[0] + x[1] * x[1] + x[2] * x[2] + x[3] * x[3]); float r = rsqrtf(sq * (1.f / 64.f) + EPS);
#pragma unroll
            for (int i = 0; i < 4; ++i) x[i] *= r * (0.125f * LOG2E) * gqd[i];
            if (latent) ROPE4V(x);
            st4bf(Qd + ((size_t)t * 16 + hm) * 64 + q16 * 4, x);
            UNP4(C.dk[ps], x);
            sq = grp16_sum(x[0] * x[0] + x[1] * x[1] + x[2] * x[2] + x[3] * x[3]); r = rsqrtf(sq * (1.f / 64.f) + EPS);
#pragma unroll
            for (int i = 0; i < 4; ++i) x[i] *= r * gkd[i];
            if (latent) ROPE4V(x);
            st4bf(Kd + ((size_t)kr * 16 + hm) * 64 + q16 * 4, x); }
    }
#undef UNP8
#undef UNP4
#undef ROPE4V
}
__device__ __forceinline__ void qkv_odd_rows(const Ctx& F, CParams& P, int e, int t_first, int t_end, int t_stride) {
    const bf16_t* P1 = (const bf16_t*)(F.ws + WS_P1);
    bf16_t* Qc = (bf16_t*)(F.ws + WS_Q1); bf16_t* Kc = (bf16_t*)(F.ws + WS_K1); bf16_t* Vc = (bf16_t*)(F.ws + WS_V1);
    const float* t32 = (const float*)(F.ws + WS_TAB32);
    const int lane = fresh_lane();
    const int q16 = lane & 15, grp = lane >> 4;
    float gq[8], gk[8];
#pragma unroll
    for (int i = 0; i < 8; ++i) { gq[i] = P.g_qn_c[e * 128 + q16 * 8 + i]; gk[i] = P.g_kn_c[e * 128 + q16 * 8 + i]; }
    if (t_first >= t_end) return;
    struct Raw { u32x4 x[5]; f32x4 rc[4]; };
    auto load_raw = [&](int t, Raw& R) {
        const bf16_t* p1 = P1 + (size_t)t * C_IN;
#pragma unroll
        for (int ps = 0; ps < 5; ++ps) { const bool isq = ps < 4; const int h = isq ? ps * 4 + grp : grp; R.x[ps] = *(const u32x4*)(p1 + (isq ? 0 : 2048) + h * 128 + q16 * 8); }
        const int s_ = t & (SEQ - 1), pos_ = (q16 >> 3) ? (s_ & 63) : (s_ >> 6); const float* tp = t32 + (pos_ * 32 + (q16 & 3) * 8) * 2;
#pragma unroll
        for (int q = 0; q < 4; ++q) R.rc[q] = *(const f32x4*)(tp + q * 4);
    };
    Raw R; load_raw(t_first, R);
    for (int t = t_first; t < t_end; t += t_stride) {
        const bool latent = t < TL; const int kr = krow_of(t);
        Raw C = R; { const int tn = t + t_stride; load_raw(tn < t_end ? tn : t, R); }
        const bool rfirst = (q16 & 7) < 4;
#pragma unroll
        for (int ps = 0; ps < 5; ++ps) {
            const bool isq = ps < 4; const int h = isq ? ps * 4 + grp : grp;
            float x[8]; { const u32x4 w = C.x[ps]; x[0] = bf_lo(w.x); x[1] = bf_hi(w.x); x[2] = bf_lo(w.y); x[3] = bf_hi(w.y); x[4] = bf_lo(w.z); x[5] = bf_hi(w.z); x[6] = bf_lo(w.w); x[7] = bf_hi(w.w); }
            float sq = 0.f;
#pragma unroll
            for (int i = 0; i < 8; ++i) sq += x[i] * x[i];
            sq = grp16_sum(sq); const float r = rsqrtf(sq * (1.f / 128.f) + EPS);
#pragma unroll
            for (int i = 0; i < 8; ++i) x[i] *= r * (isq ? gq[i] * (0.08838834764831845f * LOG2E) : gk[i]);
            if (latent) {
#pragma unroll
                for (int q = 0; q < 4; ++q)
#pragma unroll
                    for (int s2 = 0; s2 < 2; ++s2) { const int e = q * 2 + s2; const float cs = C.rc[q][s2 * 2], sn = C.rc[q][s2 * 2 + 1]; const float p = swz_xor<4>(x[e]); x[e] = rfirst ? x[e] * cs - p * sn : p * sn + x[e] * cs; } }
            st8bf(isq ? Qc + ((size_t)t * 16 + h) * 128 + q16 * 8 : Kc + ((size_t)kr * 4 + h) * 128 + q16 * 8, x); }
    }
}

template <int DQK, int SDEPTH, int ldo, int NH, int NKVH, int NVH>
__device__ __forceinline__ void attn_phase(const Ctx& F, const bf16_t* Qbuf, const bf16_t* Kbuf, const bf16_t* Vbuf, bf16_t* OF, int ocol0, bool with_ctx, const float bound  ) {
    const bool nomax = bound < 60.f;
    const float negMC = 0.f;
    constexpr int kv_div = NH / NKVH, v_div = NH / NVH;
    const int n_lat = NH * NB * 32, n_tot = n_lat + (with_ctx ? NH * NB : 0);
    constexpr int ldq = NH * DQK, ldk = NKVH * DQK, ldv = NVH * 128;
    for (int u = F.vcu; u < n_tot; u += F.G) {
        int b, h, qrow0, kstart, seq;
        if (u < n_lat) { const int bh = u >> 5, qb = u & 31; b = bh / NH; h = bh % NH; qrow0 = b * SEQ + qb * 256; kstart = b * KPB; seq = KPB; }
        else { const int bh = u - n_lat; b = bh / NH; h = bh % NH; qrow0 = TL + b * CTXL; kstart = b * KPB + SEQ; seq = CTXL; }
        const bf16_t* Qp = Qbuf + ((size_t)qrow0 * NH + h) * DQK;
        const bf16_t* Kp = Kbuf + ((size_t)kstart * NKVH + h / kv_div) * DQK;
        const bf16_t* Vp = Vbuf + ((size_t)kstart * NVH + h / v_div) * 128;
        bf16_t* Op = OF + (size_t)qrow0 * ldo + ocol0 + h * 128;
        if constexpr (SDEPTH == 0) att::attn_body_simple<DQK, (DQK == 192 ? MLA_QL : 0), ldq, ldk, ldv, ldo>(Qp, Kp, Vp, Op, seq, F.lds, F.wid);
        else { if (nomax) att::attn_body<DQK, SDEPTH, (DQK == 192 ? MLA_QL : (DQK == 128 ? GQA_QL : 0)), true, ldq, ldk, ldv, ldo>(Qp, Kp, Vp, Op, seq, F.lds, F.wid, negMC);
               else att::attn_body_simple<DQK, 0, ldq, ldk, ldv, ldo>(Qp, Kp, Vp, Op, seq, F.lds, F.wid); }
    }
}

__device__ __forceinline__ void merge_even_phase(const Ctx& F, CParams& P, int e, int layer, int m_rows) {
    const bf16_t* OD = (const bf16_t*)(F.ws + WS_OF); bf16_t* AO = (bf16_t*)(F.ws + WS_AO);
    const float lam = ((const float*)(F.ws + WS_LAM))[e];
    const float lam_init = 0.8f - 0.6f * expf(-0.3f * (float)layer);
    const int q16 = F.lane & 15, grp = F.lane >> 4;
    float gs[8];
#pragma unroll
    for (int i = 0; i < 8; ++i) gs[i] = P.g_sub_b[e * 128 + q16 * 8 + i] * (1.f - lam_init);
    for (int t = F.vcu * 8 + F.wid; t < m_rows; t += F.G * 8) {
        const bf16_t* od = OD + (size_t)t * DM; bf16_t* ao = AO + (size_t)t * DM + 1024;
#pragma unroll
        for (int ps = 0; ps < 2; ++ps) { const int h = ps * 4 + grp;
            float o0[8], o1[8], d[8]; ld8bf(od + (2 * h) * 128 + q16 * 8, o0); ld8bf(od + (2 * h + 1) * 128 + q16 * 8, o1);
            float sq = 0.f;
#pragma unroll
            for (int i = 0; i < 8; ++i) { d[i] = o0[i] - lam * o1[i]; sq += d[i] * d[i]; }
            sq = grp16_sum(sq); const float r = rsqrtf(sq * (1.f / 128.f) + EPS);
#pragma unroll
            for (int i = 0; i < 8; ++i) d[i] *= r * gs[i];
            st8bf(ao + h * 128 + q16 * 8, d); }
    }
}

__device__ __forceinline__ void wave_lds_fence() { asm volatile("s_waitcnt lgkmcnt(0)" ::: "memory"); __builtin_amdgcn_wave_barrier(); asm volatile("" ::: "memory"); }
__device__ __forceinline__ unsigned fkey(float f) { const unsigned b = __float_as_uint(f); return b ^ ((unsigned)((int)b >> 31) | 0x80000000u); }
__device__ __forceinline__ float funkey(unsigned k) { return __uint_as_float((k & 0x80000000u) ? (k ^ 0x80000000u) : ~k); }
__device__ __forceinline__ unsigned umed3(unsigned a, unsigned b, unsigned c) { unsigned r; asm("v_med3_u32 %0, %1, %2, %3" : "=v"(r) : "v"(a), "v"(b), "v"(c)); return r; }
__device__ __forceinline__ void kins16(unsigned (&L)[16], unsigned k) {
#pragma unroll
    for (int p = 15; p >= 1; --p) L[p] = umed3(L[p - 1], L[p], k);
    L[0] = L[0] > k ? L[0] : k;
}
__device__ __forceinline__ void scan_set(unsigned (&L)[16], const bf16_t* qbase  , const bf16_t* kbase  , float* buf, int lane) {
    const int r32 = lane & 31, hi = lane >> 5;
#pragma unroll
    for (int p = 0; p < 16; ++p) L[p] = 0u;
    bf16x8 a0[8], a1[8];
    { const bf16_t* ap = qbase + (size_t)r32 * DM + hi * 8;
#pragma unroll
      for (int ks = 0; ks < 8; ++ks) { a0[ks] = *(const bf16x8*)(ap + ks * 16); a1[ks] = *(const bf16x8*)(ap + (size_t)32 * DM + ks * 16); } }
#pragma unroll 1
    for (int kb = 0; kb < 4; ++kb) {
        f32x16 acc0 = {}, acc1 = {};
        { const bf16_t* bp = kbase + (size_t)(kb * 32 + r32) * 128 + hi * 8;
          bf16x8 b[8];
#pragma unroll
          for (int ks = 0; ks < 8; ++ks) b[ks] = *(const bf16x8*)(bp + ks * 16);
#pragma unroll
          for (int ks = 0; ks < 8; ++ks) { acc0 = __builtin_amdgcn_mfma_f32_32x32x16_bf16(a0[ks], b[ks], acc0, 0, 0, 0); acc1 = __builtin_amdgcn_mfma_f32_32x32x16_bf16(a1[ks], b[ks], acc1, 0, 0, 0); } }
        wave_lds_fence();
#pragma unroll
        for (int r = 0; r < 16; ++r) { const int rowi = att::crow(r, hi); buf[rowi * 33 + r32] = acc0[r]; buf[(32 + rowi) * 33 + r32] = acc1[r]; }
        wave_lds_fence();
        const unsigned tb = 127u - (unsigned)(kb * 32);
#pragma unroll 8
        for (int k = 0; k < 32; ++k) kins16(L, (fkey(buf[lane * 33 + k]) & ~127u) | (tb - (unsigned)k));
    }
}
__device__ __forceinline__ void peer_select_unit(const Ctx& F, int layer, int u) {
    const bf16_t* PQ = (const bf16_t*)(F.ws + WS_PQ); const bf16_t* SK = (const bf16_t*)(F.ws + WS_SUBK) + (size_t)layer * 8 * 2 * 128 * 128;
    int* PIDX = (int*)(F.ws + WS_PIDX); float* PG = (float*)(F.ws + WS_PG);
    float* buf = (float*)F.lds + F.wid * (64 * 33);
    const int lane = fresh_lane();
    {
        const int tile = u >> 3, h = u & 7, t0 = tile * 64;
        unsigned Ka[16], Kb[16];
        scan_set(Ka, PQ + (size_t)t0 * DM + h * 256, SK + (size_t)(h * 2) * 128 * 128, buf, lane);
        scan_set(Kb, PQ + (size_t)t0 * DM + h * 256 + 128, SK + (size_t)(h * 2 + 1) * 128 * 128, buf, lane);
        wave_lds_fence();
        float la[16], lb[16];
#pragma unroll
        for (int p = 0; p < 16; ++p) { la[p] = funkey(Ka[p] & ~127u); lb[p] = funkey(Kb[p] & ~127u);
            buf[lane * 33 + p] = __int_as_float(127 - (int)(Ka[p] & 127u)); buf[lane * 33 + 16 + p] = __int_as_float(127 - (int)(Kb[p] & 127u)); }
        wave_lds_fence();
        unsigned Kc[16];
#pragma unroll
        for (int p = 0; p < 16; ++p) Kc[p] = 0u;
#pragma unroll
        for (int r1 = 0; r1 < 16; ++r1)
#pragma unroll
            for (int r2 = 0; r2 < 16; ++r2) if ((r1 + 1) * (r2 + 1) <= 16) kins16(Kc, (fkey(la[r1] + lb[r2]) & ~255u) | (unsigned)(255 - (16 * r1 + r2)));
        float bv[16], sm = 0.f; unsigned idx[16];
#pragma unroll
        for (int p = 0; p < 16; ++p) { const int code = 255 - (int)(Kc[p] & 255u); bv[p] = funkey(Kc[p] & ~255u);
            idx[p] = (unsigned)(__float_as_int(buf[lane * 33 + (code >> 4)]) * 128 + __float_as_int(buf[lane * 33 + 16 + (code & 15)])); }
        const float bmax = bv[0];
#pragma unroll
        for (int p = 0; p < 16; ++p) { bv[p] = __expf(bv[p] - bmax); sm += bv[p]; }
        const float inv = 1.f / sm;
        const size_t o = ((size_t)(t0 + lane) * 8 + h) * 16;
#pragma unroll
        for (int q = 0; q < 4; ++q) { *(f32x4*)(PG + o + q * 4) = (f32x4){bv[q * 4] * inv, bv[q * 4 + 1] * inv, bv[q * 4 + 2] * inv, bv[q * 4 + 3] * inv};
            *(u32x4*)(PIDX + o + q * 4) = (u32x4){idx[q * 4], idx[q * 4 + 1], idx[q * 4 + 2], idx[q * 4 + 3]}; }
    }
}
__device__ __forceinline__ bool ctx_sel_hidden(const Ctx& F) { return F.G == 256; }
__device__ __forceinline__ void peer_select_phase(const Ctx& F, int layer, int m_rows) {
    const int nunits = ((ctx_sel_hidden(F) ? TL : m_rows) / 64) * 8;
#pragma unroll 1
    for (int u = F.vcu * 8 + F.wid; u < nunits; u += F.G * 8) peer_select_unit(F, layer, u);
}

__device__ __forceinline__ float gelu_tanh(float a) { const float u = 0.7978845608028654f * (a + 0.044715f * a * a * a); const float t = 1.f - 2.f / (1.f + __expf(2.f * u)); return 0.5f * a * (1.f + t); }
struct Row6 { u32x2 r[3]; };
__device__ __forceinline__ void ld_row6(Row6& R, const unsigned char* tab, int e, int lane) {
    const u32x2* rp = (const u32x2*)(tab + (size_t)e * EROW + (unsigned)lane * 24u);
    R.r[0] = rp[0]; R.r[1] = rp[1]; R.r[2] = rp[2];
}
__device__ __forceinline__ v32f dq_row6(const Row6& R, float dep) { unsigned r0 = R.r[0].x; asm volatile("" : "+v"(r0) : "v"(dep));
    const v6u w = {r0, R.r[0].y, R.r[1].x, R.r[1].y, R.r[2].x, R.r[2].y}; return __builtin_amdgcn_cvt_scalef32_pk32_f32_fp6(w, 1.0f); }
__device__ __forceinline__ float dot_row6(const Row6& R, const float (&h)[32], float& chain) {
    const v32f f = dq_row6(R, chain);
    typedef float f2_t __attribute__((ext_vector_type(2)));
    f2_t a = {0.f, 0.f}, b = {0.f, 0.f};
#pragma unroll
    for (int i = 0; i < 8; ++i) { a = __builtin_elementwise_fma((f2_t){f[i * 4 + 0], f[i * 4 + 1]}, (f2_t){h[i * 4 + 0], h[i * 4 + 1]}, a);
                                  b = __builtin_elementwise_fma((f2_t){f[i * 4 + 2], f[i * 4 + 3]}, (f2_t){h[i * 4 + 2], h[i * 4 + 3]}, b); }
    const float s = (a[0] + a[1]) + (b[0] + b[1]);
    chain = s;
    return s;
}
__device__ __forceinline__ void fma_row6(float (&out)[32], const Row6& R, float w) {
    const v32f f = dq_row6(R, out[0]);
#pragma unroll
    for (int i = 0; i < 32; ++i) out[i] = fmaf(w, f[i], out[i]);
}
__device__ __forceinline__ float reduce4(float s0, float s1, float s2, float s3, int lane) {
    const bool hi = (lane & 32) != 0, b4 = (lane & 16) != 0;
    const float r0 = xor32_partner(hi ? s0 : s2, lane), r1 = xor32_partner(hi ? s1 : s3, lane);
    const float a0 = (hi ? s2 : s0) + r0, a1 = (hi ? s3 : s1) + r1;
    const float r = swz_xor<16>(b4 ? a0 : a1);
    float b = (b4 ? a1 : a0) + r;
    b += swz_xor<8>(b); b += swz_xor<4>(b); b += swz_xor<2>(b); b += swz_xor<1>(b);
    return b;
}
__device__ __forceinline__ float rl_f(float v, int l) { return __uint_as_float(__builtin_amdgcn_readlane(__float_as_uint(v), l)); }
__device__ __forceinline__ void wr_lane(float& dst, float val_uniform, int lane_uniform, int lane) { asm volatile("" : "+s"(lane_uniform)); dst = (lane == lane_uniform) ? val_uniform : dst; }
__device__ __forceinline__ void peer_expert_tokens(const Ctx& F, CParams& P, int layer, int m_rows_all, bool last, bool dry, bool hide, unsigned* selflag, int k_lo, int k_hi) {
    const unsigned char* EU = F.ws + WS_EU + (size_t)layer * NEXP * EROW; const unsigned char* EV = F.ws + WS_EV + (size_t)layer * NEXP * EROW;
    const float* SU = (const float*)(F.ws + WS_SU) + (size_t)layer * NEXP; const float* SV = (const float*)(F.ws + WS_SV) + (size_t)layer * NEXP;
    const bf16_t* H = (const bf16_t*)(F.ws + WS_H); float* X = (float*)(F.ws + WS_X);
    const int* PIDX = (const int*)(F.ws + WS_PIDX); const float* PG = (const float*)(F.ws + WS_PG);
    const float* mod = (const float*)(F.ws + WS_MOD) + (size_t)layer * 3 * 12288;
    const int lane = fresh_lane();
    const int tstride = F.G * 8, t0 = F.vcu * 8 + F.wid + k_lo * tstride;
    const int m_hi = F.vcu * 8 + F.wid + k_hi * tstride, m_rows = m_hi < m_rows_all ? m_hi : m_rows_all;
    if (t0 >= m_rows) return;
    int id0 = PIDX[(size_t)t0 * 128 + lane], id1 = PIDX[(size_t)t0 * 128 + 64 + lane];
    u32x4 hp4[4]; float gk0, gk1;
    { const u32x4* hp = (const u32x4*)(H + (size_t)t0 * DM + (unsigned)lane * 32u);
#pragma unroll
      for (int j = 0; j < 4; ++j) hp4[j] = hp[j]; }
    gk0 = PG[(size_t)t0 * 128 + lane]; gk1 = PG[(size_t)t0 * 128 + 64 + lane];
    Row6 A[4], B[4];
#pragma unroll
    for (int q = 0; q < 4; ++q) ld_row6(A[q], EU, __builtin_amdgcn_readlane(id0, q), lane);
    for (int t = t0; t < m_rows; t += tstride) {
        const int tn = t + tstride; const int tq = tn < m_rows ? tn : t;
        float hf[32];
#pragma unroll
        for (int j = 0; j < 4; ++j)
#pragma unroll
            for (int q = 0; q < 4; ++q) { hf[j * 8 + q * 2] = bf_lo(hp4[j][q]); hf[j * 8 + q * 2 + 1] = bf_hi(hp4[j][q]); }
        const float cgk0 = gk0, cgk1 = gk1;
        const float su0 = SU[id0], sv0 = SV[id0], su1 = SU[id1], sv1 = SV[id1];
        int nid0, nid1; float ngk0, ngk1;
        if (hide && tq >= TL) {
            { unsigned sp = 0u; while (xb_ld(selflag) < (unsigned)((TT - TL) / 64 * 8)) { __builtin_amdgcn_s_sleep(1); if (++sp > XB_SPIN_CAP) break; } }
            __builtin_amdgcn_fence(__ATOMIC_ACQUIRE, "agent");
            nid0 = __hip_atomic_load(PIDX + (size_t)tq * 128 + lane, __ATOMIC_RELAXED, __HIP_MEMORY_SCOPE_AGENT); nid1 = __hip_atomic_load(PIDX + (size_t)tq * 128 + 64 + lane, __ATOMIC_RELAXED, __HIP_MEMORY_SCOPE_AGENT);
            ngk0 = __int_as_float(__hip_atomic_load((const int*)PG + (size_t)tq * 128 + lane, __ATOMIC_RELAXED, __HIP_MEMORY_SCOPE_AGENT)); ngk1 = __int_as_float(__hip_atomic_load((const int*)PG + (size_t)tq * 128 + 64 + lane, __ATOMIC_RELAXED, __HIP_MEMORY_SCOPE_AGENT));
        } else { nid0 = PIDX[(size_t)tq * 128 + lane]; nid1 = PIDX[(size_t)tq * 128 + 64 + lane]; ngk0 = PG[(size_t)tq * 128 + lane]; ngk1 = PG[(size_t)tq * 128 + 64 + lane]; }
        { const u32x4* hp = (const u32x4*)(H + (size_t)tq * DM + (unsigned)lane * 32u);
#pragma unroll
          for (int j = 0; j < 4; ++j) hp4[j] = hp[j]; }
        gk0 = ngk0; gk1 = ngk1;
        float wv0 = 0.f, wv1 = 0.f;
        float out[32];
#pragma unroll
        for (int i = 0; i < 32; ++i) out[i] = 0.f;
#pragma unroll
        for (int seg = 0; seg < 4; ++seg) {
            const int idc = (seg & 1) ? id1 : id0;
            const int idn = (seg == 0) ? id1 : (seg == 1 ? id0 : (seg == 2 ? id1 : nid0));
            const unsigned char* tabc = seg < 2 ? EU : EV; const unsigned char* tabn = (seg == 0 || seg == 3) ? EU : EV;
            const float wr = (seg & 1) ? wv1 : wv0;
            float acc = 0.f, chain = 0.f;
#pragma unroll 1
            for (int k = 0; k < 64; k += 8) {
#pragma unroll
                for (int q = 0; q < 4; ++q) ld_row6(B[q], tabc, __builtin_amdgcn_readlane(idc, k + 4 + q), lane);
                if (seg < 2) { const float d0 = dot_row6(A[0], hf, chain), d1 = dot_row6(A[1], hf, chain), d2 = dot_row6(A[2], hf, chain), d3 = dot_row6(A[3], hf, chain); const float b = reduce4(d0, d1, d2, d3, lane);
#pragma unroll
                    for (int q = 0; q < 4; ++q) wr_lane(acc, rl_f(b, 16 * q), k + q, lane); }
                else {
#pragma unroll
                    for (int q = 0; q < 4; ++q) fma_row6(out, A[q], rl_f(wr, k + q)); }
                { const bool nx = k + 8 >= 64;
#pragma unroll
                  for (int q = 0; q < 4; ++q) { const int ec = __builtin_amdgcn_readlane(idc, (k + 8 + q) & 63), en = __builtin_amdgcn_readlane(idn, q);
                      ld_row6(A[q], nx ? tabn : tabc, nx ? en : ec, lane); } }
                if (seg < 2) { const float d0 = dot_row6(B[0], hf, chain), d1 = dot_row6(B[1], hf, chain), d2 = dot_row6(B[2], hf, chain), d3 = dot_row6(B[3], hf, chain); const float b = reduce4(d0, d1, d2, d3, lane);
#pragma unroll
                    for (int q = 0; q < 4; ++q) wr_lane(acc, rl_f(b, 16 * q), k + 4 + q, lane); }
                else {
#pragma unroll
                    for (int q = 0; q < 4; ++q) fma_row6(out, B[q], rl_f(wr, k + 4 + q)); }
            }
            if (seg == 0) wv0 = cgk0 * gelu_tanh(acc * su0) * sv0;
            if (seg == 1) wv1 = cgk1 * gelu_tanh(acc * su1) * sv1;
        }
        id0 = nid0; id1 = nid1;
        const int vs = vsel_of_row(t);
        const float* gate = mod + (size_t)vs * 12288 + 5 * DM;
        float* xr = X + (size_t)t * DM; float* dst = dry ? (float*)(F.ws + WS_OF) + (size_t)t * DM : (last ? P.out + (size_t)t * DM : xr);
        float ssq = 0.f;
        const unsigned lo32 = (unsigned)lane * 32u;
        { f32x4 xo[8], gg[8];
#pragma unroll
          for (int q = 0; q < 8; ++q) { const unsigned c = lo32 + q * 4; xo[q] = *(const f32x4*)(xr + c); gg[q] = *(const f32x4*)(gate + c); }
#pragma unroll
          for (int q = 0; q < 8; ++q) { const unsigned c = lo32 + q * 4;
            f32x4 y; y[0] = xo[q][0] + gg[q][0] * out[q * 4 + 0]; y[1] = xo[q][1] + gg[q][1] * out[q * 4 + 1]; y[2] = xo[q][2] + gg[q][2] * out[q * 4 + 2]; y[3] = xo[q][3] + gg[q][3] * out[q * 4 + 3];
            *(f32x4*)(dst + c) = y;
            out[q * 4 + 0] = y[0]; out[q * 4 + 1] = y[1]; out[q * 4 + 2] = y[2]; out[q * 4 + 3] = y[3];
            ssq += y[0] * y[0] + y[1] * y[1] + y[2] * y[2] + y[3] * y[3]; } }
        if (!last && !dry) {
            const float rstd = rsqrtf(wave_sum(ssq) * (1.f / DM) + EPS);
            const float* gn = P.g_norm1 + (size_t)(layer + 1) * DM;
            const float* shf = mod + (size_t)3 * 12288 + (size_t)vs * 12288; const float* scl = shf + DM;
            bf16_t* hrow = (bf16_t*)(F.ws + WS_H) + (size_t)t * DM;
#pragma unroll
            for (int jh = 0; jh < 2; ++jh) { f32x4 g8[4], sc8[4], sh8[4];
#pragma unroll
                for (int i = 0; i < 4; ++i) { const unsigned c = lo32 + jh * 16 + i * 4; g8[i] = *(const f32x4*)(gn + c); sc8[i] = *(const f32x4*)(scl + c); sh8[i] = *(const f32x4*)(shf + c); }
#pragma unroll
                for (int jj = 0; jj < 2; ++jj) { const int j = jh * 2 + jj; u32x4 w;
#pragma unroll
                    for (int q = 0; q < 2; ++q) { const f32x4 g = g8[jj * 2 + q], sc = sc8[jj * 2 + q], sh = sh8[jj * 2 + q];
                        float y[4];
#pragma unroll
                        for (int e2 = 0; e2 < 4; ++e2) y[e2] = (out[j * 8 + q * 4 + e2] * rstd * g[e2]) * (1.f + sc[e2]) + sh[e2];
                        w[q * 2] = cvt_pk_bf16(y[0], y[1]); w[q * 2 + 1] = cvt_pk_bf16(y[2], y[3]); }
                    *(u32x4*)(hrow + lo32 + j * 8) = w; } }
        }
    }
}

__device__ __forceinline__ void ctl_wait(unsigned* c, unsigned want) { unsigned sp = 0u; while (xb_ld(c) < want) { __builtin_amdgcn_s_sleep(1); if (++sp > XB_SPIN_CAP) break; } }
__device__ __forceinline__ void peer_expert_phase(const Ctx& F, CParams& P, int layer, int m_rows, bool last, bool dry, LAS unsigned char* ldsl, const bf16_t* Wout) {
    const bool hide = ctx_sel_hidden(F) && m_rows > TL && !dry;
    unsigned* ctl = (unsigned*)(F.ws + WS_CTL) + 8192 + layer * 512;
    unsigned* selflag = ctl;
    int role = 0, ri = 0;
    if (hide && F.vcu >= 64) { const int d = F.vcu - 64;
        if (d % 12 == 0) { role = 1; ri = d / 12; } else if (d % 12 == 6) { role = 2; ri = d / 12; } else if (d % 3 == 1 && F.wid == 0) { role = 3; ri = d / 3; } }
    const int ksplit = role == 1 ? 0 : (role == 2 ? 1 : (role == 3 ? 2 : 9));
#pragma unroll 1
    for (int st = 0; st < 2; ++st) {
        const int kb = st == 0 ? 0 : ksplit, ke = st == 0 ? ksplit : 9;
        if (ke > kb) peer_expert_tokens(F, P, layer, m_rows, last, dry, hide, selflag, kb, ke);
        if (st != 0 || role == 0) continue;
        const int pmi = ri >> 3, pn = ri & 7, pm = TL / 256 + pmi;
        if (role == 1) {
            { pg8::Gemm g{(const bf16_t*)(F.ws + WS_AO), Wout, TT, DM, DM, DM}; pg8::OneUnit S{pm, pn};
              pg8::EpiResid E{(float*)(F.ws + WS_X), (const float*)(F.ws + WS_MOD) + (size_t)layer * 3 * 12288, 2, layer == 0 ? P.x : (const float*)(F.ws + WS_X), layer == 0 ? P.ctx : (const float*)(F.ws + WS_X) + (size_t)TL * DM};
              pg8::gemm_phase<pg8::EpiResid, pg8::OneUnit>(ldsl, g, S, E, F.wid); }
            asm volatile("s_waitcnt vmcnt(0)" ::: "memory"); __syncthreads();
            if (F.wid == 0 && fresh_lane() == 0) { __builtin_amdgcn_fence(__ATOMIC_RELEASE, "agent"); asm volatile("s_waitcnt vmcnt(0)" ::: "memory"); (void)xb_add(ctl + 64 + 64 * pmi, 1u);
                           ctl_wait(ctl + 64 + 64 * pmi, 8u); __builtin_amdgcn_fence(__ATOMIC_ACQUIRE, "agent"); }
            __syncthreads();
            { const int r0 = pm * 256 + pn * 32 + F.wid * 4; norm_rows(F, P, layer, 1, r0, r0 + 4, 1); }
            asm volatile("s_waitcnt vmcnt(0)" ::: "memory"); __syncthreads();
            if (F.wid == 0 && fresh_lane() == 0) { __builtin_amdgcn_fence(__ATOMIC_RELEASE, "agent"); asm volatile("s_waitcnt vmcnt(0)" ::: "memory"); (void)xb_add(ctl + 192 + 64 * pmi, 1u); }
        } else if (role == 2) {
            __syncthreads();
            if (F.wid == 0 && fresh_lane() == 0) { ctl_wait(ctl + 192 + 64 * pmi, 8u); __builtin_amdgcn_fence(__ATOMIC_ACQUIRE, "agent"); }
            __syncthreads();
            { pg8::Gemm g{(const bf16_t*)(F.ws + WS_H), (const bf16_t*)(F.ws + WS_WPQ) + (size_t)layer * DM * DM, TT, DM, DM, DM}; pg8::OneUnit S{pm, pn};
              pg8::EpiBf16 E{(bf16_t*)(F.ws + WS_PQ), DM};
              pg8::gemm_phase<pg8::EpiBf16, pg8::OneUnit>(ldsl, g, S, E, F.wid); }
            asm volatile("s_waitcnt vmcnt(0)" ::: "memory"); __syncthreads();
            if (F.wid == 0 && fresh_lane() == 0) { __builtin_amdgcn_fence(__ATOMIC_RELEASE, "agent"); asm volatile("s_waitcnt vmcnt(0)" ::: "memory"); (void)xb_add(ctl + 320, 1u); }
        } else {
            ctl_wait(ctl + 320, 16u); __builtin_amdgcn_fence(__ATOMIC_ACQUIRE, "agent");
            peer_select_unit(F, layer, (TL / 64) * 8 + ri);
            __builtin_amdgcn_fence(__ATOMIC_RELEASE, "agent");
            asm volatile("s_waitcnt vmcnt(0)" ::: "memory");
            if (fresh_lane() == 0) (void)xb_add(selflag, 1u);
        }
    }
}

__device__ __forceinline__ void qkv_odd_phase(const Ctx& F, CParams& P, int e, int layer, LAS unsigned char* ldsl) {
    if (!ctx_sel_hidden(F)) { qkv_odd_rows(F, P, e, F.vcu * 8 + F.wid, TT, F.G * 8); return; }
    const int vx = F.vcu & 31, xq = F.vcu >> 5;
    if (vx >= 29) {
        const int i = xq * 3 + vx - 29, pmi = i / 12, pn = i % 12;
        unsigned* cnt = (unsigned*)(F.ws + WS_CTL) + 8192 + layer * 512 + 384 + 64 * pmi;
        { pg8::Gemm g{(const bf16_t*)(F.ws + WS_H), (const bf16_t*)(F.ws + WS_WINC) + (size_t)e * C_IN * DM, TT, C_IN, DM, DM}; pg8::OneUnit S{TL / 256 + pmi, pn};
          pg8::EpiBf16V E{(bf16_t*)(F.ws + WS_P1), C_IN, (bf16_t*)(F.ws + WS_V1), 10, 512};
          pg8::gemm_phase<pg8::EpiBf16V, pg8::OneUnit>(ldsl, g, S, E, F.wid); }
        asm volatile("s_waitcnt vmcnt(0)" ::: "memory"); __syncthreads();
        if (F.wid == 0 && fresh_lane() == 0) { __builtin_amdgcn_fence(__ATOMIC_RELEASE, "agent"); asm volatile("s_waitcnt vmcnt(0)" ::: "memory"); (void)xb_add(cnt, 1u);
                                               ctl_wait(cnt, 12u); __builtin_amdgcn_fence(__ATOMIC_ACQUIRE, "agent"); }
        __syncthreads();
        qkv_odd_rows(F, P, e, TL + pmi * 256 + pn * 8 + F.wid, TL + pmi * 256 + 256, 96);
    } else qkv_odd_rows(F, P, e, (F.vcu - 3 * xq) * 8 + F.wid, TL, 232 * 8);
}

constexpr int N_PHASES = 1 + 2 * 11 + 2 * 9 - 3;
__global__ void __launch_bounds__(512, 2) mk_fwd(Params Pval) {
    extern __shared__ __attribute__((aligned(16))) unsigned char lds_raw[];
    LAS unsigned char* ldsl = (LAS unsigned char*)lds_raw;
    volatile LAS unsigned* misc = (volatile LAS unsigned*)(ldsl + LDS_MISC);
    if (threadIdx.x < 16) misc[threadIdx.x] = 0u;
    __syncthreads();
    XcdBarrier bar = xcd_barrier_post((unsigned*)(Pval.ws + WS_CTL) + 1024, misc);
    const int wid0 = __builtin_amdgcn_readfirstlane((int)threadIdx.x >> 6);
    const int lo = Pval.ph_lo, hi = Pval.ph_hi; int ph = 0;
#define MKCTX() Ctx F; { const int lane_ = fresh_lane(); int wid_ = wid0; asm volatile("" : "+s"(wid_)); const int tid_ = wid_ * 64 + lane_; F.tid = tid_; F.lane = lane_; F.wid = wid_; \
        int G_ = gridDim.x, bx_ = blockIdx.x; asm volatile("" : "+s"(G_), "+s"(bx_)); F.G = G_; F.vcu = (G_ % 8 == 0) ? (bx_ % 8) * (G_ / 8) + bx_ / 8 : bx_; F.bx = bx_; } \
        unsigned long long kp_ = (unsigned long long)__builtin_amdgcn_kernarg_segment_ptr(); asm volatile("" : "+s"(kp_)); CParams& P = *(CParams*)kp_; \
        F.ws = P.ws; F.lds = (char*)lds_raw; unsigned char* ws = F.ws; (void)ws; \
        bf16_t* Hb = (bf16_t*)(ws + WS_H); bf16_t* P1 = (bf16_t*)(ws + WS_P1); float* X = (float*)(ws + WS_X); const float* mod = (const float*)(ws + WS_MOD); (void)Hb; (void)P1; (void)X; (void)mod;
#define PHASE(cls, ...) do { if (ph >= lo && ph < hi) { if constexpr ((PH_MASK >> (cls)) & 1u) { \
        if constexpr ((PH_DOUBLE >> (cls)) & 1u) { const bool dry = true; (void)dry; MKCTX(); __VA_ARGS__; __syncthreads(); } \
        { const bool dry = false; (void)dry; MKCTX(); __VA_ARGS__; } } if (ph + 1 < hi) { int w0_ = wid0; asm volatile("" : "+s"(w0_)); xcd_barrier(bar, w0_ == 0 && fresh_lane() == 0); } } ++ph; } while (0)

    PHASE(0, prologue_phase(F, P));
#pragma unroll 1
    for (int layer = 0; layer < DEPTH; ++layer) {
        const int e = layer >> 1; const bool even = (layer & 1) == 0, lastl = layer == DEPTH - 1;
        const int m_post = lastl ? TL : TT;
        if (layer == 0) PHASE(1, norm_phase(F, P, layer, 0, TT));
        PHASE(2, { const bf16_t* W = even ? (const bf16_t*)(ws + WS_WINAB) + (size_t)e * AB_INP * DM : (const bf16_t*)(ws + WS_WINC) + (size_t)e * C_IN * DM;
                const int N = even ? AB_INP : C_IN;
                const int m2 = (!even && ctx_sel_hidden(F)) ? TL : TT;
                pg8::Gemm g{Hb, W, m2, N, DM, DM}; pg8::StaticOrder S; S.init(m2, N, F.G, F.bx);
                pg8::EpiBf16V E{P1, N, even ? (bf16_t*)(ws + WS_V2) : (bf16_t*)(ws + WS_V1), even ? 14 : 10, even ? 1024 : 512};
                pg8::gemm_phase<pg8::EpiBf16V, pg8::StaticOrder>(ldsl, g, S, E, F.wid); });
        if (even) {
            PHASE(3, { { pg8::Gemm g{P1, (const bf16_t*)(ws + WS_WUQ) + (size_t)e * 1536 * 768, TT, 1536, 768, AB_INP}; pg8::StaticOrder S; S.init(TT, 1536, F.G, F.bx);
                      pg8::EpiBf16 E{(bf16_t*)(ws + WS_QA), 1536};
                      pg8::gemm_phase<pg8::EpiBf16, pg8::StaticOrder>(ldsl, g, S, E, F.wid); }
                    { pg8::Gemm g{P1 + 768, (const bf16_t*)(ws + WS_WUKV) + (size_t)e * 2048 * 512, TT, 2048, 512, AB_INP}; pg8::StaticOrder S; S.init(TT, 2048, F.G, F.G - 1 - F.bx);
                      pg8::EpiBf16 E{(bf16_t*)(ws + WS_KV), 2048};
                      pg8::gemm_phase<pg8::EpiBf16, pg8::StaticOrder>(ldsl, g, S, E, F.wid); } });
            PHASE(4, qkv_even_phase(F, P, e));
            PHASE(5, { if constexpr (ATT_DBL & 1) attn_phase<192, MLA_SD, 2048, 8, 8, 8>(F, (const bf16_t*)(ws + WS_Q1), (const bf16_t*)(ws + WS_K1), (const bf16_t*)(ws + WS_V1), (bf16_t*)(ws + WS_AO), 0, !lastl, ((const float*)(ws + WS_LAM))[4 + layer * 2]);
                    if constexpr (ATT_DBL & 2) attn_phase<64, 2, 2048, 16, 16, 8>(F, (const bf16_t*)(ws + WS_Q2), (const bf16_t*)(ws + WS_K2), (const bf16_t*)(ws + WS_V2), (bf16_t*)(ws + WS_OF), 0, !lastl, ((const float*)(ws + WS_LAM))[4 + layer * 2 + 1]);
                    if constexpr (ATT_SEL & 1) attn_phase<192, MLA_SD, 2048, 8, 8, 8>(F, (const bf16_t*)(ws + WS_Q1), (const bf16_t*)(ws + WS_K1), (const bf16_t*)(ws + WS_V1), (bf16_t*)(ws + WS_AO), 0, !lastl, ((const float*)(ws + WS_LAM))[4 + layer * 2]);
                    if constexpr (ATT_SEL & 2) attn_phase<64, 2, 2048, 16, 16, 8>(F, (const bf16_t*)(ws + WS_Q2), (const bf16_t*)(ws + WS_K2), (const bf16_t*)(ws + WS_V2), (bf16_t*)(ws + WS_OF), 0, !lastl, ((const float*)(ws + WS_LAM))[4 + layer * 2 + 1]); });
            PHASE(6, merge_even_phase(F, P, e, layer, m_post));
        } else {
            PHASE(7, qkv_odd_phase(F, P, e, layer, ldsl));
            PHASE(8, attn_phase<128, GQA_SD, 2048, 16, 4, 4>(F, (const bf16_t*)(ws + WS_Q1), (const bf16_t*)(ws + WS_K1), (const bf16_t*)(ws + WS_V1), (bf16_t*)(ws + WS_AO), 0, !lastl, ((const float*)(ws + WS_LAM))[4 + layer * 2]));
        }
        PHASE(10, { const bf16_t* W = even ? (const bf16_t*)(ws + WS_WOUTAB) + (size_t)e * DM * DM : (const bf16_t*)(ws + WS_WOUTC) + (size_t)e * DM * DM;
                const int m10 = ctx_sel_hidden(F) ? TL : m_post; pg8::Gemm g{(const bf16_t*)(ws + WS_AO), W, m10, DM, DM, DM}; pg8::StaticOrder S; S.init(m10, DM, F.G, F.bx);
                pg8::EpiResid E{X, mod + (size_t)layer * 3 * 12288, 2, layer == 0 ? P.x : (const float*)X, layer == 0 ? P.ctx : (const float*)X + (size_t)TL * DM};
                pg8::gemm_phase<pg8::EpiResid, pg8::StaticOrder>(ldsl, g, S, E, F.wid); });
        PHASE(1, norm_phase(F, P, layer, 1, ctx_sel_hidden(F) ? TL : m_post));
        PHASE(11, { const int m11 = ctx_sel_hidden(F) ? TL : m_post; pg8::Gemm g{Hb, (const bf16_t*)(ws + WS_WPQ) + (size_t)layer * DM * DM, m11, DM, DM, DM}; pg8::StaticOrder S; S.init(m11, DM, F.G, F.bx);
                pg8::EpiBf16 E{(bf16_t*)(ws + WS_PQ), DM};
                pg8::gemm_phase<pg8::EpiBf16, pg8::StaticOrder>(ldsl, g, S, E, F.wid); });
        PHASE(12, peer_select_phase(F, layer, m_post));
        PHASE(13, { const bf16_t* W = even ? (const bf16_t*)(ws + WS_WOUTAB) + (size_t)e * DM * DM : (const bf16_t*)(ws + WS_WOUTC) + (size_t)e * DM * DM;
                peer_expert_phase(F, P, layer, m_post, lastl, dry, ldsl, W); });
    }
#undef PHASE
}

extern "C" void kernel_launch(void* const* d_in, const int* in_sizes, int n_in, void* d_out, int out_size, void* d_ws, size_t ws_size, hipStream_t stream) {
    static int grid = 0;
    if (grid == 0) {
        if (n_in != 28 || ws_size < WS_END) { fprintf(stderr, "kernel_launch: expected 28 inputs and >= %zu bytes of workspace, got %d / %zu\n", (size_t)WS_END, n_in, ws_size); grid = -1; return; }
        int dev = 0, cus = 0, per_cu = 0;
        if (hipGetDevice(&dev) != hipSuccess || hipDeviceGetAttribute(&cus, hipDeviceAttributeMultiprocessorCount, dev) != hipSuccess) { grid = -1; return; }
        if (hipFuncSetAttribute((const void*)mk_fwd, hipFuncAttributeMaxDynamicSharedMemorySize, LDS_BYTES) != hipSuccess) { fprintf(stderr, "kernel_launch: hipFuncSetAttribute failed\n"); grid = -1; return; }
        if (hipOccupancyMaxActiveBlocksPerMultiprocessor(&per_cu, (const void*)mk_fwd, 512, LDS_BYTES) != hipSuccess || per_cu < 1) fprintf(stderr, "kernel_launch: occupancy query says %d\n", per_cu);
        (void)hipGetLastError();
        grid = cus;
    }
    if (grid < 0) return;
    (void)hipMemsetAsync((char*)d_ws + WS_CTL, 0, CTL_BYTES, stream);
    Params p{};
    const float** pf = (const float**)&p;
    for (int i = 0; i < 28; ++i) pf[i] = (const float*)d_in[i];
    p.out = (float*)d_out; p.ws = (unsigned char*)d_ws;
#if MK_PER_PHASE_LAUNCH
    for (int i = 0; i < N_PHASES; ++i) { p.ph_lo = i; p.ph_hi = i + 1; hipLaunchKernelGGL(mk_fwd, dim3(grid), dim3(512), LDS_BYTES, stream, p); }
#else
    p.ph_lo = 0; p.ph_hi = N_PHASES;
    hipLaunchKernelGGL(mk_fwd, dim3(grid), dim3(512), LDS_BYTES, stream, p);
#endif
    const hipError_t le = hipPeekAtLastError();
    if (le != hipSuccess) fprintf(stderr, "kernel_launch: launch failed: %s\n", hipGetErrorName(le));
}
```

```cpp
#include <hip/hip_runtime.h>
#include <stdint.h>
#include <stdio.h>

#ifndef MK_PER_PHASE_LAUNCH
#define MK_PER_PHASE_LAUNCH 0
#endif

#ifndef MLA_QL
#define MLA_QL 0
#endif
#ifndef GQA_QL
#define GQA_QL 0
#endif
#ifndef QKT_GRP
#define QKT_GRP 12
#endif
#ifndef EB
#define EB 4
#endif
#ifndef PV_PIPE
#define PV_PIPE 0
#endif
#ifndef ATT_DBL
#define ATT_DBL 0
#endif
#ifndef ATT_PRIO
#define ATT_PRIO 1
#endif
#ifndef MLA_SD
#define MLA_SD 1
#endif
#ifndef GQA_SD
#define GQA_SD 2
#endif
#ifndef ATT_SEL
#define ATT_SEL 3
#endif
#ifndef PH_DOUBLE
#define PH_DOUBLE 0u
#endif
#ifndef PH_MASK
#define PH_MASK 0xFFFFFFFFu
#endif
#define LAS __attribute__((address_space(3)))
typedef unsigned short bf16_t;
typedef short bf16x8 __attribute__((ext_vector_type(8)));
typedef short s16x4 __attribute__((ext_vector_type(4)));
typedef float f32x4 __attribute__((ext_vector_type(4)));
typedef float f32x2 __attribute__((ext_vector_type(2)));
typedef float f32x16 __attribute__((ext_vector_type(16)));
typedef unsigned u32x4 __attribute__((ext_vector_type(4)));
typedef unsigned u32x2 __attribute__((ext_vector_type(2)));
typedef __bf16 bf16x2_t __attribute__((ext_vector_type(2)));

constexpr int DM = 2048, NB = 2, SEQ = 8192, DEPTH = 4, CTXL = 256;
constexpr int TL = NB * SEQ;
constexpr int TZ = NB * CTXL;
constexpr int TT = TL + TZ;
constexpr int KPB = SEQ + CTXL;
constexpr int AB_IN = 4416, AB_INP = 4608;
constexpr int C_IN = 3072;
constexpr int NEXP = 16384;
constexpr float EPS = 1e-6f;
constexpr float LOG2E = 1.4426950408889634f;

constexpr size_t al256(size_t x) { return (x + 255) / 256 * 256; }
constexpr size_t WS_CTL = 0, CTL_BYTES = 1u << 20;
constexpr size_t WS_MOD = WS_CTL + CTL_BYTES;
constexpr size_t WS_TAB16 = WS_MOD + al256((size_t)4 * 3 * 12288 * 4);
constexpr size_t WS_TAB32 = WS_TAB16 + al256((size_t)128 * 16 * 2 * 4);
constexpr size_t WS_LAM = WS_TAB32 + al256((size_t)128 * 32 * 2 * 4);
constexpr size_t WS_WINAB = WS_LAM + 256;
constexpr size_t WS_WUQ = WS_WINAB + (size_t)2 * AB_INP * DM * 2;
constexpr size_t WS_WUKV = WS_WUQ + (size_t)2 * 1536 * 768 * 2;
constexpr size_t WS_WOUTAB = WS_WUKV + (size_t)2 * 2048 * 512 * 2;
constexpr size_t WS_WINC = WS_WOUTAB + (size_t)2 * DM * DM * 2;
constexpr size_t WS_WOUTC = WS_WINC + (size_t)2 * C_IN * DM * 2;
constexpr size_t WS_WPQ = WS_WOUTC + (size_t)2 * DM * DM * 2;
constexpr size_t WS_SUBK = WS_WPQ + (size_t)4 * DM * DM * 2;
constexpr size_t WS_EU = WS_SUBK + (size_t)4 * 8 * 2 * 128 * 128 * 2;
constexpr int EROW = DM * 6 / 8;
constexpr size_t WS_EV = WS_EU + (size_t)4 * NEXP * DM;
constexpr size_t WS_SU = WS_EV + (size_t)4 * NEXP * DM;
constexpr size_t WS_SV = WS_SU + (size_t)4 * NEXP * 4;
constexpr size_t WS_X = WS_SV + (size_t)4 * NEXP * 4;
constexpr size_t WS_H = WS_X + (size_t)TT * DM * 4;
constexpr size_t WS_P1 = WS_H + (size_t)TT * DM * 2;
constexpr size_t WS_QA = WS_P1 + (size_t)TT * AB_INP * 2;
constexpr size_t WS_KV = WS_QA + (size_t)TT * 1536 * 2;
constexpr size_t WS_Q1 = WS_KV + (size_t)TT * 2048 * 2;
constexpr size_t WS_K1 = WS_Q1 + (size_t)TT * 2048 * 2;
constexpr size_t WS_V1 = WS_K1 + (size_t)TT * 1536 * 2;
constexpr size_t WS_Q2 = WS_V1 + (size_t)TT * 1024 * 2;
constexpr size_t WS_K2 = WS_Q2 + (size_t)TT * 1024 * 2;
constexpr size_t WS_V2 = WS_K2 + (size_t)TT * 1024 * 2;
constexpr size_t WS_OF = WS_V2 + (size_t)TT * 1024 * 2;
constexpr size_t WS_AO = WS_OF + (size_t)TT * 3072 * 4;
constexpr size_t WS_PQ = WS_AO + (size_t)TT * DM * 2;
constexpr size_t WS_PIDX = WS_PQ + (size_t)TT * DM * 2;
constexpr size_t WS_PG = WS_PIDX + (size_t)TT * 128 * 4;
constexpr size_t WS_END = WS_PG + (size_t)TT * 128 * 4;

constexpr int LDS_MAIN = 157696;
constexpr int LDS_MISC = LDS_MAIN;
constexpr int LDS_BYTES = LDS_MAIN + 4096;

__device__ __forceinline__ unsigned cvt_pk_bf16(float lo, float hi) { unsigned r; asm("v_cvt_pk_bf16_f32 %0, %1, %2" : "=v"(r) : "v"(lo), "v"(hi)); return r; }
__device__ __forceinline__ float bf_lo(unsigned w) { return __uint_as_float(w << 16); }
__device__ __forceinline__ float bf_hi(unsigned w) { return __uint_as_float(w & 0xffff0000u); }
template <int M> __device__ __forceinline__ float swz_xor(float v) { return __int_as_float(__builtin_amdgcn_ds_swizzle(__float_as_int(v), (M << 10) | 0x1f)); }
__device__ __forceinline__ float xor32_partner(float v, int lane) {
    const auto rr = __builtin_amdgcn_permlane32_swap(__float_as_uint(v), __float_as_uint(v), false, false);
    return __uint_as_float(lane < 32 ? rr[1] : rr[0]);
}
__device__ __forceinline__ float hw_sum(float v) {
    v += swz_xor<16>(v); v += swz_xor<8>(v); v += swz_xor<4>(v); v += swz_xor<2>(v); v += swz_xor<1>(v);
    return v;
}
__device__ __forceinline__ float wave_sum(float v) {
    v = hw_sum(v);
    const auto rr = __builtin_amdgcn_permlane32_swap(__float_as_uint(v), __float_as_uint(v), false, false);
    return __uint_as_float(rr[0]) + __uint_as_float(rr[1]);
}
__device__ __forceinline__ float wave_max(float v) {
    v = fmaxf(v, swz_xor<16>(v)); v = fmaxf(v, swz_xor<8>(v)); v = fmaxf(v, swz_xor<4>(v)); v = fmaxf(v, swz_xor<2>(v)); v = fmaxf(v, swz_xor<1>(v));
    const auto rr = __builtin_amdgcn_permlane32_swap(__float_as_uint(v), __float_as_uint(v), false, false);
    return fmaxf(__uint_as_float(rr[0]), __uint_as_float(rr[1]));
}
__device__ __forceinline__ int mbcnt64(unsigned long long m) { return (int)__builtin_amdgcn_mbcnt_hi((unsigned)(m >> 32), __builtin_amdgcn_mbcnt_lo((unsigned)m, 0u)); }
__device__ __forceinline__ int fresh_lane() { int l; asm volatile("v_mbcnt_lo_u32_b32 %0, -1, 0\n\tv_mbcnt_hi_u32_b32 %0, -1, %0" : "=v"(l)); return l; }
__device__ __forceinline__ int krow_of(int t) { return t < TL ? (t >> 13) * KPB + (t & (SEQ - 1)) : ((t - TL) >> 8) * KPB + SEQ + ((t - TL) & (CTXL - 1)); }
__device__ __forceinline__ int vsel_of_row(int t) { return t < SEQ ? 0 : (t < TL ? 1 : 2); }

#define XB_TMO      128
#define XB_XCNT(j)  (256  + 64 * (j))
#define XB_XSUB(j)  (1280 + 64 * (j))
#define XB_XGEN(j)  (2304 + 64 * (j))
#define XB_TOP      3328
#define XB_TOPGEN   3392
#define XCD_BAR_WORDS 3456
#define XB_SPIN_CAP (1u << 27)
__device__ __forceinline__ unsigned xb_ld(unsigned* p)              { return __hip_atomic_load(p, __ATOMIC_RELAXED, __HIP_MEMORY_SCOPE_AGENT); }
__device__ __forceinline__ unsigned xb_add(unsigned* p, unsigned v) { return __hip_atomic_fetch_add(p, v, __ATOMIC_RELAXED, __HIP_MEMORY_SCOPE_AGENT); }
__device__ __forceinline__ unsigned xb_xcc_id() { return (unsigned)__builtin_amdgcn_s_getreg((3 << 11) | 20) & 0xFu; }
#define XB_SPIN(cond, bar) do { unsigned _sp = 0; while (cond) { __builtin_amdgcn_s_sleep(1); \
    if ((++_sp & 255u) == 0u) { if (xb_ld(&(bar)[XB_TMO])) break; if (_sp > XB_SPIN_CAP) { atomicAdd(&(bar)[XB_TMO], 1u); break; } } } } while (0)
struct XcdBarrier { unsigned* bar; unsigned x; volatile LAS unsigned* st; };
__device__ __forceinline__ XcdBarrier xcd_barrier_post(unsigned* bar, volatile LAS unsigned* st) {
    XcdBarrier b; b.bar = bar; b.x = xb_xcc_id(); b.st = st;
    if (threadIdx.x == 0) (void)xb_add(&bar[XB_XCNT(b.x)], 1u);
    return b;
}
__device__ __forceinline__ void xcd_barrier_complete(unsigned* bar, unsigned x, unsigned& nloc, unsigned& nx) {
    asm volatile("" : "+s"(x));
    const unsigned G = gridDim.x * gridDim.y * gridDim.z;
    unsigned sum, cnt, mine, sp = 0u;
    for (;;) {
        sum = 0u; cnt = 0u; mine = 0u;
#pragma unroll
        for (unsigned j = 0; j < 16; ++j) { const unsigned c = xb_ld(&bar[XB_XCNT(j)]); sum += c; cnt += (c > 0u) ? 1u : 0u; mine = (j == x) ? c : mine; }
        if (sum == G) break;
        __builtin_amdgcn_s_sleep(1);
        if ((++sp & 255u) == 0u) { if (xb_ld(&bar[XB_TMO])) break; if (sp > XB_SPIN_CAP) { atomicAdd(&bar[XB_TMO], 1u); break; } }
    }
    nloc = mine > 0u ? mine : 1u; nx = cnt > 0u ? cnt : 1u;
}
__device__ __forceinline__ void xcd_barrier(const XcdBarrier& b, const bool thread0  ) {
    asm volatile("s_waitcnt vmcnt(0)" ::: "memory");
    __syncthreads();
    if (thread0) {
        unsigned* bar = b.bar;
        __builtin_amdgcn_s_waitcnt(0);
        unsigned nloc = b.st[0], nx = b.st[1];
        if (nloc == 0u) { xcd_barrier_complete(bar, b.x, nloc, nx); b.st[0] = nloc; b.st[1] = nx; }
        const unsigned old = xb_add(&bar[XB_XSUB(b.x)], 1u);
        const unsigned gen = old / nloc;
        if (old + 1u == (gen + 1u) * nloc) {
            __builtin_amdgcn_fence(__ATOMIC_RELEASE, "agent");
            asm volatile("s_waitcnt vmcnt(0)" ::: "memory");
            const unsigned og = xb_add(&bar[XB_TOP], 1u);
            const unsigned tg = og / nx;
            if (og + 1u == (tg + 1u) * nx) xb_add(&bar[XB_TOPGEN], 1u);
            else XB_SPIN(xb_ld(&bar[XB_TOPGEN]) == tg, bar);
            __builtin_amdgcn_fence(__ATOMIC_ACQUIRE, "agent");
            xb_add(&bar[XB_XGEN(b.x)], 1u);
            asm volatile("s_waitcnt vmcnt(0)" ::: "memory");
        } else {
            XB_SPIN(xb_ld(&bar[XB_XGEN(b.x)]) == gen, bar);
            __builtin_amdgcn_fence(__ATOMIC_ACQUIRE, "agent");
            asm volatile("s_waitcnt vmcnt(0)" ::: "memory");
        }
    }
    __syncthreads();
}

namespace pg8 {
constexpr int BM = 256, BK = 64, HALF = 128, HTB = HALF * BK * 2, STAGE_BYTES = 8 * HTB, NXCD = 8, WGM = 8;
__host__ __device__ __forceinline__ int lds_byte(int r, int c) { const int st = (r >> 4) * 2 + (c >> 5), rr = r & 15, cc = c & 31, ob = rr * 64 + cc * 2; return st * 1024 + (ob ^ (((ob >> 9) & 1) << 5)); }
__host__ __device__ __forceinline__ void stage_rc(int b, int& R, int& C) { const int st = b / 1024, sb = b % 1024, swz = sb ^ (((sb >> 9) & 1) << 5); R = (st >> 1) * 16 + swz / 64; C = (st & 1) * 32 + (swz % 64) / 2; }
__host__ __device__ __forceinline__ int perm32(int rho) { const int n = rho >> 4, i = rho & 15; return 8 * (i >> 2) + 4 * n + (i & 3); }
struct Unit { int pm, pn; };
struct Gemm { const bf16_t* A; const bf16_t* Bt; int M, N, K, lda; };
struct StaticOrder {
    int nM, nN, nwg, G, c;
    __host__ __device__ void init(int M, int N, int G_, int c_) { nM = M / BM; nN = N / BM; nwg = nM * nN; G = G_; c = c_; }
    __host__ __device__ bool next(int i, Unit& u) const {
        const long L = (long)i * G + c; if (L >= nwg) return false;
        int wgid = (int)L; { const int q = nwg / NXCD, r = nwg % NXCD, xcd = wgid % NXCD, off = wgid / NXCD; wgid = (xcd < r ? xcd * (q + 1) : r * (q + 1) + (xcd - r) * q) + off; }
        const int nig = WGM * nN, gid = wgid / nig, fm = gid * WGM, gsz = (nM - fm) < WGM ? (nM - fm) : WGM;
        u.pm = fm + ((wgid % nig) % gsz); u.pn = (wgid % nig) / gsz; return true;
    }
    __device__ __forceinline__ void a_ready(const Unit&) const {}
    __device__ __forceinline__ void done(const Unit&) const {}
};
struct OneUnit {
    int pm, pn;
    __device__ bool next(int i, Unit& u) const { if (i != 0) return false; u.pm = pm; u.pn = pn; return true; }
    __device__ __forceinline__ void a_ready(const Unit&) const {}
    __device__ __forceinline__ void done(const Unit&) const {}
};
struct EpiBf16 {
    static constexpr bool PERM = true;
    bf16_t* O; int ldc;
    __device__ __forceinline__ void operator()(const f32x4 (&acc)[2][2][4][2], const Unit& u, int wr, int wc, int fr, int fq) const {
        const int row0 = u.pm * BM + wr * 64 + fr; const int col0 = u.pn * BM + wc * 32 + 8 * fq;
#pragma unroll
        for (int ai = 0; ai < 2; ++ai)
#pragma unroll
            for (int m = 0; m < 4; ++m) { bf16_t* rowp = O + (size_t)(row0 + ai * HALF + m * 16) * ldc + col0;
#pragma unroll
                for (int bj = 0; bj < 2; ++bj) { const f32x4 v0 = acc[ai][bj][m][0], v1 = acc[ai][bj][m][1];
                    u32x4 w; w.x = cvt_pk_bf16(v0[0], v0[1]); w.y = cvt_pk_bf16(v0[2], v0[3]); w.z = cvt_pk_bf16(v1[0], v1[1]); w.w = cvt_pk_bf16(v1[2], v1[3]);
                    *(u32x4*)(rowp + bj * HALF) = w; } }
    }
};
struct EpiBf16V {
    static constexpr bool PERM = true;
    bf16_t* O; int ldc; bf16_t* V; int vpn0, vld;
    __device__ __forceinline__ void operator()(const f32x4 (&acc)[2][2][4][2], const Unit& u, int wr, int wc, int fr, int fq) const {
        const int row0 = u.pm * BM + wr * 64 + fr; const int col0 = u.pn * BM + wc * 32 + 8 * fq;
        const bool tov = u.pn >= vpn0;
        const long delta = u.pm < 32 ? 0 : (u.pm < 64 ? KPB - SEQ : (u.pm == 64 ? SEQ - TL : KPB + SEQ - TL - CTXL));
        bf16_t* base = tov ? V + delta * vld - (long)vpn0 * BM : O; const int ld = tov ? vld : ldc;
#pragma unroll
        for (int ai = 0; ai < 2; ++ai)
#pragma unroll
            for (int m = 0; m < 4; ++m) { bf16_t* rowp = base + (size_t)(row0 + ai * HALF + m * 16) * ld + col0;
#pragma unroll
                for (int bj = 0; bj < 2; ++bj) { const f32x4 v0 = acc[ai][bj][m][0], v1 = acc[ai][bj][m][1];
                    u32x4 w; w.x = cvt_pk_bf16(v0[0], v0[1]); w.y = cvt_pk_bf16(v0[2], v0[3]); w.z = cvt_pk_bf16(v1[0], v1[1]); w.w = cvt_pk_bf16(v1[2], v1[3]);
                    *(u32x4*)(rowp + bj * HALF) = w; } }
    }
};
struct EpiResid {
    static constexpr bool PERM = false;
    float* X; const float* modl; int chunk;
    const float* Rlat; const float* Rctx;
    __device__ __forceinline__ void operator()(const f32x4 (&acc)[2][2][4][2], const Unit& u, int wr, int wc, int fr, int fq) const {
        const int row0 = u.pm * BM + wr * 64 + fr, col0 = u.pn * BM + wc * 32 + 4 * fq;
        const int vs = u.pm < 32 ? 0 : (u.pm < 64 ? 1 : 2);
        const float* gate = modl + (size_t)vs * 12288 + chunk * 2048 + col0;
        f32x4 gv[2][2];
#pragma unroll
        for (int bj = 0; bj < 2; ++bj)
#pragma unroll
            for (int n = 0; n < 2; ++n) gv[bj][n] = *(const f32x4*)(gate + bj * HALF + n * 16);
#pragma unroll
        for (int ai = 0; ai < 2; ++ai) {
            f32x4 xo[4][2][2];
#pragma unroll
            for (int m = 0; m < 4; ++m) { const int row = row0 + ai * HALF + m * 16;
                const float* srcp = (vs < 2 ? Rlat + (size_t)row * DM : Rctx + (size_t)(row - TL) * DM) + col0;
#pragma unroll
                for (int bj = 0; bj < 2; ++bj)
#pragma unroll
                    for (int n = 0; n < 2; ++n) xo[m][bj][n] = *(const f32x4*)(srcp + bj * HALF + n * 16); }
#pragma unroll
            for (int m = 0; m < 4; ++m) { const int row = row0 + ai * HALF + m * 16; float* rowp = X + (size_t)row * DM + col0;
#pragma unroll
                for (int bj = 0; bj < 2; ++bj)
#pragma unroll
                    for (int n = 0; n < 2; ++n) *(f32x4*)(rowp + bj * HALF + n * 16) = xo[m][bj][n] + gv[bj][n] * acc[ai][bj][m][n]; } }
    }
};

template <class Epi, class Sched>
__device__ __forceinline__ void gemm_phase(LAS unsigned char* lds, const Gemm g, const Sched& S, const Epi& E, int tid_in) {
    const int tid_l = tid_in * 64 + fresh_lane();
    const int tid = tid_l, wid = tid_in  , lane = tid & 63, wr = wid >> 2, wc = wid & 3, fr = lane & 15, fq = lane >> 4;
    const int K = g.K, nt = K / BK, lda = g.lda;
    unsigned voffA[2], voffB[2];
#pragma unroll
    for (int i = 0; i < 2; ++i) { int R, C; stage_rc(tid * 16 + i * 8192, R, C); const int Rb = Epi::PERM ? ((R & ~31) + perm32(R & 31)) : R;
        voffA[i] = (unsigned)(R * lda + C) * 2u; voffB[i] = (unsigned)(Rb * K + C) * 2u; }
    const size_t kstep = (size_t)(BK * 2);
    const size_t hstepA = (size_t)HALF * lda * 2, hstepB = (size_t)HALF * K * 2;
    const size_t tstepA = 2 * hstepA, tstepB = 2 * hstepB;
    const unsigned ldsw = (unsigned)wid * 1024u;
    const int aoff = lds_byte(wr * 64 + fr, fq * 8), boff = lds_byte(wc * 32 + fr, fq * 8);
#define PG8_SA(b, h) (((b) * 2 + (h)) * HTB)
#define PG8_SB(b, h) ((4 + (b) * 2 + (h)) * HTB)
#define PG8_STAGE(bufoff, gbase, voff) do { _Pragma("unroll") for (int _i = 0; _i < 2; ++_i) \
        __builtin_amdgcn_global_load_lds((const unsigned*)((const char*)(gbase) + (voff)[_i]), (LAS unsigned*)(lds + (bufoff) + ldsw + _i * 8192), 16, 0, 0); } while (0)
#define PG8_LDA(dst, b, h) do { _Pragma("unroll") for (int m = 0; m < 4; ++m) _Pragma("unroll") for (int k = 0; k < 2; ++k) dst[m][k] = *(const LAS bf16x8*)(lds + PG8_SA(b, h) + aoff + m * 2048 + k * 1024); } while (0)
#define PG8_LDB(dst, b, h) do { _Pragma("unroll") for (int n = 0; n < 2; ++n) _Pragma("unroll") for (int k = 0; k < 2; ++k) dst[n][k] = *(const LAS bf16x8*)(lds + PG8_SB(b, h) + boff + n * 2048 + k * 1024); } while (0)
#define PG8_MMA(ai, bj, At, Bt) do { __builtin_amdgcn_s_setprio(1); _Pragma("unroll") for (int m = 0; m < 4; ++m) _Pragma("unroll") for (int n = 0; n < 2; ++n) _Pragma("unroll") for (int k = 0; k < 2; ++k) \
        acc[ai][bj][m][n] = __builtin_amdgcn_mfma_f32_16x16x32_bf16(Bt[n][k], At[m][k], acc[ai][bj][m][n], 0, 0, 0); __builtin_amdgcn_s_setprio(0); } while (0)
#define PG8_WAIT_V(n) asm volatile("s_waitcnt vmcnt(" #n ")" ::: "memory")
#define PG8_WAIT_L(n) asm volatile("s_waitcnt lgkmcnt(" #n ")" ::: "memory")
#define PG8_BAR __builtin_amdgcn_s_barrier()
#define PG8_SCHED __builtin_amdgcn_sched_barrier(0)
    Unit cur, nxt; int ui = 0;
    if (!S.next(0, cur)) return;
    f32x4 acc[2][2][4][2];
#pragma unroll
    for (int a = 0; a < 2; ++a)
#pragma unroll
        for (int b = 0; b < 2; ++b)
#pragma unroll
            for (int m = 0; m < 4; ++m)
#pragma unroll
                for (int n = 0; n < 2; ++n) acc[a][b][m][n] = (f32x4){0.f, 0.f, 0.f, 0.f};
    bf16x8 At[4][2], B0[2][2], B1[2][2];
    const char* cA = (const char*)g.A + (size_t)cur.pm * tstepA; const char* cB = (const char*)g.Bt + (size_t)cur.pn * tstepB;
    S.a_ready(cur);
    PG8_STAGE(PG8_SB(0, 0), cB, voffB); PG8_STAGE(PG8_SA(0, 0), cA, voffA); PG8_STAGE(PG8_SB(0, 1), cB + hstepB, voffB); PG8_STAGE(PG8_SA(0, 1), cA + hstepA, voffA);
    if (wr == 1) PG8_BAR;
    PG8_WAIT_V(4); PG8_BAR;
    PG8_STAGE(PG8_SB(1, 0), cB + kstep, voffB); PG8_STAGE(PG8_SA(1, 0), cA + kstep, voffA); PG8_STAGE(PG8_SB(1, 1), cB + hstepB + kstep, voffB);
    PG8_WAIT_V(6); PG8_BAR;
    for (;;) {
        const bool has_next = S.next(ui + 1, nxt);
        const char* nA = has_next ? (const char*)g.A + (size_t)nxt.pm * tstepA : cA; const char* nB = has_next ? (const char*)g.Bt + (size_t)nxt.pn * tstepB : cB;
        for (int t = 0; t < nt; t += 2) {
            const bool last = (t == nt - 2);
            const char* a1 = cA + (size_t)(t + 1) * kstep;
            const char* a2 = last ? nA : cA + (size_t)(t + 2) * kstep; const char* b2 = last ? nB : cB + (size_t)(t + 2) * kstep;
            const char* a3 = a2 + kstep; const char* b3 = b2 + kstep;
            if (last && has_next) S.a_ready(nxt);
            PG8_LDB(B0, 0, 0); PG8_SCHED; PG8_LDA(At, 0, 0); PG8_STAGE(PG8_SA(1, 1), a1 + hstepA, voffA);
            PG8_WAIT_L(8); PG8_BAR; PG8_WAIT_L(0); PG8_MMA(0, 0, At, B0); PG8_BAR; PG8_SCHED;
            PG8_LDB(B1, 0, 1); PG8_STAGE(PG8_SB(0, 0), b2, voffB);
            PG8_BAR; PG8_WAIT_L(0); PG8_MMA(0, 1, At, B1); PG8_BAR;
            PG8_LDA(At, 0, 1); PG8_STAGE(PG8_SA(0, 0), a2, voffA);
            PG8_BAR; PG8_WAIT_L(0); PG8_MMA(1, 0, At, B0); PG8_BAR; PG8_SCHED;
            PG8_STAGE(PG8_SB(0, 1), b2 + hstepB, voffB);
            PG8_WAIT_V(6); PG8_BAR; PG8_MMA(1, 1, At, B1); PG8_BAR;
            PG8_LDB(B0, 1, 0); PG8_SCHED; PG8_LDA(At, 1, 0); PG8_STAGE(PG8_SA(0, 1), a2 + hstepA, voffA);
            PG8_WAIT_L(8); PG8_BAR; PG8_WAIT_L(0); PG8_MMA(0, 0, At, B0); PG8_BAR; PG8_SCHED;
            PG8_LDB(B1, 1, 1); PG8_STAGE(PG8_SB(1, 0), b3, voffB);
            PG8_BAR; PG8_WAIT_L(0); PG8_MMA(0, 1, At, B1); PG8_BAR;
            PG8_LDA(At, 1, 1); PG8_STAGE(PG8_SA(1, 0), a3, voffA);
            PG8_BAR; PG8_WAIT_L(0); PG8_MMA(1, 0, At, B0); PG8_BAR; PG8_SCHED;
            PG8_STAGE(PG8_SB(1, 1), b3 + hstepB, voffB);
            PG8_WAIT_V(6); PG8_BAR; PG8_MMA(1, 1, At, B1); PG8_BAR;
        }
        E(acc, cur, wr, wc, fr, fq); S.done(cur);
        if (!has_next) break;
#pragma unroll
        for (int a = 0; a < 2; ++a)
#pragma unroll
            for (int b = 0; b < 2; ++b)
#pragma unroll
                for (int m = 0; m < 4; ++m)
#pragma unroll
                    for (int n = 0; n < 2; ++n) acc[a][b][m][n] = (f32x4){0.f, 0.f, 0.f, 0.f};
        cur = nxt; cA = nA; cB = nB; ++ui;
    }
    PG8_WAIT_V(0);
    if (wr == 0) PG8_BAR;
    PG8_BAR;
#undef PG8_SA
#undef PG8_SB
#undef PG8_STAGE
#undef PG8_LDA
#undef PG8_LDB
#undef PG8_MMA
#undef PG8_WAIT_V
#undef PG8_WAIT_L
#undef PG8_BAR
#undef PG8_SCHED
}
}

namespace att {
constexpr int NW = 8, QBLK = 32, KVBLK = 64, DV = 128;
constexpr float THR = 8.f;
constexpr int SHM_V = KVBLK * DV * 2;
#define SBAR() __builtin_amdgcn_sched_barrier(0)
__device__ __forceinline__ int crow(int r, int hi) { return (r & 3) + 8 * (r >> 2) + 4 * hi; }
__device__ __forceinline__ unsigned cvtpk(float lo, float hi) { unsigned r; asm volatile("v_cvt_pk_bf16_f32 %0, %1, %2" : "=v"(r) : "v"(lo), "v"(hi)); return r; }
__device__ __forceinline__ void partialSM(f32x16& p0, f32x16& p1, float& m_reg, float& mn, float& alpha, const float C, const float thr_raw) {
    float pmax = p0[0];
#pragma unroll
    for (int r = 1; r < 16; ++r) pmax = fmaxf(pmax, p0[r]);
#pragma unroll
    for (int r = 0; r < 16; ++r) pmax = fmaxf(pmax, p1[r]);
    { auto rr = __builtin_amdgcn_permlane32_swap(__float_as_uint(pmax), __float_as_uint(pmax), false, false);
      pmax = fmaxf(__uint_as_float(rr[0]), __uint_as_float(rr[1])); }
    if (__builtin_expect(__all(pmax - m_reg <= thr_raw), 1)) { mn = m_reg; alpha = 1.f; }
    else { mn = fmaxf(m_reg, pmax); alpha = __builtin_amdgcn_exp2f((m_reg - mn) * C); m_reg = mn; }
    const float mnC = -mn * C;
#pragma unroll
    for (int r = 0; r < 16; ++r) p0[r] = fmaf(p0[r], C, mnC);
#pragma unroll
    for (int r = 0; r < 16; ++r) p1[r] = fmaf(p1[r], C, mnC);
#pragma unroll
    for (int r = 0; r < 16; ++r) p0[r] = __builtin_amdgcn_exp2f(p0[r]);
}
__device__ __forceinline__ void finishSM(f32x16& p0, f32x16& p1, float alpha, float& l_reg, bf16x8& pa0, bf16x8& pa1, bf16x8& pa2, bf16x8& pa3) {
#pragma unroll
    for (int r = 0; r < 16; ++r) p1[r] = __builtin_amdgcn_exp2f(p1[r]);
    float ps = 0;
#pragma unroll
    for (int r = 0; r < 16; ++r) ps += p0[r];
#pragma unroll
    for (int r = 0; r < 16; ++r) ps += p1[r];
    { auto rr = __builtin_amdgcn_permlane32_swap(__float_as_uint(ps), __float_as_uint(ps), false, false);
      ps = __uint_as_float(rr[0]) + __uint_as_float(rr[1]); }
    l_reg = l_reg * alpha + ps;
#define PK4(P, BASE, OUT) do { unsigned a0 = cvtpk(P[BASE + 0], P[BASE + 1]), a1 = cvtpk(P[BASE + 2], P[BASE + 3]);   \
    unsigned b0 = cvtpk(P[BASE + 4], P[BASE + 5]), b1 = cvtpk(P[BASE + 6], P[BASE + 7]);                              \
    auto r0 = __builtin_amdgcn_permlane32_swap(a0, b0, false, false); auto r1 = __builtin_amdgcn_permlane32_swap(a1, b1, false, false); \
    u32x4 w = {r0[0], r1[0], r0[1], r1[1]}; OUT = *reinterpret_cast<bf16x8*>(&w); } while (0)
    PK4(p0, 0, pa0); PK4(p0, 8, pa1); PK4(p1, 0, pa2); PK4(p1, 8, pa3);
#undef PK4
}
__device__ __forceinline__ void partialSM_nm(f32x16& p0) {
#pragma unroll
    for (int r = 0; r < 16; ++r) p0[r] = __builtin_amdgcn_exp2f(p0[r]);
}
template <int DQK, int QL>
__device__ __forceinline__ void qkt(f32x16& p0, f32x16& p1, const char* Ks, const bf16x8 (&qr)[DQK / 16 - QL], const char* qpark, int r32, int hi) {
    constexpr int RS = DQK * 2 + 16, NQR = DQK / 16 - QL, GRP = (DQK > 128) ? QKT_GRP : DQK / 16;
    p0 = f32x16{}; p1 = f32x16{};
#pragma unroll
    for (int g0 = 0; g0 < DQK / 16; g0 += GRP) {
#pragma unroll
        for (int d0 = g0; d0 < g0 + GRP; ++d0) { const int cb = (d0 * 16 + hi * 8) * 2;
            const bf16x8 b0 = *reinterpret_cast<const bf16x8*>(Ks + r32 * RS + cb);
            const bf16x8 b1 = *reinterpret_cast<const bf16x8*>(Ks + (32 + r32) * RS + cb);
            bf16x8 qf; if (d0 < NQR) qf = qr[d0 < NQR ? d0 : 0]; else qf = *reinterpret_cast<const bf16x8*>(qpark + (d0 - NQR) * 1024);
            p0 = __builtin_amdgcn_mfma_f32_32x32x16_bf16(b0, qf, p0, 0, 0, 0);
            p1 = __builtin_amdgcn_mfma_f32_32x32x16_bf16(b1, qf, p1, 0, 0, 0); }
        if (g0 + GRP < DQK / 16) SBAR();
    }
}
__device__ __forceinline__ int v_st(int k, int c) { const int kk = (k & ~0xC) | ((k & 4) << 1) | ((k & 8) >> 1); return ((kk >> 3) * 4 + (c >> 5)) * 512 + ((kk & 7) * 32 + (c & 31)) * 2; }
__device__ __forceinline__ int v_rd_base(int lane) { return ((lane & 3) << 3) | (((lane >> 2) & 3) << 6) | (((lane >> 4) & 1) << 5) | (((lane >> 5) & 1) << 8); }
constexpr int v_rd_off(int d0, int ks, int half) { return d0 * 512 + ks * 4096 + half * 2048; }
template <int OFF> __device__ __forceinline__ s16x4 tr_read(int vb) {
    s16x4 r; asm volatile("ds_read_b64_tr_b16 %0, %1 offset:%2" : "=&v"(r) : "v"(vb), "i"(OFF) : "memory"); return r;
}
template <int D0> __device__ __forceinline__ void pv_one(f32x16& od, int vb, bf16x8 pa0, bf16x8 pa1, bf16x8 pa2, bf16x8 pa3) {
    const s16x4 l0 = tr_read<v_rd_off(D0, 0, 0)>(vb), h0 = tr_read<v_rd_off(D0, 0, 1)>(vb), l1 = tr_read<v_rd_off(D0, 1, 0)>(vb), h1 = tr_read<v_rd_off(D0, 1, 1)>(vb);
    const s16x4 l2 = tr_read<v_rd_off(D0, 2, 0)>(vb), h2 = tr_read<v_rd_off(D0, 2, 1)>(vb), l3 = tr_read<v_rd_off(D0, 3, 0)>(vb), h3 = tr_read<v_rd_off(D0, 3, 1)>(vb);
    asm volatile("s_waitcnt lgkmcnt(0)" ::: "memory"); SBAR();
#define PK(L, H) (bf16x8){L[0], L[1], L[2], L[3], H[0], H[1], H[2], H[3]}
    od = __builtin_amdgcn_mfma_f32_32x32x16_bf16(pa0, PK(l0, h0), od, 0, 0, 0);
    od = __builtin_amdgcn_mfma_f32_32x32x16_bf16(pa1, PK(l1, h1), od, 0, 0, 0);
    od = __builtin_amdgcn_mfma_f32_32x32x16_bf16(pa2, PK(l2, h2), od, 0, 0, 0);
    od = __builtin_amdgcn_mfma_f32_32x32x16_bf16(pa3, PK(l3, h3), od, 0, 0, 0);
#undef PK
}
__device__ __forceinline__ void pv_d0(f32x16* o, int vb, bf16x8 pa0, bf16x8 pa1, bf16x8 pa2, bf16x8 pa3) {
    pv_one<0>(o[0], vb, pa0, pa1, pa2, pa3); pv_one<1>(o[1], vb, pa0, pa1, pa2, pa3); pv_one<2>(o[2], vb, pa0, pa1, pa2, pa3); pv_one<3>(o[3], vb, pa0, pa1, pa2, pa3);
}
struct VFrag { s16x4 l0, h0, l1, h1, l2, h2, l3, h3; };
template <int D0> __device__ __forceinline__ void pv_rd(VFrag& f, int vb) {
    f.l0 = tr_read<v_rd_off(D0, 0, 0)>(vb); f.h0 = tr_read<v_rd_off(D0, 0, 1)>(vb); f.l1 = tr_read<v_rd_off(D0, 1, 0)>(vb); f.h1 = tr_read<v_rd_off(D0, 1, 1)>(vb);
    f.l2 = tr_read<v_rd_off(D0, 2, 0)>(vb); f.h2 = tr_read<v_rd_off(D0, 2, 1)>(vb); f.l3 = tr_read<v_rd_off(D0, 3, 0)>(vb); f.h3 = tr_read<v_rd_off(D0, 3, 1)>(vb);
}
__device__ __forceinline__ void pv_mm(f32x16& od, const VFrag& f, bf16x8 pa0, bf16x8 pa1, bf16x8 pa2, bf16x8 pa3) {
#define PK(L, H) (bf16x8){L[0], L[1], L[2], L[3], H[0], H[1], H[2], H[3]}
    od = __builtin_amdgcn_mfma_f32_32x32x16_bf16(pa0, PK(f.l0, f.h0), od, 0, 0, 0);
    od = __builtin_amdgcn_mfma_f32_32x32x16_bf16(pa1, PK(f.l1, f.h1), od, 0, 0, 0);
    od = __builtin_amdgcn_mfma_f32_32x32x16_bf16(pa2, PK(f.l2, f.h2), od, 0, 0, 0);
    od = __builtin_amdgcn_mfma_f32_32x32x16_bf16(pa3, PK(f.l3, f.h3), od, 0, 0, 0);
#undef PK
}
__device__ __forceinline__ void pv_d0_pipe(f32x16* o, int vb, bf16x8 pa0, bf16x8 pa1, bf16x8 pa2, bf16x8 pa3) {
    VFrag fa, fb;
    pv_rd<0>(fa, vb); pv_rd<1>(fb, vb);
    asm volatile("s_waitcnt lgkmcnt(8)" ::: "memory"); SBAR(); pv_mm(o[0], fa, pa0, pa1, pa2, pa3); SBAR();
    pv_rd<2>(fa, vb);
    asm volatile("s_waitcnt lgkmcnt(8)" ::: "memory"); SBAR(); pv_mm(o[1], fb, pa0, pa1, pa2, pa3); SBAR();
    pv_rd<3>(fb, vb);
    asm volatile("s_waitcnt lgkmcnt(8)" ::: "memory"); SBAR(); pv_mm(o[2], fa, pa0, pa1, pa2, pa3); SBAR();
    asm volatile("s_waitcnt lgkmcnt(0)" ::: "memory"); SBAR(); pv_mm(o[3], fb, pa0, pa1, pa2, pa3);
}
template <int DQK> struct ScaleOf { static constexpr float scale = DQK == 192 ? 0.07216878364870322f : (DQK == 128 ? 0.08838834764831845f : 0.125f); };
template <int DQK, int SDEPTH, int QL, bool NOMAX, int ldq, int ldk, int ldv, int ldo>
__device__ __forceinline__ void attn_body(const bf16_t* __restrict__ Qb, const bf16_t* __restrict__ Kh, const bf16_t* __restrict__ Vh,
                                          bf16_t* __restrict__ Ob, int seq, char* lds, int tid_in, const float negMC) {
    constexpr float C = 1.0f, thr_raw = THR * 1.4426950408889634f;
    constexpr int RS = DQK * 2 + 16  , SHM_K = KVBLK * RS, NKP = DQK / 64, KPR = DQK / 8;
    const int tid_l = tid_in * 64 + fresh_lane();
    const int tid = tid_l, wid = tid_in  , lane = tid & 63, r32 = lane & 31, hi = lane >> 5;
    char* V_lds = lds; char* K_lds = lds + 2 * SHM_V;
    float* ws = (float*)(lds + 2 * SHM_V + 2 * SHM_K) + wid * 64; float* li_l = ws; float* al_l = ws + 32;
    constexpr int NQR = DQK / 16 - QL;
    char* qpark = lds + 2 * SHM_V + 2 * SHM_K + 2048 + wid * (QL * 1024) + lane * 16;
    float m_reg = -1e30f, l_reg = 0; f32x16 o[4] = {}; bf16x8 qr[NQR];
    const bf16_t* Qw = Qb + (size_t)(wid * QBLK + r32) * ldq + hi * 8;
#pragma unroll
    for (int d0 = 0; d0 < NQR; ++d0) qr[d0] = *reinterpret_cast<const bf16x8*>(Qw + d0 * 16);
#pragma unroll
    for (int d0 = 0; d0 < QL; ++d0) *(bf16x8*)(qpark + d0 * 1024) = *reinterpret_cast<const bf16x8*>(Qw + (NQR + d0) * 16);
    const int sr = tid >> 4, sc = (tid & 15) * 8, vst0 = v_st(sr, sc), vst1 = v_st(32 + sr, sc);
    int koff[NKP], klds[NKP];
#pragma unroll
    for (int i = 0; i < NKP; ++i) { const int row = tid >> 3, c8 = (tid & 7) + 8 * i; koff[i] = row * ldk + c8 * 8; klds[i] = row * RS + c8 * 16; }
    const int vb0 = (int)(uintptr_t)V_lds + v_rd_base(lane);
    bf16x8 sv0[SDEPTH], sv1[SDEPTH], sk[SDEPTH][NKP];
#define SLOAD(i, k0) do { sv0[i] = *reinterpret_cast<const bf16x8*>(&Vh[(size_t)((k0) + sr) * ldv + sc]); sv1[i] = *reinterpret_cast<const bf16x8*>(&Vh[(size_t)((k0) + 32 + sr) * ldv + sc]); \
    _Pragma("unroll") for (int _q = 0; _q < NKP; ++_q) sk[i][_q] = *reinterpret_cast<const bf16x8*>(&Kh[(size_t)(k0) * ldk + koff[_q]]); } while (0)
#define SWRITE(b, i) do { *(bf16x8*)(V_lds + (b) * SHM_V + vst0) = sv0[i]; *(bf16x8*)(V_lds + (b) * SHM_V + vst1) = sv1[i]; \
    _Pragma("unroll") for (int _q = 0; _q < NKP; ++_q) *(bf16x8*)(K_lds + (b) * SHM_K + klds[_q]) = sk[i][_q]; } while (0)
#define SWAIT() do { if constexpr (SDEPTH == 2) { if constexpr (NKP == 1) asm volatile("s_waitcnt vmcnt(3)" ::: "memory"); else if constexpr (NKP == 2) asm volatile("s_waitcnt vmcnt(4)" ::: "memory"); else asm volatile("s_waitcnt vmcnt(5)" ::: "memory"); } \
    else asm volatile("s_waitcnt vmcnt(0)" ::: "memory"); } while (0)
#define PVD0(...) do { if constexpr (PV_PIPE != 0) pv_d0_pipe(__VA_ARGS__); else pv_d0(__VA_ARGS__); } while (0)
#define RESC(a) do { if constexpr (!NOMAX) if (__any((a) < 1.f)) { if (hi == 0) al_l[r32] = (a); asm volatile("s_waitcnt lgkmcnt(0)" ::: "memory"); \
    _Pragma("unroll") for (int d = 0; d < 4; ++d) _Pragma("unroll") for (int r = 0; r < 16; ++r) o[d][r] *= al_l[crow(r, hi)]; } } while (0)
    f32x16 pA0, pA1, pB0, pB1; float mnA, mnB, alA, alB; bf16x8 pa0, pa1, pa2, pa3; const int NT = seq / KVBLK;
    if (ATT_PRIO && wid >= 4) __builtin_amdgcn_s_setprio(1);
    constexpr int SE = 0, SO = SDEPTH - 1;
    SLOAD(SE, 0); asm volatile("s_waitcnt vmcnt(0)" ::: "memory"); SWRITE(0, SE); __syncthreads();
    qkt<DQK, QL>(pA0, pA1, K_lds, qr, qpark, r32, hi); if constexpr (NOMAX) { partialSM_nm(pA0); alA = 1.f; } else partialSM(pA0, pA1, m_reg, mnA, alA, C, thr_raw);
    SLOAD(SO, KVBLK); if constexpr (SDEPTH == 2) { if (2 < NT) SLOAD(SE, 2 * KVBLK); }
    SWAIT(); SWRITE(1, SO); __syncthreads();
    for (int j = 1; j + 1 < NT; j += 2) {
        SBAR(); qkt<DQK, QL>(pB0, pB1, K_lds + SHM_K, qr, qpark, r32, hi);
        finishSM(pA0, pA1, alA, l_reg, pa0, pa1, pa2, pa3); SBAR();
        SLOAD(SO, (j + SDEPTH) * KVBLK); SBAR();
        PVD0(o, vb0, pa0, pa1, pa2, pa3); if constexpr (NOMAX) { partialSM_nm(pB0); alB = 1.f; } else partialSM(pB0, pB1, m_reg, mnB, alB, C, thr_raw);
        __syncthreads(); SWAIT(); SWRITE(0, SE);
        RESC(alB); __syncthreads();
        SBAR(); qkt<DQK, QL>(pA0, pA1, K_lds, qr, qpark, r32, hi);
        finishSM(pB0, pB1, alB, l_reg, pa0, pa1, pa2, pa3); SBAR();
        if (SDEPTH == 1 || j + 3 < NT) SLOAD(SE, (j + 1 + SDEPTH) * KVBLK); SBAR();
        PVD0(o, vb0 + SHM_V, pa0, pa1, pa2, pa3); if constexpr (NOMAX) { partialSM_nm(pA0); alA = 1.f; } else partialSM(pA0, pA1, m_reg, mnA, alA, C, thr_raw);
        __syncthreads(); SWAIT(); SWRITE(1, SO);
        RESC(alA); __syncthreads();
    }
    SBAR(); qkt<DQK, QL>(pB0, pB1, K_lds + SHM_K, qr, qpark, r32, hi);
    finishSM(pA0, pA1, alA, l_reg, pa0, pa1, pa2, pa3); SBAR();
    PVD0(o, vb0, pa0, pa1, pa2, pa3); if constexpr (NOMAX) { partialSM_nm(pB0); alB = 1.f; } else partialSM(pB0, pB1, m_reg, mnB, alB, C, thr_raw);
    __syncthreads(); RESC(alB);
    finishSM(pB0, pB1, alB, l_reg, pa0, pa1, pa2, pa3); SBAR();
    PVD0(o, vb0 + SHM_V, pa0, pa1, pa2, pa3);
    if (ATT_PRIO) __builtin_amdgcn_s_setprio(0);
    if (hi == 0) li_l[r32] = l_reg; asm volatile("s_waitcnt lgkmcnt(0)" ::: "memory");
    float rli[16];
#pragma unroll
    for (int r = 0; r < 16; ++r) rli[r] = __builtin_amdgcn_rcpf(li_l[crow(r, hi)]);
    bf16_t* Ow = Ob + (size_t)(wid * QBLK) * ldo + (r32 & ~1);
    const bool odd = (r32 & 1) != 0;
#pragma unroll
    for (int r = 0; r < 16; r += 2) { const int orow = crow(r, hi) + (odd ? 1 : 0);
#pragma unroll
        for (int d0 = 0; d0 < 4; ++d0) { const float a = o[d0][r] * rli[r], b = o[d0][r + 1] * rli[r + 1];
            const float recv = swz_xor<1>(odd ? a : b);
            const unsigned w = odd ? cvtpk(recv, b) : cvtpk(a, recv);
            *(unsigned*)(Ow + (size_t)orow * ldo + d0 * 32) = w; } }
    __syncthreads();
#undef SLOAD
#undef SWRITE
#undef SWAIT
#undef RESC
#undef PVD0
}
template <int DQK, int QL, int ldq, int ldk, int ldv, int ldo>
__device__ __forceinline__ void attn_body_simple(const bf16_t* __restrict__ Qb, const bf16_t* __restrict__ Kh, const bf16_t* __restrict__ Vh,
                                                 bf16_t* __restrict__ Ob, int seq, char* lds, int tid_in) {
    constexpr float C = 1.0f, thr_raw = THR * 1.4426950408889634f;
    constexpr int RS = DQK * 2 + 16  , SHM_K = KVBLK * RS, NKP = DQK / 64, KPR = DQK / 8;
    const int tid_l = tid_in * 64 + fresh_lane();
    const int tid = tid_l, wid = tid_in  , lane = tid & 63, r32 = lane & 31, hi = lane >> 5;
    char* V_lds = lds; char* K_lds = lds + 2 * SHM_V;
    float* ws = (float*)(lds + 2 * SHM_V + 2 * SHM_K) + wid * 64; float* li_l = ws; float* al_l = ws + 32;
    constexpr int NQR = DQK / 16 - QL;
    char* qpark = lds + 2 * SHM_V + 2 * SHM_K + 2048 + wid * (QL * 1024) + lane * 16;
    float m_reg = -1e30f, l_reg = 0; f32x16 o[4] = {}; bf16x8 qr[NQR];
    const bf16_t* Qw = Qb + (size_t)(wid * QBLK + r32) * ldq + hi * 8;
#pragma unroll
    for (int d0 = 0; d0 < NQR; ++d0) qr[d0] = *reinterpret_cast<const bf16x8*>(Qw + d0 * 16);
#pragma unroll
    for (int d0 = 0; d0 < QL; ++d0) *(bf16x8*)(qpark + d0 * 1024) = *reinterpret_cast<const bf16x8*>(Qw + (NQR + d0) * 16);
    const int sr = tid >> 4, sc = (tid & 15) * 8, vst0 = v_st(sr, sc), vst1 = v_st(32 + sr, sc);
    int koff[NKP], klds[NKP];
#pragma unroll
    for (int i = 0; i < NKP; ++i) { const int row = tid >> 3, c8 = (tid & 7) + 8 * i; koff[i] = row * ldk + c8 * 8; klds[i] = row * RS + c8 * 16; }
    const int vb0 = (int)(uintptr_t)V_lds + v_rd_base(lane);
    bf16x8 sv0, sv1, sk[NKP];
#define SLOAD(k0) do { sv0 = *reinterpret_cast<const bf16x8*>(&Vh[(size_t)((k0) + sr) * ldv + sc]); sv1 = *reinterpret_cast<const bf16x8*>(&Vh[(size_t)((k0) + 32 + sr) * ldv + sc]); \
    _Pragma("unroll") for (int _q = 0; _q < NKP; ++_q) sk[_q] = *reinterpret_cast<const bf16x8*>(&Kh[(size_t)(k0) * ldk + koff[_q]]); } while (0)
#define SWRITE(b) do { *(bf16x8*)(V_lds + (b) * SHM_V + vst0) = sv0; *(bf16x8*)(V_lds + (b) * SHM_V + vst1) = sv1; \
    _Pragma("unroll") for (int _q = 0; _q < NKP; ++_q) *(bf16x8*)(K_lds + (b) * SHM_K + klds[_q]) = sk[_q]; } while (0)
#define RESC(a) do { if (__any((a) < 1.f)) { if (hi == 0) al_l[r32] = (a); asm volatile("s_waitcnt lgkmcnt(0)" ::: "memory"); \
    _Pragma("unroll") for (int d = 0; d < 4; ++d) _Pragma("unroll") for (int r = 0; r < 16; ++r) o[d][r] *= al_l[crow(r, hi)]; } } while (0)
    const int NT = seq / KVBLK;
    SLOAD(0); asm volatile("s_waitcnt vmcnt(0)" ::: "memory"); SWRITE(0); __syncthreads();
    for (int j = 0; j < NT; ++j) {
        const int b = j & 1;
        if (j + 1 < NT) SLOAD((j + 1) * KVBLK);
        SBAR();
        f32x16 p0, p1; float mn, al; bf16x8 pa0, pa1, pa2, pa3;
        { const char* Ks = K_lds + b * SHM_K; p0 = f32x16{}; p1 = f32x16{};
#pragma unroll
          for (int d0 = 0; d0 < DQK / 16; ++d0) { const int cb = (d0 * 16 + hi * 8) * 2;
              const bf16x8 b0 = *reinterpret_cast<const bf16x8*>(Ks + r32 * RS + cb);
              const bf16x8 b1 = *reinterpret_cast<const bf16x8*>(Ks + (32 + r32) * RS + cb);
              bf16x8 qf; if (d0 < NQR) qf = qr[d0 < NQR ? d0 : 0]; else qf = *(const bf16x8*)(qpark + (d0 - NQR) * 1024);
              p0 = __builtin_amdgcn_mfma_f32_32x32x16_bf16(b0, qf, p0, 0, 0, 0);
              p1 = __builtin_amdgcn_mfma_f32_32x32x16_bf16(b1, qf, p1, 0, 0, 0); } }
        partialSM(p0, p1, m_reg, mn, al, C, thr_raw);
        RESC(al);
        finishSM(p0, p1, al, l_reg, pa0, pa1, pa2, pa3); SBAR();
        pv_d0(o, vb0 + b * SHM_V, pa0, pa1, pa2, pa3);
        if (j + 1 < NT) { asm volatile("s_waitcnt vmcnt(0)" ::: "memory"); SWRITE(b ^ 1); }
        __syncthreads();
    }
    if (hi == 0) li_l[r32] = l_reg; asm volatile("s_waitcnt lgkmcnt(0)" ::: "memory");
    float rli[16];
#pragma unroll
    for (int r = 0; r < 16; ++r) rli[r] = __builtin_amdgcn_rcpf(li_l[crow(r, hi)]);
    bf16_t* Ow = Ob + (size_t)(wid * QBLK) * ldo + (r32 & ~1);
    const bool odd = (r32 & 1) != 0;
#pragma unroll
    for (int r = 0; r < 16; r += 2) { const int orow = crow(r, hi) + (odd ? 1 : 0);
#pragma unroll
        for (int d0 = 0; d0 < 4; ++d0) { const float a = o[d0][r] * rli[r], b = o[d0][r + 1] * rli[r + 1];
            const float recv = swz_xor<1>(odd ? a : b);
            const unsigned w = odd ? cvtpk(recv, b) : cvtpk(a, recv);
            *(unsigned*)(Ow + (size_t)orow * ldo + d0 * 32) = w; } }
    __syncthreads();
#undef SLOAD
#undef SWRITE
#undef RESC
}
}

struct Params {
    const float* x; const float* c; const float* ctx; const float* c_ctx; const float* w_mod; const float* b_mod; const float* g_norm1; const float* g_norm2;
    const float* w_in_ab; const float* g_cq; const float* w_uq; const float* g_ckv; const float* w_ukv; const float* g_qn_a; const float* g_kn_a; const float* lam_vec;
    const float* g_qn_b; const float* g_kn_b; const float* g_sub_b; const float* w_out_ab; const float* w_in_c; const float* g_qn_c; const float* g_kn_c; const float* w_out_c;
    const float* w_pq; const float* sub_keys; const float* expert_u; const float* expert_v;
    float* out; unsigned char* ws; int ph_lo, ph_hi;
};

typedef const __attribute__((address_space(4))) Params CParams;
struct Ctx {
    int tid, lane, wid, G, vcu, bx;
    unsigned char* ws; char* lds;
};

__device__ __forceinline__ void tconv(const Ctx& F, const float* src, bf16_t* dst, const float* gain, int nmat, int K, int N, int Npad, int pad_at = 1 << 30, int pad_len = 0) {
    float* tile = (float*)(F.lds + 32768);
    const int ntn = Npad / 64, ntk = K / 64, per = ntn * ntk, total = per * nmat;
    for (int it = F.vcu; it < total; it += F.G) {
        const int mat = it / per, rem = it % per, tn = rem / ntk, tk = rem % ntk, k0 = tk * 64, n0 = tn * 64;
        const float* s = src + (size_t)mat * K * N; bf16_t* d = dst + (size_t)mat * Npad * K;
        __syncthreads();
        { const int r = F.tid >> 4, c4 = (F.tid & 15) * 4;
#pragma unroll
          for (int i = 0; i < 2; ++i) { const int rr = r + i * 32; f32x4 v = (f32x4){0.f, 0.f, 0.f, 0.f};
              const int sn0 = n0 < pad_at ? n0 : n0 - pad_len;
              if (sn0 + c4 < N && !(n0 >= pad_at && n0 < pad_at + pad_len)) v = *(const f32x4*)(s + (size_t)(k0 + rr) * N + sn0 + c4);
              tile[rr * 65 + c4 + 0] = v[0]; tile[rr * 65 + c4 + 1] = v[1]; tile[rr * 65 + c4 + 2] = v[2]; tile[rr * 65 + c4 + 3] = v[3]; } }
        __syncthreads();
        { const int n = F.tid >> 3, kc = (F.tid & 7) * 8; float v[8];
#pragma unroll
          for (int e = 0; e < 8; ++e) { v[e] = tile[(kc + e) * 65 + n]; if (gain) v[e] *= gain[(size_t)mat * K + k0 + kc + e]; }
          u32x4 w; w.x = cvt_pk_bf16(v[0], v[1]); w.y = cvt_pk_bf16(v[2], v[3]); w.z = cvt_pk_bf16(v[4], v[5]); w.w = cvt_pk_bf16(v[6], v[7]);
          *(u32x4*)(d + (size_t)(n0 + n) * K + k0 + kc) = w; }
    }
}
__device__ __forceinline__ void cvt_flat(const Ctx& F, const float* src, bf16_t* dst, size_t n8) {
    for (size_t i = (size_t)F.vcu * 512 + F.tid; i < n8; i += (size_t)F.G * 512) {
        const f32x4 a = *(const f32x4*)(src + i * 8), b = *(const f32x4*)(src + i * 8 + 4);
        u32x4 w; w.x = cvt_pk_bf16(a[0], a[1]); w.y = cvt_pk_bf16(a[2], a[3]); w.z = cvt_pk_bf16(b[0], b[1]); w.w = cvt_pk_bf16(b[2], b[3]);
        *(u32x4*)(dst + i * 8) = w;
    }
}
typedef unsigned v6u __attribute__((ext_vector_type(6)));
typedef float v32f __attribute__((ext_vector_type(32)));
typedef float v16f __attribute__((ext_vector_type(16)));
__device__ __forceinline__ float fp6_val(int c) { return c < 8 ? c * 0.125f : (c < 16 ? 1.f + (c - 8) * 0.125f : (c < 24 ? 2.f + (c - 16) * 0.25f : 4.f + (c - 24) * 0.5f)); }
__device__ __forceinline__ int fp6_code(float x) { return x < 1.f ? (int)(x * 8.f + 0.5f) : (x < 2.f ? 8 + (int)((x - 1.f) * 8.f + 0.5f) : (x < 4.f ? 16 + (int)((x - 2.f) * 4.f + 0.5f) : 24 + (int)((x - 4.f) * 2.f + 0.5f))); }
__device__ __forceinline__ void cvt_rows_fp6(const Ctx& F, const float* src, unsigned char* dst, float* descale, int R) {
    float* stg = (float*)(F.lds + 65536) + F.wid * (64 * 33);
    int* permL = (int*)(F.lds + 65536 + 8 * 64 * 33 * 4) + F.wid * 32;
    float fac;
    {   v16f lo, hi;
#pragma unroll
        for (int i = 0; i < 16; ++i) { lo[i] = fp6_val(i); hi[i] = fp6_val(16 + i); }
        const v6u w = __builtin_amdgcn_cvt_scalef32_2xpk16_fp6_f32(lo, hi, 1.0f);
        const v32f f = __builtin_amdgcn_cvt_scalef32_pk32_f32_fp6(w, 1.0f);
        float mx = 0.f;
#pragma unroll
        for (int j = 0; j < 32; ++j) mx = fmaxf(mx, f[j]);
        fac = mx * (1.f / 7.5f);
        const float inv = fac > 0.f ? 1.f / fac : 1.f;
        if (F.lane == 0) {
#pragma unroll
            for (int j = 0; j < 32; ++j) permL[j] = fp6_code(f[j] * inv) & 31; }
        asm volatile("s_waitcnt lgkmcnt(0)" ::: "memory"); __builtin_amdgcn_wave_barrier(); asm volatile("" ::: "memory");
    }
    for (int row = F.vcu * 8 + F.wid; row < R; row += F.G * 8) {
        const float* s = src + (size_t)row * DM + F.lane * 32; f32x4 v[8]; float am = 0.f;
#pragma unroll
        for (int i = 0; i < 8; ++i) { v[i] = *(const f32x4*)(s + i * 4);
#pragma unroll
            for (int e = 0; e < 4; ++e) am = fmaxf(am, fabsf(v[i][e])); }
        am = wave_max(am);
        const float sc = am > 0.f ? 7.f / am : 1.f;
#pragma unroll
        for (int i = 0; i < 8; ++i)
#pragma unroll
            for (int e = 0; e < 4; ++e) stg[F.lane * 33 + permL[i * 4 + e]] = v[i][e] * sc;
        asm volatile("s_waitcnt lgkmcnt(0)" ::: "memory"); __builtin_amdgcn_wave_barrier(); asm volatile("" ::: "memory");
        v16f lo, hi;
#pragma unroll
        for (int i = 0; i < 16; ++i) { lo[i] = stg[F.lane * 33 + i]; hi[i] = stg[F.lane * 33 + 16 + i]; }
        asm volatile("s_waitcnt lgkmcnt(0)" ::: "memory"); __builtin_amdgcn_wave_barrier(); asm volatile("" ::: "memory");
        const v6u w = __builtin_amdgcn_cvt_scalef32_2xpk16_fp6_f32(lo, hi, 1.0f);
        u32x2* d = (u32x2*)(dst + (size_t)row * EROW + F.lane * 24);
        d[0] = (u32x2){w[0], w[1]}; d[1] = (u32x2){w[2], w[3]}; d[2] = (u32x2){w[4], w[5]};
        if (F.lane == 0) descale[row] = (am > 0.f ? am * (1.f / 7.f) : 1.f) / (fac > 0.f ? fac : 1.f);
    }
}
__device__ __forceinline__ float silu_f(float v) { return v / (1.f + __expf(-v)); }

__device__ __forceinline__ void prologue_phase(const Ctx& F, CParams& P) {
    unsigned char* ws = F.ws;
    {
        float* sv = (float*)F.lds;
        float* part = (float*)(F.lds + 24576);
        for (int i = F.tid; i < 3 * DM; i += 512) { const int v = i / DM, k = i % DM; const float cv = v < 2 ? P.c[v * DM + k] : P.c_ctx[k]; sv[i] = silu_f(cv); }
        __syncthreads();
        float* mod = (float*)(ws + WS_MOD);
        for (int it = F.vcu; it < DEPTH * 192; it += F.G) {
            const int l = it / 192, n0 = (it % 192) * 64;
            const float* wp = P.w_mod + ((size_t)l * DM + F.wid * 256) * 12288 + n0 + F.lane;
            float a0 = 0.f, a1 = 0.f, a2 = 0.f;
#pragma unroll 8
            for (int k = 0; k < 256; ++k) { const float w = wp[(size_t)k * 12288]; const int kk = F.wid * 256 + k; a0 += sv[kk] * w; a1 += sv[DM + kk] * w; a2 += sv[2 * DM + kk] * w; }
            part[(F.wid * 3 + 0) * 64 + F.lane] = a0; part[(F.wid * 3 + 1) * 64 + F.lane] = a1; part[(F.wid * 3 + 2) * 64 + F.lane] = a2;
            __syncthreads();
            if (F.wid < 3) { float s = 0.f;
#pragma unroll
                for (int w = 0; w < 8; ++w) s += part[(w * 3 + F.wid) * 64 + F.lane];
                mod[((size_t)l * 3 + F.wid) * 12288 + n0 + F.lane] = s + P.b_mod[(size_t)l * 12288 + n0 + F.lane]; }
            __syncthreads();
        }
    }
    if (F.vcu == 0) {
        float* t16 = (float*)(ws + WS_TAB16); float* t32 = (float*)(ws + WS_TAB32);
        for (int i = F.tid; i < 128 * 16; i += 512) { const int pos = i >> 4, f = i & 15; const float fr = powf(10000.f, -(float)f / 16.f); const float a = (float)pos * fr; float s, c; sincosf(a, &s, &c); t16[i * 2] = c; t16[i * 2 + 1] = s; }
        for (int i = F.tid; i < 128 * 32; i += 512) { const int pos = i >> 5, f = i & 31; const float fr = powf(10000.f, -(float)f / 32.f); const float a = (float)pos * fr; float s, c; sincosf(a, &s, &c); t32[i * 2] = c; t32[i * 2 + 1] = s; }
        if (F.wid == 2) { float* bnd = (float*)(ws + WS_LAM) + 4;
            for (int e2 = 0; e2 < 2; ++e2) {
                float ga = 0.f, gb = 0.f, gc = 0.f, gd = 0.f, ge = 0.f, gf = 0.f;
                for (int i = F.lane; i < 192; i += 64) { ga = fmaxf(ga, fabsf(P.g_qn_a[e2 * 192 + i])); gb = fmaxf(gb, fabsf(P.g_kn_a[e2 * 192 + i])); }
                gc = fabsf(P.g_qn_b[e2 * 64 + F.lane]); gd = fabsf(P.g_kn_b[e2 * 64 + F.lane]);
                for (int i = F.lane; i < 128; i += 64) { ge = fmaxf(ge, fabsf(P.g_qn_c[e2 * 128 + i])); gf = fmaxf(gf, fabsf(P.g_kn_c[e2 * 128 + i])); }
                ga = wave_max(ga); gb = wave_max(gb); gc = wave_max(gc); gd = wave_max(gd); ge = wave_max(ge); gf = wave_max(gf);
                if (F.lane == 0) { bnd[(2 * e2) * 2 + 0] = 1.03f * 13.856406f * ga * gb;
                                   bnd[(2 * e2) * 2 + 1] = 1.03f * 8.f * gc * gd;
                                   bnd[(2 * e2 + 1) * 2 + 0] = 1.03f * 11.313708f * ge * gf;
                                   bnd[(2 * e2 + 1) * 2 + 1] = 0.f; } } }
        if (F.wid < 2) { const float* lv = P.lam_vec + F.wid * 256; const float d1 = wave_sum(lv[F.lane] * lv[64 + F.lane]), d2 = wave_sum(lv[128 + F.lane] * lv[192 + F.lane]);
            const float lam_init = 0.8f - 0.6f * expf(-0.3f * (float)(2 * F.wid));
            if (F.lane == 0) ((float*)(ws + WS_LAM))[F.wid] = expf(d1) - expf(d2) + lam_init; }
    }
    tconv(F, P.w_in_ab, (bf16_t*)(ws + WS_WINAB), nullptr, 2, DM, AB_IN, AB_INP, 3392, AB_INP - AB_IN);
    tconv(F, P.w_uq, (bf16_t*)(ws + WS_WUQ), P.g_cq, 2, 768, 1536, 1536);
    tconv(F, P.w_ukv, (bf16_t*)(ws + WS_WUKV), P.g_ckv, 2, 512, 2048, 2048);
    tconv(F, P.w_out_ab, (bf16_t*)(ws + WS_WOUTAB), nullptr, 2, DM, DM, DM);
    tconv(F, P.w_in_c, (bf16_t*)(ws + WS_WINC), nullptr, 2, DM, C_IN, C_IN);
    tconv(F, P.w_out_c, (bf16_t*)(ws + WS_WOUTC), nullptr, 2, DM, DM, DM);
    tconv(F, P.w_pq, (bf16_t*)(ws + WS_WPQ), nullptr, 4, DM, DM, DM);
    cvt_flat(F, P.sub_keys, (bf16_t*)(ws + WS_SUBK), (size_t)4 * 8 * 2 * 128 * 128 / 8);
    cvt_rows_fp6(F, P.expert_u, ws + WS_EU, (float*)(ws + WS_SU), 4 * NEXP);
    cvt_rows_fp6(F, P.expert_v, ws + WS_EV, (float*)(ws + WS_SV), 4 * NEXP);
}

__device__ __forceinline__ void norm_rows(const Ctx& F, CParams& P, int layer, int which  , int t_first, int t_end, int t_stride) {
    float* X = (float*)(F.ws + WS_X); bf16_t* H = (bf16_t*)(F.ws + WS_H);
    const float* mod = (const float*)(F.ws + WS_MOD) + (size_t)layer * 3 * 12288;
    const float* gn = (which ? P.g_norm2 : P.g_norm1) + (size_t)layer * DM;
    const bool from_in = (layer == 0 && which == 0);
    const int lane = fresh_lane();
    if (t_first >= t_end) return;
    f32x4 g[8];
#pragma unroll
    for (int j = 0; j < 8; ++j) g[j] = *(const f32x4*)(gn + j * 256 + lane * 4);
    auto srcrow = [&](int t) { return from_in ? (t < TL ? P.x + (size_t)t * DM : P.ctx + (size_t)(t - TL) * DM) : X + (size_t)t * DM; };
    f32x4 vn[8];
    { const float* src = srcrow(t_first);
#pragma unroll
      for (int j = 0; j < 8; ++j) vn[j] = *(const f32x4*)(src + j * 256 + lane * 4); }
    for (int t = t_first; t < t_end; t += t_stride) {
        const int vs = vsel_of_row(t);
        const float* shf = mod + (size_t)vs * 12288 + (which ? 3 : 0) * DM; const float* scl = shf + DM;
        f32x4 v[8], sc[8], sh[8]; float ss = 0.f;
#pragma unroll
        for (int j = 0; j < 8; ++j) { v[j] = vn[j]; sc[j] = *(const f32x4*)(scl + j * 256 + lane * 4); sh[j] = *(const f32x4*)(shf + j * 256 + lane * 4); }
        { const int tn = t + t_stride; const float* src = srcrow(tn < t_end ? tn : t);
#pragma unroll
          for (int j = 0; j < 8; ++j) vn[j] = *(const f32x4*)(src + j * 256 + lane * 4); }
#pragma unroll
        for (int j = 0; j < 8; ++j) ss += v[j][0] * v[j][0] + v[j][1] * v[j][1] + v[j][2] * v[j][2] + v[j][3] * v[j][3];
        ss = wave_sum(ss);
        const float rstd = rsqrtf(ss * (1.f / DM) + EPS);
#pragma unroll
        for (int j = 0; j < 8; ++j) { const int c = j * 256 + lane * 4;
            f32x4 y;
#pragma unroll
            for (int e = 0; e < 4; ++e) y[e] = (v[j][e] * rstd * g[j][e]) * (1.f + sc[j][e]) + sh[j][e];
            u32x2 w; w.x = cvt_pk_bf16(y[0], y[1]); w.y = cvt_pk_bf16(y[2], y[3]);
            *(u32x2*)(H + (size_t)t * DM + c) = w; }
    }
}
__device__ __forceinline__ void norm_phase(const Ctx& F, CParams& P, int layer, int which, int m_rows) { norm_rows(F, P, layer, which, F.vcu * 8 + F.wid, m_rows, F.G * 8); }

__device__ __forceinline__ float grp16_sum(float v) { v += swz_xor<8>(v); v += swz_xor<4>(v); v += swz_xor<2>(v); v += swz_xor<1>(v); return v; }
__device__ __forceinline__ void rope4(float (&x)[4], int q16, int row, int col, const float* t16) {
    const int seg = q16 >> 3, f0 = (q16 & 3) * 4, pos = seg ? col : row; const bool first = (q16 & 7) < 4;
    const f32x4 c0 = *(const f32x4*)(t16 + (pos * 16 + f0) * 2), c1 = *(const f32x4*)(t16 + (pos * 16 + f0) * 2 + 4);
    const float cs[4] = {c0[0], c0[2], c1[0], c1[2]}, sn[4] = {c0[1], c0[3], c1[1], c1[3]};
#pragma unroll
    for (int e = 0; e < 4; ++e) { const float p = swz_xor<4>(x[e]); x[e] = first ? x[e] * cs[e] - p * sn[e] : p * sn[e] + x[e] * cs[e]; }
}
__device__ __forceinline__ void rope8(float (&x)[8], int q16, int row, int col, const float* t32) {
    const int seg = q16 >> 3, f0 = (q16 & 3) * 8, pos = seg ? col : row; const bool first = (q16 & 7) < 4;
    const float* tp = t32 + (pos * 32 + f0) * 2;
#pragma unroll
    for (int q = 0; q < 4; ++q) { const f32x4 c = *(const f32x4*)(tp + q * 4);
#pragma unroll
        for (int s = 0; s < 2; ++s) { const int e = q * 2 + s; const float cs = c[s * 2], sn = c[s * 2 + 1]; const float p = swz_xor<4>(x[e]); x[e] = first ? x[e] * cs - p * sn : p * sn + x[e] * cs; } }
}
__device__ __forceinline__ void ld8bf(const bf16_t* p, float (&x)[8]) { const u32x4 w = *(const u32x4*)p;
#pragma unroll
    for (int q = 0; q < 4; ++q) { x[q * 2] = bf_lo(w[q]); x[q * 2 + 1] = bf_hi(w[q]); } }
__device__ __forceinline__ void ld4bf(const bf16_t* p, float (&x)[4]) { const u32x2 w = *(const u32x2*)p; x[0] = bf_lo(w.x); x[1] = bf_hi(w.x); x[2] = bf_lo(w.y); x[3] = bf_hi(w.y); }
__device__ __forceinline__ void st8bf(bf16_t* p, const float (&x)[8]) { u32x4 w; w.x = cvt_pk_bf16(x[0], x[1]); w.y = cvt_pk_bf16(x[2], x[3]); w.z = cvt_pk_bf16(x[4], x[5]); w.w = cvt_pk_bf16(x[6], x[7]); *(u32x4*)p = w; }
__device__ __forceinline__ void st4bf(bf16_t* p, const float (&x)[4]) { u32x2 w; w.x = cvt_pk_bf16(x[0], x[1]); w.y = cvt_pk_bf16(x[2], x[3]); *(u32x2*)p = w; }

__device__ __forceinline__ void qkv_even_phase(const Ctx& F, CParams& P, int e) {
    const bf16_t* P1 = (const bf16_t*)(F.ws + WS_P1); const bf16_t* QA = (const bf16_t*)(F.ws + WS_QA); const bf16_t* KV = (const bf16_t*)(F.ws + WS_KV);
    bf16_t* Qm = (bf16_t*)(F.ws + WS_Q1); bf16_t* Km = (bf16_t*)(F.ws + WS_K1); bf16_t* Vm = (bf16_t*)(F.ws + WS_V1);
    bf16_t* Qd = (bf16_t*)(F.ws + WS_Q2); bf16_t* Kd = (bf16_t*)(F.ws + WS_K2); bf16_t* Vd = (bf16_t*)(F.ws + WS_V2);
    const float* t16 = (const float*)(F.ws + WS_TAB16);
    const float* gqa = P.g_qn_a + e * 192; const float* gka = P.g_kn_a + e * 192; const float* gqb = P.g_qn_b + e * 64; const float* gkb = P.g_kn_b + e * 64;
    const int q16 = F.lane & 15, grp = F.lane >> 4;
    float gq_n[8], gq_r[4], gk_n[8], gk_r[4], gqd[4], gkd[4];
#pragma unroll
    for (int i = 0; i < 8; ++i) { gq_n[i] = gqa[q16 * 8 + i]; gk_n[i] = gka[q16 * 8 + i]; }
#pragma unroll
    for (int i = 0; i < 4; ++i) { gq_r[i] = gqa[128 + q16 * 4 + i]; gk_r[i] = gka[128 + q16 * 4 + i]; gqd[i] = gqb[q16 * 4 + i]; gkd[i] = gkb[q16 * 4 + i]; }
    struct Raw { u32x2 cq[3]; u32x4 ckv; u32x2 kro; u32x4 qn[2]; u32x2 qr[2]; u32x4 kn[2], kv[2]; u32x2 dq[4], dk[4]; f32x4 rc0, rc1; };
    auto load_raw = [&](int t, Raw& R) {
        const bf16_t* p1 = P1 + (size_t)t * AB_INP;
        { const int s_ = t & (SEQ - 1), pos_ = (q16 >> 3) ? (s_ & 63) : (s_ >> 6); const float* tp = t16 + (pos_ * 16 + (q16 & 3) * 4) * 2; R.rc0 = *(const f32x4*)tp; R.rc1 = *(const f32x4*)(tp + 4); }
#pragma unroll
        for (int j = 0; j < 3; ++j) R.cq[j] = *(const u32x2*)(p1 + j * 256 + F.lane * 4);
        R.ckv = *(const u32x4*)(p1 + 768 + F.lane * 8);
        R.kro = *(const u32x2*)(p1 + 1280 + q16 * 4);
#pragma unroll
        for (int ps = 0; ps < 2; ++ps) { const int h = ps * 4 + grp; const bf16_t* src = QA + (size_t)t * 1536 + h * 192;
            R.qn[ps] = *(const u32x4*)(src + q16 * 8); R.qr[ps] = *(const u32x2*)(src + 128 + q16 * 4);
            const bf16_t* sk = KV + (size_t)t * 2048 + h * 256; R.kn[ps] = *(const u32x4*)(sk + q16 * 8); R.kv[ps] = *(const u32x4*)(sk + 128 + q16 * 8); }
#pragma unroll
        for (int ps = 0; ps < 4; ++ps) { const int hm = ps * 4 + grp; R.dq[ps] = *(const u32x2*)(p1 + 1344 + hm * 64 + q16 * 4); R.dk[ps] = *(const u32x2*)(p1 + 2368 + hm * 64 + q16 * 4); }
    };
#define UNP8(W, X) do { X[0] = bf_lo(W.x); X[1] = bf_hi(W.x); X[2] = bf_lo(W.y); X[3] = bf_hi(W.y); X[4] = bf_lo(W.z); X[5] = bf_hi(W.z); X[6] = bf_lo(W.w); X[7] = bf_hi(W.w); } while (0)
#define UNP4(W, X) do { X[0] = bf_lo(W.x); X[1] = bf_hi(W.x); X[2] = bf_lo(W.y); X[3] = bf_hi(W.y); } while (0)
    const int tfirst = F.vcu * 8 + F.wid, tstr = F.G * 8;
    Raw R; if (tfirst < TT) load_raw(tfirst, R);
    for (int t = tfirst; t < TT; t += tstr) {
        const bool latent = t < TL; const int s = t & (SEQ - 1), row = s >> 6, col = s & 63; const int kr = krow_of(t);
        Raw C = R; { const int tn = t + tstr; load_raw(tn < TT ? tn : t, R); }
        const float rcs[4] = {C.rc0[0], C.rc0[2], C.rc1[0], C.rc1[2]}, rsn[4] = {C.rc0[1], C.rc0[3], C.rc1[1], C.rc1[3]}; const bool rfirst = (q16 & 7) < 4;
#define ROPE4V(X) do { _Pragma("unroll") for (int e_ = 0; e_ < 4; ++e_) { const float p_ = swz_xor<4>(X[e_]); X[e_] = rfirst ? X[e_] * rcs[e_] - p_ * rsn[e_] : p_ * rsn[e_] + X[e_] * rcs[e_]; } } while (0)
        float ss = 0.f;
#pragma unroll
        for (int j = 0; j < 3; ++j) { float x[4]; UNP4(C.cq[j], x); ss += x[0] * x[0] + x[1] * x[1] + x[2] * x[2] + x[3] * x[3]; }
        ss = wave_sum(ss); const float rstd_q = rsqrtf(ss * (1.f / 768.f) + EPS);
        float s2 = 0.f;
        { float x[8]; UNP8(C.ckv, x);
#pragma unroll
          for (int i = 0; i < 8; ++i) s2 += x[i] * x[i]; }
        s2 = wave_sum(s2); const float rstd_kv = rsqrtf(s2 * (1.f / 512.f) + EPS);
        float kro[4]; UNP4(C.kro, kro);
#pragma unroll
        for (int ps = 0; ps < 2; ++ps) { const int h = ps * 4 + grp;
            float xn[8], xr[4]; UNP8(C.qn[ps], xn); UNP4(C.qr[ps], xr);
            float sq = 0.f;
#pragma unroll
            for (int i = 0; i < 8; ++i) { xn[i] *= rstd_q; sq += xn[i] * xn[i]; }
#pragma unroll
            for (int i = 0; i < 4; ++i) { xr[i] *= rstd_q; sq += xr[i] * xr[i]; }
            sq = grp16_sum(sq); const float r = rsqrtf(sq * (1.f / 192.f) + EPS);
            const float rq = r * (0.07216878364870322f * LOG2E);
#pragma unroll
            for (int i = 0; i < 8; ++i) xn[i] *= rq * gq_n[i];
#pragma unroll
            for (int i = 0; i < 4; ++i) xr[i] *= rq * gq_r[i];
            if (latent) ROPE4V(xr);
            bf16_t* dst = Qm + ((size_t)t * 8 + h) * 192; st8bf(dst + q16 * 8, xn); st4bf(dst + 128 + q16 * 4, xr); }
#pragma unroll
        for (int ps = 0; ps < 2; ++ps) { const int h = ps * 4 + grp;
            float xn[8], xr[4], xv[8]; UNP8(C.kn[ps], xn); UNP8(C.kv[ps], xv);
            float sq = 0.f;
#pragma unroll
            for (int i = 0; i < 8; ++i) { xn[i] *= rstd_kv; xv[i] *= rstd_kv; sq += xn[i] * xn[i]; }
#pragma unroll
            for (int i = 0; i < 4; ++i) { xr[i] = kro[i]; sq += xr[i] * xr[i]; }
            sq = grp16_sum(sq); const float r = rsqrtf(sq * (1.f / 192.f) + EPS);
#pragma unroll
            for (int i = 0; i < 8; ++i) xn[i] *= r * gk_n[i];
#pragma unroll
            for (int i = 0; i < 4; ++i) xr[i] *= r * gk_r[i];
            if (latent) ROPE4V(xr);
            bf16_t* dst = Km + ((size_t)kr * 8 + h) * 192; st8bf(dst + q16 * 8, xn); st4bf(dst + 128 + q16 * 4, xr);
            st8bf(Vm + ((size_t)kr * 8 + h) * 128 + q16 * 8, xv); }
#pragma unroll
        for (int ps = 0; ps < 4; ++ps) { const int hm = ps * 4 + grp;
            float x[4]; UNP4(C.dq[ps], x);
            float sq = grp16_sum(x[0] * x[0] + x[1] * x[1] + x[2] * x[2] + x[3] * x[3]); float r = rsqrtf(sq * (1.f / 64.f) + EPS);
#pragma unroll
            for (int i = 0; i < 4; ++i) x[i] *= r * (0.125f * LOG2E) * gqd[i];
            if (latent) ROPE4V(x);
            st4bf(Qd + ((size_t)t * 16 + hm) * 64 + q16 * 4, x);
            UNP4(C.dk[ps], x);
            sq = grp16_sum(x[0] * x[0] + x[1] * x[1] + x[2] * x[2] + x[3] * x[3]); r = rsqrtf(sq * (1.f / 64.f) + EPS);
#pragma unroll
            for (int i = 0; i < 4; ++i) x[i] *= r * gkd[i];
            if (latent) ROPE4V(x);
            st4bf(Kd + ((size_t)kr * 16 + hm) * 64 + q16 * 4, x); }
    }
#undef UNP8
#undef UNP4
#undef ROPE4V
}
__device__ __forceinline__ void qkv_odd_rows(const Ctx& F, CParams& P, int e, int t_first, int t_end, int t_stride) {
    const bf16_t* P1 = (const bf16_t*)(F.ws + WS_P1);
    bf16_t* Qc = (bf16_t*)(F.ws + WS_Q1); bf16_t* Kc = (bf16_t*)(F.ws + WS_K1); bf16_t* Vc = (bf16_t*)(F.ws + WS_V1);
    const float* t32 = (const float*)(F.ws + WS_TAB32);
    const int lane = fresh_lane();
    const int q16 = lane & 15, grp = lane >> 4;
    float gq[8], gk[8];
#pragma unroll
    for (int i = 0; i < 8; ++i) { gq[i] = P.g_qn_c[e * 128 + q16 * 8 + i]; gk[i] = P.g_kn_c[e * 128 + q16 * 8 + i]; }
    if (t_first >= t_end) return;
    struct Raw { u32x4 x[5]; f32x4 rc[4]; };
    auto load_raw = [&](int t, Raw& R) {
        const bf16_t* p1 = P1 + (size_t)t * C_IN;
#pragma unroll
        for (int ps = 0; ps < 5; ++ps) { const bool isq = ps < 4; const int h = isq ? ps * 4 + grp : grp; R.x[ps] = *(const u32x4*)(p1 + (isq ? 0 : 2048) + h * 128 + q16 * 8); }
        const int s_ = t & (SEQ - 1), pos_ = (q16 >> 3) ? (s_ & 63) : (s_ >> 6); const float* tp = t32 + (pos_ * 32 + (q16 & 3) * 8) * 2;
#pragma unroll
        for (int q = 0; q < 4; ++q) R.rc[q] = *(const f32x4*)(tp + q * 4);
    };
    Raw R; load_raw(t_first, R);
    for (int t = t_first; t < t_end; t += t_stride) {
        const bool latent = t < TL; const int kr = krow_of(t);
        Raw C = R; { const int tn = t + t_stride; load_raw(tn < t_end ? tn : t, R); }
        const bool rfirst = (q16 & 7) < 4;
#pragma unroll
        for (int ps = 0; ps < 5; ++ps) {
            const bool isq = ps < 4; const int h = isq ? ps * 4 + grp : grp;
            float x[8]; { const u32x4 w = C.x[ps]; x[0] = bf_lo(w.x); x[1] = bf_hi(w.x); x[2] = bf_lo(w.y); x[3] = bf_hi(w.y); x[4] = bf_lo(w.z); x[5] = bf_hi(w.z); x[6] = bf_lo(w.w); x[7] = bf_hi(w.w); }
            float sq = 0.f;
#pragma unroll
            for (int i = 0; i < 8; ++i) sq += x[i] * x[i];
            sq = grp16_sum(sq); const float r = rsqrtf(sq * (1.f / 128.f) + EPS);
#pragma unroll
            for (int i = 0; i < 8; ++i) x[i] *= r * (isq ? gq[i] * (0.08838834764831845f * LOG2E) : gk[i]);
            if (latent) {
#pragma unroll
                for (int q = 0; q < 4; ++q)
#pragma unroll
                    for (int s2 = 0; s2 < 2; ++s2) { const int e = q * 2 + s2; const float cs = C.rc[q][s2 * 2], sn = C.rc[q][s2 * 2 + 1]; const float p = swz_xor<4>(x[e]); x[e] = rfirst ? x[e] * cs - p * sn : p * sn + x[e] * cs; } }
            st8bf(isq ? Qc + ((size_t)t * 16 + h) * 128 + q16 * 8 : Kc + ((size_t)kr * 4 + h) * 128 + q16 * 8, x); }
    }
}

template <int DQK, int SDEPTH, int ldo, int NH, int NKVH, int NVH>
__device__ __forceinline__ void attn_phase(const Ctx& F, const bf16_t* Qbuf, const bf16_t* Kbuf, const bf16_t* Vbuf, bf16_t* OF, int ocol0, bool with_ctx, const float bound  ) {
    const bool nomax = bound < 60.f;
    const float negMC = 0.f;
    constexpr int kv_div = NH / NKVH, v_div = NH / NVH;
    const int n_lat = NH * NB * 32, n_tot = n_lat + (with_ctx ? NH * NB : 0);
    constexpr int ldq = NH * DQK, ldk = NKVH * DQK, ldv = NVH * 128;
    for (int u = F.vcu; u < n_tot; u += F.G) {
        int b, h, qrow0, kstart, seq;
        if (u < n_lat) { const int bh = u >> 5, qb = u & 31; b = bh / NH; h = bh % NH; qrow0 = b * SEQ + qb * 256; kstart = b * KPB; seq = KPB; }
        else { const int bh = u - n_lat; b = bh / NH; h = bh % NH; qrow0 = TL + b * CTXL; kstart = b * KPB + SEQ; seq = CTXL; }
        const bf16_t* Qp = Qbuf + ((size_t)qrow0 * NH + h) * DQK;
        const bf16_t* Kp = Kbuf + ((size_t)kstart * NKVH + h / kv_div) * DQK;
        const bf16_t* Vp = Vbuf + ((size_t)kstart * NVH + h / v_div) * 128;
        bf16_t* Op = OF + (size_t)qrow0 * ldo + ocol0 + h * 128;
        if constexpr (SDEPTH == 0) att::attn_body_simple<DQK, (DQK == 192 ? MLA_QL : 0), ldq, ldk, ldv, ldo>(Qp, Kp, Vp, Op, seq, F.lds, F.wid);
        else { if (nomax) att::attn_body<DQK, SDEPTH, (DQK == 192 ? MLA_QL : (DQK == 128 ? GQA_QL : 0)), true, ldq, ldk, ldv, ldo>(Qp, Kp, Vp, Op, seq, F.lds, F.wid, negMC);
               else att::attn_body_simple<DQK, 0, ldq, ldk, ldv, ldo>(Qp, Kp, Vp, Op, seq, F.lds, F.wid); }
    }
}

__device__ __forceinline__ void merge_even_phase(const Ctx& F, CParams& P, int e, int layer, int m_rows) {
    const bf16_t* OD = (const bf16_t*)(F.ws + WS_OF); bf16_t* AO = (bf16_t*)(F.ws + WS_AO);
    const float lam = ((const float*)(F.ws + WS_LAM))[e];
    const float lam_init = 0.8f - 0.6f * expf(-0.3f * (float)layer);
    const int q16 = F.lane & 15, grp = F.lane >> 4;
    float gs[8];
#pragma unroll
    for (int i = 0; i < 8; ++i) gs[i] = P.g_sub_b[e * 128 + q16 * 8 + i] * (1.f - lam_init);
    for (int t = F.vcu * 8 + F.wid; t < m_rows; t += F.G * 8) {
        const bf16_t* od = OD + (size_t)t * DM; bf16_t* ao = AO + (size_t)t * DM + 1024;
#pragma unroll
        for (int ps = 0; ps < 2; ++ps) { const int h = ps * 4 + grp;
            float o0[8], o1[8], d[8]; ld8bf(od + (2 * h) * 128 + q16 * 8, o0); ld8bf(od + (2 * h + 1) * 128 + q16 * 8, o1);
            float sq = 0.f;
#pragma unroll
            for (int i = 0; i < 8; ++i) { d[i] = o0[i] - lam * o1[i]; sq += d[i] * d[i]; }
            sq = grp16_sum(sq); const float r = rsqrtf(sq * (1.f / 128.f) + EPS);
#pragma unroll
            for (int i = 0; i < 8; ++i) d[i] *= r * gs[i];
            st8bf(ao + h * 128 + q16 * 8, d); }
    }
}

__device__ __forceinline__ void wave_lds_fence() { asm volatile("s_waitcnt lgkmcnt(0)" ::: "memory"); __builtin_amdgcn_wave_barrier(); asm volatile("" ::: "memory"); }
__device__ __forceinline__ unsigned fkey(float f) { const unsigned b = __float_as_uint(f); return b ^ ((unsigned)((int)b >> 31) | 0x80000000u); }
__device__ __forceinline__ float funkey(unsigned k) { return __uint_as_float((k & 0x80000000u) ? (k ^ 0x80000000u) : ~k); }
__device__ __forceinline__ unsigned umed3(unsigned a, unsigned b, unsigned c) { unsigned r; asm("v_med3_u32 %0, %1, %2, %3" : "=v"(r) : "v"(a), "v"(b), "v"(c)); return r; }
__device__ __forceinline__ void kins16(unsigned (&L)[16], unsigned k) {
#pragma unroll
    for (int p = 15; p >= 1; --p) L[p] = umed3(L[p - 1], L[p], k);
    L[0] = L[0] > k ? L[0] : k;
}
__device__ __forceinline__ void scan_set(unsigned (&L)[16], const bf16_t* qbase  , const bf16_t* kbase  , float* buf, int lane) {
    const int r32 = lane & 31, hi = lane >> 5;
#pragma unroll
    for (int p = 0; p < 16; ++p) L[p] = 0u;
    bf16x8 a0[8], a1[8];
    { const bf16_t* ap = qbase + (size_t)r32 * DM + hi * 8;
#pragma unroll
      for (int ks = 0; ks < 8; ++ks) { a0[ks] = *(const bf16x8*)(ap + ks * 16); a1[ks] = *(const bf16x8*)(ap + (size_t)32 * DM + ks * 16); } }
#pragma unroll 1
    for (int kb = 0; kb < 4; ++kb) {
        f32x16 acc0 = {}, acc1 = {};
        { const bf16_t* bp = kbase + (size_t)(kb * 32 + r32) * 128 + hi * 8;
          bf16x8 b[8];
#pragma unroll
          for (int ks = 0; ks < 8; ++ks) b[ks] = *(const bf16x8*)(bp + ks * 16);
#pragma unroll
          for (int ks = 0; ks < 8; ++ks) { acc0 = __builtin_amdgcn_mfma_f32_32x32x16_bf16(a0[ks], b[ks], acc0, 0, 0, 0); acc1 = __builtin_amdgcn_mfma_f32_32x32x16_bf16(a1[ks], b[ks], acc1, 0, 0, 0); } }
        wave_lds_fence();
#pragma unroll
        for (int r = 0; r < 16; ++r) { const int rowi = att::crow(r, hi); buf[rowi * 33 + r32] = acc0[r]; buf[(32 + rowi) * 33 + r32] = acc1[r]; }
        wave_lds_fence();
        const unsigned tb = 127u - (unsigned)(kb * 32);
#pragma unroll 8
        for (int k = 0; k < 32; ++k) { unsigned code = tb - (unsigned)k; asm volatile("" : "+s"(code)); kins16(L, (fkey(buf[lane * 33 + k]) & ~127u) | code); }
    }
}
__device__ __forceinline__ void peer_select_unit(const Ctx& F, int layer, int u) {
    const bf16_t* PQ = (const bf16_t*)(F.ws + WS_PQ); const bf16_t* SK = (const bf16_t*)(F.ws + WS_SUBK) + (size_t)layer * 8 * 2 * 128 * 128;
    int* PIDX = (int*)(F.ws + WS_PIDX); float* PG = (float*)(F.ws + WS_PG);
    float* buf = (float*)F.lds + F.wid * (64 * 33);
    const int lane = fresh_lane();
    {
        const int tile = u >> 3, h = u & 7, t0 = tile * 64;
        unsigned Ka[16], Kb[16];
        scan_set(Ka, PQ + (size_t)t0 * DM + h * 256, SK + (size_t)(h * 2) * 128 * 128, buf, lane);
        scan_set(Kb, PQ + (size_t)t0 * DM + h * 256 + 128, SK + (size_t)(h * 2 + 1) * 128 * 128, buf, lane);
        wave_lds_fence();
        float la[16], lb[16];
#pragma unroll
        for (int p = 0; p < 16; ++p) { la[p] = funkey(Ka[p] & ~127u); lb[p] = funkey(Kb[p] & ~127u);
            buf[lane * 33 + p] = __int_as_float(127 - (int)(Ka[p] & 127u)); buf[lane * 33 + 16 + p] = __int_as_float(127 - (int)(Kb[p] & 127u)); }
        wave_lds_fence();
        unsigned Kc[16];
#pragma unroll
        for (int p = 0; p < 16; ++p) Kc[p] = (fkey(la[0] + lb[p]) & ~255u) | (unsigned)(255 - p);
#pragma unroll
        for (int r1 = 1; r1 < 16; ++r1)
#pragma unroll
            for (int r2 = 0; r2 < 16; ++r2) if ((r1 + 1) * (r2 + 1) <= 16) kins16(Kc, (fkey(la[r1] + lb[r2]) & ~255u) | (unsigned)(255 - (16 * r1 + r2)));
        float bv[16], sm = 0.f; unsigned idx[16];
#pragma unroll
        for (int p = 0; p < 16; ++p) { const int code = 255 - (int)(Kc[p] & 255u); bv[p] = funkey(Kc[p] & ~255u);
            idx[p] = (unsigned)(__float_as_int(buf[lane * 33 + (code >> 4)]) * 128 + __float_as_int(buf[lane * 33 + 16 + (code & 15)])); }
        const float bmax = bv[0];
#pragma unroll
        for (int p = 0; p < 16; ++p) { bv[p] = __expf(bv[p] - bmax); sm += bv[p]; }
        const float inv = 1.f / sm;
        const size_t o = ((size_t)(t0 + lane) * 8 + h) * 16;
#pragma unroll
        for (int q = 0; q < 4; ++q) { *(f32x4*)(PG + o + q * 4) = (f32x4){bv[q * 4] * inv, bv[q * 4 + 1] * inv, bv[q * 4 + 2] * inv, bv[q * 4 + 3] * inv};
            *(u32x4*)(PIDX + o + q * 4) = (u32x4){idx[q * 4], idx[q * 4 + 1], idx[q * 4 + 2], idx[q * 4 + 3]}; }
    }
}
__device__ __forceinline__ bool ctx_sel_hidden(const Ctx& F) { return F.G == 256; }
__device__ __forceinline__ void peer_select_phase(const Ctx& F, int layer, int m_rows) {
    const int nunits = ((ctx_sel_hidden(F) ? TL : m_rows) / 64) * 8;
#pragma unroll 1
    for (int u = F.vcu * 8 + F.wid; u < nunits; u += F.G * 8) peer_select_unit(F, layer, u);
}

__device__ __forceinline__ float gelu_tanh(float a) { const float u = 0.7978845608028654f * (a + 0.044715f * a * a * a); const float t = 1.f - 2.f / (1.f + __expf(2.f * u)); return 0.5f * a * (1.f + t); }
struct Row6 { u32x2 r[3]; };
__device__ __forceinline__ void ld_row6(Row6& R, const unsigned char* tab, int e, int lane) {
    const u32x2* rp = (const u32x2*)(tab + (size_t)e * EROW + (unsigned)lane * 24u);
    R.r[0] = rp[0]; R.r[1] = rp[1]; R.r[2] = rp[2];
}
__device__ __forceinline__ v32f dq_row6(const Row6& R, float dep) { unsigned r0 = R.r[0].x; asm volatile("" : "+v"(r0) : "v"(dep));
    const v6u w = {r0, R.r[0].y, R.r[1].x, R.r[1].y, R.r[2].x, R.r[2].y}; return __builtin_amdgcn_cvt_scalef32_pk32_f32_fp6(w, 1.0f); }
__device__ __forceinline__ float dot_row6(const Row6& R, const float (&h)[32], float& chain) {
    const v32f f = dq_row6(R, chain);
    float s0 = 0.f, s1 = 0.f, s2 = 0.f, s3 = 0.f;
#pragma unroll
    for (int i = 0; i < 8; ++i) { s0 = fmaf(f[i * 4 + 0], h[i * 4 + 0], s0); s1 = fmaf(f[i * 4 + 1], h[i * 4 + 1], s1); s2 = fmaf(f[i * 4 + 2], h[i * 4 + 2], s2); s3 = fmaf(f[i * 4 + 3], h[i * 4 + 3], s3); }
    const float s = (s0 + s1) + (s2 + s3);
    chain = s;
    return s;
}
__device__ __forceinline__ void fma_row6(float (&out)[32], const Row6& R, float w) {
    const v32f f = dq_row6(R, out[0]);
#pragma unroll
    for (int i = 0; i < 32; ++i) out[i] = fmaf(w, f[i], out[i]);
}
__device__ __forceinline__ float reduce4(float s0, float s1, float s2, float s3, int lane) {
    const bool hi = (lane & 32) != 0, b4 = (lane & 16) != 0;
    const float r0 = xor32_partner(hi ? s0 : s2, lane), r1 = xor32_partner(hi ? s1 : s3, lane);
    const float a0 = (hi ? s2 : s0) + r0, a1 = (hi ? s3 : s1) + r1;
    const float r = swz_xor<16>(b4 ? a0 : a1);
    float b = (b4 ? a1 : a0) + r;
    b += swz_xor<8>(b); b += swz_xor<4>(b); b += swz_xor<2>(b); b += swz_xor<1>(b);
    return b;
}
__device__ __forceinline__ float rl_f(float v, int l) { return __uint_as_float(__builtin_amdgcn_readlane(__float_as_uint(v), l)); }
__device__ __forceinline__ void wr_lane(float& dst, float val_uniform, int lane_uniform, int lane) { asm volatile("" : "+s"(lane_uniform)); dst = (lane == lane_uniform) ? val_uniform : dst; }
__device__ __forceinline__ void peer_expert_tokens(const Ctx& F, CParams& P, int layer, int m_rows_all, bool last, bool dry, bool hide, unsigned* selflag, int k_lo, int k_hi) {
    const unsigned char* EU = F.ws + WS_EU + (size_t)layer * NEXP * EROW; const unsigned char* EV = F.ws + WS_EV + (size_t)layer * NEXP * EROW;
    const float* SU = (const float*)(F.ws + WS_SU) + (size_t)layer * NEXP; const float* SV = (const float*)(F.ws + WS_SV) + (size_t)layer * NEXP;
    const bf16_t* H = (const bf16_t*)(F.ws + WS_H); float* X = (float*)(F.ws + WS_X);
    const int* PIDX = (const int*)(F.ws + WS_PIDX); const float* PG = (const float*)(F.ws + WS_PG);
    const float* mod = (const float*)(F.ws + WS_MOD) + (size_t)layer * 3 * 12288;
    const int lane = fresh_lane();
    const int tstride = F.G * 8, t0 = F.vcu * 8 + F.wid + k_lo * tstride;
    const int m_hi = F.vcu * 8 + F.wid + k_hi * tstride, m_rows = m_hi < m_rows_all ? m_hi : m_rows_all;
    if (t0 >= m_rows) return;
    int id0 = PIDX[(size_t)t0 * 128 + lane], id1 = PIDX[(size_t)t0 * 128 + 64 + lane];
    u32x4 hp4[4]; float gk0, gk1;
    { const u32x4* hp = (const u32x4*)(H + (size_t)t0 * DM + (unsigned)lane * 32u);
#pragma unroll
      for (int j = 0; j < 4; ++j) hp4[j] = hp[j]; }
    gk0 = PG[(size_t)t0 * 128 + lane]; gk1 = PG[(size_t)t0 * 128 + 64 + lane];
    Row6 A[4], B[4];
#pragma unroll
    for (int q = 0; q < 4; ++q) ld_row6(A[q], EU, __builtin_amdgcn_readlane(id0, q), lane);
    for (int t = t0; t < m_rows; t += tstride) {
        const int tn = t + tstride; const int tq = tn < m_rows ? tn : t;
        float hf[32];
#pragma unroll
        for (int j = 0; j < 4; ++j)
#pragma unroll
            for (int q = 0; q < 4; ++q) { hf[j * 8 + q * 2] = bf_lo(hp4[j][q]); hf[j * 8 + q * 2 + 1] = bf_hi(hp4[j][q]); }
        const float cgk0 = gk0, cgk1 = gk1;
        const float su0 = SU[id0], sv0 = SV[id0], su1 = SU[id1], sv1 = SV[id1];
        int nid0, nid1; float ngk0, ngk1;
        if (hide && tq >= TL) {
            { unsigned sp = 0u; while (xb_ld(selflag) < (unsigned)((TT - TL) / 64 * 8)) { __builtin_amdgcn_s_sleep(1); if (++sp > XB_SPIN_CAP) break; } }
            __builtin_amdgcn_fence(__ATOMIC_ACQUIRE, "agent");
            nid0 = __hip_atomic_load(PIDX + (size_t)tq * 128 + lane, __ATOMIC_RELAXED, __HIP_MEMORY_SCOPE_AGENT); nid1 = __hip_atomic_load(PIDX + (size_t)tq * 128 + 64 + lane, __ATOMIC_RELAXED, __HIP_MEMORY_SCOPE_AGENT);
            ngk0 = __int_as_float(__hip_atomic_load((const int*)PG + (size_t)tq * 128 + lane, __ATOMIC_RELAXED, __HIP_MEMORY_SCOPE_AGENT)); ngk1 = __int_as_float(__hip_atomic_load((const int*)PG + (size_t)tq * 128 + 64 + lane, __ATOMIC_RELAXED, __HIP_MEMORY_SCOPE_AGENT));
        } else { nid0 = PIDX[(size_t)tq * 128 + lane]; nid1 = PIDX[(size_t)tq * 128 + 64 + lane]; ngk0 = PG[(size_t)tq * 128 + lane]; ngk1 = PG[(size_t)tq * 128 + 64 + lane]; }
        { const u32x4* hp = (const u32x4*)(H + (size_t)tq * DM + (unsigned)lane * 32u);
#pragma unroll
          for (int j = 0; j < 4; ++j) hp4[j] = hp[j]; }
        gk0 = ngk0; gk1 = ngk1;
        float wv0 = 0.f, wv1 = 0.f;
        float out[32];
#pragma unroll
        for (int i = 0; i < 32; ++i) out[i] = 0.f;
#pragma unroll
        for (int seg = 0; seg < 4; ++seg) {
            const int idc = (seg & 1) ? id1 : id0;
            const int idn = (seg == 0) ? id1 : (seg == 1 ? id0 : (seg == 2 ? id1 : nid0));
            const unsigned char* tabc = seg < 2 ? EU : EV; const unsigned char* tabn = (seg == 0 || seg == 3) ? EU : EV;
            const float wr = (seg & 1) ? wv1 : wv0;
            float acc = 0.f, chain = 0.f;
#pragma unroll 1
            for (int k = 0; k < 64; k += 8) {
#pragma unroll
                for (int q = 0; q < 4; ++q) ld_row6(B[q], tabc, __builtin_amdgcn_readlane(idc, k + 4 + q), lane);
                if (seg < 2) { const float d0 = dot_row6(A[0], hf, chain), d1 = dot_row6(A[1], hf, chain), d2 = dot_row6(A[2], hf, chain), d3 = dot_row6(A[3], hf, chain); const float b = reduce4(d0, d1, d2, d3, lane);
#pragma unroll
                    for (int q = 0; q < 4; ++q) wr_lane(acc, rl_f(b, 16 * q), k + q, lane); }
                else {
#pragma unroll
                    for (int q = 0; q < 4; ++q) fma_row6(out, A[q], rl_f(wr, k + q)); }
                { const bool nx = k + 8 >= 64;
#pragma unroll
                  for (int q = 0; q < 4; ++q) { const int ec = __builtin_amdgcn_readlane(idc, (k + 8 + q) & 63), en = __builtin_amdgcn_readlane(idn, q);
                      ld_row6(A[q], nx ? tabn : tabc, nx ? en : ec, lane); } }
                if (seg < 2) { const float d0 = dot_row6(B[0], hf, chain), d1 = dot_row6(B[1], hf, chain), d2 = dot_row6(B[2], hf, chain), d3 = dot_row6(B[3], hf, chain); const float b = reduce4(d0, d1, d2, d3, lane);
#pragma unroll
                    for (int q = 0; q < 4; ++q) wr_lane(acc, rl_f(b, 16 * q), k + 4 + q, lane); }
                else {
#pragma unroll
                    for (int q = 0; q < 4; ++q) fma_row6(out, B[q], rl_f(wr, k + 4 + q)); }
            }
            if (seg == 0) wv0 = cgk0 * gelu_tanh(acc * su0) * sv0;
            if (seg == 1) wv1 = cgk1 * gelu_tanh(acc * su1) * sv1;
        }
        id0 = nid0; id1 = nid1;
        const int vs = vsel_of_row(t);
        const float* gate = mod + (size_t)vs * 12288 + 5 * DM;
        float* xr = X + (size_t)t * DM; float* dst = dry ? (float*)(F.ws + WS_OF) + (size_t)t * DM : (last ? P.out + (size_t)t * DM : xr);
        float ssq = 0.f;
        const unsigned lo32 = (unsigned)lane * 32u;
        { f32x4 xo[8], gg[8];
#pragma unroll
          for (int q = 0; q < 8; ++q) { const unsigned c = lo32 + q * 4; xo[q] = *(const f32x4*)(xr + c); gg[q] = *(const f32x4*)(gate + c); }
#pragma unroll
          for (int q = 0; q < 8; ++q) { const unsigned c = lo32 + q * 4;
            f32x4 y; y[0] = xo[q][0] + gg[q][0] * out[q * 4 + 0]; y[1] = xo[q][1] + gg[q][1] * out[q * 4 + 1]; y[2] = xo[q][2] + gg[q][2] * out[q * 4 + 2]; y[3] = xo[q][3] + gg[q][3] * out[q * 4 + 3];
            *(f32x4*)(dst + c) = y;
            out[q * 4 + 0] = y[0]; out[q * 4 + 1] = y[1]; out[q * 4 + 2] = y[2]; out[q * 4 + 3] = y[3];
            ssq += y[0] * y[0] + y[1] * y[1] + y[2] * y[2] + y[3] * y[3]; } }
        if (!last && !dry) {
            const float rstd = rsqrtf(wave_sum(ssq) * (1.f / DM) + EPS);
            const float* gn = P.g_norm1 + (size_t)(layer + 1) * DM;
            const float* shf = mod + (size_t)3 * 12288 + (size_t)vs * 12288; const float* scl = shf + DM;
            bf16_t* hrow = (bf16_t*)(F.ws + WS_H) + (size_t)t * DM;
#pragma unroll
            for (int jh = 0; jh < 2; ++jh) { f32x4 g8[4], sc8[4], sh8[4];
#pragma unroll
                for (int i = 0; i < 4; ++i) { const unsigned c = lo32 + jh * 16 + i * 4; g8[i] = *(const f32x4*)(gn + c); sc8[i] = *(const f32x4*)(scl + c); sh8[i] = *(const f32x4*)(shf + c); }
#pragma unroll
                for (int jj = 0; jj < 2; ++jj) { const int j = jh * 2 + jj; u32x4 w;
#pragma unroll
                    for (int q = 0; q < 2; ++q) { const f32x4 g = g8[jj * 2 + q], sc = sc8[jj * 2 + q], sh = sh8[jj * 2 + q];
                        float y[4];
#pragma unroll
                        for (int e2 = 0; e2 < 4; ++e2) y[e2] = (out[j * 8 + q * 4 + e2] * rstd * g[e2]) * (1.f + sc[e2]) + sh[e2];
                        w[q * 2] = cvt_pk_bf16(y[0], y[1]); w[q * 2 + 1] = cvt_pk_bf16(y[2], y[3]); }
                    *(u32x4*)(hrow + lo32 + j * 8) = w; } }
        }
    }
}

__device__ __forceinline__ void ctl_wait(unsigned* c, unsigned want) { unsigned sp = 0u; while (xb_ld(c) < want) { __builtin_amdgcn_s_sleep(1); if (++sp > XB_SPIN_CAP) break; } }
__device__ __forceinline__ void peer_expert_phase(const Ctx& F, CParams& P, int layer, int m_rows, bool last, bool dry, LAS unsigned char* ldsl, const bf16_t* Wout) {
    const bool hide = ctx_sel_hidden(F) && m_rows > TL && !dry;
    unsigned* ctl = (unsigned*)(F.ws + WS_CTL) + 8192 + layer * 512;
    unsigned* selflag = ctl;
    int role = 0, ri = 0;
    if (hide && F.vcu >= 64) { const int d = F.vcu - 64;
        if (d % 12 == 0) { role = 1; ri = d / 12; } else if (d % 12 == 6) { role = 2; ri = d / 12; } else if (d % 3 == 1 && F.wid == 0) { role = 3; ri = d / 3; } }
    const int ksplit = role == 1 ? 0 : (role == 2 ? 1 : (role == 3 ? 2 : 9));
#pragma unroll 1
    for (int st = 0; st < 2; ++st) {
        const int kb = st == 0 ? 0 : ksplit, ke = st == 0 ? ksplit : 9;
        if (ke > kb) peer_expert_tokens(F, P, layer, m_rows, last, dry, hide, selflag, kb, ke);
        if (st != 0 || role == 0) continue;
        const int pmi = ri >> 3, pn = ri & 7, pm = TL / 256 + pmi;
        if (role == 1) {
            { pg8::Gemm g{(const bf16_t*)(F.ws + WS_AO), Wout, TT, DM, DM, DM}; pg8::OneUnit S{pm, pn};
              pg8::EpiResid E{(float*)(F.ws + WS_X), (const float*)(F.ws + WS_MOD) + (size_t)layer * 3 * 12288, 2, layer == 0 ? P.x : (const float*)(F.ws + WS_X), layer == 0 ? P.ctx : (const float*)(F.ws + WS_X) + (size_t)TL * DM};
              pg8::gemm_phase<pg8::EpiResid, pg8::OneUnit>(ldsl, g, S, E, F.wid); }
            asm volatile("s_waitcnt vmcnt(0)" ::: "memory"); __syncthreads();
            if (F.wid == 0 && fresh_lane() == 0) { __builtin_amdgcn_fence(__ATOMIC_RELEASE, "agent"); asm volatile("s_waitcnt vmcnt(0)" ::: "memory"); (void)xb_add(ctl + 64 + 64 * pmi, 1u);
                           ctl_wait(ctl + 64 + 64 * pmi, 8u); __builtin_amdgcn_fence(__ATOMIC_ACQUIRE, "agent"); }
            __syncthreads();
            { const int r0 = pm * 256 + pn * 32 + F.wid * 4; norm_rows(F, P, layer, 1, r0, r0 + 4, 1); }
            asm volatile("s_waitcnt vmcnt(0)" ::: "memory"); __syncthreads();
            if (F.wid == 0 && fresh_lane() == 0) { __builtin_amdgcn_fence(__ATOMIC_RELEASE, "agent"); asm volatile("s_waitcnt vmcnt(0)" ::: "memory"); (void)xb_add(ctl + 192 + 64 * pmi, 1u); }
        } else if (role == 2) {
            __syncthreads();
            if (F.wid == 0 && fresh_lane() == 0) { ctl_wait(ctl + 192 + 64 * pmi, 8u); __builtin_amdgcn_fence(__ATOMIC_ACQUIRE, "agent"); }
            __syncthreads();
            { pg8::Gemm g{(const bf16_t*)(F.ws + WS_H), (const bf16_t*)(F.ws + WS_WPQ) + (size_t)layer * DM * DM, TT, DM, DM, DM}; pg8::OneUnit S{pm, pn};
              pg8::EpiBf16 E{(bf16_t*)(F.ws + WS_PQ), DM};
              pg8::gemm_phase<pg8::EpiBf16, pg8::OneUnit>(ldsl, g, S, E, F.wid); }
            asm volatile("s_waitcnt vmcnt(0)" ::: "memory"); __syncthreads();
            if (F.wid == 0 && fresh_lane() == 0) { __builtin_amdgcn_fence(__ATOMIC_RELEASE, "agent"); asm volatile("s_waitcnt vmcnt(0)" ::: "memory"); (void)xb_add(ctl + 320, 1u); }
        } else {
            ctl_wait(ctl + 320, 16u); __builtin_amdgcn_fence(__ATOMIC_ACQUIRE, "agent");
            peer_select_unit(F, layer, (TL / 64) * 8 + ri);
            __builtin_amdgcn_fence(__ATOMIC_RELEASE, "agent");
            asm volatile("s_waitcnt vmcnt(0)" ::: "memory");
            if (fresh_lane() == 0) (void)xb_add(selflag, 1u);
        }
    }
}

__device__ __forceinline__ void qkv_odd_phase(const Ctx& F, CParams& P, int e, int layer, LAS unsigned char* ldsl) {
    if (!ctx_sel_hidden(F)) { qkv_odd_rows(F, P, e, F.vcu * 8 + F.wid, TT, F.G * 8); return; }
    const int vx = F.vcu & 31, xq = F.vcu >> 5;
    if (vx >= 29) {
        const int i = xq * 3 + vx - 29, pmi = i / 12, pn = i % 12;
        unsigned* cnt = (unsigned*)(F.ws + WS_CTL) + 8192 + layer * 512 + 384 + 64 * pmi;
        { pg8::Gemm g{(const bf16_t*)(F.ws + WS_H), (const bf16_t*)(F.ws + WS_WINC) + (size_t)e * C_IN * DM, TT, C_IN, DM, DM}; pg8::OneUnit S{TL / 256 + pmi, pn};
          pg8::EpiBf16V E{(bf16_t*)(F.ws + WS_P1), C_IN, (bf16_t*)(F.ws + WS_V1), 10, 512};
          pg8::gemm_phase<pg8::EpiBf16V, pg8::OneUnit>(ldsl, g, S, E, F.wid); }
        asm volatile("s_waitcnt vmcnt(0)" ::: "memory"); __syncthreads();
        if (F.wid == 0 && fresh_lane() == 0) { __builtin_amdgcn_fence(__ATOMIC_RELEASE, "agent"); asm volatile("s_waitcnt vmcnt(0)" ::: "memory"); (void)xb_add(cnt, 1u);
                                               ctl_wait(cnt, 12u); __builtin_amdgcn_fence(__ATOMIC_ACQUIRE, "agent"); }
        __syncthreads();
        qkv_odd_rows(F, P, e, TL + pmi * 256 + pn * 8 + F.wid, TL + pmi * 256 + 256, 96);
    } else qkv_odd_rows(F, P, e, (F.vcu - 3 * xq) * 8 + F.wid, TL, 232 * 8);
}

constexpr int N_PHASES = 1 + 2 * 11 + 2 * 9 - 3;
__global__ void __launch_bounds__(512, 2) mk_fwd(Params Pval) {
    extern __shared__ __attribute__((aligned(16))) unsigned char lds_raw[];
    LAS unsigned char* ldsl = (LAS unsigned char*)lds_raw;
    volatile LAS unsigned* misc = (volatile LAS unsigned*)(ldsl + LDS_MISC);
    if (threadIdx.x < 16) misc[threadIdx.x] = 0u;
    __syncthreads();
    XcdBarrier bar = xcd_barrier_post((unsigned*)(Pval.ws + WS_CTL) + 1024, misc);
    const int wid0 = __builtin_amdgcn_readfirstlane((int)threadIdx.x >> 6);
    const int lo = Pval.ph_lo, hi = Pval.ph_hi; int ph = 0;
#define MKCTX() Ctx F; { const int lane_ = fresh_lane(); int wid_ = wid0; asm volatile("" : "+s"(wid_)); const int tid_ = wid_ * 64 + lane_; F.tid = tid_; F.lane = lane_; F.wid = wid_; \
        int G_ = gridDim.x, bx_ = blockIdx.x; asm volatile("" : "+s"(G_), "+s"(bx_)); F.G = G_; F.vcu = (G_ % 8 == 0) ? (bx_ % 8) * (G_ / 8) + bx_ / 8 : bx_; F.bx = bx_; } \
        unsigned long long kp_ = (unsigned long long)__builtin_amdgcn_kernarg_segment_ptr(); asm volatile("" : "+s"(kp_)); CParams& P = *(CParams*)kp_; \
        F.ws = P.ws; F.lds = (char*)lds_raw; unsigned char* ws = F.ws; (void)ws; \
        bf16_t* Hb = (bf16_t*)(ws + WS_H); bf16_t* P1 = (bf16_t*)(ws + WS_P1); float* X = (float*)(ws + WS_X); const float* mod = (const float*)(ws + WS_MOD); (void)Hb; (void)P1; (void)X; (void)mod;
#define PHASE(cls, ...) do { if (ph >= lo && ph < hi) { if constexpr ((PH_MASK >> (cls)) & 1u) { \
        if constexpr ((PH_DOUBLE >> (cls)) & 1u) { const bool dry = true; (void)dry; MKCTX(); __VA_ARGS__; __syncthreads(); } \
        { const bool dry = false; (void)dry; MKCTX(); __VA_ARGS__; } } if (ph + 1 < hi) { int w0_ = wid0; asm volatile("" : "+s"(w0_)); xcd_barrier(bar, w0_ == 0 && fresh_lane() == 0); } } ++ph; } while (0)

    PHASE(0, prologue_phase(F, P));
#pragma unroll 1
    for (int layer = 0; layer < DEPTH; ++layer) {
        const int e = layer >> 1; const bool even = (layer & 1) == 0, lastl = layer == DEPTH - 1;
        const int m_post = lastl ? TL : TT;
        if (layer == 0) PHASE(1, norm_phase(F, P, layer, 0, TT));
        PHASE(2, { const bf16_t* W = even ? (const bf16_t*)(ws + WS_WINAB) + (size_t)e * AB_INP * DM : (const bf16_t*)(ws + WS_WINC) + (size_t)e * C_IN * DM;
                const int N = even ? AB_INP : C_IN;
                const int m2 = (!even && ctx_sel_hidden(F)) ? TL : TT;
                pg8::Gemm g{Hb, W, m2, N, DM, DM}; pg8::StaticOrder S; S.init(m2, N, F.G, F.bx);
                pg8::EpiBf16V E{P1, N, even ? (bf16_t*)(ws + WS_V2) : (bf16_t*)(ws + WS_V1), even ? 14 : 10, even ? 1024 : 512};
                pg8::gemm_phase<pg8::EpiBf16V, pg8::StaticOrder>(ldsl, g, S, E, F.wid); });
        if (even) {
            PHASE(3, { { pg8::Gemm g{P1, (const bf16_t*)(ws + WS_WUQ) + (size_t)e * 1536 * 768, TT, 1536, 768, AB_INP}; pg8::StaticOrder S; S.init(TT, 1536, F.G, F.bx);
                      pg8::EpiBf16 E{(bf16_t*)(ws + WS_QA), 1536};
                      pg8::gemm_phase<pg8::EpiBf16, pg8::StaticOrder>(ldsl, g, S, E, F.wid); }
                    { pg8::Gemm g{P1 + 768, (const bf16_t*)(ws + WS_WUKV) + (size_t)e * 2048 * 512, TT, 2048, 512, AB_INP}; pg8::StaticOrder S; S.init(TT, 2048, F.G, F.G - 1 - F.bx);
                      pg8::EpiBf16 E{(bf16_t*)(ws + WS_KV), 2048};
                      pg8::gemm_phase<pg8::EpiBf16, pg8::StaticOrder>(ldsl, g, S, E, F.wid); } });
            PHASE(4, qkv_even_phase(F, P, e));
            PHASE(5, { if constexpr (ATT_DBL & 1) attn_phase<192, MLA_SD, 2048, 8, 8, 8>(F, (const bf16_t*)(ws + WS_Q1), (const bf16_t*)(ws + WS_K1), (const bf16_t*)(ws + WS_V1), (bf16_t*)(ws + WS_AO), 0, !lastl, ((const float*)(ws + WS_LAM))[4 + layer * 2]);
                    if constexpr (ATT_DBL & 2) attn_phase<64, 2, 2048, 16, 16, 8>(F, (const bf16_t*)(ws + WS_Q2), (const bf16_t*)(ws + WS_K2), (const bf16_t*)(ws + WS_V2), (bf16_t*)(ws + WS_OF), 0, !lastl, ((const float*)(ws + WS_LAM))[4 + layer * 2 + 1]);
                    if constexpr (ATT_SEL & 1) attn_phase<192, MLA_SD, 2048, 8, 8, 8>(F, (const bf16_t*)(ws + WS_Q1), (const bf16_t*)(ws + WS_K1), (const bf16_t*)(ws + WS_V1), (bf16_t*)(ws + WS_AO), 0, !lastl, ((const float*)(ws + WS_LAM))[4 + layer * 2]);
                    if constexpr (ATT_SEL & 2) attn_phase<64, 2, 2048, 16, 16, 8>(F, (const bf16_t*)(ws + WS_Q2), (const bf16_t*)(ws + WS_K2), (const bf16_t*)(ws + WS_V2), (bf16_t*)(ws + WS_OF), 0, !lastl, ((const float*)(ws + WS_LAM))[4 + layer * 2 + 1]); });
            PHASE(6, merge_even_phase(F, P, e, layer, m_post));
        } else {
            PHASE(7, qkv_odd_phase(F, P, e, layer, ldsl));
            PHASE(8, attn_phase<128, GQA_SD, 2048, 16, 4, 4>(F, (const bf16_t*)(ws + WS_Q1), (const bf16_t*)(ws + WS_K1), (const bf16_t*)(ws + WS_V1), (bf16_t*)(ws + WS_AO), 0, !lastl, ((const float*)(ws + WS_LAM))[4 + layer * 2]));
        }
        PHASE(10, { const bf16_t* W = even ? (const bf16_t*)(ws + WS_WOUTAB) + (size_t)e * DM * DM : (const bf16_t*)(ws + WS_WOUTC) + (size_t)e * DM * DM;
                const int m10 = ctx_sel_hidden(F) ? TL : m_post; pg8::Gemm g{(const bf16_t*)(ws + WS_AO), W, m10, DM, DM, DM}; pg8::StaticOrder S; S.init(m10, DM, F.G, F.bx);
                pg8::EpiResid E{X, mod + (size_t)layer * 3 * 12288, 2, layer == 0 ? P.x : (const float*)X, layer == 0 ? P.ctx : (const float*)X + (size_t)TL * DM};
                pg8::gemm_phase<pg8::EpiResid, pg8::StaticOrder>(ldsl, g, S, E, F.wid); });
        PHASE(1, norm_phase(F, P, layer, 1, ctx_sel_hidden(F) ? TL : m_post));
        PHASE(11, { const int m11 = ctx_sel_hidden(F) ? TL : m_post; pg8::Gemm g{Hb, (const bf16_t*)(ws + WS_WPQ) + (size_t)layer * DM * DM, m11, DM, DM, DM}; pg8::StaticOrder S; S.init(m11, DM, F.G, F.bx);
                pg8::EpiBf16 E{(bf16_t*)(ws + WS_PQ), DM};
                pg8::gemm_phase<pg8::EpiBf16, pg8::StaticOrder>(ldsl, g, S, E, F.wid); });
        PHASE(12, peer_select_phase(F, layer, m_post));
        PHASE(13, { const bf16_t* W = even ? (const bf16_t*)(ws + WS_WOUTAB) + (size_t)e * DM * DM : (const bf16_t*)(ws + WS_WOUTC) + (size_t)e * DM * DM;
                peer_expert_phase(F, P, layer, m_post, lastl, dry, ldsl, W); });
    }
#undef PHASE
}

extern "C" void kernel_launch(void* const* d_in, const int* in_sizes, int n_in, void* d_out, int out_size, void* d_ws, size_t ws_size, hipStream_t stream) {
    static int grid = 0;
    if (grid == 0) {
        if (n_in != 28 || ws_size < WS_END) { fprintf(stderr, "kernel_launch: expected 28 inputs and >= %zu bytes of workspace, got %d / %zu\n", (size_t)WS_END, n_in, ws_size); grid = -1; return; }
        int dev = 0, cus = 0, per_cu = 0;
        if (hipGetDevice(&dev) != hipSuccess || hipDeviceGetAttribute(&cus, hipDeviceAttributeMultiprocessorCount, dev) != hipSuccess) { grid = -1; return; }
        if (hipFuncSetAttribute((const void*)mk_fwd, hipFuncAttributeMaxDynamicSharedMemorySize, LDS_BYTES) != hipSuccess) { fprintf(stderr, "kernel_launch: hipFuncSetAttribute failed\n"); grid = -1; return; }
        if (hipOccupancyMaxActiveBlocksPerMultiprocessor(&per_cu, (const void*)mk_fwd, 512, LDS_BYTES) != hipSuccess || per_cu < 1) fprintf(stderr, "kernel_launch: occupancy query says %d\n", per_cu);
        (void)hipGetLastError();
        grid = cus;
    }
    if (grid < 0) return;
    (void)hipMemsetAsync((char*)d_ws + WS_CTL, 0, CTL_BYTES, stream);
    Params p{};
    const float** pf = (const float**)&p;
    for (int i = 0; i < 28; ++i) pf[i] = (const float*)d_in[i];
    p.out = (float*)d_out; p.ws = (unsigned char*)d_ws;
#if MK_PER_PHASE_LAUNCH
    for (int i = 0; i < N_PHASES; ++i) { p.ph_lo = i; p.ph_hi = i + 1; hipLaunchKernelGGL(mk_fwd, dim3(grid), dim3(512), LDS_BYTES, stream, p); }
#else
    p.ph_lo = 0; p.ph_hi = N_PHASES;
    hipLaunchKernelGGL(mk_fwd, dim3(grid), dim3(512), LDS_BYTES, stream, p);
#endif
    const hipError_t le = hipPeekAtLastError();
    if (le != hipSuccess) fprintf(stderr, "kernel_launch: launch failed: %s\n", hipGetErrorName(le));
}
```

```cpp
#include <hip/hip_runtime.h>
#include <stdint.h>
#include <stdio.h>

#ifndef MK_PER_PHASE_LAUNCH
#define MK_PER_PHASE_LAUNCH 0
#endif

#ifndef MLA_QL
#define MLA_QL 0
#endif
#ifndef GQA_QL
#define GQA_QL 0
#endif
#ifndef QKT_GRP
#define QKT_GRP 12
#endif
#ifndef EB
#define EB 4
#endif
#ifndef PV_PIPE
#define PV_PIPE 0
#endif
#ifndef ATT_DBL
#define ATT_DBL 0
#endif
#ifndef ATT_PRIO
#define ATT_PRIO 1
#endif
#ifndef MLA_SD
#define MLA_SD 1
#endif
#ifndef GQA_SD
#define GQA_SD 2
#endif
#ifndef ATT_SEL
#define ATT_SEL 3
#endif
#ifndef PH_DOUBLE
#define PH_DOUBLE 0u
#endif
#ifndef PH_MASK
#define PH_MASK 0xFFFFFFFFu
#endif
#define LAS __attribute__((address_space(3)))
typedef unsigned short bf16_t;
typedef short bf16x8 __attribute__((ext_vector_type(8)));
typedef short s16x4 __attribute__((ext_vector_type(4)));
typedef float f32x4 __attribute__((ext_vector_type(4)));
typedef float f32x2 __attribute__((ext_vector_type(2)));
typedef float f32x16 __attribute__((ext_vector_type(16)));
typedef unsigned u32x4 __attribute__((ext_vector_type(4)));
typedef unsigned u32x2 __attribute__((ext_vector_type(2)));
typedef __bf16 bf16x2_t __attribute__((ext_vector_type(2)));

constexpr int DM = 2048, NB = 2, SEQ = 8192, DEPTH = 4, CTXL = 256;
constexpr int TL = NB * SEQ;
constexpr int TZ = NB * CTXL;
constexpr int TT = TL + TZ;
constexpr int KPB = SEQ + CTXL;
constexpr int AB_IN = 4416, AB_INP = 4608;
constexpr int C_IN = 3072;
constexpr int NEXP = 16384;
constexpr float EPS = 1e-6f;
constexpr float LOG2E = 1.4426950408889634f;

constexpr size_t al256(size_t x) { return (x + 255) / 256 * 256; }
constexpr size_t WS_CTL = 0, CTL_BYTES = 1u << 20;
constexpr size_t WS_MOD = WS_CTL + CTL_BYTES;
constexpr size_t WS_TAB16 = WS_MOD + al256((size_t)4 * 3 * 12288 * 4);
constexpr size_t WS_TAB32 = WS_TAB16 + al256((size_t)128 * 16 * 2 * 4);
constexpr size_t WS_LAM = WS_TAB32 + al256((size_t)128 * 32 * 2 * 4);
constexpr size_t WS_WINAB = WS_LAM + 256;
constexpr size_t WS_WUQ = WS_WINAB + (size_t)2 * AB_INP * DM * 2;
constexpr size_t WS_WUKV = WS_WUQ + (size_t)2 * 1536 * 768 * 2;
constexpr size_t WS_WOUTAB = WS_WUKV + (size_t)2 * 2048 * 512 * 2;
constexpr size_t WS_WINC = WS_WOUTAB + (size_t)2 * DM * DM * 2;
constexpr size_t WS_WOUTC = WS_WINC + (size_t)2 * C_IN * DM * 2;
constexpr size_t WS_WPQ = WS_WOUTC + (size_t)2 * DM * DM * 2;
constexpr size_t WS_SUBK = WS_WPQ + (size_t)4 * DM * DM * 2;
constexpr size_t WS_EU = WS_SUBK + (size_t)4 * 8 * 2 * 128 * 128 * 2;
constexpr int EROW = DM * 6 / 8;
constexpr size_t WS_EV = WS_EU + (size_t)4 * NEXP * DM;
constexpr size_t WS_SU = WS_EV + (size_t)4 * NEXP * DM;
constexpr size_t WS_SV = WS_SU + (size_t)4 * NEXP * 4;
constexpr size_t WS_X = WS_SV + (size_t)4 * NEXP * 4;
constexpr size_t WS_H = WS_X + (size_t)TT * DM * 4;
constexpr size_t WS_P1 = WS_H + (size_t)TT * DM * 2;
constexpr size_t WS_QA = WS_P1 + (size_t)TT * AB_INP * 2;
constexpr size_t WS_KV = WS_QA + (size_t)TT * 1536 * 2;
constexpr size_t WS_Q1 = WS_KV + (size_t)TT * 2048 * 2;
constexpr size_t WS_K1 = WS_Q1 + (size_t)TT * 2048 * 2;
constexpr size_t WS_V1 = WS_K1 + (size_t)TT * 1536 * 2;
constexpr size_t WS_Q2 = WS_V1 + (size_t)TT * 1024 * 2;
constexpr size_t WS_K2 = WS_Q2 + (size_t)TT * 1024 * 2;
constexpr size_t WS_V2 = WS_K2 + (size_t)TT * 1024 * 2;
constexpr size_t WS_OF = WS_V2 + (size_t)TT * 1024 * 2;
constexpr size_t WS_AO = WS_OF + (size_t)TT * 3072 * 4;
constexpr size_t WS_PQ = WS_AO + (size_t)TT * DM * 2;
constexpr size_t WS_PIDX = WS_PQ + (size_t)TT * DM * 2;
constexpr size_t WS_PG = WS_PIDX + (size_t)TT * 128 * 4;
constexpr size_t WS_END = WS_PG + (size_t)TT * 128 * 4;

constexpr int LDS_MAIN = 157696;
constexpr int LDS_MISC = LDS_MAIN;
constexpr int LDS_BYTES = LDS_MAIN + 4096;

__device__ __forceinline__ unsigned cvt_pk_bf16(float lo, float hi) { unsigned r; asm("v_cvt_pk_bf16_f32 %0, %1, %2" : "=v"(r) : "v"(lo), "v"(hi)); return r; }
__device__ __forceinline__ float bf_lo(unsigned w) { return __uint_as_float(w << 16); }
__device__ __forceinline__ float bf_hi(unsigned w) { return __uint_as_float(w & 0xffff0000u); }
template <int M> __device__ __forceinline__ float swz_xor(float v) { return __int_as_float(__builtin_amdgcn_ds_swizzle(__float_as_int(v), (M << 10) | 0x1f)); }
__device__ __forceinline__ float xor32_partner(float v, int lane) {
    const auto rr = __builtin_amdgcn_permlane32_swap(__float_as_uint(v), __float_as_uint(v), false, false);
    return __uint_as_float(lane < 32 ? rr[1] : rr[0]);
}
__device__ __forceinline__ float hw_sum(float v) {
    v += swz_xor<16>(v); v += swz_xor<8>(v); v += swz_xor<4>(v); v += swz_xor<2>(v); v += swz_xor<1>(v);
    return v;
}
__device__ __forceinline__ float wave_sum(float v) {
    v = hw_sum(v);
    const auto rr = __builtin_amdgcn_permlane32_swap(__float_as_uint(v), __float_as_uint(v), false, false);
    return __uint_as_float(rr[0]) + __uint_as_float(rr[1]);
}
__device__ __forceinline__ float wave_max(float v) {
    v = fmaxf(v, swz_xor<16>(v)); v = fmaxf(v, swz_xor<8>(v)); v = fmaxf(v, swz_xor<4>(v)); v = fmaxf(v, swz_xor<2>(v)); v = fmaxf(v, swz_xor<1>(v));
    const auto rr = __builtin_amdgcn_permlane32_swap(__float_as_uint(v), __float_as_uint(v), false, false);
    return fmaxf(__uint_as_float(rr[0]), __uint_as_float(rr[1]));
}
__device__ __forceinline__ int mbcnt64(unsigned long long m) { return (int)__builtin_amdgcn_mbcnt_hi((unsigned)(m >> 32), __builtin_amdgcn_mbcnt_lo((unsigned)m, 0u)); }
__device__ __forceinline__ int fresh_lane() { int l; asm volatile("v_mbcnt_lo_u32_b32 %0, -1, 0\n\tv_mbcnt_hi_u32_b32 %0, -1, %0" : "=v"(l)); return l; }
__device__ __forceinline__ int krow_of(int t) { return t < TL ? (t >> 13) * KPB + (t & (SEQ - 1)) : ((t - TL) >> 8) * KPB + SEQ + ((t - TL) & (CTXL - 1)); }
__device__ __forceinline__ int vsel_of_row(int t) { return t < SEQ ? 0 : (t < TL ? 1 : 2); }

#define XB_TMO      128
#define XB_XCNT(j)  (256  + 64 * (j))
#define XB_XSUB(j)  (1280 + 64 * (j))
#define XB_XGEN(j)  (2304 + 64 * (j))
#define XB_TOP      3328
#define XB_TOPGEN   3392
#define XCD_BAR_WORDS 3456
#define XB_SPIN_CAP (1u << 27)
__device__ __forceinline__ unsigned xb_ld(unsigned* p)              { return __hip_atomic_load(p, __ATOMIC_RELAXED, __HIP_MEMORY_SCOPE_AGENT); }
__device__ __forceinline__ unsigned xb_add(unsigned* p, unsigned v) { return __hip_atomic_fetch_add(p, v, __ATOMIC_RELAXED, __HIP_MEMORY_SCOPE_AGENT); }
__device__ __forceinline__ unsigned xb_xcc_id() { return (unsigned)__builtin_amdgcn_s_getreg((3 << 11) | 20) & 0xFu; }
#define XB_SPIN(cond, bar) do { unsigned _sp = 0; while (cond) { __builtin_amdgcn_s_sleep(1); \
    if ((++_sp & 255u) == 0u) { if (xb_ld(&(bar)[XB_TMO])) break; if (_sp > XB_SPIN_CAP) { atomicAdd(&(bar)[XB_TMO], 1u); break; } } } } while (0)
struct XcdBarrier { unsigned* bar; unsigned x; volatile LAS unsigned* st; };
__device__ __forceinline__ XcdBarrier xcd_barrier_post(unsigned* bar, volatile LAS unsigned* st) {
    XcdBarrier b; b.bar = bar; b.x = xb_xcc_id(); b.st = st;
    if (threadIdx.x == 0) (void)xb_add(&bar[XB_XCNT(b.x)], 1u);
    return b;
}
__device__ __forceinline__ void xcd_barrier_complete(unsigned* bar, unsigned x, unsigned& nloc, unsigned& nx) {
    asm volatile("" : "+s"(x));
    const unsigned G = gridDim.x * gridDim.y * gridDim.z;
    unsigned sum, cnt, mine, sp = 0u;
    for (;;) {
        sum = 0u; cnt = 0u; mine = 0u;
#pragma unroll
        for (unsigned j = 0; j < 16; ++j) { const unsigned c = xb_ld(&bar[XB_XCNT(j)]); sum += c; cnt += (c > 0u) ? 1u : 0u; mine = (j == x) ? c : mine; }
        if (sum == G) break;
        __builtin_amdgcn_s_sleep(1);
        if ((++sp & 255u) == 0u) { if (xb_ld(&bar[XB_TMO])) break; if (sp > XB_SPIN_CAP) { atomicAdd(&bar[XB_TMO], 1u); break; } }
    }
    nloc = mine > 0u ? mine : 1u; nx = cnt > 0u ? cnt : 1u;
}
__device__ __forceinline__ void xcd_barrier(const XcdBarrier& b, const bool thread0  ) {
    asm volatile("s_waitcnt vmcnt(0)" ::: "memory");
    __syncthreads();
    if (thread0) {
        unsigned* bar = b.bar;
        __builtin_amdgcn_s_waitcnt(0);
        unsigned nloc = b.st[0], nx = b.st[1];
        if (nloc == 0u) { xcd_barrier_complete(bar, b.x, nloc, nx); b.st[0] = nloc; b.st[1] = nx; }
        const unsigned old = xb_add(&bar[XB_XSUB(b.x)], 1u);
        const unsigned gen = old / nloc;
        if (old + 1u == (gen + 1u) * nloc) {
            __builtin_amdgcn_fence(__ATOMIC_RELEASE, "agent");
            asm volatile("s_waitcnt vmcnt(0)" ::: "memory");
            const unsigned og = xb_add(&bar[XB_TOP], 1u);
            const unsigned tg = og / nx;
            if (og + 1u == (tg + 1u) * nx) xb_add(&bar[XB_TOPGEN], 1u);
            else XB_SPIN(xb_ld(&bar[XB_TOPGEN]) == tg, bar);
            __builtin_amdgcn_fence(__ATOMIC_ACQUIRE, "agent");
            xb_add(&bar[XB_XGEN(b.x)], 1u);
            asm volatile("s_waitcnt vmcnt(0)" ::: "memory");
        } else {
            XB_SPIN(xb_ld(&bar[XB_XGEN(b.x)]) == gen, bar);
            __builtin_amdgcn_fence(__ATOMIC_ACQUIRE, "agent");
            asm volatile("s_waitcnt vmcnt(0)" ::: "memory");
        }
    }
    __syncthreads();
}

namespace pg8 {
constexpr int BM = 256, BK = 64, HALF = 128, HTB = HALF * BK * 2, STAGE_BYTES = 8 * HTB, NXCD = 8, WGM = 8;
__host__ __device__ __forceinline__ int lds_byte(int r, int c) { const int st = (r >> 4) * 2 + (c >> 5), rr = r & 15, cc = c & 31, ob = rr * 64 + cc * 2; return st * 1024 + (ob ^ (((ob >> 9) & 1) << 5)); }
__host__ __device__ __forceinline__ void stage_rc(int b, int& R, int& C) { const int st = b / 1024, sb = b % 1024, swz = sb ^ (((sb >> 9) & 1) << 5); R = (st >> 1) * 16 + swz / 64; C = (st & 1) * 32 + (swz % 64) / 2; }
__host__ __device__ __forceinline__ int perm32(int rho) { const int n = rho >> 4, i = rho & 15; return 8 * (i >> 2) + 4 * n + (i & 3); }
struct Unit { int pm, pn; };
struct Gemm { const bf16_t* A; const bf16_t* Bt; int M, N, K, lda; };
struct StaticOrder {
    int nM, nN, nwg, G, c;
    __host__ __device__ void init(int M, int N, int G_, int c_) { nM = M / BM; nN = N / BM; nwg = nM * nN; G = G_; c = c_; }
    __host__ __device__ bool next(int i, Unit& u) const {
        const long L = (long)i * G + c; if (L >= nwg) return false;
        int wgid = (int)L; { const int q = nwg / NXCD, r = nwg % NXCD, xcd = wgid % NXCD, off = wgid / NXCD; wgid = (xcd < r ? xcd * (q + 1) : r * (q + 1) + (xcd - r) * q) + off; }
        const int nig = WGM * nN, gid = wgid / nig, fm = gid * WGM, gsz = (nM - fm) < WGM ? (nM - fm) : WGM;
        u.pm = fm + ((wgid % nig) % gsz); u.pn = (wgid % nig) / gsz; return true;
    }
    __device__ __forceinline__ void a_ready(const Unit&) const {}
    __device__ __forceinline__ void done(const Unit&) const {}
};
struct OneUnit {
    int pm, pn;
    __device__ bool next(int i, Unit& u) const { if (i != 0) return false; u.pm = pm; u.pn = pn; return true; }
    __device__ __forceinline__ void a_ready(const Unit&) const {}
    __device__ __forceinline__ void done(const Unit&) const {}
};
struct EpiBf16 {
    static constexpr bool PERM = true;
    bf16_t* O; int ldc;
    __device__ __forceinline__ void operator()(const f32x4 (&acc)[2][2][4][2], const Unit& u, int wr, int wc, int fr, int fq) const {
        const int row0 = u.pm * BM + wr * 64 + fr; const int col0 = u.pn * BM + wc * 32 + 8 * fq;
#pragma unroll
        for (int ai = 0; ai < 2; ++ai)
#pragma unroll
            for (int m = 0; m < 4; ++m) { bf16_t* rowp = O + (size_t)(row0 + ai * HALF + m * 16) * ldc + col0;
#pragma unroll
                for (int bj = 0; bj < 2; ++bj) { const f32x4 v0 = acc[ai][bj][m][0], v1 = acc[ai][bj][m][1];
                    u32x4 w; w.x = cvt_pk_bf16(v0[0], v0[1]); w.y = cvt_pk_bf16(v0[2], v0[3]); w.z = cvt_pk_bf16(v1[0], v1[1]); w.w = cvt_pk_bf16(v1[2], v1[3]);
                    *(u32x4*)(rowp + bj * HALF) = w; } }
    }
};
struct EpiBf16V {
    static constexpr bool PERM = true;
    bf16_t* O; int ldc; bf16_t* V; int vpn0, vld;
    __device__ __forceinline__ void operator()(const f32x4 (&acc)[2][2][4][2], const Unit& u, int wr, int wc, int fr, int fq) const {
        const int row0 = u.pm * BM + wr * 64 + fr; const int col0 = u.pn * BM + wc * 32 + 8 * fq;
        const bool tov = u.pn >= vpn0;
        const long delta = u.pm < 32 ? 0 : (u.pm < 64 ? KPB - SEQ : (u.pm == 64 ? SEQ - TL : KPB + SEQ - TL - CTXL));
        bf16_t* base = tov ? V + delta * vld - (long)vpn0 * BM : O; const int ld = tov ? vld : ldc;
#pragma unroll
        for (int ai = 0; ai < 2; ++ai)
#pragma unroll
            for (int m = 0; m < 4; ++m) { bf16_t* rowp = base + (size_t)(row0 + ai * HALF + m * 16) * ld + col0;
#pragma unroll
                for (int bj = 0; bj < 2; ++bj) { const f32x4 v0 = acc[ai][bj][m][0], v1 = acc[ai][bj][m][1];
                    u32x4 w; w.x = cvt_pk_bf16(v0[0], v0[1]); w.y = cvt_pk_bf16(v0[2], v0[3]); w.z = cvt_pk_bf16(v1[0], v1[1]); w.w = cvt_pk_bf16(v1[2], v1[3]);
                    *(u32x4*)(rowp + bj * HALF) = w; } }
    }
};
struct EpiResid {
    static constexpr bool PERM = false;
    float* X; const float* modl; int chunk;
    const float* Rlat; const float* Rctx;
    __device__ __forceinline__ void operator()(const f32x4 (&acc)[2][2][4][2], const Unit& u, int wr, int wc, int fr, int fq) const {
        const int row0 = u.pm * BM + wr * 64 + fr, col0 = u.pn * BM + wc * 32 + 4 * fq;
        const int vs = u.pm < 32 ? 0 : (u.pm < 64 ? 1 : 2);
        const float* gate = modl + (size_t)vs * 12288 + chunk * 2048 + col0;
        f32x4 gv[2][2];
#pragma unroll
        for (int bj = 0; bj < 2; ++bj)
#pragma unroll
            for (int n = 0; n < 2; ++n) gv[bj][n] = *(const f32x4*)(gate + bj * HALF + n * 16);
#pragma unroll
        for (int ai = 0; ai < 2; ++ai) {
            f32x4 xo[4][2][2];
#pragma unroll
            for (int m = 0; m < 4; ++m) { const int row = row0 + ai * HALF + m * 16;
                const float* srcp = (vs < 2 ? Rlat + (size_t)row * DM : Rctx + (size_t)(row - TL) * DM) + col0;
#pragma unroll
                for (int bj = 0; bj < 2; ++bj)
#pragma unroll
                    for (int n = 0; n < 2; ++n) xo[m][bj][n] = *(const f32x4*)(srcp + bj * HALF + n * 16); }
#pragma unroll
            for (int m = 0; m < 4; ++m) { const int row = row0 + ai * HALF + m * 16; float* rowp = X + (size_t)row * DM + col0;
#pragma unroll
                for (int bj = 0; bj < 2; ++bj)
#pragma unroll
                    for (int n = 0; n < 2; ++n) *(f32x4*)(rowp + bj * HALF + n * 16) = xo[m][bj][n] + gv[bj][n] * acc[ai][bj][m][n]; } }
    }
};

template <class Epi, class Sched>
__device__ __forceinline__ void gemm_phase(LAS unsigned char* lds, const Gemm g, const Sched& S, const Epi& E, int tid_in) {
    const int tid_l = tid_in * 64 + fresh_lane();
    const int tid = tid_l, wid = tid_in  , lane = tid & 63, wr = wid >> 2, wc = wid & 3, fr = lane & 15, fq = lane >> 4;
    const int K = g.K, nt = K / BK, lda = g.lda;
    unsigned voffA[2], voffB[2];
#pragma unroll
    for (int i = 0; i < 2; ++i) { int R, C; stage_rc(tid * 16 + i * 8192, R, C); const int Rb = Epi::PERM ? ((R & ~31) + perm32(R & 31)) : R;
        voffA[i] = (unsigned)(R * lda + C) * 2u; voffB[i] = (unsigned)(Rb * K + C) * 2u; }
    const size_t kstep = (size_t)(BK * 2);
    const size_t hstepA = (size_t)HALF * lda * 2, hstepB = (size_t)HALF * K * 2;
    const size_t tstepA = 2 * hstepA, tstepB = 2 * hstepB;
    const unsigned ldsw = (unsigned)wid * 1024u;
    const int aoff = lds_byte(wr * 64 + fr, fq * 8), boff = lds_byte(wc * 32 + fr, fq * 8);
#define PG8_SA(b, h) (((b) * 2 + (h)) * HTB)
#define PG8_SB(b, h) ((4 + (b) * 2 + (h)) * HTB)
#define PG8_STAGE(bufoff, gbase, voff) do { _Pragma("unroll") for (int _i = 0; _i < 2; ++_i) \
        __builtin_amdgcn_global_load_lds((const unsigned*)((const char*)(gbase) + (voff)[_i]), (LAS unsigned*)(lds + (bufoff) + ldsw + _i * 8192), 16, 0, 0); } while (0)
#define PG8_LDA(dst, b, h) do { _Pragma("unroll") for (int m = 0; m < 4; ++m) _Pragma("unroll") for (int k = 0; k < 2; ++k) dst[m][k] = *(const LAS bf16x8*)(lds + PG8_SA(b, h) + aoff + m * 2048 + k * 1024); } while (0)
#define PG8_LDB(dst, b, h) do { _Pragma("unroll") for (int n = 0; n < 2; ++n) _Pragma("unroll") for (int k = 0; k < 2; ++k) dst[n][k] = *(const LAS bf16x8*)(lds + PG8_SB(b, h) + boff + n * 2048 + k * 1024); } while (0)
#define PG8_MMA(ai, bj, At, Bt) do { __builtin_amdgcn_s_setprio(1); _Pragma("unroll") for (int m = 0; m < 4; ++m) _Pragma("unroll") for (int n = 0; n < 2; ++n) _Pragma("unroll") for (int k = 0; k < 2; ++k) \
        acc[ai][bj][m][n] = __builtin_amdgcn_mfma_f32_16x16x32_bf16(Bt[n][k], At[m][k], acc[ai][bj][m][n], 0, 0, 0); __builtin_amdgcn_s_setprio(0); } while (0)
#define PG8_WAIT_V(n) asm volatile("s_waitcnt vmcnt(" #n ")" ::: "memory")
#define PG8_WAIT_L(n) asm volatile("s_waitcnt lgkmcnt(" #n ")" ::: "memory")
#define PG8_BAR __builtin_amdgcn_s_barrier()
#define PG8_SCHED __builtin_amdgcn_sched_barrier(0)
    Unit cur, nxt; int ui = 0;
    if (!S.next(0, cur)) return;
    f32x4 acc[2][2][4][2];
#pragma unroll
    for (int a = 0; a < 2; ++a)
#pragma unroll
        for (int b = 0; b < 2; ++b)
#pragma unroll
            for (int m = 0; m < 4; ++m)
#pragma unroll
                for (int n = 0; n < 2; ++n) acc[a][b][m][n] = (f32x4){0.f, 0.f, 0.f, 0.f};
    bf16x8 At[4][2], B0[2][2], B1[2][2];
    const char* cA = (const char*)g.A + (size_t)cur.pm * tstepA; const char* cB = (const char*)g.Bt + (size_t)cur.pn * tstepB;
    S.a_ready(cur);
    PG8_STAGE(PG8_SB(0, 0), cB, voffB); PG8_STAGE(PG8_SA(0, 0), cA, voffA); PG8_STAGE(PG8_SB(0, 1), cB + hstepB, voffB); PG8_STAGE(PG8_SA(0, 1), cA + hstepA, voffA);
    if (wr == 1) PG8_BAR;
    PG8_WAIT_V(4); PG8_BAR;
    PG8_STAGE(PG8_SB(1, 0), cB + kstep, voffB); PG8_STAGE(PG8_SA(1, 0), cA + kstep, voffA); PG8_STAGE(PG8_SB(1, 1), cB + hstepB + kstep, voffB);
    PG8_WAIT_V(6); PG8_BAR;
    for (;;) {
        const bool has_next = S.next(ui + 1, nxt);
        const char* nA = has_next ? (const char*)g.A + (size_t)nxt.pm * tstepA : cA; const char* nB = has_next ? (const char*)g.Bt + (size_t)nxt.pn * tstepB : cB;
        for (int t = 0; t < nt; t += 2) {
            const bool last = (t == nt - 2);
            const char* a1 = cA + (size_t)(t + 1) * kstep;
            const char* a2 = last ? nA : cA + (size_t)(t + 2) * kstep; const char* b2 = last ? nB : cB + (size_t)(t + 2) * kstep;
            const char* a3 = a2 + kstep; const char* b3 = b2 + kstep;
            if (last && has_next) S.a_ready(nxt);
            PG8_LDB(B0, 0, 0); PG8_SCHED; PG8_LDA(At, 0, 0); PG8_STAGE(PG8_SA(1, 1), a1 + hstepA, voffA);
            PG8_WAIT_L(8); PG8_BAR; PG8_WAIT_L(0); PG8_MMA(0, 0, At, B0); PG8_BAR; PG8_SCHED;
            PG8_LDB(B1, 0, 1); PG8_STAGE(PG8_SB(0, 0), b2, voffB);
            PG8_BAR; PG8_WAIT_L(0); PG8_MMA(0, 1, At, B1); PG8_BAR;
            PG8_LDA(At, 0, 1); PG8_STAGE(PG8_SA(0, 0), a2, voffA);
            PG8_BAR; PG8_WAIT_L(0); PG8_MMA(1, 0, At, B0); PG8_BAR; PG8_SCHED;
            PG8_STAGE(PG8_SB(0, 1), b2 + hstepB, voffB);
            PG8_WAIT_V(6); PG8_BAR; PG8_MMA(1, 1, At, B1); PG8_BAR;
            PG8_LDB(B0, 1, 0); PG8_SCHED; PG8_LDA(At, 1, 0); PG8_STAGE(PG8_SA(0, 1), a2 + hstepA, voffA);
            PG8_WAIT_L(8); PG8_BAR; PG8_WAIT_L(0); PG8_MMA(0, 0, At, B0); PG8_BAR; PG8_SCHED;
            PG8_LDB(B1, 1, 1); PG8_STAGE(PG8_SB(1, 0), b3, voffB);
            PG8_BAR; PG8_WAIT_L(0); PG8_MMA(0, 1, At, B1); PG8_BAR;
            PG8_LDA(At, 1, 1); PG8_STAGE(PG8_SA(1, 0), a3, voffA);
            PG8_BAR; PG8_WAIT_L(0); PG8_MMA(1, 0, At, B0); PG8_BAR; PG8_SCHED;
            PG8_STAGE(PG8_SB(1, 1), b3 + hstepB, voffB);
            PG8_WAIT_V(6); PG8_BAR; PG8_MMA(1, 1, At, B1); PG8_BAR;
        }
        E(acc, cur, wr, wc, fr, fq); S.done(cur);
        if (!has_next) break;
#pragma unroll
        for (int a = 0; a < 2; ++a)
#pragma unroll
            for (int b = 0; b < 2; ++b)
#pragma unroll
                for (int m = 0; m < 4; ++m)
#pragma unroll
                    for (int n = 0; n < 2; ++n) acc[a][b][m][n] = (f32x4){0.f, 0.f, 0.f, 0.f};
        cur = nxt; cA = nA; cB = nB; ++ui;
    }
    PG8_WAIT_V(0);
    if (wr == 0) PG8_BAR;
    PG8_BAR;
#undef PG8_SA
#undef PG8_SB
#undef PG8_STAGE
#undef PG8_LDA
#undef PG8_LDB
#undef PG8_MMA
#undef PG8_WAIT_V
#undef PG8_WAIT_L
#undef PG8_BAR
#undef PG8_SCHED
}
}

namespace att {
constexpr int NW = 8, QBLK = 32, KVBLK = 64, DV = 128;
constexpr float THR = 8.f;
constexpr int SHM_V = KVBLK * DV * 2;
#define SBAR() __builtin_amdgcn_sched_barrier(0)
__device__ __forceinline__ int crow(int r, int hi) { return (r & 3) + 8 * (r >> 2) + 4 * hi; }
__device__ __forceinline__ unsigned cvtpk(float lo, float hi) { unsigned r; asm volatile("v_cvt_pk_bf16_f32 %0, %1, %2" : "=v"(r) : "v"(lo), "v"(hi)); return r; }
__device__ __forceinline__ void partialSM(f32x16& p0, f32x16& p1, float& m_reg, float& mn, float& alpha, const float C, const float thr_raw) {
    float pmax = p0[0];
#pragma unroll
    for (int r = 1; r < 16; ++r) pmax = fmaxf(pmax, p0[r]);
#pragma unroll
    for (int r = 0; r < 16; ++r) pmax = fmaxf(pmax, p1[r]);
    { auto rr = __builtin_amdgcn_permlane32_swap(__float_as_uint(pmax), __float_as_uint(pmax), false, false);
      pmax = fmaxf(__uint_as_float(rr[0]), __uint_as_float(rr[1])); }
    if (__builtin_expect(__all(pmax - m_reg <= thr_raw), 1)) { mn = m_reg; alpha = 1.f; }
    else { mn = fmaxf(m_reg, pmax); alpha = __builtin_amdgcn_exp2f((m_reg - mn) * C); m_reg = mn; }
    const float mnC = -mn * C;
#pragma unroll
    for (int r = 0; r < 16; ++r) p0[r] = fmaf(p0[r], C, mnC);
#pragma unroll
    for (int r = 0; r < 16; ++r) p1[r] = fmaf(p1[r], C, mnC);
#pragma unroll
    for (int r = 0; r < 16; ++r) p0[r] = __builtin_amdgcn_exp2f(p0[r]);
}
__device__ __forceinline__ void finishSM(f32x16& p0, f32x16& p1, float alpha, float& l_reg, bf16x8& pa0, bf16x8& pa1, bf16x8& pa2, bf16x8& pa3) {
#pragma unroll
    for (int r = 0; r < 16; ++r) p1[r] = __builtin_amdgcn_exp2f(p1[r]);
    float ps = 0;
#pragma unroll
    for (int r = 0; r < 16; ++r) ps += p0[r];
#pragma unroll
    for (int r = 0; r < 16; ++r) ps += p1[r];
    { auto rr = __builtin_amdgcn_permlane32_swap(__float_as_uint(ps), __float_as_uint(ps), false, false);
      ps = __uint_as_float(rr[0]) + __uint_as_float(rr[1]); }
    l_reg = l_reg * alpha + ps;
#define PK4(P, BASE, OUT) do { unsigned a0 = cvtpk(P[BASE + 0], P[BASE + 1]), a1 = cvtpk(P[BASE + 2], P[BASE + 3]);   \
    unsigned b0 = cvtpk(P[BASE + 4], P[BASE + 5]), b1 = cvtpk(P[BASE + 6], P[BASE + 7]);                              \
    auto r0 = __builtin_amdgcn_permlane32_swap(a0, b0, false, false); auto r1 = __builtin_amdgcn_permlane32_swap(a1, b1, false, false); \
    u32x4 w = {r0[0], r1[0], r0[1], r1[1]}; OUT = *reinterpret_cast<bf16x8*>(&w); } while (0)
    PK4(p0, 0, pa0); PK4(p0, 8, pa1); PK4(p1, 0, pa2); PK4(p1, 8, pa3);
#undef PK4
}
__device__ __forceinline__ void partialSM_nm(f32x16& p0) {
#pragma unroll
    for (int r = 0; r < 16; ++r) p0[r] = __builtin_amdgcn_exp2f(p0[r]);
}
template <int DQK, int QL>
__device__ __forceinline__ void qkt(f32x16& p0, f32x16& p1, const char* Ks, const bf16x8 (&qr)[DQK / 16 - QL], const char* qpark, int r32, int hi) {
    constexpr int RS = DQK * 2 + 16, NQR = DQK / 16 - QL, GRP = (DQK > 128) ? QKT_GRP : DQK / 16;
    p0 = f32x16{}; p1 = f32x16{};
#pragma unroll
    for (int g0 = 0; g0 < DQK / 16; g0 += GRP) {
#pragma unroll
        for (int d0 = g0; d0 < g0 + GRP; ++d0) { const int cb = (d0 * 16 + hi * 8) * 2;
            const bf16x8 b0 = *reinterpret_cast<const bf16x8*>(Ks + r32 * RS + cb);
            const bf16x8 b1 = *reinterpret_cast<const bf16x8*>(Ks + (32 + r32) * RS + cb);
            bf16x8 qf; if (d0 < NQR) qf = qr[d0 < NQR ? d0 : 0]; else qf = *reinterpret_cast<const bf16x8*>(qpark + (d0 - NQR) * 1024);
            p0 = __builtin_amdgcn_mfma_f32_32x32x16_bf16(b0, qf, p0, 0, 0, 0);
            p1 = __builtin_amdgcn_mfma_f32_32x32x16_bf16(b1, qf, p1, 0, 0, 0); }
        if (g0 + GRP < DQK / 16) SBAR();
    }
}
__device__ __forceinline__ int v_st(int k, int c) { const int kk = (k & ~0xC) | ((k & 4) << 1) | ((k & 8) >> 1); return ((kk >> 3) * 4 + (c >> 5)) * 512 + ((kk & 7) * 32 + (c & 31)) * 2; }
__device__ __forceinline__ int v_rd_base(int lane) { return ((lane & 3) << 3) | (((lane >> 2) & 3) << 6) | (((lane >> 4) & 1) << 5) | (((lane >> 5) & 1) << 8); }
constexpr int v_rd_off(int d0, int ks, int half) { return d0 * 512 + ks * 4096 + half * 2048; }
template <int OFF> __device__ __forceinline__ s16x4 tr_read(int vb) {
    s16x4 r; asm volatile("ds_read_b64_tr_b16 %0, %1 offset:%2" : "=&v"(r) : "v"(vb), "i"(OFF) : "memory"); return r;
}
template <int D0> __device__ __forceinline__ void pv_one(f32x16& od, int vb, bf16x8 pa0, bf16x8 pa1, bf16x8 pa2, bf16x8 pa3) {
    const s16x4 l0 = tr_read<v_rd_off(D0, 0, 0)>(vb), h0 = tr_read<v_rd_off(D0, 0, 1)>(vb), l1 = tr_read<v_rd_off(D0, 1, 0)>(vb), h1 = tr_read<v_rd_off(D0, 1, 1)>(vb);
    const s16x4 l2 = tr_read<v_rd_off(D0, 2, 0)>(vb), h2 = tr_read<v_rd_off(D0, 2, 1)>(vb), l3 = tr_read<v_rd_off(D0, 3, 0)>(vb), h3 = tr_read<v_rd_off(D0, 3, 1)>(vb);
    asm volatile("s_waitcnt lgkmcnt(0)" ::: "memory"); SBAR();
#define PK(L, H) (bf16x8){L[0], L[1], L[2], L[3], H[0], H[1], H[2], H[3]}
    od = __builtin_amdgcn_mfma_f32_32x32x16_bf16(pa0, PK(l0, h0), od, 0, 0, 0);
    od = __builtin_amdgcn_mfma_f32_32x32x16_bf16(pa1, PK(l1, h1), od, 0, 0, 0);
    od = __builtin_amdgcn_mfma_f32_32x32x16_bf16(pa2, PK(l2, h2), od, 0, 0, 0);
    od = __builtin_amdgcn_mfma_f32_32x32x16_bf16(pa3, PK(l3, h3), od, 0, 0, 0);
#undef PK
}
__device__ __forceinline__ void pv_d0(f32x16* o, int vb, bf16x8 pa0, bf16x8 pa1, bf16x8 pa2, bf16x8 pa3) {
    pv_one<0>(o[0], vb, pa0, pa1, pa2, pa3); pv_one<1>(o[1], vb, pa0, pa1, pa2, pa3); pv_one<2>(o[2], vb, pa0, pa1, pa2, pa3); pv_one<3>(o[3], vb, pa0, pa1, pa2, pa3);
}
struct VFrag { s16x4 l0, h0, l1, h1, l2, h2, l3, h3; };
template <int D0> __device__ __forceinline__ void pv_rd(VFrag& f, int vb) {
    f.l0 = tr_read<v_rd_off(D0, 0, 0)>(vb); f.h0 = tr_read<v_rd_off(D0, 0, 1)>(vb); f.l1 = tr_read<v_rd_off(D0, 1, 0)>(vb); f.h1 = tr_read<v_rd_off(D0, 1, 1)>(vb);
    f.l2 = tr_read<v_rd_off(D0, 2, 0)>(vb); f.h2 = tr_read<v_rd_off(D0, 2, 1)>(vb); f.l3 = tr_read<v_rd_off(D0, 3, 0)>(vb); f.h3 = tr_read<v_rd_off(D0, 3, 1)>(vb);
}
__device__ __forceinline__ void pv_mm(f32x16& od, const VFrag& f, bf16x8 pa0, bf16x8 pa1, bf16x8 pa2, bf16x8 pa3) {
#define PK(L, H) (bf16x8){L[0], L[1], L[2], L[3], H[0], H[1], H[2], H[3]}
    od = __builtin_amdgcn_mfma_f32_32x32x16_bf16(pa0, PK(f.l0, f.h0), od, 0, 0, 0);
    od = __builtin_amdgcn_mfma_f32_32x32x16_bf16(pa1, PK(f.l1, f.h1), od, 0, 0, 0);
    od = __builtin_amdgcn_mfma_f32_32x32x16_bf16(pa2, PK(f.l2, f.h2), od, 0, 0, 0);
    od = __builtin_amdgcn_mfma_f32_32x32x16_bf16(pa3, PK(f.l3, f.h3), od, 0, 0, 0);
#undef PK
}
__device__ __forceinline__ void pv_d0_pipe(f32x16* o, int vb, bf16x8 pa0, bf16x8 pa1, bf16x8 pa2, bf16x8 pa3) {
    VFrag fa, fb;
    pv_rd<0>(fa, vb); pv_rd<1>(fb, vb);
    asm volatile("s_waitcnt lgkmcnt(8)" ::: "memory"); SBAR(); pv_mm(o[0], fa, pa0, pa1, pa2, pa3); SBAR();
    pv_rd<2>(fa, vb);
    asm volatile("s_waitcnt lgkmcnt(8)" ::: "memory"); SBAR(); pv_mm(o[1], fb, pa0, pa1, pa2, pa3); SBAR();
    pv_rd<3>(fb, vb);
    asm volatile("s_waitcnt lgkmcnt(8)" ::: "memory"); SBAR(); pv_mm(o[2], fa, pa0, pa1, pa2, pa3); SBAR();
    asm volatile("s_waitcnt lgkmcnt(0)" ::: "memory"); SBAR(); pv_mm(o[3], fb, pa0, pa1, pa2, pa3);
}
template <int DQK> struct ScaleOf { static constexpr float scale = DQK == 192 ? 0.07216878364870322f : (DQK == 128 ? 0.08838834764831845f : 0.125f); };
template <int DQK, int SDEPTH, int QL, bool NOMAX, int ldq, int ldk, int ldv, int ldo>
__device__ __forceinline__ void attn_body(const bf16_t* __restrict__ Qb, const bf16_t* __restrict__ Kh, const bf16_t* __restrict__ Vh,
                                          bf16_t* __restrict__ Ob, int seq, char* lds, int tid_in, const float negMC) {
    constexpr float C = 1.0f, thr_raw = THR * 1.4426950408889634f;
    constexpr int RS = DQK * 2 + 16  , SHM_K = KVBLK * RS, NKP = DQK / 64, KPR = DQK / 8;
    const int tid_l = tid_in * 64 + fresh_lane();
    const int tid = tid_l, wid = tid_in  , lane = tid & 63, r32 = lane & 31, hi = lane >> 5;
    char* V_lds = lds; char* K_lds = lds + 2 * SHM_V;
    float* ws = (float*)(lds + 2 * SHM_V + 2 * SHM_K) + wid * 64; float* li_l = ws; float* al_l = ws + 32;
    constexpr int NQR = DQK / 16 - QL;
    char* qpark = lds + 2 * SHM_V + 2 * SHM_K + 2048 + wid * (QL * 1024) + lane * 16;
    float m_reg = -1e30f, l_reg = 0; f32x16 o[4] = {}; bf16x8 qr[NQR];
    const bf16_t* Qw = Qb + (size_t)(wid * QBLK + r32) * ldq + hi * 8;
#pragma unroll
    for (int d0 = 0; d0 < NQR; ++d0) qr[d0] = *reinterpret_cast<const bf16x8*>(Qw + d0 * 16);
#pragma unroll
    for (int d0 = 0; d0 < QL; ++d0) *(bf16x8*)(qpark + d0 * 1024) = *reinterpret_cast<const bf16x8*>(Qw + (NQR + d0) * 16);
    const int sr = tid >> 4, sc = (tid & 15) * 8, vst0 = v_st(sr, sc), vst1 = v_st(32 + sr, sc);
    int koff[NKP], klds[NKP];
#pragma unroll
    for (int i = 0; i < NKP; ++i) { const int row = tid >> 3, c8 = (tid & 7) + 8 * i; koff[i] = row * ldk + c8 * 8; klds[i] = row * RS + c8 * 16; }
    const int vb0 = (int)(uintptr_t)V_lds + v_rd_base(lane);
    bf16x8 sv0[SDEPTH], sv1[SDEPTH], sk[SDEPTH][NKP];
#define SLOAD(i, k0) do { sv0[i] = *reinterpret_cast<const bf16x8*>(&Vh[(size_t)((k0) + sr) * ldv + sc]); sv1[i] = *reinterpret_cast<const bf16x8*>(&Vh[(size_t)((k0) + 32 + sr) * ldv + sc]); \
    _Pragma("unroll") for (int _q = 0; _q < NKP; ++_q) sk[i][_q] = *reinterpret_cast<const bf16x8*>(&Kh[(size_t)(k0) * ldk + koff[_q]]); } while (0)
#define SWRITE(b, i) do { *(bf16x8*)(V_lds + (b) * SHM_V + vst0) = sv0[i]; *(bf16x8*)(V_lds + (b) * SHM_V + vst1) = sv1[i]; \
    _Pragma("unroll") for (int _q = 0; _q < NKP; ++_q) *(bf16x8*)(K_lds + (b) * SHM_K + klds[_q]) = sk[i][_q]; } while (0)
#define SWAIT() do { if constexpr (SDEPTH == 2) { if constexpr (NKP == 1) asm volatile("s_waitcnt vmcnt(3)" ::: "memory"); else if constexpr (NKP == 2) asm volatile("s_waitcnt vmcnt(4)" ::: "memory"); else asm volatile("s_waitcnt vmcnt(5)" ::: "memory"); } \
    else asm volatile("s_waitcnt vmcnt(0)" ::: "memory"); } while (0)
#define PVD0(...) do { if constexpr (PV_PIPE != 0) pv_d0_pipe(__VA_ARGS__); else pv_d0(__VA_ARGS__); } while (0)
#define RESC(a) do { if constexpr (!NOMAX) if (__any((a) < 1.f)) { if (hi == 0) al_l[r32] = (a); asm volatile("s_waitcnt lgkmcnt(0)" ::: "memory"); \
    _Pragma("unroll") for (int d = 0; d < 4; ++d) _Pragma("unroll") for (int r = 0; r < 16; ++r) o[d][r] *= al_l[crow(r, hi)]; } } while (0)
    f32x16 pA0, pA1, pB0, pB1; float mnA, mnB, alA, alB; bf16x8 pa0, pa1, pa2, pa3; const int NT = seq / KVBLK;
    if (ATT_PRIO && wid >= 4) __builtin_amdgcn_s_setprio(1);
    constexpr int SE = 0, SO = SDEPTH - 1;
    SLOAD(SE, 0); asm volatile("s_waitcnt vmcnt(0)" ::: "memory"); SWRITE(0, SE); __syncthreads();
    qkt<DQK, QL>(pA0, pA1, K_lds, qr, qpark, r32, hi); if constexpr (NOMAX) { partialSM_nm(pA0); alA = 1.f; } else partialSM(pA0, pA1, m_reg, mnA, alA, C, thr_raw);
    SLOAD(SO, KVBLK); if constexpr (SDEPTH == 2) { if (2 < NT) SLOAD(SE, 2 * KVBLK); }
    SWAIT(); SWRITE(1, SO); __syncthreads();
    for (int j = 1; j + 1 < NT; j += 2) {
        SBAR(); qkt<DQK, QL>(pB0, pB1, K_lds + SHM_K, qr, qpark, r32, hi);
        finishSM(pA0, pA1, alA, l_reg, pa0, pa1, pa2, pa3); SBAR();
        SLOAD(SO, (j + SDEPTH) * KVBLK); SBAR();
        PVD0(o, vb0, pa0, pa1, pa2, pa3); if constexpr (NOMAX) { partialSM_nm(pB0); alB = 1.f; } else partialSM(pB0, pB1, m_reg, mnB, alB, C, thr_raw);
        __syncthreads(); SWAIT(); SWRITE(0, SE);
        RESC(alB); __syncthreads();
        SBAR(); qkt<DQK, QL>(pA0, pA1, K_lds, qr, qpark, r32, hi);
        finishSM(pB0, pB1, alB, l_reg, pa0, pa1, pa2, pa3); SBAR();
        if (SDEPTH == 1 || j + 3 < NT) SLOAD(SE, (j + 1 + SDEPTH) * KVBLK); SBAR();
        PVD0(o, vb0 + SHM_V, pa0, pa1, pa2, pa3); if constexpr (NOMAX) { partialSM_nm(pA0); alA = 1.f; } else partialSM(pA0, pA1, m_reg, mnA, alA, C, thr_raw);
        __syncthreads(); SWAIT(); SWRITE(1, SO);
        RESC(alA); __syncthreads();
    }
    SBAR(); qkt<DQK, QL>(pB0, pB1, K_lds + SHM_K, qr, qpark, r32, hi);
    finishSM(pA0, pA1, alA, l_reg, pa0, pa1, pa2, pa3); SBAR();
    PVD0(o, vb0, pa0, pa1, pa2, pa3); if constexpr (NOMAX) { partialSM_nm(pB0); alB = 1.f; } else partialSM(pB0, pB1, m_reg, mnB, alB, C, thr_raw);
    __syncthreads(); RESC(alB);
    finishSM(pB0, pB1, alB, l_reg, pa0, pa1, pa2, pa3); SBAR();
    PVD0(o, vb0 + SHM_V, pa0, pa1, pa2, pa3);
    if (ATT_PRIO) __builtin_amdgcn_s_setprio(0);
    if (hi == 0) li_l[r32] = l_reg; asm volatile("s_waitcnt lgkmcnt(0)" ::: "memory");
    float rli[16];
#pragma unroll
    for (int r = 0; r < 16; ++r) rli[r] = __builtin_amdgcn_rcpf(li_l[crow(r, hi)]);
    bf16_t* Ow = Ob + (size_t)(wid * QBLK) * ldo + (r32 & ~1);
    const bool odd = (r32 & 1) != 0;
#pragma unroll
    for (int r = 0; r < 16; r += 2) { const int orow = crow(r, hi) + (odd ? 1 : 0);
#pragma unroll
        for (int d0 = 0; d0 < 4; ++d0) { const float a = o[d0][r] * rli[r], b = o[d0][r + 1] * rli[r + 1];
            const float recv = swz_xor<1>(odd ? a : b);
            const unsigned w = odd ? cvtpk(recv, b) : cvtpk(a, recv);
            *(unsigned*)(Ow + (size_t)orow * ldo + d0 * 32) = w; } }
    __syncthreads();
#undef SLOAD
#undef SWRITE
#undef SWAIT
#undef RESC
#undef PVD0
}
template <int DQK, int QL, int ldq, int ldk, int ldv, int ldo>
__device__ __forceinline__ void attn_body_simple(const bf16_t* __restrict__ Qb, const bf16_t* __restrict__ Kh, const bf16_t* __restrict__ Vh,
                                                 bf16_t* __restrict__ Ob, int seq, char* lds, int tid_in) {
    constexpr float C = 1.0f, thr_raw = THR * 1.4426950408889634f;
    constexpr int RS = DQK * 2 + 16  , SHM_K = KVBLK * RS, NKP = DQK / 64, KPR = DQK / 8;
    const int tid_l = tid_in * 64 + fresh_lane();
    const int tid = tid_l, wid = tid_in  , lane = tid & 63, r32 = lane & 31, hi = lane >> 5;
    char* V_lds = lds; char* K_lds = lds + 2 * SHM_V;
    float* ws = (float*)(lds + 2 * SHM_V + 2 * SHM_K) + wid * 64; float* li_l = ws; float* al_l = ws + 32;
    constexpr int NQR = DQK / 16 - QL;
    char* qpark = lds + 2 * SHM_V + 2 * SHM_K + 2048 + wid * (QL * 1024) + lane * 16;
    float m_reg = -1e30f, l_reg = 0; f32x16 o[4] = {}; bf16x8 qr[NQR];
    const bf16_t* Qw = Qb + (size_t)(wid * QBLK + r32) * ldq + hi * 8;
#pragma unroll
    for (int d0 = 0; d0 < NQR; ++d0) qr[d0] = *reinterpret_cast<const bf16x8*>(Qw + d0 * 16);
#pragma unroll
    for (int d0 = 0; d0 < QL; ++d0) *(bf16x8*)(qpark + d0 * 1024) = *reinterpret_cast<const bf16x8*>(Qw + (NQR + d0) * 16);
    const int sr = tid >> 4, sc = (tid & 15) * 8, vst0 = v_st(sr, sc), vst1 = v_st(32 + sr, sc);
    int koff[NKP], klds[NKP];
#pragma unroll
    for (int i = 0; i < NKP; ++i) { const int row = tid >> 3, c8 = (tid & 7) + 8 * i; koff[i] = row * ldk + c8 * 8; klds[i] = row * RS + c8 * 16; }
    const int vb0 = (int)(uintptr_t)V_lds + v_rd_base(lane);
    bf16x8 sv0, sv1, sk[NKP];
#define SLOAD(k0) do { sv0 = *reinterpret_cast<const bf16x8*>(&Vh[(size_t)((k0) + sr) * ldv + sc]); sv1 = *reinterpret_cast<const bf16x8*>(&Vh[(size_t)((k0) + 32 + sr) * ldv + sc]); \
    _Pragma("unroll") for (int _q = 0; _q < NKP; ++_q) sk[_q] = *reinterpret_cast<const bf16x8*>(&Kh[(size_t)(k0) * ldk + koff[_q]]); } while (0)
#define SWRITE(b) do { *(bf16x8*)(V_lds + (b) * SHM_V + vst0) = sv0; *(bf16x8*)(V_lds + (b) * SHM_V + vst1) = sv1; \
    _Pragma("unroll") for (int _q = 0; _q < NKP; ++_q) *(bf16x8*)(K_lds + (b) * SHM_K + klds[_q]) = sk[_q]; } while (0)
#define RESC(a) do { if (__any((a) < 1.f)) { if (hi == 0) al_l[r32] = (a); asm volatile("s_waitcnt lgkmcnt(0)" ::: "memory"); \
    _Pragma("unroll") for (int d = 0; d < 4; ++d) _Pragma("unroll") for (int r = 0; r < 16; ++r) o[d][r] *= al_l[crow(r, hi)]; } } while (0)
    const int NT = seq / KVBLK;
    SLOAD(0); asm volatile("s_waitcnt vmcnt(0)" ::: "memory"); SWRITE(0); __syncthreads();
    for (int j = 0; j < NT; ++j) {
        const int b = j & 1;
        if (j + 1 < NT) SLOAD((j + 1) * KVBLK);
        SBAR();
        f32x16 p0, p1; float mn, al; bf16x8 pa0, pa1, pa2, pa3;
        { const char* Ks = K_lds + b * SHM_K; p0 = f32x16{}; p1 = f32x16{};
#pragma unroll
          for (int d0 = 0; d0 < DQK / 16; ++d0) { const int cb = (d0 * 16 + hi * 8) * 2;
              const bf16x8 b0 = *reinterpret_cast<const bf16x8*>(Ks + r32 * RS + cb);
              const bf16x8 b1 = *reinterpret_cast<const bf16x8*>(Ks + (32 + r32) * RS + cb);
              bf16x8 qf; if (d0 < NQR) qf = qr[d0 < NQR ? d0 : 0]; else qf = *(const bf16x8*)(qpark + (d0 - NQR) * 1024);
              p0 = __builtin_amdgcn_mfma_f32_32x32x16_bf16(b0, qf, p0, 0, 0, 0);
              p1 = __builtin_amdgcn_mfma_f32_32x32x16_bf16(b1, qf, p1, 0, 0, 0); } }
        partialSM(p0, p1, m_reg, mn, al, C, thr_raw);
        RESC(al);
        finishSM(p0, p1, al, l_reg, pa0, pa1, pa2, pa3); SBAR();
        pv_d0(o, vb0 + b * SHM_V, pa0, pa1, pa2, pa3);
        if (j + 1 < NT) { asm volatile("s_waitcnt vmcnt(0)" ::: "memory"); SWRITE(b ^ 1); }
        __syncthreads();
    }
    if (hi == 0) li_l[r32] = l_reg; asm volatile("s_waitcnt lgkmcnt(0)" ::: "memory");
    float rli[16];
#pragma unroll
    for (int r = 0; r < 16; ++r) rli[r] = __builtin_amdgcn_rcpf(li_l[crow(r, hi)]);
    bf16_t* Ow = Ob + (size_t)(wid * QBLK) * ldo + (r32 & ~1);
    const bool odd = (r32 & 1) != 0;
#pragma unroll
    for (int r = 0; r < 16; r += 2) { const int orow = crow(r, hi) + (odd ? 1 : 0);
#pragma unroll
        for (int d0 = 0; d0 < 4; ++d0) { const float a = o[d0][r] * rli[r], b = o[d0][r + 1] * rli[r + 1];
            const float recv = swz_xor<1>(odd ? a : b);
            const unsigned w = odd ? cvtpk(recv, b) : cvtpk(a, recv);
            *(unsigned*)(Ow + (size_t)orow * ldo + d0 * 32) = w; } }
    __syncthreads();
#undef SLOAD
#undef SWRITE
#undef RESC
}
}

struct Params {
    const float* x; const float* c; const float* ctx; const float* c_ctx; const float* w_mod; const float* b_mod; const float* g_norm1; const float* g_norm2;
    const float* w_in_ab; const float* g_cq; const float* w_uq; const float* g_ckv; const float* w_ukv; const float* g_qn_a; const float* g_kn_a; const float* lam_vec;
    const float* g_qn_b; const float* g_kn_b; const float* g_sub_b; const float* w_out_ab; const float* w_in_c; const float* g_qn_c; const float* g_kn_c; const float* w_out_c;
    const float* w_pq; const float* sub_keys; const float* expert_u; const float* expert_v;
    float* out; unsigned char* ws; int ph_lo, ph_hi;
};

typedef const __attribute__((address_space(4))) Params CParams;
struct Ctx {
    int tid, lane, wid, G, vcu, bx;
    unsigned char* ws; char* lds;
};

__device__ __forceinline__ void tconv(const Ctx& F, const float* src, bf16_t* dst, const float* gain, int nmat, int K, int N, int Npad, int pad_at = 1 << 30, int pad_len = 0) {
    float* tile = (float*)(F.lds + 32768);
    const int ntn = Npad / 64, ntk = K / 64, per = ntn * ntk, total = per * nmat;
    for (int it = F.vcu; it < total; it += F.G) {
        const int mat = it / per, rem = it % per, tn = rem / ntk, tk = rem % ntk, k0 = tk * 64, n0 = tn * 64;
        const float* s = src + (size_t)mat * K * N; bf16_t* d = dst + (size_t)mat * Npad * K;
        __syncthreads();
        { const int r = F.tid >> 4, c4 = (F.tid & 15) * 4;
#pragma unroll
          for (int i = 0; i < 2; ++i) { const int rr = r + i * 32; f32x4 v = (f32x4){0.f, 0.f, 0.f, 0.f};
              const int sn0 = n0 < pad_at ? n0 : n0 - pad_len;
              if (sn0 + c4 < N && !(n0 >= pad_at && n0 < pad_at + pad_len)) v = *(const f32x4*)(s + (size_t)(k0 + rr) * N + sn0 + c4);
              tile[rr * 65 + c4 + 0] = v[0]; tile[rr * 65 + c4 + 1] = v[1]; tile[rr * 65 + c4 + 2] = v[2]; tile[rr * 65 + c4 + 3] = v[3]; } }
        __syncthreads();
        { const int n = F.tid >> 3, kc = (F.tid & 7) * 8; float v[8];
#pragma unroll
          for (int e = 0; e < 8; ++e) { v[e] = tile[(kc + e) * 65 + n]; if (gain) v[e] *= gain[(size_t)mat * K + k0 + kc + e]; }
          u32x4 w; w.x = cvt_pk_bf16(v[0], v[1]); w.y = cvt_pk_bf16(v[2], v[3]); w.z = cvt_pk_bf16(v[4], v[5]); w.w = cvt_pk_bf16(v[6], v[7]);
          *(u32x4*)(d + (size_t)(n0 + n) * K + k0 + kc) = w; }
    }
}
__device__ __forceinline__ void cvt_flat(const Ctx& F, const float* src, bf16_t* dst, size_t n8) {
    for (size_t i = (size_t)F.vcu * 512 + F.tid; i < n8; i += (size_t)F.G * 512) {
        const f32x4 a = *(const f32x4*)(src + i * 8), b = *(const f32x4*)(src + i * 8 + 4);
        u32x4 w; w.x = cvt_pk_bf16(a[0], a[1]); w.y = cvt_pk_bf16(a[2], a[3]); w.z = cvt_pk_bf16(b[0], b[1]); w.w = cvt_pk_bf16(b[2], b[3]);
        *(u32x4*)(dst + i * 8) = w;
    }
}
typedef unsigned v6u __attribute__((ext_vector_type(6)));
typedef float v32f __attribute__((ext_vector_type(32)));
typedef float v16f __attribute__((ext_vector_type(16)));
__device__ __forceinline__ float fp6_val(int c) { return c < 8 ? c * 0.125f : (c < 16 ? 1.f + (c - 8) * 0.125f : (c < 24 ? 2.f + (c - 16) * 0.25f : 4.f + (c - 24) * 0.5f)); }
__device__ __forceinline__ int fp6_code(float x) { return x < 1.f ? (int)(x * 8.f + 0.5f) : (x < 2.f ? 8 + (int)((x - 1.f) * 8.f + 0.5f) : (x < 4.f ? 16 + (int)((x - 2.f) * 4.f + 0.5f) : 24 + (int)((x - 4.f) * 2.f + 0.5f))); }
__device__ __forceinline__ void cvt_rows_fp6(const Ctx& F, const float* src, unsigned char* dst, float* descale, int R) {
    float* stg = (float*)(F.lds + 65536) + F.wid * (64 * 33);
    int* permL = (int*)(F.lds + 65536 + 8 * 64 * 33 * 4) + F.wid * 32;
    float fac;
    {   v16f lo, hi;
#pragma unroll
        for (int i = 0; i < 16; ++i) { lo[i] = fp6_val(i); hi[i] = fp6_val(16 + i); }
        const v6u w = __builtin_amdgcn_cvt_scalef32_2xpk16_fp6_f32(lo, hi, 1.0f);
        const v32f f = __builtin_amdgcn_cvt_scalef32_pk32_f32_fp6(w, 1.0f);
        float mx = 0.f;
#pragma unroll
        for (int j = 0; j < 32; ++j) mx = fmaxf(mx, f[j]);
        fac = mx * (1.f / 7.5f);
        const float inv = fac > 0.f ? 1.f / fac : 1.f;
        if (F.lane == 0) {
#pragma unroll
            for (int j = 0; j < 32; ++j) permL[j] = fp6_code(f[j] * inv) & 31; }
        asm volatile("s_waitcnt lgkmcnt(0)" ::: "memory"); __builtin_amdgcn_wave_barrier(); asm volatile("" ::: "memory");
    }
    for (int row = F.vcu * 8 + F.wid; row < R; row += F.G * 8) {
        const float* s = src + (size_t)row * DM + F.lane * 4; f32x4 v[8]; float am = 0.f;
#pragma unroll
        for (int i = 0; i < 8; ++i) { v[i] = *(const f32x4*)(s + i * 256);
#pragma unroll
            for (int e = 0; e < 4; ++e) am = fmaxf(am, fabsf(v[i][e])); }
        am = wave_max(am);
        const float sc = am > 0.f ? 7.f / am : 1.f;
#pragma unroll
        for (int i = 0; i < 8; ++i)
#pragma unroll
            for (int e = 0; e < 4; ++e) stg[F.lane * 33 + permL[i * 4 + e]] = v[i][e] * sc;
        asm volatile("s_waitcnt lgkmcnt(0)" ::: "memory"); __builtin_amdgcn_wave_barrier(); asm volatile("" ::: "memory");
        v16f lo, hi;
#pragma unroll
        for (int i = 0; i < 16; ++i) { lo[i] = stg[F.lane * 33 + i]; hi[i] = stg[F.lane * 33 + 16 + i]; }
        asm volatile("s_waitcnt lgkmcnt(0)" ::: "memory"); __builtin_amdgcn_wave_barrier(); asm volatile("" ::: "memory");
        const v6u w = __builtin_amdgcn_cvt_scalef32_2xpk16_fp6_f32(lo, hi, 1.0f);
        u32x2* d = (u32x2*)(dst + (size_t)row * EROW + F.lane * 24);
        d[0] = (u32x2){w[0], w[1]}; d[1] = (u32x2){w[2], w[3]}; d[2] = (u32x2){w[4], w[5]};
        if (F.lane == 0) descale[row] = (am > 0.f ? am * (1.f / 7.f) : 1.f) / (fac > 0.f ? fac : 1.f);
    }
}
__device__ __forceinline__ float silu_f(float v) { return v / (1.f + __expf(-v)); }

__device__ __forceinline__ void prologue_phase(const Ctx& F, CParams& P) {
    unsigned char* ws = F.ws;
    {
        float* sv = (float*)F.lds;
        float* part = (float*)(F.lds + 24576);
        for (int i = F.tid; i < 3 * DM; i += 512) { const int v = i / DM, k = i % DM; const float cv = v < 2 ? P.c[v * DM + k] : P.c_ctx[k]; sv[i] = silu_f(cv); }
        __syncthreads();
        float* mod = (float*)(ws + WS_MOD);
        for (int it = F.vcu; it < DEPTH * 192; it += F.G) {
            const int l = it / 192, n0 = (it % 192) * 64;
            const float* wp = P.w_mod + ((size_t)l * DM + F.wid * 256) * 12288 + n0 + F.lane;
            float a0 = 0.f, a1 = 0.f, a2 = 0.f;
#pragma unroll 8
            for (int k = 0; k < 256; ++k) { const float w = wp[(size_t)k * 12288]; const int kk = F.wid * 256 + k; a0 += sv[kk] * w; a1 += sv[DM + kk] * w; a2 += sv[2 * DM + kk] * w; }
            part[(F.wid * 3 + 0) * 64 + F.lane] = a0; part[(F.wid * 3 + 1) * 64 + F.lane] = a1; part[(F.wid * 3 + 2) * 64 + F.lane] = a2;
            __syncthreads();
            if (F.wid < 3) { float s = 0.f;
#pragma unroll
                for (int w = 0; w < 8; ++w) s += part[(w * 3 + F.wid) * 64 + F.lane];
                mod[((size_t)l * 3 + F.wid) * 12288 + n0 + F.lane] = s + P.b_mod[(size_t)l * 12288 + n0 + F.lane]; }
            __syncthreads();
        }
    }
    if (F.vcu == 0) {
        float* t16 = (float*)(ws + WS_TAB16); float* t32 = (float*)(ws + WS_TAB32);
        for (int i = F.tid; i < 128 * 16; i += 512) { const int pos = i >> 4, f = i & 15; const float fr = powf(10000.f, -(float)f / 16.f); const float a = (float)pos * fr; float s, c; sincosf(a, &s, &c); t16[i * 2] = c; t16[i * 2 + 1] = s; }
        for (int i = F.tid; i < 128 * 32; i += 512) { const int pos = i >> 5, f = i & 31; const float fr = powf(10000.f, -(float)f / 32.f); const float a = (float)pos * fr; float s, c; sincosf(a, &s, &c); t32[i * 2] = c; t32[i * 2 + 1] = s; }
        if (F.wid == 2) { float* bnd = (float*)(ws + WS_LAM) + 4;
            for (int e2 = 0; e2 < 2; ++e2) {
                float ga = 0.f, gb = 0.f, gc = 0.f, gd = 0.f, ge = 0.f, gf = 0.f;
                for (int i = F.lane; i < 192; i += 64) { ga = fmaxf(ga, fabsf(P.g_qn_a[e2 * 192 + i])); gb = fmaxf(gb, fabsf(P.g_kn_a[e2 * 192 + i])); }
                gc = fabsf(P.g_qn_b[e2 * 64 + F.lane]); gd = fabsf(P.g_kn_b[e2 * 64 + F.lane]);
                for (int i = F.lane; i < 128; i += 64) { ge = fmaxf(ge, fabsf(P.g_qn_c[e2 * 128 + i])); gf = fmaxf(gf, fabsf(P.g_kn_c[e2 * 128 + i])); }
                ga = wave_max(ga); gb = wave_max(gb); gc = wave_max(gc); gd = wave_max(gd); ge = wave_max(ge); gf = wave_max(gf);
                if (F.lane == 0) { bnd[(2 * e2) * 2 + 0] = 1.03f * 13.856406f * ga * gb;
                                   bnd[(2 * e2) * 2 + 1] = 1.03f * 8.f * gc * gd;
                                   bnd[(2 * e2 + 1) * 2 + 0] = 1.03f * 11.313708f * ge * gf;
                                   bnd[(2 * e2 + 1) * 2 + 1] = 0.f; } } }
        if (F.wid < 2) { const float* lv = P.lam_vec + F.wid * 256; const float d1 = wave_sum(lv[F.lane] * lv[64 + F.lane]), d2 = wave_sum(lv[128 + F.lane] * lv[192 + F.lane]);
            const float lam_init = 0.8f - 0.6f * expf(-0.3f * (float)(2 * F.wid));
            if (F.lane == 0) ((float*)(ws + WS_LAM))[F.wid] = expf(d1) - expf(d2) + lam_init; }
    }
    tconv(F, P.w_in_ab, (bf16_t*)(ws + WS_WINAB), nullptr, 2, DM, AB_IN, AB_INP, 3392, AB_INP - AB_IN);
    tconv(F, P.w_uq, (bf16_t*)(ws + WS_WUQ), P.g_cq, 2, 768, 1536, 1536);
    tconv(F, P.w_ukv, (bf16_t*)(ws + WS_WUKV), P.g_ckv, 2, 512, 2048, 2048);
    tconv(F, P.w_out_ab, (bf16_t*)(ws + WS_WOUTAB), nullptr, 2, DM, DM, DM);
    tconv(F, P.w_in_c, (bf16_t*)(ws + WS_WINC), nullptr, 2, DM, C_IN, C_IN);
    tconv(F, P.w_out_c, (bf16_t*)(ws + WS_WOUTC), nullptr, 2, DM, DM, DM);
    tconv(F, P.w_pq, (bf16_t*)(ws + WS_WPQ), nullptr, 4, DM, DM, DM);
    cvt_flat(F, P.sub_keys, (bf16_t*)(ws + WS_SUBK), (size_t)4 * 8 * 2 * 128 * 128 / 8);
    cvt_rows_fp6(F, P.expert_u, ws + WS_EU, (float*)(ws + WS_SU), 4 * NEXP);
    cvt_rows_fp6(F, P.expert_v, ws + WS_EV, (float*)(ws + WS_SV), 4 * NEXP);
}

__device__ __forceinline__ void norm_rows(const Ctx& F, CParams& P, int layer, int which  , int t_first, int t_end, int t_stride) {
    float* X = (float*)(F.ws + WS_X); bf16_t* H = (bf16_t*)(F.ws + WS_H);
    const float* mod = (const float*)(F.ws + WS_MOD) + (size_t)layer * 3 * 12288;
    const float* gn = (which ? P.g_norm2 : P.g_norm1) + (size_t)layer * DM;
    const bool from_in = (layer == 0 && which == 0);
    const int lane = fresh_lane();
    if (t_first >= t_end) return;
    f32x4 g[8];
#pragma unroll
    for (int j = 0; j < 8; ++j) g[j] = *(const f32x4*)(gn + j * 256 + lane * 4);
    auto srcrow = [&](int t) { return from_in ? (t < TL ? P.x + (size_t)t * DM : P.ctx + (size_t)(t - TL) * DM) : X + (size_t)t * DM; };
    f32x4 vn[8];
    { const float* src = srcrow(t_first);
#pragma unroll
      for (int j = 0; j < 8; ++j) vn[j] = *(const f32x4*)(src + j * 256 + lane * 4); }
    for (int t = t_first; t < t_end; t += t_stride) {
        const int vs = vsel_of_row(t);
        const float* shf = mod + (size_t)vs * 12288 + (which ? 3 : 0) * DM; const float* scl = shf + DM;
        f32x4 v[8], sc[8], sh[8]; float ss = 0.f;
#pragma unroll
        for (int j = 0; j < 8; ++j) { v[j] = vn[j]; sc[j] = *(const f32x4*)(scl + j * 256 + lane * 4); sh[j] = *(const f32x4*)(shf + j * 256 + lane * 4); }
        { const int tn = t + t_stride; const float* src = srcrow(tn < t_end ? tn : t);
#pragma unroll
          for (int j = 0; j < 8; ++j) vn[j] = *(const f32x4*)(src + j * 256 + lane * 4); }
#pragma unroll
        for (int j = 0; j < 8; ++j) ss += v[j][0] * v[j][0] + v[j][1] * v[j][1] + v[j][2] * v[j][2] + v[j][3] * v[j][3];
        ss = wave_sum(ss);
        const float rstd = rsqrtf(ss * (1.f / DM) + EPS);
#pragma unroll
        for (int j = 0; j < 8; ++j) { const int c = j * 256 + lane * 4;
            f32x4 y;
#pragma unroll
            for (int e = 0; e < 4; ++e) y[e] = (v[j][e] * rstd * g[j][e]) * (1.f + sc[j][e]) + sh[j][e];
            u32x2 w; w.x = cvt_pk_bf16(y[0], y[1]); w.y = cvt_pk_bf16(y[2], y[3]);
            *(u32x2*)(H + (size_t)t * DM + c) = w; }
    }
}
__device__ __forceinline__ void norm_phase(const Ctx& F, CParams& P, int layer, int which, int m_rows) { norm_rows(F, P, layer, which, F.vcu * 8 + F.wid, m_rows, F.G * 8); }

__device__ __forceinline__ float grp16_sum(float v) { v += swz_xor<8>(v); v += swz_xor<4>(v); v += swz_xor<2>(v); v += swz_xor<1>(v); return v; }
__device__ __forceinline__ void rope4(float (&x)[4], int q16, int row, int col, const float* t16) {
    const int seg = q16 >> 3, f0 = (q16 & 3) * 4, pos = seg ? col : row; const bool first = (q16 & 7) < 4;
    const f32x4 c0 = *(const f32x4*)(t16 + (pos * 16 + f0) * 2), c1 = *(const f32x4*)(t16 + (pos * 16 + f0) * 2 + 4);
    const float cs[4] = {c0[0], c0[2], c1[0], c1[2]}, sn[4] = {c0[1], c0[3], c1[1], c1[3]};
#pragma unroll
    for (int e = 0; e < 4; ++e) { const float p = swz_xor<4>(x[e]); x[e] = first ? x[e] * cs[e] - p * sn[e] : p * sn[e] + x[e] * cs[e]; }
}
__device__ __forceinline__ void rope8(float (&x)[8], int q16, int row, int col, const float* t32) {
    const int seg = q16 >> 3, f0 = (q16 & 3) * 8, pos = seg ? col : row; const bool first = (q16 & 7) < 4;
    const float* tp = t32 + (pos * 32 + f0) * 2;
#pragma unroll
    for (int q = 0; q < 4; ++q) { const f32x4 c = *(const f32x4*)(tp + q * 4);
#pragma unroll
        for (int s = 0; s < 2; ++s) { const int e = q * 2 + s; const float cs = c[s * 2], sn = c[s * 2 + 1]; const float p = swz_xor<4>(x[e]); x[e] = first ? x[e] * cs - p * sn : p * sn + x[e] * cs; } }
}
__device__ __forceinline__ void ld8bf(const bf16_t* p, float (&x)[8]) { const u32x4 w = *(const u32x4*)p;
#pragma unroll
    for (int q = 0; q < 4; ++q) { x[q * 2] = bf_lo(w[q]); x[q * 2 + 1] = bf_hi(w[q]); } }
__device__ __forceinline__ void ld4bf(const bf16_t* p, float (&x)[4]) { const u32x2 w = *(const u32x2*)p; x[0] = bf_lo(w.x); x[1] = bf_hi(w.x); x[2] = bf_lo(w.y); x[3] = bf_hi(w.y); }
__device__ __forceinline__ void st8bf(bf16_t* p, const float (&x)[8]) { u32x4 w; w.x = cvt_pk_bf16(x[0], x[1]); w.y = cvt_pk_bf16(x[2], x[3]); w.z = cvt_pk_bf16(x[4], x[5]); w.w = cvt_pk_bf16(x[6], x[7]); *(u32x4*)p = w; }
__device__ __forceinline__ void st4bf(bf16_t* p, const float (&x)[4]) { u32x2 w; w.x = cvt_pk_bf16(x[0], x[1]); w.y = cvt_pk_bf16(x[2], x[3]); *(u32x2*)p = w; }

__device__ __forceinline__ void qkv_even_phase(const Ctx& F, CParams& P, int e) {
    const bf16_t* P1 = (const bf16_t*)(F.ws + WS_P1); const bf16_t* QA = (const bf16_t*)(F.ws + WS_QA); const bf16_t* KV = (const bf16_t*)(F.ws + WS_KV);
    bf16_t* Qm = (bf16_t*)(F.ws + WS_Q1); bf16_t* Km = (bf16_t*)(F.ws + WS_K1); bf16_t* Vm = (bf16_t*)(F.ws + WS_V1);
    bf16_t* Qd = (bf16_t*)(F.ws + WS_Q2); bf16_t* Kd = (bf16_t*)(F.ws + WS_K2); bf16_t* Vd = (bf16_t*)(F.ws + WS_V2);
    const float* t16 = (const float*)(F.ws + WS_TAB16);
    const float* gqa = P.g_qn_a + e * 192; const float* gka = P.g_kn_a + e * 192; const float* gqb = P.g_qn_b + e * 64; const float* gkb = P.g_kn_b + e * 64;
    const int q16 = F.lane & 15, grp = F.lane >> 4;
    float gq_n[8], gq_r[4], gk_n[8], gk_r[4], gqd[4], gkd[4];
#pragma unroll
    for (int i = 0; i < 8; ++i) { gq_n[i] = gqa[q16 * 8 + i]; gk_n[i] = gka[q16 * 8 + i]; }
#pragma unroll
    for (int i = 0; i < 4; ++i) { gq_r[i] = gqa[128 + q16 * 4 + i]; gk_r[i] = gka[128 + q16 * 4 + i]; gqd[i] = gqb[q16 * 4 + i]; gkd[i] = gkb[q16 * 4 + i]; }
    struct Raw { u32x2 cq[3]; u32x4 ckv; u32x2 kro; u32x4 qn[2]; u32x2 qr[2]; u32x4 kn[2], kv[2]; u32x2 dq[4], dk[4]; f32x4 rc0, rc1; };
    auto load_raw = [&](int t, Raw& R) {
        const bf16_t* p1 = P1 + (size_t)t * AB_INP;
        { const int s_ = t & (SEQ - 1), pos_ = (q16 >> 3) ? (s_ & 63) : (s_ >> 6); const float* tp = t16 + (pos_ * 16 + (q16 & 3) * 4) * 2; R.rc0 = *(const f32x4*)tp; R.rc1 = *(const f32x4*)(tp + 4); }
#pragma unroll
        for (int j = 0; j < 3; ++j) R.cq[j] = *(const u32x2*)(p1 + j * 256 + F.lane * 4);
        R.ckv = *(const u32x4*)(p1 + 768 + F.lane * 8);
        R.kro = *(const u32x2*)(p1 + 1280 + q16 * 4);
#pragma unroll
        for (int ps = 0; ps < 2; ++ps) { const int h = ps * 4 + grp; const bf16_t* src = QA + (size_t)t * 1536 + h * 192;
            R.qn[ps] = *(const u32x4*)(src + q16 * 8); R.qr[ps] = *(const u32x2*)(src + 128 + q16 * 4);
            const bf16_t* sk = KV + (size_t)t * 2048 + h * 256; R.kn[ps] = *(const u32x4*)(sk + q16 * 8); R.kv[ps] = *(const u32x4*)(sk + 128 + q16 * 8); }
#pragma unroll
        for (int ps = 0; ps < 4; ++ps) { const int hm = ps * 4 + grp; R.dq[ps] = *(const u32x2*)(p1 + 1344 + hm * 64 + q16 * 4); R.dk[ps] = *(const u32x2*)(p1 + 2368 + hm * 64 + q16 * 4); }
    };
#define UNP8(W, X) do { X[0] = bf_lo(W.x); X[1] = bf_hi(W.x); X[2] = bf_lo(W.y); X[3] = bf_hi(W.y); X[4] = bf_lo(W.z); X[5] = bf_hi(W.z); X[6] = bf_lo(W.w); X[7] = bf_hi(W.w); } while (0)
#define UNP4(W, X) do { X[0] = bf_lo(W.x); X[1] = bf_hi(W.x); X[2] = bf_lo(W.y); X[3] = bf_hi(W.y); } while (0)
    const int tfirst = F.vcu * 8 + F.wid, tstr = F.G * 8;
    Raw R; if (tfirst < TT) load_raw(tfirst, R);
    for (int t = tfirst; t < TT; t += tstr) {
        const bool latent = t < TL; const int s = t & (SEQ - 1), row = s >> 6, col = s & 63; const int kr = krow_of(t);
        Raw C = R; { const int tn = t + tstr; load_raw(tn < TT ? tn : t, R); }
        const float rcs[4] = {C.rc0[0], C.rc0[2], C.rc1[0], C.rc1[2]}, rsn[4] = {C.rc0[1], C.rc0[3], C.rc1[1], C.rc1[3]}; const bool rfirst = (q16 & 7) < 4;
#define ROPE4V(X) do { _Pragma("unroll") for (int e_ = 0; e_ < 4; ++e_) { const float p_ = swz_xor<4>(X[e_]); X[e_] = rfirst ? X[e_] * rcs[e_] - p_ * rsn[e_] : p_ * rsn[e_] + X[e_] * rcs[e_]; } } while (0)
        float ss = 0.f;
#pragma unroll
        for (int j = 0; j < 3; ++j) { float x[4]; UNP4(C.cq[j], x); ss += x[0] * x[0] + x[1] * x[1] + x[2] * x[2] + x[3] * x[3]; }
        ss = wave_sum(ss); const float rstd_q = rsqrtf(ss * (1.f / 768.f) + EPS);
        float s2 = 0.f;
        { float x[8]; UNP8(C.ckv, x);
#pragma unroll
          for (int i = 0; i < 8; ++i) s2 += x[i] * x[i]; }
        s2 = wave_sum(s2); const float rstd_kv = rsqrtf(s2 * (1.f / 512.f) + EPS);
        float kro[4]; UNP4(C.kro, kro);
#pragma unroll
        for (int ps = 0; ps < 2; ++ps) { const int h = ps * 4 + grp;
            float xn[8], xr[4]; UNP8(C.qn[ps], xn); UNP4(C.qr[ps], xr);
            float sq = 0.f;
#pragma unroll
            for (int i = 0; i < 8; ++i) { xn[i] *= rstd_q; sq += xn[i] * xn[i]; }
#pragma unroll
            for (int i = 0; i < 4; ++i) { xr[i] *= rstd_q; sq += xr[i] * xr[i]; }
            sq = grp16_sum(sq); const float r = rsqrtf(sq * (1.f / 192.f) + EPS);
            const float rq = r * (0.07216878364870322f * LOG2E);
#pragma unroll
            for (int i = 0; i < 8; ++i) xn[i] *= rq * gq_n[i];
#pragma unroll
            for (int i = 0; i < 4; ++i) xr[i] *= rq * gq_r[i];
            if (latent) ROPE4V(xr);
            bf16_t* dst = Qm + ((size_t)t * 8 + h) * 192; st8bf(dst + q16 * 8, xn); st4bf(dst + 128 + q16 * 4, xr); }
#pragma unroll
        for (int ps = 0; ps < 2; ++ps) { const int h = ps * 4 + grp;
            float xn[8], xr[4], xv[8]; UNP8(C.kn[ps], xn); UNP8(C.kv[ps], xv);
            float sq = 0.f;
#pragma unroll
            for (int i = 0; i < 8; ++i) { xn[i] *= rstd_kv; xv[i] *= rstd_kv; sq += xn[i] * xn[i]; }
#pragma unroll
            for (int i = 0; i < 4; ++i) { xr[i] = kro[i]; sq += xr[i] * xr[i]; }
            sq = grp16_sum(sq); const float r = rsqrtf(sq * (1.f / 192.f) + EPS);
#pragma unroll
            for (int i = 0; i < 8; ++i) xn[i] *= r * gk_n[i];
#pragma unroll
            for (int i = 0; i < 4; ++i) xr[i] *= r * gk_r[i];
            if (latent) ROPE4V(xr);
            bf16_t* dst = Km + ((size_t)kr * 8 + h) * 192; st8bf(dst + q16 * 8, xn); st4bf(dst + 128 + q16 * 4, xr);
            st8bf(Vm + ((size_t)kr * 8 + h) * 128 + q16 * 8, xv); }
#pragma unroll
        for (int ps = 0; ps < 4; ++ps) { const int hm = ps * 4 + grp;
            float x[4]; UNP4(C.dq[ps], x);
            float sq = grp16_sum(x[0] * x[0] + x[1] * x[1] + x[2] * x[2] + x[3] * x[3]); float r = rsqrtf(sq * (1.f / 64.f) + EPS);
#pragma unroll
            for (int i = 0; i < 4; ++i) x[i] *= r * (0.125f * LOG2E) * gqd[i];
            if (latent) ROPE4V(x);
            st4bf(Qd + ((size_t)t * 16 + hm) * 64 + q16 * 4, x);
            UNP4(C.dk[ps], x);
            sq = grp16_sum(x[0] * x[0] + x[1] * x[1] + x[2] * x[2] + x[3] * x[3]); r = rsqrtf(sq * (1.f / 64.f) + EPS);
#pragma unroll
            for (int i = 0; i < 4; ++i) x[i] *= r * gkd[i];
            if (latent) ROPE4V(x);
            st4bf(Kd + ((size_t)kr * 16 + hm) * 64 + q16 * 4, x); }
    }
#undef UNP8
#undef UNP4
#undef ROPE4V
}
__device__ __forceinline__ void qkv_odd_rows(const Ctx& F, CParams& P, int e, int t_first, int t_end, int t_stride) {
    const bf16_t* P1 = (const bf16_t*)(F.ws + WS_P1);
    bf16_t* Qc = (bf16_t*)(F.ws + WS_Q1); bf16_t* Kc = (bf16_t*)(F.ws + WS_K1); bf16_t* Vc = (bf16_t*)(F.ws + WS_V1);
    const float* t32 = (const float*)(F.ws + WS_TAB32);
    const int lane = fresh_lane();
    const int q16 = lane & 15, grp = lane >> 4;
    float gq[8], gk[8];
#pragma unroll
    for (int i = 0; i < 8; ++i) { gq[i] = P.g_qn_c[e * 128 + q16 * 8 + i]; gk[i] = P.g_kn_c[e * 128 + q16 * 8 + i]; }
    if (t_first >= t_end) return;
    struct Raw { u32x4 x[5]; f32x4 rc[4]; };
    auto load_raw = [&](int t, Raw& R) {
        const bf16_t* p1 = P1 + (size_t)t * C_IN;
#pragma unroll
        for (int ps = 0; ps < 5; ++ps) { const bool isq = ps < 4; const int h = isq ? ps * 4 + grp : grp; R.x[ps] = *(const u32x4*)(p1 + (isq ? 0 : 2048) + h * 128 + q16 * 8); }
        const int s_ = t & (SEQ - 1), pos_ = (q16 >> 3) ? (s_ & 63) : (s_ >> 6); const float* tp = t32 + (pos_ * 32 + (q16 & 3) * 8) * 2;
#pragma unroll
        for (int q = 0; q < 4; ++q) R.rc[q] = *(const f32x4*)(tp + q * 4);
    };
    Raw R; load_raw(t_first, R);
    for (int t = t_first; t < t_end; t += t_stride) {
        const bool latent = t < TL; const int kr = krow_of(t);
        Raw C = R; { const int tn = t + t_stride; load_raw(tn < t_end ? tn : t, R); }
        const bool rfirst = (q16 & 7) < 4;
#pragma unroll
        for (int ps = 0; ps < 5; ++ps) {
            const bool isq = ps < 4; const int h = isq ? ps * 4 + grp : grp;
            float x[8]; { const u32x4 w = C.x[ps]; x[0] = bf_lo(w.x); x[1] = bf_hi(w.x); x[2] = bf_lo(w.y); x[3] = bf_hi(w.y); x[4] = bf_lo(w.z); x[5] = bf_hi(w.z); x[6] = bf_lo(w.w); x[7] = bf_hi(w.w); }
            float sq = 0.f;
#pragma unroll
            for (int i = 0; i < 8; ++i) sq += x[i] * x[i];
            sq = grp16_sum(sq); const float r = rsqrtf(sq * (1.f / 128.f) + EPS);
#pragma unroll
            for (int i = 0; i < 8; ++i) x[i] *= r * (isq ? gq[i] * (0.08838834764831845f * LOG2E) : gk[i]);
            if (latent) {
#pragma unroll
                for (int q = 0; q < 4; ++q)
#pragma unroll
                    for (int s2 = 0; s2 < 2; ++s2) { const int e = q * 2 + s2; const float cs = C.rc[q][s2 * 2], sn = C.rc[q][s2 * 2 + 1]; const float p = swz_xor<4>(x[e]); x[e] = rfirst ? x[e] * cs - p * sn : p * sn + x[e] * cs; } }
            st8bf(isq ? Qc + ((size_t)t * 16 + h) * 128 + q16 * 8 : Kc + ((size_t)kr * 4 + h) * 128 + q16 * 8, x); }
    }
}

template <int DQK, int SDEPTH, int ldo, int NH, int NKVH, int NVH>
__device__ __forceinline__ void attn_phase(const Ctx& F, const bf16_t* Qbuf, const bf16_t* Kbuf, const bf16_t* Vbuf, bf16_t* OF, int ocol0, bool with_ctx, const float bound  ) {
    const bool nomax = bound < 60.f;
    const float negMC = 0.f;
    constexpr int kv_div = NH / NKVH, v_div = NH / NVH;
    const int n_lat = NH * NB * 32, n_tot = n_lat + (with_ctx ? NH * NB : 0);
    constexpr int ldq = NH * DQK, ldk = NKVH * DQK, ldv = NVH * 128;
    for (int u = F.vcu; u < n_tot; u += F.G) {
        int b, h, qrow0, kstart, seq;
        if (u < n_lat) { const int bh = u >> 5, qb = u & 31; b = bh / NH; h = bh % NH; qrow0 = b * SEQ + qb * 256; kstart = b * KPB; seq = KPB; }
        else { const int bh = u - n_lat; b = bh / NH; h = bh % NH; qrow0 = TL + b * CTXL; kstart = b * KPB + SEQ; seq = CTXL; }
        const bf16_t* Qp = Qbuf + ((size_t)qrow0 * NH + h) * DQK;
        const bf16_t* Kp = Kbuf + ((size_t)kstart * NKVH + h / kv_div) * DQK;
        const bf16_t* Vp = Vbuf + ((size_t)kstart * NVH + h / v_div) * 128;
        bf16_t* Op = OF + (size_t)qrow0 * ldo + ocol0 + h * 128;
        if constexpr (SDEPTH == 0) att::attn_body_simple<DQK, (DQK == 192 ? MLA_QL : 0), ldq, ldk, ldv, ldo>(Qp, Kp, Vp, Op, seq, F.lds, F.wid);
        else { if (nomax) att::attn_body<DQK, SDEPTH, (DQK == 192 ? MLA_QL : (DQK == 128 ? GQA_QL : 0)), true, ldq, ldk, ldv, ldo>(Qp, Kp, Vp, Op, seq, F.lds, F.wid, negMC);
               else att::attn_body_simple<DQK, 0, ldq, ldk, ldv, ldo>(Qp, Kp, Vp, Op, seq, F.lds, F.wid); }
    }
}

__device__ __forceinline__ void merge_even_phase(const Ctx& F, CParams& P, int e, int layer, int m_rows) {
    const bf16_t* OD = (const bf16_t*)(F.ws + WS_OF); bf16_t* AO = (bf16_t*)(F.ws + WS_AO);
    const float lam = ((const float*)(F.ws + WS_LAM))[e];
    const float lam_init = 0.8f - 0.6f * expf(-0.3f * (float)layer);
    const int q16 = F.lane & 15, grp = F.lane >> 4;
    float gs[8];
#pragma unroll
    for (int i = 0; i < 8; ++i) gs[i] = P.g_sub_b[e * 128 + q16 * 8 + i] * (1.f - lam_init);
    for (int t = F.vcu * 8 + F.wid; t < m_rows; t += F.G * 8) {
        const bf16_t* od = OD + (size_t)t * DM; bf16_t* ao = AO + (size_t)t * DM + 1024;
#pragma unroll
        for (int ps = 0; ps < 2; ++ps) { const int h = ps * 4 + grp;
            float o0[8], o1[8], d[8]; ld8bf(od + (2 * h) * 128 + q16 * 8, o0); ld8bf(od + (2 * h + 1) * 128 + q16 * 8, o1);
            float sq = 0.f;
#pragma unroll
            for (int i = 0; i < 8; ++i) { d[i] = o0[i] - lam * o1[i]; sq += d[i] * d[i]; }
            sq = grp16_sum(sq); const float r = rsqrtf(sq * (1.f / 128.f) + EPS);
#pragma unroll
            for (int i = 0; i < 8; ++i) d[i] *= r * gs[i];
            st8bf(ao + h * 128 + q16 * 8, d); }
    }
}

__device__ __forceinline__ void wave_lds_fence() { asm volatile("s_waitcnt lgkmcnt(0)" ::: "memory"); __builtin_amdgcn_wave_barrier(); asm volatile("" ::: "memory"); }
__device__ __forceinline__ unsigned fkey(float f) { const unsigned b = __float_as_uint(f); return b ^ ((unsigned)((int)b >> 31) | 0x80000000u); }
__device__ __forceinline__ float funkey(unsigned k) { return __uint_as_float((k & 0x80000000u) ? (k ^ 0x80000000u) : ~k); }
__device__ __forceinline__ unsigned umed3(unsigned a, unsigned b, unsigned c) { unsigned r; asm("v_med3_u32 %0, %1, %2, %3" : "=v"(r) : "v"(a), "v"(b), "v"(c)); return r; }
__device__ __forceinline__ void kins16(unsigned (&L)[16], unsigned k) {
#pragma unroll
    for (int p = 15; p >= 1; --p) L[p] = umed3(L[p - 1], L[p], k);
    L[0] = L[0] > k ? L[0] : k;
}
__device__ __forceinline__ void scan_set(unsigned (&L)[16], const bf16_t* qbase  , const bf16_t* kbase  , float* buf, int lane) {
    const int r32 = lane & 31, hi = lane >> 5;
#pragma unroll
    for (int p = 0; p < 16; ++p) L[p] = 0u;
    bf16x8 a0[8], a1[8];
    { const bf16_t* ap = qbase + (size_t)r32 * DM + hi * 8;
#pragma unroll
      for (int ks = 0; ks < 8; ++ks) { a0[ks] = *(const bf16x8*)(ap + ks * 16); a1[ks] = *(const bf16x8*)(ap + (size_t)32 * DM + ks * 16); } }
#pragma unroll 1
    for (int kb = 0; kb < 4; ++kb) {
        f32x16 acc0 = {}, acc1 = {};
        { const bf16_t* bp = kbase + (size_t)(kb * 32 + r32) * 128 + hi * 8;
          bf16x8 b[8];
#pragma unroll
          for (int ks = 0; ks < 8; ++ks) b[ks] = *(const bf16x8*)(bp + ks * 16);
#pragma unroll
          for (int ks = 0; ks < 8; ++ks) { acc0 = __builtin_amdgcn_mfma_f32_32x32x16_bf16(a0[ks], b[ks], acc0, 0, 0, 0); acc1 = __builtin_amdgcn_mfma_f32_32x32x16_bf16(a1[ks], b[ks], acc1, 0, 0, 0); } }
        wave_lds_fence();
#pragma unroll
        for (int r = 0; r < 16; ++r) { const int rowi = att::crow(r, hi); buf[rowi * 33 + r32] = acc0[r]; buf[(32 + rowi) * 33 + r32] = acc1[r]; }
        wave_lds_fence();
        const unsigned tb = 127u - (unsigned)(kb * 32);
#pragma unroll 8
        for (int k = 0; k < 32; ++k) kins16(L, (fkey(buf[lane * 33 + k]) & ~127u) | (tb - (unsigned)k));
    }
}
__device__ __forceinline__ void peer_select_unit(const Ctx& F, int layer, int u) {
    const bf16_t* PQ = (const bf16_t*)(F.ws + WS_PQ); const bf16_t* SK = (const bf16_t*)(F.ws + WS_SUBK) + (size_t)layer * 8 * 2 * 128 * 128;
    int* PIDX = (int*)(F.ws + WS_PIDX); float* PG = (float*)(F.ws + WS_PG);
    float* buf = (float*)F.lds + F.wid * (64 * 33);
    const int lane = fresh_lane();
    {
        const int tile = u >> 3, h = u & 7, t0 = tile * 64;
        unsigned Ka[16], Kb[16];
        scan_set(Ka, PQ + (size_t)t0 * DM + h * 256, SK + (size_t)(h * 2) * 128 * 128, buf, lane);
        scan_set(Kb, PQ + (size_t)t0 * DM + h * 256 + 128, SK + (size_t)(h * 2 + 1) * 128 * 128, buf, lane);
        wave_lds_fence();
        float la[16], lb[16];
#pragma unroll
        for (int p = 0; p < 16; ++p) { la[p] = funkey(Ka[p] & ~127u); lb[p] = funkey(Kb[p] & ~127u);
            buf[lane * 33 + p] = __int_as_float(127 - (int)(Ka[p] & 127u)); buf[lane * 33 + 16 + p] = __int_as_float(127 - (int)(Kb[p] & 127u)); }
        wave_lds_fence();
        unsigned Kc[16];
#pragma unroll
        for (int p = 0; p < 16; ++p) Kc[p] = 0u;
#pragma unroll
        for (int r1 = 0; r1 < 16; ++r1)
#pragma unroll
            for (int r2 = 0; r2 < 16; ++r2) if ((r1 + 1) * (r2 + 1) <= 16) kins16(Kc, (fkey(la[r1] + lb[r2]) & ~255u) | (unsigned)(255 - (16 * r1 + r2)));
        float bv[16], sm = 0.f; unsigned idx[16];
#pragma unroll
        for (int p = 0; p < 16; ++p) { const int code = 255 - (int)(Kc[p] & 255u); bv[p] = funkey(Kc[p] & ~255u);
            idx[p] = (unsigned)(__float_as_int(buf[lane * 33 + (code >> 4)]) * 128 + __float_as_int(buf[lane * 33 + 16 + (code & 15)])); }
        const float bmax = bv[0];
#pragma unroll
        for (int p = 0; p < 16; ++p) { bv[p] = __expf(bv[p] - bmax); sm += bv[p]; }
        const float inv = 1.f / sm;
        const size_t o = ((size_t)(t0 + lane) * 8 + h) * 16;
#pragma unroll
        for (int q = 0; q < 4; ++q) { *(f32x4*)(PG + o + q * 4) = (f32x4){bv[q * 4] * inv, bv[q * 4 + 1] * inv, bv[q * 4 + 2] * inv, bv[q * 4 + 3] * inv};
            *(u32x4*)(PIDX + o + q * 4) = (u32x4){idx[q * 4], idx[q * 4 + 1], idx[q * 4 + 2], idx[q * 4 + 3]}; }
    }
}
__device__ __forceinline__ bool ctx_sel_hidden(const Ctx& F) { return F.G == 256; }
__device__ __forceinline__ void peer_select_phase(const Ctx& F, int layer, int m_rows) {
    const int nunits = ((ctx_sel_hidden(F) ? TL : m_rows) / 64) * 8;
#pragma unroll 1
    for (int u = F.vcu * 8 + F.wid; u < nunits; u += F.G * 8) peer_select_unit(F, layer, u);
}

__device__ __forceinline__ float gelu_tanh(float a) { const float u = 0.7978845608028654f * (a + 0.044715f * a * a * a); const float t = 1.f - 2.f / (1.f + __expf(2.f * u)); return 0.5f * a * (1.f + t); }
struct Row6 { u32x2 r[3]; };
__device__ __forceinline__ void ld_row6(Row6& R, const unsigned char* tab, int e, int lane) {
    const u32x2* rp = (const u32x2*)(tab + (size_t)e * EROW + (unsigned)lane * 24u);
    R.r[0] = rp[0]; R.r[1] = rp[1]; R.r[2] = rp[2];
}
__device__ __forceinline__ v32f dq_row6(const Row6& R, float dep) { unsigned r0 = R.r[0].x; asm volatile("" : "+v"(r0) : "v"(dep));
    const v6u w = {r0, R.r[0].y, R.r[1].x, R.r[1].y, R.r[2].x, R.r[2].y}; return __builtin_amdgcn_cvt_scalef32_pk32_f32_fp6(w, 1.0f); }
__device__ __forceinline__ float dot_row6(const Row6& R, const float (&h)[32], float& chain) {
    const v32f f = dq_row6(R, chain);
    float s0 = 0.f, s1 = 0.f, s2 = 0.f, s3 = 0.f;
#pragma unroll
    for (int i = 0; i < 8; ++i) { s0 = fmaf(f[i * 4 + 0], h[i * 4 + 0], s0); s1 = fmaf(f[i * 4 + 1], h[i * 4 + 1], s1); s2 = fmaf(f[i * 4 + 2], h[i * 4 + 2], s2); s3 = fmaf(f[i * 4 + 3], h[i * 4 + 3], s3); }
    const float s = (s0 + s1) + (s2 + s3);
    chain = s;
    return s;
}
__device__ __forceinline__ void fma_row6(float (&out)[32], const Row6& R, float w) {
    const v32f f = dq_row6(R, out[0]);
#pragma unroll
    for (int i = 0; i < 32; ++i) out[i] = fmaf(w, f[i], out[i]);
}
__device__ __forceinline__ float reduce4(float s0, float s1, float s2, float s3, int lane) {
    const bool hi = (lane & 32) != 0, b4 = (lane & 16) != 0;
    const float r0 = xor32_partner(hi ? s0 : s2, lane), r1 = xor32_partner(hi ? s1 : s3, lane);
    const float a0 = (hi ? s2 : s0) + r0, a1 = (hi ? s3 : s1) + r1;
    const float r = swz_xor<16>(b4 ? a0 : a1);
    float b = (b4 ? a1 : a0) + r;
    b += swz_xor<8>(b); b += swz_xor<4>(b); b += swz_xor<2>(b); b += swz_xor<1>(b);
    return b;
}
__device__ __forceinline__ float rl_f(float v, int l) { return __uint_as_float(__builtin_amdgcn_readlane(__float_as_uint(v), l)); }
__device__ __forceinline__ void wr_lane(float& dst, float val_uniform, int lane_uniform, int lane) { asm volatile("" : "+s"(lane_uniform)); dst = (lane == lane_uniform) ? val_uniform : dst; }
__device__ __forceinline__ void peer_expert_tokens(const Ctx& F, CParams& P, int layer, int m_rows_all, bool last, bool dry, bool hide, unsigned* selflag, int k_lo, int k_hi) {
    const unsigned char* EU = F.ws + WS_EU + (size_t)layer * NEXP * EROW; const unsigned char* EV = F.ws + WS_EV + (size_t)layer * NEXP * EROW;
    const float* SU = (const float*)(F.ws + WS_SU) + (size_t)layer * NEXP; const float* SV = (const float*)(F.ws + WS_SV) + (size_t)layer * NEXP;
    const bf16_t* H = (const bf16_t*)(F.ws + WS_H); float* X = (float*)(F.ws + WS_X);
    const int* PIDX = (const int*)(F.ws + WS_PIDX); const float* PG = (const float*)(F.ws + WS_PG);
    const float* mod = (const float*)(F.ws + WS_MOD) + (size_t)layer * 3 * 12288;
    const int lane = fresh_lane();
    const int tstride = F.G * 8, t0 = F.vcu * 8 + F.wid + k_lo * tstride;
    const int m_hi = F.vcu * 8 + F.wid + k_hi * tstride, m_rows = m_hi < m_rows_all ? m_hi : m_rows_all;
    if (t0 >= m_rows) return;
    int id0 = PIDX[(size_t)t0 * 128 + lane], id1 = PIDX[(size_t)t0 * 128 + 64 + lane];
    u32x2 hp4[8]; float gk0, gk1;
    { const bf16_t* hp = H + (size_t)t0 * DM + (unsigned)lane * 4u;
#pragma unroll
      for (int j = 0; j < 8; ++j) hp4[j] = *(const u32x2*)(hp + j * 256); }
    gk0 = PG[(size_t)t0 * 128 + lane]; gk1 = PG[(size_t)t0 * 128 + 64 + lane];
    Row6 A[4], B[4];
#pragma unroll
    for (int q = 0; q < 4; ++q) ld_row6(A[q], EU, __builtin_amdgcn_readlane(id0, q), lane);
    for (int t = t0; t < m_rows; t += tstride) {
        const int tn = t + tstride; const int tq = tn < m_rows ? tn : t;
        float hf[32];
#pragma unroll
        for (int j = 0; j < 8; ++j) { hf[j * 4 + 0] = bf_lo(hp4[j].x); hf[j * 4 + 1] = bf_hi(hp4[j].x); hf[j * 4 + 2] = bf_lo(hp4[j].y); hf[j * 4 + 3] = bf_hi(hp4[j].y); }
        const float cgk0 = gk0, cgk1 = gk1;
        const float su0 = SU[id0], sv0 = SV[id0], su1 = SU[id1], sv1 = SV[id1];
        int nid0, nid1; float ngk0, ngk1;
        if (hide && tq >= TL) {
            { unsigned sp = 0u; while (xb_ld(selflag) < (unsigned)((TT - TL) / 64 * 8)) { __builtin_amdgcn_s_sleep(1); if (++sp > XB_SPIN_CAP) break; } }
            __builtin_amdgcn_fence(__ATOMIC_ACQUIRE, "agent");
            nid0 = __hip_atomic_load(PIDX + (size_t)tq * 128 + lane, __ATOMIC_RELAXED, __HIP_MEMORY_SCOPE_AGENT); nid1 = __hip_atomic_load(PIDX + (size_t)tq * 128 + 64 + lane, __ATOMIC_RELAXED, __HIP_MEMORY_SCOPE_AGENT);
            ngk0 = __int_as_float(__hip_atomic_load((const int*)PG + (size_t)tq * 128 + lane, __ATOMIC_RELAXED, __HIP_MEMORY_SCOPE_AGENT)); ngk1 = __int_as_float(__hip_atomic_load((const int*)PG + (size_t)tq * 128 + 64 + lane, __ATOMIC_RELAXED, __HIP_MEMORY_SCOPE_AGENT));
        } else { nid0 = PIDX[(size_t)tq * 128 + lane]; nid1 = PIDX[(size_t)tq * 128 + 64 + lane]; ngk0 = PG[(size_t)tq * 128 + lane]; ngk1 = PG[(size_t)tq * 128 + 64 + lane]; }
        { const bf16_t* hp = H + (size_t)tq * DM + (unsigned)lane * 4u;
#pragma unroll
          for (int j = 0; j < 8; ++j) hp4[j] = *(const u32x2*)(hp + j * 256); }
        gk0 = ngk0; gk1 = ngk1;
        float wv0 = 0.f, wv1 = 0.f;
        float out[32];
#pragma unroll
        for (int i = 0; i < 32; ++i) out[i] = 0.f;
#pragma unroll
        for (int seg = 0; seg < 4; ++seg) {
            const int idc = (seg & 1) ? id1 : id0;
            const int idn = (seg == 0) ? id1 : (seg == 1 ? id0 : (seg == 2 ? id1 : nid0));
            const unsigned char* tabc = seg < 2 ? EU : EV; const unsigned char* tabn = (seg == 0 || seg == 3) ? EU : EV;
            const float wr = (seg & 1) ? wv1 : wv0;
            float acc = 0.f, chain = 0.f;
#pragma unroll 1
            for (int k = 0; k < 64; k += 8) {
#pragma unroll
                for (int q = 0; q < 4; ++q) ld_row6(B[q], tabc, __builtin_amdgcn_readlane(idc, k + 4 + q), lane);
                if (seg < 2) { const float d0 = dot_row6(A[0], hf, chain), d1 = dot_row6(A[1], hf, chain), d2 = dot_row6(A[2], hf, chain), d3 = dot_row6(A[3], hf, chain); const float b = reduce4(d0, d1, d2, d3, lane);
#pragma unroll
                    for (int q = 0; q < 4; ++q) wr_lane(acc, rl_f(b, 16 * q), k + q, lane); }
                else {
#pragma unroll
                    for (int q = 0; q < 4; ++q) fma_row6(out, A[q], rl_f(wr, k + q)); }
                { const bool nx = k + 8 >= 64;
#pragma unroll
                  for (int q = 0; q < 4; ++q) { const int ec = __builtin_amdgcn_readlane(idc, (k + 8 + q) & 63), en = __builtin_amdgcn_readlane(idn, q);
                      ld_row6(A[q], nx ? tabn : tabc, nx ? en : ec, lane); } }
                if (seg < 2) { const float d0 = dot_row6(B[0], hf, chain), d1 = dot_row6(B[1], hf, chain), d2 = dot_row6(B[2], hf, chain), d3 = dot_row6(B[3], hf, chain); const float b = reduce4(d0, d1, d2, d3, lane);
#pragma unroll
                    for (int q = 0; q < 4; ++q) wr_lane(acc, rl_f(b, 16 * q), k + 4 + q, lane); }
                else {
#pragma unroll
                    for (int q = 0; q < 4; ++q) fma_row6(out, B[q], rl_f(wr, k + 4 + q)); }
            }
            if (seg == 0) wv0 = cgk0 * gelu_tanh(acc * su0) * sv0;
            if (seg == 1) wv1 = cgk1 * gelu_tanh(acc * su1) * sv1;
        }
        id0 = nid0; id1 = nid1;
        const int vs = vsel_of_row(t);
        const float* gate = mod + (size_t)vs * 12288 + 5 * DM;
        float* xr = X + (size_t)t * DM; float* dst = dry ? (float*)(F.ws + WS_OF) + (size_t)t * DM : (last ? P.out + (size_t)t * DM : xr);
        float ssq = 0.f;
        const unsigned lo4 = (unsigned)lane * 4u;
        { f32x4 xo[8], gg[8];
#pragma unroll
          for (int q = 0; q < 8; ++q) { const unsigned c = lo4 + q * 256; xo[q] = *(const f32x4*)(xr + c); gg[q] = *(const f32x4*)(gate + c); }
#pragma unroll
          for (int q = 0; q < 8; ++q) { const unsigned c = lo4 + q * 256;
            f32x4 y; y[0] = xo[q][0] + gg[q][0] * out[q * 4 + 0]; y[1] = xo[q][1] + gg[q][1] * out[q * 4 + 1]; y[2] = xo[q][2] + gg[q][2] * out[q * 4 + 2]; y[3] = xo[q][3] + gg[q][3] * out[q * 4 + 3];
            *(f32x4*)(dst + c) = y;
            out[q * 4 + 0] = y[0]; out[q * 4 + 1] = y[1]; out[q * 4 + 2] = y[2]; out[q * 4 + 3] = y[3];
            ssq += y[0] * y[0] + y[1] * y[1] + y[2] * y[2] + y[3] * y[3]; } }
        if (!last && !dry) {
            const float rstd = rsqrtf(wave_sum(ssq) * (1.f / DM) + EPS);
            const float* gn = P.g_norm1 + (size_t)(layer + 1) * DM;
            const float* shf = mod + (size_t)3 * 12288 + (size_t)vs * 12288; const float* scl = shf + DM;
            bf16_t* hrow = (bf16_t*)(F.ws + WS_H) + (size_t)t * DM;
#pragma unroll
            for (int jh = 0; jh < 2; ++jh) { f32x4 g8[4], sc8[4], sh8[4];
#pragma unroll
                for (int i = 0; i < 4; ++i) { const unsigned c = lo4 + (jh * 4 + i) * 256; g8[i] = *(const f32x4*)(gn + c); sc8[i] = *(const f32x4*)(scl + c); sh8[i] = *(const f32x4*)(shf + c); }
#pragma unroll
                for (int i = 0; i < 4; ++i) { const int qg = jh * 4 + i; const f32x4 g = g8[i], sc = sc8[i], sh = sh8[i];
                    float y[4];
#pragma unroll
                    for (int e2 = 0; e2 < 4; ++e2) y[e2] = (out[qg * 4 + e2] * rstd * g[e2]) * (1.f + sc[e2]) + sh[e2];
                    u32x2 w; w.x = cvt_pk_bf16(y[0], y[1]); w.y = cvt_pk_bf16(y[2], y[3]);
                    *(u32x2*)(hrow + lo4 + qg * 256) = w; } }
        }
    }
}

__device__ __forceinline__ void ctl_wait(unsigned* c, unsigned want) { unsigned sp = 0u; while (xb_ld(c) < want) { __builtin_amdgcn_s_sleep(1); if (++sp > XB_SPIN_CAP) break; } }
__device__ __forceinline__ void peer_expert_phase(const Ctx& F, CParams& P, int layer, int m_rows, bool last, bool dry, LAS unsigned char* ldsl, const bf16_t* Wout) {
    const bool hide = ctx_sel_hidden(F) && m_rows > TL && !dry;
    unsigned* ctl = (unsigned*)(F.ws + WS_CTL) + 8192 + layer * 512;
    unsigned* selflag = ctl;
    int role = 0, ri = 0;
    if (hide && F.vcu >= 64) { const int d = F.vcu - 64;
        if (d % 12 == 0) { role = 1; ri = d / 12; } else if (d % 12 == 6) { role = 2; ri = d / 12; } else if (d % 3 == 1 && F.wid == 0) { role = 3; ri = d / 3; } }
    const int ksplit = role == 1 ? 0 : (role == 2 ? 1 : (role == 3 ? 2 : 9));
#pragma unroll 1
    for (int st = 0; st < 2; ++st) {
        const int kb = st == 0 ? 0 : ksplit, ke = st == 0 ? ksplit : 9;
        if (ke > kb) peer_expert_tokens(F, P, layer, m_rows, last, dry, hide, selflag, kb, ke);
        if (st != 0 || role == 0) continue;
        const int pmi = ri >> 3, pn = ri & 7, pm = TL / 256 + pmi;
        if (role == 1) {
            { pg8::Gemm g{(const bf16_t*)(F.ws + WS_AO), Wout, TT, DM, DM, DM}; pg8::OneUnit S{pm, pn};
              pg8::EpiResid E{(float*)(F.ws + WS_X), (const float*)(F.ws + WS_MOD) + (size_t)layer * 3 * 12288, 2, layer == 0 ? P.x : (const float*)(F.ws + WS_X), layer == 0 ? P.ctx : (const float*)(F.ws + WS_X) + (size_t)TL * DM};
              pg8::gemm_phase<pg8::EpiResid, pg8::OneUnit>(ldsl, g, S, E, F.wid); }
            asm volatile("s_waitcnt vmcnt(0)" ::: "memory"); __syncthreads();
            if (F.wid == 0 && fresh_lane() == 0) { __builtin_amdgcn_fence(__ATOMIC_RELEASE, "agent"); asm volatile("s_waitcnt vmcnt(0)" ::: "memory"); (void)xb_add(ctl + 64 + 64 * pmi, 1u);
                           ctl_wait(ctl + 64 + 64 * pmi, 8u); __builtin_amdgcn_fence(__ATOMIC_ACQUIRE, "agent"); }
            __syncthreads();
            { const int r0 = pm * 256 + pn * 32 + F.wid * 4; norm_rows(F, P, layer, 1, r0, r0 + 4, 1); }
            asm volatile("s_waitcnt vmcnt(0)" ::: "memory"); __syncthreads();
            if (F.wid == 0 && fresh_lane() == 0) { __builtin_amdgcn_fence(__ATOMIC_RELEASE, "agent"); asm volatile("s_waitcnt vmcnt(0)" ::: "memory"); (void)xb_add(ctl + 192 + 64 * pmi, 1u); }
        } else if (role == 2) {
            __syncthreads();
            if (F.wid == 0 && fresh_lane() == 0) { ctl_wait(ctl + 192 + 64 * pmi, 8u); __builtin_amdgcn_fence(__ATOMIC_ACQUIRE, "agent"); }
            __syncthreads();
            { pg8::Gemm g{(const bf16_t*)(F.ws + WS_H), (const bf16_t*)(F.ws + WS_WPQ) + (size_t)layer * DM * DM, TT, DM, DM, DM}; pg8::OneUnit S{pm, pn};
              pg8::EpiBf16 E{(bf16_t*)(F.ws + WS_PQ), DM};
              pg8::gemm_phase<pg8::EpiBf16, pg8::OneUnit>(ldsl, g, S, E, F.wid); }
            asm volatile("s_waitcnt vmcnt(0)" ::: "memory"); __syncthreads();
            if (F.wid == 0 && fresh_lane() == 0) { __builtin_amdgcn_fence(__ATOMIC_RELEASE, "agent"); asm volatile("s_waitcnt vmcnt(0)" ::: "memory"); (void)xb_add(ctl + 320, 1u); }
        } else {
            ctl_wait(ctl + 320, 16u); __builtin_amdgcn_fence(__ATOMIC_ACQUIRE, "agent");
            peer_select_unit(F, layer, (TL / 64) * 8 + ri);
            __builtin_amdgcn_fence(__ATOMIC_RELEASE, "agent");
            asm volatile("s_waitcnt vmcnt(0)" ::: "memory");
            if (fresh_lane() == 0) (void)xb_add(selflag, 1u);
        }
    }
}

__device__ __forceinline__ void qkv_odd_phase(const Ctx& F, CParams& P, int e, int layer, LAS unsigned char* ldsl) {
    if (!ctx_sel_hidden(F)) { qkv_odd_rows(F, P, e, F.vcu * 8 + F.wid, TT, F.G * 8); return; }
    const int vx = F.vcu & 31, xq = F.vcu >> 5;
    if (vx >= 29) {
        const int i = xq * 3 + vx - 29, pmi = i / 12, pn = i % 12;
        unsigned* cnt = (unsigned*)(F.ws + WS_CTL) + 8192 + layer * 512 + 384 + 64 * pmi;
        { pg8::Gemm g{(const bf16_t*)(F.ws + WS_H), (const bf16_t*)(F.ws + WS_WINC) + (size_t)e * C_IN * DM, TT, C_IN, DM, DM}; pg8::OneUnit S{TL / 256 + pmi, pn};
          pg8::EpiBf16V E{(bf16_t*)(F.ws + WS_P1), C_IN, (bf16_t*)(F.ws + WS_V1), 10, 512};
          pg8::gemm_phase<pg8::EpiBf16V, pg8::OneUnit>(ldsl, g, S, E, F.wid); }
        asm volatile("s_waitcnt vmcnt(0)" ::: "memory"); __syncthreads();
        if (F.wid == 0 && fresh_lane() == 0) { __builtin_amdgcn_fence(__ATOMIC_RELEASE, "agent"); asm volatile("s_waitcnt vmcnt(0)" ::: "memory"); (void)xb_add(cnt, 1u);
                                               ctl_wait(cnt, 12u); __builtin_amdgcn_fence(__ATOMIC_ACQUIRE, "agent"); }
        __syncthreads();
        qkv_odd_rows(F, P, e, TL + pmi * 256 + pn * 8 + F.wid, TL + pmi * 256 + 256, 96);
    } else qkv_odd_rows(F, P, e, (F.vcu - 3 * xq) * 8 + F.wid, TL, 232 * 8);
}

constexpr int N_PHASES = 1 + 2 * 11 + 2 * 9 - 3;
__global__ void __launch_bounds__(512, 2) mk_fwd(Params Pval) {
    extern __shared__ __attribute__((aligned(16))) unsigned char lds_raw[];
    LAS unsigned char* ldsl = (LAS unsigned char*)lds_raw;
    volatile LAS unsigned* misc = (volatile LAS unsigned*)(ldsl + LDS_MISC);
    if (threadIdx.x < 16) misc[threadIdx.x] = 0u;
    __syncthreads();
    XcdBarrier bar = xcd_barrier_post((unsigned*)(Pval.ws + WS_CTL) + 1024, misc);
    const int wid0 = __builtin_amdgcn_readfirstlane((int)threadIdx.x >> 6);
    const int lo = Pval.ph_lo, hi = Pval.ph_hi; int ph = 0;
#define MKCTX() Ctx F; { const int lane_ = fresh_lane(); int wid_ = wid0; asm volatile("" : "+s"(wid_)); const int tid_ = wid_ * 64 + lane_; F.tid = tid_; F.lane = lane_; F.wid = wid_; \
        int G_ = gridDim.x, bx_ = blockIdx.x; asm volatile("" : "+s"(G_), "+s"(bx_)); F.G = G_; F.vcu = (G_ % 8 == 0) ? (bx_ % 8) * (G_ / 8) + bx_ / 8 : bx_; F.bx = bx_; } \
        unsigned long long kp_ = (unsigned long long)__builtin_amdgcn_kernarg_segment_ptr(); asm volatile("" : "+s"(kp_)); CParams& P = *(CParams*)kp_; \
        F.ws = P.ws; F.lds = (char*)lds_raw; unsigned char* ws = F.ws; (void)ws; \
        bf16_t* Hb = (bf16_t*)(ws + WS_H); bf16_t* P1 = (bf16_t*)(ws + WS_P1); float* X = (float*)(ws + WS_X); const float* mod = (const float*)(ws + WS_MOD); (void)Hb; (void)P1; (void)X; (void)mod;
#define PHASE(cls, ...) do { if (ph >= lo && ph < hi) { if constexpr ((PH_MASK >> (cls)) & 1u) { \
        if constexpr ((PH_DOUBLE >> (cls)) & 1u) { const bool dry = true; (void)dry; MKCTX(); __VA_ARGS__; __syncthreads(); } \
        { const bool dry = false; (void)dry; MKCTX(); __VA_ARGS__; } } if (ph + 1 < hi) { int w0_ = wid0; asm volatile("" : "+s"(w0_)); xcd_barrier(bar, w0_ == 0 && fresh_lane() == 0); } } ++ph; } while (0)

    PHASE(0, prologue_phase(F, P));
#pragma unroll 1
    for (int layer = 0; layer < DEPTH; ++layer) {
        const int e = layer >> 1; const bool even = (layer & 1) == 0, lastl = layer == DEPTH - 1;
        const int m_post = lastl ? TL : TT;
        if (layer == 0) PHASE(1, norm_phase(F, P, layer, 0, TT));
        PHASE(2, { const bf16_t* W = even ? (const bf16_t*)(ws + WS_WINAB) + (size_t)e * AB_INP * DM : (const bf16_t*)(ws + WS_WINC) + (size_t)e * C_IN * DM;
                const int N = even ? AB_INP : C_IN;
                const int m2 = (!even && ctx_sel_hidden(F)) ? TL : TT;
                pg8::Gemm g{Hb, W, m2, N, DM, DM}; pg8::StaticOrder S; S.init(m2, N, F.G, F.bx);
                pg8::EpiBf16V E{P1, N, even ? (bf16_t*)(ws + WS_V2) : (bf16_t*)(ws + WS_V1), even ? 14 : 10, even ? 1024 : 512};
                pg8::gemm_phase<pg8::EpiBf16V, pg8::StaticOrder>(ldsl, g, S, E, F.wid); });
        if (even) {
            PHASE(3, { { pg8::Gemm g{P1, (const bf16_t*)(ws + WS_WUQ) + (size_t)e * 1536 * 768, TT, 1536, 768, AB_INP}; pg8::StaticOrder S; S.init(TT, 1536, F.G, F.bx);
                      pg8::EpiBf16 E{(bf16_t*)(ws + WS_QA), 1536};
                      pg8::gemm_phase<pg8::EpiBf16, pg8::StaticOrder>(ldsl, g, S, E, F.wid); }
                    { pg8::Gemm g{P1 + 768, (const bf16_t*)(ws + WS_WUKV) + (size_t)e * 2048 * 512, TT, 2048, 512, AB_INP}; pg8::StaticOrder S; S.init(TT, 2048, F.G, F.G - 1 - F.bx);
                      pg8::EpiBf16 E{(bf16_t*)(ws + WS_KV), 2048};
                      pg8::gemm_phase<pg8::EpiBf16, pg8::StaticOrder>(ldsl, g, S, E, F.wid); } });
            PHASE(4, qkv_even_phase(F, P, e));
            PHASE(5, { if constexpr (ATT_DBL & 1) attn_phase<192, MLA_SD, 2048, 8, 8, 8>(F, (const bf16_t*)(ws + WS_Q1), (const bf16_t*)(ws + WS_K1), (const bf16_t*)(ws + WS_V1), (bf16_t*)(ws + WS_AO), 0, !lastl, ((const float*)(ws + WS_LAM))[4 + layer * 2]);
                    if constexpr (ATT_DBL & 2) attn_phase<64, 2, 2048, 16, 16, 8>(F, (const bf16_t*)(ws + WS_Q2), (const bf16_t*)(ws + WS_K2), (const bf16_t*)(ws + WS_V2), (bf16_t*)(ws + WS_OF), 0, !lastl, ((const float*)(ws + WS_LAM))[4 + layer * 2 + 1]);
                    if constexpr (ATT_SEL & 1) attn_phase<192, MLA_SD, 2048, 8, 8, 8>(F, (const bf16_t*)(ws + WS_Q1), (const bf16_t*)(ws + WS_K1), (const bf16_t*)(ws + WS_V1), (bf16_t*)(ws + WS_AO), 0, !lastl, ((const float*)(ws + WS_LAM))[4 + layer * 2]);
                    if constexpr (ATT_SEL & 2) attn_phase<64, 2, 2048, 16, 16, 8>(F, (const bf16_t*)(ws + WS_Q2), (const bf16_t*)(ws + WS_K2), (const bf16_t*)(ws + WS_V2), (bf16_t*)(ws + WS_OF), 0, !lastl, ((const float*)(ws + WS_LAM))[4 + layer * 2 + 1]); });
            PHASE(6, merge_even_phase(F, P, e, layer, m_post));
        } else {
            PHASE(7, qkv_odd_phase(F, P, e, layer, ldsl));
            PHASE(8, attn_phase<128, GQA_SD, 2048, 16, 4, 4>(F, (const bf16_t*)(ws + WS_Q1), (const bf16_t*)(ws + WS_K1), (const bf16_t*)(ws + WS_V1), (bf16_t*)(ws + WS_AO), 0, !lastl, ((const float*)(ws + WS_LAM))[4 + layer * 2]));
        }
        PHASE(10, { const bf16_t* W = even ? (const bf16_t*)(ws + WS_WOUTAB) + (size_t)e * DM * DM : (const bf16_t*)(ws + WS_WOUTC) + (size_t)e * DM * DM;
                const int m10 = ctx_sel_hidden(F) ? TL : m_post; pg8::Gemm g{(const bf16_t*)(ws + WS_AO), W, m10, DM, DM, DM}; pg8::StaticOrder S; S.init(m10, DM, F.G, F.bx);
                pg8::EpiResid E{X, mod + (size_t)layer * 3 * 12288, 2, layer == 0 ? P.x : (const float*)X, layer == 0 ? P.ctx : (const float*)X + (size_t)TL * DM};
                pg8::gemm_phase<pg8::EpiResid, pg8::StaticOrder>(ldsl, g, S, E, F.wid); });
        PHASE(1, norm_phase(F, P, layer, 1, ctx_sel_hidden(F) ? TL : m_post));
        PHASE(11, { const int m11 = ctx_sel_hidden(F) ? TL : m_post; pg8::Gemm g{Hb, (const bf16_t*)(ws + WS_WPQ) + (size_t)layer * DM * DM, m11, DM, DM, DM}; pg8::StaticOrder S; S.init(m11, DM, F.G, F.bx);
                pg8::EpiBf16 E{(bf16_t*)(ws + WS_PQ), DM};
                pg8::gemm_phase<pg8::EpiBf16, pg8::StaticOrder>(ldsl, g, S, E, F.wid); });
        PHASE(12, peer_select_phase(F, layer, m_post));
        PHASE(13, { const bf16_t* W = even ? (const bf16_t*)(ws + WS_WOUTAB) + (size_t)e * DM * DM : (const bf16_t*)(ws + WS_WOUTC) + (size_t)e * DM * DM;
                peer_expert_phase(F, P, layer, m_post, lastl, dry, ldsl, W); });
    }
#undef PHASE
}

extern "C" void kernel_launch(void* const* d_in, const int* in_sizes, int n_in, void* d_out, int out_size, void* d_ws, size_t ws_size, hipStream_t stream) {
    static int grid = 0;
    if (grid == 0) {
        if (n_in != 28 || ws_size < WS_END) { fprintf(stderr, "kernel_launch: expected 28 inputs and >= %zu bytes of workspace, got %d / %zu\n", (size_t)WS_END, n_in, ws_size); grid = -1; return; }
        int dev = 0, cus = 0, per_cu = 0;
        if (hipGetDevice(&dev) != hipSuccess || hipDeviceGetAttribute(&cus, hipDeviceAttributeMultiprocessorCount, dev) != hipSuccess) { grid = -1; return; }
        if (hipFuncSetAttribute((const void*)mk_fwd, hipFuncAttributeMaxDynamicSharedMemorySize, LDS_BYTES) != hipSuccess) { fprintf(stderr, "kernel_launch: hipFuncSetAttribute failed\n"); grid = -1; return; }
        if (hipOccupancyMaxActiveBlocksPerMultiprocessor(&per_cu, (const void*)mk_fwd, 512, LDS_BYTES) != hipSuccess || per_cu < 1) fprintf(stderr, "kernel_launch: occupancy query says %d\n", per_cu);
        (void)hipGetLastError();
        grid = cus;
    }
    if (grid < 0) return;
    (void)hipMemsetAsync((char*)d_ws + WS_CTL, 0, CTL_BYTES, stream);
    Params p{};
    const float** pf = (const float**)&p;
    for (int i = 0; i < 28; ++i) pf[i] = (const float*)d_in[i];
    p.out = (float*)d_out; p.ws = (unsigned char*)d_ws;
#if MK_PER_PHASE_LAUNCH
    for (int i = 0; i < N_PHASES; ++i) { p.ph_lo = i; p.ph_hi = i + 1; hipLaunchKernelGGL(mk_fwd, dim3(grid), dim3(512), LDS_BYTES, stream, p); }
#else
    p.ph_lo = 0; p.ph_hi = N_PHASES;
    hipLaunchKernelGGL(mk_fwd, dim3(grid), dim3(512), LDS_BYTES, stream, p);
#endif
    const hipError_t le = hipPeekAtLastError();
    if (le != hipSuccess) fprintf(stderr, "kernel_launch: launch failed: %s\n", hipGetErrorName(le));
}
```

```cpp
#include <hip/hip_runtime.h>
#include <stdint.h>
#include <stdio.h>

#ifndef MK_PER_PHASE_LAUNCH
#define MK_PER_PHASE_LAUNCH 0
#endif

#ifndef MLA_QL
#define MLA_QL 0
#endif
#ifndef GQA_QL
#define GQA_QL 0
#endif
#ifndef QKT_GRP
#define QKT_GRP 12
#endif
#ifndef EB
#define EB 4
#endif
#ifndef PV_PIPE
#define PV_PIPE 0
#endif
#ifndef ATT_DBL
#define ATT_DBL 0
#endif
#ifndef ATT_PRIO
#define ATT_PRIO 1
#endif
#ifndef MLA_SD
#define MLA_SD 1
#endif
#ifndef GQA_SD
#define GQA_SD 2
#endif
#ifndef ATT_SEL
#define ATT_SEL 3
#endif
#ifndef PH_DOUBLE
#define PH_DOUBLE 0u
#endif
#ifndef PH_MASK
#define PH_MASK 0xFFFFFFFFu
#endif
#define LAS __attribute__((address_space(3)))
typedef unsigned short bf16_t;
typedef short bf16x8 __attribute__((ext_vector_type(8)));
typedef short s16x4 __attribute__((ext_vector_type(4)));
typedef float f32x4 __attribute__((ext_vector_type(4)));
typedef float f32x2 __attribute__((ext_vector_type(2)));
typedef float f32x16 __attribute__((ext_vector_type(16)));
typedef unsigned u32x4 __attribute__((ext_vector_type(4)));
typedef unsigned u32x2 __attribute__((ext_vector_type(2)));
typedef __bf16 bf16x2_t __attribute__((ext_vector_type(2)));

constexpr int DM = 2048, NB = 2, SEQ = 8192, DEPTH = 4, CTXL = 256;
constexpr int TL = NB * SEQ;
constexpr int TZ = NB * CTXL;
constexpr int TT = TL + TZ;
constexpr int KPB = SEQ + CTXL;
constexpr int AB_IN = 4416, AB_INP = 4608;
constexpr int C_IN = 3072;
constexpr int NEXP = 16384;
constexpr float EPS = 1e-6f;
constexpr float LOG2E = 1.4426950408889634f;

constexpr size_t al256(size_t x) { return (x + 255) / 256 * 256; }
constexpr size_t WS_CTL = 0, CTL_BYTES = 1u << 20;
constexpr size_t WS_MOD = WS_CTL + CTL_BYTES;
constexpr size_t WS_TAB16 = WS_MOD + al256((size_t)4 * 3 * 12288 * 4);
constexpr size_t WS_TAB32 = WS_TAB16 + al256((size_t)128 * 16 * 2 * 4);
constexpr size_t WS_LAM = WS_TAB32 + al256((size_t)128 * 32 * 2 * 4);
constexpr size_t WS_WINAB = WS_LAM + 256;
constexpr size_t WS_WUQ = WS_WINAB + (size_t)2 * AB_INP * DM * 2;
constexpr size_t WS_WUKV = WS_WUQ + (size_t)2 * 1536 * 768 * 2;
constexpr size_t WS_WOUTAB = WS_WUKV + (size_t)2 * 2048 * 512 * 2;
constexpr size_t WS_WINC = WS_WOUTAB + (size_t)2 * DM * DM * 2;
constexpr size_t WS_WOUTC = WS_WINC + (size_t)2 * C_IN * DM * 2;
constexpr size_t WS_WPQ = WS_WOUTC + (size_t)2 * DM * DM * 2;
constexpr size_t WS_SUBK = WS_WPQ + (size_t)4 * DM * DM * 2;
constexpr size_t WS_EU = WS_SUBK + (size_t)4 * 8 * 2 * 128 * 128 * 2;
constexpr int EROW = DM * 6 / 8;
constexpr size_t WS_EV = WS_EU + (size_t)4 * NEXP * DM;
constexpr size_t WS_SU = WS_EV + (size_t)4 * NEXP * DM;
constexpr size_t WS_SV = WS_SU + (size_t)4 * NEXP * 4;
constexpr size_t WS_X = WS_SV + (size_t)4 * NEXP * 4;
constexpr size_t WS_H = WS_X + (size_t)TT * DM * 4;
constexpr size_t WS_P1 = WS_H + (size_t)TT * DM * 2;
constexpr size_t WS_QA = WS_P1 + (size_t)TT * AB_INP * 2;
constexpr size_t WS_KV = WS_QA + (size_t)TT * 1536 * 2;
constexpr size_t WS_Q1 = WS_KV + (size_t)TT * 2048 * 2;
constexpr size_t WS_K1 = WS_Q1 + (size_t)TT * 2048 * 2;
constexpr size_t WS_V1 = WS_K1 + (size_t)TT * 1536 * 2;
constexpr size_t WS_Q2 = WS_V1 + (size_t)TT * 1024 * 2;
constexpr size_t WS_K2 = WS_Q2 + (size_t)TT * 1024 * 2;
constexpr size_t WS_V2 = WS_K2 + (size_t)TT * 1024 * 2;
constexpr size_t WS_OF = WS_V2 + (size_t)TT * 1024 * 2;
constexpr size_t WS_AO = WS_OF + (size_t)TT * 3072 * 4;
constexpr size_t WS_PQ = WS_AO + (size_t)TT * DM * 2;
constexpr size_t WS_PIDX = WS_PQ + (size_t)TT * DM * 2;
constexpr size_t WS_PG = WS_PIDX + (size_t)TT * 128 * 4;
constexpr size_t WS_END = WS_PG + (size_t)TT * 128 * 4;

constexpr int LDS_MAIN = 157696;
constexpr int LDS_MISC = LDS_MAIN;
constexpr int LDS_BYTES = LDS_MAIN + 4096;

__device__ __forceinline__ unsigned cvt_pk_bf16(float lo, float hi) { unsigned r; asm("v_cvt_pk_bf16_f32 %0, %1, %2" : "=v"(r) : "v"(lo), "v"(hi)); return r; }
__device__ __forceinline__ float bf_lo(unsigned w) { return __uint_as_float(w << 16); }
__device__ __forceinline__ float bf_hi(unsigned w) { return __uint_as_float(w & 0xffff0000u); }
template <int M> __device__ __forceinline__ float swz_xor(float v) { return __int_as_float(__builtin_amdgcn_ds_swizzle(__float_as_int(v), (M << 10) | 0x1f)); }
__device__ __forceinline__ float xor32_partner(float v, int lane) {
    const auto rr = __builtin_amdgcn_permlane32_swap(__float_as_uint(v), __float_as_uint(v), false, false);
    return __uint_as_float(lane < 32 ? rr[1] : rr[0]);
}
__device__ __forceinline__ float hw_sum(float v) {
    v += swz_xor<16>(v); v += swz_xor<8>(v); v += swz_xor<4>(v); v += swz_xor<2>(v); v += swz_xor<1>(v);
    return v;
}
__device__ __forceinline__ float wave_sum(float v) {
    v = hw_sum(v);
    const auto rr = __builtin_amdgcn_permlane32_swap(__float_as_uint(v), __float_as_uint(v), false, false);
    return __uint_as_float(rr[0]) + __uint_as_float(rr[1]);
}
__device__ __forceinline__ float wave_max(float v) {
    v = fmaxf(v, swz_xor<16>(v)); v = fmaxf(v, swz_xor<8>(v)); v = fmaxf(v, swz_xor<4>(v)); v = fmaxf(v, swz_xor<2>(v)); v = fmaxf(v, swz_xor<1>(v));
    const auto rr = __builtin_amdgcn_permlane32_swap(__float_as_uint(v), __float_as_uint(v), false, false);
    return fmaxf(__uint_as_float(rr[0]), __uint_as_float(rr[1]));
}
__device__ __forceinline__ int mbcnt64(unsigned long long m) { return (int)__builtin_amdgcn_mbcnt_hi((unsigned)(m >> 32), __builtin_amdgcn_mbcnt_lo((unsigned)m, 0u)); }
__device__ __forceinline__ int fresh_lane() { int l; asm volatile("v_mbcnt_lo_u32_b32 %0, -1, 0\n\tv_mbcnt_hi_u32_b32 %0, -1, %0" : "=v"(l)); return l; }
__device__ __forceinline__ int krow_of(int t) { return t < TL ? (t >> 13) * KPB + (t & (SEQ - 1)) : ((t - TL) >> 8) * KPB + SEQ + ((t - TL) & (CTXL - 1)); }
__device__ __forceinline__ int vsel_of_row(int t) { return t < SEQ ? 0 : (t < TL ? 1 : 2); }

#define XB_TMO      128
#define XB_XCNT(j)  (256  + 64 * (j))
#define XB_XSUB(j)  (1280 + 64 * (j))
#define XB_XGEN(j)  (2304 + 64 * (j))
#define XB_TOP      3328
#define XB_TOPGEN   3392
#define XCD_BAR_WORDS 3456
#define XB_SPIN_CAP (1u << 27)
__device__ __forceinline__ unsigned xb_ld(unsigned* p)              { return __hip_atomic_load(p, __ATOMIC_RELAXED, __HIP_MEMORY_SCOPE_AGENT); }
__device__ __forceinline__ unsigned xb_add(unsigned* p, unsigned v) { return __hip_atomic_fetch_add(p, v, __ATOMIC_RELAXED, __HIP_MEMORY_SCOPE_AGENT); }
__device__ __forceinline__ unsigned xb_xcc_id() { return (unsigned)__builtin_amdgcn_s_getreg((3 << 11) | 20) & 0xFu; }
#define XB_SPIN(cond, bar) do { unsigned _sp = 0; while (cond) { __builtin_amdgcn_s_sleep(1); \
    if ((++_sp & 255u) == 0u) { if (xb_ld(&(bar)[XB_TMO])) break; if (_sp > XB_SPIN_CAP) { atomicAdd(&(bar)[XB_TMO], 1u); break; } } } } while (0)
struct XcdBarrier { unsigned* bar; unsigned x; volatile LAS unsigned* st; };
__device__ __forceinline__ XcdBarrier xcd_barrier_post(unsigned* bar, volatile LAS unsigned* st) {
    XcdBarrier b; b.bar = bar; b.x = xb_xcc_id(); b.st = st;
    if (threadIdx.x == 0) (void)xb_add(&bar[XB_XCNT(b.x)], 1u);
    return b;
}
__device__ __forceinline__ void xcd_barrier_complete(unsigned* bar, unsigned x, unsigned& nloc, unsigned& nx) {
    asm volatile("" : "+s"(x));
    const unsigned G = gridDim.x * gridDim.y * gridDim.z;
    unsigned sum, cnt, mine, sp = 0u;
    for (;;) {
        sum = 0u; cnt = 0u; mine = 0u;
#pragma unroll
        for (unsigned j = 0; j < 16; ++j) { const unsigned c = xb_ld(&bar[XB_XCNT(j)]); sum += c; cnt += (c > 0u) ? 1u : 0u; mine = (j == x) ? c : mine; }
        if (sum == G) break;
        __builtin_amdgcn_s_sleep(1);
        if ((++sp & 255u) == 0u) { if (xb_ld(&bar[XB_TMO])) break; if (sp > XB_SPIN_CAP) { atomicAdd(&bar[XB_TMO], 1u); break; } }
    }
    nloc = mine > 0u ? mine : 1u; nx = cnt > 0u ? cnt : 1u;
}
__device__ __forceinline__ void xcd_barrier(const XcdBarrier& b, const bool thread0  ) {
    asm volatile("s_waitcnt vmcnt(0)" ::: "memory");
    __syncthreads();
    if (thread0) {
        unsigned* bar = b.bar;
        __builtin_amdgcn_s_waitcnt(0);
        unsigned nloc = b.st[0], nx = b.st[1];
        if (nloc == 0u) { xcd_barrier_complete(bar, b.x, nloc, nx); b.st[0] = nloc; b.st[1] = nx; }
        const unsigned old = xb_add(&bar[XB_XSUB(b.x)], 1u);
        const unsigned gen = old / nloc;
        if (old + 1u == (gen + 1u) * nloc) {
            __builtin_amdgcn_fence(__ATOMIC_RELEASE, "agent");
            asm volatile("s_waitcnt vmcnt(0)" ::: "memory");
            const unsigned og = xb_add(&bar[XB_TOP], 1u);
            const unsigned tg = og / nx;
            if (og + 1u == (tg + 1u) * nx) xb_add(&bar[XB_TOPGEN], 1u);
            else XB_SPIN(xb_ld(&bar[XB_TOPGEN]) == tg, bar);
            __builtin_amdgcn_fence(__ATOMIC_ACQUIRE, "agent");
            xb_add(&bar[XB_XGEN(b.x)], 1u);
            asm volatile("s_waitcnt vmcnt(0)" ::: "memory");
        } else {
            XB_SPIN(xb_ld(&bar[XB_XGEN(b.x)]) == gen, bar);
            __builtin_amdgcn_fence(__ATOMIC_ACQUIRE, "agent");
            asm volatile("s_waitcnt vmcnt(0)" ::: "memory");
        }
    }
    __syncthreads();
}

namespace pg8 {
constexpr int BM = 256, BK = 64, HALF = 128, HTB = HALF * BK * 2, STAGE_BYTES = 8 * HTB, NXCD = 8, WGM = 8;
__host__ __device__ __forceinline__ int lds_byte(int r, int c) { const int st = (r >> 4) * 2 + (c >> 5), rr = r & 15, cc = c & 31, ob = rr * 64 + cc * 2; return st * 1024 + (ob ^ (((ob >> 9) & 1) << 5)); }
__host__ __device__ __forceinline__ void stage_rc(int b, int& R, int& C) { const int st = b / 1024, sb = b % 1024, swz = sb ^ (((sb >> 9) & 1) << 5); R = (st >> 1) * 16 + swz / 64; C = (st & 1) * 32 + (swz % 64) / 2; }
__host__ __device__ __forceinline__ int perm32(int rho) { const int n = rho >> 4, i = rho & 15; return 8 * (i >> 2) + 4 * n + (i & 3); }
struct Unit { int pm, pn; };
struct Gemm { const bf16_t* A; const bf16_t* Bt; int M, N, K, lda; };
struct StaticOrder {
    int nM, nN, nwg, G, c;
    __host__ __device__ void init(int M, int N, int G_, int c_) { nM = M / BM; nN = N / BM; nwg = nM * nN; G = G_; c = c_; }
    __host__ __device__ bool next(int i, Unit& u) const {
        const long L = (long)i * G + c; if (L >= nwg) return false;
        int wgid = (int)L; { const int q = nwg / NXCD, r = nwg % NXCD, xcd = wgid % NXCD, off = wgid / NXCD; wgid = (xcd < r ? xcd * (q + 1) : r * (q + 1) + (xcd - r) * q) + off; }
        const int nig = WGM * nN, gid = wgid / nig, fm = gid * WGM, gsz = (nM - fm) < WGM ? (nM - fm) : WGM;
        u.pm = fm + ((wgid % nig) % gsz); u.pn = (wgid % nig) / gsz; return true;
    }
    __device__ __forceinline__ void a_ready(const Unit&) const {}
    __device__ __forceinline__ void done(const Unit&) const {}
};
struct OneUnit {
    int pm, pn;
    __device__ bool next(int i, Unit& u) const { if (i != 0) return false; u.pm = pm; u.pn = pn; return true; }
    __device__ __forceinline__ void a_ready(const Unit&) const {}
    __device__ __forceinline__ void done(const Unit&) const {}
};
struct EpiBf16 {
    static constexpr bool PERM = true;
    bf16_t* O; int ldc;
    __device__ __forceinline__ void operator()(const f32x4 (&acc)[2][2][4][2], const Unit& u, int wr, int wc, int fr, int fq) const {
        const int row0 = u.pm * BM + wr * 64 + fr; const int col0 = u.pn * BM + wc * 32 + 8 * fq;
#pragma unroll
        for (int ai = 0; ai < 2; ++ai)
#pragma unroll
            for (int m = 0; m < 4; ++m) { bf16_t* rowp = O + (size_t)(row0 + ai * HALF + m * 16) * ldc + col0;
#pragma unroll
                for (int bj = 0; bj < 2; ++bj) { const f32x4 v0 = acc[ai][bj][m][0], v1 = acc[ai][bj][m][1];
                    u32x4 w; w.x = cvt_pk_bf16(v0[0], v0[1]); w.y = cvt_pk_bf16(v0[2], v0[3]); w.z = cvt_pk_bf16(v1[0], v1[1]); w.w = cvt_pk_bf16(v1[2], v1[3]);
                    *(u32x4*)(rowp + bj * HALF) = w; } }
    }
};
struct EpiBf16V {
    static constexpr bool PERM = true;
    bf16_t* O; int ldc; bf16_t* V; int vpn0, vld;
    __device__ __forceinline__ void operator()(const f32x4 (&acc)[2][2][4][2], const Unit& u, int wr, int wc, int fr, int fq) const {
        const int row0 = u.pm * BM + wr * 64 + fr; const int col0 = u.pn * BM + wc * 32 + 8 * fq;
        const bool tov = u.pn >= vpn0;
        const long delta = u.pm < 32 ? 0 : (u.pm < 64 ? KPB - SEQ : (u.pm == 64 ? SEQ - TL : KPB + SEQ - TL - CTXL));
        bf16_t* base = tov ? V + delta * vld - (long)vpn0 * BM : O; const int ld = tov ? vld : ldc;
#pragma unroll
        for (int ai = 0; ai < 2; ++ai)
#pragma unroll
            for (int m = 0; m < 4; ++m) { bf16_t* rowp = base + (size_t)(row0 + ai * HALF + m * 16) * ld + col0;
#pragma unroll
                for (int bj = 0; bj < 2; ++bj) { const f32x4 v0 = acc[ai][bj][m][0], v1 = acc[ai][bj][m][1];
                    u32x4 w; w.x = cvt_pk_bf16(v0[0], v0[1]); w.y = cvt_pk_bf16(v0[2], v0[3]); w.z = cvt_pk_bf16(v1[0], v1[1]); w.w = cvt_pk_bf16(v1[2], v1[3]);
                    *(u32x4*)(rowp + bj * HALF) = w; } }
    }
};
struct EpiResid {
    static constexpr bool PERM = false;
    float* X; const float* modl; int chunk;
    const float* Rlat; const float* Rctx;
    __device__ __forceinline__ void operator()(const f32x4 (&acc)[2][2][4][2], const Unit& u, int wr, int wc, int fr, int fq) const {
        const int row0 = u.pm * BM + wr * 64 + fr, col0 = u.pn * BM + wc * 32 + 4 * fq;
        const int vs = u.pm < 32 ? 0 : (u.pm < 64 ? 1 : 2);
        const float* gate = modl + (size_t)vs * 12288 + chunk * 2048 + col0;
        f32x4 gv[2][2];
#pragma unroll
        for (int bj = 0; bj < 2; ++bj)
#pragma unroll
            for (int n = 0; n < 2; ++n) gv[bj][n] = *(const f32x4*)(gate + bj * HALF + n * 16);
#pragma unroll
        for (int ai = 0; ai < 2; ++ai) {
            f32x4 xo[4][2][2];
#pragma unroll
            for (int m = 0; m < 4; ++m) { const int row = row0 + ai * HALF + m * 16;
                const float* srcp = (vs < 2 ? Rlat + (size_t)row * DM : Rctx + (size_t)(row - TL) * DM) + col0;
#pragma unroll
                for (int bj = 0; bj < 2; ++bj)
#pragma unroll
                    for (int n = 0; n < 2; ++n) xo[m][bj][n] = *(const f32x4*)(srcp + bj * HALF + n * 16); }
#pragma unroll
            for (int m = 0; m < 4; ++m) { const int row = row0 + ai * HALF + m * 16; float* rowp = X + (size_t)row * DM + col0;
#pragma unroll
                for (int bj = 0; bj < 2; ++bj)
#pragma unroll
                    for (int n = 0; n < 2; ++n) *(f32x4*)(rowp + bj * HALF + n * 16) = xo[m][bj][n] + gv[bj][n] * acc[ai][bj][m][n]; } }
    }
};

template <class Epi, class Sched>
__device__ __forceinline__ void gemm_phase(LAS unsigned char* lds, const Gemm g, const Sched& S, const Epi& E, int tid_in) {
    const int tid_l = tid_in * 64 + fresh_lane();
    const int tid = tid_l, wid = tid_in  , lane = tid & 63, wr = wid >> 2, wc = wid & 3, fr = lane & 15, fq = lane >> 4;
    const int K = g.K, nt = K / BK, lda = g.lda;
    unsigned voffA[2], voffB[2];
#pragma unroll
    for (int i = 0; i < 2; ++i) { int R, C; stage_rc(tid * 16 + i * 8192, R, C); const int Rb = Epi::PERM ? ((R & ~31) + perm32(R & 31)) : R;
        voffA[i] = (unsigned)(R * lda + C) * 2u; voffB[i] = (unsigned)(Rb * K + C) * 2u; }
    const size_t kstep = (size_t)(BK * 2);
    const size_t hstepA = (size_t)HALF * lda * 2, hstepB = (size_t)HALF * K * 2;
    const size_t tstepA = 2 * hstepA, tstepB = 2 * hstepB;
    const unsigned ldsw = (unsigned)wid * 1024u;
    const int aoff = lds_byte(wr * 64 + fr, fq * 8), boff = lds_byte(wc * 32 + fr, fq * 8);
#define PG8_SA(b, h) (((b) * 2 + (h)) * HTB)
#define PG8_SB(b, h) ((4 + (b) * 2 + (h)) * HTB)
#define PG8_STAGE(bufoff, gbase, voff) do { _Pragma("unroll") for (int _i = 0; _i < 2; ++_i) \
        __builtin_amdgcn_global_load_lds((const unsigned*)((const char*)(gbase) + (voff)[_i]), (LAS unsigned*)(lds + (bufoff) + ldsw + _i * 8192), 16, 0, 0); } while (0)
#define PG8_LDA(dst, b, h) do { _Pragma("unroll") for (int m = 0; m < 4; ++m) _Pragma("unroll") for (int k = 0; k < 2; ++k) dst[m][k] = *(const LAS bf16x8*)(lds + PG8_SA(b, h) + aoff + m * 2048 + k * 1024); } while (0)
#define PG8_LDB(dst, b, h) do { _Pragma("unroll") for (int n = 0; n < 2; ++n) _Pragma("unroll") for (int k = 0; k < 2; ++k) dst[n][k] = *(const LAS bf16x8*)(lds + PG8_SB(b, h) + boff + n * 2048 + k * 1024); } while (0)
#define PG8_MMA(ai, bj, At, Bt) do { __builtin_amdgcn_s_setprio(1); _Pragma("unroll") for (int m = 0; m < 4; ++m) _Pragma("unroll") for (int n = 0; n < 2; ++n) _Pragma("unroll") for (int k = 0; k < 2; ++k) \
        acc[ai][bj][m][n] = __builtin_amdgcn_mfma_f32_16x16x32_bf16(Bt[n][k], At[m][k], acc[ai][bj][m][n], 0, 0, 0); __builtin_amdgcn_s_setprio(0); } while (0)
#define PG8_WAIT_V(n) asm volatile("s_waitcnt vmcnt(" #n ")" ::: "memory")
#define PG8_WAIT_L(n) asm volatile("s_waitcnt lgkmcnt(" #n ")" ::: "memory")
#define PG8_BAR __builtin_amdgcn_s_barrier()
#define PG8_SCHED __builtin_amdgcn_sched_barrier(0)
    Unit cur, nxt; int ui = 0;
    if (!S.next(0, cur)) return;
    f32x4 acc[2][2][4][2];
#pragma unroll
    for (int a = 0; a < 2; ++a)
#pragma unroll
        for (int b = 0; b < 2; ++b)
#pragma unroll
            for (int m = 0; m < 4; ++m)
#pragma unroll
                for (int n = 0; n < 2; ++n) acc[a][b][m][n] = (f32x4){0.f, 0.f, 0.f, 0.f};
    bf16x8 At[4][2], B0[2][2], B1[2][2];
    const char* cA = (const char*)g.A + (size_t)cur.pm * tstepA; const char* cB = (const char*)g.Bt + (size_t)cur.pn * tstepB;
    S.a_ready(cur);
    PG8_STAGE(PG8_SB(0, 0), cB, voffB); PG8_STAGE(PG8_SA(0, 0), cA, voffA); PG8_STAGE(PG8_SB(0, 1), cB + hstepB, voffB); PG8_STAGE(PG8_SA(0, 1), cA + hstepA, voffA);
    if (wr == 1) PG8_BAR;
    PG8_WAIT_V(4); PG8_BAR;
    PG8_STAGE(PG8_SB(1, 0), cB + kstep, voffB); PG8_STAGE(PG8_SA(1, 0), cA + kstep, voffA); PG8_STAGE(PG8_SB(1, 1), cB + hstepB + kstep, voffB);
    PG8_WAIT_V(6); PG8_BAR;
    for (;;) {
        const bool has_next = S.next(ui + 1, nxt);
        const char* nA = has_next ? (const char*)g.A + (size_t)nxt.pm * tstepA : cA; const char* nB = has_next ? (const char*)g.Bt + (size_t)nxt.pn * tstepB : cB;
        for (int t = 0; t < nt; t += 2) {
            const bool last = (t == nt - 2);
            const char* a1 = cA + (size_t)(t + 1) * kstep;
            const char* a2 = last ? nA : cA + (size_t)(t + 2) * kstep; const char* b2 = last ? nB : cB + (size_t)(t + 2) * kstep;
            const char* a3 = a2 + kstep; const char* b3 = b2 + kstep;
            if (last && has_next) S.a_ready(nxt);
            PG8_LDB(B0, 0, 0); PG8_SCHED; PG8_LDA(At, 0, 0); PG8_STAGE(PG8_SA(1, 1), a1 + hstepA, voffA);
            PG8_WAIT_L(8); PG8_BAR; PG8_WAIT_L(0); PG8_MMA(0, 0, At, B0); PG8_BAR; PG8_SCHED;
            PG8_LDB(B1, 0, 1); PG8_STAGE(PG8_SB(0, 0), b2, voffB);
            PG8_BAR; PG8_WAIT_L(0); PG8_MMA(0, 1, At, B1); PG8_BAR;
            PG8_LDA(At, 0, 1); PG8_STAGE(PG8_SA(0, 0), a2, voffA);
            PG8_BAR; PG8_WAIT_L(0); PG8_MMA(1, 0, At, B0); PG8_BAR; PG8_SCHED;
            PG8_STAGE(PG8_SB(0, 1), b2 + hstepB, voffB);
            PG8_WAIT_V(6); PG8_BAR; PG8_MMA(1, 1, At, B1); PG8_BAR;
            PG8_LDB(B0, 1, 0); PG8_SCHED; PG8_LDA(At, 1, 0); PG8_STAGE(PG8_SA(0, 1), a2 + hstepA, voffA);
            PG8_WAIT_L(8); PG8_BAR; PG8_WAIT_L(0); PG8_MMA(0, 0, At, B0); PG8_BAR; PG8_SCHED;
            PG8_LDB(B1, 1, 1); PG8_STAGE(PG8_SB(1, 0), b3, voffB);
            PG8_BAR; PG8_WAIT_L(0); PG8_MMA(0, 1, At, B1); PG8_BAR;
            PG8_LDA(At, 1, 1); PG8_STAGE(PG8_SA(1, 0), a3, voffA);
            PG8_BAR; PG8_WAIT_L(0); PG8_MMA(1, 0, At, B0); PG8_BAR; PG8_SCHED;
            PG8_STAGE(PG8_SB(1, 1), b3 + hstepB, voffB);
            PG8_WAIT_V(6); PG8_BAR; PG8_MMA(1, 1, At, B1); PG8_BAR;
        }
        E(acc, cur, wr, wc, fr, fq); S.done(cur);
        if (!has_next) break;
#pragma unroll
        for (int a = 0; a < 2; ++a)
#pragma unroll
            for (int b = 0; b < 2; ++b)
#pragma unroll
                for (int m = 0; m < 4; ++m)
#pragma unroll
                    for (int n = 0; n < 2; ++n) acc[a][b][m][n] = (f32x4){0.f, 0.f, 0.f, 0.f};
        cur = nxt; cA = nA; cB = nB; ++ui;
    }
    PG8_WAIT_V(0);
    if (wr == 0) PG8_BAR;
    PG8_BAR;
#undef PG8_SA
#undef PG8_SB
#undef PG8_STAGE
#undef PG8_LDA
#undef PG8_LDB
#undef PG8_MMA
#undef PG8_WAIT_V
#undef PG8_WAIT_L
#undef PG8_BAR
#undef PG8_SCHED
}
}

namespace att {
constexpr int NW = 8, QBLK = 32, KVBLK = 64, DV = 128;
constexpr float THR = 8.f;
constexpr int SHM_V = KVBLK * DV * 2;
#define SBAR() __builtin_amdgcn_sched_barrier(0)
__device__ __forceinline__ int crow(int r, int hi) { return (r & 3) + 8 * (r >> 2) + 4 * hi; }
__device__ __forceinline__ unsigned cvtpk(float lo, float hi) { unsigned r; asm volatile("v_cvt_pk_bf16_f32 %0, %1, %2" : "=v"(r) : "v"(lo), "v"(hi)); return r; }
__device__ __forceinline__ void partialSM(f32x16& p0, f32x16& p1, float& m_reg, float& mn, float& alpha, const float C, const float thr_raw) {
    float pmax = p0[0];
#pragma unroll
    for (int r = 1; r < 16; ++r) pmax = fmaxf(pmax, p0[r]);
#pragma unroll
    for (int r = 0; r < 16; ++r) pmax = fmaxf(pmax, p1[r]);
    { auto rr = __builtin_amdgcn_permlane32_swap(__float_as_uint(pmax), __float_as_uint(pmax), false, false);
      pmax = fmaxf(__uint_as_float(rr[0]), __uint_as_float(rr[1])); }
    if (__builtin_expect(__all(pmax - m_reg <= thr_raw), 1)) { mn = m_reg; alpha = 1.f; }
    else { mn = fmaxf(m_reg, pmax); alpha = __builtin_amdgcn_exp2f((m_reg - mn) * C); m_reg = mn; }
    const float mnC = -mn * C;
#pragma unroll
    for (int r = 0; r < 16; ++r) p0[r] = fmaf(p0[r], C, mnC);
#pragma unroll
    for (int r = 0; r < 16; ++r) p1[r] = fmaf(p1[r], C, mnC);
#pragma unroll
    for (int r = 0; r < 16; ++r) p0[r] = __builtin_amdgcn_exp2f(p0[r]);
}
__device__ __forceinline__ void finishSM(f32x16& p0, f32x16& p1, float alpha, float& l_reg, bf16x8& pa0, bf16x8& pa1, bf16x8& pa2, bf16x8& pa3) {
#pragma unroll
    for (int r = 0; r < 16; ++r) p1[r] = __builtin_amdgcn_exp2f(p1[r]);
    float ps = 0;
#pragma unroll
    for (int r = 0; r < 16; ++r) ps += p0[r];
#pragma unroll
    for (int r = 0; r < 16; ++r) ps += p1[r];
    { auto rr = __builtin_amdgcn_permlane32_swap(__float_as_uint(ps), __float_as_uint(ps), false, false);
      ps = __uint_as_float(rr[0]) + __uint_as_float(rr[1]); }
    l_reg = l_reg * alpha + ps;
#define PK4(P, BASE, OUT) do { unsigned a0 = cvtpk(P[BASE + 0], P[BASE + 1]), a1 = cvtpk(P[BASE + 2], P[BASE + 3]);   \
    unsigned b0 = cvtpk(P[BASE + 4], P[BASE + 5]), b1 = cvtpk(P[BASE + 6], P[BASE + 7]);                              \
    auto r0 = __builtin_amdgcn_permlane32_swap(a0, b0, false, false); auto r1 = __builtin_amdgcn_permlane32_swap(a1, b1, false, false); \
    u32x4 w = {r0[0], r1[0], r0[1], r1[1]}; OUT = *reinterpret_cast<bf16x8*>(&w); } while (0)
    PK4(p0, 0, pa0); PK4(p0, 8, pa1); PK4(p1, 0, pa2); PK4(p1, 8, pa3);
#undef PK4
}
__device__ __forceinline__ void partialSM_nm(f32x16& p0) {
#pragma unroll
    for (int r = 0; r < 16; ++r) p0[r] = __builtin_amdgcn_exp2f(p0[r]);
}
template <int DQK, int QL>
__device__ __forceinline__ void qkt(f32x16& p0, f32x16& p1, const char* Ks, const bf16x8 (&qr)[DQK / 16 - QL], const char* qpark, int r32, int hi) {
    constexpr int RS = DQK * 2 + 16, NQR = DQK / 16 - QL, GRP = (DQK > 128) ? QKT_GRP : DQK / 16;
    p0 = f32x16{}; p1 = f32x16{};
#pragma unroll
    for (int g0 = 0; g0 < DQK / 16; g0 += GRP) {
#pragma unroll
        for (int d0 = g0; d0 < g0 + GRP; ++d0) { const int cb = (d0 * 16 + hi * 8) * 2;
            const bf16x8 b0 = *reinterpret_cast<const bf16x8*>(Ks + r32 * RS + cb);
            const bf16x8 b1 = *reinterpret_cast<const bf16x8*>(Ks + (32 + r32) * RS + cb);
            bf16x8 qf; if (d0 < NQR) qf = qr[d0 < NQR ? d0 : 0]; else qf = *reinterpret_cast<const bf16x8*>(qpark + (d0 - NQR) * 1024);
            p0 = __builtin_amdgcn_mfma_f32_32x32x16_bf16(b0, qf, p0, 0, 0, 0);
            p1 = __builtin_amdgcn_mfma_f32_32x32x16_bf16(b1, qf, p1, 0, 0, 0); }
        if (g0 + GRP < DQK / 16) SBAR();
    }
}
__device__ __forceinline__ int v_st(int k, int c) { const int kk = (k & ~0xC) | ((k & 4) << 1) | ((k & 8) >> 1); return ((kk >> 3) * 4 + (c >> 5)) * 512 + ((kk & 7) * 32 + (c & 31)) * 2; }
__device__ __forceinline__ int v_rd_base(int lane) { return ((lane & 3) << 3) | (((lane >> 2) & 3) << 6) | (((lane >> 4) & 1) << 5) | (((lane >> 5) & 1) << 8); }
constexpr int v_rd_off(int d0, int ks, int half) { return d0 * 512 + ks * 4096 + half * 2048; }
template <int OFF> __device__ __forceinline__ s16x4 tr_read(int vb) {
    s16x4 r; asm volatile("ds_read_b64_tr_b16 %0, %1 offset:%2" : "=&v"(r) : "v"(vb), "i"(OFF) : "memory"); return r;
}
template <int D0> __device__ __forceinline__ void pv_one(f32x16& od, int vb, bf16x8 pa0, bf16x8 pa1, bf16x8 pa2, bf16x8 pa3) {
    const s16x4 l0 = tr_read<v_rd_off(D0, 0, 0)>(vb), h0 = tr_read<v_rd_off(D0, 0, 1)>(vb), l1 = tr_read<v_rd_off(D0, 1, 0)>(vb), h1 = tr_read<v_rd_off(D0, 1, 1)>(vb);
    const s16x4 l2 = tr_read<v_rd_off(D0, 2, 0)>(vb), h2 = tr_read<v_rd_off(D0, 2, 1)>(vb), l3 = tr_read<v_rd_off(D0, 3, 0)>(vb), h3 = tr_read<v_rd_off(D0, 3, 1)>(vb);
    asm volatile("s_waitcnt lgkmcnt(0)" ::: "memory"); SBAR();
#define PK(L, H) (bf16x8){L[0], L[1], L[2], L[3], H[0], H[1], H[2], H[3]}
    od = __builtin_amdgcn_mfma_f32_32x32x16_bf16(pa0, PK(l0, h0), od, 0, 0, 0);
    od = __builtin_amdgcn_mfma_f32_32x32x16_bf16(pa1, PK(l1, h1), od, 0, 0, 0);
    od = __builtin_amdgcn_mfma_f32_32x32x16_bf16(pa2, PK(l2, h2), od, 0, 0, 0);
    od = __builtin_amdgcn_mfma_f32_32x32x16_bf16(pa3, PK(l3, h3), od, 0, 0, 0);
#undef PK
}
__device__ __forceinline__ void pv_d0(f32x16* o, int vb, bf16x8 pa0, bf16x8 pa1, bf16x8 pa2, bf16x8 pa3) {
    pv_one<0>(o[0], vb, pa0, pa1, pa2, pa3); pv_one<1>(o[1], vb, pa0, pa1, pa2, pa3); pv_one<2>(o[2], vb, pa0, pa1, pa2, pa3); pv_one<3>(o[3], vb, pa0, pa1, pa2, pa3);
}
struct VFrag { s16x4 l0, h0, l1, h1, l2, h2, l3, h3; };
template <int D0> __device__ __forceinline__ void pv_rd(VFrag& f, int vb) {
    f.l0 = tr_read<v_rd_off(D0, 0, 0)>(vb); f.h0 = tr_read<v_rd_off(D0, 0, 1)>(vb); f.l1 = tr_read<v_rd_off(D0, 1, 0)>(vb); f.h1 = tr_read<v_rd_off(D0, 1, 1)>(vb);
    f.l2 = tr_read<v_rd_off(D0, 2, 0)>(vb); f.h2 = tr_read<v_rd_off(D0, 2, 1)>(vb); f.l3 = tr_read<v_rd_off(D0, 3, 0)>(vb); f.h3 = tr_read<v_rd_off(D0, 3, 1)>(vb);
}
__device__ __forceinline__ void pv_mm(f32x16& od, const VFrag& f, bf16x8 pa0, bf16x8 pa1, bf16x8 pa2, bf16x8 pa3) {
#define PK(L, H) (bf16x8){L[0], L[1], L[2], L[3], H[0], H[1], H[2], H[3]}
    od = __builtin_amdgcn_mfma_f32_32x32x16_bf16(pa0, PK(f.l0, f.h0), od, 0, 0, 0);
    od = __builtin_amdgcn_mfma_f32_32x32x16_bf16(pa1, PK(f.l1, f.h1), od, 0, 0, 0);
    od = __builtin_amdgcn_mfma_f32_32x32x16_bf16(pa2, PK(f.l2, f.h2), od, 0, 0, 0);
    od = __builtin_amdgcn_mfma_f32_32x32x16_bf16(pa3, PK(f.l3, f.h3), od, 0, 0, 0);
#undef PK
}
__device__ __forceinline__ void pv_d0_pipe(f32x16* o, int vb, bf16x8 pa0, bf16x8 pa1, bf16x8 pa2, bf16x8 pa3) {
    VFrag fa, fb;
    pv_rd<0>(fa, vb); pv_rd<1>(fb, vb);
    asm volatile("s_waitcnt lgkmcnt(8)" ::: "memory"); SBAR(); pv_mm(o[0], fa, pa0, pa1, pa2, pa3); SBAR();
    pv_rd<2>(fa, vb);
    asm volatile("s_waitcnt lgkmcnt(8)" ::: "memory"); SBAR(); pv_mm(o[1], fb, pa0, pa1, pa2, pa3); SBAR();
    pv_rd<3>(fb, vb);
    asm volatile("s_waitcnt lgkmcnt(8)" ::: "memory"); SBAR(); pv_mm(o[2], fa, pa0, pa1, pa2, pa3); SBAR();
    asm volatile("s_waitcnt lgkmcnt(0)" ::: "memory"); SBAR(); pv_mm(o[3], fb, pa0, pa1, pa2, pa3);
}
template <int DQK> struct ScaleOf { static constexpr float scale = DQK == 192 ? 0.07216878364870322f : (DQK == 128 ? 0.08838834764831845f : 0.125f); };
template <int DQK, int SDEPTH, int QL, bool NOMAX, int ldq, int ldk, int ldv, int ldo>
__device__ __forceinline__ void attn_body(const bf16_t* __restrict__ Qb, const bf16_t* __restrict__ Kh, const bf16_t* __restrict__ Vh,
                                          bf16_t* __restrict__ Ob, int seq, char* lds, int tid_in, const float negMC) {
    constexpr float C = 1.0f, thr_raw = THR * 1.4426950408889634f;
    constexpr int RS = DQK * 2 + 16  , SHM_K = KVBLK * RS, NKP = DQK / 64, KPR = DQK / 8;
    const int tid_l = tid_in * 64 + fresh_lane();
    const int tid = tid_l, wid = tid_in  , lane = tid & 63, r32 = lane & 31, hi = lane >> 5;
    char* V_lds = lds; char* K_lds = lds + 2 * SHM_V;
    float* ws = (float*)(lds + 2 * SHM_V + 2 * SHM_K) + wid * 64; float* li_l = ws; float* al_l = ws + 32;
    constexpr int NQR = DQK / 16 - QL;
    char* qpark = lds + 2 * SHM_V + 2 * SHM_K + 2048 + wid * (QL * 1024) + lane * 16;
    float m_reg = -1e30f, l_reg = 0; f32x16 o[4] = {}; bf16x8 qr[NQR];
    const bf16_t* Qw = Qb + (size_t)(wid * QBLK + r32) * ldq + hi * 8;
#pragma unroll
    for (int d0 = 0; d0 < NQR; ++d0) qr[d0] = *reinterpret_cast<const bf16x8*>(Qw + d0 * 16);
#pragma unroll
    for (int d0 = 0; d0 < QL; ++d0) *(bf16x8*)(qpark + d0 * 1024) = *reinterpret_cast<const bf16x8*>(Qw + (NQR + d0) * 16);
    const int sr = tid >> 4, sc = (tid & 15) * 8, vst0 = v_st(sr, sc), vst1 = v_st(32 + sr, sc);
    int koff[NKP], klds[NKP];
#pragma unroll
    for (int i = 0; i < NKP; ++i) { const int row = tid >> 3, c8 = (tid & 7) + 8 * i; koff[i] = row * ldk + c8 * 8; klds[i] = row * RS + c8 * 16; }
    const int vb0 = (int)(uintptr_t)V_lds + v_rd_base(lane);
    bf16x8 sv0[SDEPTH], sv1[SDEPTH], sk[SDEPTH][NKP];
#define SLOAD(i, k0) do { sv0[i] = *reinterpret_cast<const bf16x8*>(&Vh[(size_t)((k0) + sr) * ldv + sc]); sv1[i] = *reinterpret_cast<const bf16x8*>(&Vh[(size_t)((k0) + 32 + sr) * ldv + sc]); \
    _Pragma("unroll") for (int _q = 0; _q < NKP; ++_q) sk[i][_q] = *reinterpret_cast<const bf16x8*>(&Kh[(size_t)(k0) * ldk + koff[_q]]); } while (0)
#define SWRITE(b, i) do { *(bf16x8*)(V_lds + (b) * SHM_V + vst0) = sv0[i]; *(bf16x8*)(V_lds + (b) * SHM_V + vst1) = sv1[i]; \
    _Pragma("unroll") for (int _q = 0; _q < NKP; ++_q) *(bf16x8*)(K_lds + (b) * SHM_K + klds[_q]) = sk[i][_q]; } while (0)
#define SWAIT() do { if constexpr (SDEPTH == 2) { if constexpr (NKP == 1) asm volatile("s_waitcnt vmcnt(3)" ::: "memory"); else if constexpr (NKP == 2) asm volatile("s_waitcnt vmcnt(4)" ::: "memory"); else asm volatile("s_waitcnt vmcnt(5)" ::: "memory"); } \
    else asm volatile("s_waitcnt vmcnt(0)" ::: "memory"); } while (0)
#define PVD0(...) do { if constexpr (PV_PIPE != 0) pv_d0_pipe(__VA_ARGS__); else pv_d0(__VA_ARGS__); } while (0)
#define RESC(a) do { if constexpr (!NOMAX) if (__any((a) < 1.f)) { if (hi == 0) al_l[r32] = (a); asm volatile("s_waitcnt lgkmcnt(0)" ::: "memory"); \
    _Pragma("unroll") for (int d = 0; d < 4; ++d) _Pragma("unroll") for (int r = 0; r < 16; ++r) o[d][r] *= al_l[crow(r, hi)]; } } while (0)
    f32x16 pA0, pA1, pB0, pB1; float mnA, mnB, alA, alB; bf16x8 pa0, pa1, pa2, pa3; const int NT = seq / KVBLK;
    if (ATT_PRIO && wid >= 4) __builtin_amdgcn_s_setprio(1);
    constexpr int SE = 0, SO = SDEPTH - 1;
    SLOAD(SE, 0); asm volatile("s_waitcnt vmcnt(0)" ::: "memory"); SWRITE(0, SE); __syncthreads();
    qkt<DQK, QL>(pA0, pA1, K_lds, qr, qpark, r32, hi); if constexpr (NOMAX) { partialSM_nm(pA0); alA = 1.f; } else partialSM(pA0, pA1, m_reg, mnA, alA, C, thr_raw);
    SLOAD(SO, KVBLK); if constexpr (SDEPTH == 2) { if (2 < NT) SLOAD(SE, 2 * KVBLK); }
    SWAIT(); SWRITE(1, SO); __syncthreads();
    for (int j = 1; j + 1 < NT; j += 2) {
        SBAR(); qkt<DQK, QL>(pB0, pB1, K_lds + SHM_K, qr, qpark, r32, hi);
        finishSM(pA0, pA1, alA, l_reg, pa0, pa1, pa2, pa3); SBAR();
        SLOAD(SO, (j + SDEPTH) * KVBLK); SBAR();
        PVD0(o, vb0, pa0, pa1, pa2, pa3); if constexpr (NOMAX) { partialSM_nm(pB0); alB = 1.f; } else partialSM(pB0, pB1, m_reg, mnB, alB, C, thr_raw);
        __syncthreads(); SWAIT(); SWRITE(0, SE);
        RESC(alB); __syncthreads();
        SBAR(); qkt<DQK, QL>(pA0, pA1, K_lds, qr, qpark, r32, hi);
        finishSM(pB0, pB1, alB, l_reg, pa0, pa1, pa2, pa3); SBAR();
        if (SDEPTH == 1 || j + 3 < NT) SLOAD(SE, (j + 1 + SDEPTH) * KVBLK); SBAR();
        PVD0(o, vb0 + SHM_V, pa0, pa1, pa2, pa3); if constexpr (NOMAX) { partialSM_nm(pA0); alA = 1.f; } else partialSM(pA0, pA1, m_reg, mnA, alA, C, thr_raw);
        __syncthreads(); SWAIT(); SWRITE(1, SO);
        RESC(alA); __syncthreads();
    }
    SBAR(); qkt<DQK, QL>(pB0, pB1, K_lds + SHM_K, qr, qpark, r32, hi);
    finishSM(pA0, pA1, alA, l_reg, pa0, pa1, pa2, pa3); SBAR();
    PVD0(o, vb0, pa0, pa1, pa2, pa3); if constexpr (NOMAX) { partialSM_nm(pB0); alB = 1.f; } else partialSM(pB0, pB1, m_reg, mnB, alB, C, thr_raw);
    __syncthreads(); RESC(alB);
    finishSM(pB0, pB1, alB, l_reg, pa0, pa1, pa2, pa3); SBAR();
    PVD0(o, vb0 + SHM_V, pa0, pa1, pa2, pa3);
    if (ATT_PRIO) __builtin_amdgcn_s_setprio(0);
    if (hi == 0) li_l[r32] = l_reg; asm volatile("s_waitcnt lgkmcnt(0)" ::: "memory");
    float rli[16];
#pragma unroll
    for (int r = 0; r < 16; ++r) rli[r] = __builtin_amdgcn_rcpf(li_l[crow(r, hi)]);
    bf16_t* Ow = Ob + (size_t)(wid * QBLK) * ldo + (r32 & ~1);
    const bool odd = (r32 & 1) != 0;
#pragma unroll
    for (int r = 0; r < 16; r += 2) { const int orow = crow(r, hi) + (odd ? 1 : 0);
#pragma unroll
        for (int d0 = 0; d0 < 4; ++d0) { const float a = o[d0][r] * rli[r], b = o[d0][r + 1] * rli[r + 1];
            const float recv = swz_xor<1>(odd ? a : b);
            const unsigned w = odd ? cvtpk(recv, b) : cvtpk(a, recv);
            *(unsigned*)(Ow + (size_t)orow * ldo + d0 * 32) = w; } }
    __syncthreads();
#undef SLOAD
#undef SWRITE
#undef SWAIT
#undef RESC
#undef PVD0
}
template <int DQK, int QL, int ldq, int ldk, int ldv, int ldo>
__device__ __forceinline__ void attn_body_simple(const bf16_t* __restrict__ Qb, const bf16_t* __restrict__ Kh, const bf16_t* __restrict__ Vh,
                                                 bf16_t* __restrict__ Ob, int seq, char* lds, int tid_in) {
    constexpr float C = 1.0f, thr_raw = THR * 1.4426950408889634f;
    constexpr int RS = DQK * 2 + 16  , SHM_K = KVBLK * RS, NKP = DQK / 64, KPR = DQK / 8;
    const int tid_l = tid_in * 64 + fresh_lane();
    const int tid = tid_l, wid = tid_in  , lane = tid & 63, r32 = lane & 31, hi = lane >> 5;
    char* V_lds = lds; char* K_lds = lds + 2 * SHM_V;
    float* ws = (float*)(lds + 2 * SHM_V + 2 * SHM_K) + wid * 64; float* li_l = ws; float* al_l = ws + 32;
    constexpr int NQR = DQK / 16 - QL;
    char* qpark = lds + 2 * SHM_V + 2 * SHM_K + 2048 + wid * (QL * 1024) + lane * 16;
    float m_reg = -1e30f, l_reg = 0; f32x16 o[4] = {}; bf16x8 qr[NQR];
    const bf16_t* Qw = Qb + (size_t)(wid * QBLK + r32) * ldq + hi * 8;
#pragma unroll
    for (int d0 = 0; d0 < NQR; ++d0) qr[d0] = *reinterpret_cast<const bf16x8*>(Qw + d0 * 16);
#pragma unroll
    for (int d0 = 0; d0 < QL; ++d0) *(bf16x8*)(qpark + d0 * 1024) = *reinterpret_cast<const bf16x8*>(Qw + (NQR + d0) * 16);
    const int sr = tid >> 4, sc = (tid & 15) * 8, vst0 = v_st(sr, sc), vst1 = v_st(32 + sr, sc);
    int koff[NKP], klds[NKP];
#pragma unroll
    for (int i = 0; i < NKP; ++i) { const int row = tid >> 3, c8 = (tid & 7) + 8 * i; koff[i] = row * ldk + c8 * 8; klds[i] = row * RS + c8 * 16; }
    const int vb0 = (int)(uintptr_t)V_lds + v_rd_base(lane);
    bf16x8 sv0, sv1, sk[NKP];
#define SLOAD(k0) do { sv0 = *reinterpret_cast<const bf16x8*>(&Vh[(size_t)((k0) + sr) * ldv + sc]); sv1 = *reinterpret_cast<const bf16x8*>(&Vh[(size_t)((k0) + 32 + sr) * ldv + sc]); \
    _Pragma("unroll") for (int _q = 0; _q < NKP; ++_q) sk[_q] = *reinterpret_cast<const bf16x8*>(&Kh[(size_t)(k0) * ldk + koff[_q]]); } while (0)
#define SWRITE(b) do { *(bf16x8*)(V_lds + (b) * SHM_V + vst0) = sv0; *(bf16x8*)(V_lds + (b) * SHM_V + vst1) = sv1; \
    _Pragma("unroll") for (int _q = 0; _q < NKP; ++_q) *(bf16x8*)(K_lds + (b) * SHM_K + klds[_q]) = sk[_q]; } while (0)
#define RESC(a) do { if (__any((a) < 1.f)) { if (hi == 0) al_l[r32] = (a); asm volatile("s_waitcnt lgkmcnt(0)" ::: "memory"); \
    _Pragma("unroll") for (int d = 0; d < 4; ++d) _Pragma("unroll") for (int r = 0; r < 16; ++r) o[d][r] *= al_l[crow(r, hi)]; } } while (0)
    const int NT = seq / KVBLK;
    SLOAD(0); asm volatile("s_waitcnt vmcnt(0)" ::: "memory"); SWRITE(0); __syncthreads();
    for (int j = 0; j < NT; ++j) {
        const int b = j & 1;
        if (j + 1 < NT) SLOAD((j + 1) * KVBLK);
        SBAR();
        f32x16 p0, p1; float mn, al; bf16x8 pa0, pa1, pa2, pa3;
        { const char* Ks = K_lds + b * SHM_K; p0 = f32x16{}; p1 = f32x16{};
#pragma unroll
          for (int d0 = 0; d0 < DQK / 16; ++d0) { const int cb = (d0 * 16 + hi * 8) * 2;
              const bf16x8 b0 = *reinterpret_cast<const bf16x8*>(Ks + r32 * RS + cb);
              const bf16x8 b1 = *reinterpret_cast<const bf16x8*>(Ks + (32 + r32) * RS + cb);
              bf16x8 qf; if (d0 < NQR) qf = qr[d0 < NQR ? d0 : 0]; else qf = *(const bf16x8*)(qpark + (d0 - NQR) * 1024);
              p0 = __builtin_amdgcn_mfma_f32_32x32x16_bf16(b0, qf, p0, 0, 0, 0);
              p1 = __builtin_amdgcn_mfma_f32_32x32x16_bf16(b1, qf, p1, 0, 0, 0); } }
        partialSM(p0, p1, m_reg, mn, al, C, thr_raw);
        RESC(al);
        finishSM(p0, p1, al, l_reg, pa0, pa1, pa2, pa3); SBAR();
        pv_d0(o, vb0 + b * SHM_V, pa0, pa1, pa2, pa3);
        if (j + 1 < NT) { asm volatile("s_waitcnt vmcnt(0)" ::: "memory"); SWRITE(b ^ 1); }
        __syncthreads();
    }
    if (hi == 0) li_l[r32] = l_reg; asm volatile("s_waitcnt lgkmcnt(0)" ::: "memory");
    float rli[16];
#pragma unroll
    for (int r = 0; r < 16; ++r) rli[r] = __builtin_amdgcn_rcpf(li_l[crow(r, hi)]);
    bf16_t* Ow = Ob + (size_t)(wid * QBLK) * ldo + (r32 & ~1);
    const bool odd = (r32 & 1) != 0;
#pragma unroll
    for (int r = 0; r < 16; r += 2) { const int orow = crow(r, hi) + (odd ? 1 : 0);
#pragma unroll
        for (int d0 = 0; d0 < 4; ++d0) { const float a = o[d0][r] * rli[r], b = o[d0][r + 1] * rli[r + 1];
            const float recv = swz_xor<1>(odd ? a : b);
            const unsigned w = odd ? cvtpk(recv, b) : cvtpk(a, recv);
            *(unsigned*)(Ow + (size_t)orow * ldo + d0 * 32) = w; } }
    __syncthreads();
#undef SLOAD
#undef SWRITE
#undef RESC
}
}

struct Params {
    const float* x; const float* c; const float* ctx; const float* c_ctx; const float* w_mod; const float* b_mod; const float* g_norm1; const float* g_norm2;
    const float* w_in_ab; const float* g_cq; const float* w_uq; const float* g_ckv; const float* w_ukv; const float* g_qn_a; const float* g_kn_a; const float* lam_vec;
    const float* g_qn_b; const float* g_kn_b; const float* g_sub_b; const float* w_out_ab; const float* w_in_c; const float* g_qn_c; const float* g_kn_c; const float* w_out_c;
    const float* w_pq; const float* sub_keys; const float* expert_u; const float* expert_v;
    float* out; unsigned char* ws; int ph_lo, ph_hi;
};

typedef const __attribute__((address_space(4))) Params CParams;
struct Ctx {
    int tid, lane, wid, G, vcu, bx;
    unsigned char* ws; char* lds;
};

__device__ __forceinline__ void tconv(const Ctx& F, const float* src, bf16_t* dst, const float* gain, int nmat, int K, int N, int Npad, int pad_at = 1 << 30, int pad_len = 0) {
    float* tile = (float*)(F.lds + 32768);
    const int ntn = Npad / 64, ntk = K / 64, per = ntn * ntk, total = per * nmat;
    for (int it = F.vcu; it < total; it += F.G) {
        const int mat = it / per, rem = it % per, tn = rem / ntk, tk = rem % ntk, k0 = tk * 64, n0 = tn * 64;
        const float* s = src + (size_t)mat * K * N; bf16_t* d = dst + (size_t)mat * Npad * K;
        __syncthreads();
        { const int r = F.tid >> 4, c4 = (F.tid & 15) * 4;
#pragma unroll
          for (int i = 0; i < 2; ++i) { const int rr = r + i * 32; f32x4 v = (f32x4){0.f, 0.f, 0.f, 0.f};
              const int sn0 = n0 < pad_at ? n0 : n0 - pad_len;
              if (sn0 + c4 < N && !(n0 >= pad_at && n0 < pad_at + pad_len)) v = *(const f32x4*)(s + (size_t)(k0 + rr) * N + sn0 + c4);
              tile[rr * 65 + c4 + 0] = v[0]; tile[rr * 65 + c4 + 1] = v[1]; tile[rr * 65 + c4 + 2] = v[2]; tile[rr * 65 + c4 + 3] = v[3]; } }
        __syncthreads();
        { const int n = F.tid >> 3, kc = (F.tid & 7) * 8; float v[8];
#pragma unroll
          for (int e = 0; e < 8; ++e) { v[e] = tile[(kc + e) * 65 + n]; if (gain) v[e] *= gain[(size_t)mat * K + k0 + kc + e]; }
          u32x4 w; w.x = cvt_pk_bf16(v[0], v[1]); w.y = cvt_pk_bf16(v[2], v[3]); w.z = cvt_pk_bf16(v[4], v[5]); w.w = cvt_pk_bf16(v[6], v[7]);
          *(u32x4*)(d + (size_t)(n0 + n) * K + k0 + kc) = w; }
    }
}
__device__ __forceinline__ void cvt_flat(const Ctx& F, const float* src, bf16_t* dst, size_t n8) {
    for (size_t i = (size_t)F.vcu * 512 + F.tid; i < n8; i += (size_t)F.G * 512) {
        const f32x4 a = *(const f32x4*)(src + i * 8), b = *(const f32x4*)(src + i * 8 + 4);
        u32x4 w; w.x = cvt_pk_bf16(a[0], a[1]); w.y = cvt_pk_bf16(a[2], a[3]); w.z = cvt_pk_bf16(b[0], b[1]); w.w = cvt_pk_bf16(b[2], b[3]);
        *(u32x4*)(dst + i * 8) = w;
    }
}
typedef unsigned v6u __attribute__((ext_vector_type(6)));
typedef float v32f __attribute__((ext_vector_type(32)));
typedef float v16f __attribute__((ext_vector_type(16)));
__device__ __forceinline__ float fp6_val(int c) { return c < 8 ? c * 0.125f : (c < 16 ? 1.f + (c - 8) * 0.125f : (c < 24 ? 2.f + (c - 16) * 0.25f : 4.f + (c - 24) * 0.5f)); }
__device__ __forceinline__ int fp6_code(float x) { return x < 1.f ? (int)(x * 8.f + 0.5f) : (x < 2.f ? 8 + (int)((x - 1.f) * 8.f + 0.5f) : (x < 4.f ? 16 + (int)((x - 2.f) * 4.f + 0.5f) : 24 + (int)((x - 4.f) * 2.f + 0.5f))); }
__device__ __forceinline__ void cvt_rows_fp6(const Ctx& F, const float* src, unsigned char* dst, float* descale, int R) {
    float* stg = (float*)(F.lds + 65536) + F.wid * (64 * 33);
    int* permL = (int*)(F.lds + 65536 + 8 * 64 * 33 * 4) + F.wid * 32;
    float fac;
    {   v16f lo, hi;
#pragma unroll
        for (int i = 0; i < 16; ++i) { lo[i] = fp6_val(i); hi[i] = fp6_val(16 + i); }
        const v6u w = __builtin_amdgcn_cvt_scalef32_2xpk16_fp6_f32(lo, hi, 1.0f);
        const v32f f = __builtin_amdgcn_cvt_scalef32_pk32_f32_fp6(w, 1.0f);
        float mx = 0.f;
#pragma unroll
        for (int j = 0; j < 32; ++j) mx = fmaxf(mx, f[j]);
        fac = mx * (1.f / 7.5f);
        const float inv = fac > 0.f ? 1.f / fac : 1.f;
        if (F.lane == 0) {
#pragma unroll
            for (int j = 0; j < 32; ++j) permL[j] = fp6_code(f[j] * inv) & 31; }
        asm volatile("s_waitcnt lgkmcnt(0)" ::: "memory"); __builtin_amdgcn_wave_barrier(); asm volatile("" ::: "memory");
    }
    for (int row = F.vcu * 8 + F.wid; row < R; row += F.G * 8) {
        const float* s = src + (size_t)row * DM + F.lane * 4; f32x4 v[8]; float am = 0.f;
#pragma unroll
        for (int i = 0; i < 8; ++i) { v[i] = *(const f32x4*)(s + i * 256);
#pragma unroll
            for (int e = 0; e < 4; ++e) am = fmaxf(am, fabsf(v[i][e])); }
        am = wave_max(am);
        const float sc = am > 0.f ? 7.f / am : 1.f;
#pragma unroll
        for (int i = 0; i < 8; ++i)
#pragma unroll
            for (int e = 0; e < 4; ++e) stg[F.lane * 33 + permL[i * 4 + e]] = v[i][e] * sc;
        asm volatile("s_waitcnt lgkmcnt(0)" ::: "memory"); __builtin_amdgcn_wave_barrier(); asm volatile("" ::: "memory");
        v16f lo, hi;
#pragma unroll
        for (int i = 0; i < 16; ++i) { lo[i] = stg[F.lane * 33 + i]; hi[i] = stg[F.lane * 33 + 16 + i]; }
        asm volatile("s_waitcnt lgkmcnt(0)" ::: "memory"); __builtin_amdgcn_wave_barrier(); asm volatile("" ::: "memory");
        const v6u w = __builtin_amdgcn_cvt_scalef32_2xpk16_fp6_f32(lo, hi, 1.0f);
        unsigned char* d = dst + (size_t)row * EROW;
        *(u32x4*)(d + F.lane * 16) = (u32x4){w[0], w[1], w[2], w[3]}; *(u32x2*)(d + 1024 + F.lane * 8) = (u32x2){w[4], w[5]};
        if (F.lane == 0) descale[row] = (am > 0.f ? am * (1.f / 7.f) : 1.f) / (fac > 0.f ? fac : 1.f);
    }
}
__device__ __forceinline__ float silu_f(float v) { return v / (1.f + __expf(-v)); }

__device__ __forceinline__ void prologue_phase(const Ctx& F, CParams& P) {
    unsigned char* ws = F.ws;
    {
        float* sv = (float*)F.lds;
        float* part = (float*)(F.lds + 24576);
        for (int i = F.tid; i < 3 * DM; i += 512) { const int v = i / DM, k = i % DM; const float cv = v < 2 ? P.c[v * DM + k] : P.c_ctx[k]; sv[i] = silu_f(cv); }
        __syncthreads();
        float* mod = (float*)(ws + WS_MOD);
        for (int it = F.vcu; it < DEPTH * 192; it += F.G) {
            const int l = it / 192, n0 = (it % 192) * 64;
            const float* wp = P.w_mod + ((size_t)l * DM + F.wid * 256) * 12288 + n0 + F.lane;
            float a0 = 0.f, a1 = 0.f, a2 = 0.f;
#pragma unroll 8
            for (int k = 0; k < 256; ++k) { const float w = wp[(size_t)k * 12288]; const int kk = F.wid * 256 + k; a0 += sv[kk] * w; a1 += sv[DM + kk] * w; a2 += sv[2 * DM + kk] * w; }
            part[(F.wid * 3 + 0) * 64 + F.lane] = a0; part[(F.wid * 3 + 1) * 64 + F.lane] = a1; part[(F.wid * 3 + 2) * 64 + F.lane] = a2;
            __syncthreads();
            if (F.wid < 3) { float s = 0.f;
#pragma unroll
                for (int w = 0; w < 8; ++w) s += part[(w * 3 + F.wid) * 64 + F.lane];
                mod[((size_t)l * 3 + F.wid) * 12288 + n0 + F.lane] = s + P.b_mod[(size_t)l * 12288 + n0 + F.lane]; }
            __syncthreads();
        }
    }
    if (F.vcu == 0) {
        float* t16 = (float*)(ws + WS_TAB16); float* t32 = (float*)(ws + WS_TAB32);
        for (int i = F.tid; i < 128 * 16; i += 512) { const int pos = i >> 4, f = i & 15; const float fr = powf(10000.f, -(float)f / 16.f); const float a = (float)pos * fr; float s, c; sincosf(a, &s, &c); t16[i * 2] = c; t16[i * 2 + 1] = s; }
        for (int i = F.tid; i < 128 * 32; i += 512) { const int pos = i >> 5, f = i & 31; const float fr = powf(10000.f, -(float)f / 32.f); const float a = (float)pos * fr; float s, c; sincosf(a, &s, &c); t32[i * 2] = c; t32[i * 2 + 1] = s; }
        if (F.wid == 2) { float* bnd = (float*)(ws + WS_LAM) + 4;
            for (int e2 = 0; e2 < 2; ++e2) {
                float ga = 0.f, gb = 0.f, gc = 0.f, gd = 0.f, ge = 0.f, gf = 0.f;
                for (int i = F.lane; i < 192; i += 64) { ga = fmaxf(ga, fabsf(P.g_qn_a[e2 * 192 + i])); gb = fmaxf(gb, fabsf(P.g_kn_a[e2 * 192 + i])); }
                gc = fabsf(P.g_qn_b[e2 * 64 + F.lane]); gd = fabsf(P.g_kn_b[e2 * 64 + F.lane]);
                for (int i = F.lane; i < 128; i += 64) { ge = fmaxf(ge, fabsf(P.g_qn_c[e2 * 128 + i])); gf = fmaxf(gf, fabsf(P.g_kn_c[e2 * 128 + i])); }
                ga = wave_max(ga); gb = wave_max(gb); gc = wave_max(gc); gd = wave_max(gd); ge = wave_max(ge); gf = wave_max(gf);
                if (F.lane == 0) { bnd[(2 * e2) * 2 + 0] = 1.03f * 13.856406f * ga * gb;
                                   bnd[(2 * e2) * 2 + 1] = 1.03f * 8.f * gc * gd;
                                   bnd[(2 * e2 + 1) * 2 + 0] = 1.03f * 11.313708f * ge * gf;
                                   bnd[(2 * e2 + 1) * 2 + 1] = 0.f; } } }
        if (F.wid < 2) { const float* lv = P.lam_vec + F.wid * 256; const float d1 = wave_sum(lv[F.lane] * lv[64 + F.lane]), d2 = wave_sum(lv[128 + F.lane] * lv[192 + F.lane]);
            const float lam_init = 0.8f - 0.6f * expf(-0.3f * (float)(2 * F.wid));
            if (F.lane == 0) ((float*)(ws + WS_LAM))[F.wid] = expf(d1) - expf(d2) + lam_init; }
    }
    tconv(F, P.w_in_ab, (bf16_t*)(ws + WS_WINAB), nullptr, 2, DM, AB_IN, AB_INP, 3392, AB_INP - AB_IN);
    tconv(F, P.w_uq, (bf16_t*)(ws + WS_WUQ), P.g_cq, 2, 768, 1536, 1536);
    tconv(F, P.w_ukv, (bf16_t*)(ws + WS_WUKV), P.g_ckv, 2, 512, 2048, 2048);
    tconv(F, P.w_out_ab, (bf16_t*)(ws + WS_WOUTAB), nullptr, 2, DM, DM, DM);
    tconv(F, P.w_in_c, (bf16_t*)(ws + WS_WINC), nullptr, 2, DM, C_IN, C_IN);
    tconv(F, P.w_out_c, (bf16_t*)(ws + WS_WOUTC), nullptr, 2, DM, DM, DM);
    tconv(F, P.w_pq, (bf16_t*)(ws + WS_WPQ), nullptr, 4, DM, DM, DM);
    cvt_flat(F, P.sub_keys, (bf16_t*)(ws + WS_SUBK), (size_t)4 * 8 * 2 * 128 * 128 / 8);
    cvt_rows_fp6(F, P.expert_u, ws + WS_EU, (float*)(ws + WS_SU), 4 * NEXP);
    cvt_rows_fp6(F, P.expert_v, ws + WS_EV, (float*)(ws + WS_SV), 4 * NEXP);
}

__device__ __forceinline__ void norm_rows(const Ctx& F, CParams& P, int layer, int which  , int t_first, int t_end, int t_stride) {
    float* X = (float*)(F.ws + WS_X); bf16_t* H = (bf16_t*)(F.ws + WS_H);
    const float* mod = (const float*)(F.ws + WS_MOD) + (size_t)layer * 3 * 12288;
    const float* gn = (which ? P.g_norm2 : P.g_norm1) + (size_t)layer * DM;
    const bool from_in = (layer == 0 && which == 0);
    const int lane = fresh_lane();
    if (t_first >= t_end) return;
    f32x4 g[8];
#pragma unroll
    for (int j = 0; j < 8; ++j) g[j] = *(const f32x4*)(gn + j * 256 + lane * 4);
    auto srcrow = [&](int t) { return from_in ? (t < TL ? P.x + (size_t)t * DM : P.ctx + (size_t)(t - TL) * DM) : X + (size_t)t * DM; };
    f32x4 vn[8];
    { const float* src = srcrow(t_first);
#pragma unroll
      for (int j = 0; j < 8; ++j) vn[j] = *(const f32x4*)(src + j * 256 + lane * 4); }
    for (int t = t_first; t < t_end; t += t_stride) {
        const int vs = vsel_of_row(t);
        const float* shf = mod + (size_t)vs * 12288 + (which ? 3 : 0) * DM; const float* scl = shf + DM;
        f32x4 v[8], sc[8], sh[8]; float ss = 0.f;
#pragma unroll
        for (int j = 0; j < 8; ++j) { v[j] = vn[j]; sc[j] = *(const f32x4*)(scl + j * 256 + lane * 4); sh[j] = *(const f32x4*)(shf + j * 256 + lane * 4); }
        { const int tn = t + t_stride; const float* src = srcrow(tn < t_end ? tn : t);
#pragma unroll
          for (int j = 0; j < 8; ++j) vn[j] = *(const f32x4*)(src + j * 256 + lane * 4); }
#pragma unroll
        for (int j = 0; j < 8; ++j) ss += v[j][0] * v[j][0] + v[j][1] * v[j][1] + v[j][2] * v[j][2] + v[j][3] * v[j][3];
        ss = wave_sum(ss);
        const float rstd = rsqrtf(ss * (1.f / DM) + EPS);
#pragma unroll
        for (int j = 0; j < 8; ++j) { const int c = j * 256 + lane * 4;
            f32x4 y;
#pragma unroll
            for (int e = 0; e < 4; ++e) y[e] = (v[j][e] * rstd * g[j][e]) * (1.f + sc[j][e]) + sh[j][e];
            u32x2 w; w.x = cvt_pk_bf16(y[0], y[1]); w.y = cvt_pk_bf16(y[2], y[3]);
            *(u32x2*)(H + (size_t)t * DM + c) = w; }
    }
}
__device__ __forceinline__ void norm_phase(const Ctx& F, CParams& P, int layer, int which, int m_rows) { norm_rows(F, P, layer, which, F.vcu * 8 + F.wid, m_rows, F.G * 8); }

__device__ __forceinline__ float grp16_sum(float v) { v += swz_xor<8>(v); v += swz_xor<4>(v); v += swz_xor<2>(v); v += swz_xor<1>(v); return v; }
__device__ __forceinline__ void rope4(float (&x)[4], int q16, int row, int col, const float* t16) {
    const int seg = q16 >> 3, f0 = (q16 & 3) * 4, pos = seg ? col : row; const bool first = (q16 & 7) < 4;
    const f32x4 c0 = *(const f32x4*)(t16 + (pos * 16 + f0) * 2), c1 = *(const f32x4*)(t16 + (pos * 16 + f0) * 2 + 4);
    const float cs[4] = {c0[0], c0[2], c1[0], c1[2]}, sn[4] = {c0[1], c0[3], c1[1], c1[3]};
#pragma unroll
    for (int e = 0; e < 4; ++e) { const float p = swz_xor<4>(x[e]); x[e] = first ? x[e] * cs[e] - p * sn[e] : p * sn[e] + x[e] * cs[e]; }
}
__device__ __forceinline__ void rope8(float (&x)[8], int q16, int row, int col, const float* t32) {
    const int seg = q16 >> 3, f0 = (q16 & 3) * 8, pos = seg ? col : row; const bool first = (q16 & 7) < 4;
    const float* tp = t32 + (pos * 32 + f0) * 2;
#pragma unroll
    for (int q = 0; q < 4; ++q) { const f32x4 c = *(const f32x4*)(tp + q * 4);
#pragma unroll
        for (int s = 0; s < 2; ++s) { const int e = q * 2 + s; const float cs = c[s * 2], sn = c[s * 2 + 1]; const float p = swz_xor<4>(x[e]); x[e] = first ? x[e] * cs - p * sn : p * sn + x[e] * cs; } }
}
__device__ __forceinline__ void ld8bf(const bf16_t* p, float (&x)[8]) { const u32x4 w = *(const u32x4*)p;
#pragma unroll
    for (int q = 0; q < 4; ++q) { x[q * 2] = bf_lo(w[q]); x[q * 2 + 1] = bf_hi(w[q]); } }
__device__ __forceinline__ void ld4bf(const bf16_t* p, float (&x)[4]) { const u32x2 w = *(const u32x2*)p; x[0] = bf_lo(w.x); x[1] = bf_hi(w.x); x[2] = bf_lo(w.y); x[3] = bf_hi(w.y); }
__device__ __forceinline__ void st8bf(bf16_t* p, const float (&x)[8]) { u32x4 w; w.x = cvt_pk_bf16(x[0], x[1]); w.y = cvt_pk_bf16(x[2], x[3]); w.z = cvt_pk_bf16(x[4], x[5]); w.w = cvt_pk_bf16(x[6], x[7]); *(u32x4*)p = w; }
__device__ __forceinline__ void st4bf(bf16_t* p, const float (&x)[4]) { u32x2 w; w.x = cvt_pk_bf16(x[0], x[1]); w.y = cvt_pk_bf16(x[2], x[3]); *(u32x2*)p = w; }

__device__ __forceinline__ void qkv_even_phase(const Ctx& F, CParams& P, int e) {
    const bf16_t* P1 = (const bf16_t*)(F.ws + WS_P1); const bf16_t* QA = (const bf16_t*)(F.ws + WS_QA); const bf16_t* KV = (const bf16_t*)(F.ws + WS_KV);
    bf16_t* Qm = (bf16_t*)(F.ws + WS_Q1); bf16_t* Km = (bf16_t*)(F.ws + WS_K1); bf16_t* Vm = (bf16_t*)(F.ws + WS_V1);
    bf16_t* Qd = (bf16_t*)(F.ws + WS_Q2); bf16_t* Kd = (bf16_t*)(F.ws + WS_K2); bf16_t* Vd = (bf16_t*)(F.ws + WS_V2);
    const float* t16 = (const float*)(F.ws + WS_TAB16);
    const float* gqa = P.g_qn_a + e * 192; const float* gka = P.g_kn_a + e * 192; const float* gqb = P.g_qn_b + e * 64; const float* gkb = P.g_kn_b + e * 64;
    const int q16 = F.lane & 15, grp = F.lane >> 4;
    float gq_n[8], gq_r[4], gk_n[8], gk_r[4], gqd[4], gkd[4];
#pragma unroll
    for (int i = 0; i < 8; ++i) { gq_n[i] = gqa[q16 * 8 + i]; gk_n[i] = gka[q16 * 8 + i]; }
#pragma unroll
    for (int i = 0; i < 4; ++i) { gq_r[i] = gqa[128 + q16 * 4 + i]; gk_r[i] = gka[128 + q16 * 4 + i]; gqd[i] = gqb[q16 * 4 + i]; gkd[i] = gkb[q16 * 4 + i]; }
    struct Raw { u32x2 cq[3]; u32x4 ckv; u32x2 kro; u32x4 qn[2]; u32x2 qr[2]; u32x4 kn[2], kv[2]; u32x2 dq[4], dk[4]; f32x4 rc0, rc1; };
    auto load_raw = [&](int t, Raw& R) {
        const bf16_t* p1 = P1 + (size_t)t * AB_INP;
        { const int s_ = t & (SEQ - 1), pos_ = (q16 >> 3) ? (s_ & 63) : (s_ >> 6); const float* tp = t16 + (pos_ * 16 + (q16 & 3) * 4) * 2; R.rc0 = *(const f32x4*)tp; R.rc1 = *(const f32x4*)(tp + 4); }
#pragma unroll
        for (int j = 0; j < 3; ++j) R.cq[j] = *(const u32x2*)(p1 + j * 256 + F.lane * 4);
        R.ckv = *(const u32x4*)(p1 + 768 + F.lane * 8);
        R.kro = *(const u32x2*)(p1 + 1280 + q16 * 4);
#pragma unroll
        for (int ps = 0; ps < 2; ++ps) { const int h = ps * 4 + grp; const bf16_t* src = QA + (size_t)t * 1536 + h * 192;
            R.qn[ps] = *(const u32x4*)(src + q16 * 8); R.qr[ps] = *(const u32x2*)(src + 128 + q16 * 4);
            const bf16_t* sk = KV + (size_t)t * 2048 + h * 256; R.kn[ps] = *(const u32x4*)(sk + q16 * 8); R.kv[ps] = *(const u32x4*)(sk + 128 + q16 * 8); }
#pragma unroll
        for (int ps = 0; ps < 4; ++ps) { const int hm = ps * 4 + grp; R.dq[ps] = *(const u32x2*)(p1 + 1344 + hm * 64 + q16 * 4); R.dk[ps] = *(const u32x2*)(p1 + 2368 + hm * 64 + q16 * 4); }
    };
#define UNP8(W, X) do { X[0] = bf_lo(W.x); X[1] = bf_hi(W.x); X[2] = bf_lo(W.y); X[3] = bf_hi(W.y); X[4] = bf_lo(W.z); X[5] = bf_hi(W.z); X[6] = bf_lo(W.w); X[7] = bf_hi(W.w); } while (0)
#define UNP4(W, X) do { X[0] = bf_lo(W.x); X[1] = bf_hi(W.x); X[2] = bf_lo(W.y); X[3] = bf_hi(W.y); } while (0)
    const int tfirst = F.vcu * 8 + F.wid, tstr = F.G * 8;
    Raw R; if (tfirst < TT) load_raw(tfirst, R);
    for (int t = tfirst; t < TT; t += tstr) {
        const bool latent = t < TL; const int s = t & (SEQ - 1), row = s >> 6, col = s & 63; const int kr = krow_of(t);
        Raw C = R; { const int tn = t + tstr; load_raw(tn < TT ? tn : t, R); }
        const float rcs[4] = {C.rc0[0], C.rc0[2], C.rc1[0], C.rc1[2]}, rsn[4] = {C.rc0[1], C.rc0[3], C.rc1[1], C.rc1[3]}; const bool rfirst = (q16 & 7) < 4;
#define ROPE4V(X) do { _Pragma("unroll") for (int e_ = 0; e_ < 4; ++e_) { const float p_ = swz_xor<4>(X[e_]); X[e_] = rfirst ? X[e_] * rcs[e_] - p_ * rsn[e_] : p_ * rsn[e_] + X[e_] * rcs[e_]; } } while (0)
        float ss = 0.f;
#pragma unroll
        for (int j = 0; j < 3; ++j) { float x[4]; UNP4(C.cq[j], x); ss += x[0] * x[0] + x[1] * x[1] + x[2] * x[2] + x[3] * x[3]; }
        ss = wave_sum(ss); const float rstd_q = rsqrtf(ss * (1.f / 768.f) + EPS);
        float s2 = 0.f;
        { float x[8]; UNP8(C.ckv, x);
#pragma unroll
          for (int i = 0; i < 8; ++i) s2 += x[i] * x[i]; }
        s2 = wave_sum(s2); const float rstd_kv = rsqrtf(s2 * (1.f / 512.f) + EPS);
        float kro[4]; UNP4(C.kro, kro);
#pragma unroll
        for (int ps = 0; ps < 2; ++ps) { const int h = ps * 4 + grp;
            float xn[8], xr[4]; UNP8(C.qn[ps], xn); UNP4(C.qr[ps], xr);
            float sq = 0.f;
#pragma unroll
            for (int i = 0; i < 8; ++i) { xn[i] *= rstd_q; sq += xn[i] * xn[i]; }
#pragma unroll
            for (int i = 0; i < 4; ++i) { xr[i] *= rstd_q; sq += xr[i] * xr[i]; }
            sq = grp16_sum(sq); const float r = rsqrtf(sq * (1.f / 192.f) + EPS);
            const float rq = r * (0.07216878364870322f * LOG2E);
#pragma unroll
            for (int i = 0; i < 8; ++i) xn[i] *= rq * gq_n[i];
#pragma unroll
            for (int i = 0; i < 4; ++i) xr[i] *= rq * gq_r[i];
            if (latent) ROPE4V(xr);
            bf16_t* dst = Qm + ((size_t)t * 8 + h) * 192; st8bf(dst + q16 * 8, xn); st4bf(dst + 128 + q16 * 4, xr); }
#pragma unroll
        for (int ps = 0; ps < 2; ++ps) { const int h = ps * 4 + grp;
            float xn[8], xr[4], xv[8]; UNP8(C.kn[ps], xn); UNP8(C.kv[ps], xv);
            float sq = 0.f;
#pragma unroll
            for (int i = 0; i < 8; ++i) { xn[i] *= rstd_kv; xv[i] *= rstd_kv; sq += xn[i] * xn[i]; }
#pragma unroll
            for (int i = 0; i < 4; ++i) { xr[i] = kro[i]; sq += xr[i] * xr[i]; }
            sq = grp16_sum(sq); const float r = rsqrtf(sq * (1.f / 192.f) + EPS);
#pragma unroll
            for (int i = 0; i < 8; ++i) xn[i] *= r * gk_n[i];
#pragma unroll
            for (int i = 0; i < 4; ++i) xr[i] *= r * gk_r[i];
            if (latent) ROPE4V(xr);
            bf16_t* dst = Km + ((size_t)kr * 8 + h) * 192; st8bf(dst + q16 * 8, xn); st4bf(dst + 128 + q16 * 4, xr);
            st8bf(Vm + ((size_t)kr * 8 + h) * 128 + q16 * 8, xv); }
#pragma unroll
        for (int ps = 0; ps < 4; ++ps) { const int hm = ps * 4 + grp;
            float x[4]; UNP4(C.dq[ps], x);
            float sq = grp16_sum(x[0] * x[0] + x[1] * x[1] + x[2] * x[2] + x[3] * x[3]); float r = rsqrtf(sq * (1.f / 64.f) + EPS);
#pragma unroll
            for (int i = 0; i < 4; ++i) x[i] *= r * (0.125f * LOG2E) * gqd[i];
            if (latent) ROPE4V(x);
            st4bf(Qd + ((size_t)t * 16 + hm) * 64 + q16 * 4, x);
            UNP4(C.dk[ps], x);
            sq = grp16_sum(x[0] * x[0] + x[1] * x[1] + x[2] * x[2] + x[3] * x[3]); r = rsqrtf(sq * (1.f / 64.f) + EPS);
#pragma unroll
            for (int i = 0; i < 4; ++i) x[i] *= r * gkd[i];
            if (latent) ROPE4V(x);
            st4bf(Kd + ((size_t)kr * 16 + hm) * 64 + q16 * 4, x); }
    }
#undef UNP8
#undef UNP4
#undef ROPE4V
}
__device__ __forceinline__ void qkv_odd_rows(const Ctx& F, CParams& P, int e, int t_first, int t_end, int t_stride) {
    const bf16_t* P1 = (const bf16_t*)(F.ws + WS_P1);
    bf16_t* Qc = (bf16_t*)(F.ws + WS_Q1); bf16_t* Kc = (bf16_t*)(F.ws + WS_K1); bf16_t* Vc = (bf16_t*)(F.ws + WS_V1);
    const float* t32 = (const float*)(F.ws + WS_TAB32);
    const int lane = fresh_lane();
    const int q16 = lane & 15, grp = lane >> 4;
    float gq[8], gk[8];
#pragma unroll
    for (int i = 0; i < 8; ++i) { gq[i] = P.g_qn_c[e * 128 + q16 * 8 + i]; gk[i] = P.g_kn_c[e * 128 + q16 * 8 + i]; }
    if (t_first >= t_end) return;
    struct Raw { u32x4 x[5]; f32x4 rc[4]; };
    auto load_raw = [&](int t, Raw& R) {
        const bf16_t* p1 = P1 + (size_t)t * C_IN;
#pragma unroll
        for (int ps = 0; ps < 5; ++ps) { const bool isq = ps < 4; const int h = isq ? ps * 4 + grp : grp; R.x[ps] = *(const u32x4*)(p1 + (isq ? 0 : 2048) + h * 128 + q16 * 8); }
        const int s_ = t & (SEQ - 1), pos_ = (q16 >> 3) ? (s_ & 63) : (s_ >> 6); const float* tp = t32 + (pos_ * 32 + (q16 & 3) * 8) * 2;
#pragma unroll
        for (int q = 0; q < 4; ++q) R.rc[q] = *(const f32x4*)(tp + q * 4);
    };
    Raw R; load_raw(t_first, R);
    for (int t = t_first; t < t_end; t += t_stride) {
        const bool latent = t < TL; const int kr = krow_of(t);
        Raw C = R; { const int tn = t + t_stride; load_raw(tn < t_end ? tn : t, R); }
        const bool rfirst = (q16 & 7) < 4;
#pragma unroll
        for (int ps = 0; ps < 5; ++ps) {
            const bool isq = ps < 4; const int h = isq ? ps * 4 + grp : grp;
            float x[8]; { const u32x4 w = C.x[ps]; x[0] = bf_lo(w.x); x[1] = bf_hi(w.x); x[2] = bf_lo(w.y); x[3] = bf_hi(w.y); x[4] = bf_lo(w.z); x[5] = bf_hi(w.z); x[6] = bf_lo(w.w); x[7] = bf_hi(w.w); }
            float sq = 0.f;
#pragma unroll
            for (int i = 0; i < 8; ++i) sq += x[i] * x[i];
            sq = grp16_sum(sq); const float r = rsqrtf(sq * (1.f / 128.f) + EPS);
#pragma unroll
            for (int i = 0; i < 8; ++i) x[i] *= r * (isq ? gq[i] * (0.08838834764831845f * LOG2E) : gk[i]);
            if (latent) {
#pragma unroll
                for (int q = 0; q < 4; ++q)
#pragma unroll
                    for (int s2 = 0; s2 < 2; ++s2) { const int e = q * 2 + s2; const float cs = C.rc[q][s2 * 2], sn = C.rc[q][s2 * 2 + 1]; const float p = swz_xor<4>(x[e]); x[e] = rfirst ? x[e] * cs - p * sn : p * sn + x[e] * cs; } }
            st8bf(isq ? Qc + ((size_t)t * 16 + h) * 128 + q16 * 8 : Kc + ((size_t)kr * 4 + h) * 128 + q16 * 8, x); }
    }
}

template <int DQK, int SDEPTH, int ldo, int NH, int NKVH, int NVH>
__device__ __forceinline__ void attn_phase(const Ctx& F, const bf16_t* Qbuf, const bf16_t* Kbuf, const bf16_t* Vbuf, bf16_t* OF, int ocol0, bool with_ctx, const float bound  ) {
    const bool nomax = bound < 60.f;
    const float negMC = 0.f;
    constexpr int kv_div = NH / NKVH, v_div = NH / NVH;
    const int n_lat = NH * NB * 32, n_tot = n_lat + (with_ctx ? NH * NB : 0);
    constexpr int ldq = NH * DQK, ldk = NKVH * DQK, ldv = NVH * 128;
    for (int u = F.vcu; u < n_tot; u += F.G) {
        int b, h, qrow0, kstart, seq;
        if (u < n_lat) { const int bh = u >> 5, qb = u & 31; b = bh / NH; h = bh % NH; qrow0 = b * SEQ + qb * 256; kstart = b * KPB; seq = KPB; }
        else { const int bh = u - n_lat; b = bh / NH; h = bh % NH; qrow0 = TL + b * CTXL; kstart = b * KPB + SEQ; seq = CTXL; }
        const bf16_t* Qp = Qbuf + ((size_t)qrow0 * NH + h) * DQK;
        const bf16_t* Kp = Kbuf + ((size_t)kstart * NKVH + h / kv_div) * DQK;
        const bf16_t* Vp = Vbuf + ((size_t)kstart * NVH + h / v_div) * 128;
        bf16_t* Op = OF + (size_t)qrow0 * ldo + ocol0 + h * 128;
        if constexpr (SDEPTH == 0) att::attn_body_simple<DQK, (DQK == 192 ? MLA_QL : 0), ldq, ldk, ldv, ldo>(Qp, Kp, Vp, Op, seq, F.lds, F.wid);
        else { if (nomax) att::attn_body<DQK, SDEPTH, (DQK == 192 ? MLA_QL : (DQK == 128 ? GQA_QL : 0)), true, ldq, ldk, ldv, ldo>(Qp, Kp, Vp, Op, seq, F.lds, F.wid, negMC);
               else att::attn_body_simple<DQK, 0, ldq, ldk, ldv, ldo>(Qp, Kp, Vp, Op, seq, F.lds, F.wid); }
    }
}

__device__ __forceinline__ void merge_even_phase(const Ctx& F, CParams& P, int e, int layer, int m_rows) {
    const bf16_t* OD = (const bf16_t*)(F.ws + WS_OF); bf16_t* AO = (bf16_t*)(F.ws + WS_AO);
    const float lam = ((const float*)(F.ws + WS_LAM))[e];
    const float lam_init = 0.8f - 0.6f * expf(-0.3f * (float)layer);
    const int q16 = F.lane & 15, grp = F.lane >> 4;
    float gs[8];
#pragma unroll
    for (int i = 0; i < 8; ++i) gs[i] = P.g_sub_b[e * 128 + q16 * 8 + i] * (1.f - lam_init);
    for (int t = F.vcu * 8 + F.wid; t < m_rows; t += F.G * 8) {
        const bf16_t* od = OD + (size_t)t * DM; bf16_t* ao = AO + (size_t)t * DM + 1024;
#pragma unroll
        for (int ps = 0; ps < 2; ++ps) { const int h = ps * 4 + grp;
            float o0[8], o1[8], d[8]; ld8bf(od + (2 * h) * 128 + q16 * 8, o0); ld8bf(od + (2 * h + 1) * 128 + q16 * 8, o1);
            float sq = 0.f;
#pragma unroll
            for (int i = 0; i < 8; ++i) { d[i] = o0[i] - lam * o1[i]; sq += d[i] * d[i]; }
            sq = grp16_sum(sq); const float r = rsqrtf(sq * (1.f / 128.f) + EPS);
#pragma unroll
            for (int i = 0; i < 8; ++i) d[i] *= r * gs[i];
            st8bf(ao + h * 128 + q16 * 8, d); }
    }
}

__device__ __forceinline__ void wave_lds_fence() { asm volatile("s_waitcnt lgkmcnt(0)" ::: "memory"); __builtin_amdgcn_wave_barrier(); asm volatile("" ::: "memory"); }
__device__ __forceinline__ unsigned fkey(float f) { const unsigned b = __float_as_uint(f); return b ^ ((unsigned)((int)b >> 31) | 0x80000000u); }
__device__ __forceinline__ float funkey(unsigned k) { return __uint_as_float((k & 0x80000000u) ? (k ^ 0x80000000u) : ~k); }
__device__ __forceinline__ unsigned umed3(unsigned a, unsigned b, unsigned c) { unsigned r; asm("v_med3_u32 %0, %1, %2, %3" : "=v"(r) : "v"(a), "v"(b), "v"(c)); return r; }
__device__ __forceinline__ void kins16(unsigned (&L)[16], unsigned k) {
#pragma unroll
    for (int p = 15; p >= 1; --p) L[p] = umed3(L[p - 1], L[p], k);
    L[0] = L[0] > k ? L[0] : k;
}
__device__ __forceinline__ void scan_set(unsigned (&L)[16], const bf16_t* qbase  , const bf16_t* kbase  , float* buf, int lane) {
    const int r32 = lane & 31, hi = lane >> 5;
#pragma unroll
    for (int p = 0; p < 16; ++p) L[p] = 0u;
    bf16x8 a0[8], a1[8];
    { const bf16_t* ap = qbase + (size_t)r32 * DM + hi * 8;
#pragma unroll
      for (int ks = 0; ks < 8; ++ks) { a0[ks] = *(const bf16x8*)(ap + ks * 16); a1[ks] = *(const bf16x8*)(ap + (size_t)32 * DM + ks * 16); } }
#pragma unroll 1
    for (int kb = 0; kb < 4; ++kb) {
        f32x16 acc0 = {}, acc1 = {};
        { const bf16_t* bp = kbase + (size_t)(kb * 32 + r32) * 128 + hi * 8;
          bf16x8 b[8];
#pragma unroll
          for (int ks = 0; ks < 8; ++ks) b[ks] = *(const bf16x8*)(bp + ks * 16);
#pragma unroll
          for (int ks = 0; ks < 8; ++ks) { acc0 = __builtin_amdgcn_mfma_f32_32x32x16_bf16(a0[ks], b[ks], acc0, 0, 0, 0); acc1 = __builtin_amdgcn_mfma_f32_32x32x16_bf16(a1[ks], b[ks], acc1, 0, 0, 0); } }
        wave_lds_fence();
#pragma unroll
        for (int r = 0; r < 16; ++r) { const int rowi = att::crow(r, hi); buf[rowi * 33 + r32] = acc0[r]; buf[(32 + rowi) * 33 + r32] = acc1[r]; }
        wave_lds_fence();
        const unsigned tb = 127u - (unsigned)(kb * 32);
#pragma unroll 8
        for (int k = 0; k < 32; ++k) kins16(L, (fkey(buf[lane * 33 + k]) & ~127u) | (tb - (unsigned)k));
    }
}
__device__ __forceinline__ void peer_select_unit(const Ctx& F, int layer, int u) {
    const bf16_t* PQ = (const bf16_t*)(F.ws + WS_PQ); const bf16_t* SK = (const bf16_t*)(F.ws + WS_SUBK) + (size_t)layer * 8 * 2 * 128 * 128;
    int* PIDX = (int*)(F.ws + WS_PIDX); float* PG = (float*)(F.ws + WS_PG);
    float* buf = (float*)F.lds + F.wid * (64 * 33);
    const int lane = fresh_lane();
    {
        const int tile = u >> 3, h = u & 7, t0 = tile * 64;
        unsigned Ka[16], Kb[16];
        scan_set(Ka, PQ + (size_t)t0 * DM + h * 256, SK + (size_t)(h * 2) * 128 * 128, buf, lane);
        scan_set(Kb, PQ + (size_t)t0 * DM + h * 256 + 128, SK + (size_t)(h * 2 + 1) * 128 * 128, buf, lane);
        wave_lds_fence();
        float la[16], lb[16];
#pragma unroll
        for (int p = 0; p < 16; ++p) { la[p] = funkey(Ka[p] & ~127u); lb[p] = funkey(Kb[p] & ~127u);
            buf[lane * 33 + p] = __int_as_float(127 - (int)(Ka[p] & 127u)); buf[lane * 33 + 16 + p] = __int_as_float(127 - (int)(Kb[p] & 127u)); }
        wave_lds_fence();
        unsigned Kc[16];
#pragma unroll
        for (int p = 0; p < 16; ++p) Kc[p] = 0u;
#pragma unroll
        for (int r1 = 0; r1 < 16; ++r1)
#pragma unroll
            for (int r2 = 0; r2 < 16; ++r2) if ((r1 + 1) * (r2 + 1) <= 16) kins16(Kc, (fkey(la[r1] + lb[r2]) & ~255u) | (unsigned)(255 - (16 * r1 + r2)));
        float bv[16], sm = 0.f; unsigned idx[16];
#pragma unroll
        for (int p = 0; p < 16; ++p) { const int code = 255 - (int)(Kc[p] & 255u); bv[p] = funkey(Kc[p] & ~255u);
            idx[p] = (unsigned)(__float_as_int(buf[lane * 33 + (code >> 4)]) * 128 + __float_as_int(buf[lane * 33 + 16 + (code & 15)])); }
        const float bmax = bv[0];
#pragma unroll
        for (int p = 0; p < 16; ++p) { bv[p] = __expf(bv[p] - bmax); sm += bv[p]; }
        const float inv = 1.f / sm;
        const size_t o = ((size_t)(t0 + lane) * 8 + h) * 16;
#pragma unroll
        for (int q = 0; q < 4; ++q) { *(f32x4*)(PG + o + q * 4) = (f32x4){bv[q * 4] * inv, bv[q * 4 + 1] * inv, bv[q * 4 + 2] * inv, bv[q * 4 + 3] * inv};
            *(u32x4*)(PIDX + o + q * 4) = (u32x4){idx[q * 4], idx[q * 4 + 1], idx[q * 4 + 2], idx[q * 4 + 3]}; }
    }
}
__device__ __forceinline__ bool ctx_sel_hidden(const Ctx& F) { return F.G == 256; }
__device__ __forceinline__ void peer_select_phase(const Ctx& F, int layer, int m_rows) {
    const int nunits = ((ctx_sel_hidden(F) ? TL : m_rows) / 64) * 8;
#pragma unroll 1
    for (int u = F.vcu * 8 + F.wid; u < nunits; u += F.G * 8) peer_select_unit(F, layer, u);
}

__device__ __forceinline__ float gelu_tanh(float a) { const float u = 0.7978845608028654f * (a + 0.044715f * a * a * a); const float t = 1.f - 2.f / (1.f + __expf(2.f * u)); return 0.5f * a * (1.f + t); }
struct Row6 { u32x2 r[3]; };
__device__ __forceinline__ void ld_row6(Row6& R, const unsigned char* tab, int e, int lane) {
    const unsigned char* rb = tab + (size_t)e * EROW;
    const u32x4 a = *(const u32x4*)(rb + (unsigned)lane * 16u); const u32x2 b = *(const u32x2*)(rb + 1024 + (unsigned)lane * 8u);
    R.r[0] = (u32x2){a.x, a.y}; R.r[1] = (u32x2){a.z, a.w}; R.r[2] = b;
}
__device__ __forceinline__ v32f dq_row6(const Row6& R, float dep) { unsigned r0 = R.r[0].x; asm volatile("" : "+v"(r0) : "v"(dep));
    const v6u w = {r0, R.r[0].y, R.r[1].x, R.r[1].y, R.r[2].x, R.r[2].y}; return __builtin_amdgcn_cvt_scalef32_pk32_f32_fp6(w, 1.0f); }
__device__ __forceinline__ float dot_row6(const Row6& R, const float (&h)[32], float& chain) {
    const v32f f = dq_row6(R, chain);
    float s0 = 0.f, s1 = 0.f, s2 = 0.f, s3 = 0.f;
#pragma unroll
    for (int i = 0; i < 8; ++i) { s0 = fmaf(f[i * 4 + 0], h[i * 4 + 0], s0); s1 = fmaf(f[i * 4 + 1], h[i * 4 + 1], s1); s2 = fmaf(f[i * 4 + 2], h[i * 4 + 2], s2); s3 = fmaf(f[i * 4 + 3], h[i * 4 + 3], s3); }
    const float s = (s0 + s1) + (s2 + s3);
    chain = s;
    return s;
}
__device__ __forceinline__ void fma_row6(float (&out)[32], const Row6& R, float w) {
    const v32f f = dq_row6(R, out[0]);
#pragma unroll
    for (int i = 0; i < 32; ++i) out[i] = fmaf(w, f[i], out[i]);
}
__device__ __forceinline__ float reduce4(float s0, float s1, float s2, float s3, int lane) {
    const bool hi = (lane & 32) != 0, b4 = (lane & 16) != 0;
    const float r0 = xor32_partner(hi ? s0 : s2, lane), r1 = xor32_partner(hi ? s1 : s3, lane);
    const float a0 = (hi ? s2 : s0) + r0, a1 = (hi ? s3 : s1) + r1;
    const float r = swz_xor<16>(b4 ? a0 : a1);
    float b = (b4 ? a1 : a0) + r;
    b += swz_xor<8>(b); b += swz_xor<4>(b); b += swz_xor<2>(b); b += swz_xor<1>(b);
    return b;
}
__device__ __forceinline__ float rl_f(float v, int l) { return __uint_as_float(__builtin_amdgcn_readlane(__float_as_uint(v), l)); }
__device__ __forceinline__ void wr_lane(float& dst, float val_uniform, int lane_uniform, int lane) { asm volatile("" : "+s"(lane_uniform)); dst = (lane == lane_uniform) ? val_uniform : dst; }
__device__ __forceinline__ void peer_expert_tokens(const Ctx& F, CParams& P, int layer, int m_rows_all, bool last, bool dry, bool hide, unsigned* selflag, int k_lo, int k_hi) {
    const unsigned char* EU = F.ws + WS_EU + (size_t)layer * NEXP * EROW; const unsigned char* EV = F.ws + WS_EV + (size_t)layer * NEXP * EROW;
    const float* SU = (const float*)(F.ws + WS_SU) + (size_t)layer * NEXP; const float* SV = (const float*)(F.ws + WS_SV) + (size_t)layer * NEXP;
    const bf16_t* H = (const bf16_t*)(F.ws + WS_H); float* X = (float*)(F.ws + WS_X);
    const int* PIDX = (const int*)(F.ws + WS_PIDX); const float* PG = (const float*)(F.ws + WS_PG);
    const float* mod = (const float*)(F.ws + WS_MOD) + (size_t)layer * 3 * 12288;
    const int lane = fresh_lane();
    const int tstride = F.G * 8, t0 = F.vcu * 8 + F.wid + k_lo * tstride;
    const int m_hi = F.vcu * 8 + F.wid + k_hi * tstride, m_rows = m_hi < m_rows_all ? m_hi : m_rows_all;
    if (t0 >= m_rows) return;
    int id0 = PIDX[(size_t)t0 * 128 + lane], id1 = PIDX[(size_t)t0 * 128 + 64 + lane];
    u32x2 hp4[8]; float gk0, gk1;
    { const bf16_t* hp = H + (size_t)t0 * DM + (unsigned)lane * 4u;
#pragma unroll
      for (int j = 0; j < 8; ++j) hp4[j] = *(const u32x2*)(hp + j * 256); }
    gk0 = PG[(size_t)t0 * 128 + lane]; gk1 = PG[(size_t)t0 * 128 + 64 + lane];
    Row6 A[4], B[4];
#pragma unroll
    for (int q = 0; q < 4; ++q) ld_row6(A[q], EU, __builtin_amdgcn_readlane(id0, q), lane);
    for (int t = t0; t < m_rows; t += tstride) {
        const int tn = t + tstride; const int tq = tn < m_rows ? tn : t;
        float hf[32];
#pragma unroll
        for (int j = 0; j < 8; ++j) { hf[j * 4 + 0] = bf_lo(hp4[j].x); hf[j * 4 + 1] = bf_hi(hp4[j].x); hf[j * 4 + 2] = bf_lo(hp4[j].y); hf[j * 4 + 3] = bf_hi(hp4[j].y); }
        const float cgk0 = gk0, cgk1 = gk1;
        const float su0 = SU[id0], sv0 = SV[id0], su1 = SU[id1], sv1 = SV[id1];
        int nid0, nid1; float ngk0, ngk1;
        if (hide && tq >= TL) {
            { unsigned sp = 0u; while (xb_ld(selflag) < (unsigned)((TT - TL) / 64 * 8)) { __builtin_amdgcn_s_sleep(1); if (++sp > XB_SPIN_CAP) break; } }
            __builtin_amdgcn_fence(__ATOMIC_ACQUIRE, "agent");
            nid0 = __hip_atomic_load(PIDX + (size_t)tq * 128 + lane, __ATOMIC_RELAXED, __HIP_MEMORY_SCOPE_AGENT); nid1 = __hip_atomic_load(PIDX + (size_t)tq * 128 + 64 + lane, __ATOMIC_RELAXED, __HIP_MEMORY_SCOPE_AGENT);
            ngk0 = __int_as_float(__hip_atomic_load((const int*)PG + (size_t)tq * 128 + lane, __ATOMIC_RELAXED, __HIP_MEMORY_SCOPE_AGENT)); ngk1 = __int_as_float(__hip_atomic_load((const int*)PG + (size_t)tq * 128 + 64 + lane, __ATOMIC_RELAXED, __HIP_MEMORY_SCOPE_AGENT));
        } else { nid0 = PIDX[(size_t)tq * 128 + lane]; nid1 = PIDX[(size_t)tq * 128 + 64 + lane]; ngk0 = PG[(size_t)tq * 128 + lane]; ngk1 = PG[(size_t)tq * 128 + 64 + lane]; }
        { const bf16_t* hp = H + (size_t)tq * DM + (unsigned)lane * 4u;
#pragma unroll
          for (int j = 0; j < 8; ++j) hp4[j] = *(const u32x2*)(hp + j * 256); }
        gk0 = ngk0; gk1 = ngk1;
        float wv0 = 0.f, wv1 = 0.f;
        float out[32];
#pragma unroll
        for (int i = 0; i < 32; ++i) out[i] = 0.f;
#pragma unroll
        for (int seg = 0; seg < 4; ++seg) {
            const int idc = (seg & 1) ? id1 : id0;
            const int idn = (seg == 0) ? id1 : (seg == 1 ? id0 : (seg == 2 ? id1 : nid0));
            const unsigned char* tabc = seg < 2 ? EU : EV; const unsigned char* tabn = (seg == 0 || seg == 3) ? EU : EV;
            const float wr = (seg & 1) ? wv1 : wv0;
            float acc = 0.f, chain = 0.f;
#pragma unroll 1
            for (int k = 0; k < 64; k += 8) {
#pragma unroll
                for (int q = 0; q < 4; ++q) ld_row6(B[q], tabc, __builtin_amdgcn_readlane(idc, k + 4 + q), lane);
                if (seg < 2) { const float d0 = dot_row6(A[0], hf, chain), d1 = dot_row6(A[1], hf, chain), d2 = dot_row6(A[2], hf, chain), d3 = dot_row6(A[3], hf, chain); const float b = reduce4(d0, d1, d2, d3, lane);
#pragma unroll
                    for (int q = 0; q < 4; ++q) wr_lane(acc, rl_f(b, 16 * q), k + q, lane); }
                else {
#pragma unroll
                    for (int q = 0; q < 4; ++q) fma_row6(out, A[q], rl_f(wr, k + q)); }
                { const bool nx = k + 8 >= 64;
#pragma unroll
                  for (int q = 0; q < 4; ++q) { const int ec = __builtin_amdgcn_readlane(idc, (k + 8 + q) & 63), en = __builtin_amdgcn_readlane(idn, q);
                      ld_row6(A[q], nx ? tabn : tabc, nx ? en : ec, lane); } }
                if (seg < 2) { const float d0 = dot_row6(B[0], hf, chain), d1 = dot_row6(B[1], hf, chain), d2 = dot_row6(B[2], hf, chain), d3 = dot_row6(B[3], hf, chain); const float b = reduce4(d0, d1, d2, d3, lane);
#pragma unroll
                    for (int q = 0; q < 4; ++q) wr_lane(acc, rl_f(b, 16 * q), k + 4 + q, lane); }
                else {
#pragma unroll
                    for (int q = 0; q < 4; ++q) fma_row6(out, B[q], rl_f(wr, k + 4 + q)); }
            }
            if (seg == 0) wv0 = cgk0 * gelu_tanh(acc * su0) * sv0;
            if (seg == 1) wv1 = cgk1 * gelu_tanh(acc * su1) * sv1;
        }
        id0 = nid0; id1 = nid1;
        const int vs = vsel_of_row(t);
        const float* gate = mod + (size_t)vs * 12288 + 5 * DM;
        float* xr = X + (size_t)t * DM; float* dst = dry ? (float*)(F.ws + WS_OF) + (size_t)t * DM : (last ? P.out + (size_t)t * DM : xr);
        float ssq = 0.f;
        const unsigned lo4 = (unsigned)lane * 4u;
        { f32x4 xo[8], gg[8];
#pragma unroll
          for (int q = 0; q < 8; ++q) { const unsigned c = lo4 + q * 256; xo[q] = *(const f32x4*)(xr + c); gg[q] = *(const f32x4*)(gate + c); }
#pragma unroll
          for (int q = 0; q < 8; ++q) { const unsigned c = lo4 + q * 256;
            f32x4 y; y[0] = xo[q][0] + gg[q][0] * out[q * 4 + 0]; y[1] = xo[q][1] + gg[q][1] * out[q * 4 + 1]; y[2] = xo[q][2] + gg[q][2] * out[q * 4 + 2]; y[3] = xo[q][3] + gg[q][3] * out[q * 4 + 3];
            *(f32x4*)(dst + c) = y;
            out[q * 4 + 0] = y[0]; out[q * 4 + 1] = y[1]; out[q * 4 + 2] = y[2]; out[q * 4 + 3] = y[3];
            ssq += y[0] * y[0] + y[1] * y[1] + y[2] * y[2] + y[3] * y[3]; } }
        if (!last && !dry) {
            const float rstd = rsqrtf(wave_sum(ssq) * (1.f / DM) + EPS);
            const float* gn = P.g_norm1 + (size_t)(layer + 1) * DM;
            const float* shf = mod + (size_t)3 * 12288 + (size_t)vs * 12288; const float* scl = shf + DM;
            bf16_t* hrow = (bf16_t*)(F.ws + WS_H) + (size_t)t * DM;
#pragma unroll
            for (int jh = 0; jh < 2; ++jh) { f32x4 g8[4], sc8[4], sh8[4];
#pragma unroll
                for (int i = 0; i < 4; ++i) { const unsigned c = lo4 + (jh * 4 + i) * 256; g8[i] = *(const f32x4*)(gn + c); sc8[i] = *(const f32x4*)(scl + c); sh8[i] = *(const f32x4*)(shf + c); }
#pragma unroll
                for (int i = 0; i < 4; ++i) { const int qg = jh * 4 + i; const f32x4 g = g8[i], sc = sc8[i], sh = sh8[i];
                    float y[4];
#pragma unroll
                    for (int e2 = 0; e2 < 4; ++e2) y[e2] = (out[qg * 4 + e2] * rstd * g[e2]) * (1.f + sc[e2]) + sh[e2];
                    u32x2 w; w.x = cvt_pk_bf16(y[0], y[1]); w.y = cvt_pk_bf16(y[2], y[3]);
                    *(u32x2*)(hrow + lo4 + qg * 256) = w; } }
        }
    }
}

__device__ __forceinline__ void ctl_wait(unsigned* c, unsigned want) { unsigned sp = 0u; while (xb_ld(c) < want) { __builtin_amdgcn_s_sleep(1); if (++sp > XB_SPIN_CAP) break; } }
__device__ __forceinline__ void peer_expert_phase(const Ctx& F, CParams& P, int layer, int m_rows, bool last, bool dry, LAS unsigned char* ldsl, const bf16_t* Wout) {
    const bool hide = ctx_sel_hidden(F) && m_rows > TL && !dry;
    unsigned* ctl = (unsigned*)(F.ws + WS_CTL) + 8192 + layer * 512;
    unsigned* selflag = ctl;
    int role = 0, ri = 0;
    if (hide && F.vcu >= 64) { const int d = F.vcu - 64;
        if (d % 12 == 0) { role = 1; ri = d / 12; } else if (d % 12 == 6) { role = 2; ri = d / 12; } else if (d % 3 == 1 && F.wid == 0) { role = 3; ri = d / 3; } }
    const int ksplit = role == 1 ? 0 : (role == 2 ? 1 : (role == 3 ? 2 : 9));
#pragma unroll 1
    for (int st = 0; st < 2; ++st) {
        const int kb = st == 0 ? 0 : ksplit, ke = st == 0 ? ksplit : 9;
        if (ke > kb) peer_expert_tokens(F, P, layer, m_rows, last, dry, hide, selflag, kb, ke);
        if (st != 0 || role == 0) continue;
        const int pmi = ri >> 3, pn = ri & 7, pm = TL / 256 + pmi;
        if (role == 1) {
            { pg8::Gemm g{(const bf16_t*)(F.ws + WS_AO), Wout, TT, DM, DM, DM}; pg8::OneUnit S{pm, pn};
              pg8::EpiResid E{(float*)(F.ws + WS_X), (const float*)(F.ws + WS_MOD) + (size_t)layer * 3 * 12288, 2, layer == 0 ? P.x : (const float*)(F.ws + WS_X), layer == 0 ? P.ctx : (const float*)(F.ws + WS_X) + (size_t)TL * DM};
              pg8::gemm_phase<pg8::EpiResid, pg8::OneUnit>(ldsl, g, S, E, F.wid); }
            asm volatile("s_waitcnt vmcnt(0)" ::: "memory"); __syncthreads();
            if (F.wid == 0 && fresh_lane() == 0) { __builtin_amdgcn_fence(__ATOMIC_RELEASE, "agent"); asm volatile("s_waitcnt vmcnt(0)" ::: "memory"); (void)xb_add(ctl + 64 + 64 * pmi, 1u);
                           ctl_wait(ctl + 64 + 64 * pmi, 8u); __builtin_amdgcn_fence(__ATOMIC_ACQUIRE, "agent"); }
            __syncthreads();
            { const int r0 = pm * 256 + pn * 32 + F.wid * 4; norm_rows(F, P, layer, 1, r0, r0 + 4, 1); }
            asm volatile("s_waitcnt vmcnt(0)" ::: "memory"); __syncthreads();
            if (F.wid == 0 && fresh_lane() == 0) { __builtin_amdgcn_fence(__ATOMIC_RELEASE, "agent"); asm volatile("s_waitcnt vmcnt(0)" ::: "memory"); (void)xb_add(ctl + 192 + 64 * pmi, 1u); }
        } else if (role == 2) {
            __syncthreads();
            if (F.wid == 0 && fresh_lane() == 0) { ctl_wait(ctl + 192 + 64 * pmi, 8u); __builtin_amdgcn_fence(__ATOMIC_ACQUIRE, "agent"); }
            __syncthreads();
            { pg8::Gemm g{(const bf16_t*)(F.ws + WS_H), (const bf16_t*)(F.ws + WS_WPQ) + (size_t)layer * DM * DM, TT, DM, DM, DM}; pg8::OneUnit S{pm, pn};
              pg8::EpiBf16 E{(bf16_t*)(F.ws + WS_PQ), DM};
              pg8::gemm_phase<pg8::EpiBf16, pg8::OneUnit>(ldsl, g, S, E, F.wid); }
            asm volatile("s_waitcnt vmcnt(0)" ::: "memory"); __syncthreads();
            if (F.wid == 0 && fresh_lane() == 0) { __builtin_amdgcn_fence(__ATOMIC_RELEASE, "agent"); asm volatile("s_waitcnt vmcnt(0)" ::: "memory"); (void)xb_add(ctl + 320, 1u); }
        } else {
            ctl_wait(ctl + 320, 16u); __builtin_amdgcn_fence(__ATOMIC_ACQUIRE, "agent");
            peer_select_unit(F, layer, (TL / 64) * 8 + ri);
            __builtin_amdgcn_fence(__ATOMIC_RELEASE, "agent");
            asm volatile("s_waitcnt vmcnt(0)" ::: "memory");
            if (fresh_lane() == 0) (void)xb_add(selflag, 1u);
        }
    }
}

__device__ __forceinline__ void qkv_odd_phase(const Ctx& F, CParams& P, int e, int layer, LAS unsigned char* ldsl) {
    if (!ctx_sel_hidden(F)) { qkv_odd_rows(F, P, e, F.vcu * 8 + F.wid, TT, F.G * 8); return; }
    const int vx = F.vcu & 31, xq = F.vcu >> 5;
    if (vx >= 29) {
        const int i = xq * 3 + vx - 29, pmi = i / 12, pn = i % 12;
        unsigned* cnt = (unsigned*)(F.ws + WS_CTL) + 8192 + layer * 512 + 384 + 64 * pmi;
        { pg8::Gemm g{(const bf16_t*)(F.ws + WS_H), (const bf16_t*)(F.ws + WS_WINC) + (size_t)e * C_IN * DM, TT, C_IN, DM, DM}; pg8::OneUnit S{TL / 256 + pmi, pn};
          pg8::EpiBf16V E{(bf16_t*)(F.ws + WS_P1), C_IN, (bf16_t*)(F.ws + WS_V1), 10, 512};
          pg8::gemm_phase<pg8::EpiBf16V, pg8::OneUnit>(ldsl, g, S, E, F.wid); }
        asm volatile("s_waitcnt vmcnt(0)" ::: "memory"); __syncthreads();
        if (F.wid == 0 && fresh_lane() == 0) { __builtin_amdgcn_fence(__ATOMIC_RELEASE, "agent"); asm volatile("s_waitcnt vmcnt(0)" ::: "memory"); (void)xb_add(cnt, 1u);
                                               ctl_wait(cnt, 12u); __builtin_amdgcn_fence(__ATOMIC_ACQUIRE, "agent"); }
        __syncthreads();
        qkv_odd_rows(F, P, e, TL + pmi * 256 + pn * 8 + F.wid, TL + pmi * 256 + 256, 96);
    } else qkv_odd_rows(F, P, e, (F.vcu - 3 * xq) * 8 + F.wid, TL, 232 * 8);
}

constexpr int N_PHASES = 1 + 2 * 11 + 2 * 9 - 3;
__global__ void __launch_bounds__(512, 2) mk_fwd(Params Pval) {
    extern __shared__ __attribute__((aligned(16))) unsigned char lds_raw[];
    LAS unsigned char* ldsl = (LAS unsigned char*)lds_raw;
    volatile LAS unsigned* misc = (volatile LAS unsigned*)(ldsl + LDS_MISC);
    if (threadIdx.x < 16) misc[threadIdx.x] = 0u;
    __syncthreads();
    XcdBarrier bar = xcd_barrier_post((unsigned*)(Pval.ws + WS_CTL) + 1024, misc);
    const int wid0 = __builtin_amdgcn_readfirstlane((int)threadIdx.x >> 6);
    const int lo = Pval.ph_lo, hi = Pval.ph_hi; int ph = 0;
#define MKCTX() Ctx F; { const int lane_ = fresh_lane(); int wid_ = wid0; asm volatile("" : "+s"(wid_)); const int tid_ = wid_ * 64 + lane_; F.tid = tid_; F.lane = lane_; F.wid = wid_; \
        int G_ = gridDim.x, bx_ = blockIdx.x; asm volatile("" : "+s"(G_), "+s"(bx_)); F.G = G_; F.vcu = (G_ % 8 == 0) ? (bx_ % 8) * (G_ / 8) + bx_ / 8 : bx_; F.bx = bx_; } \
        unsigned long long kp_ = (unsigned long long)__builtin_amdgcn_kernarg_segment_ptr(); asm volatile("" : "+s"(kp_)); CParams& P = *(CParams*)kp_; \
        F.ws = P.ws; F.lds = (char*)lds_raw; unsigned char* ws = F.ws; (void)ws; \
        bf16_t* Hb = (bf16_t*)(ws + WS_H); bf16_t* P1 = (bf16_t*)(ws + WS_P1); float* X = (float*)(ws + WS_X); const float* mod = (const float*)(ws + WS_MOD); (void)Hb; (void)P1; (void)X; (void)mod;
#define PHASE(cls, ...) do { if (ph >= lo && ph < hi) { if constexpr ((PH_MASK >> (cls)) & 1u) { \
        if constexpr ((PH_DOUBLE >> (cls)) & 1u) { const bool dry = true; (void)dry; MKCTX(); __VA_ARGS__; __syncthreads(); } \
        { const bool dry = false; (void)dry; MKCTX(); __VA_ARGS__; } } if (ph + 1 < hi) { int w0_ = wid0; asm volatile("" : "+s"(w0_)); xcd_barrier(bar, w0_ == 0 && fresh_lane() == 0); } } ++ph; } while (0)

    PHASE(0, prologue_phase(F, P));
#pragma unroll 1
    for (int layer = 0; layer < DEPTH; ++layer) {
        const int e = layer >> 1; const bool even = (layer & 1) == 0, lastl = layer == DEPTH - 1;
        const int m_post = lastl ? TL : TT;
        if (layer == 0) PHASE(1, norm_phase(F, P, layer, 0, TT));
        PHASE(2, { const bf16_t* W = even ? (const bf16_t*)(ws + WS_WINAB) + (size_t)e * AB_INP * DM : (const bf16_t*)(ws + WS_WINC) + (size_t)e * C_IN * DM;
                const int N = even ? AB_INP : C_IN;
                const int m2 = (!even && ctx_sel_hidden(F)) ? TL : TT;
                pg8::Gemm g{Hb, W, m2, N, DM, DM}; pg8::StaticOrder S; S.init(m2, N, F.G, F.bx);
                pg8::EpiBf16V E{P1, N, even ? (bf16_t*)(ws + WS_V2) : (bf16_t*)(ws + WS_V1), even ? 14 : 10, even ? 1024 : 512};
                pg8::gemm_phase<pg8::EpiBf16V, pg8::StaticOrder>(ldsl, g, S, E, F.wid); });
        if (even) {
            PHASE(3, { { pg8::Gemm g{P1, (const bf16_t*)(ws + WS_WUQ) + (size_t)e * 1536 * 768, TT, 1536, 768, AB_INP}; pg8::StaticOrder S; S.init(TT, 1536, F.G, F.bx);
                      pg8::EpiBf16 E{(bf16_t*)(ws + WS_QA), 1536};
                      pg8::gemm_phase<pg8::EpiBf16, pg8::StaticOrder>(ldsl, g, S, E, F.wid); }
                    { pg8::Gemm g{P1 + 768, (const bf16_t*)(ws + WS_WUKV) + (size_t)e * 2048 * 512, TT, 2048, 512, AB_INP}; pg8::StaticOrder S; S.init(TT, 2048, F.G, F.G - 1 - F.bx);
                      pg8::EpiBf16 E{(bf16_t*)(ws + WS_KV), 2048};
                      pg8::gemm_phase<pg8::EpiBf16, pg8::StaticOrder>(ldsl, g, S, E, F.wid); } });
            PHASE(4, qkv_even_phase(F, P, e));
            PHASE(5, { if constexpr (ATT_DBL & 1) attn_phase<192, MLA_SD, 2048, 8, 8, 8>(F, (const bf16_t*)(ws + WS_Q1), (const bf16_t*)(ws + WS_K1), (const bf16_t*)(ws + WS_V1), (bf16_t*)(ws + WS_AO), 0, !lastl, ((const float*)(ws + WS_LAM))[4 + layer * 2]);
                    if constexpr (ATT_DBL & 2) attn_phase<64, 2, 2048, 16, 16, 8>(F, (const bf16_t*)(ws + WS_Q2), (const bf16_t*)(ws + WS_K2), (const bf16_t*)(ws + WS_V2), (bf16_t*)(ws + WS_OF), 0, !lastl, ((const float*)(ws + WS_LAM))[4 + layer * 2 + 1]);
                    if constexpr (ATT_SEL & 1) attn_phase<192, MLA_SD, 2048, 8, 8, 8>(F, (const bf16_t*)(ws + WS_Q1), (const bf16_t*)(ws + WS_K1), (const bf16_t*)(ws + WS_V1), (bf16_t*)(ws + WS_AO), 0, !lastl, ((const float*)(ws + WS_LAM))[4 + layer * 2]);
                    if constexpr (ATT_SEL & 2) attn_phase<64, 2, 2048, 16, 16, 8>(F, (const bf16_t*)(ws + WS_Q2), (const bf16_t*)(ws + WS_K2), (const bf16_t*)(ws + WS_V2), (bf16_t*)(ws + WS_OF), 0, !lastl, ((const float*)(ws + WS_LAM))[4 + layer * 2 + 1]); });
            PHASE(6, merge_even_phase(F, P, e, layer, m_post));
        } else {
            PHASE(7, qkv_odd_phase(F, P, e, layer, ldsl));
            PHASE(8, attn_phase<128, GQA_SD, 2048, 16, 4, 4>(F, (const bf16_t*)(ws + WS_Q1), (const bf16_t*)(ws + WS_K1), (const bf16_t*)(ws + WS_V1), (bf16_t*)(ws + WS_AO), 0, !lastl, ((const float*)(ws + WS_LAM))[4 + layer * 2]));
        }
        PHASE(10, { const bf16_t* W = even ? (const bf16_t*)(ws + WS_WOUTAB) + (size_t)e * DM * DM : (const bf16_t*)(ws + WS_WOUTC) + (size_t)e * DM * DM;
                const int m10 = ctx_sel_hidden(F) ? TL : m_post; pg8::Gemm g{(const bf16_t*)(ws + WS_AO), W, m10, DM, DM, DM}; pg8::StaticOrder S; S.init(m10, DM, F.G, F.bx);
                pg8::EpiResid E{X, mod + (size_t)layer * 3 * 12288, 2, layer == 0 ? P.x : (const float*)X, layer == 0 ? P.ctx : (const float*)X + (size_t)TL * DM};
                pg8::gemm_phase<pg8::EpiResid, pg8::StaticOrder>(ldsl, g, S, E, F.wid); });
        PHASE(1, norm_phase(F, P, layer, 1, ctx_sel_hidden(F) ? TL : m_post));
        PHASE(11, { const int m11 = ctx_sel_hidden(F) ? TL : m_post; pg8::Gemm g{Hb, (const bf16_t*)(ws + WS_WPQ) + (size_t)layer * DM * DM, m11, DM, DM, DM}; pg8::StaticOrder S; S.init(m11, DM, F.G, F.bx);
                pg8::EpiBf16 E{(bf16_t*)(ws + WS_PQ), DM};
                pg8::gemm_phase<pg8::EpiBf16, pg8::StaticOrder>(ldsl, g, S, E, F.wid); });
        PHASE(12, peer_select_phase(F, layer, m_post));
        PHASE(13, { const bf16_t* W = even ? (const bf16_t*)(ws + WS_WOUTAB) + (size_t)e * DM * DM : (const bf16_t*)(ws + WS_WOUTC) + (size_t)e * DM * DM;
                peer_expert_phase(F, P, layer, m_post, lastl, dry, ldsl, W); });
    }
#undef PHASE
}

extern "C" void kernel_launch(void* const* d_in, const int* in_sizes, int n_in, void* d_out, int out_size, void* d_ws, size_t ws_size, hipStream_t stream) {
    static int grid = 0;
    if (grid == 0) {
        if (n_in != 28 || ws_size < WS_END) { fprintf(stderr, "kernel_launch: expected 28 inputs and >= %zu bytes of workspace, got %d / %zu\n", (size_t)WS_END, n_in, ws_size); grid = -1; return; }
        int dev = 0, cus = 0, per_cu = 0;
        if (hipGetDevice(&dev) != hipSuccess || hipDeviceGetAttribute(&cus, hipDeviceAttributeMultiprocessorCount, dev) != hipSuccess) { grid = -1; return; }
        if (hipFuncSetAttribute((const void*)mk_fwd, hipFuncAttributeMaxDynamicSharedMemorySize, LDS_BYTES) != hipSuccess) { fprintf(stderr, "kernel_launch: hipFuncSetAttribute failed\n"); grid = -1; return; }
        if (hipOccupancyMaxActiveBlocksPerMultiprocessor(&per_cu, (const void*)mk_fwd, 512, LDS_BYTES) != hipSuccess || per_cu < 1) fprintf(stderr, "kernel_launch: occupancy query says %d\n", per_cu);
        (void)hipGetLastError();
        grid = cus;
    }
    if (grid < 0) return;
    (void)hipMemsetAsync((char*)d_ws + WS_CTL, 0, CTL_BYTES, stream);
    Params p{};
    const float** pf = (const float**)&p;
    for (int i = 0; i < 28; ++i) pf[i] = (const float*)d_in[i];
    p.out = (float*)d_out; p.ws = (unsigned char*)d_ws;
#if MK_PER_PHASE_LAUNCH
    for (int i = 0; i < N_PHASES; ++i) { p.ph_lo = i; p.ph_hi = i + 1; hipLaunchKernelGGL(mk_fwd, dim3(grid), dim3(512), LDS_BYTES, stream, p); }
#else
    p.ph_lo = 0; p.ph_hi = N_PHASES;
    hipLaunchKernelGGL(mk_fwd, dim3(grid), dim3(512), LDS_BYTES, stream, p);
#endif
    const hipError_t le = hipPeekAtLastError();
    if (le != hipSuccess) fprintf(stderr, "kernel_launch: launch failed: %s\n", hipGetErrorName(le));
}
```

```cpp
#include <hip/hip_runtime.h>
#include <stdint.h>
#include <stdio.h>

#ifndef MK_PER_PHASE_LAUNCH
#define MK_PER_PHASE_LAUNCH 0
#endif

#ifndef MLA_QL
#define MLA_QL 0
#endif
#ifndef GQA_QL
#define GQA_QL 0
#endif
#ifndef QKT_GRP
#define QKT_GRP 12
#endif
#ifndef EB
#define EB 4
#endif
#ifndef PV_PIPE
#define PV_PIPE 0
#endif
#ifndef ATT_DBL
#define ATT_DBL 0
#endif
#ifndef ATT_PRIO
#define ATT_PRIO 1
#endif
#ifndef MLA_SD
#define MLA_SD 1
#endif
#ifndef GQA_SD
#define GQA_SD 2
#endif
#ifndef ATT_SEL
#define ATT_SEL 3
#endif
#ifndef PH_DOUBLE
#define PH_DOUBLE 0u
#endif
#ifndef PH_MASK
#define PH_MASK 0xFFFFFFFFu
#endif
#define LAS __attribute__((address_space(3)))
typedef unsigned short bf16_t;
typedef short bf16x8 __attribute__((ext_vector_type(8)));
typedef short s16x4 __attribute__((ext_vector_type(4)));
typedef float f32x4 __attribute__((ext_vector_type(4)));
typedef float f32x2 __attribute__((ext_vector_type(2)));
typedef float f32x16 __attribute__((ext_vector_type(16)));
typedef unsigned u32x4 __attribute__((ext_vector_type(4)));
typedef unsigned u32x2 __attribute__((ext_vector_type(2)));
typedef __bf16 bf16x2_t __attribute__((ext_vector_type(2)));

constexpr int DM = 2048, NB = 2, SEQ = 8192, DEPTH = 4, CTXL = 256;
constexpr int TL = NB * SEQ;
constexpr int TZ = NB * CTXL;
constexpr int TT = TL + TZ;
constexpr int KPB = SEQ + CTXL;
constexpr int AB_IN = 4416, AB_INP = 4608;
constexpr int C_IN = 3072;
constexpr int NEXP = 16384;
constexpr float EPS = 1e-6f;
constexpr float LOG2E = 1.4426950408889634f;

constexpr size_t al256(size_t x) { return (x + 255) / 256 * 256; }
constexpr size_t WS_CTL = 0, CTL_BYTES = 1u << 20;
constexpr size_t WS_MOD = WS_CTL + CTL_BYTES;
constexpr size_t WS_TAB16 = WS_MOD + al256((size_t)4 * 3 * 12288 * 4);
constexpr size_t WS_TAB32 = WS_TAB16 + al256((size_t)128 * 16 * 2 * 4);
constexpr size_t WS_LAM = WS_TAB32 + al256((size_t)128 * 32 * 2 * 4);
constexpr size_t WS_WINAB = WS_LAM + 256;
constexpr size_t WS_WUQ = WS_WINAB + (size_t)2 * AB_INP * DM * 2;
constexpr size_t WS_WUKV = WS_WUQ + (size_t)2 * 1536 * 768 * 2;
constexpr size_t WS_WOUTAB = WS_WUKV + (size_t)2 * 2048 * 512 * 2;
constexpr size_t WS_WINC = WS_WOUTAB + (size_t)2 * DM * DM * 2;
constexpr size_t WS_WOUTC = WS_WINC + (size_t)2 * C_IN * DM * 2;
constexpr size_t WS_WPQ = WS_WOUTC + (size_t)2 * DM * DM * 2;
constexpr size_t WS_SUBK = WS_WPQ + (size_t)4 * DM * DM * 2;
constexpr size_t WS_EU = WS_SUBK + (size_t)4 * 8 * 2 * 128 * 128 * 2;
constexpr int EROW = DM * 6 / 8;
constexpr size_t WS_EV = WS_EU + (size_t)4 * NEXP * DM;
constexpr size_t WS_SU = WS_EV + (size_t)4 * NEXP * DM;
constexpr size_t WS_SV = WS_SU + (size_t)4 * NEXP * 4;
constexpr size_t WS_X = WS_SV + (size_t)4 * NEXP * 4;
constexpr size_t WS_H = WS_X + (size_t)TT * DM * 4;
constexpr size_t WS_P1 = WS_H + (size_t)TT * DM * 2;
constexpr size_t WS_QA = WS_P1 + (size_t)TT * AB_INP * 2;
constexpr size_t WS_KV = WS_QA + (size_t)TT * 1536 * 2;
constexpr size_t WS_Q1 = WS_KV + (size_t)TT * 2048 * 2;
constexpr size_t WS_K1 = WS_Q1 + (size_t)TT * 2048 * 2;
constexpr size_t WS_V1 = WS_K1 + (size_t)TT * 1536 * 2;
constexpr size_t WS_Q2 = WS_V1 + (size_t)TT * 1024 * 2;
constexpr size_t WS_K2 = WS_Q2 + (size_t)TT * 1024 * 2;
constexpr size_t WS_V2 = WS_K2 + (size_t)TT * 1024 * 2;
constexpr size_t WS_OF = WS_V2 + (size_t)TT * 1024 * 2;
constexpr size_t WS_AO = WS_OF + (size_t)TT * 3072 * 4;
constexpr size_t WS_PQ = WS_AO + (size_t)TT * DM * 2;
constexpr size_t WS_PIDX = WS_PQ + (size_t)TT * DM * 2;
constexpr size_t WS_PG = WS_PIDX + (size_t)TT * 128 * 4;
constexpr size_t WS_END = WS_PG + (size_t)TT * 128 * 4;

constexpr int LDS_MAIN = 157696;
constexpr int LDS_MISC = LDS_MAIN;
constexpr int LDS_BYTES = LDS_MAIN + 4096;

__device__ __forceinline__ unsigned cvt_pk_bf16(float lo, float hi) { unsigned r; asm("v_cvt_pk_bf16_f32 %0, %1, %2" : "=v"(r) : "v"(lo), "v"(hi)); return r; }
__device__ __forceinline__ float bf_lo(unsigned w) { return __uint_as_float(w << 16); }
__device__ __forceinline__ float bf_hi(unsigned w) { return __uint_as_float(w & 0xffff0000u); }
template <int M> __device__ __forceinline__ float swz_xor(float v) { return __int_as_float(__builtin_amdgcn_ds_swizzle(__float_as_int(v), (M << 10) | 0x1f)); }
__device__ __forceinline__ float xor32_partner(float v, int lane) {
    const auto rr = __builtin_amdgcn_permlane32_swap(__float_as_uint(v), __float_as_uint(v), false, false);
    return __uint_as_float(lane < 32 ? rr[1] : rr[0]);
}
__device__ __forceinline__ float hw_sum(float v) {
    v += swz_xor<16>(v); v += swz_xor<8>(v); v += swz_xor<4>(v); v += swz_xor<2>(v); v += swz_xor<1>(v);
    return v;
}
__device__ __forceinline__ float wave_sum(float v) {
    v = hw_sum(v);
    const auto rr = __builtin_amdgcn_permlane32_swap(__float_as_uint(v), __float_as_uint(v), false, false);
    return __uint_as_float(rr[0]) + __uint_as_float(rr[1]);
}
__device__ __forceinline__ float wave_max(float v) {
    v = fmaxf(v, swz_xor<16>(v)); v = fmaxf(v, swz_xor<8>(v)); v = fmaxf(v, swz_xor<4>(v)); v = fmaxf(v, swz_xor<2>(v)); v = fmaxf(v, swz_xor<1>(v));
    const auto rr = __builtin_amdgcn_permlane32_swap(__float_as_uint(v), __float_as_uint(v), false, false);
    return fmaxf(__uint_as_float(rr[0]), __uint_as_float(rr[1]));
}
__device__ __forceinline__ int mbcnt64(unsigned long long m) { return (int)__builtin_amdgcn_mbcnt_hi((unsigned)(m >> 32), __builtin_amdgcn_mbcnt_lo((unsigned)m, 0u)); }
__device__ __forceinline__ int fresh_lane() { int l; asm volatile("v_mbcnt_lo_u32_b32 %0, -1, 0\n\tv_mbcnt_hi_u32_b32 %0, -1, %0" : "=v"(l)); return l; }
__device__ __forceinline__ int krow_of(int t) { return t < TL ? (t >> 13) * KPB + (t & (SEQ - 1)) : ((t - TL) >> 8) * KPB + SEQ + ((t - TL) & (CTXL - 1)); }
__device__ __forceinline__ int vsel_of_row(int t) { return t < SEQ ? 0 : (t < TL ? 1 : 2); }

#define XB_TMO      128
#define XB_XCNT(j)  (256  + 64 * (j))
#define XB_XSUB(j)  (1280 + 64 * (j))
#define XB_XGEN(j)  (2304 + 64 * (j))
#define XB_TOP      3328
#define XB_TOPGEN   3392
#define XCD_BAR_WORDS 3456
#define XB_SPIN_CAP (1u << 27)
__device__ __forceinline__ unsigned xb_ld(unsigned* p)              { return __hip_atomic_load(p, __ATOMIC_RELAXED, __HIP_MEMORY_SCOPE_AGENT); }
__device__ __forceinline__ unsigned xb_add(unsigned* p, unsigned v) { return __hip_atomic_fetch_add(p, v, __ATOMIC_RELAXED, __HIP_MEMORY_SCOPE_AGENT); }
__device__ __forceinline__ unsigned xb_xcc_id() { return (unsigned)__builtin_amdgcn_s_getreg((3 << 11) | 20) & 0xFu; }
#define XB_SPIN(cond, bar) do { unsigned _sp = 0; while (cond) { __builtin_amdgcn_s_sleep(1); \
    if ((++_sp & 255u) == 0u) { if (xb_ld(&(bar)[XB_TMO])) break; if (_sp > XB_SPIN_CAP) { atomicAdd(&(bar)[XB_TMO], 1u); break; } } } } while (0)
struct XcdBarrier { unsigned* bar; unsigned x; volatile LAS unsigned* st; };
__device__ __forceinline__ XcdBarrier xcd_barrier_post(unsigned* bar, volatile LAS unsigned* st) {
    XcdBarrier b; b.bar = bar; b.x = xb_xcc_id(); b.st = st;
    if (threadIdx.x == 0) (void)xb_add(&bar[XB_XCNT(b.x)], 1u);
    return b;
}
__device__ __forceinline__ void xcd_barrier_complete(unsigned* bar, unsigned x, unsigned& nloc, unsigned& nx) {
    asm volatile("" : "+s"(x));
    const unsigned G = gridDim.x * gridDim.y * gridDim.z;
    unsigned sum, cnt, mine, sp = 0u;
    for (;;) {
        sum = 0u; cnt = 0u; mine = 0u;
#pragma unroll
        for (unsigned j = 0; j < 16; ++j) { const unsigned c = xb_ld(&bar[XB_XCNT(j)]); sum += c; cnt += (c > 0u) ? 1u : 0u; mine = (j == x) ? c : mine; }
        if (sum == G) break;
        __builtin_amdgcn_s_sleep(1);
        if ((++sp & 255u) == 0u) { if (xb_ld(&bar[XB_TMO])) break; if (sp > XB_SPIN_CAP) { atomicAdd(&bar[XB_TMO], 1u); break; } }
    }
    nloc = mine > 0u ? mine : 1u; nx = cnt > 0u ? cnt : 1u;
}
__device__ __forceinline__ void xcd_barrier(const XcdBarrier& b, const bool thread0  ) {
    asm volatile("s_waitcnt vmcnt(0)" ::: "memory");
    __syncthreads();
    if (thread0) {
        unsigned* bar = b.bar;
        __builtin_amdgcn_s_waitcnt(0);
        unsigned nloc = b.st[0], nx = b.st[1];
        if (nloc == 0u) { xcd_barrier_complete(bar, b.x, nloc, nx); b.st[0] = nloc; b.st[1] = nx; }
        const unsigned old = xb_add(&bar[XB_XSUB(b.x)], 1u);
        const unsigned gen = old / nloc;
        if (old + 1u == (gen + 1u) * nloc) {
            __builtin_amdgcn_fence(__ATOMIC_RELEASE, "agent");
            asm volatile("s_waitcnt vmcnt(0)" ::: "memory");
            const unsigned og = xb_add(&bar[XB_TOP], 1u);
            const unsigned tg = og / nx;
            if (og + 1u == (tg + 1u) * nx) xb_add(&bar[XB_TOPGEN], 1u);
            else XB_SPIN(xb_ld(&bar[XB_TOPGEN]) == tg, bar);
            __builtin_amdgcn_fence(__ATOMIC_ACQUIRE, "agent");
            xb_add(&bar[XB_XGEN(b.x)], 1u);
            asm volatile("s_waitcnt vmcnt(0)" ::: "memory");
        } else {
            XB_SPIN(xb_ld(&bar[XB_XGEN(b.x)]) == gen, bar);
            __builtin_amdgcn_fence(__ATOMIC_ACQUIRE, "agent");
            asm volatile("s_waitcnt vmcnt(0)" ::: "memory");
        }
    }
    __syncthreads();
}

namespace pg8 {
constexpr int BM = 256, BK = 64, HALF = 128, HTB = HALF * BK * 2, STAGE_BYTES = 8 * HTB, NXCD = 8, WGM = 8;
__host__ __device__ __forceinline__ int lds_byte(int r, int c) { const int st = (r >> 4) * 2 + (c >> 5), rr = r & 15, cc = c & 31, ob = rr * 64 + cc * 2; return st * 1024 + (ob ^ (((ob >> 9) & 1) << 5)); }
__host__ __device__ __forceinline__ void stage_rc(int b, int& R, int& C) { const int st = b / 1024, sb = b % 1024, swz = sb ^ (((sb >> 9) & 1) << 5); R = (st >> 1) * 16 + swz / 64; C = (st & 1) * 32 + (swz % 64) / 2; }
__host__ __device__ __forceinline__ int perm32(int rho) { const int n = rho >> 4, i = rho & 15; return 8 * (i >> 2) + 4 * n + (i & 3); }
struct Unit { int pm, pn; };
struct Gemm { const bf16_t* A; const bf16_t* Bt; int M, N, K, lda; };
struct StaticOrder {
    int nM, nN, nwg, G, c;
    __host__ __device__ void init(int M, int N, int G_, int c_) { nM = M / BM; nN = N / BM; nwg = nM * nN; G = G_; c = c_; }
    __host__ __device__ bool next(int i, Unit& u) const {
        const long L = (long)i * G + c; if (L >= nwg) return false;
        int wgid = (int)L; { const int q = nwg / NXCD, r = nwg % NXCD, xcd = wgid % NXCD, off = wgid / NXCD; wgid = (xcd < r ? xcd * (q + 1) : r * (q + 1) + (xcd - r) * q) + off; }
        const int nig = WGM * nN, gid = wgid / nig, fm = gid * WGM, gsz = (nM - fm) < WGM ? (nM - fm) : WGM;
        u.pm = fm + ((wgid % nig) % gsz); u.pn = (wgid % nig) / gsz; return true;
    }
    __device__ __forceinline__ void a_ready(const Unit&) const {}
    __device__ __forceinline__ void done(const Unit&) const {}
};
struct OneUnit {
    int pm, pn;
    __device__ bool next(int i, Unit& u) const { if (i != 0) return false; u.pm = pm; u.pn = pn; return true; }
    __device__ __forceinline__ void a_ready(const Unit&) const {}
    __device__ __forceinline__ void done(const Unit&) const {}
};
struct EpiBf16 {
    static constexpr bool PERM = true;
    bf16_t* O; int ldc;
    __device__ __forceinline__ void operator()(const f32x4 (&acc)[2][2][4][2], const Unit& u, int wr, int wc, int fr, int fq) const {
        const int row0 = u.pm * BM + wr * 64 + fr; const int col0 = u.pn * BM + wc * 32 + 8 * fq;
#pragma unroll
        for (int ai = 0; ai < 2; ++ai)
#pragma unroll
            for (int m = 0; m < 4; ++m) { bf16_t* rowp = O + (size_t)(row0 + ai * HALF + m * 16) * ldc + col0;
#pragma unroll
                for (int bj = 0; bj < 2; ++bj) { const f32x4 v0 = acc[ai][bj][m][0], v1 = acc[ai][bj][m][1];
                    u32x4 w; w.x = cvt_pk_bf16(v0[0], v0[1]); w.y = cvt_pk_bf16(v0[2], v0[3]); w.z = cvt_pk_bf16(v1[0], v1[1]); w.w = cvt_pk_bf16(v1[2], v1[3]);
                    *(u32x4*)(rowp + bj * HALF) = w; } }
    }
};
struct EpiBf16V {
    static constexpr bool PERM = true;
    bf16_t* O; int ldc; bf16_t* V; int vpn0, vld;
    __device__ __forceinline__ void operator()(const f32x4 (&acc)[2][2][4][2], const Unit& u, int wr, int wc, int fr, int fq) const {
        const int row0 = u.pm * BM + wr * 64 + fr; const int col0 = u.pn * BM + wc * 32 + 8 * fq;
        const bool tov = u.pn >= vpn0;
        const long delta = u.pm < 32 ? 0 : (u.pm < 64 ? KPB - SEQ : (u.pm == 64 ? SEQ - TL : KPB + SEQ - TL - CTXL));
        bf16_t* base = tov ? V + delta * vld - (long)vpn0 * BM : O; const int ld = tov ? vld : ldc;
#pragma unroll
        for (int ai = 0; ai < 2; ++ai)
#pragma unroll
            for (int m = 0; m < 4; ++m) { bf16_t* rowp = base + (size_t)(row0 + ai * HALF + m * 16) * ld + col0;
#pragma unroll
                for (int bj = 0; bj < 2; ++bj) { const f32x4 v0 = acc[ai][bj][m][0], v1 = acc[ai][bj][m][1];
                    u32x4 w; w.x = cvt_pk_bf16(v0[0], v0[1]); w.y = cvt_pk_bf16(v0[2], v0[3]); w.z = cvt_pk_bf16(v1[0], v1[1]); w.w = cvt_pk_bf16(v1[2], v1[3]);
                    *(u32x4*)(rowp + bj * HALF) = w; } }
    }
};
struct EpiResid {
    static constexpr bool PERM = false;
    float* X; const float* modl; int chunk;
    const float* Rlat; const float* Rctx;
    __device__ __forceinline__ void operator()(const f32x4 (&acc)[2][2][4][2], const Unit& u, int wr, int wc, int fr, int fq) const {
        const int row0 = u.pm * BM + wr * 64 + fr, col0 = u.pn * BM + wc * 32 + 4 * fq;
        const int vs = u.pm < 32 ? 0 : (u.pm < 64 ? 1 : 2);
        const float* gate = modl + (size_t)vs * 12288 + chunk * 2048 + col0;
        f32x4 gv[2][2];
#pragma unroll
        for (int bj = 0; bj < 2; ++bj)
#pragma unroll
            for (int n = 0; n < 2; ++n) gv[bj][n] = *(const f32x4*)(gate + bj * HALF + n * 16);
#pragma unroll
        for (int ai = 0; ai < 2; ++ai) {
            f32x4 xo[4][2][2];
#pragma unroll
            for (int m = 0; m < 4; ++m) { const int row = row0 + ai * HALF + m * 16;
                const float* srcp = (vs < 2 ? Rlat + (size_t)row * DM : Rctx + (size_t)(row - TL) * DM) + col0;
#pragma unroll
                for (int bj = 0; bj < 2; ++bj)
#pragma unroll
                    for (int n = 0; n < 2; ++n) xo[m][bj][n] = *(const f32x4*)(srcp + bj * HALF + n * 16); }
#pragma unroll
            for (int m = 0; m < 4; ++m) { const int row = row0 + ai * HALF + m * 16; float* rowp = X + (size_t)row * DM + col0;
#pragma unroll
                for (int bj = 0; bj < 2; ++bj)
#pragma unroll
                    for (int n = 0; n < 2; ++n) *(f32x4*)(rowp + bj * HALF + n * 16) = xo[m][bj][n] + gv[bj][n] * acc[ai][bj][m][n]; } }
    }
};

template <class Epi, class Sched>
__device__ __forceinline__ void gemm_phase(LAS unsigned char* lds, const Gemm g, const Sched& S, const Epi& E, int tid_in) {
    const int tid_l = tid_in * 64 + fresh_lane();
    const int tid = tid_l, wid = tid_in  , lane = tid & 63, wr = wid >> 2, wc = wid & 3, fr = lane & 15, fq = lane >> 4;
    const int K = g.K, nt = K / BK, lda = g.lda;
    unsigned voffA[2], voffB[2];
#pragma unroll
    for (int i = 0; i < 2; ++i) { int R, C; stage_rc(tid * 16 + i * 8192, R, C); const int Rb = Epi::PERM ? ((R & ~31) + perm32(R & 31)) : R;
        voffA[i] = (unsigned)(R * lda + C) * 2u; voffB[i] = (unsigned)(Rb * K + C) * 2u; }
    const size_t kstep = (size_t)(BK * 2);
    const size_t hstepA = (size_t)HALF * lda * 2, hstepB = (size_t)HALF * K * 2;
    const size_t tstepA = 2 * hstepA, tstepB = 2 * hstepB;
    const unsigned ldsw = (unsigned)wid * 1024u;
    const int aoff = lds_byte(wr * 64 + fr, fq * 8), boff = lds_byte(wc * 32 + fr, fq * 8);
#define PG8_SA(b, h) (((b) * 2 + (h)) * HTB)
#define PG8_SB(b, h) ((4 + (b) * 2 + (h)) * HTB)
#define PG8_STAGE(bufoff, gbase, voff) do { _Pragma("unroll") for (int _i = 0; _i < 2; ++_i) \
        __builtin_amdgcn_global_load_lds((const unsigned*)((const char*)(gbase) + (voff)[_i]), (LAS unsigned*)(lds + (bufoff) + ldsw + _i * 8192), 16, 0, 0); } while (0)
#define PG8_LDA(dst, b, h) do { _Pragma("unroll") for (int m = 0; m < 4; ++m) _Pragma("unroll") for (int k = 0; k < 2; ++k) dst[m][k] = *(const LAS bf16x8*)(lds + PG8_SA(b, h) + aoff + m * 2048 + k * 1024); } while (0)
#define PG8_LDB(dst, b, h) do { _Pragma("unroll") for (int n = 0; n < 2; ++n) _Pragma("unroll") for (int k = 0; k < 2; ++k) dst[n][k] = *(const LAS bf16x8*)(lds + PG8_SB(b, h) + boff + n * 2048 + k * 1024); } while (0)
#define PG8_MMA(ai, bj, At, Bt) do { __builtin_amdgcn_s_setprio(1); _Pragma("unroll") for (int m = 0; m < 4; ++m) _Pragma("unroll") for (int n = 0; n < 2; ++n) _Pragma("unroll") for (int k = 0; k < 2; ++k) \
        acc[ai][bj][m][n] = __builtin_amdgcn_mfma_f32_16x16x32_bf16(Bt[n][k], At[m][k], acc[ai][bj][m][n], 0, 0, 0); __builtin_amdgcn_s_setprio(0); } while (0)
#define PG8_WAIT_V(n) asm volatile("s_waitcnt vmcnt(" #n ")" ::: "memory")
#define PG8_WAIT_L(n) asm volatile("s_waitcnt lgkmcnt(" #n ")" ::: "memory")
#define PG8_BAR __builtin_amdgcn_s_barrier()
#define PG8_SCHED __builtin_amdgcn_sched_barrier(0)
    Unit cur, nxt; int ui = 0;
    if (!S.next(0, cur)) return;
    f32x4 acc[2][2][4][2];
#pragma unroll
    for (int a = 0; a < 2; ++a)
#pragma unroll
        for (int b = 0; b < 2; ++b)
#pragma unroll
            for (int m = 0; m < 4; ++m)
#pragma unroll
                for (int n = 0; n < 2; ++n) acc[a][b][m][n] = (f32x4){0.f, 0.f, 0.f, 0.f};
    bf16x8 At[4][2], B0[2][2], B1[2][2];
    const char* cA = (const char*)g.A + (size_t)cur.pm * tstepA; const char* cB = (const char*)g.Bt + (size_t)cur.pn * tstepB;
    S.a_ready(cur);
    PG8_STAGE(PG8_SB(0, 0), cB, voffB); PG8_STAGE(PG8_SA(0, 0), cA, voffA); PG8_STAGE(PG8_SB(0, 1), cB + hstepB, voffB); PG8_STAGE(PG8_SA(0, 1), cA + hstepA, voffA);
    if (wr == 1) PG8_BAR;
    PG8_WAIT_V(4); PG8_BAR;
    PG8_STAGE(PG8_SB(1, 0), cB + kstep, voffB); PG8_STAGE(PG8_SA(1, 0), cA + kstep, voffA); PG8_STAGE(PG8_SB(1, 1), cB + hstepB + kstep, voffB);
    PG8_WAIT_V(6); PG8_BAR;
    for (;;) {
        const bool has_next = S.next(ui + 1, nxt);
        const char* nA = has_next ? (const char*)g.A + (size_t)nxt.pm * tstepA : cA; const char* nB = has_next ? (const char*)g.Bt + (size_t)nxt.pn * tstepB : cB;
        for (int t = 0; t < nt; t += 2) {
            const bool last = (t == nt - 2);
            const char* a1 = cA + (size_t)(t + 1) * kstep;
            const char* a2 = last ? nA : cA + (size_t)(t + 2) * kstep; const char* b2 = last ? nB : cB + (size_t)(t + 2) * kstep;
            const char* a3 = a2 + kstep; const char* b3 = b2 + kstep;
            if (last && has_next) S.a_ready(nxt);
            PG8_LDB(B0, 0, 0); PG8_SCHED; PG8_LDA(At, 0, 0); PG8_STAGE(PG8_SA(1, 1), a1 + hstepA, voffA);
            PG8_WAIT_L(8); PG8_BAR; PG8_WAIT_L(0); PG8_MMA(0, 0, At, B0); PG8_BAR; PG8_SCHED;
            PG8_LDB(B1, 0, 1); PG8_STAGE(PG8_SB(0, 0), b2, voffB);
            PG8_BAR; PG8_WAIT_L(0); PG8_MMA(0, 1, At, B1); PG8_BAR;
            PG8_LDA(At, 0, 1); PG8_STAGE(PG8_SA(0, 0), a2, voffA);
            PG8_BAR; PG8_WAIT_L(0); PG8_MMA(1, 0, At, B0); PG8_BAR; PG8_SCHED;
            PG8_STAGE(PG8_SB(0, 1), b2 + hstepB, voffB);
            PG8_WAIT_V(6); PG8_BAR; PG8_MMA(1, 1, At, B1); PG8_BAR;
            PG8_LDB(B0, 1, 0); PG8_SCHED; PG8_LDA(At, 1, 0); PG8_STAGE(PG8_SA(0, 1), a2 + hstepA, voffA);
            PG8_WAIT_L(8); PG8_BAR; PG8_WAIT_L(0); PG8_MMA(0, 0, At, B0); PG8_BAR; PG8_SCHED;
            PG8_LDB(B1, 1, 1); PG8_STAGE(PG8_SB(1, 0), b3, voffB);
            PG8_BAR; PG8_WAIT_L(0); PG8_MMA(0, 1, At, B1); PG8_BAR;
            PG8_LDA(At, 1, 1); PG8_STAGE(PG8_SA(1, 0), a3, voffA);
            PG8_BAR; PG8_WAIT_L(0); PG8_MMA(1, 0, At, B0); PG8_BAR; PG8_SCHED;
            PG8_STAGE(PG8_SB(1, 1), b3 + hstepB, voffB);
            PG8_WAIT_V(6); PG8_BAR; PG8_MMA(1, 1, At, B1); PG8_BAR;
        }
        E(acc, cur, wr, wc, fr, fq); S.done(cur);
        if (!has_next) break;
#pragma unroll
        for (int a = 0; a < 2; ++a)
#pragma unroll
            for (int b = 0; b < 2; ++b)
#pragma unroll
                for (int m = 0; m < 4; ++m)
#pragma unroll
                    for (int n = 0; n < 2; ++n) acc[a][b][m][n] = (f32x4){0.f, 0.f, 0.f, 0.f};
        cur = nxt; cA = nA; cB = nB; ++ui;
    }
    PG8_WAIT_V(0);
    if (wr == 0) PG8_BAR;
    PG8_BAR;
#undef PG8_SA
#undef PG8_SB
#undef PG8_STAGE
#undef PG8_LDA
#undef PG8_LDB
#undef PG8_MMA
#undef PG8_WAIT_V
#undef PG8_WAIT_L
#undef PG8_BAR
#undef PG8_SCHED
}
}

namespace att {
constexpr int NW = 8, QBLK = 32, KVBLK = 64, DV = 128;
constexpr float THR = 8.f;
constexpr int SHM_V = KVBLK * DV * 2;
#define SBAR() __builtin_amdgcn_sched_barrier(0)
__device__ __forceinline__ int crow(int r, int hi) { return (r & 3) + 8 * (r >> 2) + 4 * hi; }
__device__ __forceinline__ unsigned cvtpk(float lo, float hi) { unsigned r; asm volatile("v_cvt_pk_bf16_f32 %0, %1, %2" : "=v"(r) : "v"(lo), "v"(hi)); return r; }
__device__ __forceinline__ void partialSM(f32x16& p0, f32x16& p1, float& m_reg, float& mn, float& alpha, const float C, const float thr_raw) {
    float pmax = p0[0];
#pragma unroll
    for (int r = 1; r < 16; ++r) pmax = fmaxf(pmax, p0[r]);
#pragma unroll
    for (int r = 0; r < 16; ++r) pmax = fmaxf(pmax, p1[r]);
    { auto rr = __builtin_amdgcn_permlane32_swap(__float_as_uint(pmax), __float_as_uint(pmax), false, false);
      pmax = fmaxf(__uint_as_float(rr[0]), __uint_as_float(rr[1])); }
    if (__builtin_expect(__all(pmax - m_reg <= thr_raw), 1)) { mn = m_reg; alpha = 1.f; }
    else { mn = fmaxf(m_reg, pmax); alpha = __builtin_amdgcn_exp2f((m_reg - mn) * C); m_reg = mn; }
    const float mnC = -mn * C;
#pragma unroll
    for (int r = 0; r < 16; ++r) p0[r] = fmaf(p0[r], C, mnC);
#pragma unroll
    for (int r = 0; r < 16; ++r) p1[r] = fmaf(p1[r], C, mnC);
#pragma unroll
    for (int r = 0; r < 16; ++r) p0[r] = __builtin_amdgcn_exp2f(p0[r]);
}
__device__ __forceinline__ void finishSM(f32x16& p0, f32x16& p1, float alpha, float& l_reg, bf16x8& pa0, bf16x8& pa1, bf16x8& pa2, bf16x8& pa3) {
#pragma unroll
    for (int r = 0; r < 16; ++r) p1[r] = __builtin_amdgcn_exp2f(p1[r]);
    float ps = 0;
#pragma unroll
    for (int r = 0; r < 16; ++r) ps += p0[r];
#pragma unroll
    for (int r = 0; r < 16; ++r) ps += p1[r];
    { auto rr = __builtin_amdgcn_permlane32_swap(__float_as_uint(ps), __float_as_uint(ps), false, false);
      ps = __uint_as_float(rr[0]) + __uint_as_float(rr[1]); }
    l_reg = l_reg * alpha + ps;
#define PK4(P, BASE, OUT) do { unsigned a0 = cvtpk(P[BASE + 0], P[BASE + 1]), a1 = cvtpk(P[BASE + 2], P[BASE + 3]);   \
    unsigned b0 = cvtpk(P[BASE + 4], P[BASE + 5]), b1 = cvtpk(P[BASE + 6], P[BASE + 7]);                              \
    auto r0 = __builtin_amdgcn_permlane32_swap(a0, b0, false, false); auto r1 = __builtin_amdgcn_permlane32_swap(a1, b1, false, false); \
    u32x4 w = {r0[0], r1[0], r0[1], r1[1]}; OUT = *reinterpret_cast<bf16x8*>(&w); } while (0)
    PK4(p0, 0, pa0); PK4(p0, 8, pa1); PK4(p1, 0, pa2); PK4(p1, 8, pa3);
#undef PK4
}
__device__ __forceinline__ void partialSM_nm(f32x16& p0) {
#pragma unroll
    for (int r = 0; r < 16; ++r) p0[r] = __builtin_amdgcn_exp2f(p0[r]);
}
template <int DQK, int QL>
__device__ __forceinline__ void qkt(f32x16& p0, f32x16& p1, const char* Ks, const bf16x8 (&qr)[DQK / 16 - QL], const char* qpark, int r32, int hi) {
    constexpr int RS = DQK * 2 + 16, NQR = DQK / 16 - QL, GRP = (DQK > 128) ? QKT_GRP : DQK / 16;
    p0 = f32x16{}; p1 = f32x16{};
#pragma unroll
    for (int g0 = 0; g0 < DQK / 16; g0 += GRP) {
#pragma unroll
        for (int d0 = g0; d0 < g0 + GRP; ++d0) { const int cb = (d0 * 16 + hi * 8) * 2;
            const bf16x8 b0 = *reinterpret_cast<const bf16x8*>(Ks + r32 * RS + cb);
            const bf16x8 b1 = *reinterpret_cast<const bf16x8*>(Ks + (32 + r32) * RS + cb);
            bf16x8 qf; if (d0 < NQR) qf = qr[d0 < NQR ? d0 : 0]; else qf = *reinterpret_cast<const bf16x8*>(qpark + (d0 - NQR) * 1024);
            p0 = __builtin_amdgcn_mfma_f32_32x32x16_bf16(b0, qf, p0, 0, 0, 0);
            p1 = __builtin_amdgcn_mfma_f32_32x32x16_bf16(b1, qf, p1, 0, 0, 0); }
        if (g0 + GRP < DQK / 16) SBAR();
    }
}
__device__ __forceinline__ int v_st(int k, int c) { const int kk = (k & ~0xC) | ((k & 4) << 1) | ((k & 8) >> 1); return ((kk >> 3) * 4 + (c >> 5)) * 512 + ((kk & 7) * 32 + (c & 31)) * 2; }
__device__ __forceinline__ int v_rd_base(int lane) { return ((lane & 3) << 3) | (((lane >> 2) & 3) << 6) | (((lane >> 4) & 1) << 5) | (((lane >> 5) & 1) << 8); }
constexpr int v_rd_off(int d0, int ks, int half) { return d0 * 512 + ks * 4096 + half * 2048; }
template <int OFF> __device__ __forceinline__ s16x4 tr_read(int vb) {
    s16x4 r; asm volatile("ds_read_b64_tr_b16 %0, %1 offset:%2" : "=&v"(r) : "v"(vb), "i"(OFF) : "memory"); return r;
}
template <int D0> __device__ __forceinline__ void pv_one(f32x16& od, int vb, bf16x8 pa0, bf16x8 pa1, bf16x8 pa2, bf16x8 pa3) {
    const s16x4 l0 = tr_read<v_rd_off(D0, 0, 0)>(vb), h0 = tr_read<v_rd_off(D0, 0, 1)>(vb), l1 = tr_read<v_rd_off(D0, 1, 0)>(vb), h1 = tr_read<v_rd_off(D0, 1, 1)>(vb);
    const s16x4 l2 = tr_read<v_rd_off(D0, 2, 0)>(vb), h2 = tr_read<v_rd_off(D0, 2, 1)>(vb), l3 = tr_read<v_rd_off(D0, 3, 0)>(vb), h3 = tr_read<v_rd_off(D0, 3, 1)>(vb);
    asm volatile("s_waitcnt lgkmcnt(0)" ::: "memory"); SBAR();
#define PK(L, H) (bf16x8){L[0], L[1], L[2], L[3], H[0], H[1], H[2], H[3]}
    od = __builtin_amdgcn_mfma_f32_32x32x16_bf16(pa0, PK(l0, h0), od, 0, 0, 0);
    od = __builtin_amdgcn_mfma_f32_32x32x16_bf16(pa1, PK(l1, h1), od, 0, 0, 0);
    od = __builtin_amdgcn_mfma_f32_32x32x16_bf16(pa2, PK(l2, h2), od, 0, 0, 0);
    od = __builtin_amdgcn_mfma_f32_32x32x16_bf16(pa3, PK(l3, h3), od, 0, 0, 0);
#undef PK
}
__device__ __forceinline__ void pv_d0(f32x16* o, int vb, bf16x8 pa0, bf16x8 pa1, bf16x8 pa2, bf16x8 pa3) {
    pv_one<0>(o[0], vb, pa0, pa1, pa2, pa3); pv_one<1>(o[1], vb, pa0, pa1, pa2, pa3); pv_one<2>(o[2], vb, pa0, pa1, pa2, pa3); pv_one<3>(o[3], vb, pa0, pa1, pa2, pa3);
}
struct VFrag { s16x4 l0, h0, l1, h1, l2, h2, l3, h3; };
template <int D0> __device__ __forceinline__ void pv_rd(VFrag& f, int vb) {
    f.l0 = tr_read<v_rd_off(D0, 0, 0)>(vb); f.h0 = tr_read<v_rd_off(D0, 0, 1)>(vb); f.l1 = tr_read<v_rd_off(D0, 1, 0)>(vb); f.h1 = tr_read<v_rd_off(D0, 1, 1)>(vb);
    f.l2 = tr_read<v_rd_off(D0, 2, 0)>(vb); f.h2 = tr_read<v_rd_off(D0, 2, 1)>(vb); f.l3 = tr_read<v_rd_off(D0, 3, 0)>(vb); f.h3 = tr_read<v_rd_off(D0, 3, 1)>(vb);
}
__device__ __forceinline__ void pv_mm(f32x16& od, const VFrag& f, bf16x8 pa0, bf16x8 pa1, bf16x8 pa2, bf16x8 pa3) {
#define PK(L, H) (bf16x8){L[0], L[1], L[2], L[3], H[0], H[1], H[2], H[3]}
    od = __builtin_amdgcn_mfma_f32_32x32x16_bf16(pa0, PK(f.l0, f.h0), od, 0, 0, 0);
    od = __builtin_amdgcn_mfma_f32_32x32x16_bf16(pa1, PK(f.l1, f.h1), od, 0, 0, 0);
    od = __builtin_amdgcn_mfma_f32_32x32x16_bf16(pa2, PK(f.l2, f.h2), od, 0, 0, 0);
    od = __builtin_amdgcn_mfma_f32_32x32x16_bf16(pa3, PK(f.l3, f.h3), od, 0, 0, 0);
#undef PK
}
__device__ __forceinline__ void pv_d0_pipe(f32x16* o, int vb, bf16x8 pa0, bf16x8 pa1, bf16x8 pa2, bf16x8 pa3) {
    VFrag fa, fb;
    pv_rd<0>(fa, vb); pv_rd<1>(fb, vb);
    asm volatile("s_waitcnt lgkmcnt(8)" ::: "memory"); SBAR(); pv_mm(o[0], fa, pa0, pa1, pa2, pa3); SBAR();
    pv_rd<2>(fa, vb);
    asm volatile("s_waitcnt lgkmcnt(8)" ::: "memory"); SBAR(); pv_mm(o[1], fb, pa0, pa1, pa2, pa3); SBAR();
    pv_rd<3>(fb, vb);
    asm volatile("s_waitcnt lgkmcnt(8)" ::: "memory"); SBAR(); pv_mm(o[2], fa, pa0, pa1, pa2, pa3); SBAR();
    asm volatile("s_waitcnt lgkmcnt(0)" ::: "memory"); SBAR(); pv_mm(o[3], fb, pa0, pa1, pa2, pa3);
}
template <int DQK> struct ScaleOf { static constexpr float scale = DQK == 192 ? 0.07216878364870322f : (DQK == 128 ? 0.08838834764831845f : 0.125f); };
template <int DQK, int SDEPTH, int QL, bool NOMAX, int ldq, int ldk, int ldv, int ldo>
__device__ __forceinline__ void attn_body(const bf16_t* __restrict__ Qb, const bf16_t* __restrict__ Kh, const bf16_t* __restrict__ Vh,
                                          bf16_t* __restrict__ Ob, int seq, char* lds, int tid_in, const float negMC) {
    constexpr float C = 1.0f, thr_raw = THR * 1.4426950408889634f;
    constexpr int RS = DQK * 2 + 16  , SHM_K = KVBLK * RS, NKP = DQK / 64, KPR = DQK / 8;
    const int tid_l = tid_in * 64 + fresh_lane();
    const int tid = tid_l, wid = tid_in  , lane = tid & 63, r32 = lane & 31, hi = lane >> 5;
    char* V_lds = lds; char* K_lds = lds + 2 * SHM_V;
    float* ws = (float*)(lds + 2 * SHM_V + 2 * SHM_K) + wid * 64; float* li_l = ws; float* al_l = ws + 32;
    constexpr int NQR = DQK / 16 - QL;
    char* qpark = lds + 2 * SHM_V + 2 * SHM_K + 2048 + wid * (QL * 1024) + lane * 16;
    float m_reg = -1e30f, l_reg = 0; f32x16 o[4] = {}; bf16x8 qr[NQR];
    const bf16_t* Qw = Qb + (size_t)(wid * QBLK + r32) * ldq + hi * 8;
#pragma unroll
    for (int d0 = 0; d0 < NQR; ++d0) qr[d0] = *reinterpret_cast<const bf16x8*>(Qw + d0 * 16);
#pragma unroll
    for (int d0 = 0; d0 < QL; ++d0) *(bf16x8*)(qpark + d0 * 1024) = *reinterpret_cast<const bf16x8*>(Qw + (NQR + d0) * 16);
    const int sr = tid >> 4, sc = (tid & 15) * 8, vst0 = v_st(sr, sc), vst1 = v_st(32 + sr, sc);
    int koff[NKP], klds[NKP];
#pragma unroll
    for (int i = 0; i < NKP; ++i) { const int row = tid >> 3, c8 = (tid & 7) + 8 * i; koff[i] = row * ldk + c8 * 8; klds[i] = row * RS + c8 * 16; }
    const int vb0 = (int)(uintptr_t)V_lds + v_rd_base(lane);
    bf16x8 sv0[SDEPTH], sv1[SDEPTH], sk[SDEPTH][NKP];
#define SLOAD(i, k0) do { sv0[i] = *reinterpret_cast<const bf16x8*>(&Vh[(size_t)((k0) + sr) * ldv + sc]); sv1[i] = *reinterpret_cast<const bf16x8*>(&Vh[(size_t)((k0) + 32 + sr) * ldv + sc]); \
    _Pragma("unroll") for (int _q = 0; _q < NKP; ++_q) sk[i][_q] = *reinterpret_cast<const bf16x8*>(&Kh[(size_t)(k0) * ldk + koff[_q]]); } while (0)
#define SWRITE(b, i) do { *(bf16x8*)(V_lds + (b) * SHM_V + vst0) = sv0[i]; *(bf16x8*)(V_lds + (b) * SHM_V + vst1) = sv1[i]; \
    _Pragma("unroll") for (int _q = 0; _q < NKP; ++_q) *(bf16x8*)(K_lds + (b) * SHM_K + klds[_q]) = sk[i][_q]; } while (0)
#define SWAIT() do { if constexpr (SDEPTH == 2) { if constexpr (NKP == 1) asm volatile("s_waitcnt vmcnt(3)" ::: "memory"); else if constexpr (NKP == 2) asm volatile("s_waitcnt vmcnt(4)" ::: "memory"); else asm volatile("s_waitcnt vmcnt(5)" ::: "memory"); } \
    else asm volatile("s_waitcnt vmcnt(0)" ::: "memory"); } while (0)
#define PVD0(...) do { if constexpr (PV_PIPE != 0) pv_d0_pipe(__VA_ARGS__); else pv_d0(__VA_ARGS__); } while (0)
#define RESC(a) do { if constexpr (!NOMAX) if (__any((a) < 1.f)) { if (hi == 0) al_l[r32] = (a); asm volatile("s_waitcnt lgkmcnt(0)" ::: "memory"); \
    _Pragma("unroll") for (int d = 0; d < 4; ++d) _Pragma("unroll") for (int r = 0; r < 16; ++r) o[d][r] *= al_l[crow(r, hi)]; } } while (0)
    f32x16 pA0, pA1, pB0, pB1; float mnA, mnB, alA, alB; bf16x8 pa0, pa1, pa2, pa3; const int NT = seq / KVBLK;
    if (ATT_PRIO && wid >= 4) __builtin_amdgcn_s_setprio(1);
    constexpr int SE = 0, SO = SDEPTH - 1;
    SLOAD(SE, 0); asm volatile("s_waitcnt vmcnt(0)" ::: "memory"); SWRITE(0, SE); __syncthreads();
    qkt<DQK, QL>(pA0, pA1, K_lds, qr, qpark, r32, hi); if constexpr (NOMAX) { partialSM_nm(pA0); alA = 1.f; } else partialSM(pA0, pA1, m_reg, mnA, alA, C, thr_raw);
    SLOAD(SO, KVBLK); if constexpr (SDEPTH == 2) { if (2 < NT) SLOAD(SE, 2 * KVBLK); }
    SWAIT(); SWRITE(1, SO); __syncthreads();
    for (int j = 1; j + 1 < NT; j += 2) {
        SBAR(); qkt<DQK, QL>(pB0, pB1, K_lds + SHM_K, qr, qpark, r32, hi);
        finishSM(pA0, pA1, alA, l_reg, pa0, pa1, pa2, pa3); SBAR();
        SLOAD(SO, (j + SDEPTH) * KVBLK); SBAR();
        PVD0(o, vb0, pa0, pa1, pa2, pa3); if constexpr (NOMAX) { partialSM_nm(pB0); alB = 1.f; } else partialSM(pB0, pB1, m_reg, mnB, alB, C, thr_raw);
        __syncthreads(); SWAIT(); SWRITE(0, SE);
        RESC(alB); __syncthreads();
        SBAR(); qkt<DQK, QL>(pA0, pA1, K_lds, qr, qpark, r32, hi);
        finishSM(pB0, pB1, alB, l_reg, pa0, pa1, pa2, pa3); SBAR();
        if (SDEPTH == 1 || j + 3 < NT) SLOAD(SE, (j + 1 + SDEPTH) * KVBLK); SBAR();
        PVD0(o, vb0 + SHM_V, pa0, pa1, pa2, pa3); if constexpr (NOMAX) { partialSM_nm(pA0); alA = 1.f; } else partialSM(pA0, pA1, m_reg, mnA, alA, C, thr_raw);
        __syncthreads(); SWAIT(); SWRITE(1, SO);
        RESC(alA); __syncthreads();
    }
    SBAR(); qkt<DQK, QL>(pB0, pB1, K_lds + SHM_K, qr, qpark, r32, hi);
    finishSM(pA0, pA1, alA, l_reg, pa0, pa1, pa2, pa3); SBAR();
    PVD0(o, vb0, pa0, pa1, pa2, pa3); if constexpr (NOMAX) { partialSM_nm(pB0); alB = 1.f; } else partialSM(pB0, pB1, m_reg, mnB, alB, C, thr_raw);
    __syncthreads(); RESC(alB);
    finishSM(pB0, pB1, alB, l_reg, pa0, pa1, pa2, pa3); SBAR();
    PVD0(o, vb0 + SHM_V, pa0, pa1, pa2, pa3);
    if (ATT_PRIO) __builtin_amdgcn_s_setprio(0);
    if (hi == 0) li_l[r32] = l_reg; asm volatile("s_waitcnt lgkmcnt(0)" ::: "memory");
    float rli[16];
#pragma unroll
    for (int r = 0; r < 16; ++r) rli[r] = __builtin_amdgcn_rcpf(li_l[crow(r, hi)]);
    bf16_t* Ow = Ob + (size_t)(wid * QBLK) * ldo + (r32 & ~1);
    const bool odd = (r32 & 1) != 0;
#pragma unroll
    for (int r = 0; r < 16; r += 2) { const int orow = crow(r, hi) + (odd ? 1 : 0);
#pragma unroll
        for (int d0 = 0; d0 < 4; ++d0) { const float a = o[d0][r] * rli[r], b = o[d0][r + 1] * rli[r + 1];
            const float recv = swz_xor<1>(odd ? a : b);
            const unsigned w = odd ? cvtpk(recv, b) : cvtpk(a, recv);
            *(unsigned*)(Ow + (size_t)orow * ldo + d0 * 32) = w; } }
    __syncthreads();
#undef SLOAD
#undef SWRITE
#undef SWAIT
#undef RESC
#undef PVD0
}
template <int DQK, int QL, int ldq, int ldk, int ldv, int ldo>
__device__ __forceinline__ void attn_body_simple(const bf16_t* __restrict__ Qb, const bf16_t* __restrict__ Kh, const bf16_t* __restrict__ Vh,
                                                 bf16_t* __restrict__ Ob, int seq, char* lds, int tid_in) {
    constexpr float C = 1.0f, thr_raw = THR * 1.4426950408889634f;
    constexpr int RS = DQK * 2 + 16  , SHM_K = KVBLK * RS, NKP = DQK / 64, KPR = DQK / 8;
    const int tid_l = tid_in * 64 + fresh_lane();
    const int tid = tid_l, wid = tid_in  , lane = tid & 63, r32 = lane & 31, hi = lane >> 5;
    char* V_lds = lds; char* K_lds = lds + 2 * SHM_V;
    float* ws = (float*)(lds + 2 * SHM_V + 2 * SHM_K) + wid * 64; float* li_l = ws; float* al_l = ws + 32;
    constexpr int NQR = DQK / 16 - QL;
    char* qpark = lds + 2 * SHM_V + 2 * SHM_K + 2048 + wid * (QL * 1024) + lane * 16;
    float m_reg = -1e30f, l_reg = 0; f32x16 o[4] = {}; bf16x8 qr[NQR];
    const bf16_t* Qw = Qb + (size_t)(wid * QBLK + r32) * ldq + hi * 8;
#pragma unroll
    for (int d0 = 0; d0 < NQR; ++d0) qr[d0] = *reinterpret_cast<const bf16x8*>(Qw + d0 * 16);
#pragma unroll
    for (int d0 = 0; d0 < QL; ++d0) *(bf16x8*)(qpark + d0 * 1024) = *reinterpret_cast<const bf16x8*>(Qw + (NQR + d0) * 16);
    const int sr = tid >> 4, sc = (tid & 15) * 8, vst0 = v_st(sr, sc), vst1 = v_st(32 + sr, sc);
    int koff[NKP], klds[NKP];
#pragma unroll
    for (int i = 0; i < NKP; ++i) { const int row = tid >> 3, c8 = (tid & 7) + 8 * i; koff[i] = row * ldk + c8 * 8; klds[i] = row * RS + c8 * 16; }
    const int vb0 = (int)(uintptr_t)V_lds + v_rd_base(lane);
    bf16x8 sv0, sv1, sk[NKP];
#define SLOAD(k0) do { sv0 = *reinterpret_cast<const bf16x8*>(&Vh[(size_t)((k0) + sr) * ldv + sc]); sv1 = *reinterpret_cast<const bf16x8*>(&Vh[(size_t)((k0) + 32 + sr) * ldv + sc]); \
    _Pragma("unroll") for (int _q = 0; _q < NKP; ++_q) sk[_q] = *reinterpret_cast<const bf16x8*>(&Kh[(size_t)(k0) * ldk + koff[_q]]); } while (0)
#define SWRITE(b) do { *(bf16x8*)(V_lds + (b) * SHM_V + vst0) = sv0; *(bf16x8*)(V_lds + (b) * SHM_V + vst1) = sv1; \
    _Pragma("unroll") for (int _q = 0; _q < NKP; ++_q) *(bf16x8*)(K_lds + (b) * SHM_K + klds[_q]) = sk[_q]; } while (0)
#define RESC(a) do { if (__any((a) < 1.f)) { if (hi == 0) al_l[r32] = (a); asm volatile("s_waitcnt lgkmcnt(0)" ::: "memory"); \
    _Pragma("unroll") for (int d = 0; d < 4; ++d) _Pragma("unroll") for (int r = 0; r < 16; ++r) o[d][r] *= al_l[crow(r, hi)]; } } while (0)
    const int NT = seq / KVBLK;
    SLOAD(0); asm volatile("s_waitcnt vmcnt(0)" ::: "memory"); SWRITE(0); __syncthreads();
    for (int j = 0; j < NT; ++j) {
        const int b = j & 1;
        if (j + 1 < NT) SLOAD((j + 1) * KVBLK);
        SBAR();
        f32x16 p0, p1; float mn, al; bf16x8 pa0, pa1, pa2, pa3;
        { const char* Ks = K_lds + b * SHM_K; p0 = f32x16{}; p1 = f32x16{};
#pragma unroll
          for (int d0 = 0; d0 < DQK / 16; ++d0) { const int cb = (d0 * 16 + hi * 8) * 2;
              const bf16x8 b0 = *reinterpret_cast<const bf16x8*>(Ks + r32 * RS + cb);
              const bf16x8 b1 = *reinterpret_cast<const bf16x8*>(Ks + (32 + r32) * RS + cb);
              bf16x8 qf; if (d0 < NQR) qf = qr[d0 < NQR ? d0 : 0]; else qf = *(const bf16x8*)(qpark + (d0 - NQR) * 1024);
              p0 = __builtin_amdgcn_mfma_f32_32x32x16_bf16(b0, qf, p0, 0, 0, 0);
              p1 = __builtin_amdgcn_mfma_f32_32x32x16_bf16(b1, qf, p1, 0, 0, 0); } }
        partialSM(p0, p1, m_reg, mn, al, C, thr_raw);
        RESC(al);
        finishSM(p0, p1, al, l_reg, pa0, pa1, pa2, pa3); SBAR();
        pv_d0(o, vb0 + b * SHM_V, pa0, pa1, pa2, pa3);
        if (j + 1 < NT) { asm volatile("s_waitcnt vmcnt(0)" ::: "memory"); SWRITE(b ^ 1); }
        __syncthreads();
    }
    if (hi == 0) li_l[r32] = l_reg; asm volatile("s_waitcnt lgkmcnt(0)" ::: "memory");
    float rli[16];
#pragma unroll
    for (int r = 0; r < 16; ++r) rli[r] = __builtin_amdgcn_rcpf(li_l[crow(r, hi)]);
    bf16_t* Ow = Ob + (size_t)(wid * QBLK) * ldo + (r32 & ~1);
    const bool odd = (r32 & 1) != 0;
#pragma unroll
    for (int r = 0; r < 16; r += 2) { const int orow = crow(r, hi) + (odd ? 1 : 0);
#pragma unroll
        for (int d0 = 0; d0 < 4; ++d0) { const float a = o[d0][r] * rli[r], b = o[d0][r + 1] * rli[r + 1];
            const float recv = swz_xor<1>(odd ? a : b);
            const unsigned w = odd ? cvtpk(recv, b) : cvtpk(a, recv);
            *(unsigned*)(Ow + (size_t)orow * ldo + d0 * 32) = w; } }
    __syncthreads();
#undef SLOAD
#undef SWRITE
#undef RESC
}
}

struct Params {
    const float* x; const float* c; const float* ctx; const float* c_ctx; const float* w_mod; const float* b_mod; const float* g_norm1; const float* g_norm2;
    const float* w_in_ab; const float* g_cq; const float* w_uq; const float* g_ckv; const float* w_ukv; const float* g_qn_a; const float* g_kn_a; const float* lam_vec;
    const float* g_qn_b; const float* g_kn_b; const float* g_sub_b; const float* w_out_ab; const float* w_in_c; const float* g_qn_c; const float* g_kn_c; const float* w_out_c;
    const float* w_pq; const float* sub_keys; const float* expert_u; const float* expert_v;
    float* out; unsigned char* ws; int ph_lo, ph_hi;
};

typedef const __attribute__((address_space(4))) Params CParams;
struct Ctx {
    int tid, lane, wid, G, vcu, bx;
    unsigned char* ws; char* lds;
};

__device__ __forceinline__ void tconv(const Ctx& F, const float* src, bf16_t* dst, const float* gain, int nmat, int K, int N, int Npad, int pad_at = 1 << 30, int pad_len = 0) {
    float* tile = (float*)(F.lds + 32768);
    const int ntn = Npad / 64, ntk = K / 64, per = ntn * ntk, total = per * nmat;
    for (int it = F.vcu; it < total; it += F.G) {
        const int mat = it / per, rem = it % per, tn = rem / ntk, tk = rem % ntk, k0 = tk * 64, n0 = tn * 64;
        const float* s = src + (size_t)mat * K * N; bf16_t* d = dst + (size_t)mat * Npad * K;
        __syncthreads();
        { const int r = F.tid >> 4, c4 = (F.tid & 15) * 4;
#pragma unroll
          for (int i = 0; i < 2; ++i) { const int rr = r + i * 32; f32x4 v = (f32x4){0.f, 0.f, 0.f, 0.f};
              const int sn0 = n0 < pad_at ? n0 : n0 - pad_len;
              if (sn0 + c4 < N && !(n0 >= pad_at && n0 < pad_at + pad_len)) v = *(const f32x4*)(s + (size_t)(k0 + rr) * N + sn0 + c4);
              tile[rr * 65 + c4 + 0] = v[0]; tile[rr * 65 + c4 + 1] = v[1]; tile[rr * 65 + c4 + 2] = v[2]; tile[rr * 65 + c4 + 3] = v[3]; } }
        __syncthreads();
        { const int n = F.tid >> 3, kc = (F.tid & 7) * 8; float v[8];
#pragma unroll
          for (int e = 0; e < 8; ++e) { v[e] = tile[(kc + e) * 65 + n]; if (gain) v[e] *= gain[(size_t)mat * K + k0 + kc + e]; }
          u32x4 w; w.x = cvt_pk_bf16(v[0], v[1]); w.y = cvt_pk_bf16(v[2], v[3]); w.z = cvt_pk_bf16(v[4], v[5]); w.w = cvt_pk_bf16(v[6], v[7]);
          *(u32x4*)(d + (size_t)(n0 + n) * K + k0 + kc) = w; }
    }
}
__device__ __forceinline__ void cvt_flat(const Ctx& F, const float* src, bf16_t* dst, size_t n8) {
    for (size_t i = (size_t)F.vcu * 512 + F.tid; i < n8; i += (size_t)F.G * 512) {
        const f32x4 a = *(const f32x4*)(src + i * 8), b = *(const f32x4*)(src + i * 8 + 4);
        u32x4 w; w.x = cvt_pk_bf16(a[0], a[1]); w.y = cvt_pk_bf16(a[2], a[3]); w.z = cvt_pk_bf16(b[0], b[1]); w.w = cvt_pk_bf16(b[2], b[3]);
        *(u32x4*)(dst + i * 8) = w;
    }
}
typedef unsigned v6u __attribute__((ext_vector_type(6)));
typedef float v32f __attribute__((ext_vector_type(32)));
typedef float v16f __attribute__((ext_vector_type(16)));
__device__ __forceinline__ float fp6_val(int c) { return c < 8 ? c * 0.125f : (c < 16 ? 1.f + (c - 8) * 0.125f : (c < 24 ? 2.f + (c - 16) * 0.25f : 4.f + (c - 24) * 0.5f)); }
__device__ __forceinline__ int fp6_code(float x) { return x < 1.f ? (int)(x * 8.f + 0.5f) : (x < 2.f ? 8 + (int)((x - 1.f) * 8.f + 0.5f) : (x < 4.f ? 16 + (int)((x - 2.f) * 4.f + 0.5f) : 24 + (int)((x - 4.f) * 2.f + 0.5f))); }
__device__ __forceinline__ void cvt_rows_fp6(const Ctx& F, const float* src, unsigned char* dst, float* descale, int R) {
    float* stg = (float*)(F.lds + 65536) + F.wid * (64 * 33);
    int* permL = (int*)(F.lds + 65536 + 8 * 64 * 33 * 4) + F.wid * 32;
    float fac;
    {   v16f lo, hi;
#pragma unroll
        for (int i = 0; i < 16; ++i) { lo[i] = fp6_val(i); hi[i] = fp6_val(16 + i); }
        const v6u w = __builtin_amdgcn_cvt_scalef32_2xpk16_fp6_f32(lo, hi, 1.0f);
        const v32f f = __builtin_amdgcn_cvt_scalef32_pk32_f32_fp6(w, 1.0f);
        float mx = 0.f;
#pragma unroll
        for (int j = 0; j < 32; ++j) mx = fmaxf(mx, f[j]);
        fac = mx * (1.f / 7.5f);
        const float inv = fac > 0.f ? 1.f / fac : 1.f;
        if (F.lane == 0) {
#pragma unroll
            for (int j = 0; j < 32; ++j) permL[j] = fp6_code(f[j] * inv) & 31; }
        asm volatile("s_waitcnt lgkmcnt(0)" ::: "memory"); __builtin_amdgcn_wave_barrier(); asm volatile("" ::: "memory");
    }
    for (int row = F.vcu * 8 + F.wid; row < R; row += F.G * 8) {
        const float* s = src + (size_t)row * DM + F.lane * 4; f32x4 v[8]; float am = 0.f;
#pragma unroll
        for (int i = 0; i < 8; ++i) { v[i] = *(const f32x4*)(s + i * 256);
#pragma unroll
            for (int e = 0; e < 4; ++e) am = fmaxf(am, fabsf(v[i][e])); }
        am = wave_max(am);
        const float sc = am > 0.f ? 7.f / am : 1.f;
#pragma unroll
        for (int i = 0; i < 8; ++i)
#pragma unroll
            for (int e = 0; e < 4; ++e) stg[F.lane * 33 + permL[i * 4 + e]] = v[i][e] * sc;
        asm volatile("s_waitcnt lgkmcnt(0)" ::: "memory"); __builtin_amdgcn_wave_barrier(); asm volatile("" ::: "memory");
        v16f lo, hi;
#pragma unroll
        for (int i = 0; i < 16; ++i) { lo[i] = stg[F.lane * 33 + i]; hi[i] = stg[F.lane * 33 + 16 + i]; }
        asm volatile("s_waitcnt lgkmcnt(0)" ::: "memory"); __builtin_amdgcn_wave_barrier(); asm volatile("" ::: "memory");
        const v6u w = __builtin_amdgcn_cvt_scalef32_2xpk16_fp6_f32(lo, hi, 1.0f);
        unsigned char* d = dst + (size_t)row * EROW;
        *(u32x4*)(d + F.lane * 16) = (u32x4){w[0], w[1], w[2], w[3]}; *(u32x2*)(d + 1024 + F.lane * 8) = (u32x2){w[4], w[5]};
        if (F.lane == 0) descale[row] = (am > 0.f ? am * (1.f / 7.f) : 1.f) / (fac > 0.f ? fac : 1.f);
    }
}
__device__ __forceinline__ float silu_f(float v) { return v / (1.f + __expf(-v)); }

__device__ __forceinline__ void prologue_phase(const Ctx& F, CParams& P) {
    unsigned char* ws = F.ws;
    {
        float* sv = (float*)F.lds;
        float* part = (float*)(F.lds + 24576);
        for (int i = F.tid; i < 3 * DM; i += 512) { const int v = i / DM, k = i % DM; const float cv = v < 2 ? P.c[v * DM + k] : P.c_ctx[k]; sv[i] = silu_f(cv); }
        __syncthreads();
        float* mod = (float*)(ws + WS_MOD);
        for (int it = F.vcu; it < DEPTH * 192; it += F.G) {
            const int l = it / 192, n0 = (it % 192) * 64;
            const float* wp = P.w_mod + ((size_t)l * DM + F.wid * 256) * 12288 + n0 + F.lane;
            float a0 = 0.f, a1 = 0.f, a2 = 0.f;
#pragma unroll 8
            for (int k = 0; k < 256; ++k) { const float w = wp[(size_t)k * 12288]; const int kk = F.wid * 256 + k; a0 += sv[kk] * w; a1 += sv[DM + kk] * w; a2 += sv[2 * DM + kk] * w; }
            part[(F.wid * 3 + 0) * 64 + F.lane] = a0; part[(F.wid * 3 + 1) * 64 + F.lane] = a1; part[(F.wid * 3 + 2) * 64 + F.lane] = a2;
            __syncthreads();
            if (F.wid < 3) { float s = 0.f;
#pragma unroll
                for (int w = 0; w < 8; ++w) s += part[(w * 3 + F.wid) * 64 + F.lane];
                mod[((size_t)l * 3 + F.wid) * 12288 + n0 + F.lane] = s + P.b_mod[(size_t)l * 12288 + n0 + F.lane]; }
            __syncthreads();
        }
    }
    if (F.vcu == 0) {
        float* t16 = (float*)(ws + WS_TAB16); float* t32 = (float*)(ws + WS_TAB32);
        for (int i = F.tid; i < 128 * 16; i += 512) { const int pos = i >> 4, f = i & 15; const float fr = powf(10000.f, -(float)f / 16.f); const float a = (float)pos * fr; float s, c; sincosf(a, &s, &c); t16[i * 2] = c; t16[i * 2 + 1] = s; }
        for (int i = F.tid; i < 128 * 32; i += 512) { const int pos = i >> 5, f = i & 31; const float fr = powf(10000.f, -(float)f / 32.f); const float a = (float)pos * fr; float s, c; sincosf(a, &s, &c); t32[i * 2] = c; t32[i * 2 + 1] = s; }
        if (F.wid == 2) { float* bnd = (float*)(ws + WS_LAM) + 4;
            for (int e2 = 0; e2 < 2; ++e2) {
                float ga = 0.f, gb = 0.f, gc = 0.f, gd = 0.f, ge = 0.f, gf = 0.f;
                for (int i = F.lane; i < 192; i += 64) { ga = fmaxf(ga, fabsf(P.g_qn_a[e2 * 192 + i])); gb = fmaxf(gb, fabsf(P.g_kn_a[e2 * 192 + i])); }
                gc = fabsf(P.g_qn_b[e2 * 64 + F.lane]); gd = fabsf(P.g_kn_b[e2 * 64 + F.lane]);
                for (int i = F.lane; i < 128; i += 64) { ge = fmaxf(ge, fabsf(P.g_qn_c[e2 * 128 + i])); gf = fmaxf(gf, fabsf(P.g_kn_c[e2 * 128 + i])); }
                ga = wave_max(ga); gb = wave_max(gb); gc = wave_max(gc); gd = wave_max(gd); ge = wave_max(ge); gf = wave_max(gf);
                if (F.lane == 0) { bnd[(2 * e2) * 2 + 0] = 1.03f * 13.856406f * ga * gb;
                                   bnd[(2 * e2) * 2 + 1] = 1.03f * 8.f * gc * gd;
                                   bnd[(2 * e2 + 1) * 2 + 0] = 1.03f * 11.313708f * ge * gf;
                                   bnd[(2 * e2 + 1) * 2 + 1] = 0.f; } } }
        if (F.wid < 2) { const float* lv = P.lam_vec + F.wid * 256; const float d1 = wave_sum(lv[F.lane] * lv[64 + F.lane]), d2 = wave_sum(lv[128 + F.lane] * lv[192 + F.lane]);
            const float lam_init = 0.8f - 0.6f * expf(-0.3f * (float)(2 * F.wid));
            if (F.lane == 0) ((float*)(ws + WS_LAM))[F.wid] = expf(d1) - expf(d2) + lam_init; }
    }
    tconv(F, P.w_in_ab, (bf16_t*)(ws + WS_WINAB), nullptr, 2, DM, AB_IN, AB_INP, 3392, AB_INP - AB_IN);
    tconv(F, P.w_uq, (bf16_t*)(ws + WS_WUQ), P.g_cq, 2, 768, 1536, 1536);
    tconv(F, P.w_ukv, (bf16_t*)(ws + WS_WUKV), P.g_ckv, 2, 512, 2048, 2048);
    tconv(F, P.w_out_ab, (bf16_t*)(ws + WS_WOUTAB), nullptr, 2, DM, DM, DM);
    tconv(F, P.w_in_c, (bf16_t*)(ws + WS_WINC), nullptr, 2, DM, C_IN, C_IN);
    tconv(F, P.w_out_c, (bf16_t*)(ws + WS_WOUTC), nullptr, 2, DM, DM, DM);
    tconv(F, P.w_pq, (bf16_t*)(ws + WS_WPQ), nullptr, 4, DM, DM, DM);
    cvt_flat(F, P.sub_keys, (bf16_t*)(ws + WS_SUBK), (size_t)4 * 8 * 2 * 128 * 128 / 8);
    cvt_rows_fp6(F, P.expert_u, ws + WS_EU, (float*)(ws + WS_SU), 4 * NEXP);
    cvt_rows_fp6(F, P.expert_v, ws + WS_EV, (float*)(ws + WS_SV), 4 * NEXP);
}

__device__ __forceinline__ void norm_rows(const Ctx& F, CParams& P, int layer, int which  , int t_first, int t_end, int t_stride) {
    float* X = (float*)(F.ws + WS_X); bf16_t* H = (bf16_t*)(F.ws + WS_H);
    const float* mod = (const float*)(F.ws + WS_MOD) + (size_t)layer * 3 * 12288;
    const float* gn = (which ? P.g_norm2 : P.g_norm1) + (size_t)layer * DM;
    const bool from_in = (layer == 0 && which == 0);
    const int lane = fresh_lane();
    if (t_first >= t_end) return;
    f32x4 g[8];
#pragma unroll
    for (int j = 0; j < 8; ++j) g[j] = *(const f32x4*)(gn + j * 256 + lane * 4);
    auto srcrow = [&](int t) { return from_in ? (t < TL ? P.x + (size_t)t * DM : P.ctx + (size_t)(t - TL) * DM) : X + (size_t)t * DM; };
    f32x4 vn[8];
    { const float* src = srcrow(t_first);
#pragma unroll
      for (int j = 0; j < 8; ++j) vn[j] = *(const f32x4*)(src + j * 256 + lane * 4); }
    for (int t = t_first; t < t_end; t += t_stride) {
        const int vs = vsel_of_row(t);
        const float* shf = mod + (size_t)vs * 12288 + (which ? 3 : 0) * DM; const float* scl = shf + DM;
        f32x4 v[8], sc[8], sh[8]; float ss = 0.f;
#pragma unroll
        for (int j = 0; j < 8; ++j) { v[j] = vn[j]; sc[j] = *(const f32x4*)(scl + j * 256 + lane * 4); sh[j] = *(const f32x4*)(shf + j * 256 + lane * 4); }
        { const int tn = t + t_stride; const float* src = srcrow(tn < t_end ? tn : t);
#pragma unroll
          for (int j = 0; j < 8; ++j) vn[j] = *(const f32x4*)(src + j * 256 + lane * 4); }
#pragma unroll
        for (int j = 0; j < 8; ++j) ss += v[j][0] * v[j][0] + v[j][1] * v[j][1] + v[j][2] * v[j][2] + v[j][3] * v[j][3];
        ss = wave_sum(ss);
        const float rstd = rsqrtf(ss * (1.f / DM) + EPS);
#pragma unroll
        for (int j = 0; j < 8; ++j) { const int c = j * 256 + lane * 4;
            f32x4 y;
#pragma unroll
            for (int e = 0; e < 4; ++e) y[e] = (v[j][e] * rstd * g[j][e]) * (1.f + sc[j][e]) + sh[j][e];
            u32x2 w; w.x = cvt_pk_bf16(y[0], y[1]); w.y = cvt_pk_bf16(y[2], y[3]);
            *(u32x2*)(H + (size_t)t * DM + c) = w; }
    }
}
__device__ __forceinline__ void norm_phase(const Ctx& F, CParams& P, int layer, int which, int m_rows) { norm_rows(F, P, layer, which, F.vcu * 8 + F.wid, m_rows, F.G * 8); }

__device__ __forceinline__ float grp16_sum(float v) { v += swz_xor<8>(v); v += swz_xor<4>(v); v += swz_xor<2>(v); v += swz_xor<1>(v); return v; }
__device__ __forceinline__ void rope4(float (&x)[4], int q16, int row, int col, const float* t16) {
    const int seg = q16 >> 3, f0 = (q16 & 3) * 4, pos = seg ? col : row; const bool first = (q16 & 7) < 4;
    const f32x4 c0 = *(const f32x4*)(t16 + (pos * 16 + f0) * 2), c1 = *(const f32x4*)(t16 + (pos * 16 + f0) * 2 + 4);
    const float cs[4] = {c0[0], c0[2], c1[0], c1[2]}, sn[4] = {c0[1], c0[3], c1[1], c1[3]};
#pragma unroll
    for (int e = 0; e < 4; ++e) { const float p = swz_xor<4>(x[e]); x[e] = first ? x[e] * cs[e] - p * sn[e] : p * sn[e] + x[e] * cs[e]; }
}
__device__ __forceinline__ void rope8(float (&x)[8], int q16, int row, int col, const float* t32) {
    const int seg = q16 >> 3, f0 = (q16 & 3) * 8, pos = seg ? col : row; const bool first = (q16 & 7) < 4;
    const float* tp = t32 + (pos * 32 + f0) * 2;
#pragma unroll
    for (int q = 0; q < 4; ++q) { const f32x4 c = *(const f32x4*)(tp + q * 4);
#pragma unroll
        for (int s = 0; s < 2; ++s) { const int e = q * 2 + s; const float cs = c[s * 2], sn = c[s * 2 + 1]; const float p = swz_xor<4>(x[e]); x[e] = first ? x[e] * cs - p * sn : p * sn + x[e] * cs; } }
}
__device__ __forceinline__ void ld8bf(const bf16_t* p, float (&x)[8]) { const u32x4 w = *(const u32x4*)p;
#pragma unroll
    for (int q = 0; q < 4; ++q) { x[q * 2] = bf_lo(w[q]); x[q * 2 + 1] = bf_hi(w[q]); } }
__device__ __forceinline__ void ld4bf(const bf16_t* p, float (&x)[4]) { const u32x2 w = *(const u32x2*)p; x[0] = bf_lo(w.x); x[1] = bf_hi(w.x); x[2] = bf_lo(w.y); x[3] = bf_hi(w.y); }
__device__ __forceinline__ void st8bf(bf16_t* p, const float (&x)[8]) { u32x4 w; w.x = cvt_pk_bf16(x[0], x[1]); w.y = cvt_pk_bf16(x[2], x[3]); w.z = cvt_pk_bf16(x[4], x[5]); w.w = cvt_pk_bf16(x[6], x[7]); *(u32x4*)p = w; }
__device__ __forceinline__ void st4bf(bf16_t* p, const float (&x)[4]) { u32x2 w; w.x = cvt_pk_bf16(x[0], x[1]); w.y = cvt_pk_bf16(x[2], x[3]); *(u32x2*)p = w; }

__device__ __forceinline__ void qkv_even_phase(const Ctx& F, CParams& P, int e) {
    const bf16_t* P1 = (const bf16_t*)(F.ws + WS_P1); const bf16_t* QA = (const bf16_t*)(F.ws + WS_QA); const bf16_t* KV = (const bf16_t*)(F.ws + WS_KV);
    bf16_t* Qm = (bf16_t*)(F.ws + WS_Q1); bf16_t* Km = (bf16_t*)(F.ws + WS_K1); bf16_t* Vm = (bf16_t*)(F.ws + WS_V1);
    bf16_t* Qd = (bf16_t*)(F.ws + WS_Q2); bf16_t* Kd = (bf16_t*)(F.ws + WS_K2); bf16_t* Vd = (bf16_t*)(F.ws + WS_V2);
    const float* t16 = (const float*)(F.ws + WS_TAB16);
    const float* gqa = P.g_qn_a + e * 192; const float* gka = P.g_kn_a + e * 192; const float* gqb = P.g_qn_b + e * 64; const float* gkb = P.g_kn_b + e * 64;
    const int q16 = F.lane & 15, grp = F.lane >> 4;
    float gq_n[8], gq_r[4], gk_n[8], gk_r[4], gqd[4], gkd[4];
#pragma unroll
    for (int i = 0; i < 8; ++i) { gq_n[i] = gqa[q16 * 8 + i]; gk_n[i] = gka[q16 * 8 + i]; }
#pragma unroll
    for (int i = 0; i < 4; ++i) { gq_r[i] = gqa[128 + q16 * 4 + i]; gk_r[i] = gka[128 + q16 * 4 + i]; gqd[i] = gqb[q16 * 4 + i]; gkd[i] = gkb[q16 * 4 + i]; }
    struct Raw { u32x2 cq[3]; u32x4 ckv; u32x2 kro; u32x4 qn[2]; u32x2 qr[2]; u32x4 kn[2], kv[2]; u32x2 dq[4], dk[4]; f32x4 rc0, rc1; };
    auto load_raw = [&](int t, Raw& R) {
        const bf16_t* p1 = P1 + (size_t)t * AB_INP;
        { const int s_ = t & (SEQ - 1), pos_ = (q16 >> 3) ? (s_ & 63) : (s_ >> 6); const float* tp = t16 + (pos_ * 16 + (q16 & 3) * 4) * 2; R.rc0 = *(const f32x4*)tp; R.rc1 = *(const f32x4*)(tp + 4); }
#pragma unroll
        for (int j = 0; j < 3; ++j) R.cq[j] = *(const u32x2*)(p1 + j * 256 + F.lane * 4);
        R.ckv = *(const u32x4*)(p1 + 768 + F.lane * 8);
        R.kro = *(const u32x2*)(p1 + 1280 + q16 * 4);
#pragma unroll
        for (int ps = 0; ps < 2; ++ps) { const int h = ps * 4 + grp; const bf16_t* src = QA + (size_t)t * 1536 + h * 192;
            R.qn[ps] = *(const u32x4*)(src + q16 * 8); R.qr[ps] = *(const u32x2*)(src + 128 + q16 * 4);
            const bf16_t* sk = KV + (size_t)t * 2048 + h * 256; R.kn[ps] = *(const u32x4*)(sk + q16 * 8); R.kv[ps] = *(const u32x4*)(sk + 128 + q16 * 8); }
#pragma unroll
        for (int ps = 0; ps < 4; ++ps) { const int hm = ps * 4 + grp; R.dq[ps] = *(const u32x2*)(p1 + 1344 + hm * 64 + q16 * 4); R.dk[ps] = *(const u32x2*)(p1 + 2368 + hm * 64 + q16 * 4); }
    };
#define UNP8(W, X) do { X[0] = bf_lo(W.x); X[1] = bf_hi(W.x); X[2] = bf_lo(W.y); X[3] = bf_hi(W.y); X[4] = bf_lo(W.z); X[5] = bf_hi(W.z); X[6] = bf_lo(W.w); X[7] = bf_hi(W.w); } while (0)
#define UNP4(W, X) do { X[0] = bf_lo(W.x); X[1] = bf_hi(W.x); X[2] = bf_lo(W.y); X[3] = bf_hi(W.y); } while (0)
    const int tfirst = F.vcu * 8 + F.wid, tstr = F.G * 8;
    Raw R; if (tfirst < TT) load_raw(tfirst, R);
    for (int t = tfirst; t < TT; t += tstr) {
        const bool latent = t < TL; const int s = t & (SEQ - 1), row = s >> 6, col = s & 63; const int kr = krow_of(t);
        Raw C = R; { const int tn = t + tstr; load_raw(tn < TT ? tn : t, R); }
        const float rcs[4] = {C.rc0[0], C.rc0[2], C.rc1[0], C.rc1[2]}, rsn[4] = {C.rc0[1], C.rc0[3], C.rc1[1], C.rc1[3]}; const bool rfirst = (q16 & 7) < 4;
#define ROPE4V(X) do { _Pragma("unroll") for (int e_ = 0; e_ < 4; ++e_) { const float p_ = swz_xor<4>(X[e_]); X[e_] = rfirst ? X[e_] * rcs[e_] - p_ * rsn[e_] : p_ * rsn[e_] + X[e_] * rcs[e_]; } } while (0)
        float ss = 0.f;
#pragma unroll
        for (int j = 0; j < 3; ++j) { float x[4]; UNP4(C.cq[j], x); ss += x[0] * x[0] + x[1] * x[1] + x[2] * x[2] + x[3] * x[3]; }
        ss = wave_sum(ss); const float rstd_q = rsqrtf(ss * (1.f / 768.f) + EPS);
        float s2 = 0.f;
        { float x[8]; UNP8(C.ckv, x);
#pragma unroll
          for (int i = 0; i < 8; ++i) s2 += x[i] * x[i]; }
        s2 = wave_sum(s2); const float rstd_kv = rsqrtf(s2 * (1.f / 512.f) + EPS);
        float kro[4]; UNP4(C.kro, kro);
#pragma unroll
        for (int ps = 0; ps < 2; ++ps) { const int h = ps * 4 + grp;
            float xn[8], xr[4]; UNP8(C.qn[ps], xn); UNP4(C.qr[ps], xr);
            float sq = 0.f;
#pragma unroll
            for (int i = 0; i < 8; ++i) { xn[i] *= rstd_q; sq += xn[i] * xn[i]; }
#pragma unroll
            for (int i = 0; i < 4; ++i) { xr[i] *= rstd_q; sq += xr[i] * xr[i]; }
            sq = grp16_sum(sq); const float r = rsqrtf(sq * (1.f / 192.f) + EPS);
            const float rq = r * (0.07216878364870322f * LOG2E);
#pragma unroll
            for (int i = 0; i < 8; ++i) xn[i] *= rq * gq_n[i];
#pragma unroll
            for (int i = 0; i < 4; ++i) xr[i] *= rq * gq_r[i];
            if (latent) ROPE4V(xr);
            bf16_t* dst = Qm + ((size_t)t * 8 + h) * 192; st8bf(dst + q16 * 8, xn); st4bf(dst + 128 + q16 * 4, xr); }
#pragma unroll
        for (int ps = 0; ps < 2; ++ps) { const int h = ps * 4 + grp;
            float xn[8], xr[4], xv[8]; UNP8(C.kn[ps], xn); UNP8(C.kv[ps], xv);
            float sq = 0.f;
#pragma unroll
            for (int i = 0; i < 8; ++i) { xn[i] *= rstd_kv; xv[i] *= rstd_kv; sq += xn[i] * xn[i]; }
#pragma unroll
            for (int i = 0; i < 4; ++i) { xr[i] = kro[i]; sq += xr[i] * xr[i]; }
            sq = grp16_sum(sq); const float r = rsqrtf(sq * (1.f / 192.f) + EPS);
#pragma unroll
            for (int i = 0; i < 8; ++i) xn[i] *= r * gk_n[i];
#pragma unroll
            for (int i = 0; i < 4; ++i) xr[i] *= r * gk_r[i];
            if (latent) ROPE4V(xr);
            bf16_t* dst = Km + ((size_t)kr * 8 + h) * 192; st8bf(dst + q16 * 8, xn); st4bf(dst + 128 + q16 * 4, xr);
            st8bf(Vm + ((size_t)kr * 8 + h) * 128 + q16 * 8, xv); }
#pragma unroll
        for (int ps = 0; ps < 4; ++ps) { const int hm = ps * 4 + grp;
            float x[4]; UNP4(C.dq[ps], x);
            float sq = grp16_sum(x[0] * x[0] + x[1] * x[1] + x[2] * x[2] + x[3] * x[3]); float r = rsqrtf(sq * (1.f / 64.f) + EPS);
#pragma unroll
            for (int i = 0; i < 4; ++i) x[i] *= r * (0.125f * LOG2E) * gqd[i];
            if (latent) ROPE4V(x);
            st4bf(Qd + ((size_t)t * 16 + hm) * 64 + q16 * 4, x);
            UNP4(C.dk[ps], x);
            sq = grp16_sum(x[0] * x[0] + x[1] * x[1] + x[2] * x[2] + x[3] * x[3]); r = rsqrtf(sq * (1.f / 64.f) + EPS);
#pragma unroll
            for (int i = 0; i < 4; ++i) x[i] *= r * gkd[i];
            if (latent) ROPE4V(x);
            st4bf(Kd + ((size_t)kr * 16 + hm) * 64 + q16 * 4, x); }
    }
#undef UNP8
#undef UNP4
#undef ROPE4V
}
__device__ __forceinline__ void qkv_odd_rows(const Ctx& F, CParams& P, int e, int t_first, int t_end, int t_stride) {
    const bf16_t* P1 = (const bf16_t*)(F.ws + WS_P1);
    bf16_t* Qc = (bf16_t*)(F.ws + WS_Q1); bf16_t* Kc = (bf16_t*)(F.ws + WS_K1); bf16_t* Vc = (bf16_t*)(F.ws + WS_V1);
    const float* t32 = (const float*)(F.ws + WS_TAB32);
    const int lane = fresh_lane();
    const int q16 = lane & 15, grp = lane >> 4;
    float gq[8], gk[8];
#pragma unroll
    for (int i = 0; i < 8; ++i) { gq[i] = P.g_qn_c[e * 128 + q16 * 8 + i]; gk[i] = P.g_kn_c[e * 128 + q16 * 8 + i]; }
    if (t_first >= t_end) return;
    struct Raw { u32x4 x[5]; f32x4 rc[4]; };
    auto load_raw = [&](int t, Raw& R) {
        const bf16_t* p1 = P1 + (size_t)t * C_IN;
#pragma unroll
        for (int ps = 0; ps < 5; ++ps) { const bool isq = ps < 4; const int h = isq ? ps * 4 + grp : grp; R.x[ps] = *(const u32x4*)(p1 + (isq ? 0 : 2048) + h * 128 + q16 * 8); }
        const int s_ = t & (SEQ - 1), pos_ = (q16 >> 3) ? (s_ & 63) : (s_ >> 6); const float* tp = t32 + (pos_ * 32 + (q16 & 3) * 8) * 2;
#pragma unroll
        for (int q = 0; q < 4; ++q) R.rc[q] = *(const f32x4*)(tp + q * 4);
    };
    Raw R; load_raw(t_first, R);
    for (int t = t_first; t < t_end; t += t_stride) {
        const bool latent = t < TL; const int kr = krow_of(t);
        Raw C = R; { const int tn = t + t_stride; load_raw(tn < t_end ? tn : t, R); }
        const bool rfirst = (q16 & 7) < 4;
#pragma unroll
        for (int ps = 0; ps < 5; ++ps) {
            const bool isq = ps < 4; const int h = isq ? ps * 4 + grp : grp;
            float x[8]; { const u32x4 w = C.x[ps]; x[0] = bf_lo(w.x); x[1] = bf_hi(w.x); x[2] = bf_lo(w.y); x[3] = bf_hi(w.y); x[4] = bf_lo(w.z); x[5] = bf_hi(w.z); x[6] = bf_lo(w.w); x[7] = bf_hi(w.w); }
            float sq = 0.f;
#pragma unroll
            for (int i = 0; i < 8; ++i) sq += x[i] * x[i];
            sq = grp16_sum(sq); const float r = rsqrtf(sq * (1.f / 128.f) + EPS);
#pragma unroll
            for (int i = 0; i < 8; ++i) x[i] *= r * (isq ? gq[i] * (0.08838834764831845f * LOG2E) : gk[i]);
            if (latent) {
#pragma unroll
                for (int q = 0; q < 4; ++q)
#pragma unroll
                    for (int s2 = 0; s2 < 2; ++s2) { const int e = q * 2 + s2; const float cs = C.rc[q][s2 * 2], sn = C.rc[q][s2 * 2 + 1]; const float p = swz_xor<4>(x[e]); x[e] = rfirst ? x[e] * cs - p * sn : p * sn + x[e] * cs; } }
            st8bf(isq ? Qc + ((size_t)t * 16 + h) * 128 + q16 * 8 : Kc + ((size_t)kr * 4 + h) * 128 + q16 * 8, x); }
    }
}

template <int DQK, int SDEPTH, int ldo, int NH, int NKVH, int NVH>
__device__ __forceinline__ void attn_phase(const Ctx& F, const bf16_t* Qbuf, const bf16_t* Kbuf, const bf16_t* Vbuf, bf16_t* OF, int ocol0, bool with_ctx, const float bound  ) {
    const bool nomax = bound < 60.f;
    const float negMC = 0.f;
    constexpr int kv_div = NH / NKVH, v_div = NH / NVH;
    const int n_lat = NH * NB * 32, n_tot = n_lat + (with_ctx ? NH * NB : 0);
    constexpr int ldq = NH * DQK, ldk = NKVH * DQK, ldv = NVH * 128;
    for (int u = F.vcu; u < n_tot; u += F.G) {
        int b, h, qrow0, kstart, seq;
        if (u < n_lat) { const int bh = u >> 5, qb = u & 31; b = bh / NH; h = bh % NH; qrow0 = b * SEQ + qb * 256; kstart = b * KPB; seq = KPB; }
        else { const int bh = u - n_lat; b = bh / NH; h = bh % NH; qrow0 = TL + b * CTXL; kstart = b * KPB + SEQ; seq = CTXL; }
        const bf16_t* Qp = Qbuf + ((size_t)qrow0 * NH + h) * DQK;
        const bf16_t* Kp = Kbuf + ((size_t)kstart * NKVH + h / kv_div) * DQK;
        const bf16_t* Vp = Vbuf + ((size_t)kstart * NVH + h / v_div) * 128;
        bf16_t* Op = OF + (size_t)qrow0 * ldo + ocol0 + h * 128;
        if constexpr (SDEPTH == 0) att::attn_body_simple<DQK, (DQK == 192 ? MLA_QL : 0), ldq, ldk, ldv, ldo>(Qp, Kp, Vp, Op, seq, F.lds, F.wid);
        else { if (nomax) att::attn_body<DQK, SDEPTH, (DQK == 192 ? MLA_QL : (DQK == 128 ? GQA_QL : 0)), true, ldq, ldk, ldv, ldo>(Qp, Kp, Vp, Op, seq, F.lds, F.wid, negMC);
               else att::attn_body_simple<DQK, 0, ldq, ldk, ldv, ldo>(Qp, Kp, Vp, Op, seq, F.lds, F.wid); }
    }
}

__device__ __forceinline__ void merge_even_phase(const Ctx& F, CParams& P, int e, int layer, int m_rows) {
    const bf16_t* OD = (const bf16_t*)(F.ws + WS_OF); bf16_t* AO = (bf16_t*)(F.ws + WS_AO);
    const float lam = ((const float*)(F.ws + WS_LAM))[e];
    const float lam_init = 0.8f - 0.6f * expf(-0.3f * (float)layer);
    const int q16 = F.lane & 15, grp = F.lane >> 4;
    float gs[8];
#pragma unroll
    for (int i = 0; i < 8; ++i) gs[i] = P.g_sub_b[e * 128 + q16 * 8 + i] * (1.f - lam_init);
    for (int t = F.vcu * 8 + F.wid; t < m_rows; t += F.G * 8) {
        const bf16_t* od = OD + (size_t)t * DM; bf16_t* ao = AO + (size_t)t * DM + 1024;
#pragma unroll
        for (int ps = 0; ps < 2; ++ps) { const int h = ps * 4 + grp;
            float o0[8], o1[8], d[8]; ld8bf(od + (2 * h) * 128 + q16 * 8, o0); ld8bf(od + (2 * h + 1) * 128 + q16 * 8, o1);
            float sq = 0.f;
#pragma unroll
            for (int i = 0; i < 8; ++i) { d[i] = o0[i] - lam * o1[i]; sq += d[i] * d[i]; }
            sq = grp16_sum(sq); const float r = rsqrtf(sq * (1.f / 128.f) + EPS);
#pragma unroll
            for (int i = 0; i < 8; ++i) d[i] *= r * gs[i];
            st8bf(ao + h * 128 + q16 * 8, d); }
    }
}

__device__ __forceinline__ void wave_lds_fence() { asm volatile("s_waitcnt lgkmcnt(0)" ::: "memory"); __builtin_amdgcn_wave_barrier(); asm volatile("" ::: "memory"); }
__device__ __forceinline__ unsigned fkey(float f) { const unsigned b = __float_as_uint(f); return b ^ ((unsigned)((int)b >> 31) | 0x80000000u); }
__device__ __forceinline__ float funkey(unsigned k) { return __uint_as_float((k & 0x80000000u) ? (k ^ 0x80000000u) : ~k); }
__device__ __forceinline__ unsigned umed3(unsigned a, unsigned b, unsigned c) { unsigned r; asm("v_med3_u32 %0, %1, %2, %3" : "=v"(r) : "v"(a), "v"(b), "v"(c)); return r; }
__device__ __forceinline__ void kins16(unsigned (&L)[16], unsigned k) {
#pragma unroll
    for (int p = 15; p >= 1; --p) L[p] = umed3(L[p - 1], L[p], k);
    L[0] = L[0] > k ? L[0] : k;
}
__device__ __forceinline__ void scan_set(unsigned (&L)[16], const bf16_t* qbase  , const bf16_t* kbase  , float* buf, int lane) {
    const int r32 = lane & 31, hi = lane >> 5;
#pragma unroll
    for (int p = 0; p < 16; ++p) L[p] = 0u;
    bf16x8 a0[8], a1[8];
    { const bf16_t* ap = qbase + (size_t)r32 * DM + hi * 8;
#pragma unroll
      for (int ks = 0; ks < 8; ++ks) { a0[ks] = *(const bf16x8*)(ap + ks * 16); a1[ks] = *(const bf16x8*)(ap + (size_t)32 * DM + ks * 16); } }
#pragma unroll 1
    for (int kb = 0; kb < 4; ++kb) {
        f32x16 acc0 = {}, acc1 = {};
        { const bf16_t* bp = kbase + (size_t)(kb * 32 + r32) * 128 + hi * 8;
          bf16x8 b[8];
#pragma unroll
          for (int ks = 0; ks < 8; ++ks) b[ks] = *(const bf16x8*)(bp + ks * 16);
#pragma unroll
          for (int ks = 0; ks < 8; ++ks) { acc0 = __builtin_amdgcn_mfma_f32_32x32x16_bf16(a0[ks], b[ks], acc0, 0, 0, 0); acc1 = __builtin_amdgcn_mfma_f32_32x32x16_bf16(a1[ks], b[ks], acc1, 0, 0, 0); } }
        wave_lds_fence();
#pragma unroll
        for (int r = 0; r < 16; ++r) { const int rowi = att::crow(r, hi); buf[rowi * 33 + r32] = acc0[r]; buf[(32 + rowi) * 33 + r32] = acc1[r]; }
        wave_lds_fence();
        const unsigned tb = 127u - (unsigned)(kb * 32);
#pragma unroll 8
        for (int k = 0; k < 32; ++k) { unsigned code = tb - (unsigned)k; asm volatile("" : "+s"(code)); kins16(L, (fkey(buf[lane * 33 + k]) & ~127u) | code); }
    }
}
__device__ __forceinline__ void peer_select_unit(const Ctx& F, int layer, int u) {
    const bf16_t* PQ = (const bf16_t*)(F.ws + WS_PQ); const bf16_t* SK = (const bf16_t*)(F.ws + WS_SUBK) + (size_t)layer * 8 * 2 * 128 * 128;
    int* PIDX = (int*)(F.ws + WS_PIDX); float* PG = (float*)(F.ws + WS_PG);
    float* buf = (float*)F.lds + F.wid * (64 * 33);
    const int lane = fresh_lane();
    {
        const int tile = u >> 3, h = u & 7, t0 = tile * 64;
        unsigned Ka[16], Kb[16];
        scan_set(Ka, PQ + (size_t)t0 * DM + h * 256, SK + (size_t)(h * 2) * 128 * 128, buf, lane);
        scan_set(Kb, PQ + (size_t)t0 * DM + h * 256 + 128, SK + (size_t)(h * 2 + 1) * 128 * 128, buf, lane);
        wave_lds_fence();
        float la[16], lb[16];
#pragma unroll
        for (int p = 0; p < 16; ++p) { la[p] = funkey(Ka[p] & ~127u); lb[p] = funkey(Kb[p] & ~127u);
            buf[lane * 33 + p] = __int_as_float(127 - (int)(Ka[p] & 127u)); buf[lane * 33 + 16 + p] = __int_as_float(127 - (int)(Kb[p] & 127u)); }
        wave_lds_fence();
        unsigned Kc[16];
#pragma unroll
        for (int p = 0; p < 16; ++p) Kc[p] = (fkey(la[0] + lb[p]) & ~255u) | (unsigned)(255 - p);
#pragma unroll
        for (int r1 = 1; r1 < 16; ++r1)
#pragma unroll
            for (int r2 = 0; r2 < 16; ++r2) if ((r1 + 1) * (r2 + 1) <= 16) kins16(Kc, (fkey(la[r1] + lb[r2]) & ~255u) | (unsigned)(255 - (16 * r1 + r2)));
        float bv[16], sm = 0.f; unsigned idx[16];
#pragma unroll
        for (int p = 0; p < 16; ++p) { const int code = 255 - (int)(Kc[p] & 255u); bv[p] = funkey(Kc[p] & ~255u);
            idx[p] = (unsigned)(__float_as_int(buf[lane * 33 + (code >> 4)]) * 128 + __float_as_int(buf[lane * 33 + 16 + (code & 15)])); }
        const float bmax = bv[0];
#pragma unroll
        for (int p = 0; p < 16; ++p) { bv[p] = __expf(bv[p] - bmax); sm += bv[p]; }
        const float inv = 1.f / sm;
        const size_t o = ((size_t)(t0 + lane) * 8 + h) * 16;
#pragma unroll
        for (int q = 0; q < 4; ++q) { *(f32x4*)(PG + o + q * 4) = (f32x4){bv[q * 4] * inv, bv[q * 4 + 1] * inv, bv[q * 4 + 2] * inv, bv[q * 4 + 3] * inv};
            *(u32x4*)(PIDX + o + q * 4) = (u32x4){idx[q * 4], idx[q * 4 + 1], idx[q * 4 + 2], idx[q * 4 + 3]}; }
    }
}
__device__ __forceinline__ bool ctx_sel_hidden(const Ctx& F) { return F.G == 256; }
__device__ __forceinline__ void peer_select_phase(const Ctx& F, int layer, int m_rows) {
    const int nunits = ((ctx_sel_hidden(F) ? TL : m_rows) / 64) * 8;
#pragma unroll 1
    for (int u = F.vcu * 8 + F.wid; u < nunits; u += F.G * 8) peer_select_unit(F, layer, u);
}

__device__ __forceinline__ float gelu_tanh(float a) { const float u = 0.7978845608028654f * (a + 0.044715f * a * a * a); const float t = 1.f - 2.f / (1.f + __expf(2.f * u)); return 0.5f * a * (1.f + t); }
struct Row6 { u32x2 r[3]; };
__device__ __forceinline__ void ld_row6(Row6& R, const unsigned char* tab, int e, int lane) {
    const unsigned char* rb = tab + (size_t)e * EROW;
    const u32x4 a = *(const u32x4*)(rb + (unsigned)lane * 16u); const u32x2 b = *(const u32x2*)(rb + 1024 + (unsigned)lane * 8u);
    R.r[0] = (u32x2){a.x, a.y}; R.r[1] = (u32x2){a.z, a.w}; R.r[2] = b;
}
__device__ __forceinline__ v32f dq_row6(const Row6& R, float dep) { unsigned r0 = R.r[0].x; asm volatile("" : "+v"(r0) : "v"(dep));
    const v6u w = {r0, R.r[0].y, R.r[1].x, R.r[1].y, R.r[2].x, R.r[2].y}; return __builtin_amdgcn_cvt_scalef32_pk32_f32_fp6(w, 1.0f); }
__device__ __forceinline__ float dot_row6(const Row6& R, const float (&h)[32], float& chain) {
    const v32f f = dq_row6(R, chain);
    typedef float f2_t __attribute__((ext_vector_type(2)));
    f2_t a = {0.f, 0.f}, b = {0.f, 0.f};
#pragma unroll
    for (int i = 0; i < 8; ++i) { a = __builtin_elementwise_fma((f2_t){f[i * 4 + 0], f[i * 4 + 1]}, (f2_t){h[i * 4 + 0], h[i * 4 + 1]}, a);
                                  b = __builtin_elementwise_fma((f2_t){f[i * 4 + 2], f[i * 4 + 3]}, (f2_t){h[i * 4 + 2], h[i * 4 + 3]}, b); }
    const float s = (a[0] + a[1]) + (b[0] + b[1]);
    chain = s;
    return s;
}
__device__ __forceinline__ void fma_row6(float (&out)[32], const Row6& R, float w) {
    const v32f f = dq_row6(R, out[0]);
#pragma unroll
    for (int i = 0; i < 32; ++i) out[i] = fmaf(w, f[i], out[i]);
}
__device__ __forceinline__ float reduce4(float s0, float s1, float s2, float s3, int lane) {
    const bool hi = (lane & 32) != 0, b4 = (lane & 16) != 0;
    const float r0 = xor32_partner(hi ? s0 : s2, lane), r1 = xor32_partner(hi ? s1 : s3, lane);
    const float a0 = (hi ? s2 : s0) + r0, a1 = (hi ? s3 : s1) + r1;
    const float r = swz_xor<16>(b4 ? a0 : a1);
    float b = (b4 ? a1 : a0) + r;
    b += swz_xor<8>(b); b += swz_xor<4>(b); b += swz_xor<2>(b); b += swz_xor<1>(b);
    return b;
}
__device__ __forceinline__ float rl_f(float v, int l) { return __uint_as_float(__builtin_amdgcn_readlane(__float_as_uint(v), l)); }
__device__ __forceinline__ void wr_lane(float& dst, float val_uniform, int lane_uniform, int lane) { asm volatile("" : "+s"(lane_uniform)); dst = (lane == lane_uniform) ? val_uniform : dst; }
__device__ __forceinline__ void peer_expert_tokens(const Ctx& F, CParams& P, int layer, int m_rows_all, bool last, bool dry, bool hide, unsigned* selflag, int k_lo, int k_hi) {
    const unsigned char* EU = F.ws + WS_EU + (size_t)layer * NEXP * EROW; const unsigned char* EV = F.ws + WS_EV + (size_t)layer * NEXP * EROW;
    const float* SU = (const float*)(F.ws + WS_SU) + (size_t)layer * NEXP; const float* SV = (const float*)(F.ws + WS_SV) + (size_t)layer * NEXP;
    const bf16_t* H = (const bf16_t*)(F.ws + WS_H); float* X = (float*)(F.ws + WS_X);
    const int* PIDX = (const int*)(F.ws + WS_PIDX); const float* PG = (const float*)(F.ws + WS_PG);
    const float* mod = (const float*)(F.ws + WS_MOD) + (size_t)layer * 3 * 12288;
    const int lane = fresh_lane();
    const int tstride = F.G * 8, t0 = F.vcu * 8 + F.wid + k_lo * tstride;
    const int m_hi = F.vcu * 8 + F.wid + k_hi * tstride, m_rows = m_hi < m_rows_all ? m_hi : m_rows_all;
    if (t0 >= m_rows) return;
    int id0 = PIDX[(size_t)t0 * 128 + lane], id1 = PIDX[(size_t)t0 * 128 + 64 + lane];
    u32x2 hp4[8]; float gk0, gk1;
    { const bf16_t* hp = H + (size_t)t0 * DM + (unsigned)lane * 4u;
#pragma unroll
      for (int j = 0; j < 8; ++j) hp4[j] = *(const u32x2*)(hp + j * 256); }
    gk0 = PG[(size_t)t0 * 128 + lane]; gk1 = PG[(size_t)t0 * 128 + 64 + lane];
    Row6 A[4], B[4];
#pragma unroll
    for (int q = 0; q < 4; ++q) ld_row6(A[q], EU, __builtin_amdgcn_readlane(id0, q), lane);
    for (int t = t0; t < m_rows; t += tstride) {
        const int tn = t + tstride; const int tq = tn < m_rows ? tn : t;
        float hf[32];
#pragma unroll
        for (int j = 0; j < 8; ++j) { hf[j * 4 + 0] = bf_lo(hp4[j].x); hf[j * 4 + 1] = bf_hi(hp4[j].x); hf[j * 4 + 2] = bf_lo(hp4[j].y); hf[j * 4 + 3] = bf_hi(hp4[j].y); }
        const float cgk0 = gk0, cgk1 = gk1;
        const float su0 = SU[id0], sv0 = SV[id0], su1 = SU[id1], sv1 = SV[id1];
        int nid0, nid1; float ngk0, ngk1;
        if (hide && tq >= TL) {
            { unsigned sp = 0u; while (xb_ld(selflag) < (unsigned)((TT - TL) / 64 * 8)) { __builtin_amdgcn_s_sleep(1); if (++sp > XB_SPIN_CAP) break; } }
            __builtin_amdgcn_fence(__ATOMIC_ACQUIRE, "agent");
            nid0 = __hip_atomic_load(PIDX + (size_t)tq * 128 + lane, __ATOMIC_RELAXED, __HIP_MEMORY_SCOPE_AGENT); nid1 = __hip_atomic_load(PIDX + (size_t)tq * 128 + 64 + lane, __ATOMIC_RELAXED, __HIP_MEMORY_SCOPE_AGENT);
            ngk0 = __int_as_float(__hip_atomic_load((const int*)PG + (size_t)tq * 128 + lane, __ATOMIC_RELAXED, __HIP_MEMORY_SCOPE_AGENT)); ngk1 = __int_as_float(__hip_atomic_load((const int*)PG + (size_t)tq * 128 + 64 + lane, __ATOMIC_RELAXED, __HIP_MEMORY_SCOPE_AGENT));
        } else { nid0 = PIDX[(size_t)tq * 128 + lane]; nid1 = PIDX[(size_t)tq * 128 + 64 + lane]; ngk0 = PG[(size_t)tq * 128 + lane]; ngk1 = PG[(size_t)tq * 128 + 64 + lane]; }
        { const bf16_t* hp = H + (size_t)tq * DM + (unsigned)lane * 4u;
#pragma unroll
          for (int j = 0; j < 8; ++j) hp4[j] = *(const u32x2*)(hp + j * 256); }
        gk0 = ngk0; gk1 = ngk1;
        float wv0 = 0.f, wv1 = 0.f;
        float out[32];
#pragma unroll
        for (int i = 0; i < 32; ++i) out[i] = 0.f;
#pragma unroll
        for (int seg = 0; seg < 4; ++seg) {
            const int idc = (seg & 1) ? id1 : id0;
            const int idn = (seg == 0) ? id1 : (seg == 1 ? id0 : (seg == 2 ? id1 : nid0));
            const unsigned char* tabc = seg < 2 ? EU : EV; const unsigned char* tabn = (seg == 0 || seg == 3) ? EU : EV;
            const float wr = (seg & 1) ? wv1 : wv0;
            float acc = 0.f, chain = 0.f;
#pragma unroll 1
            for (int k = 0; k < 64; k += 8) {
#pragma unroll
                for (int q = 0; q < 4; ++q) ld_row6(B[q], tabc, __builtin_amdgcn_readlane(idc, k + 4 + q), lane);
                if (seg < 2) { const float d0 = dot_row6(A[0], hf, chain), d1 = dot_row6(A[1], hf, chain), d2 = dot_row6(A[2], hf, chain), d3 = dot_row6(A[3], hf, chain); const float b = reduce4(d0, d1, d2, d3, lane);
#pragma unroll
                    for (int q = 0; q < 4; ++q) wr_lane(acc, rl_f(b, 16 * q), k + q, lane); }
                else {
#pragma unroll
                    for (int q = 0; q < 4; ++q) fma_row6(out, A[q], rl_f(wr, k + q)); }
                { const bool nx = k + 8 >= 64;
#pragma unroll
                  for (int q = 0; q < 4; ++q) { const int ec = __builtin_amdgcn_readlane(idc, (k + 8 + q) & 63), en = __builtin_amdgcn_readlane(idn, q);
                      ld_row6(A[q], nx ? tabn : tabc, nx ? en : ec, lane); } }
                if (seg < 2) { const float d0 = dot_row6(B[0], hf, chain), d1 = dot_row6(B[1], hf, chain), d2 = dot_row6(B[2], hf, chain), d3 = dot_row6(B[3], hf, chain); const float b = reduce4(d0, d1, d2, d3, lane);
#pragma unroll
                    for (int q = 0; q < 4; ++q) wr_lane(acc, rl_f(b, 16 * q), k + 4 + q, lane); }
                else {
#pragma unroll
                    for (int q = 0; q < 4; ++q) fma_row6(out, B[q], rl_f(wr, k + 4 + q)); }
            }
            if (seg == 0) wv0 = cgk0 * gelu_tanh(acc * su0) * sv0;
            if (seg == 1) wv1 = cgk1 * gelu_tanh(acc * su1) * sv1;
        }
        id0 = nid0; id1 = nid1;
        const int vs = vsel_of_row(t);
        const float* gate = mod + (size_t)vs * 12288 + 5 * DM;
        float* xr = X + (size_t)t * DM; float* dst = dry ? (float*)(F.ws + WS_OF) + (size_t)t * DM : (last ? P.out + (size_t)t * DM : xr);
        float ssq = 0.f;
        const unsigned lo4 = (unsigned)lane * 4u;
        { f32x4 xo[8], gg[8];
#pragma unroll
          for (int q = 0; q < 8; ++q) { const unsigned c = lo4 + q * 256; xo[q] = *(const f32x4*)(xr + c); gg[q] = *(const f32x4*)(gate + c); }
#pragma unroll
          for (int q = 0; q < 8; ++q) { const unsigned c = lo4 + q * 256;
            f32x4 y; y[0] = xo[q][0] + gg[q][0] * out[q * 4 + 0]; y[1] = xo[q][1] + gg[q][1] * out[q * 4 + 1]; y[2] = xo[q][2] + gg[q][2] * out[q * 4 + 2]; y[3] = xo[q][3] + gg[q][3] * out[q * 4 + 3];
            *(f32x4*)(dst + c) = y;
            out[q * 4 + 0] = y[0]; out[q * 4 + 1] = y[1]; out[q * 4 + 2] = y[2]; out[q * 4 + 3] = y[3];
            ssq += y[0] * y[0] + y[1] * y[1] + y[2] * y[2] + y[3] * y[3]; } }
        if (!last && !dry) {
            const float rstd = rsqrtf(wave_sum(ssq) * (1.f / DM) + EPS);
            const float* gn = P.g_norm1 + (size_t)(layer + 1) * DM;
            const float* shf = mod + (size_t)3 * 12288 + (size_t)vs * 12288; const float* scl = shf + DM;
            bf16_t* hrow = (bf16_t*)(F.ws + WS_H) + (size_t)t * DM;
#pragma unroll
            for (int jh = 0; jh < 2; ++jh) { f32x4 g8[4], sc8[4], sh8[4];
#pragma unroll
                for (int i = 0; i < 4; ++i) { const unsigned c = lo4 + (jh * 4 + i) * 256; g8[i] = *(const f32x4*)(gn + c); sc8[i] = *(const f32x4*)(scl + c); sh8[i] = *(const f32x4*)(shf + c); }
#pragma unroll
                for (int i = 0; i < 4; ++i) { const int qg = jh * 4 + i; const f32x4 g = g8[i], sc = sc8[i], sh = sh8[i];
                    float y[4];
#pragma unroll
                    for (int e2 = 0; e2 < 4; ++e2) y[e2] = (out[qg * 4 + e2] * rstd * g[e2]) * (1.f + sc[e2]) + sh[e2];
                    u32x2 w; w.x = cvt_pk_bf16(y[0], y[1]); w.y = cvt_pk_bf16(y[2], y[3]);
                    *(u32x2*)(hrow + lo4 + qg * 256) = w; } }
        }
    }
}

__device__ __forceinline__ void ctl_wait(unsigned* c, unsigned want) { unsigned sp = 0u; while (xb_ld(c) < want) { __builtin_amdgcn_s_sleep(1); if (++sp > XB_SPIN_CAP) break; } }
__device__ __forceinline__ void peer_expert_phase(const Ctx& F, CParams& P, int layer, int m_rows, bool last, bool dry, LAS unsigned char* ldsl, const bf16_t* Wout) {
    const bool hide = ctx_sel_hidden(F) && m_rows > TL && !dry;
    unsigned* ctl = (unsigned*)(F.ws + WS_CTL) + 8192 + layer * 512;
    unsigned* selflag = ctl;
    int role = 0, ri = 0;
    if (hide && F.vcu >= 64) { const int d = F.vcu - 64;
        if (d % 12 == 0) { role = 1; ri = d / 12; } else if (d % 12 == 6) { role = 2; ri = d / 12; } else if (d % 3 == 1 && F.wid == 0) { role = 3; ri = d / 3; } }
    const int ksplit = role == 1 ? 0 : (role == 2 ? 1 : (role == 3 ? 2 : 9));
#pragma unroll 1
    for (int st = 0; st < 2; ++st) {
        const int kb = st == 0 ? 0 : ksplit, ke = st == 0 ? ksplit : 9;
        if (ke > kb) peer_expert_tokens(F, P, layer, m_rows, last, dry, hide, selflag, kb, ke);
        if (st != 0 || role == 0) continue;
        const int pmi = ri >> 3, pn = ri & 7, pm = TL / 256 + pmi;
        if (role == 1) {
            { pg8::Gemm g{(const bf16_t*)(F.ws + WS_AO), Wout, TT, DM, DM, DM}; pg8::OneUnit S{pm, pn};
              pg8::EpiResid E{(float*)(F.ws + WS_X), (const float*)(F.ws + WS_MOD) + (size_t)layer * 3 * 12288, 2, layer == 0 ? P.x : (const float*)(F.ws + WS_X), layer == 0 ? P.ctx : (const float*)(F.ws + WS_X) + (size_t)TL * DM};
              pg8::gemm_phase<pg8::EpiResid, pg8::OneUnit>(ldsl, g, S, E, F.wid); }
            asm volatile("s_waitcnt vmcnt(0)" ::: "memory"); __syncthreads();
            if (F.wid == 0 && fresh_lane() == 0) { __builtin_amdgcn_fence(__ATOMIC_RELEASE, "agent"); asm volatile("s_waitcnt vmcnt(0)" ::: "memory"); (void)xb_add(ctl + 64 + 64 * pmi, 1u);
                           ctl_wait(ctl + 64 + 64 * pmi, 8u); __builtin_amdgcn_fence(__ATOMIC_ACQUIRE, "agent"); }
            __syncthreads();
            { const int r0 = pm * 256 + pn * 32 + F.wid * 4; norm_rows(F, P, layer, 1, r0, r0 + 4, 1); }
            asm volatile("s_waitcnt vmcnt(0)" ::: "memory"); __syncthreads();
            if (F.wid == 0 && fresh_lane() == 0) { __builtin_amdgcn_fence(__ATOMIC_RELEASE, "agent"); asm volatile("s_waitcnt vmcnt(0)" ::: "memory"); (void)xb_add(ctl + 192 + 64 * pmi, 1u); }
        } else if (role == 2) {
            __syncthreads();
            if (F.wid == 0 && fresh_lane() == 0) { ctl_wait(ctl + 192 + 64 * pmi, 8u); __builtin_amdgcn_fence(__ATOMIC_ACQUIRE, "agent"); }
            __syncthreads();
            { pg8::Gemm g{(const bf16_t*)(F.ws + WS_H), (const bf16_t*)(F.ws + WS_WPQ) + (size_t)layer * DM * DM, TT, DM, DM, DM}; pg8::OneUnit S{pm, pn};
              pg8::EpiBf16 E{(bf16_t*)(F.ws + WS_PQ), DM};
              pg8::gemm_phase<pg8::EpiBf16, pg8::OneUnit>(ldsl, g, S, E, F.wid); }
            asm volatile("s_waitcnt vmcnt(0)" ::: "memory"); __syncthreads();
            if (F.wid == 0 && fresh_lane() == 0) { __builtin_amdgcn_fence(__ATOMIC_RELEASE, "agent"); asm volatile("s_waitcnt vmcnt(0)" ::: "memory"); (void)xb_add(ctl + 320, 1u); }
        } else {
            ctl_wait(ctl + 320, 16u); __builtin_amdgcn_fence(__ATOMIC_ACQUIRE, "agent");
            peer_select_unit(F, layer, (TL / 64) * 8 + ri);
            __builtin_amdgcn_fence(__ATOMIC_RELEASE, "agent");
            asm volatile("s_waitcnt vmcnt(0)" ::: "memory");
            if (fresh_lane() == 0) (void)xb_add(selflag, 1u);
        }
    }
}

__device__ __forceinline__ void qkv_odd_phase(const Ctx& F, CParams& P, int e, int layer, LAS unsigned char* ldsl) {
    if (!ctx_sel_hidden(F)) { qkv_odd_rows(F, P, e, F.vcu * 8 + F.wid, TT, F.G * 8); return; }
    const int vx = F.vcu & 31, xq = F.vcu >> 5;
    if (vx >= 29) {
        const int i = xq * 3 + vx - 29, pmi = i / 12, pn = i % 12;
        unsigned* cnt = (unsigned*)(F.ws + WS_CTL) + 8192 + layer * 512 + 384 + 64 * pmi;
        { pg8::Gemm g{(const bf16_t*)(F.ws + WS_H), (const bf16_t*)(F.ws + WS_WINC) + (size_t)e * C_IN * DM, TT, C_IN, DM, DM}; pg8::OneUnit S{TL / 256 + pmi, pn};
          pg8::EpiBf16V E{(bf16_t*)(F.ws + WS_P1), C_IN, (bf16_t*)(F.ws + WS_V1), 10, 512};
          pg8::gemm_phase<pg8::EpiBf16V, pg8::OneUnit>(ldsl, g, S, E, F.wid); }
        asm volatile("s_waitcnt vmcnt(0)" ::: "memory"); __syncthreads();
        if (F.wid == 0 && fresh_lane() == 0) { __builtin_amdgcn_fence(__ATOMIC_RELEASE, "agent"); asm volatile("s_waitcnt vmcnt(0)" ::: "memory"); (void)xb_add(cnt, 1u);
                                               ctl_wait(cnt, 12u); __builtin_amdgcn_fence(__ATOMIC_ACQUIRE, "agent"); }
        __syncthreads();
        qkv_odd_rows(F, P, e, TL + pmi * 256 + pn * 8 + F.wid, TL + pmi * 256 + 256, 96);
    } else qkv_odd_rows(F, P, e, (F.vcu - 3 * xq) * 8 + F.wid, TL, 232 * 8);
}

constexpr int N_PHASES = 1 + 2 * 11 + 2 * 9 - 3;
__global__ void __launch_bounds__(512, 2) mk_fwd(Params Pval) {
    extern __shared__ __attribute__((aligned(16))) unsigned char lds_raw[];
    LAS unsigned char* ldsl = (LAS unsigned char*)lds_raw;
    volatile LAS unsigned* misc = (volatile LAS unsigned*)(ldsl + LDS_MISC);
    if (threadIdx.x < 16) misc[threadIdx.x] = 0u;
    __syncthreads();
    XcdBarrier bar = xcd_barrier_post((unsigned*)(Pval.ws + WS_CTL) + 1024, misc);
    const int wid0 = __builtin_amdgcn_readfirstlane((int)threadIdx.x >> 6);
    const int lo = Pval.ph_lo, hi = Pval.ph_hi; int ph = 0;
#define MKCTX() Ctx F; { const int lane_ = fresh_lane(); int wid_ = wid0; asm volatile("" : "+s"(wid_)); const int tid_ = wid_ * 64 + lane_; F.tid = tid_; F.lane = lane_; F.wid = wid_; \
        int G_ = gridDim.x, bx_ = blockIdx.x; asm volatile("" : "+s"(G_), "+s"(bx_)); F.G = G_; F.vcu = (G_ % 8 == 0) ? (bx_ % 8) * (G_ / 8) + bx_ / 8 : bx_; F.bx = bx_; } \
        unsigned long long kp_ = (unsigned long long)__builtin_amdgcn_kernarg_segment_ptr(); asm volatile("" : "+s"(kp_)); CParams& P = *(CParams*)kp_; \
        F.ws = P.ws; F.lds = (char*)lds_raw; unsigned char* ws = F.ws; (void)ws; \
        bf16_t* Hb = (bf16_t*)(ws + WS_H); bf16_t* P1 = (bf16_t*)(ws + WS_P1); float* X = (float*)(ws + WS_X); const float* mod = (const float*)(ws + WS_MOD); (void)Hb; (void)P1; (void)X; (void)mod;
#define PHASE(cls, ...) do { if (ph >= lo && ph < hi) { if constexpr ((PH_MASK >> (cls)) & 1u) { \
        if constexpr ((PH_DOUBLE >> (cls)) & 1u) { const bool dry = true; (void)dry; MKCTX(); __VA_ARGS__; __syncthreads(); } \
        { const bool dry = false; (void)dry; MKCTX(); __VA_ARGS__; } } if (ph + 1 < hi) { int w0_ = wid0; asm volatile("" : "+s"(w0_)); xcd_barrier(bar, w0_ == 0 && fresh_lane() == 0); } } ++ph; } while (0)

    PHASE(0, prologue_phase(F, P));
#pragma unroll 1
    for (int layer = 0; layer < DEPTH; ++layer) {
        const int e = layer >> 1; const bool even = (layer & 1) == 0, lastl = layer == DEPTH - 1;
        const int m_post = lastl ? TL : TT;
        if (layer == 0) PHASE(1, norm_phase(F, P, layer, 0, TT));
        PHASE(2, { const bf16_t* W = even ? (const bf16_t*)(ws + WS_WINAB) + (size_t)e * AB_INP * DM : (const bf16_t*)(ws + WS_WINC) + (size_t)e * C_IN * DM;
                const int N = even ? AB_INP : C_IN;
                const int m2 = (!even && ctx_sel_hidden(F)) ? TL : TT;
                pg8::Gemm g{Hb, W, m2, N, DM, DM}; pg8::StaticOrder S; S.init(m2, N, F.G, F.bx);
                pg8::EpiBf16V E{P1, N, even ? (bf16_t*)(ws + WS_V2) : (bf16_t*)(ws + WS_V1), even ? 14 : 10, even ? 1024 : 512};
                pg8::gemm_phase<pg8::EpiBf16V, pg8::StaticOrder>(ldsl, g, S, E, F.wid); });
        if (even) {
            PHASE(3, { { pg8::Gemm g{P1, (const bf16_t*)(ws + WS_WUQ) + (size_t)e * 1536 * 768, TT, 1536, 768, AB_INP}; pg8::StaticOrder S; S.init(TT, 1536, F.G, F.bx);
                      pg8::EpiBf16 E{(bf16_t*)(ws + WS_QA), 1536};
                      pg8::gemm_phase<pg8::EpiBf16, pg8::StaticOrder>(ldsl, g, S, E, F.wid); }
                    { pg8::Gemm g{P1 + 768, (const bf16_t*)(ws + WS_WUKV) + (size_t)e * 2048 * 512, TT, 2048, 512, AB_INP}; pg8::StaticOrder S; S.init(TT, 2048, F.G, F.G - 1 - F.bx);
                      pg8::EpiBf16 E{(bf16_t*)(ws + WS_KV), 2048};
                      pg8::gemm_phase<pg8::EpiBf16, pg8::StaticOrder>(ldsl, g, S, E, F.wid); } });
            PHASE(4, qkv_even_phase(F, P, e));
            PHASE(5, { if constexpr (ATT_DBL & 1) attn_phase<192, MLA_SD, 2048, 8, 8, 8>(F, (const bf16_t*)(ws + WS_Q1), (const bf16_t*)(ws + WS_K1), (const bf16_t*)(ws + WS_V1), (bf16_t*)(ws + WS_AO), 0, !lastl, ((const float*)(ws + WS_LAM))[4 + layer * 2]);
                    if constexpr (ATT_DBL & 2) attn_phase<64, 2, 2048, 16, 16, 8>(F, (const bf16_t*)(ws + WS_Q2), (const bf16_t*)(ws + WS_K2), (const bf16_t*)(ws + WS_V2), (bf16_t*)(ws + WS_OF), 0, !lastl, ((const float*)(ws + WS_LAM))[4 + layer * 2 + 1]);
                    if constexpr (ATT_SEL & 1) attn_phase<192, MLA_SD, 2048, 8, 8, 8>(F, (const bf16_t*)(ws + WS_Q1), (const bf16_t*)(ws + WS_K1), (const bf16_t*)(ws + WS_V1), (bf16_t*)(ws + WS_AO), 0, !lastl, ((const float*)(ws + WS_LAM))[4 + layer * 2]);
                    if constexpr (ATT_SEL & 2) attn_phase<64, 2, 2048, 16, 16, 8>(F, (const bf16_t*)(ws + WS_Q2), (const bf16_t*)(ws + WS_K2), (const bf16_t*)(ws + WS_V2), (bf16_t*)(ws + WS_OF), 0, !lastl, ((const float*)(ws + WS_LAM))[4 + layer * 2 + 1]); });
            PHASE(6, merge_even_phase(F, P, e, layer, m_post));
        } else {
            PHASE(7, qkv_odd_phase(F, P, e, layer, ldsl));
            PHASE(8, attn_phase<128, GQA_SD, 2048, 16, 4, 4>(F, (const bf16_t*)(ws + WS_Q1), (const bf16_t*)(ws + WS_K1), (const bf16_t*)(ws + WS_V1), (bf16_t*)(ws + WS_AO), 0, !lastl, ((const float*)(ws + WS_LAM))[4 + layer * 2]));
        }
        PHASE(10, { const bf16_t* W = even ? (const bf16_t*)(ws + WS_WOUTAB) + (size_t)e * DM * DM : (const bf16_t*)(ws + WS_WOUTC) + (size_t)e * DM * DM;
                const int m10 = ctx_sel_hidden(F) ? TL : m_post; pg8::Gemm g{(const bf16_t*)(ws + WS_AO), W, m10, DM, DM, DM}; pg8::StaticOrder S; S.init(m10, DM, F.G, F.bx);
                pg8::EpiResid E{X, mod + (size_t)layer * 3 * 12288, 2, layer == 0 ? P.x : (const float*)X, layer == 0 ? P.ctx : (const float*)X + (size_t)TL * DM};
                pg8::gemm_phase<pg8::EpiResid, pg8::StaticOrder>(ldsl, g, S, E, F.wid); });
        PHASE(1, norm_phase(F, P, layer, 1, ctx_sel_hidden(F) ? TL : m_post));
        PHASE(11, { const int m11 = ctx_sel_hidden(F) ? TL : m_post; pg8::Gemm g{Hb, (const bf16_t*)(ws + WS_WPQ) + (size_t)layer * DM * DM, m11, DM, DM, DM}; pg8::StaticOrder S; S.init(m11, DM, F.G, F.bx);
                pg8::EpiBf16 E{(bf16_t*)(ws + WS_PQ), DM};
                pg8::gemm_phase<pg8::EpiBf16, pg8::StaticOrder>(ldsl, g, S, E, F.wid); });
        PHASE(12, peer_select_phase(F, layer, m_post));
        PHASE(13, { const bf16_t* W = even ? (const bf16_t*)(ws + WS_WOUTAB) + (size_t)e * DM * DM : (const bf16_t*)(ws + WS_WOUTC) + (size_t)e * DM * DM;
                peer_expert_phase(F, P, layer, m_post, lastl, dry, ldsl, W); });
    }
#undef PHASE
}

extern "C" void kernel_launch(void* const* d_in, const int* in_sizes, int n_in, void* d_out, int out_size, void* d_ws, size_t ws_size, hipStream_t stream) {
    static int grid = 0;
    if (grid == 0) {
        if (n_in != 28 || ws_size < WS_END) { fprintf(stderr, "kernel_launch: expected 28 inputs and >= %zu bytes of workspace, got %d / %zu\n", (size_t)WS_END, n_in, ws_size); grid = -1; return; }
        int dev = 0, cus = 0, per_cu = 0;
        if (hipGetDevice(&dev) != hipSuccess || hipDeviceGetAttribute(&cus, hipDeviceAttributeMultiprocessorCount, dev) != hipSuccess) { grid = -1; return; }
        if (hipFuncSetAttribute((const void*)mk_fwd, hipFuncAttributeMaxDynamicSharedMemorySize, LDS_BYTES) != hipSuccess) { fprintf(stderr, "kernel_launch: hipFuncSetAttribute failed\n"); grid = -1; return; }
        if (hipOccupancyMaxActiveBlocksPerMultiprocessor(&per_cu, (const void*)mk_fwd, 512, LDS_BYTES) != hipSuccess || per_cu < 1) fprintf(stderr, "kernel_launch: occupancy query says %d\n", per_cu);
        (void)hipGetLastError();
        grid = cus;
    }
    if (grid < 0) return;
    (void)hipMemsetAsync((char*)d_ws + WS_CTL, 0, CTL_BYTES, stream);
    Params p{};
    const float** pf = (const float**)&p;
    for (int i = 0; i < 28; ++i) pf[i] = (const float*)d_in[i];
    p.out = (float*)d_out; p.ws = (unsigned char*)d_ws;
#if MK_PER_PHASE_LAUNCH
    for (int i = 0; i < N_PHASES; ++i) { p.ph_lo = i; p.ph_hi = i + 1; hipLaunchKernelGGL(mk_fwd, dim3(grid), dim3(512), LDS_BYTES, stream, p); }
#else
    p.ph_lo = 0; p.ph_hi = N_PHASES;
    hipLaunchKernelGGL(mk_fwd, dim3(grid), dim3(512), LDS_BYTES, stream, p);
#endif
    const hipError_t le = hipPeekAtLastError();
    if (le != hipSuccess) fprintf(stderr, "kernel_launch: launch failed: %s\n", hipGetErrorName(le));
}
```

```cpp
#include <hip/hip_runtime.h>
#include <stdint.h>
#include <stdio.h>

#ifndef MK_PER_PHASE_LAUNCH
#define MK_PER_PHASE_LAUNCH 0
#endif

#ifndef MLA_QL
#define MLA_QL 0
#endif
#ifndef GQA_QL
#define GQA_QL 0
#endif
#ifndef QKT_GRP
#define QKT_GRP 12
#endif
#ifndef EB
#define EB 4
#endif
#ifndef PV_PIPE
#define PV_PIPE 0
#endif
#ifndef ATT_DBL
#define ATT_DBL 0
#endif
#ifndef ATT_PRIO
#define ATT_PRIO 1
#endif
#ifndef MLA_SD
#define MLA_SD 1
#endif
#ifndef GQA_SD
#define GQA_SD 2
#endif
#ifndef ATT_SEL
#define ATT_SEL 3
#endif
#ifndef PH_DOUBLE
#define PH_DOUBLE 0u
#endif
#ifndef PH_MASK
#define PH_MASK 0xFFFFFFFFu
#endif
#define LAS __attribute__((address_space(3)))
typedef unsigned short bf16_t;
typedef short bf16x8 __attribute__((ext_vector_type(8)));
typedef short s16x4 __attribute__((ext_vector_type(4)));
typedef float f32x4 __attribute__((ext_vector_type(4)));
typedef float f32x2 __attribute__((ext_vector_type(2)));
typedef float f32x16 __attribute__((ext_vector_type(16)));
typedef unsigned u32x4 __attribute__((ext_vector_type(4)));
typedef unsigned u32x2 __attribute__((ext_vector_type(2)));
typedef __bf16 bf16x2_t __attribute__((ext_vector_type(2)));

constexpr int DM = 2048, NB = 2, SEQ = 8192, DEPTH = 4, CTXL = 256;
constexpr int TL = NB * SEQ;
constexpr int TZ = NB * CTXL;
constexpr int TT = TL + TZ;
constexpr int KPB = SEQ + CTXL;
constexpr int AB_IN = 4416, AB_INP = 4608;
constexpr int C_IN = 3072;
constexpr int NEXP = 16384;
constexpr float EPS = 1e-6f;
constexpr float LOG2E = 1.4426950408889634f;

constexpr size_t al256(size_t x) { return (x + 255) / 256 * 256; }
constexpr size_t WS_CTL = 0, CTL_BYTES = 1u << 20;
constexpr size_t WS_MOD = WS_CTL + CTL_BYTES;
constexpr size_t WS_TAB16 = WS_MOD + al256((size_t)4 * 3 * 12288 * 4);
constexpr size_t WS_TAB32 = WS_TAB16 + al256((size_t)128 * 16 * 2 * 4);
constexpr size_t WS_LAM = WS_TAB32 + al256((size_t)128 * 32 * 2 * 4);
constexpr size_t WS_WINAB = WS_LAM + 256;
constexpr size_t WS_WUQ = WS_WINAB + (size_t)2 * AB_INP * DM * 2;
constexpr size_t WS_WUKV = WS_WUQ + (size_t)2 * 1536 * 768 * 2;
constexpr size_t WS_WOUTAB = WS_WUKV + (size_t)2 * 2048 * 512 * 2;
constexpr size_t WS_WINC = WS_WOUTAB + (size_t)2 * DM * DM * 2;
constexpr size_t WS_WOUTC = WS_WINC + (size_t)2 * C_IN * DM * 2;
constexpr size_t WS_WPQ = WS_WOUTC + (size_t)2 * DM * DM * 2;
constexpr size_t WS_SUBK = WS_WPQ + (size_t)4 * DM * DM * 2;
constexpr size_t WS_EU = WS_SUBK + (size_t)4 * 8 * 2 * 128 * 128 * 2;
constexpr int EROW = DM * 6 / 8;
constexpr size_t WS_EV = WS_EU + (size_t)4 * NEXP * DM;
constexpr size_t WS_SU = WS_EV + (size_t)4 * NEXP * DM;
constexpr size_t WS_SV = WS_SU + (size_t)4 * NEXP * 4;
constexpr size_t WS_X = WS_SV + (size_t)4 * NEXP * 4;
constexpr size_t WS_H = WS_X + (size_t)TT * DM * 4;
constexpr size_t WS_P1 = WS_H + (size_t)TT * DM * 2;
constexpr size_t WS_QA = WS_P1 + (size_t)TT * AB_INP * 2;
constexpr size_t WS_KV = WS_QA + (size_t)TT * 1536 * 2;
constexpr size_t WS_Q1 = WS_KV + (size_t)TT * 2048 * 2;
constexpr size_t WS_K1 = WS_Q1 + (size_t)TT * 2048 * 2;
constexpr size_t WS_V1 = WS_K1 + (size_t)TT * 1536 * 2;
constexpr size_t WS_Q2 = WS_V1 + (size_t)TT * 1024 * 2;
constexpr size_t WS_K2 = WS_Q2 + (size_t)TT * 1024 * 2;
constexpr size_t WS_V2 = WS_K2 + (size_t)TT * 1024 * 2;
constexpr size_t WS_OF = WS_V2 + (size_t)TT * 1024 * 2;
constexpr size_t WS_AO = WS_OF + (size_t)TT * 3072 * 4;
constexpr size_t WS_PQ = WS_AO + (size_t)TT * DM * 2;
constexpr size_t WS_PIDX = WS_PQ + (size_t)TT * DM * 2;
constexpr size_t WS_PG = WS_PIDX + (size_t)TT * 128 * 4;
constexpr size_t WS_END = WS_PG + (size_t)TT * 128 * 4;

constexpr int LDS_MAIN = 157696;
constexpr int LDS_MISC = LDS_MAIN;
constexpr int LDS_BYTES = LDS_MAIN + 4096;

__device__ __forceinline__ unsigned cvt_pk_bf16(float lo, float hi) { unsigned r; asm("v_cvt_pk_bf16_f32 %0, %1, %2" : "=v"(r) : "v"(lo), "v"(hi)); return r; }
__device__ __forceinline__ float bf_lo(unsigned w) { return __uint_as_float(w << 16); }
__device__ __forceinline__ float bf_hi(unsigned w) { return __uint_as_float(w & 0xffff0000u); }
template <int M> __device__ __forceinline__ float swz_xor(float v) { return __int_as_float(__builtin_amdgcn_ds_swizzle(__float_as_int(v), (M << 10) | 0x1f)); }
__device__ __forceinline__ float xor32_partner(float v, int lane) {
    const auto rr = __builtin_amdgcn_permlane32_swap(__float_as_uint(v), __float_as_uint(v), false, false);
    return __uint_as_float(lane < 32 ? rr[1] : rr[0]);
}
__device__ __forceinline__ float hw_sum(float v) {
    v += swz_xor<16>(v); v += swz_xor<8>(v); v += swz_xor<4>(v); v += swz_xor<2>(v); v += swz_xor<1>(v);
    return v;
}
__device__ __forceinline__ float wave_sum(float v) {
    v = hw_sum(v);
    const auto rr = __builtin_amdgcn_permlane32_swap(__float_as_uint(v), __float_as_uint(v), false, false);
    return __uint_as_float(rr[0]) + __uint_as_float(rr[1]);
}
__device__ __forceinline__ float wave_max(float v) {
    v = fmaxf(v, swz_xor<16>(v)); v = fmaxf(v, swz_xor<8>(v)); v = fmaxf(v, swz_xor<4>(v)); v = fmaxf(v, swz_xor<2>(v)); v = fmaxf(v, swz_xor<1>(v));
    const auto rr = __builtin_amdgcn_permlane32_swap(__float_as_uint(v), __float_as_uint(v), false, false);
    return fmaxf(__uint_as_float(rr[0]), __uint_as_float(rr[1]));
}
__device__ __forceinline__ int mbcnt64(unsigned long long m) { return (int)__builtin_amdgcn_mbcnt_hi((unsigned)(m >> 32), __builtin_amdgcn_mbcnt_lo((unsigned)m, 0u)); }
__device__ __forceinline__ int fresh_lane() { int l; asm volatile("v_mbcnt_lo_u32_b32 %0, -1, 0\n\tv_mbcnt_hi_u32_b32 %0, -1, %0" : "=v"(l)); return l; }
__device__ __forceinline__ int krow_of(int t) { return t < TL ? (t >> 13) * KPB + (t & (SEQ - 1)) : ((t - TL) >> 8) * KPB + SEQ + ((t - TL) & (CTXL - 1)); }
__device__ __forceinline__ int vsel_of_row(int t) { return t < SEQ ? 0 : (t < TL ? 1 : 2); }

#define XB_TMO      128
#define XB_XCNT(j)  (256  + 64 * (j))
#define XB_XSUB(j)  (1280 + 64 * (j))
#define XB_XGEN(j)  (2304 + 64 * (j))
#define XB_TOP      3328
#define XB_TOPGEN   3392
#define XCD_BAR_WORDS 3456
#define XB_SPIN_CAP (1u << 27)
__device__ __forceinline__ unsigned xb_ld(unsigned* p)              { return __hip_atomic_load(p, __ATOMIC_RELAXED, __HIP_MEMORY_SCOPE_AGENT); }
__device__ __forceinline__ unsigned xb_add(unsigned* p, unsigned v) { return __hip_atomic_fetch_add(p, v, __ATOMIC_RELAXED, __HIP_MEMORY_SCOPE_AGENT); }
__device__ __forceinline__ unsigned xb_xcc_id() { return (unsigned)__builtin_amdgcn_s_getreg((3 << 11) | 20) & 0xFu; }
#define XB_SPIN(cond, bar) do { unsigned _sp = 0; while (cond) { __builtin_amdgcn_s_sleep(1); \
    if ((++_sp & 255u) == 0u) { if (xb_ld(&(bar)[XB_TMO])) break; if (_sp > XB_SPIN_CAP) { atomicAdd(&(bar)[XB_TMO], 1u); break; } } } } while (0)
struct XcdBarrier { unsigned* bar; unsigned x; volatile LAS unsigned* st; };
__device__ __forceinline__ XcdBarrier xcd_barrier_post(unsigned* bar, volatile LAS unsigned* st) {
    XcdBarrier b; b.bar = bar; b.x = xb_xcc_id(); b.st = st;
    if (threadIdx.x == 0) (void)xb_add(&bar[XB_XCNT(b.x)], 1u);
    return b;
}
__device__ __forceinline__ void xcd_barrier_complete(unsigned* bar, unsigned x, unsigned& nloc, unsigned& nx) {
    asm volatile("" : "+s"(x));
    const unsigned G = gridDim.x * gridDim.y * gridDim.z;
    unsigned sum, cnt, mine, sp = 0u;
    for (;;) {
        sum = 0u; cnt = 0u; mine = 0u;
#pragma unroll
        for (unsigned j = 0; j < 16; ++j) { const unsigned c = xb_ld(&bar[XB_XCNT(j)]); sum += c; cnt += (c > 0u) ? 1u : 0u; mine = (j == x) ? c : mine; }
        if (sum == G) break;
        __builtin_amdgcn_s_sleep(1);
        if ((++sp & 255u) == 0u) { if (xb_ld(&bar[XB_TMO])) break; if (sp > XB_SPIN_CAP) { atomicAdd(&bar[XB_TMO], 1u); break; } }
    }
    nloc = mine > 0u ? mine : 1u; nx = cnt > 0u ? cnt : 1u;
}
__device__ __forceinline__ void xcd_barrier(const XcdBarrier& b, const bool thread0  ) {
    asm volatile("s_waitcnt vmcnt(0)" ::: "memory");
    __syncthreads();
    if (thread0) {
        unsigned* bar = b.bar;
        __builtin_amdgcn_s_waitcnt(0);
        unsigned nloc = b.st[0], nx = b.st[1];
        if (nloc == 0u) { xcd_barrier_complete(bar, b.x, nloc, nx); b.st[0] = nloc; b.st[1] = nx; }
        const unsigned old = xb_add(&bar[XB_XSUB(b.x)], 1u);
        const unsigned gen = old / nloc;
        if (old + 1u == (gen + 1u) * nloc) {
            __builtin_amdgcn_fence(__ATOMIC_RELEASE, "agent");
            asm volatile("s_waitcnt vmcnt(0)" ::: "memory");
            const unsigned og = xb_add(&bar[XB_TOP], 1u);
            const unsigned tg = og / nx;
            if (og + 1u == (tg + 1u) * nx) xb_add(&bar[XB_TOPGEN], 1u);
            else XB_SPIN(xb_ld(&bar[XB_TOPGEN]) == tg, bar);
            __builtin_amdgcn_fence(__ATOMIC_ACQUIRE, "agent");
            xb_add(&bar[XB_XGEN(b.x)], 1u);
            asm volatile("s_waitcnt vmcnt(0)" ::: "memory");
        } else {
            XB_SPIN(xb_ld(&bar[XB_XGEN(b.x)]) == gen, bar);
            __builtin_amdgcn_fence(__ATOMIC_ACQUIRE, "agent");
            asm volatile("s_waitcnt vmcnt(0)" ::: "memory");
        }
    }
    __syncthreads();
}

namespace pg8 {
constexpr int BM = 256, BK = 64, HALF = 128, HTB = HALF * BK * 2, STAGE_BYTES = 8 * HTB, NXCD = 8, WGM = 8;
__host__ __device__ __forceinline__ int lds_byte(int r, int c) { const int st = (r >> 4) * 2 + (c >> 5), rr = r & 15, cc = c & 31, ob = rr * 64 + cc * 2; return st * 1024 + (ob ^ (((ob >> 9) & 1) << 5)); }
__host__ __device__ __forceinline__ void stage_rc(int b, int& R, int& C) { const int st = b / 1024, sb = b % 1024, swz = sb ^ (((sb >> 9) & 1) << 5); R = (st >> 1) * 16 + swz / 64; C = (st & 1) * 32 + (swz % 64) / 2; }
__host__ __device__ __forceinline__ int perm32(int rho) { const int n = rho >> 4, i = rho & 15; return 8 * (i >> 2) + 4 * n + (i & 3); }
struct Unit { int pm, pn; };
struct Gemm { const bf16_t* A; const bf16_t* Bt; int M, N, K, lda; };
struct StaticOrder {
    int nM, nN, nwg, G, c;
    __host__ __device__ void init(int M, int N, int G_, int c_) { nM = M / BM; nN = N / BM; nwg = nM * nN; G = G_; c = c_; }
    __host__ __device__ bool next(int i, Unit& u) const {
        const long L = (long)i * G + c; if (L >= nwg) return false;
        int wgid = (int)L; { const int q = nwg / NXCD, r = nwg % NXCD, xcd = wgid % NXCD, off = wgid / NXCD; wgid = (xcd < r ? xcd * (q + 1) : r * (q + 1) + (xcd - r) * q) + off; }
        const int nig = WGM * nN, gid = wgid / nig, fm = gid * WGM, gsz = (nM - fm) < WGM ? (nM - fm) : WGM;
        u.pm = fm + ((wgid % nig) % gsz); u.pn = (wgid % nig) / gsz; return true;
    }
    __device__ __forceinline__ void a_ready(const Unit&) const {}
    __device__ __forceinline__ void done(const Unit&) const {}
};
struct OneUnit {
    int pm, pn;
    __device__ bool next(int i, Unit& u) const { if (i != 0) return false; u.pm = pm; u.pn = pn; return true; }
    __device__ __forceinline__ void a_ready(const Unit&) const {}
    __device__ __forceinline__ void done(const Unit&) const {}
};
struct EpiBf16 {
    static constexpr bool PERM = true;
    bf16_t* O; int ldc;
    __device__ __forceinline__ void operator()(const f32x4 (&acc)[2][2][4][2], const Unit& u, int wr, int wc, int fr, int fq) const {
        const int row0 = u.pm * BM + wr * 64 + fr; const int col0 = u.pn * BM + wc * 32 + 8 * fq;
#pragma unroll
        for (int ai = 0; ai < 2; ++ai)
#pragma unroll
            for (int m = 0; m < 4; ++m) { bf16_t* rowp = O + (size_t)(row0 + ai * HALF + m * 16) * ldc + col0;
#pragma unroll
                for (int bj = 0; bj < 2; ++bj) { const f32x4 v0 = acc[ai][bj][m][0], v1 = acc[ai][bj][m][1];
                    u32x4 w; w.x = cvt_pk_bf16(v0[0], v0[1]); w.y = cvt_pk_bf16(v0[2], v0[3]); w.z = cvt_pk_bf16(v1[0], v1[1]); w.w = cvt_pk_bf16(v1[2], v1[3]);
                    *(u32x4*)(rowp + bj * HALF) = w; } }
    }
};
struct EpiBf16V {
    static constexpr bool PERM = true;
    bf16_t* O; int ldc; bf16_t* V; int vpn0, vld;
    __device__ __forceinline__ void operator()(const f32x4 (&acc)[2][2][4][2], const Unit& u, int wr, int wc, int fr, int fq) const {
        const int row0 = u.pm * BM + wr * 64 + fr; const int col0 = u.pn * BM + wc * 32 + 8 * fq;
        const bool tov = u.pn >= vpn0;
        const long delta = u.pm < 32 ? 0 : (u.pm < 64 ? KPB - SEQ : (u.pm == 64 ? SEQ - TL : KPB + SEQ - TL - CTXL));
        bf16_t* base = tov ? V + delta * vld - (long)vpn0 * BM : O; const int ld = tov ? vld : ldc;
#pragma unroll
        for (int ai = 0; ai < 2; ++ai)
#pragma unroll
            for (int m = 0; m < 4; ++m) { bf16_t* rowp = base + (size_t)(row0 + ai * HALF + m * 16) * ld + col0;
#pragma unroll
                for (int bj = 0; bj < 2; ++bj) { const f32x4 v0 = acc[ai][bj][m][0], v1 = acc[ai][bj][m][1];
                    u32x4 w; w.x = cvt_pk_bf16(v0[0], v0[1]); w.y = cvt_pk_bf16(v0[2], v0[3]); w.z = cvt_pk_bf16(v1[0], v1[1]); w.w = cvt_pk_bf16(v1[2], v1[3]);
                    *(u32x4*)(rowp + bj * HALF) = w; } }
    }
};
struct EpiResid {
    static constexpr bool PERM = false;
    float* X; const float* modl; int chunk;
    const float* Rlat; const float* Rctx;
    __device__ __forceinline__ void operator()(const f32x4 (&acc)[2][2][4][2], const Unit& u, int wr, int wc, int fr, int fq) const {
        const int row0 = u.pm * BM + wr * 64 + fr, col0 = u.pn * BM + wc * 32 + 4 * fq;
        const int vs = u.pm < 32 ? 0 : (u.pm < 64 ? 1 : 2);
        const float* gate = modl + (size_t)vs * 12288 + chunk * 2048 + col0;
        f32x4 gv[2][2];
#pragma unroll
        for (int bj = 0; bj < 2; ++bj)
#pragma unroll
            for (int n = 0; n < 2; ++n) gv[bj][n] = *(const f32x4*)(gate + bj * HALF + n * 16);
#pragma unroll
        for (int ai = 0; ai < 2; ++ai) {
            f32x4 xo[4][2][2];
#pragma unroll
            for (int m = 0; m < 4; ++m) { const int row = row0 + ai * HALF + m * 16;
                const float* srcp = (vs < 2 ? Rlat + (size_t)row * DM : Rctx + (size_t)(row - TL) * DM) + col0;
#pragma unroll
                for (int bj = 0; bj < 2; ++bj)
#pragma unroll
                    for (int n = 0; n < 2; ++n) xo[m][bj][n] = *(const f32x4*)(srcp + bj * HALF + n * 16); }
#pragma unroll
            for (int m = 0; m < 4; ++m) { const int row = row0 + ai * HALF + m * 16; float* rowp = X + (size_t)row * DM + col0;
#pragma unroll
                for (int bj = 0; bj < 2; ++bj)
#pragma unroll
                    for (int n = 0; n < 2; ++n) *(f32x4*)(rowp + bj * HALF + n * 16) = xo[m][bj][n] + gv[bj][n] * acc[ai][bj][m][n]; } }
    }
};

template <class Epi, class Sched>
__device__ __forceinline__ void gemm_phase(LAS unsigned char* lds, const Gemm g, const Sched& S, const Epi& E, int tid_in) {
    const int tid_l = tid_in * 64 + fresh_lane();
    const int tid = tid_l, wid = tid_in  , lane = tid & 63, wr = wid >> 2, wc = wid & 3, fr = lane & 15, fq = lane >> 4;
    const int K = g.K, nt = K / BK, lda = g.lda;
    unsigned voffA[2], voffB[2];
#pragma unroll
    for (int i = 0; i < 2; ++i) { int R, C; stage_rc(tid * 16 + i * 8192, R, C); const int Rb = Epi::PERM ? ((R & ~31) + perm32(R & 31)) : R;
        voffA[i] = (unsigned)(R * lda + C) * 2u; voffB[i] = (unsigned)(Rb * K + C) * 2u; }
    const size_t kstep = (size_t)(BK * 2);
    const size_t hstepA = (size_t)HALF * lda * 2, hstepB = (size_t)HALF * K * 2;
    const size_t tstepA = 2 * hstepA, tstepB = 2 * hstepB;
    const unsigned ldsw = (unsigned)wid * 1024u;
    const int aoff = lds_byte(wr * 64 + fr, fq * 8), boff = lds_byte(wc * 32 + fr, fq * 8);
#define PG8_SA(b, h) (((b) * 2 + (h)) * HTB)
#define PG8_SB(b, h) ((4 + (b) * 2 + (h)) * HTB)
#define PG8_STAGE(bufoff, gbase, voff) do { _Pragma("unroll") for (int _i = 0; _i < 2; ++_i) \
        __builtin_amdgcn_global_load_lds((const unsigned*)((const char*)(gbase) + (voff)[_i]), (LAS unsigned*)(lds + (bufoff) + ldsw + _i * 8192), 16, 0, 0); } while (0)
#define PG8_LDA(dst, b, h) do { _Pragma("unroll") for (int m = 0; m < 4; ++m) _Pragma("unroll") for (int k = 0; k < 2; ++k) dst[m][k] = *(const LAS bf16x8*)(lds + PG8_SA(b, h) + aoff + m * 2048 + k * 1024); } while (0)
#define PG8_LDB(dst, b, h) do { _Pragma("unroll") for (int n = 0; n < 2; ++n) _Pragma("unroll") for (int k = 0; k < 2; ++k) dst[n][k] = *(const LAS bf16x8*)(lds + PG8_SB(b, h) + boff + n * 2048 + k * 1024); } while (0)
#define PG8_MMA(ai, bj, At, Bt) do { __builtin_amdgcn_s_setprio(1); _Pragma("unroll") for (int m = 0; m < 4; ++m) _Pragma("unroll") for (int n = 0; n < 2; ++n) _Pragma("unroll") for (int k = 0; k < 2; ++k) \
        acc[ai][bj][m][n] = __builtin_amdgcn_mfma_f32_16x16x32_bf16(Bt[n][k], At[m][k], acc[ai][bj][m][n], 0, 0, 0); __builtin_amdgcn_s_setprio(0); } while (0)
#define PG8_WAIT_V(n) asm volatile("s_waitcnt vmcnt(" #n ")" ::: "memory")
#define PG8_WAIT_L(n) asm volatile("s_waitcnt lgkmcnt(" #n ")" ::: "memory")
#define PG8_BAR __builtin_amdgcn_s_barrier()
#define PG8_SCHED __builtin_amdgcn_sched_barrier(0)
    Unit cur, nxt; int ui = 0;
    if (!S.next(0, cur)) return;
    f32x4 acc[2][2][4][2];
#pragma unroll
    for (int a = 0; a < 2; ++a)
#pragma unroll
        for (int b = 0; b < 2; ++b)
#pragma unroll
            for (int m = 0; m < 4; ++m)
#pragma unroll
                for (int n = 0; n < 2; ++n) acc[a][b][m][n] = (f32x4){0.f, 0.f, 0.f, 0.f};
    bf16x8 At[4][2], B0[2][2], B1[2][2];
    const char* cA = (const char*)g.A + (size_t)cur.pm * tstepA; const char* cB = (const char*)g.Bt + (size_t)cur.pn * tstepB;
    S.a_ready(cur);
    PG8_STAGE(PG8_SB(0, 0), cB, voffB); PG8_STAGE(PG8_SA(0, 0), cA, voffA); PG8_STAGE(PG8_SB(0, 1), cB + hstepB, voffB); PG8_STAGE(PG8_SA(0, 1), cA + hstepA, voffA);
    if (wr == 1) PG8_BAR;
    PG8_WAIT_V(4); PG8_BAR;
    PG8_STAGE(PG8_SB(1, 0), cB + kstep, voffB); PG8_STAGE(PG8_SA(1, 0), cA + kstep, voffA); PG8_STAGE(PG8_SB(1, 1), cB + hstepB + kstep, voffB);
    PG8_WAIT_V(6); PG8_BAR;
    for (;;) {
        const bool has_next = S.next(ui + 1, nxt);
        const char* nA = has_next ? (const char*)g.A + (size_t)nxt.pm * tstepA : cA; const char* nB = has_next ? (const char*)g.Bt + (size_t)nxt.pn * tstepB : cB;
        for (int t = 0; t < nt; t += 2) {
            const bool last = (t == nt - 2);
            const char* a1 = cA + (size_t)(t + 1) * kstep;
            const char* a2 = last ? nA : cA + (size_t)(t + 2) * kstep; const char* b2 = last ? nB : cB + (size_t)(t + 2) * kstep;
            const char* a3 = a2 + kstep; const char* b3 = b2 + kstep;
            if (last && has_next) S.a_ready(nxt);
            PG8_LDB(B0, 0, 0); PG8_SCHED; PG8_LDA(At, 0, 0); PG8_STAGE(PG8_SA(1, 1), a1 + hstepA, voffA);
            PG8_WAIT_L(8); PG8_BAR; PG8_WAIT_L(0); PG8_MMA(0, 0, At, B0); PG8_BAR; PG8_SCHED;
            PG8_LDB(B1, 0, 1); PG8_STAGE(PG8_SB(0, 0), b2, voffB);
            PG8_BAR; PG8_WAIT_L(0); PG8_MMA(0, 1, At, B1); PG8_BAR;
            PG8_LDA(At, 0, 1); PG8_STAGE(PG8_SA(0, 0), a2, voffA);
            PG8_BAR; PG8_WAIT_L(0); PG8_MMA(1, 0, At, B0); PG8_BAR; PG8_SCHED;
            PG8_STAGE(PG8_SB(0, 1), b2 + hstepB, voffB);
            PG8_WAIT_V(6); PG8_BAR; PG8_MMA(1, 1, At, B1); PG8_BAR;
            PG8_LDB(B0, 1, 0); PG8_SCHED; PG8_LDA(At, 1, 0); PG8_STAGE(PG8_SA(0, 1), a2 + hstepA, voffA);
            PG8_WAIT_L(8); PG8_BAR; PG8_WAIT_L(0); PG8_MMA(0, 0, At, B0); PG8_BAR; PG8_SCHED;
            PG8_LDB(B1, 1, 1); PG8_STAGE(PG8_SB(1, 0), b3, voffB);
            PG8_BAR; PG8_WAIT_L(0); PG8_MMA(0, 1, At, B1); PG8_BAR;
            PG8_LDA(At, 1, 1); PG8_STAGE(PG8_SA(1, 0), a3, voffA);
            PG8_BAR; PG8_WAIT_L(0); PG8_MMA(1, 0, At, B0); PG8_BAR; PG8_SCHED;
            PG8_STAGE(PG8_SB(1, 1), b3 + hstepB, voffB);
            PG8_WAIT_V(6); PG8_BAR; PG8_MMA(1, 1, At, B1); PG8_BAR;
        }
        E(acc, cur, wr, wc, fr, fq); S.done(cur);
        if (!has_next) break;
#pragma unroll
        for (int a = 0; a < 2; ++a)
#pragma unroll
            for (int b = 0; b < 2; ++b)
#pragma unroll
                for (int m = 0; m < 4; ++m)
#pragma unroll
                    for (int n = 0; n < 2; ++n) acc[a][b][m][n] = (f32x4){0.f, 0.f, 0.f, 0.f};
        cur = nxt; cA = nA; cB = nB; ++ui;
    }
    PG8_WAIT_V(0);
    if (wr == 0) PG8_BAR;
    PG8_BAR;
#undef PG8_SA
#undef PG8_SB
#undef PG8_STAGE
#undef PG8_LDA
#undef PG8_LDB
#undef PG8_MMA
#undef PG8_WAIT_V
#undef PG8_WAIT_L
#undef PG8_BAR
#undef PG8_SCHED
}
}

namespace att {
constexpr int NW = 8, QBLK = 32, KVBLK = 64, DV = 128;
constexpr float THR = 8.f;
constexpr int SHM_V = KVBLK * DV * 2;
#define SBAR() __builtin_amdgcn_sched_barrier(0)
__device__ __forceinline__ int crow(int r, int hi) { return (r & 3) + 8 * (r >> 2) + 4 * hi; }
__device__ __forceinline__ unsigned cvtpk(float lo, float hi) { unsigned r; asm volatile("v_cvt_pk_bf16_f32 %0, %1, %2" : "=v"(r) : "v"(lo), "v"(hi)); return r; }
__device__ __forceinline__ void partialSM(f32x16& p0, f32x16& p1, float& m_reg, float& mn, float& alpha, const float C, const float thr_raw) {
    float pmax = p0[0];
#pragma unroll
    for (int r = 1; r < 16; ++r) pmax = fmaxf(pmax, p0[r]);
#pragma unroll
    for (int r = 0; r < 16; ++r) pmax = fmaxf(pmax, p1[r]);
    { auto rr = __builtin_amdgcn_permlane32_swap(__float_as_uint(pmax), __float_as_uint(pmax), false, false);
      pmax = fmaxf(__uint_as_float(rr[0]), __uint_as_float(rr[1])); }
    if (__builtin_expect(__all(pmax - m_reg <= thr_raw), 1)) { mn = m_reg; alpha = 1.f; }
    else { mn = fmaxf(m_reg, pmax); alpha = __builtin_amdgcn_exp2f((m_reg - mn) * C); m_reg = mn; }
    const float mnC = -mn * C;
#pragma unroll
    for (int r = 0; r < 16; ++r) p0[r] = fmaf(p0[r], C, mnC);
#pragma unroll
    for (int r = 0; r < 16; ++r) p1[r] = fmaf(p1[r], C, mnC);
#pragma unroll
    for (int r = 0; r < 16; ++r) p0[r] = __builtin_amdgcn_exp2f(p0[r]);
}
__device__ __forceinline__ void finishSM(f32x16& p0, f32x16& p1, float alpha, float& l_reg, bf16x8& pa0, bf16x8& pa1, bf16x8& pa2, bf16x8& pa3) {
#pragma unroll
    for (int r = 0; r < 16; ++r) p1[r] = __builtin_amdgcn_exp2f(p1[r]);
    float ps = 0;
#pragma unroll
    for (int r = 0; r < 16; ++r) ps += p0[r];
#pragma unroll
    for (int r = 0; r < 16; ++r) ps += p1[r];
    { auto rr = __builtin_amdgcn_permlane32_swap(__float_as_uint(ps), __float_as_uint(ps), false, false);
      ps = __uint_as_float(rr[0]) + __uint_as_float(rr[1]); }
    l_reg = l_reg * alpha + ps;
#define PK4(P, BASE, OUT) do { unsigned a0 = cvtpk(P[BASE + 0], P[BASE + 1]), a1 = cvtpk(P[BASE + 2], P[BASE + 3]);   \
    unsigned b0 = cvtpk(P[BASE + 4], P[BASE + 5]), b1 = cvtpk(P[BASE + 6], P[BASE + 7]);                              \
    auto r0 = __builtin_amdgcn_permlane32_swap(a0, b0, false, false); auto r1 = __builtin_amdgcn_permlane32_swap(a1, b1, false, false); \
    u32x4 w = {r0[0], r1[0], r0[1], r1[1]}; OUT = *reinterpret_cast<bf16x8*>(&w); } while (0)
    PK4(p0, 0, pa0); PK4(p0, 8, pa1); PK4(p1, 0, pa2); PK4(p1, 8, pa3);
#undef PK4
}
__device__ __forceinline__ void partialSM_nm(f32x16& p0) {
#pragma unroll
    for (int r = 0; r < 16; ++r) p0[r] = __builtin_amdgcn_exp2f(p0[r]);
}
template <int DQK, int QL>
__device__ __forceinline__ void qkt(f32x16& p0, f32x16& p1, const char* Ks, const bf16x8 (&qr)[DQK / 16 - QL], const char* qpark, int r32, int hi) {
    constexpr int RS = DQK * 2 + 16, NQR = DQK / 16 - QL, GRP = (DQK > 128) ? QKT_GRP : DQK / 16;
    p0 = f32x16{}; p1 = f32x16{};
#pragma unroll
    for (int g0 = 0; g0 < DQK / 16; g0 += GRP) {
#pragma unroll
        for (int d0 = g0; d0 < g0 + GRP; ++d0) { const int cb = (d0 * 16 + hi * 8) * 2;
            const bf16x8 b0 = *reinterpret_cast<const bf16x8*>(Ks + r32 * RS + cb);
            const bf16x8 b1 = *reinterpret_cast<const bf16x8*>(Ks + (32 + r32) * RS + cb);
            bf16x8 qf; if (d0 < NQR) qf = qr[d0 < NQR ? d0 : 0]; else qf = *reinterpret_cast<const bf16x8*>(qpark + (d0 - NQR) * 1024);
            p0 = __builtin_amdgcn_mfma_f32_32x32x16_bf16(b0, qf, p0, 0, 0, 0);
            p1 = __builtin_amdgcn_mfma_f32_32x32x16_bf16(b1, qf, p1, 0, 0, 0); }
        if (g0 + GRP < DQK / 16) SBAR();
    }
}
__device__ __forceinline__ int v_st(int k, int c) { const int kk = (k & ~0xC) | ((k & 4) << 1) | ((k & 8) >> 1); return ((kk >> 3) * 4 + (c >> 5)) * 512 + ((kk & 7) * 32 + (c & 31)) * 2; }
__device__ __forceinline__ int v_rd_base(int lane) { return ((lane & 3) << 3) | (((lane >> 2) & 3) << 6) | (((lane >> 4) & 1) << 5) | (((lane >> 5) & 1) << 8); }
constexpr int v_rd_off(int d0, int ks, int half) { return d0 * 512 + ks * 4096 + half * 2048; }
template <int OFF> __device__ __forceinline__ s16x4 tr_read(int vb) {
    s16x4 r; asm volatile("ds_read_b64_tr_b16 %0, %1 offset:%2" : "=&v"(r) : "v"(vb), "i"(OFF) : "memory"); return r;
}
template <int D0> __device__ __forceinline__ void pv_one(f32x16& od, int vb, bf16x8 pa0, bf16x8 pa1, bf16x8 pa2, bf16x8 pa3) {
    const s16x4 l0 = tr_read<v_rd_off(D0, 0, 0)>(vb), h0 = tr_read<v_rd_off(D0, 0, 1)>(vb), l1 = tr_read<v_rd_off(D0, 1, 0)>(vb), h1 = tr_read<v_rd_off(D0, 1, 1)>(vb);
    const s16x4 l2 = tr_read<v_rd_off(D0, 2, 0)>(vb), h2 = tr_read<v_rd_off(D0, 2, 1)>(vb), l3 = tr_read<v_rd_off(D0, 3, 0)>(vb), h3 = tr_read<v_rd_off(D0, 3, 1)>(vb);
    asm volatile("s_waitcnt lgkmcnt(0)" ::: "memory"); SBAR();
#define PK(L, H) (bf16x8){L[0], L[1], L[2], L[3], H[0], H[1], H[2], H[3]}
    od = __builtin_amdgcn_mfma_f32_32x32x16_bf16(pa0, PK(l0, h0), od, 0, 0, 0);
    od = __builtin_amdgcn_mfma_f32_32x32x16_bf16(pa1, PK(l1, h1), od, 0, 0, 0);
    od = __builtin_amdgcn_mfma_f32_32x32x16_bf16(pa2, PK(l2, h2), od, 0, 0, 0);
    od = __builtin_amdgcn_mfma_f32_32x32x16_bf16(pa3, PK(l3, h3), od, 0, 0, 0);
#undef PK
}
__device__ __forceinline__ void pv_d0(f32x16* o, int vb, bf16x8 pa0, bf16x8 pa1, bf16x8 pa2, bf16x8 pa3) {
    pv_one<0>(o[0], vb, pa0, pa1, pa2, pa3); pv_one<1>(o[1], vb, pa0, pa1, pa2, pa3); pv_one<2>(o[2], vb, pa0, pa1, pa2, pa3); pv_one<3>(o[3], vb, pa0, pa1, pa2, pa3);
}
struct VFrag { s16x4 l0, h0, l1, h1, l2, h2, l3, h3; };
template <int D0> __device__ __forceinline__ void pv_rd(VFrag& f, int vb) {
    f.l0 = tr_read<v_rd_off(D0, 0, 0)>(vb); f.h0 = tr_read<v_rd_off(D0, 0, 1)>(vb); f.l1 = tr_read<v_rd_off(D0, 1, 0)>(vb); f.h1 = tr_read<v_rd_off(D0, 1, 1)>(vb);
    f.l2 = tr_read<v_rd_off(D0, 2, 0)>(vb); f.h2 = tr_read<v_rd_off(D0, 2, 1)>(vb); f.l3 = tr_read<v_rd_off(D0, 3, 0)>(vb); f.h3 = tr_read<v_rd_off(D0, 3, 1)>(vb);
}
__device__ __forceinline__ void pv_mm(f32x16& od, const VFrag& f, bf16x8 pa0, bf16x8 pa1, bf16x8 pa2, bf16x8 pa3) {
#define PK(L, H) (bf16x8){L[0], L[1], L[2], L[3], H[0], H[1], H[2], H[3]}
    od = __builtin_amdgcn_mfma_f32_32x32x16_bf16(pa0, PK(f.l0, f.h0), od, 0, 0, 0);
    od = __builtin_amdgcn_mfma_f32_32x32x16_bf16(pa1, PK(f.l1, f.h1), od, 0, 0, 0);
    od = __builtin_amdgcn_mfma_f32_32x32x16_bf16(pa2, PK(f.l2, f.h2), od, 0, 0, 0);
    od = __builtin_amdgcn_mfma_f32_32x32x16_bf16(pa3, PK(f.l3, f.h3), od, 0, 0, 0);
#undef PK
}
__device__ __forceinline__ void pv_d0_pipe(f32x16* o, int vb, bf16x8 pa0, bf16x8 pa1, bf16x8 pa2, bf16x8 pa3) {
    VFrag fa, fb;
    pv_rd<0>(fa, vb); pv_rd<1>(fb, vb);
    asm volatile("s_waitcnt lgkmcnt(8)" ::: "memory"); SBAR(); pv_mm(o[0], fa, pa0, pa1, pa2, pa3); SBAR();
    pv_rd<2>(fa, vb);
    asm volatile("s_waitcnt lgkmcnt(8)" ::: "memory"); SBAR(); pv_mm(o[1], fb, pa0, pa1, pa2, pa3); SBAR();
    pv_rd<3>(fb, vb);
    asm volatile("s_waitcnt lgkmcnt(8)" ::: "memory"); SBAR(); pv_mm(o[2], fa, pa0, pa1, pa2, pa3); SBAR();
    asm volatile("s_waitcnt lgkmcnt(0)" ::: "memory"); SBAR(); pv_mm(o[3], fb, pa0, pa1, pa2, pa3);
}
template <int DQK> struct ScaleOf { static constexpr float scale = DQK == 192 ? 0.07216878364870322f : (DQK == 128 ? 0.08838834764831845f : 0.125f); };
template <int DQK, int SDEPTH, int QL, bool NOMAX, int ldq, int ldk, int ldv, int ldo>
__device__ __forceinline__ void attn_body(const bf16_t* __restrict__ Qb, const bf16_t* __restrict__ Kh, const bf16_t* __restrict__ Vh,
                                          bf16_t* __restrict__ Ob, int seq, char* lds, int tid_in, const float negMC) {
    constexpr float C = 1.0f, thr_raw = THR * 1.4426950408889634f;
    constexpr int RS = DQK * 2 + 16  , SHM_K = KVBLK * RS, NKP = DQK / 64, KPR = DQK / 8;
    const int tid_l = tid_in * 64 + fresh_lane();
    const int tid = tid_l, wid = tid_in  , lane = tid & 63, r32 = lane & 31, hi = lane >> 5;
    char* V_lds = lds; char* K_lds = lds + 2 * SHM_V;
    float* ws = (float*)(lds + 2 * SHM_V + 2 * SHM_K) + wid * 64; float* li_l = ws; float* al_l = ws + 32;
    constexpr int NQR = DQK / 16 - QL;
    char* qpark = lds + 2 * SHM_V + 2 * SHM_K + 2048 + wid * (QL * 1024) + lane * 16;
    float m_reg = -1e30f, l_reg = 0; f32x16 o[4] = {}; bf16x8 qr[NQR];
    const bf16_t* Qw = Qb + (size_t)(wid * QBLK + r32) * ldq + hi * 8;
#pragma unroll
    for (int d0 = 0; d0 < NQR; ++d0) qr[d0] = *reinterpret_cast<const bf16x8*>(Qw + d0 * 16);
#pragma unroll
    for (int d0 = 0; d0 < QL; ++d0) *(bf16x8*)(qpark + d0 * 1024) = *reinterpret_cast<const bf16x8*>(Qw + (NQR + d0) * 16);
    const int sr = tid >> 4, sc = (tid & 15) * 8, vst0 = v_st(sr, sc), vst1 = v_st(32 + sr, sc);
    int koff[NKP], klds[NKP];
#pragma unroll
    for (int i = 0; i < NKP; ++i) { const int row = tid >> 3, c8 = (tid & 7) + 8 * i; koff[i] = row * ldk + c8 * 8; klds[i] = row * RS + c8 * 16; }
    const int vb0 = (int)(uintptr_t)V_lds + v_rd_base(lane);
    bf16x8 sv0[SDEPTH], sv1[SDEPTH], sk[SDEPTH][NKP];
#define SLOAD(i, k0) do { sv0[i] = *reinterpret_cast<const bf16x8*>(&Vh[(size_t)((k0) + sr) * ldv + sc]); sv1[i] = *reinterpret_cast<const bf16x8*>(&Vh[(size_t)((k0) + 32 + sr) * ldv + sc]); \
    _Pragma("unroll") for (int _q = 0; _q < NKP; ++_q) sk[i][_q] = *reinterpret_cast<const bf16x8*>(&Kh[(size_t)(k0) * ldk + koff[_q]]); } while (0)
#define SWRITE(b, i) do { *(bf16x8*)(V_lds + (b) * SHM_V + vst0) = sv0[i]; *(bf16x8*)(V_lds + (b) * SHM_V + vst1) = sv1[i]; \
    _Pragma("unroll") for (int _q = 0; _q < NKP; ++_q) *(bf16x8*)(K_lds + (b) * SHM_K + klds[_q]) = sk[i][_q]; } while (0)
#define SWAIT() do { if constexpr (SDEPTH == 2) { if constexpr (NKP == 1) asm volatile("s_waitcnt vmcnt(3)" ::: "memory"); else if constexpr (NKP == 2) asm volatile("s_waitcnt vmcnt(4)" ::: "memory"); else asm volatile("s_waitcnt vmcnt(5)" ::: "memory"); } \
    else asm volatile("s_waitcnt vmcnt(0)" ::: "memory"); } while (0)
#define PVD0(...) do { if constexpr (PV_PIPE != 0) pv_d0_pipe(__VA_ARGS__); else pv_d0(__VA_ARGS__); } while (0)
#define RESC(a) do { if constexpr (!NOMAX) if (__any((a) < 1.f)) { if (hi == 0) al_l[r32] = (a); asm volatile("s_waitcnt lgkmcnt(0)" ::: "memory"); \
    _Pragma("unroll") for (int d = 0; d < 4; ++d) _Pragma("unroll") for (int r = 0; r < 16; ++r) o[d][r] *= al_l[crow(r, hi)]; } } while (0)
    f32x16 pA0, pA1, pB0, pB1; float mnA, mnB, alA, alB; bf16x8 pa0, pa1, pa2, pa3; const int NT = seq / KVBLK;
    if (ATT_PRIO && wid >= 4) __builtin_amdgcn_s_setprio(1);
    constexpr int SE = 0, SO = SDEPTH - 1;
    SLOAD(SE, 0); asm volatile("s_waitcnt vmcnt(0)" ::: "memory"); SWRITE(0, SE); __syncthreads();
    qkt<DQK, QL>(pA0, pA1, K_lds, qr, qpark, r32, hi); if constexpr (NOMAX) { partialSM_nm(pA0); alA = 1.f; } else partialSM(pA0, pA1, m_reg, mnA, alA, C, thr_raw);
    SLOAD(SO, KVBLK); if constexpr (SDEPTH == 2) { if (2 < NT) SLOAD(SE, 2 * KVBLK); }
    SWAIT(); SWRITE(1, SO); __syncthreads();
    for (int j = 1; j + 1 < NT; j += 2) {
        SBAR(); qkt<DQK, QL>(pB0, pB1, K_lds + SHM_K, qr, qpark, r32, hi);
        finishSM(pA0, pA1, alA, l_reg, pa0, pa1, pa2, pa3); SBAR();
        SLOAD(SO, (j + SDEPTH) * KVBLK); SBAR();
        PVD0(o, vb0, pa0, pa1, pa2, pa3); if constexpr (NOMAX) { partialSM_nm(pB0); alB = 1.f; } else partialSM(pB0, pB1, m_reg, mnB, alB, C, thr_raw);
        __syncthreads(); SWAIT(); SWRITE(0, SE);
        RESC(alB); __syncthreads();
        SBAR(); qkt<DQK, QL>(pA0, pA1, K_lds, qr, qpark, r32, hi);
        finishSM(pB0, pB1, alB, l_reg, pa0, pa1, pa2, pa3); SBAR();
        if (SDEPTH == 1 || j + 3 < NT) SLOAD(SE, (j + 1 + SDEPTH) * KVBLK); SBAR();
        PVD0(o, vb0 + SHM_V, pa0, pa1, pa2, pa3); if constexpr (NOMAX) { partialSM_nm(pA0); alA = 1.f; } else partialSM(pA0, pA1, m_reg, mnA, alA, C, thr_raw);
        __syncthreads(); SWAIT(); SWRITE(1, SO);
        RESC(alA); __syncthreads();
    }
    SBAR(); qkt<DQK, QL>(pB0, pB1, K_lds + SHM_K, qr, qpark, r32, hi);
    finishSM(pA0, pA1, alA, l_reg, pa0, pa1, pa2, pa3); SBAR();
    PVD0(o, vb0, pa0, pa1, pa2, pa3); if constexpr (NOMAX) { partialSM_nm(pB0); alB = 1.f; } else partialSM(pB0, pB1, m_reg, mnB, alB, C, thr_raw);
    __syncthreads(); RESC(alB);
    finishSM(pB0, pB1, alB, l_reg, pa0, pa1, pa2, pa3); SBAR();
    PVD0(o, vb0 + SHM_V, pa0, pa1, pa2, pa3);
    if (ATT_PRIO) __builtin_amdgcn_s_setprio(0);
    if (hi == 0) li_l[r32] = l_reg; asm volatile("s_waitcnt lgkmcnt(0)" ::: "memory");
    float rli[16];
#pragma unroll
    for (int r = 0; r < 16; ++r) rli[r] = __builtin_amdgcn_rcpf(li_l[crow(r, hi)]);
    bf16_t* Ow = Ob + (size_t)(wid * QBLK) * ldo + (r32 & ~1);
    const bool odd = (r32 & 1) != 0;
#pragma unroll
    for (int r = 0; r < 16; r += 2) { const int orow = crow(r, hi) + (odd ? 1 : 0);
#pragma unroll
        for (int d0 = 0; d0 < 4; ++d0) { const float a = o[d0][r] * rli[r], b = o[d0][r + 1] * rli[r + 1];
            const float recv = swz_xor<1>(odd ? a : b);
            const unsigned w = odd ? cvtpk(recv, b) : cvtpk(a, recv);
            *(unsigned*)(Ow + (size_t)orow * ldo + d0 * 32) = w; } }
    __syncthreads();
#undef SLOAD
#undef SWRITE
#undef SWAIT
#undef RESC
#undef PVD0
}
template <int DQK, int QL, int ldq, int ldk, int ldv, int ldo>
__device__ __forceinline__ void attn_body_simple(const bf16_t* __restrict__ Qb, const bf16_t* __restrict__ Kh, const bf16_t* __restrict__ Vh,
                                                 bf16_t* __restrict__ Ob, int seq, char* lds, int tid_in) {
    constexpr float C = 1.0f, thr_raw = THR * 1.4426950408889634f;
    constexpr int RS = DQK * 2 + 16  , SHM_K = KVBLK * RS, NKP = DQK / 64, KPR = DQK / 8;
    const int tid_l = tid_in * 64 + fresh_lane();
    const int tid = tid_l, wid = tid_in  , lane = tid & 63, r32 = lane & 31, hi = lane >> 5;
    char* V_lds = lds; char* K_lds = lds + 2 * SHM_V;
    float* ws = (float*)(lds + 2 * SHM_V + 2 * SHM_K) + wid * 64; float* li_l = ws; float* al_l = ws + 32;
    constexpr int NQR = DQK / 16 - QL;
    char* qpark = lds + 2 * SHM_V + 2 * SHM_K + 2048 + wid * (QL * 1024) + lane * 16;
    float m_reg = -1e30f, l_reg = 0; f32x16 o[4] = {}; bf16x8 qr[NQR];
    const bf16_t* Qw = Qb + (size_t)(wid * QBLK + r32) * ldq + hi * 8;
#pragma unroll
    for (int d0 = 0; d0 < NQR; ++d0) qr[d0] = *reinterpret_cast<const bf16x8*>(Qw + d0 * 16);
#pragma unroll
    for (int d0 = 0; d0 < QL; ++d0) *(bf16x8*)(qpark + d0 * 1024) = *reinterpret_cast<const bf16x8*>(Qw + (NQR + d0) * 16);
    const int sr = tid >> 4, sc = (tid & 15) * 8, vst0 = v_st(sr, sc), vst1 = v_st(32 + sr, sc);
    int koff[NKP], klds[NKP];
#pragma unroll
    for (int i = 0; i < NKP; ++i) { const int row = tid >> 3, c8 = (tid & 7) + 8 * i; koff[i] = row * ldk + c8 * 8; klds[i] = row * RS + c8 * 16; }
    const int vb0 = (int)(uintptr_t)V_lds + v_rd_base(lane);
    bf16x8 sv0, sv1, sk[NKP];
#define SLOAD(k0) do { sv0 = *reinterpret_cast<const bf16x8*>(&Vh[(size_t)((k0) + sr) * ldv + sc]); sv1 = *reinterpret_cast<const bf16x8*>(&Vh[(size_t)((k0) + 32 + sr) * ldv + sc]); \
    _Pragma("unroll") for (int _q = 0; _q < NKP; ++_q) sk[_q] = *reinterpret_cast<const bf16x8*>(&Kh[(size_t)(k0) * ldk + koff[_q]]); } while (0)
#define SWRITE(b) do { *(bf16x8*)(V_lds + (b) * SHM_V + vst0) = sv0; *(bf16x8*)(V_lds + (b) * SHM_V + vst1) = sv1; \
    _Pragma("unroll") for (int _q = 0; _q < NKP; ++_q) *(bf16x8*)(K_lds + (b) * SHM_K + klds[_q]) = sk[_q]; } while (0)
#define RESC(a) do { if (__any((a) < 1.f)) { if (hi == 0) al_l[r32] = (a); asm volatile("s_waitcnt lgkmcnt(0)" ::: "memory"); \
    _Pragma("unroll") for (int d = 0; d < 4; ++d) _Pragma("unroll") for (int r = 0; r < 16; ++r) o[d][r] *= al_l[crow(r, hi)]; } } while (0)
    const int NT = seq / KVBLK;
    SLOAD(0); asm volatile("s_waitcnt vmcnt(0)" ::: "memory"); SWRITE(0); __syncthreads();
    for (int j = 0; j < NT; ++j) {
        const int b = j & 1;
        if (j + 1 < NT) SLOAD((j + 1) * KVBLK);
        SBAR();
        f32x16 p0, p1; float mn, al; bf16x8 pa0, pa1, pa2, pa3;
        { const char* Ks = K_lds + b * SHM_K; p0 = f32x16{}; p1 = f32x16{};
#pragma unroll
          for (int d0 = 0; d0 < DQK / 16; ++d0) { const int cb = (d0 * 16 + hi * 8) * 2;
              const bf16x8 b0 = *reinterpret_cast<const bf16x8*>(Ks + r32 * RS + cb);
              const bf16x8 b1 = *reinterpret_cast<const bf16x8*>(Ks + (32 + r32) * RS + cb);
              bf16x8 qf; if (d0 < NQR) qf = qr[d0 < NQR ? d0 : 0]; else qf = *(const bf16x8*)(qpark + (d0 - NQR) * 1024);
              p0 = __builtin_amdgcn_mfma_f32_32x32x16_bf16(b0, qf, p0, 0, 0, 0);
              p1 = __builtin_amdgcn_mfma_f32_32x32x16_bf16(b1, qf, p1, 0, 0, 0); } }
        partialSM(p0, p1, m_reg, mn, al, C, thr_raw);
        RESC(al);
        finishSM(p0, p1, al, l_reg, pa0, pa1, pa2, pa3); SBAR();
        pv_d0(o, vb0 + b * SHM_V, pa0, pa1, pa2, pa3);
        if (j + 1 < NT) { asm volatile("s_waitcnt vmcnt(0)" ::: "memory"); SWRITE(b ^ 1); }
        __syncthreads();
    }
    if (hi == 0) li_l[r32] = l_reg; asm volatile("s_waitcnt lgkmcnt(0)" ::: "memory");
    float rli[16];
#pragma unroll
    for (int r = 0; r < 16; ++r) rli[r] = __builtin_amdgcn_rcpf(li_l[crow(r, hi)]);
    bf16_t* Ow = Ob + (size_t)(wid * QBLK) * ldo + (r32 & ~1);
    const bool odd = (r32 & 1) != 0;
#pragma unroll
    for (int r = 0; r < 16; r += 2) { const int orow = crow(r, hi) + (odd ? 1 : 0);
#pragma unroll
        for (int d0 = 0; d0 < 4; ++d0) { const float a = o[d0][r] * rli[r], b = o[d0][r + 1] * rli[r + 1];
            const float recv = swz_xor<1>(odd ? a : b);
            const unsigned w = odd ? cvtpk(recv, b) : cvtpk(a, recv);
            *(unsigned*)(Ow + (size_t)orow * ldo + d0 * 32) = w; } }
    __syncthreads();
#undef SLOAD
#undef SWRITE
#undef RESC
}
}

struct Params {
    const float* x; const float* c; const float* ctx; const float* c_ctx; const float* w_mod; const float* b_mod; const float* g_norm1; const float* g_norm2;
    const float* w_in_ab; const float* g_cq; const float* w_uq; const float* g_ckv; const float* w_ukv; const float* g_qn_a; const float* g_kn_a; const float* lam_vec;
    const float* g_qn_b; const float* g_kn_b; const float* g_sub_b; const float* w_out_ab; const float* w_in_c; const float* g_qn_c; const float* g_kn_c; const float* w_out_c;
    const float* w_pq; const float* sub_keys; const float* expert_u; const float* expert_v;
    float* out; unsigned char* ws; int ph_lo, ph_hi;
};

typedef const __attribute__((address_space(4))) Params CParams;
struct Ctx {
    int tid, lane, wid, G, vcu, bx;
    unsigned char* ws; char* lds;
};

__device__ __forceinline__ void tconv(const Ctx& F, const float* src, bf16_t* dst, const float* gain, int nmat, int K, int N, int Npad, int pad_at = 1 << 30, int pad_len = 0) {
    float* tile = (float*)(F.lds + 32768);
    const int ntn = Npad / 64, ntk = K / 64, per = ntn * ntk, total = per * nmat;
    for (int it = F.vcu; it < total; it += F.G) {
        const int mat = it / per, rem = it % per, tn = rem / ntk, tk = rem % ntk, k0 = tk * 64, n0 = tn * 64;
        const float* s = src + (size_t)mat * K * N; bf16_t* d = dst + (size_t)mat * Npad * K;
        __syncthreads();
        { const int r = F.tid >> 4, c4 = (F.tid & 15) * 4;
#pragma unroll
          for (int i = 0; i < 2; ++i) { const int rr = r + i * 32; f32x4 v = (f32x4){0.f, 0.f, 0.f, 0.f};
              const int sn0 = n0 < pad_at ? n0 : n0 - pad_len;
              if (sn0 + c4 < N && !(n0 >= pad_at && n0 < pad_at + pad_len)) v = *(const f32x4*)(s + (size_t)(k0 + rr) * N + sn0 + c4);
              tile[rr * 65 + c4 + 0] = v[0]; tile[rr * 65 + c4 + 1] = v[1]; tile[rr * 65 + c4 + 2] = v[2]; tile[rr * 65 + c4 + 3] = v[3]; } }
        __syncthreads();
        { const int n = F.tid >> 3, kc = (F.tid & 7) * 8; float v[8];
#pragma unroll
          for (int e = 0; e < 8; ++e) { v[e] = tile[(kc + e) * 65 + n]; if (gain) v[e] *= gain[(size_t)mat * K + k0 + kc + e]; }
          u32x4 w; w.x = cvt_pk_bf16(v[0], v[1]); w.y = cvt_pk_bf16(v[2], v[3]); w.z = cvt_pk_bf16(v[4], v[5]); w.w = cvt_pk_bf16(v[6], v[7]);
          *(u32x4*)(d + (size_t)(n0 + n) * K + k0 + kc) = w; }
    }
}
__device__ __forceinline__ void cvt_flat(const Ctx& F, const float* src, bf16_t* dst, size_t n8) {
    for (size_t i = (size_t)F.vcu * 512 + F.tid; i < n8; i += (size_t)F.G * 512) {
        const f32x4 a = *(const f32x4*)(src + i * 8), b = *(const f32x4*)(src + i * 8 + 4);
        u32x4 w; w.x = cvt_pk_bf16(a[0], a[1]); w.y = cvt_pk_bf16(a[2], a[3]); w.z = cvt_pk_bf16(b[0], b[1]); w.w = cvt_pk_bf16(b[2], b[3]);
        *(u32x4*)(dst + i * 8) = w;
    }
}
typedef unsigned v6u __attribute__((ext_vector_type(6)));
typedef float v32f __attribute__((ext_vector_type(32)));
typedef float v16f __attribute__((ext_vector_type(16)));
__device__ __forceinline__ float fp6_val(int c) { return c < 8 ? c * 0.125f : (c < 16 ? 1.f + (c - 8) * 0.125f : (c < 24 ? 2.f + (c - 16) * 0.25f : 4.f + (c - 24) * 0.5f)); }
__device__ __forceinline__ int fp6_code(float x) { return x < 1.f ? (int)(x * 8.f + 0.5f) : (x < 2.f ? 8 + (int)((x - 1.f) * 8.f + 0.5f) : (x < 4.f ? 16 + (int)((x - 2.f) * 4.f + 0.5f) : 24 + (int)((x - 4.f) * 2.f + 0.5f))); }
__device__ __forceinline__ void cvt_rows_fp6(const Ctx& F, const float* src, unsigned char* dst, float* descale, int R) {
    float* stg = (float*)(F.lds + 65536) + F.wid * (64 * 33);
    int* permL = (int*)(F.lds + 65536 + 8 * 64 * 33 * 4) + F.wid * 32;
    float fac;
    {   v16f lo, hi;
#pragma unroll
        for (int i = 0; i < 16; ++i) { lo[i] = fp6_val(i); hi[i] = fp6_val(16 + i); }
        const v6u w = __builtin_amdgcn_cvt_scalef32_2xpk16_fp6_f32(lo, hi, 1.0f);
        const v32f f = __builtin_amdgcn_cvt_scalef32_pk32_f32_fp6(w, 1.0f);
        float mx = 0.f;
#pragma unroll
        for (int j = 0; j < 32; ++j) mx = fmaxf(mx, f[j]);
        fac = mx * (1.f / 7.5f);
        const float inv = fac > 0.f ? 1.f / fac : 1.f;
        if (F.lane == 0) {
#pragma unroll
            for (int j = 0; j < 32; ++j) permL[j] = fp6_code(f[j] * inv) & 31; }
        asm volatile("s_waitcnt lgkmcnt(0)" ::: "memory"); __builtin_amdgcn_wave_barrier(); asm volatile("" ::: "memory");
    }
    for (int row = F.vcu * 8 + F.wid; row < R; row += F.G * 8) {
        const float* s = src + (size_t)row * DM + F.lane * 4; f32x4 v[8]; float am = 0.f;
#pragma unroll
        for (int i = 0; i < 8; ++i) { v[i] = *(const f32x4*)(s + i * 256);
#pragma unroll
            for (int e = 0; e < 4; ++e) am = fmaxf(am, fabsf(v[i][e])); }
        am = wave_max(am);
        const float sc = am > 0.f ? 7.f / am : 1.f;
#pragma unroll
        for (int i = 0; i < 8; ++i)
#pragma unroll
            for (int e = 0; e < 4; ++e) stg[F.lane * 33 + permL[i * 4 + e]] = v[i][e] * sc;
        asm volatile("s_waitcnt lgkmcnt(0)" ::: "memory"); __builtin_amdgcn_wave_barrier(); asm volatile("" ::: "memory");
        v16f lo, hi;
#pragma unroll
        for (int i = 0; i < 16; ++i) { lo[i] = stg[F.lane * 33 + i]; hi[i] = stg[F.lane * 33 + 16 + i]; }
        asm volatile("s_waitcnt lgkmcnt(0)" ::: "memory"); __builtin_amdgcn_wave_barrier(); asm volatile("" ::: "memory");
        const v6u w = __builtin_amdgcn_cvt_scalef32_2xpk16_fp6_f32(lo, hi, 1.0f);
        unsigned char* d = dst + (size_t)row * EROW;
        *(u32x4*)(d + F.lane * 16) = (u32x4){w[0], w[1], w[2], w[3]}; *(u32x2*)(d + 1024 + F.lane * 8) = (u32x2){w[4], w[5]};
        if (F.lane == 0) descale[row] = (am > 0.f ? am * (1.f / 7.f) : 1.f) / (fac > 0.f ? fac : 1.f);
    }
}
__device__ __forceinline__ float silu_f(float v) { return v / (1.f + __expf(-v)); }

__device__ __forceinline__ void prologue_phase(const Ctx& F, CParams& P) {
    unsigned char* ws = F.ws;
    {
        float* sv = (float*)F.lds;
        float* part = (float*)(F.lds + 24576);
        for (int i = F.tid; i < 3 * DM; i += 512) { const int v = i / DM, k = i % DM; const float cv = v < 2 ? P.c[v * DM + k] : P.c_ctx[k]; sv[i] = silu_f(cv); }
        __syncthreads();
        float* mod = (float*)(ws + WS_MOD);
        for (int it = F.vcu; it < DEPTH * 192; it += F.G) {
            const int l = it / 192, n0 = (it % 192) * 64;
            const float* wp = P.w_mod + ((size_t)l * DM + F.wid * 256) * 12288 + n0 + F.lane;
            float a0 = 0.f, a1 = 0.f, a2 = 0.f;
#pragma unroll 8
            for (int k = 0; k < 256; ++k) { const float w = wp[(size_t)k * 12288]; const int kk = F.wid * 256 + k; a0 += sv[kk] * w; a1 += sv[DM + kk] * w; a2 += sv[2 * DM + kk] * w; }
            part[(F.wid * 3 + 0) * 64 + F.lane] = a0; part[(F.wid * 3 + 1) * 64 + F.lane] = a1; part[(F.wid * 3 + 2) * 64 + F.lane] = a2;
            __syncthreads();
            if (F.wid < 3) { float s = 0.f;
#pragma unroll
                for (int w = 0; w < 8; ++w) s += part[(w * 3 + F.wid) * 64 + F.lane];
                mod[((size_t)l * 3 + F.wid) * 12288 + n0 + F.lane] = s + P.b_mod[(size_t)l * 12288 + n0 + F.lane]; }
            __syncthreads();
        }
    }
    if (F.vcu == 0) {
        float* t16 = (float*)(ws + WS_TAB16); float* t32 = (float*)(ws + WS_TAB32);
        for (int i = F.tid; i < 128 * 16; i += 512) { const int pos = i >> 4, f = i & 15; const float fr = powf(10000.f, -(float)f / 16.f); const float a = (float)pos * fr; float s, c; sincosf(a, &s, &c); t16[i * 2] = c; t16[i * 2 + 1] = s; }
        for (int i = F.tid; i < 128 * 32; i += 512) { const int pos = i >> 5, f = i & 31; const float fr = powf(10000.f, -(float)f / 32.f); const float a = (float)pos * fr; float s, c; sincosf(a, &s, &c); t32[i * 2] = c; t32[i * 2 + 1] = s; }
        if (F.wid == 2) { float* bnd = (float*)(ws + WS_LAM) + 4;
            for (int e2 = 0; e2 < 2; ++e2) {
                float ga = 0.f, gb = 0.f, gc = 0.f, gd = 0.f, ge = 0.f, gf = 0.f;
                for (int i = F.lane; i < 192; i += 64) { ga = fmaxf(ga, fabsf(P.g_qn_a[e2 * 192 + i])); gb = fmaxf(gb, fabsf(P.g_kn_a[e2 * 192 + i])); }
                gc = fabsf(P.g_qn_b[e2 * 64 + F.lane]); gd = fabsf(P.g_kn_b[e2 * 64 + F.lane]);
                for (int i = F.lane; i < 128; i += 64) { ge = fmaxf(ge, fabsf(P.g_qn_c[e2 * 128 + i])); gf = fmaxf(gf, fabsf(P.g_kn_c[e2 * 128 + i])); }
                ga = wave_max(ga); gb = wave_max(gb); gc = wave_max(gc); gd = wave_max(gd); ge = wave_max(ge); gf = wave_max(gf);
                if (F.lane == 0) { bnd[(2 * e2) * 2 + 0] = 1.03f * 13.856406f * ga * gb;
                                   bnd[(2 * e2) * 2 + 1] = 1.03f * 8.f * gc * gd;
                                   bnd[(2 * e2 + 1) * 2 + 0] = 1.03f * 11.313708f * ge * gf;
                                   bnd[(2 * e2 + 1) * 2 + 1] = 0.f; } } }
        if (F.wid < 2) { const float* lv = P.lam_vec + F.wid * 256; const float d1 = wave_sum(lv[F.lane] * lv[64 + F.lane]), d2 = wave_sum(lv[128 + F.lane] * lv[192 + F.lane]);
            const float lam_init = 0.8f - 0.6f * expf(-0.3f * (float)(2 * F.wid));
            if (F.lane == 0) ((float*)(ws + WS_LAM))[F.wid] = expf(d1) - expf(d2) + lam_init; }
    }
    tconv(F, P.w_in_ab, (bf16_t*)(ws + WS_WINAB), nullptr, 2, DM, AB_IN, AB_INP, 3392, AB_INP - AB_IN);
    tconv(F, P.w_uq, (bf16_t*)(ws + WS_WUQ), P.g_cq, 2, 768, 1536, 1536);
    tconv(F, P.w_ukv, (bf16_t*)(ws + WS_WUKV), P.g_ckv, 2, 512, 2048, 2048);
    tconv(F, P.w_out_ab, (bf16_t*)(ws + WS_WOUTAB), nullptr, 2, DM, DM, DM);
    tconv(F, P.w_in_c, (bf16_t*)(ws + WS_WINC), nullptr, 2, DM, C_IN, C_IN);
    tconv(F, P.w_out_c, (bf16_t*)(ws + WS_WOUTC), nullptr, 2, DM, DM, DM);
    tconv(F, P.w_pq, (bf16_t*)(ws + WS_WPQ), nullptr, 4, DM, DM, DM);
    cvt_flat(F, P.sub_keys, (bf16_t*)(ws + WS_SUBK), (size_t)4 * 8 * 2 * 128 * 128 / 8);
    cvt_rows_fp6(F, P.expert_u, ws + WS_EU, (float*)(ws + WS_SU), 4 * NEXP);
    cvt_rows_fp6(F, P.expert_v, ws + WS_EV, (float*)(ws + WS_SV), 4 * NEXP);
}

__device__ __forceinline__ void norm_rows(const Ctx& F, CParams& P, int layer, int which  , int t_first, int t_end, int t_stride) {
    float* X = (float*)(F.ws + WS_X); bf16_t* H = (bf16_t*)(F.ws + WS_H);
    const float* mod = (const float*)(F.ws + WS_MOD) + (size_t)layer * 3 * 12288;
    const float* gn = (which ? P.g_norm2 : P.g_norm1) + (size_t)layer * DM;
    const bool from_in = (layer == 0 && which == 0);
    const int lane = fresh_lane();
    if (t_first >= t_end) return;
    f32x4 g[8];
#pragma unroll
    for (int j = 0; j < 8; ++j) g[j] = *(const f32x4*)(gn + j * 256 + lane * 4);
    auto srcrow = [&](int t) { return from_in ? (t < TL ? P.x + (size_t)t * DM : P.ctx + (size_t)(t - TL) * DM) : X + (size_t)t * DM; };
    f32x4 vn[8];
    { const float* src = srcrow(t_first);
#pragma unroll
      for (int j = 0; j < 8; ++j) vn[j] = *(const f32x4*)(src + j * 256 + lane * 4); }
    for (int t = t_first; t < t_end; t += t_stride) {
        const int vs = vsel_of_row(t);
        const float* shf = mod + (size_t)vs * 12288 + (which ? 3 : 0) * DM; const float* scl = shf + DM;
        f32x4 v[8], sc[8], sh[8]; float ss = 0.f;
#pragma unroll
        for (int j = 0; j < 8; ++j) { v[j] = vn[j]; sc[j] = *(const f32x4*)(scl + j * 256 + lane * 4); sh[j] = *(const f32x4*)(shf + j * 256 + lane * 4); }
        { const int tn = t + t_stride; const float* src = srcrow(tn < t_end ? tn : t);
#pragma unroll
          for (int j = 0; j < 8; ++j) vn[j] = *(const f32x4*)(src + j * 256 + lane * 4); }
#pragma unroll
        for (int j = 0; j < 8; ++j) ss += v[j][0] * v[j][0] + v[j][1] * v[j][1] + v[j][2] * v[j][2] + v[j][3] * v[j][3];
        ss = wave_sum(ss);
        const float rstd = rsqrtf(ss * (1.f / DM) + EPS);
#pragma unroll
        for (int j = 0; j < 8; ++j) { const int c = j * 256 + lane * 4;
            f32x4 y;
#pragma unroll
            for (int e = 0; e < 4; ++e) y[e] = (v[j][e] * rstd * g[j][e]) * (1.f + sc[j][e]) + sh[j][e];
            u32x2 w; w.x = cvt_pk_bf16(y[0], y[1]); w.y = cvt_pk_bf16(y[2], y[3]);
            *(u32x2*)(H + (size_t)t * DM + c) = w; }
    }
}
__device__ __forceinline__ void norm_phase(const Ctx& F, CParams& P, int layer, int which, int m_rows) { norm_rows(F, P, layer, which, F.vcu * 8 + F.wid, m_rows, F.G * 8); }

#define DPP_ADD(V, CTRL) (V) += __int_as_float(__builtin_amdgcn_update_dpp(0, __float_as_int(V), (CTRL), 0xf, 0xf, true))
__device__ __forceinline__ float grp16_sum(float v) { DPP_ADD(v, 0xB1); DPP_ADD(v, 0x4E); DPP_ADD(v, 0x141); DPP_ADD(v, 0x140); return v; }
__device__ __forceinline__ void rope4(float (&x)[4], int q16, int row, int col, const float* t16) {
    const int seg = q16 >> 3, f0 = (q16 & 3) * 4, pos = seg ? col : row; const bool first = (q16 & 7) < 4;
    const f32x4 c0 = *(const f32x4*)(t16 + (pos * 16 + f0) * 2), c1 = *(const f32x4*)(t16 + (pos * 16 + f0) * 2 + 4);
    const float cs[4] = {c0[0], c0[2], c1[0], c1[2]}, sn[4] = {c0[1], c0[3], c1[1], c1[3]};
#pragma unroll
    for (int e = 0; e < 4; ++e) { const float p = swz_xor<4>(x[e]); x[e] = first ? x[e] * cs[e] - p * sn[e] : p * sn[e] + x[e] * cs[e]; }
}
__device__ __forceinline__ void rope8(float (&x)[8], int q16, int row, int col, const float* t32) {
    const int seg = q16 >> 3, f0 = (q16 & 3) * 8, pos = seg ? col : row; const bool first = (q16 & 7) < 4;
    const float* tp = t32 + (pos * 32 + f0) * 2;
#pragma unroll
    for (int q = 0; q < 4; ++q) { const f32x4 c = *(const f32x4*)(tp + q * 4);
#pragma unroll
        for (int s = 0; s < 2; ++s) { const int e = q * 2 + s; const float cs = c[s * 2], sn = c[s * 2 + 1]; const float p = swz_xor<4>(x[e]); x[e] = first ? x[e] * cs - p * sn : p * sn + x[e] * cs; } }
}
__device__ __forceinline__ void ld8bf(const bf16_t* p, float (&x)[8]) { const u32x4 w = *(const u32x4*)p;
#pragma unroll
    for (int q = 0; q < 4; ++q) { x[q * 2] = bf_lo(w[q]); x[q * 2 + 1] = bf_hi(w[q]); } }
__device__ __forceinline__ void ld4bf(const bf16_t* p, float (&x)[4]) { const u32x2 w = *(const u32x2*)p; x[0] = bf_lo(w.x); x[1] = bf_hi(w.x); x[2] = bf_lo(w.y); x[3] = bf_hi(w.y); }
__device__ __forceinline__ void st8bf(bf16_t* p, const float (&x)[8]) { u32x4 w; w.x = cvt_pk_bf16(x[0], x[1]); w.y = cvt_pk_bf16(x[2], x[3]); w.z = cvt_pk_bf16(x[4], x[5]); w.w = cvt_pk_bf16(x[6], x[7]); *(u32x4*)p = w; }
__device__ __forceinline__ void st4bf(bf16_t* p, const float (&x)[4]) { u32x2 w; w.x = cvt_pk_bf16(x[0], x[1]); w.y = cvt_pk_bf16(x[2], x[3]); *(u32x2*)p = w; }

__device__ __forceinline__ void qkv_even_phase(const Ctx& F, CParams& P, int e) {
    const bf16_t* P1 = (const bf16_t*)(F.ws + WS_P1); const bf16_t* QA = (const bf16_t*)(F.ws + WS_QA); const bf16_t* KV = (const bf16_t*)(F.ws + WS_KV);
    bf16_t* Qm = (bf16_t*)(F.ws + WS_Q1); bf16_t* Km = (bf16_t*)(F.ws + WS_K1); bf16_t* Vm = (bf16_t*)(F.ws + WS_V1);
    bf16_t* Qd = (bf16_t*)(F.ws + WS_Q2); bf16_t* Kd = (bf16_t*)(F.ws + WS_K2); bf16_t* Vd = (bf16_t*)(F.ws + WS_V2);
    const float* t16 = (const float*)(F.ws + WS_TAB16);
    const float* gqa = P.g_qn_a + e * 192; const float* gka = P.g_kn_a + e * 192; const float* gqb = P.g_qn_b + e * 64; const float* gkb = P.g_kn_b + e * 64;
    const int q16 = F.lane & 15, grp = F.lane >> 4;
    float gq_n[8], gq_r[4], gk_n[8], gk_r[4], gqd[4], gkd[4];
#pragma unroll
    for (int i = 0; i < 8; ++i) { gq_n[i] = gqa[q16 * 8 + i]; gk_n[i] = gka[q16 * 8 + i]; }
#pragma unroll
    for (int i = 0; i < 4; ++i) { gq_r[i] = gqa[128 + q16 * 4 + i]; gk_r[i] = gka[128 + q16 * 4 + i]; gqd[i] = gqb[q16 * 4 + i]; gkd[i] = gkb[q16 * 4 + i]; }
    struct Raw { u32x2 cq[3]; u32x4 ckv; u32x2 kro; u32x4 qn[2]; u32x2 qr[2]; u32x4 kn[2], kv[2]; u32x2 dq[4], dk[4]; f32x4 rc0, rc1; };
    auto load_raw = [&](int t, Raw& R) {
        const bf16_t* p1 = P1 + (size_t)t * AB_INP;
        { const int s_ = t & (SEQ - 1), pos_ = (q16 >> 3) ? (s_ & 63) : (s_ >> 6); const float* tp = t16 + (pos_ * 16 + (q16 & 3) * 4) * 2; R.rc0 = *(const f32x4*)tp; R.rc1 = *(const f32x4*)(tp + 4); }
#pragma unroll
        for (int j = 0; j < 3; ++j) R.cq[j] = *(const u32x2*)(p1 + j * 256 + F.lane * 4);
        R.ckv = *(const u32x4*)(p1 + 768 + F.lane * 8);
        R.kro = *(const u32x2*)(p1 + 1280 + q16 * 4);
#pragma unroll
        for (int ps = 0; ps < 2; ++ps) { const int h = ps * 4 + grp; const bf16_t* src = QA + (size_t)t * 1536 + h * 192;
            R.qn[ps] = *(const u32x4*)(src + q16 * 8); R.qr[ps] = *(const u32x2*)(src + 128 + q16 * 4);
            const bf16_t* sk = KV + (size_t)t * 2048 + h * 256; R.kn[ps] = *(const u32x4*)(sk + q16 * 8); R.kv[ps] = *(const u32x4*)(sk + 128 + q16 * 8); }
#pragma unroll
        for (int ps = 0; ps < 4; ++ps) { const int hm = ps * 4 + grp; R.dq[ps] = *(const u32x2*)(p1 + 1344 + hm * 64 + q16 * 4); R.dk[ps] = *(const u32x2*)(p1 + 2368 + hm * 64 + q16 * 4); }
    };
#define UNP8(W, X) do { X[0] = bf_lo(W.x); X[1] = bf_hi(W.x); X[2] = bf_lo(W.y); X[3] = bf_hi(W.y); X[4] = bf_lo(W.z); X[5] = bf_hi(W.z); X[6] = bf_lo(W.w); X[7] = bf_hi(W.w); } while (0)
#define UNP4(W, X) do { X[0] = bf_lo(W.x); X[1] = bf_hi(W.x); X[2] = bf_lo(W.y); X[3] = bf_hi(W.y); } while (0)
    const int tfirst = F.vcu * 8 + F.wid, tstr = F.G * 8;
    Raw R; if (tfirst < TT) load_raw(tfirst, R);
    for (int t = tfirst; t < TT; t += tstr) {
        const bool latent = t < TL; const int s = t & (SEQ - 1), row = s >> 6, col = s & 63; const int kr = krow_of(t);
        Raw C = R; { const int tn = t + tstr; load_raw(tn < TT ? tn : t, R); }
        const float rcs[4] = {C.rc0[0], C.rc0[2], C.rc1[0], C.rc1[2]}, rsn[4] = {C.rc0[1], C.rc0[3], C.rc1[1], C.rc1[3]}; const bool rfirst = (q16 & 7) < 4;
#define ROPE4V(X) do { _Pragma("unroll") for (int e_ = 0; e_ < 4; ++e_) { const float p_ = swz_xor<4>(X[e_]); X[e_] = rfirst ? X[e_] * rcs[e_] - p_ * rsn[e_] : p_ * rsn[e_] + X[e_] * rcs[e_]; } } while (0)
        float ss = 0.f;
#pragma unroll
        for (int j = 0; j < 3; ++j) { float x[4]; UNP4(C.cq[j], x); ss += x[0] * x[0] + x[1] * x[1] + x[2] * x[2] + x[3] * x[3]; }
        ss = wave_sum(ss); const float rstd_q = rsqrtf(ss * (1.f / 768.f) + EPS);
        float s2 = 0.f;
        { float x[8]; UNP8(C.ckv, x);
#pragma unroll
          for (int i = 0; i < 8; ++i) s2 += x[i] * x[i]; }
        s2 = wave_sum(s2); const float rstd_kv = rsqrtf(s2 * (1.f / 512.f) + EPS);
        float kro[4]; UNP4(C.kro, kro);
#pragma unroll
        for (int ps = 0; ps < 2; ++ps) { const int h = ps * 4 + grp;
            float xn[8], xr[4]; UNP8(C.qn[ps], xn); UNP4(C.qr[ps], xr);
            float sq = 0.f;
#pragma unroll
            for (int i = 0; i < 8; ++i) { xn[i] *= rstd_q; sq += xn[i] * xn[i]; }
#pragma unroll
            for (int i = 0; i < 4; ++i) { xr[i] *= rstd_q; sq += xr[i] * xr[i]; }
            sq = grp16_sum(sq); const float r = rsqrtf(sq * (1.f / 192.f) + EPS);
            const float rq = r * (0.07216878364870322f * LOG2E);
#pragma unroll
            for (int i = 0; i < 8; ++i) xn[i] *= rq * gq_n[i];
#pragma unroll
            for (int i = 0; i < 4; ++i) xr[i] *= rq * gq_r[i];
            if (latent) ROPE4V(xr);
            bf16_t* dst = Qm + ((size_t)t * 8 + h) * 192; st8bf(dst + q16 * 8, xn); st4bf(dst + 128 + q16 * 4, xr); }
#pragma unroll
        for (int ps = 0; ps < 2; ++ps) { const int h = ps * 4 + grp;
            float xn[8], xr[4], xv[8]; UNP8(C.kn[ps], xn); UNP8(C.kv[ps], xv);
            float sq = 0.f;
#pragma unroll
            for (int i = 0; i < 8; ++i) { xn[i] *= rstd_kv; xv[i] *= rstd_kv; sq += xn[i] * xn[i]; }
#pragma unroll
            for (int i = 0; i < 4; ++i) { xr[i] = kro[i]; sq += xr[i] * xr[i]; }
            sq = grp16_sum(sq); const float r = rsqrtf(sq * (1.f / 192.f) + EPS);
#pragma unroll
            for (int i = 0; i < 8; ++i) xn[i] *= r * gk_n[i];
#pragma unroll
            for (int i = 0; i < 4; ++i) xr[i] *= r * gk_r[i];
            if (latent) ROPE4V(xr);
            bf16_t* dst = Km + ((size_t)kr * 8 + h) * 192; st8bf(dst + q16 * 8, xn); st4bf(dst + 128 + q16 * 4, xr);
            st8bf(Vm + ((size_t)kr * 8 + h) * 128 + q16 * 8, xv); }
#pragma unroll
        for (int ps = 0; ps < 4; ++ps) { const int hm = ps * 4 + grp;
            float x[4]; UNP4(C.dq[ps], x);
            float sq = grp16_sum(x[0] * x[0] + x[1] * x[1] + x[2] * x[2] + x[3] * x[3]); float r = rsqrtf(sq * (1.f / 64.f) + EPS);
#pragma unroll
            for (int i = 0; i < 4; ++i) x[i] *= r * (0.125f * LOG2E) * gqd[i];
            if (latent) ROPE4V(x);
            st4bf(Qd + ((size_t)t * 16 + hm) * 64 + q16 * 4, x);
            UNP4(C.dk[ps], x);
            sq = grp16_sum(x[0] * x[0] + x[1] * x[1] + x[2] * x[2] + x[3] * x[3]); r = rsqrtf(sq * (1.f / 64.f) + EPS);
#pragma unroll
            for (int i = 0; i < 4; ++i) x[i] *= r * gkd[i];
            if (latent) ROPE4V(x);
            st4bf(Kd + ((size_t)kr * 16 + hm) * 64 + q16 * 4, x); }
    }
#undef UNP8
#undef UNP4
#undef ROPE4V
}
__device__ __forceinline__ void qkv_odd_rows(const Ctx& F, CParams& P, int e, int t_first, int t_end, int t_stride) {
    const bf16_t* P1 = (const bf16_t*)(F.ws + WS_P1);
    bf16_t* Qc = (bf16_t*)(F.ws + WS_Q1); bf16_t* Kc = (bf16_t*)(F.ws + WS_K1); bf16_t* Vc = (bf16_t*)(F.ws + WS_V1);
    const float* t32 = (const float*)(F.ws + WS_TAB32);
    const int lane = fresh_lane();
    const int q16 = lane & 15, grp = lane >> 4;
    float gq[8], gk[8];
#pragma unroll
    for (int i = 0; i < 8; ++i) { gq[i] = P.g_qn_c[e * 128 + q16 * 8 + i]; gk[i] = P.g_kn_c[e * 128 + q16 * 8 + i]; }
    if (t_first >= t_end) return;
    struct Raw { u32x4 x[5]; f32x4 rc[4]; };
    auto load_raw = [&](int t, Raw& R) {
        const bf16_t* p1 = P1 + (size_t)t * C_IN;
#pragma unroll
        for (int ps = 0; ps < 5; ++ps) { const bool isq = ps < 4; const int h = isq ? ps * 4 + grp : grp; R.x[ps] = *(const u32x4*)(p1 + (isq ? 0 : 2048) + h * 128 + q16 * 8); }
        const int s_ = t & (SEQ - 1), pos_ = (q16 >> 3) ? (s_ & 63) : (s_ >> 6); const float* tp = t32 + (pos_ * 32 + (q16 & 3) * 8) * 2;
#pragma unroll
        for (int q = 0; q < 4; ++q) R.rc[q] = *(const f32x4*)(tp + q * 4);
    };
    Raw R; load_raw(t_first, R);
    for (int t = t_first; t < t_end; t += t_stride) {
        const bool latent = t < TL; const int kr = krow_of(t);
        Raw C = R; { const int tn = t + t_stride; load_raw(tn < t_end ? tn : t, R); }
        const bool rfirst = (q16 & 7) < 4;
#pragma unroll
        for (int ps = 0; ps < 5; ++ps) {
            const bool isq = ps < 4; const int h = isq ? ps * 4 + grp : grp;
            float x[8]; { const u32x4 w = C.x[ps]; x[0] = bf_lo(w.x); x[1] = bf_hi(w.x); x[2] = bf_lo(w.y); x[3] = bf_hi(w.y); x[4] = bf_lo(w.z); x[5] = bf_hi(w.z); x[6] = bf_lo(w.w); x[7] = bf_hi(w.w); }
            float sq = 0.f;
#pragma unroll
            for (int i = 0; i < 8; ++i) sq += x[i] * x[i];
            sq = grp16_sum(sq); const float r = rsqrtf(sq * (1.f / 128.f) + EPS);
#pragma unroll
            for (int i = 0; i < 8; ++i) x[i] *= r * (isq ? gq[i] * (0.08838834764831845f * LOG2E) : gk[i]);
            if (latent) {
#pragma unroll
                for (int q = 0; q < 4; ++q)
#pragma unroll
                    for (int s2 = 0; s2 < 2; ++s2) { const int e = q * 2 + s2; const float cs = C.rc[q][s2 * 2], sn = C.rc[q][s2 * 2 + 1]; const float p = swz_xor<4>(x[e]); x[e] = rfirst ? x[e] * cs - p * sn : p * sn + x[e] * cs; } }
            st8bf(isq ? Qc + ((size_t)t * 16 + h) * 128 + q16 * 8 : Kc + ((size_t)kr * 4 + h) * 128 + q16 * 8, x); }
    }
}

template <int DQK, int SDEPTH, int ldo, int NH, int NKVH, int NVH>
__device__ __forceinline__ void attn_phase(const Ctx& F, const bf16_t* Qbuf, const bf16_t* Kbuf, const bf16_t* Vbuf, bf16_t* OF, int ocol0, bool with_ctx, const float bound  ) {
    const bool nomax = bound < 60.f;
    const float negMC = 0.f;
    constexpr int kv_div = NH / NKVH, v_div = NH / NVH;
    const int n_lat = NH * NB * 32, n_tot = n_lat + (with_ctx ? NH * NB : 0);
    constexpr int ldq = NH * DQK, ldk = NKVH * DQK, ldv = NVH * 128;
    for (int u = F.vcu; u < n_tot; u += F.G) {
        int b, h, qrow0, kstart, seq;
        if (u < n_lat) { const int bh = u >> 5, qb = u & 31; b = bh / NH; h = bh % NH; qrow0 = b * SEQ + qb * 256; kstart = b * KPB; seq = KPB; }
        else { const int bh = u - n_lat; b = bh / NH; h = bh % NH; qrow0 = TL + b * CTXL; kstart = b * KPB + SEQ; seq = CTXL; }
        const bf16_t* Qp = Qbuf + ((size_t)qrow0 * NH + h) * DQK;
        const bf16_t* Kp = Kbuf + ((size_t)kstart * NKVH + h / kv_div) * DQK;
        const bf16_t* Vp = Vbuf + ((size_t)kstart * NVH + h / v_div) * 128;
        bf16_t* Op = OF + (size_t)qrow0 * ldo + ocol0 + h * 128;
        if constexpr (SDEPTH == 0) att::attn_body_simple<DQK, (DQK == 192 ? MLA_QL : 0), ldq, ldk, ldv, ldo>(Qp, Kp, Vp, Op, seq, F.lds, F.wid);
        else { if (nomax) att::attn_body<DQK, SDEPTH, (DQK == 192 ? MLA_QL : (DQK == 128 ? GQA_QL : 0)), true, ldq, ldk, ldv, ldo>(Qp, Kp, Vp, Op, seq, F.lds, F.wid, negMC);
               else att::attn_body_simple<DQK, 0, ldq, ldk, ldv, ldo>(Qp, Kp, Vp, Op, seq, F.lds, F.wid); }
    }
}

__device__ __forceinline__ void merge_even_phase(const Ctx& F, CParams& P, int e, int layer, int m_rows) {
    const bf16_t* OD = (const bf16_t*)(F.ws + WS_OF); bf16_t* AO = (bf16_t*)(F.ws + WS_AO);
    const float lam = ((const float*)(F.ws + WS_LAM))[e];
    const float lam_init = 0.8f - 0.6f * expf(-0.3f * (float)layer);
    const int q16 = F.lane & 15, grp = F.lane >> 4;
    float gs[8];
#pragma unroll
    for (int i = 0; i < 8; ++i) gs[i] = P.g_sub_b[e * 128 + q16 * 8 + i] * (1.f - lam_init);
    for (int t = F.vcu * 8 + F.wid; t < m_rows; t += F.G * 8) {
        const bf16_t* od = OD + (size_t)t * DM; bf16_t* ao = AO + (size_t)t * DM + 1024;
#pragma unroll
        for (int ps = 0; ps < 2; ++ps) { const int h = ps * 4 + grp;
            float o0[8], o1[8], d[8]; ld8bf(od + (2 * h) * 128 + q16 * 8, o0); ld8bf(od + (2 * h + 1) * 128 + q16 * 8, o1);
            float sq = 0.f;
#pragma unroll
            for (int i = 0; i < 8; ++i) { d[i] = o0[i] - lam * o1[i]; sq += d[i] * d[i]; }
            sq = grp16_sum(sq); const float r = rsqrtf(sq * (1.f / 128.f) + EPS);
#pragma unroll
            for (int i = 0; i < 8; ++i) d[i] *= r * gs[i];
            st8bf(ao + h * 128 + q16 * 8, d); }
    }
}

__device__ __forceinline__ void wave_lds_fence() { asm volatile("s_waitcnt lgkmcnt(0)" ::: "memory"); __builtin_amdgcn_wave_barrier(); asm volatile("" ::: "memory"); }
__device__ __forceinline__ unsigned fkey(float f) { const unsigned b = __float_as_uint(f); return b ^ ((unsigned)((int)b >> 31) | 0x80000000u); }
__device__ __forceinline__ float funkey(unsigned k) { return __uint_as_float((k & 0x80000000u) ? (k ^ 0x80000000u) : ~k); }
__device__ __forceinline__ unsigned umed3(unsigned a, unsigned b, unsigned c) { unsigned r; asm("v_med3_u32 %0, %1, %2, %3" : "=v"(r) : "v"(a), "v"(b), "v"(c)); return r; }
__device__ __forceinline__ void kins16(unsigned (&L)[16], unsigned k) {
#pragma unroll
    for (int p = 15; p >= 1; --p) L[p] = umed3(L[p - 1], L[p], k);
    L[0] = L[0] > k ? L[0] : k;
}
__device__ __forceinline__ void scan_set(unsigned (&L)[16], const bf16_t* qbase  , const bf16_t* kbase  , float* buf, int lane) {
    const int r32 = lane & 31, hi = lane >> 5;
#pragma unroll
    for (int p = 0; p < 16; ++p) L[p] = 0u;
    bf16x8 a0[8], a1[8];
    { const bf16_t* ap = qbase + (size_t)r32 * DM + hi * 8;
#pragma unroll
      for (int ks = 0; ks < 8; ++ks) { a0[ks] = *(const bf16x8*)(ap + ks * 16); a1[ks] = *(const bf16x8*)(ap + (size_t)32 * DM + ks * 16); } }
#pragma unroll 1
    for (int kb = 0; kb < 4; ++kb) {
        f32x16 acc0 = {}, acc1 = {};
        { const bf16_t* bp = kbase + (size_t)(kb * 32 + r32) * 128 + hi * 8;
          bf16x8 b[8];
#pragma unroll
          for (int ks = 0; ks < 8; ++ks) b[ks] = *(const bf16x8*)(bp + ks * 16);
#pragma unroll
          for (int ks = 0; ks < 8; ++ks) { acc0 = __builtin_amdgcn_mfma_f32_32x32x16_bf16(a0[ks], b[ks], acc0, 0, 0, 0); acc1 = __builtin_amdgcn_mfma_f32_32x32x16_bf16(a1[ks], b[ks], acc1, 0, 0, 0); } }
        wave_lds_fence();
#pragma unroll
        for (int r = 0; r < 16; ++r) { const int rowi = att::crow(r, hi); buf[rowi * 33 + r32] = acc0[r]; buf[(32 + rowi) * 33 + r32] = acc1[r]; }
        wave_lds_fence();
        const unsigned tb = 127u - (unsigned)(kb * 32);
#pragma unroll 8
        for (int k = 0; k < 32; ++k) { unsigned code = tb - (unsigned)k; asm volatile("" : "+s"(code)); kins16(L, (fkey(buf[lane * 33 + k]) & ~127u) | code); }
    }
}
__device__ __forceinline__ void peer_select_unit(const Ctx& F, int layer, int u) {
    const bf16_t* PQ = (const bf16_t*)(F.ws + WS_PQ); const bf16_t* SK = (const bf16_t*)(F.ws + WS_SUBK) + (size_t)layer * 8 * 2 * 128 * 128;
    int* PIDX = (int*)(F.ws + WS_PIDX); float* PG = (float*)(F.ws + WS_PG);
    float* buf = (float*)F.lds + F.wid * (64 * 33);
    const int lane = fresh_lane();
    {
        const int tile = u >> 3, h = u & 7, t0 = tile * 64;
        unsigned Ka[16], Kb[16];
        scan_set(Ka, PQ + (size_t)t0 * DM + h * 256, SK + (size_t)(h * 2) * 128 * 128, buf, lane);
        scan_set(Kb, PQ + (size_t)t0 * DM + h * 256 + 128, SK + (size_t)(h * 2 + 1) * 128 * 128, buf, lane);
        wave_lds_fence();
        float la[16], lb[16];
#pragma unroll
        for (int p = 0; p < 16; ++p) { la[p] = funkey(Ka[p] & ~127u); lb[p] = funkey(Kb[p] & ~127u);
            buf[lane * 33 + p] = __int_as_float(127 - (int)(Ka[p] & 127u)); buf[lane * 33 + 16 + p] = __int_as_float(127 - (int)(Kb[p] & 127u)); }
        wave_lds_fence();
        unsigned Kc[16];
#pragma unroll
        for (int p = 0; p < 16; ++p) Kc[p] = (fkey(la[0] + lb[p]) & ~255u) | (unsigned)(255 - p);
#pragma unroll
        for (int r1 = 1; r1 < 16; ++r1)
#pragma unroll
            for (int r2 = 0; r2 < 16; ++r2) if ((r1 + 1) * (r2 + 1) <= 16) kins16(Kc, (fkey(la[r1] + lb[r2]) & ~255u) | (unsigned)(255 - (16 * r1 + r2)));
        float bv[16], sm = 0.f; unsigned idx[16];
#pragma unroll
        for (int p = 0; p < 16; ++p) { const int code = 255 - (int)(Kc[p] & 255u); bv[p] = funkey(Kc[p] & ~255u);
            idx[p] = (unsigned)(__float_as_int(buf[lane * 33 + (code >> 4)]) * 128 + __float_as_int(buf[lane * 33 + 16 + (code & 15)])); }
        const float bmax = bv[0];
#pragma unroll
        for (int p = 0; p < 16; ++p) { bv[p] = __expf(bv[p] - bmax); sm += bv[p]; }
        const float inv = 1.f / sm;
        const size_t o = ((size_t)(t0 + lane) * 8 + h) * 16;
#pragma unroll
        for (int q = 0; q < 4; ++q) { *(f32x4*)(PG + o + q * 4) = (f32x4){bv[q * 4] * inv, bv[q * 4 + 1] * inv, bv[q * 4 + 2] * inv, bv[q * 4 + 3] * inv};
            *(u32x4*)(PIDX + o + q * 4) = (u32x4){idx[q * 4], idx[q * 4 + 1], idx[q * 4 + 2], idx[q * 4 + 3]}; }
    }
}
__device__ __forceinline__ bool ctx_sel_hidden(const Ctx& F) { return F.G == 256; }
__device__ __forceinline__ void peer_select_phase(const Ctx& F, int layer, int m_rows) {
    const int nunits = ((ctx_sel_hidden(F) ? TL : m_rows) / 64) * 8;
#pragma unroll 1
    for (int u = F.vcu * 8 + F.wid; u < nunits; u += F.G * 8) peer_select_unit(F, layer, u);
}

__device__ __forceinline__ float gelu_tanh(float a) { const float u = 0.7978845608028654f * (a + 0.044715f * a * a * a); const float t = 1.f - 2.f / (1.f + __expf(2.f * u)); return 0.5f * a * (1.f + t); }
struct Row6 { u32x2 r[3]; };
__device__ __forceinline__ void ld_row6(Row6& R, const unsigned char* tab, int e, int lane) {
    const unsigned char* rb = tab + (size_t)e * EROW;
    const u32x4 a = *(const u32x4*)(rb + (unsigned)lane * 16u); const u32x2 b = *(const u32x2*)(rb + 1024 + (unsigned)lane * 8u);
    R.r[0] = (u32x2){a.x, a.y}; R.r[1] = (u32x2){a.z, a.w}; R.r[2] = b;
}
__device__ __forceinline__ v32f dq_row6(const Row6& R, float dep) { unsigned r0 = R.r[0].x; asm volatile("" : "+v"(r0) : "v"(dep));
    const v6u w = {r0, R.r[0].y, R.r[1].x, R.r[1].y, R.r[2].x, R.r[2].y}; return __builtin_amdgcn_cvt_scalef32_pk32_f32_fp6(w, 1.0f); }
__device__ __forceinline__ float dot_row6(const Row6& R, const float (&h)[32], float& chain) {
    const v32f f = dq_row6(R, chain);
    typedef float f2_t __attribute__((ext_vector_type(2)));
    f2_t a = {0.f, 0.f}, b = {0.f, 0.f};
#pragma unroll
    for (int i = 0; i < 8; ++i) { a = __builtin_elementwise_fma((f2_t){f[i * 4 + 0], f[i * 4 + 1]}, (f2_t){h[i * 4 + 0], h[i * 4 + 1]}, a);
                                  b = __builtin_elementwise_fma((f2_t){f[i * 4 + 2], f[i * 4 + 3]}, (f2_t){h[i * 4 + 2], h[i * 4 + 3]}, b); }
    const float s = (a[0] + a[1]) + (b[0] + b[1]);
    chain = s;
    return s;
}
__device__ __forceinline__ void fma_row6(float (&out)[32], const Row6& R, float w) {
    const v32f f = dq_row6(R, out[0]);
#pragma unroll
    for (int i = 0; i < 32; ++i) out[i] = fmaf(w, f[i], out[i]);
}
__device__ __forceinline__ float reduce4(float s0, float s1, float s2, float s3, int lane) {
    const bool hi = (lane & 32) != 0, b4 = (lane & 16) != 0;
    const float r0 = xor32_partner(hi ? s0 : s2, lane), r1 = xor32_partner(hi ? s1 : s3, lane);
    const float a0 = (hi ? s2 : s0) + r0, a1 = (hi ? s3 : s1) + r1;
    const float r = swz_xor<16>(b4 ? a0 : a1);
    float b = (b4 ? a1 : a0) + r;
    b += swz_xor<8>(b); b += swz_xor<4>(b); b += swz_xor<2>(b); b += swz_xor<1>(b);
    return b;
}
__device__ __forceinline__ float rl_f(float v, int l) { return __uint_as_float(__builtin_amdgcn_readlane(__float_as_uint(v), l)); }
__device__ __forceinline__ void wr_lane(float& dst, float val_uniform, int lane_uniform, int lane) { asm volatile("" : "+s"(lane_uniform)); dst = (lane == lane_uniform) ? val_uniform : dst; }
__device__ __forceinline__ void peer_expert_tokens(const Ctx& F, CParams& P, int layer, int m_rows_all, bool last, bool dry, bool hide, unsigned* selflag, int k_lo, int k_hi) {
    const unsigned char* EU = F.ws + WS_EU + (size_t)layer * NEXP * EROW; const unsigned char* EV = F.ws + WS_EV + (size_t)layer * NEXP * EROW;
    const float* SU = (const float*)(F.ws + WS_SU) + (size_t)layer * NEXP; const float* SV = (const float*)(F.ws + WS_SV) + (size_t)layer * NEXP;
    const bf16_t* H = (const bf16_t*)(F.ws + WS_H); float* X = (float*)(F.ws + WS_X);
    const int* PIDX = (const int*)(F.ws + WS_PIDX); const float* PG = (const float*)(F.ws + WS_PG);
    const float* mod = (const float*)(F.ws + WS_MOD) + (size_t)layer * 3 * 12288;
    const int lane = fresh_lane();
    const int tstride = F.G * 8, t0 = F.vcu * 8 + F.wid + k_lo * tstride;
    const int m_hi = F.vcu * 8 + F.wid + k_hi * tstride, m_rows = m_hi < m_rows_all ? m_hi : m_rows_all;
    if (t0 >= m_rows) return;
    int id0 = PIDX[(size_t)t0 * 128 + lane], id1 = PIDX[(size_t)t0 * 128 + 64 + lane];
    u32x2 hp4[8]; float gk0, gk1;
    { const bf16_t* hp = H + (size_t)t0 * DM + (unsigned)lane * 4u;
#pragma unroll
      for (int j = 0; j < 8; ++j) hp4[j] = *(const u32x2*)(hp + j * 256); }
    gk0 = PG[(size_t)t0 * 128 + lane]; gk1 = PG[(size_t)t0 * 128 + 64 + lane];
    Row6 A[4], B[4];
#pragma unroll
    for (int q = 0; q < 4; ++q) ld_row6(A[q], EU, __builtin_amdgcn_readlane(id0, q), lane);
    for (int t = t0; t < m_rows; t += tstride) {
        const int tn = t + tstride; const int tq = tn < m_rows ? tn : t;
        float hf[32];
#pragma unroll
        for (int j = 0; j < 8; ++j) { hf[j * 4 + 0] = bf_lo(hp4[j].x); hf[j * 4 + 1] = bf_hi(hp4[j].x); hf[j * 4 + 2] = bf_lo(hp4[j].y); hf[j * 4 + 3] = bf_hi(hp4[j].y); }
        const float cgk0 = gk0, cgk1 = gk1;
        const float su0 = SU[id0], sv0 = SV[id0], su1 = SU[id1], sv1 = SV[id1];
        int nid0, nid1; float ngk0, ngk1;
        if (hide && tq >= TL) {
            { unsigned sp = 0u; while (xb_ld(selflag) < (unsigned)((TT - TL) / 64 * 8)) { __builtin_amdgcn_s_sleep(1); if (++sp > XB_SPIN_CAP) break; } }
            __builtin_amdgcn_fence(__ATOMIC_ACQUIRE, "agent");
            nid0 = __hip_atomic_load(PIDX + (size_t)tq * 128 + lane, __ATOMIC_RELAXED, __HIP_MEMORY_SCOPE_AGENT); nid1 = __hip_atomic_load(PIDX + (size_t)tq * 128 + 64 + lane, __ATOMIC_RELAXED, __HIP_MEMORY_SCOPE_AGENT);
            ngk0 = __int_as_float(__hip_atomic_load((const int*)PG + (size_t)tq * 128 + lane, __ATOMIC_RELAXED, __HIP_MEMORY_SCOPE_AGENT)); ngk1 = __int_as_float(__hip_atomic_load((const int*)PG + (size_t)tq * 128 + 64 + lane, __ATOMIC_RELAXED, __HIP_MEMORY_SCOPE_AGENT));
        } else { nid0 = PIDX[(size_t)tq * 128 + lane]; nid1 = PIDX[(size_t)tq * 128 + 64 + lane]; ngk0 = PG[(size_t)tq * 128 + lane]; ngk1 = PG[(size_t)tq * 128 + 64 + lane]; }
        { const bf16_t* hp = H + (size_t)tq * DM + (unsigned)lane * 4u;
#pragma unroll
          for (int j = 0; j < 8; ++j) hp4[j] = *(const u32x2*)(hp + j * 256); }
        gk0 = ngk0; gk1 = ngk1;
        float wv0 = 0.f, wv1 = 0.f;
        float out[32];
#pragma unroll
        for (int i = 0; i < 32; ++i) out[i] = 0.f;
#pragma unroll
        for (int seg = 0; seg < 4; ++seg) {
            const int idc = (seg & 1) ? id1 : id0;
            const int idn = (seg == 0) ? id1 : (seg == 1 ? id0 : (seg == 2 ? id1 : nid0));
            const unsigned char* tabc = seg < 2 ? EU : EV; const unsigned char* tabn = (seg == 0 || seg == 3) ? EU : EV;
            const float wr = (seg & 1) ? wv1 : wv0;
            float acc = 0.f, chain = 0.f;
#pragma unroll 1
            for (int k = 0; k < 64; k += 8) {
#pragma unroll
                for (int q = 0; q < 4; ++q) ld_row6(B[q], tabc, __builtin_amdgcn_readlane(idc, k + 4 + q), lane);
                if (seg < 2) { const float d0 = dot_row6(A[0], hf, chain), d1 = dot_row6(A[1], hf, chain), d2 = dot_row6(A[2], hf, chain), d3 = dot_row6(A[3], hf, chain); const float b = reduce4(d0, d1, d2, d3, lane);
#pragma unroll
                    for (int q = 0; q < 4; ++q) wr_lane(acc, rl_f(b, 16 * q), k + q, lane); }
                else {
#pragma unroll
                    for (int q = 0; q < 4; ++q) fma_row6(out, A[q], rl_f(wr, k + q)); }
                { const bool nx = k + 8 >= 64;
#pragma unroll
                  for (int q = 0; q < 4; ++q) { const int ec = __builtin_amdgcn_readlane(idc, (k + 8 + q) & 63), en = __builtin_amdgcn_readlane(idn, q);
                      ld_row6(A[q], nx ? tabn : tabc, nx ? en : ec, lane); } }
                if (seg < 2) { const float d0 = dot_row6(B[0], hf, chain), d1 = dot_row6(B[1], hf, chain), d2 = dot_row6(B[2], hf, chain), d3 = dot_row6(B[3], hf, chain); const float b = reduce4(d0, d1, d2, d3, lane);
#pragma unroll
                    for (int q = 0; q < 4; ++q) wr_lane(acc, rl_f(b, 16 * q), k + 4 + q, lane); }
                else {
#pragma unroll
                    for (int q = 0; q < 4; ++q) fma_row6(out, B[q], rl_f(wr, k + 4 + q)); }
            }
            if (seg == 0) wv0 = cgk0 * gelu_tanh(acc * su0) * sv0;
            if (seg == 1) wv1 = cgk1 * gelu_tanh(acc * su1) * sv1;
        }
        id0 = nid0; id1 = nid1;
        const int vs = vsel_of_row(t);
        const float* gate = mod + (size_t)vs * 12288 + 5 * DM;
        float* xr = X + (size_t)t * DM; float* dst = dry ? (float*)(F.ws + WS_OF) + (size_t)t * DM : (last ? P.out + (size_t)t * DM : xr);
        float ssq = 0.f;
        const unsigned lo4 = (unsigned)lane * 4u;
        { f32x4 xo[8], gg[8];
#pragma unroll
          for (int q = 0; q < 8; ++q) { const unsigned c = lo4 + q * 256; xo[q] = *(const f32x4*)(xr + c); gg[q] = *(const f32x4*)(gate + c); }
#pragma unroll
          for (int q = 0; q < 8; ++q) { const unsigned c = lo4 + q * 256;
            f32x4 y; y[0] = xo[q][0] + gg[q][0] * out[q * 4 + 0]; y[1] = xo[q][1] + gg[q][1] * out[q * 4 + 1]; y[2] = xo[q][2] + gg[q][2] * out[q * 4 + 2]; y[3] = xo[q][3] + gg[q][3] * out[q * 4 + 3];
            *(f32x4*)(dst + c) = y;
            out[q * 4 + 0] = y[0]; out[q * 4 + 1] = y[1]; out[q * 4 + 2] = y[2]; out[q * 4 + 3] = y[3];
            ssq += y[0] * y[0] + y[1] * y[1] + y[2] * y[2] + y[3] * y[3]; } }
        if (!last && !dry) {
            const float rstd = rsqrtf(wave_sum(ssq) * (1.f / DM) + EPS);
            const float* gn = P.g_norm1 + (size_t)(layer + 1) * DM;
            const float* shf = mod + (size_t)3 * 12288 + (size_t)vs * 12288; const float* scl = shf + DM;
            bf16_t* hrow = (bf16_t*)(F.ws + WS_H) + (size_t)t * DM;
#pragma unroll
            for (int jh = 0; jh < 2; ++jh) { f32x4 g8[4], sc8[4], sh8[4];
#pragma unroll
                for (int i = 0; i < 4; ++i) { const unsigned c = lo4 + (jh * 4 + i) * 256; g8[i] = *(const f32x4*)(gn + c); sc8[i] = *(const f32x4*)(scl + c); sh8[i] = *(const f32x4*)(shf + c); }
#pragma unroll
                for (int i = 0; i < 4; ++i) { const int qg = jh * 4 + i; const f32x4 g = g8[i], sc = sc8[i], sh = sh8[i];
                    float y[4];
#pragma unroll
                    for (int e2 = 0; e2 < 4; ++e2) y[e2] = (out[qg * 4 + e2] * rstd * g[e2]) * (1.f + sc[e2]) + sh[e2];
                    u32x2 w; w.x = cvt_pk_bf16(y[0], y[1]); w.y = cvt_pk_bf16(y[2], y[3]);
                    *(u32x2*)(hrow + lo4 + qg * 256) = w; } }
        }
    }
}

__device__ __forceinline__ void ctl_wait(unsigned* c, unsigned want) { unsigned sp = 0u; while (xb_ld(c) < want) { __builtin_amdgcn_s_sleep(1); if (++sp > XB_SPIN_CAP) break; } }
__device__ __forceinline__ void peer_expert_phase(const Ctx& F, CParams& P, int layer, int m_rows, bool last, bool dry, LAS unsigned char* ldsl, const bf16_t* Wout) {
    const bool hide = ctx_sel_hidden(F) && m_rows > TL && !dry;
    unsigned* ctl = (unsigned*)(F.ws + WS_CTL) + 8192 + layer * 512;
    unsigned* selflag = ctl;
    int role = 0, ri = 0;
    if (hide && F.vcu >= 64) { const int d = F.vcu - 64;
        if (d % 12 == 0) { role = 1; ri = d / 12; } else if (d % 12 == 6) { role = 2; ri = d / 12; } else if (d % 3 == 1 && F.wid == 0) { role = 3; ri = d / 3; } }
    const int ksplit = role == 1 ? 0 : (role == 2 ? 1 : (role == 3 ? 2 : 9));
#pragma unroll 1
    for (int st = 0; st < 2; ++st) {
        const int kb = st == 0 ? 0 : ksplit, ke = st == 0 ? ksplit : 9;
        if (ke > kb) peer_expert_tokens(F, P, layer, m_rows, last, dry, hide, selflag, kb, ke);
        if (st != 0 || role == 0) continue;
        const int pmi = ri >> 3, pn = ri & 7, pm = TL / 256 + pmi;
        if (role == 1) {
            { pg8::Gemm g{(const bf16_t*)(F.ws + WS_AO), Wout, TT, DM, DM, DM}; pg8::OneUnit S{pm, pn};
              pg8::EpiResid E{(float*)(F.ws + WS_X), (const float*)(F.ws + WS_MOD) + (size_t)layer * 3 * 12288, 2, layer == 0 ? P.x : (const float*)(F.ws + WS_X), layer == 0 ? P.ctx : (const float*)(F.ws + WS_X) + (size_t)TL * DM};
              pg8::gemm_phase<pg8::EpiResid, pg8::OneUnit>(ldsl, g, S, E, F.wid); }
            asm volatile("s_waitcnt vmcnt(0)" ::: "memory"); __syncthreads();
            if (F.wid == 0 && fresh_lane() == 0) { __builtin_amdgcn_fence(__ATOMIC_RELEASE, "agent"); asm volatile("s_waitcnt vmcnt(0)" ::: "memory"); (void)xb_add(ctl + 64 + 64 * pmi, 1u);
                           ctl_wait(ctl + 64 + 64 * pmi, 8u); __builtin_amdgcn_fence(__ATOMIC_ACQUIRE, "agent"); }
            __syncthreads();
            { const int r0 = pm * 256 + pn * 32 + F.wid * 4; norm_rows(F, P, layer, 1, r0, r0 + 4, 1); }
            asm volatile("s_waitcnt vmcnt(0)" ::: "memory"); __syncthreads();
            if (F.wid == 0 && fresh_lane() == 0) { __builtin_amdgcn_fence(__ATOMIC_RELEASE, "agent"); asm volatile("s_waitcnt vmcnt(0)" ::: "memory"); (void)xb_add(ctl + 192 + 64 * pmi, 1u); }
        } else if (role == 2) {
            __syncthreads();
            if (F.wid == 0 && fresh_lane() == 0) { ctl_wait(ctl + 192 + 64 * pmi, 8u); __builtin_amdgcn_fence(__ATOMIC_ACQUIRE, "agent"); }
            __syncthreads();
            { pg8::Gemm g{(const bf16_t*)(F.ws + WS_H), (const bf16_t*)(F.ws + WS_WPQ) + (size_t)layer * DM * DM, TT, DM, DM, DM}; pg8::OneUnit S{pm, pn};
              pg8::EpiBf16 E{(bf16_t*)(F.ws + WS_PQ), DM};
              pg8::gemm_phase<pg8::EpiBf16, pg8::OneUnit>(ldsl, g, S, E, F.wid); }
            asm volatile("s_waitcnt vmcnt(0)" ::: "memory"); __syncthreads();
            if (F.wid == 0 && fresh_lane() == 0) { __builtin_amdgcn_fence(__ATOMIC_RELEASE, "agent"); asm volatile("s_waitcnt vmcnt(0)" ::: "memory"); (void)xb_add(ctl + 320, 1u); }
        } else {
            ctl_wait(ctl + 320, 16u); __builtin_amdgcn_fence(__ATOMIC_ACQUIRE, "agent");
            peer_select_unit(F, layer, (TL / 64) * 8 + ri);
            __builtin_amdgcn_fence(__ATOMIC_RELEASE, "agent");
            asm volatile("s_waitcnt vmcnt(0)" ::: "memory");
            if (fresh_lane() == 0) (void)xb_add(selflag, 1u);
        }
    }
}

__device__ __forceinline__ void qkv_odd_phase(const Ctx& F, CParams& P, int e, int layer, LAS unsigned char* ldsl) {
    if (!ctx_sel_hidden(F)) { qkv_odd_rows(F, P, e, F.vcu * 8 + F.wid, TT, F.G * 8); return; }
    const int vx = F.vcu & 31, xq = F.vcu >> 5;
    if (vx >= 29) {
        const int i = xq * 3 + vx - 29, pmi = i / 12, pn = i % 12;
        unsigned* cnt = (unsigned*)(F.ws + WS_CTL) + 8192 + layer * 512 + 384 + 64 * pmi;
        { pg8::Gemm g{(const bf16_t*)(F.ws + WS_H), (const bf16_t*)(F.ws + WS_WINC) + (size_t)e * C_IN * DM, TT, C_IN, DM, DM}; pg8::OneUnit S{TL / 256 + pmi, pn};
          pg8::EpiBf16V E{(bf16_t*)(F.ws + WS_P1), C_IN, (bf16_t*)(F.ws + WS_V1), 10, 512};
          pg8::gemm_phase<pg8::EpiBf16V, pg8::OneUnit>(ldsl, g, S, E, F.wid); }
        asm volatile("s_waitcnt vmcnt(0)" ::: "memory"); __syncthreads();
        if (F.wid == 0 && fresh_lane() == 0) { __builtin_amdgcn_fence(__ATOMIC_RELEASE, "agent"); asm volatile("s_waitcnt vmcnt(0)" ::: "memory"); (void)xb_add(cnt, 1u);
                                               ctl_wait(cnt, 12u); __builtin_amdgcn_fence(__ATOMIC_ACQUIRE, "agent"); }
        __syncthreads();
        qkv_odd_rows(F, P, e, TL + pmi * 256 + pn * 8 + F.wid, TL + pmi * 256 + 256, 96);
    } else qkv_odd_rows(F, P, e, (F.vcu - 3 * xq) * 8 + F.wid, TL, 232 * 8);
}

constexpr int N_PHASES = 1 + 2 * 11 + 2 * 9 - 3;
__global__ void __launch_bounds__(512, 2) mk_fwd(Params Pval) {
    extern __shared__ __attribute__((aligned(16))) unsigned char lds_raw[];
    LAS unsigned char* ldsl = (LAS unsigned char*)lds_raw;
    volatile LAS unsigned* misc = (volatile LAS unsigned*)(ldsl + LDS_MISC);
    if (threadIdx.x < 16) misc[threadIdx.x] = 0u;
    __syncthreads();
    XcdBarrier bar = xcd_barrier_post((unsigned*)(Pval.ws + WS_CTL) + 1024, misc);
    const int wid0 = __builtin_amdgcn_readfirstlane((int)threadIdx.x >> 6);
    const int lo = Pval.ph_lo, hi = Pval.ph_hi; int ph = 0;
#define MKCTX() Ctx F; { const int lane_ = fresh_lane(); int wid_ = wid0; asm volatile("" : "+s"(wid_)); const int tid_ = wid_ * 64 + lane_; F.tid = tid_; F.lane = lane_; F.wid = wid_; \
        int G_ = gridDim.x, bx_ = blockIdx.x; asm volatile("" : "+s"(G_), "+s"(bx_)); F.G = G_; F.vcu = (G_ % 8 == 0) ? (bx_ % 8) * (G_ / 8) + bx_ / 8 : bx_; F.bx = bx_; } \
        unsigned long long kp_ = (unsigned long long)__builtin_amdgcn_kernarg_segment_ptr(); asm volatile("" : "+s"(kp_)); CParams& P = *(CParams*)kp_; \
        F.ws = P.ws; F.lds = (char*)lds_raw; unsigned char* ws = F.ws; (void)ws; \
        bf16_t* Hb = (bf16_t*)(ws + WS_H); bf16_t* P1 = (bf16_t*)(ws + WS_P1); float* X = (float*)(ws + WS_X); const float* mod = (const float*)(ws + WS_MOD); (void)Hb; (void)P1; (void)X; (void)mod;
#define PHASE(cls, ...) do { if (ph >= lo && ph < hi) { if constexpr ((PH_MASK >> (cls)) & 1u) { \
        if constexpr ((PH_DOUBLE >> (cls)) & 1u) { const bool dry = true; (void)dry; MKCTX(); __VA_ARGS__; __syncthreads(); } \
        { const bool dry = false; (void)dry; MKCTX(); __VA_ARGS__; } } if (ph + 1 < hi) { int w0_ = wid0; asm volatile("" : "+s"(w0_)); xcd_barrier(bar, w0_ == 0 && fresh_lane() == 0); } } ++ph; } while (0)

    PHASE(0, prologue_phase(F, P));
#pragma unroll 1
    for (int layer = 0; layer < DEPTH; ++layer) {
        const int e = layer >> 1; const bool even = (layer & 1) == 0, lastl = layer == DEPTH - 1;
        const int m_post = lastl ? TL : TT;
        if (layer == 0) PHASE(1, norm_phase(F, P, layer, 0, TT));
        PHASE(2, { const bf16_t* W = even ? (const bf16_t*)(ws + WS_WINAB) + (size_t)e * AB_INP * DM : (const bf16_t*)(ws + WS_WINC) + (size_t)e * C_IN * DM;
                const int N = even ? AB_INP : C_IN;
                const int m2 = (!even && ctx_sel_hidden(F)) ? TL : TT;
                pg8::Gemm g{Hb, W, m2, N, DM, DM}; pg8::StaticOrder S; S.init(m2, N, F.G, F.bx);
                pg8::EpiBf16V E{P1, N, even ? (bf16_t*)(ws + WS_V2) : (bf16_t*)(ws + WS_V1), even ? 14 : 10, even ? 1024 : 512};
                pg8::gemm_phase<pg8::EpiBf16V, pg8::StaticOrder>(ldsl, g, S, E, F.wid); });
        if (even) {
            PHASE(3, { { pg8::Gemm g{P1, (const bf16_t*)(ws + WS_WUQ) + (size_t)e * 1536 * 768, TT, 1536, 768, AB_INP}; pg8::StaticOrder S; S.init(TT, 1536, F.G, F.bx);
                      pg8::EpiBf16 E{(bf16_t*)(ws + WS_QA), 1536};
                      pg8::gemm_phase<pg8::EpiBf16, pg8::StaticOrder>(ldsl, g, S, E, F.wid); }
                    { pg8::Gemm g{P1 + 768, (const bf16_t*)(ws + WS_WUKV) + (size_t)e * 2048 * 512, TT, 2048, 512, AB_INP}; pg8::StaticOrder S; S.init(TT, 2048, F.G, F.G - 1 - F.bx);
                      pg8::EpiBf16 E{(bf16_t*)(ws + WS_KV), 2048};
                      pg8::gemm_phase<pg8::EpiBf16, pg8::StaticOrder>(ldsl, g, S, E, F.wid); } });
            PHASE(4, qkv_even_phase(F, P, e));
            PHASE(5, { if constexpr (ATT_DBL & 1) attn_phase<192, MLA_SD, 2048, 8, 8, 8>(F, (const bf16_t*)(ws + WS_Q1), (const bf16_t*)(ws + WS_K1), (const bf16_t*)(ws + WS_V1), (bf16_t*)(ws + WS_AO), 0, !lastl, ((const float*)(ws + WS_LAM))[4 + layer * 2]);
                    if constexpr (ATT_DBL & 2) attn_phase<64, 2, 2048, 16, 16, 8>(F, (const bf16_t*)(ws + WS_Q2), (const bf16_t*)(ws + WS_K2), (const bf16_t*)(ws + WS_V2), (bf16_t*)(ws + WS_OF), 0, !lastl, ((const float*)(ws + WS_LAM))[4 + layer * 2 + 1]);
                    if constexpr (ATT_SEL & 1) attn_phase<192, MLA_SD, 2048, 8, 8, 8>(F, (const bf16_t*)(ws + WS_Q1), (const bf16_t*)(ws + WS_K1), (const bf16_t*)(ws + WS_V1), (bf16_t*)(ws + WS_AO), 0, !lastl, ((const float*)(ws + WS_LAM))[4 + layer * 2]);
                    if constexpr (ATT_SEL & 2) attn_phase<64, 2, 2048, 16, 16, 8>(F, (const bf16_t*)(ws + WS_Q2), (const bf16_t*)(ws + WS_K2), (const bf16_t*)(ws + WS_V2), (bf16_t*)(ws + WS_OF), 0, !lastl, ((const float*)(ws + WS_LAM))[4 + layer * 2 + 1]); });
            PHASE(6, merge_even_phase(F, P, e, layer, m_post));
        } else {
            PHASE(7, qkv_odd_phase(F, P, e, layer, ldsl));
            PHASE(8, attn_phase<128, GQA_SD, 2048, 16, 4, 4>(F, (const bf16_t*)(ws + WS_Q1), (const bf16_t*)(ws + WS_K1), (const bf16_t*)(ws + WS_V1), (bf16_t*)(ws + WS_AO), 0, !lastl, ((const float*)(ws + WS_LAM))[4 + layer * 2]));
        }
        PHASE(10, { const bf16_t* W = even ? (const bf16_t*)(ws + WS_WOUTAB) + (size_t)e * DM * DM : (const bf16_t*)(ws + WS_WOUTC) + (size_t)e * DM * DM;
                const int m10 = ctx_sel_hidden(F) ? TL : m_post; pg8::Gemm g{(const bf16_t*)(ws + WS_AO), W, m10, DM, DM, DM}; pg8::StaticOrder S; S.init(m10, DM, F.G, F.bx);
                pg8::EpiResid E{X, mod + (size_t)layer * 3 * 12288, 2, layer == 0 ? P.x : (const float*)X, layer == 0 ? P.ctx : (const float*)X + (size_t)TL * DM};
                pg8::gemm_phase<pg8::EpiResid, pg8::StaticOrder>(ldsl, g, S, E, F.wid); });
        PHASE(1, norm_phase(F, P, layer, 1, ctx_sel_hidden(F) ? TL : m_post));
        PHASE(11, { const int m11 = ctx_sel_hidden(F) ? TL : m_post; pg8::Gemm g{Hb, (const bf16_t*)(ws + WS_WPQ) + (size_t)layer * DM * DM, m11, DM, DM, DM}; pg8::StaticOrder S; S.init(m11, DM, F.G, F.bx);
                pg8::EpiBf16 E{(bf16_t*)(ws + WS_PQ), DM};
                pg8::gemm_phase<pg8::EpiBf16, pg8::StaticOrder>(ldsl, g, S, E, F.wid); });
        PHASE(12, peer_select_phase(F, layer, m_post));
        PHASE(13, { const bf16_t* W = even ? (const bf16_t*)(ws + WS_WOUTAB) + (size_t)e * DM * DM : (const bf16_t*)(ws + WS_WOUTC) + (size_t)e * DM * DM;
                peer_expert_phase(F, P, layer, m_post, lastl, dry, ldsl, W); });
    }
#undef PHASE
}

extern "C" void kernel_launch(void* const* d_in, const int* in_sizes, int n_in, void* d_out, int out_size, void* d_ws, size_t ws_size, hipStream_t stream) {
    static int grid = 0;
    if (grid == 0) {
        if (n_in != 28 || ws_size < WS_END) { fprintf(stderr, "kernel_launch: expected 28 inputs and >= %zu bytes of workspace, got %d / %zu\n", (size_t)WS_END, n_in, ws_size); grid = -1; return; }
        int dev = 0, cus = 0, per_cu = 0;
        if (hipGetDevice(&dev) != hipSuccess || hipDeviceGetAttribute(&cus, hipDeviceAttributeMultiprocessorCount, dev) != hipSuccess) { grid = -1; return; }
        if (hipFuncSetAttribute((const void*)mk_fwd, hipFuncAttributeMaxDynamicSharedMemorySize, LDS_BYTES) != hipSuccess) { fprintf(stderr, "kernel_launch: hipFuncSetAttribute failed\n"); grid = -1; return; }
        if (hipOccupancyMaxActiveBlocksPerMultiprocessor(&per_cu, (const void*)mk_fwd, 512, LDS_BYTES) != hipSuccess || per_cu < 1) fprintf(stderr, "kernel_launch: occupancy query says %d\n", per_cu);
        (void)hipGetLastError();
        grid = cus;
    }
    if (grid < 0) return;
    (void)hipMemsetAsync((char*)d_ws + WS_CTL, 0, CTL_BYTES, stream);
    Params p{};
    const float** pf = (const float**)&p;
    for (int i = 0; i < 28; ++i) pf[i] = (const float*)d_in[i];
    p.out = (float*)d_out; p.ws = (unsigned char*)d_ws;
#if MK_PER_PHASE_LAUNCH
    for (int i = 0; i < N_PHASES; ++i) { p.ph_lo = i; p.ph_hi = i + 1; hipLaunchKernelGGL(mk_fwd, dim3(grid), dim3(512), LDS_BYTES, stream, p); }
#else
    p.ph_lo = 0; p.ph_hi = N_PHASES;
    hipLaunchKernelGGL(mk_fwd, dim3(grid), dim3(512), LDS_BYTES, stream, p);
#endif
    const hipError_t le = hipPeekAtLastError();
    if (le != hipSuccess) fprintf(stderr, "kernel_launch: launch failed: %s\n", hipGetErrorName(le));
}
```
